# Optimizing an MI355X kernel written in HIP

```python
import math
import jax
import jax.numpy as jnp
from jax import lax
import numpy as np


D_MODEL = 1024
BATCH = 1
SEQ = 16384
DEPTH = 4

GRID_W = 64
CTX_LEN = 256
N_MOD = 6

GLA_HEADS = 4
GLA_DK = 64
GLA_DV = 128
GLA_K = GLA_HEADS * GLA_DK
GLA_V = GLA_HEADS * GLA_DV
GLA_GATE_RANK = 16
GLA_TAU = 16.0
GLA_CHUNK = 64

RWKV_HEADS = 8
RWKV_N = 64
RWKV_W = RWKV_HEADS * RWKV_N
RWKV_DECAY_RANK = 64
RWKV_A_RANK = 64
RWKV_GATE_RANK = 128
RWKV_GN_EPS = 64e-5
RWKV_SIZES = (RWKV_W, RWKV_W, RWKV_W, RWKV_DECAY_RANK, RWKV_DECAY_RANK, RWKV_A_RANK, RWKV_A_RANK, RWKV_GATE_RANK)
RWKV_IN = sum(RWKV_SIZES)

S5_WIDTH = 512
S5_GROUP = 16
S5_GROUPS = S5_WIDTH // S5_GROUP
S5_STATE = 64

N_BRANCH = 3
BRANCH_W = 512
IN_SIZES = (GLA_K, GLA_K, GLA_V, GLA_V, GLA_GATE_RANK, GLA_GATE_RANK, RWKV_IN, S5_WIDTH, N_BRANCH * D_MODEL)
D_IN = sum(IN_SIZES)

PEER_HEADS = 8
PEER_NKEYS = 128
PEER_EXPERTS = PEER_NKEYS * PEER_NKEYS
PEER_DQ = 256
PEER_HALF = PEER_DQ // 2
PEER_TOPK = 16
PEER_BLOCK = 128

kernel_name = 'hybrid_gla_rwkv7_s5_peer_dit'


def rms_norm(x, g, eps=1e-6):
    xf = x.astype(jnp.float32)
    y = xf * lax.rsqrt(jnp.mean(xf * xf, axis=-1, keepdims=True) + eps)
    return (y * g.astype(jnp.float32)).astype(x.dtype)


def modulate(x, g, shift, scale):
    return rms_norm(x, g) * (1.0 + scale) + shift


def split_last(z, sizes):
    return jnp.split(z, [int(s) for s in np.cumsum(sizes)[:-1]], axis=-1)


def heads(t, n_heads):
    return t.reshape(t.shape[0], t.shape[1], n_heads, -1).astype(jnp.float32)


def flip_seq(t):
    return jnp.flip(t, axis=1)


def to_col_major(t):
    b, l = t.shape[0], t.shape[1]
    rows = l // GRID_W
    rest = t.shape[2:]
    return t.reshape(b, rows, GRID_W, *rest).swapaxes(1, 2).reshape(b, l, *rest)


def from_col_major(t):
    b, l = t.shape[0], t.shape[1]
    rows = l // GRID_W
    rest = t.shape[2:]
    return t.reshape(b, GRID_W, rows, *rest).swapaxes(1, 2).reshape(b, l, *rest)


def token_shift(z, w):
    zp = jnp.pad(z, ((0, 0), (1, 1), (0, 0)))
    return w[0] * zp[:, :-2] + w[1] * zp[:, 1:-1] + w[2] * zp[:, 2:]


def gla_chunk_scan(q, k, v, log_a, s0):
    b, l, h, dk = q.shape
    dv = v.shape[-1]
    nc = l // GLA_CHUNK
    q, k, log_a = [t.reshape(b, nc, GLA_CHUNK, h, dk) for t in (q, k, log_a)]
    v = v.reshape(b, nc, GLA_CHUNK, h, dv)
    cum = jnp.cumsum(log_a, axis=2)
    q_in = q * jnp.exp(cum)
    k_in = k * jnp.exp(-cum)
    lower = jnp.tril(jnp.ones((GLA_CHUNK, GLA_CHUNK), dtype=bool))
    att = jnp.where(lower, jnp.einsum('bnihk,bnjhk->bnhij', q_in, k_in), 0.0)
    o = jnp.einsum('bnhij,bnjhv->bnihv', att, v)
    last = cum[:, :, -1]
    kv = jnp.einsum('bnchk,bnchv->bnhkv', k * jnp.exp(last[:, :, None] - cum), v)

    def step(s, inp):
        dec, kv_n = inp
        return dec[..., None] * s + kv_n, s

    s_fin, s_prev = lax.scan(step, s0, (jnp.moveaxis(jnp.exp(last), 1, 0), jnp.moveaxis(kv, 1, 0)))
    o = o + jnp.einsum('bnchk,nbhkv->bnchv', q_in, s_prev)
    return o.reshape(b, l, h, dv), s_fin


def rwkv_scan(r, w, k, v, kk, a, s0):
    def step(s, inp):
        r_t, w_t, k_t, v_t, kk_t, a_t = inp
        sa = jnp.einsum('bhvk,bhk->bhv', s, -kk_t)
        s = s * w_t[:, :, None, :] + sa[..., None] * (kk_t * a_t)[:, :, None, :] + v_t[..., None] * k_t[:, :, None, :]
        return s, jnp.einsum('bhvk,bhk->bhv', s, r_t)

    xs = tuple(jnp.moveaxis(t, 1, 0) for t in (r, w, k, v, kk, a))
    s_fin, y = lax.scan(step, s0, xs)
    return jnp.moveaxis(y, 0, 1), s_fin


def s5_scan(u, lam_re, lam_im, log_step, b_re, b_im, s0):
    dt = jnp.exp(log_step)[:, None]
    mag = jnp.exp(lam_re * dt)
    a_re = mag * jnp.cos(lam_im * dt)
    a_im = mag * jnp.sin(lam_im * dt)
    den = lam_re * lam_re + lam_im * lam_im
    f_re = ((a_re - 1.0) * lam_re + a_im * lam_im) / den
    f_im = (a_im * lam_re - (a_re - 1.0) * lam_im) / den
    bb_re = f_re[..., None] * b_re - f_im[..., None] * b_im
    bb_im = f_re[..., None] * b_im + f_im[..., None] * b_re
    bu_re = jnp.einsum('gpc,blgc->blgp', bb_re, u)
    bu_im = jnp.einsum('gpc,blgc->blgp', bb_im, u)
    h_re, h_im = s0[:, 0], s0[:, 1]
    bu_re = bu_re.at[:, 0].add(a_re * h_re - a_im * h_im)
    bu_im = bu_im.at[:, 0].add(a_re * h_im + a_im * h_re)
    ar = jnp.broadcast_to(a_re, bu_re.shape)
    ai = jnp.broadcast_to(a_im, bu_re.shape)

    def combine(e1, e2):
        a1r, a1i, b1r, b1i = e1
        a2r, a2i, b2r, b2i = e2
        return (a2r * a1r - a2i * a1i, a2r * a1i + a2i * a1r,
                a2r * b1r - a2i * b1i + b2r, a2r * b1i + a2i * b1r + b2i)

    _, _, xr, xi = lax.associative_scan(combine, (ar, ai, bu_re, bu_im), axis=1)
    x = jnp.stack([xr, xi], axis=2)
    return x, x[:, -1]


def two_dir(scan_fn, ctx_f, lat_f, ctx_b, lat_b, p_f, p_b, s0):
    yc_f, sc_f = scan_fn(*ctx_f, *p_f, s0)
    yl_f, _ = scan_fn(*lat_f, *p_f, sc_f)
    yc_b, sc_b = scan_fn(*[flip_seq(t) for t in ctx_b], *p_b, s0)
    yl_b, _ = scan_fn(*[flip_seq(t) for t in lat_b], *p_b, sc_b)
    return yc_f + flip_seq(yc_b), yl_f + flip_seq(yl_b)


def token_mixers(hc, hl, need_ctx, w_in, gla_w_a2, gla_b_a, gla_norm_g, rwkv_conv, rwkv_w0, rwkv_w2,
                 rwkv_a0, rwkv_a2, rwkv_g2, rwkv_k_k, rwkv_k_a, rwkv_r_k, rwkv_ln_w, rwkv_ln_b,
                 s5_lam_re, s5_lam_im, s5_log_step, s5_b_re, s5_b_im, s5_c_re, s5_c_im, s5_d, s5_w_glu,
                 w_branch, w_out):
    bsz = hl.shape[0]
    zc = split_last(hc @ w_in, IN_SIZES)
    zl = split_last(hl @ w_in, IN_SIZES)

    def gla_prep(z, col_major):
        q, k, v, a_f, a_b = z[0], z[1], z[2], z[4], z[5]
        la = [jax.nn.log_sigmoid(heads(lr @ gla_w_a2[d] + gla_b_a[d], GLA_HEADS)) / GLA_TAU
              for d, lr in enumerate((a_f, a_b))]
        seq = [heads(q, GLA_HEADS) * GLA_DK ** -0.5, heads(k, GLA_HEADS), heads(v, GLA_HEADS)] + la
        return [to_col_major(t) for t in seq] if col_major else seq

    gc, gl = gla_prep(zc, False), gla_prep(zl, True)
    s0 = jnp.zeros((bsz, GLA_HEADS, GLA_DK, GLA_DV), jnp.float32)
    gla_c, gla_l = two_dir(gla_chunk_scan, gc[:4], gl[:4], gc[:3] + gc[4:], gl[:3] + gl[4:], (), (), s0)
    gla_l = from_col_major(gla_l)

    k_a = rwkv_k_a.reshape(RWKV_HEADS, RWKV_N)

    def rwkv_prep(zr):
        zr = token_shift(zr, rwkv_conv)
        r, k, v, w_f, w_b, a_f, a_b, g = split_last(zr, RWKV_SIZES)
        decay = [jnp.exp(-jnp.exp(-jax.nn.softplus(-heads(rwkv_w0[d] + jnp.tanh(lr) @ rwkv_w2[d], RWKV_HEADS)) - 0.5))
                 for d, lr in enumerate((w_f, w_b))]
        a = [jax.nn.sigmoid(heads(rwkv_a0[d] + lr @ rwkv_a2[d], RWKV_HEADS)) for d, lr in enumerate((a_f, a_b))]
        kk = heads(k * rwkv_k_k, RWKV_HEADS)
        kk = kk / jnp.maximum(jnp.sqrt(jnp.sum(kk * kk, axis=-1, keepdims=True)), 1e-12)
        kh, rh, vh = heads(k, RWKV_HEADS), heads(r, RWKV_HEADS), heads(v, RWKV_HEADS)
        kd = [kh * (1.0 + (ad - 1.0) * k_a) for ad in a]
        seqs = [(rh, decay[d], kd[d], vh, kk, a[d]) for d in range(2)]
        return seqs, (rh, kd[0] + kd[1], vh, g)

    (rc, ec), (rl, el) = rwkv_prep(zc[6]), rwkv_prep(zl[6])
    s0 = jnp.zeros((bsz, RWKV_HEADS, RWKV_N, RWKV_N), jnp.float32)
    rwkv_c, rwkv_l = two_dir(rwkv_scan, rc[0], rl[0], rc[1], rl[1], (), (), s0)

    uc, ul = heads(zc[7], S5_GROUPS), heads(zl[7], S5_GROUPS)
    p_f = (s5_lam_re[0], s5_lam_im[0], s5_log_step[0], s5_b_re, s5_b_im)
    p_b = (s5_lam_re[1], s5_lam_im[1], s5_log_step[1], s5_b_re, s5_b_im)
    s0 = jnp.zeros((bsz, 2, S5_GROUPS, S5_STATE), jnp.float32)
    x5_c, x5_l = two_dir(s5_scan, (uc,), (ul,), (uc,), (ul,), p_f, p_b, s0)

    def side_out(z, o_gla, y_rwkv, extra, x_s5, u):
        b, l = o_gla.shape[0], o_gla.shape[1]
        o_gla = o_gla * lax.rsqrt(jnp.mean(o_gla * o_gla, -1, keepdims=True) + 1e-6) * gla_norm_g
        br_gla = o_gla.reshape(b, l, GLA_V) * jax.nn.silu(z[3].astype(jnp.float32))
        rh, kd_sum, vh, g = extra
        mu = jnp.mean(y_rwkv, -1, keepdims=True)
        var = jnp.mean(jnp.square(y_rwkv - mu), -1, keepdims=True)
        y = ((y_rwkv - mu) * lax.rsqrt(var + RWKV_GN_EPS)).reshape(b, l, RWKV_W) * rwkv_ln_w + rwkv_ln_b
        y = y + (jnp.sum(rh * kd_sum * rwkv_r_k, -1, keepdims=True) * vh).reshape(b, l, RWKV_W)
        br_rwkv = y * (jax.nn.sigmoid(g) @ rwkv_g2)
        ys = (jnp.einsum('gcp,blgp->blgc', s5_c_re, x_s5[:, :, 0])
              - jnp.einsum('gcp,blgp->blgc', s5_c_im, x_s5[:, :, 1]))
        ys = (ys + s5_d.reshape(S5_GROUPS, S5_GROUP) * u).reshape(b, l, S5_WIDTH)
        lin, glu_gate = jnp.split(jax.nn.gelu(ys) @ s5_w_glu, 2, axis=-1)
        br_s5 = lin * jax.nn.sigmoid(glu_gate)
        gates = jax.nn.sigmoid(z[8].reshape(b, l, N_BRANCH, D_MODEL).astype(jnp.float32))
        br = jnp.einsum('blnc,ncd->blnd', jnp.stack([br_gla, br_rwkv, br_s5], axis=2), w_branch)
        return jnp.sum(gates * br, axis=2) @ w_out

    ml = side_out(zl, gla_l, rwkv_l, el, x5_l, ul)
    mc = side_out(zc, gla_c, rwkv_c, ec, x5_c, uc) if need_ctx else None
    return mc, ml


def peer_ffn(t, w_q, sub_keys, u, v):
    n = t.shape[0]
    q = (t @ w_q).reshape(n, PEER_HEADS, 2, PEER_HALF).astype(jnp.float32)
    s = jnp.einsum('nhsd,hskd->nhsk', q, sub_keys.astype(jnp.float32))
    s1, i1 = lax.top_k(s[:, :, 0], PEER_TOPK)
    s2, i2 = lax.top_k(s[:, :, 1], PEER_TOPK)
    cand = (s1[..., :, None] + s2[..., None, :]).reshape(n, PEER_HEADS, PEER_TOPK * PEER_TOPK)
    cidx = (i1[..., :, None] * PEER_NKEYS + i2[..., None, :]).reshape(n, PEER_HEADS, PEER_TOPK * PEER_TOPK)
    top, pos = lax.top_k(cand, PEER_TOPK)
    idx = jnp.take_along_axis(cidx, pos, axis=-1)
    g = jax.nn.softmax(top, axis=-1)
    nb = n // PEER_BLOCK

    def block(args):
        tb, ib, gb = args
        act = jax.nn.gelu(jnp.einsum('td,thkd->thk', tb, u[ib]).astype(jnp.float32))
        return jnp.einsum('thk,thkd->td', (gb * act).astype(v.dtype), v[ib])

    out = lax.map(block, (t.reshape(nb, PEER_BLOCK, t.shape[-1]),
                          idx.reshape(nb, PEER_BLOCK, PEER_HEADS, PEER_TOPK),
                          g.reshape(nb, PEER_BLOCK, PEER_HEADS, PEER_TOPK)))
    return out.reshape(n, -1)


def setup_inputs(seed: int = 0) -> dict:
    key = jax.random.key(seed)
    keys = iter(jax.random.split(key, 48))
    f32 = jnp.float32

    def nrm(shape, scale):
        return jax.random.normal(next(keys), shape, f32) * scale

    L, D = DEPTH, D_MODEL
    log_lo, log_hi = math.log(1e-3), math.log(1e-1)
    return {
        'x': nrm((BATCH, SEQ, D), 1.0),
        'c': nrm((BATCH, D), 1.0),
        'ctx': nrm((BATCH, CTX_LEN, D), 1.0),
        'c_ctx': nrm((D,), 1.0),
        'w_mod': nrm((L, D, N_MOD * D), 0.5 * D ** -0.5),
        'b_mod': nrm((L, N_MOD * D), 0.02),
        'norm1_g': 1.0 + nrm((L, D), 0.02),
        'norm2_g': 1.0 + nrm((L, D), 0.02),
        'w_in': nrm((L, D, D_IN), D ** -0.5),
        'gla_w_a2': nrm((L, 2, GLA_GATE_RANK, GLA_K), GLA_GATE_RANK ** -0.5),
        'gla_b_a': nrm((L, 2, GLA_K), 0.1),
        'gla_norm_g': 1.0 + nrm((L, GLA_DV), 0.02),
        'rwkv_conv': jnp.array([0.25, 0.5, 0.25], f32)[None, :, None] + nrm((L, 3, RWKV_IN), 0.05),
        'rwkv_w0': jnp.linspace(-6.5, -1.5, RWKV_W, dtype=f32) + nrm((L, 2, RWKV_W), 0.1),
        'rwkv_w2': nrm((L, 2, RWKV_DECAY_RANK, RWKV_W), 0.1),
        'rwkv_a0': nrm((L, 2, RWKV_W), 0.1),
        'rwkv_a2': nrm((L, 2, RWKV_A_RANK, RWKV_W), 0.1),
        'rwkv_g2': nrm((L, RWKV_GATE_RANK, RWKV_W), RWKV_GATE_RANK ** -0.5),
        'rwkv_k_k': 0.85 + nrm((L, RWKV_W), 0.02),
        'rwkv_k_a': 1.0 + nrm((L, RWKV_W), 0.02),
        'rwkv_r_k': nrm((L, RWKV_HEADS, RWKV_N), 0.1),
        'rwkv_ln_w': 1.0 + nrm((L, RWKV_W), 0.02),
        'rwkv_ln_b': nrm((L, RWKV_W), 0.02),
        's5_lam_re': -0.5 + nrm((L, 2, S5_GROUPS, S5_STATE), 0.01),
        's5_lam_im': math.pi * jnp.arange(S5_STATE, dtype=f32) + nrm((L, 2, S5_GROUPS, S5_STATE), 0.01),
        's5_log_step': log_lo + (log_hi - log_lo) * jax.random.uniform(next(keys), (L, 2, S5_GROUPS), f32),
        's5_b_re': nrm((L, S5_GROUPS, S5_STATE, S5_GROUP), (2 * S5_GROUP) ** -0.5),
        's5_b_im': nrm((L, S5_GROUPS, S5_STATE, S5_GROUP), (2 * S5_GROUP) ** -0.5),
        's5_c_re': nrm((L, S5_GROUPS, S5_GROUP, S5_STATE), S5_STATE ** -0.5),
        's5_c_im': nrm((L, S5_GROUPS, S5_GROUP, S5_STATE), S5_STATE ** -0.5),
        's5_d': nrm((L, S5_WIDTH), 0.5),
        's5_w_glu': nrm((L, S5_WIDTH, 2 * S5_WIDTH), S5_WIDTH ** -0.5),
        'w_branch': nrm((L, N_BRANCH, BRANCH_W, D), BRANCH_W ** -0.5),
        'w_out': nrm((L, D, D), D ** -0.5),
        'peer_w_q': nrm((L, D, PEER_HEADS * PEER_DQ), D ** -0.5),
        'peer_sub_keys': nrm((L, PEER_HEADS, 2, PEER_NKEYS, PEER_HALF), PEER_HALF ** -0.5),
        'peer_u': nrm((L, PEER_EXPERTS, D), D ** -0.5),
        'peer_v': nrm((L, PEER_EXPERTS, D), PEER_HEADS ** -0.5),
        'final_g': 1.0 + nrm((D,), 0.02),
    }


def reference(x, c, ctx, c_ctx, w_mod, b_mod, norm1_g, norm2_g, w_in, gla_w_a2, gla_b_a, gla_norm_g,
              rwkv_conv, rwkv_w0, rwkv_w2, rwkv_a0, rwkv_a2, rwkv_g2, rwkv_k_k, rwkv_k_a, rwkv_r_k,
              rwkv_ln_w, rwkv_ln_b, s5_lam_re, s5_lam_im, s5_log_step, s5_b_re, s5_b_im, s5_c_re, s5_c_im,
              s5_d, s5_w_glu, w_branch, w_out, peer_w_q, peer_sub_keys, peer_u, peer_v, final_g):
    xl, xc = x, ctx
    for i in range(DEPTH):
        last = i == DEPTH - 1
        mod_l = (jax.nn.silu(c) @ w_mod[i] + b_mod[i])[:, None, :]
        mod_c = jax.nn.silu(c_ctx) @ w_mod[i] + b_mod[i]
        sh1, sc1, g1, sh2, sc2, g2 = jnp.split(mod_l, N_MOD, axis=-1)
        csh1, csc1, cg1, csh2, csc2, cg2 = jnp.split(mod_c, N_MOD, axis=-1)
        mc, ml = token_mixers(
            modulate(xc, norm1_g[i], csh1, csc1), modulate(xl, norm1_g[i], sh1, sc1), not last,
            w_in[i], gla_w_a2[i], gla_b_a[i], gla_norm_g[i], rwkv_conv[i], rwkv_w0[i], rwkv_w2[i],
            rwkv_a0[i], rwkv_a2[i], rwkv_g2[i], rwkv_k_k[i], rwkv_k_a[i], rwkv_r_k[i], rwkv_ln_w[i],
            rwkv_ln_b[i], s5_lam_re[i], s5_lam_im[i], s5_log_step[i], s5_b_re[i], s5_b_im[i],
            s5_c_re[i], s5_c_im[i], s5_d[i], s5_w_glu[i], w_branch[i], w_out[i])
        xl = xl + g1 * ml
        hl = modulate(xl, norm2_g[i], sh2, sc2)
        if last:
            f = peer_ffn(hl.reshape(-1, D_MODEL), peer_w_q[i], peer_sub_keys[i], peer_u[i], peer_v[i])
            xl = xl + g2 * f.reshape(xl.shape)
        else:
            xc = xc + cg1 * mc
            hc = modulate(xc, norm2_g[i], csh2, csc2)
            n_c = hc.shape[0] * hc.shape[1]
            f = peer_ffn(jnp.concatenate([hc.reshape(-1, D_MODEL), hl.reshape(-1, D_MODEL)], axis=0),
                         peer_w_q[i], peer_sub_keys[i], peer_u[i], peer_v[i])
            xc = xc + cg2 * f[:n_c].reshape(xc.shape)
            xl = xl + g2 * f[n_c:].reshape(xl.shape)
    return rms_norm(xl, final_g)
```

```cpp
#include <hip/hip_runtime.h>
#ifndef EMU
#include <hip/hip_cooperative_groups.h>
namespace cg = cooperative_groups;
#endif
#include <cstdio>
#include <cstdint>
#include <cstring>

#ifdef CFG_SMALL
#define D_MODEL 128
#define SEQ 512
#define DEPTH 2
#define GRID_W 8
#define CTX 128
#define GH 1
#define RH 2
#define SG 8
#define PH 2
#else
#define D_MODEL 1024
#define SEQ 16384
#define DEPTH 4
#define GRID_W 64
#define CTX 256
#define GH 4
#define RH 8
#define SG 32
#define PH 8
#endif
#define MTOT (CTX + SEQ)
#define ROWS (SEQ / GRID_W)
#define GLA_K (GH * 64)
#define GLA_V (GH * 128)
#define RW (RH * 64)
#define RWKV_IN (3 * RW + 4 * 64 + 128)
#define SW (SG * 16)
#define BW GLA_V
#define ZQ 0
#define ZK (GLA_K)
#define ZV (2 * GLA_K)
#define ZOG (ZV + GLA_V)
#define ZAF (ZOG + GLA_V)
#define ZAB (ZAF + 16)
#define ZR (ZAB + 16)
#define ZS5 (ZR + RWKV_IN)
#define ZG (ZS5 + SW)
#define D_IN (ZG + 3 * D_MODEL)
#define NC (MTOT / 64)
#define NCC (CTX / 64)
#define RB (ROWS / 64)
#define PQ (PH * 256)
#define NEXP 16384
#define NTHREADS 256
#define SMEM_BYTES 102400

typedef unsigned short bf16_t;

__device__ __forceinline__ float bf2f(bf16_t h) { return __builtin_bit_cast(float, ((unsigned)h) << 16); }
__device__ __forceinline__ bf16_t f2bf(float f) { unsigned u = __builtin_bit_cast(unsigned, f); u += 0x7FFFu + ((u >> 16) & 1u); return (bf16_t)(u >> 16); }
__device__ __forceinline__ float sigmoidf_(float x) { return 1.0f / (1.0f + expf(-x)); }
__device__ __forceinline__ float siluf_(float x) { return x * sigmoidf_(x); }
__device__ __forceinline__ float geluf_(float x) { return 0.5f * x * (1.0f + tanhf(0.7978845608028654f * (x + 0.044715f * x * x * x))); }
__device__ __forceinline__ float softplusf_(float x) { return fmaxf(x, 0.f) + log1pf(expf(-fabsf(x))); }
__device__ __forceinline__ float wave_sum(float v) {
#pragma unroll
    for (int m = 32; m >= 1; m >>= 1) v += __shfl_xor(v, m, 64);
    return v;
}

struct P {
    const float* in[39];
    float* out;
    float* X;
    bf16_t* H;
    bf16_t* Z;
    float* MOD;
    bf16_t* R; bf16_t* V; bf16_t* KK; bf16_t* KD; bf16_t* BB;
    float* W;
    float* BONUS;
    bf16_t* GS;
    float* Y;
    float* KV;
    float* DEC;
    float* OGLA;
    float* S5A;
    float* S5BB;
    float* S5END;
    bf16_t* GY;
    float* YN;
    bf16_t* BR;
    bf16_t* M;
    float* Q;
    int* IDX;
    float* G;
    unsigned* bar;
};

enum { I_X = 0, I_C, I_CTX, I_CCTX, I_WMOD, I_BMOD, I_N1G, I_N2G, I_WIN, I_GLA_WA2, I_GLA_BA, I_GLA_NG, I_RCONV, I_RW0, I_RW2, I_RA0, I_RA2, I_RG2,
       I_RKK, I_RKA, I_RRK, I_RLNW, I_RLNB, I_S5LRE, I_S5LIM, I_S5LS, I_S5BRE, I_S5BIM, I_S5CRE, I_S5CIM, I_S5D, I_S5GLU, I_WBR, I_WOUT, I_PWQ, I_PKEYS, I_PU, I_PV, I_FG };

#ifdef EMU
#define WAVE_SYNC() emu_wave_barrier()
#ifndef EMU_GRID
#define EMU_GRID 4
#endif
#else
#define WAVE_SYNC() __builtin_amdgcn_wave_barrier()
#endif
__device__ __forceinline__ void grid_sync_all() {
#ifdef EMU
    emu_grid_sync();
#else
    cg::this_grid().sync();
#endif
}

__device__ __forceinline__ int gla_tok(int n, int i) {
    if (n < NCC) return n * 64 + i;
    int m = n - NCC; int col = m / RB, rb = m % RB;
    return CTX + (rb * 64 + i) * GRID_W + col;
}
__device__ __forceinline__ int chunk_order(int d, int s) {
    if (d == 0) return s;
    return (s < NCC) ? (NCC - 1 - s) : (NC - 1 - (s - NCC));
}
__device__ __forceinline__ int tok_order(int d, int s) {
    if (d == 0) return s;
    return (s < CTX) ? (CTX - 1 - s) : (MTOT - 1 - (s - CTX));
}

__device__ __forceinline__ void gemm_core(const bf16_t* A, int lda, const float* B, int ldb, int K, int m0, int n0, int N, float* lds, float (&acc)[4][4]) {
    float* As = lds; float* Bs = lds + 16 * 68;
    const int tid = threadIdx.x, ty = tid >> 4, tx = tid & 15;
    for (int k0 = 0; k0 < K; k0 += 16) {
        {
            int r = tid >> 2, kq = (tid & 3) * 4;
            const bf16_t* ap = A + (size_t)(m0 + r) * lda + k0 + kq;
#pragma unroll
            for (int j = 0; j < 4; ++j) As[(kq + j) * 68 + r] = bf2f(ap[j]);
        }
        {
            int k = tid >> 4, nq = (tid & 15) * 4;
#pragma unroll
            for (int j = 0; j < 4; ++j) { int n = n0 + nq + j; Bs[k * 68 + nq + j] = (n < N) ? B[(size_t)(k0 + k) * ldb + n] : 0.f; }
        }
        __syncthreads();
#pragma unroll
        for (int k = 0; k < 16; ++k) {
            float a[4], b[4];
#pragma unroll
            for (int i = 0; i < 4; ++i) { a[i] = As[k * 68 + ty * 4 + i]; b[i] = Bs[k * 68 + tx * 4 + i]; }
#pragma unroll
            for (int i = 0; i < 4; ++i)
#pragma unroll
                for (int j = 0; j < 4; ++j) acc[i][j] += a[i] * b[j];
        }
        __syncthreads();
    }
}
#define ZERO_ACC(acc) { _Pragma("unroll") for (int i_ = 0; i_ < 4; ++i_) _Pragma("unroll") for (int j_ = 0; j_ < 4; ++j_) acc[i_][j_] = 0.f; }

__device__ __forceinline__ void phase_init(const P& p, char* smem) {
    const int tid = threadIdx.x;
    float* sc = (float*)smem;
    for (int i = tid; i < D_MODEL; i += NTHREADS) { sc[i] = siluf_(p.in[I_CCTX][i]); sc[D_MODEL + i] = siluf_(p.in[I_C][i]); }
    __syncthreads();
    const int ncolblk = (6 * D_MODEL) / NTHREADS;
    for (int job = blockIdx.x; job < DEPTH * ncolblk; job += gridDim.x) {
        int l = job / ncolblk, n = (job % ncolblk) * NTHREADS + tid;
        const float* w = p.in[I_WMOD] + (size_t)l * D_MODEL * 6 * D_MODEL + n;
        float a0 = 0.f, a1 = 0.f;
        for (int k = 0; k < D_MODEL; ++k) { float wv = w[(size_t)k * 6 * D_MODEL]; a0 += sc[k] * wv; a1 += sc[D_MODEL + k] * wv; }
        float b = p.in[I_BMOD][l * 6 * D_MODEL + n];
        p.MOD[(size_t)(l * 2 + 0) * 6 * D_MODEL + n] = a0 + b;
        p.MOD[(size_t)(l * 2 + 1) * 6 * D_MODEL + n] = a1 + b;
    }
    const size_t gtid = (size_t)blockIdx.x * NTHREADS + tid, gn = (size_t)gridDim.x * NTHREADS;
    for (size_t i = gtid; i < (size_t)CTX * D_MODEL; i += gn) p.X[i] = p.in[I_CTX][i];
    for (size_t i = gtid; i < (size_t)SEQ * D_MODEL; i += gn) p.X[(size_t)CTX * D_MODEL + i] = p.in[I_X][i];
    __syncthreads();
}

__device__ __forceinline__ void phase_s5const(const P& p, int l) {
    const size_t gtid = (size_t)blockIdx.x * NTHREADS + threadIdx.x, gn = (size_t)gridDim.x * NTHREADS;
    for (size_t i = gtid; i < (size_t)2 * SG * 64; i += gn) {
        int d = (int)(i / (SG * 64)), g = (int)((i / 64) % SG), s = (int)(i % 64);
        size_t li = ((size_t)(l * 2 + d) * SG + g) * 64 + s;
        float lre = p.in[I_S5LRE][li], lim = p.in[I_S5LIM][li];
        float dt = expf(p.in[I_S5LS][(l * 2 + d) * SG + g]);
        float mag = expf(lre * dt);
        float are = mag * cosf(lim * dt), aim = mag * sinf(lim * dt);
        float den = lre * lre + lim * lim;
        float fre = ((are - 1.0f) * lre + aim * lim) / den;
        float fim = (aim * lre - (are - 1.0f) * lim) / den;
        p.S5A[i * 2 + 0] = are; p.S5A[i * 2 + 1] = aim;
        const float* bre = p.in[I_S5BRE] + (((size_t)l * SG + g) * 64 + s) * 16;
        const float* bim = p.in[I_S5BIM] + (((size_t)l * SG + g) * 64 + s) * 16;
        for (int c = 0; c < 16; ++c) {
            p.S5BB[(i * 16 + c) * 2 + 0] = fre * bre[c] - fim * bim[c];
            p.S5BB[(i * 16 + c) * 2 + 1] = fre * bim[c] + fim * bre[c];
        }
    }
}

__device__ __forceinline__ void phase_norm(const P& p, int l, int which) {
    const int lane = threadIdx.x & 63;
    const int gw = (blockIdx.x * NTHREADS + threadIdx.x) >> 6, nw = (gridDim.x * NTHREADS) >> 6;
    const float* g = p.in[which ? I_N2G : I_N1G] + l * D_MODEL;
    for (int t = gw; t < MTOT; t += nw) {
        const float* x = p.X + (size_t)t * D_MODEL;
        const float* mod = p.MOD + (size_t)(l * 2 + (t >= CTX ? 1 : 0)) * 6 * D_MODEL + (which ? 3 * D_MODEL : 0);
        float v[D_MODEL / 64]; float ss = 0.f;
#pragma unroll
        for (int j = 0; j < D_MODEL / 64; ++j) { v[j] = x[lane + 64 * j]; ss += v[j] * v[j]; }
        ss = wave_sum(ss);
        float rstd = rsqrtf(ss / D_MODEL + 1e-6f);
#pragma unroll
        for (int j = 0; j < D_MODEL / 64; ++j) {
            int e = lane + 64 * j;
            p.H[(size_t)t * D_MODEL + e] = f2bf(v[j] * rstd * g[e] * (1.0f + mod[D_MODEL + e]) + mod[e]);
        }
    }
}

__device__ __forceinline__ void phase_gemm_in(const P& p, int l, char* smem) {
    const int tid = threadIdx.x, ty = tid >> 4, tx = tid & 15;
    const int ntn = (D_IN + 63) / 64, ntm = MTOT / 64;
    const float* B = p.in[I_WIN] + (size_t)l * D_MODEL * D_IN;
    for (int job = blockIdx.x; job < ntm * ntn; job += gridDim.x) {
        int m0 = (job / ntn) * 64, n0 = (job % ntn) * 64;
        float acc[4][4]; ZERO_ACC(acc);
        gemm_core(p.H, D_MODEL, B, D_IN, D_MODEL, m0, n0, D_IN, (float*)smem, acc);
#pragma unroll
        for (int i = 0; i < 4; ++i)
#pragma unroll
            for (int j = 0; j < 4; ++j) { int n = n0 + tx * 4 + j; if (n < D_IN) p.Z[(size_t)(m0 + ty * 4 + i) * D_IN + n] = f2bf(acc[i][j]); }
    }
}

#define RTOK 4
__device__ __forceinline__ void phase_rwkv_prep(const P& p, int l, char* smem) {
    const int tid = threadIdx.x, lane = tid & 63;
    float* zs = (float*)smem;
    const float* conv = p.in[I_RCONV] + (size_t)l * 3 * RWKV_IN;
    const float* w0 = p.in[I_RW0] + (size_t)l * 2 * RW;
    const float* w2 = p.in[I_RW2] + (size_t)l * 2 * 64 * RW;
    const float* a0 = p.in[I_RA0] + (size_t)l * 2 * RW;
    const float* a2 = p.in[I_RA2] + (size_t)l * 2 * 64 * RW;
    const float* k_k = p.in[I_RKK] + (size_t)l * RW;
    const float* k_a = p.in[I_RKA] + (size_t)l * RW;
    const float* r_k = p.in[I_RRK] + (size_t)l * RW;
    for (int job = blockIdx.x; job < MTOT / RTOK; job += gridDim.x) {
        const int t0 = job * RTOK;
        __syncthreads();
        for (int idx = tid; idx < RTOK * RWKV_IN; idx += NTHREADS) {
            int tt = idx / RWKV_IN, c = idx % RWKV_IN; int t = t0 + tt;
            bool first = (t == 0) || (t == CTX), last = (t == CTX - 1) || (t == MTOT - 1);
            const bf16_t* zp = p.Z + (size_t)t * D_IN + ZR + c;
            float v = conv[RWKV_IN + c] * bf2f(zp[0]);
            if (!first) v += conv[c] * bf2f(zp[-D_IN]);
            if (!last) v += conv[2 * RWKV_IN + c] * bf2f(zp[D_IN]);
            if (c >= 3 * RW && c < 3 * RW + 128) v = tanhf(v);
            zs[idx] = v;
        }
        __syncthreads();
        for (int c = tid; c < RW; c += NTHREADS) {
            const int h = c >> 6;
            float accw[2][RTOK], acca[2][RTOK];
#pragma unroll
            for (int d = 0; d < 2; ++d)
#pragma unroll
                for (int tt = 0; tt < RTOK; ++tt) { accw[d][tt] = w0[d * RW + c]; acca[d][tt] = a0[d * RW + c]; }
            for (int j = 0; j < 64; ++j) {
#pragma unroll
                for (int d = 0; d < 2; ++d) {
                    float wv = w2[((size_t)d * 64 + j) * RW + c], av = a2[((size_t)d * 64 + j) * RW + c];
#pragma unroll
                    for (int tt = 0; tt < RTOK; ++tt) {
                        accw[d][tt] += zs[tt * RWKV_IN + 3 * RW + d * 64 + j] * wv;
                        acca[d][tt] += zs[tt * RWKV_IN + 3 * RW + 128 + d * 64 + j] * av;
                    }
                }
            }
#pragma unroll
            for (int tt = 0; tt < RTOK; ++tt) {
                const int t = t0 + tt;
                float r = zs[tt * RWKV_IN + c], k = zs[tt * RWKV_IN + RW + c], v = zs[tt * RWKV_IN + 2 * RW + c];
                float kkr = k * k_k[c];
                float nrm = wave_sum(kkr * kkr);
                float kk = kkr / fmaxf(sqrtf(nrm), 1e-12f);
                float kdsum = 0.f;
#pragma unroll
                for (int d = 0; d < 2; ++d) {
                    float dec = expf(-expf(-softplusf_(-accw[d][tt]) - 0.5f));
                    float aa = sigmoidf_(acca[d][tt]);
                    float kd = k * (1.0f + (aa - 1.0f) * k_a[c]);
                    kdsum += kd;
                    size_t o = ((size_t)d * MTOT + t) * RW + c;
                    p.W[o] = dec; p.KD[o] = f2bf(kd); p.BB[o] = f2bf(kk * aa);
                }
                size_t o = (size_t)t * RW + c;
                p.R[o] = f2bf(r); p.V[o] = f2bf(v); p.KK[o] = f2bf(kk);
                float bon = wave_sum(r * kdsum * r_k[c]);
                if (lane == 0) p.BONUS[(size_t)t * RH + h] = bon;
            }
        }
        for (int idx = tid; idx < RTOK * 128; idx += NTHREADS) {
            int tt = idx >> 7, j = idx & 127;
            p.GS[(size_t)(t0 + tt) * 128 + j] = f2bf(sigmoidf_(zs[tt * RWKV_IN + 3 * RW + 256 + j]));
        }
    }
    __syncthreads();
}

#define G_SQ 0
#define G_SK 4096
#define G_SV 8192
#define G_CUM 16384
#define G_ATT 20480
#define G_END 24576
__device__ __forceinline__ void gla_load(const P& p, int l, int n, int h, int d, float* s) {
    const int tid = threadIdx.x;
    float* alr = s + G_ATT;
    for (int idx = tid; idx < 64 * 64; idx += NTHREADS) {
        int i = idx >> 6, c = idx & 63; int t = gla_tok(n, i);
        const bf16_t* z = p.Z + (size_t)t * D_IN;
        s[G_SQ + idx] = bf2f(z[ZQ + h * 64 + c]) * 0.125f;
        s[G_SK + idx] = bf2f(z[ZK + h * 64 + c]);
    }
    for (int idx = tid; idx < 64 * 128; idx += NTHREADS) {
        int i = idx >> 7, c = idx & 127; int t = gla_tok(n, i);
        s[G_SV + idx] = bf2f(p.Z[(size_t)t * D_IN + ZV + h * 128 + c]);
    }
    for (int idx = tid; idx < 64 * 16; idx += NTHREADS) {
        int i = idx >> 4, r = idx & 15; int t = gla_tok(n, i);
        alr[idx] = bf2f(p.Z[(size_t)t * D_IN + (d ? ZAB : ZAF) + r]);
    }
    __syncthreads();
    const float* wa2 = p.in[I_GLA_WA2] + ((size_t)(l * 2 + d) * 16) * GLA_K + h * 64;
    const float* ba = p.in[I_GLA_BA] + (size_t)(l * 2 + d) * GLA_K + h * 64;
    for (int idx = tid; idx < 64 * 64; idx += NTHREADS) {
        int i = idx >> 6, c = idx & 63;
        float a = ba[c];
#pragma unroll
        for (int r = 0; r < 16; ++r) a += alr[i * 16 + r] * wa2[(size_t)r * GLA_K + c];
        float ls = fminf(a, 0.f) - log1pf(expf(-fabsf(a)));
        s[G_CUM + idx] = ls * (1.0f / 16.0f);
    }
    __syncthreads();
    if (tid < 64) {
        float run = 0.f;
        if (d == 0) { for (int i = 0; i < 64; ++i) { run += s[G_CUM + i * 64 + tid]; s[G_CUM + i * 64 + tid] = run; } }
        else { for (int i = 63; i >= 0; --i) { run += s[G_CUM + i * 64 + tid]; s[G_CUM + i * 64 + tid] = run; } }
    }
    __syncthreads();
}

__device__ __forceinline__ void phase_gla_kv(const P& p, int l, char* smem) {
    float* s = (float*)smem;
    const int tid = threadIdx.x;
    for (int job = blockIdx.x; job < NC * GH; job += gridDim.x) {
        const int n = job / GH, h = job % GH;
        for (int d = 0; d < 2; ++d) {
            __syncthreads();
            gla_load(p, l, n, h, d, s);
            const int li = d ? 0 : 63;
            for (int idx = tid; idx < 64 * 64; idx += NTHREADS) {
                int c = idx & 63;
                s[G_SQ + idx] = s[G_SK + idx] * expf(s[G_CUM + li * 64 + c] - s[G_CUM + idx]);
            }
            if (tid < 64) p.DEC[((size_t)(d * NC + n) * GH + h) * 64 + tid] = expf(s[G_CUM + li * 64 + tid]);
            __syncthreads();
            float* kv = p.KV + ((size_t)(d * NC + n) * GH + h) * 64 * 128;
            const int dv = tid & 127, kh = (tid >> 7) * 32;
            float acc[32];
#pragma unroll
            for (int j = 0; j < 32; ++j) acc[j] = 0.f;
            for (int i = 0; i < 64; ++i) {
                float vv = s[G_SV + i * 128 + dv];
#pragma unroll
                for (int j = 0; j < 32; ++j) acc[j] += s[G_SQ + i * 64 + kh + j] * vv;
            }
#pragma unroll
            for (int j = 0; j < 32; ++j) kv[(size_t)(kh + j) * 128 + dv] = acc[j];
        }
    }
    __syncthreads();
}

__device__ __forceinline__ void gla_scan_job(const P& p, int job) {
    int base = job * NTHREADS + threadIdx.x;
    int d = base / (GH * 8192), h = (base / 8192) % GH, e = base % 8192;
    float S = 0.f;
    for (int s = 0; s < NC; ++s) {
        int n = chunk_order(d, s);
        size_t o = ((size_t)(d * NC + n) * GH + h);
        float kv = p.KV[o * 8192 + e];
        float dec = p.DEC[o * 64 + (e >> 7)];
        p.KV[o * 8192 + e] = S;
        S = dec * S + kv;
    }
}

__device__ __forceinline__ void phase_gla_out(const P& p, int l, char* smem) {
    float* s = (float*)smem;
    const int tid = threadIdx.x;
    const int tx = tid & 31, ty = tid >> 5;
    for (int job = blockIdx.x; job < NC * GH; job += gridDim.x) {
        const int n = job / GH, h = job % GH;
        float o[8][4];
#pragma unroll
        for (int i = 0; i < 8; ++i)
#pragma unroll
            for (int j = 0; j < 4; ++j) o[i][j] = 0.f;
        for (int d = 0; d < 2; ++d) {
            __syncthreads();
            gla_load(p, l, n, h, d, s);
            for (int idx = tid; idx < 64 * 64; idx += NTHREADS) {
                float c = s[G_CUM + idx];
                s[G_SQ + idx] *= expf(c);
                s[G_SK + idx] *= expf(-c);
            }
            __syncthreads();
            for (int idx = tid; idx < 64 * 64; idx += NTHREADS) {
                int i = idx >> 6, j = idx & 63;
                bool ok = d ? (j >= i) : (j <= i);
                float a = 0.f;
                if (ok) { for (int c = 0; c < 64; ++c) a += s[G_SQ + i * 64 + c] * s[G_SK + j * 64 + c]; }
                s[G_ATT + idx] = a;
            }
            __syncthreads();
            const float* S = p.KV + ((size_t)(d * NC + n) * GH + h) * 64 * 128;
            for (int j = 0; j < 64; ++j) {
                float v4[4], s4[4];
#pragma unroll
                for (int c = 0; c < 4; ++c) { v4[c] = s[G_SV + j * 128 + tx * 4 + c]; s4[c] = S[(size_t)j * 128 + tx * 4 + c]; }
#pragma unroll
                for (int i = 0; i < 8; ++i) {
                    float a = s[G_ATT + (ty * 8 + i) * 64 + j], q = s[G_SQ + (ty * 8 + i) * 64 + j];
#pragma unroll
                    for (int c = 0; c < 4; ++c) o[i][c] += a * v4[c] + q * s4[c];
                }
            }
        }
#pragma unroll
        for (int i = 0; i < 8; ++i) {
            int t = gla_tok(n, ty * 8 + i);
#pragma unroll
            for (int c = 0; c < 4; ++c) p.OGLA[(size_t)t * GLA_V + h * 128 + tx * 4 + c] = o[i][c];
        }
    }
    __syncthreads();
}

__device__ __forceinline__ void rwkv_scan_job(const P& p, int job, char* smem) {
    const int tid = threadIdx.x;
    const int d = job / (RH * 4), h = (job / 4) % RH, rb = job % 4;
    const int rl = tid >> 4, seg = tid & 15, row = rb * 16 + rl;
    bf16_t* sKK = (bf16_t*)smem;
    bf16_t* sBB = sKK + 4096;
    bf16_t* sKD = sBB + 4096;
    bf16_t* sR = sKD + 4096;
    bf16_t* sV = sR + 4096;
    float* sW = (float*)(sV + 4096);
    float S[4] = {0.f, 0.f, 0.f, 0.f};
    for (int s0 = 0; s0 < MTOT; s0 += 64) {
        __syncthreads();
        for (int idx = tid; idx < 4096; idx += NTHREADS) {
            int i = idx >> 6, c = idx & 63; int t = tok_order(d, s0 + i);
            size_t o1 = (size_t)t * RW + h * 64 + c, o2 = ((size_t)d * MTOT + t) * RW + h * 64 + c;
            sKK[idx] = p.KK[o1]; sR[idx] = p.R[o1]; sV[idx] = p.V[o1];
            sBB[idx] = p.BB[o2]; sKD[idx] = p.KD[o2]; sW[idx] = p.W[o2];
        }
        __syncthreads();
        for (int i = 0; i < 64; ++i) {
            float kk[4], w[4], b[4], kd[4], r[4];
#pragma unroll
            for (int c = 0; c < 4; ++c) {
                int o = i * 64 + seg * 4 + c;
                kk[c] = bf2f(sKK[o]); w[c] = sW[o]; b[c] = bf2f(sBB[o]); kd[c] = bf2f(sKD[o]); r[c] = bf2f(sR[o]);
            }
            float v = bf2f(sV[i * 64 + row]);
            float sa = 0.f;
#pragma unroll
            for (int c = 0; c < 4; ++c) sa -= S[c] * kk[c];
            sa += __shfl_xor(sa, 1, 64); sa += __shfl_xor(sa, 2, 64); sa += __shfl_xor(sa, 4, 64); sa += __shfl_xor(sa, 8, 64);
            float y = 0.f;
#pragma unroll
            for (int c = 0; c < 4; ++c) { S[c] = S[c] * w[c] + sa * b[c] + v * kd[c]; y += S[c] * r[c]; }
            y += __shfl_xor(y, 1, 64); y += __shfl_xor(y, 2, 64); y += __shfl_xor(y, 4, 64); y += __shfl_xor(y, 8, 64);
            if (seg == 0) { int t = tok_order(d, s0 + i); p.Y[((size_t)d * MTOT + t) * RW + h * 64 + row] = y; }
        }
    }
    __syncthreads();
}

__device__ __forceinline__ void s5_local_job(const P& p, int job, char* smem, bool with_carry) {
    const int tid = threadIdx.x;
    const int n = job / SG, g = job % SG;
    float* su = (float*)smem;
    float* xs = su + 1024;
    float* cre = xs + 2 * 64 * 64 * 2;
    float* cim = cre + 1024;
    __syncthreads();
    for (int idx = tid; idx < 1024; idx += NTHREADS) {
        int i = idx >> 4, c = idx & 15;
        su[idx] = bf2f(p.Z[(size_t)(n * 64 + i) * D_IN + ZS5 + g * 16 + c]);
    }
    __syncthreads();
    if (tid < 128) {
        const int d = tid >> 6, st = tid & 63;
        size_t ci = ((size_t)d * SG + g) * 64 + st;
        float are = p.S5A[ci * 2], aim = p.S5A[ci * 2 + 1];
        float bre[16], bim[16];
#pragma unroll
        for (int c = 0; c < 16; ++c) { bre[c] = p.S5BB[(ci * 16 + c) * 2]; bim[c] = p.S5BB[(ci * 16 + c) * 2 + 1]; }
        size_t eo = (((size_t)d * NC + n) * SG + g) * 64 + st;
        float xr = 0.f, xi = 0.f;
        if (with_carry) { xr = p.S5END[eo * 2]; xi = p.S5END[eo * 2 + 1]; }
        for (int ii = 0; ii < 64; ++ii) {
            int i = d ? 63 - ii : ii;
            float ur = 0.f, ui = 0.f;
#pragma unroll
            for (int c = 0; c < 16; ++c) { float u = su[i * 16 + c]; ur += bre[c] * u; ui += bim[c] * u; }
            float nr = are * xr - aim * xi + ur, ni = are * xi + aim * xr + ui;
            xr = nr; xi = ni;
            if (with_carry) { xs[((d * 64 + i) * 64 + st) * 2] = xr; xs[((d * 64 + i) * 64 + st) * 2 + 1] = xi; }
        }
        if (!with_carry) { p.S5END[eo * 2] = xr; p.S5END[eo * 2 + 1] = xi; }
    }
}
__device__ __forceinline__ void s5_out_job(const P& p, int l, int job, char* smem) {
    const int tid = threadIdx.x;
    const int n = job / SG, g = job % SG;
    float* su = (float*)smem;
    float* xs = su + 1024;
    float* cre = xs + 2 * 64 * 64 * 2;
    float* cim = cre + 1024;
    s5_local_job(p, job, smem, true);
    for (int idx = tid; idx < 1024; idx += NTHREADS) {
        cre[idx] = p.in[I_S5CRE][((size_t)l * SG + g) * 1024 + idx];
        cim[idx] = p.in[I_S5CIM][((size_t)l * SG + g) * 1024 + idx];
    }
    __syncthreads();
    for (int idx = tid; idx < 1024; idx += NTHREADS) {
        int i = idx >> 4, c = idx & 15;
        float a = 0.f;
        for (int st = 0; st < 64; ++st) {
            float xr = xs[((0 * 64 + i) * 64 + st) * 2] + xs[((1 * 64 + i) * 64 + st) * 2];
            float xi = xs[((0 * 64 + i) * 64 + st) * 2 + 1] + xs[((1 * 64 + i) * 64 + st) * 2 + 1];
            a += cre[c * 64 + st] * xr - cim[c * 64 + st] * xi;
        }
        a += p.in[I_S5D][(size_t)l * SW + g * 16 + c] * su[idx];
        p.GY[(size_t)(n * 64 + i) * SW + g * 16 + c] = f2bf(geluf_(a));
    }
    __syncthreads();
}
__device__ __forceinline__ void s5_carry_job(const P& p, int job) {
    int base = job * NTHREADS + threadIdx.x;
    if (base >= 2 * SG * 64) return;
    int d = base / (SG * 64), g = (base / 64) % SG, st = base % 64;
    size_t ci = ((size_t)d * SG + g) * 64 + st;
    float ar = p.S5A[ci * 2], ai = p.S5A[ci * 2 + 1];
    for (int i = 0; i < 6; ++i) { float nr = ar * ar - ai * ai, ni = 2.f * ar * ai; ar = nr; ai = ni; }
    float cr = 0.f, cim = 0.f;
    for (int s = 0; s < NC; ++s) {
        int n = chunk_order(d, s);
        size_t eo = (((size_t)d * NC + n) * SG + g) * 64 + st;
        float er = p.S5END[eo * 2], ei = p.S5END[eo * 2 + 1];
        p.S5END[eo * 2] = cr; p.S5END[eo * 2 + 1] = cim;
        float nr = ar * cr - ai * cim + er, ni = ar * cim + ai * cr + ei;
        cr = nr; cim = ni;
    }
}

__device__ __forceinline__ void phase_side_elem(const P& p, int l) {
    const int lane = threadIdx.x & 63;
    const int gw = (blockIdx.x * NTHREADS + threadIdx.x) >> 6, nw = (gridDim.x * NTHREADS) >> 6;
    const float* gng = p.in[I_GLA_NG] + (size_t)l * 128;
    const float* lnw = p.in[I_RLNW] + (size_t)l * RW;
    const float* lnb = p.in[I_RLNB] + (size_t)l * RW;
    for (int t = gw; t < MTOT; t += nw) {
        for (int h = 0; h < GH; ++h) {
            float o0 = p.OGLA[(size_t)t * GLA_V + h * 128 + lane], o1 = p.OGLA[(size_t)t * GLA_V + h * 128 + 64 + lane];
            float ss = wave_sum(o0 * o0 + o1 * o1);
            float rstd = rsqrtf(ss / 128.f + 1e-6f);
            float z0 = bf2f(p.Z[(size_t)t * D_IN + ZOG + h * 128 + lane]), z1 = bf2f(p.Z[(size_t)t * D_IN + ZOG + h * 128 + 64 + lane]);
            p.BR[(size_t)t * 3 * BW + h * 128 + lane] = f2bf(o0 * rstd * gng[lane] * siluf_(z0));
            p.BR[(size_t)t * 3 * BW + h * 128 + 64 + lane] = f2bf(o1 * rstd * gng[64 + lane] * siluf_(z1));
        }
        for (int h = 0; h < RH; ++h) {
            int c = h * 64 + lane;
            float y = p.Y[(size_t)t * RW + c] + p.Y[((size_t)MTOT + t) * RW + c];
            float mu = wave_sum(y) * (1.f / 64.f);
            float dv = y - mu;
            float var = wave_sum(dv * dv) * (1.f / 64.f);
            float yn = dv * rsqrtf(var + 64e-5f) * lnw[c] + lnb[c];
            yn += p.BONUS[(size_t)t * RH + h] * bf2f(p.V[(size_t)t * RW + c]);
            p.YN[(size_t)t * RW + c] = yn;
        }
    }
}

__device__ __forceinline__ void phase_side_gemm(const P& p, int l, char* smem) {
    const int tid = threadIdx.x, ty = tid >> 4, tx = tid & 15;
    const int ntm = MTOT / 64, nt1 = RW / 64, nt2 = SW / 64;
    for (int job = blockIdx.x; job < ntm * (nt1 + nt2); job += gridDim.x) {
        int m0 = (job / (nt1 + nt2)) * 64, jn = job % (nt1 + nt2);
        if (jn < nt1) {
            int n0 = jn * 64;
            float acc[4][4]; ZERO_ACC(acc);
            gemm_core(p.GS, 128, p.in[I_RG2] + (size_t)l * 128 * RW, RW, 128, m0, n0, RW, (float*)smem, acc);
#pragma unroll
            for (int i = 0; i < 4; ++i)
#pragma unroll
                for (int j = 0; j < 4; ++j) {
                    int t = m0 + ty * 4 + i, n = n0 + tx * 4 + j;
                    p.BR[(size_t)t * 3 * BW + BW + n] = f2bf(p.YN[(size_t)t * RW + n] * acc[i][j]);
                }
        } else {
            int n0 = (jn - nt1) * 64;
            float a1[4][4], a2[4][4]; ZERO_ACC(a1); ZERO_ACC(a2);
            const float* B = p.in[I_S5GLU] + (size_t)l * SW * 2 * SW;
            gemm_core(p.GY, SW, B, 2 * SW, SW, m0, n0, 2 * SW, (float*)smem, a1);
            gemm_core(p.GY, SW, B, 2 * SW, SW, m0, SW + n0, 2 * SW, (float*)smem, a2);
#pragma unroll
            for (int i = 0; i < 4; ++i)
#pragma unroll
                for (int j = 0; j < 4; ++j) {
                    int t = m0 + ty * 4 + i, n = n0 + tx * 4 + j;
                    p.BR[(size_t)t * 3 * BW + 2 * BW + n] = f2bf(a1[i][j] * sigmoidf_(a2[i][j]));
                }
        }
    }
}

__device__ __forceinline__ void phase_merge(const P& p, int l, char* smem) {
    const int tid = threadIdx.x, ty = tid >> 4, tx = tid & 15;
    const int ntm = MTOT / 64, ntn = D_MODEL / 64;
    for (int job = blockIdx.x; job < ntm * ntn; job += gridDim.x) {
        int m0 = (job / ntn) * 64, n0 = (job % ntn) * 64;
        float macc[4][4]; ZERO_ACC(macc);
        for (int b = 0; b < 3; ++b) {
            float acc[4][4]; ZERO_ACC(acc);
            gemm_core(p.BR + b * BW, 3 * BW, p.in[I_WBR] + ((size_t)l * 3 + b) * BW * D_MODEL, D_MODEL, BW, m0, n0, D_MODEL, (float*)smem, acc);
#pragma unroll
            for (int i = 0; i < 4; ++i)
#pragma unroll
                for (int j = 0; j < 4; ++j) {
                    int t = m0 + ty * 4 + i, n = n0 + tx * 4 + j;
                    macc[i][j] += sigmoidf_(bf2f(p.Z[(size_t)t * D_IN + ZG + b * D_MODEL + n])) * acc[i][j];
                }
        }
#pragma unroll
        for (int i = 0; i < 4; ++i)
#pragma unroll
            for (int j = 0; j < 4; ++j) p.M[(size_t)(m0 + ty * 4 + i) * D_MODEL + n0 + tx * 4 + j] = f2bf(macc[i][j]);
    }
}

__device__ __forceinline__ void phase_outproj(const P& p, int l, char* smem) {
    const int tid = threadIdx.x, ty = tid >> 4, tx = tid & 15;
    const int ntm = MTOT / 64, ntn = D_MODEL / 64;
    for (int job = blockIdx.x; job < ntm * ntn; job += gridDim.x) {
        int m0 = (job / ntn) * 64, n0 = (job % ntn) * 64;
        float acc[4][4]; ZERO_ACC(acc);
        gemm_core(p.M, D_MODEL, p.in[I_WOUT] + (size_t)l * D_MODEL * D_MODEL, D_MODEL, D_MODEL, m0, n0, D_MODEL, (float*)smem, acc);
        const float* g1 = p.MOD + (size_t)(l * 2 + (m0 >= CTX ? 1 : 0)) * 6 * D_MODEL + 2 * D_MODEL;
#pragma unroll
        for (int i = 0; i < 4; ++i)
#pragma unroll
            for (int j = 0; j < 4; ++j) { int n = n0 + tx * 4 + j; p.X[(size_t)(m0 + ty * 4 + i) * D_MODEL + n] += g1[n] * acc[i][j]; }
    }
}

__device__ __forceinline__ void phase_peer_q(const P& p, int l, char* smem) {
    const int tid = threadIdx.x, ty = tid >> 4, tx = tid & 15;
    const int ntm = MTOT / 64, ntn = PQ / 64;
    for (int job = blockIdx.x; job < ntm * ntn; job += gridDim.x) {
        int m0 = (job / ntn) * 64, n0 = (job % ntn) * 64;
        float acc[4][4]; ZERO_ACC(acc);
        gemm_core(p.H, D_MODEL, p.in[I_PWQ] + (size_t)l * D_MODEL * PQ, PQ, D_MODEL, m0, n0, PQ, (float*)smem, acc);
#pragma unroll
        for (int i = 0; i < 4; ++i)
#pragma unroll
            for (int j = 0; j < 4; ++j) p.Q[(size_t)(m0 + ty * 4 + i) * PQ + n0 + tx * 4 + j] = acc[i][j];
    }
}

__device__ __forceinline__ void wave_argmax(float& v, int& idx) {
#pragma unroll
    for (int m = 32; m >= 1; m >>= 1) {
        float ov = __shfl_xor(v, m, 64); int oi = __shfl_xor(idx, m, 64);
        if (ov > v || (ov == v && oi < idx)) { v = ov; idx = oi; }
    }
}

__device__ __forceinline__ void phase_peer_topk(const P& p, int l, char* smem) {
    const int lane = threadIdx.x & 63, wv = threadIdx.x >> 6;
    float* ws = (float*)smem + wv * 384;
    float* sq = ws; float* s1t = ws + 256; float* s2t = ws + 272; int* i1t = (int*)(ws + 288); int* i2t = (int*)(ws + 304);
    const int gw = (blockIdx.x * NTHREADS + threadIdx.x) >> 6, nw = (gridDim.x * NTHREADS) >> 6;
    const float NEG = -3.0e38f;
    for (int job = gw; job < MTOT * PH; job += nw) {
        const int t = job / PH, h = job % PH;
        const float* q = p.Q + (size_t)t * PQ + h * 256;
        for (int i = lane; i < 256; i += 64) sq[i] = q[i];
        WAVE_SYNC();
        const float* keys = p.in[I_PKEYS] + ((size_t)(l * PH + h) * 2) * 128 * 128;
        float sc[2][2] = {{0.f, 0.f}, {0.f, 0.f}};
        {
            const float4* k00 = (const float4*)(keys + ((size_t)0 * 128 + lane) * 128);
            const float4* k01 = (const float4*)(keys + ((size_t)0 * 128 + lane + 64) * 128);
            const float4* k10 = (const float4*)(keys + ((size_t)1 * 128 + lane) * 128);
            const float4* k11 = (const float4*)(keys + ((size_t)1 * 128 + lane + 64) * 128);
            const float4* q4 = (const float4*)sq;
#pragma unroll 2
            for (int dd = 0; dd < 32; ++dd) {
                float4 qa = q4[dd], qb = q4[32 + dd];
                float4 a = k00[dd], b = k01[dd], c = k10[dd], e = k11[dd];
                sc[0][0] += qa.x * a.x + qa.y * a.y + qa.z * a.z + qa.w * a.w;
                sc[0][1] += qa.x * b.x + qa.y * b.y + qa.z * b.z + qa.w * b.w;
                sc[1][0] += qb.x * c.x + qb.y * c.y + qb.z * c.z + qb.w * c.w;
                sc[1][1] += qb.x * e.x + qb.y * e.y + qb.z * e.z + qb.w * e.w;
            }
        }
#pragma unroll
        for (int s = 0; s < 2; ++s) {
            float v0 = sc[s][0], v1 = sc[s][1];
            for (int r = 0; r < 16; ++r) {
                float bv; int bi;
                if (v0 >= v1) { bv = v0; bi = lane; } else { bv = v1; bi = lane + 64; }
                wave_argmax(bv, bi);
                if (bi == lane) v0 = NEG;
                if (bi == lane + 64) v1 = NEG;
                if (lane == 0) { if (s == 0) { s1t[r] = bv; i1t[r] = bi; } else { s2t[r] = bv; i2t[r] = bi; } }
            }
        }
        WAVE_SYNC();
        float cv[4];
#pragma unroll
        for (int j = 0; j < 4; ++j) { int c = lane * 4 + j; cv[j] = s1t[c >> 4] + s2t[c & 15]; }
        float topv = 0.f; int topc = 0; float mx = 0.f;
        for (int r = 0; r < 16; ++r) {
            float bv = cv[0]; int bi = lane * 4;
#pragma unroll
            for (int j = 1; j < 4; ++j) if (cv[j] > bv) { bv = cv[j]; bi = lane * 4 + j; }
            wave_argmax(bv, bi);
#pragma unroll
            for (int j = 0; j < 4; ++j) if (bi == lane * 4 + j) cv[j] = NEG;
            if (r == 0) mx = bv;
            if (lane == r) { topv = bv; topc = bi; }
        }
        float e = (lane < 16) ? expf(topv - mx) : 0.f;
        float sum = wave_sum(e);
        if (lane < 16) {
            p.IDX[(size_t)t * PH * 16 + h * 16 + lane] = i1t[topc >> 4] * 128 + i2t[topc & 15];
            p.G[(size_t)t * PH * 16 + h * 16 + lane] = e / sum;
        }
        WAVE_SYNC();
    }
}

__device__ __forceinline__ void phase_peer_gather(const P& p, int l) {
    const int lane = threadIdx.x & 63;
    const int gw = (blockIdx.x * NTHREADS + threadIdx.x) >> 6, nw = (gridDim.x * NTHREADS) >> 6;
    const float* U = p.in[I_PU] + (size_t)l * NEXP * D_MODEL;
    const float* V = p.in[I_PV] + (size_t)l * NEXP * D_MODEL;
    for (int t = gw; t < MTOT; t += nw) {
        float hv[D_MODEL / 64], acc[D_MODEL / 64];
#pragma unroll
        for (int j = 0; j < D_MODEL / 64; ++j) { hv[j] = bf2f(p.H[(size_t)t * D_MODEL + lane + 64 * j]); acc[j] = 0.f; }
        for (int e0 = 0; e0 < PH * 16; e0 += 64) {
            int my_idx = 0; float my_g = 0.f;
            if (e0 + lane < PH * 16) { my_idx = p.IDX[(size_t)t * PH * 16 + e0 + lane]; my_g = p.G[(size_t)t * PH * 16 + e0 + lane]; }
            int cnt = (PH * 16 - e0) < 64 ? (PH * 16 - e0) : 64;
            for (int k = 0; k < cnt; ++k) {
                int ei = __shfl(my_idx, k, 64); float gg = __shfl(my_g, k, 64);
                const float* u = U + (size_t)ei * D_MODEL;
                float dt = 0.f;
#pragma unroll
                for (int j = 0; j < D_MODEL / 64; ++j) dt += hv[j] * u[lane + 64 * j];
                dt = wave_sum(dt);
                float coef = gg * geluf_(dt);
                const float* v = V + (size_t)ei * D_MODEL;
#pragma unroll
                for (int j = 0; j < D_MODEL / 64; ++j) acc[j] += coef * v[lane + 64 * j];
            }
        }
        const float* g2 = p.MOD + (size_t)(l * 2 + (t >= CTX ? 1 : 0)) * 6 * D_MODEL + 5 * D_MODEL;
#pragma unroll
        for (int j = 0; j < D_MODEL / 64; ++j) p.X[(size_t)t * D_MODEL + lane + 64 * j] += g2[lane + 64 * j] * acc[j];
    }
}

__device__ __forceinline__ void phase_final(const P& p) {
    const int lane = threadIdx.x & 63;
    const int gw = (blockIdx.x * NTHREADS + threadIdx.x) >> 6, nw = (gridDim.x * NTHREADS) >> 6;
    const float* g = p.in[I_FG];
    for (int t = gw; t < SEQ; t += nw) {
        const float* x = p.X + (size_t)(CTX + t) * D_MODEL;
        float v[D_MODEL / 64]; float ss = 0.f;
#pragma unroll
        for (int j = 0; j < D_MODEL / 64; ++j) { v[j] = x[lane + 64 * j]; ss += v[j] * v[j]; }
        ss = wave_sum(ss);
        float rstd = rsqrtf(ss / D_MODEL + 1e-6f);
#pragma unroll
        for (int j = 0; j < D_MODEL / 64; ++j) p.out[(size_t)t * D_MODEL + lane + 64 * j] = v[j] * rstd * g[lane + 64 * j];
    }
}

__global__ void __launch_bounds__(NTHREADS) fwd_megakernel(P p) {
#ifdef EMU
    char* smem = emu_smem();
#else
    __shared__ __attribute__((aligned(16))) char smem_raw[SMEM_BYTES];
    char* smem = smem_raw;
#endif
    phase_init(p, smem);
    grid_sync_all();
    for (int l = 0; l < DEPTH; ++l) {
        phase_norm(p, l, 0);
        phase_s5const(p, l);
        grid_sync_all();
        phase_gemm_in(p, l, smem);
        grid_sync_all();
        phase_rwkv_prep(p, l, smem);
        phase_gla_kv(p, l, smem);
        for (int job = blockIdx.x; job < NC * SG; job += gridDim.x) s5_local_job(p, job, smem, false);
        __syncthreads();
        grid_sync_all();
        {
            const int n_rw = 2 * RH * 4, n_gla = 2 * GH * 8192 / NTHREADS, n_s5 = (2 * SG * 64 + NTHREADS - 1) / NTHREADS;
            for (int job = blockIdx.x; job < n_rw + n_gla + n_s5; job += gridDim.x) {
                if (job < n_rw) rwkv_scan_job(p, job, smem);
                else if (job < n_rw + n_gla) gla_scan_job(p, job - n_rw);
                else s5_carry_job(p, job - n_rw - n_gla);
            }
        }
        grid_sync_all();
        phase_gla_out(p, l, smem);
        for (int job = blockIdx.x; job < NC * SG; job += gridDim.x) s5_out_job(p, l, job, smem);
        grid_sync_all();
        phase_side_elem(p, l);
        grid_sync_all();
        phase_side_gemm(p, l, smem);
        grid_sync_all();
        phase_merge(p, l, smem);
        grid_sync_all();
        phase_outproj(p, l, smem);
        grid_sync_all();
        phase_norm(p, l, 1);
        grid_sync_all();
        phase_peer_q(p, l, smem);
        grid_sync_all();
        phase_peer_topk(p, l, smem);
        grid_sync_all();
        phase_peer_gather(p, l);
        grid_sync_all();
    }
    phase_final(p);
}

static inline size_t align_up(size_t x) { return (x + 255) & ~(size_t)255; }

extern "C" void kernel_launch(void* const* d_in, const int* in_sizes, int n_in, void* d_out, int out_size, void* d_ws, size_t ws_size, hipStream_t stream) {
    P p;
    memset(&p, 0, sizeof(p));
    for (int i = 0; i < 39; ++i) p.in[i] = (const float*)d_in[i];
    p.out = (float*)d_out;
    char* w = (char*)d_ws; size_t off = 0;
    auto take = [&](size_t bytes) { void* r = w + off; off = align_up(off + bytes); return r; };
    p.bar = (unsigned*)take(16384);
    p.X = (float*)take((size_t)MTOT * D_MODEL * 4);
    p.H = (bf16_t*)take((size_t)MTOT * D_MODEL * 2);
    p.MOD = (float*)take((size_t)DEPTH * 2 * 6 * D_MODEL * 4);
    p.Z = (bf16_t*)take((size_t)MTOT * D_IN * 2);
    p.R = (bf16_t*)take((size_t)MTOT * RW * 2);
    p.V = (bf16_t*)take((size_t)MTOT * RW * 2);
    p.KK = (bf16_t*)take((size_t)MTOT * RW * 2);
    p.KD = (bf16_t*)take((size_t)2 * MTOT * RW * 2);
    p.BB = (bf16_t*)take((size_t)2 * MTOT * RW * 2);
    p.W = (float*)take((size_t)2 * MTOT * RW * 4);
    p.BONUS = (float*)take((size_t)MTOT * RH * 4);
    p.GS = (bf16_t*)take((size_t)MTOT * 128 * 2);
    p.Y = (float*)take((size_t)2 * MTOT * RW * 4);
    p.KV = (float*)take((size_t)2 * NC * GH * 8192 * 4);
    p.DEC = (float*)take((size_t)2 * NC * GH * 64 * 4);
    p.OGLA = (float*)take((size_t)MTOT * GLA_V * 4);
    p.S5A = (float*)take((size_t)2 * SG * 64 * 2 * 4);
    p.S5BB = (float*)take((size_t)2 * SG * 64 * 16 * 2 * 4);
    p.S5END = (float*)take((size_t)2 * NC * SG * 64 * 2 * 4);
    p.GY = (bf16_t*)take((size_t)MTOT * SW * 2);
    p.YN = (float*)take((size_t)MTOT * RW * 4);
    p.BR = (bf16_t*)take((size_t)MTOT * 3 * BW * 2);
    p.M = (bf16_t*)take((size_t)MTOT * D_MODEL * 2);
    p.IDX = (int*)take((size_t)MTOT * PH * 16 * 4);
    p.G = (float*)take((size_t)MTOT * PH * 16 * 4);
    p.Q = (float*)p.Z;
    static_assert((size_t)PQ * 4 <= (size_t)D_IN * 2, "Q alias");
    if (off > ws_size) { fprintf(stderr, "ws too small: need %zu have %zu\n", off, ws_size); return; }
#ifdef EMU
    fprintf(stderr, "ws used %zu MB\n", off >> 20);
    emu_launch([=] { fwd_megakernel(p); }, EMU_GRID, NTHREADS);
#else
    static int grid_blocks = 0;
    if (!grid_blocks) {
        int dev = 0, cus = 0, per_cu = 0;
        hipGetDevice(&dev);
        hipDeviceGetAttribute(&cus, hipDeviceAttributeMultiprocessorCount, dev);
        hipOccupancyMaxActiveBlocksPerMultiprocessor(&per_cu, fwd_megakernel, NTHREADS, 0);
        if (per_cu > 1) per_cu = 1;
        grid_blocks = cus * per_cu;
    }
    void* args[] = {&p};
    hipError_t e = hipLaunchCooperativeKernel((void*)fwd_megakernel, dim3(grid_blocks), dim3(NTHREADS), args, 0, stream);
    if (e != hipSuccess) fprintf(stderr, "cooperative launch failed: %s (grid %d)\n", hipGetErrorString(e), grid_blocks);
#endif
}
```

```cpp
#include <hip/hip_runtime.h>
#ifndef EMU
#include <hip/hip_cooperative_groups.h>
namespace cg = cooperative_groups;
#endif
#include <cstdio>
#include <cstdint>
#include <cstring>

#ifdef CFG_SMALL
#define D_MODEL 128
#define SEQ 512
#define DEPTH 2
#define GRID_W 8
#define CTX 128
#define GH 1
#define RH 2
#define SG 8
#define PH 2
#else
#define D_MODEL 1024
#define SEQ 16384
#define DEPTH 4
#define GRID_W 64
#define CTX 256
#define GH 4
#define RH 8
#define SG 32
#define PH 8
#endif
#define MTOT (CTX + SEQ)
#define ROWS (SEQ / GRID_W)
#define GLA_K (GH * 64)
#define GLA_V (GH * 128)
#define RW (RH * 64)
#define RWKV_IN (3 * RW + 4 * 64 + 128)
#define SW (SG * 16)
#define BW GLA_V
#define ZQ 0
#define ZK (GLA_K)
#define ZV (2 * GLA_K)
#define ZOG (ZV + GLA_V)
#define ZAF (ZOG + GLA_V)
#define ZAB (ZAF + 16)
#define ZR (ZAB + 16)
#define ZS5 (ZR + RWKV_IN)
#define ZG (ZS5 + SW)
#define D_IN (ZG + 3 * D_MODEL)
#define NC (MTOT / 64)
#define NCC (CTX / 64)
#define RB (ROWS / 64)
#define PQ (PH * 256)
#define NEXP 16384
#define NTHREADS 256
#define SMEM_BYTES 102400

typedef unsigned short bf16_t;
typedef short bf16x8 __attribute__((ext_vector_type(8)));
typedef float f32x4 __attribute__((ext_vector_type(4)));
typedef unsigned u32x4 __attribute__((ext_vector_type(4)));
typedef unsigned u32x2 __attribute__((ext_vector_type(2)));
#ifdef EMU
#define MFMA16(a, b, c) emu_mfma_16x16x32_bf16(a, b, c)
#else
#define MFMA16(a, b, c) __builtin_amdgcn_mfma_f32_16x16x32_bf16(a, b, c, 0, 0, 0)
#endif
#define NPAD(n) (((n) + 127) / 128 * 128)

__device__ __forceinline__ float bf2f(bf16_t h) { return __builtin_bit_cast(float, ((unsigned)h) << 16); }
__device__ __forceinline__ bf16_t f2bf(float f) { unsigned u = __builtin_bit_cast(unsigned, f); u += 0x7FFFu + ((u >> 16) & 1u); return (bf16_t)(u >> 16); }
__device__ __forceinline__ float sigmoidf_(float x) { return 1.0f / (1.0f + expf(-x)); }
__device__ __forceinline__ float siluf_(float x) { return x * sigmoidf_(x); }
__device__ __forceinline__ float geluf_(float x) { return 0.5f * x * (1.0f + tanhf(0.7978845608028654f * (x + 0.044715f * x * x * x))); }
__device__ __forceinline__ float softplusf_(float x) { return fmaxf(x, 0.f) + log1pf(expf(-fabsf(x))); }
__device__ __forceinline__ float wave_sum(float v) {
#pragma unroll
    for (int m = 32; m >= 1; m >>= 1) v += __shfl_xor(v, m, 64);
    return v;
}

struct P {
    const float* in[39];
    float* out;
    float* X;
    bf16_t* H;
    bf16_t* Z;
    float* MOD;
    bf16_t* R; bf16_t* V; bf16_t* KK; bf16_t* KD; bf16_t* BB;
    float* W;
    float* BONUS;
    bf16_t* GS;
    float* Y;
    float* KV;
    float* DEC;
    float* OGLA;
    float* S5A;
    float* S5BB;
    float* S5END;
    bf16_t* GY;
    float* YN;
    bf16_t* BR;
    bf16_t* M;
    float* Q;
    int* IDX;
    float* G;
    unsigned* bar;
    bf16_t* WT_IN;
    bf16_t* WT_G2;
    bf16_t* WT_GLU;
    bf16_t* WT_BR;
    bf16_t* WT_OUT;
    bf16_t* WT_Q;
};

enum { I_X = 0, I_C, I_CTX, I_CCTX, I_WMOD, I_BMOD, I_N1G, I_N2G, I_WIN, I_GLA_WA2, I_GLA_BA, I_GLA_NG, I_RCONV, I_RW0, I_RW2, I_RA0, I_RA2, I_RG2,
       I_RKK, I_RKA, I_RRK, I_RLNW, I_RLNB, I_S5LRE, I_S5LIM, I_S5LS, I_S5BRE, I_S5BIM, I_S5CRE, I_S5CIM, I_S5D, I_S5GLU, I_WBR, I_WOUT, I_PWQ, I_PKEYS, I_PU, I_PV, I_FG };

#ifdef EMU
__device__ __forceinline__ int otid() { return threadIdx.x; }
__device__ __forceinline__ int obid() { return blockIdx.x; }
#else
__device__ __forceinline__ int otid() { int t = threadIdx.x; asm volatile("" : "+v"(t)); return t; }
__device__ __forceinline__ int obid() { int b = blockIdx.x; asm volatile("" : "+s"(b)); return b; }
#endif
#ifdef EMU
#define WAVE_SYNC() emu_wave_barrier()
#ifndef EMU_GRID
#define EMU_GRID 4
#endif
#else
#define WAVE_SYNC() __builtin_amdgcn_wave_barrier()
#endif
__device__ __forceinline__ void grid_sync_all() {
#ifdef EMU
    emu_grid_sync();
#else
    cg::this_grid().sync();
#endif
}

__device__ __forceinline__ int gla_tok(int n, int i) {
    if (n < NCC) return n * 64 + i;
    int m = n - NCC; int col = m / RB, rb = m % RB;
    return CTX + (rb * 64 + i) * GRID_W + col;
}
__device__ __forceinline__ int chunk_order(int d, int s) {
    if (d == 0) return s;
    return (s < NCC) ? (NCC - 1 - s) : (NC - 1 - (s - NCC));
}
__device__ __forceinline__ int tok_order(int d, int s) {
    if (d == 0) return s;
    return (s < CTX) ? (CTX - 1 - s) : (MTOT - 1 - (s - CTX));
}


#define LDS_ROW 72
__device__ __forceinline__ void mfma_gemm_tile(const bf16_t* Wt, int ldw, const bf16_t* Act, int lda, int K, int n0, int m0, bf16_t* lds, f32x4 (&acc)[4][4]) {
    bf16_t* Ws = lds; bf16_t* As = lds + 128 * LDS_ROW;
    const int tid = otid(), lane = tid & 63, wave = tid >> 6, wn = wave >> 1, wm = wave & 1;
    const int lrow = tid >> 3, lkc = (tid & 7) * 8;
    u32x4 pw[4], pa[4];
#pragma unroll
    for (int i = 0; i < 4; ++i) {
        pw[i] = *(const u32x4*)(Wt + (size_t)(n0 + lrow + 32 * i) * ldw + lkc);
        pa[i] = *(const u32x4*)(Act + (size_t)(m0 + lrow + 32 * i) * lda + lkc);
    }
    for (int k0 = 0; k0 < K; k0 += 64) {
        __syncthreads();
#pragma unroll
        for (int i = 0; i < 4; ++i) {
            *(u32x4*)(Ws + (lrow + 32 * i) * LDS_ROW + lkc) = pw[i];
            *(u32x4*)(As + (lrow + 32 * i) * LDS_ROW + lkc) = pa[i];
        }
        __syncthreads();
        if (k0 + 64 < K) {
#pragma unroll
            for (int i = 0; i < 4; ++i) {
                pw[i] = *(const u32x4*)(Wt + (size_t)(n0 + lrow + 32 * i) * ldw + k0 + 64 + lkc);
                pa[i] = *(const u32x4*)(Act + (size_t)(m0 + lrow + 32 * i) * lda + k0 + 64 + lkc);
            }
        }
#pragma unroll
        for (int ks = 0; ks < 2; ++ks) {
            bf16x8 a[4], b[4];
#pragma unroll
            for (int i = 0; i < 4; ++i) {
                a[i] = *(const bf16x8*)(Ws + (wn * 64 + i * 16 + (lane & 15)) * LDS_ROW + ks * 32 + (lane >> 4) * 8);
                b[i] = *(const bf16x8*)(As + (wm * 64 + i * 16 + (lane & 15)) * LDS_ROW + ks * 32 + (lane >> 4) * 8);
            }
#pragma unroll
            for (int ni = 0; ni < 4; ++ni)
#pragma unroll
                for (int mi = 0; mi < 4; ++mi) acc[ni][mi] = MFMA16(a[ni], b[mi], acc[ni][mi]);
        }
    }
}
#define ZERO_ACC4(acc) { _Pragma("unroll") for (int i_ = 0; i_ < 4; ++i_) _Pragma("unroll") for (int j_ = 0; j_ < 4; ++j_) acc[i_][j_] = (f32x4){0.f, 0.f, 0.f, 0.f}; }
#define FOR_ACC(acc, n0, m0, BODY) { const int lane_ = otid() & 63, wave_ = otid() >> 6; \
    _Pragma("unroll") for (int ni_ = 0; ni_ < 4; ++ni_) _Pragma("unroll") for (int mi_ = 0; mi_ < 4; ++mi_) { \
        const int n = (n0) + (wave_ >> 1) * 64 + ni_ * 16 + (lane_ >> 4) * 4; const int m = (m0) + (wave_ & 1) * 64 + mi_ * 16 + (lane_ & 15); const f32x4 v = acc[ni_][mi_]; BODY } }
__device__ __forceinline__ u32x2 pack4(float a, float b, float c, float d) { u32x2 r; r.x = (unsigned)f2bf(a) | ((unsigned)f2bf(b) << 16); r.y = (unsigned)f2bf(c) | ((unsigned)f2bf(d) << 16); return r; }

__device__ __forceinline__ void convert_wt_job(const float* W, int K, int N, int Npad, bf16_t* out, int job, float* T, int ilv) {
    const int tid = otid();
    const int nkt = K / 64;
    const int n0 = (job / nkt) * 64, k0 = (job % nkt) * 64;
    __syncthreads();
    for (int idx = tid; idx < 4096; idx += NTHREADS) {
        int kk = idx >> 6, nn = idx & 63;
        int nr = n0 + nn; int src = ilv ? ((nr & 1) ? (N / 2 + (nr >> 1)) : (nr >> 1)) : nr;
        T[kk * 65 + nn] = (nr < N) ? W[(size_t)(k0 + kk) * N + src] : 0.f;
    }
    __syncthreads();
    {
        int nn = tid >> 2, part = tid & 3;
        unsigned w[8];
#pragma unroll
        for (int j = 0; j < 8; ++j) w[j] = (unsigned)f2bf(T[(part * 16 + 2 * j) * 65 + nn]) | ((unsigned)f2bf(T[(part * 16 + 2 * j + 1) * 65 + nn]) << 16);
        u32x4* o = (u32x4*)(out + (size_t)(n0 + nn) * K + k0 + part * 16);
        o[0] = (u32x4){w[0], w[1], w[2], w[3]}; o[1] = (u32x4){w[4], w[5], w[6], w[7]};
    }
}
__device__ __forceinline__ void phase_convert_weights(const P& p, int l, char* smem) {
    float* T = (float*)smem;
    struct Item { const float* W; int K, N, Npad; bf16_t* out; };
    const Item items[8] = {
        {p.in[I_WIN] + (size_t)l * D_MODEL * D_IN, D_MODEL, D_IN, NPAD(D_IN), p.WT_IN},
        {p.in[I_RG2] + (size_t)l * 128 * RW, 128, RW, RW, p.WT_G2},
        {p.in[I_S5GLU] + (size_t)l * SW * 2 * SW, SW, 2 * SW, 2 * SW, p.WT_GLU},
        {p.in[I_WBR] + ((size_t)l * 3 + 0) * BW * D_MODEL, BW, D_MODEL, D_MODEL, p.WT_BR},
        {p.in[I_WBR] + ((size_t)l * 3 + 1) * BW * D_MODEL, BW, D_MODEL, D_MODEL, p.WT_BR + (size_t)D_MODEL * BW},
        {p.in[I_WBR] + ((size_t)l * 3 + 2) * BW * D_MODEL, BW, D_MODEL, D_MODEL, p.WT_BR + (size_t)2 * D_MODEL * BW},
        {p.in[I_WOUT] + (size_t)l * D_MODEL * D_MODEL, D_MODEL, D_MODEL, D_MODEL, p.WT_OUT},
        {p.in[I_PWQ] + (size_t)l * D_MODEL * PQ, D_MODEL, PQ, PQ, p.WT_Q}};
    int base = 0;
#pragma unroll
    for (int it = 0; it < 8; ++it) {
        const int nj = (items[it].Npad / 64) * (items[it].K / 64);
        for (int j = (int)((obid() + gridDim.x - (base % gridDim.x)) % gridDim.x); j < nj; j += gridDim.x)
            convert_wt_job(items[it].W, items[it].K, items[it].N, items[it].Npad, items[it].out, j, T, it == 2);
        base += nj;
    }
    __syncthreads();
}

__device__ __forceinline__ void phase_init(const P& p, char* smem) {
    const int tid = otid();
    float* sc = (float*)smem;
    for (int i = tid; i < D_MODEL; i += NTHREADS) { sc[i] = siluf_(p.in[I_CCTX][i]); sc[D_MODEL + i] = siluf_(p.in[I_C][i]); }
    __syncthreads();
    const int ncolblk = (6 * D_MODEL) / NTHREADS;
    for (int job = obid(); job < DEPTH * ncolblk; job += gridDim.x) {
        int l = job / ncolblk, n = (job % ncolblk) * NTHREADS + tid;
        const float* w = p.in[I_WMOD] + (size_t)l * D_MODEL * 6 * D_MODEL + n;
        float a0 = 0.f, a1 = 0.f;
        for (int k = 0; k < D_MODEL; ++k) { float wv = w[(size_t)k * 6 * D_MODEL]; a0 += sc[k] * wv; a1 += sc[D_MODEL + k] * wv; }
        float b = p.in[I_BMOD][l * 6 * D_MODEL + n];
        p.MOD[(size_t)(l * 2 + 0) * 6 * D_MODEL + n] = a0 + b;
        p.MOD[(size_t)(l * 2 + 1) * 6 * D_MODEL + n] = a1 + b;
    }
    const size_t gtid = (size_t)obid() * NTHREADS + tid, gn = (size_t)gridDim.x * NTHREADS;
    for (size_t i = gtid; i < (size_t)CTX * D_MODEL; i += gn) p.X[i] = p.in[I_CTX][i];
    for (size_t i = gtid; i < (size_t)SEQ * D_MODEL; i += gn) p.X[(size_t)CTX * D_MODEL + i] = p.in[I_X][i];
    __syncthreads();
}

__device__ __forceinline__ void phase_s5const(const P& p, int l) {
    const size_t gtid = (size_t)obid() * NTHREADS + otid(), gn = (size_t)gridDim.x * NTHREADS;
    for (size_t i = gtid; i < (size_t)2 * SG * 64; i += gn) {
        int d = (int)(i / (SG * 64)), g = (int)((i / 64) % SG), s = (int)(i % 64);
        size_t li = ((size_t)(l * 2 + d) * SG + g) * 64 + s;
        float lre = p.in[I_S5LRE][li], lim = p.in[I_S5LIM][li];
        float dt = expf(p.in[I_S5LS][(l * 2 + d) * SG + g]);
        float mag = expf(lre * dt);
        float are = mag * cosf(lim * dt), aim = mag * sinf(lim * dt);
        float den = lre * lre + lim * lim;
        float fre = ((are - 1.0f) * lre + aim * lim) / den;
        float fim = (aim * lre - (are - 1.0f) * lim) / den;
        p.S5A[i * 2 + 0] = are; p.S5A[i * 2 + 1] = aim;
        const float* bre = p.in[I_S5BRE] + (((size_t)l * SG + g) * 64 + s) * 16;
        const float* bim = p.in[I_S5BIM] + (((size_t)l * SG + g) * 64 + s) * 16;
        for (int c = 0; c < 16; ++c) {
            p.S5BB[(i * 16 + c) * 2 + 0] = fre * bre[c] - fim * bim[c];
            p.S5BB[(i * 16 + c) * 2 + 1] = fre * bim[c] + fim * bre[c];
        }
    }
}

__device__ __forceinline__ void phase_norm(const P& p, int l, int which) {
    const int lane = otid() & 63;
    const int gw = (obid() * NTHREADS + otid()) >> 6, nw = (gridDim.x * NTHREADS) >> 6;
    const float* g = p.in[which ? I_N2G : I_N1G] + l * D_MODEL;
    for (int t = gw; t < MTOT; t += nw) {
        const float* x = p.X + (size_t)t * D_MODEL;
        const float* mod = p.MOD + (size_t)(l * 2 + (t >= CTX ? 1 : 0)) * 6 * D_MODEL + (which ? 3 * D_MODEL : 0);
        float v[D_MODEL / 64]; float ss = 0.f;
#pragma unroll
        for (int j = 0; j < D_MODEL / 64; ++j) { v[j] = x[lane + 64 * j]; ss += v[j] * v[j]; }
        ss = wave_sum(ss);
        float rstd = rsqrtf(ss / D_MODEL + 1e-6f);
#pragma unroll
        for (int j = 0; j < D_MODEL / 64; ++j) {
            int e = lane + 64 * j;
            p.H[(size_t)t * D_MODEL + e] = f2bf(v[j] * rstd * g[e] * (1.0f + mod[D_MODEL + e]) + mod[e]);
        }
    }
}

__device__ __forceinline__ void phase_gemm_in(const P& p, int l, char* smem) {
    const int ntn = NPAD(D_IN) / 128, ntm = MTOT / 128;
    for (int job = obid(); job < ntm * ntn; job += gridDim.x) {
        const int m0 = (job / ntn) * 128, n0 = (job % ntn) * 128;
        f32x4 acc[4][4]; ZERO_ACC4(acc);
        mfma_gemm_tile(p.WT_IN, D_MODEL, p.H, D_MODEL, D_MODEL, n0, m0, (bf16_t*)smem, acc);
        FOR_ACC(acc, n0, m0, { if (n < D_IN) *(u32x2*)(p.Z + (size_t)m * D_IN + n) = pack4(v[0], v[1], v[2], v[3]); })
    }
}

#define RTOK 4
__device__ __forceinline__ void phase_rwkv_prep(const P& p, int l, char* smem) {
    const int tid = otid(), lane = tid & 63;
    float* zs = (float*)smem;
    const float* conv = p.in[I_RCONV] + (size_t)l * 3 * RWKV_IN;
    const float* w0 = p.in[I_RW0] + (size_t)l * 2 * RW;
    const float* w2 = p.in[I_RW2] + (size_t)l * 2 * 64 * RW;
    const float* a0 = p.in[I_RA0] + (size_t)l * 2 * RW;
    const float* a2 = p.in[I_RA2] + (size_t)l * 2 * 64 * RW;
    const float* k_k = p.in[I_RKK] + (size_t)l * RW;
    const float* k_a = p.in[I_RKA] + (size_t)l * RW;
    const float* r_k = p.in[I_RRK] + (size_t)l * RW;
    for (int job = obid(); job < MTOT / RTOK; job += gridDim.x) {
        const int t0 = job * RTOK;
        __syncthreads();
        for (int idx = tid; idx < RTOK * RWKV_IN; idx += NTHREADS) {
            int tt = idx / RWKV_IN, c = idx % RWKV_IN; int t = t0 + tt;
            bool first = (t == 0) || (t == CTX), last = (t == CTX - 1) || (t == MTOT - 1);
            const bf16_t* zp = p.Z + (size_t)t * D_IN + ZR + c;
            float v = conv[RWKV_IN + c] * bf2f(zp[0]);
            if (!first) v += conv[c] * bf2f(zp[-D_IN]);
            if (!last) v += conv[2 * RWKV_IN + c] * bf2f(zp[D_IN]);
            if (c >= 3 * RW && c < 3 * RW + 128) v = tanhf(v);
            zs[idx] = v;
        }
        __syncthreads();
        for (int c = tid; c < RW; c += NTHREADS) {
            const int h = c >> 6;
            float accw[2][RTOK], acca[2][RTOK];
#pragma unroll
            for (int d = 0; d < 2; ++d)
#pragma unroll
                for (int tt = 0; tt < RTOK; ++tt) { accw[d][tt] = w0[d * RW + c]; acca[d][tt] = a0[d * RW + c]; }
            for (int j = 0; j < 64; ++j) {
#pragma unroll
                for (int d = 0; d < 2; ++d) {
                    float wv = w2[((size_t)d * 64 + j) * RW + c], av = a2[((size_t)d * 64 + j) * RW + c];
#pragma unroll
                    for (int tt = 0; tt < RTOK; ++tt) {
                        accw[d][tt] += zs[tt * RWKV_IN + 3 * RW + d * 64 + j] * wv;
                        acca[d][tt] += zs[tt * RWKV_IN + 3 * RW + 128 + d * 64 + j] * av;
                    }
                }
            }
#pragma unroll
            for (int tt = 0; tt < RTOK; ++tt) {
                const int t = t0 + tt;
                float r = zs[tt * RWKV_IN + c], k = zs[tt * RWKV_IN + RW + c], v = zs[tt * RWKV_IN + 2 * RW + c];
                float kkr = k * k_k[c];
                float nrm = wave_sum(kkr * kkr);
                float kk = kkr / fmaxf(sqrtf(nrm), 1e-12f);
                float kdsum = 0.f;
#pragma unroll
                for (int d = 0; d < 2; ++d) {
                    float dec = expf(-expf(-softplusf_(-accw[d][tt]) - 0.5f));
                    float aa = sigmoidf_(acca[d][tt]);
                    float kd = k * (1.0f + (aa - 1.0f) * k_a[c]);
                    kdsum += kd;
                    size_t o = ((size_t)d * MTOT + t) * RW + c;
                    p.W[o] = dec; p.KD[o] = f2bf(kd); p.BB[o] = f2bf(kk * aa);
                }
                size_t o = (size_t)t * RW + c;
                p.R[o] = f2bf(r); p.V[o] = f2bf(v); p.KK[o] = f2bf(kk);
                float bon = wave_sum(r * kdsum * r_k[c]);
                if (lane == 0) p.BONUS[(size_t)t * RH + h] = bon;
            }
        }
        for (int idx = tid; idx < RTOK * 128; idx += NTHREADS) {
            int tt = idx >> 7, j = idx & 127;
            p.GS[(size_t)(t0 + tt) * 128 + j] = f2bf(sigmoidf_(zs[tt * RWKV_IN + 3 * RW + 256 + j]));
        }
    }
    __syncthreads();
}

#define G_SQ 0
#define G_SK 4096
#define G_SV 8192
#define G_CUM 16384
#define G_ATT 20480
#define G_END 24576
__device__ __forceinline__ void gla_load(const P& p, int l, int n, int h, int d, float* s) {
    const int tid = otid();
    float* alr = s + G_ATT;
    for (int idx = tid; idx < 64 * 64; idx += NTHREADS) {
        int i = idx >> 6, c = idx & 63; int t = gla_tok(n, i);
        const bf16_t* z = p.Z + (size_t)t * D_IN;
        s[G_SQ + idx] = bf2f(z[ZQ + h * 64 + c]) * 0.125f;
        s[G_SK + idx] = bf2f(z[ZK + h * 64 + c]);
    }
    for (int idx = tid; idx < 64 * 128; idx += NTHREADS) {
        int i = idx >> 7, c = idx & 127; int t = gla_tok(n, i);
        s[G_SV + idx] = bf2f(p.Z[(size_t)t * D_IN + ZV + h * 128 + c]);
    }
    for (int idx = tid; idx < 64 * 16; idx += NTHREADS) {
        int i = idx >> 4, r = idx & 15; int t = gla_tok(n, i);
        alr[idx] = bf2f(p.Z[(size_t)t * D_IN + (d ? ZAB : ZAF) + r]);
    }
    __syncthreads();
    const float* wa2 = p.in[I_GLA_WA2] + ((size_t)(l * 2 + d) * 16) * GLA_K + h * 64;
    const float* ba = p.in[I_GLA_BA] + (size_t)(l * 2 + d) * GLA_K + h * 64;
    for (int idx = tid; idx < 64 * 64; idx += NTHREADS) {
        int i = idx >> 6, c = idx & 63;
        float a = ba[c];
#pragma unroll
        for (int r = 0; r < 16; ++r) a += alr[i * 16 + r] * wa2[(size_t)r * GLA_K + c];
        float ls = fminf(a, 0.f) - log1pf(expf(-fabsf(a)));
        s[G_CUM + idx] = ls * (1.0f / 16.0f);
    }
    __syncthreads();
    if (tid < 64) {
        float run = 0.f;
        if (d == 0) { for (int i = 0; i < 64; ++i) { run += s[G_CUM + i * 64 + tid]; s[G_CUM + i * 64 + tid] = run; } }
        else { for (int i = 63; i >= 0; --i) { run += s[G_CUM + i * 64 + tid]; s[G_CUM + i * 64 + tid] = run; } }
    }
    __syncthreads();
}

__device__ __forceinline__ void phase_gla_kv(const P& p, int l, char* smem) {
    float* s = (float*)smem;
    const int tid = otid();
    for (int job = obid(); job < NC * GH; job += gridDim.x) {
        const int n = job / GH, h = job % GH;
        for (int d = 0; d < 2; ++d) {
            __syncthreads();
            gla_load(p, l, n, h, d, s);
            const int li = d ? 0 : 63;
            for (int idx = tid; idx < 64 * 64; idx += NTHREADS) {
                int c = idx & 63;
                s[G_SQ + idx] = s[G_SK + idx] * expf(s[G_CUM + li * 64 + c] - s[G_CUM + idx]);
            }
            if (tid < 64) p.DEC[((size_t)(d * NC + n) * GH + h) * 64 + tid] = expf(s[G_CUM + li * 64 + tid]);
            __syncthreads();
            float* kv = p.KV + ((size_t)(d * NC + n) * GH + h) * 64 * 128;
            const int dv = tid & 127, kh = (tid >> 7) * 32;
            float acc[32];
#pragma unroll
            for (int j = 0; j < 32; ++j) acc[j] = 0.f;
            for (int i = 0; i < 64; ++i) {
                float vv = s[G_SV + i * 128 + dv];
#pragma unroll
                for (int j = 0; j < 32; ++j) acc[j] += s[G_SQ + i * 64 + kh + j] * vv;
            }
#pragma unroll
            for (int j = 0; j < 32; ++j) kv[(size_t)(kh + j) * 128 + dv] = acc[j];
        }
    }
    __syncthreads();
}

__device__ __forceinline__ void gla_scan_job(const P& p, int job) {
    int base = job * NTHREADS + otid();
    int d = base / (GH * 8192), h = (base / 8192) % GH, e = base % 8192;
    float S = 0.f;
    for (int s = 0; s < NC; ++s) {
        int n = chunk_order(d, s);
        size_t o = ((size_t)(d * NC + n) * GH + h);
        float kv = p.KV[o * 8192 + e];
        float dec = p.DEC[o * 64 + (e >> 7)];
        p.KV[o * 8192 + e] = S;
        S = dec * S + kv;
    }
}

__device__ __forceinline__ void phase_gla_out(const P& p, int l, char* smem) {
    float* s = (float*)smem;
    const int tid = otid();
    const int tx = tid & 31, ty = tid >> 5;
    for (int job = obid(); job < NC * GH; job += gridDim.x) {
        const int n = job / GH, h = job % GH;
        float o[8][4];
#pragma unroll
        for (int i = 0; i < 8; ++i)
#pragma unroll
            for (int j = 0; j < 4; ++j) o[i][j] = 0.f;
        for (int d = 0; d < 2; ++d) {
            __syncthreads();
            gla_load(p, l, n, h, d, s);
            for (int idx = tid; idx < 64 * 64; idx += NTHREADS) {
                float c = s[G_CUM + idx];
                s[G_SQ + idx] *= expf(c);
                s[G_SK + idx] *= expf(-c);
            }
            __syncthreads();
            for (int idx = tid; idx < 64 * 64; idx += NTHREADS) {
                int i = idx >> 6, j = idx & 63;
                bool ok = d ? (j >= i) : (j <= i);
                float a = 0.f;
                if (ok) { for (int c = 0; c < 64; ++c) a += s[G_SQ + i * 64 + c] * s[G_SK + j * 64 + c]; }
                s[G_ATT + idx] = a;
            }
            __syncthreads();
            const float* S = p.KV + ((size_t)(d * NC + n) * GH + h) * 64 * 128;
            for (int j = 0; j < 64; ++j) {
                float v4[4], s4[4];
#pragma unroll
                for (int c = 0; c < 4; ++c) { v4[c] = s[G_SV + j * 128 + tx * 4 + c]; s4[c] = S[(size_t)j * 128 + tx * 4 + c]; }
#pragma unroll
                for (int i = 0; i < 8; ++i) {
                    float a = s[G_ATT + (ty * 8 + i) * 64 + j], q = s[G_SQ + (ty * 8 + i) * 64 + j];
#pragma unroll
                    for (int c = 0; c < 4; ++c) o[i][c] += a * v4[c] + q * s4[c];
                }
            }
        }
#pragma unroll
        for (int i = 0; i < 8; ++i) {
            int t = gla_tok(n, ty * 8 + i);
#pragma unroll
            for (int c = 0; c < 4; ++c) p.OGLA[(size_t)t * GLA_V + h * 128 + tx * 4 + c] = o[i][c];
        }
    }
    __syncthreads();
}

__device__ __forceinline__ void rwkv_scan_job(const P& p, int job, char* smem) {
    const int tid = otid();
    const int d = job / (RH * 4), h = (job / 4) % RH, rb = job % 4;
    const int rl = tid >> 4, seg = tid & 15, row = rb * 16 + rl;
    bf16_t* sKK = (bf16_t*)smem;
    bf16_t* sBB = sKK + 4096;
    bf16_t* sKD = sBB + 4096;
    bf16_t* sR = sKD + 4096;
    bf16_t* sV = sR + 4096;
    float* sW = (float*)(sV + 4096);
    float S[4] = {0.f, 0.f, 0.f, 0.f};
    for (int s0 = 0; s0 < MTOT; s0 += 64) {
        __syncthreads();
        for (int idx = tid; idx < 4096; idx += NTHREADS) {
            int i = idx >> 6, c = idx & 63; int t = tok_order(d, s0 + i);
            size_t o1 = (size_t)t * RW + h * 64 + c, o2 = ((size_t)d * MTOT + t) * RW + h * 64 + c;
            sKK[idx] = p.KK[o1]; sR[idx] = p.R[o1]; sV[idx] = p.V[o1];
            sBB[idx] = p.BB[o2]; sKD[idx] = p.KD[o2]; sW[idx] = p.W[o2];
        }
        __syncthreads();
        for (int i = 0; i < 64; ++i) {
            float kk[4], w[4], b[4], kd[4], r[4];
#pragma unroll
            for (int c = 0; c < 4; ++c) {
                int o = i * 64 + seg * 4 + c;
                kk[c] = bf2f(sKK[o]); w[c] = sW[o]; b[c] = bf2f(sBB[o]); kd[c] = bf2f(sKD[o]); r[c] = bf2f(sR[o]);
            }
            float v = bf2f(sV[i * 64 + row]);
            float sa = 0.f;
#pragma unroll
            for (int c = 0; c < 4; ++c) sa -= S[c] * kk[c];
            sa += __shfl_xor(sa, 1, 64); sa += __shfl_xor(sa, 2, 64); sa += __shfl_xor(sa, 4, 64); sa += __shfl_xor(sa, 8, 64);
            float y = 0.f;
#pragma unroll
            for (int c = 0; c < 4; ++c) { S[c] = S[c] * w[c] + sa * b[c] + v * kd[c]; y += S[c] * r[c]; }
            y += __shfl_xor(y, 1, 64); y += __shfl_xor(y, 2, 64); y += __shfl_xor(y, 4, 64); y += __shfl_xor(y, 8, 64);
            if (seg == 0) { int t = tok_order(d, s0 + i); p.Y[((size_t)d * MTOT + t) * RW + h * 64 + row] = y; }
        }
    }
    __syncthreads();
}

__device__ __forceinline__ void s5_local_job(const P& p, int job, char* smem, bool with_carry) {
    const int tid = otid();
    const int n = job / SG, g = job % SG;
    float* su = (float*)smem;
    float* xs = su + 1024;
    float* cre = xs + 2 * 64 * 64 * 2;
    float* cim = cre + 1024;
    __syncthreads();
    for (int idx = tid; idx < 1024; idx += NTHREADS) {
        int i = idx >> 4, c = idx & 15;
        su[idx] = bf2f(p.Z[(size_t)(n * 64 + i) * D_IN + ZS5 + g * 16 + c]);
    }
    __syncthreads();
    if (tid < 128) {
        const int d = tid >> 6, st = tid & 63;
        size_t ci = ((size_t)d * SG + g) * 64 + st;
        float are = p.S5A[ci * 2], aim = p.S5A[ci * 2 + 1];
        float bre[16], bim[16];
#pragma unroll
        for (int c = 0; c < 16; ++c) { bre[c] = p.S5BB[(ci * 16 + c) * 2]; bim[c] = p.S5BB[(ci * 16 + c) * 2 + 1]; }
        size_t eo = (((size_t)d * NC + n) * SG + g) * 64 + st;
        float xr = 0.f, xi = 0.f;
        if (with_carry) { xr = p.S5END[eo * 2]; xi = p.S5END[eo * 2 + 1]; }
        for (int ii = 0; ii < 64; ++ii) {
            int i = d ? 63 - ii : ii;
            float ur = 0.f, ui = 0.f;
#pragma unroll
            for (int c = 0; c < 16; ++c) { float u = su[i * 16 + c]; ur += bre[c] * u; ui += bim[c] * u; }
            float nr = are * xr - aim * xi + ur, ni = are * xi + aim * xr + ui;
            xr = nr; xi = ni;
            if (with_carry) { xs[((d * 64 + i) * 64 + st) * 2] = xr; xs[((d * 64 + i) * 64 + st) * 2 + 1] = xi; }
        }
        if (!with_carry) { p.S5END[eo * 2] = xr; p.S5END[eo * 2 + 1] = xi; }
    }
}
__device__ __forceinline__ void s5_out_job(const P& p, int l, int job, char* smem) {
    const int tid = otid();
    const int n = job / SG, g = job % SG;
    float* su = (float*)smem;
    float* xs = su + 1024;
    float* cre = xs + 2 * 64 * 64 * 2;
    float* cim = cre + 1024;
    s5_local_job(p, job, smem, true);
    for (int idx = tid; idx < 1024; idx += NTHREADS) {
        cre[idx] = p.in[I_S5CRE][((size_t)l * SG + g) * 1024 + idx];
        cim[idx] = p.in[I_S5CIM][((size_t)l * SG + g) * 1024 + idx];
    }
    __syncthreads();
    for (int idx = tid; idx < 1024; idx += NTHREADS) {
        int i = idx >> 4, c = idx & 15;
        float a = 0.f;
        for (int st = 0; st < 64; ++st) {
            float xr = xs[((0 * 64 + i) * 64 + st) * 2] + xs[((1 * 64 + i) * 64 + st) * 2];
            float xi = xs[((0 * 64 + i) * 64 + st) * 2 + 1] + xs[((1 * 64 + i) * 64 + st) * 2 + 1];
            a += cre[c * 64 + st] * xr - cim[c * 64 + st] * xi;
        }
        a += p.in[I_S5D][(size_t)l * SW + g * 16 + c] * su[idx];
        p.GY[(size_t)(n * 64 + i) * SW + g * 16 + c] = f2bf(geluf_(a));
    }
    __syncthreads();
}
__device__ __forceinline__ void s5_carry_job(const P& p, int job) {
    int base = job * NTHREADS + otid();
    if (base >= 2 * SG * 64) return;
    int d = base / (SG * 64), g = (base / 64) % SG, st = base % 64;
    size_t ci = ((size_t)d * SG + g) * 64 + st;
    float ar = p.S5A[ci * 2], ai = p.S5A[ci * 2 + 1];
    for (int i = 0; i < 6; ++i) { float nr = ar * ar - ai * ai, ni = 2.f * ar * ai; ar = nr; ai = ni; }
    float cr = 0.f, cim = 0.f;
    for (int s = 0; s < NC; ++s) {
        int n = chunk_order(d, s);
        size_t eo = (((size_t)d * NC + n) * SG + g) * 64 + st;
        float er = p.S5END[eo * 2], ei = p.S5END[eo * 2 + 1];
        p.S5END[eo * 2] = cr; p.S5END[eo * 2 + 1] = cim;
        float nr = ar * cr - ai * cim + er, ni = ar * cim + ai * cr + ei;
        cr = nr; cim = ni;
    }
}

__device__ __forceinline__ void phase_side_elem(const P& p, int l) {
    const int lane = otid() & 63;
    const int gw = (obid() * NTHREADS + otid()) >> 6, nw = (gridDim.x * NTHREADS) >> 6;
    const float* gng = p.in[I_GLA_NG] + (size_t)l * 128;
    const float* lnw = p.in[I_RLNW] + (size_t)l * RW;
    const float* lnb = p.in[I_RLNB] + (size_t)l * RW;
    for (int t = gw; t < MTOT; t += nw) {
        for (int h = 0; h < GH; ++h) {
            float o0 = p.OGLA[(size_t)t * GLA_V + h * 128 + lane], o1 = p.OGLA[(size_t)t * GLA_V + h * 128 + 64 + lane];
            float ss = wave_sum(o0 * o0 + o1 * o1);
            float rstd = rsqrtf(ss / 128.f + 1e-6f);
            float z0 = bf2f(p.Z[(size_t)t * D_IN + ZOG + h * 128 + lane]), z1 = bf2f(p.Z[(size_t)t * D_IN + ZOG + h * 128 + 64 + lane]);
            p.BR[(size_t)t * 3 * BW + h * 128 + lane] = f2bf(o0 * rstd * gng[lane] * siluf_(z0));
            p.BR[(size_t)t * 3 * BW + h * 128 + 64 + lane] = f2bf(o1 * rstd * gng[64 + lane] * siluf_(z1));
        }
        for (int h = 0; h < RH; ++h) {
            int c = h * 64 + lane;
            float y = p.Y[(size_t)t * RW + c] + p.Y[((size_t)MTOT + t) * RW + c];
            float mu = wave_sum(y) * (1.f / 64.f);
            float dv = y - mu;
            float var = wave_sum(dv * dv) * (1.f / 64.f);
            float yn = dv * rsqrtf(var + 64e-5f) * lnw[c] + lnb[c];
            yn += p.BONUS[(size_t)t * RH + h] * bf2f(p.V[(size_t)t * RW + c]);
            p.YN[(size_t)t * RW + c] = yn;
        }
    }
}

__device__ __forceinline__ void phase_side_gemm(const P& p, int l, char* smem) {
    const int ntm = MTOT / 128, nt1 = NPAD(RW) / 128, nt2 = (2 * SW) / 128;
    for (int job = obid(); job < ntm * (nt1 + nt2); job += gridDim.x) {
        const int m0 = (job / (nt1 + nt2)) * 128, jn = job % (nt1 + nt2);
        f32x4 acc[4][4]; ZERO_ACC4(acc);
        if (jn < nt1) {
            const int n0 = jn * 128;
            mfma_gemm_tile(p.WT_G2, 128, p.GS, 128, 128, n0, m0, (bf16_t*)smem, acc);
            FOR_ACC(acc, n0, m0, { if (n < RW) { const float4 y = *(const float4*)(p.YN + (size_t)m * RW + n);
                *(u32x2*)(p.BR + (size_t)m * 3 * BW + BW + n) = pack4(y.x * v[0], y.y * v[1], y.z * v[2], y.w * v[3]); } })
        } else {
            const int n0 = (jn - nt1) * 128;
            mfma_gemm_tile(p.WT_GLU, SW, p.GY, SW, SW, n0, m0, (bf16_t*)smem, acc);
            FOR_ACC(acc, n0, m0, { const unsigned w = (unsigned)f2bf(v[0] * sigmoidf_(v[1])) | ((unsigned)f2bf(v[2] * sigmoidf_(v[3])) << 16);
                *(unsigned*)(p.BR + (size_t)m * 3 * BW + 2 * BW + (n >> 1)) = w; })
        }
    }
}

__device__ __forceinline__ void phase_merge(const P& p, int l, char* smem) {
    const int ntm = MTOT / 128, ntn = D_MODEL / 128;
    for (int job = obid(); job < ntm * ntn; job += gridDim.x) {
        const int m0 = (job / ntn) * 128, n0 = (job % ntn) * 128;
        f32x4 macc[4][4]; ZERO_ACC4(macc);
        for (int b = 0; b < 3; ++b) {
            f32x4 acc[4][4]; ZERO_ACC4(acc);
            mfma_gemm_tile(p.WT_BR + (size_t)b * D_MODEL * BW, BW, p.BR + b * BW, 3 * BW, BW, n0, m0, (bf16_t*)smem, acc);
            const int lane_ = otid() & 63, wave_ = otid() >> 6;
#pragma unroll
            for (int ni = 0; ni < 4; ++ni)
#pragma unroll
                for (int mi = 0; mi < 4; ++mi) {
                    const int n = n0 + (wave_ >> 1) * 64 + ni * 16 + (lane_ >> 4) * 4, m = m0 + (wave_ & 1) * 64 + mi * 16 + (lane_ & 15);
                    const u32x2 g = *(const u32x2*)(p.Z + (size_t)m * D_IN + ZG + b * D_MODEL + n);
                    macc[ni][mi][0] += sigmoidf_(bf2f((bf16_t)(g.x & 0xFFFF))) * acc[ni][mi][0];
                    macc[ni][mi][1] += sigmoidf_(bf2f((bf16_t)(g.x >> 16))) * acc[ni][mi][1];
                    macc[ni][mi][2] += sigmoidf_(bf2f((bf16_t)(g.y & 0xFFFF))) * acc[ni][mi][2];
                    macc[ni][mi][3] += sigmoidf_(bf2f((bf16_t)(g.y >> 16))) * acc[ni][mi][3];
                }
        }
        FOR_ACC(macc, n0, m0, { *(u32x2*)(p.M + (size_t)m * D_MODEL + n) = pack4(v[0], v[1], v[2], v[3]); })
    }
}

__device__ __forceinline__ void phase_outproj(const P& p, int l, char* smem) {
    const int ntm = MTOT / 128, ntn = D_MODEL / 128;
    for (int job = obid(); job < ntm * ntn; job += gridDim.x) {
        const int m0 = (job / ntn) * 128, n0 = (job % ntn) * 128;
        f32x4 acc[4][4]; ZERO_ACC4(acc);
        mfma_gemm_tile(p.WT_OUT, D_MODEL, p.M, D_MODEL, D_MODEL, n0, m0, (bf16_t*)smem, acc);
        FOR_ACC(acc, n0, m0, { const float* g1 = p.MOD + (size_t)(l * 2 + (m >= CTX ? 1 : 0)) * 6 * D_MODEL + 2 * D_MODEL + n;
            float4* xp = (float4*)(p.X + (size_t)m * D_MODEL + n); float4 x = *xp;
            x.x += g1[0] * v[0]; x.y += g1[1] * v[1]; x.z += g1[2] * v[2]; x.w += g1[3] * v[3]; *xp = x; })
    }
}

__device__ __forceinline__ void phase_peer_q(const P& p, int l, char* smem) {
    const int ntm = MTOT / 128, ntn = PQ / 128;
    for (int job = obid(); job < ntm * ntn; job += gridDim.x) {
        const int m0 = (job / ntn) * 128, n0 = (job % ntn) * 128;
        f32x4 acc[4][4]; ZERO_ACC4(acc);
        mfma_gemm_tile(p.WT_Q, D_MODEL, p.H, D_MODEL, D_MODEL, n0, m0, (bf16_t*)smem, acc);
        FOR_ACC(acc, n0, m0, { float4 o; o.x = v[0]; o.y = v[1]; o.z = v[2]; o.w = v[3]; *(float4*)(p.Q + (size_t)m * PQ + n) = o; })
    }
}

__device__ __forceinline__ void wave_argmax(float& v, int& idx) {
#pragma unroll
    for (int m = 32; m >= 1; m >>= 1) {
        float ov = __shfl_xor(v, m, 64); int oi = __shfl_xor(idx, m, 64);
        if (ov > v || (ov == v && oi < idx)) { v = ov; idx = oi; }
    }
}

__device__ __forceinline__ void phase_peer_topk(const P& p, int l, char* smem) {
    const int lane = otid() & 63, wv = otid() >> 6;
    float* ws = (float*)smem + wv * 384;
    float* sq = ws; float* s1t = ws + 256; float* s2t = ws + 272; int* i1t = (int*)(ws + 288); int* i2t = (int*)(ws + 304);
    const int gw = (obid() * NTHREADS + otid()) >> 6, nw = (gridDim.x * NTHREADS) >> 6;
    const float NEG = -3.0e38f;
    for (int job = gw; job < MTOT * PH; job += nw) {
        const int t = job / PH, h = job % PH;
        const float* q = p.Q + (size_t)t * PQ + h * 256;
        for (int i = lane; i < 256; i += 64) sq[i] = q[i];
        WAVE_SYNC();
        const float* keys = p.in[I_PKEYS] + ((size_t)(l * PH + h) * 2) * 128 * 128;
        float sc[2][2] = {{0.f, 0.f}, {0.f, 0.f}};
        {
            const float4* k00 = (const float4*)(keys + ((size_t)0 * 128 + lane) * 128);
            const float4* k01 = (const float4*)(keys + ((size_t)0 * 128 + lane + 64) * 128);
            const float4* k10 = (const float4*)(keys + ((size_t)1 * 128 + lane) * 128);
            const float4* k11 = (const float4*)(keys + ((size_t)1 * 128 + lane + 64) * 128);
            const float4* q4 = (const float4*)sq;
#pragma unroll 2
            for (int dd = 0; dd < 32; ++dd) {
                float4 qa = q4[dd], qb = q4[32 + dd];
                float4 a = k00[dd], b = k01[dd], c = k10[dd], e = k11[dd];
                sc[0][0] += qa.x * a.x + qa.y * a.y + qa.z * a.z + qa.w * a.w;
                sc[0][1] += qa.x * b.x + qa.y * b.y + qa.z * b.z + qa.w * b.w;
                sc[1][0] += qb.x * c.x + qb.y * c.y + qb.z * c.z + qb.w * c.w;
                sc[1][1] += qb.x * e.x + qb.y * e.y + qb.z * e.z + qb.w * e.w;
            }
        }
#pragma unroll
        for (int s = 0; s < 2; ++s) {
            float v0 = sc[s][0], v1 = sc[s][1];
            for (int r = 0; r < 16; ++r) {
                float bv; int bi;
                if (v0 >= v1) { bv = v0; bi = lane; } else { bv = v1; bi = lane + 64; }
                wave_argmax(bv, bi);
                if (bi == lane) v0 = NEG;
                if (bi == lane + 64) v1 = NEG;
                if (lane == 0) { if (s == 0) { s1t[r] = bv; i1t[r] = bi; } else { s2t[r] = bv; i2t[r] = bi; } }
            }
        }
        WAVE_SYNC();
        float cv[4];
#pragma unroll
        for (int j = 0; j < 4; ++j) { int c = lane * 4 + j; cv[j] = s1t[c >> 4] + s2t[c & 15]; }
        float topv = 0.f; int topc = 0; float mx = 0.f;
        for (int r = 0; r < 16; ++r) {
            float bv = cv[0]; int bi = lane * 4;
#pragma unroll
            for (int j = 1; j < 4; ++j) if (cv[j] > bv) { bv = cv[j]; bi = lane * 4 + j; }
            wave_argmax(bv, bi);
#pragma unroll
            for (int j = 0; j < 4; ++j) if (bi == lane * 4 + j) cv[j] = NEG;
            if (r == 0) mx = bv;
            if (lane == r) { topv = bv; topc = bi; }
        }
        float e = (lane < 16) ? expf(topv - mx) : 0.f;
        float sum = wave_sum(e);
        if (lane < 16) {
            p.IDX[(size_t)t * PH * 16 + h * 16 + lane] = i1t[topc >> 4] * 128 + i2t[topc & 15];
            p.G[(size_t)t * PH * 16 + h * 16 + lane] = e / sum;
        }
        WAVE_SYNC();
    }
}

__device__ __forceinline__ void phase_peer_gather(const P& p, int l) {
    const int lane = otid() & 63;
    const int gw = (obid() * NTHREADS + otid()) >> 6, nw = (gridDim.x * NTHREADS) >> 6;
    const float* U = p.in[I_PU] + (size_t)l * NEXP * D_MODEL;
    const float* V = p.in[I_PV] + (size_t)l * NEXP * D_MODEL;
    for (int t = gw; t < MTOT; t += nw) {
        float hv[D_MODEL / 64], acc[D_MODEL / 64];
#pragma unroll
        for (int j = 0; j < D_MODEL / 64; ++j) { hv[j] = bf2f(p.H[(size_t)t * D_MODEL + lane + 64 * j]); acc[j] = 0.f; }
        for (int e0 = 0; e0 < PH * 16; e0 += 64) {
            int my_idx = 0; float my_g = 0.f;
            if (e0 + lane < PH * 16) { my_idx = p.IDX[(size_t)t * PH * 16 + e0 + lane]; my_g = p.G[(size_t)t * PH * 16 + e0 + lane]; }
            int cnt = (PH * 16 - e0) < 64 ? (PH * 16 - e0) : 64;
            for (int k = 0; k < cnt; ++k) {
                int ei = __shfl(my_idx, k, 64); float gg = __shfl(my_g, k, 64);
                const float* u = U + (size_t)ei * D_MODEL;
                float dt = 0.f;
#pragma unroll
                for (int j = 0; j < D_MODEL / 64; ++j) dt += hv[j] * u[lane + 64 * j];
                dt = wave_sum(dt);
                float coef = gg * geluf_(dt);
                const float* v = V + (size_t)ei * D_MODEL;
#pragma unroll
                for (int j = 0; j < D_MODEL / 64; ++j) acc[j] += coef * v[lane + 64 * j];
            }
        }
        const float* g2 = p.MOD + (size_t)(l * 2 + (t >= CTX ? 1 : 0)) * 6 * D_MODEL + 5 * D_MODEL;
#pragma unroll
        for (int j = 0; j < D_MODEL / 64; ++j) p.X[(size_t)t * D_MODEL + lane + 64 * j] += g2[lane + 64 * j] * acc[j];
    }
}

__device__ __forceinline__ void phase_final(const P& p) {
    const int lane = otid() & 63;
    const int gw = (obid() * NTHREADS + otid()) >> 6, nw = (gridDim.x * NTHREADS) >> 6;
    const float* g = p.in[I_FG];
    for (int t = gw; t < SEQ; t += nw) {
        const float* x = p.X + (size_t)(CTX + t) * D_MODEL;
        float v[D_MODEL / 64]; float ss = 0.f;
#pragma unroll
        for (int j = 0; j < D_MODEL / 64; ++j) { v[j] = x[lane + 64 * j]; ss += v[j] * v[j]; }
        ss = wave_sum(ss);
        float rstd = rsqrtf(ss / D_MODEL + 1e-6f);
#pragma unroll
        for (int j = 0; j < D_MODEL / 64; ++j) p.out[(size_t)t * D_MODEL + lane + 64 * j] = v[j] * rstd * g[lane + 64 * j];
    }
}

__global__ void __launch_bounds__(NTHREADS) fwd_megakernel(P p) {
#ifdef EMU
    char* smem = emu_smem();
#else
    __shared__ __attribute__((aligned(16))) char smem_raw[SMEM_BYTES];
    char* smem = smem_raw;
#endif
    phase_init(p, smem);
    grid_sync_all();
    for (int l = 0; l < DEPTH; ++l) {
        phase_norm(p, l, 0);
        phase_s5const(p, l);
        phase_convert_weights(p, l, smem);
        grid_sync_all();
        phase_gemm_in(p, l, smem);
        grid_sync_all();
        phase_rwkv_prep(p, l, smem);
        phase_gla_kv(p, l, smem);
        for (int job = obid(); job < NC * SG; job += gridDim.x) s5_local_job(p, job, smem, false);
        __syncthreads();
        grid_sync_all();
        {
            const int n_rw = 2 * RH * 4, n_gla = 2 * GH * 8192 / NTHREADS, n_s5 = (2 * SG * 64 + NTHREADS - 1) / NTHREADS;
            for (int job = obid(); job < n_rw + n_gla + n_s5; job += gridDim.x) {
                if (job < n_rw) rwkv_scan_job(p, job, smem);
                else if (job < n_rw + n_gla) gla_scan_job(p, job - n_rw);
                else s5_carry_job(p, job - n_rw - n_gla);
            }
        }
        grid_sync_all();
        phase_gla_out(p, l, smem);
        for (int job = obid(); job < NC * SG; job += gridDim.x) s5_out_job(p, l, job, smem);
        grid_sync_all();
        phase_side_elem(p, l);
        grid_sync_all();
        phase_side_gemm(p, l, smem);
        grid_sync_all();
        phase_merge(p, l, smem);
        grid_sync_all();
        phase_outproj(p, l, smem);
        grid_sync_all();
        phase_norm(p, l, 1);
        grid_sync_all();
        phase_peer_q(p, l, smem);
        grid_sync_all();
        phase_peer_topk(p, l, smem);
        grid_sync_all();
        phase_peer_gather(p, l);
        grid_sync_all();
    }
    phase_final(p);
}

static inline size_t align_up(size_t x) { return (x + 255) & ~(size_t)255; }

extern "C" void kernel_launch(void* const* d_in, const int* in_sizes, int n_in, void* d_out, int out_size, void* d_ws, size_t ws_size, hipStream_t stream) {
    P p;
    memset(&p, 0, sizeof(p));
    for (int i = 0; i < 39; ++i) p.in[i] = (const float*)d_in[i];
    p.out = (float*)d_out;
    char* w = (char*)d_ws; size_t off = 0;
    auto take = [&](size_t bytes) { void* r = w + off; off = align_up(off + bytes); return r; };
    p.bar = (unsigned*)take(16384);
    p.X = (float*)take((size_t)MTOT * D_MODEL * 4);
    p.H = (bf16_t*)take((size_t)MTOT * D_MODEL * 2);
    p.MOD = (float*)take((size_t)DEPTH * 2 * 6 * D_MODEL * 4);
    p.Z = (bf16_t*)take((size_t)MTOT * D_IN * 2);
    p.R = (bf16_t*)take((size_t)MTOT * RW * 2);
    p.V = (bf16_t*)take((size_t)MTOT * RW * 2);
    p.KK = (bf16_t*)take((size_t)MTOT * RW * 2);
    p.KD = (bf16_t*)take((size_t)2 * MTOT * RW * 2);
    p.BB = (bf16_t*)take((size_t)2 * MTOT * RW * 2);
    p.W = (float*)take((size_t)2 * MTOT * RW * 4);
    p.BONUS = (float*)take((size_t)MTOT * RH * 4);
    p.GS = (bf16_t*)take((size_t)MTOT * 128 * 2);
    p.Y = (float*)take((size_t)2 * MTOT * RW * 4);
    p.KV = (float*)take((size_t)2 * NC * GH * 8192 * 4);
    p.DEC = (float*)take((size_t)2 * NC * GH * 64 * 4);
    p.OGLA = (float*)take((size_t)MTOT * GLA_V * 4);
    p.S5A = (float*)take((size_t)2 * SG * 64 * 2 * 4);
    p.S5BB = (float*)take((size_t)2 * SG * 64 * 16 * 2 * 4);
    p.S5END = (float*)take((size_t)2 * NC * SG * 64 * 2 * 4);
    p.GY = (bf16_t*)take((size_t)MTOT * SW * 2);
    p.YN = (float*)take((size_t)MTOT * RW * 4);
    p.BR = (bf16_t*)take((size_t)MTOT * 3 * BW * 2);
    p.M = (bf16_t*)take((size_t)MTOT * D_MODEL * 2);
    p.IDX = (int*)take((size_t)MTOT * PH * 16 * 4);
    p.G = (float*)take((size_t)MTOT * PH * 16 * 4);
    p.WT_IN = (bf16_t*)take((size_t)NPAD(D_IN) * D_MODEL * 2);
    p.WT_G2 = (bf16_t*)take((size_t)NPAD(RW) * 128 * 2);
    p.WT_GLU = (bf16_t*)take((size_t)NPAD(2 * SW) * SW * 2);
    p.WT_BR = (bf16_t*)take((size_t)3 * D_MODEL * BW * 2);
    p.WT_OUT = (bf16_t*)take((size_t)D_MODEL * D_MODEL * 2);
    p.WT_Q = (bf16_t*)take((size_t)PQ * D_MODEL * 2);
    p.Q = (float*)p.Z;
    static_assert((size_t)PQ * 4 <= (size_t)D_IN * 2, "Q alias");
    if (off > ws_size) { fprintf(stderr, "ws too small: need %zu have %zu\n", off, ws_size); return; }
#ifdef EMU
    fprintf(stderr, "ws used %zu MB\n", off >> 20);
    emu_launch([=] { fwd_megakernel(p); }, EMU_GRID, NTHREADS);
#else
    static int grid_blocks = 0;
    if (!grid_blocks) {
        int dev = 0, cus = 0, per_cu = 0;
        hipGetDevice(&dev);
        hipDeviceGetAttribute(&cus, hipDeviceAttributeMultiprocessorCount, dev);
        hipOccupancyMaxActiveBlocksPerMultiprocessor(&per_cu, fwd_megakernel, NTHREADS, 0);
        if (per_cu > 1) per_cu = 1;
        grid_blocks = cus * per_cu;
    }
    void* args[] = {&p};
    hipError_t e = hipLaunchCooperativeKernel((void*)fwd_megakernel, dim3(grid_blocks), dim3(NTHREADS), args, 0, stream);
    if (e != hipSuccess) fprintf(stderr, "cooperative launch failed: %s (grid %d)\n", hipGetErrorString(e), grid_blocks);
#endif
}
```

```cpp
#include <hip/hip_runtime.h>
#ifndef EMU
#include <hip/hip_cooperative_groups.h>
namespace cg = cooperative_groups;
#endif
#include <cstdio>
#include <cstdint>
#include <cstring>

#ifdef CFG_SMALL
#define D_MODEL 128
#define SEQ 512
#define DEPTH 2
#define GRID_W 8
#define CTX 128
#define GH 1
#define RH 2
#define SG 8
#define PH 2
#else
#define D_MODEL 1024
#define SEQ 16384
#define DEPTH 4
#define GRID_W 64
#define CTX 256
#define GH 4
#define RH 8
#define SG 32
#define PH 8
#endif
#define MTOT (CTX + SEQ)
#define ROWS (SEQ / GRID_W)
#define GLA_K (GH * 64)
#define GLA_V (GH * 128)
#define RW (RH * 64)
#define RWKV_IN (3 * RW + 4 * 64 + 128)
#define SW (SG * 16)
#define BW GLA_V
#define ZQ 0
#define ZK (GLA_K)
#define ZV (2 * GLA_K)
#define ZOG (ZV + GLA_V)
#define ZAF (ZOG + GLA_V)
#define ZAB (ZAF + 16)
#define ZR (ZAB + 16)
#define ZS5 (ZR + RWKV_IN)
#define ZG (ZS5 + SW)
#define D_IN (ZG + 3 * D_MODEL)
#define NC (MTOT / 64)
#define NCC (CTX / 64)
#define RB (ROWS / 64)
#define PQ (PH * 256)
#define NEXP 16384
#define NTHREADS 256
#define SMEM_BYTES 102400

typedef unsigned short bf16_t;
typedef short bf16x8 __attribute__((ext_vector_type(8)));
typedef float f32x4 __attribute__((ext_vector_type(4)));
typedef unsigned u32x4 __attribute__((ext_vector_type(4)));
typedef unsigned u32x2 __attribute__((ext_vector_type(2)));
#ifdef EMU
#define MFMA16(a, b, c) emu_mfma_16x16x32_bf16(a, b, c)
#else
#define MFMA16(a, b, c) __builtin_amdgcn_mfma_f32_16x16x32_bf16(a, b, c, 0, 0, 0)
#endif
#define NPAD(n) (((n) + 127) / 128 * 128)

__device__ __forceinline__ float bf2f(bf16_t h) { return __builtin_bit_cast(float, ((unsigned)h) << 16); }
__device__ __forceinline__ bf16_t f2bf(float f) { unsigned u = __builtin_bit_cast(unsigned, f); u += 0x7FFFu + ((u >> 16) & 1u); return (bf16_t)(u >> 16); }
__device__ __forceinline__ float sigmoidf_(float x) { return 1.0f / (1.0f + expf(-x)); }
__device__ __forceinline__ float siluf_(float x) { return x * sigmoidf_(x); }
__device__ __forceinline__ float geluf_(float x) { return 0.5f * x * (1.0f + tanhf(0.7978845608028654f * (x + 0.044715f * x * x * x))); }
__device__ __forceinline__ float softplusf_(float x) { return fmaxf(x, 0.f) + log1pf(expf(-fabsf(x))); }
__device__ __forceinline__ float wave_sum(float v) {
#pragma unroll
    for (int m = 32; m >= 1; m >>= 1) v += __shfl_xor(v, m, 64);
    return v;
}

struct P {
    const float* in[39];
    float* out;
    float* X;
    bf16_t* H;
    bf16_t* Z;
    float* MOD;
    bf16_t* R; bf16_t* V; bf16_t* KK; bf16_t* KD; bf16_t* BB;
    float* W;
    float* BONUS;
    bf16_t* GS;
    float* Y;
    float* KV;
    float* DEC;
    float* OGLA;
    float* S5A;
    float* S5BB;
    float* S5END;
    bf16_t* GY;
    float* YN;
    bf16_t* BR;
    bf16_t* M;
    float* Q;
    int* IDX;
    float* G;
    unsigned* bar;
    bf16_t* WT_IN;
    bf16_t* WT_G2;
    bf16_t* WT_GLU;
    bf16_t* WT_BR;
    bf16_t* WT_OUT;
    bf16_t* WT_Q;
    bf16_t* UB; bf16_t* VB;
};

enum { I_X = 0, I_C, I_CTX, I_CCTX, I_WMOD, I_BMOD, I_N1G, I_N2G, I_WIN, I_GLA_WA2, I_GLA_BA, I_GLA_NG, I_RCONV, I_RW0, I_RW2, I_RA0, I_RA2, I_RG2,
       I_RKK, I_RKA, I_RRK, I_RLNW, I_RLNB, I_S5LRE, I_S5LIM, I_S5LS, I_S5BRE, I_S5BIM, I_S5CRE, I_S5CIM, I_S5D, I_S5GLU, I_WBR, I_WOUT, I_PWQ, I_PKEYS, I_PU, I_PV, I_FG };

#ifdef EMU
__device__ __forceinline__ int otid() { return threadIdx.x; }
__device__ __forceinline__ int obid() { return blockIdx.x; }
#else
__device__ __forceinline__ int otid() { int t = threadIdx.x; asm volatile("" : "+v"(t)); return t; }
__device__ __forceinline__ int obid() { int b = blockIdx.x; asm volatile("" : "+s"(b)); return b; }
#endif
#ifdef EMU
#define WAVE_SYNC() emu_wave_barrier()
#ifndef EMU_GRID
#define EMU_GRID 4
#endif
#else
#define WAVE_SYNC() __builtin_amdgcn_wave_barrier()
#endif
#ifndef EMU
#define XB_TMO      128
#define XB_XCNT(j)  (256  + 64 * (j))
#define XB_XSUB(j)  (1280 + 64 * (j))
#define XB_XGEN(j)  (2304 + 64 * (j))
#define XB_TOP      3328
#define XB_TOPGEN   3392
#define XCD_BAR_WORDS 3456
#define XB_SPIN_CAP (1u << 22)
#define LAS __attribute__((address_space(3)))
__device__ __forceinline__ unsigned xb_ld(unsigned* p)              { return __hip_atomic_load(p, __ATOMIC_RELAXED, __HIP_MEMORY_SCOPE_AGENT); }
__device__ __forceinline__ unsigned xb_add(unsigned* p, unsigned v) { return __hip_atomic_fetch_add(p, v, __ATOMIC_RELAXED, __HIP_MEMORY_SCOPE_AGENT); }
__device__ __forceinline__ unsigned xb_xcc_id() { return (unsigned)__builtin_amdgcn_s_getreg((3 << 11) | 20) & 0xFu; }
#define XB_SPIN(cond, bar) do { unsigned _sp = 0; while (cond) { __builtin_amdgcn_s_sleep(1); \
    if ((++_sp & 255u) == 0u) { if (xb_ld(&(bar)[XB_TMO])) break; if (_sp > XB_SPIN_CAP) { atomicAdd(&(bar)[XB_TMO], 1u); break; } } } } while (0)
struct XcdBarrier { unsigned* bar; unsigned x; volatile LAS unsigned* st; };
__device__ __forceinline__ XcdBarrier xcd_barrier_post(unsigned* bar, volatile LAS unsigned* st) {
    XcdBarrier b; b.bar = bar; b.x = xb_xcc_id(); b.st = st;
    if (threadIdx.x == 0) (void)xb_add(&bar[XB_XCNT(b.x)], 1u);
    return b;
}
__device__ __forceinline__ void xcd_barrier_complete(unsigned* bar, unsigned x, unsigned& nloc, unsigned& nx) {
    const unsigned G = gridDim.x * gridDim.y * gridDim.z;
    unsigned sum, cnt, mine, sp = 0u;
    for (;;) {
        sum = 0u; cnt = 0u; mine = 0u;
#pragma unroll
        for (unsigned j = 0; j < 16; ++j) { const unsigned c = xb_ld(&bar[XB_XCNT(j)]); sum += c; cnt += (c > 0u) ? 1u : 0u; mine = (j == x) ? c : mine; }
        if (sum == G) break;
        __builtin_amdgcn_s_sleep(1);
        if ((++sp & 255u) == 0u) { if (xb_ld(&bar[XB_TMO])) break; if (sp > XB_SPIN_CAP) { atomicAdd(&bar[XB_TMO], 1u); break; } }
    }
    nloc = mine > 0u ? mine : 1u; nx = cnt > 0u ? cnt : 1u;
}
__device__ __forceinline__ void xcd_barrier(const XcdBarrier& b) {
    asm volatile("s_waitcnt vmcnt(0)" ::: "memory");
    __syncthreads();
    if (threadIdx.x == 0) {
        unsigned* bar = b.bar;
        __builtin_amdgcn_s_waitcnt(0);
        unsigned nloc = b.st[0], nx = b.st[1];
        if (nloc == 0u) { xcd_barrier_complete(bar, b.x, nloc, nx); b.st[0] = nloc; b.st[1] = nx; }
        const unsigned old = xb_add(&bar[XB_XSUB(b.x)], 1u);
        const unsigned gen = old / nloc;
        if (old + 1u == (gen + 1u) * nloc) {
            __builtin_amdgcn_fence(__ATOMIC_RELEASE, "agent");
            asm volatile("s_waitcnt vmcnt(0)" ::: "memory");
            const unsigned og = xb_add(&bar[XB_TOP], 1u);
            const unsigned tg = og / nx;
            if (og + 1u == (tg + 1u) * nx) xb_add(&bar[XB_TOPGEN], 1u);
            else XB_SPIN(xb_ld(&bar[XB_TOPGEN]) == tg, bar);
            __builtin_amdgcn_fence(__ATOMIC_ACQUIRE, "agent");
            xb_add(&bar[XB_XGEN(b.x)], 1u);
            asm volatile("s_waitcnt vmcnt(0)" ::: "memory");
        } else {
            XB_SPIN(xb_ld(&bar[XB_XGEN(b.x)]) == gen, bar);
            __builtin_amdgcn_fence(__ATOMIC_ACQUIRE, "agent");
            asm volatile("s_waitcnt vmcnt(0)" ::: "memory");
        }
    }
    __syncthreads();
}
#define GRID_SYNC() xcd_barrier(xb)
#else
#define GRID_SYNC() emu_grid_sync()
#endif

__device__ __forceinline__ int gla_tok(int n, int i) {
    if (n < NCC) return n * 64 + i;
    int m = n - NCC; int col = m / RB, rb = m % RB;
    return CTX + (rb * 64 + i) * GRID_W + col;
}
__device__ __forceinline__ int chunk_order(int d, int s) {
    if (d == 0) return s;
    return (s < NCC) ? (NCC - 1 - s) : (NC - 1 - (s - NCC));
}
__device__ __forceinline__ int tok_order(int d, int s) {
    if (d == 0) return s;
    return (s < CTX) ? (CTX - 1 - s) : (MTOT - 1 - (s - CTX));
}


#define LDS_ROW 72
__device__ __forceinline__ void mfma_gemm_tile(const bf16_t* Wt, int ldw, const bf16_t* Act, int lda, int K, int n0, int m0, bf16_t* lds, f32x4 (&acc)[4][4]) {
    bf16_t* Ws = lds; bf16_t* As = lds + 128 * LDS_ROW;
    const int tid = otid(), lane = tid & 63, wave = tid >> 6, wn = wave >> 1, wm = wave & 1;
    const int lrow = tid >> 3, lkc = (tid & 7) * 8;
    u32x4 pw[4], pa[4];
#pragma unroll
    for (int i = 0; i < 4; ++i) {
        pw[i] = *(const u32x4*)(Wt + (size_t)(n0 + lrow + 32 * i) * ldw + lkc);
        pa[i] = *(const u32x4*)(Act + (size_t)(m0 + lrow + 32 * i) * lda + lkc);
    }
    for (int k0 = 0; k0 < K; k0 += 64) {
        __syncthreads();
#pragma unroll
        for (int i = 0; i < 4; ++i) {
            *(u32x4*)(Ws + (lrow + 32 * i) * LDS_ROW + lkc) = pw[i];
            *(u32x4*)(As + (lrow + 32 * i) * LDS_ROW + lkc) = pa[i];
        }
        __syncthreads();
        if (k0 + 64 < K) {
#pragma unroll
            for (int i = 0; i < 4; ++i) {
                pw[i] = *(const u32x4*)(Wt + (size_t)(n0 + lrow + 32 * i) * ldw + k0 + 64 + lkc);
                pa[i] = *(const u32x4*)(Act + (size_t)(m0 + lrow + 32 * i) * lda + k0 + 64 + lkc);
            }
        }
#pragma unroll
        for (int ks = 0; ks < 2; ++ks) {
            bf16x8 a[4], b[4];
#pragma unroll
            for (int i = 0; i < 4; ++i) {
                a[i] = *(const bf16x8*)(Ws + (wn * 64 + i * 16 + (lane & 15)) * LDS_ROW + ks * 32 + (lane >> 4) * 8);
                b[i] = *(const bf16x8*)(As + (wm * 64 + i * 16 + (lane & 15)) * LDS_ROW + ks * 32 + (lane >> 4) * 8);
            }
#pragma unroll
            for (int ni = 0; ni < 4; ++ni)
#pragma unroll
                for (int mi = 0; mi < 4; ++mi) acc[ni][mi] = MFMA16(a[ni], b[mi], acc[ni][mi]);
        }
    }
}
#define ZERO_ACC4(acc) { _Pragma("unroll") for (int i_ = 0; i_ < 4; ++i_) _Pragma("unroll") for (int j_ = 0; j_ < 4; ++j_) acc[i_][j_] = (f32x4){0.f, 0.f, 0.f, 0.f}; }
#define FOR_ACC(acc, n0, m0, BODY) { const int lane_ = otid() & 63, wave_ = otid() >> 6; \
    _Pragma("unroll") for (int ni_ = 0; ni_ < 4; ++ni_) _Pragma("unroll") for (int mi_ = 0; mi_ < 4; ++mi_) { \
        const int n = (n0) + (wave_ >> 1) * 64 + ni_ * 16 + (lane_ >> 4) * 4; const int m = (m0) + (wave_ & 1) * 64 + mi_ * 16 + (lane_ & 15); const f32x4 v = acc[ni_][mi_]; BODY } }
__device__ __forceinline__ u32x2 pack4(float a, float b, float c, float d) { u32x2 r; r.x = (unsigned)f2bf(a) | ((unsigned)f2bf(b) << 16); r.y = (unsigned)f2bf(c) | ((unsigned)f2bf(d) << 16); return r; }

__device__ __forceinline__ void convert_wt_job(const float* W, int K, int N, int Npad, bf16_t* out, int job, float* T, int ilv) {
    const int tid = otid();
    const int nkt = K / 64;
    const int n0 = (job / nkt) * 64, k0 = (job % nkt) * 64;
    __syncthreads();
    for (int idx = tid; idx < 4096; idx += NTHREADS) {
        int kk = idx >> 6, nn = idx & 63;
        int nr = n0 + nn; int src = ilv ? ((nr & 1) ? (N / 2 + (nr >> 1)) : (nr >> 1)) : nr;
        T[kk * 65 + nn] = (nr < N) ? W[(size_t)(k0 + kk) * N + src] : 0.f;
    }
    __syncthreads();
    {
        int nn = tid >> 2, part = tid & 3;
        unsigned w[8];
#pragma unroll
        for (int j = 0; j < 8; ++j) w[j] = (unsigned)f2bf(T[(part * 16 + 2 * j) * 65 + nn]) | ((unsigned)f2bf(T[(part * 16 + 2 * j + 1) * 65 + nn]) << 16);
        u32x4* o = (u32x4*)(out + (size_t)(n0 + nn) * K + k0 + part * 16);
        o[0] = (u32x4){w[0], w[1], w[2], w[3]}; o[1] = (u32x4){w[4], w[5], w[6], w[7]};
    }
}
__device__ __forceinline__ void phase_convert_weights(const P& p, int l, char* smem) {
    float* T = (float*)smem;
    struct Item { const float* W; int K, N, Npad; bf16_t* out; };
    const Item items[8] = {
        {p.in[I_WIN] + (size_t)l * D_MODEL * D_IN, D_MODEL, D_IN, NPAD(D_IN), p.WT_IN},
        {p.in[I_RG2] + (size_t)l * 128 * RW, 128, RW, RW, p.WT_G2},
        {p.in[I_S5GLU] + (size_t)l * SW * 2 * SW, SW, 2 * SW, 2 * SW, p.WT_GLU},
        {p.in[I_WBR] + ((size_t)l * 3 + 0) * BW * D_MODEL, BW, D_MODEL, D_MODEL, p.WT_BR},
        {p.in[I_WBR] + ((size_t)l * 3 + 1) * BW * D_MODEL, BW, D_MODEL, D_MODEL, p.WT_BR + (size_t)D_MODEL * BW},
        {p.in[I_WBR] + ((size_t)l * 3 + 2) * BW * D_MODEL, BW, D_MODEL, D_MODEL, p.WT_BR + (size_t)2 * D_MODEL * BW},
        {p.in[I_WOUT] + (size_t)l * D_MODEL * D_MODEL, D_MODEL, D_MODEL, D_MODEL, p.WT_OUT},
        {p.in[I_PWQ] + (size_t)l * D_MODEL * PQ, D_MODEL, PQ, PQ, p.WT_Q}};
    int base = 0;
#pragma unroll
    for (int it = 0; it < 8; ++it) {
        const int nj = (items[it].Npad / 64) * (items[it].K / 64);
        for (int j = (int)((obid() + gridDim.x - (base % gridDim.x)) % gridDim.x); j < nj; j += gridDim.x)
            convert_wt_job(items[it].W, items[it].K, items[it].N, items[it].Npad, items[it].out, j, T, it == 2);
        base += nj;
    }
    __syncthreads();
}

__device__ __forceinline__ void phase_init(const P& p, char* smem) {
    const int tid = otid();
    float* sc = (float*)smem;
    for (int i = tid; i < D_MODEL; i += NTHREADS) { sc[i] = siluf_(p.in[I_CCTX][i]); sc[D_MODEL + i] = siluf_(p.in[I_C][i]); }
    __syncthreads();
    const int ncolblk = (6 * D_MODEL) / NTHREADS;
    for (int job = obid(); job < DEPTH * ncolblk; job += gridDim.x) {
        int l = job / ncolblk, n = (job % ncolblk) * NTHREADS + tid;
        const float* w = p.in[I_WMOD] + (size_t)l * D_MODEL * 6 * D_MODEL + n;
        float a0 = 0.f, a1 = 0.f;
        for (int k = 0; k < D_MODEL; ++k) { float wv = w[(size_t)k * 6 * D_MODEL]; a0 += sc[k] * wv; a1 += sc[D_MODEL + k] * wv; }
        float b = p.in[I_BMOD][l * 6 * D_MODEL + n];
        p.MOD[(size_t)(l * 2 + 0) * 6 * D_MODEL + n] = a0 + b;
        p.MOD[(size_t)(l * 2 + 1) * 6 * D_MODEL + n] = a1 + b;
    }
    const size_t gtid = (size_t)obid() * NTHREADS + tid, gn = (size_t)gridDim.x * NTHREADS;
    for (size_t i = gtid; i < (size_t)CTX * D_MODEL; i += gn) p.X[i] = p.in[I_CTX][i];
    for (size_t i = gtid; i < (size_t)SEQ * D_MODEL; i += gn) p.X[(size_t)CTX * D_MODEL + i] = p.in[I_X][i];
    __syncthreads();
}

__device__ __forceinline__ void phase_s5const(const P& p, int l) {
    const size_t gtid = (size_t)obid() * NTHREADS + otid(), gn = (size_t)gridDim.x * NTHREADS;
    for (size_t i = gtid; i < (size_t)2 * SG * 64; i += gn) {
        int d = (int)(i / (SG * 64)), g = (int)((i / 64) % SG), s = (int)(i % 64);
        size_t li = ((size_t)(l * 2 + d) * SG + g) * 64 + s;
        float lre = p.in[I_S5LRE][li], lim = p.in[I_S5LIM][li];
        float dt = expf(p.in[I_S5LS][(l * 2 + d) * SG + g]);
        float mag = expf(lre * dt);
        float are = mag * cosf(lim * dt), aim = mag * sinf(lim * dt);
        float den = lre * lre + lim * lim;
        float fre = ((are - 1.0f) * lre + aim * lim) / den;
        float fim = (aim * lre - (are - 1.0f) * lim) / den;
        p.S5A[i * 2 + 0] = are; p.S5A[i * 2 + 1] = aim;
        const float* bre = p.in[I_S5BRE] + (((size_t)l * SG + g) * 64 + s) * 16;
        const float* bim = p.in[I_S5BIM] + (((size_t)l * SG + g) * 64 + s) * 16;
        for (int c = 0; c < 16; ++c) {
            p.S5BB[(i * 16 + c) * 2 + 0] = fre * bre[c] - fim * bim[c];
            p.S5BB[(i * 16 + c) * 2 + 1] = fre * bim[c] + fim * bre[c];
        }
    }
}

__device__ __forceinline__ void phase_norm(const P& p, int l, int which) {
    const int lane = otid() & 63;
    const int gw = (obid() * NTHREADS + otid()) >> 6, nw = (gridDim.x * NTHREADS) >> 6;
    const float* g = p.in[which ? I_N2G : I_N1G] + l * D_MODEL;
    for (int t = gw; t < MTOT; t += nw) {
        const float* x = p.X + (size_t)t * D_MODEL;
        const float* mod = p.MOD + (size_t)(l * 2 + (t >= CTX ? 1 : 0)) * 6 * D_MODEL + (which ? 3 * D_MODEL : 0);
        float v[D_MODEL / 64]; float ss = 0.f;
#pragma unroll
        for (int j = 0; j < D_MODEL / 64; ++j) { v[j] = x[lane + 64 * j]; ss += v[j] * v[j]; }
        ss = wave_sum(ss);
        float rstd = rsqrtf(ss / D_MODEL + 1e-6f);
#pragma unroll
        for (int j = 0; j < D_MODEL / 64; ++j) {
            int e = lane + 64 * j;
            p.H[(size_t)t * D_MODEL + e] = f2bf(v[j] * rstd * g[e] * (1.0f + mod[D_MODEL + e]) + mod[e]);
        }
    }
}

__device__ __forceinline__ void phase_gemm_in(const P& p, int l, char* smem) {
    const int ntn = NPAD(D_IN) / 128, ntm = MTOT / 128;
    for (int job = obid(); job < ntm * ntn; job += gridDim.x) {
        const int m0 = (job / ntn) * 128, n0 = (job % ntn) * 128;
        f32x4 acc[4][4]; ZERO_ACC4(acc);
        mfma_gemm_tile(p.WT_IN, D_MODEL, p.H, D_MODEL, D_MODEL, n0, m0, (bf16_t*)smem, acc);
        FOR_ACC(acc, n0, m0, { if (n < D_IN) *(u32x2*)(p.Z + (size_t)m * D_IN + n) = pack4(v[0], v[1], v[2], v[3]); })
    }
}

#define RTOK 4
__device__ __forceinline__ void phase_rwkv_prep(const P& p, int l, char* smem) {
    const int tid = otid(), lane = tid & 63;
    float* zs = (float*)smem;
    const float* conv = p.in[I_RCONV] + (size_t)l * 3 * RWKV_IN;
    const float* w0 = p.in[I_RW0] + (size_t)l * 2 * RW;
    const float* w2 = p.in[I_RW2] + (size_t)l * 2 * 64 * RW;
    const float* a0 = p.in[I_RA0] + (size_t)l * 2 * RW;
    const float* a2 = p.in[I_RA2] + (size_t)l * 2 * 64 * RW;
    const float* k_k = p.in[I_RKK] + (size_t)l * RW;
    const float* k_a = p.in[I_RKA] + (size_t)l * RW;
    const float* r_k = p.in[I_RRK] + (size_t)l * RW;
    for (int job = obid(); job < MTOT / RTOK; job += gridDim.x) {
        const int t0 = job * RTOK;
        __syncthreads();
        for (int idx = tid; idx < RTOK * RWKV_IN; idx += NTHREADS) {
            int tt = idx / RWKV_IN, c = idx % RWKV_IN; int t = t0 + tt;
            bool first = (t == 0) || (t == CTX), last = (t == CTX - 1) || (t == MTOT - 1);
            const bf16_t* zp = p.Z + (size_t)t * D_IN + ZR + c;
            float v = conv[RWKV_IN + c] * bf2f(zp[0]);
            if (!first) v += conv[c] * bf2f(zp[-D_IN]);
            if (!last) v += conv[2 * RWKV_IN + c] * bf2f(zp[D_IN]);
            if (c >= 3 * RW && c < 3 * RW + 128) v = tanhf(v);
            zs[idx] = v;
        }
        __syncthreads();
        for (int c = tid; c < RW; c += NTHREADS) {
            const int h = c >> 6;
            float accw[2][RTOK], acca[2][RTOK];
#pragma unroll
            for (int d = 0; d < 2; ++d)
#pragma unroll
                for (int tt = 0; tt < RTOK; ++tt) { accw[d][tt] = w0[d * RW + c]; acca[d][tt] = a0[d * RW + c]; }
            for (int j = 0; j < 64; ++j) {
#pragma unroll
                for (int d = 0; d < 2; ++d) {
                    float wv = w2[((size_t)d * 64 + j) * RW + c], av = a2[((size_t)d * 64 + j) * RW + c];
#pragma unroll
                    for (int tt = 0; tt < RTOK; ++tt) {
                        accw[d][tt] += zs[tt * RWKV_IN + 3 * RW + d * 64 + j] * wv;
                        acca[d][tt] += zs[tt * RWKV_IN + 3 * RW + 128 + d * 64 + j] * av;
                    }
                }
            }
#pragma unroll
            for (int tt = 0; tt < RTOK; ++tt) {
                const int t = t0 + tt;
                float r = zs[tt * RWKV_IN + c], k = zs[tt * RWKV_IN + RW + c], v = zs[tt * RWKV_IN + 2 * RW + c];
                float kkr = k * k_k[c];
                float nrm = wave_sum(kkr * kkr);
                float kk = kkr / fmaxf(sqrtf(nrm), 1e-12f);
                float kdsum = 0.f;
#pragma unroll
                for (int d = 0; d < 2; ++d) {
                    float dec = expf(-expf(-softplusf_(-accw[d][tt]) - 0.5f));
                    float aa = sigmoidf_(acca[d][tt]);
                    float kd = k * (1.0f + (aa - 1.0f) * k_a[c]);
                    kdsum += kd;
                    size_t o = ((size_t)d * MTOT + t) * RW + c;
                    p.W[o] = dec; p.KD[o] = f2bf(kd); p.BB[o] = f2bf(kk * aa);
                }
                size_t o = (size_t)t * RW + c;
                p.R[o] = f2bf(r); p.V[o] = f2bf(v); p.KK[o] = f2bf(kk);
                float bon = wave_sum(r * kdsum * r_k[c]);
                if (lane == 0) p.BONUS[(size_t)t * RH + h] = bon;
            }
        }
        for (int idx = tid; idx < RTOK * 128; idx += NTHREADS) {
            int tt = idx >> 7, j = idx & 127;
            p.GS[(size_t)(t0 + tt) * 128 + j] = f2bf(sigmoidf_(zs[tt * RWKV_IN + 3 * RW + 256 + j]));
        }
    }
    __syncthreads();
}

#define G_SQ 0
#define G_SK 4096
#define G_SV 8192
#define G_CUM 16384
#define G_ATT 20480
#define G_END 24576
__device__ __forceinline__ void gla_load(const P& p, int l, int n, int h, int d, float* s) {
    const int tid = otid();
    float* alr = s + G_ATT;
    for (int idx = tid; idx < 64 * 64; idx += NTHREADS) {
        int i = idx >> 6, c = idx & 63; int t = gla_tok(n, i);
        const bf16_t* z = p.Z + (size_t)t * D_IN;
        s[G_SQ + idx] = bf2f(z[ZQ + h * 64 + c]) * 0.125f;
        s[G_SK + idx] = bf2f(z[ZK + h * 64 + c]);
    }
    for (int idx = tid; idx < 64 * 128; idx += NTHREADS) {
        int i = idx >> 7, c = idx & 127; int t = gla_tok(n, i);
        s[G_SV + idx] = bf2f(p.Z[(size_t)t * D_IN + ZV + h * 128 + c]);
    }
    for (int idx = tid; idx < 64 * 16; idx += NTHREADS) {
        int i = idx >> 4, r = idx & 15; int t = gla_tok(n, i);
        alr[idx] = bf2f(p.Z[(size_t)t * D_IN + (d ? ZAB : ZAF) + r]);
    }
    __syncthreads();
    const float* wa2 = p.in[I_GLA_WA2] + ((size_t)(l * 2 + d) * 16) * GLA_K + h * 64;
    const float* ba = p.in[I_GLA_BA] + (size_t)(l * 2 + d) * GLA_K + h * 64;
    for (int idx = tid; idx < 64 * 64; idx += NTHREADS) {
        int i = idx >> 6, c = idx & 63;
        float a = ba[c];
#pragma unroll
        for (int r = 0; r < 16; ++r) a += alr[i * 16 + r] * wa2[(size_t)r * GLA_K + c];
        float ls = fminf(a, 0.f) - log1pf(expf(-fabsf(a)));
        s[G_CUM + idx] = ls * (1.0f / 16.0f);
    }
    __syncthreads();
    if (tid < 64) {
        float run = 0.f;
        if (d == 0) { for (int i = 0; i < 64; ++i) { run += s[G_CUM + i * 64 + tid]; s[G_CUM + i * 64 + tid] = run; } }
        else { for (int i = 63; i >= 0; --i) { run += s[G_CUM + i * 64 + tid]; s[G_CUM + i * 64 + tid] = run; } }
    }
    __syncthreads();
}

__device__ __forceinline__ void phase_gla_kv(const P& p, int l, char* smem) {
    float* s = (float*)smem;
    const int tid = otid();
    for (int job = obid(); job < NC * GH; job += gridDim.x) {
        const int n = job / GH, h = job % GH;
        for (int d = 0; d < 2; ++d) {
            __syncthreads();
            gla_load(p, l, n, h, d, s);
            const int li = d ? 0 : 63;
            for (int idx = tid; idx < 64 * 64; idx += NTHREADS) {
                int c = idx & 63;
                s[G_SQ + idx] = s[G_SK + idx] * expf(s[G_CUM + li * 64 + c] - s[G_CUM + idx]);
            }
            if (tid < 64) p.DEC[((size_t)(d * NC + n) * GH + h) * 64 + tid] = expf(s[G_CUM + li * 64 + tid]);
            __syncthreads();
            float* kv = p.KV + ((size_t)(d * NC + n) * GH + h) * 64 * 128;
            const int dv = tid & 127, kh = (tid >> 7) * 32;
            float acc[32];
#pragma unroll
            for (int j = 0; j < 32; ++j) acc[j] = 0.f;
            for (int i = 0; i < 64; ++i) {
                float vv = s[G_SV + i * 128 + dv];
#pragma unroll
                for (int j = 0; j < 32; ++j) acc[j] += s[G_SQ + i * 64 + kh + j] * vv;
            }
#pragma unroll
            for (int j = 0; j < 32; ++j) kv[(size_t)(kh + j) * 128 + dv] = acc[j];
        }
    }
    __syncthreads();
}

__device__ __forceinline__ void gla_scan_job(const P& p, int job) {
    int base = job * NTHREADS + otid();
    int d = base / (GH * 8192), h = (base / 8192) % GH, e = base % 8192;
    float S = 0.f;
    for (int s = 0; s < NC; ++s) {
        int n = chunk_order(d, s);
        size_t o = ((size_t)(d * NC + n) * GH + h);
        float kv = p.KV[o * 8192 + e];
        float dec = p.DEC[o * 64 + (e >> 7)];
        p.KV[o * 8192 + e] = S;
        S = dec * S + kv;
    }
}

__device__ __forceinline__ void phase_gla_out(const P& p, int l, char* smem) {
    float* s = (float*)smem;
    const int tid = otid();
    const int tx = tid & 31, ty = tid >> 5;
    for (int job = obid(); job < NC * GH; job += gridDim.x) {
        const int n = job / GH, h = job % GH;
        float o[8][4];
#pragma unroll
        for (int i = 0; i < 8; ++i)
#pragma unroll
            for (int j = 0; j < 4; ++j) o[i][j] = 0.f;
        for (int d = 0; d < 2; ++d) {
            __syncthreads();
            gla_load(p, l, n, h, d, s);
            for (int idx = tid; idx < 64 * 64; idx += NTHREADS) {
                float c = s[G_CUM + idx];
                s[G_SQ + idx] *= expf(c);
                s[G_SK + idx] *= expf(-c);
            }
            __syncthreads();
            for (int idx = tid; idx < 64 * 64; idx += NTHREADS) {
                int i = idx >> 6, j = idx & 63;
                bool ok = d ? (j >= i) : (j <= i);
                float a = 0.f;
                if (ok) { for (int c = 0; c < 64; ++c) a += s[G_SQ + i * 64 + c] * s[G_SK + j * 64 + c]; }
                s[G_ATT + idx] = a;
            }
            __syncthreads();
            const float* S = p.KV + ((size_t)(d * NC + n) * GH + h) * 64 * 128;
            for (int j = 0; j < 64; ++j) {
                float v4[4], s4[4];
#pragma unroll
                for (int c = 0; c < 4; ++c) { v4[c] = s[G_SV + j * 128 + tx * 4 + c]; s4[c] = S[(size_t)j * 128 + tx * 4 + c]; }
#pragma unroll
                for (int i = 0; i < 8; ++i) {
                    float a = s[G_ATT + (ty * 8 + i) * 64 + j], q = s[G_SQ + (ty * 8 + i) * 64 + j];
#pragma unroll
                    for (int c = 0; c < 4; ++c) o[i][c] += a * v4[c] + q * s4[c];
                }
            }
        }
#pragma unroll
        for (int i = 0; i < 8; ++i) {
            int t = gla_tok(n, ty * 8 + i);
#pragma unroll
            for (int c = 0; c < 4; ++c) p.OGLA[(size_t)t * GLA_V + h * 128 + tx * 4 + c] = o[i][c];
        }
    }
    __syncthreads();
}

__device__ __forceinline__ void rwkv_scan_job(const P& p, int job, char* smem) {
    const int tid = otid();
    const int d = job / (RH * 4), h = (job / 4) % RH, rb = job % 4;
    const int rl = tid >> 4, seg = tid & 15, row = rb * 16 + rl;
    bf16_t* sKK = (bf16_t*)smem;
    bf16_t* sBB = sKK + 4096;
    bf16_t* sKD = sBB + 4096;
    bf16_t* sR = sKD + 4096;
    bf16_t* sV = sR + 4096;
    float* sW = (float*)(sV + 4096);
    float S[4] = {0.f, 0.f, 0.f, 0.f};
    for (int s0 = 0; s0 < MTOT; s0 += 64) {
        __syncthreads();
        for (int idx = tid; idx < 4096; idx += NTHREADS) {
            int i = idx >> 6, c = idx & 63; int t = tok_order(d, s0 + i);
            size_t o1 = (size_t)t * RW + h * 64 + c, o2 = ((size_t)d * MTOT + t) * RW + h * 64 + c;
            sKK[idx] = p.KK[o1]; sR[idx] = p.R[o1]; sV[idx] = p.V[o1];
            sBB[idx] = p.BB[o2]; sKD[idx] = p.KD[o2]; sW[idx] = p.W[o2];
        }
        __syncthreads();
        for (int i = 0; i < 64; ++i) {
            float kk[4], w[4], b[4], kd[4], r[4];
#pragma unroll
            for (int c = 0; c < 4; ++c) {
                int o = i * 64 + seg * 4 + c;
                kk[c] = bf2f(sKK[o]); w[c] = sW[o]; b[c] = bf2f(sBB[o]); kd[c] = bf2f(sKD[o]); r[c] = bf2f(sR[o]);
            }
            float v = bf2f(sV[i * 64 + row]);
            float sa = 0.f;
#pragma unroll
            for (int c = 0; c < 4; ++c) sa -= S[c] * kk[c];
            sa += __shfl_xor(sa, 1, 64); sa += __shfl_xor(sa, 2, 64); sa += __shfl_xor(sa, 4, 64); sa += __shfl_xor(sa, 8, 64);
            float y = 0.f;
#pragma unroll
            for (int c = 0; c < 4; ++c) { S[c] = S[c] * w[c] + sa * b[c] + v * kd[c]; y += S[c] * r[c]; }
            y += __shfl_xor(y, 1, 64); y += __shfl_xor(y, 2, 64); y += __shfl_xor(y, 4, 64); y += __shfl_xor(y, 8, 64);
            if (seg == 0) { int t = tok_order(d, s0 + i); p.Y[((size_t)d * MTOT + t) * RW + h * 64 + row] = y; }
        }
    }
    __syncthreads();
}

__device__ __forceinline__ void s5_local_job(const P& p, int job, char* smem, bool with_carry) {
    const int tid = otid();
    const int n = job / SG, g = job % SG;
    float* su = (float*)smem;
    float* xs = su + 1024;
    float* cre = xs + 2 * 64 * 64 * 2;
    float* cim = cre + 1024;
    __syncthreads();
    for (int idx = tid; idx < 1024; idx += NTHREADS) {
        int i = idx >> 4, c = idx & 15;
        su[idx] = bf2f(p.Z[(size_t)(n * 64 + i) * D_IN + ZS5 + g * 16 + c]);
    }
    __syncthreads();
    if (tid < 128) {
        const int d = tid >> 6, st = tid & 63;
        size_t ci = ((size_t)d * SG + g) * 64 + st;
        float are = p.S5A[ci * 2], aim = p.S5A[ci * 2 + 1];
        float bre[16], bim[16];
#pragma unroll
        for (int c = 0; c < 16; ++c) { bre[c] = p.S5BB[(ci * 16 + c) * 2]; bim[c] = p.S5BB[(ci * 16 + c) * 2 + 1]; }
        size_t eo = (((size_t)d * NC + n) * SG + g) * 64 + st;
        float xr = 0.f, xi = 0.f;
        if (with_carry) { xr = p.S5END[eo * 2]; xi = p.S5END[eo * 2 + 1]; }
        for (int ii = 0; ii < 64; ++ii) {
            int i = d ? 63 - ii : ii;
            float ur = 0.f, ui = 0.f;
#pragma unroll
            for (int c = 0; c < 16; ++c) { float u = su[i * 16 + c]; ur += bre[c] * u; ui += bim[c] * u; }
            float nr = are * xr - aim * xi + ur, ni = are * xi + aim * xr + ui;
            xr = nr; xi = ni;
            if (with_carry) { xs[((d * 64 + i) * 64 + st) * 2] = xr; xs[((d * 64 + i) * 64 + st) * 2 + 1] = xi; }
        }
        if (!with_carry) { p.S5END[eo * 2] = xr; p.S5END[eo * 2 + 1] = xi; }
    }
}
__device__ __forceinline__ void s5_out_job(const P& p, int l, int job, char* smem) {
    const int tid = otid();
    const int n = job / SG, g = job % SG;
    float* su = (float*)smem;
    float* xs = su + 1024;
    float* cre = xs + 2 * 64 * 64 * 2;
    float* cim = cre + 1024;
    s5_local_job(p, job, smem, true);
    for (int idx = tid; idx < 1024; idx += NTHREADS) {
        cre[idx] = p.in[I_S5CRE][((size_t)l * SG + g) * 1024 + idx];
        cim[idx] = p.in[I_S5CIM][((size_t)l * SG + g) * 1024 + idx];
    }
    __syncthreads();
    for (int idx = tid; idx < 1024; idx += NTHREADS) {
        int i = idx >> 4, c = idx & 15;
        float a = 0.f;
        for (int st = 0; st < 64; ++st) {
            float xr = xs[((0 * 64 + i) * 64 + st) * 2] + xs[((1 * 64 + i) * 64 + st) * 2];
            float xi = xs[((0 * 64 + i) * 64 + st) * 2 + 1] + xs[((1 * 64 + i) * 64 + st) * 2 + 1];
            a += cre[c * 64 + st] * xr - cim[c * 64 + st] * xi;
        }
        a += p.in[I_S5D][(size_t)l * SW + g * 16 + c] * su[idx];
        p.GY[(size_t)(n * 64 + i) * SW + g * 16 + c] = f2bf(geluf_(a));
    }
    __syncthreads();
}
__device__ __forceinline__ void s5_carry_job(const P& p, int job) {
    int base = job * NTHREADS + otid();
    if (base >= 2 * SG * 64) return;
    int d = base / (SG * 64), g = (base / 64) % SG, st = base % 64;
    size_t ci = ((size_t)d * SG + g) * 64 + st;
    float ar = p.S5A[ci * 2], ai = p.S5A[ci * 2 + 1];
    for (int i = 0; i < 6; ++i) { float nr = ar * ar - ai * ai, ni = 2.f * ar * ai; ar = nr; ai = ni; }
    float cr = 0.f, cim = 0.f;
    for (int s = 0; s < NC; ++s) {
        int n = chunk_order(d, s);
        size_t eo = (((size_t)d * NC + n) * SG + g) * 64 + st;
        float er = p.S5END[eo * 2], ei = p.S5END[eo * 2 + 1];
        p.S5END[eo * 2] = cr; p.S5END[eo * 2 + 1] = cim;
        float nr = ar * cr - ai * cim + er, ni = ar * cim + ai * cr + ei;
        cr = nr; cim = ni;
    }
}

__device__ __forceinline__ void phase_side_elem(const P& p, int l) {
    const int lane = otid() & 63;
    const int gw = (obid() * NTHREADS + otid()) >> 6, nw = (gridDim.x * NTHREADS) >> 6;
    const float* gng = p.in[I_GLA_NG] + (size_t)l * 128;
    const float* lnw = p.in[I_RLNW] + (size_t)l * RW;
    const float* lnb = p.in[I_RLNB] + (size_t)l * RW;
    for (int t = gw; t < MTOT; t += nw) {
        for (int h = 0; h < GH; ++h) {
            float o0 = p.OGLA[(size_t)t * GLA_V + h * 128 + lane], o1 = p.OGLA[(size_t)t * GLA_V + h * 128 + 64 + lane];
            float ss = wave_sum(o0 * o0 + o1 * o1);
            float rstd = rsqrtf(ss / 128.f + 1e-6f);
            float z0 = bf2f(p.Z[(size_t)t * D_IN + ZOG + h * 128 + lane]), z1 = bf2f(p.Z[(size_t)t * D_IN + ZOG + h * 128 + 64 + lane]);
            p.BR[(size_t)t * 3 * BW + h * 128 + lane] = f2bf(o0 * rstd * gng[lane] * siluf_(z0));
            p.BR[(size_t)t * 3 * BW + h * 128 + 64 + lane] = f2bf(o1 * rstd * gng[64 + lane] * siluf_(z1));
        }
        for (int h = 0; h < RH; ++h) {
            int c = h * 64 + lane;
            float y = p.Y[(size_t)t * RW + c] + p.Y[((size_t)MTOT + t) * RW + c];
            float mu = wave_sum(y) * (1.f / 64.f);
            float dv = y - mu;
            float var = wave_sum(dv * dv) * (1.f / 64.f);
            float yn = dv * rsqrtf(var + 64e-5f) * lnw[c] + lnb[c];
            yn += p.BONUS[(size_t)t * RH + h] * bf2f(p.V[(size_t)t * RW + c]);
            p.YN[(size_t)t * RW + c] = yn;
        }
    }
}

__device__ __forceinline__ void phase_side_gemm(const P& p, int l, char* smem) {
    const int ntm = MTOT / 128, nt1 = NPAD(RW) / 128, nt2 = (2 * SW) / 128;
    for (int job = obid(); job < ntm * (nt1 + nt2); job += gridDim.x) {
        const int m0 = (job / (nt1 + nt2)) * 128, jn = job % (nt1 + nt2);
        f32x4 acc[4][4]; ZERO_ACC4(acc);
        if (jn < nt1) {
            const int n0 = jn * 128;
            mfma_gemm_tile(p.WT_G2, 128, p.GS, 128, 128, n0, m0, (bf16_t*)smem, acc);
            FOR_ACC(acc, n0, m0, { if (n < RW) { const float4 y = *(const float4*)(p.YN + (size_t)m * RW + n);
                *(u32x2*)(p.BR + (size_t)m * 3 * BW + BW + n) = pack4(y.x * v[0], y.y * v[1], y.z * v[2], y.w * v[3]); } })
        } else {
            const int n0 = (jn - nt1) * 128;
            mfma_gemm_tile(p.WT_GLU, SW, p.GY, SW, SW, n0, m0, (bf16_t*)smem, acc);
            FOR_ACC(acc, n0, m0, { const unsigned w = (unsigned)f2bf(v[0] * sigmoidf_(v[1])) | ((unsigned)f2bf(v[2] * sigmoidf_(v[3])) << 16);
                *(unsigned*)(p.BR + (size_t)m * 3 * BW + 2 * BW + (n >> 1)) = w; })
        }
    }
}

__device__ __forceinline__ void phase_merge(const P& p, int l, char* smem) {
    const int ntm = MTOT / 128, ntn = D_MODEL / 128;
    for (int job = obid(); job < ntm * ntn; job += gridDim.x) {
        const int m0 = (job / ntn) * 128, n0 = (job % ntn) * 128;
        f32x4 macc[4][4]; ZERO_ACC4(macc);
        for (int b = 0; b < 3; ++b) {
            f32x4 acc[4][4]; ZERO_ACC4(acc);
            mfma_gemm_tile(p.WT_BR + (size_t)b * D_MODEL * BW, BW, p.BR + b * BW, 3 * BW, BW, n0, m0, (bf16_t*)smem, acc);
            const int lane_ = otid() & 63, wave_ = otid() >> 6;
#pragma unroll
            for (int ni = 0; ni < 4; ++ni)
#pragma unroll
                for (int mi = 0; mi < 4; ++mi) {
                    const int n = n0 + (wave_ >> 1) * 64 + ni * 16 + (lane_ >> 4) * 4, m = m0 + (wave_ & 1) * 64 + mi * 16 + (lane_ & 15);
                    const u32x2 g = *(const u32x2*)(p.Z + (size_t)m * D_IN + ZG + b * D_MODEL + n);
                    macc[ni][mi][0] += sigmoidf_(bf2f((bf16_t)(g.x & 0xFFFF))) * acc[ni][mi][0];
                    macc[ni][mi][1] += sigmoidf_(bf2f((bf16_t)(g.x >> 16))) * acc[ni][mi][1];
                    macc[ni][mi][2] += sigmoidf_(bf2f((bf16_t)(g.y & 0xFFFF))) * acc[ni][mi][2];
                    macc[ni][mi][3] += sigmoidf_(bf2f((bf16_t)(g.y >> 16))) * acc[ni][mi][3];
                }
        }
        FOR_ACC(macc, n0, m0, { *(u32x2*)(p.M + (size_t)m * D_MODEL + n) = pack4(v[0], v[1], v[2], v[3]); })
    }
}

__device__ __forceinline__ void phase_outproj(const P& p, int l, char* smem) {
    const int ntm = MTOT / 128, ntn = D_MODEL / 128;
    for (int job = obid(); job < ntm * ntn; job += gridDim.x) {
        const int m0 = (job / ntn) * 128, n0 = (job % ntn) * 128;
        f32x4 acc[4][4]; ZERO_ACC4(acc);
        mfma_gemm_tile(p.WT_OUT, D_MODEL, p.M, D_MODEL, D_MODEL, n0, m0, (bf16_t*)smem, acc);
        FOR_ACC(acc, n0, m0, { const float* g1 = p.MOD + (size_t)(l * 2 + (m >= CTX ? 1 : 0)) * 6 * D_MODEL + 2 * D_MODEL + n;
            float4* xp = (float4*)(p.X + (size_t)m * D_MODEL + n); float4 x = *xp;
            x.x += g1[0] * v[0]; x.y += g1[1] * v[1]; x.z += g1[2] * v[2]; x.w += g1[3] * v[3]; *xp = x; })
    }
}

__device__ __forceinline__ void phase_peer_q(const P& p, int l, char* smem) {
    const int ntm = MTOT / 128, ntn = PQ / 128;
    for (int job = obid(); job < ntm * ntn; job += gridDim.x) {
        const int m0 = (job / ntn) * 128, n0 = (job % ntn) * 128;
        f32x4 acc[4][4]; ZERO_ACC4(acc);
        mfma_gemm_tile(p.WT_Q, D_MODEL, p.H, D_MODEL, D_MODEL, n0, m0, (bf16_t*)smem, acc);
        FOR_ACC(acc, n0, m0, { float4 o; o.x = v[0]; o.y = v[1]; o.z = v[2]; o.w = v[3]; *(float4*)(p.Q + (size_t)m * PQ + n) = o; })
    }
}

__device__ __forceinline__ void wave_argmax(float& v, int& idx) {
#pragma unroll
    for (int m = 32; m >= 1; m >>= 1) {
        float ov = __shfl_xor(v, m, 64); int oi = __shfl_xor(idx, m, 64);
        if (ov > v || (ov == v && oi < idx)) { v = ov; idx = oi; }
    }
}

__device__ __forceinline__ void phase_peer_topk(const P& p, int l, char* smem) {
    const int lane = otid() & 63, wv = otid() >> 6;
    float* ws = (float*)smem + wv * 384;
    float* sq = ws; float* s1t = ws + 256; float* s2t = ws + 272; int* i1t = (int*)(ws + 288); int* i2t = (int*)(ws + 304);
    const int gw = (obid() * NTHREADS + otid()) >> 6, nw = (gridDim.x * NTHREADS) >> 6;
    const float NEG = -3.0e38f;
    for (int job = gw; job < MTOT * PH; job += nw) {
        const int t = job / PH, h = job % PH;
        const float* q = p.Q + (size_t)t * PQ + h * 256;
        for (int i = lane; i < 256; i += 64) sq[i] = q[i];
        WAVE_SYNC();
        const float* keys = p.in[I_PKEYS] + ((size_t)(l * PH + h) * 2) * 128 * 128;
        float sc[2][2] = {{0.f, 0.f}, {0.f, 0.f}};
        {
            const float4* k00 = (const float4*)(keys + ((size_t)0 * 128 + lane) * 128);
            const float4* k01 = (const float4*)(keys + ((size_t)0 * 128 + lane + 64) * 128);
            const float4* k10 = (const float4*)(keys + ((size_t)1 * 128 + lane) * 128);
            const float4* k11 = (const float4*)(keys + ((size_t)1 * 128 + lane + 64) * 128);
            const float4* q4 = (const float4*)sq;
#pragma unroll 2
            for (int dd = 0; dd < 32; ++dd) {
                float4 qa = q4[dd], qb = q4[32 + dd];
                float4 a = k00[dd], b = k01[dd], c = k10[dd], e = k11[dd];
                sc[0][0] += qa.x * a.x + qa.y * a.y + qa.z * a.z + qa.w * a.w;
                sc[0][1] += qa.x * b.x + qa.y * b.y + qa.z * b.z + qa.w * b.w;
                sc[1][0] += qb.x * c.x + qb.y * c.y + qb.z * c.z + qb.w * c.w;
                sc[1][1] += qb.x * e.x + qb.y * e.y + qb.z * e.z + qb.w * e.w;
            }
        }
#pragma unroll
        for (int s = 0; s < 2; ++s) {
            float v0 = sc[s][0], v1 = sc[s][1];
            for (int r = 0; r < 16; ++r) {
                float bv; int bi;
                if (v0 >= v1) { bv = v0; bi = lane; } else { bv = v1; bi = lane + 64; }
                wave_argmax(bv, bi);
                if (bi == lane) v0 = NEG;
                if (bi == lane + 64) v1 = NEG;
                if (lane == 0) { if (s == 0) { s1t[r] = bv; i1t[r] = bi; } else { s2t[r] = bv; i2t[r] = bi; } }
            }
        }
        WAVE_SYNC();
        float cv[4];
#pragma unroll
        for (int j = 0; j < 4; ++j) { int c = lane * 4 + j; cv[j] = s1t[c >> 4] + s2t[c & 15]; }
        float topv = 0.f; int topc = 0; float mx = 0.f;
        for (int r = 0; r < 16; ++r) {
            float bv = cv[0]; int bi = lane * 4;
#pragma unroll
            for (int j = 1; j < 4; ++j) if (cv[j] > bv) { bv = cv[j]; bi = lane * 4 + j; }
            wave_argmax(bv, bi);
#pragma unroll
            for (int j = 0; j < 4; ++j) if (bi == lane * 4 + j) cv[j] = NEG;
            if (r == 0) mx = bv;
            if (lane == r) { topv = bv; topc = bi; }
        }
        float e = (lane < 16) ? expf(topv - mx) : 0.f;
        float sum = wave_sum(e);
        if (lane < 16) {
            p.IDX[(size_t)t * PH * 16 + h * 16 + lane] = i1t[topc >> 4] * 128 + i2t[topc & 15];
            p.G[(size_t)t * PH * 16 + h * 16 + lane] = e / sum;
        }
        WAVE_SYNC();
    }
}

#define PEER_CONV_JOBS (2 * NEXP * D_MODEL / 2048)
__device__ __forceinline__ void peer_conv_job(const P& p, int l, int job) {
    const int tid = otid();
    const int which = job / (NEXP * D_MODEL / 2048);
    const size_t e0 = (size_t)(job % (NEXP * D_MODEL / 2048)) * 2048 + tid * 8;
    const float* src = p.in[which ? I_PV : I_PU] + (size_t)l * NEXP * D_MODEL + e0;
    bf16_t* dst = (which ? p.VB : p.UB) + e0;
    const float4 a = *(const float4*)src, b = *(const float4*)(src + 4);
    u32x4 o; o.x = (unsigned)f2bf(a.x) | ((unsigned)f2bf(a.y) << 16); o.y = (unsigned)f2bf(a.z) | ((unsigned)f2bf(a.w) << 16);
    o.z = (unsigned)f2bf(b.x) | ((unsigned)f2bf(b.y) << 16); o.w = (unsigned)f2bf(b.z) | ((unsigned)f2bf(b.w) << 16);
    *(u32x4*)dst = o;
}
#define LO16(x) __builtin_bit_cast(float, (x) << 16)
#define HI16(x) __builtin_bit_cast(float, (x) & 0xFFFF0000u)
#define GNV ((D_MODEL + 511) / 512)
__device__ __forceinline__ void phase_peer_gather(const P& p, int l) {
    const int lane = otid() & 63;
    const int gw = (obid() * NTHREADS + otid()) >> 6, nw = (gridDim.x * NTHREADS) >> 6;
    for (int t = gw; t < MTOT; t += nw) {
        float hv[GNV][8], acc[GNV][8];
#pragma unroll
        for (int c = 0; c < GNV; ++c) {
            const bool act = (c * 512 + lane * 8) < D_MODEL;
            const u32x4 z4 = {0u, 0u, 0u, 0u};
            const u32x4 h4 = act ? *(const u32x4*)(p.H + (size_t)t * D_MODEL + c * 512 + lane * 8) : z4;
            hv[c][0] = LO16(h4.x); hv[c][1] = HI16(h4.x); hv[c][2] = LO16(h4.y); hv[c][3] = HI16(h4.y);
            hv[c][4] = LO16(h4.z); hv[c][5] = HI16(h4.z); hv[c][6] = LO16(h4.w); hv[c][7] = HI16(h4.w);
#pragma unroll
            for (int j = 0; j < 8; ++j) acc[c][j] = 0.f;
        }
        for (int e0 = 0; e0 < PH * 16; e0 += 64) {
            int my_idx = 0; float my_g = 0.f;
            if (e0 + lane < PH * 16) { my_idx = p.IDX[(size_t)t * PH * 16 + e0 + lane]; my_g = p.G[(size_t)t * PH * 16 + e0 + lane]; }
            const int cnt = (PH * 16 - e0) < 64 ? (PH * 16 - e0) : 64;
            for (int k = 0; k < cnt; k += 4) {
                int ei[4]; float gg[4]; u32x4 ur[4][GNV], vr[4][GNV];
#pragma unroll
                for (int q = 0; q < 4; ++q) { ei[q] = __shfl(my_idx, k + q, 64); gg[q] = __shfl(my_g, k + q, 64); }
#pragma unroll
                for (int q = 0; q < 4; ++q)
#pragma unroll
                    for (int c = 0; c < GNV; ++c) ur[q][c] = ((c * 512 + lane * 8) < D_MODEL) ? *(const u32x4*)(p.UB + (size_t)ei[q] * D_MODEL + c * 512 + lane * 8) : (u32x4){0u, 0u, 0u, 0u};
#pragma unroll
                for (int q = 0; q < 4; ++q)
#pragma unroll
                    for (int c = 0; c < GNV; ++c) vr[q][c] = ((c * 512 + lane * 8) < D_MODEL) ? *(const u32x4*)(p.VB + (size_t)ei[q] * D_MODEL + c * 512 + lane * 8) : (u32x4){0u, 0u, 0u, 0u};
                float dt[4];
#pragma unroll
                for (int q = 0; q < 4; ++q) {
                    float d = 0.f;
#pragma unroll
                    for (int c = 0; c < GNV; ++c) {
                        d += hv[c][0] * LO16(ur[q][c].x) + hv[c][1] * HI16(ur[q][c].x) + hv[c][2] * LO16(ur[q][c].y) + hv[c][3] * HI16(ur[q][c].y)
                           + hv[c][4] * LO16(ur[q][c].z) + hv[c][5] * HI16(ur[q][c].z) + hv[c][6] * LO16(ur[q][c].w) + hv[c][7] * HI16(ur[q][c].w);
                    }
                    dt[q] = d;
                }
#pragma unroll
                for (int m = 32; m >= 1; m >>= 1) {
#pragma unroll
                    for (int q = 0; q < 4; ++q) dt[q] += __shfl_xor(dt[q], m, 64);
                }
#pragma unroll
                for (int q = 0; q < 4; ++q) {
                    const float coef = gg[q] * geluf_(dt[q]);
#pragma unroll
                    for (int c = 0; c < GNV; ++c) {
                        acc[c][0] += coef * LO16(vr[q][c].x); acc[c][1] += coef * HI16(vr[q][c].x); acc[c][2] += coef * LO16(vr[q][c].y); acc[c][3] += coef * HI16(vr[q][c].y);
                        acc[c][4] += coef * LO16(vr[q][c].z); acc[c][5] += coef * HI16(vr[q][c].z); acc[c][6] += coef * LO16(vr[q][c].w); acc[c][7] += coef * HI16(vr[q][c].w);
                    }
                }
            }
        }
        const float* g2 = p.MOD + (size_t)(l * 2 + (t >= CTX ? 1 : 0)) * 6 * D_MODEL + 5 * D_MODEL;
#pragma unroll
        for (int c = 0; c < GNV; ++c) if ((c * 512 + lane * 8) < D_MODEL) {
            float* xp = p.X + (size_t)t * D_MODEL + c * 512 + lane * 8;
            const float* gp = g2 + c * 512 + lane * 8;
            float4 x0 = *(float4*)xp, x1 = *(float4*)(xp + 4);
            x0.x += gp[0] * acc[c][0]; x0.y += gp[1] * acc[c][1]; x0.z += gp[2] * acc[c][2]; x0.w += gp[3] * acc[c][3];
            x1.x += gp[4] * acc[c][4]; x1.y += gp[5] * acc[c][5]; x1.z += gp[6] * acc[c][6]; x1.w += gp[7] * acc[c][7];
            *(float4*)xp = x0; *(float4*)(xp + 4) = x1;
        }
    }
}

__device__ __forceinline__ void phase_final(const P& p) {
    const int lane = otid() & 63;
    const int gw = (obid() * NTHREADS + otid()) >> 6, nw = (gridDim.x * NTHREADS) >> 6;
    const float* g = p.in[I_FG];
    for (int t = gw; t < SEQ; t += nw) {
        const float* x = p.X + (size_t)(CTX + t) * D_MODEL;
        float v[D_MODEL / 64]; float ss = 0.f;
#pragma unroll
        for (int j = 0; j < D_MODEL / 64; ++j) { v[j] = x[lane + 64 * j]; ss += v[j] * v[j]; }
        ss = wave_sum(ss);
        float rstd = rsqrtf(ss / D_MODEL + 1e-6f);
#pragma unroll
        for (int j = 0; j < D_MODEL / 64; ++j) p.out[(size_t)t * D_MODEL + lane + 64 * j] = v[j] * rstd * g[lane + 64 * j];
    }
}

__global__ void __launch_bounds__(NTHREADS) fwd_megakernel(P p) {
#ifdef EMU
    char* smem = emu_smem();
#else
    __shared__ __attribute__((aligned(16))) char smem_raw[SMEM_BYTES + 16];
    char* smem = smem_raw;
#endif
#ifndef EMU
    volatile LAS unsigned* xst = (volatile LAS unsigned*)(smem_raw + SMEM_BYTES);
    if (threadIdx.x == 0) { xst[0] = 0u; xst[1] = 0u; xst[2] = 0u; xst[3] = 0u; }
    __syncthreads();
    XcdBarrier xb = xcd_barrier_post(p.bar, xst);
#endif
    phase_init(p, smem);
#ifndef EMU
    cg::this_grid().sync();
#endif
    GRID_SYNC();
    for (int l = 0; l < DEPTH; ++l) {
        phase_norm(p, l, 0);
        phase_s5const(p, l);
        phase_convert_weights(p, l, smem);
        GRID_SYNC();
        phase_gemm_in(p, l, smem);
        GRID_SYNC();
        phase_rwkv_prep(p, l, smem);
        phase_gla_kv(p, l, smem);
        for (int job = obid(); job < NC * SG; job += gridDim.x) s5_local_job(p, job, smem, false);
        __syncthreads();
        GRID_SYNC();
        {
            const int n_rw = 2 * RH * 4, n_gla = 2 * GH * 8192 / NTHREADS, n_s5 = (2 * SG * 64 + NTHREADS - 1) / NTHREADS;
            for (int job = obid(); job < n_rw + n_gla + n_s5 + PEER_CONV_JOBS; job += gridDim.x) {
                if (job < n_rw) rwkv_scan_job(p, job, smem);
                else if (job < n_rw + n_gla) gla_scan_job(p, job - n_rw);
                else if (job < n_rw + n_gla + n_s5) s5_carry_job(p, job - n_rw - n_gla);
                else peer_conv_job(p, l, job - n_rw - n_gla - n_s5);
            }
        }
        GRID_SYNC();
        phase_gla_out(p, l, smem);
        for (int job = obid(); job < NC * SG; job += gridDim.x) s5_out_job(p, l, job, smem);
        GRID_SYNC();
        phase_side_elem(p, l);
        GRID_SYNC();
        phase_side_gemm(p, l, smem);
        GRID_SYNC();
        phase_merge(p, l, smem);
        GRID_SYNC();
        phase_outproj(p, l, smem);
        GRID_SYNC();
        phase_norm(p, l, 1);
        GRID_SYNC();
        phase_peer_q(p, l, smem);
        GRID_SYNC();
        phase_peer_topk(p, l, smem);
        GRID_SYNC();
        phase_peer_gather(p, l);
        GRID_SYNC();
    }
    phase_final(p);
}

static inline size_t align_up(size_t x) { return (x + 255) & ~(size_t)255; }

extern "C" void kernel_launch(void* const* d_in, const int* in_sizes, int n_in, void* d_out, int out_size, void* d_ws, size_t ws_size, hipStream_t stream) {
    P p;
    memset(&p, 0, sizeof(p));
    for (int i = 0; i < 39; ++i) p.in[i] = (const float*)d_in[i];
    p.out = (float*)d_out;
    char* w = (char*)d_ws; size_t off = 0;
    auto take = [&](size_t bytes) { void* r = w + off; off = align_up(off + bytes); return r; };
    p.bar = (unsigned*)take(16384);
    p.X = (float*)take((size_t)MTOT * D_MODEL * 4);
    p.H = (bf16_t*)take((size_t)MTOT * D_MODEL * 2);
    p.MOD = (float*)take((size_t)DEPTH * 2 * 6 * D_MODEL * 4);
    p.Z = (bf16_t*)take((size_t)MTOT * D_IN * 2);
    p.R = (bf16_t*)take((size_t)MTOT * RW * 2);
    p.V = (bf16_t*)take((size_t)MTOT * RW * 2);
    p.KK = (bf16_t*)take((size_t)MTOT * RW * 2);
    p.KD = (bf16_t*)take((size_t)2 * MTOT * RW * 2);
    p.BB = (bf16_t*)take((size_t)2 * MTOT * RW * 2);
    p.W = (float*)take((size_t)2 * MTOT * RW * 4);
    p.BONUS = (float*)take((size_t)MTOT * RH * 4);
    p.GS = (bf16_t*)take((size_t)MTOT * 128 * 2);
    p.Y = (float*)take((size_t)2 * MTOT * RW * 4);
    p.KV = (float*)take((size_t)2 * NC * GH * 8192 * 4);
    p.DEC = (float*)take((size_t)2 * NC * GH * 64 * 4);
    p.OGLA = (float*)take((size_t)MTOT * GLA_V * 4);
    p.S5A = (float*)take((size_t)2 * SG * 64 * 2 * 4);
    p.S5BB = (float*)take((size_t)2 * SG * 64 * 16 * 2 * 4);
    p.S5END = (float*)take((size_t)2 * NC * SG * 64 * 2 * 4);
    p.GY = (bf16_t*)take((size_t)MTOT * SW * 2);
    p.YN = (float*)take((size_t)MTOT * RW * 4);
    p.BR = (bf16_t*)take((size_t)MTOT * 3 * BW * 2);
    p.M = (bf16_t*)take((size_t)MTOT * D_MODEL * 2);
    p.IDX = (int*)take((size_t)MTOT * PH * 16 * 4);
    p.G = (float*)take((size_t)MTOT * PH * 16 * 4);
    p.WT_IN = (bf16_t*)take((size_t)NPAD(D_IN) * D_MODEL * 2);
    p.WT_G2 = (bf16_t*)take((size_t)NPAD(RW) * 128 * 2);
    p.WT_GLU = (bf16_t*)take((size_t)NPAD(2 * SW) * SW * 2);
    p.WT_BR = (bf16_t*)take((size_t)3 * D_MODEL * BW * 2);
    p.WT_OUT = (bf16_t*)take((size_t)D_MODEL * D_MODEL * 2);
    p.WT_Q = (bf16_t*)take((size_t)PQ * D_MODEL * 2);
    p.UB = (bf16_t*)take((size_t)NEXP * D_MODEL * 2);
    p.VB = (bf16_t*)take((size_t)NEXP * D_MODEL * 2);
    p.Q = (float*)p.Z;
    static_assert((size_t)PQ * 4 <= (size_t)D_IN * 2, "Q alias");
    if (off > ws_size) { fprintf(stderr, "ws too small: need %zu have %zu\n", off, ws_size); return; }
#ifdef EMU
    fprintf(stderr, "ws used %zu MB\n", off >> 20);
    emu_launch([=] { fwd_megakernel(p); }, EMU_GRID, NTHREADS);
#else
    hipMemsetAsync(p.bar, 0, 16384, stream);
    static int grid_blocks = 0;
    if (!grid_blocks) {
        int dev = 0, cus = 0, per_cu = 0;
        hipGetDevice(&dev);
        hipDeviceGetAttribute(&cus, hipDeviceAttributeMultiprocessorCount, dev);
        hipOccupancyMaxActiveBlocksPerMultiprocessor(&per_cu, fwd_megakernel, NTHREADS, 0);
        if (per_cu > 1) per_cu = 1;
        grid_blocks = cus * per_cu;
    }
    void* args[] = {&p};
    hipError_t e = hipLaunchCooperativeKernel((void*)fwd_megakernel, dim3(grid_blocks), dim3(NTHREADS), args, 0, stream);
    if (e != hipSuccess) fprintf(stderr, "cooperative launch failed: %s (grid %d)\n", hipGetErrorString(e), grid_blocks);
#endif
}
```

```cpp
#include <hip/hip_runtime.h>
#ifndef EMU
#include <hip/hip_cooperative_groups.h>
namespace cg = cooperative_groups;
#endif
#include <cstdio>
#include <cstdint>
#include <cstring>

#ifdef CFG_SMALL
#define D_MODEL 128
#define SEQ 512
#define DEPTH 2
#define GRID_W 8
#define CTX 128
#define GH 1
#define RH 2
#define SG 8
#define PH 2
#else
#define D_MODEL 1024
#define SEQ 16384
#define DEPTH 4
#define GRID_W 64
#define CTX 256
#define GH 4
#define RH 8
#define SG 32
#define PH 8
#endif
#define MTOT (CTX + SEQ)
#define ROWS (SEQ / GRID_W)
#define GLA_K (GH * 64)
#define GLA_V (GH * 128)
#define RW (RH * 64)
#define RWKV_IN (3 * RW + 4 * 64 + 128)
#define SW (SG * 16)
#define BW GLA_V
#define ZQ 0
#define ZK (GLA_K)
#define ZV (2 * GLA_K)
#define ZOG (ZV + GLA_V)
#define ZAF (ZOG + GLA_V)
#define ZAB (ZAF + 16)
#define ZR (ZAB + 16)
#define ZS5 (ZR + RWKV_IN)
#define ZG (ZS5 + SW)
#define D_IN (ZG + 3 * D_MODEL)
#define NC (MTOT / 64)
#define NCC (CTX / 64)
#define RB (ROWS / 64)
#define PQ (PH * 256)
#define NEXP 16384
#define NTHREADS 256
#define SMEM_BYTES 117760

typedef unsigned short bf16_t;
typedef short bf16x8 __attribute__((ext_vector_type(8)));
typedef float f32x4 __attribute__((ext_vector_type(4)));
typedef unsigned u32x4 __attribute__((ext_vector_type(4)));
typedef unsigned u32x2 __attribute__((ext_vector_type(2)));
#ifdef EMU
#define MFMA16(a, b, c) emu_mfma_16x16x32_bf16(a, b, c)
#else
#define MFMA16(a, b, c) __builtin_amdgcn_mfma_f32_16x16x32_bf16(a, b, c, 0, 0, 0)
#endif
#define NPAD(n) (((n) + 127) / 128 * 128)

__device__ __forceinline__ float bf2f(bf16_t h) { return __builtin_bit_cast(float, ((unsigned)h) << 16); }
__device__ __forceinline__ bf16_t f2bf(float f) { unsigned u = __builtin_bit_cast(unsigned, f); u += 0x7FFFu + ((u >> 16) & 1u); return (bf16_t)(u >> 16); }
__device__ __forceinline__ float sigmoidf_(float x) { return 1.0f / (1.0f + expf(-x)); }
__device__ __forceinline__ float siluf_(float x) { return x * sigmoidf_(x); }
__device__ __forceinline__ float geluf_(float x) { return 0.5f * x * (1.0f + tanhf(0.7978845608028654f * (x + 0.044715f * x * x * x))); }
__device__ __forceinline__ float softplusf_(float x) { return fmaxf(x, 0.f) + log1pf(expf(-fabsf(x))); }
__device__ __forceinline__ float wave_sum(float v) {
#pragma unroll
    for (int m = 32; m >= 1; m >>= 1) v += __shfl_xor(v, m, 64);
    return v;
}

struct P {
    const float* in[39];
    float* out;
    float* X;
    bf16_t* H;
    bf16_t* Z;
    float* MOD;
    bf16_t* R; bf16_t* V; bf16_t* KK; bf16_t* KD; bf16_t* BB;
    float* LW;
    bf16_t* MTF;
    float* NTF;
    bf16_t* SN;
    bf16_t* QH;
    float* BONUS;
    bf16_t* GS;
    float* Y;
    float* KV;
    float* DEC;
    float* OGLA;
    float* S5A;
    float* S5BB;
    float* S5END;
    bf16_t* GY;
    float* YN;
    bf16_t* BR;
    bf16_t* M;
    float* Q;
    int* IDX;
    float* G;
    unsigned* bar;
    bf16_t* WT_IN;
    bf16_t* WT_G2;
    bf16_t* WT_GLU;
    bf16_t* WT_BR;
    bf16_t* WT_OUT;
    bf16_t* WT_Q;
    bf16_t* UB; bf16_t* VB;
};

enum { I_X = 0, I_C, I_CTX, I_CCTX, I_WMOD, I_BMOD, I_N1G, I_N2G, I_WIN, I_GLA_WA2, I_GLA_BA, I_GLA_NG, I_RCONV, I_RW0, I_RW2, I_RA0, I_RA2, I_RG2,
       I_RKK, I_RKA, I_RRK, I_RLNW, I_RLNB, I_S5LRE, I_S5LIM, I_S5LS, I_S5BRE, I_S5BIM, I_S5CRE, I_S5CIM, I_S5D, I_S5GLU, I_WBR, I_WOUT, I_PWQ, I_PKEYS, I_PU, I_PV, I_FG };

#ifdef EMU
__device__ __forceinline__ int otid() { return threadIdx.x; }
__device__ __forceinline__ int obid() { return blockIdx.x; }
#else
__device__ __forceinline__ int otid() { int t = threadIdx.x; asm volatile("" : "+v"(t)); return t; }
__device__ __forceinline__ int obid() { int b = blockIdx.x; asm volatile("" : "+s"(b)); return b; }
#endif
#ifdef EMU
#define WAVE_SYNC() emu_wave_barrier()
#ifndef EMU_GRID
#define EMU_GRID 4
#endif
#else
#define WAVE_SYNC() __builtin_amdgcn_wave_barrier()
#endif
#ifndef EMU
#define XB_TMO      128
#define XB_XCNT(j)  (256  + 64 * (j))
#define XB_XSUB(j)  (1280 + 64 * (j))
#define XB_XGEN(j)  (2304 + 64 * (j))
#define XB_TOP      3328
#define XB_TOPGEN   3392
#define XCD_BAR_WORDS 3456
#define XB_SPIN_CAP (1u << 22)
#define LAS __attribute__((address_space(3)))
__device__ __forceinline__ unsigned xb_ld(unsigned* p)              { return __hip_atomic_load(p, __ATOMIC_RELAXED, __HIP_MEMORY_SCOPE_AGENT); }
__device__ __forceinline__ unsigned xb_add(unsigned* p, unsigned v) { return __hip_atomic_fetch_add(p, v, __ATOMIC_RELAXED, __HIP_MEMORY_SCOPE_AGENT); }
__device__ __forceinline__ unsigned xb_xcc_id() { return (unsigned)__builtin_amdgcn_s_getreg((3 << 11) | 20) & 0xFu; }
#define XB_SPIN(cond, bar) do { unsigned _sp = 0; while (cond) { __builtin_amdgcn_s_sleep(1); \
    if ((++_sp & 255u) == 0u) { if (xb_ld(&(bar)[XB_TMO])) break; if (_sp > XB_SPIN_CAP) { atomicAdd(&(bar)[XB_TMO], 1u); break; } } } } while (0)
struct XcdBarrier { unsigned* bar; unsigned x; volatile LAS unsigned* st; };
__device__ __forceinline__ XcdBarrier xcd_barrier_post(unsigned* bar, volatile LAS unsigned* st) {
    XcdBarrier b; b.bar = bar; b.x = xb_xcc_id(); b.st = st;
    if (threadIdx.x == 0) (void)xb_add(&bar[XB_XCNT(b.x)], 1u);
    return b;
}
__device__ __forceinline__ void xcd_barrier_complete(unsigned* bar, unsigned x, unsigned& nloc, unsigned& nx) {
    const unsigned G = gridDim.x * gridDim.y * gridDim.z;
    unsigned sum, cnt, mine, sp = 0u;
    for (;;) {
        sum = 0u; cnt = 0u; mine = 0u;
#pragma unroll
        for (unsigned j = 0; j < 16; ++j) { const unsigned c = xb_ld(&bar[XB_XCNT(j)]); sum += c; cnt += (c > 0u) ? 1u : 0u; mine = (j == x) ? c : mine; }
        if (sum == G) break;
        __builtin_amdgcn_s_sleep(1);
        if ((++sp & 255u) == 0u) { if (xb_ld(&bar[XB_TMO])) break; if (sp > XB_SPIN_CAP) { atomicAdd(&bar[XB_TMO], 1u); break; } }
    }
    nloc = mine > 0u ? mine : 1u; nx = cnt > 0u ? cnt : 1u;
}
__device__ __forceinline__ void xcd_barrier(const XcdBarrier& b) {
    asm volatile("s_waitcnt vmcnt(0)" ::: "memory");
    __syncthreads();
    if (threadIdx.x == 0) {
        unsigned* bar = b.bar;
        __builtin_amdgcn_s_waitcnt(0);
        unsigned nloc = b.st[0], nx = b.st[1];
        if (nloc == 0u) { xcd_barrier_complete(bar, b.x, nloc, nx); b.st[0] = nloc; b.st[1] = nx; }
        const unsigned old = xb_add(&bar[XB_XSUB(b.x)], 1u);
        const unsigned gen = old / nloc;
        if (old + 1u == (gen + 1u) * nloc) {
            __builtin_amdgcn_fence(__ATOMIC_RELEASE, "agent");
            asm volatile("s_waitcnt vmcnt(0)" ::: "memory");
            const unsigned og = xb_add(&bar[XB_TOP], 1u);
            const unsigned tg = og / nx;
            if (og + 1u == (tg + 1u) * nx) xb_add(&bar[XB_TOPGEN], 1u);
            else XB_SPIN(xb_ld(&bar[XB_TOPGEN]) == tg, bar);
            __builtin_amdgcn_fence(__ATOMIC_ACQUIRE, "agent");
            xb_add(&bar[XB_XGEN(b.x)], 1u);
            asm volatile("s_waitcnt vmcnt(0)" ::: "memory");
        } else {
            XB_SPIN(xb_ld(&bar[XB_XGEN(b.x)]) == gen, bar);
            __builtin_amdgcn_fence(__ATOMIC_ACQUIRE, "agent");
            asm volatile("s_waitcnt vmcnt(0)" ::: "memory");
        }
    }
    __syncthreads();
}
#define GRID_SYNC() xcd_barrier(xb)
#else
#define GRID_SYNC() emu_grid_sync()
#endif

__device__ __forceinline__ int gla_tok(int n, int i) {
    if (n < NCC) return n * 64 + i;
    int m = n - NCC; int col = m / RB, rb = m % RB;
    return CTX + (rb * 64 + i) * GRID_W + col;
}
__device__ __forceinline__ int chunk_order(int d, int s) {
    if (d == 0) return s;
    return (s < NCC) ? (NCC - 1 - s) : (NC - 1 - (s - NCC));
}
__device__ __forceinline__ int tok_order(int d, int s) {
    if (d == 0) return s;
    return (s < CTX) ? (CTX - 1 - s) : (MTOT - 1 - (s - CTX));
}


#define LDS_ROW 72
__device__ __forceinline__ void mfma_gemm_tile(const bf16_t* Wt, int ldw, const bf16_t* Act, int lda, int K, int n0, int m0, bf16_t* lds, f32x4 (&acc)[4][4]) {
    bf16_t* Ws = lds; bf16_t* As = lds + 128 * LDS_ROW;
    const int tid = otid(), lane = tid & 63, wave = tid >> 6, wn = wave >> 1, wm = wave & 1;
    const int lrow = tid >> 3, lkc = (tid & 7) * 8;
    u32x4 pw[4], pa[4];
#pragma unroll
    for (int i = 0; i < 4; ++i) {
        pw[i] = *(const u32x4*)(Wt + (size_t)(n0 + lrow + 32 * i) * ldw + lkc);
        pa[i] = *(const u32x4*)(Act + (size_t)(m0 + lrow + 32 * i) * lda + lkc);
    }
    for (int k0 = 0; k0 < K; k0 += 64) {
        __syncthreads();
#pragma unroll
        for (int i = 0; i < 4; ++i) {
            *(u32x4*)(Ws + (lrow + 32 * i) * LDS_ROW + lkc) = pw[i];
            *(u32x4*)(As + (lrow + 32 * i) * LDS_ROW + lkc) = pa[i];
        }
        __syncthreads();
        if (k0 + 64 < K) {
#pragma unroll
            for (int i = 0; i < 4; ++i) {
                pw[i] = *(const u32x4*)(Wt + (size_t)(n0 + lrow + 32 * i) * ldw + k0 + 64 + lkc);
                pa[i] = *(const u32x4*)(Act + (size_t)(m0 + lrow + 32 * i) * lda + k0 + 64 + lkc);
            }
        }
#pragma unroll
        for (int ks = 0; ks < 2; ++ks) {
            bf16x8 a[4], b[4];
#pragma unroll
            for (int i = 0; i < 4; ++i) {
                a[i] = *(const bf16x8*)(Ws + (wn * 64 + i * 16 + (lane & 15)) * LDS_ROW + ks * 32 + (lane >> 4) * 8);
                b[i] = *(const bf16x8*)(As + (wm * 64 + i * 16 + (lane & 15)) * LDS_ROW + ks * 32 + (lane >> 4) * 8);
            }
#pragma unroll
            for (int ni = 0; ni < 4; ++ni)
#pragma unroll
                for (int mi = 0; mi < 4; ++mi) acc[ni][mi] = MFMA16(a[ni], b[mi], acc[ni][mi]);
        }
    }
}
#define ZERO_ACC4(acc) { _Pragma("unroll") for (int i_ = 0; i_ < 4; ++i_) _Pragma("unroll") for (int j_ = 0; j_ < 4; ++j_) acc[i_][j_] = (f32x4){0.f, 0.f, 0.f, 0.f}; }
#define FOR_ACC(acc, n0, m0, BODY) { const int lane_ = otid() & 63, wave_ = otid() >> 6; \
    _Pragma("unroll") for (int ni_ = 0; ni_ < 4; ++ni_) _Pragma("unroll") for (int mi_ = 0; mi_ < 4; ++mi_) { \
        const int n = (n0) + (wave_ >> 1) * 64 + ni_ * 16 + (lane_ >> 4) * 4; const int m = (m0) + (wave_ & 1) * 64 + mi_ * 16 + (lane_ & 15); const f32x4 v = acc[ni_][mi_]; BODY } }
__device__ __forceinline__ u32x2 pack4(float a, float b, float c, float d) { u32x2 r; r.x = (unsigned)f2bf(a) | ((unsigned)f2bf(b) << 16); r.y = (unsigned)f2bf(c) | ((unsigned)f2bf(d) << 16); return r; }

__device__ __forceinline__ void convert_wt_job(const float* W, int K, int N, int Npad, bf16_t* out, int job, float* T, int ilv) {
    const int tid = otid();
    const int nkt = K / 64;
    const int n0 = (job / nkt) * 64, k0 = (job % nkt) * 64;
    __syncthreads();
    for (int idx = tid; idx < 4096; idx += NTHREADS) {
        int kk = idx >> 6, nn = idx & 63;
        int nr = n0 + nn; int src = ilv ? ((nr & 1) ? (N / 2 + (nr >> 1)) : (nr >> 1)) : nr;
        T[kk * 65 + nn] = (nr < N) ? W[(size_t)(k0 + kk) * N + src] : 0.f;
    }
    __syncthreads();
    {
        int nn = tid >> 2, part = tid & 3;
        unsigned w[8];
#pragma unroll
        for (int j = 0; j < 8; ++j) w[j] = (unsigned)f2bf(T[(part * 16 + 2 * j) * 65 + nn]) | ((unsigned)f2bf(T[(part * 16 + 2 * j + 1) * 65 + nn]) << 16);
        u32x4* o = (u32x4*)(out + (size_t)(n0 + nn) * K + k0 + part * 16);
        o[0] = (u32x4){w[0], w[1], w[2], w[3]}; o[1] = (u32x4){w[4], w[5], w[6], w[7]};
    }
}
__device__ __forceinline__ void phase_convert_weights(const P& p, int l, char* smem) {
    float* T = (float*)smem;
    struct Item { const float* W; int K, N, Npad; bf16_t* out; };
    const Item items[8] = {
        {p.in[I_WIN] + (size_t)l * D_MODEL * D_IN, D_MODEL, D_IN, NPAD(D_IN), p.WT_IN},
        {p.in[I_RG2] + (size_t)l * 128 * RW, 128, RW, RW, p.WT_G2},
        {p.in[I_S5GLU] + (size_t)l * SW * 2 * SW, SW, 2 * SW, 2 * SW, p.WT_GLU},
        {p.in[I_WBR] + ((size_t)l * 3 + 0) * BW * D_MODEL, BW, D_MODEL, D_MODEL, p.WT_BR},
        {p.in[I_WBR] + ((size_t)l * 3 + 1) * BW * D_MODEL, BW, D_MODEL, D_MODEL, p.WT_BR + (size_t)D_MODEL * BW},
        {p.in[I_WBR] + ((size_t)l * 3 + 2) * BW * D_MODEL, BW, D_MODEL, D_MODEL, p.WT_BR + (size_t)2 * D_MODEL * BW},
        {p.in[I_WOUT] + (size_t)l * D_MODEL * D_MODEL, D_MODEL, D_MODEL, D_MODEL, p.WT_OUT},
        {p.in[I_PWQ] + (size_t)l * D_MODEL * PQ, D_MODEL, PQ, PQ, p.WT_Q}};
    int base = 0;
#pragma unroll
    for (int it = 0; it < 8; ++it) {
        const int nj = (items[it].Npad / 64) * (items[it].K / 64);
        for (int j = (int)((obid() + gridDim.x - (base % gridDim.x)) % gridDim.x); j < nj; j += gridDim.x)
            convert_wt_job(items[it].W, items[it].K, items[it].N, items[it].Npad, items[it].out, j, T, it == 2);
        base += nj;
    }
    __syncthreads();
}

__device__ __forceinline__ void phase_init(const P& p, char* smem) {
    const int tid = otid();
    float* sc = (float*)smem;
    for (int i = tid; i < D_MODEL; i += NTHREADS) { sc[i] = siluf_(p.in[I_CCTX][i]); sc[D_MODEL + i] = siluf_(p.in[I_C][i]); }
    __syncthreads();
    const int ncolblk = (6 * D_MODEL) / NTHREADS;
    for (int job = obid(); job < DEPTH * ncolblk; job += gridDim.x) {
        int l = job / ncolblk, n = (job % ncolblk) * NTHREADS + tid;
        const float* w = p.in[I_WMOD] + (size_t)l * D_MODEL * 6 * D_MODEL + n;
        float a0 = 0.f, a1 = 0.f;
        for (int k = 0; k < D_MODEL; ++k) { float wv = w[(size_t)k * 6 * D_MODEL]; a0 += sc[k] * wv; a1 += sc[D_MODEL + k] * wv; }
        float b = p.in[I_BMOD][l * 6 * D_MODEL + n];
        p.MOD[(size_t)(l * 2 + 0) * 6 * D_MODEL + n] = a0 + b;
        p.MOD[(size_t)(l * 2 + 1) * 6 * D_MODEL + n] = a1 + b;
    }
    const size_t gtid = (size_t)obid() * NTHREADS + tid, gn = (size_t)gridDim.x * NTHREADS;
    for (size_t i = gtid; i < (size_t)CTX * D_MODEL; i += gn) p.X[i] = p.in[I_CTX][i];
    for (size_t i = gtid; i < (size_t)SEQ * D_MODEL; i += gn) p.X[(size_t)CTX * D_MODEL + i] = p.in[I_X][i];
    __syncthreads();
}

__device__ __forceinline__ void phase_s5const(const P& p, int l) {
    const size_t gtid = (size_t)obid() * NTHREADS + otid(), gn = (size_t)gridDim.x * NTHREADS;
    for (size_t i = gtid; i < (size_t)2 * SG * 64; i += gn) {
        int d = (int)(i / (SG * 64)), g = (int)((i / 64) % SG), s = (int)(i % 64);
        size_t li = ((size_t)(l * 2 + d) * SG + g) * 64 + s;
        float lre = p.in[I_S5LRE][li], lim = p.in[I_S5LIM][li];
        float dt = expf(p.in[I_S5LS][(l * 2 + d) * SG + g]);
        float mag = expf(lre * dt);
        float are = mag * cosf(lim * dt), aim = mag * sinf(lim * dt);
        float den = lre * lre + lim * lim;
        float fre = ((are - 1.0f) * lre + aim * lim) / den;
        float fim = (aim * lre - (are - 1.0f) * lim) / den;
        p.S5A[i * 2 + 0] = are; p.S5A[i * 2 + 1] = aim;
        const float* bre = p.in[I_S5BRE] + (((size_t)l * SG + g) * 64 + s) * 16;
        const float* bim = p.in[I_S5BIM] + (((size_t)l * SG + g) * 64 + s) * 16;
        for (int c = 0; c < 16; ++c) {
            p.S5BB[(i * 16 + c) * 2 + 0] = fre * bre[c] - fim * bim[c];
            p.S5BB[(i * 16 + c) * 2 + 1] = fre * bim[c] + fim * bre[c];
        }
    }
}

__device__ __forceinline__ void phase_norm(const P& p, int l, int which) {
    const int lane = otid() & 63;
    const int gw = (obid() * NTHREADS + otid()) >> 6, nw = (gridDim.x * NTHREADS) >> 6;
    const float* g = p.in[which ? I_N2G : I_N1G] + l * D_MODEL;
    for (int t = gw; t < MTOT; t += nw) {
        const float* x = p.X + (size_t)t * D_MODEL;
        const float* mod = p.MOD + (size_t)(l * 2 + (t >= CTX ? 1 : 0)) * 6 * D_MODEL + (which ? 3 * D_MODEL : 0);
        float v[D_MODEL / 64]; float ss = 0.f;
#pragma unroll
        for (int j = 0; j < D_MODEL / 64; ++j) { v[j] = x[lane + 64 * j]; ss += v[j] * v[j]; }
        ss = wave_sum(ss);
        float rstd = rsqrtf(ss / D_MODEL + 1e-6f);
#pragma unroll
        for (int j = 0; j < D_MODEL / 64; ++j) {
            int e = lane + 64 * j;
            p.H[(size_t)t * D_MODEL + e] = f2bf(v[j] * rstd * g[e] * (1.0f + mod[D_MODEL + e]) + mod[e]);
        }
    }
}

__device__ __forceinline__ void phase_gemm_in(const P& p, int l, char* smem) {
    const int ntn = NPAD(D_IN) / 128, ntm = MTOT / 128;
    for (int job = obid(); job < ntm * ntn; job += gridDim.x) {
        const int m0 = (job / ntn) * 128, n0 = (job % ntn) * 128;
        f32x4 acc[4][4]; ZERO_ACC4(acc);
        mfma_gemm_tile(p.WT_IN, D_MODEL, p.H, D_MODEL, D_MODEL, n0, m0, (bf16_t*)smem, acc);
        FOR_ACC(acc, n0, m0, { if (n < D_IN) *(u32x2*)(p.Z + (size_t)m * D_IN + n) = pack4(v[0], v[1], v[2], v[3]); })
    }
}

#define RTOK 4
__device__ __forceinline__ void phase_rwkv_prep(const P& p, int l, char* smem) {
    const int tid = otid(), lane = tid & 63;
    float* zs = (float*)smem;
    const float* conv = p.in[I_RCONV] + (size_t)l * 3 * RWKV_IN;
    const float* w0 = p.in[I_RW0] + (size_t)l * 2 * RW;
    const float* w2 = p.in[I_RW2] + (size_t)l * 2 * 64 * RW;
    const float* a0 = p.in[I_RA0] + (size_t)l * 2 * RW;
    const float* a2 = p.in[I_RA2] + (size_t)l * 2 * 64 * RW;
    const float* k_k = p.in[I_RKK] + (size_t)l * RW;
    const float* k_a = p.in[I_RKA] + (size_t)l * RW;
    const float* r_k = p.in[I_RRK] + (size_t)l * RW;
    for (int job = obid(); job < MTOT / RTOK; job += gridDim.x) {
        const int t0 = job * RTOK;
        __syncthreads();
        for (int idx = tid; idx < RTOK * RWKV_IN; idx += NTHREADS) {
            int tt = idx / RWKV_IN, c = idx % RWKV_IN; int t = t0 + tt;
            bool first = (t == 0) || (t == CTX), last = (t == CTX - 1) || (t == MTOT - 1);
            const bf16_t* zp = p.Z + (size_t)t * D_IN + ZR + c;
            float v = conv[RWKV_IN + c] * bf2f(zp[0]);
            if (!first) v += conv[c] * bf2f(zp[-D_IN]);
            if (!last) v += conv[2 * RWKV_IN + c] * bf2f(zp[D_IN]);
            if (c >= 3 * RW && c < 3 * RW + 128) v = tanhf(v);
            zs[idx] = v;
        }
        __syncthreads();
        for (int c = tid; c < RW; c += NTHREADS) {
            const int h = c >> 6;
            float accw[2][RTOK], acca[2][RTOK];
#pragma unroll
            for (int d = 0; d < 2; ++d)
#pragma unroll
                for (int tt = 0; tt < RTOK; ++tt) { accw[d][tt] = w0[d * RW + c]; acca[d][tt] = a0[d * RW + c]; }
            for (int j = 0; j < 64; ++j) {
#pragma unroll
                for (int d = 0; d < 2; ++d) {
                    float wv = w2[((size_t)d * 64 + j) * RW + c], av = a2[((size_t)d * 64 + j) * RW + c];
#pragma unroll
                    for (int tt = 0; tt < RTOK; ++tt) {
                        accw[d][tt] += zs[tt * RWKV_IN + 3 * RW + d * 64 + j] * wv;
                        acca[d][tt] += zs[tt * RWKV_IN + 3 * RW + 128 + d * 64 + j] * av;
                    }
                }
            }
#pragma unroll
            for (int tt = 0; tt < RTOK; ++tt) {
                const int t = t0 + tt;
                float r = zs[tt * RWKV_IN + c], k = zs[tt * RWKV_IN + RW + c], v = zs[tt * RWKV_IN + 2 * RW + c];
                float kkr = k * k_k[c];
                float nrm = wave_sum(kkr * kkr);
                float kk = kkr / fmaxf(sqrtf(nrm), 1e-12f);
                float kdsum = 0.f;
#pragma unroll
                for (int d = 0; d < 2; ++d) {
                    float dec = -expf(-softplusf_(-accw[d][tt]) - 0.5f);
                    float aa = sigmoidf_(acca[d][tt]);
                    float kd = k * (1.0f + (aa - 1.0f) * k_a[c]);
                    kdsum += kd;
                    size_t o = ((size_t)d * MTOT + t) * RW + c;
                    p.LW[o] = dec; p.KD[o] = f2bf(kd); p.BB[o] = f2bf(kk * aa);
                }
                size_t o = (size_t)t * RW + c;
                p.R[o] = f2bf(r); p.V[o] = f2bf(v); p.KK[o] = f2bf(kk);
                float bon = wave_sum(r * kdsum * r_k[c]);
                if (lane == 0) p.BONUS[(size_t)t * RH + h] = bon;
            }
        }
        for (int idx = tid; idx < RTOK * 128; idx += NTHREADS) {
            int tt = idx >> 7, j = idx & 127;
            p.GS[(size_t)(t0 + tt) * 128 + j] = f2bf(sigmoidf_(zs[tt * RWKV_IN + 3 * RW + 256 + j]));
        }
    }
    __syncthreads();
}

#define G_SQ 0
#define G_SK 4096
#define G_SV 8192
#define G_CUM 16384
#define G_ATT 20480
#define G_END 24576
__device__ __forceinline__ void gla_load(const P& p, int l, int n, int h, int d, float* s) {
    const int tid = otid();
    float* alr = s + G_ATT;
    for (int idx = tid; idx < 64 * 64; idx += NTHREADS) {
        int i = idx >> 6, c = idx & 63; int t = gla_tok(n, i);
        const bf16_t* z = p.Z + (size_t)t * D_IN;
        s[G_SQ + idx] = bf2f(z[ZQ + h * 64 + c]) * 0.125f;
        s[G_SK + idx] = bf2f(z[ZK + h * 64 + c]);
    }
    for (int idx = tid; idx < 64 * 128; idx += NTHREADS) {
        int i = idx >> 7, c = idx & 127; int t = gla_tok(n, i);
        s[G_SV + idx] = bf2f(p.Z[(size_t)t * D_IN + ZV + h * 128 + c]);
    }
    for (int idx = tid; idx < 64 * 16; idx += NTHREADS) {
        int i = idx >> 4, r = idx & 15; int t = gla_tok(n, i);
        alr[idx] = bf2f(p.Z[(size_t)t * D_IN + (d ? ZAB : ZAF) + r]);
    }
    __syncthreads();
    const float* wa2 = p.in[I_GLA_WA2] + ((size_t)(l * 2 + d) * 16) * GLA_K + h * 64;
    const float* ba = p.in[I_GLA_BA] + (size_t)(l * 2 + d) * GLA_K + h * 64;
    for (int idx = tid; idx < 64 * 64; idx += NTHREADS) {
        int i = idx >> 6, c = idx & 63;
        float a = ba[c];
#pragma unroll
        for (int r = 0; r < 16; ++r) a += alr[i * 16 + r] * wa2[(size_t)r * GLA_K + c];
        float ls = fminf(a, 0.f) - log1pf(expf(-fabsf(a)));
        s[G_CUM + idx] = ls * (1.0f / 16.0f);
    }
    __syncthreads();
    if (tid < 64) {
        float run = 0.f;
        if (d == 0) { for (int i = 0; i < 64; ++i) { run += s[G_CUM + i * 64 + tid]; s[G_CUM + i * 64 + tid] = run; } }
        else { for (int i = 63; i >= 0; --i) { run += s[G_CUM + i * 64 + tid]; s[G_CUM + i * 64 + tid] = run; } }
    }
    __syncthreads();
}

__device__ __forceinline__ void phase_gla_kv(const P& p, int l, char* smem) {
    float* s = (float*)smem;
    const int tid = otid();
    for (int job = obid(); job < NC * GH; job += gridDim.x) {
        const int n = job / GH, h = job % GH;
        for (int d = 0; d < 2; ++d) {
            __syncthreads();
            gla_load(p, l, n, h, d, s);
            const int li = d ? 0 : 63;
            for (int idx = tid; idx < 64 * 64; idx += NTHREADS) {
                int c = idx & 63;
                s[G_SQ + idx] = s[G_SK + idx] * expf(s[G_CUM + li * 64 + c] - s[G_CUM + idx]);
            }
            if (tid < 64) p.DEC[((size_t)(d * NC + n) * GH + h) * 64 + tid] = expf(s[G_CUM + li * 64 + tid]);
            __syncthreads();
            float* kv = p.KV + ((size_t)(d * NC + n) * GH + h) * 64 * 128;
            const int dv = tid & 127, kh = (tid >> 7) * 32;
            float acc[32];
#pragma unroll
            for (int j = 0; j < 32; ++j) acc[j] = 0.f;
            for (int i = 0; i < 64; ++i) {
                float vv = s[G_SV + i * 128 + dv];
#pragma unroll
                for (int j = 0; j < 32; ++j) acc[j] += s[G_SQ + i * 64 + kh + j] * vv;
            }
#pragma unroll
            for (int j = 0; j < 32; ++j) kv[(size_t)(kh + j) * 128 + dv] = acc[j];
        }
    }
    __syncthreads();
}

__device__ __forceinline__ void gla_scan_job(const P& p, int job) {
    int base = job * NTHREADS + otid();
    int d = base / (GH * 8192), h = (base / 8192) % GH, e = base % 8192;
    float S = 0.f;
    for (int s = 0; s < NC; ++s) {
        int n = chunk_order(d, s);
        size_t o = ((size_t)(d * NC + n) * GH + h);
        float kv = p.KV[o * 8192 + e];
        float dec = p.DEC[o * 64 + (e >> 7)];
        p.KV[o * 8192 + e] = S;
        S = dec * S + kv;
    }
}

__device__ __forceinline__ void phase_gla_out(const P& p, int l, char* smem) {
    float* s = (float*)smem;
    const int tid = otid();
    const int tx = tid & 31, ty = tid >> 5;
    for (int job = obid(); job < NC * GH; job += gridDim.x) {
        const int n = job / GH, h = job % GH;
        float o[8][4];
#pragma unroll
        for (int i = 0; i < 8; ++i)
#pragma unroll
            for (int j = 0; j < 4; ++j) o[i][j] = 0.f;
        for (int d = 0; d < 2; ++d) {
            __syncthreads();
            gla_load(p, l, n, h, d, s);
            for (int idx = tid; idx < 64 * 64; idx += NTHREADS) {
                float c = s[G_CUM + idx];
                s[G_SQ + idx] *= expf(c);
                s[G_SK + idx] *= expf(-c);
            }
            __syncthreads();
            for (int idx = tid; idx < 64 * 64; idx += NTHREADS) {
                int i = idx >> 6, j = idx & 63;
                bool ok = d ? (j >= i) : (j <= i);
                float a = 0.f;
                if (ok) { for (int c = 0; c < 64; ++c) a += s[G_SQ + i * 64 + c] * s[G_SK + j * 64 + c]; }
                s[G_ATT + idx] = a;
            }
            __syncthreads();
            const float* S = p.KV + ((size_t)(d * NC + n) * GH + h) * 64 * 128;
            for (int j = 0; j < 64; ++j) {
                float v4[4], s4[4];
#pragma unroll
                for (int c = 0; c < 4; ++c) { v4[c] = s[G_SV + j * 128 + tx * 4 + c]; s4[c] = S[(size_t)j * 128 + tx * 4 + c]; }
#pragma unroll
                for (int i = 0; i < 8; ++i) {
                    float a = s[G_ATT + (ty * 8 + i) * 64 + j], q = s[G_SQ + (ty * 8 + i) * 64 + j];
#pragma unroll
                    for (int c = 0; c < 4; ++c) o[i][c] += a * v4[c] + q * s4[c];
                }
            }
        }
#pragma unroll
        for (int i = 0; i < 8; ++i) {
            int t = gla_tok(n, ty * 8 + i);
#pragma unroll
            for (int c = 0; c < 4; ++c) p.OGLA[(size_t)t * GLA_V + h * 128 + tx * 4 + c] = o[i][c];
        }
    }
    __syncthreads();
}

#define CH_ROW 72
#define CH_SLOT (64 * CH_ROW)
#define CH_XR_OFF (7 * CH_SLOT * 2)
#define CH_AAB_OFF (CH_XR_OFF + 64 * 132 * 4)
#define CH_GC_OFF (CH_AAB_OFF + 64 * 72 * 4)
template <int MT, int NT>
__device__ __forceinline__ void lds_mm(const bf16_t* A, int m0, const bf16_t* Bt, int n0, f32x4 (&acc)[MT][NT]) {
    const int lane = otid() & 63, q = lane >> 4, r = lane & 15;
#pragma unroll
    for (int s = 0; s < 2; ++s) {
        bf16x8 a[MT], b[NT];
#pragma unroll
        for (int i = 0; i < MT; ++i) a[i] = *(const bf16x8*)(A + (m0 + i * 16 + r) * CH_ROW + s * 32 + q * 8);
#pragma unroll
        for (int i = 0; i < NT; ++i) b[i] = *(const bf16x8*)(Bt + (n0 + i * 16 + r) * CH_ROW + s * 32 + q * 8);
#pragma unroll
        for (int i = 0; i < MT; ++i)
#pragma unroll
            for (int jj = 0; jj < NT; ++jj) acc[i][jj] = MFMA16(a[i], b[jj], acc[i][jj]);
    }
}
__device__ __forceinline__ void rwkv_chunk_job(const P& p, int job, char* smem) {
    const int tid = otid(), lane = tid & 63, wv = tid >> 6, q = lane >> 4, r = lane & 15;
    const int d = job / (NC * RH), n = (job / RH) % NC, h = job % RH;
    const size_t base = (size_t)(d * NC + n) * RH + h;
    bf16_t* S0 = (bf16_t*)smem; bf16_t* S1 = S0 + CH_SLOT; bf16_t* S2 = S1 + CH_SLOT; bf16_t* S3 = S2 + CH_SLOT;
    bf16_t* S4 = S3 + CH_SLOT; bf16_t* S5 = S4 + CH_SLOT; bf16_t* S6 = S5 + CH_SLOT;
    float* X = (float*)(smem + CH_XR_OFF);
    float* AABt = (float*)(smem + CH_AAB_OFF);
    bf16_t* U0t = (bf16_t*)(smem + CH_AAB_OFF);
    bf16_t* Aht = U0t + CH_SLOT;
    float* GC = (float*)(smem + CH_GC_OFF);
    __syncthreads();
    for (int idx = tid; idx < 4096; idx += NTHREADS) {
        const int i = idx >> 6, k = idx & 63; const int tok = 64 * n + (d ? 63 - i : i);
        X[i * 132 + k] = p.LW[((size_t)d * MTOT + tok) * RW + h * 64 + k];
    }
    __syncthreads();
    {
        const int k = tid & 63, seg = tid >> 6;
        float v[16]; float run = 0.f;
#pragma unroll
        for (int e = 0; e < 16; ++e) { run += X[(seg * 16 + e) * 132 + k]; v[e] = run; }
        AABt[seg * 64 + k] = run;
        __syncthreads();
        float off = 0.f;
        for (int s2 = 0; s2 < seg; ++s2) off += AABt[s2 * 64 + k];
#pragma unroll
        for (int e = 0; e < 16; ++e) X[(seg * 16 + e) * 132 + k] = v[e] + off;
    }
    __syncthreads();
    for (int idx = tid; idx < 4096; idx += NTHREADS) {
        const int i = idx >> 6, k = idx & 63; const int tok = 64 * n + (d ? 63 - i : i);
        const size_t o1 = (size_t)tok * RW + h * 64 + k, o2 = ((size_t)d * MTOT + tok) * RW + h * 64 + k;
        const float L = X[i * 132 + k], Lp = (i > 0) ? X[(i - 1) * 132 + k] : 0.f, LC = X[63 * 132 + k];
        const float kkv = bf2f(p.KK[o1]), rv = bf2f(p.R[o1]), vv = bf2f(p.V[o1]), kdv = bf2f(p.KD[o2]), bbv = bf2f(p.BB[o2]);
        const float eL = expf(L), eLp = expf(Lp), eNL = expf(-L), eCL = expf(LC - L);
        const float at = -kkv * eLp;
        S0[i * CH_ROW + k] = f2bf(at);
        X[i * 132 + 64 + k] = at;
        S1[i * CH_ROW + k] = f2bf(rv * eL);
        S2[i * CH_ROW + k] = f2bf(bbv * eNL);
        S3[i * CH_ROW + k] = f2bf(kdv * eNL);
        S4[k * CH_ROW + i] = f2bf(vv);
        S5[k * CH_ROW + i] = f2bf(bbv * eCL);
        S6[k * CH_ROW + i] = f2bf(kdv * eCL);
        if (i == 63) GC[k] = eL;
    }
    __syncthreads();
    {
        f32x4 acc[4][4]; ZERO_ACC4(acc);
        lds_mm<4, 4>((wv < 2) ? S0 : S1, 0, (wv & 1) ? S3 : S2, 0, acc);
        __syncthreads();
#pragma unroll
        for (int mt = 0; mt < 4; ++mt)
#pragma unroll
            for (int nt = 0; nt < 4; ++nt) {
                const int jc = nt * 16 + r, i0 = mt * 16 + 4 * q;
                if (wv == 0) {
                    f32x4 o;
#pragma unroll
                    for (int e = 0; e < 4; ++e) o[e] = (jc < i0 + e) ? acc[mt][nt][e] : 0.f;
                    *(f32x4*)(AABt + jc * 72 + i0) = o;
                } else {
                    bf16_t* dst = (wv == 1) ? S0 : ((wv == 2) ? S2 : S3);
#pragma unroll
                    for (int e = 0; e < 4; ++e) {
                        const bool ok = (wv == 1) ? (jc < i0 + e) : (jc <= i0 + e);
                        dst[(i0 + e) * CH_ROW + jc] = f2bf(ok ? acc[mt][nt][e] : 0.f);
                    }
                }
            }
    }
    __syncthreads();
    {
        f32x4 acc[1][4];
#pragma unroll
        for (int nt = 0; nt < 4; ++nt) acc[0][nt] = (f32x4){0.f, 0.f, 0.f, 0.f};
        lds_mm<1, 4>(S0, 16 * wv, S4, 0, acc);
#pragma unroll
        for (int nt = 0; nt < 4; ++nt)
#pragma unroll
            for (int e = 0; e < 4; ++e) X[(16 * wv + 4 * q + e) * 132 + nt * 16 + r] = acc[0][nt][e];
    }
    __syncthreads();
    if (tid < 128) {
        const int c = tid;
        for (int bi = 0; bi < 4; ++bi) {
            float acc[16];
#pragma unroll
            for (int e = 0; e < 16; ++e) acc[e] = X[(16 * bi + e) * 132 + c];
            for (int jj = 0; jj < 16 * bi; ++jj) {
                const float uj = X[jj * 132 + c];
                const f32x4* ap = (const f32x4*)(AABt + jj * 72 + 16 * bi);
                const f32x4 a0 = ap[0], a1 = ap[1], a2 = ap[2], a3 = ap[3];
#pragma unroll
                for (int e = 0; e < 4; ++e) { acc[e] += a0[e] * uj; acc[4 + e] += a1[e] * uj; acc[8 + e] += a2[e] * uj; acc[12 + e] += a3[e] * uj; }
            }
#pragma unroll
            for (int e = 0; e < 16; ++e) {
                const float u = acc[e];
                X[(16 * bi + e) * 132 + c] = u;
                const f32x4* ap = (const f32x4*)(AABt + (16 * bi + e) * 72 + 16 * bi);
                const f32x4 a0 = ap[0], a1 = ap[1], a2 = ap[2], a3 = ap[3];
#pragma unroll
                for (int e2 = 0; e2 < 16; ++e2) if (e2 > e) acc[e2] += ((e2 < 4) ? a0[e2 & 3] : (e2 < 8) ? a1[e2 & 3] : (e2 < 12) ? a2[e2 & 3] : a3[e2 & 3]) * u;
            }
        }
    }
    __syncthreads();
    if (tid < 128) {
        const int c = tid;
        bf16_t* dst = (c < 64) ? (U0t + c * CH_ROW) : (Aht + (c - 64) * CH_ROW);
        u32x4 ov[8];
#pragma unroll
        for (int g = 0; g < 8; ++g) {
            float v[8];
#pragma unroll
            for (int e = 0; e < 8; ++e) v[e] = X[(g * 8 + e) * 132 + c];
            ov[g].x = (unsigned)f2bf(v[0]) | ((unsigned)f2bf(v[1]) << 16); ov[g].y = (unsigned)f2bf(v[2]) | ((unsigned)f2bf(v[3]) << 16);
            ov[g].z = (unsigned)f2bf(v[4]) | ((unsigned)f2bf(v[5]) << 16); ov[g].w = (unsigned)f2bf(v[6]) | ((unsigned)f2bf(v[7]) << 16);
        }
#pragma unroll
        for (int g = 0; g < 8; ++g) *(u32x4*)(dst + g * 8) = ov[g];
    }
    __syncthreads();
    {
        f32x4 acc[4][4]; ZERO_ACC4(acc);
        if (wv == 0) {
            lds_mm<4, 4>(S5, 0, Aht, 0, acc);
#pragma unroll
            for (int mt = 0; mt < 4; ++mt)
#pragma unroll
                for (int nt = 0; nt < 4; ++nt)
#pragma unroll
                    for (int e = 0; e < 4; ++e) {
                        const int kp = mt * 16 + 4 * q + e, kc = nt * 16 + r;
                        X[kp * 68 + kc] = acc[mt][nt][e] + ((kp == kc) ? GC[kc] : 0.f);
                    }
        } else if (wv == 1) {
            lds_mm<4, 4>(S5, 0, U0t, 0, acc);
            lds_mm<4, 4>(S6, 0, S4, 0, acc);
#pragma unroll
            for (int mt = 0; mt < 4; ++mt)
#pragma unroll
                for (int nt = 0; nt < 4; ++nt) *(f32x4*)(p.NTF + (((base * 4 + nt) * 4 + mt) * 64 + lane) * 4) = acc[mt][nt];
        } else if (wv == 2) {
            lds_mm<4, 4>(S2, 0, Aht, 0, acc);
#pragma unroll
            for (int mt = 0; mt < 4; ++mt)
#pragma unroll
                for (int nt = 0; nt < 4; ++nt)
#pragma unroll
                    for (int e = 0; e < 4; ++e) {
                        const int t = mt * 16 + 4 * q + e, kc = nt * 16 + r;
                        p.QH[(base * 64 + t) * 64 + kc] = f2bf(acc[mt][nt][e] + bf2f(S1[t * CH_ROW + kc]));
                    }
        } else {
            lds_mm<4, 4>(S2, 0, U0t, 0, acc);
            lds_mm<4, 4>(S3, 0, S4, 0, acc);
#pragma unroll
            for (int mt = 0; mt < 4; ++mt)
#pragma unroll
                for (int nt = 0; nt < 4; ++nt)
#pragma unroll
                    for (int e = 0; e < 4; ++e) {
                        const int t = mt * 16 + 4 * q + e; const int tok = 64 * n + (d ? 63 - t : t);
                        p.Y[((size_t)d * MTOT + tok) * RW + h * 64 + nt * 16 + r] = acc[mt][nt][e];
                    }
        }
    }
    __syncthreads();
    for (int u = tid; u < 512; u += NTHREADS) {
        const int tile = u >> 7, s2 = (u >> 6) & 1, ln = u & 63;
        const int kp = tile * 16 + (ln & 15), qq = ln >> 4;
        unsigned hi[4], lo[4];
#pragma unroll
        for (int jp = 0; jp < 4; ++jp) {
            unsigned hh[2], ll[2];
#pragma unroll
            for (int z = 0; z < 2; ++z) {
                const int jj = jp * 2 + z; const int k = 32 * s2 + 16 * (jj >> 2) + 4 * qq + (jj & 3);
                const float v = X[kp * 68 + k]; const bf16_t hb = f2bf(v); const bf16_t lb = f2bf(v - bf2f(hb));
                hh[z] = hb; ll[z] = lb;
            }
            hi[jp] = hh[0] | (hh[1] << 16); lo[jp] = ll[0] | (ll[1] << 16);
        }
        *(u32x4*)(p.MTF + ((((base * 2 + 0) * 4 + tile) * 2 + s2) * 64 + ln) * 8) = (u32x4){hi[0], hi[1], hi[2], hi[3]};
        *(u32x4*)(p.MTF + ((((base * 2 + 1) * 4 + tile) * 2 + s2) * 64 + ln) * 8) = (u32x4){lo[0], lo[1], lo[2], lo[3]};
    }
}

__device__ __forceinline__ void rwkv_seq_load(const P& p, size_t base, int wv, int lane, u32x4 (&mh)[4][2], u32x4 (&ml)[4][2], f32x4 (&nt)[4]) {
#pragma unroll
    for (int tile = 0; tile < 4; ++tile) {
#pragma unroll
        for (int s2 = 0; s2 < 2; ++s2) {
            mh[tile][s2] = *(const u32x4*)(p.MTF + ((((base * 2 + 0) * 4 + tile) * 2 + s2) * 64 + lane) * 8);
            ml[tile][s2] = *(const u32x4*)(p.MTF + ((((base * 2 + 1) * 4 + tile) * 2 + s2) * 64 + lane) * 8);
        }
        nt[tile] = *(const f32x4*)(p.NTF + (((base * 4 + wv) * 4 + tile) * 64 + lane) * 4);
    }
}
__device__ __forceinline__ void rwkv_seq_job(const P& p, int job) {
    const int tid = otid(), lane = tid & 63, wv = tid >> 6, q = lane >> 4, r = lane & 15;
    const int d = job / RH, h = job % RH;
    f32x4 X[4];
#pragma unroll
    for (int kt = 0; kt < 4; ++kt) X[kt] = (f32x4){0.f, 0.f, 0.f, 0.f};
    u32x4 mh[4][2], ml[4][2]; f32x4 nt[4];
    size_t base = (size_t)(d * NC + chunk_order(d, 0)) * RH + h;
    rwkv_seq_load(p, base, wv, lane, mh, ml, nt);
    for (int s = 0; s < NC; ++s) {
        u32x4 mh2[4][2], ml2[4][2]; f32x4 nt2[4];
        const size_t base2 = (size_t)(d * NC + chunk_order(d, (s + 1 < NC) ? s + 1 : s)) * RH + h;
        rwkv_seq_load(p, base2, wv, lane, mh2, ml2, nt2);
        unsigned xh[4][2], xl[4][2];
#pragma unroll
        for (int kt = 0; kt < 4; ++kt) {
            bf16_t hb[4], lb[4];
#pragma unroll
            for (int e = 0; e < 4; ++e) { hb[e] = f2bf(X[kt][e]); lb[e] = f2bf(X[kt][e] - bf2f(hb[e])); }
            xh[kt][0] = (unsigned)hb[0] | ((unsigned)hb[1] << 16); xh[kt][1] = (unsigned)hb[2] | ((unsigned)hb[3] << 16);
            xl[kt][0] = (unsigned)lb[0] | ((unsigned)lb[1] << 16); xl[kt][1] = (unsigned)lb[2] | ((unsigned)lb[3] << 16);
            *(u32x2*)(p.SN + (base * 64 + 16 * wv + r) * 64 + 16 * kt + 4 * q) = (u32x2){xh[kt][0], xh[kt][1]};
        }
        bf16x8 bh[2], bl[2];
#pragma unroll
        for (int s2 = 0; s2 < 2; ++s2) {
            bh[s2] = __builtin_bit_cast(bf16x8, ((u32x4){xh[2 * s2][0], xh[2 * s2][1], xh[2 * s2 + 1][0], xh[2 * s2 + 1][1]}));
            bl[s2] = __builtin_bit_cast(bf16x8, ((u32x4){xl[2 * s2][0], xl[2 * s2][1], xl[2 * s2 + 1][0], xl[2 * s2 + 1][1]}));
        }
#pragma unroll
        for (int tile = 0; tile < 4; ++tile) {
            f32x4 acc = nt[tile];
#pragma unroll
            for (int s2 = 0; s2 < 2; ++s2) {
                const bf16x8 ah = __builtin_bit_cast(bf16x8, mh[tile][s2]), al = __builtin_bit_cast(bf16x8, ml[tile][s2]);
                acc = MFMA16(ah, bh[s2], acc);
                acc = MFMA16(al, bh[s2], acc);
                acc = MFMA16(ah, bl[s2], acc);
            }
            X[tile] = acc;
        }
        base = base2;
#pragma unroll
        for (int tile = 0; tile < 4; ++tile) {
            nt[tile] = nt2[tile];
#pragma unroll
            for (int s2 = 0; s2 < 2; ++s2) { mh[tile][s2] = mh2[tile][s2]; ml[tile][s2] = ml2[tile][s2]; }
        }
    }
}
__device__ __forceinline__ void rwkv_out_job(const P& p, int job) {
    const int tid = otid(), lane = tid & 63, wv = tid >> 6, q = lane >> 4, r = lane & 15;
    const int d = job / (NC * RH), n = (job / RH) % NC, h = job % RH;
    const size_t base = (size_t)(d * NC + n) * RH + h;
    f32x4 acc[4];
#pragma unroll
    for (int nt = 0; nt < 4; ++nt) acc[nt] = (f32x4){0.f, 0.f, 0.f, 0.f};
#pragma unroll
    for (int s2 = 0; s2 < 2; ++s2) {
        const bf16x8 a = *(const bf16x8*)(p.QH + (base * 64 + 16 * wv + r) * 64 + s2 * 32 + q * 8);
#pragma unroll
        for (int nt = 0; nt < 4; ++nt) {
            const bf16x8 b = *(const bf16x8*)(p.SN + (base * 64 + nt * 16 + r) * 64 + s2 * 32 + q * 8);
            acc[nt] = MFMA16(a, b, acc[nt]);
        }
    }
#pragma unroll
    for (int nt = 0; nt < 4; ++nt)
#pragma unroll
        for (int e = 0; e < 4; ++e) {
            const int t = 16 * wv + 4 * q + e; const int tok = 64 * n + (d ? 63 - t : t);
            p.Y[((size_t)d * MTOT + tok) * RW + h * 64 + nt * 16 + r] += acc[nt][e];
        }
}

__device__ __forceinline__ void s5_local_job(const P& p, int job, char* smem, bool with_carry) {
    const int tid = otid();
    const int n = job / SG, g = job % SG;
    float* su = (float*)smem;
    float* xs = su + 1024;
    float* cre = xs + 2 * 64 * 64 * 2;
    float* cim = cre + 1024;
    __syncthreads();
    for (int idx = tid; idx < 1024; idx += NTHREADS) {
        int i = idx >> 4, c = idx & 15;
        su[idx] = bf2f(p.Z[(size_t)(n * 64 + i) * D_IN + ZS5 + g * 16 + c]);
    }
    __syncthreads();
    if (tid < 128) {
        const int d = tid >> 6, st = tid & 63;
        size_t ci = ((size_t)d * SG + g) * 64 + st;
        float are = p.S5A[ci * 2], aim = p.S5A[ci * 2 + 1];
        float bre[16], bim[16];
#pragma unroll
        for (int c = 0; c < 16; ++c) { bre[c] = p.S5BB[(ci * 16 + c) * 2]; bim[c] = p.S5BB[(ci * 16 + c) * 2 + 1]; }
        size_t eo = (((size_t)d * NC + n) * SG + g) * 64 + st;
        float xr = 0.f, xi = 0.f;
        if (with_carry) { xr = p.S5END[eo * 2]; xi = p.S5END[eo * 2 + 1]; }
        for (int ii = 0; ii < 64; ++ii) {
            int i = d ? 63 - ii : ii;
            float ur = 0.f, ui = 0.f;
#pragma unroll
            for (int c = 0; c < 16; ++c) { float u = su[i * 16 + c]; ur += bre[c] * u; ui += bim[c] * u; }
            float nr = are * xr - aim * xi + ur, ni = are * xi + aim * xr + ui;
            xr = nr; xi = ni;
            if (with_carry) { xs[((d * 64 + i) * 64 + st) * 2] = xr; xs[((d * 64 + i) * 64 + st) * 2 + 1] = xi; }
        }
        if (!with_carry) { p.S5END[eo * 2] = xr; p.S5END[eo * 2 + 1] = xi; }
    }
}
__device__ __forceinline__ void s5_out_job(const P& p, int l, int job, char* smem) {
    const int tid = otid();
    const int n = job / SG, g = job % SG;
    float* su = (float*)smem;
    float* xs = su + 1024;
    float* cre = xs + 2 * 64 * 64 * 2;
    float* cim = cre + 1024;
    s5_local_job(p, job, smem, true);
    for (int idx = tid; idx < 1024; idx += NTHREADS) {
        cre[idx] = p.in[I_S5CRE][((size_t)l * SG + g) * 1024 + idx];
        cim[idx] = p.in[I_S5CIM][((size_t)l * SG + g) * 1024 + idx];
    }
    __syncthreads();
    for (int idx = tid; idx < 1024; idx += NTHREADS) {
        int i = idx >> 4, c = idx & 15;
        float a = 0.f;
        for (int st = 0; st < 64; ++st) {
            float xr = xs[((0 * 64 + i) * 64 + st) * 2] + xs[((1 * 64 + i) * 64 + st) * 2];
            float xi = xs[((0 * 64 + i) * 64 + st) * 2 + 1] + xs[((1 * 64 + i) * 64 + st) * 2 + 1];
            a += cre[c * 64 + st] * xr - cim[c * 64 + st] * xi;
        }
        a += p.in[I_S5D][(size_t)l * SW + g * 16 + c] * su[idx];
        p.GY[(size_t)(n * 64 + i) * SW + g * 16 + c] = f2bf(geluf_(a));
    }
    __syncthreads();
}
__device__ __forceinline__ void s5_carry_job(const P& p, int job) {
    int base = job * NTHREADS + otid();
    if (base >= 2 * SG * 64) return;
    int d = base / (SG * 64), g = (base / 64) % SG, st = base % 64;
    size_t ci = ((size_t)d * SG + g) * 64 + st;
    float ar = p.S5A[ci * 2], ai = p.S5A[ci * 2 + 1];
    for (int i = 0; i < 6; ++i) { float nr = ar * ar - ai * ai, ni = 2.f * ar * ai; ar = nr; ai = ni; }
    float cr = 0.f, cim = 0.f;
    for (int s = 0; s < NC; ++s) {
        int n = chunk_order(d, s);
        size_t eo = (((size_t)d * NC + n) * SG + g) * 64 + st;
        float er = p.S5END[eo * 2], ei = p.S5END[eo * 2 + 1];
        p.S5END[eo * 2] = cr; p.S5END[eo * 2 + 1] = cim;
        float nr = ar * cr - ai * cim + er, ni = ar * cim + ai * cr + ei;
        cr = nr; cim = ni;
    }
}

__device__ __forceinline__ void phase_side_elem(const P& p, int l) {
    const int lane = otid() & 63;
    const int gw = (obid() * NTHREADS + otid()) >> 6, nw = (gridDim.x * NTHREADS) >> 6;
    const float* gng = p.in[I_GLA_NG] + (size_t)l * 128;
    const float* lnw = p.in[I_RLNW] + (size_t)l * RW;
    const float* lnb = p.in[I_RLNB] + (size_t)l * RW;
    for (int t = gw; t < MTOT; t += nw) {
        for (int h = 0; h < GH; ++h) {
            float o0 = p.OGLA[(size_t)t * GLA_V + h * 128 + lane], o1 = p.OGLA[(size_t)t * GLA_V + h * 128 + 64 + lane];
            float ss = wave_sum(o0 * o0 + o1 * o1);
            float rstd = rsqrtf(ss / 128.f + 1e-6f);
            float z0 = bf2f(p.Z[(size_t)t * D_IN + ZOG + h * 128 + lane]), z1 = bf2f(p.Z[(size_t)t * D_IN + ZOG + h * 128 + 64 + lane]);
            p.BR[(size_t)t * 3 * BW + h * 128 + lane] = f2bf(o0 * rstd * gng[lane] * siluf_(z0));
            p.BR[(size_t)t * 3 * BW + h * 128 + 64 + lane] = f2bf(o1 * rstd * gng[64 + lane] * siluf_(z1));
        }
        for (int h = 0; h < RH; ++h) {
            int c = h * 64 + lane;
            float y = p.Y[(size_t)t * RW + c] + p.Y[((size_t)MTOT + t) * RW + c];
            float mu = wave_sum(y) * (1.f / 64.f);
            float dv = y - mu;
            float var = wave_sum(dv * dv) * (1.f / 64.f);
            float yn = dv * rsqrtf(var + 64e-5f) * lnw[c] + lnb[c];
            yn += p.BONUS[(size_t)t * RH + h] * bf2f(p.V[(size_t)t * RW + c]);
            p.YN[(size_t)t * RW + c] = yn;
        }
    }
}

__device__ __forceinline__ void phase_side_gemm(const P& p, int l, char* smem) {
    const int ntm = MTOT / 128, nt1 = NPAD(RW) / 128, nt2 = (2 * SW) / 128;
    for (int job = obid(); job < ntm * (nt1 + nt2); job += gridDim.x) {
        const int m0 = (job / (nt1 + nt2)) * 128, jn = job % (nt1 + nt2);
        f32x4 acc[4][4]; ZERO_ACC4(acc);
        if (jn < nt1) {
            const int n0 = jn * 128;
            mfma_gemm_tile(p.WT_G2, 128, p.GS, 128, 128, n0, m0, (bf16_t*)smem, acc);
            FOR_ACC(acc, n0, m0, { if (n < RW) { const float4 y = *(const float4*)(p.YN + (size_t)m * RW + n);
                *(u32x2*)(p.BR + (size_t)m * 3 * BW + BW + n) = pack4(y.x * v[0], y.y * v[1], y.z * v[2], y.w * v[3]); } })
        } else {
            const int n0 = (jn - nt1) * 128;
            mfma_gemm_tile(p.WT_GLU, SW, p.GY, SW, SW, n0, m0, (bf16_t*)smem, acc);
            FOR_ACC(acc, n0, m0, { const unsigned w = (unsigned)f2bf(v[0] * sigmoidf_(v[1])) | ((unsigned)f2bf(v[2] * sigmoidf_(v[3])) << 16);
                *(unsigned*)(p.BR + (size_t)m * 3 * BW + 2 * BW + (n >> 1)) = w; })
        }
    }
}

__device__ __forceinline__ void phase_merge(const P& p, int l, char* smem) {
    const int ntm = MTOT / 128, ntn = D_MODEL / 128;
    for (int job = obid(); job < ntm * ntn; job += gridDim.x) {
        const int m0 = (job / ntn) * 128, n0 = (job % ntn) * 128;
        f32x4 macc[4][4]; ZERO_ACC4(macc);
        for (int b = 0; b < 3; ++b) {
            f32x4 acc[4][4]; ZERO_ACC4(acc);
            mfma_gemm_tile(p.WT_BR + (size_t)b * D_MODEL * BW, BW, p.BR + b * BW, 3 * BW, BW, n0, m0, (bf16_t*)smem, acc);
            const int lane_ = otid() & 63, wave_ = otid() >> 6;
#pragma unroll
            for (int ni = 0; ni < 4; ++ni)
#pragma unroll
                for (int mi = 0; mi < 4; ++mi) {
                    const int n = n0 + (wave_ >> 1) * 64 + ni * 16 + (lane_ >> 4) * 4, m = m0 + (wave_ & 1) * 64 + mi * 16 + (lane_ & 15);
                    const u32x2 g = *(const u32x2*)(p.Z + (size_t)m * D_IN + ZG + b * D_MODEL + n);
                    macc[ni][mi][0] += sigmoidf_(bf2f((bf16_t)(g.x & 0xFFFF))) * acc[ni][mi][0];
                    macc[ni][mi][1] += sigmoidf_(bf2f((bf16_t)(g.x >> 16))) * acc[ni][mi][1];
                    macc[ni][mi][2] += sigmoidf_(bf2f((bf16_t)(g.y & 0xFFFF))) * acc[ni][mi][2];
                    macc[ni][mi][3] += sigmoidf_(bf2f((bf16_t)(g.y >> 16))) * acc[ni][mi][3];
                }
        }
        FOR_ACC(macc, n0, m0, { *(u32x2*)(p.M + (size_t)m * D_MODEL + n) = pack4(v[0], v[1], v[2], v[3]); })
    }
}

__device__ __forceinline__ void phase_outproj(const P& p, int l, char* smem) {
    const int ntm = MTOT / 128, ntn = D_MODEL / 128;
    for (int job = obid(); job < ntm * ntn; job += gridDim.x) {
        const int m0 = (job / ntn) * 128, n0 = (job % ntn) * 128;
        f32x4 acc[4][4]; ZERO_ACC4(acc);
        mfma_gemm_tile(p.WT_OUT, D_MODEL, p.M, D_MODEL, D_MODEL, n0, m0, (bf16_t*)smem, acc);
        FOR_ACC(acc, n0, m0, { const float* g1 = p.MOD + (size_t)(l * 2 + (m >= CTX ? 1 : 0)) * 6 * D_MODEL + 2 * D_MODEL + n;
            float4* xp = (float4*)(p.X + (size_t)m * D_MODEL + n); float4 x = *xp;
            x.x += g1[0] * v[0]; x.y += g1[1] * v[1]; x.z += g1[2] * v[2]; x.w += g1[3] * v[3]; *xp = x; })
    }
}

__device__ __forceinline__ void phase_peer_q(const P& p, int l, char* smem) {
    const int ntm = MTOT / 128, ntn = PQ / 128;
    for (int job = obid(); job < ntm * ntn; job += gridDim.x) {
        const int m0 = (job / ntn) * 128, n0 = (job % ntn) * 128;
        f32x4 acc[4][4]; ZERO_ACC4(acc);
        mfma_gemm_tile(p.WT_Q, D_MODEL, p.H, D_MODEL, D_MODEL, n0, m0, (bf16_t*)smem, acc);
        FOR_ACC(acc, n0, m0, { float4 o; o.x = v[0]; o.y = v[1]; o.z = v[2]; o.w = v[3]; *(float4*)(p.Q + (size_t)m * PQ + n) = o; })
    }
}

__device__ __forceinline__ void wave_argmax(float& v, int& idx) {
#pragma unroll
    for (int m = 32; m >= 1; m >>= 1) {
        float ov = __shfl_xor(v, m, 64); int oi = __shfl_xor(idx, m, 64);
        if (ov > v || (ov == v && oi < idx)) { v = ov; idx = oi; }
    }
}

__device__ __forceinline__ void phase_peer_topk(const P& p, int l, char* smem) {
    const int lane = otid() & 63, wv = otid() >> 6;
    float* ws = (float*)smem + wv * 384;
    float* sq = ws; float* s1t = ws + 256; float* s2t = ws + 272; int* i1t = (int*)(ws + 288); int* i2t = (int*)(ws + 304);
    const int gw = (obid() * NTHREADS + otid()) >> 6, nw = (gridDim.x * NTHREADS) >> 6;
    const float NEG = -3.0e38f;
    for (int job = gw; job < MTOT * PH; job += nw) {
        const int t = job / PH, h = job % PH;
        const float* q = p.Q + (size_t)t * PQ + h * 256;
        for (int i = lane; i < 256; i += 64) sq[i] = q[i];
        WAVE_SYNC();
        const float* keys = p.in[I_PKEYS] + ((size_t)(l * PH + h) * 2) * 128 * 128;
        float sc[2][2] = {{0.f, 0.f}, {0.f, 0.f}};
        {
            const float4* k00 = (const float4*)(keys + ((size_t)0 * 128 + lane) * 128);
            const float4* k01 = (const float4*)(keys + ((size_t)0 * 128 + lane + 64) * 128);
            const float4* k10 = (const float4*)(keys + ((size_t)1 * 128 + lane) * 128);
            const float4* k11 = (const float4*)(keys + ((size_t)1 * 128 + lane + 64) * 128);
            const float4* q4 = (const float4*)sq;
#pragma unroll 2
            for (int dd = 0; dd < 32; ++dd) {
                float4 qa = q4[dd], qb = q4[32 + dd];
                float4 a = k00[dd], b = k01[dd], c = k10[dd], e = k11[dd];
                sc[0][0] += qa.x * a.x + qa.y * a.y + qa.z * a.z + qa.w * a.w;
                sc[0][1] += qa.x * b.x + qa.y * b.y + qa.z * b.z + qa.w * b.w;
                sc[1][0] += qb.x * c.x + qb.y * c.y + qb.z * c.z + qb.w * c.w;
                sc[1][1] += qb.x * e.x + qb.y * e.y + qb.z * e.z + qb.w * e.w;
            }
        }
#pragma unroll
        for (int s = 0; s < 2; ++s) {
            float v0 = sc[s][0], v1 = sc[s][1];
            for (int r = 0; r < 16; ++r) {
                float bv; int bi;
                if (v0 >= v1) { bv = v0; bi = lane; } else { bv = v1; bi = lane + 64; }
                wave_argmax(bv, bi);
                if (bi == lane) v0 = NEG;
                if (bi == lane + 64) v1 = NEG;
                if (lane == 0) { if (s == 0) { s1t[r] = bv; i1t[r] = bi; } else { s2t[r] = bv; i2t[r] = bi; } }
            }
        }
        WAVE_SYNC();
        float cv[4];
#pragma unroll
        for (int j = 0; j < 4; ++j) { int c = lane * 4 + j; cv[j] = s1t[c >> 4] + s2t[c & 15]; }
        float topv = 0.f; int topc = 0; float mx = 0.f;
        for (int r = 0; r < 16; ++r) {
            float bv = cv[0]; int bi = lane * 4;
#pragma unroll
            for (int j = 1; j < 4; ++j) if (cv[j] > bv) { bv = cv[j]; bi = lane * 4 + j; }
            wave_argmax(bv, bi);
#pragma unroll
            for (int j = 0; j < 4; ++j) if (bi == lane * 4 + j) cv[j] = NEG;
            if (r == 0) mx = bv;
            if (lane == r) { topv = bv; topc = bi; }
        }
        float e = (lane < 16) ? expf(topv - mx) : 0.f;
        float sum = wave_sum(e);
        if (lane < 16) {
            p.IDX[(size_t)t * PH * 16 + h * 16 + lane] = i1t[topc >> 4] * 128 + i2t[topc & 15];
            p.G[(size_t)t * PH * 16 + h * 16 + lane] = e / sum;
        }
        WAVE_SYNC();
    }
}

#define PEER_CONV_JOBS (2 * NEXP * D_MODEL / 2048)
__device__ __forceinline__ void peer_conv_job(const P& p, int l, int job) {
    const int tid = otid();
    const int which = job / (NEXP * D_MODEL / 2048);
    const size_t e0 = (size_t)(job % (NEXP * D_MODEL / 2048)) * 2048 + tid * 8;
    const float* src = p.in[which ? I_PV : I_PU] + (size_t)l * NEXP * D_MODEL + e0;
    bf16_t* dst = (which ? p.VB : p.UB) + e0;
    const float4 a = *(const float4*)src, b = *(const float4*)(src + 4);
    u32x4 o; o.x = (unsigned)f2bf(a.x) | ((unsigned)f2bf(a.y) << 16); o.y = (unsigned)f2bf(a.z) | ((unsigned)f2bf(a.w) << 16);
    o.z = (unsigned)f2bf(b.x) | ((unsigned)f2bf(b.y) << 16); o.w = (unsigned)f2bf(b.z) | ((unsigned)f2bf(b.w) << 16);
    *(u32x4*)dst = o;
}
#define LO16(x) __builtin_bit_cast(float, (x) << 16)
#define HI16(x) __builtin_bit_cast(float, (x) & 0xFFFF0000u)
#define GNV ((D_MODEL + 511) / 512)
__device__ __forceinline__ void phase_peer_gather(const P& p, int l) {
    const int lane = otid() & 63;
    const int gw = (obid() * NTHREADS + otid()) >> 6, nw = (gridDim.x * NTHREADS) >> 6;
    for (int t = gw; t < MTOT; t += nw) {
        float hv[GNV][8], acc[GNV][8];
#pragma unroll
        for (int c = 0; c < GNV; ++c) {
            const bool act = (c * 512 + lane * 8) < D_MODEL;
            const u32x4 z4 = {0u, 0u, 0u, 0u};
            const u32x4 h4 = act ? *(const u32x4*)(p.H + (size_t)t * D_MODEL + c * 512 + lane * 8) : z4;
            hv[c][0] = LO16(h4.x); hv[c][1] = HI16(h4.x); hv[c][2] = LO16(h4.y); hv[c][3] = HI16(h4.y);
            hv[c][4] = LO16(h4.z); hv[c][5] = HI16(h4.z); hv[c][6] = LO16(h4.w); hv[c][7] = HI16(h4.w);
#pragma unroll
            for (int j = 0; j < 8; ++j) acc[c][j] = 0.f;
        }
        for (int e0 = 0; e0 < PH * 16; e0 += 64) {
            int my_idx = 0; float my_g = 0.f;
            if (e0 + lane < PH * 16) { my_idx = p.IDX[(size_t)t * PH * 16 + e0 + lane]; my_g = p.G[(size_t)t * PH * 16 + e0 + lane]; }
            const int cnt = (PH * 16 - e0) < 64 ? (PH * 16 - e0) : 64;
            for (int k = 0; k < cnt; k += 4) {
                int ei[4]; float gg[4]; u32x4 ur[4][GNV], vr[4][GNV];
#pragma unroll
                for (int q = 0; q < 4; ++q) { ei[q] = __shfl(my_idx, k + q, 64); gg[q] = __shfl(my_g, k + q, 64); }
#pragma unroll
                for (int q = 0; q < 4; ++q)
#pragma unroll
                    for (int c = 0; c < GNV; ++c) ur[q][c] = ((c * 512 + lane * 8) < D_MODEL) ? *(const u32x4*)(p.UB + (size_t)ei[q] * D_MODEL + c * 512 + lane * 8) : (u32x4){0u, 0u, 0u, 0u};
#pragma unroll
                for (int q = 0; q < 4; ++q)
#pragma unroll
                    for (int c = 0; c < GNV; ++c) vr[q][c] = ((c * 512 + lane * 8) < D_MODEL) ? *(const u32x4*)(p.VB + (size_t)ei[q] * D_MODEL + c * 512 + lane * 8) : (u32x4){0u, 0u, 0u, 0u};
                float dt[4];
#pragma unroll
                for (int q = 0; q < 4; ++q) {
                    float d = 0.f;
#pragma unroll
                    for (int c = 0; c < GNV; ++c) {
                        d += hv[c][0] * LO16(ur[q][c].x) + hv[c][1] * HI16(ur[q][c].x) + hv[c][2] * LO16(ur[q][c].y) + hv[c][3] * HI16(ur[q][c].y)
                           + hv[c][4] * LO16(ur[q][c].z) + hv[c][5] * HI16(ur[q][c].z) + hv[c][6] * LO16(ur[q][c].w) + hv[c][7] * HI16(ur[q][c].w);
                    }
                    dt[q] = d;
                }
#pragma unroll
                for (int m = 32; m >= 1; m >>= 1) {
#pragma unroll
                    for (int q = 0; q < 4; ++q) dt[q] += __shfl_xor(dt[q], m, 64);
                }
#pragma unroll
                for (int q = 0; q < 4; ++q) {
                    const float coef = gg[q] * geluf_(dt[q]);
#pragma unroll
                    for (int c = 0; c < GNV; ++c) {
                        acc[c][0] += coef * LO16(vr[q][c].x); acc[c][1] += coef * HI16(vr[q][c].x); acc[c][2] += coef * LO16(vr[q][c].y); acc[c][3] += coef * HI16(vr[q][c].y);
                        acc[c][4] += coef * LO16(vr[q][c].z); acc[c][5] += coef * HI16(vr[q][c].z); acc[c][6] += coef * LO16(vr[q][c].w); acc[c][7] += coef * HI16(vr[q][c].w);
                    }
                }
            }
        }
        const float* g2 = p.MOD + (size_t)(l * 2 + (t >= CTX ? 1 : 0)) * 6 * D_MODEL + 5 * D_MODEL;
#pragma unroll
        for (int c = 0; c < GNV; ++c) if ((c * 512 + lane * 8) < D_MODEL) {
            float* xp = p.X + (size_t)t * D_MODEL + c * 512 + lane * 8;
            const float* gp = g2 + c * 512 + lane * 8;
            float4 x0 = *(float4*)xp, x1 = *(float4*)(xp + 4);
            x0.x += gp[0] * acc[c][0]; x0.y += gp[1] * acc[c][1]; x0.z += gp[2] * acc[c][2]; x0.w += gp[3] * acc[c][3];
            x1.x += gp[4] * acc[c][4]; x1.y += gp[5] * acc[c][5]; x1.z += gp[6] * acc[c][6]; x1.w += gp[7] * acc[c][7];
            *(float4*)xp = x0; *(float4*)(xp + 4) = x1;
        }
    }
}

__device__ __forceinline__ void phase_final(const P& p) {
    const int lane = otid() & 63;
    const int gw = (obid() * NTHREADS + otid()) >> 6, nw = (gridDim.x * NTHREADS) >> 6;
    const float* g = p.in[I_FG];
    for (int t = gw; t < SEQ; t += nw) {
        const float* x = p.X + (size_t)(CTX + t) * D_MODEL;
        float v[D_MODEL / 64]; float ss = 0.f;
#pragma unroll
        for (int j = 0; j < D_MODEL / 64; ++j) { v[j] = x[lane + 64 * j]; ss += v[j] * v[j]; }
        ss = wave_sum(ss);
        float rstd = rsqrtf(ss / D_MODEL + 1e-6f);
#pragma unroll
        for (int j = 0; j < D_MODEL / 64; ++j) p.out[(size_t)t * D_MODEL + lane + 64 * j] = v[j] * rstd * g[lane + 64 * j];
    }
}

__global__ void __launch_bounds__(NTHREADS) fwd_megakernel(P p) {
#ifdef EMU
    char* smem = emu_smem();
#else
    __shared__ __attribute__((aligned(16))) char smem_raw[SMEM_BYTES + 16];
    char* smem = smem_raw;
#endif
#ifndef EMU
    volatile LAS unsigned* xst = (volatile LAS unsigned*)(smem_raw + SMEM_BYTES);
    if (threadIdx.x == 0) { xst[0] = 0u; xst[1] = 0u; xst[2] = 0u; xst[3] = 0u; }
    __syncthreads();
    XcdBarrier xb = xcd_barrier_post(p.bar, xst);
#endif
    phase_init(p, smem);
#ifndef EMU
    cg::this_grid().sync();
#endif
    GRID_SYNC();
    for (int l = 0; l < DEPTH; ++l) {
        phase_norm(p, l, 0);
        phase_s5const(p, l);
        phase_convert_weights(p, l, smem);
        GRID_SYNC();
        phase_gemm_in(p, l, smem);
        GRID_SYNC();
        phase_rwkv_prep(p, l, smem);
        GRID_SYNC();
        for (int job = obid(); job < 2 * NC * RH; job += gridDim.x) rwkv_chunk_job(p, job, smem);
        __syncthreads();
        phase_gla_kv(p, l, smem);
        for (int job = obid(); job < NC * SG; job += gridDim.x) s5_local_job(p, job, smem, false);
        __syncthreads();
        GRID_SYNC();
        {
            const int n_rw = 2 * RH, n_gla = 2 * GH * 8192 / NTHREADS, n_s5 = (2 * SG * 64 + NTHREADS - 1) / NTHREADS;
            for (int job = obid(); job < n_rw + n_gla + n_s5 + PEER_CONV_JOBS; job += gridDim.x) {
                if (job < n_rw) rwkv_seq_job(p, job);
                else if (job < n_rw + n_gla) gla_scan_job(p, job - n_rw);
                else if (job < n_rw + n_gla + n_s5) s5_carry_job(p, job - n_rw - n_gla);
                else peer_conv_job(p, l, job - n_rw - n_gla - n_s5);
            }
        }
        GRID_SYNC();
        for (int job = obid(); job < 2 * NC * RH; job += gridDim.x) rwkv_out_job(p, job);
        phase_gla_out(p, l, smem);
        for (int job = obid(); job < NC * SG; job += gridDim.x) s5_out_job(p, l, job, smem);
        GRID_SYNC();
        phase_side_elem(p, l);
        GRID_SYNC();
        phase_side_gemm(p, l, smem);
        GRID_SYNC();
        phase_merge(p, l, smem);
        GRID_SYNC();
        phase_outproj(p, l, smem);
        GRID_SYNC();
        phase_norm(p, l, 1);
        GRID_SYNC();
        phase_peer_q(p, l, smem);
        GRID_SYNC();
        phase_peer_topk(p, l, smem);
        GRID_SYNC();
        phase_peer_gather(p, l);
        GRID_SYNC();
    }
    phase_final(p);
}

static inline size_t align_up(size_t x) { return (x + 255) & ~(size_t)255; }

extern "C" void kernel_launch(void* const* d_in, const int* in_sizes, int n_in, void* d_out, int out_size, void* d_ws, size_t ws_size, hipStream_t stream) {
    P p;
    memset(&p, 0, sizeof(p));
    for (int i = 0; i < 39; ++i) p.in[i] = (const float*)d_in[i];
    p.out = (float*)d_out;
    char* w = (char*)d_ws; size_t off = 0;
    auto take = [&](size_t bytes) { void* r = w + off; off = align_up(off + bytes); return r; };
    p.bar = (unsigned*)take(16384);
    p.X = (float*)take((size_t)MTOT * D_MODEL * 4);
    p.H = (bf16_t*)take((size_t)MTOT * D_MODEL * 2);
    p.MOD = (float*)take((size_t)DEPTH * 2 * 6 * D_MODEL * 4);
    p.Z = (bf16_t*)take((size_t)MTOT * D_IN * 2);
    p.V = (bf16_t*)take((size_t)MTOT * RW * 2);
    {
        char* ra = (char*)take((size_t)MTOT * RW * 2 * 2 > (size_t)MTOT * GLA_V * 4 ? (size_t)MTOT * RW * 2 * 2 : (size_t)MTOT * GLA_V * 4);
        p.R = (bf16_t*)ra; p.KK = (bf16_t*)(ra + (size_t)MTOT * RW * 2);
        p.OGLA = (float*)ra;
    }
    {
        char* rb = (char*)take((size_t)2 * MTOT * RW * 2 > (size_t)2 * MTOT * PH * 16 * 4 ? (size_t)2 * MTOT * RW * 2 : (size_t)2 * MTOT * PH * 16 * 4);
        p.KD = (bf16_t*)rb;
        p.IDX = (int*)rb; p.G = (float*)(rb + (size_t)MTOT * PH * 16 * 4);
    }
    p.BB = (bf16_t*)take((size_t)2 * MTOT * RW * 2);
    p.LW = (float*)take((size_t)2 * MTOT * RW * 4);
    p.BONUS = (float*)take((size_t)MTOT * RH * 4);
    p.GS = (bf16_t*)take((size_t)MTOT * 128 * 2);
    p.Y = (float*)take((size_t)2 * MTOT * RW * 4);
    p.KV = (float*)take((size_t)2 * NC * GH * 8192 * 4);
    p.DEC = (float*)take((size_t)2 * NC * GH * 64 * 4);
    p.S5A = (float*)take((size_t)2 * SG * 64 * 2 * 4);
    p.S5BB = (float*)take((size_t)2 * SG * 64 * 16 * 2 * 4);
    p.S5END = (float*)take((size_t)2 * NC * SG * 64 * 2 * 4);
    {
        const size_t szc1 = (size_t)2 * NC * RH * 8192 * 2 + (size_t)2 * NC * RH * 4096 * 4;
        const size_t szc2 = (size_t)MTOT * SW * 2 + (size_t)MTOT * RW * 4 + (size_t)MTOT * 3 * BW * 2 + (size_t)MTOT * D_MODEL * 2 + 1024;
        char* rc = (char*)take(szc1 > szc2 ? szc1 : szc2);
        p.MTF = (bf16_t*)rc; p.NTF = (float*)(rc + (size_t)2 * NC * RH * 8192 * 2);
        char* c2 = rc;
        p.GY = (bf16_t*)c2; c2 += align_up((size_t)MTOT * SW * 2);
        p.YN = (float*)c2; c2 += align_up((size_t)MTOT * RW * 4);
        p.BR = (bf16_t*)c2; c2 += align_up((size_t)MTOT * 3 * BW * 2);
        p.M = (bf16_t*)c2;
    }
    p.SN = (bf16_t*)take((size_t)2 * NC * RH * 4096 * 2);
    p.QH = (bf16_t*)take((size_t)2 * NC * RH * 4096 * 2);
    p.WT_IN = (bf16_t*)take((size_t)NPAD(D_IN) * D_MODEL * 2);
    p.WT_G2 = (bf16_t*)take((size_t)NPAD(RW) * 128 * 2);
    p.WT_GLU = (bf16_t*)take((size_t)NPAD(2 * SW) * SW * 2);
    p.WT_BR = (bf16_t*)take((size_t)3 * D_MODEL * BW * 2);
    p.WT_OUT = (bf16_t*)take((size_t)D_MODEL * D_MODEL * 2);
    p.WT_Q = (bf16_t*)take((size_t)PQ * D_MODEL * 2);
    p.UB = (bf16_t*)take((size_t)NEXP * D_MODEL * 2);
    p.VB = (bf16_t*)take((size_t)NEXP * D_MODEL * 2);
    p.Q = (float*)p.Z;
    static_assert((size_t)PQ * 4 <= (size_t)D_IN * 2, "Q alias");
    if (off > ws_size) { fprintf(stderr, "ws too small: need %zu have %zu\n", off, ws_size); return; }
#ifdef EMU
    fprintf(stderr, "ws used %zu MB\n", off >> 20);
    emu_launch([=] { fwd_megakernel(p); }, EMU_GRID, NTHREADS);
#else
    hipMemsetAsync(p.bar, 0, 16384, stream);
    static int grid_blocks = 0;
    if (!grid_blocks) {
        int dev = 0, cus = 0, per_cu = 0;
        hipGetDevice(&dev);
        hipDeviceGetAttribute(&cus, hipDeviceAttributeMultiprocessorCount, dev);
        hipOccupancyMaxActiveBlocksPerMultiprocessor(&per_cu, fwd_megakernel, NTHREADS, 0);
        if (per_cu > 1) per_cu = 1;
        grid_blocks = cus * per_cu;
    }
    void* args[] = {&p};
    hipError_t e = hipLaunchCooperativeKernel((void*)fwd_megakernel, dim3(grid_blocks), dim3(NTHREADS), args, 0, stream);
    if (e != hipSuccess) fprintf(stderr, "cooperative launch failed: %s (grid %d)\n", hipGetErrorString(e), grid_blocks);
#endif
}
```

```cpp
#include <hip/hip_runtime.h>
#ifndef EMU
#include <hip/hip_cooperative_groups.h>
namespace cg = cooperative_groups;
#endif
#include <cstdio>
#include <cstdint>
#include <cstring>

#ifdef CFG_SMALL
#define D_MODEL 128
#define SEQ 512
#define DEPTH 2
#define GRID_W 8
#define CTX 128
#define GH 1
#define RH 2
#define SG 8
#define PH 2
#else
#define D_MODEL 1024
#define SEQ 16384
#define DEPTH 4
#define GRID_W 64
#define CTX 256
#define GH 4
#define RH 8
#define SG 32
#define PH 8
#endif
#define MTOT (CTX + SEQ)
#define ROWS (SEQ / GRID_W)
#define GLA_K (GH * 64)
#define GLA_V (GH * 128)
#define RW (RH * 64)
#define RWKV_IN (3 * RW + 4 * 64 + 128)
#define SW (SG * 16)
#define BW GLA_V
#define ZQ 0
#define ZK (GLA_K)
#define ZV (2 * GLA_K)
#define ZOG (ZV + GLA_V)
#define ZAF (ZOG + GLA_V)
#define ZAB (ZAF + 16)
#define ZR (ZAB + 16)
#define ZS5 (ZR + RWKV_IN)
#define ZG (ZS5 + SW)
#define D_IN (ZG + 3 * D_MODEL)
#define NC (MTOT / 64)
#define NCC (CTX / 64)
#define RB (ROWS / 64)
#define PQ (PH * 256)
#define NEXP 16384
#define NTHREADS 256
#define SMEM_BYTES 117760

typedef unsigned short bf16_t;
typedef short bf16x8 __attribute__((ext_vector_type(8)));
typedef float f32x4 __attribute__((ext_vector_type(4)));
typedef unsigned u32x4 __attribute__((ext_vector_type(4)));
typedef unsigned u32x2 __attribute__((ext_vector_type(2)));
#ifdef EMU
#define MFMA16(a, b, c) emu_mfma_16x16x32_bf16(a, b, c)
#else
#define MFMA16(a, b, c) __builtin_amdgcn_mfma_f32_16x16x32_bf16(a, b, c, 0, 0, 0)
#endif
#define NPAD(n) (((n) + 127) / 128 * 128)

__device__ __forceinline__ float bf2f(bf16_t h) { return __builtin_bit_cast(float, ((unsigned)h) << 16); }
__device__ __forceinline__ bf16_t f2bf(float f) { unsigned u = __builtin_bit_cast(unsigned, f); u += 0x7FFFu + ((u >> 16) & 1u); return (bf16_t)(u >> 16); }
__device__ __forceinline__ float sigmoidf_(float x) { return 1.0f / (1.0f + expf(-x)); }
__device__ __forceinline__ float siluf_(float x) { return x * sigmoidf_(x); }
__device__ __forceinline__ float geluf_(float x) { return 0.5f * x * (1.0f + tanhf(0.7978845608028654f * (x + 0.044715f * x * x * x))); }
__device__ __forceinline__ float softplusf_(float x) { return fmaxf(x, 0.f) + log1pf(expf(-fabsf(x))); }
__device__ __forceinline__ float wave_sum(float v) {
#pragma unroll
    for (int m = 32; m >= 1; m >>= 1) v += __shfl_xor(v, m, 64);
    return v;
}

struct P {
    const float* in[39];
    float* out;
    float* X;
    bf16_t* H;
    bf16_t* Z;
    float* MOD;
    bf16_t* R; bf16_t* V; bf16_t* KK; bf16_t* KD; bf16_t* BB;
    float* LW;
    bf16_t* MTF;
    float* NTF;
    bf16_t* SN;
    bf16_t* QH;
    float* BONUS;
    bf16_t* GS;
    float* Y;
    float* KV;
    float* DEC;
    float* OGLA;
    float* S5A;
    float* S5BB;
    float* S5END;
    bf16_t* GY;
    float* YN;
    bf16_t* BR;
    bf16_t* M;
    bf16_t* QHI; bf16_t* QLO;
    bf16_t* KHI; bf16_t* KLO;
    int* IDX;
    float* G;
    unsigned* bar;
    bf16_t* WT_IN;
    bf16_t* WT_G2;
    bf16_t* WT_GLU;
    bf16_t* WT_BR;
    bf16_t* WT_OUT;
    bf16_t* WT_Q;
    bf16_t* UB; bf16_t* VB;
};

enum { I_X = 0, I_C, I_CTX, I_CCTX, I_WMOD, I_BMOD, I_N1G, I_N2G, I_WIN, I_GLA_WA2, I_GLA_BA, I_GLA_NG, I_RCONV, I_RW0, I_RW2, I_RA0, I_RA2, I_RG2,
       I_RKK, I_RKA, I_RRK, I_RLNW, I_RLNB, I_S5LRE, I_S5LIM, I_S5LS, I_S5BRE, I_S5BIM, I_S5CRE, I_S5CIM, I_S5D, I_S5GLU, I_WBR, I_WOUT, I_PWQ, I_PKEYS, I_PU, I_PV, I_FG };

#ifdef EMU
__device__ __forceinline__ int otid() { return threadIdx.x; }
__device__ __forceinline__ int obid() { return blockIdx.x; }
#else
__device__ __forceinline__ int otid() { int t = threadIdx.x; asm volatile("" : "+v"(t)); return t; }
__device__ __forceinline__ int obid() { int b = blockIdx.x; asm volatile("" : "+s"(b)); return b; }
#endif
#ifdef EMU
#define WAVE_SYNC() emu_wave_barrier()
#ifndef EMU_GRID
#define EMU_GRID 4
#endif
#else
#define WAVE_SYNC() __builtin_amdgcn_wave_barrier()
#endif
#ifndef EMU
#define XB_TMO      128
#define XB_XCNT(j)  (256  + 64 * (j))
#define XB_XSUB(j)  (1280 + 64 * (j))
#define XB_XGEN(j)  (2304 + 64 * (j))
#define XB_TOP      3328
#define XB_TOPGEN   3392
#define XCD_BAR_WORDS 3456
#define XB_SPIN_CAP (1u << 22)
#define LAS __attribute__((address_space(3)))
__device__ __forceinline__ unsigned xb_ld(unsigned* p)              { return __hip_atomic_load(p, __ATOMIC_RELAXED, __HIP_MEMORY_SCOPE_AGENT); }
__device__ __forceinline__ unsigned xb_add(unsigned* p, unsigned v) { return __hip_atomic_fetch_add(p, v, __ATOMIC_RELAXED, __HIP_MEMORY_SCOPE_AGENT); }
__device__ __forceinline__ unsigned xb_xcc_id() { return (unsigned)__builtin_amdgcn_s_getreg((3 << 11) | 20) & 0xFu; }
#define XB_SPIN(cond, bar) do { unsigned _sp = 0; while (cond) { __builtin_amdgcn_s_sleep(1); \
    if ((++_sp & 255u) == 0u) { if (xb_ld(&(bar)[XB_TMO])) break; if (_sp > XB_SPIN_CAP) { atomicAdd(&(bar)[XB_TMO], 1u); break; } } } } while (0)
struct XcdBarrier { unsigned* bar; unsigned x; volatile LAS unsigned* st; };
__device__ __forceinline__ XcdBarrier xcd_barrier_post(unsigned* bar, volatile LAS unsigned* st) {
    XcdBarrier b; b.bar = bar; b.x = xb_xcc_id(); b.st = st;
    if (threadIdx.x == 0) (void)xb_add(&bar[XB_XCNT(b.x)], 1u);
    return b;
}
__device__ __forceinline__ void xcd_barrier_complete(unsigned* bar, unsigned x, unsigned& nloc, unsigned& nx) {
    const unsigned G = gridDim.x * gridDim.y * gridDim.z;
    unsigned sum, cnt, mine, sp = 0u;
    for (;;) {
        sum = 0u; cnt = 0u; mine = 0u;
#pragma unroll
        for (unsigned j = 0; j < 16; ++j) { const unsigned c = xb_ld(&bar[XB_XCNT(j)]); sum += c; cnt += (c > 0u) ? 1u : 0u; mine = (j == x) ? c : mine; }
        if (sum == G) break;
        __builtin_amdgcn_s_sleep(1);
        if ((++sp & 255u) == 0u) { if (xb_ld(&bar[XB_TMO])) break; if (sp > XB_SPIN_CAP) { atomicAdd(&bar[XB_TMO], 1u); break; } }
    }
    nloc = mine > 0u ? mine : 1u; nx = cnt > 0u ? cnt : 1u;
}
__device__ __forceinline__ void xcd_barrier(const XcdBarrier& b) {
    asm volatile("s_waitcnt vmcnt(0)" ::: "memory");
    __syncthreads();
    if (threadIdx.x == 0) {
        unsigned* bar = b.bar;
        __builtin_amdgcn_s_waitcnt(0);
        unsigned nloc = b.st[0], nx = b.st[1];
        if (nloc == 0u) { xcd_barrier_complete(bar, b.x, nloc, nx); b.st[0] = nloc; b.st[1] = nx; }
        const unsigned old = xb_add(&bar[XB_XSUB(b.x)], 1u);
        const unsigned gen = old / nloc;
        if (old + 1u == (gen + 1u) * nloc) {
            __builtin_amdgcn_fence(__ATOMIC_RELEASE, "agent");
            asm volatile("s_waitcnt vmcnt(0)" ::: "memory");
            const unsigned og = xb_add(&bar[XB_TOP], 1u);
            const unsigned tg = og / nx;
            if (og + 1u == (tg + 1u) * nx) xb_add(&bar[XB_TOPGEN], 1u);
            else XB_SPIN(xb_ld(&bar[XB_TOPGEN]) == tg, bar);
            __builtin_amdgcn_fence(__ATOMIC_ACQUIRE, "agent");
            xb_add(&bar[XB_XGEN(b.x)], 1u);
            asm volatile("s_waitcnt vmcnt(0)" ::: "memory");
        } else {
            XB_SPIN(xb_ld(&bar[XB_XGEN(b.x)]) == gen, bar);
            __builtin_amdgcn_fence(__ATOMIC_ACQUIRE, "agent");
            asm volatile("s_waitcnt vmcnt(0)" ::: "memory");
        }
    }
    __syncthreads();
}
#define GRID_SYNC() xcd_barrier(xb)
#else
#define GRID_SYNC() emu_grid_sync()
#endif

__device__ __forceinline__ int gla_tok(int n, int i) {
    if (n < NCC) return n * 64 + i;
    int m = n - NCC; int col = m / RB, rb = m % RB;
    return CTX + (rb * 64 + i) * GRID_W + col;
}
__device__ __forceinline__ int chunk_order(int d, int s) {
    if (d == 0) return s;
    return (s < NCC) ? (NCC - 1 - s) : (NC - 1 - (s - NCC));
}
__device__ __forceinline__ int tok_order(int d, int s) {
    if (d == 0) return s;
    return (s < CTX) ? (CTX - 1 - s) : (MTOT - 1 - (s - CTX));
}


#define LDS_ROW 72
__device__ __forceinline__ void mfma_gemm_tile(const bf16_t* Wt, int ldw, const bf16_t* Act, int lda, int K, int n0, int m0, bf16_t* lds, f32x4 (&acc)[4][4]) {
    bf16_t* Ws = lds; bf16_t* As = lds + 128 * LDS_ROW;
    const int tid = otid(), lane = tid & 63, wave = tid >> 6, wn = wave >> 1, wm = wave & 1;
    const int lrow = tid >> 3, lkc = (tid & 7) * 8;
    u32x4 pw[4], pa[4];
#pragma unroll
    for (int i = 0; i < 4; ++i) {
        pw[i] = *(const u32x4*)(Wt + (size_t)(n0 + lrow + 32 * i) * ldw + lkc);
        pa[i] = *(const u32x4*)(Act + (size_t)(m0 + lrow + 32 * i) * lda + lkc);
    }
    for (int k0 = 0; k0 < K; k0 += 64) {
        __syncthreads();
#pragma unroll
        for (int i = 0; i < 4; ++i) {
            *(u32x4*)(Ws + (lrow + 32 * i) * LDS_ROW + lkc) = pw[i];
            *(u32x4*)(As + (lrow + 32 * i) * LDS_ROW + lkc) = pa[i];
        }
        __syncthreads();
        if (k0 + 64 < K) {
#pragma unroll
            for (int i = 0; i < 4; ++i) {
                pw[i] = *(const u32x4*)(Wt + (size_t)(n0 + lrow + 32 * i) * ldw + k0 + 64 + lkc);
                pa[i] = *(const u32x4*)(Act + (size_t)(m0 + lrow + 32 * i) * lda + k0 + 64 + lkc);
            }
        }
#pragma unroll
        for (int ks = 0; ks < 2; ++ks) {
            bf16x8 a[4], b[4];
#pragma unroll
            for (int i = 0; i < 4; ++i) {
                a[i] = *(const bf16x8*)(Ws + (wn * 64 + i * 16 + (lane & 15)) * LDS_ROW + ks * 32 + (lane >> 4) * 8);
                b[i] = *(const bf16x8*)(As + (wm * 64 + i * 16 + (lane & 15)) * LDS_ROW + ks * 32 + (lane >> 4) * 8);
            }
#pragma unroll
            for (int ni = 0; ni < 4; ++ni)
#pragma unroll
                for (int mi = 0; mi < 4; ++mi) acc[ni][mi] = MFMA16(a[ni], b[mi], acc[ni][mi]);
        }
    }
}
#define ZERO_ACC4(acc) { _Pragma("unroll") for (int i_ = 0; i_ < 4; ++i_) _Pragma("unroll") for (int j_ = 0; j_ < 4; ++j_) acc[i_][j_] = (f32x4){0.f, 0.f, 0.f, 0.f}; }
#define FOR_ACC(acc, n0, m0, BODY) { const int lane_ = otid() & 63, wave_ = otid() >> 6; \
    _Pragma("unroll") for (int ni_ = 0; ni_ < 4; ++ni_) _Pragma("unroll") for (int mi_ = 0; mi_ < 4; ++mi_) { \
        const int n = (n0) + (wave_ >> 1) * 64 + ni_ * 16 + (lane_ >> 4) * 4; const int m = (m0) + (wave_ & 1) * 64 + mi_ * 16 + (lane_ & 15); const f32x4 v = acc[ni_][mi_]; BODY } }
__device__ __forceinline__ u32x2 pack4(float a, float b, float c, float d) { u32x2 r; r.x = (unsigned)f2bf(a) | ((unsigned)f2bf(b) << 16); r.y = (unsigned)f2bf(c) | ((unsigned)f2bf(d) << 16); return r; }

__device__ __forceinline__ void convert_wt_job(const float* W, int K, int N, int Npad, bf16_t* out, int job, float* T, int ilv) {
    const int tid = otid();
    const int nkt = K / 64;
    const int n0 = (job / nkt) * 64, k0 = (job % nkt) * 64;
    __syncthreads();
    for (int idx = tid; idx < 4096; idx += NTHREADS) {
        int kk = idx >> 6, nn = idx & 63;
        int nr = n0 + nn; int src = ilv ? ((nr & 1) ? (N / 2 + (nr >> 1)) : (nr >> 1)) : nr;
        T[kk * 65 + nn] = (nr < N) ? W[(size_t)(k0 + kk) * N + src] : 0.f;
    }
    __syncthreads();
    {
        int nn = tid >> 2, part = tid & 3;
        unsigned w[8];
#pragma unroll
        for (int j = 0; j < 8; ++j) w[j] = (unsigned)f2bf(T[(part * 16 + 2 * j) * 65 + nn]) | ((unsigned)f2bf(T[(part * 16 + 2 * j + 1) * 65 + nn]) << 16);
        u32x4* o = (u32x4*)(out + (size_t)(n0 + nn) * K + k0 + part * 16);
        o[0] = (u32x4){w[0], w[1], w[2], w[3]}; o[1] = (u32x4){w[4], w[5], w[6], w[7]};
    }
}
__device__ __forceinline__ void phase_convert_weights(const P& p, int l, char* smem) {
    float* T = (float*)smem;
    struct Item { const float* W; int K, N, Npad; bf16_t* out; };
    const Item items[8] = {
        {p.in[I_WIN] + (size_t)l * D_MODEL * D_IN, D_MODEL, D_IN, NPAD(D_IN), p.WT_IN},
        {p.in[I_RG2] + (size_t)l * 128 * RW, 128, RW, RW, p.WT_G2},
        {p.in[I_S5GLU] + (size_t)l * SW * 2 * SW, SW, 2 * SW, 2 * SW, p.WT_GLU},
        {p.in[I_WBR] + ((size_t)l * 3 + 0) * BW * D_MODEL, BW, D_MODEL, D_MODEL, p.WT_BR},
        {p.in[I_WBR] + ((size_t)l * 3 + 1) * BW * D_MODEL, BW, D_MODEL, D_MODEL, p.WT_BR + (size_t)D_MODEL * BW},
        {p.in[I_WBR] + ((size_t)l * 3 + 2) * BW * D_MODEL, BW, D_MODEL, D_MODEL, p.WT_BR + (size_t)2 * D_MODEL * BW},
        {p.in[I_WOUT] + (size_t)l * D_MODEL * D_MODEL, D_MODEL, D_MODEL, D_MODEL, p.WT_OUT},
        {p.in[I_PWQ] + (size_t)l * D_MODEL * PQ, D_MODEL, PQ, PQ, p.WT_Q}};
    int base = 0;
#pragma unroll
    for (int it = 0; it < 8; ++it) {
        const int nj = (items[it].Npad / 64) * (items[it].K / 64);
        for (int j = (int)((obid() + gridDim.x - (base % gridDim.x)) % gridDim.x); j < nj; j += gridDim.x)
            convert_wt_job(items[it].W, items[it].K, items[it].N, items[it].Npad, items[it].out, j, T, it == 2);
        base += nj;
    }
    __syncthreads();
    {
        const float* ks = p.in[I_PKEYS] + (size_t)l * PH * 2 * 128 * 128;
        for (size_t i = (size_t)obid() * NTHREADS + otid(); i < (size_t)PH * 2 * 128 * 128; i += (size_t)gridDim.x * NTHREADS) {
            const float v = ks[i]; const bf16_t hb = f2bf(v);
            p.KHI[i] = hb; p.KLO[i] = f2bf(v - bf2f(hb));
        }
    }
}

__device__ __forceinline__ void phase_init(const P& p, char* smem) {
    const int tid = otid();
    float* sc = (float*)smem;
    for (int i = tid; i < D_MODEL; i += NTHREADS) { sc[i] = siluf_(p.in[I_CCTX][i]); sc[D_MODEL + i] = siluf_(p.in[I_C][i]); }
    __syncthreads();
    const int ncolblk = (6 * D_MODEL) / NTHREADS;
    for (int job = obid(); job < DEPTH * ncolblk; job += gridDim.x) {
        int l = job / ncolblk, n = (job % ncolblk) * NTHREADS + tid;
        const float* w = p.in[I_WMOD] + (size_t)l * D_MODEL * 6 * D_MODEL + n;
        float a0 = 0.f, a1 = 0.f;
        for (int k = 0; k < D_MODEL; ++k) { float wv = w[(size_t)k * 6 * D_MODEL]; a0 += sc[k] * wv; a1 += sc[D_MODEL + k] * wv; }
        float b = p.in[I_BMOD][l * 6 * D_MODEL + n];
        p.MOD[(size_t)(l * 2 + 0) * 6 * D_MODEL + n] = a0 + b;
        p.MOD[(size_t)(l * 2 + 1) * 6 * D_MODEL + n] = a1 + b;
    }
    const size_t gtid = (size_t)obid() * NTHREADS + tid, gn = (size_t)gridDim.x * NTHREADS;
    for (size_t i = gtid; i < (size_t)CTX * D_MODEL; i += gn) p.X[i] = p.in[I_CTX][i];
    for (size_t i = gtid; i < (size_t)SEQ * D_MODEL; i += gn) p.X[(size_t)CTX * D_MODEL + i] = p.in[I_X][i];
    __syncthreads();
}

__device__ __forceinline__ void phase_s5const(const P& p, int l) {
    const size_t gtid = (size_t)obid() * NTHREADS + otid(), gn = (size_t)gridDim.x * NTHREADS;
    for (size_t i = gtid; i < (size_t)2 * SG * 64; i += gn) {
        int d = (int)(i / (SG * 64)), g = (int)((i / 64) % SG), s = (int)(i % 64);
        size_t li = ((size_t)(l * 2 + d) * SG + g) * 64 + s;
        float lre = p.in[I_S5LRE][li], lim = p.in[I_S5LIM][li];
        float dt = expf(p.in[I_S5LS][(l * 2 + d) * SG + g]);
        float mag = expf(lre * dt);
        float are = mag * cosf(lim * dt), aim = mag * sinf(lim * dt);
        float den = lre * lre + lim * lim;
        float fre = ((are - 1.0f) * lre + aim * lim) / den;
        float fim = (aim * lre - (are - 1.0f) * lim) / den;
        p.S5A[i * 2 + 0] = are; p.S5A[i * 2 + 1] = aim;
        const float* bre = p.in[I_S5BRE] + (((size_t)l * SG + g) * 64 + s) * 16;
        const float* bim = p.in[I_S5BIM] + (((size_t)l * SG + g) * 64 + s) * 16;
        for (int c = 0; c < 16; ++c) {
            p.S5BB[(i * 16 + c) * 2 + 0] = fre * bre[c] - fim * bim[c];
            p.S5BB[(i * 16 + c) * 2 + 1] = fre * bim[c] + fim * bre[c];
        }
    }
}

__device__ __forceinline__ void phase_norm(const P& p, int l, int which) {
    const int lane = otid() & 63;
    const int gw = (obid() * NTHREADS + otid()) >> 6, nw = (gridDim.x * NTHREADS) >> 6;
    const float* g = p.in[which ? I_N2G : I_N1G] + l * D_MODEL;
    for (int t = gw; t < MTOT; t += nw) {
        const float* x = p.X + (size_t)t * D_MODEL;
        const float* mod = p.MOD + (size_t)(l * 2 + (t >= CTX ? 1 : 0)) * 6 * D_MODEL + (which ? 3 * D_MODEL : 0);
        float v[D_MODEL / 64]; float ss = 0.f;
#pragma unroll
        for (int j = 0; j < D_MODEL / 64; ++j) { v[j] = x[lane + 64 * j]; ss += v[j] * v[j]; }
        ss = wave_sum(ss);
        float rstd = rsqrtf(ss / D_MODEL + 1e-6f);
#pragma unroll
        for (int j = 0; j < D_MODEL / 64; ++j) {
            int e = lane + 64 * j;
            p.H[(size_t)t * D_MODEL + e] = f2bf(v[j] * rstd * g[e] * (1.0f + mod[D_MODEL + e]) + mod[e]);
        }
    }
}

__device__ __forceinline__ void phase_gemm_in(const P& p, int l, char* smem) {
    const int ntn = NPAD(D_IN) / 128, ntm = MTOT / 128;
    for (int job = obid(); job < ntm * ntn; job += gridDim.x) {
        const int m0 = (job / ntn) * 128, n0 = (job % ntn) * 128;
        f32x4 acc[4][4]; ZERO_ACC4(acc);
        mfma_gemm_tile(p.WT_IN, D_MODEL, p.H, D_MODEL, D_MODEL, n0, m0, (bf16_t*)smem, acc);
        FOR_ACC(acc, n0, m0, { if (n < D_IN) *(u32x2*)(p.Z + (size_t)m * D_IN + n) = pack4(v[0], v[1], v[2], v[3]); })
    }
}

#define RTOK 4
__device__ __forceinline__ void phase_rwkv_prep(const P& p, int l, char* smem) {
    const int tid = otid(), lane = tid & 63;
    float* zs = (float*)smem;
    const float* conv = p.in[I_RCONV] + (size_t)l * 3 * RWKV_IN;
    const float* w0 = p.in[I_RW0] + (size_t)l * 2 * RW;
    const float* w2 = p.in[I_RW2] + (size_t)l * 2 * 64 * RW;
    const float* a0 = p.in[I_RA0] + (size_t)l * 2 * RW;
    const float* a2 = p.in[I_RA2] + (size_t)l * 2 * 64 * RW;
    const float* k_k = p.in[I_RKK] + (size_t)l * RW;
    const float* k_a = p.in[I_RKA] + (size_t)l * RW;
    const float* r_k = p.in[I_RRK] + (size_t)l * RW;
    for (int job = obid(); job < MTOT / RTOK; job += gridDim.x) {
        const int t0 = job * RTOK;
        __syncthreads();
        for (int idx = tid; idx < RTOK * RWKV_IN; idx += NTHREADS) {
            int tt = idx / RWKV_IN, c = idx % RWKV_IN; int t = t0 + tt;
            bool first = (t == 0) || (t == CTX), last = (t == CTX - 1) || (t == MTOT - 1);
            const bf16_t* zp = p.Z + (size_t)t * D_IN + ZR + c;
            float v = conv[RWKV_IN + c] * bf2f(zp[0]);
            if (!first) v += conv[c] * bf2f(zp[-D_IN]);
            if (!last) v += conv[2 * RWKV_IN + c] * bf2f(zp[D_IN]);
            if (c >= 3 * RW && c < 3 * RW + 128) v = tanhf(v);
            zs[idx] = v;
        }
        __syncthreads();
        for (int c = tid; c < RW; c += NTHREADS) {
            const int h = c >> 6;
            float accw[2][RTOK], acca[2][RTOK];
#pragma unroll
            for (int d = 0; d < 2; ++d)
#pragma unroll
                for (int tt = 0; tt < RTOK; ++tt) { accw[d][tt] = w0[d * RW + c]; acca[d][tt] = a0[d * RW + c]; }
            for (int j = 0; j < 64; ++j) {
#pragma unroll
                for (int d = 0; d < 2; ++d) {
                    float wv = w2[((size_t)d * 64 + j) * RW + c], av = a2[((size_t)d * 64 + j) * RW + c];
#pragma unroll
                    for (int tt = 0; tt < RTOK; ++tt) {
                        accw[d][tt] += zs[tt * RWKV_IN + 3 * RW + d * 64 + j] * wv;
                        acca[d][tt] += zs[tt * RWKV_IN + 3 * RW + 128 + d * 64 + j] * av;
                    }
                }
            }
#pragma unroll
            for (int tt = 0; tt < RTOK; ++tt) {
                const int t = t0 + tt;
                float r = zs[tt * RWKV_IN + c], k = zs[tt * RWKV_IN + RW + c], v = zs[tt * RWKV_IN + 2 * RW + c];
                float kkr = k * k_k[c];
                float nrm = wave_sum(kkr * kkr);
                float kk = kkr / fmaxf(sqrtf(nrm), 1e-12f);
                float kdsum = 0.f;
#pragma unroll
                for (int d = 0; d < 2; ++d) {
                    float dec = -expf(-softplusf_(-accw[d][tt]) - 0.5f);
                    float aa = sigmoidf_(acca[d][tt]);
                    float kd = k * (1.0f + (aa - 1.0f) * k_a[c]);
                    kdsum += kd;
                    size_t o = ((size_t)d * MTOT + t) * RW + c;
                    p.LW[o] = dec; p.KD[o] = f2bf(kd); p.BB[o] = f2bf(kk * aa);
                }
                size_t o = (size_t)t * RW + c;
                p.R[o] = f2bf(r); p.V[o] = f2bf(v); p.KK[o] = f2bf(kk);
                float bon = wave_sum(r * kdsum * r_k[c]);
                if (lane == 0) p.BONUS[(size_t)t * RH + h] = bon;
            }
        }
        for (int idx = tid; idx < RTOK * 128; idx += NTHREADS) {
            int tt = idx >> 7, j = idx & 127;
            p.GS[(size_t)(t0 + tt) * 128 + j] = f2bf(sigmoidf_(zs[tt * RWKV_IN + 3 * RW + 256 + j]));
        }
    }
    __syncthreads();
}

#define G_SQ 0
#define G_SK 4096
#define G_SV 8192
#define G_CUM 16384
#define G_ATT 20480
#define G_END 24576
__device__ __forceinline__ void gla_load(const P& p, int l, int n, int h, int d, float* s) {
    const int tid = otid();
    float* alr = s + G_ATT;
    for (int idx = tid; idx < 64 * 64; idx += NTHREADS) {
        int i = idx >> 6, c = idx & 63; int t = gla_tok(n, i);
        const bf16_t* z = p.Z + (size_t)t * D_IN;
        s[G_SQ + idx] = bf2f(z[ZQ + h * 64 + c]) * 0.125f;
        s[G_SK + idx] = bf2f(z[ZK + h * 64 + c]);
    }
    for (int idx = tid; idx < 64 * 128; idx += NTHREADS) {
        int i = idx >> 7, c = idx & 127; int t = gla_tok(n, i);
        s[G_SV + idx] = bf2f(p.Z[(size_t)t * D_IN + ZV + h * 128 + c]);
    }
    for (int idx = tid; idx < 64 * 16; idx += NTHREADS) {
        int i = idx >> 4, r = idx & 15; int t = gla_tok(n, i);
        alr[idx] = bf2f(p.Z[(size_t)t * D_IN + (d ? ZAB : ZAF) + r]);
    }
    __syncthreads();
    const float* wa2 = p.in[I_GLA_WA2] + ((size_t)(l * 2 + d) * 16) * GLA_K + h * 64;
    const float* ba = p.in[I_GLA_BA] + (size_t)(l * 2 + d) * GLA_K + h * 64;
    for (int idx = tid; idx < 64 * 64; idx += NTHREADS) {
        int i = idx >> 6, c = idx & 63;
        float a = ba[c];
#pragma unroll
        for (int r = 0; r < 16; ++r) a += alr[i * 16 + r] * wa2[(size_t)r * GLA_K + c];
        float ls = fminf(a, 0.f) - log1pf(expf(-fabsf(a)));
        s[G_CUM + idx] = ls * (1.0f / 16.0f);
    }
    __syncthreads();
    if (tid < 64) {
        float run = 0.f;
        if (d == 0) { for (int i = 0; i < 64; ++i) { run += s[G_CUM + i * 64 + tid]; s[G_CUM + i * 64 + tid] = run; } }
        else { for (int i = 63; i >= 0; --i) { run += s[G_CUM + i * 64 + tid]; s[G_CUM + i * 64 + tid] = run; } }
    }
    __syncthreads();
}

__device__ __forceinline__ void phase_gla_kv(const P& p, int l, char* smem) {
    float* s = (float*)smem;
    const int tid = otid();
    for (int job = obid(); job < NC * GH; job += gridDim.x) {
        const int n = job / GH, h = job % GH;
        for (int d = 0; d < 2; ++d) {
            __syncthreads();
            gla_load(p, l, n, h, d, s);
            const int li = d ? 0 : 63;
            for (int idx = tid; idx < 64 * 64; idx += NTHREADS) {
                int c = idx & 63;
                s[G_SQ + idx] = s[G_SK + idx] * expf(s[G_CUM + li * 64 + c] - s[G_CUM + idx]);
            }
            if (tid < 64) p.DEC[((size_t)(d * NC + n) * GH + h) * 64 + tid] = expf(s[G_CUM + li * 64 + tid]);
            __syncthreads();
            float* kv = p.KV + ((size_t)(d * NC + n) * GH + h) * 64 * 128;
            const int dv = tid & 127, kh = (tid >> 7) * 32;
            float acc[32];
#pragma unroll
            for (int j = 0; j < 32; ++j) acc[j] = 0.f;
            for (int i = 0; i < 64; ++i) {
                float vv = s[G_SV + i * 128 + dv];
#pragma unroll
                for (int j = 0; j < 32; ++j) acc[j] += s[G_SQ + i * 64 + kh + j] * vv;
            }
#pragma unroll
            for (int j = 0; j < 32; ++j) kv[(size_t)(kh + j) * 128 + dv] = acc[j];
        }
    }
    __syncthreads();
}

__device__ __forceinline__ void gla_scan_job(const P& p, int job) {
    int base = job * NTHREADS + otid();
    int d = base / (GH * 8192), h = (base / 8192) % GH, e = base % 8192;
    float S = 0.f;
    for (int s = 0; s < NC; ++s) {
        int n = chunk_order(d, s);
        size_t o = ((size_t)(d * NC + n) * GH + h);
        float kv = p.KV[o * 8192 + e];
        float dec = p.DEC[o * 64 + (e >> 7)];
        p.KV[o * 8192 + e] = S;
        S = dec * S + kv;
    }
}

__device__ __forceinline__ void phase_gla_out(const P& p, int l, char* smem) {
    float* s = (float*)smem;
    const int tid = otid();
    const int tx = tid & 31, ty = tid >> 5;
    for (int job = obid(); job < NC * GH; job += gridDim.x) {
        const int n = job / GH, h = job % GH;
        float o[8][4];
#pragma unroll
        for (int i = 0; i < 8; ++i)
#pragma unroll
            for (int j = 0; j < 4; ++j) o[i][j] = 0.f;
        for (int d = 0; d < 2; ++d) {
            __syncthreads();
            gla_load(p, l, n, h, d, s);
            for (int idx = tid; idx < 64 * 64; idx += NTHREADS) {
                float c = s[G_CUM + idx];
                s[G_SQ + idx] *= expf(c);
                s[G_SK + idx] *= expf(-c);
            }
            __syncthreads();
            for (int idx = tid; idx < 64 * 64; idx += NTHREADS) {
                int i = idx >> 6, j = idx & 63;
                bool ok = d ? (j >= i) : (j <= i);
                float a = 0.f;
                if (ok) { for (int c = 0; c < 64; ++c) a += s[G_SQ + i * 64 + c] * s[G_SK + j * 64 + c]; }
                s[G_ATT + idx] = a;
            }
            __syncthreads();
            const float* S = p.KV + ((size_t)(d * NC + n) * GH + h) * 64 * 128;
            for (int j = 0; j < 64; ++j) {
                float v4[4], s4[4];
#pragma unroll
                for (int c = 0; c < 4; ++c) { v4[c] = s[G_SV + j * 128 + tx * 4 + c]; s4[c] = S[(size_t)j * 128 + tx * 4 + c]; }
#pragma unroll
                for (int i = 0; i < 8; ++i) {
                    float a = s[G_ATT + (ty * 8 + i) * 64 + j], q = s[G_SQ + (ty * 8 + i) * 64 + j];
#pragma unroll
                    for (int c = 0; c < 4; ++c) o[i][c] += a * v4[c] + q * s4[c];
                }
            }
        }
#pragma unroll
        for (int i = 0; i < 8; ++i) {
            int t = gla_tok(n, ty * 8 + i);
#pragma unroll
            for (int c = 0; c < 4; ++c) p.OGLA[(size_t)t * GLA_V + h * 128 + tx * 4 + c] = o[i][c];
        }
    }
    __syncthreads();
}

#define CH_ROW 72
#define CH_SLOT (64 * CH_ROW)
#define CH_XR_OFF (7 * CH_SLOT * 2)
#define CH_AAB_OFF (CH_XR_OFF + 64 * 132 * 4)
#define CH_GC_OFF (CH_AAB_OFF + 64 * 72 * 4)
template <int MT, int NT>
__device__ __forceinline__ void lds_mm(const bf16_t* A, int m0, const bf16_t* Bt, int n0, f32x4 (&acc)[MT][NT]) {
    const int lane = otid() & 63, q = lane >> 4, r = lane & 15;
#pragma unroll
    for (int s = 0; s < 2; ++s) {
        bf16x8 a[MT], b[NT];
#pragma unroll
        for (int i = 0; i < MT; ++i) a[i] = *(const bf16x8*)(A + (m0 + i * 16 + r) * CH_ROW + s * 32 + q * 8);
#pragma unroll
        for (int i = 0; i < NT; ++i) b[i] = *(const bf16x8*)(Bt + (n0 + i * 16 + r) * CH_ROW + s * 32 + q * 8);
#pragma unroll
        for (int i = 0; i < MT; ++i)
#pragma unroll
            for (int jj = 0; jj < NT; ++jj) acc[i][jj] = MFMA16(a[i], b[jj], acc[i][jj]);
    }
}
__device__ __forceinline__ void rwkv_chunk_job(const P& p, int job, char* smem) {
    const int tid = otid(), lane = tid & 63, wv = tid >> 6, q = lane >> 4, r = lane & 15;
    const int d = job / (NC * RH), n = (job / RH) % NC, h = job % RH;
    const size_t base = (size_t)(d * NC + n) * RH + h;
    bf16_t* S0 = (bf16_t*)smem; bf16_t* S1 = S0 + CH_SLOT; bf16_t* S2 = S1 + CH_SLOT; bf16_t* S3 = S2 + CH_SLOT;
    bf16_t* S4 = S3 + CH_SLOT; bf16_t* S5 = S4 + CH_SLOT; bf16_t* S6 = S5 + CH_SLOT;
    float* X = (float*)(smem + CH_XR_OFF);
    float* AABt = (float*)(smem + CH_AAB_OFF);
    bf16_t* U0t = (bf16_t*)(smem + CH_AAB_OFF);
    bf16_t* Aht = U0t + CH_SLOT;
    float* GC = (float*)(smem + CH_GC_OFF);
    __syncthreads();
    for (int idx = tid; idx < 4096; idx += NTHREADS) {
        const int i = idx >> 6, k = idx & 63; const int tok = 64 * n + (d ? 63 - i : i);
        X[i * 132 + k] = p.LW[((size_t)d * MTOT + tok) * RW + h * 64 + k];
    }
    __syncthreads();
    {
        const int k = tid & 63, seg = tid >> 6;
        float v[16]; float run = 0.f;
#pragma unroll
        for (int e = 0; e < 16; ++e) { run += X[(seg * 16 + e) * 132 + k]; v[e] = run; }
        AABt[seg * 64 + k] = run;
        __syncthreads();
        float off = 0.f;
        for (int s2 = 0; s2 < seg; ++s2) off += AABt[s2 * 64 + k];
#pragma unroll
        for (int e = 0; e < 16; ++e) X[(seg * 16 + e) * 132 + k] = v[e] + off;
    }
    __syncthreads();
    for (int idx = tid; idx < 4096; idx += NTHREADS) {
        const int i = idx >> 6, k = idx & 63; const int tok = 64 * n + (d ? 63 - i : i);
        const size_t o1 = (size_t)tok * RW + h * 64 + k, o2 = ((size_t)d * MTOT + tok) * RW + h * 64 + k;
        const float L = X[i * 132 + k], Lp = (i > 0) ? X[(i - 1) * 132 + k] : 0.f, LC = X[63 * 132 + k];
        const float kkv = bf2f(p.KK[o1]), rv = bf2f(p.R[o1]), vv = bf2f(p.V[o1]), kdv = bf2f(p.KD[o2]), bbv = bf2f(p.BB[o2]);
        const float eL = expf(L), eLp = expf(Lp), eNL = expf(-L), eCL = expf(LC - L);
        const float at = -kkv * eLp;
        S0[i * CH_ROW + k] = f2bf(at);
        X[i * 132 + 64 + k] = at;
        S1[i * CH_ROW + k] = f2bf(rv * eL);
        S2[i * CH_ROW + k] = f2bf(bbv * eNL);
        S3[i * CH_ROW + k] = f2bf(kdv * eNL);
        S4[k * CH_ROW + i] = f2bf(vv);
        S5[k * CH_ROW + i] = f2bf(bbv * eCL);
        S6[k * CH_ROW + i] = f2bf(kdv * eCL);
        if (i == 63) GC[k] = eL;
    }
    __syncthreads();
    {
        f32x4 acc[4][4]; ZERO_ACC4(acc);
        lds_mm<4, 4>((wv < 2) ? S0 : S1, 0, (wv & 1) ? S3 : S2, 0, acc);
        __syncthreads();
#pragma unroll
        for (int mt = 0; mt < 4; ++mt)
#pragma unroll
            for (int nt = 0; nt < 4; ++nt) {
                const int jc = nt * 16 + r, i0 = mt * 16 + 4 * q;
                if (wv == 0) {
                    f32x4 o;
#pragma unroll
                    for (int e = 0; e < 4; ++e) o[e] = (jc < i0 + e) ? acc[mt][nt][e] : 0.f;
                    *(f32x4*)(AABt + jc * 72 + i0) = o;
                } else {
                    bf16_t* dst = (wv == 1) ? S0 : ((wv == 2) ? S2 : S3);
#pragma unroll
                    for (int e = 0; e < 4; ++e) {
                        const bool ok = (wv == 1) ? (jc < i0 + e) : (jc <= i0 + e);
                        dst[(i0 + e) * CH_ROW + jc] = f2bf(ok ? acc[mt][nt][e] : 0.f);
                    }
                }
            }
    }
    __syncthreads();
    {
        f32x4 acc[1][4];
#pragma unroll
        for (int nt = 0; nt < 4; ++nt) acc[0][nt] = (f32x4){0.f, 0.f, 0.f, 0.f};
        lds_mm<1, 4>(S0, 16 * wv, S4, 0, acc);
#pragma unroll
        for (int nt = 0; nt < 4; ++nt)
#pragma unroll
            for (int e = 0; e < 4; ++e) X[(16 * wv + 4 * q + e) * 132 + nt * 16 + r] = acc[0][nt][e];
    }
    __syncthreads();
    if (tid < 128) {
        const int c = tid;
        for (int bi = 0; bi < 4; ++bi) {
            float acc[16];
#pragma unroll
            for (int e = 0; e < 16; ++e) acc[e] = X[(16 * bi + e) * 132 + c];
            for (int jj = 0; jj < 16 * bi; ++jj) {
                const float uj = X[jj * 132 + c];
                const f32x4* ap = (const f32x4*)(AABt + jj * 72 + 16 * bi);
                const f32x4 a0 = ap[0], a1 = ap[1], a2 = ap[2], a3 = ap[3];
#pragma unroll
                for (int e = 0; e < 4; ++e) { acc[e] += a0[e] * uj; acc[4 + e] += a1[e] * uj; acc[8 + e] += a2[e] * uj; acc[12 + e] += a3[e] * uj; }
            }
#pragma unroll
            for (int e = 0; e < 16; ++e) {
                const float u = acc[e];
                X[(16 * bi + e) * 132 + c] = u;
                const f32x4* ap = (const f32x4*)(AABt + (16 * bi + e) * 72 + 16 * bi);
                const f32x4 a0 = ap[0], a1 = ap[1], a2 = ap[2], a3 = ap[3];
#pragma unroll
                for (int e2 = 0; e2 < 16; ++e2) if (e2 > e) acc[e2] += ((e2 < 4) ? a0[e2 & 3] : (e2 < 8) ? a1[e2 & 3] : (e2 < 12) ? a2[e2 & 3] : a3[e2 & 3]) * u;
            }
        }
    }
    __syncthreads();
    if (tid < 128) {
        const int c = tid;
        bf16_t* dst = (c < 64) ? (U0t + c * CH_ROW) : (Aht + (c - 64) * CH_ROW);
        u32x4 ov[8];
#pragma unroll
        for (int g = 0; g < 8; ++g) {
            float v[8];
#pragma unroll
            for (int e = 0; e < 8; ++e) v[e] = X[(g * 8 + e) * 132 + c];
            ov[g].x = (unsigned)f2bf(v[0]) | ((unsigned)f2bf(v[1]) << 16); ov[g].y = (unsigned)f2bf(v[2]) | ((unsigned)f2bf(v[3]) << 16);
            ov[g].z = (unsigned)f2bf(v[4]) | ((unsigned)f2bf(v[5]) << 16); ov[g].w = (unsigned)f2bf(v[6]) | ((unsigned)f2bf(v[7]) << 16);
        }
#pragma unroll
        for (int g = 0; g < 8; ++g) *(u32x4*)(dst + g * 8) = ov[g];
    }
    __syncthreads();
    {
        f32x4 acc[4][4]; ZERO_ACC4(acc);
        if (wv == 0) {
            lds_mm<4, 4>(S5, 0, Aht, 0, acc);
#pragma unroll
            for (int mt = 0; mt < 4; ++mt)
#pragma unroll
                for (int nt = 0; nt < 4; ++nt)
#pragma unroll
                    for (int e = 0; e < 4; ++e) {
                        const int kp = mt * 16 + 4 * q + e, kc = nt * 16 + r;
                        X[kp * 68 + kc] = acc[mt][nt][e] + ((kp == kc) ? GC[kc] : 0.f);
                    }
        } else if (wv == 1) {
            lds_mm<4, 4>(S5, 0, U0t, 0, acc);
            lds_mm<4, 4>(S6, 0, S4, 0, acc);
#pragma unroll
            for (int mt = 0; mt < 4; ++mt)
#pragma unroll
                for (int nt = 0; nt < 4; ++nt) *(f32x4*)(p.NTF + (((base * 4 + nt) * 4 + mt) * 64 + lane) * 4) = acc[mt][nt];
        } else if (wv == 2) {
            lds_mm<4, 4>(S2, 0, Aht, 0, acc);
#pragma unroll
            for (int mt = 0; mt < 4; ++mt)
#pragma unroll
                for (int nt = 0; nt < 4; ++nt)
#pragma unroll
                    for (int e = 0; e < 4; ++e) {
                        const int t = mt * 16 + 4 * q + e, kc = nt * 16 + r;
                        p.QH[(base * 64 + t) * 64 + kc] = f2bf(acc[mt][nt][e] + bf2f(S1[t * CH_ROW + kc]));
                    }
        } else {
            lds_mm<4, 4>(S2, 0, U0t, 0, acc);
            lds_mm<4, 4>(S3, 0, S4, 0, acc);
#pragma unroll
            for (int mt = 0; mt < 4; ++mt)
#pragma unroll
                for (int nt = 0; nt < 4; ++nt)
#pragma unroll
                    for (int e = 0; e < 4; ++e) {
                        const int t = mt * 16 + 4 * q + e; const int tok = 64 * n + (d ? 63 - t : t);
                        p.Y[((size_t)d * MTOT + tok) * RW + h * 64 + nt * 16 + r] = acc[mt][nt][e];
                    }
        }
    }
    __syncthreads();
    for (int u = tid; u < 512; u += NTHREADS) {
        const int tile = u >> 7, s2 = (u >> 6) & 1, ln = u & 63;
        const int kp = tile * 16 + (ln & 15), qq = ln >> 4;
        unsigned hi[4], lo[4];
#pragma unroll
        for (int jp = 0; jp < 4; ++jp) {
            unsigned hh[2], ll[2];
#pragma unroll
            for (int z = 0; z < 2; ++z) {
                const int jj = jp * 2 + z; const int k = 32 * s2 + 16 * (jj >> 2) + 4 * qq + (jj & 3);
                const float v = X[kp * 68 + k]; const bf16_t hb = f2bf(v); const bf16_t lb = f2bf(v - bf2f(hb));
                hh[z] = hb; ll[z] = lb;
            }
            hi[jp] = hh[0] | (hh[1] << 16); lo[jp] = ll[0] | (ll[1] << 16);
        }
        *(u32x4*)(p.MTF + ((((base * 2 + 0) * 4 + tile) * 2 + s2) * 64 + ln) * 8) = (u32x4){hi[0], hi[1], hi[2], hi[3]};
        *(u32x4*)(p.MTF + ((((base * 2 + 1) * 4 + tile) * 2 + s2) * 64 + ln) * 8) = (u32x4){lo[0], lo[1], lo[2], lo[3]};
    }
}

__device__ __forceinline__ void rwkv_seq_load(const P& p, size_t base, int wv, int lane, u32x4 (&mh)[4][2], u32x4 (&ml)[4][2], f32x4 (&nt)[4]) {
#pragma unroll
    for (int tile = 0; tile < 4; ++tile) {
#pragma unroll
        for (int s2 = 0; s2 < 2; ++s2) {
            mh[tile][s2] = *(const u32x4*)(p.MTF + ((((base * 2 + 0) * 4 + tile) * 2 + s2) * 64 + lane) * 8);
            ml[tile][s2] = *(const u32x4*)(p.MTF + ((((base * 2 + 1) * 4 + tile) * 2 + s2) * 64 + lane) * 8);
        }
        nt[tile] = *(const f32x4*)(p.NTF + (((base * 4 + wv) * 4 + tile) * 64 + lane) * 4);
    }
}
__device__ __forceinline__ void rwkv_seq_job(const P& p, int job) {
    const int tid = otid(), lane = tid & 63, wv = tid >> 6, q = lane >> 4, r = lane & 15;
    const int d = job / RH, h = job % RH;
    f32x4 X[4];
#pragma unroll
    for (int kt = 0; kt < 4; ++kt) X[kt] = (f32x4){0.f, 0.f, 0.f, 0.f};
    u32x4 mh[4][2], ml[4][2]; f32x4 nt[4];
    size_t base = (size_t)(d * NC + chunk_order(d, 0)) * RH + h;
    rwkv_seq_load(p, base, wv, lane, mh, ml, nt);
    for (int s = 0; s < NC; ++s) {
        u32x4 mh2[4][2], ml2[4][2]; f32x4 nt2[4];
        const size_t base2 = (size_t)(d * NC + chunk_order(d, (s + 1 < NC) ? s + 1 : s)) * RH + h;
        rwkv_seq_load(p, base2, wv, lane, mh2, ml2, nt2);
        unsigned xh[4][2], xl[4][2];
#pragma unroll
        for (int kt = 0; kt < 4; ++kt) {
            bf16_t hb[4], lb[4];
#pragma unroll
            for (int e = 0; e < 4; ++e) { hb[e] = f2bf(X[kt][e]); lb[e] = f2bf(X[kt][e] - bf2f(hb[e])); }
            xh[kt][0] = (unsigned)hb[0] | ((unsigned)hb[1] << 16); xh[kt][1] = (unsigned)hb[2] | ((unsigned)hb[3] << 16);
            xl[kt][0] = (unsigned)lb[0] | ((unsigned)lb[1] << 16); xl[kt][1] = (unsigned)lb[2] | ((unsigned)lb[3] << 16);
            *(u32x2*)(p.SN + (base * 64 + 16 * wv + r) * 64 + 16 * kt + 4 * q) = (u32x2){xh[kt][0], xh[kt][1]};
        }
        bf16x8 bh[2], bl[2];
#pragma unroll
        for (int s2 = 0; s2 < 2; ++s2) {
            bh[s2] = __builtin_bit_cast(bf16x8, ((u32x4){xh[2 * s2][0], xh[2 * s2][1], xh[2 * s2 + 1][0], xh[2 * s2 + 1][1]}));
            bl[s2] = __builtin_bit_cast(bf16x8, ((u32x4){xl[2 * s2][0], xl[2 * s2][1], xl[2 * s2 + 1][0], xl[2 * s2 + 1][1]}));
        }
#pragma unroll
        for (int tile = 0; tile < 4; ++tile) {
            f32x4 acc = nt[tile];
#pragma unroll
            for (int s2 = 0; s2 < 2; ++s2) {
                const bf16x8 ah = __builtin_bit_cast(bf16x8, mh[tile][s2]), al = __builtin_bit_cast(bf16x8, ml[tile][s2]);
                acc = MFMA16(ah, bh[s2], acc);
                acc = MFMA16(al, bh[s2], acc);
                acc = MFMA16(ah, bl[s2], acc);
            }
            X[tile] = acc;
        }
        base = base2;
#pragma unroll
        for (int tile = 0; tile < 4; ++tile) {
            nt[tile] = nt2[tile];
#pragma unroll
            for (int s2 = 0; s2 < 2; ++s2) { mh[tile][s2] = mh2[tile][s2]; ml[tile][s2] = ml2[tile][s2]; }
        }
    }
}
__device__ __forceinline__ void rwkv_out_job(const P& p, int job) {
    const int tid = otid(), lane = tid & 63, wv = tid >> 6, q = lane >> 4, r = lane & 15;
    const int d = job / (NC * RH), n = (job / RH) % NC, h = job % RH;
    const size_t base = (size_t)(d * NC + n) * RH + h;
    f32x4 acc[4];
#pragma unroll
    for (int nt = 0; nt < 4; ++nt) acc[nt] = (f32x4){0.f, 0.f, 0.f, 0.f};
#pragma unroll
    for (int s2 = 0; s2 < 2; ++s2) {
        const bf16x8 a = *(const bf16x8*)(p.QH + (base * 64 + 16 * wv + r) * 64 + s2 * 32 + q * 8);
#pragma unroll
        for (int nt = 0; nt < 4; ++nt) {
            const bf16x8 b = *(const bf16x8*)(p.SN + (base * 64 + nt * 16 + r) * 64 + s2 * 32 + q * 8);
            acc[nt] = MFMA16(a, b, acc[nt]);
        }
    }
#pragma unroll
    for (int nt = 0; nt < 4; ++nt)
#pragma unroll
        for (int e = 0; e < 4; ++e) {
            const int t = 16 * wv + 4 * q + e; const int tok = 64 * n + (d ? 63 - t : t);
            p.Y[((size_t)d * MTOT + tok) * RW + h * 64 + nt * 16 + r] += acc[nt][e];
        }
}

__device__ __forceinline__ void s5_local_job(const P& p, int job, char* smem, bool with_carry) {
    const int tid = otid();
    const int n = job / SG, g = job % SG;
    float* su = (float*)smem;
    float* xs = su + 1024;
    float* cre = xs + 2 * 64 * 64 * 2;
    float* cim = cre + 1024;
    __syncthreads();
    for (int idx = tid; idx < 1024; idx += NTHREADS) {
        int i = idx >> 4, c = idx & 15;
        su[idx] = bf2f(p.Z[(size_t)(n * 64 + i) * D_IN + ZS5 + g * 16 + c]);
    }
    __syncthreads();
    if (tid < 128) {
        const int d = tid >> 6, st = tid & 63;
        size_t ci = ((size_t)d * SG + g) * 64 + st;
        float are = p.S5A[ci * 2], aim = p.S5A[ci * 2 + 1];
        float bre[16], bim[16];
#pragma unroll
        for (int c = 0; c < 16; ++c) { bre[c] = p.S5BB[(ci * 16 + c) * 2]; bim[c] = p.S5BB[(ci * 16 + c) * 2 + 1]; }
        size_t eo = (((size_t)d * NC + n) * SG + g) * 64 + st;
        float xr = 0.f, xi = 0.f;
        if (with_carry) { xr = p.S5END[eo * 2]; xi = p.S5END[eo * 2 + 1]; }
        for (int ii = 0; ii < 64; ++ii) {
            int i = d ? 63 - ii : ii;
            float ur = 0.f, ui = 0.f;
#pragma unroll
            for (int c = 0; c < 16; ++c) { float u = su[i * 16 + c]; ur += bre[c] * u; ui += bim[c] * u; }
            float nr = are * xr - aim * xi + ur, ni = are * xi + aim * xr + ui;
            xr = nr; xi = ni;
            if (with_carry) { xs[((d * 64 + i) * 64 + st) * 2] = xr; xs[((d * 64 + i) * 64 + st) * 2 + 1] = xi; }
        }
        if (!with_carry) { p.S5END[eo * 2] = xr; p.S5END[eo * 2 + 1] = xi; }
    }
}
__device__ __forceinline__ void s5_out_job(const P& p, int l, int job, char* smem) {
    const int tid = otid();
    const int n = job / SG, g = job % SG;
    float* su = (float*)smem;
    float* xs = su + 1024;
    float* cre = xs + 2 * 64 * 64 * 2;
    float* cim = cre + 1024;
    s5_local_job(p, job, smem, true);
    for (int idx = tid; idx < 1024; idx += NTHREADS) {
        cre[idx] = p.in[I_S5CRE][((size_t)l * SG + g) * 1024 + idx];
        cim[idx] = p.in[I_S5CIM][((size_t)l * SG + g) * 1024 + idx];
    }
    __syncthreads();
    for (int idx = tid; idx < 1024; idx += NTHREADS) {
        int i = idx >> 4, c = idx & 15;
        float a = 0.f;
        for (int st = 0; st < 64; ++st) {
            float xr = xs[((0 * 64 + i) * 64 + st) * 2] + xs[((1 * 64 + i) * 64 + st) * 2];
            float xi = xs[((0 * 64 + i) * 64 + st) * 2 + 1] + xs[((1 * 64 + i) * 64 + st) * 2 + 1];
            a += cre[c * 64 + st] * xr - cim[c * 64 + st] * xi;
        }
        a += p.in[I_S5D][(size_t)l * SW + g * 16 + c] * su[idx];
        p.GY[(size_t)(n * 64 + i) * SW + g * 16 + c] = f2bf(geluf_(a));
    }
    __syncthreads();
}
__device__ __forceinline__ void s5_carry_job(const P& p, int job) {
    int base = job * NTHREADS + otid();
    if (base >= 2 * SG * 64) return;
    int d = base / (SG * 64), g = (base / 64) % SG, st = base % 64;
    size_t ci = ((size_t)d * SG + g) * 64 + st;
    float ar = p.S5A[ci * 2], ai = p.S5A[ci * 2 + 1];
    for (int i = 0; i < 6; ++i) { float nr = ar * ar - ai * ai, ni = 2.f * ar * ai; ar = nr; ai = ni; }
    float cr = 0.f, cim = 0.f;
    for (int s = 0; s < NC; ++s) {
        int n = chunk_order(d, s);
        size_t eo = (((size_t)d * NC + n) * SG + g) * 64 + st;
        float er = p.S5END[eo * 2], ei = p.S5END[eo * 2 + 1];
        p.S5END[eo * 2] = cr; p.S5END[eo * 2 + 1] = cim;
        float nr = ar * cr - ai * cim + er, ni = ar * cim + ai * cr + ei;
        cr = nr; cim = ni;
    }
}

__device__ __forceinline__ void phase_side_elem(const P& p, int l) {
    const int lane = otid() & 63;
    const int gw = (obid() * NTHREADS + otid()) >> 6, nw = (gridDim.x * NTHREADS) >> 6;
    const float* gng = p.in[I_GLA_NG] + (size_t)l * 128;
    const float* lnw = p.in[I_RLNW] + (size_t)l * RW;
    const float* lnb = p.in[I_RLNB] + (size_t)l * RW;
    for (int t = gw; t < MTOT; t += nw) {
        for (int h = 0; h < GH; ++h) {
            float o0 = p.OGLA[(size_t)t * GLA_V + h * 128 + lane], o1 = p.OGLA[(size_t)t * GLA_V + h * 128 + 64 + lane];
            float ss = wave_sum(o0 * o0 + o1 * o1);
            float rstd = rsqrtf(ss / 128.f + 1e-6f);
            float z0 = bf2f(p.Z[(size_t)t * D_IN + ZOG + h * 128 + lane]), z1 = bf2f(p.Z[(size_t)t * D_IN + ZOG + h * 128 + 64 + lane]);
            p.BR[(size_t)t * 3 * BW + h * 128 + lane] = f2bf(o0 * rstd * gng[lane] * siluf_(z0));
            p.BR[(size_t)t * 3 * BW + h * 128 + 64 + lane] = f2bf(o1 * rstd * gng[64 + lane] * siluf_(z1));
        }
        for (int h = 0; h < RH; ++h) {
            int c = h * 64 + lane;
            float y = p.Y[(size_t)t * RW + c] + p.Y[((size_t)MTOT + t) * RW + c];
            float mu = wave_sum(y) * (1.f / 64.f);
            float dv = y - mu;
            float var = wave_sum(dv * dv) * (1.f / 64.f);
            float yn = dv * rsqrtf(var + 64e-5f) * lnw[c] + lnb[c];
            yn += p.BONUS[(size_t)t * RH + h] * bf2f(p.V[(size_t)t * RW + c]);
            p.YN[(size_t)t * RW + c] = yn;
        }
    }
}

__device__ __forceinline__ void phase_side_gemm(const P& p, int l, char* smem) {
    const int ntm = MTOT / 128, nt1 = NPAD(RW) / 128, nt2 = (2 * SW) / 128;
    for (int job = obid(); job < ntm * (nt1 + nt2); job += gridDim.x) {
        const int m0 = (job / (nt1 + nt2)) * 128, jn = job % (nt1 + nt2);
        f32x4 acc[4][4]; ZERO_ACC4(acc);
        if (jn < nt1) {
            const int n0 = jn * 128;
            mfma_gemm_tile(p.WT_G2, 128, p.GS, 128, 128, n0, m0, (bf16_t*)smem, acc);
            FOR_ACC(acc, n0, m0, { if (n < RW) { const float4 y = *(const float4*)(p.YN + (size_t)m * RW + n);
                *(u32x2*)(p.BR + (size_t)m * 3 * BW + BW + n) = pack4(y.x * v[0], y.y * v[1], y.z * v[2], y.w * v[3]); } })
        } else {
            const int n0 = (jn - nt1) * 128;
            mfma_gemm_tile(p.WT_GLU, SW, p.GY, SW, SW, n0, m0, (bf16_t*)smem, acc);
            FOR_ACC(acc, n0, m0, { const unsigned w = (unsigned)f2bf(v[0] * sigmoidf_(v[1])) | ((unsigned)f2bf(v[2] * sigmoidf_(v[3])) << 16);
                *(unsigned*)(p.BR + (size_t)m * 3 * BW + 2 * BW + (n >> 1)) = w; })
        }
    }
}

__device__ __forceinline__ void phase_merge(const P& p, int l, char* smem) {
    const int ntm = MTOT / 128, ntn = D_MODEL / 128;
    for (int job = obid(); job < ntm * ntn; job += gridDim.x) {
        const int m0 = (job / ntn) * 128, n0 = (job % ntn) * 128;
        f32x4 macc[4][4]; ZERO_ACC4(macc);
        for (int b = 0; b < 3; ++b) {
            f32x4 acc[4][4]; ZERO_ACC4(acc);
            mfma_gemm_tile(p.WT_BR + (size_t)b * D_MODEL * BW, BW, p.BR + b * BW, 3 * BW, BW, n0, m0, (bf16_t*)smem, acc);
            const int lane_ = otid() & 63, wave_ = otid() >> 6;
#pragma unroll
            for (int ni = 0; ni < 4; ++ni)
#pragma unroll
                for (int mi = 0; mi < 4; ++mi) {
                    const int n = n0 + (wave_ >> 1) * 64 + ni * 16 + (lane_ >> 4) * 4, m = m0 + (wave_ & 1) * 64 + mi * 16 + (lane_ & 15);
                    const u32x2 g = *(const u32x2*)(p.Z + (size_t)m * D_IN + ZG + b * D_MODEL + n);
                    macc[ni][mi][0] += sigmoidf_(bf2f((bf16_t)(g.x & 0xFFFF))) * acc[ni][mi][0];
                    macc[ni][mi][1] += sigmoidf_(bf2f((bf16_t)(g.x >> 16))) * acc[ni][mi][1];
                    macc[ni][mi][2] += sigmoidf_(bf2f((bf16_t)(g.y & 0xFFFF))) * acc[ni][mi][2];
                    macc[ni][mi][3] += sigmoidf_(bf2f((bf16_t)(g.y >> 16))) * acc[ni][mi][3];
                }
        }
        FOR_ACC(macc, n0, m0, { *(u32x2*)(p.M + (size_t)m * D_MODEL + n) = pack4(v[0], v[1], v[2], v[3]); })
    }
}

__device__ __forceinline__ void phase_outproj(const P& p, int l, char* smem) {
    const int ntm = MTOT / 128, ntn = D_MODEL / 128;
    for (int job = obid(); job < ntm * ntn; job += gridDim.x) {
        const int m0 = (job / ntn) * 128, n0 = (job % ntn) * 128;
        f32x4 acc[4][4]; ZERO_ACC4(acc);
        mfma_gemm_tile(p.WT_OUT, D_MODEL, p.M, D_MODEL, D_MODEL, n0, m0, (bf16_t*)smem, acc);
        FOR_ACC(acc, n0, m0, { const float* g1 = p.MOD + (size_t)(l * 2 + (m >= CTX ? 1 : 0)) * 6 * D_MODEL + 2 * D_MODEL + n;
            float4* xp = (float4*)(p.X + (size_t)m * D_MODEL + n); float4 x = *xp;
            x.x += g1[0] * v[0]; x.y += g1[1] * v[1]; x.z += g1[2] * v[2]; x.w += g1[3] * v[3]; *xp = x; })
    }
}

__device__ __forceinline__ void store_q_hilo(const P& p, int m, int n, const f32x4 v) {
    const bf16_t h0 = f2bf(v[0]), h1 = f2bf(v[1]), h2 = f2bf(v[2]), h3 = f2bf(v[3]);
    u32x2 hv; hv.x = (unsigned)h0 | ((unsigned)h1 << 16); hv.y = (unsigned)h2 | ((unsigned)h3 << 16);
    *(u32x2*)(p.QHI + (size_t)m * PQ + n) = hv;
    *(u32x2*)(p.QLO + (size_t)m * PQ + n) = pack4(v[0] - bf2f(h0), v[1] - bf2f(h1), v[2] - bf2f(h2), v[3] - bf2f(h3));
}
__device__ __forceinline__ void phase_peer_q(const P& p, int l, char* smem) {
    const int ntm = MTOT / 128, ntn = PQ / 128;
    for (int job = obid(); job < ntm * ntn; job += gridDim.x) {
        const int m0 = (job / ntn) * 128, n0 = (job % ntn) * 128;
        f32x4 acc[4][4]; ZERO_ACC4(acc);
        mfma_gemm_tile(p.WT_Q, D_MODEL, p.H, D_MODEL, D_MODEL, n0, m0, (bf16_t*)smem, acc);
        FOR_ACC(acc, n0, m0, { store_q_hilo(p, m, n, v); })
    }
}

__device__ __forceinline__ void phase_peer_topk(const P& p, int l, char* smem) {
    const int tid = otid(), lane = tid & 63, wv = tid >> 6, q = lane >> 4, r = lane & 15;
    float* sc = (float*)smem + wv * 4480;
    float* s1t = sc + 4096; float* s2t = s1t + 16; int* i1t = (int*)(s2t + 16); int* i2t = i1t + 16;
    float* cvv = s2t + 48; int* cii = (int*)(cvv + 64); float* tpv = cvv + 128; int* tpe = (int*)(tpv + 16);
    int pi = 0, pj = 0; bool pact = false;
    {
        int cnt = 0;
        for (int i = 0; i < 16; ++i) { const int nj = 16 / (i + 1); if (lane >= cnt && lane < cnt + nj) { pi = i; pj = lane - cnt; pact = true; } cnt += nj; }
    }
    const int gw = (obid() * NTHREADS + tid) >> 6, nw = (gridDim.x * NTHREADS) >> 6;
    for (int job = gw; job < (MTOT / 16) * PH; job += nw) {
        const int t0 = (job / PH) * 16, h = job % PH;
#pragma unroll
        for (int sd = 0; sd < 2; ++sd) {
            f32x4 acc[8];
#pragma unroll
            for (int nt = 0; nt < 8; ++nt) acc[nt] = (f32x4){0.f, 0.f, 0.f, 0.f};
#pragma unroll
            for (int ks = 0; ks < 4; ++ks) {
                const size_t qo = (size_t)(t0 + r) * PQ + h * 256 + sd * 128 + ks * 32 + q * 8;
                const bf16x8 ah = *(const bf16x8*)(p.QHI + qo), al = *(const bf16x8*)(p.QLO + qo);
#pragma unroll
                for (int nt = 0; nt < 8; ++nt) {
                    const size_t ko = ((size_t)(h * 2 + sd) * 128 + nt * 16 + r) * 128 + ks * 32 + q * 8;
                    const bf16x8 bh = *(const bf16x8*)(p.KHI + ko), bl = *(const bf16x8*)(p.KLO + ko);
                    acc[nt] = MFMA16(ah, bh, acc[nt]);
                    acc[nt] = MFMA16(al, bh, acc[nt]);
                    acc[nt] = MFMA16(ah, bl, acc[nt]);
                }
            }
#pragma unroll
            for (int nt = 0; nt < 8; ++nt)
#pragma unroll
                for (int e = 0; e < 4; ++e) sc[((4 * q + e) * 2 + sd) * 128 + nt * 16 + r] = acc[nt][e];
        }
        WAVE_SYNC();
        for (int tt = 0; tt < 16; ++tt) {
#pragma unroll
            for (int sd = 0; sd < 2; ++sd) {
                const float* sv = sc + (tt * 2 + sd) * 128;
                const float v0 = sv[lane], v1 = sv[lane + 64];
                int r0 = 0, r1 = 0;
                for (int k4 = 0; k4 < 32; ++k4) {
                    const f32x4 o = *(const f32x4*)(sv + k4 * 4);
#pragma unroll
                    for (int e = 0; e < 4; ++e) {
                        const int oi = k4 * 4 + e;
                        r0 += (o[e] > v0 || (o[e] == v0 && oi < lane)) ? 1 : 0;
                        r1 += (o[e] > v1 || (o[e] == v1 && oi < lane + 64)) ? 1 : 0;
                    }
                }
                float* st = sd ? s2t : s1t; int* it = sd ? i2t : i1t;
                if (r0 < 16) { st[r0] = v0; it[r0] = lane; }
                if (r1 < 16) { st[r1] = v1; it[r1] = lane + 64; }
            }
            WAVE_SYNC();
            const float cv = pact ? (s1t[pi] + s2t[pj]) : -3.0e38f;
            const int ci = pact ? (pi * 16 + pj) : (1024 + lane);
            cvv[lane] = cv; cii[lane] = ci;
            WAVE_SYNC();
            int rk = 0;
            for (int k4 = 0; k4 < 16; ++k4) {
                const f32x4 o = *(const f32x4*)(cvv + k4 * 4);
#pragma unroll
                for (int e = 0; e < 4; ++e) { const int oi = cii[k4 * 4 + e]; rk += (o[e] > cv || (o[e] == cv && oi < ci)) ? 1 : 0; }
            }
            if (rk < 16) { tpv[rk] = cv; tpe[rk] = i1t[pi] * 128 + i2t[pj]; }
            WAVE_SYNC();
            const float tv = tpv[lane & 15], mx = tpv[0];
            float e = expf(tv - mx);
            float sum = e;
            sum += __shfl_xor(sum, 1, 64); sum += __shfl_xor(sum, 2, 64); sum += __shfl_xor(sum, 4, 64); sum += __shfl_xor(sum, 8, 64);
            if (lane < 16) {
                p.IDX[(size_t)(t0 + tt) * PH * 16 + h * 16 + lane] = tpe[lane];
                p.G[(size_t)(t0 + tt) * PH * 16 + h * 16 + lane] = e / sum;
            }
            WAVE_SYNC();
        }
    }
}

#define PEER_CONV_JOBS (2 * NEXP * D_MODEL / 2048)
__device__ __forceinline__ void peer_conv_job(const P& p, int l, int job) {
    const int tid = otid();
    const int which = job / (NEXP * D_MODEL / 2048);
    const size_t e0 = (size_t)(job % (NEXP * D_MODEL / 2048)) * 2048 + tid * 8;
    const float* src = p.in[which ? I_PV : I_PU] + (size_t)l * NEXP * D_MODEL + e0;
    bf16_t* dst = (which ? p.VB : p.UB) + e0;
    const float4 a = *(const float4*)src, b = *(const float4*)(src + 4);
    u32x4 o; o.x = (unsigned)f2bf(a.x) | ((unsigned)f2bf(a.y) << 16); o.y = (unsigned)f2bf(a.z) | ((unsigned)f2bf(a.w) << 16);
    o.z = (unsigned)f2bf(b.x) | ((unsigned)f2bf(b.y) << 16); o.w = (unsigned)f2bf(b.z) | ((unsigned)f2bf(b.w) << 16);
    *(u32x4*)dst = o;
}
#define LO16(x) __builtin_bit_cast(float, (x) << 16)
#define HI16(x) __builtin_bit_cast(float, (x) & 0xFFFF0000u)
#define GNV ((D_MODEL + 511) / 512)
struct GBuf { u32x4 u[4][GNV]; u32x4 v[4][GNV]; float gg[4]; };
__device__ __forceinline__ void gather_load(const P& p, GBuf& b, int g, int idx0, int idx1, float g0, float g1, int lane) {
#pragma unroll
    for (int q = 0; q < 4; ++q) {
        const int k = g * 4 + q;
        const int ei = __shfl((k < 64) ? idx0 : idx1, k & 63, 64);
        b.gg[q] = __shfl((k < 64) ? g0 : g1, k & 63, 64);
#pragma unroll
        for (int c = 0; c < GNV; ++c) {
            const bool act = (c * 512 + lane * 8) < D_MODEL;
            b.u[q][c] = act ? *(const u32x4*)(p.UB + (size_t)ei * D_MODEL + c * 512 + lane * 8) : (u32x4){0u, 0u, 0u, 0u};
            b.v[q][c] = act ? *(const u32x4*)(p.VB + (size_t)ei * D_MODEL + c * 512 + lane * 8) : (u32x4){0u, 0u, 0u, 0u};
        }
    }
}
__device__ __forceinline__ void gather_compute(const GBuf& b, const float (&hv)[GNV][8], float (&acc)[GNV][8]) {
    float dt[4];
#pragma unroll
    for (int q = 0; q < 4; ++q) {
        float d = 0.f;
#pragma unroll
        for (int c = 0; c < GNV; ++c) {
            d += hv[c][0] * LO16(b.u[q][c].x) + hv[c][1] * HI16(b.u[q][c].x) + hv[c][2] * LO16(b.u[q][c].y) + hv[c][3] * HI16(b.u[q][c].y)
               + hv[c][4] * LO16(b.u[q][c].z) + hv[c][5] * HI16(b.u[q][c].z) + hv[c][6] * LO16(b.u[q][c].w) + hv[c][7] * HI16(b.u[q][c].w);
        }
        dt[q] = d;
    }
#pragma unroll
    for (int m = 32; m >= 1; m >>= 1) {
#pragma unroll
        for (int q = 0; q < 4; ++q) dt[q] += __shfl_xor(dt[q], m, 64);
    }
#pragma unroll
    for (int q = 0; q < 4; ++q) {
        const float coef = b.gg[q] * geluf_(dt[q]);
#pragma unroll
        for (int c = 0; c < GNV; ++c) {
            acc[c][0] += coef * LO16(b.v[q][c].x); acc[c][1] += coef * HI16(b.v[q][c].x); acc[c][2] += coef * LO16(b.v[q][c].y); acc[c][3] += coef * HI16(b.v[q][c].y);
            acc[c][4] += coef * LO16(b.v[q][c].z); acc[c][5] += coef * HI16(b.v[q][c].z); acc[c][6] += coef * LO16(b.v[q][c].w); acc[c][7] += coef * HI16(b.v[q][c].w);
        }
    }
}
__device__ __forceinline__ void phase_peer_gather(const P& p, int l) {
    const int lane = otid() & 63;
    const int gw = (obid() * NTHREADS + otid()) >> 6, nw = (gridDim.x * NTHREADS) >> 6;
    constexpr int NG = PH * 16 / 4;
    for (int t = gw; t < MTOT; t += nw) {
        float hv[GNV][8], acc[GNV][8];
#pragma unroll
        for (int c = 0; c < GNV; ++c) {
            const bool act = (c * 512 + lane * 8) < D_MODEL;
            const u32x4 z4 = {0u, 0u, 0u, 0u};
            const u32x4 h4 = act ? *(const u32x4*)(p.H + (size_t)t * D_MODEL + c * 512 + lane * 8) : z4;
            hv[c][0] = LO16(h4.x); hv[c][1] = HI16(h4.x); hv[c][2] = LO16(h4.y); hv[c][3] = HI16(h4.y);
            hv[c][4] = LO16(h4.z); hv[c][5] = HI16(h4.z); hv[c][6] = LO16(h4.w); hv[c][7] = HI16(h4.w);
#pragma unroll
            for (int j = 0; j < 8; ++j) acc[c][j] = 0.f;
        }
        int idx0 = 0, idx1 = 0; float g0 = 0.f, g1 = 0.f;
        if (lane < PH * 16) { idx0 = p.IDX[(size_t)t * PH * 16 + lane]; g0 = p.G[(size_t)t * PH * 16 + lane]; }
        if (64 + lane < PH * 16) { idx1 = p.IDX[(size_t)t * PH * 16 + 64 + lane]; g1 = p.G[(size_t)t * PH * 16 + 64 + lane]; }
        GBuf ba, bb;
        gather_load(p, ba, 0, idx0, idx1, g0, g1, lane);
        for (int g = 0; g < NG; g += 2) {
            gather_load(p, bb, g + 1, idx0, idx1, g0, g1, lane);
            gather_compute(ba, hv, acc);
            if (g + 2 < NG) gather_load(p, ba, g + 2, idx0, idx1, g0, g1, lane);
            gather_compute(bb, hv, acc);
        }
        const float* g2 = p.MOD + (size_t)(l * 2 + (t >= CTX ? 1 : 0)) * 6 * D_MODEL + 5 * D_MODEL;
#pragma unroll
        for (int c = 0; c < GNV; ++c) if ((c * 512 + lane * 8) < D_MODEL) {
            float* xp = p.X + (size_t)t * D_MODEL + c * 512 + lane * 8;
            const float* gp = g2 + c * 512 + lane * 8;
            float4 x0 = *(float4*)xp, x1 = *(float4*)(xp + 4);
            x0.x += gp[0] * acc[c][0]; x0.y += gp[1] * acc[c][1]; x0.z += gp[2] * acc[c][2]; x0.w += gp[3] * acc[c][3];
            x1.x += gp[4] * acc[c][4]; x1.y += gp[5] * acc[c][5]; x1.z += gp[6] * acc[c][6]; x1.w += gp[7] * acc[c][7];
            *(float4*)xp = x0; *(float4*)(xp + 4) = x1;
        }
    }
}

__device__ __forceinline__ void phase_final(const P& p) {
    const int lane = otid() & 63;
    const int gw = (obid() * NTHREADS + otid()) >> 6, nw = (gridDim.x * NTHREADS) >> 6;
    const float* g = p.in[I_FG];
    for (int t = gw; t < SEQ; t += nw) {
        const float* x = p.X + (size_t)(CTX + t) * D_MODEL;
        float v[D_MODEL / 64]; float ss = 0.f;
#pragma unroll
        for (int j = 0; j < D_MODEL / 64; ++j) { v[j] = x[lane + 64 * j]; ss += v[j] * v[j]; }
        ss = wave_sum(ss);
        float rstd = rsqrtf(ss / D_MODEL + 1e-6f);
#pragma unroll
        for (int j = 0; j < D_MODEL / 64; ++j) p.out[(size_t)t * D_MODEL + lane + 64 * j] = v[j] * rstd * g[lane + 64 * j];
    }
}

__global__ void __launch_bounds__(NTHREADS) fwd_megakernel(P p) {
#ifdef EMU
    char* smem = emu_smem();
#else
    __shared__ __attribute__((aligned(16))) char smem_raw[SMEM_BYTES + 16];
    char* smem = smem_raw;
#endif
#ifndef EMU
    volatile LAS unsigned* xst = (volatile LAS unsigned*)(smem_raw + SMEM_BYTES);
    if (threadIdx.x == 0) { xst[0] = 0u; xst[1] = 0u; xst[2] = 0u; xst[3] = 0u; }
    __syncthreads();
    XcdBarrier xb = xcd_barrier_post(p.bar, xst);
#endif
    phase_init(p, smem);
#ifndef EMU
    cg::this_grid().sync();
#endif
    GRID_SYNC();
    for (int l = 0; l < DEPTH; ++l) {
        phase_norm(p, l, 0);
        phase_s5const(p, l);
        phase_convert_weights(p, l, smem);
        GRID_SYNC();
        phase_gemm_in(p, l, smem);
        GRID_SYNC();
        phase_rwkv_prep(p, l, smem);
        GRID_SYNC();
        for (int job = obid(); job < 2 * NC * RH; job += gridDim.x) rwkv_chunk_job(p, job, smem);
        __syncthreads();
        phase_gla_kv(p, l, smem);
        for (int job = obid(); job < NC * SG; job += gridDim.x) s5_local_job(p, job, smem, false);
        __syncthreads();
        GRID_SYNC();
        {
            const int n_rw = 2 * RH, n_gla = 2 * GH * 8192 / NTHREADS, n_s5 = (2 * SG * 64 + NTHREADS - 1) / NTHREADS;
            for (int job = obid(); job < n_rw + n_gla + n_s5 + PEER_CONV_JOBS; job += gridDim.x) {
                if (job < n_rw) rwkv_seq_job(p, job);
                else if (job < n_rw + n_gla) gla_scan_job(p, job - n_rw);
                else if (job < n_rw + n_gla + n_s5) s5_carry_job(p, job - n_rw - n_gla);
                else peer_conv_job(p, l, job - n_rw - n_gla - n_s5);
            }
        }
        GRID_SYNC();
        for (int job = obid(); job < 2 * NC * RH; job += gridDim.x) rwkv_out_job(p, job);
        phase_gla_out(p, l, smem);
        for (int job = obid(); job < NC * SG; job += gridDim.x) s5_out_job(p, l, job, smem);
        GRID_SYNC();
        phase_side_elem(p, l);
        GRID_SYNC();
        phase_side_gemm(p, l, smem);
        GRID_SYNC();
        phase_merge(p, l, smem);
        GRID_SYNC();
        phase_outproj(p, l, smem);
        GRID_SYNC();
        phase_norm(p, l, 1);
        GRID_SYNC();
        phase_peer_q(p, l, smem);
        GRID_SYNC();
        phase_peer_topk(p, l, smem);
        GRID_SYNC();
        phase_peer_gather(p, l);
        GRID_SYNC();
    }
    phase_final(p);
}

static inline size_t align_up(size_t x) { return (x + 255) & ~(size_t)255; }

extern "C" void kernel_launch(void* const* d_in, const int* in_sizes, int n_in, void* d_out, int out_size, void* d_ws, size_t ws_size, hipStream_t stream) {
    P p;
    memset(&p, 0, sizeof(p));
    for (int i = 0; i < 39; ++i) p.in[i] = (const float*)d_in[i];
    p.out = (float*)d_out;
    char* w = (char*)d_ws; size_t off = 0;
    auto take = [&](size_t bytes) { void* r = w + off; off = align_up(off + bytes); return r; };
    p.bar = (unsigned*)take(16384);
    p.X = (float*)take((size_t)MTOT * D_MODEL * 4);
    p.H = (bf16_t*)take((size_t)MTOT * D_MODEL * 2);
    p.MOD = (float*)take((size_t)DEPTH * 2 * 6 * D_MODEL * 4);
    p.Z = (bf16_t*)take((size_t)MTOT * D_IN * 2);
    p.V = (bf16_t*)take((size_t)MTOT * RW * 2);
    {
        char* ra = (char*)take((size_t)MTOT * RW * 2 * 2 > (size_t)MTOT * GLA_V * 4 ? (size_t)MTOT * RW * 2 * 2 : (size_t)MTOT * GLA_V * 4);
        p.R = (bf16_t*)ra; p.KK = (bf16_t*)(ra + (size_t)MTOT * RW * 2);
        p.OGLA = (float*)ra;
    }
    {
        char* rb = (char*)take((size_t)2 * MTOT * RW * 2 > (size_t)2 * MTOT * PH * 16 * 4 ? (size_t)2 * MTOT * RW * 2 : (size_t)2 * MTOT * PH * 16 * 4);
        p.KD = (bf16_t*)rb;
        p.IDX = (int*)rb; p.G = (float*)(rb + (size_t)MTOT * PH * 16 * 4);
    }
    p.BB = (bf16_t*)take((size_t)2 * MTOT * RW * 2);
    p.LW = (float*)take((size_t)2 * MTOT * RW * 4);
    p.BONUS = (float*)take((size_t)MTOT * RH * 4);
    p.GS = (bf16_t*)take((size_t)MTOT * 128 * 2);
    p.Y = (float*)take((size_t)2 * MTOT * RW * 4);
    p.KV = (float*)take((size_t)2 * NC * GH * 8192 * 4);
    p.DEC = (float*)take((size_t)2 * NC * GH * 64 * 4);
    p.S5A = (float*)take((size_t)2 * SG * 64 * 2 * 4);
    p.S5BB = (float*)take((size_t)2 * SG * 64 * 16 * 2 * 4);
    p.S5END = (float*)take((size_t)2 * NC * SG * 64 * 2 * 4);
    {
        const size_t szc1 = (size_t)2 * NC * RH * 8192 * 2 + (size_t)2 * NC * RH * 4096 * 4;
        const size_t szc2 = (size_t)MTOT * SW * 2 + (size_t)MTOT * RW * 4 + (size_t)MTOT * 3 * BW * 2 + (size_t)MTOT * D_MODEL * 2 + 1024;
        char* rc = (char*)take(szc1 > szc2 ? szc1 : szc2);
        p.MTF = (bf16_t*)rc; p.NTF = (float*)(rc + (size_t)2 * NC * RH * 8192 * 2);
        char* c2 = rc;
        p.GY = (bf16_t*)c2; c2 += align_up((size_t)MTOT * SW * 2);
        p.YN = (float*)c2; c2 += align_up((size_t)MTOT * RW * 4);
        p.BR = (bf16_t*)c2; c2 += align_up((size_t)MTOT * 3 * BW * 2);
        p.M = (bf16_t*)c2;
    }
    p.SN = (bf16_t*)take((size_t)2 * NC * RH * 4096 * 2);
    p.QH = (bf16_t*)take((size_t)2 * NC * RH * 4096 * 2);
    p.WT_IN = (bf16_t*)take((size_t)NPAD(D_IN) * D_MODEL * 2);
    p.WT_G2 = (bf16_t*)take((size_t)NPAD(RW) * 128 * 2);
    p.WT_GLU = (bf16_t*)take((size_t)NPAD(2 * SW) * SW * 2);
    p.WT_BR = (bf16_t*)take((size_t)3 * D_MODEL * BW * 2);
    p.WT_OUT = (bf16_t*)take((size_t)D_MODEL * D_MODEL * 2);
    p.WT_Q = (bf16_t*)take((size_t)PQ * D_MODEL * 2);
    p.UB = (bf16_t*)take((size_t)NEXP * D_MODEL * 2);
    p.VB = (bf16_t*)take((size_t)NEXP * D_MODEL * 2);
    p.QHI = p.Z; p.QLO = p.Z + (size_t)MTOT * PQ;
    p.KHI = (bf16_t*)take((size_t)PH * 2 * 128 * 128 * 2); p.KLO = (bf16_t*)take((size_t)PH * 2 * 128 * 128 * 2);
    static_assert((size_t)PQ * 4 <= (size_t)D_IN * 2, "Q alias");
    if (off > ws_size) { fprintf(stderr, "ws too small: need %zu have %zu\n", off, ws_size); return; }
#ifdef EMU
    fprintf(stderr, "ws used %zu MB\n", off >> 20);
    emu_launch([=] { fwd_megakernel(p); }, EMU_GRID, NTHREADS);
#else
    hipMemsetAsync(p.bar, 0, 16384, stream);
    static int grid_blocks = 0;
    if (!grid_blocks) {
        int dev = 0, cus = 0, per_cu = 0;
        hipGetDevice(&dev);
        hipDeviceGetAttribute(&cus, hipDeviceAttributeMultiprocessorCount, dev);
        hipOccupancyMaxActiveBlocksPerMultiprocessor(&per_cu, fwd_megakernel, NTHREADS, 0);
        if (per_cu > 1) per_cu = 1;
        grid_blocks = cus * per_cu;
    }
    void* args[] = {&p};
    hipError_t e = hipLaunchCooperativeKernel((void*)fwd_megakernel, dim3(grid_blocks), dim3(NTHREADS), args, 0, stream);
    if (e != hipSuccess) fprintf(stderr, "cooperative launch failed: %s (grid %d)\n", hipGetErrorString(e), grid_blocks);
#endif
}
```

```cpp
#include <hip/hip_runtime.h>
#ifndef EMU
#include <hip/hip_cooperative_groups.h>
namespace cg = cooperative_groups;
#endif
#include <cstdio>
#include <cstdint>
#include <cstring>

#ifdef CFG_SMALL
#define D_MODEL 128
#define SEQ 512
#define DEPTH 2
#define GRID_W 8
#define CTX 128
#define GH 1
#define RH 2
#define SG 8
#define PH 2
#else
#define D_MODEL 1024
#define SEQ 16384
#define DEPTH 4
#define GRID_W 64
#define CTX 256
#define GH 4
#define RH 8
#define SG 32
#define PH 8
#endif
#define MTOT (CTX + SEQ)
#define ROWS (SEQ / GRID_W)
#define GLA_K (GH * 64)
#define GLA_V (GH * 128)
#define RW (RH * 64)
#define RWKV_IN (3 * RW + 4 * 64 + 128)
#define SW (SG * 16)
#define BW GLA_V
#define ZQ 0
#define ZK (GLA_K)
#define ZV (2 * GLA_K)
#define ZOG (ZV + GLA_V)
#define ZAF (ZOG + GLA_V)
#define ZAB (ZAF + 16)
#define ZR (ZAB + 16)
#define ZS5 (ZR + RWKV_IN)
#define ZG (ZS5 + SW)
#define D_IN (ZG + 3 * D_MODEL)
#define NC (MTOT / 64)
#define NCC (CTX / 64)
#define RB (ROWS / 64)
#define PQ (PH * 256)
#define NEXP 16384
#define NTHREADS 256
#define SMEM_BYTES 133120

typedef unsigned short bf16_t;
typedef short bf16x8 __attribute__((ext_vector_type(8)));
typedef float f32x4 __attribute__((ext_vector_type(4)));
typedef unsigned u32x4 __attribute__((ext_vector_type(4)));
typedef unsigned u32x2 __attribute__((ext_vector_type(2)));
#ifdef EMU
#define MFMA16(a, b, c) emu_mfma_16x16x32_bf16(a, b, c)
#else
#define MFMA16(a, b, c) __builtin_amdgcn_mfma_f32_16x16x32_bf16(a, b, c, 0, 0, 0)
#endif
typedef float f32x2 __attribute__((ext_vector_type(2)));
#ifdef EMU
#define CVT_PK_FP8(a, b, old, hi) emu_cvt_pk_fp8_f32(a, b, old, hi)
#define CVT_PK_F32_FP8(w, hi) emu_cvt_pk_f32_fp8(w, hi)
#else
#define CVT_PK_FP8(a, b, old, hi) __builtin_amdgcn_cvt_pk_fp8_f32(a, b, old, hi)
#define CVT_PK_F32_FP8(w, hi) __builtin_amdgcn_cvt_pk_f32_fp8(w, hi)
#endif
#define NPAD(n) (((n) + 127) / 128 * 128)

__device__ __forceinline__ float bf2f(bf16_t h) { return __builtin_bit_cast(float, ((unsigned)h) << 16); }
__device__ __forceinline__ bf16_t f2bf(float f) { unsigned u = __builtin_bit_cast(unsigned, f); u += 0x7FFFu + ((u >> 16) & 1u); return (bf16_t)(u >> 16); }
#ifdef EMU
#define fexp_(x) expf(x)
#else
#define fexp_(x) __expf(x)
#endif
#define LO16(x) __builtin_bit_cast(float, (x) << 16)
#define HI16(x) __builtin_bit_cast(float, (x) & 0xFFFF0000u)
__device__ __forceinline__ float sigmoidf_(float x) { return 1.0f / (1.0f + expf(-x)); }
__device__ __forceinline__ float siluf_(float x) { return x * sigmoidf_(x); }
__device__ __forceinline__ float geluf_(float x) { const float y = 1.5957691216057308f * (x + 0.044715f * x * x * x); return x / (1.0f + fexp_(-y)); }
__device__ __forceinline__ float softplusf_(float x) { return fmaxf(x, 0.f) + log1pf(expf(-fabsf(x))); }
__device__ __forceinline__ float wave_sum(float v) {
#pragma unroll
    for (int m = 32; m >= 1; m >>= 1) v += __shfl_xor(v, m, 64);
    return v;
}

struct P {
    const float* in[39];
    float* out;
    float* X;
    bf16_t* H;
    bf16_t* Z;
    float* MOD;
    bf16_t* R; bf16_t* V; bf16_t* KK; bf16_t* KD; bf16_t* BB;
    float* LW;
    bf16_t* MTF;
    float* NTF;
    bf16_t* SN;
    bf16_t* QH;
    float* BONUS;
    bf16_t* KS;
    bf16_t* LR;
    bf16_t* WT_W2;
    bf16_t* WT_A2;
    bf16_t* GS;
    float* Y;
    float* KV;
    bf16_t* SP;
    float* DEC;
    float* OGLA;
    float* S5A;
    float* S5BB;
    float* S5END;
    bf16_t* GY;
    float* YN;
    bf16_t* BR;
    bf16_t* M;
    bf16_t* QHI; bf16_t* QLO;
    bf16_t* KHI; bf16_t* KLO;
    int* IDX;
    float* G;
    float* GU;
    unsigned* bar;
    bf16_t* WT_IN;
    bf16_t* WT_G2;
    bf16_t* WT_GLU;
    bf16_t* WT_BR;
    bf16_t* WT_OUT;
    bf16_t* WT_Q;
    unsigned char* U8; unsigned char* V8;
    float* USC; float* VSC;
};

enum { I_X = 0, I_C, I_CTX, I_CCTX, I_WMOD, I_BMOD, I_N1G, I_N2G, I_WIN, I_GLA_WA2, I_GLA_BA, I_GLA_NG, I_RCONV, I_RW0, I_RW2, I_RA0, I_RA2, I_RG2,
       I_RKK, I_RKA, I_RRK, I_RLNW, I_RLNB, I_S5LRE, I_S5LIM, I_S5LS, I_S5BRE, I_S5BIM, I_S5CRE, I_S5CIM, I_S5D, I_S5GLU, I_WBR, I_WOUT, I_PWQ, I_PKEYS, I_PU, I_PV, I_FG };

#ifdef EMU
__device__ __forceinline__ int otid() { return threadIdx.x; }
__device__ __forceinline__ int obid() { return blockIdx.x; }
#else
__device__ __forceinline__ int otid() { int t = threadIdx.x; asm volatile("" : "+v"(t)); return t; }
__device__ __forceinline__ int obid() { int b = blockIdx.x; asm volatile("" : "+s"(b)); return b; }
#endif
#ifdef EMU
#define WAVE_SYNC() emu_wave_barrier()
#ifndef EMU_GRID
#define EMU_GRID 4
#endif
#else
#define WAVE_SYNC() __builtin_amdgcn_wave_barrier()
#endif
#ifndef EMU
#define XB_TMO      128
#define XB_XCNT(j)  (256  + 64 * (j))
#define XB_XSUB(j)  (1280 + 64 * (j))
#define XB_XGEN(j)  (2304 + 64 * (j))
#define XB_TOP      3328
#define XB_TOPGEN   3392
#define XCD_BAR_WORDS 3456
#define XB_SPIN_CAP (1u << 22)
#define LAS __attribute__((address_space(3)))
__device__ __forceinline__ unsigned xb_ld(unsigned* p)              { return __hip_atomic_load(p, __ATOMIC_RELAXED, __HIP_MEMORY_SCOPE_AGENT); }
__device__ __forceinline__ unsigned xb_add(unsigned* p, unsigned v) { return __hip_atomic_fetch_add(p, v, __ATOMIC_RELAXED, __HIP_MEMORY_SCOPE_AGENT); }
__device__ __forceinline__ unsigned xb_xcc_id() { return (unsigned)__builtin_amdgcn_s_getreg((3 << 11) | 20) & 0xFu; }
#define XB_SPIN(cond, bar) do { unsigned _sp = 0; while (cond) { __builtin_amdgcn_s_sleep(1); \
    if ((++_sp & 255u) == 0u) { if (xb_ld(&(bar)[XB_TMO])) break; if (_sp > XB_SPIN_CAP) { atomicAdd(&(bar)[XB_TMO], 1u); break; } } } } while (0)
struct XcdBarrier { unsigned* bar; unsigned x; volatile LAS unsigned* st; };
__device__ __forceinline__ XcdBarrier xcd_barrier_post(unsigned* bar, volatile LAS unsigned* st) {
    XcdBarrier b; b.bar = bar; b.x = xb_xcc_id(); b.st = st;
    if (threadIdx.x == 0) (void)xb_add(&bar[XB_XCNT(b.x)], 1u);
    return b;
}
__device__ __forceinline__ void xcd_barrier_complete(unsigned* bar, unsigned x, unsigned& nloc, unsigned& nx) {
    const unsigned G = gridDim.x * gridDim.y * gridDim.z;
    unsigned sum, cnt, mine, sp = 0u;
    for (;;) {
        sum = 0u; cnt = 0u; mine = 0u;
#pragma unroll
        for (unsigned j = 0; j < 16; ++j) { const unsigned c = xb_ld(&bar[XB_XCNT(j)]); sum += c; cnt += (c > 0u) ? 1u : 0u; mine = (j == x) ? c : mine; }
        if (sum == G) break;
        __builtin_amdgcn_s_sleep(1);
        if ((++sp & 255u) == 0u) { if (xb_ld(&bar[XB_TMO])) break; if (sp > XB_SPIN_CAP) { atomicAdd(&bar[XB_TMO], 1u); break; } }
    }
    nloc = mine > 0u ? mine : 1u; nx = cnt > 0u ? cnt : 1u;
}
__device__ __forceinline__ void xcd_barrier(const XcdBarrier& b) {
    asm volatile("s_waitcnt vmcnt(0)" ::: "memory");
    __syncthreads();
    if (threadIdx.x == 0) {
        unsigned* bar = b.bar;
        __builtin_amdgcn_s_waitcnt(0);
        unsigned nloc = b.st[0], nx = b.st[1];
        if (nloc == 0u) { xcd_barrier_complete(bar, b.x, nloc, nx); b.st[0] = nloc; b.st[1] = nx; }
        const unsigned old = xb_add(&bar[XB_XSUB(b.x)], 1u);
        const unsigned gen = old / nloc;
        if (old + 1u == (gen + 1u) * nloc) {
            __builtin_amdgcn_fence(__ATOMIC_RELEASE, "agent");
            asm volatile("s_waitcnt vmcnt(0)" ::: "memory");
            const unsigned og = xb_add(&bar[XB_TOP], 1u);
            const unsigned tg = og / nx;
            if (og + 1u == (tg + 1u) * nx) xb_add(&bar[XB_TOPGEN], 1u);
            else XB_SPIN(xb_ld(&bar[XB_TOPGEN]) == tg, bar);
            __builtin_amdgcn_fence(__ATOMIC_ACQUIRE, "agent");
            xb_add(&bar[XB_XGEN(b.x)], 1u);
            asm volatile("s_waitcnt vmcnt(0)" ::: "memory");
        } else {
            XB_SPIN(xb_ld(&bar[XB_XGEN(b.x)]) == gen, bar);
            __builtin_amdgcn_fence(__ATOMIC_ACQUIRE, "agent");
            asm volatile("s_waitcnt vmcnt(0)" ::: "memory");
        }
    }
    __syncthreads();
}
#define GRID_SYNC() xcd_barrier(xb)
#else
#define GRID_SYNC() emu_grid_sync()
#endif

#ifdef EMU
#define LOADP() const P& p = p_arg
#else
typedef __attribute__((address_space(4))) const unsigned long long cu64_t;
__device__ __forceinline__ void load_params(P& p) {
    cu64_t* q = (cu64_t*)__builtin_amdgcn_kernarg_segment_ptr();
    asm volatile("" : "+s"(q));
    unsigned long long w[sizeof(P) / 8];
#pragma unroll
    for (int i = 0; i < (int)(sizeof(P) / 8); ++i) w[i] = q[i];
    __builtin_memcpy(&p, w, sizeof(P));
}
#define LOADP() P p; load_params(p)
#endif
#define PROBE_MULT 3
#if defined(PROBE_ID) && !defined(EMU)
#define PROBE_INIT() unsigned long long probe_t0 = wall_clock64()
#define PROBE_AFTER(id) { if (blockIdx.x == 0) { unsigned long long now_ = wall_clock64(); if ((id) == PROBE_ID) { const unsigned long long dt_ = now_ - probe_t0; \
    while (wall_clock64() - now_ < dt_ * PROBE_MULT) __builtin_amdgcn_s_sleep(8); now_ = wall_clock64(); } probe_t0 = now_; } }
#else
#define PROBE_INIT()
#define PROBE_AFTER(id)
#endif
__device__ __forceinline__ int gla_tok(int n, int i) {
    if (n < NCC) return n * 64 + i;
    int m = n - NCC; int col = m / RB, rb = m % RB;
    return CTX + (rb * 64 + i) * GRID_W + col;
}
__device__ __forceinline__ int chunk_order(int d, int s) {
    if (d == 0) return s;
    return (s < NCC) ? (NCC - 1 - s) : (NC - 1 - (s - NCC));
}
__device__ __forceinline__ int tok_order(int d, int s) {
    if (d == 0) return s;
    return (s < CTX) ? (CTX - 1 - s) : (MTOT - 1 - (s - CTX));
}


#define LDS_ROW 72
__device__ __forceinline__ void mfma_gemm_tile(const bf16_t* Wt, int ldw, const bf16_t* Act, int lda, int K, int n0, int m0, bf16_t* lds, f32x4 (&acc)[4][4]) {
    bf16_t* Ws = lds; bf16_t* As = lds + 128 * LDS_ROW;
    const int tid = otid(), lane = tid & 63, wave = tid >> 6, wn = wave >> 1, wm = wave & 1;
    const int lrow = tid >> 3, lkc = (tid & 7) * 8;
    u32x4 pw[4], pa[4];
#pragma unroll
    for (int i = 0; i < 4; ++i) {
        pw[i] = *(const u32x4*)(Wt + (size_t)(n0 + lrow + 32 * i) * ldw + lkc);
        pa[i] = *(const u32x4*)(Act + (size_t)(m0 + lrow + 32 * i) * lda + lkc);
    }
    for (int k0 = 0; k0 < K; k0 += 64) {
        __syncthreads();
#pragma unroll
        for (int i = 0; i < 4; ++i) {
            *(u32x4*)(Ws + (lrow + 32 * i) * LDS_ROW + lkc) = pw[i];
            *(u32x4*)(As + (lrow + 32 * i) * LDS_ROW + lkc) = pa[i];
        }
        __syncthreads();
        if (k0 + 64 < K) {
#pragma unroll
            for (int i = 0; i < 4; ++i) {
                pw[i] = *(const u32x4*)(Wt + (size_t)(n0 + lrow + 32 * i) * ldw + k0 + 64 + lkc);
                pa[i] = *(const u32x4*)(Act + (size_t)(m0 + lrow + 32 * i) * lda + k0 + 64 + lkc);
            }
        }
#pragma unroll
        for (int ks = 0; ks < 2; ++ks) {
            bf16x8 a[4], b[4];
#pragma unroll
            for (int i = 0; i < 4; ++i) {
                a[i] = *(const bf16x8*)(Ws + (wn * 64 + i * 16 + (lane & 15)) * LDS_ROW + ks * 32 + (lane >> 4) * 8);
                b[i] = *(const bf16x8*)(As + (wm * 64 + i * 16 + (lane & 15)) * LDS_ROW + ks * 32 + (lane >> 4) * 8);
            }
#pragma unroll
            for (int ni = 0; ni < 4; ++ni)
#pragma unroll
                for (int mi = 0; mi < 4; ++mi) acc[ni][mi] = MFMA16(a[ni], b[mi], acc[ni][mi]);
        }
    }
}
#define ZERO_ACC4(acc) { _Pragma("unroll") for (int i_ = 0; i_ < 4; ++i_) _Pragma("unroll") for (int j_ = 0; j_ < 4; ++j_) acc[i_][j_] = (f32x4){0.f, 0.f, 0.f, 0.f}; }
#define FOR_ACC(acc, n0, m0, BODY) { const int lane_ = otid() & 63, wave_ = otid() >> 6; \
    _Pragma("unroll") for (int ni_ = 0; ni_ < 4; ++ni_) _Pragma("unroll") for (int mi_ = 0; mi_ < 4; ++mi_) { \
        const int n = (n0) + (wave_ >> 1) * 64 + ni_ * 16 + (lane_ >> 4) * 4; const int m = (m0) + (wave_ & 1) * 64 + mi_ * 16 + (lane_ & 15); const f32x4 v = acc[ni_][mi_]; BODY } }
__device__ __forceinline__ u32x2 pack4(float a, float b, float c, float d) { u32x2 r; r.x = (unsigned)f2bf(a) | ((unsigned)f2bf(b) << 16); r.y = (unsigned)f2bf(c) | ((unsigned)f2bf(d) << 16); return r; }

__device__ __forceinline__ void convert_wt_job(const float* W, int K, int N, int Npad, bf16_t* out, int job, float* T, int ilv) {
    const int tid = otid();
    const int nkt = K / 64;
    const int n0 = (job / nkt) * 64, k0 = (job % nkt) * 64;
    __syncthreads();
    for (int idx = tid; idx < 4096; idx += NTHREADS) {
        int kk = idx >> 6, nn = idx & 63;
        int nr = n0 + nn; int src = ilv ? ((nr & 1) ? (N / 2 + (nr >> 1)) : (nr >> 1)) : nr;
        T[kk * 65 + nn] = (nr < N) ? W[(size_t)(k0 + kk) * N + src] : 0.f;
    }
    __syncthreads();
    {
        int nn = tid >> 2, part = tid & 3;
        unsigned w[8];
#pragma unroll
        for (int j = 0; j < 8; ++j) w[j] = (unsigned)f2bf(T[(part * 16 + 2 * j) * 65 + nn]) | ((unsigned)f2bf(T[(part * 16 + 2 * j + 1) * 65 + nn]) << 16);
        u32x4* o = (u32x4*)(out + (size_t)(n0 + nn) * K + k0 + part * 16);
        o[0] = (u32x4){w[0], w[1], w[2], w[3]}; o[1] = (u32x4){w[4], w[5], w[6], w[7]};
    }
}
__device__ __forceinline__ void phase_convert_weights(const P& p, int l, char* smem) {
    float* T = (float*)smem;
    struct Item { const float* W; int K, N, Npad; bf16_t* out; };
    const Item items[12] = {
        {p.in[I_RW2] + ((size_t)l * 2 + 0) * 64 * RW, 64, RW, NPAD(RW), p.WT_W2},
        {p.in[I_RW2] + ((size_t)l * 2 + 1) * 64 * RW, 64, RW, NPAD(RW), p.WT_W2 + (size_t)NPAD(RW) * 64},
        {p.in[I_RA2] + ((size_t)l * 2 + 0) * 64 * RW, 64, RW, NPAD(RW), p.WT_A2},
        {p.in[I_RA2] + ((size_t)l * 2 + 1) * 64 * RW, 64, RW, NPAD(RW), p.WT_A2 + (size_t)NPAD(RW) * 64},
        {p.in[I_WIN] + (size_t)l * D_MODEL * D_IN, D_MODEL, D_IN, NPAD(D_IN), p.WT_IN},
        {p.in[I_RG2] + (size_t)l * 128 * RW, 128, RW, RW, p.WT_G2},
        {p.in[I_S5GLU] + (size_t)l * SW * 2 * SW, SW, 2 * SW, 2 * SW, p.WT_GLU},
        {p.in[I_WBR] + ((size_t)l * 3 + 0) * BW * D_MODEL, BW, D_MODEL, D_MODEL, p.WT_BR},
        {p.in[I_WBR] + ((size_t)l * 3 + 1) * BW * D_MODEL, BW, D_MODEL, D_MODEL, p.WT_BR + (size_t)D_MODEL * BW},
        {p.in[I_WBR] + ((size_t)l * 3 + 2) * BW * D_MODEL, BW, D_MODEL, D_MODEL, p.WT_BR + (size_t)2 * D_MODEL * BW},
        {p.in[I_WOUT] + (size_t)l * D_MODEL * D_MODEL, D_MODEL, D_MODEL, D_MODEL, p.WT_OUT},
        {p.in[I_PWQ] + (size_t)l * D_MODEL * PQ, D_MODEL, PQ, PQ, p.WT_Q}};
    int base = 0;
#pragma unroll
    for (int it = 0; it < 12; ++it) {
        const int nj = (items[it].Npad / 64) * (items[it].K / 64);
        for (int j = (int)((obid() + gridDim.x - (base % gridDim.x)) % gridDim.x); j < nj; j += gridDim.x)
            convert_wt_job(items[it].W, items[it].K, items[it].N, items[it].Npad, items[it].out, j, T, it == 6);
        base += nj;
    }
    __syncthreads();
    {
        const float* ks = p.in[I_PKEYS] + (size_t)l * PH * 2 * 128 * 128;
        for (size_t i = (size_t)obid() * NTHREADS + otid(); i < (size_t)PH * 2 * 128 * 128; i += (size_t)gridDim.x * NTHREADS) {
            const float v = ks[i]; const bf16_t hb = f2bf(v);
            p.KHI[i] = hb; p.KLO[i] = f2bf(v - bf2f(hb));
        }
    }
}

__device__ __forceinline__ void phase_init(const P& p, char* smem) {
    const int tid = otid();
    float* sc = (float*)smem;
    for (int i = tid; i < D_MODEL; i += NTHREADS) { sc[i] = siluf_(p.in[I_CCTX][i]); sc[D_MODEL + i] = siluf_(p.in[I_C][i]); }
    __syncthreads();
    const int ncolblk = (6 * D_MODEL) / NTHREADS;
    for (int job = obid(); job < DEPTH * ncolblk; job += gridDim.x) {
        int l = job / ncolblk, n = (job % ncolblk) * NTHREADS + tid;
        const float* w = p.in[I_WMOD] + (size_t)l * D_MODEL * 6 * D_MODEL + n;
        float a0 = 0.f, a1 = 0.f;
        for (int k = 0; k < D_MODEL; ++k) { float wv = w[(size_t)k * 6 * D_MODEL]; a0 += sc[k] * wv; a1 += sc[D_MODEL + k] * wv; }
        float b = p.in[I_BMOD][l * 6 * D_MODEL + n];
        p.MOD[(size_t)(l * 2 + 0) * 6 * D_MODEL + n] = a0 + b;
        p.MOD[(size_t)(l * 2 + 1) * 6 * D_MODEL + n] = a1 + b;
    }
    const size_t gtid = (size_t)obid() * NTHREADS + tid, gn = (size_t)gridDim.x * NTHREADS;
    for (size_t i = gtid; i < (size_t)CTX * D_MODEL; i += gn) p.X[i] = p.in[I_CTX][i];
    for (size_t i = gtid; i < (size_t)SEQ * D_MODEL; i += gn) p.X[(size_t)CTX * D_MODEL + i] = p.in[I_X][i];
    __syncthreads();
}

__device__ __forceinline__ void phase_s5const(const P& p, int l) {
    const size_t gtid = (size_t)obid() * NTHREADS + otid(), gn = (size_t)gridDim.x * NTHREADS;
    for (size_t i = gtid; i < (size_t)2 * SG * 64; i += gn) {
        int d = (int)(i / (SG * 64)), g = (int)((i / 64) % SG), s = (int)(i % 64);
        size_t li = ((size_t)(l * 2 + d) * SG + g) * 64 + s;
        float lre = p.in[I_S5LRE][li], lim = p.in[I_S5LIM][li];
        float dt = expf(p.in[I_S5LS][(l * 2 + d) * SG + g]);
        float mag = expf(lre * dt);
        float are = mag * cosf(lim * dt), aim = mag * sinf(lim * dt);
        float den = lre * lre + lim * lim;
        float fre = ((are - 1.0f) * lre + aim * lim) / den;
        float fim = (aim * lre - (are - 1.0f) * lim) / den;
        p.S5A[i * 2 + 0] = are; p.S5A[i * 2 + 1] = aim;
        const float* bre = p.in[I_S5BRE] + (((size_t)l * SG + g) * 64 + s) * 16;
        const float* bim = p.in[I_S5BIM] + (((size_t)l * SG + g) * 64 + s) * 16;
        for (int c = 0; c < 16; ++c) {
            p.S5BB[(i * 16 + c) * 2 + 0] = fre * bre[c] - fim * bim[c];
            p.S5BB[(i * 16 + c) * 2 + 1] = fre * bim[c] + fim * bre[c];
        }
    }
}

__device__ __forceinline__ void phase_norm(const P& p, int l, int which) {
    const int lane = otid() & 63;
    const int gw = (obid() * NTHREADS + otid()) >> 6, nw = (gridDim.x * NTHREADS) >> 6;
    const float* g = p.in[which ? I_N2G : I_N1G] + l * D_MODEL;
    constexpr int NJ = (D_MODEL + 255) / 256;
    for (int t = gw; t < MTOT; t += nw) {
        const float* x = p.X + (size_t)t * D_MODEL;
        const float* mod = p.MOD + (size_t)(l * 2 + (t >= CTX ? 1 : 0)) * 6 * D_MODEL + (which ? 3 * D_MODEL : 0);
        float4 v[NJ]; float ss = 0.f;
#pragma unroll
        for (int j = 0; j < NJ; ++j) {
            const int e = j * 256 + lane * 4;
            if (e < D_MODEL) v[j] = *(const float4*)(x + e); else { v[j].x = 0.f; v[j].y = 0.f; v[j].z = 0.f; v[j].w = 0.f; }
            ss += v[j].x * v[j].x + v[j].y * v[j].y + v[j].z * v[j].z + v[j].w * v[j].w;
        }
        ss = wave_sum(ss);
        const float rstd = rsqrtf(ss / D_MODEL + 1e-6f);
#pragma unroll
        for (int j = 0; j < NJ; ++j) {
            const int e = j * 256 + lane * 4;
            if (e < D_MODEL) {
                const float4 gg = *(const float4*)(g + e), sc = *(const float4*)(mod + D_MODEL + e), sh = *(const float4*)(mod + e);
                *(u32x2*)(p.H + (size_t)t * D_MODEL + e) = pack4(v[j].x * rstd * gg.x * (1.0f + sc.x) + sh.x, v[j].y * rstd * gg.y * (1.0f + sc.y) + sh.y,
                                                                 v[j].z * rstd * gg.z * (1.0f + sc.z) + sh.z, v[j].w * rstd * gg.w * (1.0f + sc.w) + sh.w);
            }
        }
    }
}

__device__ __forceinline__ void phase_gemm_in(const P& p, int l, char* smem) {
    const int ntn = NPAD(D_IN) / 128, ntm = MTOT / 128;
    for (int job = obid(); job < ntm * ntn; job += gridDim.x) {
        const int m0 = (job / ntn) * 128, n0 = (job % ntn) * 128;
        f32x4 acc[4][4]; ZERO_ACC4(acc);
        mfma_gemm_tile(p.WT_IN, D_MODEL, p.H, D_MODEL, D_MODEL, n0, m0, (bf16_t*)smem, acc);
        FOR_ACC(acc, n0, m0, { if (n < D_IN) *(u32x2*)(p.Z + (size_t)m * D_IN + n) = pack4(v[0], v[1], v[2], v[3]); })
    }
}

__device__ __forceinline__ void unpack8(const u32x4 w, float (&f)[8]) {
    f[0] = LO16(w.x); f[1] = HI16(w.x); f[2] = LO16(w.y); f[3] = HI16(w.y); f[4] = LO16(w.z); f[5] = HI16(w.z); f[6] = LO16(w.w); f[7] = HI16(w.w);
}
__device__ __forceinline__ u32x4 pack8(const float (&f)[8]) {
    u32x4 o; o.x = (unsigned)f2bf(f[0]) | ((unsigned)f2bf(f[1]) << 16); o.y = (unsigned)f2bf(f[2]) | ((unsigned)f2bf(f[3]) << 16);
    o.z = (unsigned)f2bf(f[4]) | ((unsigned)f2bf(f[5]) << 16); o.w = (unsigned)f2bf(f[6]) | ((unsigned)f2bf(f[7]) << 16); return o;
}
__device__ __forceinline__ void load8f(const float* p, float (&f)[8]) {
    const float4 a = *(const float4*)p, b = *(const float4*)(p + 4);
    f[0] = a.x; f[1] = a.y; f[2] = a.z; f[3] = a.w; f[4] = b.x; f[5] = b.y; f[6] = b.z; f[7] = b.w;
}
__device__ __forceinline__ void store8f(float* p, const float (&f)[8]) {
    float4 a, b; a.x = f[0]; a.y = f[1]; a.z = f[2]; a.w = f[3]; b.x = f[4]; b.y = f[5]; b.z = f[6]; b.w = f[7];
    *(float4*)p = a; *(float4*)(p + 4) = b;
}
__device__ __forceinline__ void conv8(const bf16_t* zp, const float* conv, int c0, bool act, bool first, bool last, float (&out)[8]) {
    const u32x4 z4 = {0u, 0u, 0u, 0u};
    const u32x4 a0 = act ? *(const u32x4*)(zp + c0) : z4;
    const u32x4 am = (act && !first) ? *(const u32x4*)(zp + c0 - D_IN) : z4;
    const u32x4 an = (act && !last) ? *(const u32x4*)(zp + c0 + D_IN) : z4;
    float w0[8], w1[8], w2[8], f0[8], fm[8], fn[8];
    if (act) { load8f(conv + c0, w0); load8f(conv + RWKV_IN + c0, w1); load8f(conv + 2 * RWKV_IN + c0, w2); }
    else {
#pragma unroll
        for (int e = 0; e < 8; ++e) { w0[e] = 0.f; w1[e] = 0.f; w2[e] = 0.f; }
    }
    unpack8(a0, f0); unpack8(am, fm); unpack8(an, fn);
#pragma unroll
    for (int e = 0; e < 8; ++e) out[e] = w1[e] * f0[e] + w0[e] * fm[e] + w2[e] * fn[e];
}
__device__ __forceinline__ void phase_rwkv_prep1(const P& p, int l) {
    const int lane = otid() & 63;
    const int gw = (obid() * NTHREADS + otid()) >> 6, nw = (gridDim.x * NTHREADS) >> 6;
    const float* conv = p.in[I_RCONV] + (size_t)l * 3 * RWKV_IN;
    const float* k_k = p.in[I_RKK] + (size_t)l * RW;
    const bool act = lane * 8 < RW, act2 = lane * 8 < 384;
    float kkw[8];
    if (act) load8f(k_k + lane * 8, kkw);
    else {
#pragma unroll
        for (int e = 0; e < 8; ++e) kkw[e] = 0.f;
    }
    for (int t = gw; t < MTOT; t += nw) {
        const bool first = (t == 0) || (t == CTX), last = (t == CTX - 1) || (t == MTOT - 1);
        const bf16_t* zp = p.Z + (size_t)t * D_IN + ZR;
        float rv[8], kv[8], vv[8], lr[8];
        conv8(zp, conv, 0 * RW + lane * 8, act, first, last, rv);
        conv8(zp, conv, 1 * RW + lane * 8, act, first, last, kv);
        conv8(zp, conv, 2 * RW + lane * 8, act, first, last, vv);
        conv8(zp, conv, 3 * RW + lane * 8, act2, first, last, lr);
        float kk[8]; float ss = 0.f;
#pragma unroll
        for (int e = 0; e < 8; ++e) { kk[e] = kv[e] * kkw[e]; ss += kk[e] * kk[e]; }
        ss += __shfl_xor(ss, 1, 64); ss += __shfl_xor(ss, 2, 64); ss += __shfl_xor(ss, 4, 64);
        const float inv = 1.0f / fmaxf(sqrtf(ss), 1e-12f);
#pragma unroll
        for (int e = 0; e < 8; ++e) kk[e] *= inv;
        if (act) {
            const size_t o = (size_t)t * RW + lane * 8;
            *(u32x4*)(p.R + o) = pack8(rv); *(u32x4*)(p.KS + o) = pack8(kv); *(u32x4*)(p.V + o) = pack8(vv); *(u32x4*)(p.KK + o) = pack8(kk);
        }
        if (act2) {
            const int cc = lane * 8;
            if (cc < 128) {
#pragma unroll
                for (int e = 0; e < 8; ++e) lr[e] = tanhf(lr[e]);
                *(u32x4*)(p.LR + (size_t)t * 256 + cc) = pack8(lr);
            } else if (cc < 256) {
                *(u32x4*)(p.LR + (size_t)t * 256 + cc) = pack8(lr);
            } else {
#pragma unroll
                for (int e = 0; e < 8; ++e) lr[e] = sigmoidf_(lr[e]);
                *(u32x4*)(p.GS + (size_t)t * 128 + cc - 256) = pack8(lr);
            }
        }
    }
}
__device__ __forceinline__ void phase_rwkv_prep2(const P& p, int l, char* smem) {
    const int ntm = MTOT / 128, ntn = NPAD(RW) / 128;
    const float* k_a = p.in[I_RKA] + (size_t)l * RW;
    const float* r_k = p.in[I_RRK] + (size_t)l * RW;
    for (int job = obid(); job < ntm * ntn * 2; job += gridDim.x) {
        const int d = job % 2, n0 = ((job / 2) % ntn) * 128, m0 = (job / (2 * ntn)) * 128;
        const float* w0 = p.in[I_RW0] + (size_t)(l * 2 + d) * RW;
        const float* a0 = p.in[I_RA0] + (size_t)(l * 2 + d) * RW;
        f32x4 accw[4][4], acca[4][4]; ZERO_ACC4(accw); ZERO_ACC4(acca);
        mfma_gemm_tile(p.WT_W2 + (size_t)d * NPAD(RW) * 64, 64, p.LR + d * 64, 256, 64, n0, m0, (bf16_t*)smem, accw);
        mfma_gemm_tile(p.WT_A2 + (size_t)d * NPAD(RW) * 64, 64, p.LR + 128 + d * 64, 256, 64, n0, m0, (bf16_t*)smem, acca);
        const int lane = otid() & 63, wave = otid() >> 6;
#pragma unroll
        for (int mi = 0; mi < 4; ++mi) {
            const int m = m0 + (wave & 1) * 64 + mi * 16 + (lane & 15);
            float bon = 0.f;
#pragma unroll
            for (int ni = 0; ni < 4; ++ni) {
                const int n = n0 + (wave >> 1) * 64 + ni * 16 + (lane >> 4) * 4;
                if (n < RW) {
                    const u32x2 kq = *(const u32x2*)(p.KS + (size_t)m * RW + n), kkq = *(const u32x2*)(p.KK + (size_t)m * RW + n), rq = *(const u32x2*)(p.R + (size_t)m * RW + n);
                    const float kv[4] = {LO16(kq.x), HI16(kq.x), LO16(kq.y), HI16(kq.y)};
                    const float kkv[4] = {LO16(kkq.x), HI16(kkq.x), LO16(kkq.y), HI16(kkq.y)};
                    const float rv[4] = {LO16(rq.x), HI16(rq.x), LO16(rq.y), HI16(rq.y)};
                    float lw[4], kd[4], bb[4];
#pragma unroll
                    for (int e = 0; e < 4; ++e) {
                        const float x = w0[n + e] + accw[ni][mi][e];
                        lw[e] = -expf(-softplusf_(-x) - 0.5f);
                        const float aa = sigmoidf_(a0[n + e] + acca[ni][mi][e]);
                        kd[e] = kv[e] * (1.0f + (aa - 1.0f) * k_a[n + e]);
                        bb[e] = kkv[e] * aa;
                        bon += rv[e] * kd[e] * r_k[n + e];
                    }
                    const size_t o = ((size_t)d * MTOT + m) * RW + n;
                    float4 lo4; lo4.x = lw[0]; lo4.y = lw[1]; lo4.z = lw[2]; lo4.w = lw[3];
                    *(float4*)(p.LW + o) = lo4;
                    *(u32x2*)(p.KD + o) = pack4(kd[0], kd[1], kd[2], kd[3]);
                    *(u32x2*)(p.BB + o) = pack4(bb[0], bb[1], bb[2], bb[3]);
                }
            }
            bon += __shfl_xor(bon, 16, 64); bon += __shfl_xor(bon, 32, 64);
            const int hh = (n0 + (wave >> 1) * 64) >> 6;
            if ((lane >> 4) == 0 && hh < RH) p.BONUS[((size_t)d * MTOT + m) * RH + hh] = bon;
        }
    }
}

#define CH_ROW 72
#define CH_SLOT (64 * CH_ROW)
#define CH_XR_OFF (7 * CH_SLOT * 2)
#define CH_AAB_OFF (CH_XR_OFF + 64 * 132 * 4)
#define CH_GC_OFF (CH_AAB_OFF + 64 * 72 * 4)
template <int MT, int NT>
__device__ __forceinline__ void lds_mm(const bf16_t* A, int m0, const bf16_t* Bt, int n0, f32x4 (&acc)[MT][NT]) {
    const int lane = otid() & 63, q = lane >> 4, r = lane & 15;
#pragma unroll
    for (int s = 0; s < 2; ++s) {
        bf16x8 a[MT], b[NT];
#pragma unroll
        for (int i = 0; i < MT; ++i) a[i] = *(const bf16x8*)(A + (m0 + i * 16 + r) * CH_ROW + s * 32 + q * 8);
#pragma unroll
        for (int i = 0; i < NT; ++i) b[i] = *(const bf16x8*)(Bt + (n0 + i * 16 + r) * CH_ROW + s * 32 + q * 8);
#pragma unroll
        for (int i = 0; i < MT; ++i)
#pragma unroll
            for (int jj = 0; jj < NT; ++jj) acc[i][jj] = MFMA16(a[i], b[jj], acc[i][jj]);
    }
}
__device__ __forceinline__ void rwkv_chunk_job(const P& p, int job, char* smem) {
    const int tid = otid(), lane = tid & 63, wv = tid >> 6, q = lane >> 4, r = lane & 15;
    const int d = job / (NC * RH), n = (job / RH) % NC, h = job % RH;
    const size_t base = (size_t)(d * NC + n) * RH + h;
    bf16_t* S0 = (bf16_t*)smem; bf16_t* S1 = S0 + CH_SLOT; bf16_t* S2 = S1 + CH_SLOT; bf16_t* S3 = S2 + CH_SLOT;
    bf16_t* S4 = S3 + CH_SLOT; bf16_t* S5 = S4 + CH_SLOT; bf16_t* S6 = S5 + CH_SLOT;
    float* X = (float*)(smem + CH_XR_OFF);
    float* AABt = (float*)(smem + CH_AAB_OFF);
    bf16_t* U0t = (bf16_t*)(smem + CH_AAB_OFF);
    bf16_t* Aht = U0t + CH_SLOT;
    float* GC = (float*)(smem + CH_GC_OFF);
    __syncthreads();
    for (int idx = tid; idx < 4096; idx += NTHREADS) {
        const int i = idx >> 6, k = idx & 63; const int tok = 64 * n + (d ? 63 - i : i);
        X[i * 132 + k] = p.LW[((size_t)d * MTOT + tok) * RW + h * 64 + k];
    }
    __syncthreads();
    {
        const int k = tid & 63, seg = tid >> 6;
        float v[16]; float run = 0.f;
#pragma unroll
        for (int e = 0; e < 16; ++e) { run += X[(seg * 16 + e) * 132 + k]; v[e] = run; }
        AABt[seg * 64 + k] = run;
        __syncthreads();
        float off = 0.f;
        for (int s2 = 0; s2 < seg; ++s2) off += AABt[s2 * 64 + k];
#pragma unroll
        for (int e = 0; e < 16; ++e) X[(seg * 16 + e) * 132 + k] = v[e] + off;
    }
    __syncthreads();
    for (int idx = tid; idx < 4096; idx += NTHREADS) {
        const int i = idx >> 6, k = idx & 63; const int tok = 64 * n + (d ? 63 - i : i);
        const size_t o1 = (size_t)tok * RW + h * 64 + k, o2 = ((size_t)d * MTOT + tok) * RW + h * 64 + k;
        const float L = X[i * 132 + k], Lp = (i > 0) ? X[(i - 1) * 132 + k] : 0.f, LC = X[63 * 132 + k];
        const float kkv = bf2f(p.KK[o1]), rv = bf2f(p.R[o1]), vv = bf2f(p.V[o1]), kdv = bf2f(p.KD[o2]), bbv = bf2f(p.BB[o2]);
        const float eL = expf(L), eLp = expf(Lp), eNL = expf(-L), eCL = expf(LC - L);
        const float at = -kkv * eLp;
        S0[i * CH_ROW + k] = f2bf(at);
        X[i * 132 + 64 + k] = at;
        S1[i * CH_ROW + k] = f2bf(rv * eL);
        S2[i * CH_ROW + k] = f2bf(bbv * eNL);
        S3[i * CH_ROW + k] = f2bf(kdv * eNL);
        S4[k * CH_ROW + i] = f2bf(vv);
        S5[k * CH_ROW + i] = f2bf(bbv * eCL);
        S6[k * CH_ROW + i] = f2bf(kdv * eCL);
        if (i == 63) GC[k] = eL;
    }
    __syncthreads();
    {
        f32x4 acc[4][4]; ZERO_ACC4(acc);
        lds_mm<4, 4>((wv < 2) ? S0 : S1, 0, (wv & 1) ? S3 : S2, 0, acc);
        __syncthreads();
#pragma unroll
        for (int mt = 0; mt < 4; ++mt)
#pragma unroll
            for (int nt = 0; nt < 4; ++nt) {
                const int jc = nt * 16 + r, i0 = mt * 16 + 4 * q;
                if (wv == 0) {
                    f32x4 o;
#pragma unroll
                    for (int e = 0; e < 4; ++e) o[e] = (jc < i0 + e) ? acc[mt][nt][e] : 0.f;
                    *(f32x4*)(AABt + jc * 72 + i0) = o;
                } else {
                    bf16_t* dst = (wv == 1) ? S0 : ((wv == 2) ? S2 : S3);
#pragma unroll
                    for (int e = 0; e < 4; ++e) {
                        const bool ok = (wv == 1) ? (jc < i0 + e) : (jc <= i0 + e);
                        dst[(i0 + e) * CH_ROW + jc] = f2bf(ok ? acc[mt][nt][e] : 0.f);
                    }
                }
            }
    }
    __syncthreads();
    {
        f32x4 acc[1][4];
#pragma unroll
        for (int nt = 0; nt < 4; ++nt) acc[0][nt] = (f32x4){0.f, 0.f, 0.f, 0.f};
        lds_mm<1, 4>(S0, 16 * wv, S4, 0, acc);
#pragma unroll
        for (int nt = 0; nt < 4; ++nt)
#pragma unroll
            for (int e = 0; e < 4; ++e) X[(16 * wv + 4 * q + e) * 132 + nt * 16 + r] = acc[0][nt][e];
    }
    __syncthreads();
    if (tid < 128) {
        const int c = tid;
        for (int bi = 0; bi < 4; ++bi) {
            float acc[16];
#pragma unroll
            for (int e = 0; e < 16; ++e) acc[e] = X[(16 * bi + e) * 132 + c];
            for (int jj = 0; jj < 16 * bi; ++jj) {
                const float uj = X[jj * 132 + c];
                const f32x4* ap = (const f32x4*)(AABt + jj * 72 + 16 * bi);
                const f32x4 a0 = ap[0], a1 = ap[1], a2 = ap[2], a3 = ap[3];
#pragma unroll
                for (int e = 0; e < 4; ++e) { acc[e] += a0[e] * uj; acc[4 + e] += a1[e] * uj; acc[8 + e] += a2[e] * uj; acc[12 + e] += a3[e] * uj; }
            }
#pragma unroll
            for (int e = 0; e < 16; ++e) {
                const float u = acc[e];
                X[(16 * bi + e) * 132 + c] = u;
                const f32x4* ap = (const f32x4*)(AABt + (16 * bi + e) * 72 + 16 * bi);
                const f32x4 a0 = ap[0], a1 = ap[1], a2 = ap[2], a3 = ap[3];
#pragma unroll
                for (int e2 = 0; e2 < 16; ++e2) if (e2 > e) acc[e2] += ((e2 < 4) ? a0[e2 & 3] : (e2 < 8) ? a1[e2 & 3] : (e2 < 12) ? a2[e2 & 3] : a3[e2 & 3]) * u;
            }
        }
    }
    __syncthreads();
    if (tid < 128) {
        const int c = tid;
        bf16_t* dst = (c < 64) ? (U0t + c * CH_ROW) : (Aht + (c - 64) * CH_ROW);
        u32x4 ov[8];
#pragma unroll
        for (int g = 0; g < 8; ++g) {
            float v[8];
#pragma unroll
            for (int e = 0; e < 8; ++e) v[e] = X[(g * 8 + e) * 132 + c];
            ov[g].x = (unsigned)f2bf(v[0]) | ((unsigned)f2bf(v[1]) << 16); ov[g].y = (unsigned)f2bf(v[2]) | ((unsigned)f2bf(v[3]) << 16);
            ov[g].z = (unsigned)f2bf(v[4]) | ((unsigned)f2bf(v[5]) << 16); ov[g].w = (unsigned)f2bf(v[6]) | ((unsigned)f2bf(v[7]) << 16);
        }
#pragma unroll
        for (int g = 0; g < 8; ++g) *(u32x4*)(dst + g * 8) = ov[g];
    }
    __syncthreads();
    {
        f32x4 acc[4][4]; ZERO_ACC4(acc);
        if (wv == 0) {
            lds_mm<4, 4>(S5, 0, Aht, 0, acc);
#pragma unroll
            for (int mt = 0; mt < 4; ++mt)
#pragma unroll
                for (int nt = 0; nt < 4; ++nt)
#pragma unroll
                    for (int e = 0; e < 4; ++e) {
                        const int kp = mt * 16 + 4 * q + e, kc = nt * 16 + r;
                        X[kp * 68 + kc] = acc[mt][nt][e] + ((kp == kc) ? GC[kc] : 0.f);
                    }
        } else if (wv == 1) {
            lds_mm<4, 4>(S5, 0, U0t, 0, acc);
            lds_mm<4, 4>(S6, 0, S4, 0, acc);
#pragma unroll
            for (int mt = 0; mt < 4; ++mt)
#pragma unroll
                for (int nt = 0; nt < 4; ++nt) *(f32x4*)(p.NTF + (((base * 4 + nt) * 4 + mt) * 64 + lane) * 4) = acc[mt][nt];
        } else if (wv == 2) {
            lds_mm<4, 4>(S2, 0, Aht, 0, acc);
#pragma unroll
            for (int mt = 0; mt < 4; ++mt)
#pragma unroll
                for (int nt = 0; nt < 4; ++nt)
#pragma unroll
                    for (int e = 0; e < 4; ++e) {
                        const int t = mt * 16 + 4 * q + e, kc = nt * 16 + r;
                        p.QH[(base * 64 + t) * 64 + kc] = f2bf(acc[mt][nt][e] + bf2f(S1[t * CH_ROW + kc]));
                    }
        } else {
            lds_mm<4, 4>(S2, 0, U0t, 0, acc);
            lds_mm<4, 4>(S3, 0, S4, 0, acc);
#pragma unroll
            for (int mt = 0; mt < 4; ++mt)
#pragma unroll
                for (int nt = 0; nt < 4; ++nt)
#pragma unroll
                    for (int e = 0; e < 4; ++e) {
                        const int t = mt * 16 + 4 * q + e; const int tok = 64 * n + (d ? 63 - t : t);
                        p.Y[((size_t)d * MTOT + tok) * RW + h * 64 + nt * 16 + r] = acc[mt][nt][e];
                    }
        }
    }
    __syncthreads();
    for (int u = tid; u < 512; u += NTHREADS) {
        const int tile = u >> 7, s2 = (u >> 6) & 1, ln = u & 63;
        const int kp = tile * 16 + (ln & 15), qq = ln >> 4;
        unsigned hi[4], lo[4];
#pragma unroll
        for (int jp = 0; jp < 4; ++jp) {
            unsigned hh[2], ll[2];
#pragma unroll
            for (int z = 0; z < 2; ++z) {
                const int jj = jp * 2 + z; const int k = 32 * s2 + 16 * (jj >> 2) + 4 * qq + (jj & 3);
                const float v = X[kp * 68 + k]; const bf16_t hb = f2bf(v); const bf16_t lb = f2bf(v - bf2f(hb));
                hh[z] = hb; ll[z] = lb;
            }
            hi[jp] = hh[0] | (hh[1] << 16); lo[jp] = ll[0] | (ll[1] << 16);
        }
        *(u32x4*)(p.MTF + ((((base * 2 + 0) * 4 + tile) * 2 + s2) * 64 + ln) * 8) = (u32x4){hi[0], hi[1], hi[2], hi[3]};
        *(u32x4*)(p.MTF + ((((base * 2 + 1) * 4 + tile) * 2 + s2) * 64 + ln) * 8) = (u32x4){lo[0], lo[1], lo[2], lo[3]};
    }
}

__device__ __forceinline__ void rwkv_seq_load(const P& p, size_t base, int wv, int lane, u32x4 (&mh)[4][2], u32x4 (&ml)[4][2], f32x4 (&nt)[4]) {
#pragma unroll
    for (int tile = 0; tile < 4; ++tile) {
#pragma unroll
        for (int s2 = 0; s2 < 2; ++s2) {
            mh[tile][s2] = *(const u32x4*)(p.MTF + ((((base * 2 + 0) * 4 + tile) * 2 + s2) * 64 + lane) * 8);
            ml[tile][s2] = *(const u32x4*)(p.MTF + ((((base * 2 + 1) * 4 + tile) * 2 + s2) * 64 + lane) * 8);
        }
        nt[tile] = *(const f32x4*)(p.NTF + (((base * 4 + wv) * 4 + tile) * 64 + lane) * 4);
    }
}
__device__ __forceinline__ void rwkv_seq_job(const P& p, int job) {
    const int tid = otid(), lane = tid & 63, wv = tid >> 6, q = lane >> 4, r = lane & 15;
    const int d = job / RH, h = job % RH;
    f32x4 X[4];
#pragma unroll
    for (int kt = 0; kt < 4; ++kt) X[kt] = (f32x4){0.f, 0.f, 0.f, 0.f};
    u32x4 mh[4][2], ml[4][2]; f32x4 nt[4];
    size_t base = (size_t)(d * NC + chunk_order(d, 0)) * RH + h;
    rwkv_seq_load(p, base, wv, lane, mh, ml, nt);
    for (int s = 0; s < NC; ++s) {
        u32x4 mh2[4][2], ml2[4][2]; f32x4 nt2[4];
        const size_t base2 = (size_t)(d * NC + chunk_order(d, (s + 1 < NC) ? s + 1 : s)) * RH + h;
        rwkv_seq_load(p, base2, wv, lane, mh2, ml2, nt2);
        unsigned xh[4][2], xl[4][2];
#pragma unroll
        for (int kt = 0; kt < 4; ++kt) {
            bf16_t hb[4], lb[4];
#pragma unroll
            for (int e = 0; e < 4; ++e) { hb[e] = f2bf(X[kt][e]); lb[e] = f2bf(X[kt][e] - bf2f(hb[e])); }
            xh[kt][0] = (unsigned)hb[0] | ((unsigned)hb[1] << 16); xh[kt][1] = (unsigned)hb[2] | ((unsigned)hb[3] << 16);
            xl[kt][0] = (unsigned)lb[0] | ((unsigned)lb[1] << 16); xl[kt][1] = (unsigned)lb[2] | ((unsigned)lb[3] << 16);
            *(u32x2*)(p.SN + (base * 64 + 16 * wv + r) * 64 + 16 * kt + 4 * q) = (u32x2){xh[kt][0], xh[kt][1]};
        }
        bf16x8 bh[2], bl[2];
#pragma unroll
        for (int s2 = 0; s2 < 2; ++s2) {
            bh[s2] = __builtin_bit_cast(bf16x8, ((u32x4){xh[2 * s2][0], xh[2 * s2][1], xh[2 * s2 + 1][0], xh[2 * s2 + 1][1]}));
            bl[s2] = __builtin_bit_cast(bf16x8, ((u32x4){xl[2 * s2][0], xl[2 * s2][1], xl[2 * s2 + 1][0], xl[2 * s2 + 1][1]}));
        }
#pragma unroll
        for (int tile = 0; tile < 4; ++tile) {
            f32x4 acc = nt[tile];
#pragma unroll
            for (int s2 = 0; s2 < 2; ++s2) {
                const bf16x8 ah = __builtin_bit_cast(bf16x8, mh[tile][s2]), al = __builtin_bit_cast(bf16x8, ml[tile][s2]);
                acc = MFMA16(ah, bh[s2], acc);
                acc = MFMA16(al, bh[s2], acc);
                acc = MFMA16(ah, bl[s2], acc);
            }
            X[tile] = acc;
        }
        base = base2;
#pragma unroll
        for (int tile = 0; tile < 4; ++tile) {
            nt[tile] = nt2[tile];
#pragma unroll
            for (int s2 = 0; s2 < 2; ++s2) { mh[tile][s2] = mh2[tile][s2]; ml[tile][s2] = ml2[tile][s2]; }
        }
    }
}
__device__ __forceinline__ void rwkv_out_job(const P& p, int job) {
    const int tid = otid(), lane = tid & 63, wv = tid >> 6, q = lane >> 4, r = lane & 15;
    const int d = job / (NC * RH), n = (job / RH) % NC, h = job % RH;
    const size_t base = (size_t)(d * NC + n) * RH + h;
    f32x4 acc[4];
#pragma unroll
    for (int nt = 0; nt < 4; ++nt) acc[nt] = (f32x4){0.f, 0.f, 0.f, 0.f};
#pragma unroll
    for (int s2 = 0; s2 < 2; ++s2) {
        const bf16x8 a = *(const bf16x8*)(p.QH + (base * 64 + 16 * wv + r) * 64 + s2 * 32 + q * 8);
#pragma unroll
        for (int nt = 0; nt < 4; ++nt) {
            const bf16x8 b = *(const bf16x8*)(p.SN + (base * 64 + nt * 16 + r) * 64 + s2 * 32 + q * 8);
            acc[nt] = MFMA16(a, b, acc[nt]);
        }
    }
#pragma unroll
    for (int nt = 0; nt < 4; ++nt)
#pragma unroll
        for (int e = 0; e < 4; ++e) {
            const int t = 16 * wv + 4 * q + e; const int tok = 64 * n + (d ? 63 - t : t);
            p.Y[((size_t)d * MTOT + tok) * RW + h * 64 + nt * 16 + r] += acc[nt][e];
        }
}

#define GL_QR 0
#define GL_KR 9216
#define GL_VT 18432
#define GL_QI 36864
#define GL_KI 46080
#define GL_AT 55296
#define GL_CUM 64512
#define GL_ALR 81920
#define GL_WA 86016
__device__ __forceinline__ void gla_load_qkv(const P& p, int n, int h, char* smem) {
    const int tid = otid();
    bf16_t* Qr = (bf16_t*)(smem + GL_QR); bf16_t* Kr = (bf16_t*)(smem + GL_KR); bf16_t* Vt = (bf16_t*)(smem + GL_VT);
    for (int c = tid; c < 512; c += NTHREADS) {
        const int row = c >> 3, part = c & 7; const int t = gla_tok(n, row);
        const u32x4 qv = *(const u32x4*)(p.Z + (size_t)t * D_IN + ZQ + h * 64 + part * 8);
        const u32x4 kv = *(const u32x4*)(p.Z + (size_t)t * D_IN + ZK + h * 64 + part * 8);
        u32x4 qs;
        qs.x = (unsigned)f2bf(LO16(qv.x) * 0.125f) | ((unsigned)f2bf(HI16(qv.x) * 0.125f) << 16);
        qs.y = (unsigned)f2bf(LO16(qv.y) * 0.125f) | ((unsigned)f2bf(HI16(qv.y) * 0.125f) << 16);
        qs.z = (unsigned)f2bf(LO16(qv.z) * 0.125f) | ((unsigned)f2bf(HI16(qv.z) * 0.125f) << 16);
        qs.w = (unsigned)f2bf(LO16(qv.w) * 0.125f) | ((unsigned)f2bf(HI16(qv.w) * 0.125f) << 16);
        *(u32x4*)(Qr + row * CH_ROW + part * 8) = qs;
        *(u32x4*)(Kr + row * CH_ROW + part * 8) = kv;
    }
    for (int c = tid; c < 1024; c += NTHREADS) {
        const int row = c >> 4, part = c & 15; const int t = gla_tok(n, row);
        const u32x4 vv = *(const u32x4*)(p.Z + (size_t)t * D_IN + ZV + h * 128 + part * 8);
        bf16_t* dst = Vt + (part * 8) * CH_ROW + row;
        dst[0 * CH_ROW] = (bf16_t)(vv.x & 0xFFFF); dst[1 * CH_ROW] = (bf16_t)(vv.x >> 16);
        dst[2 * CH_ROW] = (bf16_t)(vv.y & 0xFFFF); dst[3 * CH_ROW] = (bf16_t)(vv.y >> 16);
        dst[4 * CH_ROW] = (bf16_t)(vv.z & 0xFFFF); dst[5 * CH_ROW] = (bf16_t)(vv.z >> 16);
        dst[6 * CH_ROW] = (bf16_t)(vv.w & 0xFFFF); dst[7 * CH_ROW] = (bf16_t)(vv.w >> 16);
    }
}
__device__ __forceinline__ void gla_cum(const P& p, int l, int n, int h, int d, char* smem) {
    const int tid = otid();
    float* CUM = (float*)(smem + GL_CUM); float* ALR = (float*)(smem + GL_ALR); float* WA = (float*)(smem + GL_WA);
    for (int c = tid; c < 256; c += NTHREADS) {
        const int row = c >> 2, part = c & 3; const int t = gla_tok(n, row);
        const u32x2 a = *(const u32x2*)(p.Z + (size_t)t * D_IN + (d ? ZAB : ZAF) + part * 4);
        float* dst = ALR + row * 16 + part * 4;
        dst[0] = LO16(a.x); dst[1] = HI16(a.x); dst[2] = LO16(a.y); dst[3] = HI16(a.y);
    }
    for (int c = tid; c < 16 * 64 + 64; c += NTHREADS) {
        if (c < 1024) WA[c] = p.in[I_GLA_WA2][((size_t)(l * 2 + d) * 16 + (c >> 6)) * GLA_K + h * 64 + (c & 63)];
        else WA[c] = p.in[I_GLA_BA][(size_t)(l * 2 + d) * GLA_K + h * 64 + (c - 1024)];
    }
    __syncthreads();
    for (int idx = tid; idx < 4096; idx += NTHREADS) {
        const int i = idx >> 6, k = idx & 63;
        float a = WA[1024 + k];
#pragma unroll
        for (int r = 0; r < 16; ++r) a += ALR[i * 16 + r] * WA[r * 64 + k];
        CUM[i * 68 + k] = (fminf(a, 0.f) - log1pf(expf(-fabsf(a)))) * (1.0f / 16.0f);
    }
    __syncthreads();
    {
        const int k = tid & 63, seg = (tid >> 6) & 3;
        float v[16]; float run = 0.f;
        if (tid < 256) {
#pragma unroll
            for (int e = 0; e < 16; ++e) { const int pos = seg * 16 + e; const int i = d ? 63 - pos : pos; run += CUM[i * 68 + k]; v[e] = run; }
            ALR[seg * 64 + k] = run;
        }
        __syncthreads();
        if (tid < 256) {
            float off = 0.f;
            for (int s2 = 0; s2 < seg; ++s2) off += ALR[s2 * 64 + k];
#pragma unroll
            for (int e = 0; e < 16; ++e) { const int pos = seg * 16 + e; const int i = d ? 63 - pos : pos; CUM[i * 68 + k] = v[e] + off; }
        }
    }
    __syncthreads();
}
__device__ __forceinline__ void phase_gla_kv(const P& p, int l, char* smem) {
    const int tid = otid(), lane = tid & 63, wv = tid >> 6, q = lane >> 4, r = lane & 15;
    bf16_t* Kr = (bf16_t*)(smem + GL_KR); bf16_t* Vt = (bf16_t*)(smem + GL_VT); bf16_t* KdT = (bf16_t*)(smem + GL_KI);
    float* CUM = (float*)(smem + GL_CUM);
    for (int job = obid(); job < NC * GH; job += gridDim.x) {
        const int n = job / GH, h = job % GH;
        __syncthreads();
        gla_load_qkv(p, n, h, smem);
        for (int d = 0; d < 2; ++d) {
            gla_cum(p, l, n, h, d, smem);
            const int li = d ? 0 : 63;
            for (int idx = tid; idx < 4096; idx += NTHREADS) {
                const int i = idx >> 6, k = idx & 63;
                KdT[k * CH_ROW + i] = f2bf(bf2f(Kr[i * CH_ROW + k]) * expf(CUM[li * 68 + k] - CUM[i * 68 + k]));
            }
            if (tid < 64) p.DEC[((size_t)(d * NC + n) * GH + h) * 64 + tid] = expf(CUM[li * 68 + tid]);
            __syncthreads();
            float* kvt = p.KV + ((size_t)(d * NC + n) * GH + h) * 8192;
            for (int mt = wv; mt < 4; mt += NTHREADS / 64) {
                f32x4 acc[1][8];
#pragma unroll
                for (int nt = 0; nt < 8; ++nt) acc[0][nt] = (f32x4){0.f, 0.f, 0.f, 0.f};
                lds_mm<1, 8>(KdT, 16 * mt, Vt, 0, acc);
#pragma unroll
                for (int nt = 0; nt < 8; ++nt) *(f32x4*)(kvt + (size_t)(nt * 16 + r) * 64 + 16 * mt + 4 * q) = acc[0][nt];
            }
            __syncthreads();
        }
    }
    __syncthreads();
}
__device__ __forceinline__ void gla_scan_job(const P& p, int job) {
    const int base = job * NTHREADS + otid();
    const int d = base / (GH * 8192), h = (base / 8192) % GH, e = base % 8192;
    const float* __restrict__ kvp = p.KV; const float* __restrict__ decp = p.DEC; bf16_t* __restrict__ sp = p.SP;
    float S = 0.f;
    for (int s = 0; s < NC; s += 4) {
        float kv[4], dc[4]; size_t oo[4];
#pragma unroll
        for (int u = 0; u < 4; ++u) {
            const int n = chunk_order(d, (s + u < NC) ? s + u : NC - 1);
            oo[u] = ((size_t)(d * NC + n) * GH + h);
            kv[u] = kvp[oo[u] * 8192 + e]; dc[u] = decp[oo[u] * 64 + (e & 63)];
        }
#pragma unroll
        for (int u = 0; u < 4; ++u) if (s + u < NC) { sp[oo[u] * 8192 + e] = f2bf(S); S = dc[u] * S + kv[u]; }
    }
}
__device__ __forceinline__ void phase_gla_out(const P& p, int l, char* smem) {
    const int tid = otid(), lane = tid & 63, wv = tid >> 6, q = lane >> 4, r = lane & 15;
    bf16_t* Qr = (bf16_t*)(smem + GL_QR); bf16_t* Kr = (bf16_t*)(smem + GL_KR); bf16_t* Vt = (bf16_t*)(smem + GL_VT);
    bf16_t* Qi = (bf16_t*)(smem + GL_QI); bf16_t* Ki = (bf16_t*)(smem + GL_KI); bf16_t* At = (bf16_t*)(smem + GL_AT);
    float* CUM = (float*)(smem + GL_CUM);
    for (int job = obid(); job < NC * GH; job += gridDim.x) {
        const int n = job / GH, h = job % GH;
        __syncthreads();
        gla_load_qkv(p, n, h, smem);
        f32x4 o[1][8];
#pragma unroll
        for (int nt = 0; nt < 8; ++nt) o[0][nt] = (f32x4){0.f, 0.f, 0.f, 0.f};
        for (int d = 0; d < 2; ++d) {
            gla_cum(p, l, n, h, d, smem);
            for (int idx = tid; idx < 4096; idx += NTHREADS) {
                const int i = idx >> 6, k = idx & 63; const float c = CUM[i * 68 + k];
                Qi[i * CH_ROW + k] = f2bf(bf2f(Qr[i * CH_ROW + k]) * expf(c));
                Ki[i * CH_ROW + k] = f2bf(bf2f(Kr[i * CH_ROW + k]) * expf(-c));
            }
            __syncthreads();
            if (wv < 4) {
                f32x4 a[1][4];
#pragma unroll
                for (int nt = 0; nt < 4; ++nt) a[0][nt] = (f32x4){0.f, 0.f, 0.f, 0.f};
                lds_mm<1, 4>(Qi, 16 * wv, Ki, 0, a);
#pragma unroll
                for (int nt = 0; nt < 4; ++nt)
#pragma unroll
                    for (int e = 0; e < 4; ++e) {
                        const int i = 16 * wv + 4 * q + e, j = nt * 16 + r;
                        const bool ok = d ? (j >= i) : (j <= i);
                        At[i * CH_ROW + j] = f2bf(ok ? a[0][nt][e] : 0.f);
                    }
                WAVE_SYNC();
                lds_mm<1, 8>(At, 16 * wv, Vt, 0, o);
                const bf16_t* sp = p.SP + ((size_t)(d * NC + n) * GH + h) * 8192;
#pragma unroll
                for (int s2 = 0; s2 < 2; ++s2) {
                    const bf16x8 af = *(const bf16x8*)(Qi + (16 * wv + r) * CH_ROW + s2 * 32 + q * 8);
#pragma unroll
                    for (int nt = 0; nt < 8; ++nt) {
                        const bf16x8 bfr = *(const bf16x8*)(sp + (size_t)(nt * 16 + r) * 64 + s2 * 32 + q * 8);
                        o[0][nt] = MFMA16(af, bfr, o[0][nt]);
                    }
                }
            }
            __syncthreads();
        }
        if (wv < 4) {
#pragma unroll
            for (int nt = 0; nt < 8; ++nt)
#pragma unroll
                for (int e = 0; e < 4; ++e) {
                    const int t = gla_tok(n, 16 * wv + 4 * q + e);
                    p.OGLA[(size_t)t * GLA_V + h * 128 + nt * 16 + r] = o[0][nt][e];
                }
        }
    }
    __syncthreads();
}

#define S5_BU_OFF 4096
#define S5_CT_OFF (4096 + 2 * 64 * 130 * 4)
__device__ __forceinline__ void s5_local_job(const P& p, int job, char* smem, bool with_carry) {
    const int tid = otid();
    const int n = job / SG, g = job % SG;
    float* su = (float*)smem; float* BU = (float*)(smem + S5_BU_OFF);
    __syncthreads();
    for (int c = tid; c < 256; c += NTHREADS) {
        const int row = c >> 2, part = c & 3;
        const u32x2 a = *(const u32x2*)(p.Z + (size_t)(n * 64 + row) * D_IN + ZS5 + g * 16 + part * 4);
        float* dst = su + row * 16 + part * 4;
        dst[0] = LO16(a.x); dst[1] = HI16(a.x); dst[2] = LO16(a.y); dst[3] = HI16(a.y);
    }
    __syncthreads();
    if (tid < 256) {
        const int st = tid & 63, d = (tid >> 7) & 1, half = (tid >> 6) & 1;
        const size_t ci = ((size_t)d * SG + g) * 64 + st;
        float bre[16], bim[16];
#pragma unroll
        for (int c = 0; c < 16; ++c) { const float2 b2 = *(const float2*)(p.S5BB + (ci * 16 + c) * 2); bre[c] = b2.x; bim[c] = b2.y; }
        for (int ii = 0; ii < 32; ++ii) {
            const int i = half * 32 + ii;
            const f32x4* up = (const f32x4*)(su + i * 16);
            const f32x4 u0 = up[0], u1 = up[1], u2 = up[2], u3 = up[3];
            float ur = 0.f, ui = 0.f;
#pragma unroll
            for (int c = 0; c < 4; ++c) {
                ur += bre[c] * u0[c] + bre[4 + c] * u1[c] + bre[8 + c] * u2[c] + bre[12 + c] * u3[c];
                ui += bim[c] * u0[c] + bim[4 + c] * u1[c] + bim[8 + c] * u2[c] + bim[12 + c] * u3[c];
            }
            float2 o; o.x = ur; o.y = ui;
            *(float2*)(BU + (d * 64 + i) * 130 + st * 2) = o;
        }
    }
    __syncthreads();
    if (tid < 128) {
        const int d = tid >> 6, st = tid & 63;
        const size_t ci = ((size_t)d * SG + g) * 64 + st;
        const float are = p.S5A[ci * 2], aim = p.S5A[ci * 2 + 1];
        const size_t eo = (((size_t)d * NC + n) * SG + g) * 64 + st;
        float xr = 0.f, xi = 0.f;
        if (with_carry) { xr = p.S5END[eo * 2]; xi = p.S5END[eo * 2 + 1]; }
#pragma unroll 8
        for (int ii = 0; ii < 64; ++ii) {
            const int i = d ? 63 - ii : ii;
            float2* bp = (float2*)(BU + (d * 64 + i) * 130 + st * 2);
            const float2 b = *bp;
            const float nr = are * xr - aim * xi + b.x, ni = are * xi + aim * xr + b.y;
            xr = nr; xi = ni;
            if (with_carry) { float2 o; o.x = xr; o.y = xi; *bp = o; }
        }
        if (!with_carry) { p.S5END[eo * 2] = xr; p.S5END[eo * 2 + 1] = xi; }
    }
}
__device__ __forceinline__ void s5_out_job(const P& p, int l, int job, char* smem) {
    const int tid = otid();
    const int n = job / SG, g = job % SG;
    float* su = (float*)smem; float* X = (float*)(smem + S5_BU_OFF); float* CTr = (float*)(smem + S5_CT_OFF); float* CTi = CTr + 1024;
    s5_local_job(p, job, smem, true);
    for (int idx = tid; idx < 1024; idx += NTHREADS) {
        const int c = idx >> 6, pp = idx & 63;
        CTr[pp * 16 + c] = p.in[I_S5CRE][((size_t)l * SG + g) * 1024 + idx];
        CTi[pp * 16 + c] = p.in[I_S5CIM][((size_t)l * SG + g) * 1024 + idx];
    }
    __syncthreads();
    for (int idx = tid; idx < 1024; idx += NTHREADS) {
        const int i = idx >> 4, c = idx & 15;
        const float* x0 = X + (0 * 64 + i) * 130; const float* x1 = X + (1 * 64 + i) * 130;
        float a = 0.f;
#pragma unroll 8
        for (int st = 0; st < 64; ++st) {
            const float2 f = *(const float2*)(x0 + st * 2), b = *(const float2*)(x1 + st * 2);
            a += CTr[st * 16 + c] * (f.x + b.x) - CTi[st * 16 + c] * (f.y + b.y);
        }
        a += p.in[I_S5D][(size_t)l * SW + g * 16 + c] * su[idx];
        p.GY[(size_t)(n * 64 + i) * SW + g * 16 + c] = f2bf(geluf_(a));
    }
    __syncthreads();
}
__device__ __forceinline__ void s5_carry_job(const P& p, int job) {
    int base = job * NTHREADS + otid();
    if (base >= 2 * SG * 64) return;
    int d = base / (SG * 64), g = (base / 64) % SG, st = base % 64;
    size_t ci = ((size_t)d * SG + g) * 64 + st;
    float ar = p.S5A[ci * 2], ai = p.S5A[ci * 2 + 1];
    for (int i = 0; i < 6; ++i) { float nr = ar * ar - ai * ai, ni = 2.f * ar * ai; ar = nr; ai = ni; }
    float cr = 0.f, cim = 0.f;
    for (int s = 0; s < NC; ++s) {
        int n = chunk_order(d, s);
        size_t eo = (((size_t)d * NC + n) * SG + g) * 64 + st;
        float er = p.S5END[eo * 2], ei = p.S5END[eo * 2 + 1];
        p.S5END[eo * 2] = cr; p.S5END[eo * 2 + 1] = cim;
        float nr = ar * cr - ai * cim + er, ni = ar * cim + ai * cr + ei;
        cr = nr; cim = ni;
    }
}

__device__ __forceinline__ void phase_side_elem(const P& p, int l) {
    const int lane = otid() & 63;
    const int gw = (obid() * NTHREADS + otid()) >> 6, nw = (gridDim.x * NTHREADS) >> 6;
    const bool actg = lane * 8 < GLA_V, actr = lane * 8 < RW;
    float gng[8], lnw[8], lnb[8];
#pragma unroll
    for (int e = 0; e < 8; ++e) { gng[e] = 0.f; lnw[e] = 0.f; lnb[e] = 0.f; }
    if (actg) load8f(p.in[I_GLA_NG] + (size_t)l * 128 + ((lane * 8) & 127), gng);
    if (actr) { load8f(p.in[I_RLNW] + (size_t)l * RW + lane * 8, lnw); load8f(p.in[I_RLNB] + (size_t)l * RW + lane * 8, lnb); }
    for (int t = gw; t < MTOT; t += nw) {
        float og[8], zo[8], y0[8], y1[8], vv[8];
        const u32x4 z4 = {0u, 0u, 0u, 0u};
#pragma unroll
        for (int e = 0; e < 8; ++e) { og[e] = 0.f; y0[e] = 0.f; y1[e] = 0.f; }
        if (actg) load8f(p.OGLA + (size_t)t * GLA_V + lane * 8, og);
        unpack8(actg ? *(const u32x4*)(p.Z + (size_t)t * D_IN + ZOG + lane * 8) : z4, zo);
        if (actr) { load8f(p.Y + (size_t)t * RW + lane * 8, y0); load8f(p.Y + ((size_t)MTOT + t) * RW + lane * 8, y1); }
        unpack8(actr ? *(const u32x4*)(p.V + (size_t)t * RW + lane * 8) : z4, vv);
        const int hh = (lane * 8) >> 6;
        const float bon = actr ? (p.BONUS[(size_t)t * RH + hh] + p.BONUS[((size_t)MTOT + t) * RH + hh]) : 0.f;
        float ss = 0.f;
#pragma unroll
        for (int e = 0; e < 8; ++e) ss += og[e] * og[e];
        ss += __shfl_xor(ss, 1, 64); ss += __shfl_xor(ss, 2, 64); ss += __shfl_xor(ss, 4, 64); ss += __shfl_xor(ss, 8, 64);
        const float rstd = rsqrtf(ss * (1.0f / 128.f) + 1e-6f);
        float br[8];
#pragma unroll
        for (int e = 0; e < 8; ++e) br[e] = og[e] * rstd * gng[e] * siluf_(zo[e]);
        if (actg) *(u32x4*)(p.BR + (size_t)t * 3 * BW + lane * 8) = pack8(br);
        float y[8]; float sm = 0.f;
#pragma unroll
        for (int e = 0; e < 8; ++e) { y[e] = y0[e] + y1[e]; sm += y[e]; }
        sm += __shfl_xor(sm, 1, 64); sm += __shfl_xor(sm, 2, 64); sm += __shfl_xor(sm, 4, 64);
        const float mu = sm * (1.0f / 64.f);
        float sv = 0.f;
#pragma unroll
        for (int e = 0; e < 8; ++e) { y[e] -= mu; sv += y[e] * y[e]; }
        sv += __shfl_xor(sv, 1, 64); sv += __shfl_xor(sv, 2, 64); sv += __shfl_xor(sv, 4, 64);
        const float rs = rsqrtf(sv * (1.0f / 64.f) + 64e-5f);
        float yn[8];
#pragma unroll
        for (int e = 0; e < 8; ++e) yn[e] = y[e] * rs * lnw[e] + lnb[e] + bon * vv[e];
        if (actr) store8f(p.YN + (size_t)t * RW + lane * 8, yn);
    }
}

__device__ __forceinline__ void phase_side_gemm(const P& p, int l, char* smem) {
    const int ntm = MTOT / 128, nt1 = NPAD(RW) / 128, nt2 = (2 * SW) / 128;
    for (int job = obid(); job < ntm * (nt1 + nt2); job += gridDim.x) {
        const int m0 = (job / (nt1 + nt2)) * 128, jn = job % (nt1 + nt2);
        f32x4 acc[4][4]; ZERO_ACC4(acc);
        if (jn < nt1) {
            const int n0 = jn * 128;
            mfma_gemm_tile(p.WT_G2, 128, p.GS, 128, 128, n0, m0, (bf16_t*)smem, acc);
            FOR_ACC(acc, n0, m0, { if (n < RW) { const float4 y = *(const float4*)(p.YN + (size_t)m * RW + n);
                *(u32x2*)(p.BR + (size_t)m * 3 * BW + BW + n) = pack4(y.x * v[0], y.y * v[1], y.z * v[2], y.w * v[3]); } })
        } else {
            const int n0 = (jn - nt1) * 128;
            mfma_gemm_tile(p.WT_GLU, SW, p.GY, SW, SW, n0, m0, (bf16_t*)smem, acc);
            FOR_ACC(acc, n0, m0, { const unsigned w = (unsigned)f2bf(v[0] * sigmoidf_(v[1])) | ((unsigned)f2bf(v[2] * sigmoidf_(v[3])) << 16);
                *(unsigned*)(p.BR + (size_t)m * 3 * BW + 2 * BW + (n >> 1)) = w; })
        }
    }
}

__device__ __forceinline__ void phase_merge(const P& p, int l, char* smem) {
    const int ntm = MTOT / 128, ntn = D_MODEL / 128;
    for (int job = obid(); job < ntm * ntn; job += gridDim.x) {
        const int m0 = (job / ntn) * 128, n0 = (job % ntn) * 128;
        f32x4 macc[4][4]; ZERO_ACC4(macc);
        for (int b = 0; b < 3; ++b) {
            f32x4 acc[4][4]; ZERO_ACC4(acc);
            mfma_gemm_tile(p.WT_BR + (size_t)b * D_MODEL * BW, BW, p.BR + b * BW, 3 * BW, BW, n0, m0, (bf16_t*)smem, acc);
            const int lane_ = otid() & 63, wave_ = otid() >> 6;
#pragma unroll
            for (int ni = 0; ni < 4; ++ni)
#pragma unroll
                for (int mi = 0; mi < 4; ++mi) {
                    const int n = n0 + (wave_ >> 1) * 64 + ni * 16 + (lane_ >> 4) * 4, m = m0 + (wave_ & 1) * 64 + mi * 16 + (lane_ & 15);
                    const u32x2 g = *(const u32x2*)(p.Z + (size_t)m * D_IN + ZG + b * D_MODEL + n);
                    macc[ni][mi][0] += sigmoidf_(bf2f((bf16_t)(g.x & 0xFFFF))) * acc[ni][mi][0];
                    macc[ni][mi][1] += sigmoidf_(bf2f((bf16_t)(g.x >> 16))) * acc[ni][mi][1];
                    macc[ni][mi][2] += sigmoidf_(bf2f((bf16_t)(g.y & 0xFFFF))) * acc[ni][mi][2];
                    macc[ni][mi][3] += sigmoidf_(bf2f((bf16_t)(g.y >> 16))) * acc[ni][mi][3];
                }
        }
        FOR_ACC(macc, n0, m0, { *(u32x2*)(p.M + (size_t)m * D_MODEL + n) = pack4(v[0], v[1], v[2], v[3]); })
    }
}

__device__ __forceinline__ void phase_outproj(const P& p, int l, char* smem) {
    const int ntm = MTOT / 128, ntn = D_MODEL / 128;
    for (int job = obid(); job < ntm * ntn; job += gridDim.x) {
        const int m0 = (job / ntn) * 128, n0 = (job % ntn) * 128;
        f32x4 acc[4][4]; ZERO_ACC4(acc);
        mfma_gemm_tile(p.WT_OUT, D_MODEL, p.M, D_MODEL, D_MODEL, n0, m0, (bf16_t*)smem, acc);
        FOR_ACC(acc, n0, m0, { const float* g1 = p.MOD + (size_t)(l * 2 + (m >= CTX ? 1 : 0)) * 6 * D_MODEL + 2 * D_MODEL + n;
            float4* xp = (float4*)(p.X + (size_t)m * D_MODEL + n); float4 x = *xp;
            x.x += g1[0] * v[0]; x.y += g1[1] * v[1]; x.z += g1[2] * v[2]; x.w += g1[3] * v[3]; *xp = x; })
    }
}

__device__ __forceinline__ void store_q_hilo(const P& p, int m, int n, const f32x4 v) {
    const bf16_t h0 = f2bf(v[0]), h1 = f2bf(v[1]), h2 = f2bf(v[2]), h3 = f2bf(v[3]);
    u32x2 hv; hv.x = (unsigned)h0 | ((unsigned)h1 << 16); hv.y = (unsigned)h2 | ((unsigned)h3 << 16);
    *(u32x2*)(p.QHI + (size_t)m * PQ + n) = hv;
    *(u32x2*)(p.QLO + (size_t)m * PQ + n) = pack4(v[0] - bf2f(h0), v[1] - bf2f(h1), v[2] - bf2f(h2), v[3] - bf2f(h3));
}
__device__ __forceinline__ void phase_peer_q(const P& p, int l, char* smem) {
    const int ntm = MTOT / 128, ntn = PQ / 128;
    for (int job = obid(); job < ntm * ntn; job += gridDim.x) {
        const int m0 = (job / ntn) * 128, n0 = (job % ntn) * 128;
        f32x4 acc[4][4]; ZERO_ACC4(acc);
        mfma_gemm_tile(p.WT_Q, D_MODEL, p.H, D_MODEL, D_MODEL, n0, m0, (bf16_t*)smem, acc);
        FOR_ACC(acc, n0, m0, { store_q_hilo(p, m, n, v); })
    }
}

#define TK_ROW 129
#define TK_INSERT(lv, li, xv, xi) { float x_ = (xv); int i_ = (xi); _Pragma("unroll") for (int z_ = 0; z_ < 16; ++z_) { const bool g_ = x_ > lv[z_]; \
    const float tv_ = g_ ? lv[z_] : x_; const int ti_ = g_ ? li[z_] : i_; lv[z_] = g_ ? x_ : lv[z_]; li[z_] = g_ ? i_ : li[z_]; x_ = tv_; i_ = ti_; } }
__device__ __forceinline__ void phase_peer_topk(const P& p, int l, char* smem) {
    const int tid = otid(), lane = tid & 63, wv = tid >> 6, q = lane >> 4, r = lane & 15;
    float* sc = (float*)smem + wv * (64 * TK_ROW);
    const int gw = (obid() * NTHREADS + tid) >> 6, nw = (gridDim.x * NTHREADS) >> 6;
    const float NEG = -3.0e38f;
    for (int job = gw; job < (MTOT / 32) * PH; job += nw) {
        const int t0 = (job / PH) * 32, h = job % PH;
#pragma unroll
        for (int sd = 0; sd < 2; ++sd) {
            f32x4 acc[2][8];
#pragma unroll
            for (int mt = 0; mt < 2; ++mt)
#pragma unroll
                for (int nt = 0; nt < 8; ++nt) acc[mt][nt] = (f32x4){0.f, 0.f, 0.f, 0.f};
#pragma unroll
            for (int ks = 0; ks < 4; ++ks) {
                bf16x8 ah[2], al[2];
#pragma unroll
                for (int mt = 0; mt < 2; ++mt) {
                    const size_t qo = (size_t)(t0 + mt * 16 + r) * PQ + h * 256 + sd * 128 + ks * 32 + q * 8;
                    ah[mt] = *(const bf16x8*)(p.QHI + qo); al[mt] = *(const bf16x8*)(p.QLO + qo);
                }
#pragma unroll
                for (int nt = 0; nt < 8; ++nt) {
                    const size_t ko = ((size_t)(h * 2 + sd) * 128 + nt * 16 + r) * 128 + ks * 32 + q * 8;
                    const bf16x8 bh = *(const bf16x8*)(p.KHI + ko), bl = *(const bf16x8*)(p.KLO + ko);
#pragma unroll
                    for (int mt = 0; mt < 2; ++mt) {
                        acc[mt][nt] = MFMA16(ah[mt], bh, acc[mt][nt]);
                        acc[mt][nt] = MFMA16(al[mt], bh, acc[mt][nt]);
                        acc[mt][nt] = MFMA16(ah[mt], bl, acc[mt][nt]);
                    }
                }
            }
#pragma unroll
            for (int mt = 0; mt < 2; ++mt)
#pragma unroll
                for (int nt = 0; nt < 8; ++nt)
#pragma unroll
                    for (int e = 0; e < 4; ++e) sc[(sd * 32 + mt * 16 + 4 * q + e) * TK_ROW + nt * 16 + r] = acc[mt][nt][e];
        }
        WAVE_SYNC();
        float lv[16]; int li[16];
#pragma unroll
        for (int z = 0; z < 16; ++z) { lv[z] = NEG; li[z] = 0; }
        {
            const float* row = sc + lane * TK_ROW;
#pragma unroll 4
            for (int k = 0; k < 128; ++k) TK_INSERT(lv, li, row[k], k);
        }
        WAVE_SYNC();
        {
            float* row = sc + lane * TK_ROW;
#pragma unroll
            for (int z = 0; z < 16; ++z) { row[z] = lv[z]; ((int*)row)[16 + z] = li[z]; }
        }
        WAVE_SYNC();
        const float* r1 = sc + (lane & 31) * TK_ROW; const float* r2 = sc + (32 + (lane & 31)) * TK_ROW;
        float tv[16]; int tc[16];
#pragma unroll
        for (int z = 0; z < 16; ++z) { tv[z] = NEG; tc[z] = 0; }
        for (int i = 0; i < 16; ++i) {
            const float a = r1[i];
            const int nj = 16 / (i + 1);
            for (int j = 0; j < nj; ++j) TK_INSERT(tv, tc, a + r2[j], i * 16 + j);
        }
        if (lane < 32) {
            float vals[16]; float mx = 0.f; float ssum = 0.f;
#pragma unroll
            for (int z = 0; z < 16; ++z) { vals[z] = r1[tc[z] >> 4] + r2[tc[z] & 15]; if (z == 0) mx = vals[0]; vals[z] = expf(vals[z] - mx); ssum += vals[z]; }
            const float inv = 1.0f / ssum;
            const size_t o = (size_t)(t0 + lane) * PH * 16 + h * 16;
#pragma unroll
            for (int z = 0; z < 16; ++z) {
                const int ex_ = ((const int*)r1)[16 + (tc[z] >> 4)] * 128 + ((const int*)r2)[16 + (tc[z] & 15)];
                p.IDX[o + z] = ex_;
                p.G[o + z] = vals[z] * inv * p.VSC[ex_];
                p.GU[o + z] = p.USC[ex_];
            }
        }
        WAVE_SYNC();
    }
}

#define PEER_CONV_JOBS (2 * NEXP / 4)
__device__ __forceinline__ void peer_conv_job(const P& p, int l, int job) {
    const int tid = otid(), lane = tid & 63, wv = tid >> 6;
    if (wv >= 4) return;
    const int rowg = job * 4 + wv; const int which = rowg / NEXP, row = rowg % NEXP;
    const float* src = p.in[which ? I_PV : I_PU] + ((size_t)l * NEXP + row) * D_MODEL + lane * 16;
    const bool act = lane * 16 < D_MODEL;
    float v[16]; float amax = 0.f;
#pragma unroll
    for (int c = 0; c < 4; ++c) {
        float4 a; a.x = 0.f; a.y = 0.f; a.z = 0.f; a.w = 0.f;
        if (act) a = *(const float4*)(src + c * 4);
        v[c * 4 + 0] = a.x; v[c * 4 + 1] = a.y; v[c * 4 + 2] = a.z; v[c * 4 + 3] = a.w;
        amax = fmaxf(amax, fmaxf(fmaxf(fabsf(a.x), fabsf(a.y)), fmaxf(fabsf(a.z), fabsf(a.w))));
    }
#pragma unroll
    for (int m = 32; m >= 1; m >>= 1) amax = fmaxf(amax, __shfl_xor(amax, m, 64));
    int ex = 0;
    if (amax > 0.f) ex = 7 - (int)((__builtin_bit_cast(unsigned, amax) >> 23) & 0xFF) + 127;
    ex = ex < -100 ? -100 : (ex > 100 ? 100 : ex);
    const float sc = __builtin_bit_cast(float, (unsigned)(ex + 127) << 23), isc = __builtin_bit_cast(float, (unsigned)(127 - ex) << 23);
    u32x4 o;
    int w0 = 0, w1 = 0, w2 = 0, w3 = 0;
    w0 = CVT_PK_FP8(v[0] * sc, v[1] * sc, w0, false); w0 = CVT_PK_FP8(v[2] * sc, v[3] * sc, w0, true);
    w1 = CVT_PK_FP8(v[4] * sc, v[5] * sc, w1, false); w1 = CVT_PK_FP8(v[6] * sc, v[7] * sc, w1, true);
    w2 = CVT_PK_FP8(v[8] * sc, v[9] * sc, w2, false); w2 = CVT_PK_FP8(v[10] * sc, v[11] * sc, w2, true);
    w3 = CVT_PK_FP8(v[12] * sc, v[13] * sc, w3, false); w3 = CVT_PK_FP8(v[14] * sc, v[15] * sc, w3, true);
    o.x = (unsigned)w0; o.y = (unsigned)w1; o.z = (unsigned)w2; o.w = (unsigned)w3;
    unsigned char* dst = (which ? p.V8 : p.U8) + (size_t)row * D_MODEL + lane * 16;
    if (act) *(u32x4*)dst = o;
    if (lane == 0) (which ? p.VSC : p.USC)[row] = isc;
}
#define GE 8
struct GBuf { u32x4 u[GE]; u32x4 v[GE]; float gu; float gv; };
__device__ __forceinline__ void gather_load(const P& p, GBuf& b, int g, int idx0, int idx1, float g0, float g1, float u0, float u1, int lane) {
    const bool act = lane * 16 < D_MODEL;
#pragma unroll
    for (int q = 0; q < GE; ++q) {
        const int k = g * GE + q;
        const int ei = __shfl((k < 64) ? idx0 : idx1, k & 63, 64);
        b.u[q] = act ? *(const u32x4*)(p.U8 + (size_t)ei * D_MODEL + lane * 16) : (u32x4){0u, 0u, 0u, 0u};
        b.v[q] = act ? *(const u32x4*)(p.V8 + (size_t)ei * D_MODEL + lane * 16) : (u32x4){0u, 0u, 0u, 0u};
    }
    const int km = g * GE + ((lane >> 3) & 7);
    b.gv = __shfl((km < 64) ? g0 : g1, km & 63, 64);
    b.gu = __shfl((km < 64) ? u0 : u1, km & 63, 64);
}
__device__ __forceinline__ void gather_compute(const GBuf& b, const float (&hv)[16], float (&acc)[16], int lane) {
    float dt[GE];
#pragma unroll
    for (int q = 0; q < GE; ++q) {
        float d = 0.f;
#pragma unroll
        for (int c = 0; c < 4; ++c) {
            const f32x2 lo = CVT_PK_F32_FP8((int)b.u[q][c], false), hi = CVT_PK_F32_FP8((int)b.u[q][c], true);
            d += hv[c * 4 + 0] * lo.x + hv[c * 4 + 1] * lo.y + hv[c * 4 + 2] * hi.x + hv[c * 4 + 3] * hi.y;
        }
        dt[q] = d;
    }
    float r4[4], r2[2], r1;
    {
        const bool up = (lane & 32) != 0;
#pragma unroll
        for (int q = 0; q < 4; ++q) { const float keep = up ? dt[4 + q] : dt[q], send = up ? dt[q] : dt[4 + q]; r4[q] = keep + __shfl_xor(send, 32, 64); }
    }
    {
        const bool up = (lane & 16) != 0;
#pragma unroll
        for (int q = 0; q < 2; ++q) { const float keep = up ? r4[2 + q] : r4[q], send = up ? r4[q] : r4[2 + q]; r2[q] = keep + __shfl_xor(send, 16, 64); }
    }
    {
        const bool up = (lane & 8) != 0;
        const float keep = up ? r2[1] : r2[0], send = up ? r2[0] : r2[1];
        r1 = keep + __shfl_xor(send, 8, 64);
    }
    r1 += __shfl_xor(r1, 4, 64); r1 += __shfl_xor(r1, 2, 64); r1 += __shfl_xor(r1, 1, 64);
    const float coef_mine = b.gv * geluf_(r1 * b.gu);
#pragma unroll
    for (int q = 0; q < GE; ++q) {
        const float coef = __shfl(coef_mine, q * 8, 64);
#pragma unroll
        for (int c = 0; c < 4; ++c) {
            const f32x2 lo = CVT_PK_F32_FP8((int)b.v[q][c], false), hi = CVT_PK_F32_FP8((int)b.v[q][c], true);
            acc[c * 4 + 0] += coef * lo.x; acc[c * 4 + 1] += coef * lo.y; acc[c * 4 + 2] += coef * hi.x; acc[c * 4 + 3] += coef * hi.y;
        }
    }
}
__device__ __forceinline__ void phase_peer_gather(const P& p, int l) {
    const int lane = otid() & 63;
    const int gw = (obid() * NTHREADS + otid()) >> 6, nw = (gridDim.x * NTHREADS) >> 6;
    constexpr int NG = PH * 16 / GE;
    const bool act = lane * 16 < D_MODEL;
    for (int t = gw; t < MTOT; t += nw) {
        float hv[16], acc[16];
        {
            const u32x4 z4 = {0u, 0u, 0u, 0u};
            const u32x4 ha = act ? *(const u32x4*)(p.H + (size_t)t * D_MODEL + lane * 16) : z4;
            const u32x4 hb = act ? *(const u32x4*)(p.H + (size_t)t * D_MODEL + lane * 16 + 8) : z4;
            hv[0] = LO16(ha.x); hv[1] = HI16(ha.x); hv[2] = LO16(ha.y); hv[3] = HI16(ha.y); hv[4] = LO16(ha.z); hv[5] = HI16(ha.z); hv[6] = LO16(ha.w); hv[7] = HI16(ha.w);
            hv[8] = LO16(hb.x); hv[9] = HI16(hb.x); hv[10] = LO16(hb.y); hv[11] = HI16(hb.y); hv[12] = LO16(hb.z); hv[13] = HI16(hb.z); hv[14] = LO16(hb.w); hv[15] = HI16(hb.w);
#pragma unroll
            for (int j = 0; j < 16; ++j) acc[j] = 0.f;
        }
        int idx0 = 0, idx1 = 0; float g0 = 0.f, g1 = 0.f, u0 = 0.f, u1 = 0.f;
        if (lane < PH * 16) { idx0 = p.IDX[(size_t)t * PH * 16 + lane]; g0 = p.G[(size_t)t * PH * 16 + lane]; u0 = p.GU[(size_t)t * PH * 16 + lane]; }
        if (64 + lane < PH * 16) { idx1 = p.IDX[(size_t)t * PH * 16 + 64 + lane]; g1 = p.G[(size_t)t * PH * 16 + 64 + lane]; u1 = p.GU[(size_t)t * PH * 16 + 64 + lane]; }
        GBuf ba, bb;
        gather_load(p, ba, 0, idx0, idx1, g0, g1, u0, u1, lane);
        for (int g = 0; g < NG; g += 2) {
            gather_load(p, bb, g + 1, idx0, idx1, g0, g1, u0, u1, lane);
            gather_compute(ba, hv, acc, lane);
            if (g + 2 < NG) gather_load(p, ba, g + 2, idx0, idx1, g0, g1, u0, u1, lane);
            gather_compute(bb, hv, acc, lane);
        }
        if (act) {
            const float* g2 = p.MOD + (size_t)(l * 2 + (t >= CTX ? 1 : 0)) * 6 * D_MODEL + 5 * D_MODEL + lane * 16;
            float* xp = p.X + (size_t)t * D_MODEL + lane * 16;
#pragma unroll
            for (int c = 0; c < 4; ++c) {
                float4 x = *(float4*)(xp + c * 4);
                x.x += g2[c * 4 + 0] * acc[c * 4 + 0]; x.y += g2[c * 4 + 1] * acc[c * 4 + 1]; x.z += g2[c * 4 + 2] * acc[c * 4 + 2]; x.w += g2[c * 4 + 3] * acc[c * 4 + 3];
                *(float4*)(xp + c * 4) = x;
            }
        }
    }
}

__device__ __forceinline__ void phase_final(const P& p) {
    const int lane = otid() & 63;
    const int gw = (obid() * NTHREADS + otid()) >> 6, nw = (gridDim.x * NTHREADS) >> 6;
    const float* g = p.in[I_FG];
    for (int t = gw; t < SEQ; t += nw) {
        const float* x = p.X + (size_t)(CTX + t) * D_MODEL;
        float v[D_MODEL / 64]; float ss = 0.f;
#pragma unroll
        for (int j = 0; j < D_MODEL / 64; ++j) { v[j] = x[lane + 64 * j]; ss += v[j] * v[j]; }
        ss = wave_sum(ss);
        float rstd = rsqrtf(ss / D_MODEL + 1e-6f);
#pragma unroll
        for (int j = 0; j < D_MODEL / 64; ++j) p.out[(size_t)t * D_MODEL + lane + 64 * j] = v[j] * rstd * g[lane + 64 * j];
    }
}

__global__ void __launch_bounds__(NTHREADS) fwd_megakernel(P p_arg) {
#ifdef EMU
    char* smem = emu_smem();
#else
    __shared__ __attribute__((aligned(16))) char smem_raw[SMEM_BYTES + 16];
    char* smem = smem_raw;
#endif
#ifndef EMU
    volatile LAS unsigned* xst = (volatile LAS unsigned*)(smem_raw + SMEM_BYTES);
    if (threadIdx.x == 0) { xst[0] = 0u; xst[1] = 0u; xst[2] = 0u; xst[3] = 0u; }
    __syncthreads();
    XcdBarrier xb = xcd_barrier_post(p_arg.bar, xst);
#endif
    { LOADP(); phase_init(p, smem); }
#ifndef EMU
    cg::this_grid().sync();
#endif
    GRID_SYNC();
    PROBE_INIT();
    for (int l = 0; l < DEPTH; ++l) {
        { LOADP(); phase_norm(p, l, 0); }
        { LOADP(); phase_s5const(p, l); }
        { LOADP(); phase_convert_weights(p, l, smem); }
        GRID_SYNC(); PROBE_AFTER(0);
        { LOADP(); phase_gemm_in(p, l, smem); }
        GRID_SYNC(); PROBE_AFTER(1);
        { LOADP(); phase_rwkv_prep1(p, l); }
        GRID_SYNC(); PROBE_AFTER(14);
        { LOADP(); phase_rwkv_prep2(p, l, smem); }
        GRID_SYNC(); PROBE_AFTER(2);
        { LOADP(); for (int job = obid(); job < 2 * NC * RH; job += gridDim.x) rwkv_chunk_job(p, job, smem); }
        __syncthreads();
        { LOADP(); phase_gla_kv(p, l, smem); }
        { LOADP(); for (int job = obid(); job < NC * SG; job += gridDim.x) s5_local_job(p, job, smem, false); }
        __syncthreads();
        GRID_SYNC(); PROBE_AFTER(3);
        {
            LOADP();
            const int n_rw = 2 * RH, n_gla = 2 * GH * 8192 / NTHREADS, n_s5 = (2 * SG * 64 + NTHREADS - 1) / NTHREADS;
            for (int job = obid(); job < n_rw + n_gla + n_s5 + PEER_CONV_JOBS; job += gridDim.x) {
                if (job < n_rw) rwkv_seq_job(p, job);
                else if (job < n_rw + n_gla) gla_scan_job(p, job - n_rw);
                else if (job < n_rw + n_gla + n_s5) s5_carry_job(p, job - n_rw - n_gla);
                else peer_conv_job(p, l, job - n_rw - n_gla - n_s5);
            }
        }
        GRID_SYNC(); PROBE_AFTER(4);
        { LOADP(); for (int job = obid(); job < 2 * NC * RH; job += gridDim.x) rwkv_out_job(p, job); }
        { LOADP(); phase_gla_out(p, l, smem); }
        { LOADP(); for (int job = obid(); job < NC * SG; job += gridDim.x) s5_out_job(p, l, job, smem); }
        GRID_SYNC(); PROBE_AFTER(5);
        { LOADP(); phase_side_elem(p, l); }
        GRID_SYNC(); PROBE_AFTER(6);
        { LOADP(); phase_side_gemm(p, l, smem); }
        GRID_SYNC(); PROBE_AFTER(7);
        { LOADP(); phase_merge(p, l, smem); }
        GRID_SYNC(); PROBE_AFTER(8);
        { LOADP(); phase_outproj(p, l, smem); }
        GRID_SYNC(); PROBE_AFTER(9);
        { LOADP(); phase_norm(p, l, 1); }
        GRID_SYNC(); PROBE_AFTER(10);
        { LOADP(); phase_peer_q(p, l, smem); }
        GRID_SYNC(); PROBE_AFTER(11);
        { LOADP(); phase_peer_topk(p, l, smem); }
        GRID_SYNC(); PROBE_AFTER(12);
        { LOADP(); phase_peer_gather(p, l); }
        GRID_SYNC(); PROBE_AFTER(13);
    }
    { LOADP(); phase_final(p); }
}

static inline size_t align_up(size_t x) { return (x + 255) & ~(size_t)255; }

extern "C" void kernel_launch(void* const* d_in, const int* in_sizes, int n_in, void* d_out, int out_size, void* d_ws, size_t ws_size, hipStream_t stream) {
    P p;
    memset(&p, 0, sizeof(p));
    for (int i = 0; i < 39; ++i) p.in[i] = (const float*)d_in[i];
    p.out = (float*)d_out;
    char* w = (char*)d_ws; size_t off = 0;
    auto take = [&](size_t bytes) { void* r = w + off; off = align_up(off + bytes); return r; };
    p.bar = (unsigned*)take(16384);
    p.X = (float*)take((size_t)MTOT * D_MODEL * 4);
    p.H = (bf16_t*)take((size_t)MTOT * D_MODEL * 2);
    p.MOD = (float*)take((size_t)DEPTH * 2 * 6 * D_MODEL * 4);
    p.Z = (bf16_t*)take((size_t)MTOT * D_IN * 2);
    p.V = (bf16_t*)take((size_t)MTOT * RW * 2);
    {
        char* ra = (char*)take((size_t)MTOT * RW * 2 * 2 > (size_t)MTOT * GLA_V * 4 ? (size_t)MTOT * RW * 2 * 2 : (size_t)MTOT * GLA_V * 4);
        p.R = (bf16_t*)ra; p.KK = (bf16_t*)(ra + (size_t)MTOT * RW * 2);
        p.OGLA = (float*)ra;
    }
    {
        char* rb = (char*)take((size_t)2 * MTOT * RW * 2 > (size_t)3 * MTOT * PH * 16 * 4 ? (size_t)2 * MTOT * RW * 2 : (size_t)3 * MTOT * PH * 16 * 4);
        p.KD = (bf16_t*)rb;
        p.IDX = (int*)rb; p.G = (float*)(rb + (size_t)MTOT * PH * 16 * 4); p.GU = (float*)(rb + (size_t)2 * MTOT * PH * 16 * 4);
    }
    p.BB = (bf16_t*)take((size_t)2 * MTOT * RW * 2);
    p.LW = (float*)take((size_t)2 * MTOT * RW * 4);
    p.SP = (bf16_t*)p.LW;
    static_assert((size_t)2 * NC * GH * 8192 * 2 <= (size_t)2 * MTOT * RW * 4, "SP alias");
    p.BONUS = (float*)take((size_t)2 * MTOT * RH * 4);
    p.KS = (bf16_t*)take((size_t)MTOT * RW * 2);
    p.LR = (bf16_t*)take((size_t)MTOT * 256 * 2);
    p.WT_W2 = (bf16_t*)take((size_t)2 * NPAD(RW) * 64 * 2);
    p.WT_A2 = (bf16_t*)take((size_t)2 * NPAD(RW) * 64 * 2);
    p.GS = (bf16_t*)take((size_t)MTOT * 128 * 2);
    p.Y = (float*)take((size_t)2 * MTOT * RW * 4);
    p.KV = (float*)take((size_t)2 * NC * GH * 8192 * 4);
    p.DEC = (float*)take((size_t)2 * NC * GH * 64 * 4);
    p.S5A = (float*)take((size_t)2 * SG * 64 * 2 * 4);
    p.S5BB = (float*)take((size_t)2 * SG * 64 * 16 * 2 * 4);
    p.S5END = (float*)take((size_t)2 * NC * SG * 64 * 2 * 4);
    {
        const size_t szc1 = (size_t)2 * NC * RH * 8192 * 2 + (size_t)2 * NC * RH * 4096 * 4;
        const size_t szc2 = (size_t)MTOT * SW * 2 + (size_t)MTOT * RW * 4 + (size_t)MTOT * 3 * BW * 2 + (size_t)MTOT * D_MODEL * 2 + 1024;
        char* rc = (char*)take(szc1 > szc2 ? szc1 : szc2);
        p.MTF = (bf16_t*)rc; p.NTF = (float*)(rc + (size_t)2 * NC * RH * 8192 * 2);
        char* c2 = rc;
        p.GY = (bf16_t*)c2; c2 += align_up((size_t)MTOT * SW * 2);
        p.YN = (float*)c2; c2 += align_up((size_t)MTOT * RW * 4);
        p.BR = (bf16_t*)c2; c2 += align_up((size_t)MTOT * 3 * BW * 2);
        p.M = (bf16_t*)c2;
    }
    p.SN = (bf16_t*)take((size_t)2 * NC * RH * 4096 * 2);
    p.QH = (bf16_t*)take((size_t)2 * NC * RH * 4096 * 2);
    p.WT_IN = (bf16_t*)take((size_t)NPAD(D_IN) * D_MODEL * 2);
    p.WT_G2 = (bf16_t*)take((size_t)NPAD(RW) * 128 * 2);
    p.WT_GLU = (bf16_t*)take((size_t)NPAD(2 * SW) * SW * 2);
    p.WT_BR = (bf16_t*)take((size_t)3 * D_MODEL * BW * 2);
    p.WT_OUT = (bf16_t*)take((size_t)D_MODEL * D_MODEL * 2);
    p.WT_Q = (bf16_t*)take((size_t)PQ * D_MODEL * 2);
    p.U8 = (unsigned char*)take((size_t)NEXP * D_MODEL);
    p.V8 = (unsigned char*)take((size_t)NEXP * D_MODEL);
    p.USC = (float*)take((size_t)NEXP * 4); p.VSC = (float*)take((size_t)NEXP * 4);
    p.QHI = p.Z; p.QLO = p.Z + (size_t)MTOT * PQ;
    p.KHI = (bf16_t*)take((size_t)PH * 2 * 128 * 128 * 2); p.KLO = (bf16_t*)take((size_t)PH * 2 * 128 * 128 * 2);
    static_assert((size_t)PQ * 4 <= (size_t)D_IN * 2, "Q alias");
    if (off > ws_size) { fprintf(stderr, "ws too small: need %zu have %zu\n", off, ws_size); return; }
#ifdef EMU
    fprintf(stderr, "ws used %zu MB\n", off >> 20);
    emu_launch([=] { fwd_megakernel(p); }, EMU_GRID, NTHREADS);
#else
    hipMemsetAsync(p.bar, 0, 16384, stream);
    static int grid_blocks = 0;
    if (!grid_blocks) {
        int dev = 0, cus = 0, per_cu = 0;
        hipGetDevice(&dev);
        hipDeviceGetAttribute(&cus, hipDeviceAttributeMultiprocessorCount, dev);
        hipOccupancyMaxActiveBlocksPerMultiprocessor(&per_cu, fwd_megakernel, NTHREADS, 0);
        if (per_cu > 1) per_cu = 1;
        grid_blocks = cus * per_cu;
    }
    void* args[] = {&p};
    hipError_t e = hipLaunchCooperativeKernel((void*)fwd_megakernel, dim3(grid_blocks), dim3(NTHREADS), args, 0, stream);
    if (e != hipSuccess) fprintf(stderr, "cooperative launch failed: %s (grid %d)\n", hipGetErrorString(e), grid_blocks);
#endif
}
```

```cpp
#include <hip/hip_runtime.h>
#ifndef EMU
#include <hip/hip_cooperative_groups.h>
namespace cg = cooperative_groups;
#endif
#include <cstdio>
#include <cstdint>
#include <cstring>

#ifdef CFG_SMALL
#define D_MODEL 128
#define SEQ 512
#define DEPTH 2
#define GRID_W 8
#define CTX 128
#define GH 1
#define RH 2
#define SG 8
#define PH 2
#else
#define D_MODEL 1024
#define SEQ 16384
#define DEPTH 4
#define GRID_W 64
#define CTX 256
#define GH 4
#define RH 8
#define SG 32
#define PH 8
#endif
#define MTOT (CTX + SEQ)
#define ROWS (SEQ / GRID_W)
#define GLA_K (GH * 64)
#define GLA_V (GH * 128)
#define RW (RH * 64)
#define RWKV_IN (3 * RW + 4 * 64 + 128)
#define SW (SG * 16)
#define BW GLA_V
#define ZQ 0
#define ZK (GLA_K)
#define ZV (2 * GLA_K)
#define ZOG (ZV + GLA_V)
#define ZAF (ZOG + GLA_V)
#define ZAB (ZAF + 16)
#define ZR (ZAB + 16)
#define ZS5 (ZR + RWKV_IN)
#define ZG (ZS5 + SW)
#define D_IN (ZG + 3 * D_MODEL)
#define NC (MTOT / 64)
#define NCC (CTX / 64)
#define RB (ROWS / 64)
#define PQ (PH * 256)
#define NEXP 16384
#define NTHREADS 256
#define SMEM_BYTES 133120

typedef unsigned short bf16_t;
typedef short bf16x8 __attribute__((ext_vector_type(8)));
typedef float f32x4 __attribute__((ext_vector_type(4)));
typedef unsigned u32x4 __attribute__((ext_vector_type(4)));
typedef unsigned u32x2 __attribute__((ext_vector_type(2)));
#ifdef EMU
#define MFMA16(a, b, c) emu_mfma_16x16x32_bf16(a, b, c)
#else
#define MFMA16(a, b, c) __builtin_amdgcn_mfma_f32_16x16x32_bf16(a, b, c, 0, 0, 0)
#endif
typedef float f32x2 __attribute__((ext_vector_type(2)));
#ifdef EMU
#define CVT_PK_FP8(a, b, old, hi) emu_cvt_pk_fp8_f32(a, b, old, hi)
#define CVT_PK_F32_FP8(w, hi) emu_cvt_pk_f32_fp8(w, hi)
#else
#define CVT_PK_FP8(a, b, old, hi) __builtin_amdgcn_cvt_pk_fp8_f32(a, b, old, hi)
#define CVT_PK_F32_FP8(w, hi) __builtin_amdgcn_cvt_pk_f32_fp8(w, hi)
#endif
#define NPAD(n) (((n) + 127) / 128 * 128)

__device__ __forceinline__ float bf2f(bf16_t h) { return __builtin_bit_cast(float, ((unsigned)h) << 16); }
#ifdef EMU
__device__ __forceinline__ bf16_t f2bf(float f) { unsigned u = __builtin_bit_cast(unsigned, f); u += 0x7FFFu + ((u >> 16) & 1u); return (bf16_t)(u >> 16); }
__device__ __forceinline__ unsigned pack2bf(float a, float b) { return (unsigned)f2bf(a) | ((unsigned)f2bf(b) << 16); }
#else
typedef float f2v_t __attribute__((ext_vector_type(2))); typedef __bf16 b2v_t __attribute__((ext_vector_type(2)));
__device__ __forceinline__ bf16_t f2bf(float f) { return __builtin_bit_cast(unsigned short, (__bf16)f); }
__device__ __forceinline__ unsigned pack2bf(float a, float b) { f2v_t v = {a, b}; b2v_t r = __builtin_convertvector(v, b2v_t); return __builtin_bit_cast(unsigned, r); }
#endif
#ifdef EMU
#define fexp_(x) expf(x)
#define flog_(x) logf(x)
#else
#define fexp_(x) __expf(x)
#define flog_(x) __logf(x)
#endif
#define LO16(x) __builtin_bit_cast(float, (x) << 16)
#define HI16(x) __builtin_bit_cast(float, (x) & 0xFFFF0000u)
__device__ __forceinline__ float sigmoidf_(float x) { return 1.0f / (1.0f + fexp_(-x)); }
__device__ __forceinline__ float siluf_(float x) { return x * sigmoidf_(x); }
__device__ __forceinline__ float geluf_(float x) { const float y = 1.5957691216057308f * (x + 0.044715f * x * x * x); return x / (1.0f + fexp_(-y)); }
__device__ __forceinline__ float softplusf_(float x) { return fmaxf(x, 0.f) + flog_(1.0f + fexp_(-fabsf(x))); }
__device__ __forceinline__ float tanhf_(float x) { const float e = fexp_(-2.0f * fabsf(x)); const float t = (1.0f - e) / (1.0f + e); return x < 0.f ? -t : t; }
__device__ __forceinline__ float wave_sum(float v) {
#pragma unroll
    for (int m = 32; m >= 1; m >>= 1) v += __shfl_xor(v, m, 64);
    return v;
}

struct P {
    const float* in[39];
    float* out;
    float* X;
    bf16_t* H;
    bf16_t* Z;
    float* MOD;
    bf16_t* R; bf16_t* V; bf16_t* KK; bf16_t* KD; bf16_t* BB;
    float* LW;
    char* REC;
    bf16_t* SN;
    bf16_t* QH;
    float* BONUS;
    bf16_t* KS;
    bf16_t* LR;
    bf16_t* WT_W2;
    bf16_t* WT_A2;
    bf16_t* GS;
    float* Y;
    float* KV;
    bf16_t* SP;
    float* DEC;
    float* OGLA;
    float* S5A;
    float* S5BB;
    float* S5END;
    float* S5CAR;
    bf16_t* GY;
    float* YN;
    bf16_t* BR;
    bf16_t* M;
    bf16_t* QHI; bf16_t* QLO;
    bf16_t* KHI; bf16_t* KLO;
    int* IDX;
    float* G;
    float* GU;
    unsigned* bar;
    bf16_t* WT_IN;
    bf16_t* WT_G2;
    bf16_t* WT_GLU;
    bf16_t* WT_BR;
    bf16_t* WT_OUT;
    bf16_t* WT_Q;
    unsigned char* U8; unsigned char* V8;
    float* USC; float* VSC;
};

enum { I_X = 0, I_C, I_CTX, I_CCTX, I_WMOD, I_BMOD, I_N1G, I_N2G, I_WIN, I_GLA_WA2, I_GLA_BA, I_GLA_NG, I_RCONV, I_RW0, I_RW2, I_RA0, I_RA2, I_RG2,
       I_RKK, I_RKA, I_RRK, I_RLNW, I_RLNB, I_S5LRE, I_S5LIM, I_S5LS, I_S5BRE, I_S5BIM, I_S5CRE, I_S5CIM, I_S5D, I_S5GLU, I_WBR, I_WOUT, I_PWQ, I_PKEYS, I_PU, I_PV, I_FG };

#ifdef EMU
__device__ __forceinline__ int otid() { return threadIdx.x; }
__device__ __forceinline__ int obid() { return blockIdx.x; }
#else
__device__ __forceinline__ int otid() { int t = threadIdx.x; asm volatile("" : "+v"(t)); return t; }
__device__ __forceinline__ int obid() { int b = blockIdx.x; asm volatile("" : "+s"(b)); return b; }
#endif
#ifdef EMU
#define WAVE_SYNC() emu_wave_barrier()
#ifndef EMU_GRID
#define EMU_GRID 4
#endif
#else
#define WAVE_SYNC() __builtin_amdgcn_wave_barrier()
#endif
#ifndef EMU
#define XB_TMO      128
#define XB_XCNT(j)  (256  + 64 * (j))
#define XB_XSUB(j)  (1280 + 64 * (j))
#define XB_XGEN(j)  (2304 + 64 * (j))
#define XB_TOP      3328
#define XB_TOPGEN   3392
#define XCD_BAR_WORDS 3456
#define XB_SPIN_CAP (1u << 22)
#define LAS __attribute__((address_space(3)))
__device__ __forceinline__ unsigned xb_ld(unsigned* p)              { return __hip_atomic_load(p, __ATOMIC_RELAXED, __HIP_MEMORY_SCOPE_AGENT); }
__device__ __forceinline__ unsigned xb_add(unsigned* p, unsigned v) { return __hip_atomic_fetch_add(p, v, __ATOMIC_RELAXED, __HIP_MEMORY_SCOPE_AGENT); }
__device__ __forceinline__ unsigned xb_xcc_id() { return (unsigned)__builtin_amdgcn_s_getreg((3 << 11) | 20) & 0xFu; }
#define XB_SPIN(cond, bar) do { unsigned _sp = 0; while (cond) { __builtin_amdgcn_s_sleep(1); \
    if ((++_sp & 255u) == 0u) { if (xb_ld(&(bar)[XB_TMO])) break; if (_sp > XB_SPIN_CAP) { atomicAdd(&(bar)[XB_TMO], 1u); break; } } } } while (0)
struct XcdBarrier { unsigned* bar; unsigned x; volatile LAS unsigned* st; };
__device__ __forceinline__ XcdBarrier xcd_barrier_post(unsigned* bar, volatile LAS unsigned* st) {
    XcdBarrier b; b.bar = bar; b.x = xb_xcc_id(); b.st = st;
    if (threadIdx.x == 0) (void)xb_add(&bar[XB_XCNT(b.x)], 1u);
    return b;
}
__device__ __forceinline__ void xcd_barrier_complete(unsigned* bar, unsigned x, unsigned& nloc, unsigned& nx) {
    const unsigned G = gridDim.x * gridDim.y * gridDim.z;
    unsigned sum, cnt, mine, sp = 0u;
    for (;;) {
        sum = 0u; cnt = 0u; mine = 0u;
#pragma unroll
        for (unsigned j = 0; j < 16; ++j) { const unsigned c = xb_ld(&bar[XB_XCNT(j)]); sum += c; cnt += (c > 0u) ? 1u : 0u; mine = (j == x) ? c : mine; }
        if (sum == G) break;
        __builtin_amdgcn_s_sleep(1);
        if ((++sp & 255u) == 0u) { if (xb_ld(&bar[XB_TMO])) break; if (sp > XB_SPIN_CAP) { atomicAdd(&bar[XB_TMO], 1u); break; } }
    }
    nloc = mine > 0u ? mine : 1u; nx = cnt > 0u ? cnt : 1u;
}
__device__ __forceinline__ void xcd_barrier(const XcdBarrier& b) {
    asm volatile("s_waitcnt vmcnt(0)" ::: "memory");
    __syncthreads();
    if (threadIdx.x == 0) {
        unsigned* bar = b.bar;
        __builtin_amdgcn_s_waitcnt(0);
        unsigned nloc = b.st[0], nx = b.st[1];
        if (nloc == 0u) { xcd_barrier_complete(bar, b.x, nloc, nx); b.st[0] = nloc; b.st[1] = nx; }
        const unsigned old = xb_add(&bar[XB_XSUB(b.x)], 1u);
        const unsigned gen = old / nloc;
        if (old + 1u == (gen + 1u) * nloc) {
            __builtin_amdgcn_fence(__ATOMIC_RELEASE, "agent");
            asm volatile("s_waitcnt vmcnt(0)" ::: "memory");
            const unsigned og = xb_add(&bar[XB_TOP], 1u);
            const unsigned tg = og / nx;
            if (og + 1u == (tg + 1u) * nx) xb_add(&bar[XB_TOPGEN], 1u);
            else XB_SPIN(xb_ld(&bar[XB_TOPGEN]) == tg, bar);
            __builtin_amdgcn_fence(__ATOMIC_ACQUIRE, "agent");
            xb_add(&bar[XB_XGEN(b.x)], 1u);
            asm volatile("s_waitcnt vmcnt(0)" ::: "memory");
        } else {
            XB_SPIN(xb_ld(&bar[XB_XGEN(b.x)]) == gen, bar);
            __builtin_amdgcn_fence(__ATOMIC_ACQUIRE, "agent");
            asm volatile("s_waitcnt vmcnt(0)" ::: "memory");
        }
    }
    __syncthreads();
}
#define GRID_SYNC() xcd_barrier(xb)
#else
#define GRID_SYNC() emu_grid_sync()
#endif

#ifdef EMU
#define LOADP() const P& p = p_arg
#else
typedef __attribute__((address_space(4))) const unsigned long long cu64_t;
__device__ __forceinline__ void load_params(P& p) {
    cu64_t* q = (cu64_t*)__builtin_amdgcn_kernarg_segment_ptr();
    asm volatile("" : "+s"(q));
    unsigned long long w[sizeof(P) / 8];
#pragma unroll
    for (int i = 0; i < (int)(sizeof(P) / 8); ++i) w[i] = q[i];
    __builtin_memcpy(&p, w, sizeof(P));
}
#define LOADP() P p; load_params(p)
#endif
#define PROBE_MULT 3
#if defined(PROBE_ID) && !defined(EMU)
#define PROBE_INIT() unsigned long long probe_t0 = wall_clock64()
#define PROBE_AFTER(id) { if (blockIdx.x == 0) { unsigned long long now_ = wall_clock64(); if ((id) == PROBE_ID) { const unsigned long long dt_ = now_ - probe_t0; \
    while (wall_clock64() - now_ < dt_ * PROBE_MULT) __builtin_amdgcn_s_sleep(8); now_ = wall_clock64(); } probe_t0 = now_; } }
#else
#define PROBE_INIT()
#define PROBE_AFTER(id)
#endif
__device__ __forceinline__ int gla_tok(int n, int i) {
    if (n < NCC) return n * 64 + i;
    int m = n - NCC; int col = m / RB, rb = m % RB;
    return CTX + (rb * 64 + i) * GRID_W + col;
}
__device__ __forceinline__ int chunk_order(int d, int s) {
    if (d == 0) return s;
    return (s < NCC) ? (NCC - 1 - s) : (NC - 1 - (s - NCC));
}
__device__ __forceinline__ int tok_order(int d, int s) {
    if (d == 0) return s;
    return (s < CTX) ? (CTX - 1 - s) : (MTOT - 1 - (s - CTX));
}


#define LDS_ROW 72
__device__ __forceinline__ void mfma_gemm_tile(const bf16_t* Wt, int ldw, const bf16_t* Act, int lda, int K, int n0, int m0, bf16_t* lds, f32x4 (&acc)[4][4]) {
    bf16_t* Ws = lds; bf16_t* As = lds + 128 * LDS_ROW;
    const int tid = otid(), lane = tid & 63, wave = tid >> 6, wn = wave >> 1, wm = wave & 1;
    const int lrow = tid >> 3, lkc = (tid & 7) * 8;
    u32x4 pw[4], pa[4];
#pragma unroll
    for (int i = 0; i < 4; ++i) {
        pw[i] = *(const u32x4*)(Wt + (size_t)(n0 + lrow + 32 * i) * ldw + lkc);
        pa[i] = *(const u32x4*)(Act + (size_t)(m0 + lrow + 32 * i) * lda + lkc);
    }
    for (int k0 = 0; k0 < K; k0 += 64) {
        __syncthreads();
#pragma unroll
        for (int i = 0; i < 4; ++i) {
            *(u32x4*)(Ws + (lrow + 32 * i) * LDS_ROW + lkc) = pw[i];
            *(u32x4*)(As + (lrow + 32 * i) * LDS_ROW + lkc) = pa[i];
        }
        __syncthreads();
        if (k0 + 64 < K) {
#pragma unroll
            for (int i = 0; i < 4; ++i) {
                pw[i] = *(const u32x4*)(Wt + (size_t)(n0 + lrow + 32 * i) * ldw + k0 + 64 + lkc);
                pa[i] = *(const u32x4*)(Act + (size_t)(m0 + lrow + 32 * i) * lda + k0 + 64 + lkc);
            }
        }
#pragma unroll
        for (int ks = 0; ks < 2; ++ks) {
            bf16x8 a[4], b[4];
#pragma unroll
            for (int i = 0; i < 4; ++i) {
                a[i] = *(const bf16x8*)(Ws + (wn * 64 + i * 16 + (lane & 15)) * LDS_ROW + ks * 32 + (lane >> 4) * 8);
                b[i] = *(const bf16x8*)(As + (wm * 64 + i * 16 + (lane & 15)) * LDS_ROW + ks * 32 + (lane >> 4) * 8);
            }
#pragma unroll
            for (int ni = 0; ni < 4; ++ni)
#pragma unroll
                for (int mi = 0; mi < 4; ++mi) acc[ni][mi] = MFMA16(a[ni], b[mi], acc[ni][mi]);
        }
    }
}
#define ZERO_ACC4(acc) { _Pragma("unroll") for (int i_ = 0; i_ < 4; ++i_) _Pragma("unroll") for (int j_ = 0; j_ < 4; ++j_) acc[i_][j_] = (f32x4){0.f, 0.f, 0.f, 0.f}; }
#define FOR_ACC(acc, n0, m0, BODY) { const int lane_ = otid() & 63, wave_ = otid() >> 6; \
    _Pragma("unroll") for (int ni_ = 0; ni_ < 4; ++ni_) _Pragma("unroll") for (int mi_ = 0; mi_ < 4; ++mi_) { \
        const int n = (n0) + (wave_ >> 1) * 64 + ni_ * 16 + (lane_ >> 4) * 4; const int m = (m0) + (wave_ & 1) * 64 + mi_ * 16 + (lane_ & 15); const f32x4 v = acc[ni_][mi_]; BODY } }
__device__ __forceinline__ u32x2 pack4(float a, float b, float c, float d) { u32x2 r; r.x = pack2bf(a, b); r.y = pack2bf(c, d); return r; }

__device__ __forceinline__ void convert_wt_job(const float* W, int K, int N, int Npad, bf16_t* out, int job, float* T, int ilv) {
    const int tid = otid();
    const int nkt = K / 64;
    const int n0 = (job / nkt) * 64, k0 = (job % nkt) * 64;
    __syncthreads();
    for (int idx = tid; idx < 4096; idx += NTHREADS) {
        int kk = idx >> 6, nn = idx & 63;
        int nr = n0 + nn; int src = ilv ? ((nr & 1) ? (N / 2 + (nr >> 1)) : (nr >> 1)) : nr;
        T[kk * 65 + nn] = (nr < N) ? W[(size_t)(k0 + kk) * N + src] : 0.f;
    }
    __syncthreads();
    {
        int nn = tid >> 2, part = tid & 3;
        unsigned w[8];
#pragma unroll
        for (int j = 0; j < 8; ++j) w[j] = pack2bf(T[(part * 16 + 2 * j) * 65 + nn], T[(part * 16 + 2 * j + 1) * 65 + nn]);
        u32x4* o = (u32x4*)(out + (size_t)(n0 + nn) * K + k0 + part * 16);
        o[0] = (u32x4){w[0], w[1], w[2], w[3]}; o[1] = (u32x4){w[4], w[5], w[6], w[7]};
    }
}
__device__ __forceinline__ void phase_convert_weights(const P& p, int l, char* smem) {
    float* T = (float*)smem;
    struct Item { const float* W; int K, N, Npad; bf16_t* out; };
    const Item items[12] = {
        {p.in[I_RW2] + ((size_t)l * 2 + 0) * 64 * RW, 64, RW, NPAD(RW), p.WT_W2},
        {p.in[I_RW2] + ((size_t)l * 2 + 1) * 64 * RW, 64, RW, NPAD(RW), p.WT_W2 + (size_t)NPAD(RW) * 64},
        {p.in[I_RA2] + ((size_t)l * 2 + 0) * 64 * RW, 64, RW, NPAD(RW), p.WT_A2},
        {p.in[I_RA2] + ((size_t)l * 2 + 1) * 64 * RW, 64, RW, NPAD(RW), p.WT_A2 + (size_t)NPAD(RW) * 64},
        {p.in[I_WIN] + (size_t)l * D_MODEL * D_IN, D_MODEL, D_IN, NPAD(D_IN), p.WT_IN},
        {p.in[I_RG2] + (size_t)l * 128 * RW, 128, RW, RW, p.WT_G2},
        {p.in[I_S5GLU] + (size_t)l * SW * 2 * SW, SW, 2 * SW, 2 * SW, p.WT_GLU},
        {p.in[I_WBR] + ((size_t)l * 3 + 0) * BW * D_MODEL, BW, D_MODEL, D_MODEL, p.WT_BR},
        {p.in[I_WBR] + ((size_t)l * 3 + 1) * BW * D_MODEL, BW, D_MODEL, D_MODEL, p.WT_BR + (size_t)D_MODEL * BW},
        {p.in[I_WBR] + ((size_t)l * 3 + 2) * BW * D_MODEL, BW, D_MODEL, D_MODEL, p.WT_BR + (size_t)2 * D_MODEL * BW},
        {p.in[I_WOUT] + (size_t)l * D_MODEL * D_MODEL, D_MODEL, D_MODEL, D_MODEL, p.WT_OUT},
        {p.in[I_PWQ] + (size_t)l * D_MODEL * PQ, D_MODEL, PQ, PQ, p.WT_Q}};
    int base = 0;
#pragma unroll
    for (int it = 0; it < 12; ++it) {
        const int nj = (items[it].Npad / 64) * (items[it].K / 64);
        for (int j = (int)((obid() + gridDim.x - (base % gridDim.x)) % gridDim.x); j < nj; j += gridDim.x)
            convert_wt_job(items[it].W, items[it].K, items[it].N, items[it].Npad, items[it].out, j, T, it == 6);
        base += nj;
    }
    __syncthreads();
    {
        const float* ks = p.in[I_PKEYS] + (size_t)l * PH * 2 * 128 * 128;
        for (size_t i = (size_t)obid() * NTHREADS + otid(); i < (size_t)PH * 2 * 128 * 128; i += (size_t)gridDim.x * NTHREADS) {
            const float v = ks[i]; const bf16_t hb = f2bf(v);
            p.KHI[i] = hb; p.KLO[i] = f2bf(v - bf2f(hb));
        }
    }
}

__device__ __forceinline__ void phase_init(const P& p, char* smem) {
    const int tid = otid();
    float* sc = (float*)smem;
    for (int i = tid; i < D_MODEL; i += NTHREADS) { sc[i] = siluf_(p.in[I_CCTX][i]); sc[D_MODEL + i] = siluf_(p.in[I_C][i]); }
    __syncthreads();
    const int ncolblk = (6 * D_MODEL) / NTHREADS;
    for (int job = obid(); job < DEPTH * ncolblk; job += gridDim.x) {
        int l = job / ncolblk, n = (job % ncolblk) * NTHREADS + tid;
        const float* w = p.in[I_WMOD] + (size_t)l * D_MODEL * 6 * D_MODEL + n;
        float a0 = 0.f, a1 = 0.f;
        for (int k = 0; k < D_MODEL; ++k) { float wv = w[(size_t)k * 6 * D_MODEL]; a0 += sc[k] * wv; a1 += sc[D_MODEL + k] * wv; }
        float b = p.in[I_BMOD][l * 6 * D_MODEL + n];
        p.MOD[(size_t)(l * 2 + 0) * 6 * D_MODEL + n] = a0 + b;
        p.MOD[(size_t)(l * 2 + 1) * 6 * D_MODEL + n] = a1 + b;
    }
    const size_t gtid = (size_t)obid() * NTHREADS + tid, gn = (size_t)gridDim.x * NTHREADS;
    for (size_t i = gtid; i < (size_t)CTX * D_MODEL; i += gn) p.X[i] = p.in[I_CTX][i];
    for (size_t i = gtid; i < (size_t)SEQ * D_MODEL; i += gn) p.X[(size_t)CTX * D_MODEL + i] = p.in[I_X][i];
    __syncthreads();
}

__device__ __forceinline__ void phase_s5const(const P& p, int l) {
    const size_t gtid = (size_t)obid() * NTHREADS + otid(), gn = (size_t)gridDim.x * NTHREADS;
    for (size_t i = gtid; i < (size_t)2 * SG * 64; i += gn) {
        int d = (int)(i / (SG * 64)), g = (int)((i / 64) % SG), s = (int)(i % 64);
        size_t li = ((size_t)(l * 2 + d) * SG + g) * 64 + s;
        float lre = p.in[I_S5LRE][li], lim = p.in[I_S5LIM][li];
        float dt = expf(p.in[I_S5LS][(l * 2 + d) * SG + g]);
        float mag = expf(lre * dt);
        float are = mag * cosf(lim * dt), aim = mag * sinf(lim * dt);
        float den = lre * lre + lim * lim;
        float fre = ((are - 1.0f) * lre + aim * lim) / den;
        float fim = (aim * lre - (are - 1.0f) * lim) / den;
        p.S5A[i * 2 + 0] = are; p.S5A[i * 2 + 1] = aim;
        const float* bre = p.in[I_S5BRE] + (((size_t)l * SG + g) * 64 + s) * 16;
        const float* bim = p.in[I_S5BIM] + (((size_t)l * SG + g) * 64 + s) * 16;
        for (int c = 0; c < 16; ++c) {
            p.S5BB[(i * 16 + c) * 2 + 0] = fre * bre[c] - fim * bim[c];
            p.S5BB[(i * 16 + c) * 2 + 1] = fre * bim[c] + fim * bre[c];
        }
    }
}

__device__ __forceinline__ void phase_norm(const P& p, int l, int which) {
    const int lane = otid() & 63;
    const int gw = (obid() * NTHREADS + otid()) >> 6, nw = (gridDim.x * NTHREADS) >> 6;
    const float* g = p.in[which ? I_N2G : I_N1G] + l * D_MODEL;
    constexpr int NJ = (D_MODEL + 255) / 256;
    for (int t = gw; t < MTOT; t += nw) {
        const float* x = p.X + (size_t)t * D_MODEL;
        const float* mod = p.MOD + (size_t)(l * 2 + (t >= CTX ? 1 : 0)) * 6 * D_MODEL + (which ? 3 * D_MODEL : 0);
        float4 v[NJ]; float ss = 0.f;
#pragma unroll
        for (int j = 0; j < NJ; ++j) {
            const int e = j * 256 + lane * 4;
            if (e < D_MODEL) v[j] = *(const float4*)(x + e); else { v[j].x = 0.f; v[j].y = 0.f; v[j].z = 0.f; v[j].w = 0.f; }
            ss += v[j].x * v[j].x + v[j].y * v[j].y + v[j].z * v[j].z + v[j].w * v[j].w;
        }
        ss = wave_sum(ss);
        const float rstd = rsqrtf(ss / D_MODEL + 1e-6f);
#pragma unroll
        for (int j = 0; j < NJ; ++j) {
            const int e = j * 256 + lane * 4;
            if (e < D_MODEL) {
                const float4 gg = *(const float4*)(g + e), sc = *(const float4*)(mod + D_MODEL + e), sh = *(const float4*)(mod + e);
                *(u32x2*)(p.H + (size_t)t * D_MODEL + e) = pack4(v[j].x * rstd * gg.x * (1.0f + sc.x) + sh.x, v[j].y * rstd * gg.y * (1.0f + sc.y) + sh.y,
                                                                 v[j].z * rstd * gg.z * (1.0f + sc.z) + sh.z, v[j].w * rstd * gg.w * (1.0f + sc.w) + sh.w);
            }
        }
    }
}

__device__ __forceinline__ void phase_gemm_in(const P& p, int l, char* smem) {
    const int ntn = NPAD(D_IN) / 128, ntm = MTOT / 128;
    for (int job = obid(); job < ntm * ntn; job += gridDim.x) {
        const int m0 = (job / ntn) * 128, n0 = (job % ntn) * 128;
        f32x4 acc[4][4]; ZERO_ACC4(acc);
        mfma_gemm_tile(p.WT_IN, D_MODEL, p.H, D_MODEL, D_MODEL, n0, m0, (bf16_t*)smem, acc);
        FOR_ACC(acc, n0, m0, { if (n < D_IN) *(u32x2*)(p.Z + (size_t)m * D_IN + n) = pack4(v[0], v[1], v[2], v[3]); })
    }
}

__device__ __forceinline__ void unpack8(const u32x4 w, float (&f)[8]) {
    f[0] = LO16(w.x); f[1] = HI16(w.x); f[2] = LO16(w.y); f[3] = HI16(w.y); f[4] = LO16(w.z); f[5] = HI16(w.z); f[6] = LO16(w.w); f[7] = HI16(w.w);
}
__device__ __forceinline__ u32x4 pack8(const float (&f)[8]) {
    u32x4 o; o.x = pack2bf(f[0], f[1]); o.y = pack2bf(f[2], f[3]);
    o.z = pack2bf(f[4], f[5]); o.w = pack2bf(f[6], f[7]); return o;
}
__device__ __forceinline__ void load8f(const float* p, float (&f)[8]) {
    const float4 a = *(const float4*)p, b = *(const float4*)(p + 4);
    f[0] = a.x; f[1] = a.y; f[2] = a.z; f[3] = a.w; f[4] = b.x; f[5] = b.y; f[6] = b.z; f[7] = b.w;
}
__device__ __forceinline__ void store8f(float* p, const float (&f)[8]) {
    float4 a, b; a.x = f[0]; a.y = f[1]; a.z = f[2]; a.w = f[3]; b.x = f[4]; b.y = f[5]; b.z = f[6]; b.w = f[7];
    *(float4*)p = a; *(float4*)(p + 4) = b;
}
__device__ __forceinline__ void conv8(const bf16_t* zp, const float* conv, int c0, bool act, bool first, bool last, float (&out)[8]) {
    const u32x4 z4 = {0u, 0u, 0u, 0u};
    const u32x4 a0 = act ? *(const u32x4*)(zp + c0) : z4;
    const u32x4 am = (act && !first) ? *(const u32x4*)(zp + c0 - D_IN) : z4;
    const u32x4 an = (act && !last) ? *(const u32x4*)(zp + c0 + D_IN) : z4;
    float w0[8], w1[8], w2[8], f0[8], fm[8], fn[8];
    if (act) { load8f(conv + c0, w0); load8f(conv + RWKV_IN + c0, w1); load8f(conv + 2 * RWKV_IN + c0, w2); }
    else {
#pragma unroll
        for (int e = 0; e < 8; ++e) { w0[e] = 0.f; w1[e] = 0.f; w2[e] = 0.f; }
    }
    unpack8(a0, f0); unpack8(am, fm); unpack8(an, fn);
#pragma unroll
    for (int e = 0; e < 8; ++e) out[e] = w1[e] * f0[e] + w0[e] * fm[e] + w2[e] * fn[e];
}
__device__ __forceinline__ void phase_rwkv_prep1(const P& p, int l) {
    const int lane = otid() & 63;
    const int gw = (obid() * NTHREADS + otid()) >> 6, nw = (gridDim.x * NTHREADS) >> 6;
    const float* conv = p.in[I_RCONV] + (size_t)l * 3 * RWKV_IN;
    const float* k_k = p.in[I_RKK] + (size_t)l * RW;
    const bool act = lane * 8 < RW, act2 = lane * 8 < 384;
    float kkw[8];
    if (act) load8f(k_k + lane * 8, kkw);
    else {
#pragma unroll
        for (int e = 0; e < 8; ++e) kkw[e] = 0.f;
    }
    for (int t = gw; t < MTOT; t += nw) {
        const bool first = (t == 0) || (t == CTX), last = (t == CTX - 1) || (t == MTOT - 1);
        const bf16_t* zp = p.Z + (size_t)t * D_IN + ZR;
        float rv[8], kv[8], vv[8], lr[8];
        conv8(zp, conv, 0 * RW + lane * 8, act, first, last, rv);
        conv8(zp, conv, 1 * RW + lane * 8, act, first, last, kv);
        conv8(zp, conv, 2 * RW + lane * 8, act, first, last, vv);
        conv8(zp, conv, 3 * RW + lane * 8, act2, first, last, lr);
        float kk[8]; float ss = 0.f;
#pragma unroll
        for (int e = 0; e < 8; ++e) { kk[e] = kv[e] * kkw[e]; ss += kk[e] * kk[e]; }
        ss += __shfl_xor(ss, 1, 64); ss += __shfl_xor(ss, 2, 64); ss += __shfl_xor(ss, 4, 64);
        const float inv = 1.0f / fmaxf(sqrtf(ss), 1e-12f);
#pragma unroll
        for (int e = 0; e < 8; ++e) kk[e] *= inv;
        if (act) {
            const size_t o = (size_t)t * RW + lane * 8;
            *(u32x4*)(p.R + o) = pack8(rv); *(u32x4*)(p.KS + o) = pack8(kv); *(u32x4*)(p.V + o) = pack8(vv); *(u32x4*)(p.KK + o) = pack8(kk);
        }
        if (act2) {
            const int cc = lane * 8;
            if (cc < 128) {
#pragma unroll
                for (int e = 0; e < 8; ++e) lr[e] = tanhf_(lr[e]);
                *(u32x4*)(p.LR + (size_t)t * 256 + cc) = pack8(lr);
            } else if (cc < 256) {
                *(u32x4*)(p.LR + (size_t)t * 256 + cc) = pack8(lr);
            } else {
#pragma unroll
                for (int e = 0; e < 8; ++e) lr[e] = sigmoidf_(lr[e]);
                *(u32x4*)(p.GS + (size_t)t * 128 + cc - 256) = pack8(lr);
            }
        }
    }
}
__device__ __forceinline__ void phase_rwkv_prep2(const P& p, int l, char* smem) {
    const int ntm = MTOT / 128, ntn = NPAD(RW) / 128;
    const float* k_a = p.in[I_RKA] + (size_t)l * RW;
    const float* r_k = p.in[I_RRK] + (size_t)l * RW;
    for (int job = obid(); job < ntm * ntn * 2; job += gridDim.x) {
        const int d = job % 2, n0 = ((job / 2) % ntn) * 128, m0 = (job / (2 * ntn)) * 128;
        const float* w0 = p.in[I_RW0] + (size_t)(l * 2 + d) * RW;
        const float* a0 = p.in[I_RA0] + (size_t)(l * 2 + d) * RW;
        f32x4 accw[4][4], acca[4][4]; ZERO_ACC4(accw); ZERO_ACC4(acca);
        mfma_gemm_tile(p.WT_W2 + (size_t)d * NPAD(RW) * 64, 64, p.LR + d * 64, 256, 64, n0, m0, (bf16_t*)smem, accw);
        mfma_gemm_tile(p.WT_A2 + (size_t)d * NPAD(RW) * 64, 64, p.LR + 128 + d * 64, 256, 64, n0, m0, (bf16_t*)smem, acca);
        const int lane = otid() & 63, wave = otid() >> 6;
#pragma unroll
        for (int mi = 0; mi < 4; ++mi) {
            const int m = m0 + (wave & 1) * 64 + mi * 16 + (lane & 15);
            float bon = 0.f;
#pragma unroll
            for (int ni = 0; ni < 4; ++ni) {
                const int n = n0 + (wave >> 1) * 64 + ni * 16 + (lane >> 4) * 4;
                if (n < RW) {
                    const u32x2 kq = *(const u32x2*)(p.KS + (size_t)m * RW + n), kkq = *(const u32x2*)(p.KK + (size_t)m * RW + n), rq = *(const u32x2*)(p.R + (size_t)m * RW + n);
                    const float kv[4] = {LO16(kq.x), HI16(kq.x), LO16(kq.y), HI16(kq.y)};
                    const float kkv[4] = {LO16(kkq.x), HI16(kkq.x), LO16(kkq.y), HI16(kkq.y)};
                    const float rv[4] = {LO16(rq.x), HI16(rq.x), LO16(rq.y), HI16(rq.y)};
                    float lw[4], kd[4], bb[4];
#pragma unroll
                    for (int e = 0; e < 4; ++e) {
                        const float x = w0[n + e] + accw[ni][mi][e];
                        lw[e] = -fexp_(-softplusf_(-x) - 0.5f);
                        const float aa = sigmoidf_(a0[n + e] + acca[ni][mi][e]);
                        kd[e] = kv[e] * (1.0f + (aa - 1.0f) * k_a[n + e]);
                        bb[e] = kkv[e] * aa;
                        bon += rv[e] * kd[e] * r_k[n + e];
                    }
                    const size_t o = ((size_t)d * MTOT + m) * RW + n;
                    float4 lo4; lo4.x = lw[0]; lo4.y = lw[1]; lo4.z = lw[2]; lo4.w = lw[3];
                    *(float4*)(p.LW + o) = lo4;
                    *(u32x2*)(p.KD + o) = pack4(kd[0], kd[1], kd[2], kd[3]);
                    *(u32x2*)(p.BB + o) = pack4(bb[0], bb[1], bb[2], bb[3]);
                }
            }
            bon += __shfl_xor(bon, 16, 64); bon += __shfl_xor(bon, 32, 64);
            const int hh = (n0 + (wave >> 1) * 64) >> 6;
            if ((lane >> 4) == 0 && hh < RH) p.BONUS[((size_t)d * MTOT + m) * RH + hh] = bon;
        }
    }
}

#define CH_ROW 72
#define SEQ_REC 16640
#define CH_SLOT (64 * CH_ROW)
#define CH_XR_OFF (7 * CH_SLOT * 2)
#define CH_AAB_OFF (CH_XR_OFF + 64 * 132 * 4)
#define CH_GC_OFF (CH_AAB_OFF + 64 * 72 * 4)
template <int MT, int NT>
__device__ __forceinline__ void lds_mm(const bf16_t* A, int m0, const bf16_t* Bt, int n0, f32x4 (&acc)[MT][NT]) {
    const int lane = otid() & 63, q = lane >> 4, r = lane & 15;
#pragma unroll
    for (int s = 0; s < 2; ++s) {
        bf16x8 a[MT], b[NT];
#pragma unroll
        for (int i = 0; i < MT; ++i) a[i] = *(const bf16x8*)(A + (m0 + i * 16 + r) * CH_ROW + s * 32 + q * 8);
#pragma unroll
        for (int i = 0; i < NT; ++i) b[i] = *(const bf16x8*)(Bt + (n0 + i * 16 + r) * CH_ROW + s * 32 + q * 8);
#pragma unroll
        for (int i = 0; i < MT; ++i)
#pragma unroll
            for (int jj = 0; jj < NT; ++jj) acc[i][jj] = MFMA16(a[i], b[jj], acc[i][jj]);
    }
}
__device__ __forceinline__ void rwkv_chunk_job(const P& p, int job, char* smem) {
    const int tid = otid(), lane = tid & 63, wv = tid >> 6, q = lane >> 4, r = lane & 15;
    const int d = job / (NC * RH), n = (job / RH) % NC, h = job % RH;
    const size_t base = (size_t)(d * NC + n) * RH + h;
    bf16_t* S0 = (bf16_t*)smem; bf16_t* S1 = S0 + CH_SLOT; bf16_t* S2 = S1 + CH_SLOT; bf16_t* S3 = S2 + CH_SLOT;
    bf16_t* S4 = S3 + CH_SLOT; bf16_t* S5 = S4 + CH_SLOT; bf16_t* S6 = S5 + CH_SLOT;
    float* X = (float*)(smem + CH_XR_OFF);
    float* AABt = (float*)(smem + CH_AAB_OFF);
    bf16_t* U0t = (bf16_t*)(smem + CH_AAB_OFF);
    bf16_t* Aht = U0t + CH_SLOT;
    float* GC = (float*)(smem + CH_GC_OFF);
    __syncthreads();
    u32x4 gkk[2], gr[2], gv[2], gkd[2], gbb[2]; float lw[2][8];
#pragma unroll
    for (int it = 0; it < 2; ++it) {
        const int c = tid + 256 * it, i = c >> 3, k0 = (c & 7) * 8; const int tok = 64 * n + (d ? 63 - i : i);
        const size_t o1 = (size_t)tok * RW + h * 64 + k0, o2 = ((size_t)d * MTOT + tok) * RW + h * 64 + k0;
        load8f(p.LW + o2, lw[it]);
        gkk[it] = *(const u32x4*)(p.KK + o1); gr[it] = *(const u32x4*)(p.R + o1); gv[it] = *(const u32x4*)(p.V + o1);
        gkd[it] = *(const u32x4*)(p.KD + o2); gbb[it] = *(const u32x4*)(p.BB + o2);
    }
#pragma unroll
    for (int it = 0; it < 2; ++it) { const int c = tid + 256 * it; store8f(X + (c >> 3) * 132 + (c & 7) * 8, lw[it]); }
    __syncthreads();
    {
        const int k = tid & 63, seg = tid >> 6;
        float v[16]; float run = 0.f;
#pragma unroll
        for (int e = 0; e < 16; ++e) { run += X[(seg * 16 + e) * 132 + k]; v[e] = run; }
        AABt[seg * 64 + k] = run;
        __syncthreads();
        float off = 0.f;
        for (int s2 = 0; s2 < seg; ++s2) off += AABt[s2 * 64 + k];
#pragma unroll
        for (int e = 0; e < 16; ++e) X[(seg * 16 + e) * 132 + k] = v[e] + off;
    }
    __syncthreads();
#pragma unroll
    for (int it = 0; it < 2; ++it) {
        const int c = tid + 256 * it, i = c >> 3, k0 = (c & 7) * 8;
        float L[8], Lp[8], LC[8], kkv[8], rv[8], vv[8], kdv[8], bbv[8];
        load8f(X + i * 132 + k0, L); load8f(X + 63 * 132 + k0, LC);
        if (i > 0) load8f(X + (i - 1) * 132 + k0, Lp);
        else {
#pragma unroll
            for (int e = 0; e < 8; ++e) Lp[e] = 0.f;
        }
        unpack8(gkk[it], kkv); unpack8(gr[it], rv); unpack8(gv[it], vv); unpack8(gkd[it], kdv); unpack8(gbb[it], bbv);
        float at[8], rt[8], bt[8], kt[8], bh[8], kh[8];
#pragma unroll
        for (int e = 0; e < 8; ++e) {
            const float eL = fexp_(L[e]), eLp = fexp_(Lp[e]), eNL = fexp_(-L[e]), eCL = fexp_(LC[e] - L[e]);
            at[e] = -kkv[e] * eLp; rt[e] = rv[e] * eL; bt[e] = bbv[e] * eNL; kt[e] = kdv[e] * eNL; bh[e] = bbv[e] * eCL; kh[e] = kdv[e] * eCL;
            if (i == 63) GC[k0 + e] = eL;
        }
        *(u32x4*)(S0 + i * CH_ROW + k0) = pack8(at);
        store8f(X + i * 132 + 64 + k0, at);
        *(u32x4*)(S1 + i * CH_ROW + k0) = pack8(rt);
        *(u32x4*)(S2 + i * CH_ROW + k0) = pack8(bt);
        *(u32x4*)(S3 + i * CH_ROW + k0) = pack8(kt);
#pragma unroll
        for (int e = 0; e < 8; ++e) {
            S4[(k0 + e) * CH_ROW + i] = f2bf(vv[e]);
            S5[(k0 + e) * CH_ROW + i] = f2bf(bh[e]);
            S6[(k0 + e) * CH_ROW + i] = f2bf(kh[e]);
        }
    }
    __syncthreads();
    {
        f32x4 acc[4][4]; ZERO_ACC4(acc);
        lds_mm<4, 4>((wv < 2) ? S0 : S1, 0, (wv & 1) ? S3 : S2, 0, acc);
        __syncthreads();
#pragma unroll
        for (int mt = 0; mt < 4; ++mt)
#pragma unroll
            for (int nt = 0; nt < 4; ++nt) {
                const int jc = nt * 16 + r, i0 = mt * 16 + 4 * q;
                if (wv == 0) {
                    f32x4 o;
#pragma unroll
                    for (int e = 0; e < 4; ++e) o[e] = (jc < i0 + e) ? acc[mt][nt][e] : 0.f;
                    *(f32x4*)(AABt + jc * 72 + i0) = o;
                } else {
                    bf16_t* dst = (wv == 1) ? S0 : ((wv == 2) ? S2 : S3);
#pragma unroll
                    for (int e = 0; e < 4; ++e) {
                        const bool ok = (wv == 1) ? (jc < i0 + e) : (jc <= i0 + e);
                        dst[(i0 + e) * CH_ROW + jc] = f2bf(ok ? acc[mt][nt][e] : 0.f);
                    }
                }
            }
    }
    __syncthreads();
    {
        f32x4 acc[1][4];
#pragma unroll
        for (int nt = 0; nt < 4; ++nt) acc[0][nt] = (f32x4){0.f, 0.f, 0.f, 0.f};
        lds_mm<1, 4>(S0, 16 * wv, S4, 0, acc);
#pragma unroll
        for (int nt = 0; nt < 4; ++nt)
#pragma unroll
            for (int e = 0; e < 4; ++e) X[(16 * wv + 4 * q + e) * 132 + nt * 16 + r] = acc[0][nt][e];
    }
    __syncthreads();
    if (tid < 128) {
        const int c = tid;
        for (int bi = 0; bi < 4; ++bi) {
            float acc[16];
#pragma unroll
            for (int e = 0; e < 16; ++e) acc[e] = X[(16 * bi + e) * 132 + c];
            for (int jj = 0; jj < 16 * bi; ++jj) {
                const float uj = X[jj * 132 + c];
                const f32x4* ap = (const f32x4*)(AABt + jj * 72 + 16 * bi);
                const f32x4 a0 = ap[0], a1 = ap[1], a2 = ap[2], a3 = ap[3];
#pragma unroll
                for (int e = 0; e < 4; ++e) { acc[e] += a0[e] * uj; acc[4 + e] += a1[e] * uj; acc[8 + e] += a2[e] * uj; acc[12 + e] += a3[e] * uj; }
            }
#pragma unroll
            for (int e = 0; e < 16; ++e) {
                const float u = acc[e];
                X[(16 * bi + e) * 132 + c] = u;
                const f32x4* ap = (const f32x4*)(AABt + (16 * bi + e) * 72 + 16 * bi);
                const f32x4 a0 = ap[0], a1 = ap[1], a2 = ap[2], a3 = ap[3];
#pragma unroll
                for (int e2 = 0; e2 < 16; ++e2) if (e2 > e) acc[e2] += ((e2 < 4) ? a0[e2 & 3] : (e2 < 8) ? a1[e2 & 3] : (e2 < 12) ? a2[e2 & 3] : a3[e2 & 3]) * u;
            }
        }
    }
    __syncthreads();
    if (tid < 128) {
        const int c = tid;
        bf16_t* dst = (c < 64) ? (U0t + c * CH_ROW) : (Aht + (c - 64) * CH_ROW);
        u32x4 ov[8];
#pragma unroll
        for (int g = 0; g < 8; ++g) {
            float v[8];
#pragma unroll
            for (int e = 0; e < 8; ++e) v[e] = X[(g * 8 + e) * 132 + c];
            ov[g].x = pack2bf(v[0], v[1]); ov[g].y = pack2bf(v[2], v[3]);
            ov[g].z = pack2bf(v[4], v[5]); ov[g].w = pack2bf(v[6], v[7]);
        }
#pragma unroll
        for (int g = 0; g < 8; ++g) *(u32x4*)(dst + g * 8) = ov[g];
    }
    __syncthreads();
    {
        f32x4 acc[4][4]; ZERO_ACC4(acc);
        char* rec = p.REC + base * SEQ_REC;
        if (wv == 0) {
            lds_mm<4, 4>(Aht, 0, S5, 0, acc);
#pragma unroll
            for (int nt = 0; nt < 4; ++nt)
#pragma unroll
                for (int s2 = 0; s2 < 2; ++s2) {
                    u32x4 o;
                    o.x = pack2bf(acc[2 * s2][nt][0], acc[2 * s2][nt][1]); o.y = pack2bf(acc[2 * s2][nt][2], acc[2 * s2][nt][3]);
                    o.z = pack2bf(acc[2 * s2 + 1][nt][0], acc[2 * s2 + 1][nt][1]); o.w = pack2bf(acc[2 * s2 + 1][nt][2], acc[2 * s2 + 1][nt][3]);
                    *(u32x4*)(rec + (((nt * 2 + s2) * 64 + lane) * 8) * 2) = o;
                }
        } else if (wv == 1) {
            lds_mm<4, 4>(S5, 0, U0t, 0, acc);
            lds_mm<4, 4>(S6, 0, S4, 0, acc);
#pragma unroll
            for (int mt = 0; mt < 4; ++mt)
#pragma unroll
                for (int nt = 0; nt < 4; ++nt) *(u32x2*)(rec + 8192 + (((nt * 4 + mt) * 64 + lane) * 4) * 2) = pack4(acc[mt][nt][0], acc[mt][nt][1], acc[mt][nt][2], acc[mt][nt][3]);
        } else if (wv == 2) {
            lds_mm<4, 4>(S2, 0, Aht, 0, acc);
#pragma unroll
            for (int mt = 0; mt < 4; ++mt)
#pragma unroll
                for (int nt = 0; nt < 4; ++nt)
#pragma unroll
                    for (int e = 0; e < 4; ++e) {
                        const int t = mt * 16 + 4 * q + e, kc = nt * 16 + r;
                        p.QH[(base * 64 + t) * 64 + kc] = f2bf(acc[mt][nt][e] + bf2f(S1[t * CH_ROW + kc]));
                    }
        } else if (wv == 3) {
            lds_mm<4, 4>(S2, 0, U0t, 0, acc);
            lds_mm<4, 4>(S3, 0, S4, 0, acc);
#pragma unroll
            for (int mt = 0; mt < 4; ++mt)
#pragma unroll
                for (int nt = 0; nt < 4; ++nt)
#pragma unroll
                    for (int e = 0; e < 4; ++e) {
                        const int t = mt * 16 + 4 * q + e; const int tok = 64 * n + (d ? 63 - t : t);
                        p.Y[((size_t)d * MTOT + tok) * RW + h * 64 + nt * 16 + r] = acc[mt][nt][e];
                    }
        }
        if (tid < 64) ((float*)(rec + 16384))[tid] = GC[tid];
    }
}

#define SEQ_SLOT 16896
__device__ __forceinline__ void rwkv_seq_gload(const P& p, size_t base, int tid, u32x4 (&g)[5]) {
    const u32x4* m = (const u32x4*)(p.REC + base * SEQ_REC);
#pragma unroll
    for (int i = 0; i < 4; ++i) g[i] = m[tid + 256 * i];
    if (tid < 16) g[4] = m[1024 + tid];
}
__device__ __forceinline__ void rwkv_seq_lstore(char* slot, int tid, const u32x4 (&g)[5]) {
    u32x4* d = (u32x4*)slot;
#pragma unroll
    for (int i = 0; i < 4; ++i) d[tid + 256 * i] = g[i];
    if (tid < 16) d[1024 + tid] = g[4];
}
__device__ __forceinline__ void rwkv_seq_step(const P& p, const char* slot, size_t base, int wv, int lane, f32x4 (&X)[4]) {
    const int q = lane >> 4, r = lane & 15;
    const bf16_t* mt = (const bf16_t*)slot; const bf16_t* ntb = (const bf16_t*)(slot + 8192); const float* gc = (const float*)(slot + 16384);
    unsigned xh[4][2];
#pragma unroll
    for (int kt = 0; kt < 4; ++kt) {
        xh[kt][0] = pack2bf(X[kt][0], X[kt][1]); xh[kt][1] = pack2bf(X[kt][2], X[kt][3]);
        *(u32x2*)(p.SN + (base * 64 + 16 * wv + r) * 64 + 16 * kt + 4 * q) = (u32x2){xh[kt][0], xh[kt][1]};
    }
    bf16x8 bh[2];
#pragma unroll
    for (int s2 = 0; s2 < 2; ++s2) bh[s2] = __builtin_bit_cast(bf16x8, ((u32x4){xh[2 * s2][0], xh[2 * s2][1], xh[2 * s2 + 1][0], xh[2 * s2 + 1][1]}));
#pragma unroll
    for (int tile = 0; tile < 4; ++tile) {
        const u32x2 nb = *(const u32x2*)(ntb + ((wv * 4 + tile) * 64 + lane) * 4);
        const f32x4 g4 = *(const f32x4*)(gc + tile * 16 + 4 * q);
        f32x4 acc;
        acc[0] = g4[0] * X[tile][0] + LO16(nb.x); acc[1] = g4[1] * X[tile][1] + HI16(nb.x);
        acc[2] = g4[2] * X[tile][2] + LO16(nb.y); acc[3] = g4[3] * X[tile][3] + HI16(nb.y);
#pragma unroll
        for (int s2 = 0; s2 < 2; ++s2) {
            const bf16x8 ah = *(const bf16x8*)(mt + ((tile * 2 + s2) * 64 + lane) * 8);
            acc = MFMA16(ah, bh[s2], acc);
        }
        X[tile] = acc;
    }
}
__device__ __forceinline__ void rwkv_seq_job(const P& p, int job, char* smem) {
    const int tid = otid(), lane = tid & 63, wv = tid >> 6;
    const int d = job / RH, h = job % RH;
    f32x4 X[4];
#pragma unroll
    for (int kt = 0; kt < 4; ++kt) X[kt] = (f32x4){0.f, 0.f, 0.f, 0.f};
    u32x4 g0[5], g1[5], g2[5];
#define SEQ_BASE(s_) ((size_t)(d * NC + chunk_order(d, ((s_) < NC) ? (s_) : NC - 1)) * RH + h)
    __syncthreads();
    rwkv_seq_gload(p, SEQ_BASE(0), tid, g0);
    rwkv_seq_gload(p, SEQ_BASE(1), tid, g1);
    rwkv_seq_gload(p, SEQ_BASE(2), tid, g2);
    rwkv_seq_lstore(smem, tid, g0);
    __syncthreads();
    for (int s = 0; s < NC; s += 6) {
#define SEQ_SUB(u, GFREE, GNEXT) \
        if (s + (u) < NC) { \
            rwkv_seq_gload(p, SEQ_BASE(s + (u) + 3), tid, GFREE); \
            rwkv_seq_step(p, smem + (((u) & 1) ? SEQ_SLOT : 0), SEQ_BASE(s + (u)), wv, lane, X); \
            rwkv_seq_lstore(smem + (((u) & 1) ? 0 : SEQ_SLOT), tid, GNEXT); \
        } \
        __syncthreads();
        SEQ_SUB(0, g0, g1)
        SEQ_SUB(1, g1, g2)
        SEQ_SUB(2, g2, g0)
        SEQ_SUB(3, g0, g1)
        SEQ_SUB(4, g1, g2)
        SEQ_SUB(5, g2, g0)
#undef SEQ_SUB
    }
#undef SEQ_BASE
}
__device__ __forceinline__ void rwkv_out_job(const P& p, int job) {
    const int tid = otid(), lane = tid & 63, wv = tid >> 6, q = lane >> 4, r = lane & 15;
    const int d = job / (NC * RH), n = (job / RH) % NC, h = job % RH;
    const size_t base = (size_t)(d * NC + n) * RH + h;
    f32x4 acc[4];
#pragma unroll
    for (int nt = 0; nt < 4; ++nt) acc[nt] = (f32x4){0.f, 0.f, 0.f, 0.f};
#pragma unroll
    for (int s2 = 0; s2 < 2; ++s2) {
        const bf16x8 a = *(const bf16x8*)(p.QH + (base * 64 + 16 * wv + r) * 64 + s2 * 32 + q * 8);
#pragma unroll
        for (int nt = 0; nt < 4; ++nt) {
            const bf16x8 b = *(const bf16x8*)(p.SN + (base * 64 + nt * 16 + r) * 64 + s2 * 32 + q * 8);
            acc[nt] = MFMA16(a, b, acc[nt]);
        }
    }
#pragma unroll
    for (int nt = 0; nt < 4; ++nt)
#pragma unroll
        for (int e = 0; e < 4; ++e) {
            const int t = 16 * wv + 4 * q + e; const int tok = 64 * n + (d ? 63 - t : t);
            p.Y[((size_t)d * MTOT + tok) * RW + h * 64 + nt * 16 + r] += acc[nt][e];
        }
}

#define GL_QR 0
#define GL_KR 9216
#define GL_VT 18432
#define GL_QI 36864
#define GL_KI 46080
#define GL_AT 55296
#define GL_CUM 64512
#define GL_ALR 81920
#define GL_WA 86016
__device__ __forceinline__ void gla_load_qkv(const P& p, int n, int h, char* smem) {
    const int tid = otid();
    bf16_t* Qr = (bf16_t*)(smem + GL_QR); bf16_t* Kr = (bf16_t*)(smem + GL_KR); bf16_t* Vt = (bf16_t*)(smem + GL_VT);
    for (int c = tid; c < 512; c += NTHREADS) {
        const int row = c >> 3, part = c & 7; const int t = gla_tok(n, row);
        const u32x4 qv = *(const u32x4*)(p.Z + (size_t)t * D_IN + ZQ + h * 64 + part * 8);
        const u32x4 kv = *(const u32x4*)(p.Z + (size_t)t * D_IN + ZK + h * 64 + part * 8);
        u32x4 qs;
        qs.x = pack2bf(LO16(qv.x) * 0.125f, HI16(qv.x) * 0.125f);
        qs.y = pack2bf(LO16(qv.y) * 0.125f, HI16(qv.y) * 0.125f);
        qs.z = pack2bf(LO16(qv.z) * 0.125f, HI16(qv.z) * 0.125f);
        qs.w = pack2bf(LO16(qv.w) * 0.125f, HI16(qv.w) * 0.125f);
        *(u32x4*)(Qr + row * CH_ROW + part * 8) = qs;
        *(u32x4*)(Kr + row * CH_ROW + part * 8) = kv;
    }
    for (int c = tid; c < 1024; c += NTHREADS) {
        const int row = c >> 4, part = c & 15; const int t = gla_tok(n, row);
        const u32x4 vv = *(const u32x4*)(p.Z + (size_t)t * D_IN + ZV + h * 128 + part * 8);
        bf16_t* dst = Vt + (part * 8) * CH_ROW + row;
        dst[0 * CH_ROW] = (bf16_t)(vv.x & 0xFFFF); dst[1 * CH_ROW] = (bf16_t)(vv.x >> 16);
        dst[2 * CH_ROW] = (bf16_t)(vv.y & 0xFFFF); dst[3 * CH_ROW] = (bf16_t)(vv.y >> 16);
        dst[4 * CH_ROW] = (bf16_t)(vv.z & 0xFFFF); dst[5 * CH_ROW] = (bf16_t)(vv.z >> 16);
        dst[6 * CH_ROW] = (bf16_t)(vv.w & 0xFFFF); dst[7 * CH_ROW] = (bf16_t)(vv.w >> 16);
    }
}
__device__ __forceinline__ void gla_cum(const P& p, int l, int n, int h, int d, char* smem) {
    const int tid = otid();
    float* CUM = (float*)(smem + GL_CUM); float* ALR = (float*)(smem + GL_ALR); float* WA = (float*)(smem + GL_WA);
    for (int c = tid; c < 256; c += NTHREADS) {
        const int row = c >> 2, part = c & 3; const int t = gla_tok(n, row);
        const u32x2 a = *(const u32x2*)(p.Z + (size_t)t * D_IN + (d ? ZAB : ZAF) + part * 4);
        float* dst = ALR + row * 16 + part * 4;
        dst[0] = LO16(a.x); dst[1] = HI16(a.x); dst[2] = LO16(a.y); dst[3] = HI16(a.y);
    }
    for (int c = tid; c < 16 * 64 + 64; c += NTHREADS) {
        if (c < 1024) WA[c] = p.in[I_GLA_WA2][((size_t)(l * 2 + d) * 16 + (c >> 6)) * GLA_K + h * 64 + (c & 63)];
        else WA[c] = p.in[I_GLA_BA][(size_t)(l * 2 + d) * GLA_K + h * 64 + (c - 1024)];
    }
    __syncthreads();
    for (int idx = tid; idx < 4096; idx += NTHREADS) {
        const int i = idx >> 6, k = idx & 63;
        float a = WA[1024 + k];
#pragma unroll
        for (int r = 0; r < 16; ++r) a += ALR[i * 16 + r] * WA[r * 64 + k];
        CUM[i * 68 + k] = (fminf(a, 0.f) - flog_(1.0f + fexp_(-fabsf(a)))) * (1.0f / 16.0f);
    }
    __syncthreads();
    {
        const int k = tid & 63, seg = (tid >> 6) & 3;
        float v[16]; float run = 0.f;
        if (tid < 256) {
#pragma unroll
            for (int e = 0; e < 16; ++e) { const int pos = seg * 16 + e; const int i = d ? 63 - pos : pos; run += CUM[i * 68 + k]; v[e] = run; }
            ALR[seg * 64 + k] = run;
        }
        __syncthreads();
        if (tid < 256) {
            float off = 0.f;
            for (int s2 = 0; s2 < seg; ++s2) off += ALR[s2 * 64 + k];
#pragma unroll
            for (int e = 0; e < 16; ++e) { const int pos = seg * 16 + e; const int i = d ? 63 - pos : pos; CUM[i * 68 + k] = v[e] + off; }
        }
    }
    __syncthreads();
}
__device__ __forceinline__ void phase_gla_kv(const P& p, int l, char* smem) {
    const int tid = otid(), lane = tid & 63, wv = tid >> 6, q = lane >> 4, r = lane & 15;
    bf16_t* Kr = (bf16_t*)(smem + GL_KR); bf16_t* Vt = (bf16_t*)(smem + GL_VT); bf16_t* KdT = (bf16_t*)(smem + GL_KI);
    float* CUM = (float*)(smem + GL_CUM);
    for (int job = obid(); job < NC * GH; job += gridDim.x) {
        const int n = job / GH, h = job % GH;
        __syncthreads();
        gla_load_qkv(p, n, h, smem);
        for (int d = 0; d < 2; ++d) {
            gla_cum(p, l, n, h, d, smem);
            const int li = d ? 0 : 63;
            for (int idx = tid; idx < 4096; idx += NTHREADS) {
                const int i = idx >> 6, k = idx & 63;
                KdT[k * CH_ROW + i] = f2bf(bf2f(Kr[i * CH_ROW + k]) * fexp_(CUM[li * 68 + k] - CUM[i * 68 + k]));
            }
            if (tid < 64) p.DEC[((size_t)(d * NC + n) * GH + h) * 64 + tid] = fexp_(CUM[li * 68 + tid]);
            __syncthreads();
            float* kvt = p.KV + ((size_t)(d * NC + n) * GH + h) * 8192;
            for (int mt = wv; mt < 4; mt += NTHREADS / 64) {
                f32x4 acc[1][8];
#pragma unroll
                for (int nt = 0; nt < 8; ++nt) acc[0][nt] = (f32x4){0.f, 0.f, 0.f, 0.f};
                lds_mm<1, 8>(KdT, 16 * mt, Vt, 0, acc);
#pragma unroll
                for (int nt = 0; nt < 8; ++nt) *(f32x4*)(kvt + (size_t)(nt * 16 + r) * 64 + 16 * mt + 4 * q) = acc[0][nt];
            }
            __syncthreads();
        }
    }
    __syncthreads();
}
__device__ __forceinline__ void gla_scan_job(const P& p, int job) {
    const int base = job * NTHREADS + otid();
    const int d = base / (GH * 8192), h = (base / 8192) % GH, e = base % 8192;
    const float* __restrict__ kvp = p.KV; const float* __restrict__ decp = p.DEC; bf16_t* __restrict__ sp = p.SP;
    float S = 0.f;
    for (int s = 0; s < NC; s += 4) {
        float kv[4], dc[4]; size_t oo[4];
#pragma unroll
        for (int u = 0; u < 4; ++u) {
            const int n = chunk_order(d, (s + u < NC) ? s + u : NC - 1);
            oo[u] = ((size_t)(d * NC + n) * GH + h);
            kv[u] = kvp[oo[u] * 8192 + e]; dc[u] = decp[oo[u] * 64 + (e & 63)];
        }
#pragma unroll
        for (int u = 0; u < 4; ++u) if (s + u < NC) { sp[oo[u] * 8192 + e] = f2bf(S); S = dc[u] * S + kv[u]; }
    }
}
__device__ __forceinline__ void phase_gla_out(const P& p, int l, char* smem) {
    const int tid = otid(), lane = tid & 63, wv = tid >> 6, q = lane >> 4, r = lane & 15;
    bf16_t* Qr = (bf16_t*)(smem + GL_QR); bf16_t* Kr = (bf16_t*)(smem + GL_KR); bf16_t* Vt = (bf16_t*)(smem + GL_VT);
    bf16_t* Qi = (bf16_t*)(smem + GL_QI); bf16_t* Ki = (bf16_t*)(smem + GL_KI); bf16_t* At = (bf16_t*)(smem + GL_AT);
    float* CUM = (float*)(smem + GL_CUM);
    for (int job = obid(); job < NC * GH; job += gridDim.x) {
        const int n = job / GH, h = job % GH;
        __syncthreads();
        gla_load_qkv(p, n, h, smem);
        f32x4 o[1][8];
#pragma unroll
        for (int nt = 0; nt < 8; ++nt) o[0][nt] = (f32x4){0.f, 0.f, 0.f, 0.f};
        for (int d = 0; d < 2; ++d) {
            gla_cum(p, l, n, h, d, smem);
            for (int idx = tid; idx < 4096; idx += NTHREADS) {
                const int i = idx >> 6, k = idx & 63; const float c = CUM[i * 68 + k];
                Qi[i * CH_ROW + k] = f2bf(bf2f(Qr[i * CH_ROW + k]) * fexp_(c));
                Ki[i * CH_ROW + k] = f2bf(bf2f(Kr[i * CH_ROW + k]) * fexp_(-c));
            }
            __syncthreads();
            if (wv < 4) {
                f32x4 a[1][4];
#pragma unroll
                for (int nt = 0; nt < 4; ++nt) a[0][nt] = (f32x4){0.f, 0.f, 0.f, 0.f};
                lds_mm<1, 4>(Qi, 16 * wv, Ki, 0, a);
#pragma unroll
                for (int nt = 0; nt < 4; ++nt)
#pragma unroll
                    for (int e = 0; e < 4; ++e) {
                        const int i = 16 * wv + 4 * q + e, j = nt * 16 + r;
                        const bool ok = d ? (j >= i) : (j <= i);
                        At[i * CH_ROW + j] = f2bf(ok ? a[0][nt][e] : 0.f);
                    }
                WAVE_SYNC();
                lds_mm<1, 8>(At, 16 * wv, Vt, 0, o);
                const bf16_t* sp = p.SP + ((size_t)(d * NC + n) * GH + h) * 8192;
#pragma unroll
                for (int s2 = 0; s2 < 2; ++s2) {
                    const bf16x8 af = *(const bf16x8*)(Qi + (16 * wv + r) * CH_ROW + s2 * 32 + q * 8);
#pragma unroll
                    for (int nt = 0; nt < 8; ++nt) {
                        const bf16x8 bfr = *(const bf16x8*)(sp + (size_t)(nt * 16 + r) * 64 + s2 * 32 + q * 8);
                        o[0][nt] = MFMA16(af, bfr, o[0][nt]);
                    }
                }
            }
            __syncthreads();
        }
        if (wv < 4) {
#pragma unroll
            for (int nt = 0; nt < 8; ++nt)
#pragma unroll
                for (int e = 0; e < 4; ++e) {
                    const int t = gla_tok(n, 16 * wv + 4 * q + e);
                    p.OGLA[(size_t)t * GLA_V + h * 128 + nt * 16 + r] = o[0][nt][e];
                }
        }
    }
    __syncthreads();
}

#define S5_BU_OFF 4096
#define S5_CT_OFF (4096 + 2 * 64 * 130 * 4)
__device__ __forceinline__ void phase_s5_pass(const P& p, int l, char* smem, bool with_out) {
    const int tid = otid();
    float* su = (float*)smem; float* BU = (float*)(smem + S5_BU_OFF); float* CTr = (float*)(smem + S5_CT_OFF); float* CTi = CTr + 1024;
    const int st = tid & 63, dB = (tid >> 7) & 1, half = (tid >> 6) & 1;
    const int dS = (tid >> 6) & 1;
    float bre[16], bim[16]; float are = 0.f, aim = 0.f; float dco = 0.f;
    int cur_g = -1;
    const int job0 = obid();
    u32x2 unext = {0u, 0u};
    if (job0 < NC * SG && tid < 256) unext = *(const u32x2*)(p.Z + (size_t)((job0 / SG) * 64 + (tid >> 2)) * D_IN + ZS5 + (job0 % SG) * 16 + (tid & 3) * 4);
    for (int job = job0; job < NC * SG; job += gridDim.x) {
        const int n = job / SG, g = job % SG;
        __syncthreads();
        if (g != cur_g) {
            cur_g = g;
            if (tid < 256) {
                const size_t ci = ((size_t)dB * SG + g) * 64 + st;
#pragma unroll
                for (int c = 0; c < 16; ++c) { const float2 b2 = *(const float2*)(p.S5BB + (ci * 16 + c) * 2); bre[c] = b2.x; bim[c] = b2.y; }
            }
            if (tid < 128) { const size_t ci = ((size_t)dS * SG + g) * 64 + st; are = p.S5A[ci * 2]; aim = p.S5A[ci * 2 + 1]; }
            if (with_out) {
                for (int idx = tid; idx < 1024; idx += NTHREADS) {
                    const int c = idx >> 6, pp = idx & 63;
                    CTr[pp * 16 + c] = p.in[I_S5CRE][((size_t)l * SG + g) * 1024 + idx];
                    CTi[pp * 16 + c] = p.in[I_S5CIM][((size_t)l * SG + g) * 1024 + idx];
                }
                dco = p.in[I_S5D][(size_t)l * SW + g * 16 + (tid & 15)];
            }
        }
        if (tid < 256) {
            float* dst = su + (tid >> 2) * 16 + (tid & 3) * 4;
            dst[0] = LO16(unext.x); dst[1] = HI16(unext.x); dst[2] = LO16(unext.y); dst[3] = HI16(unext.y);
            const int jn = job + gridDim.x;
            if (jn < NC * SG) unext = *(const u32x2*)(p.Z + (size_t)((jn / SG) * 64 + (tid >> 2)) * D_IN + ZS5 + (jn % SG) * 16 + (tid & 3) * 4);
        }
        float xr = 0.f, xi = 0.f;
        const size_t eo = (((size_t)dS * NC + n) * SG + g) * 64 + st;
        if (with_out && tid < 128) { const float2 c2 = *(const float2*)(p.S5CAR + eo * 2); xr = c2.x; xi = c2.y; }
        __syncthreads();
        if (tid < 256) {
            for (int ii = 0; ii < 32; ++ii) {
                const int i = half * 32 + ii;
                const f32x4* up = (const f32x4*)(su + i * 16);
                const f32x4 u0 = up[0], u1 = up[1], u2 = up[2], u3 = up[3];
                float ur = 0.f, ui = 0.f;
#pragma unroll
                for (int c = 0; c < 4; ++c) {
                    ur += bre[c] * u0[c] + bre[4 + c] * u1[c] + bre[8 + c] * u2[c] + bre[12 + c] * u3[c];
                    ui += bim[c] * u0[c] + bim[4 + c] * u1[c] + bim[8 + c] * u2[c] + bim[12 + c] * u3[c];
                }
                float2 o; o.x = ur; o.y = ui;
                *(float2*)(BU + (dB * 64 + i) * 130 + st * 2) = o;
            }
        }
        __syncthreads();
        if (tid < 128) {
#pragma unroll 8
            for (int ii = 0; ii < 64; ++ii) {
                const int i = dS ? 63 - ii : ii;
                float2* bp = (float2*)(BU + (dS * 64 + i) * 130 + st * 2);
                const float2 b = *bp;
                const float nr = are * xr - aim * xi + b.x, ni = are * xi + aim * xr + b.y;
                xr = nr; xi = ni;
                if (with_out) { float2 o; o.x = xr; o.y = xi; *bp = o; }
            }
            if (!with_out) { float2 o; o.x = xr; o.y = xi; *(float2*)(p.S5END + eo * 2) = o; }
        }
        if (with_out) {
            __syncthreads();
            for (int idx = tid; idx < 1024; idx += NTHREADS) {
                const int i = idx >> 4, c = idx & 15;
                const float* x0 = BU + (0 * 64 + i) * 130; const float* x1 = BU + (1 * 64 + i) * 130;
                float a = 0.f;
#pragma unroll 8
                for (int s2 = 0; s2 < 64; ++s2) {
                    const float2 f = *(const float2*)(x0 + s2 * 2), b = *(const float2*)(x1 + s2 * 2);
                    a += CTr[s2 * 16 + c] * (f.x + b.x) - CTi[s2 * 16 + c] * (f.y + b.y);
                }
                a += dco * su[idx];
                p.GY[(size_t)(n * 64 + i) * SW + g * 16 + c] = f2bf(geluf_(a));
            }
        }
    }
    __syncthreads();
}
__device__ __forceinline__ void s5_carry_job(const P& p, int job) {
    const int base = job * NTHREADS + otid();
    if (base >= 2 * SG * 64) return;
    const int d = base / (SG * 64), g = (base / 64) % SG, st = base % 64;
    const size_t ci = ((size_t)d * SG + g) * 64 + st;
    float ar = p.S5A[ci * 2], ai = p.S5A[ci * 2 + 1];
    for (int i = 0; i < 6; ++i) { const float nr = ar * ar - ai * ai, ni = 2.f * ar * ai; ar = nr; ai = ni; }
    const float2* __restrict__ endp = (const float2*)p.S5END; float2* __restrict__ carp = (float2*)p.S5CAR;
    float cr = 0.f, cim = 0.f;
    for (int s = 0; s < NC; s += 4) {
        float2 ev[4]; size_t eo[4];
#pragma unroll
        for (int u = 0; u < 4; ++u) {
            const int n = chunk_order(d, (s + u < NC) ? s + u : NC - 1);
            eo[u] = (((size_t)d * NC + n) * SG + g) * 64 + st;
            ev[u] = endp[eo[u]];
        }
#pragma unroll
        for (int u = 0; u < 4; ++u) if (s + u < NC) {
            float2 c; c.x = cr; c.y = cim; carp[eo[u]] = c;
            const float nr = ar * cr - ai * cim + ev[u].x, ni = ar * cim + ai * cr + ev[u].y;
            cr = nr; cim = ni;
        }
    }
}

__device__ __forceinline__ void phase_side_elem(const P& p, int l) {
    const int lane = otid() & 63;
    const int gw = (obid() * NTHREADS + otid()) >> 6, nw = (gridDim.x * NTHREADS) >> 6;
    const bool actg = lane * 8 < GLA_V, actr = lane * 8 < RW;
    float gng[8], lnw[8], lnb[8];
#pragma unroll
    for (int e = 0; e < 8; ++e) { gng[e] = 0.f; lnw[e] = 0.f; lnb[e] = 0.f; }
    if (actg) load8f(p.in[I_GLA_NG] + (size_t)l * 128 + ((lane * 8) & 127), gng);
    if (actr) { load8f(p.in[I_RLNW] + (size_t)l * RW + lane * 8, lnw); load8f(p.in[I_RLNB] + (size_t)l * RW + lane * 8, lnb); }
    for (int t = gw; t < MTOT; t += nw) {
        float og[8], zo[8], y0[8], y1[8], vv[8];
        const u32x4 z4 = {0u, 0u, 0u, 0u};
#pragma unroll
        for (int e = 0; e < 8; ++e) { og[e] = 0.f; y0[e] = 0.f; y1[e] = 0.f; }
        if (actg) load8f(p.OGLA + (size_t)t * GLA_V + lane * 8, og);
        unpack8(actg ? *(const u32x4*)(p.Z + (size_t)t * D_IN + ZOG + lane * 8) : z4, zo);
        if (actr) { load8f(p.Y + (size_t)t * RW + lane * 8, y0); load8f(p.Y + ((size_t)MTOT + t) * RW + lane * 8, y1); }
        unpack8(actr ? *(const u32x4*)(p.V + (size_t)t * RW + lane * 8) : z4, vv);
        const int hh = (lane * 8) >> 6;
        const float bon = actr ? (p.BONUS[(size_t)t * RH + hh] + p.BONUS[((size_t)MTOT + t) * RH + hh]) : 0.f;
        float ss = 0.f;
#pragma unroll
        for (int e = 0; e < 8; ++e) ss += og[e] * og[e];
        ss += __shfl_xor(ss, 1, 64); ss += __shfl_xor(ss, 2, 64); ss += __shfl_xor(ss, 4, 64); ss += __shfl_xor(ss, 8, 64);
        const float rstd = rsqrtf(ss * (1.0f / 128.f) + 1e-6f);
        float br[8];
#pragma unroll
        for (int e = 0; e < 8; ++e) br[e] = og[e] * rstd * gng[e] * siluf_(zo[e]);
        if (actg) *(u32x4*)(p.BR + (size_t)t * 3 * BW + lane * 8) = pack8(br);
        float y[8]; float sm = 0.f;
#pragma unroll
        for (int e = 0; e < 8; ++e) { y[e] = y0[e] + y1[e]; sm += y[e]; }
        sm += __shfl_xor(sm, 1, 64); sm += __shfl_xor(sm, 2, 64); sm += __shfl_xor(sm, 4, 64);
        const float mu = sm * (1.0f / 64.f);
        float sv = 0.f;
#pragma unroll
        for (int e = 0; e < 8; ++e) { y[e] -= mu; sv += y[e] * y[e]; }
        sv += __shfl_xor(sv, 1, 64); sv += __shfl_xor(sv, 2, 64); sv += __shfl_xor(sv, 4, 64);
        const float rs = rsqrtf(sv * (1.0f / 64.f) + 64e-5f);
        float yn[8];
#pragma unroll
        for (int e = 0; e < 8; ++e) yn[e] = y[e] * rs * lnw[e] + lnb[e] + bon * vv[e];
        if (actr) store8f(p.YN + (size_t)t * RW + lane * 8, yn);
    }
}

__device__ __forceinline__ void phase_side_gemm(const P& p, int l, char* smem) {
    const int ntm = MTOT / 128, nt1 = NPAD(RW) / 128, nt2 = (2 * SW) / 128;
    for (int job = obid(); job < ntm * (nt1 + nt2); job += gridDim.x) {
        const int m0 = (job / (nt1 + nt2)) * 128, jn = job % (nt1 + nt2);
        f32x4 acc[4][4]; ZERO_ACC4(acc);
        if (jn < nt1) {
            const int n0 = jn * 128;
            mfma_gemm_tile(p.WT_G2, 128, p.GS, 128, 128, n0, m0, (bf16_t*)smem, acc);
            FOR_ACC(acc, n0, m0, { if (n < RW) { const float4 y = *(const float4*)(p.YN + (size_t)m * RW + n);
                *(u32x2*)(p.BR + (size_t)m * 3 * BW + BW + n) = pack4(y.x * v[0], y.y * v[1], y.z * v[2], y.w * v[3]); } })
        } else {
            const int n0 = (jn - nt1) * 128;
            mfma_gemm_tile(p.WT_GLU, SW, p.GY, SW, SW, n0, m0, (bf16_t*)smem, acc);
            FOR_ACC(acc, n0, m0, { const unsigned w = pack2bf(v[0] * sigmoidf_(v[1]), v[2] * sigmoidf_(v[3]));
                *(unsigned*)(p.BR + (size_t)m * 3 * BW + 2 * BW + (n >> 1)) = w; })
        }
    }
}

__device__ __forceinline__ void phase_merge(const P& p, int l, char* smem) {
    const int ntm = MTOT / 128, ntn = D_MODEL / 128;
    for (int job = obid(); job < ntm * ntn; job += gridDim.x) {
        const int m0 = (job / ntn) * 128, n0 = (job % ntn) * 128;
        f32x4 macc[4][4]; ZERO_ACC4(macc);
        for (int b = 0; b < 3; ++b) {
            f32x4 acc[4][4]; ZERO_ACC4(acc);
            mfma_gemm_tile(p.WT_BR + (size_t)b * D_MODEL * BW, BW, p.BR + b * BW, 3 * BW, BW, n0, m0, (bf16_t*)smem, acc);
            const int lane_ = otid() & 63, wave_ = otid() >> 6;
#pragma unroll
            for (int ni = 0; ni < 4; ++ni)
#pragma unroll
                for (int mi = 0; mi < 4; ++mi) {
                    const int n = n0 + (wave_ >> 1) * 64 + ni * 16 + (lane_ >> 4) * 4, m = m0 + (wave_ & 1) * 64 + mi * 16 + (lane_ & 15);
                    const u32x2 g = *(const u32x2*)(p.Z + (size_t)m * D_IN + ZG + b * D_MODEL + n);
                    macc[ni][mi][0] += sigmoidf_(bf2f((bf16_t)(g.x & 0xFFFF))) * acc[ni][mi][0];
                    macc[ni][mi][1] += sigmoidf_(bf2f((bf16_t)(g.x >> 16))) * acc[ni][mi][1];
                    macc[ni][mi][2] += sigmoidf_(bf2f((bf16_t)(g.y & 0xFFFF))) * acc[ni][mi][2];
                    macc[ni][mi][3] += sigmoidf_(bf2f((bf16_t)(g.y >> 16))) * acc[ni][mi][3];
                }
        }
        FOR_ACC(macc, n0, m0, { *(u32x2*)(p.M + (size_t)m * D_MODEL + n) = pack4(v[0], v[1], v[2], v[3]); })
    }
}

__device__ __forceinline__ void phase_outproj(const P& p, int l, char* smem) {
    const int ntm = MTOT / 128, ntn = D_MODEL / 128;
    for (int job = obid(); job < ntm * ntn; job += gridDim.x) {
        const int m0 = (job / ntn) * 128, n0 = (job % ntn) * 128;
        f32x4 acc[4][4]; ZERO_ACC4(acc);
        mfma_gemm_tile(p.WT_OUT, D_MODEL, p.M, D_MODEL, D_MODEL, n0, m0, (bf16_t*)smem, acc);
        FOR_ACC(acc, n0, m0, { const float* g1 = p.MOD + (size_t)(l * 2 + (m >= CTX ? 1 : 0)) * 6 * D_MODEL + 2 * D_MODEL + n;
            float4* xp = (float4*)(p.X + (size_t)m * D_MODEL + n); float4 x = *xp;
            x.x += g1[0] * v[0]; x.y += g1[1] * v[1]; x.z += g1[2] * v[2]; x.w += g1[3] * v[3]; *xp = x; })
    }
}

__device__ __forceinline__ void store_q_hilo(const P& p, int m, int n, const f32x4 v) {
    const bf16_t h0 = f2bf(v[0]), h1 = f2bf(v[1]), h2 = f2bf(v[2]), h3 = f2bf(v[3]);
    u32x2 hv; hv.x = (unsigned)h0 | ((unsigned)h1 << 16); hv.y = (unsigned)h2 | ((unsigned)h3 << 16);
    *(u32x2*)(p.QHI + (size_t)m * PQ + n) = hv;
    *(u32x2*)(p.QLO + (size_t)m * PQ + n) = pack4(v[0] - bf2f(h0), v[1] - bf2f(h1), v[2] - bf2f(h2), v[3] - bf2f(h3));
}
__device__ __forceinline__ void phase_peer_q(const P& p, int l, char* smem) {
    const int ntm = MTOT / 128, ntn = PQ / 128;
    for (int job = obid(); job < ntm * ntn; job += gridDim.x) {
        const int m0 = (job / ntn) * 128, n0 = (job % ntn) * 128;
        f32x4 acc[4][4]; ZERO_ACC4(acc);
        mfma_gemm_tile(p.WT_Q, D_MODEL, p.H, D_MODEL, D_MODEL, n0, m0, (bf16_t*)smem, acc);
        FOR_ACC(acc, n0, m0, { store_q_hilo(p, m, n, v); })
    }
}

#define TK_ROW 129
__device__ __forceinline__ unsigned tk_key(float f, unsigned lowmask, unsigned low) {
    unsigned u = __builtin_bit_cast(unsigned, f);
    u ^= (u & 0x80000000u) ? 0xFFFFFFFFu : 0x80000000u;
    return (u & ~lowmask) | low;
}
#define TK_INSERT(lv, xk) { unsigned x_ = (xk); _Pragma("unroll") for (int z_ = 0; z_ < 16; ++z_) { const unsigned hi_ = lv[z_] > x_ ? lv[z_] : x_; x_ = lv[z_] > x_ ? x_ : lv[z_]; lv[z_] = hi_; } }
__device__ __forceinline__ void phase_peer_topk(const P& p, int l, char* smem) {
    const int tid = otid(), lane = tid & 63, wv = tid >> 6, q = lane >> 4, r = lane & 15;
    float* sc = (float*)smem + wv * (64 * TK_ROW);
    const int gw = (obid() * NTHREADS + tid) >> 6, nw = (gridDim.x * NTHREADS) >> 6;
    const float NEG = -3.0e38f;
    for (int job = gw; job < (MTOT / 32) * PH; job += nw) {
        const int t0 = (job / PH) * 32, h = job % PH;
#pragma unroll
        for (int sd = 0; sd < 2; ++sd) {
            f32x4 acc[2][8];
#pragma unroll
            for (int mt = 0; mt < 2; ++mt)
#pragma unroll
                for (int nt = 0; nt < 8; ++nt) acc[mt][nt] = (f32x4){0.f, 0.f, 0.f, 0.f};
#pragma unroll
            for (int ks = 0; ks < 4; ++ks) {
                bf16x8 ah[2], al[2];
#pragma unroll
                for (int mt = 0; mt < 2; ++mt) {
                    const size_t qo = (size_t)(t0 + mt * 16 + r) * PQ + h * 256 + sd * 128 + ks * 32 + q * 8;
                    ah[mt] = *(const bf16x8*)(p.QHI + qo); al[mt] = *(const bf16x8*)(p.QLO + qo);
                }
#pragma unroll
                for (int nt = 0; nt < 8; ++nt) {
                    const size_t ko = ((size_t)(h * 2 + sd) * 128 + nt * 16 + r) * 128 + ks * 32 + q * 8;
                    const bf16x8 bh = *(const bf16x8*)(p.KHI + ko), bl = *(const bf16x8*)(p.KLO + ko);
#pragma unroll
                    for (int mt = 0; mt < 2; ++mt) {
                        acc[mt][nt] = MFMA16(ah[mt], bh, acc[mt][nt]);
                        acc[mt][nt] = MFMA16(al[mt], bh, acc[mt][nt]);
                        acc[mt][nt] = MFMA16(ah[mt], bl, acc[mt][nt]);
                    }
                }
            }
#pragma unroll
            for (int mt = 0; mt < 2; ++mt)
#pragma unroll
                for (int nt = 0; nt < 8; ++nt)
#pragma unroll
                    for (int e = 0; e < 4; ++e) sc[(sd * 32 + mt * 16 + 4 * q + e) * TK_ROW + nt * 16 + r] = acc[mt][nt][e];
        }
        WAVE_SYNC();
        unsigned lv[16];
#pragma unroll
        for (int z = 0; z < 16; ++z) lv[z] = 0u;
        {
            const float* row = sc + lane * TK_ROW;
#pragma unroll 4
            for (int k = 0; k < 128; ++k) TK_INSERT(lv, tk_key(row[k], 0x7Fu, (unsigned)(127 - k)));
        }
        float lvv[16]; int li[16];
        {
            const float* row = sc + lane * TK_ROW;
#pragma unroll
            for (int z = 0; z < 16; ++z) { li[z] = 127 - (int)(lv[z] & 0x7Fu); lvv[z] = row[li[z]]; }
        }
        WAVE_SYNC();
        {
            float* row = sc + lane * TK_ROW;
#pragma unroll
            for (int z = 0; z < 16; ++z) { row[z] = lvv[z]; ((int*)row)[16 + z] = li[z]; }
        }
        WAVE_SYNC();
        const float* r1 = sc + (lane & 31) * TK_ROW; const float* r2 = sc + (32 + (lane & 31)) * TK_ROW;
        unsigned tk[16];
#pragma unroll
        for (int z = 0; z < 16; ++z) tk[z] = 0u;
        for (int i = 0; i < 16; ++i) {
            const float a = r1[i];
            const int nj = 16 / (i + 1);
            for (int j = 0; j < nj; ++j) TK_INSERT(tk, tk_key(a + r2[j], 0xFFu, (unsigned)(255 - (i * 16 + j))));
        }
        int tc[16];
#pragma unroll
        for (int z = 0; z < 16; ++z) tc[z] = 255 - (int)(tk[z] & 0xFFu);
        if (lane < 32) {
            float vals[16]; float mx = 0.f; float ssum = 0.f;
#pragma unroll
            for (int z = 0; z < 16; ++z) { vals[z] = r1[tc[z] >> 4] + r2[tc[z] & 15]; if (z == 0) mx = vals[0]; vals[z] = fexp_(vals[z] - mx); ssum += vals[z]; }
            const float inv = 1.0f / ssum;
            const size_t o = (size_t)(t0 + lane) * PH * 16 + h * 16;
#pragma unroll
            for (int z = 0; z < 16; ++z) {
                const int ex_ = ((const int*)r1)[16 + (tc[z] >> 4)] * 128 + ((const int*)r2)[16 + (tc[z] & 15)];
                p.IDX[o + z] = ex_;
                p.G[o + z] = vals[z] * inv * p.VSC[ex_];
                p.GU[o + z] = p.USC[ex_];
            }
        }
        WAVE_SYNC();
    }
}

#define PEER_CONV_JOBS (2 * NEXP / 4)
__device__ __forceinline__ void peer_conv_job(const P& p, int l, int job) {
    const int tid = otid(), lane = tid & 63, wv = tid >> 6;
    if (wv >= 4) return;
    const int rowg = job * 4 + wv; const int which = rowg / NEXP, row = rowg % NEXP;
    const float* src = p.in[which ? I_PV : I_PU] + ((size_t)l * NEXP + row) * D_MODEL + lane * 16;
    const bool act = lane * 16 < D_MODEL;
    float v[16]; float amax = 0.f;
#pragma unroll
    for (int c = 0; c < 4; ++c) {
        float4 a; a.x = 0.f; a.y = 0.f; a.z = 0.f; a.w = 0.f;
        if (act) a = *(const float4*)(src + c * 4);
        v[c * 4 + 0] = a.x; v[c * 4 + 1] = a.y; v[c * 4 + 2] = a.z; v[c * 4 + 3] = a.w;
        amax = fmaxf(amax, fmaxf(fmaxf(fabsf(a.x), fabsf(a.y)), fmaxf(fabsf(a.z), fabsf(a.w))));
    }
#pragma unroll
    for (int m = 32; m >= 1; m >>= 1) amax = fmaxf(amax, __shfl_xor(amax, m, 64));
    int ex = 0;
    if (amax > 0.f) ex = 7 - (int)((__builtin_bit_cast(unsigned, amax) >> 23) & 0xFF) + 127;
    ex = ex < -100 ? -100 : (ex > 100 ? 100 : ex);
    const float sc = __builtin_bit_cast(float, (unsigned)(ex + 127) << 23), isc = __builtin_bit_cast(float, (unsigned)(127 - ex) << 23);
    u32x4 o;
    int w0 = 0, w1 = 0, w2 = 0, w3 = 0;
    w0 = CVT_PK_FP8(v[0] * sc, v[1] * sc, w0, false); w0 = CVT_PK_FP8(v[2] * sc, v[3] * sc, w0, true);
    w1 = CVT_PK_FP8(v[4] * sc, v[5] * sc, w1, false); w1 = CVT_PK_FP8(v[6] * sc, v[7] * sc, w1, true);
    w2 = CVT_PK_FP8(v[8] * sc, v[9] * sc, w2, false); w2 = CVT_PK_FP8(v[10] * sc, v[11] * sc, w2, true);
    w3 = CVT_PK_FP8(v[12] * sc, v[13] * sc, w3, false); w3 = CVT_PK_FP8(v[14] * sc, v[15] * sc, w3, true);
    o.x = (unsigned)w0; o.y = (unsigned)w1; o.z = (unsigned)w2; o.w = (unsigned)w3;
    unsigned char* dst = (which ? p.V8 : p.U8) + (size_t)row * D_MODEL + lane * 16;
    if (act) *(u32x4*)dst = o;
    if (lane == 0) (which ? p.VSC : p.USC)[row] = isc;
}
#define GE 8
struct GBuf { u32x4 u[GE]; u32x4 v[GE]; float gu; float gv; };
__device__ __forceinline__ void gather_load(const P& p, GBuf& b, int g, int idx0, int idx1, float g0, float g1, float u0, float u1, int lane) {
    const bool act = lane * 16 < D_MODEL;
#pragma unroll
    for (int q = 0; q < GE; ++q) {
        const int k = g * GE + q;
        const int ei = __shfl((k < 64) ? idx0 : idx1, k & 63, 64);
        b.u[q] = act ? *(const u32x4*)(p.U8 + (size_t)ei * D_MODEL + lane * 16) : (u32x4){0u, 0u, 0u, 0u};
        b.v[q] = act ? *(const u32x4*)(p.V8 + (size_t)ei * D_MODEL + lane * 16) : (u32x4){0u, 0u, 0u, 0u};
    }
    const int km = g * GE + ((lane >> 3) & 7);
    b.gv = __shfl((km < 64) ? g0 : g1, km & 63, 64);
    b.gu = __shfl((km < 64) ? u0 : u1, km & 63, 64);
}
__device__ __forceinline__ void gather_compute(const GBuf& b, const float (&hv)[16], float (&acc)[16], int lane) {
    float dt[GE];
#pragma unroll
    for (int q = 0; q < GE; ++q) {
        float d = 0.f;
#pragma unroll
        for (int c = 0; c < 4; ++c) {
            const f32x2 lo = CVT_PK_F32_FP8((int)b.u[q][c], false), hi = CVT_PK_F32_FP8((int)b.u[q][c], true);
            d += hv[c * 4 + 0] * lo.x + hv[c * 4 + 1] * lo.y + hv[c * 4 + 2] * hi.x + hv[c * 4 + 3] * hi.y;
        }
        dt[q] = d;
    }
    float r4[4], r2[2], r1;
    {
        const bool up = (lane & 32) != 0;
#pragma unroll
        for (int q = 0; q < 4; ++q) { const float keep = up ? dt[4 + q] : dt[q], send = up ? dt[q] : dt[4 + q]; r4[q] = keep + __shfl_xor(send, 32, 64); }
    }
    {
        const bool up = (lane & 16) != 0;
#pragma unroll
        for (int q = 0; q < 2; ++q) { const float keep = up ? r4[2 + q] : r4[q], send = up ? r4[q] : r4[2 + q]; r2[q] = keep + __shfl_xor(send, 16, 64); }
    }
    {
        const bool up = (lane & 8) != 0;
        const float keep = up ? r2[1] : r2[0], send = up ? r2[0] : r2[1];
        r1 = keep + __shfl_xor(send, 8, 64);
    }
    r1 += __shfl_xor(r1, 4, 64); r1 += __shfl_xor(r1, 2, 64); r1 += __shfl_xor(r1, 1, 64);
    const float coef_mine = b.gv * geluf_(r1 * b.gu);
#pragma unroll
    for (int q = 0; q < GE; ++q) {
        const float coef = __shfl(coef_mine, q * 8, 64);
#pragma unroll
        for (int c = 0; c < 4; ++c) {
            const f32x2 lo = CVT_PK_F32_FP8((int)b.v[q][c], false), hi = CVT_PK_F32_FP8((int)b.v[q][c], true);
            acc[c * 4 + 0] += coef * lo.x; acc[c * 4 + 1] += coef * lo.y; acc[c * 4 + 2] += coef * hi.x; acc[c * 4 + 3] += coef * hi.y;
        }
    }
}
__device__ __forceinline__ void phase_peer_gather(const P& p, int l) {
    const int lane = otid() & 63;
    const int gw = (obid() * NTHREADS + otid()) >> 6, nw = (gridDim.x * NTHREADS) >> 6;
    constexpr int NG = PH * 16 / GE;
    const bool act = lane * 16 < D_MODEL;
    for (int t = gw; t < MTOT; t += nw) {
        float hv[16], acc[16];
        {
            const u32x4 z4 = {0u, 0u, 0u, 0u};
            const u32x4 ha = act ? *(const u32x4*)(p.H + (size_t)t * D_MODEL + lane * 16) : z4;
            const u32x4 hb = act ? *(const u32x4*)(p.H + (size_t)t * D_MODEL + lane * 16 + 8) : z4;
            hv[0] = LO16(ha.x); hv[1] = HI16(ha.x); hv[2] = LO16(ha.y); hv[3] = HI16(ha.y); hv[4] = LO16(ha.z); hv[5] = HI16(ha.z); hv[6] = LO16(ha.w); hv[7] = HI16(ha.w);
            hv[8] = LO16(hb.x); hv[9] = HI16(hb.x); hv[10] = LO16(hb.y); hv[11] = HI16(hb.y); hv[12] = LO16(hb.z); hv[13] = HI16(hb.z); hv[14] = LO16(hb.w); hv[15] = HI16(hb.w);
#pragma unroll
            for (int j = 0; j < 16; ++j) acc[j] = 0.f;
        }
        int idx0 = 0, idx1 = 0; float g0 = 0.f, g1 = 0.f, u0 = 0.f, u1 = 0.f;
        if (lane < PH * 16) { idx0 = p.IDX[(size_t)t * PH * 16 + lane]; g0 = p.G[(size_t)t * PH * 16 + lane]; u0 = p.GU[(size_t)t * PH * 16 + lane]; }
        if (64 + lane < PH * 16) { idx1 = p.IDX[(size_t)t * PH * 16 + 64 + lane]; g1 = p.G[(size_t)t * PH * 16 + 64 + lane]; u1 = p.GU[(size_t)t * PH * 16 + 64 + lane]; }
        GBuf ba, bb;
        gather_load(p, ba, 0, idx0, idx1, g0, g1, u0, u1, lane);
        for (int g = 0; g < NG; g += 2) {
            gather_load(p, bb, g + 1, idx0, idx1, g0, g1, u0, u1, lane);
            gather_compute(ba, hv, acc, lane);
            if (g + 2 < NG) gather_load(p, ba, g + 2, idx0, idx1, g0, g1, u0, u1, lane);
            gather_compute(bb, hv, acc, lane);
        }
        if (act) {
            const float* g2 = p.MOD + (size_t)(l * 2 + (t >= CTX ? 1 : 0)) * 6 * D_MODEL + 5 * D_MODEL + lane * 16;
            float* xp = p.X + (size_t)t * D_MODEL + lane * 16;
#pragma unroll
            for (int c = 0; c < 4; ++c) {
                float4 x = *(float4*)(xp + c * 4);
                x.x += g2[c * 4 + 0] * acc[c * 4 + 0]; x.y += g2[c * 4 + 1] * acc[c * 4 + 1]; x.z += g2[c * 4 + 2] * acc[c * 4 + 2]; x.w += g2[c * 4 + 3] * acc[c * 4 + 3];
                *(float4*)(xp + c * 4) = x;
            }
        }
    }
}

__device__ __forceinline__ void phase_final(const P& p) {
    const int lane = otid() & 63;
    const int gw = (obid() * NTHREADS + otid()) >> 6, nw = (gridDim.x * NTHREADS) >> 6;
    const float* g = p.in[I_FG];
    for (int t = gw; t < SEQ; t += nw) {
        const float* x = p.X + (size_t)(CTX + t) * D_MODEL;
        float v[D_MODEL / 64]; float ss = 0.f;
#pragma unroll
        for (int j = 0; j < D_MODEL / 64; ++j) { v[j] = x[lane + 64 * j]; ss += v[j] * v[j]; }
        ss = wave_sum(ss);
        float rstd = rsqrtf(ss / D_MODEL + 1e-6f);
#pragma unroll
        for (int j = 0; j < D_MODEL / 64; ++j) p.out[(size_t)t * D_MODEL + lane + 64 * j] = v[j] * rstd * g[lane + 64 * j];
    }
}

__global__ void __launch_bounds__(NTHREADS) fwd_megakernel(P p_arg) {
#ifdef EMU
    char* smem = emu_smem();
#else
    __shared__ __attribute__((aligned(16))) char smem_raw[SMEM_BYTES + 16];
    char* smem = smem_raw;
#endif
#ifndef EMU
    volatile LAS unsigned* xst = (volatile LAS unsigned*)(smem_raw + SMEM_BYTES);
    if (threadIdx.x == 0) { xst[0] = 0u; xst[1] = 0u; xst[2] = 0u; xst[3] = 0u; }
    __syncthreads();
    XcdBarrier xb = xcd_barrier_post(p_arg.bar, xst);
#endif
    { LOADP(); phase_init(p, smem); }
#ifndef EMU
    cg::this_grid().sync();
#endif
    GRID_SYNC();
    PROBE_INIT();
    for (int l = 0; l < DEPTH; ++l) {
        { LOADP(); phase_norm(p, l, 0); }
        { LOADP(); phase_s5const(p, l); }
        { LOADP(); phase_convert_weights(p, l, smem); }
        GRID_SYNC(); PROBE_AFTER(0);
        { LOADP(); phase_gemm_in(p, l, smem); }
        GRID_SYNC(); PROBE_AFTER(1);
        { LOADP(); phase_rwkv_prep1(p, l); }
        GRID_SYNC(); PROBE_AFTER(14);
        { LOADP(); phase_rwkv_prep2(p, l, smem); }
        GRID_SYNC(); PROBE_AFTER(2);
        { LOADP(); for (int job = obid(); job < 2 * NC * RH; job += gridDim.x) rwkv_chunk_job(p, job, smem); }
        __syncthreads();
        { LOADP(); phase_gla_kv(p, l, smem); }
        { LOADP(); phase_s5_pass(p, l, smem, false); }
        GRID_SYNC(); PROBE_AFTER(3);
        {
            LOADP();
            const int n_rw = 2 * RH, n_gla = 2 * GH * 8192 / NTHREADS, n_s5 = (2 * SG * 64 + NTHREADS - 1) / NTHREADS;
            for (int job = obid(); job < n_rw + n_gla + n_s5 + PEER_CONV_JOBS; job += gridDim.x) {
                if (job < n_rw) rwkv_seq_job(p, job, smem);
                else if (job < n_rw + n_gla) gla_scan_job(p, job - n_rw);
                else if (job < n_rw + n_gla + n_s5) s5_carry_job(p, job - n_rw - n_gla);
                else peer_conv_job(p, l, job - n_rw - n_gla - n_s5);
            }
        }
        GRID_SYNC(); PROBE_AFTER(4);
        { LOADP(); for (int job = obid(); job < 2 * NC * RH; job += gridDim.x) rwkv_out_job(p, job); }
        { LOADP(); phase_gla_out(p, l, smem); }
        { LOADP(); phase_s5_pass(p, l, smem, true); }
        GRID_SYNC(); PROBE_AFTER(5);
        { LOADP(); phase_side_elem(p, l); }
        GRID_SYNC(); PROBE_AFTER(6);
        { LOADP(); phase_side_gemm(p, l, smem); }
        GRID_SYNC(); PROBE_AFTER(7);
        { LOADP(); phase_merge(p, l, smem); }
        GRID_SYNC(); PROBE_AFTER(8);
        { LOADP(); phase_outproj(p, l, smem); }
        GRID_SYNC(); PROBE_AFTER(9);
        { LOADP(); phase_norm(p, l, 1); }
        GRID_SYNC(); PROBE_AFTER(10);
        { LOADP(); phase_peer_q(p, l, smem); }
        GRID_SYNC(); PROBE_AFTER(11);
        { LOADP(); phase_peer_topk(p, l, smem); }
        GRID_SYNC(); PROBE_AFTER(12);
        { LOADP(); phase_peer_gather(p, l); }
        GRID_SYNC(); PROBE_AFTER(13);
    }
    { LOADP(); phase_final(p); }
}

static inline size_t align_up(size_t x) { return (x + 255) & ~(size_t)255; }

extern "C" void kernel_launch(void* const* d_in, const int* in_sizes, int n_in, void* d_out, int out_size, void* d_ws, size_t ws_size, hipStream_t stream) {
    P p;
    memset(&p, 0, sizeof(p));
    for (int i = 0; i < 39; ++i) p.in[i] = (const float*)d_in[i];
    p.out = (float*)d_out;
    char* w = (char*)d_ws; size_t off = 0;
    auto take = [&](size_t bytes) { void* r = w + off; off = align_up(off + bytes); return r; };
    p.bar = (unsigned*)take(16384);
    p.X = (float*)take((size_t)MTOT * D_MODEL * 4);
    p.H = (bf16_t*)take((size_t)MTOT * D_MODEL * 2);
    p.MOD = (float*)take((size_t)DEPTH * 2 * 6 * D_MODEL * 4);
    p.Z = (bf16_t*)take((size_t)MTOT * D_IN * 2);
    p.V = (bf16_t*)take((size_t)MTOT * RW * 2);
    {
        char* ra = (char*)take((size_t)MTOT * RW * 2 * 2 > (size_t)MTOT * GLA_V * 4 ? (size_t)MTOT * RW * 2 * 2 : (size_t)MTOT * GLA_V * 4);
        p.R = (bf16_t*)ra; p.KK = (bf16_t*)(ra + (size_t)MTOT * RW * 2);
        p.OGLA = (float*)ra;
    }
    {
        char* rb = (char*)take((size_t)2 * MTOT * RW * 2 > (size_t)3 * MTOT * PH * 16 * 4 ? (size_t)2 * MTOT * RW * 2 : (size_t)3 * MTOT * PH * 16 * 4);
        p.KD = (bf16_t*)rb;
        p.IDX = (int*)rb; p.G = (float*)(rb + (size_t)MTOT * PH * 16 * 4); p.GU = (float*)(rb + (size_t)2 * MTOT * PH * 16 * 4);
    }
    p.BB = (bf16_t*)take((size_t)2 * MTOT * RW * 2);
    p.LW = (float*)take((size_t)2 * MTOT * RW * 4);
    p.SP = (bf16_t*)p.LW;
    static_assert((size_t)2 * NC * GH * 8192 * 2 <= (size_t)2 * MTOT * RW * 4, "SP alias");
    p.BONUS = (float*)take((size_t)2 * MTOT * RH * 4);
    p.KS = (bf16_t*)take((size_t)MTOT * RW * 2);
    p.LR = (bf16_t*)take((size_t)MTOT * 256 * 2);
    p.WT_W2 = (bf16_t*)take((size_t)2 * NPAD(RW) * 64 * 2);
    p.WT_A2 = (bf16_t*)take((size_t)2 * NPAD(RW) * 64 * 2);
    p.GS = (bf16_t*)take((size_t)MTOT * 128 * 2);
    p.Y = (float*)take((size_t)2 * MTOT * RW * 4);
    p.KV = (float*)take((size_t)2 * NC * GH * 8192 * 4);
    p.DEC = (float*)take((size_t)2 * NC * GH * 64 * 4);
    p.S5A = (float*)take((size_t)2 * SG * 64 * 2 * 4);
    p.S5BB = (float*)take((size_t)2 * SG * 64 * 16 * 2 * 4);
    p.S5END = (float*)take((size_t)2 * NC * SG * 64 * 2 * 4);
    p.S5CAR = (float*)take((size_t)2 * NC * SG * 64 * 2 * 4);
    {
        const size_t szc1 = (size_t)2 * NC * RH * SEQ_REC;
        const size_t szc2 = (size_t)MTOT * SW * 2 + (size_t)MTOT * RW * 4 + (size_t)MTOT * 3 * BW * 2 + (size_t)MTOT * D_MODEL * 2 + 1024;
        char* rc = (char*)take(szc1 > szc2 ? szc1 : szc2);
        p.REC = rc;
        char* c2 = rc;
        p.GY = (bf16_t*)c2; c2 += align_up((size_t)MTOT * SW * 2);
        p.YN = (float*)c2; c2 += align_up((size_t)MTOT * RW * 4);
        p.BR = (bf16_t*)c2; c2 += align_up((size_t)MTOT * 3 * BW * 2);
        p.M = (bf16_t*)c2;
    }
    p.SN = (bf16_t*)take((size_t)2 * NC * RH * 4096 * 2);
    p.QH = (bf16_t*)take((size_t)2 * NC * RH * 4096 * 2);
    p.WT_IN = (bf16_t*)take((size_t)NPAD(D_IN) * D_MODEL * 2);
    p.WT_G2 = (bf16_t*)take((size_t)NPAD(RW) * 128 * 2);
    p.WT_GLU = (bf16_t*)take((size_t)NPAD(2 * SW) * SW * 2);
    p.WT_BR = (bf16_t*)take((size_t)3 * D_MODEL * BW * 2);
    p.WT_OUT = (bf16_t*)take((size_t)D_MODEL * D_MODEL * 2);
    p.WT_Q = (bf16_t*)take((size_t)PQ * D_MODEL * 2);
    p.U8 = (unsigned char*)take((size_t)NEXP * D_MODEL);
    p.V8 = (unsigned char*)take((size_t)NEXP * D_MODEL);
    p.USC = (float*)take((size_t)NEXP * 4); p.VSC = (float*)take((size_t)NEXP * 4);
    p.QHI = p.Z; p.QLO = p.Z + (size_t)MTOT * PQ;
    p.KHI = (bf16_t*)take((size_t)PH * 2 * 128 * 128 * 2); p.KLO = (bf16_t*)take((size_t)PH * 2 * 128 * 128 * 2);
    static_assert((size_t)PQ * 4 <= (size_t)D_IN * 2, "Q alias");
    if (off > ws_size) { fprintf(stderr, "ws too small: need %zu have %zu\n", off, ws_size); return; }
#ifdef EMU
    fprintf(stderr, "ws used %zu MB\n", off >> 20);
    emu_launch([=] { fwd_megakernel(p); }, EMU_GRID, NTHREADS);
#else
    hipMemsetAsync(p.bar, 0, 16384, stream);
    static int grid_blocks = 0;
    if (!grid_blocks) {
        int dev = 0, cus = 0, per_cu = 0;
        hipGetDevice(&dev);
        hipDeviceGetAttribute(&cus, hipDeviceAttributeMultiprocessorCount, dev);
        hipOccupancyMaxActiveBlocksPerMultiprocessor(&per_cu, fwd_megakernel, NTHREADS, 0);
        if (per_cu > 1) per_cu = 1;
        grid_blocks = cus * per_cu;
    }
    void* args[] = {&p};
    hipError_t e = hipLaunchCooperativeKernel((void*)fwd_megakernel, dim3(grid_blocks), dim3(NTHREADS), args, 0, stream);
    if (e != hipSuccess) fprintf(stderr, "cooperative launch failed: %s (grid %d)\n", hipGetErrorString(e), grid_blocks);
#endif
}
```

```cpp
#include <hip/hip_runtime.h>
#ifndef EMU
#include <hip/hip_cooperative_groups.h>
namespace cg = cooperative_groups;
#endif
#include <cstdio>
#include <cstdint>
#include <cstring>

#ifdef CFG_SMALL
#define D_MODEL 128
#define SEQ 512
#define DEPTH 2
#define GRID_W 8
#define CTX 128
#define GH 1
#define RH 2
#define SG 8
#define PH 2
#else
#define D_MODEL 1024
#define SEQ 16384
#define DEPTH 4
#define GRID_W 64
#define CTX 256
#define GH 4
#define RH 8
#define SG 32
#define PH 8
#endif
#define MTOT (CTX + SEQ)
#define ROWS (SEQ / GRID_W)
#define GLA_K (GH * 64)
#define GLA_V (GH * 128)
#define RW (RH * 64)
#define RWKV_IN (3 * RW + 4 * 64 + 128)
#define SW (SG * 16)
#define BW GLA_V
#define ZQ 0
#define ZK (GLA_K)
#define ZV (2 * GLA_K)
#define ZOG (ZV + GLA_V)
#define ZAF (ZOG + GLA_V)
#define ZAB (ZAF + 16)
#define ZR (ZAB + 16)
#define ZS5 (ZR + RWKV_IN)
#define ZG (ZS5 + SW)
#define D_IN (ZG + 3 * D_MODEL)
#define NC (MTOT / 64)
#define NCC (CTX / 64)
#define RB (ROWS / 64)
#define PQ (PH * 256)
#define NEXP 16384
#define NTHREADS 256
#define SMEM_BYTES 133120

typedef unsigned short bf16_t;
typedef short bf16x8 __attribute__((ext_vector_type(8)));
typedef float f32x4 __attribute__((ext_vector_type(4)));
typedef unsigned u32x4 __attribute__((ext_vector_type(4)));
typedef unsigned u32x2 __attribute__((ext_vector_type(2)));
#ifdef EMU
#define MFMA16(a, b, c) emu_mfma_16x16x32_bf16(a, b, c)
#else
#define MFMA16(a, b, c) __builtin_amdgcn_mfma_f32_16x16x32_bf16(a, b, c, 0, 0, 0)
#endif
typedef float f32x2 __attribute__((ext_vector_type(2)));
#ifdef EMU
#define CVT_PK_FP8(a, b, old, hi) emu_cvt_pk_fp8_f32(a, b, old, hi)
#define CVT_PK_F32_FP8(w, hi) emu_cvt_pk_f32_fp8(w, hi)
#else
#define CVT_PK_FP8(a, b, old, hi) __builtin_amdgcn_cvt_pk_fp8_f32(a, b, old, hi)
#define CVT_PK_F32_FP8(w, hi) __builtin_amdgcn_cvt_pk_f32_fp8(w, hi)
#endif
#define NPAD(n) (((n) + 127) / 128 * 128)

__device__ __forceinline__ float bf2f(bf16_t h) { return __builtin_bit_cast(float, ((unsigned)h) << 16); }
#ifdef EMU
__device__ __forceinline__ bf16_t f2bf(float f) { unsigned u = __builtin_bit_cast(unsigned, f); u += 0x7FFFu + ((u >> 16) & 1u); return (bf16_t)(u >> 16); }
__device__ __forceinline__ unsigned pack2bf(float a, float b) { return (unsigned)f2bf(a) | ((unsigned)f2bf(b) << 16); }
#else
typedef float f2v_t __attribute__((ext_vector_type(2))); typedef __bf16 b2v_t __attribute__((ext_vector_type(2)));
__device__ __forceinline__ bf16_t f2bf(float f) { return __builtin_bit_cast(unsigned short, (__bf16)f); }
__device__ __forceinline__ unsigned pack2bf(float a, float b) { f2v_t v = {a, b}; b2v_t r = __builtin_convertvector(v, b2v_t); return __builtin_bit_cast(unsigned, r); }
#endif
#ifdef EMU
#define fexp_(x) expf(x)
#define flog_(x) logf(x)
#else
#define fexp_(x) __expf(x)
#define flog_(x) __logf(x)
#endif
#define LO16(x) __builtin_bit_cast(float, (x) << 16)
#define HI16(x) __builtin_bit_cast(float, (x) & 0xFFFF0000u)
__device__ __forceinline__ float sigmoidf_(float x) { return 1.0f / (1.0f + fexp_(-x)); }
__device__ __forceinline__ float siluf_(float x) { return x * sigmoidf_(x); }
__device__ __forceinline__ float geluf_(float x) { const float y = 1.5957691216057308f * (x + 0.044715f * x * x * x); return x / (1.0f + fexp_(-y)); }
__device__ __forceinline__ float softplusf_(float x) { return fmaxf(x, 0.f) + flog_(1.0f + fexp_(-fabsf(x))); }
__device__ __forceinline__ float tanhf_(float x) { const float e = fexp_(-2.0f * fabsf(x)); const float t = (1.0f - e) / (1.0f + e); return x < 0.f ? -t : t; }
__device__ __forceinline__ float wave_sum(float v) {
#pragma unroll
    for (int m = 32; m >= 1; m >>= 1) v += __shfl_xor(v, m, 64);
    return v;
}

struct P {
    const float* in[39];
    float* out;
    float* X;
    bf16_t* H;
    bf16_t* Z;
    float* MOD;
    bf16_t* R; bf16_t* V; bf16_t* KK; bf16_t* KD; bf16_t* BB;
    float* LW;
    char* REC;
    bf16_t* SN;
    bf16_t* QH;
    float* BONUS;
    bf16_t* KS;
    bf16_t* LR;
    bf16_t* WT_W2;
    bf16_t* WT_A2;
    bf16_t* GS;
    float* Y;
    float* KV;
    bf16_t* SP;
    float* DEC;
    float* OGLA;
    float* S5A;
    float* S5BB;
    float* S5END;
    float* S5CAR;
    bf16_t* GY;
    float* YN;
    bf16_t* BR;
    bf16_t* M;
    bf16_t* QHI; bf16_t* QLO;
    bf16_t* KHI; bf16_t* KLO;
    int* IDX;
    float* G;
    float* GU;
    unsigned* bar;
    bf16_t* WT_IN;
    bf16_t* WT_G2;
    bf16_t* WT_GLU;
    bf16_t* WT_BR;
    bf16_t* WT_OUT;
    bf16_t* WT_Q;
    unsigned char* U8; unsigned char* V8;
    float* USC; float* VSC;
};

enum { I_X = 0, I_C, I_CTX, I_CCTX, I_WMOD, I_BMOD, I_N1G, I_N2G, I_WIN, I_GLA_WA2, I_GLA_BA, I_GLA_NG, I_RCONV, I_RW0, I_RW2, I_RA0, I_RA2, I_RG2,
       I_RKK, I_RKA, I_RRK, I_RLNW, I_RLNB, I_S5LRE, I_S5LIM, I_S5LS, I_S5BRE, I_S5BIM, I_S5CRE, I_S5CIM, I_S5D, I_S5GLU, I_WBR, I_WOUT, I_PWQ, I_PKEYS, I_PU, I_PV, I_FG };

#ifdef EMU
__device__ __forceinline__ int otid() { return threadIdx.x; }
__device__ __forceinline__ int obid() { return blockIdx.x; }
#else
__device__ __forceinline__ int otid() { int t = threadIdx.x; asm volatile("" : "+v"(t)); return t; }
__device__ __forceinline__ int obid() { int b = blockIdx.x; asm volatile("" : "+s"(b)); return b; }
#endif
#ifdef EMU
#define WAVE_SYNC() emu_wave_barrier()
#ifndef EMU_GRID
#define EMU_GRID 4
#endif
#else
#define WAVE_SYNC() __builtin_amdgcn_wave_barrier()
#endif
#ifndef EMU
#define XB_TMO      128
#define XB_XCNT(j)  (256  + 64 * (j))
#define XB_XSUB(j)  (1280 + 64 * (j))
#define XB_XGEN(j)  (2304 + 64 * (j))
#define XB_TOP      3328
#define XB_TOPGEN   3392
#define XCD_BAR_WORDS 3456
#define XB_SPIN_CAP (1u << 22)
#define LAS __attribute__((address_space(3)))
__device__ __forceinline__ unsigned xb_ld(unsigned* p)              { return __hip_atomic_load(p, __ATOMIC_RELAXED, __HIP_MEMORY_SCOPE_AGENT); }
__device__ __forceinline__ unsigned xb_add(unsigned* p, unsigned v) { return __hip_atomic_fetch_add(p, v, __ATOMIC_RELAXED, __HIP_MEMORY_SCOPE_AGENT); }
__device__ __forceinline__ unsigned xb_xcc_id() { return (unsigned)__builtin_amdgcn_s_getreg((3 << 11) | 20) & 0xFu; }
#define XB_SPIN(cond, bar) do { unsigned _sp = 0; while (cond) { __builtin_amdgcn_s_sleep(1); \
    if ((++_sp & 255u) == 0u) { if (xb_ld(&(bar)[XB_TMO])) break; if (_sp > XB_SPIN_CAP) { atomicAdd(&(bar)[XB_TMO], 1u); break; } } } } while (0)
struct XcdBarrier { unsigned* bar; unsigned x; volatile LAS unsigned* st; };
__device__ __forceinline__ XcdBarrier xcd_barrier_post(unsigned* bar, volatile LAS unsigned* st) {
    XcdBarrier b; b.bar = bar; b.x = xb_xcc_id(); b.st = st;
    if (threadIdx.x == 0) (void)xb_add(&bar[XB_XCNT(b.x)], 1u);
    return b;
}
__device__ __forceinline__ void xcd_barrier_complete(unsigned* bar, unsigned x, unsigned& nloc, unsigned& nx) {
    const unsigned G = gridDim.x * gridDim.y * gridDim.z;
    unsigned sum, cnt, mine, sp = 0u;
    for (;;) {
        sum = 0u; cnt = 0u; mine = 0u;
#pragma unroll
        for (unsigned j = 0; j < 16; ++j) { const unsigned c = xb_ld(&bar[XB_XCNT(j)]); sum += c; cnt += (c > 0u) ? 1u : 0u; mine = (j == x) ? c : mine; }
        if (sum == G) break;
        __builtin_amdgcn_s_sleep(1);
        if ((++sp & 255u) == 0u) { if (xb_ld(&bar[XB_TMO])) break; if (sp > XB_SPIN_CAP) { atomicAdd(&bar[XB_TMO], 1u); break; } }
    }
    nloc = mine > 0u ? mine : 1u; nx = cnt > 0u ? cnt : 1u;
}
__device__ __forceinline__ void xcd_barrier(const XcdBarrier& b) {
    asm volatile("s_waitcnt vmcnt(0)" ::: "memory");
    __syncthreads();
    if (threadIdx.x == 0) {
        unsigned* bar = b.bar;
        __builtin_amdgcn_s_waitcnt(0);
        unsigned nloc = b.st[0], nx = b.st[1];
        if (nloc == 0u) { xcd_barrier_complete(bar, b.x, nloc, nx); b.st[0] = nloc; b.st[1] = nx; }
        const unsigned old = xb_add(&bar[XB_XSUB(b.x)], 1u);
        const unsigned gen = old / nloc;
        if (old + 1u == (gen + 1u) * nloc) {
            __builtin_amdgcn_fence(__ATOMIC_RELEASE, "agent");
            asm volatile("s_waitcnt vmcnt(0)" ::: "memory");
            const unsigned og = xb_add(&bar[XB_TOP], 1u);
            const unsigned tg = og / nx;
            if (og + 1u == (tg + 1u) * nx) xb_add(&bar[XB_TOPGEN], 1u);
            else XB_SPIN(xb_ld(&bar[XB_TOPGEN]) == tg, bar);
            __builtin_amdgcn_fence(__ATOMIC_ACQUIRE, "agent");
            xb_add(&bar[XB_XGEN(b.x)], 1u);
            asm volatile("s_waitcnt vmcnt(0)" ::: "memory");
        } else {
            XB_SPIN(xb_ld(&bar[XB_XGEN(b.x)]) == gen, bar);
            __builtin_amdgcn_fence(__ATOMIC_ACQUIRE, "agent");
            asm volatile("s_waitcnt vmcnt(0)" ::: "memory");
        }
    }
    __syncthreads();
}
#define GRID_SYNC() xcd_barrier(xb)
#else
#define GRID_SYNC() emu_grid_sync()
#endif

#ifdef EMU
#define LOADP() const P& p = p_arg
#else
typedef __attribute__((address_space(4))) const unsigned long long cu64_t;
__device__ __forceinline__ void load_params(P& p) {
    cu64_t* q = (cu64_t*)__builtin_amdgcn_kernarg_segment_ptr();
    asm volatile("" : "+s"(q));
    unsigned long long w[sizeof(P) / 8];
#pragma unroll
    for (int i = 0; i < (int)(sizeof(P) / 8); ++i) w[i] = q[i];
    __builtin_memcpy(&p, w, sizeof(P));
}
#define LOADP() P p; load_params(p)
#endif
#define PROBE_MULT 3
#if defined(PROBE_ID) && !defined(EMU)
#define PROBE_INIT() unsigned long long probe_t0 = wall_clock64()
#define PROBE_AFTER(id) { if (blockIdx.x == 0) { unsigned long long now_ = wall_clock64(); if ((id) == PROBE_ID) { const unsigned long long dt_ = now_ - probe_t0; \
    while (wall_clock64() - now_ < dt_ * PROBE_MULT) __builtin_amdgcn_s_sleep(8); now_ = wall_clock64(); } probe_t0 = now_; } }
#else
#define PROBE_INIT()
#define PROBE_AFTER(id)
#endif
__device__ __forceinline__ int gla_tok(int n, int i) {
    if (n < NCC) return n * 64 + i;
    int m = n - NCC; int col = m / RB, rb = m % RB;
    return CTX + (rb * 64 + i) * GRID_W + col;
}
__device__ __forceinline__ int chunk_order(int d, int s) {
    if (d == 0) return s;
    return (s < NCC) ? (NCC - 1 - s) : (NC - 1 - (s - NCC));
}
__device__ __forceinline__ int tok_order(int d, int s) {
    if (d == 0) return s;
    return (s < CTX) ? (CTX - 1 - s) : (MTOT - 1 - (s - CTX));
}


#define LDS_ROW 72
__device__ __forceinline__ void mfma_gemm_tile(const bf16_t* Wt, int ldw, const bf16_t* Act, int lda, int K, int n0, int m0, bf16_t* lds, f32x4 (&acc)[4][4]) {
    bf16_t* Ws = lds; bf16_t* As = lds + 128 * LDS_ROW;
    const int tid = otid(), lane = tid & 63, wave = tid >> 6, wn = wave >> 1, wm = wave & 1;
    const int lrow = tid >> 3, lkc = (tid & 7) * 8;
    u32x4 pw[4], pa[4];
#pragma unroll
    for (int i = 0; i < 4; ++i) {
        pw[i] = *(const u32x4*)(Wt + (size_t)(n0 + lrow + 32 * i) * ldw + lkc);
        pa[i] = *(const u32x4*)(Act + (size_t)(m0 + lrow + 32 * i) * lda + lkc);
    }
    for (int k0 = 0; k0 < K; k0 += 64) {
        __syncthreads();
#pragma unroll
        for (int i = 0; i < 4; ++i) {
            *(u32x4*)(Ws + (lrow + 32 * i) * LDS_ROW + lkc) = pw[i];
            *(u32x4*)(As + (lrow + 32 * i) * LDS_ROW + lkc) = pa[i];
        }
        __syncthreads();
        if (k0 + 64 < K) {
#pragma unroll
            for (int i = 0; i < 4; ++i) {
                pw[i] = *(const u32x4*)(Wt + (size_t)(n0 + lrow + 32 * i) * ldw + k0 + 64 + lkc);
                pa[i] = *(const u32x4*)(Act + (size_t)(m0 + lrow + 32 * i) * lda + k0 + 64 + lkc);
            }
        }
#pragma unroll
        for (int ks = 0; ks < 2; ++ks) {
            bf16x8 a[4], b[4];
#pragma unroll
            for (int i = 0; i < 4; ++i) {
                a[i] = *(const bf16x8*)(Ws + (wn * 64 + i * 16 + (lane & 15)) * LDS_ROW + ks * 32 + (lane >> 4) * 8);
                b[i] = *(const bf16x8*)(As + (wm * 64 + i * 16 + (lane & 15)) * LDS_ROW + ks * 32 + (lane >> 4) * 8);
            }
#pragma unroll
            for (int ni = 0; ni < 4; ++ni)
#pragma unroll
                for (int mi = 0; mi < 4; ++mi) acc[ni][mi] = MFMA16(a[ni], b[mi], acc[ni][mi]);
        }
    }
}
#define ZERO_ACC4(acc) { _Pragma("unroll") for (int i_ = 0; i_ < 4; ++i_) _Pragma("unroll") for (int j_ = 0; j_ < 4; ++j_) acc[i_][j_] = (f32x4){0.f, 0.f, 0.f, 0.f}; }
#define FOR_ACC(acc, n0, m0, BODY) { const int lane_ = otid() & 63, wave_ = otid() >> 6; \
    _Pragma("unroll") for (int ni_ = 0; ni_ < 4; ++ni_) _Pragma("unroll") for (int mi_ = 0; mi_ < 4; ++mi_) { \
        const int n = (n0) + (wave_ >> 1) * 64 + ni_ * 16 + (lane_ >> 4) * 4; const int m = (m0) + (wave_ & 1) * 64 + mi_ * 16 + (lane_ & 15); const f32x4 v = acc[ni_][mi_]; BODY } }
__device__ __forceinline__ u32x2 pack4(float a, float b, float c, float d) { u32x2 r; r.x = pack2bf(a, b); r.y = pack2bf(c, d); return r; }

__device__ __forceinline__ void convert_wt_job(const float* W, int K, int N, int Npad, bf16_t* out, int job, float* T, int ilv) {
    const int tid = otid();
    const int nkt = K / 64;
    const int n0 = (job / nkt) * 64, k0 = (job % nkt) * 64;
    __syncthreads();
    for (int idx = tid; idx < 4096; idx += NTHREADS) {
        int kk = idx >> 6, nn = idx & 63;
        int nr = n0 + nn; int src = ilv ? ((nr & 1) ? (N / 2 + (nr >> 1)) : (nr >> 1)) : nr;
        T[kk * 65 + nn] = (nr < N) ? W[(size_t)(k0 + kk) * N + src] : 0.f;
    }
    __syncthreads();
    {
        int nn = tid >> 2, part = tid & 3;
        unsigned w[8];
#pragma unroll
        for (int j = 0; j < 8; ++j) w[j] = pack2bf(T[(part * 16 + 2 * j) * 65 + nn], T[(part * 16 + 2 * j + 1) * 65 + nn]);
        u32x4* o = (u32x4*)(out + (size_t)(n0 + nn) * K + k0 + part * 16);
        o[0] = (u32x4){w[0], w[1], w[2], w[3]}; o[1] = (u32x4){w[4], w[5], w[6], w[7]};
    }
}
__device__ __forceinline__ void phase_convert_weights(const P& p, int l, char* smem) {
    float* T = (float*)smem;
    struct Item { const float* W; int K, N, Npad; bf16_t* out; };
    const Item items[12] = {
        {p.in[I_RW2] + ((size_t)l * 2 + 0) * 64 * RW, 64, RW, NPAD(RW), p.WT_W2},
        {p.in[I_RW2] + ((size_t)l * 2 + 1) * 64 * RW, 64, RW, NPAD(RW), p.WT_W2 + (size_t)NPAD(RW) * 64},
        {p.in[I_RA2] + ((size_t)l * 2 + 0) * 64 * RW, 64, RW, NPAD(RW), p.WT_A2},
        {p.in[I_RA2] + ((size_t)l * 2 + 1) * 64 * RW, 64, RW, NPAD(RW), p.WT_A2 + (size_t)NPAD(RW) * 64},
        {p.in[I_WIN] + (size_t)l * D_MODEL * D_IN, D_MODEL, D_IN, NPAD(D_IN), p.WT_IN},
        {p.in[I_RG2] + (size_t)l * 128 * RW, 128, RW, RW, p.WT_G2},
        {p.in[I_S5GLU] + (size_t)l * SW * 2 * SW, SW, 2 * SW, 2 * SW, p.WT_GLU},
        {p.in[I_WBR] + ((size_t)l * 3 + 0) * BW * D_MODEL, BW, D_MODEL, D_MODEL, p.WT_BR},
        {p.in[I_WBR] + ((size_t)l * 3 + 1) * BW * D_MODEL, BW, D_MODEL, D_MODEL, p.WT_BR + (size_t)D_MODEL * BW},
        {p.in[I_WBR] + ((size_t)l * 3 + 2) * BW * D_MODEL, BW, D_MODEL, D_MODEL, p.WT_BR + (size_t)2 * D_MODEL * BW},
        {p.in[I_WOUT] + (size_t)l * D_MODEL * D_MODEL, D_MODEL, D_MODEL, D_MODEL, p.WT_OUT},
        {p.in[I_PWQ] + (size_t)l * D_MODEL * PQ, D_MODEL, PQ, PQ, p.WT_Q}};
    int base = 0;
#pragma unroll
    for (int it = 0; it < 12; ++it) {
        const int nj = (items[it].Npad / 64) * (items[it].K / 64);
        for (int j = (int)((obid() + gridDim.x - (base % gridDim.x)) % gridDim.x); j < nj; j += gridDim.x)
            convert_wt_job(items[it].W, items[it].K, items[it].N, items[it].Npad, items[it].out, j, T, it == 6);
        base += nj;
    }
    __syncthreads();
    {
        const float* ks = p.in[I_PKEYS] + (size_t)l * PH * 2 * 128 * 128;
        for (size_t i = (size_t)obid() * NTHREADS + otid(); i < (size_t)PH * 2 * 128 * 128; i += (size_t)gridDim.x * NTHREADS) {
            const float v = ks[i]; const bf16_t hb = f2bf(v);
            p.KHI[i] = hb; p.KLO[i] = f2bf(v - bf2f(hb));
        }
    }
}

__device__ __forceinline__ void phase_init(const P& p, char* smem) {
    const int tid = otid();
    float* sc = (float*)smem;
    for (int i = tid; i < D_MODEL; i += NTHREADS) { sc[i] = siluf_(p.in[I_CCTX][i]); sc[D_MODEL + i] = siluf_(p.in[I_C][i]); }
    __syncthreads();
    const int ncolblk = (6 * D_MODEL) / NTHREADS;
    for (int job = obid(); job < DEPTH * ncolblk; job += gridDim.x) {
        int l = job / ncolblk, n = (job % ncolblk) * NTHREADS + tid;
        const float* w = p.in[I_WMOD] + (size_t)l * D_MODEL * 6 * D_MODEL + n;
        float a0 = 0.f, a1 = 0.f;
        for (int k = 0; k < D_MODEL; ++k) { float wv = w[(size_t)k * 6 * D_MODEL]; a0 += sc[k] * wv; a1 += sc[D_MODEL + k] * wv; }
        float b = p.in[I_BMOD][l * 6 * D_MODEL + n];
        p.MOD[(size_t)(l * 2 + 0) * 6 * D_MODEL + n] = a0 + b;
        p.MOD[(size_t)(l * 2 + 1) * 6 * D_MODEL + n] = a1 + b;
    }
    const size_t gtid = (size_t)obid() * NTHREADS + tid, gn = (size_t)gridDim.x * NTHREADS;
    for (size_t i = gtid; i < (size_t)CTX * D_MODEL; i += gn) p.X[i] = p.in[I_CTX][i];
    for (size_t i = gtid; i < (size_t)SEQ * D_MODEL; i += gn) p.X[(size_t)CTX * D_MODEL + i] = p.in[I_X][i];
    __syncthreads();
}

__device__ __forceinline__ void phase_s5const(const P& p, int l) {
    const size_t gtid = (size_t)obid() * NTHREADS + otid(), gn = (size_t)gridDim.x * NTHREADS;
    for (size_t i = gtid; i < (size_t)2 * SG * 64; i += gn) {
        int d = (int)(i / (SG * 64)), g = (int)((i / 64) % SG), s = (int)(i % 64);
        size_t li = ((size_t)(l * 2 + d) * SG + g) * 64 + s;
        float lre = p.in[I_S5LRE][li], lim = p.in[I_S5LIM][li];
        float dt = expf(p.in[I_S5LS][(l * 2 + d) * SG + g]);
        float mag = expf(lre * dt);
        float are = mag * cosf(lim * dt), aim = mag * sinf(lim * dt);
        float den = lre * lre + lim * lim;
        float fre = ((are - 1.0f) * lre + aim * lim) / den;
        float fim = (aim * lre - (are - 1.0f) * lim) / den;
        p.S5A[i * 2 + 0] = are; p.S5A[i * 2 + 1] = aim;
        const float* bre = p.in[I_S5BRE] + (((size_t)l * SG + g) * 64 + s) * 16;
        const float* bim = p.in[I_S5BIM] + (((size_t)l * SG + g) * 64 + s) * 16;
        for (int c = 0; c < 16; ++c) {
            p.S5BB[(i * 16 + c) * 2 + 0] = fre * bre[c] - fim * bim[c];
            p.S5BB[(i * 16 + c) * 2 + 1] = fre * bim[c] + fim * bre[c];
        }
    }
}

__device__ __forceinline__ void phase_norm(const P& p, int l, int which) {
    const int lane = otid() & 63;
    const int gw = (obid() * NTHREADS + otid()) >> 6, nw = (gridDim.x * NTHREADS) >> 6;
    const float* g = p.in[which ? I_N2G : I_N1G] + l * D_MODEL;
    constexpr int NJ = (D_MODEL + 255) / 256;
    for (int t = gw; t < MTOT; t += nw) {
        const float* x = p.X + (size_t)t * D_MODEL;
        const float* mod = p.MOD + (size_t)(l * 2 + (t >= CTX ? 1 : 0)) * 6 * D_MODEL + (which ? 3 * D_MODEL : 0);
        float4 v[NJ]; float ss = 0.f;
#pragma unroll
        for (int j = 0; j < NJ; ++j) {
            const int e = j * 256 + lane * 4;
            if (e < D_MODEL) v[j] = *(const float4*)(x + e); else { v[j].x = 0.f; v[j].y = 0.f; v[j].z = 0.f; v[j].w = 0.f; }
            ss += v[j].x * v[j].x + v[j].y * v[j].y + v[j].z * v[j].z + v[j].w * v[j].w;
        }
        ss = wave_sum(ss);
        const float rstd = rsqrtf(ss / D_MODEL + 1e-6f);
#pragma unroll
        for (int j = 0; j < NJ; ++j) {
            const int e = j * 256 + lane * 4;
            if (e < D_MODEL) {
                const float4 gg = *(const float4*)(g + e), sc = *(const float4*)(mod + D_MODEL + e), sh = *(const float4*)(mod + e);
                *(u32x2*)(p.H + (size_t)t * D_MODEL + e) = pack4(v[j].x * rstd * gg.x * (1.0f + sc.x) + sh.x, v[j].y * rstd * gg.y * (1.0f + sc.y) + sh.y,
                                                                 v[j].z * rstd * gg.z * (1.0f + sc.z) + sh.z, v[j].w * rstd * gg.w * (1.0f + sc.w) + sh.w);
            }
        }
    }
}

__device__ __forceinline__ void phase_gemm_in(const P& p, int l, char* smem) {
    const int ntn = NPAD(D_IN) / 128, ntm = MTOT / 128;
    for (int job = obid(); job < ntm * ntn; job += gridDim.x) {
        const int m0 = (job / ntn) * 128, n0 = (job % ntn) * 128;
        f32x4 acc[4][4]; ZERO_ACC4(acc);
        mfma_gemm_tile(p.WT_IN, D_MODEL, p.H, D_MODEL, D_MODEL, n0, m0, (bf16_t*)smem, acc);
        FOR_ACC(acc, n0, m0, { if (n < D_IN) *(u32x2*)(p.Z + (size_t)m * D_IN + n) = pack4(v[0], v[1], v[2], v[3]); })
    }
}

__device__ __forceinline__ void unpack8(const u32x4 w, float (&f)[8]) {
    f[0] = LO16(w.x); f[1] = HI16(w.x); f[2] = LO16(w.y); f[3] = HI16(w.y); f[4] = LO16(w.z); f[5] = HI16(w.z); f[6] = LO16(w.w); f[7] = HI16(w.w);
}
__device__ __forceinline__ u32x4 pack8(const float (&f)[8]) {
    u32x4 o; o.x = pack2bf(f[0], f[1]); o.y = pack2bf(f[2], f[3]);
    o.z = pack2bf(f[4], f[5]); o.w = pack2bf(f[6], f[7]); return o;
}
__device__ __forceinline__ void load8f(const float* p, float (&f)[8]) {
    const float4 a = *(const float4*)p, b = *(const float4*)(p + 4);
    f[0] = a.x; f[1] = a.y; f[2] = a.z; f[3] = a.w; f[4] = b.x; f[5] = b.y; f[6] = b.z; f[7] = b.w;
}
__device__ __forceinline__ void store8f(float* p, const float (&f)[8]) {
    float4 a, b; a.x = f[0]; a.y = f[1]; a.z = f[2]; a.w = f[3]; b.x = f[4]; b.y = f[5]; b.z = f[6]; b.w = f[7];
    *(float4*)p = a; *(float4*)(p + 4) = b;
}
__device__ __forceinline__ void conv8(const bf16_t* zp, const float* conv, int c0, bool act, bool first, bool last, float (&out)[8]) {
    const u32x4 z4 = {0u, 0u, 0u, 0u};
    const u32x4 a0 = act ? *(const u32x4*)(zp + c0) : z4;
    const u32x4 am = (act && !first) ? *(const u32x4*)(zp + c0 - D_IN) : z4;
    const u32x4 an = (act && !last) ? *(const u32x4*)(zp + c0 + D_IN) : z4;
    float w0[8], w1[8], w2[8], f0[8], fm[8], fn[8];
    if (act) { load8f(conv + c0, w0); load8f(conv + RWKV_IN + c0, w1); load8f(conv + 2 * RWKV_IN + c0, w2); }
    else {
#pragma unroll
        for (int e = 0; e < 8; ++e) { w0[e] = 0.f; w1[e] = 0.f; w2[e] = 0.f; }
    }
    unpack8(a0, f0); unpack8(am, fm); unpack8(an, fn);
#pragma unroll
    for (int e = 0; e < 8; ++e) out[e] = w1[e] * f0[e] + w0[e] * fm[e] + w2[e] * fn[e];
}
__device__ __forceinline__ void phase_rwkv_prep1(const P& p, int l) {
    const int lane = otid() & 63;
    const int gw = (obid() * NTHREADS + otid()) >> 6, nw = (gridDim.x * NTHREADS) >> 6;
    const float* conv = p.in[I_RCONV] + (size_t)l * 3 * RWKV_IN;
    const float* k_k = p.in[I_RKK] + (size_t)l * RW;
    const bool act = lane * 8 < RW, act2 = lane * 8 < 384;
    float kkw[8];
    if (act) load8f(k_k + lane * 8, kkw);
    else {
#pragma unroll
        for (int e = 0; e < 8; ++e) kkw[e] = 0.f;
    }
    for (int t = gw; t < MTOT; t += nw) {
        const bool first = (t == 0) || (t == CTX), last = (t == CTX - 1) || (t == MTOT - 1);
        const bf16_t* zp = p.Z + (size_t)t * D_IN + ZR;
        float rv[8], kv[8], vv[8], lr[8];
        conv8(zp, conv, 0 * RW + lane * 8, act, first, last, rv);
        conv8(zp, conv, 1 * RW + lane * 8, act, first, last, kv);
        conv8(zp, conv, 2 * RW + lane * 8, act, first, last, vv);
        conv8(zp, conv, 3 * RW + lane * 8, act2, first, last, lr);
        float kk[8]; float ss = 0.f;
#pragma unroll
        for (int e = 0; e < 8; ++e) { kk[e] = kv[e] * kkw[e]; ss += kk[e] * kk[e]; }
        ss += __shfl_xor(ss, 1, 64); ss += __shfl_xor(ss, 2, 64); ss += __shfl_xor(ss, 4, 64);
        const float inv = 1.0f / fmaxf(sqrtf(ss), 1e-12f);
#pragma unroll
        for (int e = 0; e < 8; ++e) kk[e] *= inv;
        if (act) {
            const size_t o = (size_t)t * RW + lane * 8;
            *(u32x4*)(p.R + o) = pack8(rv); *(u32x4*)(p.KS + o) = pack8(kv); *(u32x4*)(p.V + o) = pack8(vv); *(u32x4*)(p.KK + o) = pack8(kk);
        }
        if (act2) {
            const int cc = lane * 8;
            if (cc < 128) {
#pragma unroll
                for (int e = 0; e < 8; ++e) lr[e] = tanhf_(lr[e]);
                *(u32x4*)(p.LR + (size_t)t * 256 + cc) = pack8(lr);
            } else if (cc < 256) {
                *(u32x4*)(p.LR + (size_t)t * 256 + cc) = pack8(lr);
            } else {
#pragma unroll
                for (int e = 0; e < 8; ++e) lr[e] = sigmoidf_(lr[e]);
                *(u32x4*)(p.GS + (size_t)t * 128 + cc - 256) = pack8(lr);
            }
        }
    }
}
__device__ __forceinline__ void phase_rwkv_prep2(const P& p, int l, char* smem) {
    const int ntm = MTOT / 128, ntn = NPAD(RW) / 128;
    const float* k_a = p.in[I_RKA] + (size_t)l * RW;
    const float* r_k = p.in[I_RRK] + (size_t)l * RW;
    for (int job = obid(); job < ntm * ntn * 2; job += gridDim.x) {
        const int d = job % 2, n0 = ((job / 2) % ntn) * 128, m0 = (job / (2 * ntn)) * 128;
        const float* w0 = p.in[I_RW0] + (size_t)(l * 2 + d) * RW;
        const float* a0 = p.in[I_RA0] + (size_t)(l * 2 + d) * RW;
        f32x4 accw[4][4], acca[4][4]; ZERO_ACC4(accw); ZERO_ACC4(acca);
        mfma_gemm_tile(p.WT_W2 + (size_t)d * NPAD(RW) * 64, 64, p.LR + d * 64, 256, 64, n0, m0, (bf16_t*)smem, accw);
        mfma_gemm_tile(p.WT_A2 + (size_t)d * NPAD(RW) * 64, 64, p.LR + 128 + d * 64, 256, 64, n0, m0, (bf16_t*)smem, acca);
        const int lane = otid() & 63, wave = otid() >> 6;
#pragma unroll
        for (int mi = 0; mi < 4; ++mi) {
            const int m = m0 + (wave & 1) * 64 + mi * 16 + (lane & 15);
            float bon = 0.f;
#pragma unroll
            for (int ni = 0; ni < 4; ++ni) {
                const int n = n0 + (wave >> 1) * 64 + ni * 16 + (lane >> 4) * 4;
                if (n < RW) {
                    const u32x2 kq = *(const u32x2*)(p.KS + (size_t)m * RW + n), kkq = *(const u32x2*)(p.KK + (size_t)m * RW + n), rq = *(const u32x2*)(p.R + (size_t)m * RW + n);
                    const float kv[4] = {LO16(kq.x), HI16(kq.x), LO16(kq.y), HI16(kq.y)};
                    const float kkv[4] = {LO16(kkq.x), HI16(kkq.x), LO16(kkq.y), HI16(kkq.y)};
                    const float rv[4] = {LO16(rq.x), HI16(rq.x), LO16(rq.y), HI16(rq.y)};
                    float lw[4], kd[4], bb[4];
#pragma unroll
                    for (int e = 0; e < 4; ++e) {
                        const float x = w0[n + e] + accw[ni][mi][e];
                        lw[e] = -fexp_(-softplusf_(-x) - 0.5f);
                        const float aa = sigmoidf_(a0[n + e] + acca[ni][mi][e]);
                        kd[e] = kv[e] * (1.0f + (aa - 1.0f) * k_a[n + e]);
                        bb[e] = kkv[e] * aa;
                        bon += rv[e] * kd[e] * r_k[n + e];
                    }
                    const size_t o = ((size_t)d * MTOT + m) * RW + n;
                    float4 lo4; lo4.x = lw[0]; lo4.y = lw[1]; lo4.z = lw[2]; lo4.w = lw[3];
                    *(float4*)(p.LW + o) = lo4;
                    *(u32x2*)(p.KD + o) = pack4(kd[0], kd[1], kd[2], kd[3]);
                    *(u32x2*)(p.BB + o) = pack4(bb[0], bb[1], bb[2], bb[3]);
                }
            }
            bon += __shfl_xor(bon, 16, 64); bon += __shfl_xor(bon, 32, 64);
            const int hh = (n0 + (wave >> 1) * 64) >> 6;
            if ((lane >> 4) == 0 && hh < RH) p.BONUS[((size_t)d * MTOT + m) * RH + hh] = bon;
        }
    }
}

#define CH_ROW 72
#define SEQ_REC 16640
#define CH_SLOT (64 * CH_ROW)
#define CH_XR_OFF (7 * CH_SLOT * 2)
#define CH_AAB_OFF (CH_XR_OFF + 64 * 132 * 4)
#define CH_GC_OFF (CH_AAB_OFF + 64 * 72 * 4)
template <int MT, int NT>
__device__ __forceinline__ void lds_mm(const bf16_t* A, int m0, const bf16_t* Bt, int n0, f32x4 (&acc)[MT][NT]) {
    const int lane = otid() & 63, q = lane >> 4, r = lane & 15;
#pragma unroll
    for (int s = 0; s < 2; ++s) {
        bf16x8 a[MT], b[NT];
#pragma unroll
        for (int i = 0; i < MT; ++i) a[i] = *(const bf16x8*)(A + (m0 + i * 16 + r) * CH_ROW + s * 32 + q * 8);
#pragma unroll
        for (int i = 0; i < NT; ++i) b[i] = *(const bf16x8*)(Bt + (n0 + i * 16 + r) * CH_ROW + s * 32 + q * 8);
#pragma unroll
        for (int i = 0; i < MT; ++i)
#pragma unroll
            for (int jj = 0; jj < NT; ++jj) acc[i][jj] = MFMA16(a[i], b[jj], acc[i][jj]);
    }
}
__device__ __forceinline__ void rwkv_chunk_job(const P& p, int job, char* smem) {
    const int tid = otid(), lane = tid & 63, wv = tid >> 6, q = lane >> 4, r = lane & 15;
    const int d = job / (NC * RH), n = (job / RH) % NC, h = job % RH;
    const size_t base = (size_t)(d * NC + n) * RH + h;
    bf16_t* S0 = (bf16_t*)smem; bf16_t* S1 = S0 + CH_SLOT; bf16_t* S2 = S1 + CH_SLOT; bf16_t* S3 = S2 + CH_SLOT;
    bf16_t* S4 = S3 + CH_SLOT; bf16_t* S5 = S4 + CH_SLOT; bf16_t* S6 = S5 + CH_SLOT;
    float* X = (float*)(smem + CH_XR_OFF);
    float* AABt = (float*)(smem + CH_AAB_OFF);
    bf16_t* U0t = (bf16_t*)(smem + CH_AAB_OFF);
    bf16_t* Aht = U0t + CH_SLOT;
    float* GC = (float*)(smem + CH_GC_OFF);
    __syncthreads();
    u32x4 gkk[2], gr[2], gv[2], gkd[2], gbb[2]; float lw[2][8];
#pragma unroll
    for (int it = 0; it < 2; ++it) {
        const int c = tid + 256 * it, i = c >> 3, k0 = (c & 7) * 8; const int tok = 64 * n + (d ? 63 - i : i);
        const size_t o1 = (size_t)tok * RW + h * 64 + k0, o2 = ((size_t)d * MTOT + tok) * RW + h * 64 + k0;
        load8f(p.LW + o2, lw[it]);
        gkk[it] = *(const u32x4*)(p.KK + o1); gr[it] = *(const u32x4*)(p.R + o1); gv[it] = *(const u32x4*)(p.V + o1);
        gkd[it] = *(const u32x4*)(p.KD + o2); gbb[it] = *(const u32x4*)(p.BB + o2);
    }
#pragma unroll
    for (int it = 0; it < 2; ++it) { const int c = tid + 256 * it; store8f(X + (c >> 3) * 132 + (c & 7) * 8, lw[it]); }
    __syncthreads();
    {
        const int k = tid & 63, seg = tid >> 6;
        float v[16]; float run = 0.f;
#pragma unroll
        for (int e = 0; e < 16; ++e) { run += X[(seg * 16 + e) * 132 + k]; v[e] = run; }
        AABt[seg * 64 + k] = run;
        __syncthreads();
        float off = 0.f;
        for (int s2 = 0; s2 < seg; ++s2) off += AABt[s2 * 64 + k];
#pragma unroll
        for (int e = 0; e < 16; ++e) X[(seg * 16 + e) * 132 + k] = v[e] + off;
    }
    __syncthreads();
#pragma unroll
    for (int it = 0; it < 2; ++it) {
        const int c = tid + 256 * it, i = c >> 3, k0 = (c & 7) * 8;
        float L[8], Lp[8], LC[8], kkv[8], rv[8], vv[8], kdv[8], bbv[8];
        load8f(X + i * 132 + k0, L); load8f(X + 63 * 132 + k0, LC);
        if (i > 0) load8f(X + (i - 1) * 132 + k0, Lp);
        else {
#pragma unroll
            for (int e = 0; e < 8; ++e) Lp[e] = 0.f;
        }
        unpack8(gkk[it], kkv); unpack8(gr[it], rv); unpack8(gv[it], vv); unpack8(gkd[it], kdv); unpack8(gbb[it], bbv);
        float at[8], rt[8], bt[8], kt[8], bh[8], kh[8];
#pragma unroll
        for (int e = 0; e < 8; ++e) {
            const float eL = fexp_(L[e]), eLp = fexp_(Lp[e]), eNL = fexp_(-L[e]), eCL = fexp_(LC[e] - L[e]);
            at[e] = -kkv[e] * eLp; rt[e] = rv[e] * eL; bt[e] = bbv[e] * eNL; kt[e] = kdv[e] * eNL; bh[e] = bbv[e] * eCL; kh[e] = kdv[e] * eCL;
            if (i == 63) GC[k0 + e] = eL;
        }
        *(u32x4*)(S0 + i * CH_ROW + k0) = pack8(at);
        store8f(X + i * 132 + 64 + k0, at);
        *(u32x4*)(S1 + i * CH_ROW + k0) = pack8(rt);
        *(u32x4*)(S2 + i * CH_ROW + k0) = pack8(bt);
        *(u32x4*)(S3 + i * CH_ROW + k0) = pack8(kt);
#pragma unroll
        for (int e = 0; e < 8; ++e) {
            S4[(k0 + e) * CH_ROW + i] = f2bf(vv[e]);
            S5[(k0 + e) * CH_ROW + i] = f2bf(bh[e]);
            S6[(k0 + e) * CH_ROW + i] = f2bf(kh[e]);
        }
    }
    __syncthreads();
    {
        f32x4 acc[4][4]; ZERO_ACC4(acc);
        lds_mm<4, 4>((wv < 2) ? S0 : S1, 0, (wv & 1) ? S3 : S2, 0, acc);
        __syncthreads();
#pragma unroll
        for (int mt = 0; mt < 4; ++mt)
#pragma unroll
            for (int nt = 0; nt < 4; ++nt) {
                const int jc = nt * 16 + r, i0 = mt * 16 + 4 * q;
                if (wv == 0) {
                    f32x4 o;
#pragma unroll
                    for (int e = 0; e < 4; ++e) o[e] = (jc < i0 + e) ? acc[mt][nt][e] : 0.f;
                    *(f32x4*)(AABt + jc * 72 + i0) = o;
                } else {
                    bf16_t* dst = (wv == 1) ? S0 : ((wv == 2) ? S2 : S3);
#pragma unroll
                    for (int e = 0; e < 4; ++e) {
                        const bool ok = (wv == 1) ? (jc < i0 + e) : (jc <= i0 + e);
                        dst[(i0 + e) * CH_ROW + jc] = f2bf(ok ? acc[mt][nt][e] : 0.f);
                    }
                }
            }
    }
    __syncthreads();
    {
        f32x4 acc[1][4];
#pragma unroll
        for (int nt = 0; nt < 4; ++nt) acc[0][nt] = (f32x4){0.f, 0.f, 0.f, 0.f};
        lds_mm<1, 4>(S0, 16 * wv, S4, 0, acc);
#pragma unroll
        for (int nt = 0; nt < 4; ++nt)
#pragma unroll
            for (int e = 0; e < 4; ++e) X[(16 * wv + 4 * q + e) * 132 + nt * 16 + r] = acc[0][nt][e];
    }
    __syncthreads();
    if (tid < 128) {
        const int c = tid;
        for (int bi = 0; bi < 4; ++bi) {
            float acc[16];
#pragma unroll
            for (int e = 0; e < 16; ++e) acc[e] = X[(16 * bi + e) * 132 + c];
            for (int jj = 0; jj < 16 * bi; ++jj) {
                const float uj = X[jj * 132 + c];
                const f32x4* ap = (const f32x4*)(AABt + jj * 72 + 16 * bi);
                const f32x4 a0 = ap[0], a1 = ap[1], a2 = ap[2], a3 = ap[3];
#pragma unroll
                for (int e = 0; e < 4; ++e) { acc[e] += a0[e] * uj; acc[4 + e] += a1[e] * uj; acc[8 + e] += a2[e] * uj; acc[12 + e] += a3[e] * uj; }
            }
#pragma unroll
            for (int e = 0; e < 16; ++e) {
                const float u = acc[e];
                X[(16 * bi + e) * 132 + c] = u;
                const f32x4* ap = (const f32x4*)(AABt + (16 * bi + e) * 72 + 16 * bi);
                const f32x4 a0 = ap[0], a1 = ap[1], a2 = ap[2], a3 = ap[3];
#pragma unroll
                for (int e2 = 0; e2 < 16; ++e2) if (e2 > e) acc[e2] += ((e2 < 4) ? a0[e2 & 3] : (e2 < 8) ? a1[e2 & 3] : (e2 < 12) ? a2[e2 & 3] : a3[e2 & 3]) * u;
            }
        }
    }
    __syncthreads();
    if (tid < 128) {
        const int c = tid;
        bf16_t* dst = (c < 64) ? (U0t + c * CH_ROW) : (Aht + (c - 64) * CH_ROW);
        u32x4 ov[8];
#pragma unroll
        for (int g = 0; g < 8; ++g) {
            float v[8];
#pragma unroll
            for (int e = 0; e < 8; ++e) v[e] = X[(g * 8 + e) * 132 + c];
            ov[g].x = pack2bf(v[0], v[1]); ov[g].y = pack2bf(v[2], v[3]);
            ov[g].z = pack2bf(v[4], v[5]); ov[g].w = pack2bf(v[6], v[7]);
        }
#pragma unroll
        for (int g = 0; g < 8; ++g) *(u32x4*)(dst + g * 8) = ov[g];
    }
    __syncthreads();
    {
        f32x4 acc[4][4]; ZERO_ACC4(acc);
        char* rec = p.REC + base * SEQ_REC;
        if (wv == 0) {
            lds_mm<4, 4>(Aht, 0, S5, 0, acc);
#pragma unroll
            for (int nt = 0; nt < 4; ++nt)
#pragma unroll
                for (int s2 = 0; s2 < 2; ++s2) {
                    u32x4 o;
                    o.x = pack2bf(acc[2 * s2][nt][0], acc[2 * s2][nt][1]); o.y = pack2bf(acc[2 * s2][nt][2], acc[2 * s2][nt][3]);
                    o.z = pack2bf(acc[2 * s2 + 1][nt][0], acc[2 * s2 + 1][nt][1]); o.w = pack2bf(acc[2 * s2 + 1][nt][2], acc[2 * s2 + 1][nt][3]);
                    *(u32x4*)(rec + (((nt * 2 + s2) * 64 + lane) * 8) * 2) = o;
                }
        } else if (wv == 1) {
            lds_mm<4, 4>(S5, 0, U0t, 0, acc);
            lds_mm<4, 4>(S6, 0, S4, 0, acc);
#pragma unroll
            for (int mt = 0; mt < 4; ++mt)
#pragma unroll
                for (int nt = 0; nt < 4; ++nt) *(u32x2*)(rec + 8192 + (((nt * 4 + mt) * 64 + lane) * 4) * 2) = pack4(acc[mt][nt][0], acc[mt][nt][1], acc[mt][nt][2], acc[mt][nt][3]);
        } else if (wv == 2) {
            lds_mm<4, 4>(S2, 0, Aht, 0, acc);
#pragma unroll
            for (int mt = 0; mt < 4; ++mt)
#pragma unroll
                for (int nt = 0; nt < 4; ++nt)
#pragma unroll
                    for (int e = 0; e < 4; ++e) {
                        const int t = mt * 16 + 4 * q + e, kc = nt * 16 + r;
                        p.QH[(base * 64 + t) * 64 + kc] = f2bf(acc[mt][nt][e] + bf2f(S1[t * CH_ROW + kc]));
                    }
        } else if (wv == 3) {
            lds_mm<4, 4>(S2, 0, U0t, 0, acc);
            lds_mm<4, 4>(S3, 0, S4, 0, acc);
#pragma unroll
            for (int mt = 0; mt < 4; ++mt)
#pragma unroll
                for (int nt = 0; nt < 4; ++nt)
#pragma unroll
                    for (int e = 0; e < 4; ++e) {
                        const int t = mt * 16 + 4 * q + e; const int tok = 64 * n + (d ? 63 - t : t);
                        p.Y[((size_t)d * MTOT + tok) * RW + h * 64 + nt * 16 + r] = acc[mt][nt][e];
                    }
        }
        if (tid < 64) ((float*)(rec + 16384))[tid] = GC[tid];
    }
}

#define SEQ_SLOT 16896
__device__ __forceinline__ void rwkv_seq_gload(const P& p, size_t base, int tid, u32x4 (&g)[5]) {
    const u32x4* m = (const u32x4*)(p.REC + base * SEQ_REC);
#pragma unroll
    for (int i = 0; i < 4; ++i) g[i] = m[tid + 256 * i];
    if (tid < 16) g[4] = m[1024 + tid];
}
__device__ __forceinline__ void rwkv_seq_lstore(char* slot, int tid, const u32x4 (&g)[5]) {
    u32x4* d = (u32x4*)slot;
#pragma unroll
    for (int i = 0; i < 4; ++i) d[tid + 256 * i] = g[i];
    if (tid < 16) d[1024 + tid] = g[4];
}
__device__ __forceinline__ void rwkv_seq_step(const P& p, const char* slot, size_t base, int wv, int lane, f32x4 (&X)[4]) {
    const int q = lane >> 4, r = lane & 15;
    const bf16_t* mt = (const bf16_t*)slot; const bf16_t* ntb = (const bf16_t*)(slot + 8192); const float* gc = (const float*)(slot + 16384);
    unsigned xh[4][2];
#pragma unroll
    for (int kt = 0; kt < 4; ++kt) {
        xh[kt][0] = pack2bf(X[kt][0], X[kt][1]); xh[kt][1] = pack2bf(X[kt][2], X[kt][3]);
        *(u32x2*)(p.SN + (base * 64 + 16 * wv + r) * 64 + 16 * kt + 4 * q) = (u32x2){xh[kt][0], xh[kt][1]};
    }
    bf16x8 bh[2];
#pragma unroll
    for (int s2 = 0; s2 < 2; ++s2) bh[s2] = __builtin_bit_cast(bf16x8, ((u32x4){xh[2 * s2][0], xh[2 * s2][1], xh[2 * s2 + 1][0], xh[2 * s2 + 1][1]}));
#pragma unroll
    for (int tile = 0; tile < 4; ++tile) {
        const u32x2 nb = *(const u32x2*)(ntb + ((wv * 4 + tile) * 64 + lane) * 4);
        const f32x4 g4 = *(const f32x4*)(gc + tile * 16 + 4 * q);
        f32x4 acc;
        acc[0] = g4[0] * X[tile][0] + LO16(nb.x); acc[1] = g4[1] * X[tile][1] + HI16(nb.x);
        acc[2] = g4[2] * X[tile][2] + LO16(nb.y); acc[3] = g4[3] * X[tile][3] + HI16(nb.y);
#pragma unroll
        for (int s2 = 0; s2 < 2; ++s2) {
            const bf16x8 ah = *(const bf16x8*)(mt + ((tile * 2 + s2) * 64 + lane) * 8);
            acc = MFMA16(ah, bh[s2], acc);
        }
        X[tile] = acc;
    }
}
__device__ __forceinline__ void rwkv_seq_job(const P& p, int job, char* smem) {
    const int tid = otid(), lane = tid & 63, wv = tid >> 6;
    const int d = job / RH, h = job % RH;
    f32x4 X[4];
#pragma unroll
    for (int kt = 0; kt < 4; ++kt) X[kt] = (f32x4){0.f, 0.f, 0.f, 0.f};
    u32x4 g0[5], g1[5], g2[5];
#define SEQ_BASE(s_) ((size_t)(d * NC + chunk_order(d, ((s_) < NC) ? (s_) : NC - 1)) * RH + h)
    __syncthreads();
    rwkv_seq_gload(p, SEQ_BASE(0), tid, g0);
    rwkv_seq_gload(p, SEQ_BASE(1), tid, g1);
    rwkv_seq_gload(p, SEQ_BASE(2), tid, g2);
    rwkv_seq_lstore(smem, tid, g0);
    __syncthreads();
    for (int s = 0; s < NC; s += 6) {
#define SEQ_SUB(u, GFREE, GNEXT) \
        if (s + (u) < NC) { \
            rwkv_seq_gload(p, SEQ_BASE(s + (u) + 3), tid, GFREE); \
            rwkv_seq_step(p, smem + (((u) & 1) ? SEQ_SLOT : 0), SEQ_BASE(s + (u)), wv, lane, X); \
            rwkv_seq_lstore(smem + (((u) & 1) ? 0 : SEQ_SLOT), tid, GNEXT); \
        } \
        __syncthreads();
        SEQ_SUB(0, g0, g1)
        SEQ_SUB(1, g1, g2)
        SEQ_SUB(2, g2, g0)
        SEQ_SUB(3, g0, g1)
        SEQ_SUB(4, g1, g2)
        SEQ_SUB(5, g2, g0)
#undef SEQ_SUB
    }
#undef SEQ_BASE
}
__device__ __forceinline__ void rwkv_out_job(const P& p, int job) {
    const int tid = otid(), lane = tid & 63, wv = tid >> 6, q = lane >> 4, r = lane & 15;
    const int d = job / (NC * RH), n = (job / RH) % NC, h = job % RH;
    const size_t base = (size_t)(d * NC + n) * RH + h;
    f32x4 acc[4];
#pragma unroll
    for (int nt = 0; nt < 4; ++nt) acc[nt] = (f32x4){0.f, 0.f, 0.f, 0.f};
#pragma unroll
    for (int s2 = 0; s2 < 2; ++s2) {
        const bf16x8 a = *(const bf16x8*)(p.QH + (base * 64 + 16 * wv + r) * 64 + s2 * 32 + q * 8);
#pragma unroll
        for (int nt = 0; nt < 4; ++nt) {
            const bf16x8 b = *(const bf16x8*)(p.SN + (base * 64 + nt * 16 + r) * 64 + s2 * 32 + q * 8);
            acc[nt] = MFMA16(a, b, acc[nt]);
        }
    }
#pragma unroll
    for (int nt = 0; nt < 4; ++nt)
#pragma unroll
        for (int e = 0; e < 4; ++e) {
            const int t = 16 * wv + 4 * q + e; const int tok = 64 * n + (d ? 63 - t : t);
            p.Y[((size_t)d * MTOT + tok) * RW + h * 64 + nt * 16 + r] += acc[nt][e];
        }
}

#define GL_QR 0
#define GL_KR 9216
#define GL_VT 18432
#define GL_QI 36864
#define GL_KI 46080
#define GL_AT 55296
#define GL_CUM 64512
#define GL_ALR 81920
#define GL_WA 86016
__device__ __forceinline__ void gla_load_qkv(const P& p, int n, int h, char* smem) {
    const int tid = otid();
    bf16_t* Qr = (bf16_t*)(smem + GL_QR); bf16_t* Kr = (bf16_t*)(smem + GL_KR); bf16_t* Vt = (bf16_t*)(smem + GL_VT);
    for (int c = tid; c < 512; c += NTHREADS) {
        const int row = c >> 3, part = c & 7; const int t = gla_tok(n, row);
        const u32x4 qv = *(const u32x4*)(p.Z + (size_t)t * D_IN + ZQ + h * 64 + part * 8);
        const u32x4 kv = *(const u32x4*)(p.Z + (size_t)t * D_IN + ZK + h * 64 + part * 8);
        u32x4 qs;
        qs.x = pack2bf(LO16(qv.x) * 0.125f, HI16(qv.x) * 0.125f);
        qs.y = pack2bf(LO16(qv.y) * 0.125f, HI16(qv.y) * 0.125f);
        qs.z = pack2bf(LO16(qv.z) * 0.125f, HI16(qv.z) * 0.125f);
        qs.w = pack2bf(LO16(qv.w) * 0.125f, HI16(qv.w) * 0.125f);
        *(u32x4*)(Qr + row * CH_ROW + part * 8) = qs;
        *(u32x4*)(Kr + row * CH_ROW + part * 8) = kv;
    }
    for (int c = tid; c < 1024; c += NTHREADS) {
        const int row = c >> 4, part = c & 15; const int t = gla_tok(n, row);
        const u32x4 vv = *(const u32x4*)(p.Z + (size_t)t * D_IN + ZV + h * 128 + part * 8);
        bf16_t* dst = Vt + (part * 8) * CH_ROW + row;
        dst[0 * CH_ROW] = (bf16_t)(vv.x & 0xFFFF); dst[1 * CH_ROW] = (bf16_t)(vv.x >> 16);
        dst[2 * CH_ROW] = (bf16_t)(vv.y & 0xFFFF); dst[3 * CH_ROW] = (bf16_t)(vv.y >> 16);
        dst[4 * CH_ROW] = (bf16_t)(vv.z & 0xFFFF); dst[5 * CH_ROW] = (bf16_t)(vv.z >> 16);
        dst[6 * CH_ROW] = (bf16_t)(vv.w & 0xFFFF); dst[7 * CH_ROW] = (bf16_t)(vv.w >> 16);
    }
}
__device__ __forceinline__ void gla_cum(const P& p, int l, int n, int h, int d, char* smem) {
    const int tid = otid();
    float* CUM = (float*)(smem + GL_CUM); float* ALR = (float*)(smem + GL_ALR); float* WA = (float*)(smem + GL_WA);
    for (int c = tid; c < 256; c += NTHREADS) {
        const int row = c >> 2, part = c & 3; const int t = gla_tok(n, row);
        const u32x2 a = *(const u32x2*)(p.Z + (size_t)t * D_IN + (d ? ZAB : ZAF) + part * 4);
        float* dst = ALR + row * 16 + part * 4;
        dst[0] = LO16(a.x); dst[1] = HI16(a.x); dst[2] = LO16(a.y); dst[3] = HI16(a.y);
    }
    for (int c = tid; c < 16 * 64 + 64; c += NTHREADS) {
        if (c < 1024) WA[c] = p.in[I_GLA_WA2][((size_t)(l * 2 + d) * 16 + (c >> 6)) * GLA_K + h * 64 + (c & 63)];
        else WA[c] = p.in[I_GLA_BA][(size_t)(l * 2 + d) * GLA_K + h * 64 + (c - 1024)];
    }
    __syncthreads();
    for (int idx = tid; idx < 4096; idx += NTHREADS) {
        const int i = idx >> 6, k = idx & 63;
        float a = WA[1024 + k];
#pragma unroll
        for (int r = 0; r < 16; ++r) a += ALR[i * 16 + r] * WA[r * 64 + k];
        CUM[i * 68 + k] = (fminf(a, 0.f) - flog_(1.0f + fexp_(-fabsf(a)))) * (1.0f / 16.0f);
    }
    __syncthreads();
    {
        const int k = tid & 63, seg = (tid >> 6) & 3;
        float v[16]; float run = 0.f;
        if (tid < 256) {
#pragma unroll
            for (int e = 0; e < 16; ++e) { const int pos = seg * 16 + e; const int i = d ? 63 - pos : pos; run += CUM[i * 68 + k]; v[e] = run; }
            ALR[seg * 64 + k] = run;
        }
        __syncthreads();
        if (tid < 256) {
            float off = 0.f;
            for (int s2 = 0; s2 < seg; ++s2) off += ALR[s2 * 64 + k];
#pragma unroll
            for (int e = 0; e < 16; ++e) { const int pos = seg * 16 + e; const int i = d ? 63 - pos : pos; CUM[i * 68 + k] = v[e] + off; }
        }
    }
    __syncthreads();
}
__device__ __forceinline__ void phase_gla_kv(const P& p, int l, char* smem) {
    const int tid = otid(), lane = tid & 63, wv = tid >> 6, q = lane >> 4, r = lane & 15;
    bf16_t* Kr = (bf16_t*)(smem + GL_KR); bf16_t* Vt = (bf16_t*)(smem + GL_VT); bf16_t* KdT = (bf16_t*)(smem + GL_KI);
    float* CUM = (float*)(smem + GL_CUM);
    for (int job = obid(); job < NC * GH; job += gridDim.x) {
        const int n = job / GH, h = job % GH;
        __syncthreads();
        gla_load_qkv(p, n, h, smem);
        for (int d = 0; d < 2; ++d) {
            gla_cum(p, l, n, h, d, smem);
            const int li = d ? 0 : 63;
            for (int idx = tid; idx < 4096; idx += NTHREADS) {
                const int i = idx >> 6, k = idx & 63;
                KdT[k * CH_ROW + i] = f2bf(bf2f(Kr[i * CH_ROW + k]) * fexp_(CUM[li * 68 + k] - CUM[i * 68 + k]));
            }
            if (tid < 64) p.DEC[((size_t)(d * NC + n) * GH + h) * 64 + tid] = fexp_(CUM[li * 68 + tid]);
            __syncthreads();
            float* kvt = p.KV + ((size_t)(d * NC + n) * GH + h) * 8192;
            for (int mt = wv; mt < 4; mt += NTHREADS / 64) {
                f32x4 acc[1][8];
#pragma unroll
                for (int nt = 0; nt < 8; ++nt) acc[0][nt] = (f32x4){0.f, 0.f, 0.f, 0.f};
                lds_mm<1, 8>(KdT, 16 * mt, Vt, 0, acc);
#pragma unroll
                for (int nt = 0; nt < 8; ++nt) *(f32x4*)(kvt + (size_t)(nt * 16 + r) * 64 + 16 * mt + 4 * q) = acc[0][nt];
            }
            __syncthreads();
        }
    }
    __syncthreads();
}
__device__ __forceinline__ void gla_scan_job(const P& p, int job) {
    const int base = job * NTHREADS + otid();
    const int d = base / (GH * 8192), h = (base / 8192) % GH, e = base % 8192;
    const float* __restrict__ kvp = p.KV; const float* __restrict__ decp = p.DEC; bf16_t* __restrict__ sp = p.SP;
    float S = 0.f;
    for (int s = 0; s < NC; s += 4) {
        float kv[4], dc[4]; size_t oo[4];
#pragma unroll
        for (int u = 0; u < 4; ++u) {
            const int n = chunk_order(d, (s + u < NC) ? s + u : NC - 1);
            oo[u] = ((size_t)(d * NC + n) * GH + h);
            kv[u] = kvp[oo[u] * 8192 + e]; dc[u] = decp[oo[u] * 64 + (e & 63)];
        }
#pragma unroll
        for (int u = 0; u < 4; ++u) if (s + u < NC) { sp[oo[u] * 8192 + e] = f2bf(S); S = dc[u] * S + kv[u]; }
    }
}
__device__ __forceinline__ void phase_gla_out(const P& p, int l, char* smem) {
    const int tid = otid(), lane = tid & 63, wv = tid >> 6, q = lane >> 4, r = lane & 15;
    bf16_t* Qr = (bf16_t*)(smem + GL_QR); bf16_t* Kr = (bf16_t*)(smem + GL_KR); bf16_t* Vt = (bf16_t*)(smem + GL_VT);
    bf16_t* Qi = (bf16_t*)(smem + GL_QI); bf16_t* Ki = (bf16_t*)(smem + GL_KI); bf16_t* At = (bf16_t*)(smem + GL_AT);
    float* CUM = (float*)(smem + GL_CUM);
    for (int job = obid(); job < NC * GH; job += gridDim.x) {
        const int n = job / GH, h = job % GH;
        __syncthreads();
        gla_load_qkv(p, n, h, smem);
        f32x4 o[1][8];
#pragma unroll
        for (int nt = 0; nt < 8; ++nt) o[0][nt] = (f32x4){0.f, 0.f, 0.f, 0.f};
        for (int d = 0; d < 2; ++d) {
            gla_cum(p, l, n, h, d, smem);
            for (int idx = tid; idx < 4096; idx += NTHREADS) {
                const int i = idx >> 6, k = idx & 63; const float c = CUM[i * 68 + k];
                Qi[i * CH_ROW + k] = f2bf(bf2f(Qr[i * CH_ROW + k]) * fexp_(c));
                Ki[i * CH_ROW + k] = f2bf(bf2f(Kr[i * CH_ROW + k]) * fexp_(-c));
            }
            __syncthreads();
            if (wv < 4) {
                f32x4 a[1][4];
#pragma unroll
                for (int nt = 0; nt < 4; ++nt) a[0][nt] = (f32x4){0.f, 0.f, 0.f, 0.f};
                lds_mm<1, 4>(Qi, 16 * wv, Ki, 0, a);
#pragma unroll
                for (int nt = 0; nt < 4; ++nt)
#pragma unroll
                    for (int e = 0; e < 4; ++e) {
                        const int i = 16 * wv + 4 * q + e, j = nt * 16 + r;
                        const bool ok = d ? (j >= i) : (j <= i);
                        At[i * CH_ROW + j] = f2bf(ok ? a[0][nt][e] : 0.f);
                    }
                WAVE_SYNC();
                lds_mm<1, 8>(At, 16 * wv, Vt, 0, o);
                const bf16_t* sp = p.SP + ((size_t)(d * NC + n) * GH + h) * 8192;
#pragma unroll
                for (int s2 = 0; s2 < 2; ++s2) {
                    const bf16x8 af = *(const bf16x8*)(Qi + (16 * wv + r) * CH_ROW + s2 * 32 + q * 8);
#pragma unroll
                    for (int nt = 0; nt < 8; ++nt) {
                        const bf16x8 bfr = *(const bf16x8*)(sp + (size_t)(nt * 16 + r) * 64 + s2 * 32 + q * 8);
                        o[0][nt] = MFMA16(af, bfr, o[0][nt]);
                    }
                }
            }
            __syncthreads();
        }
        if (wv < 4) {
#pragma unroll
            for (int nt = 0; nt < 8; ++nt)
#pragma unroll
                for (int e = 0; e < 4; ++e) {
                    const int t = gla_tok(n, 16 * wv + 4 * q + e);
                    p.OGLA[(size_t)t * GLA_V + h * 128 + nt * 16 + r] = o[0][nt][e];
                }
        }
    }
    __syncthreads();
}

#define S5_XH_OFF (2 * 64 * 132 * 4)
#define S5_XL_OFF (S5_XH_OFF + 64 * 136 * 2)
#define S5_CT_OFF (S5_XL_OFF + 64 * 136 * 2)
__device__ __forceinline__ void phase_s5_pass(const P& p, int l, char* smem, bool with_out) {
    const int tid = otid(), lane = tid & 63, wv = tid >> 6, q = lane >> 4, r = lane & 15;
    float* BU = (float*)smem; bf16_t* XH = (bf16_t*)(smem + S5_XH_OFF); bf16_t* XL = (bf16_t*)(smem + S5_XL_OFF); bf16_t* CTp = (bf16_t*)(smem + S5_CT_OFF);
    const int dW = (wv >> 1) & 1, ntb = (wv & 1) * 4;
    const int dS = (tid >> 6) & 1, st = tid & 63;
    bf16x8 bhi[4], blo[4];
    float are = 0.f, aim = 0.f, dco = 0.f;
    int cur_g = -1;
    const bf16x8 zero8 = {0, 0, 0, 0, 0, 0, 0, 0};
    for (int job = obid(); job < NC * SG; job += gridDim.x) {
        const int n = job / SG, g = job % SG;
        __syncthreads();
        if (g != cur_g) {
            cur_g = g;
            if (wv < 4) {
#pragma unroll
                for (int jn = 0; jn < 4; ++jn) {
                    const int kk = 16 * (ntb + jn) + r; const size_t ci = ((size_t)dW * SG + g) * 64 + (kk >> 1);
                    float f[8], lo[8];
#pragma unroll
                    for (int e = 0; e < 8; ++e) f[e] = (q < 2) ? p.S5BB[(ci * 16 + 8 * q + e) * 2 + (kk & 1)] : 0.f;
                    const u32x4 hv = pack8(f);
                    float hf[8]; unpack8(hv, hf);
#pragma unroll
                    for (int e = 0; e < 8; ++e) lo[e] = f[e] - hf[e];
                    bhi[jn] = __builtin_bit_cast(bf16x8, hv); blo[jn] = __builtin_bit_cast(bf16x8, pack8(lo));
                }
            }
            if (tid < 128) { const size_t ci = ((size_t)dS * SG + g) * 64 + st; are = p.S5A[ci * 2]; aim = p.S5A[ci * 2 + 1]; }
            if (with_out) {
                for (int idx = tid; idx < 16 * 128; idx += NTHREADS) {
                    const int c = idx >> 7, kk = idx & 127;
                    const float v = (kk & 1) ? -p.in[I_S5CIM][((size_t)l * SG + g) * 1024 + c * 64 + (kk >> 1)] : p.in[I_S5CRE][((size_t)l * SG + g) * 1024 + c * 64 + (kk >> 1)];
                    CTp[c * 136 + kk] = f2bf(v);
                }
                dco = p.in[I_S5D][(size_t)l * SW + g * 16 + r];
            }
        }
        float xr = 0.f, xi = 0.f;
        const size_t eo = (((size_t)dS * NC + n) * SG + g) * 64 + st;
        if (with_out && tid < 128) { const float2 c2 = *(const float2*)(p.S5CAR + eo * 2); xr = c2.x; xi = c2.y; }
        if (wv < 4) {
#pragma unroll
            for (int mt = 0; mt < 4; ++mt) {
                const bf16x8 a = (q < 2) ? *(const bf16x8*)(p.Z + (size_t)(n * 64 + 16 * mt + r) * D_IN + ZS5 + g * 16 + 8 * q) : zero8;
#pragma unroll
                for (int jn = 0; jn < 4; ++jn) {
                    f32x4 acc = {0.f, 0.f, 0.f, 0.f};
                    acc = MFMA16(a, bhi[jn], acc);
                    acc = MFMA16(a, blo[jn], acc);
#pragma unroll
                    for (int e = 0; e < 4; ++e) BU[(dW * 64 + 16 * mt + 4 * q + e) * 132 + 16 * (ntb + jn) + r] = acc[e];
                }
            }
        }
        __syncthreads();
        if (tid < 128) {
#pragma unroll 8
            for (int ii = 0; ii < 64; ++ii) {
                const int i = dS ? 63 - ii : ii;
                float2* bp = (float2*)(BU + (dS * 64 + i) * 132 + st * 2);
                const float2 b = *bp;
                const float nr = are * xr - aim * xi + b.x, ni = are * xi + aim * xr + b.y;
                xr = nr; xi = ni;
                if (with_out) { float2 o; o.x = xr; o.y = xi; *bp = o; }
            }
            if (!with_out) { float2 o; o.x = xr; o.y = xi; *(float2*)(p.S5END + eo * 2) = o; }
        }
        if (with_out) {
            __syncthreads();
            for (int cidx = tid; cidx < 64 * 16; cidx += NTHREADS) {
                const int i = cidx >> 4, k0 = (cidx & 15) * 8;
                float a[8], b[8], lo[8];
                load8f(BU + (0 * 64 + i) * 132 + k0, a); load8f(BU + (1 * 64 + i) * 132 + k0, b);
#pragma unroll
                for (int e = 0; e < 8; ++e) a[e] += b[e];
                const u32x4 hv = pack8(a);
                float hf[8]; unpack8(hv, hf);
#pragma unroll
                for (int e = 0; e < 8; ++e) lo[e] = a[e] - hf[e];
                *(u32x4*)(XH + i * 136 + k0) = hv; *(u32x4*)(XL + i * 136 + k0) = pack8(lo);
            }
            __syncthreads();
            if (wv < 4) {
                f32x4 acc = {0.f, 0.f, 0.f, 0.f};
#pragma unroll
                for (int ks = 0; ks < 4; ++ks) {
                    const bf16x8 ah = *(const bf16x8*)(XH + (16 * wv + r) * 136 + ks * 32 + q * 8), al = *(const bf16x8*)(XL + (16 * wv + r) * 136 + ks * 32 + q * 8);
                    const bf16x8 b = *(const bf16x8*)(CTp + r * 136 + ks * 32 + q * 8);
                    acc = MFMA16(ah, b, acc);
                    acc = MFMA16(al, b, acc);
                }
#pragma unroll
                for (int e = 0; e < 4; ++e) {
                    const int i = 16 * wv + 4 * q + e;
                    const float u = bf2f(p.Z[(size_t)(n * 64 + i) * D_IN + ZS5 + g * 16 + r]);
                    p.GY[(size_t)(n * 64 + i) * SW + g * 16 + r] = f2bf(geluf_(acc[e] + dco * u));
                }
            }
        }
    }
    __syncthreads();
}
__device__ __forceinline__ void s5_carry_job(const P& p, int job) {
    const int base = job * NTHREADS + otid();
    if (base >= 2 * SG * 64) return;
    const int d = base / (SG * 64), g = (base / 64) % SG, st = base % 64;
    const size_t ci = ((size_t)d * SG + g) * 64 + st;
    float ar = p.S5A[ci * 2], ai = p.S5A[ci * 2 + 1];
    for (int i = 0; i < 6; ++i) { const float nr = ar * ar - ai * ai, ni = 2.f * ar * ai; ar = nr; ai = ni; }
    const float2* __restrict__ endp = (const float2*)p.S5END; float2* __restrict__ carp = (float2*)p.S5CAR;
    float cr = 0.f, cim = 0.f;
    for (int s = 0; s < NC; s += 4) {
        float2 ev[4]; size_t eo[4];
#pragma unroll
        for (int u = 0; u < 4; ++u) {
            const int n = chunk_order(d, (s + u < NC) ? s + u : NC - 1);
            eo[u] = (((size_t)d * NC + n) * SG + g) * 64 + st;
            ev[u] = endp[eo[u]];
        }
#pragma unroll
        for (int u = 0; u < 4; ++u) if (s + u < NC) {
            float2 c; c.x = cr; c.y = cim; carp[eo[u]] = c;
            const float nr = ar * cr - ai * cim + ev[u].x, ni = ar * cim + ai * cr + ev[u].y;
            cr = nr; cim = ni;
        }
    }
}

__device__ __forceinline__ void phase_side_elem(const P& p, int l) {
    const int lane = otid() & 63;
    const int gw = (obid() * NTHREADS + otid()) >> 6, nw = (gridDim.x * NTHREADS) >> 6;
    const bool actg = lane * 8 < GLA_V, actr = lane * 8 < RW;
    float gng[8], lnw[8], lnb[8];
#pragma unroll
    for (int e = 0; e < 8; ++e) { gng[e] = 0.f; lnw[e] = 0.f; lnb[e] = 0.f; }
    if (actg) load8f(p.in[I_GLA_NG] + (size_t)l * 128 + ((lane * 8) & 127), gng);
    if (actr) { load8f(p.in[I_RLNW] + (size_t)l * RW + lane * 8, lnw); load8f(p.in[I_RLNB] + (size_t)l * RW + lane * 8, lnb); }
    for (int t = gw; t < MTOT; t += nw) {
        float og[8], zo[8], y0[8], y1[8], vv[8];
        const u32x4 z4 = {0u, 0u, 0u, 0u};
#pragma unroll
        for (int e = 0; e < 8; ++e) { og[e] = 0.f; y0[e] = 0.f; y1[e] = 0.f; }
        if (actg) load8f(p.OGLA + (size_t)t * GLA_V + lane * 8, og);
        unpack8(actg ? *(const u32x4*)(p.Z + (size_t)t * D_IN + ZOG + lane * 8) : z4, zo);
        if (actr) { load8f(p.Y + (size_t)t * RW + lane * 8, y0); load8f(p.Y + ((size_t)MTOT + t) * RW + lane * 8, y1); }
        unpack8(actr ? *(const u32x4*)(p.V + (size_t)t * RW + lane * 8) : z4, vv);
        const int hh = (lane * 8) >> 6;
        const float bon = actr ? (p.BONUS[(size_t)t * RH + hh] + p.BONUS[((size_t)MTOT + t) * RH + hh]) : 0.f;
        float ss = 0.f;
#pragma unroll
        for (int e = 0; e < 8; ++e) ss += og[e] * og[e];
        ss += __shfl_xor(ss, 1, 64); ss += __shfl_xor(ss, 2, 64); ss += __shfl_xor(ss, 4, 64); ss += __shfl_xor(ss, 8, 64);
        const float rstd = rsqrtf(ss * (1.0f / 128.f) + 1e-6f);
        float br[8];
#pragma unroll
        for (int e = 0; e < 8; ++e) br[e] = og[e] * rstd * gng[e] * siluf_(zo[e]);
        if (actg) *(u32x4*)(p.BR + (size_t)t * 3 * BW + lane * 8) = pack8(br);
        float y[8]; float sm = 0.f;
#pragma unroll
        for (int e = 0; e < 8; ++e) { y[e] = y0[e] + y1[e]; sm += y[e]; }
        sm += __shfl_xor(sm, 1, 64); sm += __shfl_xor(sm, 2, 64); sm += __shfl_xor(sm, 4, 64);
        const float mu = sm * (1.0f / 64.f);
        float sv = 0.f;
#pragma unroll
        for (int e = 0; e < 8; ++e) { y[e] -= mu; sv += y[e] * y[e]; }
        sv += __shfl_xor(sv, 1, 64); sv += __shfl_xor(sv, 2, 64); sv += __shfl_xor(sv, 4, 64);
        const float rs = rsqrtf(sv * (1.0f / 64.f) + 64e-5f);
        float yn[8];
#pragma unroll
        for (int e = 0; e < 8; ++e) yn[e] = y[e] * rs * lnw[e] + lnb[e] + bon * vv[e];
        if (actr) store8f(p.YN + (size_t)t * RW + lane * 8, yn);
    }
}

__device__ __forceinline__ void phase_side_gemm(const P& p, int l, char* smem) {
    const int ntm = MTOT / 128, nt1 = NPAD(RW) / 128, nt2 = (2 * SW) / 128;
    for (int job = obid(); job < ntm * (nt1 + nt2); job += gridDim.x) {
        const int m0 = (job / (nt1 + nt2)) * 128, jn = job % (nt1 + nt2);
        f32x4 acc[4][4]; ZERO_ACC4(acc);
        if (jn < nt1) {
            const int n0 = jn * 128;
            mfma_gemm_tile(p.WT_G2, 128, p.GS, 128, 128, n0, m0, (bf16_t*)smem, acc);
            FOR_ACC(acc, n0, m0, { if (n < RW) { const float4 y = *(const float4*)(p.YN + (size_t)m * RW + n);
                *(u32x2*)(p.BR + (size_t)m * 3 * BW + BW + n) = pack4(y.x * v[0], y.y * v[1], y.z * v[2], y.w * v[3]); } })
        } else {
            const int n0 = (jn - nt1) * 128;
            mfma_gemm_tile(p.WT_GLU, SW, p.GY, SW, SW, n0, m0, (bf16_t*)smem, acc);
            FOR_ACC(acc, n0, m0, { const unsigned w = pack2bf(v[0] * sigmoidf_(v[1]), v[2] * sigmoidf_(v[3]));
                *(unsigned*)(p.BR + (size_t)m * 3 * BW + 2 * BW + (n >> 1)) = w; })
        }
    }
}

__device__ __forceinline__ void phase_merge(const P& p, int l, char* smem) {
    const int ntm = MTOT / 128, ntn = D_MODEL / 128;
    for (int job = obid(); job < ntm * ntn; job += gridDim.x) {
        const int m0 = (job / ntn) * 128, n0 = (job % ntn) * 128;
        f32x4 macc[4][4]; ZERO_ACC4(macc);
        for (int b = 0; b < 3; ++b) {
            f32x4 acc[4][4]; ZERO_ACC4(acc);
            mfma_gemm_tile(p.WT_BR + (size_t)b * D_MODEL * BW, BW, p.BR + b * BW, 3 * BW, BW, n0, m0, (bf16_t*)smem, acc);
            const int lane_ = otid() & 63, wave_ = otid() >> 6;
#pragma unroll
            for (int ni = 0; ni < 4; ++ni)
#pragma unroll
                for (int mi = 0; mi < 4; ++mi) {
                    const int n = n0 + (wave_ >> 1) * 64 + ni * 16 + (lane_ >> 4) * 4, m = m0 + (wave_ & 1) * 64 + mi * 16 + (lane_ & 15);
                    const u32x2 g = *(const u32x2*)(p.Z + (size_t)m * D_IN + ZG + b * D_MODEL + n);
                    macc[ni][mi][0] += sigmoidf_(bf2f((bf16_t)(g.x & 0xFFFF))) * acc[ni][mi][0];
                    macc[ni][mi][1] += sigmoidf_(bf2f((bf16_t)(g.x >> 16))) * acc[ni][mi][1];
                    macc[ni][mi][2] += sigmoidf_(bf2f((bf16_t)(g.y & 0xFFFF))) * acc[ni][mi][2];
                    macc[ni][mi][3] += sigmoidf_(bf2f((bf16_t)(g.y >> 16))) * acc[ni][mi][3];
                }
        }
        FOR_ACC(macc, n0, m0, { *(u32x2*)(p.M + (size_t)m * D_MODEL + n) = pack4(v[0], v[1], v[2], v[3]); })
    }
}

__device__ __forceinline__ void phase_outproj(const P& p, int l, char* smem) {
    const int ntm = MTOT / 128, ntn = D_MODEL / 128;
    for (int job = obid(); job < ntm * ntn; job += gridDim.x) {
        const int m0 = (job / ntn) * 128, n0 = (job % ntn) * 128;
        f32x4 acc[4][4]; ZERO_ACC4(acc);
        mfma_gemm_tile(p.WT_OUT, D_MODEL, p.M, D_MODEL, D_MODEL, n0, m0, (bf16_t*)smem, acc);
        FOR_ACC(acc, n0, m0, { const float* g1 = p.MOD + (size_t)(l * 2 + (m >= CTX ? 1 : 0)) * 6 * D_MODEL + 2 * D_MODEL + n;
            float4* xp = (float4*)(p.X + (size_t)m * D_MODEL + n); float4 x = *xp;
            x.x += g1[0] * v[0]; x.y += g1[1] * v[1]; x.z += g1[2] * v[2]; x.w += g1[3] * v[3]; *xp = x; })
    }
}

__device__ __forceinline__ void store_q_hilo(const P& p, int m, int n, const f32x4 v) {
    const bf16_t h0 = f2bf(v[0]), h1 = f2bf(v[1]), h2 = f2bf(v[2]), h3 = f2bf(v[3]);
    u32x2 hv; hv.x = (unsigned)h0 | ((unsigned)h1 << 16); hv.y = (unsigned)h2 | ((unsigned)h3 << 16);
    *(u32x2*)(p.QHI + (size_t)m * PQ + n) = hv;
    *(u32x2*)(p.QLO + (size_t)m * PQ + n) = pack4(v[0] - bf2f(h0), v[1] - bf2f(h1), v[2] - bf2f(h2), v[3] - bf2f(h3));
}
__device__ __forceinline__ void phase_peer_q(const P& p, int l, char* smem) {
    const int ntm = MTOT / 128, ntn = PQ / 128;
    for (int job = obid(); job < ntm * ntn; job += gridDim.x) {
        const int m0 = (job / ntn) * 128, n0 = (job % ntn) * 128;
        f32x4 acc[4][4]; ZERO_ACC4(acc);
        mfma_gemm_tile(p.WT_Q, D_MODEL, p.H, D_MODEL, D_MODEL, n0, m0, (bf16_t*)smem, acc);
        FOR_ACC(acc, n0, m0, { store_q_hilo(p, m, n, v); })
    }
}

#define TK_ROW 129
__device__ __forceinline__ unsigned tk_key(float f, unsigned lowmask, unsigned low) {
    unsigned u = __builtin_bit_cast(unsigned, f);
    u ^= (u & 0x80000000u) ? 0xFFFFFFFFu : 0x80000000u;
    return (u & ~lowmask) | low;
}
#define TK_INSERT(lv, xk) { unsigned x_ = (xk); _Pragma("unroll") for (int z_ = 0; z_ < 16; ++z_) { const unsigned hi_ = lv[z_] > x_ ? lv[z_] : x_; x_ = lv[z_] > x_ ? x_ : lv[z_]; lv[z_] = hi_; } }
__device__ __forceinline__ void phase_peer_topk(const P& p, int l, char* smem) {
    const int tid = otid(), lane = tid & 63, wv = tid >> 6, q = lane >> 4, r = lane & 15;
    float* sc = (float*)smem + wv * (64 * TK_ROW);
    const int gw = (obid() * NTHREADS + tid) >> 6, nw = (gridDim.x * NTHREADS) >> 6;
    const float NEG = -3.0e38f;
    for (int job = gw; job < (MTOT / 32) * PH; job += nw) {
        const int t0 = (job / PH) * 32, h = job % PH;
#pragma unroll
        for (int sd = 0; sd < 2; ++sd) {
            f32x4 acc[2][8];
#pragma unroll
            for (int mt = 0; mt < 2; ++mt)
#pragma unroll
                for (int nt = 0; nt < 8; ++nt) acc[mt][nt] = (f32x4){0.f, 0.f, 0.f, 0.f};
#pragma unroll
            for (int ks = 0; ks < 4; ++ks) {
                bf16x8 ah[2], al[2];
#pragma unroll
                for (int mt = 0; mt < 2; ++mt) {
                    const size_t qo = (size_t)(t0 + mt * 16 + r) * PQ + h * 256 + sd * 128 + ks * 32 + q * 8;
                    ah[mt] = *(const bf16x8*)(p.QHI + qo); al[mt] = *(const bf16x8*)(p.QLO + qo);
                }
#pragma unroll
                for (int nt = 0; nt < 8; ++nt) {
                    const size_t ko = ((size_t)(h * 2 + sd) * 128 + nt * 16 + r) * 128 + ks * 32 + q * 8;
                    const bf16x8 bh = *(const bf16x8*)(p.KHI + ko), bl = *(const bf16x8*)(p.KLO + ko);
#pragma unroll
                    for (int mt = 0; mt < 2; ++mt) {
                        acc[mt][nt] = MFMA16(ah[mt], bh, acc[mt][nt]);
                        acc[mt][nt] = MFMA16(al[mt], bh, acc[mt][nt]);
                        acc[mt][nt] = MFMA16(ah[mt], bl, acc[mt][nt]);
                    }
                }
            }
#pragma unroll
            for (int mt = 0; mt < 2; ++mt)
#pragma unroll
                for (int nt = 0; nt < 8; ++nt)
#pragma unroll
                    for (int e = 0; e < 4; ++e) sc[(sd * 32 + mt * 16 + 4 * q + e) * TK_ROW + nt * 16 + r] = acc[mt][nt][e];
        }
        WAVE_SYNC();
        unsigned lv[16];
#pragma unroll
        for (int z = 0; z < 16; ++z) lv[z] = 0u;
        {
            const float* row = sc + lane * TK_ROW;
#pragma unroll 4
            for (int k = 0; k < 128; ++k) TK_INSERT(lv, tk_key(row[k], 0x7Fu, (unsigned)(127 - k)));
        }
        float lvv[16]; int li[16];
        {
            const float* row = sc + lane * TK_ROW;
#pragma unroll
            for (int z = 0; z < 16; ++z) { li[z] = 127 - (int)(lv[z] & 0x7Fu); lvv[z] = row[li[z]]; }
        }
        WAVE_SYNC();
        {
            float* row = sc + lane * TK_ROW;
#pragma unroll
            for (int z = 0; z < 16; ++z) { row[z] = lvv[z]; ((int*)row)[16 + z] = li[z]; }
        }
        WAVE_SYNC();
        const float* r1 = sc + (lane & 31) * TK_ROW; const float* r2 = sc + (32 + (lane & 31)) * TK_ROW;
        unsigned tk[16];
#pragma unroll
        for (int z = 0; z < 16; ++z) tk[z] = 0u;
        for (int i = 0; i < 16; ++i) {
            const float a = r1[i];
            const int nj = 16 / (i + 1);
            for (int j = 0; j < nj; ++j) TK_INSERT(tk, tk_key(a + r2[j], 0xFFu, (unsigned)(255 - (i * 16 + j))));
        }
        int tc[16];
#pragma unroll
        for (int z = 0; z < 16; ++z) tc[z] = 255 - (int)(tk[z] & 0xFFu);
        if (lane < 32) {
            float vals[16]; float mx = 0.f; float ssum = 0.f;
#pragma unroll
            for (int z = 0; z < 16; ++z) { vals[z] = r1[tc[z] >> 4] + r2[tc[z] & 15]; if (z == 0) mx = vals[0]; vals[z] = fexp_(vals[z] - mx); ssum += vals[z]; }
            const float inv = 1.0f / ssum;
            const size_t o = (size_t)(t0 + lane) * PH * 16 + h * 16;
#pragma unroll
            for (int z = 0; z < 16; ++z) {
                const int ex_ = ((const int*)r1)[16 + (tc[z] >> 4)] * 128 + ((const int*)r2)[16 + (tc[z] & 15)];
                p.IDX[o + z] = ex_;
                p.G[o + z] = vals[z] * inv * p.VSC[ex_];
                p.GU[o + z] = p.USC[ex_];
            }
        }
        WAVE_SYNC();
    }
}

#define PEER_CONV_JOBS (2 * NEXP / 4)
__device__ __forceinline__ void peer_conv_job(const P& p, int l, int job) {
    const int tid = otid(), lane = tid & 63, wv = tid >> 6;
    if (wv >= 4) return;
    const int rowg = job * 4 + wv; const int which = rowg / NEXP, row = rowg % NEXP;
    const float* src = p.in[which ? I_PV : I_PU] + ((size_t)l * NEXP + row) * D_MODEL + lane * 16;
    const bool act = lane * 16 < D_MODEL;
    float v[16]; float amax = 0.f;
#pragma unroll
    for (int c = 0; c < 4; ++c) {
        float4 a; a.x = 0.f; a.y = 0.f; a.z = 0.f; a.w = 0.f;
        if (act) a = *(const float4*)(src + c * 4);
        v[c * 4 + 0] = a.x; v[c * 4 + 1] = a.y; v[c * 4 + 2] = a.z; v[c * 4 + 3] = a.w;
        amax = fmaxf(amax, fmaxf(fmaxf(fabsf(a.x), fabsf(a.y)), fmaxf(fabsf(a.z), fabsf(a.w))));
    }
#pragma unroll
    for (int m = 32; m >= 1; m >>= 1) amax = fmaxf(amax, __shfl_xor(amax, m, 64));
    int ex = 0;
    if (amax > 0.f) ex = 7 - (int)((__builtin_bit_cast(unsigned, amax) >> 23) & 0xFF) + 127;
    ex = ex < -100 ? -100 : (ex > 100 ? 100 : ex);
    const float sc = __builtin_bit_cast(float, (unsigned)(ex + 127) << 23), isc = __builtin_bit_cast(float, (unsigned)(127 - ex) << 23);
    u32x4 o;
    int w0 = 0, w1 = 0, w2 = 0, w3 = 0;
    w0 = CVT_PK_FP8(v[0] * sc, v[1] * sc, w0, false); w0 = CVT_PK_FP8(v[2] * sc, v[3] * sc, w0, true);
    w1 = CVT_PK_FP8(v[4] * sc, v[5] * sc, w1, false); w1 = CVT_PK_FP8(v[6] * sc, v[7] * sc, w1, true);
    w2 = CVT_PK_FP8(v[8] * sc, v[9] * sc, w2, false); w2 = CVT_PK_FP8(v[10] * sc, v[11] * sc, w2, true);
    w3 = CVT_PK_FP8(v[12] * sc, v[13] * sc, w3, false); w3 = CVT_PK_FP8(v[14] * sc, v[15] * sc, w3, true);
    o.x = (unsigned)w0; o.y = (unsigned)w1; o.z = (unsigned)w2; o.w = (unsigned)w3;
    unsigned char* dst = (which ? p.V8 : p.U8) + (size_t)row * D_MODEL + lane * 16;
    if (act) *(u32x4*)dst = o;
    if (lane == 0) (which ? p.VSC : p.USC)[row] = isc;
}
#define GE 8
struct GBuf { u32x4 u[GE]; u32x4 v[GE]; float gu; float gv; };
__device__ __forceinline__ void gather_load(const P& p, GBuf& b, int g, int idx0, int idx1, float g0, float g1, float u0, float u1, int lane) {
    const bool act = lane * 16 < D_MODEL;
#pragma unroll
    for (int q = 0; q < GE; ++q) {
        const int k = g * GE + q;
        const int ei = __shfl((k < 64) ? idx0 : idx1, k & 63, 64);
        b.u[q] = act ? *(const u32x4*)(p.U8 + (size_t)ei * D_MODEL + lane * 16) : (u32x4){0u, 0u, 0u, 0u};
        b.v[q] = act ? *(const u32x4*)(p.V8 + (size_t)ei * D_MODEL + lane * 16) : (u32x4){0u, 0u, 0u, 0u};
    }
    const int km = g * GE + ((lane >> 3) & 7);
    b.gv = __shfl((km < 64) ? g0 : g1, km & 63, 64);
    b.gu = __shfl((km < 64) ? u0 : u1, km & 63, 64);
}
__device__ __forceinline__ void gather_compute(const GBuf& b, const float (&hv)[16], float (&acc)[16], int lane) {
    float dt[GE];
#pragma unroll
    for (int q = 0; q < GE; ++q) {
        float d = 0.f;
#pragma unroll
        for (int c = 0; c < 4; ++c) {
            const f32x2 lo = CVT_PK_F32_FP8((int)b.u[q][c], false), hi = CVT_PK_F32_FP8((int)b.u[q][c], true);
            d += hv[c * 4 + 0] * lo.x + hv[c * 4 + 1] * lo.y + hv[c * 4 + 2] * hi.x + hv[c * 4 + 3] * hi.y;
        }
        dt[q] = d;
    }
    float r4[4], r2[2], r1;
    {
        const bool up = (lane & 32) != 0;
#pragma unroll
        for (int q = 0; q < 4; ++q) { const float keep = up ? dt[4 + q] : dt[q], send = up ? dt[q] : dt[4 + q]; r4[q] = keep + __shfl_xor(send, 32, 64); }
    }
    {
        const bool up = (lane & 16) != 0;
#pragma unroll
        for (int q = 0; q < 2; ++q) { const float keep = up ? r4[2 + q] : r4[q], send = up ? r4[q] : r4[2 + q]; r2[q] = keep + __shfl_xor(send, 16, 64); }
    }
    {
        const bool up = (lane & 8) != 0;
        const float keep = up ? r2[1] : r2[0], send = up ? r2[0] : r2[1];
        r1 = keep + __shfl_xor(send, 8, 64);
    }
    r1 += __shfl_xor(r1, 4, 64); r1 += __shfl_xor(r1, 2, 64); r1 += __shfl_xor(r1, 1, 64);
    const float coef_mine = b.gv * geluf_(r1 * b.gu);
#pragma unroll
    for (int q = 0; q < GE; ++q) {
        const float coef = __shfl(coef_mine, q * 8, 64);
#pragma unroll
        for (int c = 0; c < 4; ++c) {
            const f32x2 lo = CVT_PK_F32_FP8((int)b.v[q][c], false), hi = CVT_PK_F32_FP8((int)b.v[q][c], true);
            acc[c * 4 + 0] += coef * lo.x; acc[c * 4 + 1] += coef * lo.y; acc[c * 4 + 2] += coef * hi.x; acc[c * 4 + 3] += coef * hi.y;
        }
    }
}
__device__ __forceinline__ void phase_peer_gather(const P& p, int l) {
    const int lane = otid() & 63;
    const int gw = (obid() * NTHREADS + otid()) >> 6, nw = (gridDim.x * NTHREADS) >> 6;
    constexpr int NG = PH * 16 / GE;
    const bool act = lane * 16 < D_MODEL;
    for (int t = gw; t < MTOT; t += nw) {
        float hv[16], acc[16];
        {
            const u32x4 z4 = {0u, 0u, 0u, 0u};
            const u32x4 ha = act ? *(const u32x4*)(p.H + (size_t)t * D_MODEL + lane * 16) : z4;
            const u32x4 hb = act ? *(const u32x4*)(p.H + (size_t)t * D_MODEL + lane * 16 + 8) : z4;
            hv[0] = LO16(ha.x); hv[1] = HI16(ha.x); hv[2] = LO16(ha.y); hv[3] = HI16(ha.y); hv[4] = LO16(ha.z); hv[5] = HI16(ha.z); hv[6] = LO16(ha.w); hv[7] = HI16(ha.w);
            hv[8] = LO16(hb.x); hv[9] = HI16(hb.x); hv[10] = LO16(hb.y); hv[11] = HI16(hb.y); hv[12] = LO16(hb.z); hv[13] = HI16(hb.z); hv[14] = LO16(hb.w); hv[15] = HI16(hb.w);
#pragma unroll
            for (int j = 0; j < 16; ++j) acc[j] = 0.f;
        }
        int idx0 = 0, idx1 = 0; float g0 = 0.f, g1 = 0.f, u0 = 0.f, u1 = 0.f;
        if (lane < PH * 16) { idx0 = p.IDX[(size_t)t * PH * 16 + lane]; g0 = p.G[(size_t)t * PH * 16 + lane]; u0 = p.GU[(size_t)t * PH * 16 + lane]; }
        if (64 + lane < PH * 16) { idx1 = p.IDX[(size_t)t * PH * 16 + 64 + lane]; g1 = p.G[(size_t)t * PH * 16 + 64 + lane]; u1 = p.GU[(size_t)t * PH * 16 + 64 + lane]; }
        GBuf ba, bb;
        gather_load(p, ba, 0, idx0, idx1, g0, g1, u0, u1, lane);
        for (int g = 0; g < NG; g += 2) {
            gather_load(p, bb, g + 1, idx0, idx1, g0, g1, u0, u1, lane);
            gather_compute(ba, hv, acc, lane);
            if (g + 2 < NG) gather_load(p, ba, g + 2, idx0, idx1, g0, g1, u0, u1, lane);
            gather_compute(bb, hv, acc, lane);
        }
        if (act) {
            const float* g2 = p.MOD + (size_t)(l * 2 + (t >= CTX ? 1 : 0)) * 6 * D_MODEL + 5 * D_MODEL + lane * 16;
            float* xp = p.X + (size_t)t * D_MODEL + lane * 16;
#pragma unroll
            for (int c = 0; c < 4; ++c) {
                float4 x = *(float4*)(xp + c * 4);
                x.x += g2[c * 4 + 0] * acc[c * 4 + 0]; x.y += g2[c * 4 + 1] * acc[c * 4 + 1]; x.z += g2[c * 4 + 2] * acc[c * 4 + 2]; x.w += g2[c * 4 + 3] * acc[c * 4 + 3];
                *(float4*)(xp + c * 4) = x;
            }
        }
    }
}

__device__ __forceinline__ void phase_final(const P& p) {
    const int lane = otid() & 63;
    const int gw = (obid() * NTHREADS + otid()) >> 6, nw = (gridDim.x * NTHREADS) >> 6;
    const float* g = p.in[I_FG];
    for (int t = gw; t < SEQ; t += nw) {
        const float* x = p.X + (size_t)(CTX + t) * D_MODEL;
        float v[D_MODEL / 64]; float ss = 0.f;
#pragma unroll
        for (int j = 0; j < D_MODEL / 64; ++j) { v[j] = x[lane + 64 * j]; ss += v[j] * v[j]; }
        ss = wave_sum(ss);
        float rstd = rsqrtf(ss / D_MODEL + 1e-6f);
#pragma unroll
        for (int j = 0; j < D_MODEL / 64; ++j) p.out[(size_t)t * D_MODEL + lane + 64 * j] = v[j] * rstd * g[lane + 64 * j];
    }
}

__global__ void __launch_bounds__(NTHREADS) fwd_megakernel(P p_arg) {
#ifdef EMU
    char* smem = emu_smem();
#else
    __shared__ __attribute__((aligned(16))) char smem_raw[SMEM_BYTES + 16];
    char* smem = smem_raw;
#endif
#ifndef EMU
    volatile LAS unsigned* xst = (volatile LAS unsigned*)(smem_raw + SMEM_BYTES);
    if (threadIdx.x == 0) { xst[0] = 0u; xst[1] = 0u; xst[2] = 0u; xst[3] = 0u; }
    __syncthreads();
    XcdBarrier xb = xcd_barrier_post(p_arg.bar, xst);
#endif
    { LOADP(); phase_init(p, smem); }
#ifndef EMU
    cg::this_grid().sync();
#endif
    GRID_SYNC();
    PROBE_INIT();
    for (int l = 0; l < DEPTH; ++l) {
        { LOADP(); phase_norm(p, l, 0); }
        { LOADP(); phase_s5const(p, l); }
        { LOADP(); phase_convert_weights(p, l, smem); }
        GRID_SYNC(); PROBE_AFTER(0);
        { LOADP(); phase_gemm_in(p, l, smem); }
        GRID_SYNC(); PROBE_AFTER(1);
        { LOADP(); phase_rwkv_prep1(p, l); }
        GRID_SYNC(); PROBE_AFTER(14);
        { LOADP(); phase_rwkv_prep2(p, l, smem); }
        GRID_SYNC(); PROBE_AFTER(2);
        { LOADP(); for (int job = obid(); job < 2 * NC * RH; job += gridDim.x) rwkv_chunk_job(p, job, smem); }
        __syncthreads();
        { LOADP(); phase_gla_kv(p, l, smem); }
        { LOADP(); phase_s5_pass(p, l, smem, false); }
        GRID_SYNC(); PROBE_AFTER(3);
        {
            LOADP();
            const int n_rw = 2 * RH, n_gla = 2 * GH * 8192 / NTHREADS, n_s5 = (2 * SG * 64 + NTHREADS - 1) / NTHREADS;
            for (int job = obid(); job < n_rw + n_gla + n_s5 + PEER_CONV_JOBS; job += gridDim.x) {
                if (job < n_rw) rwkv_seq_job(p, job, smem);
                else if (job < n_rw + n_gla) gla_scan_job(p, job - n_rw);
                else if (job < n_rw + n_gla + n_s5) s5_carry_job(p, job - n_rw - n_gla);
                else peer_conv_job(p, l, job - n_rw - n_gla - n_s5);
            }
        }
        GRID_SYNC(); PROBE_AFTER(4);
        { LOADP(); for (int job = obid(); job < 2 * NC * RH; job += gridDim.x) rwkv_out_job(p, job); }
        { LOADP(); phase_gla_out(p, l, smem); }
        { LOADP(); phase_s5_pass(p, l, smem, true); }
        GRID_SYNC(); PROBE_AFTER(5);
        { LOADP(); phase_side_elem(p, l); }
        GRID_SYNC(); PROBE_AFTER(6);
        { LOADP(); phase_side_gemm(p, l, smem); }
        GRID_SYNC(); PROBE_AFTER(7);
        { LOADP(); phase_merge(p, l, smem); }
        GRID_SYNC(); PROBE_AFTER(8);
        { LOADP(); phase_outproj(p, l, smem); }
        GRID_SYNC(); PROBE_AFTER(9);
        { LOADP(); phase_norm(p, l, 1); }
        GRID_SYNC(); PROBE_AFTER(10);
        { LOADP(); phase_peer_q(p, l, smem); }
        GRID_SYNC(); PROBE_AFTER(11);
        { LOADP(); phase_peer_topk(p, l, smem); }
        GRID_SYNC(); PROBE_AFTER(12);
        { LOADP(); phase_peer_gather(p, l); }
        GRID_SYNC(); PROBE_AFTER(13);
    }
    { LOADP(); phase_final(p); }
}

static inline size_t align_up(size_t x) { return (x + 255) & ~(size_t)255; }

extern "C" void kernel_launch(void* const* d_in, const int* in_sizes, int n_in, void* d_out, int out_size, void* d_ws, size_t ws_size, hipStream_t stream) {
    P p;
    memset(&p, 0, sizeof(p));
    for (int i = 0; i < 39; ++i) p.in[i] = (const float*)d_in[i];
    p.out = (float*)d_out;
    char* w = (char*)d_ws; size_t off = 0;
    auto take = [&](size_t bytes) { void* r = w + off; off = align_up(off + bytes); return r; };
    p.bar = (unsigned*)take(16384);
    p.X = (float*)take((size_t)MTOT * D_MODEL * 4);
    p.H = (bf16_t*)take((size_t)MTOT * D_MODEL * 2);
    p.MOD = (float*)take((size_t)DEPTH * 2 * 6 * D_MODEL * 4);
    p.Z = (bf16_t*)take((size_t)MTOT * D_IN * 2);
    p.V = (bf16_t*)take((size_t)MTOT * RW * 2);
    {
        char* ra = (char*)take((size_t)MTOT * RW * 2 * 2 > (size_t)MTOT * GLA_V * 4 ? (size_t)MTOT * RW * 2 * 2 : (size_t)MTOT * GLA_V * 4);
        p.R = (bf16_t*)ra; p.KK = (bf16_t*)(ra + (size_t)MTOT * RW * 2);
        p.OGLA = (float*)ra;
    }
    {
        char* rb = (char*)take((size_t)2 * MTOT * RW * 2 > (size_t)3 * MTOT * PH * 16 * 4 ? (size_t)2 * MTOT * RW * 2 : (size_t)3 * MTOT * PH * 16 * 4);
        p.KD = (bf16_t*)rb;
        p.IDX = (int*)rb; p.G = (float*)(rb + (size_t)MTOT * PH * 16 * 4); p.GU = (float*)(rb + (size_t)2 * MTOT * PH * 16 * 4);
    }
    p.BB = (bf16_t*)take((size_t)2 * MTOT * RW * 2);
    p.LW = (float*)take((size_t)2 * MTOT * RW * 4);
    p.SP = (bf16_t*)p.LW;
    static_assert((size_t)2 * NC * GH * 8192 * 2 <= (size_t)2 * MTOT * RW * 4, "SP alias");
    p.BONUS = (float*)take((size_t)2 * MTOT * RH * 4);
    p.KS = (bf16_t*)take((size_t)MTOT * RW * 2);
    p.LR = (bf16_t*)take((size_t)MTOT * 256 * 2);
    p.WT_W2 = (bf16_t*)take((size_t)2 * NPAD(RW) * 64 * 2);
    p.WT_A2 = (bf16_t*)take((size_t)2 * NPAD(RW) * 64 * 2);
    p.GS = (bf16_t*)take((size_t)MTOT * 128 * 2);
    p.Y = (float*)take((size_t)2 * MTOT * RW * 4);
    p.KV = (float*)take((size_t)2 * NC * GH * 8192 * 4);
    p.DEC = (float*)take((size_t)2 * NC * GH * 64 * 4);
    p.S5A = (float*)take((size_t)2 * SG * 64 * 2 * 4);
    p.S5BB = (float*)take((size_t)2 * SG * 64 * 16 * 2 * 4);
    p.S5END = (float*)take((size_t)2 * NC * SG * 64 * 2 * 4);
    p.S5CAR = (float*)take((size_t)2 * NC * SG * 64 * 2 * 4);
    {
        const size_t szc1 = (size_t)2 * NC * RH * SEQ_REC;
        const size_t szc2 = (size_t)MTOT * SW * 2 + (size_t)MTOT * RW * 4 + (size_t)MTOT * 3 * BW * 2 + (size_t)MTOT * D_MODEL * 2 + 1024;
        char* rc = (char*)take(szc1 > szc2 ? szc1 : szc2);
        p.REC = rc;
        char* c2 = rc;
        p.GY = (bf16_t*)c2; c2 += align_up((size_t)MTOT * SW * 2);
        p.YN = (float*)c2; c2 += align_up((size_t)MTOT * RW * 4);
        p.BR = (bf16_t*)c2; c2 += align_up((size_t)MTOT * 3 * BW * 2);
        p.M = (bf16_t*)c2;
    }
    p.SN = (bf16_t*)take((size_t)2 * NC * RH * 4096 * 2);
    p.QH = (bf16_t*)take((size_t)2 * NC * RH * 4096 * 2);
    p.WT_IN = (bf16_t*)take((size_t)NPAD(D_IN) * D_MODEL * 2);
    p.WT_G2 = (bf16_t*)take((size_t)NPAD(RW) * 128 * 2);
    p.WT_GLU = (bf16_t*)take((size_t)NPAD(2 * SW) * SW * 2);
    p.WT_BR = (bf16_t*)take((size_t)3 * D_MODEL * BW * 2);
    p.WT_OUT = (bf16_t*)take((size_t)D_MODEL * D_MODEL * 2);
    p.WT_Q = (bf16_t*)take((size_t)PQ * D_MODEL * 2);
    p.U8 = (unsigned char*)take((size_t)NEXP * D_MODEL);
    p.V8 = (unsigned char*)take((size_t)NEXP * D_MODEL);
    p.USC = (float*)take((size_t)NEXP * 4); p.VSC = (float*)take((size_t)NEXP * 4);
    p.QHI = p.Z; p.QLO = p.Z + (size_t)MTOT * PQ;
    p.KHI = (bf16_t*)take((size_t)PH * 2 * 128 * 128 * 2); p.KLO = (bf16_t*)take((size_t)PH * 2 * 128 * 128 * 2);
    static_assert((size_t)PQ * 4 <= (size_t)D_IN * 2, "Q alias");
    if (off > ws_size) { fprintf(stderr, "ws too small: need %zu have %zu\n", off, ws_size); return; }
#ifdef EMU
    fprintf(stderr, "ws used %zu MB\n", off >> 20);
    emu_launch([=] { fwd_megakernel(p); }, EMU_GRID, NTHREADS);
#else
    hipMemsetAsync(p.bar, 0, 16384, stream);
    static int grid_blocks = 0;
    if (!grid_blocks) {
        int dev = 0, cus = 0, per_cu = 0;
        hipGetDevice(&dev);
        hipDeviceGetAttribute(&cus, hipDeviceAttributeMultiprocessorCount, dev);
        hipOccupancyMaxActiveBlocksPerMultiprocessor(&per_cu, fwd_megakernel, NTHREADS, 0);
        if (per_cu > 1) per_cu = 1;
        grid_blocks = cus * per_cu;
    }
    void* args[] = {&p};
    hipError_t e = hipLaunchCooperativeKernel((void*)fwd_megakernel, dim3(grid_blocks), dim3(NTHREADS), args, 0, stream);
    if (e != hipSuccess) fprintf(stderr, "cooperative launch failed: %s (grid %d)\n", hipGetErrorString(e), grid_blocks);
#endif
}
```

```cpp
#include <hip/hip_runtime.h>
#ifndef EMU
#include <hip/hip_cooperative_groups.h>
namespace cg = cooperative_groups;
#endif
#include <cstdio>
#include <cstdint>
#include <cstring>
#include <type_traits>

#ifdef CFG_SMALL
#define D_MODEL 128
#define SEQ 640
#define DEPTH 2
#define GRID_W 10
#define CTX 128
#define GH 1
#define RH 2
#define SG 8
#define PH 2
#else
#define D_MODEL 1024
#define SEQ 16384
#define DEPTH 4
#define GRID_W 64
#define CTX 256
#define GH 4
#define RH 8
#define SG 32
#define PH 8
#endif
#define MTOT (CTX + SEQ)
#define ROWS (SEQ / GRID_W)
#define GLA_K (GH * 64)
#define GLA_V (GH * 128)
#define RW (RH * 64)
#define RWKV_IN (3 * RW + 4 * 64 + 128)
#define SW (SG * 16)
#define BW GLA_V
#define ZQ 0
#define ZK (GLA_K)
#define ZV (2 * GLA_K)
#define ZOG (ZV + GLA_V)
#define ZAF (ZOG + GLA_V)
#define ZAB (ZAF + 16)
#define ZR (ZAB + 16)
#define ZS5 (ZR + RWKV_IN)
#define ZG (ZS5 + SW)
#define D_IN (ZG + 3 * D_MODEL)
#define NC (MTOT / 64)
#define NCC (CTX / 64)
#define RB (ROWS / 64)
#define PQ (PH * 256)
#define NEXP 16384
#define NTHREADS 256
#define SMEM_BYTES 133120

typedef unsigned short bf16_t;
typedef short bf16x8 __attribute__((ext_vector_type(8)));
typedef float f32x4 __attribute__((ext_vector_type(4)));
typedef unsigned u32x4 __attribute__((ext_vector_type(4)));
typedef unsigned u32x2 __attribute__((ext_vector_type(2)));
#ifdef EMU
#define MFMA16(a, b, c) emu_mfma_16x16x32_bf16(a, b, c)
#else
#define MFMA16(a, b, c) __builtin_amdgcn_mfma_f32_16x16x32_bf16(a, b, c, 0, 0, 0)
#endif
typedef float f32x2 __attribute__((ext_vector_type(2)));
#ifdef EMU
#define CVT_PK_FP8(a, b, old, hi) emu_cvt_pk_fp8_f32(a, b, old, hi)
#define CVT_PK_F32_FP8(w, hi) emu_cvt_pk_f32_fp8(w, hi)
#else
#define CVT_PK_FP8(a, b, old, hi) __builtin_amdgcn_cvt_pk_fp8_f32(a, b, old, hi)
#define CVT_PK_F32_FP8(w, hi) __builtin_amdgcn_cvt_pk_f32_fp8(w, hi)
#endif
#ifdef EMU
#define MFMA16_ACC(a, b, c) c = emu_mfma_16x16x32_bf16(a, b, c)
#else
#define MFMA16_ACC(a, b, c) asm volatile("v_mfma_f32_16x16x32_bf16 %0, %1, %2, %0" : "+a"(c) : "v"(a), "v"(b))
#endif
#define NPAD(n) (((n) + 127) / 128 * 128)
#define NPAD192(n) (((n) + 191) / 192 * 192)

__device__ __forceinline__ float bf2f(bf16_t h) { return __builtin_bit_cast(float, ((unsigned)h) << 16); }
#ifdef EMU
__device__ __forceinline__ bf16_t f2bf(float f) { unsigned u = __builtin_bit_cast(unsigned, f); u += 0x7FFFu + ((u >> 16) & 1u); return (bf16_t)(u >> 16); }
__device__ __forceinline__ unsigned pack2bf(float a, float b) { return (unsigned)f2bf(a) | ((unsigned)f2bf(b) << 16); }
#else
typedef float f2v_t __attribute__((ext_vector_type(2))); typedef __bf16 b2v_t __attribute__((ext_vector_type(2)));
__device__ __forceinline__ bf16_t f2bf(float f) { return __builtin_bit_cast(unsigned short, (__bf16)f); }
__device__ __forceinline__ unsigned pack2bf(float a, float b) { f2v_t v = {a, b}; b2v_t r = __builtin_convertvector(v, b2v_t); return __builtin_bit_cast(unsigned, r); }
#endif
#ifdef EMU
#define fexp_(x) expf(x)
#define flog_(x) logf(x)
#else
#define fexp_(x) __expf(x)
#define flog_(x) __logf(x)
#endif
#define LO16(x) __builtin_bit_cast(float, (x) << 16)
#define HI16(x) __builtin_bit_cast(float, (x) & 0xFFFF0000u)
__device__ __forceinline__ float sigmoidf_(float x) { return 1.0f / (1.0f + fexp_(-x)); }
__device__ __forceinline__ float siluf_(float x) { return x * sigmoidf_(x); }
__device__ __forceinline__ float geluf_(float x) { const float y = 1.5957691216057308f * (x + 0.044715f * x * x * x); return x / (1.0f + fexp_(-y)); }
__device__ __forceinline__ float softplusf_(float x) { return fmaxf(x, 0.f) + flog_(1.0f + fexp_(-fabsf(x))); }
__device__ __forceinline__ float tanhf_(float x) { const float e = fexp_(-2.0f * fabsf(x)); const float t = (1.0f - e) / (1.0f + e); return x < 0.f ? -t : t; }
__device__ __forceinline__ float wave_sum(float v) {
#pragma unroll
    for (int m = 32; m >= 1; m >>= 1) v += __shfl_xor(v, m, 64);
    return v;
}

struct P {
    const float* in[39];
    float* out;
    float* X;
    bf16_t* H;
    bf16_t* Z;
    float* MOD;
    bf16_t* R; bf16_t* V; bf16_t* KK; bf16_t* KD; bf16_t* BB;
    float* LW;
    char* REC;
    bf16_t* SN;
    bf16_t* QH;
    float* BONUS;
    bf16_t* KS;
    bf16_t* LR;
    bf16_t* WT_W2;
    bf16_t* WT_A2;
    bf16_t* GS;
    float* Y;
    float* KV;
    bf16_t* SP;
    float* DEC;
    float* OGLA;
    float* S5A;
    float* S5BB;
    float* S5END;
    float* S5CAR;
    bf16_t* GY;
    float* YN;
    bf16_t* BR;
    bf16_t* M;
    bf16_t* QHI; bf16_t* QLO;
    bf16_t* KHI; bf16_t* KLO;
    int* IDX;
    float* G;
    float* GU;
    unsigned* bar;
    bf16_t* WT_IN;
    bf16_t* WT_G2;
    bf16_t* WT_GLU;
    bf16_t* WT_BR;
    bf16_t* WT_OUT;
    bf16_t* WT_Q;
    unsigned char* U8; unsigned char* V8;
    float* USC; float* VSC;
};

enum { I_X = 0, I_C, I_CTX, I_CCTX, I_WMOD, I_BMOD, I_N1G, I_N2G, I_WIN, I_GLA_WA2, I_GLA_BA, I_GLA_NG, I_RCONV, I_RW0, I_RW2, I_RA0, I_RA2, I_RG2,
       I_RKK, I_RKA, I_RRK, I_RLNW, I_RLNB, I_S5LRE, I_S5LIM, I_S5LS, I_S5BRE, I_S5BIM, I_S5CRE, I_S5CIM, I_S5D, I_S5GLU, I_WBR, I_WOUT, I_PWQ, I_PKEYS, I_PU, I_PV, I_FG };

#ifdef EMU
__device__ __forceinline__ int otid() { return threadIdx.x; }
__device__ __forceinline__ int obid() { return blockIdx.x; }
#else
__device__ __forceinline__ int otid() { int t = threadIdx.x; asm volatile("" : "+v"(t)); return t; }
__device__ __forceinline__ int obid() { int b = blockIdx.x; asm volatile("" : "+s"(b)); return b; }
#endif
#ifdef EMU
#define WAVE_SYNC() emu_wave_barrier()
#ifndef EMU_GRID
#define EMU_GRID 4
#endif
#else
#define WAVE_SYNC() __builtin_amdgcn_wave_barrier()
#endif
#ifndef EMU
#define XB_TMO      128
#define XB_XCNT(j)  (256  + 64 * (j))
#define XB_XSUB(j)  (1280 + 64 * (j))
#define XB_XGEN(j)  (2304 + 64 * (j))
#define XB_TOP      3328
#define XB_TOPGEN   3392
#define XCD_BAR_WORDS 3456
#define XB_SPIN_CAP (1u << 22)
#define LAS __attribute__((address_space(3)))
__device__ __forceinline__ unsigned xb_ld(unsigned* p)              { return __hip_atomic_load(p, __ATOMIC_RELAXED, __HIP_MEMORY_SCOPE_AGENT); }
__device__ __forceinline__ unsigned xb_add(unsigned* p, unsigned v) { return __hip_atomic_fetch_add(p, v, __ATOMIC_RELAXED, __HIP_MEMORY_SCOPE_AGENT); }
__device__ __forceinline__ unsigned xb_xcc_id() { return (unsigned)__builtin_amdgcn_s_getreg((3 << 11) | 20) & 0xFu; }
#define XB_SPIN(cond, bar) do { unsigned _sp = 0; while (cond) { __builtin_amdgcn_s_sleep(1); \
    if ((++_sp & 255u) == 0u) { if (xb_ld(&(bar)[XB_TMO])) break; if (_sp > XB_SPIN_CAP) { atomicAdd(&(bar)[XB_TMO], 1u); break; } } } } while (0)
struct XcdBarrier { unsigned* bar; unsigned x; volatile LAS unsigned* st; };
__device__ __forceinline__ XcdBarrier xcd_barrier_post(unsigned* bar, volatile LAS unsigned* st) {
    XcdBarrier b; b.bar = bar; b.x = xb_xcc_id(); b.st = st;
    if (threadIdx.x == 0) (void)xb_add(&bar[XB_XCNT(b.x)], 1u);
    return b;
}
__device__ __forceinline__ void xcd_barrier_complete(unsigned* bar, unsigned x, unsigned& nloc, unsigned& nx) {
    const unsigned G = gridDim.x * gridDim.y * gridDim.z;
    unsigned sum, cnt, mine, sp = 0u;
    for (;;) {
        sum = 0u; cnt = 0u; mine = 0u;
#pragma unroll
        for (unsigned j = 0; j < 16; ++j) { const unsigned c = xb_ld(&bar[XB_XCNT(j)]); sum += c; cnt += (c > 0u) ? 1u : 0u; mine = (j == x) ? c : mine; }
        if (sum == G) break;
        __builtin_amdgcn_s_sleep(1);
        if ((++sp & 255u) == 0u) { if (xb_ld(&bar[XB_TMO])) break; if (sp > XB_SPIN_CAP) { atomicAdd(&bar[XB_TMO], 1u); break; } }
    }
    nloc = mine > 0u ? mine : 1u; nx = cnt > 0u ? cnt : 1u;
}
__device__ __forceinline__ void xcd_barrier(const XcdBarrier& b) {
    asm volatile("s_waitcnt vmcnt(0)" ::: "memory");
    __syncthreads();
    if (threadIdx.x == 0) {
        unsigned* bar = b.bar;
        __builtin_amdgcn_s_waitcnt(0);
        unsigned nloc = b.st[0], nx = b.st[1];
        if (nloc == 0u) { xcd_barrier_complete(bar, b.x, nloc, nx); b.st[0] = nloc; b.st[1] = nx; }
        const unsigned old = xb_add(&bar[XB_XSUB(b.x)], 1u);
        const unsigned gen = old / nloc;
        if (old + 1u == (gen + 1u) * nloc) {
            __builtin_amdgcn_fence(__ATOMIC_RELEASE, "agent");
            asm volatile("s_waitcnt vmcnt(0)" ::: "memory");
            const unsigned og = xb_add(&bar[XB_TOP], 1u);
            const unsigned tg = og / nx;
            if (og + 1u == (tg + 1u) * nx) xb_add(&bar[XB_TOPGEN], 1u);
            else XB_SPIN(xb_ld(&bar[XB_TOPGEN]) == tg, bar);
            __builtin_amdgcn_fence(__ATOMIC_ACQUIRE, "agent");
            xb_add(&bar[XB_XGEN(b.x)], 1u);
            asm volatile("s_waitcnt vmcnt(0)" ::: "memory");
        } else {
            XB_SPIN(xb_ld(&bar[XB_XGEN(b.x)]) == gen, bar);
            __builtin_amdgcn_fence(__ATOMIC_ACQUIRE, "agent");
            asm volatile("s_waitcnt vmcnt(0)" ::: "memory");
        }
    }
    __syncthreads();
}
#define GRID_SYNC() xcd_barrier(xb)
#else
#define GRID_SYNC() emu_grid_sync()
#endif

#ifdef EMU
#define LOADP() const P& p = p_arg
#else
typedef __attribute__((address_space(4))) const unsigned long long cu64_t;
__device__ __forceinline__ void load_params(P& p) {
    cu64_t* q = (cu64_t*)__builtin_amdgcn_kernarg_segment_ptr();
    asm volatile("" : "+s"(q));
    unsigned long long w[sizeof(P) / 8];
#pragma unroll
    for (int i = 0; i < (int)(sizeof(P) / 8); ++i) w[i] = q[i];
    __builtin_memcpy(&p, w, sizeof(P));
}
#define LOADP() P p; load_params(p)
#endif
#define PROBE_MULT 3
#if defined(PROBE_ID) && !defined(EMU)
#define PROBE_INIT() unsigned long long probe_t0 = wall_clock64()
#define PROBE_AFTER(id) { if (blockIdx.x == 0) { unsigned long long now_ = wall_clock64(); if ((id) == PROBE_ID) { const unsigned long long dt_ = now_ - probe_t0; \
    while (wall_clock64() - now_ < dt_ * PROBE_MULT) __builtin_amdgcn_s_sleep(8); now_ = wall_clock64(); } probe_t0 = now_; } }
#else
#define PROBE_INIT()
#define PROBE_AFTER(id)
#endif
__device__ __forceinline__ int gla_tok(int n, int i) {
    if (n < NCC) return n * 64 + i;
    int m = n - NCC; int col = m / RB, rb = m % RB;
    return CTX + (rb * 64 + i) * GRID_W + col;
}
__device__ __forceinline__ int chunk_order(int d, int s) {
    if (d == 0) return s;
    return (s < NCC) ? (NCC - 1 - s) : (NC - 1 - (s - NCC));
}
__device__ __forceinline__ int tok_order(int d, int s) {
    if (d == 0) return s;
    return (s < CTX) ? (CTX - 1 - s) : (MTOT - 1 - (s - CTX));
}


#define LDS_ROW 72
__device__ __forceinline__ void mfma_gemm_tile(const bf16_t* Wt, int ldw, const bf16_t* Act, int lda, int K, int n0, int m0, bf16_t* lds, f32x4 (&acc)[4][4]) {
    bf16_t* Ws = lds; bf16_t* As = lds + 128 * LDS_ROW;
    const int tid = otid(), lane = tid & 63, wave = tid >> 6, wn = wave >> 1, wm = wave & 1;
    const int lrow = tid >> 3, lkc = (tid & 7) * 8;
    u32x4 pw[4], pa[4];
#pragma unroll
    for (int i = 0; i < 4; ++i) {
        pw[i] = *(const u32x4*)(Wt + (size_t)(n0 + lrow + 32 * i) * ldw + lkc);
        pa[i] = *(const u32x4*)(Act + (size_t)(m0 + lrow + 32 * i) * lda + lkc);
    }
    for (int k0 = 0; k0 < K; k0 += 64) {
        __syncthreads();
#pragma unroll
        for (int i = 0; i < 4; ++i) {
            *(u32x4*)(Ws + (lrow + 32 * i) * LDS_ROW + lkc) = pw[i];
            *(u32x4*)(As + (lrow + 32 * i) * LDS_ROW + lkc) = pa[i];
        }
        __syncthreads();
        if (k0 + 64 < K) {
#pragma unroll
            for (int i = 0; i < 4; ++i) {
                pw[i] = *(const u32x4*)(Wt + (size_t)(n0 + lrow + 32 * i) * ldw + k0 + 64 + lkc);
                pa[i] = *(const u32x4*)(Act + (size_t)(m0 + lrow + 32 * i) * lda + k0 + 64 + lkc);
            }
        }
#pragma unroll
        for (int ks = 0; ks < 2; ++ks) {
            bf16x8 a[4], b[4];
#pragma unroll
            for (int i = 0; i < 4; ++i) {
                a[i] = *(const bf16x8*)(Ws + (wn * 64 + i * 16 + (lane & 15)) * LDS_ROW + ks * 32 + (lane >> 4) * 8);
                b[i] = *(const bf16x8*)(As + (wm * 64 + i * 16 + (lane & 15)) * LDS_ROW + ks * 32 + (lane >> 4) * 8);
            }
#pragma unroll
            for (int ni = 0; ni < 4; ++ni)
#pragma unroll
                for (int mi = 0; mi < 4; ++mi) acc[ni][mi] = MFMA16(a[ni], b[mi], acc[ni][mi]);
        }
    }
}
#define L32_ROW 40
#ifdef EMU
struct BufRsrc { const char* base; };
__device__ __forceinline__ BufRsrc make_rsrc(const void* p, size_t) { BufRsrc r; r.base = (const char*)p; return r; }
__device__ __forceinline__ u32x4 buf_load16(const BufRsrc& r, unsigned voff, unsigned soff) { return *(const u32x4*)(r.base + voff + soff); }
#else
typedef __amdgpu_buffer_rsrc_t BufRsrc;
__device__ __forceinline__ BufRsrc make_rsrc(const void* p, size_t bytes) { return __builtin_amdgcn_make_buffer_rsrc((void*)p, 0, (int)bytes, 0x00020000); }
__device__ __forceinline__ u32x4 buf_load16(const BufRsrc& r, unsigned voff, unsigned soff) { return __builtin_bit_cast(u32x4, __builtin_amdgcn_raw_buffer_load_b128(r, voff, soff, 0)); }
#endif
template <int NI, int MI>
__device__ __forceinline__ void mfma_gemm_tile_t(const bf16_t* Wt, int ldw, size_t wbytes, const bf16_t* Act, int lda, size_t abytes, int K, int n0, int m0, bf16_t* lds, f32x4 (&acc)[NI][MI]) {
    constexpr int WR = 32 * NI, AR = 32 * MI, BUF = (WR + AR) * L32_ROW;
    const int tid = otid(), lane = tid & 63, wave = tid >> 6, wn = wave >> 1, wm = wave & 1;
    const int lrow = tid >> 2, lkc = (tid & 3) * 8;
    const BufRsrc rw = make_rsrc(Wt, wbytes), ra = make_rsrc(Act, abytes);
    unsigned vw[NI / 2], va[MI / 2];
#pragma unroll
    for (int i = 0; i < NI / 2; ++i) vw[i] = (unsigned)(((size_t)(n0 + lrow + 64 * i) * ldw + lkc) * 2);
#pragma unroll
    for (int i = 0; i < MI / 2; ++i) va[i] = (unsigned)(((size_t)(m0 + lrow + 64 * i) * lda + lkc) * 2);
    u32x4 qw0[NI / 2], qa0[MI / 2], qw1[NI / 2], qa1[MI / 2];
    const int nk = K / 32;
#define GT_LOAD(QW, QA, KT) { const unsigned so_ = (unsigned)(((KT) < nk) ? (KT) : (nk - 1)) * 64u; \
    _Pragma("unroll") for (int i = 0; i < NI / 2; ++i) QW[i] = buf_load16(rw, vw[i], so_); \
    _Pragma("unroll") for (int i = 0; i < MI / 2; ++i) QA[i] = buf_load16(ra, va[i], so_); }
#define GT_STORE(QW, QA, DST) { \
    _Pragma("unroll") for (int i = 0; i < NI / 2; ++i) *(u32x4*)((DST) + (lrow + 64 * i) * L32_ROW + lkc) = QW[i]; \
    _Pragma("unroll") for (int i = 0; i < MI / 2; ++i) *(u32x4*)((DST) + (WR + lrow + 64 * i) * L32_ROW + lkc) = QA[i]; }
#define GT_COMPUTE(CUR) { bf16x8 b[MI], a[NI]; \
    _Pragma("unroll") for (int i = 0; i < MI; ++i) b[i] = *(const bf16x8*)((CUR) + (WR + wm * 16 * MI + i * 16 + (lane & 15)) * L32_ROW + (lane >> 4) * 8); \
    _Pragma("unroll") for (int i = 0; i < NI; ++i) a[i] = *(const bf16x8*)((CUR) + (wn * 16 * NI + i * 16 + (lane & 15)) * L32_ROW + (lane >> 4) * 8); \
    _Pragma("unroll") for (int ni = 0; ni < NI; ++ni) { \
        _Pragma("unroll") for (int mi = 0; mi < MI; ++mi) MFMA16_ACC(a[ni], b[mi], acc[ni][mi]); } }
    GT_LOAD(qw0, qa0, 0)
    GT_LOAD(qw1, qa1, 1)
    __syncthreads();
    GT_STORE(qw0, qa0, lds)
    GT_LOAD(qw0, qa0, 2)
    __syncthreads();
    for (int kt = 0; kt < nk; kt += 2) {
        GT_COMPUTE(lds)
        GT_STORE(qw1, qa1, lds + BUF)
        GT_LOAD(qw1, qa1, kt + 3)
        __syncthreads();
        GT_COMPUTE(lds + BUF)
        GT_STORE(qw0, qa0, lds)
        GT_LOAD(qw0, qa0, kt + 4)
        __syncthreads();
    }
#undef GT_LOAD
#undef GT_STORE
#undef GT_COMPUTE
}
#define ZERO_ACC4(acc) { _Pragma("unroll") for (int i_ = 0; i_ < 4; ++i_) _Pragma("unroll") for (int j_ = 0; j_ < 4; ++j_) acc[i_][j_] = (f32x4){0.f, 0.f, 0.f, 0.f}; }
#define FOR_ACC(acc, n0, m0, BODY) { const int lane_ = otid() & 63, wave_ = otid() >> 6; \
    _Pragma("unroll") for (int ni_ = 0; ni_ < 4; ++ni_) _Pragma("unroll") for (int mi_ = 0; mi_ < 4; ++mi_) { \
        const int n = (n0) + (wave_ >> 1) * 64 + ni_ * 16 + (lane_ >> 4) * 4; const int m = (m0) + (wave_ & 1) * 64 + mi_ * 16 + (lane_ & 15); const f32x4 v = acc[ni_][mi_]; BODY } }
__device__ __forceinline__ u32x2 pack4(float a, float b, float c, float d) { u32x2 r; r.x = pack2bf(a, b); r.y = pack2bf(c, d); return r; }

__device__ __forceinline__ void convert_wt_job(const float* W, int K, int N, int Npad, bf16_t* out, int job, float* T, int ilv) {
    const int tid = otid();
    const int nkt = K / 64;
    const int n0 = (job / nkt) * 64, k0 = (job % nkt) * 64;
    __syncthreads();
    for (int idx = tid; idx < 4096; idx += NTHREADS) {
        int kk = idx >> 6, nn = idx & 63;
        int nr = n0 + nn; int src = ilv ? ((nr & 1) ? (N / 2 + (nr >> 1)) : (nr >> 1)) : nr;
        T[kk * 65 + nn] = (nr < N) ? W[(size_t)(k0 + kk) * N + src] : 0.f;
    }
    __syncthreads();
    {
        int nn = tid >> 2, part = tid & 3;
        unsigned w[8];
#pragma unroll
        for (int j = 0; j < 8; ++j) w[j] = pack2bf(T[(part * 16 + 2 * j) * 65 + nn], T[(part * 16 + 2 * j + 1) * 65 + nn]);
        u32x4* o = (u32x4*)(out + (size_t)(n0 + nn) * K + k0 + part * 16);
        o[0] = (u32x4){w[0], w[1], w[2], w[3]}; o[1] = (u32x4){w[4], w[5], w[6], w[7]};
    }
}
__device__ __forceinline__ void phase_convert_weights(const P& p, int l, char* smem) {
    float* T = (float*)smem;
    struct Item { const float* W; int K, N, Npad; bf16_t* out; };
    const Item items[12] = {
        {p.in[I_RW2] + ((size_t)l * 2 + 0) * 64 * RW, 64, RW, NPAD(RW), p.WT_W2},
        {p.in[I_RW2] + ((size_t)l * 2 + 1) * 64 * RW, 64, RW, NPAD(RW), p.WT_W2 + (size_t)NPAD(RW) * 64},
        {p.in[I_RA2] + ((size_t)l * 2 + 0) * 64 * RW, 64, RW, NPAD(RW), p.WT_A2},
        {p.in[I_RA2] + ((size_t)l * 2 + 1) * 64 * RW, 64, RW, NPAD(RW), p.WT_A2 + (size_t)NPAD(RW) * 64},
        {p.in[I_WIN] + (size_t)l * D_MODEL * D_IN, D_MODEL, D_IN, NPAD192(D_IN), p.WT_IN},
        {p.in[I_RG2] + (size_t)l * 128 * RW, 128, RW, RW, p.WT_G2},
        {p.in[I_S5GLU] + (size_t)l * SW * 2 * SW, SW, 2 * SW, 2 * SW, p.WT_GLU},
        {p.in[I_WBR] + ((size_t)l * 3 + 0) * BW * D_MODEL, BW, D_MODEL, D_MODEL, p.WT_BR},
        {p.in[I_WBR] + ((size_t)l * 3 + 1) * BW * D_MODEL, BW, D_MODEL, D_MODEL, p.WT_BR + (size_t)D_MODEL * BW},
        {p.in[I_WBR] + ((size_t)l * 3 + 2) * BW * D_MODEL, BW, D_MODEL, D_MODEL, p.WT_BR + (size_t)2 * D_MODEL * BW},
        {p.in[I_WOUT] + (size_t)l * D_MODEL * D_MODEL, D_MODEL, D_MODEL, D_MODEL, p.WT_OUT},
        {p.in[I_PWQ] + (size_t)l * D_MODEL * PQ, D_MODEL, PQ, PQ, p.WT_Q}};
    int base = 0;
#pragma unroll
    for (int it = 0; it < 12; ++it) {
        const int nj = (items[it].Npad / 64) * (items[it].K / 64);
        for (int j = (int)((obid() + gridDim.x - (base % gridDim.x)) % gridDim.x); j < nj; j += gridDim.x)
            convert_wt_job(items[it].W, items[it].K, items[it].N, items[it].Npad, items[it].out, j, T, it == 6);
        base += nj;
    }
    __syncthreads();
    {
        const float* ks = p.in[I_PKEYS] + (size_t)l * PH * 2 * 128 * 128;
        for (size_t i = (size_t)obid() * NTHREADS + otid(); i < (size_t)PH * 2 * 128 * 128; i += (size_t)gridDim.x * NTHREADS) {
            const float v = ks[i]; const bf16_t hb = f2bf(v);
            p.KHI[i] = hb; p.KLO[i] = f2bf(v - bf2f(hb));
        }
    }
}

__device__ __forceinline__ bool tile_map(int it, int ntm, int ntn, int PM, int& mt, int& nt) {
    const int b = obid(); const int G = gridDim.x;
    long id;
    if ((G & 7) == 0) { const int x = b & 7, slot = b >> 3, spx = G >> 3; id = ((long)it * 8 + x) * spx + slot; }
    else id = (long)it * G + b;
    if (id >= (long)ntm * ntn) return false;
    const int full = ntm / PM; const long fullsz = (long)full * PM * ntn;
    if (id < fullsz) { const int p = (int)(id / (PM * ntn)), rem = (int)(id % (PM * ntn)); nt = rem / PM; mt = p * PM + rem % PM; }
    else { const int rem = (int)(id - fullsz), hh = ntm - full * PM; nt = rem / hh; mt = full * PM + rem % hh; }
    return true;
}

template <int NI, int MI, class Pre, class Post>
__device__ __forceinline__ void gemm_tile_run(const bf16_t* Wt, int ldw, size_t wbytes, const bf16_t* Act, int lda, size_t abytes, int K, int n0, int m0, bf16_t* lds, Pre pre, Post post) {
    f32x4 acc[NI][MI];
#pragma unroll
    for (int i = 0; i < NI; ++i)
#pragma unroll
        for (int j = 0; j < MI; ++j) acc[i][j] = (f32x4){0.f, 0.f, 0.f, 0.f};
    pre(m0, n0, acc, lds);
    mfma_gemm_tile_t<NI, MI>(Wt, ldw, wbytes, Act, lda, abytes, K, n0, m0, lds, acc);
    const int lane = otid() & 63, wave = otid() >> 6;
#pragma unroll
    for (int ni = 0; ni < NI; ++ni)
#pragma unroll
        for (int mi = 0; mi < MI; ++mi)
            post(ni, mi, m0 + (wave & 1) * 16 * MI + mi * 16 + (lane & 15), n0 + (wave >> 1) * 16 * NI + ni * 16 + (lane >> 4) * 4, acc[ni][mi]);
}
struct NoPre { template <class A> __device__ __forceinline__ void operator()(int, int, A&, bf16_t*) const {} };
template <int NI, class PreM, class PreT, class Post>
__device__ __forceinline__ void gemm_phase(const bf16_t* Wt, int ldw, size_t wbytes, const bf16_t* Act, int lda, size_t abytes, int K, int N, bf16_t* lds, PreM prem, PreT pret, Post post) {
    const int ntn = N / (32 * NI), ntm = MTOT / 256 - 1;
    const int PM = (ntn >= 16) ? 2 : ((ntn >= 8) ? 4 : 8);
    for (int it = 0;; ++it) {
        int mt_, nt_; if (!tile_map(it, ntm, ntn, PM, mt_, nt_)) break;
        gemm_tile_run<NI, 8>(Wt, ldw, wbytes, Act, lda, abytes, K, nt_ * 32 * NI, mt_ * 256, lds, prem, post);
    }
    for (int job = obid(); job < 4 * ntn; job += gridDim.x)
        gemm_tile_run<NI, 2>(Wt, ldw, wbytes, Act, lda, abytes, K, (job >> 2) * 32 * NI, MTOT - 256 + (job & 3) * 64, lds, pret, post);
}

__device__ __forceinline__ void phase_init(const P& p, char* smem) {
    const int tid = otid();
    float* sc = (float*)smem;
    for (int i = tid; i < D_MODEL; i += NTHREADS) { sc[i] = siluf_(p.in[I_CCTX][i]); sc[D_MODEL + i] = siluf_(p.in[I_C][i]); }
    __syncthreads();
    const int ncolblk = (6 * D_MODEL) / NTHREADS;
    for (int job = obid(); job < DEPTH * ncolblk; job += gridDim.x) {
        int l = job / ncolblk, n = (job % ncolblk) * NTHREADS + tid;
        const float* w = p.in[I_WMOD] + (size_t)l * D_MODEL * 6 * D_MODEL + n;
        float a0 = 0.f, a1 = 0.f;
        for (int k = 0; k < D_MODEL; ++k) { float wv = w[(size_t)k * 6 * D_MODEL]; a0 += sc[k] * wv; a1 += sc[D_MODEL + k] * wv; }
        float b = p.in[I_BMOD][l * 6 * D_MODEL + n];
        p.MOD[(size_t)(l * 2 + 0) * 6 * D_MODEL + n] = a0 + b;
        p.MOD[(size_t)(l * 2 + 1) * 6 * D_MODEL + n] = a1 + b;
    }
    const size_t gtid = (size_t)obid() * NTHREADS + tid, gn = (size_t)gridDim.x * NTHREADS;
    for (size_t i = gtid; i < (size_t)CTX * D_MODEL; i += gn) p.X[i] = p.in[I_CTX][i];
    for (size_t i = gtid; i < (size_t)SEQ * D_MODEL; i += gn) p.X[(size_t)CTX * D_MODEL + i] = p.in[I_X][i];
    __syncthreads();
}

__device__ __forceinline__ void phase_s5const(const P& p, int l) {
    const size_t gtid = (size_t)obid() * NTHREADS + otid(), gn = (size_t)gridDim.x * NTHREADS;
    for (size_t i = gtid; i < (size_t)2 * SG * 64; i += gn) {
        int d = (int)(i / (SG * 64)), g = (int)((i / 64) % SG), s = (int)(i % 64);
        size_t li = ((size_t)(l * 2 + d) * SG + g) * 64 + s;
        float lre = p.in[I_S5LRE][li], lim = p.in[I_S5LIM][li];
        float dt = expf(p.in[I_S5LS][(l * 2 + d) * SG + g]);
        float mag = expf(lre * dt);
        float are = mag * cosf(lim * dt), aim = mag * sinf(lim * dt);
        float den = lre * lre + lim * lim;
        float fre = ((are - 1.0f) * lre + aim * lim) / den;
        float fim = (aim * lre - (are - 1.0f) * lim) / den;
        p.S5A[i * 2 + 0] = are; p.S5A[i * 2 + 1] = aim;
        const float* bre = p.in[I_S5BRE] + (((size_t)l * SG + g) * 64 + s) * 16;
        const float* bim = p.in[I_S5BIM] + (((size_t)l * SG + g) * 64 + s) * 16;
        for (int c = 0; c < 16; ++c) {
            p.S5BB[(i * 16 + c) * 2 + 0] = fre * bre[c] - fim * bim[c];
            p.S5BB[(i * 16 + c) * 2 + 1] = fre * bim[c] + fim * bre[c];
        }
    }
}

__device__ __forceinline__ void phase_norm(const P& p, int l, int which) {
    const int lane = otid() & 63;
    const int gw = (obid() * NTHREADS + otid()) >> 6, nw = (gridDim.x * NTHREADS) >> 6;
    const float* g = p.in[which ? I_N2G : I_N1G] + l * D_MODEL;
    constexpr int NJ = (D_MODEL + 255) / 256;
    for (int t = gw; t < MTOT; t += nw) {
        const float* x = p.X + (size_t)t * D_MODEL;
        const float* mod = p.MOD + (size_t)(l * 2 + (t >= CTX ? 1 : 0)) * 6 * D_MODEL + (which ? 3 * D_MODEL : 0);
        float4 v[NJ]; float ss = 0.f;
#pragma unroll
        for (int j = 0; j < NJ; ++j) {
            const int e = j * 256 + lane * 4;
            if (e < D_MODEL) v[j] = *(const float4*)(x + e); else { v[j].x = 0.f; v[j].y = 0.f; v[j].z = 0.f; v[j].w = 0.f; }
            ss += v[j].x * v[j].x + v[j].y * v[j].y + v[j].z * v[j].z + v[j].w * v[j].w;
        }
        ss = wave_sum(ss);
        const float rstd = rsqrtf(ss / D_MODEL + 1e-6f);
#pragma unroll
        for (int j = 0; j < NJ; ++j) {
            const int e = j * 256 + lane * 4;
            if (e < D_MODEL) {
                const float4 gg = *(const float4*)(g + e), sc = *(const float4*)(mod + D_MODEL + e), sh = *(const float4*)(mod + e);
                *(u32x2*)(p.H + (size_t)t * D_MODEL + e) = pack4(v[j].x * rstd * gg.x * (1.0f + sc.x) + sh.x, v[j].y * rstd * gg.y * (1.0f + sc.y) + sh.y,
                                                                 v[j].z * rstd * gg.z * (1.0f + sc.z) + sh.z, v[j].w * rstd * gg.w * (1.0f + sc.w) + sh.w);
            }
        }
    }
}

__device__ __forceinline__ void phase_gemm_in(const P& p, int l, char* smem) {
    constexpr int NI = 6, MI = 8;
    const int ntn = NPAD192(D_IN) / 192, ntm = MTOT / 256;
    for (int it = 0;; ++it) {
        int mt_, nt_; if (!tile_map(it, ntm, ntn, 4, mt_, nt_)) break;
        const int m0 = mt_ * 256, n0 = nt_ * 192;
        f32x4 acc[NI][MI];
#pragma unroll
        for (int i = 0; i < NI; ++i)
#pragma unroll
            for (int j = 0; j < MI; ++j) acc[i][j] = (f32x4){0.f, 0.f, 0.f, 0.f};
        mfma_gemm_tile_t<NI, MI>(p.WT_IN, D_MODEL, (size_t)NPAD192(D_IN) * D_MODEL * 2, p.H, D_MODEL, (size_t)MTOT * D_MODEL * 2, D_MODEL, n0, m0, (bf16_t*)smem, acc);
        const int lane = otid() & 63, wave = otid() >> 6;
#pragma unroll
        for (int ni = 0; ni < NI; ++ni)
#pragma unroll
            for (int mi = 0; mi < MI; ++mi) {
                const int n = n0 + (wave >> 1) * 16 * NI + ni * 16 + (lane >> 4) * 4, m = m0 + (wave & 1) * 16 * MI + mi * 16 + (lane & 15);
                if (n < D_IN) *(u32x2*)(p.Z + (size_t)m * D_IN + n) = pack4(acc[ni][mi][0], acc[ni][mi][1], acc[ni][mi][2], acc[ni][mi][3]);
            }
    }
}

__device__ __forceinline__ void unpack8(const u32x4 w, float (&f)[8]) {
    f[0] = LO16(w.x); f[1] = HI16(w.x); f[2] = LO16(w.y); f[3] = HI16(w.y); f[4] = LO16(w.z); f[5] = HI16(w.z); f[6] = LO16(w.w); f[7] = HI16(w.w);
}
__device__ __forceinline__ u32x4 pack8(const float (&f)[8]) {
    u32x4 o; o.x = pack2bf(f[0], f[1]); o.y = pack2bf(f[2], f[3]);
    o.z = pack2bf(f[4], f[5]); o.w = pack2bf(f[6], f[7]); return o;
}
__device__ __forceinline__ void load8f(const float* p, float (&f)[8]) {
    const float4 a = *(const float4*)p, b = *(const float4*)(p + 4);
    f[0] = a.x; f[1] = a.y; f[2] = a.z; f[3] = a.w; f[4] = b.x; f[5] = b.y; f[6] = b.z; f[7] = b.w;
}
__device__ __forceinline__ void store8f(float* p, const float (&f)[8]) {
    float4 a, b; a.x = f[0]; a.y = f[1]; a.z = f[2]; a.w = f[3]; b.x = f[4]; b.y = f[5]; b.z = f[6]; b.w = f[7];
    *(float4*)p = a; *(float4*)(p + 4) = b;
}
__device__ __forceinline__ void conv8(const bf16_t* zp, const float* conv, int c0, bool act, bool first, bool last, float (&out)[8]) {
    const u32x4 z4 = {0u, 0u, 0u, 0u};
    const u32x4 a0 = act ? *(const u32x4*)(zp + c0) : z4;
    const u32x4 am = (act && !first) ? *(const u32x4*)(zp + c0 - D_IN) : z4;
    const u32x4 an = (act && !last) ? *(const u32x4*)(zp + c0 + D_IN) : z4;
    float w0[8], w1[8], w2[8], f0[8], fm[8], fn[8];
    if (act) { load8f(conv + c0, w0); load8f(conv + RWKV_IN + c0, w1); load8f(conv + 2 * RWKV_IN + c0, w2); }
    else {
#pragma unroll
        for (int e = 0; e < 8; ++e) { w0[e] = 0.f; w1[e] = 0.f; w2[e] = 0.f; }
    }
    unpack8(a0, f0); unpack8(am, fm); unpack8(an, fn);
#pragma unroll
    for (int e = 0; e < 8; ++e) out[e] = w1[e] * f0[e] + w0[e] * fm[e] + w2[e] * fn[e];
}
__device__ __forceinline__ void phase_rwkv_prep1(const P& p, int l) {
    const int lane = otid() & 63;
    const int gw = (obid() * NTHREADS + otid()) >> 6, nw = (gridDim.x * NTHREADS) >> 6;
    const float* conv = p.in[I_RCONV] + (size_t)l * 3 * RWKV_IN;
    const float* k_k = p.in[I_RKK] + (size_t)l * RW;
    const bool act = lane * 8 < RW, act2 = lane * 8 < 384;
    float kkw[8];
    if (act) load8f(k_k + lane * 8, kkw);
    else {
#pragma unroll
        for (int e = 0; e < 8; ++e) kkw[e] = 0.f;
    }
    for (int t = gw; t < MTOT; t += nw) {
        const bool first = (t == 0) || (t == CTX), last = (t == CTX - 1) || (t == MTOT - 1);
        const bf16_t* zp = p.Z + (size_t)t * D_IN + ZR;
        float rv[8], kv[8], vv[8], lr[8];
        conv8(zp, conv, 0 * RW + lane * 8, act, first, last, rv);
        conv8(zp, conv, 1 * RW + lane * 8, act, first, last, kv);
        conv8(zp, conv, 2 * RW + lane * 8, act, first, last, vv);
        conv8(zp, conv, 3 * RW + lane * 8, act2, first, last, lr);
        float kk[8]; float ss = 0.f;
#pragma unroll
        for (int e = 0; e < 8; ++e) { kk[e] = kv[e] * kkw[e]; ss += kk[e] * kk[e]; }
        ss += __shfl_xor(ss, 1, 64); ss += __shfl_xor(ss, 2, 64); ss += __shfl_xor(ss, 4, 64);
        const float inv = 1.0f / fmaxf(sqrtf(ss), 1e-12f);
#pragma unroll
        for (int e = 0; e < 8; ++e) kk[e] *= inv;
        if (act) {
            const size_t o = (size_t)t * RW + lane * 8;
            *(u32x4*)(p.R + o) = pack8(rv); *(u32x4*)(p.KS + o) = pack8(kv); *(u32x4*)(p.V + o) = pack8(vv); *(u32x4*)(p.KK + o) = pack8(kk);
        }
        if (act2) {
            const int cc = lane * 8;
            if (cc < 128) {
#pragma unroll
                for (int e = 0; e < 8; ++e) lr[e] = tanhf_(lr[e]);
                *(u32x4*)(p.LR + (size_t)t * 256 + cc) = pack8(lr);
            } else if (cc < 256) {
                *(u32x4*)(p.LR + (size_t)t * 256 + cc) = pack8(lr);
            } else {
#pragma unroll
                for (int e = 0; e < 8; ++e) lr[e] = sigmoidf_(lr[e]);
                *(u32x4*)(p.GS + (size_t)t * 128 + cc - 256) = pack8(lr);
            }
        }
    }
}
__device__ __forceinline__ void phase_rwkv_prep2(const P& p, int l, char* smem) {
    const int ntm = MTOT / 128, ntn = NPAD(RW) / 128;
    const float* k_a = p.in[I_RKA] + (size_t)l * RW;
    const float* r_k = p.in[I_RRK] + (size_t)l * RW;
    for (int job = obid(); job < ntm * ntn * 2; job += gridDim.x) {
        const int d = job % 2, n0 = ((job / 2) % ntn) * 128, m0 = (job / (2 * ntn)) * 128;
        const float* w0 = p.in[I_RW0] + (size_t)(l * 2 + d) * RW;
        const float* a0 = p.in[I_RA0] + (size_t)(l * 2 + d) * RW;
        f32x4 accw[4][4], acca[4][4]; ZERO_ACC4(accw); ZERO_ACC4(acca);
        mfma_gemm_tile(p.WT_W2 + (size_t)d * NPAD(RW) * 64, 64, p.LR + d * 64, 256, 64, n0, m0, (bf16_t*)smem, accw);
        mfma_gemm_tile(p.WT_A2 + (size_t)d * NPAD(RW) * 64, 64, p.LR + 128 + d * 64, 256, 64, n0, m0, (bf16_t*)smem, acca);
        const int lane = otid() & 63, wave = otid() >> 6;
#pragma unroll
        for (int mi = 0; mi < 4; ++mi) {
            const int m = m0 + (wave & 1) * 64 + mi * 16 + (lane & 15);
            float bon = 0.f;
#pragma unroll
            for (int ni = 0; ni < 4; ++ni) {
                const int n = n0 + (wave >> 1) * 64 + ni * 16 + (lane >> 4) * 4;
                if (n < RW) {
                    const u32x2 kq = *(const u32x2*)(p.KS + (size_t)m * RW + n), kkq = *(const u32x2*)(p.KK + (size_t)m * RW + n), rq = *(const u32x2*)(p.R + (size_t)m * RW + n);
                    const float kv[4] = {LO16(kq.x), HI16(kq.x), LO16(kq.y), HI16(kq.y)};
                    const float kkv[4] = {LO16(kkq.x), HI16(kkq.x), LO16(kkq.y), HI16(kkq.y)};
                    const float rv[4] = {LO16(rq.x), HI16(rq.x), LO16(rq.y), HI16(rq.y)};
                    float lw[4], kd[4], bb[4];
#pragma unroll
                    for (int e = 0; e < 4; ++e) {
                        const float x = w0[n + e] + accw[ni][mi][e];
                        lw[e] = -fexp_(-softplusf_(-x) - 0.5f);
                        const float aa = sigmoidf_(a0[n + e] + acca[ni][mi][e]);
                        kd[e] = kv[e] * (1.0f + (aa - 1.0f) * k_a[n + e]);
                        bb[e] = kkv[e] * aa;
                        bon += rv[e] * kd[e] * r_k[n + e];
                    }
                    const size_t o = ((size_t)d * MTOT + m) * RW + n;
                    float4 lo4; lo4.x = lw[0]; lo4.y = lw[1]; lo4.z = lw[2]; lo4.w = lw[3];
                    *(float4*)(p.LW + o) = lo4;
                    *(u32x2*)(p.KD + o) = pack4(kd[0], kd[1], kd[2], kd[3]);
                    *(u32x2*)(p.BB + o) = pack4(bb[0], bb[1], bb[2], bb[3]);
                }
            }
            bon += __shfl_xor(bon, 16, 64); bon += __shfl_xor(bon, 32, 64);
            const int hh = (n0 + (wave >> 1) * 64) >> 6;
            if ((lane >> 4) == 0 && hh < RH) p.BONUS[((size_t)d * MTOT + m) * RH + hh] = bon;
        }
    }
}

#define CH_ROW 72
#define SEQ_REC 16640
#define CH_SLOT (64 * CH_ROW)
#define CH_XR_OFF (7 * CH_SLOT * 2)
#define CH_AAB_OFF (CH_XR_OFF + 64 * 132 * 4)
#define CH_GC_OFF (CH_AAB_OFF + 64 * 72 * 4)
template <int MT, int NT>
__device__ __forceinline__ void lds_mm(const bf16_t* A, int m0, const bf16_t* Bt, int n0, f32x4 (&acc)[MT][NT]) {
    const int lane = otid() & 63, q = lane >> 4, r = lane & 15;
#pragma unroll
    for (int s = 0; s < 2; ++s) {
        bf16x8 a[MT], b[NT];
#pragma unroll
        for (int i = 0; i < MT; ++i) a[i] = *(const bf16x8*)(A + (m0 + i * 16 + r) * CH_ROW + s * 32 + q * 8);
#pragma unroll
        for (int i = 0; i < NT; ++i) b[i] = *(const bf16x8*)(Bt + (n0 + i * 16 + r) * CH_ROW + s * 32 + q * 8);
#pragma unroll
        for (int i = 0; i < MT; ++i)
#pragma unroll
            for (int jj = 0; jj < NT; ++jj) acc[i][jj] = MFMA16(a[i], b[jj], acc[i][jj]);
    }
}
__device__ __forceinline__ void rwkv_chunk_job(const P& p, int job, char* smem) {
    const int tid = otid(), lane = tid & 63, wv = tid >> 6, q = lane >> 4, r = lane & 15;
    const int d = job / (NC * RH), n = (job / RH) % NC, h = job % RH;
    const size_t base = (size_t)(d * NC + n) * RH + h;
    bf16_t* S0 = (bf16_t*)smem; bf16_t* S1 = S0 + CH_SLOT; bf16_t* S2 = S1 + CH_SLOT; bf16_t* S3 = S2 + CH_SLOT;
    bf16_t* S4 = S3 + CH_SLOT; bf16_t* S5 = S4 + CH_SLOT; bf16_t* S6 = S5 + CH_SLOT;
    float* X = (float*)(smem + CH_XR_OFF);
    float* AABt = (float*)(smem + CH_AAB_OFF);
    bf16_t* U0t = (bf16_t*)(smem + CH_AAB_OFF);
    bf16_t* Aht = U0t + CH_SLOT;
    float* GC = (float*)(smem + CH_GC_OFF);
    __syncthreads();
    u32x4 gkk[2], gr[2], gv[2], gkd[2], gbb[2]; float lw[2][8];
#pragma unroll
    for (int it = 0; it < 2; ++it) {
        const int c = tid + 256 * it, i = c >> 3, k0 = (c & 7) * 8; const int tok = 64 * n + (d ? 63 - i : i);
        const size_t o1 = (size_t)tok * RW + h * 64 + k0, o2 = ((size_t)d * MTOT + tok) * RW + h * 64 + k0;
        load8f(p.LW + o2, lw[it]);
        gkk[it] = *(const u32x4*)(p.KK + o1); gr[it] = *(const u32x4*)(p.R + o1); gv[it] = *(const u32x4*)(p.V + o1);
        gkd[it] = *(const u32x4*)(p.KD + o2); gbb[it] = *(const u32x4*)(p.BB + o2);
    }
#pragma unroll
    for (int it = 0; it < 2; ++it) { const int c = tid + 256 * it; store8f(X + (c >> 3) * 132 + (c & 7) * 8, lw[it]); }
    __syncthreads();
    {
        const int k = tid & 63, seg = tid >> 6;
        float v[16]; float run = 0.f;
#pragma unroll
        for (int e = 0; e < 16; ++e) { run += X[(seg * 16 + e) * 132 + k]; v[e] = run; }
        AABt[seg * 64 + k] = run;
        __syncthreads();
        float off = 0.f;
        for (int s2 = 0; s2 < seg; ++s2) off += AABt[s2 * 64 + k];
#pragma unroll
        for (int e = 0; e < 16; ++e) X[(seg * 16 + e) * 132 + k] = v[e] + off;
    }
    __syncthreads();
#pragma unroll
    for (int it = 0; it < 2; ++it) {
        const int c = tid + 256 * it, i = c >> 3, k0 = (c & 7) * 8;
        float L[8], Lp[8], LC[8], kkv[8], rv[8], vv[8], kdv[8], bbv[8];
        load8f(X + i * 132 + k0, L); load8f(X + 63 * 132 + k0, LC);
        if (i > 0) load8f(X + (i - 1) * 132 + k0, Lp);
        else {
#pragma unroll
            for (int e = 0; e < 8; ++e) Lp[e] = 0.f;
        }
        unpack8(gkk[it], kkv); unpack8(gr[it], rv); unpack8(gv[it], vv); unpack8(gkd[it], kdv); unpack8(gbb[it], bbv);
        float at[8], rt[8], bt[8], kt[8], bh[8], kh[8];
#pragma unroll
        for (int e = 0; e < 8; ++e) {
            const float eL = fexp_(L[e]), eLp = fexp_(Lp[e]), eNL = fexp_(-L[e]), eCL = fexp_(LC[e] - L[e]);
            at[e] = -kkv[e] * eLp; rt[e] = rv[e] * eL; bt[e] = bbv[e] * eNL; kt[e] = kdv[e] * eNL; bh[e] = bbv[e] * eCL; kh[e] = kdv[e] * eCL;
            if (i == 63) GC[k0 + e] = eL;
        }
        *(u32x4*)(S0 + i * CH_ROW + k0) = pack8(at);
        store8f(X + i * 132 + 64 + k0, at);
        *(u32x4*)(S1 + i * CH_ROW + k0) = pack8(rt);
        *(u32x4*)(S2 + i * CH_ROW + k0) = pack8(bt);
        *(u32x4*)(S3 + i * CH_ROW + k0) = pack8(kt);
#pragma unroll
        for (int e = 0; e < 8; ++e) {
            S4[(k0 + e) * CH_ROW + i] = f2bf(vv[e]);
            S5[(k0 + e) * CH_ROW + i] = f2bf(bh[e]);
            S6[(k0 + e) * CH_ROW + i] = f2bf(kh[e]);
        }
    }
    __syncthreads();
    {
        f32x4 acc[4][4]; ZERO_ACC4(acc);
        lds_mm<4, 4>((wv < 2) ? S0 : S1, 0, (wv & 1) ? S3 : S2, 0, acc);
        __syncthreads();
#pragma unroll
        for (int mt = 0; mt < 4; ++mt)
#pragma unroll
            for (int nt = 0; nt < 4; ++nt) {
                const int jc = nt * 16 + r, i0 = mt * 16 + 4 * q;
                if (wv == 0) {
                    f32x4 o;
#pragma unroll
                    for (int e = 0; e < 4; ++e) o[e] = (jc < i0 + e) ? acc[mt][nt][e] : 0.f;
                    *(f32x4*)(AABt + jc * 72 + i0) = o;
                } else {
                    bf16_t* dst = (wv == 1) ? S0 : ((wv == 2) ? S2 : S3);
#pragma unroll
                    for (int e = 0; e < 4; ++e) {
                        const bool ok = (wv == 1) ? (jc < i0 + e) : (jc <= i0 + e);
                        dst[(i0 + e) * CH_ROW + jc] = f2bf(ok ? acc[mt][nt][e] : 0.f);
                    }
                }
            }
    }
    __syncthreads();
    {
        f32x4 acc[1][4];
#pragma unroll
        for (int nt = 0; nt < 4; ++nt) acc[0][nt] = (f32x4){0.f, 0.f, 0.f, 0.f};
        lds_mm<1, 4>(S0, 16 * wv, S4, 0, acc);
#pragma unroll
        for (int nt = 0; nt < 4; ++nt)
#pragma unroll
            for (int e = 0; e < 4; ++e) X[(16 * wv + 4 * q + e) * 132 + nt * 16 + r] = acc[0][nt][e];
    }
    __syncthreads();
    if (tid < 128) {
        const int c = tid;
        for (int bi = 0; bi < 4; ++bi) {
            float acc[16];
#pragma unroll
            for (int e = 0; e < 16; ++e) acc[e] = X[(16 * bi + e) * 132 + c];
            for (int jj = 0; jj < 16 * bi; ++jj) {
                const float uj = X[jj * 132 + c];
                const f32x4* ap = (const f32x4*)(AABt + jj * 72 + 16 * bi);
                const f32x4 a0 = ap[0], a1 = ap[1], a2 = ap[2], a3 = ap[3];
#pragma unroll
                for (int e = 0; e < 4; ++e) { acc[e] += a0[e] * uj; acc[4 + e] += a1[e] * uj; acc[8 + e] += a2[e] * uj; acc[12 + e] += a3[e] * uj; }
            }
#pragma unroll
            for (int e = 0; e < 16; ++e) {
                const float u = acc[e];
                X[(16 * bi + e) * 132 + c] = u;
                const f32x4* ap = (const f32x4*)(AABt + (16 * bi + e) * 72 + 16 * bi);
                const f32x4 a0 = ap[0], a1 = ap[1], a2 = ap[2], a3 = ap[3];
#pragma unroll
                for (int e2 = 0; e2 < 16; ++e2) if (e2 > e) acc[e2] += ((e2 < 4) ? a0[e2 & 3] : (e2 < 8) ? a1[e2 & 3] : (e2 < 12) ? a2[e2 & 3] : a3[e2 & 3]) * u;
            }
        }
    }
    __syncthreads();
    if (tid < 128) {
        const int c = tid;
        bf16_t* dst = (c < 64) ? (U0t + c * CH_ROW) : (Aht + (c - 64) * CH_ROW);
        u32x4 ov[8];
#pragma unroll
        for (int g = 0; g < 8; ++g) {
            float v[8];
#pragma unroll
            for (int e = 0; e < 8; ++e) v[e] = X[(g * 8 + e) * 132 + c];
            ov[g].x = pack2bf(v[0], v[1]); ov[g].y = pack2bf(v[2], v[3]);
            ov[g].z = pack2bf(v[4], v[5]); ov[g].w = pack2bf(v[6], v[7]);
        }
#pragma unroll
        for (int g = 0; g < 8; ++g) *(u32x4*)(dst + g * 8) = ov[g];
    }
    __syncthreads();
    {
        f32x4 acc[4][4]; ZERO_ACC4(acc);
        char* rec = p.REC + base * SEQ_REC;
        if (wv == 0) {
            lds_mm<4, 4>(Aht, 0, S5, 0, acc);
#pragma unroll
            for (int nt = 0; nt < 4; ++nt)
#pragma unroll
                for (int s2 = 0; s2 < 2; ++s2) {
                    u32x4 o;
                    o.x = pack2bf(acc[2 * s2][nt][0], acc[2 * s2][nt][1]); o.y = pack2bf(acc[2 * s2][nt][2], acc[2 * s2][nt][3]);
                    o.z = pack2bf(acc[2 * s2 + 1][nt][0], acc[2 * s2 + 1][nt][1]); o.w = pack2bf(acc[2 * s2 + 1][nt][2], acc[2 * s2 + 1][nt][3]);
                    *(u32x4*)(rec + (((nt * 2 + s2) * 64 + lane) * 8) * 2) = o;
                }
        } else if (wv == 1) {
            lds_mm<4, 4>(S5, 0, U0t, 0, acc);
            lds_mm<4, 4>(S6, 0, S4, 0, acc);
#pragma unroll
            for (int mt = 0; mt < 4; ++mt)
#pragma unroll
                for (int nt = 0; nt < 4; ++nt) *(u32x2*)(rec + 8192 + (((nt * 4 + mt) * 64 + lane) * 4) * 2) = pack4(acc[mt][nt][0], acc[mt][nt][1], acc[mt][nt][2], acc[mt][nt][3]);
        } else if (wv == 2) {
            lds_mm<4, 4>(S2, 0, Aht, 0, acc);
#pragma unroll
            for (int mt = 0; mt < 4; ++mt)
#pragma unroll
                for (int nt = 0; nt < 4; ++nt)
#pragma unroll
                    for (int e = 0; e < 4; ++e) {
                        const int t = mt * 16 + 4 * q + e, kc = nt * 16 + r;
                        p.QH[(base * 64 + t) * 64 + kc] = f2bf(acc[mt][nt][e] + bf2f(S1[t * CH_ROW + kc]));
                    }
        } else if (wv == 3) {
            lds_mm<4, 4>(S2, 0, U0t, 0, acc);
            lds_mm<4, 4>(S3, 0, S4, 0, acc);
#pragma unroll
            for (int mt = 0; mt < 4; ++mt)
#pragma unroll
                for (int nt = 0; nt < 4; ++nt)
#pragma unroll
                    for (int e = 0; e < 4; ++e) {
                        const int t = mt * 16 + 4 * q + e; const int tok = 64 * n + (d ? 63 - t : t);
                        p.Y[((size_t)d * MTOT + tok) * RW + h * 64 + nt * 16 + r] = acc[mt][nt][e];
                    }
        }
        if (tid < 64) ((float*)(rec + 16384))[tid] = GC[tid];
    }
}

#define SEQ_SLOT 16896
__device__ __forceinline__ void rwkv_seq_gload(const P& p, size_t base, int tid, u32x4 (&g)[5]) {
    const u32x4* m = (const u32x4*)(p.REC + base * SEQ_REC);
#pragma unroll
    for (int i = 0; i < 4; ++i) g[i] = m[tid + 256 * i];
    if (tid < 16) g[4] = m[1024 + tid];
}
__device__ __forceinline__ void rwkv_seq_lstore(char* slot, int tid, const u32x4 (&g)[5]) {
    u32x4* d = (u32x4*)slot;
#pragma unroll
    for (int i = 0; i < 4; ++i) d[tid + 256 * i] = g[i];
    if (tid < 16) d[1024 + tid] = g[4];
}
__device__ __forceinline__ void rwkv_seq_step(const P& p, const char* slot, size_t base, int wv, int lane, f32x4 (&X)[4]) {
    const int q = lane >> 4, r = lane & 15;
    const bf16_t* mt = (const bf16_t*)slot; const bf16_t* ntb = (const bf16_t*)(slot + 8192); const float* gc = (const float*)(slot + 16384);
    unsigned xh[4][2];
#pragma unroll
    for (int kt = 0; kt < 4; ++kt) {
        xh[kt][0] = pack2bf(X[kt][0], X[kt][1]); xh[kt][1] = pack2bf(X[kt][2], X[kt][3]);
        *(u32x2*)(p.SN + (base * 64 + 16 * wv + r) * 64 + 16 * kt + 4 * q) = (u32x2){xh[kt][0], xh[kt][1]};
    }
    bf16x8 bh[2];
#pragma unroll
    for (int s2 = 0; s2 < 2; ++s2) bh[s2] = __builtin_bit_cast(bf16x8, ((u32x4){xh[2 * s2][0], xh[2 * s2][1], xh[2 * s2 + 1][0], xh[2 * s2 + 1][1]}));
#pragma unroll
    for (int tile = 0; tile < 4; ++tile) {
        const u32x2 nb = *(const u32x2*)(ntb + ((wv * 4 + tile) * 64 + lane) * 4);
        const f32x4 g4 = *(const f32x4*)(gc + tile * 16 + 4 * q);
        f32x4 acc;
        acc[0] = g4[0] * X[tile][0] + LO16(nb.x); acc[1] = g4[1] * X[tile][1] + HI16(nb.x);
        acc[2] = g4[2] * X[tile][2] + LO16(nb.y); acc[3] = g4[3] * X[tile][3] + HI16(nb.y);
#pragma unroll
        for (int s2 = 0; s2 < 2; ++s2) {
            const bf16x8 ah = *(const bf16x8*)(mt + ((tile * 2 + s2) * 64 + lane) * 8);
            acc = MFMA16(ah, bh[s2], acc);
        }
        X[tile] = acc;
    }
}
__device__ __forceinline__ void rwkv_seq_job(const P& p, int job, char* smem) {
    const int tid = otid(), lane = tid & 63, wv = tid >> 6;
    const int d = job / RH, h = job % RH;
    f32x4 X[4];
#pragma unroll
    for (int kt = 0; kt < 4; ++kt) X[kt] = (f32x4){0.f, 0.f, 0.f, 0.f};
    u32x4 g0[5], g1[5], g2[5];
#define SEQ_BASE(s_) ((size_t)(d * NC + chunk_order(d, ((s_) < NC) ? (s_) : NC - 1)) * RH + h)
    __syncthreads();
    rwkv_seq_gload(p, SEQ_BASE(0), tid, g0);
    rwkv_seq_gload(p, SEQ_BASE(1), tid, g1);
    rwkv_seq_gload(p, SEQ_BASE(2), tid, g2);
    rwkv_seq_lstore(smem, tid, g0);
    __syncthreads();
    for (int s = 0; s < NC; s += 6) {
#define SEQ_SUB(u, GFREE, GNEXT) \
        if (s + (u) < NC) { \
            rwkv_seq_gload(p, SEQ_BASE(s + (u) + 3), tid, GFREE); \
            rwkv_seq_step(p, smem + (((u) & 1) ? SEQ_SLOT : 0), SEQ_BASE(s + (u)), wv, lane, X); \
            rwkv_seq_lstore(smem + (((u) & 1) ? 0 : SEQ_SLOT), tid, GNEXT); \
        } \
        __syncthreads();
        SEQ_SUB(0, g0, g1)
        SEQ_SUB(1, g1, g2)
        SEQ_SUB(2, g2, g0)
        SEQ_SUB(3, g0, g1)
        SEQ_SUB(4, g1, g2)
        SEQ_SUB(5, g2, g0)
#undef SEQ_SUB
    }
#undef SEQ_BASE
}
__device__ __forceinline__ void rwkv_out_job(const P& p, int job) {
    const int tid = otid(), lane = tid & 63, wv = tid >> 6, q = lane >> 4, r = lane & 15;
    const int d = job / (NC * RH), n = (job / RH) % NC, h = job % RH;
    const size_t base = (size_t)(d * NC + n) * RH + h;
    f32x4 acc[4];
#pragma unroll
    for (int nt = 0; nt < 4; ++nt) acc[nt] = (f32x4){0.f, 0.f, 0.f, 0.f};
#pragma unroll
    for (int s2 = 0; s2 < 2; ++s2) {
        const bf16x8 a = *(const bf16x8*)(p.QH + (base * 64 + 16 * wv + r) * 64 + s2 * 32 + q * 8);
#pragma unroll
        for (int nt = 0; nt < 4; ++nt) {
            const bf16x8 b = *(const bf16x8*)(p.SN + (base * 64 + nt * 16 + r) * 64 + s2 * 32 + q * 8);
            acc[nt] = MFMA16(a, b, acc[nt]);
        }
    }
#pragma unroll
    for (int nt = 0; nt < 4; ++nt)
#pragma unroll
        for (int e = 0; e < 4; ++e) {
            const int t = 16 * wv + 4 * q + e; const int tok = 64 * n + (d ? 63 - t : t);
            p.Y[((size_t)d * MTOT + tok) * RW + h * 64 + nt * 16 + r] += acc[nt][e];
        }
}

#define GL_QR 0
#define GL_KR 9216
#define GL_VT 18432
#define GL_QI 36864
#define GL_KI 46080
#define GL_AT 55296
#define GL_CUM 64512
#define GL_ALR 81920
#define GL_WA 86016
__device__ __forceinline__ void gla_load_qkv(const P& p, int n, int h, char* smem) {
    const int tid = otid();
    bf16_t* Qr = (bf16_t*)(smem + GL_QR); bf16_t* Kr = (bf16_t*)(smem + GL_KR); bf16_t* Vt = (bf16_t*)(smem + GL_VT);
    for (int c = tid; c < 512; c += NTHREADS) {
        const int row = c >> 3, part = c & 7; const int t = gla_tok(n, row);
        const u32x4 qv = *(const u32x4*)(p.Z + (size_t)t * D_IN + ZQ + h * 64 + part * 8);
        const u32x4 kv = *(const u32x4*)(p.Z + (size_t)t * D_IN + ZK + h * 64 + part * 8);
        u32x4 qs;
        qs.x = pack2bf(LO16(qv.x) * 0.125f, HI16(qv.x) * 0.125f);
        qs.y = pack2bf(LO16(qv.y) * 0.125f, HI16(qv.y) * 0.125f);
        qs.z = pack2bf(LO16(qv.z) * 0.125f, HI16(qv.z) * 0.125f);
        qs.w = pack2bf(LO16(qv.w) * 0.125f, HI16(qv.w) * 0.125f);
        *(u32x4*)(Qr + row * CH_ROW + part * 8) = qs;
        *(u32x4*)(Kr + row * CH_ROW + part * 8) = kv;
    }
    for (int c = tid; c < 1024; c += NTHREADS) {
        const int row = c >> 4, part = c & 15; const int t = gla_tok(n, row);
        const u32x4 vv = *(const u32x4*)(p.Z + (size_t)t * D_IN + ZV + h * 128 + part * 8);
        bf16_t* dst = Vt + (part * 8) * CH_ROW + row;
        dst[0 * CH_ROW] = (bf16_t)(vv.x & 0xFFFF); dst[1 * CH_ROW] = (bf16_t)(vv.x >> 16);
        dst[2 * CH_ROW] = (bf16_t)(vv.y & 0xFFFF); dst[3 * CH_ROW] = (bf16_t)(vv.y >> 16);
        dst[4 * CH_ROW] = (bf16_t)(vv.z & 0xFFFF); dst[5 * CH_ROW] = (bf16_t)(vv.z >> 16);
        dst[6 * CH_ROW] = (bf16_t)(vv.w & 0xFFFF); dst[7 * CH_ROW] = (bf16_t)(vv.w >> 16);
    }
}
__device__ __forceinline__ void gla_cum(const P& p, int l, int n, int h, int d, char* smem) {
    const int tid = otid();
    float* CUM = (float*)(smem + GL_CUM); float* ALR = (float*)(smem + GL_ALR); float* WA = (float*)(smem + GL_WA);
    for (int c = tid; c < 256; c += NTHREADS) {
        const int row = c >> 2, part = c & 3; const int t = gla_tok(n, row);
        const u32x2 a = *(const u32x2*)(p.Z + (size_t)t * D_IN + (d ? ZAB : ZAF) + part * 4);
        float* dst = ALR + row * 16 + part * 4;
        dst[0] = LO16(a.x); dst[1] = HI16(a.x); dst[2] = LO16(a.y); dst[3] = HI16(a.y);
    }
    for (int c = tid; c < 16 * 64 + 64; c += NTHREADS) {
        if (c < 1024) WA[c] = p.in[I_GLA_WA2][((size_t)(l * 2 + d) * 16 + (c >> 6)) * GLA_K + h * 64 + (c & 63)];
        else WA[c] = p.in[I_GLA_BA][(size_t)(l * 2 + d) * GLA_K + h * 64 + (c - 1024)];
    }
    __syncthreads();
    for (int idx = tid; idx < 4096; idx += NTHREADS) {
        const int i = idx >> 6, k = idx & 63;
        float a = WA[1024 + k];
#pragma unroll
        for (int r = 0; r < 16; ++r) a += ALR[i * 16 + r] * WA[r * 64 + k];
        CUM[i * 68 + k] = (fminf(a, 0.f) - flog_(1.0f + fexp_(-fabsf(a)))) * (1.0f / 16.0f);
    }
    __syncthreads();
    {
        const int k = tid & 63, seg = (tid >> 6) & 3;
        float v[16]; float run = 0.f;
        if (tid < 256) {
#pragma unroll
            for (int e = 0; e < 16; ++e) { const int pos = seg * 16 + e; const int i = d ? 63 - pos : pos; run += CUM[i * 68 + k]; v[e] = run; }
            ALR[seg * 64 + k] = run;
        }
        __syncthreads();
        if (tid < 256) {
            float off = 0.f;
            for (int s2 = 0; s2 < seg; ++s2) off += ALR[s2 * 64 + k];
#pragma unroll
            for (int e = 0; e < 16; ++e) { const int pos = seg * 16 + e; const int i = d ? 63 - pos : pos; CUM[i * 68 + k] = v[e] + off; }
        }
    }
    __syncthreads();
}
__device__ __forceinline__ void phase_gla_kv(const P& p, int l, char* smem) {
    const int tid = otid(), lane = tid & 63, wv = tid >> 6, q = lane >> 4, r = lane & 15;
    bf16_t* Kr = (bf16_t*)(smem + GL_KR); bf16_t* Vt = (bf16_t*)(smem + GL_VT); bf16_t* KdT = (bf16_t*)(smem + GL_KI);
    float* CUM = (float*)(smem + GL_CUM);
    for (int job = obid(); job < NC * GH; job += gridDim.x) {
        const int n = job / GH, h = job % GH;
        __syncthreads();
        gla_load_qkv(p, n, h, smem);
        for (int d = 0; d < 2; ++d) {
            gla_cum(p, l, n, h, d, smem);
            const int li = d ? 0 : 63;
            for (int idx = tid; idx < 4096; idx += NTHREADS) {
                const int i = idx >> 6, k = idx & 63;
                KdT[k * CH_ROW + i] = f2bf(bf2f(Kr[i * CH_ROW + k]) * fexp_(CUM[li * 68 + k] - CUM[i * 68 + k]));
            }
            if (tid < 64) p.DEC[((size_t)(d * NC + n) * GH + h) * 64 + tid] = fexp_(CUM[li * 68 + tid]);
            __syncthreads();
            float* kvt = p.KV + ((size_t)(d * NC + n) * GH + h) * 8192;
            for (int mt = wv; mt < 4; mt += NTHREADS / 64) {
                f32x4 acc[1][8];
#pragma unroll
                for (int nt = 0; nt < 8; ++nt) acc[0][nt] = (f32x4){0.f, 0.f, 0.f, 0.f};
                lds_mm<1, 8>(KdT, 16 * mt, Vt, 0, acc);
#pragma unroll
                for (int nt = 0; nt < 8; ++nt) *(f32x4*)(kvt + (size_t)(nt * 16 + r) * 64 + 16 * mt + 4 * q) = acc[0][nt];
            }
            __syncthreads();
        }
    }
    __syncthreads();
}
__device__ __forceinline__ void gla_scan_job(const P& p, int job) {
    const int base = job * NTHREADS + otid();
    const int d = base / (GH * 8192), h = (base / 8192) % GH, e = base % 8192;
    const float* __restrict__ kvp = p.KV; const float* __restrict__ decp = p.DEC; bf16_t* __restrict__ sp = p.SP;
    float S = 0.f;
    for (int s = 0; s < NC; s += 4) {
        float kv[4], dc[4]; size_t oo[4];
#pragma unroll
        for (int u = 0; u < 4; ++u) {
            const int n = chunk_order(d, (s + u < NC) ? s + u : NC - 1);
            oo[u] = ((size_t)(d * NC + n) * GH + h);
            kv[u] = kvp[oo[u] * 8192 + e]; dc[u] = decp[oo[u] * 64 + (e & 63)];
        }
#pragma unroll
        for (int u = 0; u < 4; ++u) if (s + u < NC) { sp[oo[u] * 8192 + e] = f2bf(S); S = dc[u] * S + kv[u]; }
    }
}
__device__ __forceinline__ void phase_gla_out(const P& p, int l, char* smem) {
    const int tid = otid(), lane = tid & 63, wv = tid >> 6, q = lane >> 4, r = lane & 15;
    bf16_t* Qr = (bf16_t*)(smem + GL_QR); bf16_t* Kr = (bf16_t*)(smem + GL_KR); bf16_t* Vt = (bf16_t*)(smem + GL_VT);
    bf16_t* Qi = (bf16_t*)(smem + GL_QI); bf16_t* Ki = (bf16_t*)(smem + GL_KI); bf16_t* At = (bf16_t*)(smem + GL_AT);
    float* CUM = (float*)(smem + GL_CUM);
    for (int job = obid(); job < NC * GH; job += gridDim.x) {
        const int n = job / GH, h = job % GH;
        __syncthreads();
        gla_load_qkv(p, n, h, smem);
        f32x4 o[1][8];
#pragma unroll
        for (int nt = 0; nt < 8; ++nt) o[0][nt] = (f32x4){0.f, 0.f, 0.f, 0.f};
        for (int d = 0; d < 2; ++d) {
            gla_cum(p, l, n, h, d, smem);
            for (int idx = tid; idx < 4096; idx += NTHREADS) {
                const int i = idx >> 6, k = idx & 63; const float c = CUM[i * 68 + k];
                Qi[i * CH_ROW + k] = f2bf(bf2f(Qr[i * CH_ROW + k]) * fexp_(c));
                Ki[i * CH_ROW + k] = f2bf(bf2f(Kr[i * CH_ROW + k]) * fexp_(-c));
            }
            __syncthreads();
            if (wv < 4) {
                f32x4 a[1][4];
#pragma unroll
                for (int nt = 0; nt < 4; ++nt) a[0][nt] = (f32x4){0.f, 0.f, 0.f, 0.f};
                lds_mm<1, 4>(Qi, 16 * wv, Ki, 0, a);
#pragma unroll
                for (int nt = 0; nt < 4; ++nt)
#pragma unroll
                    for (int e = 0; e < 4; ++e) {
                        const int i = 16 * wv + 4 * q + e, j = nt * 16 + r;
                        const bool ok = d ? (j >= i) : (j <= i);
                        At[i * CH_ROW + j] = f2bf(ok ? a[0][nt][e] : 0.f);
                    }
                WAVE_SYNC();
                lds_mm<1, 8>(At, 16 * wv, Vt, 0, o);
                const bf16_t* sp = p.SP + ((size_t)(d * NC + n) * GH + h) * 8192;
#pragma unroll
                for (int s2 = 0; s2 < 2; ++s2) {
                    const bf16x8 af = *(const bf16x8*)(Qi + (16 * wv + r) * CH_ROW + s2 * 32 + q * 8);
#pragma unroll
                    for (int nt = 0; nt < 8; ++nt) {
                        const bf16x8 bfr = *(const bf16x8*)(sp + (size_t)(nt * 16 + r) * 64 + s2 * 32 + q * 8);
                        o[0][nt] = MFMA16(af, bfr, o[0][nt]);
                    }
                }
            }
            __syncthreads();
        }
        if (wv < 4) {
#pragma unroll
            for (int nt = 0; nt < 8; ++nt)
#pragma unroll
                for (int e = 0; e < 4; ++e) {
                    const int t = gla_tok(n, 16 * wv + 4 * q + e);
                    p.OGLA[(size_t)t * GLA_V + h * 128 + nt * 16 + r] = o[0][nt][e];
                }
        }
    }
    __syncthreads();
}

#define S5_XH_OFF (2 * 64 * 132 * 4)
#define S5_XL_OFF (S5_XH_OFF + 64 * 136 * 2)
#define S5_CT_OFF (S5_XL_OFF + 64 * 136 * 2)
__device__ __forceinline__ void phase_s5_pass(const P& p, int l, char* smem, bool with_out) {
    const int tid = otid(), lane = tid & 63, wv = tid >> 6, q = lane >> 4, r = lane & 15;
    float* BU = (float*)smem; bf16_t* XH = (bf16_t*)(smem + S5_XH_OFF); bf16_t* XL = (bf16_t*)(smem + S5_XL_OFF); bf16_t* CTp = (bf16_t*)(smem + S5_CT_OFF);
    const int dW = (wv >> 1) & 1, ntb = (wv & 1) * 4;
    const int dS = (tid >> 6) & 1, st = tid & 63;
    bf16x8 bhi[4], blo[4];
    float are = 0.f, aim = 0.f, dco = 0.f;
    int cur_g = -1;
    const bf16x8 zero8 = {0, 0, 0, 0, 0, 0, 0, 0};
    for (int job = obid(); job < NC * SG; job += gridDim.x) {
        const int n = job / SG, g = job % SG;
        __syncthreads();
        if (g != cur_g) {
            cur_g = g;
            if (wv < 4) {
#pragma unroll
                for (int jn = 0; jn < 4; ++jn) {
                    const int kk = 16 * (ntb + jn) + r; const size_t ci = ((size_t)dW * SG + g) * 64 + (kk >> 1);
                    float f[8], lo[8];
#pragma unroll
                    for (int e = 0; e < 8; ++e) f[e] = (q < 2) ? p.S5BB[(ci * 16 + 8 * q + e) * 2 + (kk & 1)] : 0.f;
                    const u32x4 hv = pack8(f);
                    float hf[8]; unpack8(hv, hf);
#pragma unroll
                    for (int e = 0; e < 8; ++e) lo[e] = f[e] - hf[e];
                    bhi[jn] = __builtin_bit_cast(bf16x8, hv); blo[jn] = __builtin_bit_cast(bf16x8, pack8(lo));
                }
            }
            if (tid < 128) { const size_t ci = ((size_t)dS * SG + g) * 64 + st; are = p.S5A[ci * 2]; aim = p.S5A[ci * 2 + 1]; }
            if (with_out) {
                for (int idx = tid; idx < 16 * 128; idx += NTHREADS) {
                    const int c = idx >> 7, kk = idx & 127;
                    const float v = (kk & 1) ? -p.in[I_S5CIM][((size_t)l * SG + g) * 1024 + c * 64 + (kk >> 1)] : p.in[I_S5CRE][((size_t)l * SG + g) * 1024 + c * 64 + (kk >> 1)];
                    CTp[c * 136 + kk] = f2bf(v);
                }
                dco = p.in[I_S5D][(size_t)l * SW + g * 16 + r];
            }
        }
        float xr = 0.f, xi = 0.f;
        const size_t eo = (((size_t)dS * NC + n) * SG + g) * 64 + st;
        if (with_out && tid < 128) { const float2 c2 = *(const float2*)(p.S5CAR + eo * 2); xr = c2.x; xi = c2.y; }
        if (wv < 4) {
#pragma unroll
            for (int mt = 0; mt < 4; ++mt) {
                const bf16x8 a = (q < 2) ? *(const bf16x8*)(p.Z + (size_t)(n * 64 + 16 * mt + r) * D_IN + ZS5 + g * 16 + 8 * q) : zero8;
#pragma unroll
                for (int jn = 0; jn < 4; ++jn) {
                    f32x4 acc = {0.f, 0.f, 0.f, 0.f};
                    acc = MFMA16(a, bhi[jn], acc);
                    acc = MFMA16(a, blo[jn], acc);
#pragma unroll
                    for (int e = 0; e < 4; ++e) BU[(dW * 64 + 16 * mt + 4 * q + e) * 132 + 16 * (ntb + jn) + r] = acc[e];
                }
            }
        }
        __syncthreads();
        if (tid < 128) {
#pragma unroll 8
            for (int ii = 0; ii < 64; ++ii) {
                const int i = dS ? 63 - ii : ii;
                float2* bp = (float2*)(BU + (dS * 64 + i) * 132 + st * 2);
                const float2 b = *bp;
                const float nr = are * xr - aim * xi + b.x, ni = are * xi + aim * xr + b.y;
                xr = nr; xi = ni;
                if (with_out) { float2 o; o.x = xr; o.y = xi; *bp = o; }
            }
            if (!with_out) { float2 o; o.x = xr; o.y = xi; *(float2*)(p.S5END + eo * 2) = o; }
        }
        if (with_out) {
            __syncthreads();
            for (int cidx = tid; cidx < 64 * 16; cidx += NTHREADS) {
                const int i = cidx >> 4, k0 = (cidx & 15) * 8;
                float a[8], b[8], lo[8];
                load8f(BU + (0 * 64 + i) * 132 + k0, a); load8f(BU + (1 * 64 + i) * 132 + k0, b);
#pragma unroll
                for (int e = 0; e < 8; ++e) a[e] += b[e];
                const u32x4 hv = pack8(a);
                float hf[8]; unpack8(hv, hf);
#pragma unroll
                for (int e = 0; e < 8; ++e) lo[e] = a[e] - hf[e];
                *(u32x4*)(XH + i * 136 + k0) = hv; *(u32x4*)(XL + i * 136 + k0) = pack8(lo);
            }
            __syncthreads();
            if (wv < 4) {
                f32x4 acc = {0.f, 0.f, 0.f, 0.f};
#pragma unroll
                for (int ks = 0; ks < 4; ++ks) {
                    const bf16x8 ah = *(const bf16x8*)(XH + (16 * wv + r) * 136 + ks * 32 + q * 8), al = *(const bf16x8*)(XL + (16 * wv + r) * 136 + ks * 32 + q * 8);
                    const bf16x8 b = *(const bf16x8*)(CTp + r * 136 + ks * 32 + q * 8);
                    acc = MFMA16(ah, b, acc);
                    acc = MFMA16(al, b, acc);
                }
#pragma unroll
                for (int e = 0; e < 4; ++e) {
                    const int i = 16 * wv + 4 * q + e;
                    const float u = bf2f(p.Z[(size_t)(n * 64 + i) * D_IN + ZS5 + g * 16 + r]);
                    p.GY[(size_t)(n * 64 + i) * SW + g * 16 + r] = f2bf(geluf_(acc[e] + dco * u));
                }
            }
        }
    }
    __syncthreads();
}
__device__ __forceinline__ void s5_carry_job(const P& p, int job) {
    const int base = job * NTHREADS + otid();
    if (base >= 2 * SG * 64) return;
    const int d = base / (SG * 64), g = (base / 64) % SG, st = base % 64;
    const size_t ci = ((size_t)d * SG + g) * 64 + st;
    float ar = p.S5A[ci * 2], ai = p.S5A[ci * 2 + 1];
    for (int i = 0; i < 6; ++i) { const float nr = ar * ar - ai * ai, ni = 2.f * ar * ai; ar = nr; ai = ni; }
    const float2* __restrict__ endp = (const float2*)p.S5END; float2* __restrict__ carp = (float2*)p.S5CAR;
    float cr = 0.f, cim = 0.f;
    for (int s = 0; s < NC; s += 4) {
        float2 ev[4]; size_t eo[4];
#pragma unroll
        for (int u = 0; u < 4; ++u) {
            const int n = chunk_order(d, (s + u < NC) ? s + u : NC - 1);
            eo[u] = (((size_t)d * NC + n) * SG + g) * 64 + st;
            ev[u] = endp[eo[u]];
        }
#pragma unroll
        for (int u = 0; u < 4; ++u) if (s + u < NC) {
            float2 c; c.x = cr; c.y = cim; carp[eo[u]] = c;
            const float nr = ar * cr - ai * cim + ev[u].x, ni = ar * cim + ai * cr + ev[u].y;
            cr = nr; cim = ni;
        }
    }
}

__device__ __forceinline__ void phase_side_elem(const P& p, int l) {
    const int lane = otid() & 63;
    const int gw = (obid() * NTHREADS + otid()) >> 6, nw = (gridDim.x * NTHREADS) >> 6;
    const bool actg = lane * 8 < GLA_V, actr = lane * 8 < RW;
    float gng[8], lnw[8], lnb[8];
#pragma unroll
    for (int e = 0; e < 8; ++e) { gng[e] = 0.f; lnw[e] = 0.f; lnb[e] = 0.f; }
    if (actg) load8f(p.in[I_GLA_NG] + (size_t)l * 128 + ((lane * 8) & 127), gng);
    if (actr) { load8f(p.in[I_RLNW] + (size_t)l * RW + lane * 8, lnw); load8f(p.in[I_RLNB] + (size_t)l * RW + lane * 8, lnb); }
    for (int t = gw; t < MTOT; t += nw) {
        float og[8], zo[8], y0[8], y1[8], vv[8];
        const u32x4 z4 = {0u, 0u, 0u, 0u};
#pragma unroll
        for (int e = 0; e < 8; ++e) { og[e] = 0.f; y0[e] = 0.f; y1[e] = 0.f; }
        if (actg) load8f(p.OGLA + (size_t)t * GLA_V + lane * 8, og);
        unpack8(actg ? *(const u32x4*)(p.Z + (size_t)t * D_IN + ZOG + lane * 8) : z4, zo);
        if (actr) { load8f(p.Y + (size_t)t * RW + lane * 8, y0); load8f(p.Y + ((size_t)MTOT + t) * RW + lane * 8, y1); }
        unpack8(actr ? *(const u32x4*)(p.V + (size_t)t * RW + lane * 8) : z4, vv);
        const int hh = (lane * 8) >> 6;
        const float bon = actr ? (p.BONUS[(size_t)t * RH + hh] + p.BONUS[((size_t)MTOT + t) * RH + hh]) : 0.f;
        float ss = 0.f;
#pragma unroll
        for (int e = 0; e < 8; ++e) ss += og[e] * og[e];
        ss += __shfl_xor(ss, 1, 64); ss += __shfl_xor(ss, 2, 64); ss += __shfl_xor(ss, 4, 64); ss += __shfl_xor(ss, 8, 64);
        const float rstd = rsqrtf(ss * (1.0f / 128.f) + 1e-6f);
        float br[8];
#pragma unroll
        for (int e = 0; e < 8; ++e) br[e] = og[e] * rstd * gng[e] * siluf_(zo[e]);
        if (actg) *(u32x4*)(p.BR + (size_t)t * 3 * BW + lane * 8) = pack8(br);
        float y[8]; float sm = 0.f;
#pragma unroll
        for (int e = 0; e < 8; ++e) { y[e] = y0[e] + y1[e]; sm += y[e]; }
        sm += __shfl_xor(sm, 1, 64); sm += __shfl_xor(sm, 2, 64); sm += __shfl_xor(sm, 4, 64);
        const float mu = sm * (1.0f / 64.f);
        float sv = 0.f;
#pragma unroll
        for (int e = 0; e < 8; ++e) { y[e] -= mu; sv += y[e] * y[e]; }
        sv += __shfl_xor(sv, 1, 64); sv += __shfl_xor(sv, 2, 64); sv += __shfl_xor(sv, 4, 64);
        const float rs = rsqrtf(sv * (1.0f / 64.f) + 64e-5f);
        float yn[8];
#pragma unroll
        for (int e = 0; e < 8; ++e) yn[e] = y[e] * rs * lnw[e] + lnb[e] + bon * vv[e];
        if (actr) store8f(p.YN + (size_t)t * RW + lane * 8, yn);
    }
}

__device__ __forceinline__ void phase_side_gemm(const P& p, int l, char* smem) {
    gemm_phase<4>(p.WT_G2, 128, (size_t)NPAD(RW) * 128 * 2, p.GS, 128, (size_t)MTOT * 128 * 2, 128, NPAD(RW), (bf16_t*)smem, NoPre(), NoPre(),
        [&](int, int, int m, int n, const f32x4 v) {
            if (n < RW) { const float4 y = *(const float4*)(p.YN + (size_t)m * RW + n);
                *(u32x2*)(p.BR + (size_t)m * 3 * BW + BW + n) = pack4(y.x * v[0], y.y * v[1], y.z * v[2], y.w * v[3]); }
        });
    gemm_phase<4>(p.WT_GLU, SW, (size_t)NPAD(2 * SW) * SW * 2, p.GY, SW, (size_t)MTOT * SW * 2, SW, 2 * SW, (bf16_t*)smem, NoPre(), NoPre(),
        [&](int, int, int m, int n, const f32x4 v) {
            *(unsigned*)(p.BR + (size_t)m * 3 * BW + 2 * BW + (n >> 1)) = pack2bf(v[0] * sigmoidf_(v[1]), v[2] * sigmoidf_(v[3]));
        });
}

__device__ __forceinline__ void phase_merge(const P& p, int l, char* smem) {
    const int ntn = D_MODEL / 128, ntm = MTOT / 256 - 1;
    auto run = [&](auto mi_tag, int n0, int m0) {
        constexpr int MI = decltype(mi_tag)::value;
        f32x4 acc[4][MI];
#pragma unroll
        for (int i = 0; i < 4; ++i)
#pragma unroll
            for (int j = 0; j < MI; ++j) acc[i][j] = (f32x4){0.f, 0.f, 0.f, 0.f};
        const int lane = otid() & 63, wave = otid() >> 6;
        for (int b = 0; b < 3; ++b) {
            mfma_gemm_tile_t<4, MI>(p.WT_BR + (size_t)b * D_MODEL * BW, BW, (size_t)D_MODEL * BW * 2, p.BR + b * BW, 3 * BW, (size_t)MTOT * 3 * BW * 2 - b * BW * 2, BW, n0, m0, (bf16_t*)smem, acc);
#pragma unroll
            for (int ni = 0; ni < 4; ++ni)
#pragma unroll
                for (int mi = 0; mi < MI; ++mi) {
                    const int n = n0 + (wave >> 1) * 64 + ni * 16 + (lane >> 4) * 4, m = m0 + (wave & 1) * 16 * MI + mi * 16 + (lane & 15);
                    const u32x2 g = *(const u32x2*)(p.Z + (size_t)m * D_IN + ZG + b * D_MODEL + n);
                    float num[4] = {1.f, 1.f, 1.f, 1.f};
                    if (b < 2) {
                        const u32x2 gn = *(const u32x2*)(p.Z + (size_t)m * D_IN + ZG + (b + 1) * D_MODEL + n);
                        num[0] = 1.0f + fexp_(-LO16(gn.x)); num[1] = 1.0f + fexp_(-HI16(gn.x)); num[2] = 1.0f + fexp_(-LO16(gn.y)); num[3] = 1.0f + fexp_(-HI16(gn.y));
                    }
                    acc[ni][mi][0] *= num[0] / (1.0f + fexp_(-LO16(g.x))); acc[ni][mi][1] *= num[1] / (1.0f + fexp_(-HI16(g.x)));
                    acc[ni][mi][2] *= num[2] / (1.0f + fexp_(-LO16(g.y))); acc[ni][mi][3] *= num[3] / (1.0f + fexp_(-HI16(g.y)));
                }
        }
#pragma unroll
        for (int ni = 0; ni < 4; ++ni)
#pragma unroll
            for (int mi = 0; mi < MI; ++mi) {
                const int n = n0 + (wave >> 1) * 64 + ni * 16 + (lane >> 4) * 4, m = m0 + (wave & 1) * 16 * MI + mi * 16 + (lane & 15);
                *(u32x2*)(p.M + (size_t)m * D_MODEL + n) = pack4(acc[ni][mi][0], acc[ni][mi][1], acc[ni][mi][2], acc[ni][mi][3]);
            }
    };
    for (int it = 0;; ++it) {
        int mt_, nt_; if (!tile_map(it, ntm, ntn, (ntn >= 8) ? 4 : 8, mt_, nt_)) break;
        run(std::integral_constant<int, 8>(), nt_ * 128, mt_ * 256);
    }
    for (int job = obid(); job < 4 * ntn; job += gridDim.x) run(std::integral_constant<int, 2>(), (job >> 2) * 128, MTOT - 256 + (job & 3) * 64);
}

__device__ __forceinline__ void phase_outproj(const P& p, int l, char* smem) {
    gemm_phase<4>(p.WT_OUT, D_MODEL, (size_t)D_MODEL * D_MODEL * 2, p.M, D_MODEL, (size_t)MTOT * D_MODEL * 2, D_MODEL, D_MODEL, (bf16_t*)smem, NoPre(), NoPre(),
        [&](int, int, int m, int n, const f32x4 v) {
            const float* g1 = p.MOD + (size_t)(l * 2 + (m >= CTX ? 1 : 0)) * 6 * D_MODEL + 2 * D_MODEL + n;
            float4* xp = (float4*)(p.X + (size_t)m * D_MODEL + n); float4 x = *xp;
            x.x += g1[0] * v[0]; x.y += g1[1] * v[1]; x.z += g1[2] * v[2]; x.w += g1[3] * v[3]; *xp = x;
        });
}

__device__ __forceinline__ void store_q_hilo(const P& p, int m, int n, const f32x4 v) {
    const bf16_t h0 = f2bf(v[0]), h1 = f2bf(v[1]), h2 = f2bf(v[2]), h3 = f2bf(v[3]);
    u32x2 hv; hv.x = (unsigned)h0 | ((unsigned)h1 << 16); hv.y = (unsigned)h2 | ((unsigned)h3 << 16);
    *(u32x2*)(p.QHI + (size_t)m * PQ + n) = hv;
    *(u32x2*)(p.QLO + (size_t)m * PQ + n) = pack4(v[0] - bf2f(h0), v[1] - bf2f(h1), v[2] - bf2f(h2), v[3] - bf2f(h3));
}
__device__ __forceinline__ void phase_peer_q(const P& p, int l, char* smem) {
    gemm_phase<4>(p.WT_Q, D_MODEL, (size_t)PQ * D_MODEL * 2, p.H, D_MODEL, (size_t)MTOT * D_MODEL * 2, D_MODEL, PQ, (bf16_t*)smem, NoPre(), NoPre(),
        [&](int, int, int m, int n, const f32x4 v) { store_q_hilo(p, m, n, v); });
}

#define TK_ROW 129
__device__ __forceinline__ unsigned tk_key(float f, unsigned lowmask, unsigned low) {
    unsigned u = __builtin_bit_cast(unsigned, f);
    u ^= (u & 0x80000000u) ? 0xFFFFFFFFu : 0x80000000u;
    return (u & ~lowmask) | low;
}
#define TK_INSERT(lv, xk) { unsigned x_ = (xk); _Pragma("unroll") for (int z_ = 0; z_ < 16; ++z_) { const unsigned hi_ = lv[z_] > x_ ? lv[z_] : x_; x_ = lv[z_] > x_ ? x_ : lv[z_]; lv[z_] = hi_; } }
__device__ __forceinline__ void phase_peer_topk(const P& p, int l, char* smem) {
    const int tid = otid(), lane = tid & 63, wv = tid >> 6, q = lane >> 4, r = lane & 15;
    float* sc = (float*)smem + wv * (64 * TK_ROW);
    const int gw = (obid() * NTHREADS + tid) >> 6, nw = (gridDim.x * NTHREADS) >> 6;
    const float NEG = -3.0e38f;
    for (int job = gw; job < (MTOT / 32) * PH; job += nw) {
        const int t0 = (job / PH) * 32, h = job % PH;
#pragma unroll
        for (int sd = 0; sd < 2; ++sd) {
            f32x4 acc[2][8];
#pragma unroll
            for (int mt = 0; mt < 2; ++mt)
#pragma unroll
                for (int nt = 0; nt < 8; ++nt) acc[mt][nt] = (f32x4){0.f, 0.f, 0.f, 0.f};
#pragma unroll
            for (int ks = 0; ks < 4; ++ks) {
                bf16x8 ah[2], al[2];
#pragma unroll
                for (int mt = 0; mt < 2; ++mt) {
                    const size_t qo = (size_t)(t0 + mt * 16 + r) * PQ + h * 256 + sd * 128 + ks * 32 + q * 8;
                    ah[mt] = *(const bf16x8*)(p.QHI + qo); al[mt] = *(const bf16x8*)(p.QLO + qo);
                }
#pragma unroll
                for (int nt = 0; nt < 8; ++nt) {
                    const size_t ko = ((size_t)(h * 2 + sd) * 128 + nt * 16 + r) * 128 + ks * 32 + q * 8;
                    const bf16x8 bh = *(const bf16x8*)(p.KHI + ko), bl = *(const bf16x8*)(p.KLO + ko);
#pragma unroll
                    for (int mt = 0; mt < 2; ++mt) {
                        acc[mt][nt] = MFMA16(ah[mt], bh, acc[mt][nt]);
                        acc[mt][nt] = MFMA16(al[mt], bh, acc[mt][nt]);
                        acc[mt][nt] = MFMA16(ah[mt], bl, acc[mt][nt]);
                    }
                }
            }
#pragma unroll
            for (int mt = 0; mt < 2; ++mt)
#pragma unroll
                for (int nt = 0; nt < 8; ++nt)
#pragma unroll
                    for (int e = 0; e < 4; ++e) sc[(sd * 32 + mt * 16 + 4 * q + e) * TK_ROW + nt * 16 + r] = acc[mt][nt][e];
        }
        WAVE_SYNC();
        unsigned lv[16];
#pragma unroll
        for (int z = 0; z < 16; ++z) lv[z] = 0u;
        {
            const float* row = sc + lane * TK_ROW;
#pragma unroll 4
            for (int k = 0; k < 128; ++k) TK_INSERT(lv, tk_key(row[k], 0x7Fu, (unsigned)(127 - k)));
        }
        float lvv[16]; int li[16];
        {
            const float* row = sc + lane * TK_ROW;
#pragma unroll
            for (int z = 0; z < 16; ++z) { li[z] = 127 - (int)(lv[z] & 0x7Fu); lvv[z] = row[li[z]]; }
        }
        WAVE_SYNC();
        {
            float* row = sc + lane * TK_ROW;
#pragma unroll
            for (int z = 0; z < 16; ++z) { row[z] = lvv[z]; ((int*)row)[16 + z] = li[z]; }
        }
        WAVE_SYNC();
        const float* r1 = sc + (lane & 31) * TK_ROW; const float* r2 = sc + (32 + (lane & 31)) * TK_ROW;
        unsigned tk[16];
#pragma unroll
        for (int z = 0; z < 16; ++z) tk[z] = 0u;
        for (int i = 0; i < 16; ++i) {
            const float a = r1[i];
            const int nj = 16 / (i + 1);
            for (int j = 0; j < nj; ++j) TK_INSERT(tk, tk_key(a + r2[j], 0xFFu, (unsigned)(255 - (i * 16 + j))));
        }
        int tc[16];
#pragma unroll
        for (int z = 0; z < 16; ++z) tc[z] = 255 - (int)(tk[z] & 0xFFu);
        if (lane < 32) {
            float vals[16]; float mx = 0.f; float ssum = 0.f;
#pragma unroll
            for (int z = 0; z < 16; ++z) { vals[z] = r1[tc[z] >> 4] + r2[tc[z] & 15]; if (z == 0) mx = vals[0]; vals[z] = fexp_(vals[z] - mx); ssum += vals[z]; }
            const float inv = 1.0f / ssum;
            const size_t o = (size_t)(t0 + lane) * PH * 16 + h * 16;
#pragma unroll
            for (int z = 0; z < 16; ++z) {
                const int ex_ = ((const int*)r1)[16 + (tc[z] >> 4)] * 128 + ((const int*)r2)[16 + (tc[z] & 15)];
                p.IDX[o + z] = ex_;
                p.G[o + z] = vals[z] * inv * p.VSC[ex_];
                p.GU[o + z] = p.USC[ex_];
            }
        }
        WAVE_SYNC();
    }
}

#define PEER_CONV_JOBS (2 * NEXP / 4)
__device__ __forceinline__ void peer_conv_job(const P& p, int l, int job) {
    const int tid = otid(), lane = tid & 63, wv = tid >> 6;
    if (wv >= 4) return;
    const int rowg = job * 4 + wv; const int which = rowg / NEXP, row = rowg % NEXP;
    const float* src = p.in[which ? I_PV : I_PU] + ((size_t)l * NEXP + row) * D_MODEL + lane * 16;
    const bool act = lane * 16 < D_MODEL;
    float v[16]; float amax = 0.f;
#pragma unroll
    for (int c = 0; c < 4; ++c) {
        float4 a; a.x = 0.f; a.y = 0.f; a.z = 0.f; a.w = 0.f;
        if (act) a = *(const float4*)(src + c * 4);
        v[c * 4 + 0] = a.x; v[c * 4 + 1] = a.y; v[c * 4 + 2] = a.z; v[c * 4 + 3] = a.w;
        amax = fmaxf(amax, fmaxf(fmaxf(fabsf(a.x), fabsf(a.y)), fmaxf(fabsf(a.z), fabsf(a.w))));
    }
#pragma unroll
    for (int m = 32; m >= 1; m >>= 1) amax = fmaxf(amax, __shfl_xor(amax, m, 64));
    int ex = 0;
    if (amax > 0.f) ex = 7 - (int)((__builtin_bit_cast(unsigned, amax) >> 23) & 0xFF) + 127;
    ex = ex < -100 ? -100 : (ex > 100 ? 100 : ex);
    const float sc = __builtin_bit_cast(float, (unsigned)(ex + 127) << 23), isc = __builtin_bit_cast(float, (unsigned)(127 - ex) << 23);
    u32x4 o;
    int w0 = 0, w1 = 0, w2 = 0, w3 = 0;
    w0 = CVT_PK_FP8(v[0] * sc, v[1] * sc, w0, false); w0 = CVT_PK_FP8(v[2] * sc, v[3] * sc, w0, true);
    w1 = CVT_PK_FP8(v[4] * sc, v[5] * sc, w1, false); w1 = CVT_PK_FP8(v[6] * sc, v[7] * sc, w1, true);
    w2 = CVT_PK_FP8(v[8] * sc, v[9] * sc, w2, false); w2 = CVT_PK_FP8(v[10] * sc, v[11] * sc, w2, true);
    w3 = CVT_PK_FP8(v[12] * sc, v[13] * sc, w3, false); w3 = CVT_PK_FP8(v[14] * sc, v[15] * sc, w3, true);
    o.x = (unsigned)w0; o.y = (unsigned)w1; o.z = (unsigned)w2; o.w = (unsigned)w3;
    unsigned char* dst = (which ? p.V8 : p.U8) + (size_t)row * D_MODEL + lane * 16;
    if (act) *(u32x4*)dst = o;
    if (lane == 0) (which ? p.VSC : p.USC)[row] = isc;
}
#define GE 4
struct GBuf { u32x4 u[GE]; u32x4 v[GE]; float gu; float gv; };
__device__ __forceinline__ void gather_load(const P& p, GBuf& b, int g, int idx0, int idx1, float g0, float g1, float u0, float u1, int lane) {
    const bool act = lane * 16 < D_MODEL;
#pragma unroll
    for (int q = 0; q < GE; ++q) {
        const int k = g * GE + q;
        const int ei = __shfl((k < 64) ? idx0 : idx1, k & 63, 64);
        b.u[q] = act ? *(const u32x4*)(p.U8 + (size_t)ei * D_MODEL + lane * 16) : (u32x4){0u, 0u, 0u, 0u};
        b.v[q] = act ? *(const u32x4*)(p.V8 + (size_t)ei * D_MODEL + lane * 16) : (u32x4){0u, 0u, 0u, 0u};
    }
    const int km = g * GE + ((lane >> 4) & 3);
    b.gv = __shfl((km < 64) ? g0 : g1, km & 63, 64);
    b.gu = __shfl((km < 64) ? u0 : u1, km & 63, 64);
}
__device__ __forceinline__ void gather_compute(const GBuf& b, const float (&hv)[16], float (&acc)[16], int lane) {
    float dt[GE];
#pragma unroll
    for (int q = 0; q < GE; ++q) {
        float d = 0.f;
#pragma unroll
        for (int c = 0; c < 4; ++c) {
            const f32x2 lo = CVT_PK_F32_FP8((int)b.u[q][c], false), hi = CVT_PK_F32_FP8((int)b.u[q][c], true);
            d += hv[c * 4 + 0] * lo.x + hv[c * 4 + 1] * lo.y + hv[c * 4 + 2] * hi.x + hv[c * 4 + 3] * hi.y;
        }
        dt[q] = d;
    }
    float r2[2], r1;
    {
        const bool up = (lane & 32) != 0;
#pragma unroll
        for (int q = 0; q < 2; ++q) { const float keep = up ? dt[2 + q] : dt[q], send = up ? dt[q] : dt[2 + q]; r2[q] = keep + __shfl_xor(send, 32, 64); }
    }
    {
        const bool up = (lane & 16) != 0;
        const float keep = up ? r2[1] : r2[0], send = up ? r2[0] : r2[1];
        r1 = keep + __shfl_xor(send, 16, 64);
    }
    r1 += __shfl_xor(r1, 8, 64); r1 += __shfl_xor(r1, 4, 64); r1 += __shfl_xor(r1, 2, 64); r1 += __shfl_xor(r1, 1, 64);
    const float coef_mine = b.gv * geluf_(r1 * b.gu);
#pragma unroll
    for (int q = 0; q < GE; ++q) {
        const float coef = __shfl(coef_mine, q * 16, 64);
#pragma unroll
        for (int c = 0; c < 4; ++c) {
            const f32x2 lo = CVT_PK_F32_FP8((int)b.v[q][c], false), hi = CVT_PK_F32_FP8((int)b.v[q][c], true);
            acc[c * 4 + 0] += coef * lo.x; acc[c * 4 + 1] += coef * lo.y; acc[c * 4 + 2] += coef * hi.x; acc[c * 4 + 3] += coef * hi.y;
        }
    }
}
__device__ __forceinline__ void phase_peer_gather(const P& p, int l) {
    const int lane = otid() & 63;
    const int gw = (obid() * NTHREADS + otid()) >> 6, nw = (gridDim.x * NTHREADS) >> 6;
    constexpr int NG = PH * 16 / GE;
    const bool act = lane * 16 < D_MODEL;
    for (int t = gw; t < MTOT; t += nw) {
        float hv[16], acc[16];
        {
            const u32x4 z4 = {0u, 0u, 0u, 0u};
            const u32x4 ha = act ? *(const u32x4*)(p.H + (size_t)t * D_MODEL + lane * 16) : z4;
            const u32x4 hb = act ? *(const u32x4*)(p.H + (size_t)t * D_MODEL + lane * 16 + 8) : z4;
            hv[0] = LO16(ha.x); hv[1] = HI16(ha.x); hv[2] = LO16(ha.y); hv[3] = HI16(ha.y); hv[4] = LO16(ha.z); hv[5] = HI16(ha.z); hv[6] = LO16(ha.w); hv[7] = HI16(ha.w);
            hv[8] = LO16(hb.x); hv[9] = HI16(hb.x); hv[10] = LO16(hb.y); hv[11] = HI16(hb.y); hv[12] = LO16(hb.z); hv[13] = HI16(hb.z); hv[14] = LO16(hb.w); hv[15] = HI16(hb.w);
#pragma unroll
            for (int j = 0; j < 16; ++j) acc[j] = 0.f;
        }
        int idx0 = 0, idx1 = 0; float g0 = 0.f, g1 = 0.f, u0 = 0.f, u1 = 0.f;
        if (lane < PH * 16) { idx0 = p.IDX[(size_t)t * PH * 16 + lane]; g0 = p.G[(size_t)t * PH * 16 + lane]; u0 = p.GU[(size_t)t * PH * 16 + lane]; }
        if (64 + lane < PH * 16) { idx1 = p.IDX[(size_t)t * PH * 16 + 64 + lane]; g1 = p.G[(size_t)t * PH * 16 + 64 + lane]; u1 = p.GU[(size_t)t * PH * 16 + 64 + lane]; }
        GBuf b0, b1, b2;
        gather_load(p, b0, 0, idx0, idx1, g0, g1, u0, u1, lane);
        gather_load(p, b1, 1, idx0, idx1, g0, g1, u0, u1, lane);
        for (int g = 0; g < NG; g += 3) {
            if (g + 2 < NG) gather_load(p, b2, g + 2, idx0, idx1, g0, g1, u0, u1, lane);
            gather_compute(b0, hv, acc, lane);
            if (g + 1 < NG) {
                if (g + 3 < NG) gather_load(p, b0, g + 3, idx0, idx1, g0, g1, u0, u1, lane);
                gather_compute(b1, hv, acc, lane);
            }
            if (g + 2 < NG) {
                if (g + 4 < NG) gather_load(p, b1, g + 4, idx0, idx1, g0, g1, u0, u1, lane);
                gather_compute(b2, hv, acc, lane);
            }
        }
        if (act) {
            const float* g2 = p.MOD + (size_t)(l * 2 + (t >= CTX ? 1 : 0)) * 6 * D_MODEL + 5 * D_MODEL + lane * 16;
            float* xp = p.X + (size_t)t * D_MODEL + lane * 16;
#pragma unroll
            for (int c = 0; c < 4; ++c) {
                float4 x = *(float4*)(xp + c * 4);
                x.x += g2[c * 4 + 0] * acc[c * 4 + 0]; x.y += g2[c * 4 + 1] * acc[c * 4 + 1]; x.z += g2[c * 4 + 2] * acc[c * 4 + 2]; x.w += g2[c * 4 + 3] * acc[c * 4 + 3];
                *(float4*)(xp + c * 4) = x;
            }
        }
    }
}

__device__ __forceinline__ void phase_final(const P& p) {
    const int lane = otid() & 63;
    const int gw = (obid() * NTHREADS + otid()) >> 6, nw = (gridDim.x * NTHREADS) >> 6;
    const float* g = p.in[I_FG];
    for (int t = gw; t < SEQ; t += nw) {
        const float* x = p.X + (size_t)(CTX + t) * D_MODEL;
        float v[D_MODEL / 64]; float ss = 0.f;
#pragma unroll
        for (int j = 0; j < D_MODEL / 64; ++j) { v[j] = x[lane + 64 * j]; ss += v[j] * v[j]; }
        ss = wave_sum(ss);
        float rstd = rsqrtf(ss / D_MODEL + 1e-6f);
#pragma unroll
        for (int j = 0; j < D_MODEL / 64; ++j) p.out[(size_t)t * D_MODEL + lane + 64 * j] = v[j] * rstd * g[lane + 64 * j];
    }
}

__global__ void __launch_bounds__(NTHREADS) fwd_megakernel(P p_arg) {
#ifdef EMU
    char* smem = emu_smem();
#else
    __shared__ __attribute__((aligned(16))) char smem_raw[SMEM_BYTES + 16];
    char* smem = smem_raw;
#endif
#ifndef EMU
    volatile LAS unsigned* xst = (volatile LAS unsigned*)(smem_raw + SMEM_BYTES);
    if (threadIdx.x == 0) { xst[0] = 0u; xst[1] = 0u; xst[2] = 0u; xst[3] = 0u; }
    __syncthreads();
    XcdBarrier xb = xcd_barrier_post(p_arg.bar, xst);
#endif
    { LOADP(); phase_init(p, smem); }
#ifndef EMU
    cg::this_grid().sync();
#endif
    GRID_SYNC();
    PROBE_INIT();
    for (int l = 0; l < DEPTH; ++l) {
        { LOADP(); phase_norm(p, l, 0); }
        { LOADP(); phase_s5const(p, l); }
        { LOADP(); phase_convert_weights(p, l, smem); }
        GRID_SYNC(); PROBE_AFTER(0);
        { LOADP(); phase_gemm_in(p, l, smem); }
        GRID_SYNC(); PROBE_AFTER(1);
        { LOADP(); phase_rwkv_prep1(p, l); }
        GRID_SYNC(); PROBE_AFTER(14);
        { LOADP(); phase_rwkv_prep2(p, l, smem); }
        GRID_SYNC(); PROBE_AFTER(2);
        { LOADP(); for (int job = obid(); job < 2 * NC * RH; job += gridDim.x) rwkv_chunk_job(p, job, smem); }
        __syncthreads();
        { LOADP(); phase_gla_kv(p, l, smem); }
        { LOADP(); phase_s5_pass(p, l, smem, false); }
        GRID_SYNC(); PROBE_AFTER(3);
        {
            LOADP();
            const int n_rw = 2 * RH, n_gla = 2 * GH * 8192 / NTHREADS, n_s5 = (2 * SG * 64 + NTHREADS - 1) / NTHREADS;
            for (int job = obid(); job < n_rw + n_gla + n_s5 + PEER_CONV_JOBS; job += gridDim.x) {
                if (job < n_rw) rwkv_seq_job(p, job, smem);
                else if (job < n_rw + n_gla) gla_scan_job(p, job - n_rw);
                else if (job < n_rw + n_gla + n_s5) s5_carry_job(p, job - n_rw - n_gla);
                else peer_conv_job(p, l, job - n_rw - n_gla - n_s5);
            }
        }
        GRID_SYNC(); PROBE_AFTER(4);
        { LOADP(); for (int job = obid(); job < 2 * NC * RH; job += gridDim.x) rwkv_out_job(p, job); }
        { LOADP(); phase_gla_out(p, l, smem); }
        { LOADP(); phase_s5_pass(p, l, smem, true); }
        GRID_SYNC(); PROBE_AFTER(5);
        { LOADP(); phase_side_elem(p, l); }
        GRID_SYNC(); PROBE_AFTER(6);
        { LOADP(); phase_side_gemm(p, l, smem); }
        GRID_SYNC(); PROBE_AFTER(7);
        { LOADP(); phase_merge(p, l, smem); }
        GRID_SYNC(); PROBE_AFTER(8);
        { LOADP(); phase_outproj(p, l, smem); }
        GRID_SYNC(); PROBE_AFTER(9);
        { LOADP(); phase_norm(p, l, 1); }
        GRID_SYNC(); PROBE_AFTER(10);
        { LOADP(); phase_peer_q(p, l, smem); }
        GRID_SYNC(); PROBE_AFTER(11);
        { LOADP(); phase_peer_topk(p, l, smem); }
        GRID_SYNC(); PROBE_AFTER(12);
        { LOADP(); phase_peer_gather(p, l); }
        GRID_SYNC(); PROBE_AFTER(13);
    }
    { LOADP(); phase_final(p); }
}

static inline size_t align_up(size_t x) { return (x + 255) & ~(size_t)255; }

extern "C" void kernel_launch(void* const* d_in, const int* in_sizes, int n_in, void* d_out, int out_size, void* d_ws, size_t ws_size, hipStream_t stream) {
    P p;
    memset(&p, 0, sizeof(p));
    for (int i = 0; i < 39; ++i) p.in[i] = (const float*)d_in[i];
    p.out = (float*)d_out;
    char* w = (char*)d_ws; size_t off = 0;
    auto take = [&](size_t bytes) { void* r = w + off; off = align_up(off + bytes); return r; };
    p.bar = (unsigned*)take(16384);
    p.X = (float*)take((size_t)MTOT * D_MODEL * 4);
    p.H = (bf16_t*)take((size_t)MTOT * D_MODEL * 2);
    p.MOD = (float*)take((size_t)DEPTH * 2 * 6 * D_MODEL * 4);
    p.Z = (bf16_t*)take((size_t)MTOT * D_IN * 2);
    p.V = (bf16_t*)take((size_t)MTOT * RW * 2);
    {
        char* ra = (char*)take((size_t)MTOT * RW * 2 * 2 > (size_t)MTOT * GLA_V * 4 ? (size_t)MTOT * RW * 2 * 2 : (size_t)MTOT * GLA_V * 4);
        p.R = (bf16_t*)ra; p.KK = (bf16_t*)(ra + (size_t)MTOT * RW * 2);
        p.OGLA = (float*)ra;
    }
    {
        char* rb = (char*)take((size_t)2 * MTOT * RW * 2 > (size_t)3 * MTOT * PH * 16 * 4 ? (size_t)2 * MTOT * RW * 2 : (size_t)3 * MTOT * PH * 16 * 4);
        p.KD = (bf16_t*)rb;
        p.IDX = (int*)rb; p.G = (float*)(rb + (size_t)MTOT * PH * 16 * 4); p.GU = (float*)(rb + (size_t)2 * MTOT * PH * 16 * 4);
    }
    p.BB = (bf16_t*)take((size_t)2 * MTOT * RW * 2);
    p.LW = (float*)take((size_t)2 * MTOT * RW * 4);
    p.SP = (bf16_t*)p.LW;
    static_assert((size_t)2 * NC * GH * 8192 * 2 <= (size_t)2 * MTOT * RW * 4, "SP alias");
    p.BONUS = (float*)take((size_t)2 * MTOT * RH * 4);
    p.KS = (bf16_t*)take((size_t)MTOT * RW * 2);
    p.LR = (bf16_t*)take((size_t)MTOT * 256 * 2);
    p.WT_W2 = (bf16_t*)take((size_t)2 * NPAD(RW) * 64 * 2);
    p.WT_A2 = (bf16_t*)take((size_t)2 * NPAD(RW) * 64 * 2);
    p.GS = (bf16_t*)take((size_t)MTOT * 128 * 2);
    p.Y = (float*)take((size_t)2 * MTOT * RW * 4);
    p.KV = (float*)take((size_t)2 * NC * GH * 8192 * 4);
    p.DEC = (float*)take((size_t)2 * NC * GH * 64 * 4);
    p.S5A = (float*)take((size_t)2 * SG * 64 * 2 * 4);
    p.S5BB = (float*)take((size_t)2 * SG * 64 * 16 * 2 * 4);
    p.S5END = (float*)take((size_t)2 * NC * SG * 64 * 2 * 4);
    p.S5CAR = (float*)take((size_t)2 * NC * SG * 64 * 2 * 4);
    {
        const size_t szc1 = (size_t)2 * NC * RH * SEQ_REC;
        const size_t szc2 = (size_t)MTOT * SW * 2 + (size_t)MTOT * RW * 4 + (size_t)MTOT * 3 * BW * 2 + (size_t)MTOT * D_MODEL * 2 + 1024;
        char* rc = (char*)take(szc1 > szc2 ? szc1 : szc2);
        p.REC = rc;
        char* c2 = rc;
        p.GY = (bf16_t*)c2; c2 += align_up((size_t)MTOT * SW * 2);
        p.YN = (float*)c2; c2 += align_up((size_t)MTOT * RW * 4);
        p.BR = (bf16_t*)c2; c2 += align_up((size_t)MTOT * 3 * BW * 2);
        p.M = (bf16_t*)c2;
    }
    p.SN = (bf16_t*)take((size_t)2 * NC * RH * 4096 * 2);
    p.QH = (bf16_t*)take((size_t)2 * NC * RH * 4096 * 2);
    p.WT_IN = (bf16_t*)take((size_t)NPAD192(D_IN) * D_MODEL * 2);
    p.WT_G2 = (bf16_t*)take((size_t)NPAD(RW) * 128 * 2);
    p.WT_GLU = (bf16_t*)take((size_t)NPAD(2 * SW) * SW * 2);
    p.WT_BR = (bf16_t*)take((size_t)3 * D_MODEL * BW * 2);
    p.WT_OUT = (bf16_t*)take((size_t)D_MODEL * D_MODEL * 2);
    p.WT_Q = (bf16_t*)take((size_t)PQ * D_MODEL * 2);
    p.U8 = (unsigned char*)take((size_t)NEXP * D_MODEL);
    p.V8 = (unsigned char*)take((size_t)NEXP * D_MODEL);
    p.USC = (float*)take((size_t)NEXP * 4); p.VSC = (float*)take((size_t)NEXP * 4);
    p.QHI = p.Z; p.QLO = p.Z + (size_t)MTOT * PQ;
    p.KHI = (bf16_t*)take((size_t)PH * 2 * 128 * 128 * 2); p.KLO = (bf16_t*)take((size_t)PH * 2 * 128 * 128 * 2);
    static_assert((size_t)PQ * 4 <= (size_t)D_IN * 2, "Q alias");
    if (off > ws_size) { fprintf(stderr, "ws too small: need %zu have %zu\n", off, ws_size); return; }
#ifdef EMU
    fprintf(stderr, "ws used %zu MB\n", off >> 20);
    emu_launch([=] { fwd_megakernel(p); }, EMU_GRID, NTHREADS);
#else
    hipMemsetAsync(p.bar, 0, 16384, stream);
    static int grid_blocks = 0;
    if (!grid_blocks) {
        int dev = 0, cus = 0, per_cu = 0;
        hipGetDevice(&dev);
        hipDeviceGetAttribute(&cus, hipDeviceAttributeMultiprocessorCount, dev);
        hipOccupancyMaxActiveBlocksPerMultiprocessor(&per_cu, fwd_megakernel, NTHREADS, 0);
        if (per_cu > 1) per_cu = 1;
        grid_blocks = cus * per_cu;
    }
    void* args[] = {&p};
    hipError_t e = hipLaunchCooperativeKernel((void*)fwd_megakernel, dim3(grid_blocks), dim3(NTHREADS), args, 0, stream);
    if (e != hipSuccess) fprintf(stderr, "cooperative launch failed: %s (grid %d)\n", hipGetErrorString(e), grid_blocks);
#endif
}
```

```cpp
#include <hip/hip_runtime.h>
#ifndef EMU
#include <hip/hip_cooperative_groups.h>
namespace cg = cooperative_groups;
#endif
#include <cstdio>
#include <cstdint>
#include <cstring>
#include <type_traits>

#ifdef CFG_SMALL
#define D_MODEL 128
#define SEQ 640
#define DEPTH 2
#define GRID_W 10
#define CTX 128
#define GH 1
#define RH 2
#define SG 8
#define PH 2
#else
#define D_MODEL 1024
#define SEQ 16384
#define DEPTH 4
#define GRID_W 64
#define CTX 256
#define GH 4
#define RH 8
#define SG 32
#define PH 8
#endif
#define MTOT (CTX + SEQ)
#define ROWS (SEQ / GRID_W)
#define GLA_K (GH * 64)
#define GLA_V (GH * 128)
#define RW (RH * 64)
#define RWKV_IN (3 * RW + 4 * 64 + 128)
#define SW (SG * 16)
#define BW GLA_V
#define ZQ 0
#define ZK (GLA_K)
#define ZV (2 * GLA_K)
#define ZOG (ZV + GLA_V)
#define ZAF (ZOG + GLA_V)
#define ZAB (ZAF + 16)
#define ZR (ZAB + 16)
#define ZS5 (ZR + RWKV_IN)
#define ZG (ZS5 + SW)
#define D_IN (ZG + 3 * D_MODEL)
#define ZLD ZG
#define NC (MTOT / 64)
#define NCC (CTX / 64)
#define RB (ROWS / 64)
#define PQ (PH * 256)
#define NEXP 16384
#define NTHREADS 256
#define SMEM_BYTES 133120

typedef unsigned short bf16_t;
typedef short bf16x8 __attribute__((ext_vector_type(8)));
typedef float f32x4 __attribute__((ext_vector_type(4)));
typedef unsigned u32x4 __attribute__((ext_vector_type(4)));
typedef unsigned u32x2 __attribute__((ext_vector_type(2)));
#ifdef EMU
#define MFMA16(a, b, c) emu_mfma_16x16x32_bf16(a, b, c)
#else
#define MFMA16(a, b, c) __builtin_amdgcn_mfma_f32_16x16x32_bf16(a, b, c, 0, 0, 0)
#endif
typedef float f32x2 __attribute__((ext_vector_type(2)));
#ifdef EMU
#define CVT_PK_FP8(a, b, old, hi) emu_cvt_pk_fp8_f32(a, b, old, hi)
#define CVT_PK_F32_FP8(w, hi) emu_cvt_pk_f32_fp8(w, hi)
#else
#define CVT_PK_FP8(a, b, old, hi) __builtin_amdgcn_cvt_pk_fp8_f32(a, b, old, hi)
#define CVT_PK_F32_FP8(w, hi) __builtin_amdgcn_cvt_pk_f32_fp8(w, hi)
#endif
#ifdef EMU
#define MFMA16_ACC(a, b, c) c = emu_mfma_16x16x32_bf16(a, b, c)
#else
#define MFMA16_ACC(a, b, c) asm volatile("v_mfma_f32_16x16x32_bf16 %0, %1, %2, %0" : "+a"(c) : "v"(a), "v"(b))
#endif
#define NPAD(n) (((n) + 127) / 128 * 128)
#define NPAD192(n) (((n) + 383) / 384 * 384)

__device__ __forceinline__ float bf2f(bf16_t h) { return __builtin_bit_cast(float, ((unsigned)h) << 16); }
#ifdef EMU
__device__ __forceinline__ bf16_t f2bf(float f) { unsigned u = __builtin_bit_cast(unsigned, f); u += 0x7FFFu + ((u >> 16) & 1u); return (bf16_t)(u >> 16); }
__device__ __forceinline__ unsigned pack2bf(float a, float b) { return (unsigned)f2bf(a) | ((unsigned)f2bf(b) << 16); }
#else
typedef float f2v_t __attribute__((ext_vector_type(2))); typedef __bf16 b2v_t __attribute__((ext_vector_type(2)));
__device__ __forceinline__ bf16_t f2bf(float f) { return __builtin_bit_cast(unsigned short, (__bf16)f); }
__device__ __forceinline__ unsigned pack2bf(float a, float b) { f2v_t v = {a, b}; b2v_t r = __builtin_convertvector(v, b2v_t); return __builtin_bit_cast(unsigned, r); }
#endif
#ifdef EMU
#define fexp_(x) expf(x)
#define flog_(x) logf(x)
#else
#define fexp_(x) __expf(x)
#define flog_(x) __logf(x)
#endif
#define LO16(x) __builtin_bit_cast(float, (x) << 16)
#define HI16(x) __builtin_bit_cast(float, (x) & 0xFFFF0000u)
__device__ __forceinline__ float sigmoidf_(float x) { return 1.0f / (1.0f + fexp_(-x)); }
__device__ __forceinline__ float siluf_(float x) { return x * sigmoidf_(x); }
__device__ __forceinline__ float geluf_(float x) { const float y = 1.5957691216057308f * (x + 0.044715f * x * x * x); return x / (1.0f + fexp_(-y)); }
__device__ __forceinline__ float softplusf_(float x) { return fmaxf(x, 0.f) + flog_(1.0f + fexp_(-fabsf(x))); }
__device__ __forceinline__ float tanhf_(float x) { const float e = fexp_(-2.0f * fabsf(x)); const float t = (1.0f - e) / (1.0f + e); return x < 0.f ? -t : t; }
__device__ __forceinline__ float wave_sum(float v) {
#pragma unroll
    for (int m = 32; m >= 1; m >>= 1) v += __shfl_xor(v, m, 64);
    return v;
}

struct P {
    const float* in[39];
    float* out;
    float* X;
    bf16_t* H;
    bf16_t* Z;
    bf16_t* ZGT;
    float* MOD;
    bf16_t* R; bf16_t* V; bf16_t* KK; bf16_t* KD; bf16_t* BB;
    float* LW;
    char* REC;
    bf16_t* SN;
    bf16_t* QH;
    float* BONUS;
    bf16_t* KS;
    bf16_t* LR;
    bf16_t* WT_W2;
    bf16_t* WT_A2;
    bf16_t* GS;
    float* Y;
    float* KV;
    bf16_t* SP;
    float* DEC;
    float* OGLA;
    float* S5A;
    float* S5BB;
    float* S5END;
    float* S5CAR;
    bf16_t* GY;
    float* YN;
    bf16_t* BR;
    bf16_t* M;
    bf16_t* QHI; bf16_t* QLO;
    bf16_t* KHI; bf16_t* KLO;
    int* IDX;
    float* G;
    float* GU;
    unsigned* bar;
    bf16_t* WT_IN;
    bf16_t* WT_G2;
    bf16_t* WT_GLU;
    bf16_t* WT_BR;
    bf16_t* WT_OUT;
    bf16_t* WT_Q;
    unsigned char* U8; unsigned char* V8;
    float* USC; float* VSC;
};

enum { I_X = 0, I_C, I_CTX, I_CCTX, I_WMOD, I_BMOD, I_N1G, I_N2G, I_WIN, I_GLA_WA2, I_GLA_BA, I_GLA_NG, I_RCONV, I_RW0, I_RW2, I_RA0, I_RA2, I_RG2,
       I_RKK, I_RKA, I_RRK, I_RLNW, I_RLNB, I_S5LRE, I_S5LIM, I_S5LS, I_S5BRE, I_S5BIM, I_S5CRE, I_S5CIM, I_S5D, I_S5GLU, I_WBR, I_WOUT, I_PWQ, I_PKEYS, I_PU, I_PV, I_FG };

#ifdef EMU
__device__ __forceinline__ int otid() { return threadIdx.x; }
__device__ __forceinline__ int obid() { return blockIdx.x; }
#else
__device__ __forceinline__ int otid() { int t = threadIdx.x; asm volatile("" : "+v"(t)); return t; }
__device__ __forceinline__ int obid() { int b = blockIdx.x; asm volatile("" : "+s"(b)); return b; }
#endif
#ifdef EMU
#define WAVE_SYNC() emu_wave_barrier()
#ifndef EMU_GRID
#define EMU_GRID 4
#endif
#else
#define WAVE_SYNC() __builtin_amdgcn_wave_barrier()
#endif
#ifndef EMU
#define XB_TMO      128
#define XB_XCNT(j)  (256  + 64 * (j))
#define XB_XSUB(j)  (1280 + 64 * (j))
#define XB_XGEN(j)  (2304 + 64 * (j))
#define XB_TOP      3328
#define XB_TOPGEN   3392
#define XCD_BAR_WORDS 3456
#define XB_SPIN_CAP (1u << 22)
#define LAS __attribute__((address_space(3)))
__device__ __forceinline__ unsigned xb_ld(unsigned* p)              { return __hip_atomic_load(p, __ATOMIC_RELAXED, __HIP_MEMORY_SCOPE_AGENT); }
__device__ __forceinline__ unsigned xb_add(unsigned* p, unsigned v) { return __hip_atomic_fetch_add(p, v, __ATOMIC_RELAXED, __HIP_MEMORY_SCOPE_AGENT); }
__device__ __forceinline__ unsigned xb_xcc_id() { return (unsigned)__builtin_amdgcn_s_getreg((3 << 11) | 20) & 0xFu; }
#define XB_SPIN(cond, bar) do { unsigned _sp = 0; while (cond) { __builtin_amdgcn_s_sleep(1); \
    if ((++_sp & 255u) == 0u) { if (xb_ld(&(bar)[XB_TMO])) break; if (_sp > XB_SPIN_CAP) { atomicAdd(&(bar)[XB_TMO], 1u); break; } } } } while (0)
struct XcdBarrier { unsigned* bar; unsigned x; volatile LAS unsigned* st; };
__device__ __forceinline__ XcdBarrier xcd_barrier_post(unsigned* bar, volatile LAS unsigned* st) {
    XcdBarrier b; b.bar = bar; b.x = xb_xcc_id(); b.st = st;
    if (threadIdx.x == 0) st[3] = xb_add(&bar[XB_XCNT(b.x)], 1u);
    return b;
}
__device__ __forceinline__ void xcd_barrier_complete(unsigned* bar, unsigned x, unsigned& nloc, unsigned& nx) {
    const unsigned G = gridDim.x * gridDim.y * gridDim.z;
    unsigned sum, cnt, mine, sp = 0u;
    for (;;) {
        sum = 0u; cnt = 0u; mine = 0u;
#pragma unroll
        for (unsigned j = 0; j < 16; ++j) { const unsigned c = xb_ld(&bar[XB_XCNT(j)]); sum += c; cnt += (c > 0u) ? 1u : 0u; mine = (j == x) ? c : mine; }
        if (sum == G) break;
        __builtin_amdgcn_s_sleep(1);
        if ((++sp & 255u) == 0u) { if (xb_ld(&bar[XB_TMO])) break; if (sp > XB_SPIN_CAP) { atomicAdd(&bar[XB_TMO], 1u); break; } }
    }
    nloc = mine > 0u ? mine : 1u; nx = cnt > 0u ? cnt : 1u;
}
__device__ __forceinline__ void xcd_barrier(const XcdBarrier& b) {
    asm volatile("s_waitcnt vmcnt(0)" ::: "memory");
    __syncthreads();
    if (threadIdx.x == 0) {
        unsigned* bar = b.bar;
        __builtin_amdgcn_s_waitcnt(0);
        unsigned nloc = b.st[0], nx = b.st[1];
        if (nloc == 0u) { xcd_barrier_complete(bar, b.x, nloc, nx); b.st[0] = nloc; b.st[1] = nx; }
        const unsigned old = xb_add(&bar[XB_XSUB(b.x)], 1u);
        const unsigned gen = old / nloc;
        if (old + 1u == (gen + 1u) * nloc) {
            __builtin_amdgcn_fence(__ATOMIC_RELEASE, "agent");
            asm volatile("s_waitcnt vmcnt(0)" ::: "memory");
            const unsigned og = xb_add(&bar[XB_TOP], 1u);
            const unsigned tg = og / nx;
            if (og + 1u == (tg + 1u) * nx) xb_add(&bar[XB_TOPGEN], 1u);
            else XB_SPIN(xb_ld(&bar[XB_TOPGEN]) == tg, bar);
            __builtin_amdgcn_fence(__ATOMIC_ACQUIRE, "agent");
            xb_add(&bar[XB_XGEN(b.x)], 1u);
            asm volatile("s_waitcnt vmcnt(0)" ::: "memory");
        } else {
            XB_SPIN(xb_ld(&bar[XB_XGEN(b.x)]) == gen, bar);
            __builtin_amdgcn_fence(__ATOMIC_ACQUIRE, "agent");
            asm volatile("s_waitcnt vmcnt(0)" ::: "memory");
        }
    }
    __syncthreads();
}
#define GRID_SYNC() xcd_barrier(xb)
#else
#define GRID_SYNC() emu_grid_sync()
#endif

#ifdef EMU
#define LOADP() const P& p = p_arg
#else
typedef __attribute__((address_space(4))) const unsigned long long cu64_t;
__device__ __forceinline__ void load_params(P& p) {
    cu64_t* q = (cu64_t*)__builtin_amdgcn_kernarg_segment_ptr();
    asm volatile("" : "+s"(q));
    unsigned long long w[sizeof(P) / 8];
#pragma unroll
    for (int i = 0; i < (int)(sizeof(P) / 8); ++i) w[i] = q[i];
    __builtin_memcpy(&p, w, sizeof(P));
}
#define LOADP() P p; load_params(p)
#endif
#define PROBE_MULT 3
#if defined(PROBE_ID) && !defined(EMU)
#define PROBE_INIT() unsigned long long probe_t0 = wall_clock64()
#define PROBE_AFTER(id) { if (blockIdx.x == 0) { unsigned long long now_ = wall_clock64(); if ((id) == PROBE_ID) { const unsigned long long dt_ = now_ - probe_t0; \
    while (wall_clock64() - now_ < dt_ * PROBE_MULT) __builtin_amdgcn_s_sleep(8); now_ = wall_clock64(); } probe_t0 = now_; } }
#else
#define PROBE_INIT()
#define PROBE_AFTER(id)
#endif
__device__ __forceinline__ int gla_tok(int n, int i) {
    if (n < NCC) return n * 64 + i;
    int m = n - NCC; int col = m / RB, rb = m % RB;
    return CTX + (rb * 64 + i) * GRID_W + col;
}
__device__ __forceinline__ int chunk_order(int d, int s) {
    if (d == 0) return s;
    return (s < NCC) ? (NCC - 1 - s) : (NC - 1 - (s - NCC));
}
__device__ __forceinline__ int tok_order(int d, int s) {
    if (d == 0) return s;
    return (s < CTX) ? (CTX - 1 - s) : (MTOT - 1 - (s - CTX));
}


#define LDS_ROW 72
__device__ __forceinline__ void mfma_gemm_tile(const bf16_t* Wt, int ldw, const bf16_t* Act, int lda, int K, int n0, int m0, bf16_t* lds, f32x4 (&acc)[4][4]) {
    bf16_t* Ws = lds; bf16_t* As = lds + 128 * LDS_ROW;
    const int tid = otid(), lane = tid & 63, wave = tid >> 6, wn = wave >> 1, wm = wave & 1;
    const int lrow = tid >> 3, lkc = (tid & 7) * 8;
    u32x4 pw[4], pa[4];
#pragma unroll
    for (int i = 0; i < 4; ++i) {
        pw[i] = *(const u32x4*)(Wt + (size_t)(n0 + lrow + 32 * i) * ldw + lkc);
        pa[i] = *(const u32x4*)(Act + (size_t)(m0 + lrow + 32 * i) * lda + lkc);
    }
    for (int k0 = 0; k0 < K; k0 += 64) {
        __syncthreads();
#pragma unroll
        for (int i = 0; i < 4; ++i) {
            *(u32x4*)(Ws + (lrow + 32 * i) * LDS_ROW + lkc) = pw[i];
            *(u32x4*)(As + (lrow + 32 * i) * LDS_ROW + lkc) = pa[i];
        }
        __syncthreads();
        if (k0 + 64 < K) {
#pragma unroll
            for (int i = 0; i < 4; ++i) {
                pw[i] = *(const u32x4*)(Wt + (size_t)(n0 + lrow + 32 * i) * ldw + k0 + 64 + lkc);
                pa[i] = *(const u32x4*)(Act + (size_t)(m0 + lrow + 32 * i) * lda + k0 + 64 + lkc);
            }
        }
#pragma unroll
        for (int ks = 0; ks < 2; ++ks) {
            bf16x8 a[4], b[4];
#pragma unroll
            for (int i = 0; i < 4; ++i) {
                a[i] = *(const bf16x8*)(Ws + (wn * 64 + i * 16 + (lane & 15)) * LDS_ROW + ks * 32 + (lane >> 4) * 8);
                b[i] = *(const bf16x8*)(As + (wm * 64 + i * 16 + (lane & 15)) * LDS_ROW + ks * 32 + (lane >> 4) * 8);
            }
#pragma unroll
            for (int ni = 0; ni < 4; ++ni)
#pragma unroll
                for (int mi = 0; mi < 4; ++mi) acc[ni][mi] = MFMA16(a[ni], b[mi], acc[ni][mi]);
        }
    }
}
#define L64_ROW 72
#ifdef EMU
struct BufRsrc { const char* base; };
__device__ __forceinline__ BufRsrc make_rsrc(const void* p, size_t) { BufRsrc r; r.base = (const char*)p; return r; }
__device__ __forceinline__ u32x4 buf_load16(const BufRsrc& r, unsigned voff, unsigned soff) { return *(const u32x4*)(r.base + voff + soff); }
#else
typedef __amdgpu_buffer_rsrc_t BufRsrc;
__device__ __forceinline__ BufRsrc make_rsrc(const void* p, size_t bytes) { return __builtin_amdgcn_make_buffer_rsrc((void*)p, 0, (int)bytes, 0x00020000); }
__device__ __forceinline__ u32x4 buf_load16(const BufRsrc& r, unsigned voff, unsigned soff) { return __builtin_bit_cast(u32x4, __builtin_amdgcn_raw_buffer_load_b128(r, voff, soff, 0)); }
#endif
template <int NI, int MI>
__device__ __forceinline__ void mfma_gemm_tile_t(const bf16_t* Wt, int ldw, size_t wbytes, const bf16_t* Act, int lda, size_t abytes, int K, int n0, int m0, bf16_t* lds, f32x4 (&acc)[NI][MI], unsigned long long* gacc = nullptr) {
    constexpr int WR = 32 * NI, AR = 32 * MI, BUF = (WR + AR) * L64_ROW;
    const int tid = otid(), lane = tid & 63, wave = tid >> 6, wn = wave >> 1, wm = wave & 1;
    const int lrow = tid >> 3, lkc = (tid & 7) * 8;
    const BufRsrc rw = make_rsrc(Wt, wbytes), ra = make_rsrc(Act, abytes);
    unsigned vw[NI], va[MI];
#pragma unroll
    for (int i = 0; i < NI; ++i) vw[i] = (unsigned)(((size_t)(n0 + lrow + 32 * i) * ldw + lkc) * 2);
#pragma unroll
    for (int i = 0; i < MI; ++i) va[i] = (unsigned)(((size_t)(m0 + lrow + 32 * i) * lda + lkc) * 2);
    u32x4 qw0[NI], qa0[MI];
    const int nk = K / 64;
#define GT_LOAD(QW, QA, KT) { const unsigned so_ = (unsigned)(((KT) < nk) ? (KT) : (nk - 1)) * 128u; \
    _Pragma("unroll") for (int i = 0; i < NI; ++i) QW[i] = buf_load16(rw, vw[i], so_); \
    _Pragma("unroll") for (int i = 0; i < MI; ++i) QA[i] = buf_load16(ra, va[i], so_); }
#define GT_STORE(QW, QA, DST) { \
    _Pragma("unroll") for (int i = 0; i < NI; ++i) *(u32x4*)((DST) + (lrow + 32 * i) * L64_ROW + lkc) = QW[i]; \
    _Pragma("unroll") for (int i = 0; i < MI; ++i) *(u32x4*)((DST) + (WR + lrow + 32 * i) * L64_ROW + lkc) = QA[i]; }
#define GT_COMPUTE(CUR) { _Pragma("unroll") for (int ks = 0; ks < 2; ++ks) { bf16x8 b[MI], a[NI]; \
    _Pragma("unroll") for (int i = 0; i < MI; ++i) b[i] = *(const bf16x8*)((CUR) + (WR + wm * 16 * MI + i * 16 + (lane & 15)) * L64_ROW + ks * 32 + (lane >> 4) * 8); \
    _Pragma("unroll") for (int i = 0; i < NI; ++i) a[i] = *(const bf16x8*)((CUR) + (wn * 16 * NI + i * 16 + (lane & 15)) * L64_ROW + ks * 32 + (lane >> 4) * 8); \
    _Pragma("unroll") for (int ni = 0; ni < NI; ++ni) { \
        _Pragma("unroll") for (int mi = 0; mi < MI; ++mi) MFMA16_ACC(a[ni], b[mi], acc[ni][mi]); } } }
    GT_LOAD(qw0, qa0, 0)
    __syncthreads();
    GT_STORE(qw0, qa0, lds)
    __syncthreads();
    for (int kt = 0; kt < nk; kt += 2) {
        GT_LOAD(qw0, qa0, kt + 1)
        GT_COMPUTE(lds)
        GT_STORE(qw0, qa0, lds + BUF)
        __syncthreads();
        GT_LOAD(qw0, qa0, kt + 2)
        GT_COMPUTE(lds + BUF)
        GT_STORE(qw0, qa0, lds)
        __syncthreads();
    }
#undef GT_LOAD
#undef GT_STORE
#undef GT_COMPUTE
}
#define ZERO_ACC4(acc) { _Pragma("unroll") for (int i_ = 0; i_ < 4; ++i_) _Pragma("unroll") for (int j_ = 0; j_ < 4; ++j_) acc[i_][j_] = (f32x4){0.f, 0.f, 0.f, 0.f}; }
#define FOR_ACC(acc, n0, m0, BODY) { const int lane_ = otid() & 63, wave_ = otid() >> 6; \
    _Pragma("unroll") for (int ni_ = 0; ni_ < 4; ++ni_) _Pragma("unroll") for (int mi_ = 0; mi_ < 4; ++mi_) { \
        const int n = (n0) + (wave_ >> 1) * 64 + ni_ * 16 + (lane_ >> 4) * 4; const int m = (m0) + (wave_ & 1) * 64 + mi_ * 16 + (lane_ & 15); const f32x4 v = acc[ni_][mi_]; BODY } }
__device__ __forceinline__ u32x2 pack4(float a, float b, float c, float d) { u32x2 r; r.x = pack2bf(a, b); r.y = pack2bf(c, d); return r; }

__device__ __forceinline__ void convert_wt_job(const float* W, int K, int N, int Npad, bf16_t* out, int job, float* T, int ilv) {
    const int tid = otid();
    const int nkt = K / 64;
    const int n0 = (job / nkt) * 64, k0 = (job % nkt) * 64;
    __syncthreads();
    for (int idx = tid; idx < 4096; idx += NTHREADS) {
        int kk = idx >> 6, nn = idx & 63;
        int nr = n0 + nn; int src = ilv ? ((nr & 1) ? (N / 2 + (nr >> 1)) : (nr >> 1)) : nr;
        T[kk * 65 + nn] = (nr < N) ? W[(size_t)(k0 + kk) * N + src] : 0.f;
    }
    __syncthreads();
    {
        int nn = tid >> 2, part = tid & 3;
        unsigned w[8];
#pragma unroll
        for (int j = 0; j < 8; ++j) w[j] = pack2bf(T[(part * 16 + 2 * j) * 65 + nn], T[(part * 16 + 2 * j + 1) * 65 + nn]);
        u32x4* o = (u32x4*)(out + (size_t)(n0 + nn) * K + k0 + part * 16);
        o[0] = (u32x4){w[0], w[1], w[2], w[3]}; o[1] = (u32x4){w[4], w[5], w[6], w[7]};
    }
}
__device__ __forceinline__ void phase_convert_weights(const P& p, int l, char* smem) {
    float* T = (float*)smem;
    struct Item { const float* W; int K, N, Npad; bf16_t* out; };
    const Item items[12] = {
        {p.in[I_RW2] + ((size_t)l * 2 + 0) * 64 * RW, 64, RW, NPAD(RW), p.WT_W2},
        {p.in[I_RW2] + ((size_t)l * 2 + 1) * 64 * RW, 64, RW, NPAD(RW), p.WT_W2 + (size_t)NPAD(RW) * 64},
        {p.in[I_RA2] + ((size_t)l * 2 + 0) * 64 * RW, 64, RW, NPAD(RW), p.WT_A2},
        {p.in[I_RA2] + ((size_t)l * 2 + 1) * 64 * RW, 64, RW, NPAD(RW), p.WT_A2 + (size_t)NPAD(RW) * 64},
        {p.in[I_WIN] + (size_t)l * D_MODEL * D_IN, D_MODEL, D_IN, NPAD192(D_IN), p.WT_IN},
        {p.in[I_RG2] + (size_t)l * 128 * RW, 128, RW, RW, p.WT_G2},
        {p.in[I_S5GLU] + (size_t)l * SW * 2 * SW, SW, 2 * SW, 2 * SW, p.WT_GLU},
        {p.in[I_WBR] + ((size_t)l * 3 + 0) * BW * D_MODEL, BW, D_MODEL, D_MODEL, p.WT_BR},
        {p.in[I_WBR] + ((size_t)l * 3 + 1) * BW * D_MODEL, BW, D_MODEL, D_MODEL, p.WT_BR + (size_t)D_MODEL * BW},
        {p.in[I_WBR] + ((size_t)l * 3 + 2) * BW * D_MODEL, BW, D_MODEL, D_MODEL, p.WT_BR + (size_t)2 * D_MODEL * BW},
        {p.in[I_WOUT] + (size_t)l * D_MODEL * D_MODEL, D_MODEL, D_MODEL, D_MODEL, p.WT_OUT},
        {p.in[I_PWQ] + (size_t)l * D_MODEL * PQ, D_MODEL, PQ, PQ, p.WT_Q}};
    int base = 0;
#pragma unroll
    for (int it = 0; it < 12; ++it) {
        const int nj = (items[it].Npad / 64) * (items[it].K / 64);
        for (int j = (int)((obid() + gridDim.x - (base % gridDim.x)) % gridDim.x); j < nj; j += gridDim.x)
            convert_wt_job(items[it].W, items[it].K, items[it].N, items[it].Npad, items[it].out, j, T, it == 6);
        base += nj;
    }
    __syncthreads();
    {
        const float* ks = p.in[I_PKEYS] + (size_t)l * PH * 2 * 128 * 128;
        for (size_t i = (size_t)obid() * NTHREADS + otid(); i < (size_t)PH * 2 * 128 * 128; i += (size_t)gridDim.x * NTHREADS) {
            const float v = ks[i]; const bf16_t hb = f2bf(v);
            p.KHI[i] = hb; p.KLO[i] = f2bf(v - bf2f(hb));
        }
    }
}

#ifdef EMU
__device__ __forceinline__ int xcd_rank() { return obid(); }
#else
__device__ __forceinline__ int xcd_rank() { return (int)((volatile LAS unsigned*)(unsigned)(SMEM_BYTES))[2]; }
#endif
__device__ __forceinline__ bool tile_map(int it, int ntm, int ntn, int PM, int& mt, int& nt) {
    const int G = gridDim.x;
    const long id = (long)it * G + xcd_rank();
    if (id >= (long)ntm * ntn) return false;
    const int full = ntm / PM; const long fullsz = (long)full * PM * ntn;
    if (id < fullsz) { const int p = (int)(id / (PM * ntn)), rem = (int)(id % (PM * ntn)); nt = rem / PM; mt = p * PM + rem % PM; }
    else { const int rem = (int)(id - fullsz), hh = ntm - full * PM; nt = rem / hh; mt = full * PM + rem % hh; }
    return true;
}

template <int NI, int MI, class Pre, class Post>
__device__ __forceinline__ void gemm_tile_run(const bf16_t* Wt, int ldw, size_t wbytes, const bf16_t* Act, int lda, size_t abytes, int K, int n0, int m0, bf16_t* lds, Pre pre, Post post) {
    f32x4 acc[NI][MI];
#pragma unroll
    for (int i = 0; i < NI; ++i)
#pragma unroll
        for (int j = 0; j < MI; ++j) acc[i][j] = (f32x4){0.f, 0.f, 0.f, 0.f};
    pre(m0, n0, acc, lds);
    mfma_gemm_tile_t<NI, MI>(Wt, ldw, wbytes, Act, lda, abytes, K, n0, m0, lds, acc);
    const int lane = otid() & 63, wave = otid() >> 6;
#pragma unroll
    for (int ni = 0; ni < NI; ++ni)
#pragma unroll
        for (int mi = 0; mi < MI; ++mi)
            post(ni, mi, m0 + (wave & 1) * 16 * MI + mi * 16 + (lane & 15), n0 + (wave >> 1) * 16 * NI + ni * 16 + (lane >> 4) * 4, acc[ni][mi]);
}
struct NoPre { template <class A> __device__ __forceinline__ void operator()(int, int, A&, bf16_t*) const {} };
template <int NI, class PreM, class PreT, class Post>
__device__ __forceinline__ void gemm_phase(const bf16_t* Wt, int ldw, size_t wbytes, const bf16_t* Act, int lda, size_t abytes, int K, int N, bf16_t* lds, PreM prem, PreT pret, Post post) {
    const int ntn = N / (32 * NI), ntm = MTOT / 256 - 1;
    const int PM = (ntn >= 16) ? 2 : ((ntn >= 8) ? 4 : 8);
    for (int it = 0;; ++it) {
        int mt_, nt_; if (!tile_map(it, ntm, ntn, PM, mt_, nt_)) break;
        gemm_tile_run<NI, 8>(Wt, ldw, wbytes, Act, lda, abytes, K, nt_ * 32 * NI, mt_ * 256, lds, prem, post);
    }
    for (int job = obid(); job < 4 * ntn; job += gridDim.x)
        gemm_tile_run<NI, 2>(Wt, ldw, wbytes, Act, lda, abytes, K, (job >> 2) * 32 * NI, MTOT - 256 + (job & 3) * 64, lds, pret, post);
}

__device__ __forceinline__ void phase_init(const P& p, char* smem) {
    const int tid = otid();
    float* sc = (float*)smem;
    for (int i = tid; i < D_MODEL; i += NTHREADS) { sc[i] = siluf_(p.in[I_CCTX][i]); sc[D_MODEL + i] = siluf_(p.in[I_C][i]); }
    __syncthreads();
    const int ncolblk = (6 * D_MODEL) / NTHREADS;
    for (int job = obid(); job < DEPTH * ncolblk; job += gridDim.x) {
        int l = job / ncolblk, n = (job % ncolblk) * NTHREADS + tid;
        const float* w = p.in[I_WMOD] + (size_t)l * D_MODEL * 6 * D_MODEL + n;
        float a0 = 0.f, a1 = 0.f;
        for (int k = 0; k < D_MODEL; ++k) { float wv = w[(size_t)k * 6 * D_MODEL]; a0 += sc[k] * wv; a1 += sc[D_MODEL + k] * wv; }
        float b = p.in[I_BMOD][l * 6 * D_MODEL + n];
        p.MOD[(size_t)(l * 2 + 0) * 6 * D_MODEL + n] = a0 + b;
        p.MOD[(size_t)(l * 2 + 1) * 6 * D_MODEL + n] = a1 + b;
    }
    const size_t gtid = (size_t)obid() * NTHREADS + tid, gn = (size_t)gridDim.x * NTHREADS;
    for (size_t i = gtid; i < (size_t)CTX * D_MODEL; i += gn) p.X[i] = p.in[I_CTX][i];
    for (size_t i = gtid; i < (size_t)SEQ * D_MODEL; i += gn) p.X[(size_t)CTX * D_MODEL + i] = p.in[I_X][i];
    __syncthreads();
}

__device__ __forceinline__ void phase_s5const(const P& p, int l) {
    const size_t gtid = (size_t)obid() * NTHREADS + otid(), gn = (size_t)gridDim.x * NTHREADS;
    for (size_t i = gtid; i < (size_t)2 * SG * 64; i += gn) {
        int d = (int)(i / (SG * 64)), g = (int)((i / 64) % SG), s = (int)(i % 64);
        size_t li = ((size_t)(l * 2 + d) * SG + g) * 64 + s;
        float lre = p.in[I_S5LRE][li], lim = p.in[I_S5LIM][li];
        float dt = expf(p.in[I_S5LS][(l * 2 + d) * SG + g]);
        float mag = expf(lre * dt);
        float are = mag * cosf(lim * dt), aim = mag * sinf(lim * dt);
        float den = lre * lre + lim * lim;
        float fre = ((are - 1.0f) * lre + aim * lim) / den;
        float fim = (aim * lre - (are - 1.0f) * lim) / den;
        p.S5A[i * 2 + 0] = are; p.S5A[i * 2 + 1] = aim;
        const float* bre = p.in[I_S5BRE] + (((size_t)l * SG + g) * 64 + s) * 16;
        const float* bim = p.in[I_S5BIM] + (((size_t)l * SG + g) * 64 + s) * 16;
        for (int c = 0; c < 16; ++c) {
            p.S5BB[(i * 16 + c) * 2 + 0] = fre * bre[c] - fim * bim[c];
            p.S5BB[(i * 16 + c) * 2 + 1] = fre * bim[c] + fim * bre[c];
        }
    }
}

__device__ __forceinline__ void phase_norm(const P& p, int l, int which) {
    const int lane = otid() & 63;
    const int gw = (obid() * NTHREADS + otid()) >> 6, nw = (gridDim.x * NTHREADS) >> 6;
    const float* g = p.in[which ? I_N2G : I_N1G] + l * D_MODEL;
    constexpr int NJ = (D_MODEL + 255) / 256;
    for (int t = gw; t < MTOT; t += nw) {
        const float* x = p.X + (size_t)t * D_MODEL;
        const float* mod = p.MOD + (size_t)(l * 2 + (t >= CTX ? 1 : 0)) * 6 * D_MODEL + (which ? 3 * D_MODEL : 0);
        float4 v[NJ]; float ss = 0.f;
#pragma unroll
        for (int j = 0; j < NJ; ++j) {
            const int e = j * 256 + lane * 4;
            if (e < D_MODEL) v[j] = *(const float4*)(x + e); else { v[j].x = 0.f; v[j].y = 0.f; v[j].z = 0.f; v[j].w = 0.f; }
            ss += v[j].x * v[j].x + v[j].y * v[j].y + v[j].z * v[j].z + v[j].w * v[j].w;
        }
        ss = wave_sum(ss);
        const float rstd = rsqrtf(ss / D_MODEL + 1e-6f);
#pragma unroll
        for (int j = 0; j < NJ; ++j) {
            const int e = j * 256 + lane * 4;
            if (e < D_MODEL) {
                const float4 gg = *(const float4*)(g + e), sc = *(const float4*)(mod + D_MODEL + e), sh = *(const float4*)(mod + e);
                *(u32x2*)(p.H + (size_t)t * D_MODEL + e) = pack4(v[j].x * rstd * gg.x * (1.0f + sc.x) + sh.x, v[j].y * rstd * gg.y * (1.0f + sc.y) + sh.y,
                                                                 v[j].z * rstd * gg.z * (1.0f + sc.z) + sh.z, v[j].w * rstd * gg.w * (1.0f + sc.w) + sh.w);
            }
        }
    }
}

__device__ __forceinline__ void phase_gemm_in(const P& p, int l, char* smem) {
    constexpr int NI = 4, MI = 8;
    const int ntn = NPAD192(D_IN) / 128, ntm = MTOT / 256;
    for (int it = 0;; ++it) {
        int mt_, nt_; if (!tile_map(it, ntm, ntn, 4, mt_, nt_)) break;
        const int m0 = mt_ * 256, n0 = nt_ * 128;
        f32x4 acc[NI][MI];
#pragma unroll
        for (int i = 0; i < NI; ++i)
#pragma unroll
            for (int j = 0; j < MI; ++j) acc[i][j] = (f32x4){0.f, 0.f, 0.f, 0.f};
        mfma_gemm_tile_t<NI, MI>(p.WT_IN, D_MODEL, (size_t)NPAD192(D_IN) * D_MODEL * 2, p.H, D_MODEL, (size_t)MTOT * D_MODEL * 2, D_MODEL, n0, m0, (bf16_t*)smem, acc);
        const int lane = otid() & 63, wave = otid() >> 6;
#pragma unroll
        for (int ni = 0; ni < NI; ++ni)
#pragma unroll
            for (int mi = 0; mi < MI; ++mi) {
                const int n = n0 + (wave >> 1) * 16 * NI + ni * 16 + (lane >> 4) * 4, m = m0 + (wave & 1) * 16 * MI + mi * 16 + (lane & 15);
                const u32x2 pk_ = pack4(acc[ni][mi][0], acc[ni][mi][1], acc[ni][mi][2], acc[ni][mi][3]);
                if (n < ZG) *(u32x2*)(p.Z + (size_t)m * ZLD + n) = pk_;
                else if (n < D_IN) *(u32x2*)(p.ZGT + ((((size_t)(m >> 4) * (3 * D_MODEL / 16) + ((n - ZG) >> 4)) * 64 + lane) * 4)) =
                    pack4(sigmoidf_(acc[ni][mi][0]), sigmoidf_(acc[ni][mi][1]), sigmoidf_(acc[ni][mi][2]), sigmoidf_(acc[ni][mi][3]));
            }
    }
}

__device__ __forceinline__ void unpack8(const u32x4 w, float (&f)[8]) {
    f[0] = LO16(w.x); f[1] = HI16(w.x); f[2] = LO16(w.y); f[3] = HI16(w.y); f[4] = LO16(w.z); f[5] = HI16(w.z); f[6] = LO16(w.w); f[7] = HI16(w.w);
}
__device__ __forceinline__ u32x4 pack8(const float (&f)[8]) {
    u32x4 o; o.x = pack2bf(f[0], f[1]); o.y = pack2bf(f[2], f[3]);
    o.z = pack2bf(f[4], f[5]); o.w = pack2bf(f[6], f[7]); return o;
}
__device__ __forceinline__ void load8f(const float* p, float (&f)[8]) {
    const float4 a = *(const float4*)p, b = *(const float4*)(p + 4);
    f[0] = a.x; f[1] = a.y; f[2] = a.z; f[3] = a.w; f[4] = b.x; f[5] = b.y; f[6] = b.z; f[7] = b.w;
}
__device__ __forceinline__ void store8f(float* p, const float (&f)[8]) {
    float4 a, b; a.x = f[0]; a.y = f[1]; a.z = f[2]; a.w = f[3]; b.x = f[4]; b.y = f[5]; b.z = f[6]; b.w = f[7];
    *(float4*)p = a; *(float4*)(p + 4) = b;
}
__device__ __forceinline__ void conv8(const bf16_t* zp, const float* conv, int c0, bool act, bool first, bool last, float (&out)[8]) {
    const u32x4 z4 = {0u, 0u, 0u, 0u};
    const u32x4 a0 = act ? *(const u32x4*)(zp + c0) : z4;
    const u32x4 am = (act && !first) ? *(const u32x4*)(zp + c0 - ZLD) : z4;
    const u32x4 an = (act && !last) ? *(const u32x4*)(zp + c0 + ZLD) : z4;
    float w0[8], w1[8], w2[8], f0[8], fm[8], fn[8];
    if (act) { load8f(conv + c0, w0); load8f(conv + RWKV_IN + c0, w1); load8f(conv + 2 * RWKV_IN + c0, w2); }
    else {
#pragma unroll
        for (int e = 0; e < 8; ++e) { w0[e] = 0.f; w1[e] = 0.f; w2[e] = 0.f; }
    }
    unpack8(a0, f0); unpack8(am, fm); unpack8(an, fn);
#pragma unroll
    for (int e = 0; e < 8; ++e) out[e] = w1[e] * f0[e] + w0[e] * fm[e] + w2[e] * fn[e];
}
__device__ __forceinline__ void phase_rwkv_prep1(const P& p, int l) {
    const int lane = otid() & 63;
    const int gw = (obid() * NTHREADS + otid()) >> 6, nw = (gridDim.x * NTHREADS) >> 6;
    const float* conv = p.in[I_RCONV] + (size_t)l * 3 * RWKV_IN;
    const float* k_k = p.in[I_RKK] + (size_t)l * RW;
    const bool act = lane * 8 < RW, act2 = lane * 8 < 384;
    float kkw[8];
    if (act) load8f(k_k + lane * 8, kkw);
    else {
#pragma unroll
        for (int e = 0; e < 8; ++e) kkw[e] = 0.f;
    }
    for (int t = gw; t < MTOT; t += nw) {
        const bool first = (t == 0) || (t == CTX), last = (t == CTX - 1) || (t == MTOT - 1);
        const bf16_t* zp = p.Z + (size_t)t * ZLD + ZR;
        float rv[8], kv[8], vv[8], lr[8];
        conv8(zp, conv, 0 * RW + lane * 8, act, first, last, rv);
        conv8(zp, conv, 1 * RW + lane * 8, act, first, last, kv);
        conv8(zp, conv, 2 * RW + lane * 8, act, first, last, vv);
        conv8(zp, conv, 3 * RW + lane * 8, act2, first, last, lr);
        float kk[8]; float ss = 0.f;
#pragma unroll
        for (int e = 0; e < 8; ++e) { kk[e] = kv[e] * kkw[e]; ss += kk[e] * kk[e]; }
        ss += __shfl_xor(ss, 1, 64); ss += __shfl_xor(ss, 2, 64); ss += __shfl_xor(ss, 4, 64);
        const float inv = 1.0f / fmaxf(sqrtf(ss), 1e-12f);
#pragma unroll
        for (int e = 0; e < 8; ++e) kk[e] *= inv;
        if (act) {
            const size_t o = (size_t)t * RW + lane * 8;
            *(u32x4*)(p.R + o) = pack8(rv); *(u32x4*)(p.KS + o) = pack8(kv); *(u32x4*)(p.V + o) = pack8(vv); *(u32x4*)(p.KK + o) = pack8(kk);
        }
        if (act2) {
            const int cc = lane * 8;
            if (cc < 128) {
#pragma unroll
                for (int e = 0; e < 8; ++e) lr[e] = tanhf_(lr[e]);
                *(u32x4*)(p.LR + (size_t)t * 256 + cc) = pack8(lr);
            } else if (cc < 256) {
                *(u32x4*)(p.LR + (size_t)t * 256 + cc) = pack8(lr);
            } else {
#pragma unroll
                for (int e = 0; e < 8; ++e) lr[e] = sigmoidf_(lr[e]);
                *(u32x4*)(p.GS + (size_t)t * 128 + cc - 256) = pack8(lr);
            }
        }
    }
}
__device__ __forceinline__ void phase_rwkv_prep2(const P& p, int l, char* smem) {
    const int ntm = MTOT / 128, ntn = NPAD(RW) / 128;
    const float* k_a = p.in[I_RKA] + (size_t)l * RW;
    const float* r_k = p.in[I_RRK] + (size_t)l * RW;
    for (int job = obid(); job < ntm * ntn * 2; job += gridDim.x) {
        const int d = job % 2, n0 = ((job / 2) % ntn) * 128, m0 = (job / (2 * ntn)) * 128;
        const float* w0 = p.in[I_RW0] + (size_t)(l * 2 + d) * RW;
        const float* a0 = p.in[I_RA0] + (size_t)(l * 2 + d) * RW;
        f32x4 accw[4][4], acca[4][4]; ZERO_ACC4(accw); ZERO_ACC4(acca);
        mfma_gemm_tile(p.WT_W2 + (size_t)d * NPAD(RW) * 64, 64, p.LR + d * 64, 256, 64, n0, m0, (bf16_t*)smem, accw);
        mfma_gemm_tile(p.WT_A2 + (size_t)d * NPAD(RW) * 64, 64, p.LR + 128 + d * 64, 256, 64, n0, m0, (bf16_t*)smem, acca);
        const int lane = otid() & 63, wave = otid() >> 6;
#pragma unroll
        for (int mi = 0; mi < 4; ++mi) {
            const int m = m0 + (wave & 1) * 64 + mi * 16 + (lane & 15);
            float bon = 0.f;
#pragma unroll
            for (int ni = 0; ni < 4; ++ni) {
                const int n = n0 + (wave >> 1) * 64 + ni * 16 + (lane >> 4) * 4;
                if (n < RW) {
                    const u32x2 kq = *(const u32x2*)(p.KS + (size_t)m * RW + n), kkq = *(const u32x2*)(p.KK + (size_t)m * RW + n), rq = *(const u32x2*)(p.R + (size_t)m * RW + n);
                    const float kv[4] = {LO16(kq.x), HI16(kq.x), LO16(kq.y), HI16(kq.y)};
                    const float kkv[4] = {LO16(kkq.x), HI16(kkq.x), LO16(kkq.y), HI16(kkq.y)};
                    const float rv[4] = {LO16(rq.x), HI16(rq.x), LO16(rq.y), HI16(rq.y)};
                    float lw[4], kd[4], bb[4];
#pragma unroll
                    for (int e = 0; e < 4; ++e) {
                        const float x = w0[n + e] + accw[ni][mi][e];
                        lw[e] = -fexp_(-softplusf_(-x) - 0.5f);
                        const float aa = sigmoidf_(a0[n + e] + acca[ni][mi][e]);
                        kd[e] = kv[e] * (1.0f + (aa - 1.0f) * k_a[n + e]);
                        bb[e] = kkv[e] * aa;
                        bon += rv[e] * kd[e] * r_k[n + e];
                    }
                    const size_t o = ((size_t)d * MTOT + m) * RW + n;
                    float4 lo4; lo4.x = lw[0]; lo4.y = lw[1]; lo4.z = lw[2]; lo4.w = lw[3];
                    *(float4*)(p.LW + o) = lo4;
                    *(u32x2*)(p.KD + o) = pack4(kd[0], kd[1], kd[2], kd[3]);
                    *(u32x2*)(p.BB + o) = pack4(bb[0], bb[1], bb[2], bb[3]);
                }
            }
            bon += __shfl_xor(bon, 16, 64); bon += __shfl_xor(bon, 32, 64);
            const int hh = (n0 + (wave >> 1) * 64) >> 6;
            if ((lane >> 4) == 0 && hh < RH) p.BONUS[((size_t)d * MTOT + m) * RH + hh] = bon;
        }
    }
}

#define CH_ROW 72
#define SEQ_REC 16640
#define CH_SLOT (64 * CH_ROW)
#define CH_XR_OFF (7 * CH_SLOT * 2)
#define CH_AAB_OFF (CH_XR_OFF + 64 * 132 * 4)
#define CH_GC_OFF (CH_AAB_OFF + 64 * 72 * 4)
template <int MT, int NT>
__device__ __forceinline__ void lds_mm(const bf16_t* A, int m0, const bf16_t* Bt, int n0, f32x4 (&acc)[MT][NT]) {
    const int lane = otid() & 63, q = lane >> 4, r = lane & 15;
#pragma unroll
    for (int s = 0; s < 2; ++s) {
        bf16x8 a[MT], b[NT];
#pragma unroll
        for (int i = 0; i < MT; ++i) a[i] = *(const bf16x8*)(A + (m0 + i * 16 + r) * CH_ROW + s * 32 + q * 8);
#pragma unroll
        for (int i = 0; i < NT; ++i) b[i] = *(const bf16x8*)(Bt + (n0 + i * 16 + r) * CH_ROW + s * 32 + q * 8);
#pragma unroll
        for (int i = 0; i < MT; ++i)
#pragma unroll
            for (int jj = 0; jj < NT; ++jj) acc[i][jj] = MFMA16(a[i], b[jj], acc[i][jj]);
    }
}
__device__ __forceinline__ void rwkv_chunk_job(const P& p, int job, char* smem) {
    const int tid = otid(), lane = tid & 63, wv = tid >> 6, q = lane >> 4, r = lane & 15;
    const int d = job / (NC * RH), n = (job / RH) % NC, h = job % RH;
    const size_t base = (size_t)(d * NC + n) * RH + h;
    bf16_t* S0 = (bf16_t*)smem; bf16_t* S1 = S0 + CH_SLOT; bf16_t* S2 = S1 + CH_SLOT; bf16_t* S3 = S2 + CH_SLOT;
    bf16_t* S4 = S3 + CH_SLOT; bf16_t* S5 = S4 + CH_SLOT; bf16_t* S6 = S5 + CH_SLOT;
    float* X = (float*)(smem + CH_XR_OFF);
    float* AABt = (float*)(smem + CH_AAB_OFF);
    bf16_t* U0t = (bf16_t*)(smem + CH_AAB_OFF);
    bf16_t* Aht = U0t + CH_SLOT;
    float* GC = (float*)(smem + CH_GC_OFF);
    __syncthreads();
    u32x4 gkk[2], gr[2], gv[2], gkd[2], gbb[2]; float lw[2][8];
#pragma unroll
    for (int it = 0; it < 2; ++it) {
        const int c = tid + 256 * it, i = c >> 3, k0 = (c & 7) * 8; const int tok = 64 * n + (d ? 63 - i : i);
        const size_t o1 = (size_t)tok * RW + h * 64 + k0, o2 = ((size_t)d * MTOT + tok) * RW + h * 64 + k0;
        load8f(p.LW + o2, lw[it]);
        gkk[it] = *(const u32x4*)(p.KK + o1); gr[it] = *(const u32x4*)(p.R + o1); gv[it] = *(const u32x4*)(p.V + o1);
        gkd[it] = *(const u32x4*)(p.KD + o2); gbb[it] = *(const u32x4*)(p.BB + o2);
    }
#pragma unroll
    for (int it = 0; it < 2; ++it) { const int c = tid + 256 * it; store8f(X + (c >> 3) * 132 + (c & 7) * 8, lw[it]); }
    __syncthreads();
    {
        const int k = tid & 63, seg = tid >> 6;
        float v[16]; float run = 0.f;
#pragma unroll
        for (int e = 0; e < 16; ++e) { run += X[(seg * 16 + e) * 132 + k]; v[e] = run; }
        AABt[seg * 64 + k] = run;
        __syncthreads();
        float off = 0.f;
        for (int s2 = 0; s2 < seg; ++s2) off += AABt[s2 * 64 + k];
#pragma unroll
        for (int e = 0; e < 16; ++e) X[(seg * 16 + e) * 132 + k] = v[e] + off;
    }
    __syncthreads();
#pragma unroll
    for (int it = 0; it < 2; ++it) {
        const int c = tid + 256 * it, i = c >> 3, k0 = (c & 7) * 8;
        float L[8], Lp[8], LC[8], kkv[8], rv[8], vv[8], kdv[8], bbv[8];
        load8f(X + i * 132 + k0, L); load8f(X + 63 * 132 + k0, LC);
        if (i > 0) load8f(X + (i - 1) * 132 + k0, Lp);
        else {
#pragma unroll
            for (int e = 0; e < 8; ++e) Lp[e] = 0.f;
        }
        unpack8(gkk[it], kkv); unpack8(gr[it], rv); unpack8(gv[it], vv); unpack8(gkd[it], kdv); unpack8(gbb[it], bbv);
        float at[8], rt[8], bt[8], kt[8], bh[8], kh[8];
#pragma unroll
        for (int e = 0; e < 8; ++e) {
            const float eL = fexp_(L[e]), eLp = fexp_(Lp[e]), eNL = fexp_(-L[e]), eCL = fexp_(LC[e] - L[e]);
            at[e] = -kkv[e] * eLp; rt[e] = rv[e] * eL; bt[e] = bbv[e] * eNL; kt[e] = kdv[e] * eNL; bh[e] = bbv[e] * eCL; kh[e] = kdv[e] * eCL;
            if (i == 63) GC[k0 + e] = eL;
        }
        *(u32x4*)(S0 + i * CH_ROW + k0) = pack8(at);
        store8f(X + i * 132 + 64 + k0, at);
        *(u32x4*)(S1 + i * CH_ROW + k0) = pack8(rt);
        *(u32x4*)(S2 + i * CH_ROW + k0) = pack8(bt);
        *(u32x4*)(S3 + i * CH_ROW + k0) = pack8(kt);
#pragma unroll
        for (int e = 0; e < 8; ++e) {
            S4[(k0 + e) * CH_ROW + i] = f2bf(vv[e]);
            S5[(k0 + e) * CH_ROW + i] = f2bf(bh[e]);
            S6[(k0 + e) * CH_ROW + i] = f2bf(kh[e]);
        }
    }
    __syncthreads();
    {
        f32x4 acc[4][4]; ZERO_ACC4(acc);
        lds_mm<4, 4>((wv < 2) ? S0 : S1, 0, (wv & 1) ? S3 : S2, 0, acc);
        __syncthreads();
#pragma unroll
        for (int mt = 0; mt < 4; ++mt)
#pragma unroll
            for (int nt = 0; nt < 4; ++nt) {
                const int jc = nt * 16 + r, i0 = mt * 16 + 4 * q;
                if (wv == 0) {
                    f32x4 o;
#pragma unroll
                    for (int e = 0; e < 4; ++e) o[e] = (jc < i0 + e) ? acc[mt][nt][e] : 0.f;
                    *(f32x4*)(AABt + jc * 72 + i0) = o;
                } else {
                    bf16_t* dst = (wv == 1) ? S0 : ((wv == 2) ? S2 : S3);
#pragma unroll
                    for (int e = 0; e < 4; ++e) {
                        const bool ok = (wv == 1) ? (jc < i0 + e) : (jc <= i0 + e);
                        dst[(i0 + e) * CH_ROW + jc] = f2bf(ok ? acc[mt][nt][e] : 0.f);
                    }
                }
            }
    }
    __syncthreads();
    {
        f32x4 acc[1][4];
#pragma unroll
        for (int nt = 0; nt < 4; ++nt) acc[0][nt] = (f32x4){0.f, 0.f, 0.f, 0.f};
        lds_mm<1, 4>(S0, 16 * wv, S4, 0, acc);
#pragma unroll
        for (int nt = 0; nt < 4; ++nt)
#pragma unroll
            for (int e = 0; e < 4; ++e) X[(16 * wv + 4 * q + e) * 132 + nt * 16 + r] = acc[0][nt][e];
    }
    __syncthreads();
    if (tid < 128) {
        const int c = tid;
        for (int bi = 0; bi < 4; ++bi) {
            float acc[16];
#pragma unroll
            for (int e = 0; e < 16; ++e) acc[e] = X[(16 * bi + e) * 132 + c];
            for (int jj = 0; jj < 16 * bi; ++jj) {
                const float uj = X[jj * 132 + c];
                const f32x4* ap = (const f32x4*)(AABt + jj * 72 + 16 * bi);
                const f32x4 a0 = ap[0], a1 = ap[1], a2 = ap[2], a3 = ap[3];
#pragma unroll
                for (int e = 0; e < 4; ++e) { acc[e] += a0[e] * uj; acc[4 + e] += a1[e] * uj; acc[8 + e] += a2[e] * uj; acc[12 + e] += a3[e] * uj; }
            }
#pragma unroll
            for (int e = 0; e < 16; ++e) {
                const float u = acc[e];
                X[(16 * bi + e) * 132 + c] = u;
                const f32x4* ap = (const f32x4*)(AABt + (16 * bi + e) * 72 + 16 * bi);
                const f32x4 a0 = ap[0], a1 = ap[1], a2 = ap[2], a3 = ap[3];
#pragma unroll
                for (int e2 = 0; e2 < 16; ++e2) if (e2 > e) acc[e2] += ((e2 < 4) ? a0[e2 & 3] : (e2 < 8) ? a1[e2 & 3] : (e2 < 12) ? a2[e2 & 3] : a3[e2 & 3]) * u;
            }
        }
    }
    __syncthreads();
    if (tid < 128) {
        const int c = tid;
        bf16_t* dst = (c < 64) ? (U0t + c * CH_ROW) : (Aht + (c - 64) * CH_ROW);
        u32x4 ov[8];
#pragma unroll
        for (int g = 0; g < 8; ++g) {
            float v[8];
#pragma unroll
            for (int e = 0; e < 8; ++e) v[e] = X[(g * 8 + e) * 132 + c];
            ov[g].x = pack2bf(v[0], v[1]); ov[g].y = pack2bf(v[2], v[3]);
            ov[g].z = pack2bf(v[4], v[5]); ov[g].w = pack2bf(v[6], v[7]);
        }
#pragma unroll
        for (int g = 0; g < 8; ++g) *(u32x4*)(dst + g * 8) = ov[g];
    }
    __syncthreads();
    {
        f32x4 acc[4][4]; ZERO_ACC4(acc);
        char* rec = p.REC + base * SEQ_REC;
        if (wv == 0) {
            lds_mm<4, 4>(Aht, 0, S5, 0, acc);
#pragma unroll
            for (int nt = 0; nt < 4; ++nt)
#pragma unroll
                for (int s2 = 0; s2 < 2; ++s2) {
                    u32x4 o;
                    o.x = pack2bf(acc[2 * s2][nt][0], acc[2 * s2][nt][1]); o.y = pack2bf(acc[2 * s2][nt][2], acc[2 * s2][nt][3]);
                    o.z = pack2bf(acc[2 * s2 + 1][nt][0], acc[2 * s2 + 1][nt][1]); o.w = pack2bf(acc[2 * s2 + 1][nt][2], acc[2 * s2 + 1][nt][3]);
                    *(u32x4*)(rec + (((nt * 2 + s2) * 64 + lane) * 8) * 2) = o;
                }
        } else if (wv == 1) {
            lds_mm<4, 4>(S5, 0, U0t, 0, acc);
            lds_mm<4, 4>(S6, 0, S4, 0, acc);
#pragma unroll
            for (int mt = 0; mt < 4; ++mt)
#pragma unroll
                for (int nt = 0; nt < 4; ++nt) *(u32x2*)(rec + 8192 + (((nt * 4 + mt) * 64 + lane) * 4) * 2) = pack4(acc[mt][nt][0], acc[mt][nt][1], acc[mt][nt][2], acc[mt][nt][3]);
        } else if (wv == 2) {
            lds_mm<4, 4>(S2, 0, Aht, 0, acc);
#pragma unroll
            for (int mt = 0; mt < 4; ++mt)
#pragma unroll
                for (int nt = 0; nt < 4; ++nt)
#pragma unroll
                    for (int e = 0; e < 4; ++e) {
                        const int t = mt * 16 + 4 * q + e, kc = nt * 16 + r;
                        p.QH[(base * 64 + t) * 64 + kc] = f2bf(acc[mt][nt][e] + bf2f(S1[t * CH_ROW + kc]));
                    }
        } else if (wv == 3) {
            lds_mm<4, 4>(S2, 0, U0t, 0, acc);
            lds_mm<4, 4>(S3, 0, S4, 0, acc);
#pragma unroll
            for (int mt = 0; mt < 4; ++mt)
#pragma unroll
                for (int nt = 0; nt < 4; ++nt)
#pragma unroll
                    for (int e = 0; e < 4; ++e) {
                        const int t = mt * 16 + 4 * q + e; const int tok = 64 * n + (d ? 63 - t : t);
                        p.Y[((size_t)d * MTOT + tok) * RW + h * 64 + nt * 16 + r] = acc[mt][nt][e];
                    }
        }
        if (tid < 64) ((float*)(rec + 16384))[tid] = GC[tid];
    }
}

#define SEQ_SLOT 16896
__device__ __forceinline__ void rwkv_seq_gload(const P& p, size_t base, int tid, u32x4 (&g)[5]) {
    const u32x4* m = (const u32x4*)(p.REC + base * SEQ_REC);
#pragma unroll
    for (int i = 0; i < 4; ++i) g[i] = m[tid + 256 * i];
    if (tid < 16) g[4] = m[1024 + tid];
}
__device__ __forceinline__ void rwkv_seq_lstore(char* slot, int tid, const u32x4 (&g)[5]) {
    u32x4* d = (u32x4*)slot;
#pragma unroll
    for (int i = 0; i < 4; ++i) d[tid + 256 * i] = g[i];
    if (tid < 16) d[1024 + tid] = g[4];
}
__device__ __forceinline__ void rwkv_seq_step(const P& p, const char* slot, size_t base, int wv, int lane, f32x4 (&X)[4]) {
    const int q = lane >> 4, r = lane & 15;
    const bf16_t* mt = (const bf16_t*)slot; const bf16_t* ntb = (const bf16_t*)(slot + 8192); const float* gc = (const float*)(slot + 16384);
    unsigned xh[4][2];
#pragma unroll
    for (int kt = 0; kt < 4; ++kt) {
        xh[kt][0] = pack2bf(X[kt][0], X[kt][1]); xh[kt][1] = pack2bf(X[kt][2], X[kt][3]);
        *(u32x2*)(p.SN + (base * 64 + 16 * wv + r) * 64 + 16 * kt + 4 * q) = (u32x2){xh[kt][0], xh[kt][1]};
    }
    bf16x8 bh[2];
#pragma unroll
    for (int s2 = 0; s2 < 2; ++s2) bh[s2] = __builtin_bit_cast(bf16x8, ((u32x4){xh[2 * s2][0], xh[2 * s2][1], xh[2 * s2 + 1][0], xh[2 * s2 + 1][1]}));
#pragma unroll
    for (int tile = 0; tile < 4; ++tile) {
        const u32x2 nb = *(const u32x2*)(ntb + ((wv * 4 + tile) * 64 + lane) * 4);
        const f32x4 g4 = *(const f32x4*)(gc + tile * 16 + 4 * q);
        f32x4 acc;
        acc[0] = g4[0] * X[tile][0] + LO16(nb.x); acc[1] = g4[1] * X[tile][1] + HI16(nb.x);
        acc[2] = g4[2] * X[tile][2] + LO16(nb.y); acc[3] = g4[3] * X[tile][3] + HI16(nb.y);
#pragma unroll
        for (int s2 = 0; s2 < 2; ++s2) {
            const bf16x8 ah = *(const bf16x8*)(mt + ((tile * 2 + s2) * 64 + lane) * 8);
            acc = MFMA16(ah, bh[s2], acc);
        }
        X[tile] = acc;
    }
}
__device__ __forceinline__ void rwkv_seq_job(const P& p, int job, char* smem) {
    const int tid = otid(), lane = tid & 63, wv = tid >> 6;
    const int d = job / RH, h = job % RH;
    f32x4 X[4];
#pragma unroll
    for (int kt = 0; kt < 4; ++kt) X[kt] = (f32x4){0.f, 0.f, 0.f, 0.f};
    u32x4 g0[5], g1[5], g2[5];
#define SEQ_BASE(s_) ((size_t)(d * NC + chunk_order(d, ((s_) < NC) ? (s_) : NC - 1)) * RH + h)
    __syncthreads();
    rwkv_seq_gload(p, SEQ_BASE(0), tid, g0);
    rwkv_seq_gload(p, SEQ_BASE(1), tid, g1);
    rwkv_seq_gload(p, SEQ_BASE(2), tid, g2);
    rwkv_seq_lstore(smem, tid, g0);
    __syncthreads();
    for (int s = 0; s < NC; s += 6) {
#define SEQ_SUB(u, GFREE, GNEXT) \
        if (s + (u) < NC) { \
            rwkv_seq_gload(p, SEQ_BASE(s + (u) + 3), tid, GFREE); \
            rwkv_seq_step(p, smem + (((u) & 1) ? SEQ_SLOT : 0), SEQ_BASE(s + (u)), wv, lane, X); \
            rwkv_seq_lstore(smem + (((u) & 1) ? 0 : SEQ_SLOT), tid, GNEXT); \
        } \
        __syncthreads();
        SEQ_SUB(0, g0, g1)
        SEQ_SUB(1, g1, g2)
        SEQ_SUB(2, g2, g0)
        SEQ_SUB(3, g0, g1)
        SEQ_SUB(4, g1, g2)
        SEQ_SUB(5, g2, g0)
#undef SEQ_SUB
    }
#undef SEQ_BASE
}
__device__ __forceinline__ void rwkv_out_job(const P& p, int job) {
    const int tid = otid(), lane = tid & 63, wv = tid >> 6, q = lane >> 4, r = lane & 15;
    const int d = job / (NC * RH), n = (job / RH) % NC, h = job % RH;
    const size_t base = (size_t)(d * NC + n) * RH + h;
    f32x4 acc[4];
#pragma unroll
    for (int nt = 0; nt < 4; ++nt) acc[nt] = (f32x4){0.f, 0.f, 0.f, 0.f};
#pragma unroll
    for (int s2 = 0; s2 < 2; ++s2) {
        const bf16x8 a = *(const bf16x8*)(p.QH + (base * 64 + 16 * wv + r) * 64 + s2 * 32 + q * 8);
#pragma unroll
        for (int nt = 0; nt < 4; ++nt) {
            const bf16x8 b = *(const bf16x8*)(p.SN + (base * 64 + nt * 16 + r) * 64 + s2 * 32 + q * 8);
            acc[nt] = MFMA16(a, b, acc[nt]);
        }
    }
#pragma unroll
    for (int nt = 0; nt < 4; ++nt)
#pragma unroll
        for (int e = 0; e < 4; ++e) {
            const int t = 16 * wv + 4 * q + e; const int tok = 64 * n + (d ? 63 - t : t);
            p.Y[((size_t)d * MTOT + tok) * RW + h * 64 + nt * 16 + r] += acc[nt][e];
        }
}

#define GL_QR 0
#define GL_KR 9216
#define GL_VT 18432
#define GL_QI 36864
#define GL_KI 46080
#define GL_AT 55296
#define GL_CUM 64512
#define GL_ALR 81920
#define GL_WA 86016
__device__ __forceinline__ void gla_load_qkv(const P& p, int n, int h, char* smem) {
    const int tid = otid();
    bf16_t* Qr = (bf16_t*)(smem + GL_QR); bf16_t* Kr = (bf16_t*)(smem + GL_KR); bf16_t* Vt = (bf16_t*)(smem + GL_VT);
    for (int c = tid; c < 512; c += NTHREADS) {
        const int row = c >> 3, part = c & 7; const int t = gla_tok(n, row);
        const u32x4 qv = *(const u32x4*)(p.Z + (size_t)t * ZLD + ZQ + h * 64 + part * 8);
        const u32x4 kv = *(const u32x4*)(p.Z + (size_t)t * ZLD + ZK + h * 64 + part * 8);
        u32x4 qs;
        qs.x = pack2bf(LO16(qv.x) * 0.125f, HI16(qv.x) * 0.125f);
        qs.y = pack2bf(LO16(qv.y) * 0.125f, HI16(qv.y) * 0.125f);
        qs.z = pack2bf(LO16(qv.z) * 0.125f, HI16(qv.z) * 0.125f);
        qs.w = pack2bf(LO16(qv.w) * 0.125f, HI16(qv.w) * 0.125f);
        *(u32x4*)(Qr + row * CH_ROW + part * 8) = qs;
        *(u32x4*)(Kr + row * CH_ROW + part * 8) = kv;
    }
    for (int c = tid; c < 1024; c += NTHREADS) {
        const int row = c >> 4, part = c & 15; const int t = gla_tok(n, row);
        const u32x4 vv = *(const u32x4*)(p.Z + (size_t)t * ZLD + ZV + h * 128 + part * 8);
        bf16_t* dst = Vt + (part * 8) * CH_ROW + row;
        dst[0 * CH_ROW] = (bf16_t)(vv.x & 0xFFFF); dst[1 * CH_ROW] = (bf16_t)(vv.x >> 16);
        dst[2 * CH_ROW] = (bf16_t)(vv.y & 0xFFFF); dst[3 * CH_ROW] = (bf16_t)(vv.y >> 16);
        dst[4 * CH_ROW] = (bf16_t)(vv.z & 0xFFFF); dst[5 * CH_ROW] = (bf16_t)(vv.z >> 16);
        dst[6 * CH_ROW] = (bf16_t)(vv.w & 0xFFFF); dst[7 * CH_ROW] = (bf16_t)(vv.w >> 16);
    }
}
__device__ __forceinline__ void gla_cum(const P& p, int l, int n, int h, int d, char* smem) {
    const int tid = otid();
    float* CUM = (float*)(smem + GL_CUM); float* ALR = (float*)(smem + GL_ALR); float* WA = (float*)(smem + GL_WA);
    for (int c = tid; c < 256; c += NTHREADS) {
        const int row = c >> 2, part = c & 3; const int t = gla_tok(n, row);
        const u32x2 a = *(const u32x2*)(p.Z + (size_t)t * ZLD + (d ? ZAB : ZAF) + part * 4);
        float* dst = ALR + row * 16 + part * 4;
        dst[0] = LO16(a.x); dst[1] = HI16(a.x); dst[2] = LO16(a.y); dst[3] = HI16(a.y);
    }
    for (int c = tid; c < 16 * 64 + 64; c += NTHREADS) {
        if (c < 1024) WA[c] = p.in[I_GLA_WA2][((size_t)(l * 2 + d) * 16 + (c >> 6)) * GLA_K + h * 64 + (c & 63)];
        else WA[c] = p.in[I_GLA_BA][(size_t)(l * 2 + d) * GLA_K + h * 64 + (c - 1024)];
    }
    __syncthreads();
    for (int idx = tid; idx < 4096; idx += NTHREADS) {
        const int i = idx >> 6, k = idx & 63;
        float a = WA[1024 + k];
#pragma unroll
        for (int r = 0; r < 16; ++r) a += ALR[i * 16 + r] * WA[r * 64 + k];
        CUM[i * 68 + k] = (fminf(a, 0.f) - flog_(1.0f + fexp_(-fabsf(a)))) * (1.0f / 16.0f);
    }
    __syncthreads();
    {
        const int k = tid & 63, seg = (tid >> 6) & 3;
        float v[16]; float run = 0.f;
        if (tid < 256) {
#pragma unroll
            for (int e = 0; e < 16; ++e) { const int pos = seg * 16 + e; const int i = d ? 63 - pos : pos; run += CUM[i * 68 + k]; v[e] = run; }
            ALR[seg * 64 + k] = run;
        }
        __syncthreads();
        if (tid < 256) {
            float off = 0.f;
            for (int s2 = 0; s2 < seg; ++s2) off += ALR[s2 * 64 + k];
#pragma unroll
            for (int e = 0; e < 16; ++e) { const int pos = seg * 16 + e; const int i = d ? 63 - pos : pos; CUM[i * 68 + k] = v[e] + off; }
        }
    }
    __syncthreads();
}
__device__ __forceinline__ void phase_gla_kv(const P& p, int l, char* smem) {
    const int tid = otid(), lane = tid & 63, wv = tid >> 6, q = lane >> 4, r = lane & 15;
    bf16_t* Kr = (bf16_t*)(smem + GL_KR); bf16_t* Vt = (bf16_t*)(smem + GL_VT); bf16_t* KdT = (bf16_t*)(smem + GL_KI);
    float* CUM = (float*)(smem + GL_CUM);
    for (int job = obid(); job < NC * GH; job += gridDim.x) {
        const int n = job / GH, h = job % GH;
        __syncthreads();
        gla_load_qkv(p, n, h, smem);
        for (int d = 0; d < 2; ++d) {
            gla_cum(p, l, n, h, d, smem);
            const int li = d ? 0 : 63;
            for (int idx = tid; idx < 4096; idx += NTHREADS) {
                const int i = idx >> 6, k = idx & 63;
                KdT[k * CH_ROW + i] = f2bf(bf2f(Kr[i * CH_ROW + k]) * fexp_(CUM[li * 68 + k] - CUM[i * 68 + k]));
            }
            if (tid < 64) p.DEC[((size_t)(d * NC + n) * GH + h) * 64 + tid] = fexp_(CUM[li * 68 + tid]);
            __syncthreads();
            float* kvt = p.KV + ((size_t)(d * NC + n) * GH + h) * 8192;
            for (int mt = wv; mt < 4; mt += NTHREADS / 64) {
                f32x4 acc[1][8];
#pragma unroll
                for (int nt = 0; nt < 8; ++nt) acc[0][nt] = (f32x4){0.f, 0.f, 0.f, 0.f};
                lds_mm<1, 8>(KdT, 16 * mt, Vt, 0, acc);
#pragma unroll
                for (int nt = 0; nt < 8; ++nt) *(f32x4*)(kvt + (size_t)(nt * 16 + r) * 64 + 16 * mt + 4 * q) = acc[0][nt];
            }
            __syncthreads();
        }
    }
    __syncthreads();
}
__device__ __forceinline__ void gla_scan_job(const P& p, int job) {
    const int base = job * NTHREADS + otid();
    const int d = base / (GH * 8192), h = (base / 8192) % GH, e = base % 8192;
    const float* __restrict__ kvp = p.KV; const float* __restrict__ decp = p.DEC; bf16_t* __restrict__ sp = p.SP;
    float S = 0.f;
    for (int s = 0; s < NC; s += 4) {
        float kv[4], dc[4]; size_t oo[4];
#pragma unroll
        for (int u = 0; u < 4; ++u) {
            const int n = chunk_order(d, (s + u < NC) ? s + u : NC - 1);
            oo[u] = ((size_t)(d * NC + n) * GH + h);
            kv[u] = kvp[oo[u] * 8192 + e]; dc[u] = decp[oo[u] * 64 + (e & 63)];
        }
#pragma unroll
        for (int u = 0; u < 4; ++u) if (s + u < NC) { sp[oo[u] * 8192 + e] = f2bf(S); S = dc[u] * S + kv[u]; }
    }
}
__device__ __forceinline__ void phase_gla_out(const P& p, int l, char* smem) {
    const int tid = otid(), lane = tid & 63, wv = tid >> 6, q = lane >> 4, r = lane & 15;
    bf16_t* Qr = (bf16_t*)(smem + GL_QR); bf16_t* Kr = (bf16_t*)(smem + GL_KR); bf16_t* Vt = (bf16_t*)(smem + GL_VT);
    bf16_t* Qi = (bf16_t*)(smem + GL_QI); bf16_t* Ki = (bf16_t*)(smem + GL_KI); bf16_t* At = (bf16_t*)(smem + GL_AT);
    float* CUM = (float*)(smem + GL_CUM);
    for (int job = obid(); job < NC * GH; job += gridDim.x) {
        const int n = job / GH, h = job % GH;
        __syncthreads();
        gla_load_qkv(p, n, h, smem);
        f32x4 o[1][8];
#pragma unroll
        for (int nt = 0; nt < 8; ++nt) o[0][nt] = (f32x4){0.f, 0.f, 0.f, 0.f};
        for (int d = 0; d < 2; ++d) {
            gla_cum(p, l, n, h, d, smem);
            for (int idx = tid; idx < 4096; idx += NTHREADS) {
                const int i = idx >> 6, k = idx & 63; const float c = CUM[i * 68 + k];
                Qi[i * CH_ROW + k] = f2bf(bf2f(Qr[i * CH_ROW + k]) * fexp_(c));
                Ki[i * CH_ROW + k] = f2bf(bf2f(Kr[i * CH_ROW + k]) * fexp_(-c));
            }
            __syncthreads();
            if (wv < 4) {
                f32x4 a[1][4];
#pragma unroll
                for (int nt = 0; nt < 4; ++nt) a[0][nt] = (f32x4){0.f, 0.f, 0.f, 0.f};
                lds_mm<1, 4>(Qi, 16 * wv, Ki, 0, a);
#pragma unroll
                for (int nt = 0; nt < 4; ++nt)
#pragma unroll
                    for (int e = 0; e < 4; ++e) {
                        const int i = 16 * wv + 4 * q + e, j = nt * 16 + r;
                        const bool ok = d ? (j >= i) : (j <= i);
                        At[i * CH_ROW + j] = f2bf(ok ? a[0][nt][e] : 0.f);
                    }
                WAVE_SYNC();
                lds_mm<1, 8>(At, 16 * wv, Vt, 0, o);
                const bf16_t* sp = p.SP + ((size_t)(d * NC + n) * GH + h) * 8192;
#pragma unroll
                for (int s2 = 0; s2 < 2; ++s2) {
                    const bf16x8 af = *(const bf16x8*)(Qi + (16 * wv + r) * CH_ROW + s2 * 32 + q * 8);
#pragma unroll
                    for (int nt = 0; nt < 8; ++nt) {
                        const bf16x8 bfr = *(const bf16x8*)(sp + (size_t)(nt * 16 + r) * 64 + s2 * 32 + q * 8);
                        o[0][nt] = MFMA16(af, bfr, o[0][nt]);
                    }
                }
            }
            __syncthreads();
        }
        if (wv < 4) {
#pragma unroll
            for (int nt = 0; nt < 8; ++nt)
#pragma unroll
                for (int e = 0; e < 4; ++e) {
                    const int t = gla_tok(n, 16 * wv + 4 * q + e);
                    p.OGLA[(size_t)t * GLA_V + h * 128 + nt * 16 + r] = o[0][nt][e];
                }
        }
    }
    __syncthreads();
}

#define S5_XH_OFF (2 * 64 * 132 * 4)
#define S5_XL_OFF (S5_XH_OFF + 64 * 136 * 2)
#define S5_CT_OFF (S5_XL_OFF + 64 * 136 * 2)
__device__ __forceinline__ void phase_s5_pass(const P& p, int l, char* smem, bool with_out) {
    const int tid = otid(), lane = tid & 63, wv = tid >> 6, q = lane >> 4, r = lane & 15;
    float* BU = (float*)smem; bf16_t* XH = (bf16_t*)(smem + S5_XH_OFF); bf16_t* XL = (bf16_t*)(smem + S5_XL_OFF); bf16_t* CTp = (bf16_t*)(smem + S5_CT_OFF);
    const int dW = (wv >> 1) & 1, ntb = (wv & 1) * 4;
    const int dS = (tid >> 6) & 1, st = tid & 63;
    bf16x8 bhi[4], blo[4];
    float are = 0.f, aim = 0.f, dco = 0.f;
    int cur_g = -1;
    const bf16x8 zero8 = {0, 0, 0, 0, 0, 0, 0, 0};
    for (int job = obid(); job < NC * SG; job += gridDim.x) {
        const int n = job / SG, g = job % SG;
        __syncthreads();
        if (g != cur_g) {
            cur_g = g;
            if (wv < 4) {
#pragma unroll
                for (int jn = 0; jn < 4; ++jn) {
                    const int kk = 16 * (ntb + jn) + r; const size_t ci = ((size_t)dW * SG + g) * 64 + (kk >> 1);
                    float f[8], lo[8];
#pragma unroll
                    for (int e = 0; e < 8; ++e) f[e] = (q < 2) ? p.S5BB[(ci * 16 + 8 * q + e) * 2 + (kk & 1)] : 0.f;
                    const u32x4 hv = pack8(f);
                    float hf[8]; unpack8(hv, hf);
#pragma unroll
                    for (int e = 0; e < 8; ++e) lo[e] = f[e] - hf[e];
                    bhi[jn] = __builtin_bit_cast(bf16x8, hv); blo[jn] = __builtin_bit_cast(bf16x8, pack8(lo));
                }
            }
            if (tid < 128) { const size_t ci = ((size_t)dS * SG + g) * 64 + st; are = p.S5A[ci * 2]; aim = p.S5A[ci * 2 + 1]; }
            if (with_out) {
                for (int idx = tid; idx < 16 * 128; idx += NTHREADS) {
                    const int c = idx >> 7, kk = idx & 127;
                    const float v = (kk & 1) ? -p.in[I_S5CIM][((size_t)l * SG + g) * 1024 + c * 64 + (kk >> 1)] : p.in[I_S5CRE][((size_t)l * SG + g) * 1024 + c * 64 + (kk >> 1)];
                    CTp[c * 136 + kk] = f2bf(v);
                }
                dco = p.in[I_S5D][(size_t)l * SW + g * 16 + r];
            }
        }
        float xr = 0.f, xi = 0.f;
        const size_t eo = (((size_t)dS * NC + n) * SG + g) * 64 + st;
        if (with_out && tid < 128) { const float2 c2 = *(const float2*)(p.S5CAR + eo * 2); xr = c2.x; xi = c2.y; }
        if (wv < 4) {
#pragma unroll
            for (int mt = 0; mt < 4; ++mt) {
                const bf16x8 a = (q < 2) ? *(const bf16x8*)(p.Z + (size_t)(n * 64 + 16 * mt + r) * ZLD + ZS5 + g * 16 + 8 * q) : zero8;
#pragma unroll
                for (int jn = 0; jn < 4; ++jn) {
                    f32x4 acc = {0.f, 0.f, 0.f, 0.f};
                    acc = MFMA16(a, bhi[jn], acc);
                    acc = MFMA16(a, blo[jn], acc);
#pragma unroll
                    for (int e = 0; e < 4; ++e) BU[(dW * 64 + 16 * mt + 4 * q + e) * 132 + 16 * (ntb + jn) + r] = acc[e];
                }
            }
        }
        __syncthreads();
        if (tid < 128) {
#pragma unroll 8
            for (int ii = 0; ii < 64; ++ii) {
                const int i = dS ? 63 - ii : ii;
                float2* bp = (float2*)(BU + (dS * 64 + i) * 132 + st * 2);
                const float2 b = *bp;
                const float nr = are * xr - aim * xi + b.x, ni = are * xi + aim * xr + b.y;
                xr = nr; xi = ni;
                if (with_out) { float2 o; o.x = xr; o.y = xi; *bp = o; }
            }
            if (!with_out) { float2 o; o.x = xr; o.y = xi; *(float2*)(p.S5END + eo * 2) = o; }
        }
        if (with_out) {
            __syncthreads();
            for (int cidx = tid; cidx < 64 * 16; cidx += NTHREADS) {
                const int i = cidx >> 4, k0 = (cidx & 15) * 8;
                float a[8], b[8], lo[8];
                load8f(BU + (0 * 64 + i) * 132 + k0, a); load8f(BU + (1 * 64 + i) * 132 + k0, b);
#pragma unroll
                for (int e = 0; e < 8; ++e) a[e] += b[e];
                const u32x4 hv = pack8(a);
                float hf[8]; unpack8(hv, hf);
#pragma unroll
                for (int e = 0; e < 8; ++e) lo[e] = a[e] - hf[e];
                *(u32x4*)(XH + i * 136 + k0) = hv; *(u32x4*)(XL + i * 136 + k0) = pack8(lo);
            }
            __syncthreads();
            if (wv < 4) {
                f32x4 acc = {0.f, 0.f, 0.f, 0.f};
#pragma unroll
                for (int ks = 0; ks < 4; ++ks) {
                    const bf16x8 ah = *(const bf16x8*)(XH + (16 * wv + r) * 136 + ks * 32 + q * 8), al = *(const bf16x8*)(XL + (16 * wv + r) * 136 + ks * 32 + q * 8);
                    const bf16x8 b = *(const bf16x8*)(CTp + r * 136 + ks * 32 + q * 8);
                    acc = MFMA16(ah, b, acc);
                    acc = MFMA16(al, b, acc);
                }
#pragma unroll
                for (int e = 0; e < 4; ++e) {
                    const int i = 16 * wv + 4 * q + e;
                    const float u = bf2f(p.Z[(size_t)(n * 64 + i) * ZLD + ZS5 + g * 16 + r]);
                    p.GY[(size_t)(n * 64 + i) * SW + g * 16 + r] = f2bf(geluf_(acc[e] + dco * u));
                }
            }
        }
    }
    __syncthreads();
}
__device__ __forceinline__ void s5_carry_job(const P& p, int job) {
    const int base = job * NTHREADS + otid();
    if (base >= 2 * SG * 64) return;
    const int d = base / (SG * 64), g = (base / 64) % SG, st = base % 64;
    const size_t ci = ((size_t)d * SG + g) * 64 + st;
    float ar = p.S5A[ci * 2], ai = p.S5A[ci * 2 + 1];
    for (int i = 0; i < 6; ++i) { const float nr = ar * ar - ai * ai, ni = 2.f * ar * ai; ar = nr; ai = ni; }
    const float2* __restrict__ endp = (const float2*)p.S5END; float2* __restrict__ carp = (float2*)p.S5CAR;
    float cr = 0.f, cim = 0.f;
    for (int s = 0; s < NC; s += 4) {
        float2 ev[4]; size_t eo[4];
#pragma unroll
        for (int u = 0; u < 4; ++u) {
            const int n = chunk_order(d, (s + u < NC) ? s + u : NC - 1);
            eo[u] = (((size_t)d * NC + n) * SG + g) * 64 + st;
            ev[u] = endp[eo[u]];
        }
#pragma unroll
        for (int u = 0; u < 4; ++u) if (s + u < NC) {
            float2 c; c.x = cr; c.y = cim; carp[eo[u]] = c;
            const float nr = ar * cr - ai * cim + ev[u].x, ni = ar * cim + ai * cr + ev[u].y;
            cr = nr; cim = ni;
        }
    }
}

__device__ __forceinline__ void phase_side_elem(const P& p, int l) {
    const int lane = otid() & 63;
    const int gw = (obid() * NTHREADS + otid()) >> 6, nw = (gridDim.x * NTHREADS) >> 6;
    const bool actg = lane * 8 < GLA_V, actr = lane * 8 < RW;
    float gng[8], lnw[8], lnb[8];
#pragma unroll
    for (int e = 0; e < 8; ++e) { gng[e] = 0.f; lnw[e] = 0.f; lnb[e] = 0.f; }
    if (actg) load8f(p.in[I_GLA_NG] + (size_t)l * 128 + ((lane * 8) & 127), gng);
    if (actr) { load8f(p.in[I_RLNW] + (size_t)l * RW + lane * 8, lnw); load8f(p.in[I_RLNB] + (size_t)l * RW + lane * 8, lnb); }
    for (int t = gw; t < MTOT; t += nw) {
        float og[8], zo[8], y0[8], y1[8], vv[8];
        const u32x4 z4 = {0u, 0u, 0u, 0u};
#pragma unroll
        for (int e = 0; e < 8; ++e) { og[e] = 0.f; y0[e] = 0.f; y1[e] = 0.f; }
        if (actg) load8f(p.OGLA + (size_t)t * GLA_V + lane * 8, og);
        unpack8(actg ? *(const u32x4*)(p.Z + (size_t)t * ZLD + ZOG + lane * 8) : z4, zo);
        if (actr) { load8f(p.Y + (size_t)t * RW + lane * 8, y0); load8f(p.Y + ((size_t)MTOT + t) * RW + lane * 8, y1); }
        unpack8(actr ? *(const u32x4*)(p.V + (size_t)t * RW + lane * 8) : z4, vv);
        const int hh = (lane * 8) >> 6;
        const float bon = actr ? (p.BONUS[(size_t)t * RH + hh] + p.BONUS[((size_t)MTOT + t) * RH + hh]) : 0.f;
        float ss = 0.f;
#pragma unroll
        for (int e = 0; e < 8; ++e) ss += og[e] * og[e];
        ss += __shfl_xor(ss, 1, 64); ss += __shfl_xor(ss, 2, 64); ss += __shfl_xor(ss, 4, 64); ss += __shfl_xor(ss, 8, 64);
        const float rstd = rsqrtf(ss * (1.0f / 128.f) + 1e-6f);
        float br[8];
#pragma unroll
        for (int e = 0; e < 8; ++e) br[e] = og[e] * rstd * gng[e] * siluf_(zo[e]);
        if (actg) *(u32x4*)(p.BR + (size_t)t * 3 * BW + lane * 8) = pack8(br);
        float y[8]; float sm = 0.f;
#pragma unroll
        for (int e = 0; e < 8; ++e) { y[e] = y0[e] + y1[e]; sm += y[e]; }
        sm += __shfl_xor(sm, 1, 64); sm += __shfl_xor(sm, 2, 64); sm += __shfl_xor(sm, 4, 64);
        const float mu = sm * (1.0f / 64.f);
        float sv = 0.f;
#pragma unroll
        for (int e = 0; e < 8; ++e) { y[e] -= mu; sv += y[e] * y[e]; }
        sv += __shfl_xor(sv, 1, 64); sv += __shfl_xor(sv, 2, 64); sv += __shfl_xor(sv, 4, 64);
        const float rs = rsqrtf(sv * (1.0f / 64.f) + 64e-5f);
        float yn[8];
#pragma unroll
        for (int e = 0; e < 8; ++e) yn[e] = y[e] * rs * lnw[e] + lnb[e] + bon * vv[e];
        if (actr) store8f(p.YN + (size_t)t * RW + lane * 8, yn);
    }
}

__device__ __forceinline__ void phase_side_gemm(const P& p, int l, char* smem) {
    gemm_phase<4>(p.WT_G2, 128, (size_t)NPAD(RW) * 128 * 2, p.GS, 128, (size_t)MTOT * 128 * 2, 128, NPAD(RW), (bf16_t*)smem, NoPre(), NoPre(),
        [&](int, int, int m, int n, const f32x4 v) {
            if (n < RW) { const float4 y = *(const float4*)(p.YN + (size_t)m * RW + n);
                *(u32x2*)(p.BR + (size_t)m * 3 * BW + BW + n) = pack4(y.x * v[0], y.y * v[1], y.z * v[2], y.w * v[3]); }
        });
    gemm_phase<4>(p.WT_GLU, SW, (size_t)NPAD(2 * SW) * SW * 2, p.GY, SW, (size_t)MTOT * SW * 2, SW, 2 * SW, (bf16_t*)smem, NoPre(), NoPre(),
        [&](int, int, int m, int n, const f32x4 v) {
            *(unsigned*)(p.BR + (size_t)m * 3 * BW + 2 * BW + (n >> 1)) = pack2bf(v[0] * sigmoidf_(v[1]), v[2] * sigmoidf_(v[3]));
        });
}

__device__ __forceinline__ void phase_merge(const P& p, int l, char* smem) {
    const int ntn = D_MODEL / 128, ntm = (MTOT - 256) / 128;
    auto run = [&](auto mi_tag, int n0, int m0) {
        constexpr int MI = decltype(mi_tag)::value;
        f32x4 macc[4][MI];
#pragma unroll
        for (int i = 0; i < 4; ++i)
#pragma unroll
            for (int j = 0; j < MI; ++j) macc[i][j] = (f32x4){0.f, 0.f, 0.f, 0.f};
        const int lane = otid() & 63, wave = otid() >> 6;
        for (int b = 0; b < 3; ++b) {
            f32x4 acc[4][MI];
#pragma unroll
            for (int i = 0; i < 4; ++i)
#pragma unroll
                for (int j = 0; j < MI; ++j) acc[i][j] = (f32x4){0.f, 0.f, 0.f, 0.f};
            mfma_gemm_tile_t<4, MI>(p.WT_BR + (size_t)b * D_MODEL * BW, BW, (size_t)D_MODEL * BW * 2, p.BR + b * BW, 3 * BW, (size_t)MTOT * 3 * BW * 2 - b * BW * 2, BW, n0, m0, (bf16_t*)smem, acc);
#pragma unroll
            for (int ni = 0; ni < 4; ++ni)
#pragma unroll
                for (int mi = 0; mi < MI; ++mi) {
                    const int n = n0 + (wave >> 1) * 64 + ni * 16 + (lane >> 4) * 4, m = m0 + (wave & 1) * 16 * MI + mi * 16 + (lane & 15);
                    const u32x2 g = *(const u32x2*)(p.ZGT + ((((size_t)(m >> 4) * (3 * D_MODEL / 16) + ((b * D_MODEL + n) >> 4)) * 64 + lane) * 4));
                    macc[ni][mi][0] += LO16(g.x) * acc[ni][mi][0]; macc[ni][mi][1] += HI16(g.x) * acc[ni][mi][1];
                    macc[ni][mi][2] += LO16(g.y) * acc[ni][mi][2]; macc[ni][mi][3] += HI16(g.y) * acc[ni][mi][3];
                }
        }
#pragma unroll
        for (int ni = 0; ni < 4; ++ni)
#pragma unroll
            for (int mi = 0; mi < MI; ++mi) {
                const int n = n0 + (wave >> 1) * 64 + ni * 16 + (lane >> 4) * 4, m = m0 + (wave & 1) * 16 * MI + mi * 16 + (lane & 15);
                *(u32x2*)(p.M + (size_t)m * D_MODEL + n) = pack4(macc[ni][mi][0], macc[ni][mi][1], macc[ni][mi][2], macc[ni][mi][3]);
            }
    };
    for (int it = 0;; ++it) {
        int mt_, nt_; if (!tile_map(it, ntm, ntn, (ntn >= 8) ? 4 : 8, mt_, nt_)) break;
        run(std::integral_constant<int, 4>(), nt_ * 128, mt_ * 128);
    }
    for (int job = obid(); job < 4 * ntn; job += gridDim.x) run(std::integral_constant<int, 2>(), (job >> 2) * 128, MTOT - 256 + (job & 3) * 64);
}

__device__ __forceinline__ void phase_outproj(const P& p, int l, char* smem) {
    gemm_phase<4>(p.WT_OUT, D_MODEL, (size_t)D_MODEL * D_MODEL * 2, p.M, D_MODEL, (size_t)MTOT * D_MODEL * 2, D_MODEL, D_MODEL, (bf16_t*)smem, NoPre(), NoPre(),
        [&](int, int, int m, int n, const f32x4 v) {
            const float* g1 = p.MOD + (size_t)(l * 2 + (m >= CTX ? 1 : 0)) * 6 * D_MODEL + 2 * D_MODEL + n;
            float4* xp = (float4*)(p.X + (size_t)m * D_MODEL + n); float4 x = *xp;
            x.x += g1[0] * v[0]; x.y += g1[1] * v[1]; x.z += g1[2] * v[2]; x.w += g1[3] * v[3]; *xp = x;
        });
}

__device__ __forceinline__ void store_q_hilo(const P& p, int m, int n, const f32x4 v) {
    const bf16_t h0 = f2bf(v[0]), h1 = f2bf(v[1]), h2 = f2bf(v[2]), h3 = f2bf(v[3]);
    u32x2 hv; hv.x = (unsigned)h0 | ((unsigned)h1 << 16); hv.y = (unsigned)h2 | ((unsigned)h3 << 16);
    *(u32x2*)(p.QHI + (size_t)m * PQ + n) = hv;
    *(u32x2*)(p.QLO + (size_t)m * PQ + n) = pack4(v[0] - bf2f(h0), v[1] - bf2f(h1), v[2] - bf2f(h2), v[3] - bf2f(h3));
}
__device__ __forceinline__ void phase_peer_q(const P& p, int l, char* smem) {
    gemm_phase<4>(p.WT_Q, D_MODEL, (size_t)PQ * D_MODEL * 2, p.H, D_MODEL, (size_t)MTOT * D_MODEL * 2, D_MODEL, PQ, (bf16_t*)smem, NoPre(), NoPre(),
        [&](int, int, int m, int n, const f32x4 v) { store_q_hilo(p, m, n, v); });
}

#define TK_ROW 129
__device__ __forceinline__ unsigned tk_key(float f, unsigned lowmask, unsigned low) {
    unsigned u = __builtin_bit_cast(unsigned, f);
    u ^= (u & 0x80000000u) ? 0xFFFFFFFFu : 0x80000000u;
    return (u & ~lowmask) | low;
}
#define TK_INSERT(lv, xk) { unsigned x_ = (xk); _Pragma("unroll") for (int z_ = 0; z_ < 16; ++z_) { const unsigned hi_ = lv[z_] > x_ ? lv[z_] : x_; x_ = lv[z_] > x_ ? x_ : lv[z_]; lv[z_] = hi_; } }
__device__ __forceinline__ void phase_peer_topk(const P& p, int l, char* smem) {
    const int tid = otid(), lane = tid & 63, wv = tid >> 6, q = lane >> 4, r = lane & 15;
    float* sc = (float*)smem + wv * (64 * TK_ROW);
    const int gw = (obid() * NTHREADS + tid) >> 6, nw = (gridDim.x * NTHREADS) >> 6;
    const float NEG = -3.0e38f;
    for (int job = gw; job < (MTOT / 32) * PH; job += nw) {
        const int t0 = (job / PH) * 32, h = job % PH;
#pragma unroll
        for (int sd = 0; sd < 2; ++sd) {
            f32x4 acc[2][8];
#pragma unroll
            for (int mt = 0; mt < 2; ++mt)
#pragma unroll
                for (int nt = 0; nt < 8; ++nt) acc[mt][nt] = (f32x4){0.f, 0.f, 0.f, 0.f};
#pragma unroll
            for (int ks = 0; ks < 4; ++ks) {
                bf16x8 ah[2], al[2];
#pragma unroll
                for (int mt = 0; mt < 2; ++mt) {
                    const size_t qo = (size_t)(t0 + mt * 16 + r) * PQ + h * 256 + sd * 128 + ks * 32 + q * 8;
                    ah[mt] = *(const bf16x8*)(p.QHI + qo); al[mt] = *(const bf16x8*)(p.QLO + qo);
                }
#pragma unroll
                for (int nt = 0; nt < 8; ++nt) {
                    const size_t ko = ((size_t)(h * 2 + sd) * 128 + nt * 16 + r) * 128 + ks * 32 + q * 8;
                    const bf16x8 bh = *(const bf16x8*)(p.KHI + ko), bl = *(const bf16x8*)(p.KLO + ko);
#pragma unroll
                    for (int mt = 0; mt < 2; ++mt) {
                        acc[mt][nt] = MFMA16(ah[mt], bh, acc[mt][nt]);
                        acc[mt][nt] = MFMA16(al[mt], bh, acc[mt][nt]);
                        acc[mt][nt] = MFMA16(ah[mt], bl, acc[mt][nt]);
                    }
                }
            }
#pragma unroll
            for (int mt = 0; mt < 2; ++mt)
#pragma unroll
                for (int nt = 0; nt < 8; ++nt)
#pragma unroll
                    for (int e = 0; e < 4; ++e) sc[(sd * 32 + mt * 16 + 4 * q + e) * TK_ROW + nt * 16 + r] = acc[mt][nt][e];
        }
        WAVE_SYNC();
        unsigned lv[16];
#pragma unroll
        for (int z = 0; z < 16; ++z) lv[z] = 0u;
        {
            const float* row = sc + lane * TK_ROW;
#pragma unroll 4
            for (int k = 0; k < 128; ++k) TK_INSERT(lv, tk_key(row[k], 0x7Fu, (unsigned)(127 - k)));
        }
        float lvv[16]; int li[16];
        {
            const float* row = sc + lane * TK_ROW;
#pragma unroll
            for (int z = 0; z < 16; ++z) { li[z] = 127 - (int)(lv[z] & 0x7Fu); lvv[z] = row[li[z]]; }
        }
        WAVE_SYNC();
        {
            float* row = sc + lane * TK_ROW;
#pragma unroll
            for (int z = 0; z < 16; ++z) { row[z] = lvv[z]; ((int*)row)[16 + z] = li[z]; }
        }
        WAVE_SYNC();
        const float* r1 = sc + (lane & 31) * TK_ROW; const float* r2 = sc + (32 + (lane & 31)) * TK_ROW;
        unsigned tk[16];
#pragma unroll
        for (int z = 0; z < 16; ++z) tk[z] = 0u;
        for (int i = 0; i < 16; ++i) {
            const float a = r1[i];
            const int nj = 16 / (i + 1);
            for (int j = 0; j < nj; ++j) TK_INSERT(tk, tk_key(a + r2[j], 0xFFu, (unsigned)(255 - (i * 16 + j))));
        }
        int tc[16];
#pragma unroll
        for (int z = 0; z < 16; ++z) tc[z] = 255 - (int)(tk[z] & 0xFFu);
        if (lane < 32) {
            float vals[16]; float mx = 0.f; float ssum = 0.f;
#pragma unroll
            for (int z = 0; z < 16; ++z) { vals[z] = r1[tc[z] >> 4] + r2[tc[z] & 15]; if (z == 0) mx = vals[0]; vals[z] = fexp_(vals[z] - mx); ssum += vals[z]; }
            const float inv = 1.0f / ssum;
            const size_t o = (size_t)(t0 + lane) * PH * 16 + h * 16;
#pragma unroll
            for (int z = 0; z < 16; ++z) {
                const int ex_ = ((const int*)r1)[16 + (tc[z] >> 4)] * 128 + ((const int*)r2)[16 + (tc[z] & 15)];
                p.IDX[o + z] = ex_;
                p.G[o + z] = vals[z] * inv * p.VSC[ex_];
                p.GU[o + z] = p.USC[ex_];
            }
        }
        WAVE_SYNC();
    }
}

#define PEER_CONV_JOBS (2 * NEXP / 4)
__device__ __forceinline__ void peer_conv_job(const P& p, int l, int job) {
    const int tid = otid(), lane = tid & 63, wv = tid >> 6;
    if (wv >= 4) return;
    const int rowg = job * 4 + wv; const int which = rowg / NEXP, row = rowg % NEXP;
    const float* src = p.in[which ? I_PV : I_PU] + ((size_t)l * NEXP + row) * D_MODEL + lane * 16;
    const bool act = lane * 16 < D_MODEL;
    float v[16]; float amax = 0.f;
#pragma unroll
    for (int c = 0; c < 4; ++c) {
        float4 a; a.x = 0.f; a.y = 0.f; a.z = 0.f; a.w = 0.f;
        if (act) a = *(const float4*)(src + c * 4);
        v[c * 4 + 0] = a.x; v[c * 4 + 1] = a.y; v[c * 4 + 2] = a.z; v[c * 4 + 3] = a.w;
        amax = fmaxf(amax, fmaxf(fmaxf(fabsf(a.x), fabsf(a.y)), fmaxf(fabsf(a.z), fabsf(a.w))));
    }
#pragma unroll
    for (int m = 32; m >= 1; m >>= 1) amax = fmaxf(amax, __shfl_xor(amax, m, 64));
    int ex = 0;
    if (amax > 0.f) ex = 7 - (int)((__builtin_bit_cast(unsigned, amax) >> 23) & 0xFF) + 127;
    ex = ex < -100 ? -100 : (ex > 100 ? 100 : ex);
    const float sc = __builtin_bit_cast(float, (unsigned)(ex + 127) << 23), isc = __builtin_bit_cast(float, (unsigned)(127 - ex) << 23);
    u32x4 o;
    int w0 = 0, w1 = 0, w2 = 0, w3 = 0;
    w0 = CVT_PK_FP8(v[0] * sc, v[1] * sc, w0, false); w0 = CVT_PK_FP8(v[2] * sc, v[3] * sc, w0, true);
    w1 = CVT_PK_FP8(v[4] * sc, v[5] * sc, w1, false); w1 = CVT_PK_FP8(v[6] * sc, v[7] * sc, w1, true);
    w2 = CVT_PK_FP8(v[8] * sc, v[9] * sc, w2, false); w2 = CVT_PK_FP8(v[10] * sc, v[11] * sc, w2, true);
    w3 = CVT_PK_FP8(v[12] * sc, v[13] * sc, w3, false); w3 = CVT_PK_FP8(v[14] * sc, v[15] * sc, w3, true);
    o.x = (unsigned)w0; o.y = (unsigned)w1; o.z = (unsigned)w2; o.w = (unsigned)w3;
    unsigned char* dst = (which ? p.V8 : p.U8) + (size_t)row * D_MODEL + lane * 16;
    if (act) *(u32x4*)dst = o;
    if (lane == 0) (which ? p.VSC : p.USC)[row] = isc;
}
#define GE 4
struct GBuf { u32x4 u[GE]; u32x4 v[GE]; float gu; float gv; };
__device__ __forceinline__ void gather_load(const P& p, GBuf& b, int g, int idx0, int idx1, float g0, float g1, float u0, float u1, int lane) {
    const bool act = lane * 16 < D_MODEL;
#pragma unroll
    for (int q = 0; q < GE; ++q) {
        const int k = g * GE + q;
        const int ei = __shfl((k < 64) ? idx0 : idx1, k & 63, 64);
        b.u[q] = act ? *(const u32x4*)(p.U8 + (size_t)ei * D_MODEL + lane * 16) : (u32x4){0u, 0u, 0u, 0u};
        b.v[q] = act ? *(const u32x4*)(p.V8 + (size_t)ei * D_MODEL + lane * 16) : (u32x4){0u, 0u, 0u, 0u};
    }
    const int km = g * GE + ((lane >> 4) & 3);
    b.gv = __shfl((km < 64) ? g0 : g1, km & 63, 64);
    b.gu = __shfl((km < 64) ? u0 : u1, km & 63, 64);
}
__device__ __forceinline__ void gather_compute(const GBuf& b, const float (&hv)[16], float (&acc)[16], int lane) {
    float dt[GE];
#pragma unroll
    for (int q = 0; q < GE; ++q) {
        float d = 0.f;
#pragma unroll
        for (int c = 0; c < 4; ++c) {
            const f32x2 lo = CVT_PK_F32_FP8((int)b.u[q][c], false), hi = CVT_PK_F32_FP8((int)b.u[q][c], true);
            d += hv[c * 4 + 0] * lo.x + hv[c * 4 + 1] * lo.y + hv[c * 4 + 2] * hi.x + hv[c * 4 + 3] * hi.y;
        }
        dt[q] = d;
    }
    float r2[2], r1;
    {
        const bool up = (lane & 32) != 0;
#pragma unroll
        for (int q = 0; q < 2; ++q) { const float keep = up ? dt[2 + q] : dt[q], send = up ? dt[q] : dt[2 + q]; r2[q] = keep + __shfl_xor(send, 32, 64); }
    }
    {
        const bool up = (lane & 16) != 0;
        const float keep = up ? r2[1] : r2[0], send = up ? r2[0] : r2[1];
        r1 = keep + __shfl_xor(send, 16, 64);
    }
    r1 += __shfl_xor(r1, 8, 64); r1 += __shfl_xor(r1, 4, 64); r1 += __shfl_xor(r1, 2, 64); r1 += __shfl_xor(r1, 1, 64);
    const float coef_mine = b.gv * geluf_(r1 * b.gu);
#pragma unroll
    for (int q = 0; q < GE; ++q) {
        const float coef = __shfl(coef_mine, q * 16, 64);
#pragma unroll
        for (int c = 0; c < 4; ++c) {
            const f32x2 lo = CVT_PK_F32_FP8((int)b.v[q][c], false), hi = CVT_PK_F32_FP8((int)b.v[q][c], true);
            acc[c * 4 + 0] += coef * lo.x; acc[c * 4 + 1] += coef * lo.y; acc[c * 4 + 2] += coef * hi.x; acc[c * 4 + 3] += coef * hi.y;
        }
    }
}
__device__ __forceinline__ void phase_peer_gather(const P& p, int l) {
    const int lane = otid() & 63;
    const int gw = (obid() * NTHREADS + otid()) >> 6, nw = (gridDim.x * NTHREADS) >> 6;
    constexpr int NG = PH * 16 / GE;
    const bool act = lane * 16 < D_MODEL;
    for (int t = gw; t < MTOT; t += nw) {
        float hv[16], acc[16];
        {
            const u32x4 z4 = {0u, 0u, 0u, 0u};
            const u32x4 ha = act ? *(const u32x4*)(p.H + (size_t)t * D_MODEL + lane * 16) : z4;
            const u32x4 hb = act ? *(const u32x4*)(p.H + (size_t)t * D_MODEL + lane * 16 + 8) : z4;
            hv[0] = LO16(ha.x); hv[1] = HI16(ha.x); hv[2] = LO16(ha.y); hv[3] = HI16(ha.y); hv[4] = LO16(ha.z); hv[5] = HI16(ha.z); hv[6] = LO16(ha.w); hv[7] = HI16(ha.w);
            hv[8] = LO16(hb.x); hv[9] = HI16(hb.x); hv[10] = LO16(hb.y); hv[11] = HI16(hb.y); hv[12] = LO16(hb.z); hv[13] = HI16(hb.z); hv[14] = LO16(hb.w); hv[15] = HI16(hb.w);
#pragma unroll
            for (int j = 0; j < 16; ++j) acc[j] = 0.f;
        }
        int idx0 = 0, idx1 = 0; float g0 = 0.f, g1 = 0.f, u0 = 0.f, u1 = 0.f;
        if (lane < PH * 16) { idx0 = p.IDX[(size_t)t * PH * 16 + lane]; g0 = p.G[(size_t)t * PH * 16 + lane]; u0 = p.GU[(size_t)t * PH * 16 + lane]; }
        if (64 + lane < PH * 16) { idx1 = p.IDX[(size_t)t * PH * 16 + 64 + lane]; g1 = p.G[(size_t)t * PH * 16 + 64 + lane]; u1 = p.GU[(size_t)t * PH * 16 + 64 + lane]; }
        GBuf b0, b1, b2;
        gather_load(p, b0, 0, idx0, idx1, g0, g1, u0, u1, lane);
        gather_load(p, b1, 1, idx0, idx1, g0, g1, u0, u1, lane);
        for (int g = 0; g < NG; g += 3) {
            if (g + 2 < NG) gather_load(p, b2, g + 2, idx0, idx1, g0, g1, u0, u1, lane);
            gather_compute(b0, hv, acc, lane);
            if (g + 1 < NG) {
                if (g + 3 < NG) gather_load(p, b0, g + 3, idx0, idx1, g0, g1, u0, u1, lane);
                gather_compute(b1, hv, acc, lane);
            }
            if (g + 2 < NG) {
                if (g + 4 < NG) gather_load(p, b1, g + 4, idx0, idx1, g0, g1, u0, u1, lane);
                gather_compute(b2, hv, acc, lane);
            }
        }
        if (act) {
            const float* g2 = p.MOD + (size_t)(l * 2 + (t >= CTX ? 1 : 0)) * 6 * D_MODEL + 5 * D_MODEL + lane * 16;
            float* xp = p.X + (size_t)t * D_MODEL + lane * 16;
#pragma unroll
            for (int c = 0; c < 4; ++c) {
                float4 x = *(float4*)(xp + c * 4);
                x.x += g2[c * 4 + 0] * acc[c * 4 + 0]; x.y += g2[c * 4 + 1] * acc[c * 4 + 1]; x.z += g2[c * 4 + 2] * acc[c * 4 + 2]; x.w += g2[c * 4 + 3] * acc[c * 4 + 3];
                *(float4*)(xp + c * 4) = x;
            }
        }
    }
}

__device__ __forceinline__ void phase_final(const P& p) {
    const int lane = otid() & 63;
    const int gw = (obid() * NTHREADS + otid()) >> 6, nw = (gridDim.x * NTHREADS) >> 6;
    const float* g = p.in[I_FG];
    for (int t = gw; t < SEQ; t += nw) {
        const float* x = p.X + (size_t)(CTX + t) * D_MODEL;
        float v[D_MODEL / 64]; float ss = 0.f;
#pragma unroll
        for (int j = 0; j < D_MODEL / 64; ++j) { v[j] = x[lane + 64 * j]; ss += v[j] * v[j]; }
        ss = wave_sum(ss);
        float rstd = rsqrtf(ss / D_MODEL + 1e-6f);
#pragma unroll
        for (int j = 0; j < D_MODEL / 64; ++j) p.out[(size_t)t * D_MODEL + lane + 64 * j] = v[j] * rstd * g[lane + 64 * j];
    }
}

__global__ void __launch_bounds__(NTHREADS) fwd_megakernel(P p_arg) {
#ifdef EMU
    char* smem = emu_smem();
#else
    __shared__ __attribute__((aligned(16))) char smem_raw[SMEM_BYTES + 16];
    char* smem = smem_raw;
#endif
#ifndef EMU
    volatile LAS unsigned* xst = (volatile LAS unsigned*)(smem_raw + SMEM_BYTES);
    if (threadIdx.x == 0) { xst[0] = 0u; xst[1] = 0u; xst[2] = 0u; xst[3] = 0u; }
    __syncthreads();
    XcdBarrier xb = xcd_barrier_post(p_arg.bar, xst);
#endif
    { LOADP(); phase_init(p, smem); }
#ifndef EMU
    cg::this_grid().sync();
#endif
    GRID_SYNC();
#ifndef EMU
    if (threadIdx.x == 0) {
        unsigned base_ = 0;
        for (unsigned j = 0; j < xb.x; ++j) base_ += xb_ld(&p_arg.bar[XB_XCNT(j)]);
        xst[2] = base_ + xst[3];
    }
    __syncthreads();
#endif
    PROBE_INIT();
    for (int l = 0; l < DEPTH; ++l) {
        { LOADP(); phase_norm(p, l, 0); }
        { LOADP(); phase_s5const(p, l); }
        { LOADP(); phase_convert_weights(p, l, smem); }
        GRID_SYNC(); PROBE_AFTER(0);
        { LOADP(); phase_gemm_in(p, l, smem); }
        GRID_SYNC(); PROBE_AFTER(1);
        { LOADP(); phase_rwkv_prep1(p, l); }
        GRID_SYNC(); PROBE_AFTER(14);
        { LOADP(); phase_rwkv_prep2(p, l, smem); }
        GRID_SYNC(); PROBE_AFTER(2);
        { LOADP(); for (int job = obid(); job < 2 * NC * RH; job += gridDim.x) rwkv_chunk_job(p, job, smem); }
        __syncthreads();
        { LOADP(); phase_gla_kv(p, l, smem); }
        { LOADP(); phase_s5_pass(p, l, smem, false); }
        GRID_SYNC(); PROBE_AFTER(3);
        {
            LOADP();
            const int n_rw = 2 * RH, n_gla = 2 * GH * 8192 / NTHREADS, n_s5 = (2 * SG * 64 + NTHREADS - 1) / NTHREADS;
            for (int job = obid(); job < n_rw + n_gla + n_s5 + PEER_CONV_JOBS; job += gridDim.x) {
                if (job < n_rw) rwkv_seq_job(p, job, smem);
                else if (job < n_rw + n_gla) gla_scan_job(p, job - n_rw);
                else if (job < n_rw + n_gla + n_s5) s5_carry_job(p, job - n_rw - n_gla);
                else peer_conv_job(p, l, job - n_rw - n_gla - n_s5);
            }
        }
        GRID_SYNC(); PROBE_AFTER(4);
        { LOADP(); for (int job = obid(); job < 2 * NC * RH; job += gridDim.x) rwkv_out_job(p, job); }
        { LOADP(); phase_gla_out(p, l, smem); }
        { LOADP(); phase_s5_pass(p, l, smem, true); }
        GRID_SYNC(); PROBE_AFTER(5);
        { LOADP(); phase_side_elem(p, l); }
        GRID_SYNC(); PROBE_AFTER(6);
        { LOADP(); phase_side_gemm(p, l, smem); }
        GRID_SYNC(); PROBE_AFTER(7);
        { LOADP(); phase_merge(p, l, smem); }
        GRID_SYNC(); PROBE_AFTER(8);
        { LOADP(); phase_outproj(p, l, smem); }
        GRID_SYNC(); PROBE_AFTER(9);
        { LOADP(); phase_norm(p, l, 1); }
        GRID_SYNC(); PROBE_AFTER(10);
        { LOADP(); phase_peer_q(p, l, smem); }
        GRID_SYNC(); PROBE_AFTER(11);
        { LOADP(); phase_peer_topk(p, l, smem); }
        GRID_SYNC(); PROBE_AFTER(12);
        { LOADP(); phase_peer_gather(p, l); }
        GRID_SYNC(); PROBE_AFTER(13);
    }
    { LOADP(); phase_final(p); }
}

static inline size_t align_up(size_t x) { return (x + 255) & ~(size_t)255; }

extern "C" void kernel_launch(void* const* d_in, const int* in_sizes, int n_in, void* d_out, int out_size, void* d_ws, size_t ws_size, hipStream_t stream) {
    P p;
    memset(&p, 0, sizeof(p));
    for (int i = 0; i < 39; ++i) p.in[i] = (const float*)d_in[i];
    p.out = (float*)d_out;
    char* w = (char*)d_ws; size_t off = 0;
    auto take = [&](size_t bytes) { void* r = w + off; off = align_up(off + bytes); return r; };
    p.bar = (unsigned*)take(16384);
    p.X = (float*)take((size_t)MTOT * D_MODEL * 4);
    p.H = (bf16_t*)take((size_t)MTOT * D_MODEL * 2);
    p.MOD = (float*)take((size_t)DEPTH * 2 * 6 * D_MODEL * 4);
    p.Z = (bf16_t*)take((size_t)MTOT * ZLD * 2);
    p.ZGT = (bf16_t*)take((size_t)MTOT * 3 * D_MODEL * 2);
    p.V = (bf16_t*)take((size_t)MTOT * RW * 2);
    {
        char* ra = (char*)take((size_t)MTOT * RW * 2 * 2 > (size_t)MTOT * GLA_V * 4 ? (size_t)MTOT * RW * 2 * 2 : (size_t)MTOT * GLA_V * 4);
        p.R = (bf16_t*)ra; p.KK = (bf16_t*)(ra + (size_t)MTOT * RW * 2);
        p.OGLA = (float*)ra;
    }
    {
        char* rb = (char*)take((size_t)2 * MTOT * RW * 2 > (size_t)3 * MTOT * PH * 16 * 4 ? (size_t)2 * MTOT * RW * 2 : (size_t)3 * MTOT * PH * 16 * 4);
        p.KD = (bf16_t*)rb;
        p.IDX = (int*)rb; p.G = (float*)(rb + (size_t)MTOT * PH * 16 * 4); p.GU = (float*)(rb + (size_t)2 * MTOT * PH * 16 * 4);
    }
    p.BB = (bf16_t*)take((size_t)2 * MTOT * RW * 2);
    p.LW = (float*)take((size_t)2 * MTOT * RW * 4);
    p.SP = (bf16_t*)p.LW;
    static_assert((size_t)2 * NC * GH * 8192 * 2 <= (size_t)2 * MTOT * RW * 4, "SP alias");
    p.BONUS = (float*)take((size_t)2 * MTOT * RH * 4);
    p.KS = (bf16_t*)take((size_t)MTOT * RW * 2);
    p.LR = (bf16_t*)take((size_t)MTOT * 256 * 2);
    p.WT_W2 = (bf16_t*)take((size_t)2 * NPAD(RW) * 64 * 2);
    p.WT_A2 = (bf16_t*)take((size_t)2 * NPAD(RW) * 64 * 2);
    p.GS = (bf16_t*)take((size_t)MTOT * 128 * 2);
    p.Y = (float*)take((size_t)2 * MTOT * RW * 4);
    p.KV = (float*)take((size_t)2 * NC * GH * 8192 * 4);
    p.DEC = (float*)take((size_t)2 * NC * GH * 64 * 4);
    p.S5A = (float*)take((size_t)2 * SG * 64 * 2 * 4);
    p.S5BB = (float*)take((size_t)2 * SG * 64 * 16 * 2 * 4);
    p.S5END = (float*)take((size_t)2 * NC * SG * 64 * 2 * 4);
    p.S5CAR = (float*)take((size_t)2 * NC * SG * 64 * 2 * 4);
    {
        const size_t szc1 = (size_t)2 * NC * RH * SEQ_REC;
        const size_t szc2 = (size_t)MTOT * SW * 2 + (size_t)MTOT * RW * 4 + (size_t)MTOT * 3 * BW * 2 + (size_t)MTOT * D_MODEL * 2 + 1024;
        char* rc = (char*)take(szc1 > szc2 ? szc1 : szc2);
        p.REC = rc;
        char* c2 = rc;
        p.GY = (bf16_t*)c2; c2 += align_up((size_t)MTOT * SW * 2);
        p.YN = (float*)c2; c2 += align_up((size_t)MTOT * RW * 4);
        p.BR = (bf16_t*)c2; c2 += align_up((size_t)MTOT * 3 * BW * 2);
        p.M = (bf16_t*)c2;
    }
    p.SN = (bf16_t*)take((size_t)2 * NC * RH * 4096 * 2);
    p.QH = (bf16_t*)take((size_t)2 * NC * RH * 4096 * 2);
    p.WT_IN = (bf16_t*)take((size_t)NPAD192(D_IN) * D_MODEL * 2);
    p.WT_G2 = (bf16_t*)take((size_t)NPAD(RW) * 128 * 2);
    p.WT_GLU = (bf16_t*)take((size_t)NPAD(2 * SW) * SW * 2);
    p.WT_BR = (bf16_t*)take((size_t)3 * D_MODEL * BW * 2);
    p.WT_OUT = (bf16_t*)take((size_t)D_MODEL * D_MODEL * 2);
    p.WT_Q = (bf16_t*)take((size_t)PQ * D_MODEL * 2);
    p.U8 = (unsigned char*)take((size_t)NEXP * D_MODEL);
    p.V8 = (unsigned char*)take((size_t)NEXP * D_MODEL);
    p.USC = (float*)take((size_t)NEXP * 4); p.VSC = (float*)take((size_t)NEXP * 4);
    p.QHI = p.Z; p.QLO = p.Z + (size_t)MTOT * PQ;
    p.KHI = (bf16_t*)take((size_t)PH * 2 * 128 * 128 * 2); p.KLO = (bf16_t*)take((size_t)PH * 2 * 128 * 128 * 2);
    static_assert((size_t)PQ * 4 <= (size_t)D_IN * 2 && ((size_t)MTOT * ZLD * 2) % 256 == 0, "Q alias");
    if (off > ws_size) { fprintf(stderr, "ws too small: need %zu have %zu\n", off, ws_size); return; }
#ifdef EMU
    fprintf(stderr, "ws used %zu MB\n", off >> 20);
    emu_launch([=] { fwd_megakernel(p); }, EMU_GRID, NTHREADS);
#else
    hipMemsetAsync(p.bar, 0, 16384, stream);
    static int grid_blocks = 0;
    if (!grid_blocks) {
        int dev = 0, cus = 0, per_cu = 0;
        hipGetDevice(&dev);
        hipDeviceGetAttribute(&cus, hipDeviceAttributeMultiprocessorCount, dev);
        hipOccupancyMaxActiveBlocksPerMultiprocessor(&per_cu, fwd_megakernel, NTHREADS, 0);
        if (per_cu > 1) per_cu = 1;
        grid_blocks = cus * per_cu;
    }
    void* args[] = {&p};
    hipError_t e = hipLaunchCooperativeKernel((void*)fwd_megakernel, dim3(grid_blocks), dim3(NTHREADS), args, 0, stream);
    if (e != hipSuccess) fprintf(stderr, "cooperative launch failed: %s (grid %d)\n", hipGetErrorString(e), grid_blocks);
#endif
}
```

```cpp
#include <hip/hip_runtime.h>
#ifndef EMU
#include <hip/hip_cooperative_groups.h>
namespace cg = cooperative_groups;
#endif
#include <cstdio>
#include <cstdint>
#include <cstring>
#include <type_traits>

#ifdef CFG_SMALL
#define D_MODEL 128
#define SEQ 640
#define DEPTH 2
#define GRID_W 10
#define CTX 128
#define GH 1
#define RH 2
#define SG 8
#define PH 2
#else
#define D_MODEL 1024
#define SEQ 16384
#define DEPTH 4
#define GRID_W 64
#define CTX 256
#define GH 4
#define RH 8
#define SG 32
#define PH 8
#endif
#define MTOT (CTX + SEQ)
#define ROWS (SEQ / GRID_W)
#define GLA_K (GH * 64)
#define GLA_V (GH * 128)
#define RW (RH * 64)
#define RWKV_IN (3 * RW + 4 * 64 + 128)
#define SW (SG * 16)
#define BW GLA_V
#define ZQ 0
#define ZK (GLA_K)
#define ZV (2 * GLA_K)
#define ZOG (ZV + GLA_V)
#define ZAF (ZOG + GLA_V)
#define ZAB (ZAF + 16)
#define ZR (ZAB + 16)
#define ZS5 (ZR + RWKV_IN)
#define ZG (ZS5 + SW)
#define D_IN (ZG + 3 * D_MODEL)
#define ZLD ZG
#define NC (MTOT / 64)
#define NCC (CTX / 64)
#define RB (ROWS / 64)
#define PQ (PH * 256)
#define NEXP 16384
#define NTHREADS 256
#define SMEM_BYTES 133120

typedef unsigned short bf16_t;
typedef short bf16x8 __attribute__((ext_vector_type(8)));
typedef float f32x4 __attribute__((ext_vector_type(4)));
typedef unsigned u32x4 __attribute__((ext_vector_type(4)));
typedef unsigned u32x2 __attribute__((ext_vector_type(2)));
#ifdef EMU
#define MFMA16(a, b, c) emu_mfma_16x16x32_bf16(a, b, c)
#else
#define MFMA16(a, b, c) __builtin_amdgcn_mfma_f32_16x16x32_bf16(a, b, c, 0, 0, 0)
#endif
typedef float f32x2 __attribute__((ext_vector_type(2)));
#ifdef EMU
#define CVT_PK_FP8(a, b, old, hi) emu_cvt_pk_fp8_f32(a, b, old, hi)
#define CVT_PK_F32_FP8(w, hi) emu_cvt_pk_f32_fp8(w, hi)
#else
#define CVT_PK_FP8(a, b, old, hi) __builtin_amdgcn_cvt_pk_fp8_f32(a, b, old, hi)
#define CVT_PK_F32_FP8(w, hi) __builtin_amdgcn_cvt_pk_f32_fp8(w, hi)
#endif
#ifdef EMU
#define MFMA16_ACC(a, b, c) c = emu_mfma_16x16x32_bf16(a, b, c)
#else
#define MFMA16_ACC(a, b, c) asm volatile("v_mfma_f32_16x16x32_bf16 %0, %1, %2, %0" : "+a"(c) : "v"(a), "v"(b))
#endif
#define NPAD(n) (((n) + 127) / 128 * 128)
#define NPAD192(n) (((n) + 383) / 384 * 384)

__device__ __forceinline__ float bf2f(bf16_t h) { return __builtin_bit_cast(float, ((unsigned)h) << 16); }
#ifdef EMU
__device__ __forceinline__ bf16_t f2bf(float f) { unsigned u = __builtin_bit_cast(unsigned, f); u += 0x7FFFu + ((u >> 16) & 1u); return (bf16_t)(u >> 16); }
__device__ __forceinline__ unsigned pack2bf(float a, float b) { return (unsigned)f2bf(a) | ((unsigned)f2bf(b) << 16); }
#else
typedef float f2v_t __attribute__((ext_vector_type(2))); typedef __bf16 b2v_t __attribute__((ext_vector_type(2)));
__device__ __forceinline__ bf16_t f2bf(float f) { return __builtin_bit_cast(unsigned short, (__bf16)f); }
__device__ __forceinline__ unsigned pack2bf(float a, float b) { f2v_t v = {a, b}; b2v_t r = __builtin_convertvector(v, b2v_t); return __builtin_bit_cast(unsigned, r); }
#endif
#ifdef EMU
#define fexp_(x) expf(x)
#define flog_(x) logf(x)
#else
#define fexp_(x) __expf(x)
#define flog_(x) __logf(x)
#endif
#define LO16(x) __builtin_bit_cast(float, (x) << 16)
#define HI16(x) __builtin_bit_cast(float, (x) & 0xFFFF0000u)
__device__ __forceinline__ float sigmoidf_(float x) { return 1.0f / (1.0f + fexp_(-x)); }
__device__ __forceinline__ float siluf_(float x) { return x * sigmoidf_(x); }
__device__ __forceinline__ float geluf_(float x) { const float y = 1.5957691216057308f * (x + 0.044715f * x * x * x); return x / (1.0f + fexp_(-y)); }
__device__ __forceinline__ float softplusf_(float x) { return fmaxf(x, 0.f) + flog_(1.0f + fexp_(-fabsf(x))); }
__device__ __forceinline__ float tanhf_(float x) { const float e = fexp_(-2.0f * fabsf(x)); const float t = (1.0f - e) / (1.0f + e); return x < 0.f ? -t : t; }
__device__ __forceinline__ float wave_sum(float v) {
#pragma unroll
    for (int m = 32; m >= 1; m >>= 1) v += __shfl_xor(v, m, 64);
    return v;
}

struct P {
    const float* in[39];
    float* out;
    float* X;
    bf16_t* H;
    bf16_t* Z;
    bf16_t* ZGT;
    float* MOD;
    bf16_t* R; bf16_t* V; bf16_t* KK; bf16_t* KD; bf16_t* BB;
    float* LW;
    char* REC;
    bf16_t* SN;
    bf16_t* QH;
    float* BONUS;
    bf16_t* KS;
    bf16_t* LR;
    bf16_t* WT_W2;
    bf16_t* WT_A2;
    bf16_t* GS;
    float* Y;
    float* Y0T;
    float* KV;
    bf16_t* SP;
    float* DEC;
    float* OGLA;
    float* S5A;
    float* S5BB;
    float* S5END;
    float* S5CAR;
    bf16_t* GY;
    float* YN;
    bf16_t* BR;
    bf16_t* M;
    bf16_t* QHI; bf16_t* QLO;
    bf16_t* KHI; bf16_t* KLO;
    int* IDX;
    float* G;
    float* GU;
    unsigned* bar;
    bf16_t* WT_IN;
    bf16_t* WT_G2;
    bf16_t* WT_GLU;
    bf16_t* WT_BR;
    bf16_t* WT_OUT;
    bf16_t* WT_Q;
    unsigned char* U8; unsigned char* V8;
    float* USC; float* VSC;
};

enum { I_X = 0, I_C, I_CTX, I_CCTX, I_WMOD, I_BMOD, I_N1G, I_N2G, I_WIN, I_GLA_WA2, I_GLA_BA, I_GLA_NG, I_RCONV, I_RW0, I_RW2, I_RA0, I_RA2, I_RG2,
       I_RKK, I_RKA, I_RRK, I_RLNW, I_RLNB, I_S5LRE, I_S5LIM, I_S5LS, I_S5BRE, I_S5BIM, I_S5CRE, I_S5CIM, I_S5D, I_S5GLU, I_WBR, I_WOUT, I_PWQ, I_PKEYS, I_PU, I_PV, I_FG };

#ifdef EMU
__device__ __forceinline__ int otid() { return threadIdx.x; }
__device__ __forceinline__ int obid() { return blockIdx.x; }
#else
__device__ __forceinline__ int otid() { int t = threadIdx.x; asm volatile("" : "+v"(t)); return t; }
__device__ __forceinline__ int obid() { int b = blockIdx.x; asm volatile("" : "+s"(b)); return b; }
#endif
#ifdef EMU
#define WAVE_SYNC() emu_wave_barrier()
#ifndef EMU_GRID
#define EMU_GRID 4
#endif
#else
#define WAVE_SYNC() __builtin_amdgcn_wave_barrier()
#endif
#ifndef EMU
#define XB_TMO      128
#define XB_XCNT(j)  (256  + 64 * (j))
#define XB_XSUB(j)  (1280 + 64 * (j))
#define XB_XGEN(j)  (2304 + 64 * (j))
#define XB_TOP      3328
#define XB_TOPGEN   3392
#define XCD_BAR_WORDS 3456
#define XB_SPIN_CAP (1u << 22)
#define LAS __attribute__((address_space(3)))
__device__ __forceinline__ unsigned xb_ld(unsigned* p)              { return __hip_atomic_load(p, __ATOMIC_RELAXED, __HIP_MEMORY_SCOPE_AGENT); }
__device__ __forceinline__ unsigned xb_add(unsigned* p, unsigned v) { return __hip_atomic_fetch_add(p, v, __ATOMIC_RELAXED, __HIP_MEMORY_SCOPE_AGENT); }
__device__ __forceinline__ unsigned xb_xcc_id() { return (unsigned)__builtin_amdgcn_s_getreg((3 << 11) | 20) & 0xFu; }
#define XB_SPIN(cond, bar) do { unsigned _sp = 0; while (cond) { __builtin_amdgcn_s_sleep(1); \
    if ((++_sp & 255u) == 0u) { if (xb_ld(&(bar)[XB_TMO])) break; if (_sp > XB_SPIN_CAP) { atomicAdd(&(bar)[XB_TMO], 1u); break; } } } } while (0)
struct XcdBarrier { unsigned* bar; unsigned x; volatile LAS unsigned* st; };
__device__ __forceinline__ XcdBarrier xcd_barrier_post(unsigned* bar, volatile LAS unsigned* st) {
    XcdBarrier b; b.bar = bar; b.x = xb_xcc_id(); b.st = st;
    if (threadIdx.x == 0) st[3] = xb_add(&bar[XB_XCNT(b.x)], 1u);
    return b;
}
__device__ __forceinline__ void xcd_barrier_complete(unsigned* bar, unsigned x, unsigned& nloc, unsigned& nx) {
    const unsigned G = gridDim.x * gridDim.y * gridDim.z;
    unsigned sum, cnt, mine, sp = 0u;
    for (;;) {
        sum = 0u; cnt = 0u; mine = 0u;
#pragma unroll
        for (unsigned j = 0; j < 16; ++j) { const unsigned c = xb_ld(&bar[XB_XCNT(j)]); sum += c; cnt += (c > 0u) ? 1u : 0u; mine = (j == x) ? c : mine; }
        if (sum == G) break;
        __builtin_amdgcn_s_sleep(1);
        if ((++sp & 255u) == 0u) { if (xb_ld(&bar[XB_TMO])) break; if (sp > XB_SPIN_CAP) { atomicAdd(&bar[XB_TMO], 1u); break; } }
    }
    nloc = mine > 0u ? mine : 1u; nx = cnt > 0u ? cnt : 1u;
}
__device__ __forceinline__ void xcd_barrier(const XcdBarrier& b) {
    asm volatile("s_waitcnt vmcnt(0)" ::: "memory");
    __syncthreads();
    if (threadIdx.x == 0) {
        unsigned* bar = b.bar;
        __builtin_amdgcn_s_waitcnt(0);
        unsigned nloc = b.st[0], nx = b.st[1];
        if (nloc == 0u) { xcd_barrier_complete(bar, b.x, nloc, nx); b.st[0] = nloc; b.st[1] = nx; }
        const unsigned old = xb_add(&bar[XB_XSUB(b.x)], 1u);
        const unsigned gen = old / nloc;
        if (old + 1u == (gen + 1u) * nloc) {
            __builtin_amdgcn_fence(__ATOMIC_RELEASE, "agent");
            asm volatile("s_waitcnt vmcnt(0)" ::: "memory");
            const unsigned og = xb_add(&bar[XB_TOP], 1u);
            const unsigned tg = og / nx;
            if (og + 1u == (tg + 1u) * nx) xb_add(&bar[XB_TOPGEN], 1u);
            else XB_SPIN(xb_ld(&bar[XB_TOPGEN]) == tg, bar);
            __builtin_amdgcn_fence(__ATOMIC_ACQUIRE, "agent");
            xb_add(&bar[XB_XGEN(b.x)], 1u);
            asm volatile("s_waitcnt vmcnt(0)" ::: "memory");
        } else {
            XB_SPIN(xb_ld(&bar[XB_XGEN(b.x)]) == gen, bar);
            __builtin_amdgcn_fence(__ATOMIC_ACQUIRE, "agent");
            asm volatile("s_waitcnt vmcnt(0)" ::: "memory");
        }
    }
    __syncthreads();
}
#define GRID_SYNC() xcd_barrier(xb)
#else
#define GRID_SYNC() emu_grid_sync()
#endif

#ifdef EMU
#define LOADP() const P& p = p_arg
#else
typedef __attribute__((address_space(4))) const unsigned long long cu64_t;
__device__ __forceinline__ void load_params(P& p) {
    cu64_t* q = (cu64_t*)__builtin_amdgcn_kernarg_segment_ptr();
    asm volatile("" : "+s"(q));
    unsigned long long w[sizeof(P) / 8];
#pragma unroll
    for (int i = 0; i < (int)(sizeof(P) / 8); ++i) w[i] = q[i];
    __builtin_memcpy(&p, w, sizeof(P));
}
#define LOADP() P p; load_params(p)
#endif
#define PROBE_MULT 3
#if defined(PROBE_ID) && !defined(EMU)
#define PROBE_INIT() unsigned long long probe_t0 = wall_clock64()
#define PROBE_AFTER(id) { if (blockIdx.x == 0) { unsigned long long now_ = wall_clock64(); if ((id) == PROBE_ID) { const unsigned long long dt_ = now_ - probe_t0; \
    while (wall_clock64() - now_ < dt_ * PROBE_MULT) __builtin_amdgcn_s_sleep(8); now_ = wall_clock64(); } probe_t0 = now_; } }
#else
#define PROBE_INIT()
#define PROBE_AFTER(id)
#endif
__device__ __forceinline__ int gla_tok(int n, int i) {
    if (n < NCC) return n * 64 + i;
    int m = n - NCC; int col = m / RB, rb = m % RB;
    return CTX + (rb * 64 + i) * GRID_W + col;
}
__device__ __forceinline__ int chunk_order(int d, int s) {
    if (d == 0) return s;
    return (s < NCC) ? (NCC - 1 - s) : (NC - 1 - (s - NCC));
}
__device__ __forceinline__ int tok_order(int d, int s) {
    if (d == 0) return s;
    return (s < CTX) ? (CTX - 1 - s) : (MTOT - 1 - (s - CTX));
}


#define LDS_ROW 72
__device__ __forceinline__ void mfma_gemm_tile(const bf16_t* Wt, int ldw, const bf16_t* Act, int lda, int K, int n0, int m0, bf16_t* lds, f32x4 (&acc)[4][4]) {
    bf16_t* Ws = lds; bf16_t* As = lds + 128 * LDS_ROW;
    const int tid = otid(), lane = tid & 63, wave = tid >> 6, wn = wave >> 1, wm = wave & 1;
    const int lrow = tid >> 3, lkc = (tid & 7) * 8;
    u32x4 pw[4], pa[4];
#pragma unroll
    for (int i = 0; i < 4; ++i) {
        pw[i] = *(const u32x4*)(Wt + (size_t)(n0 + lrow + 32 * i) * ldw + lkc);
        pa[i] = *(const u32x4*)(Act + (size_t)(m0 + lrow + 32 * i) * lda + lkc);
    }
    for (int k0 = 0; k0 < K; k0 += 64) {
        __syncthreads();
#pragma unroll
        for (int i = 0; i < 4; ++i) {
            *(u32x4*)(Ws + (lrow + 32 * i) * LDS_ROW + lkc) = pw[i];
            *(u32x4*)(As + (lrow + 32 * i) * LDS_ROW + lkc) = pa[i];
        }
        __syncthreads();
        if (k0 + 64 < K) {
#pragma unroll
            for (int i = 0; i < 4; ++i) {
                pw[i] = *(const u32x4*)(Wt + (size_t)(n0 + lrow + 32 * i) * ldw + k0 + 64 + lkc);
                pa[i] = *(const u32x4*)(Act + (size_t)(m0 + lrow + 32 * i) * lda + k0 + 64 + lkc);
            }
        }
#pragma unroll
        for (int ks = 0; ks < 2; ++ks) {
            bf16x8 a[4], b[4];
#pragma unroll
            for (int i = 0; i < 4; ++i) {
                a[i] = *(const bf16x8*)(Ws + (wn * 64 + i * 16 + (lane & 15)) * LDS_ROW + ks * 32 + (lane >> 4) * 8);
                b[i] = *(const bf16x8*)(As + (wm * 64 + i * 16 + (lane & 15)) * LDS_ROW + ks * 32 + (lane >> 4) * 8);
            }
#pragma unroll
            for (int ni = 0; ni < 4; ++ni)
#pragma unroll
                for (int mi = 0; mi < 4; ++mi) acc[ni][mi] = MFMA16(a[ni], b[mi], acc[ni][mi]);
        }
    }
}
#define L64_ROW 72
#ifdef EMU
struct BufRsrc { const char* base; };
__device__ __forceinline__ BufRsrc make_rsrc(const void* p, size_t) { BufRsrc r; r.base = (const char*)p; return r; }
__device__ __forceinline__ u32x4 buf_load16(const BufRsrc& r, unsigned voff, unsigned soff) { return *(const u32x4*)(r.base + voff + soff); }
#else
typedef __amdgpu_buffer_rsrc_t BufRsrc;
__device__ __forceinline__ BufRsrc make_rsrc(const void* p, size_t bytes) { return __builtin_amdgcn_make_buffer_rsrc((void*)p, 0, (int)bytes, 0x00020000); }
__device__ __forceinline__ u32x4 buf_load16(const BufRsrc& r, unsigned voff, unsigned soff) { return __builtin_bit_cast(u32x4, __builtin_amdgcn_raw_buffer_load_b128(r, voff, soff, 0)); }
#endif
template <int NI, int MI>
__device__ __forceinline__ void mfma_gemm_tile_t(const bf16_t* Wt, int ldw, size_t wbytes, const bf16_t* Act, int lda, size_t abytes, int K, int n0, int m0, bf16_t* lds, f32x4 (&acc)[NI][MI], unsigned long long* gacc = nullptr) {
    constexpr int WR = 32 * NI, AR = 32 * MI, BUF = (WR + AR) * L64_ROW;
    const int tid = otid(), lane = tid & 63, wave = tid >> 6, wn = wave >> 1, wm = wave & 1;
    const int lrow = tid >> 3, lkc = (tid & 7) * 8;
    const BufRsrc rw = make_rsrc(Wt, wbytes), ra = make_rsrc(Act, abytes);
    unsigned vw[NI], va[MI];
#pragma unroll
    for (int i = 0; i < NI; ++i) vw[i] = (unsigned)(((size_t)(n0 + lrow + 32 * i) * ldw + lkc) * 2);
#pragma unroll
    for (int i = 0; i < MI; ++i) va[i] = (unsigned)(((size_t)(m0 + lrow + 32 * i) * lda + lkc) * 2);
    u32x4 qw0[NI], qa0[MI];
    const int nk = K / 64;
#define GT_LOAD(QW, QA, KT) { const unsigned so_ = (unsigned)(((KT) < nk) ? (KT) : (nk - 1)) * 128u; \
    _Pragma("unroll") for (int i = 0; i < NI; ++i) QW[i] = buf_load16(rw, vw[i], so_); \
    _Pragma("unroll") for (int i = 0; i < MI; ++i) QA[i] = buf_load16(ra, va[i], so_); }
#define GT_STORE(QW, QA, DST) { \
    _Pragma("unroll") for (int i = 0; i < NI; ++i) *(u32x4*)((DST) + (lrow + 32 * i) * L64_ROW + lkc) = QW[i]; \
    _Pragma("unroll") for (int i = 0; i < MI; ++i) *(u32x4*)((DST) + (WR + lrow + 32 * i) * L64_ROW + lkc) = QA[i]; }
#define GT_COMPUTE(CUR) { _Pragma("unroll") for (int ks = 0; ks < 2; ++ks) { bf16x8 b[MI], a[NI]; \
    _Pragma("unroll") for (int i = 0; i < MI; ++i) b[i] = *(const bf16x8*)((CUR) + (WR + wm * 16 * MI + i * 16 + (lane & 15)) * L64_ROW + ks * 32 + (lane >> 4) * 8); \
    _Pragma("unroll") for (int i = 0; i < NI; ++i) a[i] = *(const bf16x8*)((CUR) + (wn * 16 * NI + i * 16 + (lane & 15)) * L64_ROW + ks * 32 + (lane >> 4) * 8); \
    _Pragma("unroll") for (int ni = 0; ni < NI; ++ni) { \
        _Pragma("unroll") for (int mi = 0; mi < MI; ++mi) MFMA16_ACC(a[ni], b[mi], acc[ni][mi]); } } }
    GT_LOAD(qw0, qa0, 0)
    __syncthreads();
    GT_STORE(qw0, qa0, lds)
    __syncthreads();
    for (int kt = 0; kt < nk; kt += 2) {
        GT_LOAD(qw0, qa0, kt + 1)
        GT_COMPUTE(lds)
        GT_STORE(qw0, qa0, lds + BUF)
        __syncthreads();
        GT_LOAD(qw0, qa0, kt + 2)
        GT_COMPUTE(lds + BUF)
        GT_STORE(qw0, qa0, lds)
        __syncthreads();
    }
#undef GT_LOAD
#undef GT_STORE
#undef GT_COMPUTE
}
#define ZERO_ACC4(acc) { _Pragma("unroll") for (int i_ = 0; i_ < 4; ++i_) _Pragma("unroll") for (int j_ = 0; j_ < 4; ++j_) acc[i_][j_] = (f32x4){0.f, 0.f, 0.f, 0.f}; }
#define FOR_ACC(acc, n0, m0, BODY) { const int lane_ = otid() & 63, wave_ = otid() >> 6; \
    _Pragma("unroll") for (int ni_ = 0; ni_ < 4; ++ni_) _Pragma("unroll") for (int mi_ = 0; mi_ < 4; ++mi_) { \
        const int n = (n0) + (wave_ >> 1) * 64 + ni_ * 16 + (lane_ >> 4) * 4; const int m = (m0) + (wave_ & 1) * 64 + mi_ * 16 + (lane_ & 15); const f32x4 v = acc[ni_][mi_]; BODY } }
__device__ __forceinline__ u32x2 pack4(float a, float b, float c, float d) { u32x2 r; r.x = pack2bf(a, b); r.y = pack2bf(c, d); return r; }

__device__ __forceinline__ void convert_wt_job(const float* W, int K, int N, int Npad, bf16_t* out, int job, float* T, int ilv) {
    const int tid = otid();
    const int nkt = K / 64;
    const int n0 = (job / nkt) * 64, k0 = (job % nkt) * 64;
    __syncthreads();
    for (int idx = tid; idx < 4096; idx += NTHREADS) {
        int kk = idx >> 6, nn = idx & 63;
        int nr = n0 + nn; int src = ilv ? ((nr & 1) ? (N / 2 + (nr >> 1)) : (nr >> 1)) : nr;
        T[kk * 65 + nn] = (nr < N) ? W[(size_t)(k0 + kk) * N + src] : 0.f;
    }
    __syncthreads();
    {
        int nn = tid >> 2, part = tid & 3;
        unsigned w[8];
#pragma unroll
        for (int j = 0; j < 8; ++j) w[j] = pack2bf(T[(part * 16 + 2 * j) * 65 + nn], T[(part * 16 + 2 * j + 1) * 65 + nn]);
        u32x4* o = (u32x4*)(out + (size_t)(n0 + nn) * K + k0 + part * 16);
        o[0] = (u32x4){w[0], w[1], w[2], w[3]}; o[1] = (u32x4){w[4], w[5], w[6], w[7]};
    }
}
__device__ __forceinline__ void phase_convert_weights(const P& p, int l, char* smem) {
    float* T = (float*)smem;
    struct Item { const float* W; int K, N, Npad; bf16_t* out; };
    const Item items[12] = {
        {p.in[I_RW2] + ((size_t)l * 2 + 0) * 64 * RW, 64, RW, NPAD(RW), p.WT_W2},
        {p.in[I_RW2] + ((size_t)l * 2 + 1) * 64 * RW, 64, RW, NPAD(RW), p.WT_W2 + (size_t)NPAD(RW) * 64},
        {p.in[I_RA2] + ((size_t)l * 2 + 0) * 64 * RW, 64, RW, NPAD(RW), p.WT_A2},
        {p.in[I_RA2] + ((size_t)l * 2 + 1) * 64 * RW, 64, RW, NPAD(RW), p.WT_A2 + (size_t)NPAD(RW) * 64},
        {p.in[I_WIN] + (size_t)l * D_MODEL * D_IN, D_MODEL, D_IN, NPAD192(D_IN), p.WT_IN},
        {p.in[I_RG2] + (size_t)l * 128 * RW, 128, RW, RW, p.WT_G2},
        {p.in[I_S5GLU] + (size_t)l * SW * 2 * SW, SW, 2 * SW, 2 * SW, p.WT_GLU},
        {p.in[I_WBR] + ((size_t)l * 3 + 0) * BW * D_MODEL, BW, D_MODEL, D_MODEL, p.WT_BR},
        {p.in[I_WBR] + ((size_t)l * 3 + 1) * BW * D_MODEL, BW, D_MODEL, D_MODEL, p.WT_BR + (size_t)D_MODEL * BW},
        {p.in[I_WBR] + ((size_t)l * 3 + 2) * BW * D_MODEL, BW, D_MODEL, D_MODEL, p.WT_BR + (size_t)2 * D_MODEL * BW},
        {p.in[I_WOUT] + (size_t)l * D_MODEL * D_MODEL, D_MODEL, D_MODEL, D_MODEL, p.WT_OUT},
        {p.in[I_PWQ] + (size_t)l * D_MODEL * PQ, D_MODEL, PQ, PQ, p.WT_Q}};
    int base = 0;
#pragma unroll
    for (int it = 0; it < 12; ++it) {
        const int nj = (items[it].Npad / 64) * (items[it].K / 64);
        for (int j = (int)((obid() + gridDim.x - (base % gridDim.x)) % gridDim.x); j < nj; j += gridDim.x)
            convert_wt_job(items[it].W, items[it].K, items[it].N, items[it].Npad, items[it].out, j, T, it == 6);
        base += nj;
    }
    __syncthreads();
    {
        const float* ks = p.in[I_PKEYS] + (size_t)l * PH * 2 * 128 * 128;
        for (size_t i = (size_t)obid() * NTHREADS + otid(); i < (size_t)PH * 2 * 128 * 128; i += (size_t)gridDim.x * NTHREADS) {
            const float v = ks[i]; const bf16_t hb = f2bf(v);
            p.KHI[i] = hb; p.KLO[i] = f2bf(v - bf2f(hb));
        }
    }
}

#ifdef EMU
__device__ __forceinline__ int xcd_rank() { return obid(); }
#else
__device__ __forceinline__ int xcd_rank() { return (int)((volatile LAS unsigned*)(unsigned)(SMEM_BYTES))[2]; }
#endif
__device__ __forceinline__ bool tile_map(int it, int ntm, int ntn, int PM, int& mt, int& nt) {
    const int G = gridDim.x;
    const long id = (long)it * G + xcd_rank();
    if (id >= (long)ntm * ntn) return false;
    const int full = ntm / PM; const long fullsz = (long)full * PM * ntn;
    if (id < fullsz) { const int p = (int)(id / (PM * ntn)), rem = (int)(id % (PM * ntn)); nt = rem / PM; mt = p * PM + rem % PM; }
    else { const int rem = (int)(id - fullsz), hh = ntm - full * PM; nt = rem / hh; mt = full * PM + rem % hh; }
    return true;
}

template <int NI, int MI, class Pre, class Post>
__device__ __forceinline__ void gemm_tile_run(const bf16_t* Wt, int ldw, size_t wbytes, const bf16_t* Act, int lda, size_t abytes, int K, int n0, int m0, bf16_t* lds, Pre pre, Post post) {
    f32x4 acc[NI][MI];
#pragma unroll
    for (int i = 0; i < NI; ++i)
#pragma unroll
        for (int j = 0; j < MI; ++j) acc[i][j] = (f32x4){0.f, 0.f, 0.f, 0.f};
    pre(m0, n0, acc, lds);
    mfma_gemm_tile_t<NI, MI>(Wt, ldw, wbytes, Act, lda, abytes, K, n0, m0, lds, acc);
    const int lane = otid() & 63, wave = otid() >> 6;
#pragma unroll
    for (int ni = 0; ni < NI; ++ni)
#pragma unroll
        for (int mi = 0; mi < MI; ++mi)
            post(ni, mi, m0 + (wave & 1) * 16 * MI + mi * 16 + (lane & 15), n0 + (wave >> 1) * 16 * NI + ni * 16 + (lane >> 4) * 4, acc[ni][mi]);
}
struct NoPre { template <class A> __device__ __forceinline__ void operator()(int, int, A&, bf16_t*) const {} };
template <int NI, class PreM, class PreT, class Post>
__device__ __forceinline__ void gemm_phase(const bf16_t* Wt, int ldw, size_t wbytes, const bf16_t* Act, int lda, size_t abytes, int K, int N, bf16_t* lds, PreM prem, PreT pret, Post post) {
    const int ntn = N / (32 * NI), ntm = MTOT / 256 - 1;
    const int PM = (ntn >= 16) ? 2 : ((ntn >= 8) ? 4 : 8);
    for (int it = 0;; ++it) {
        int mt_, nt_; if (!tile_map(it, ntm, ntn, PM, mt_, nt_)) break;
        gemm_tile_run<NI, 8>(Wt, ldw, wbytes, Act, lda, abytes, K, nt_ * 32 * NI, mt_ * 256, lds, prem, post);
    }
    for (int job = obid(); job < 4 * ntn; job += gridDim.x)
        gemm_tile_run<NI, 2>(Wt, ldw, wbytes, Act, lda, abytes, K, (job >> 2) * 32 * NI, MTOT - 256 + (job & 3) * 64, lds, pret, post);
}

__device__ __forceinline__ void phase_init(const P& p, char* smem) {
    const int tid = otid();
    float* sc = (float*)smem;
    for (int i = tid; i < D_MODEL; i += NTHREADS) { sc[i] = siluf_(p.in[I_CCTX][i]); sc[D_MODEL + i] = siluf_(p.in[I_C][i]); }
    __syncthreads();
    const int ncolblk = (6 * D_MODEL) / NTHREADS;
    for (int job = obid(); job < DEPTH * ncolblk; job += gridDim.x) {
        int l = job / ncolblk, n = (job % ncolblk) * NTHREADS + tid;
        const float* w = p.in[I_WMOD] + (size_t)l * D_MODEL * 6 * D_MODEL + n;
        float a0 = 0.f, a1 = 0.f;
        for (int k = 0; k < D_MODEL; ++k) { float wv = w[(size_t)k * 6 * D_MODEL]; a0 += sc[k] * wv; a1 += sc[D_MODEL + k] * wv; }
        float b = p.in[I_BMOD][l * 6 * D_MODEL + n];
        p.MOD[(size_t)(l * 2 + 0) * 6 * D_MODEL + n] = a0 + b;
        p.MOD[(size_t)(l * 2 + 1) * 6 * D_MODEL + n] = a1 + b;
    }
    const size_t gtid = (size_t)obid() * NTHREADS + tid, gn = (size_t)gridDim.x * NTHREADS;
    for (size_t i = gtid; i < (size_t)CTX * D_MODEL; i += gn) p.X[i] = p.in[I_CTX][i];
    for (size_t i = gtid; i < (size_t)SEQ * D_MODEL; i += gn) p.X[(size_t)CTX * D_MODEL + i] = p.in[I_X][i];
    __syncthreads();
}

__device__ __forceinline__ void phase_s5const(const P& p, int l) {
    const size_t gtid = (size_t)obid() * NTHREADS + otid(), gn = (size_t)gridDim.x * NTHREADS;
    for (size_t i = gtid; i < (size_t)2 * SG * 64; i += gn) {
        int d = (int)(i / (SG * 64)), g = (int)((i / 64) % SG), s = (int)(i % 64);
        size_t li = ((size_t)(l * 2 + d) * SG + g) * 64 + s;
        float lre = p.in[I_S5LRE][li], lim = p.in[I_S5LIM][li];
        float dt = expf(p.in[I_S5LS][(l * 2 + d) * SG + g]);
        float mag = expf(lre * dt);
        float are = mag * cosf(lim * dt), aim = mag * sinf(lim * dt);
        float den = lre * lre + lim * lim;
        float fre = ((are - 1.0f) * lre + aim * lim) / den;
        float fim = (aim * lre - (are - 1.0f) * lim) / den;
        p.S5A[i * 2 + 0] = are; p.S5A[i * 2 + 1] = aim;
        const float* bre = p.in[I_S5BRE] + (((size_t)l * SG + g) * 64 + s) * 16;
        const float* bim = p.in[I_S5BIM] + (((size_t)l * SG + g) * 64 + s) * 16;
        for (int c = 0; c < 16; ++c) {
            p.S5BB[(i * 16 + c) * 2 + 0] = fre * bre[c] - fim * bim[c];
            p.S5BB[(i * 16 + c) * 2 + 1] = fre * bim[c] + fim * bre[c];
        }
    }
}

__device__ __forceinline__ void phase_norm(const P& p, int l, int which) {
    const int lane = otid() & 63;
    const int gw = (obid() * NTHREADS + otid()) >> 6, nw = (gridDim.x * NTHREADS) >> 6;
    const float* g = p.in[which ? I_N2G : I_N1G] + l * D_MODEL;
    constexpr int NJ = (D_MODEL + 255) / 256;
    for (int t = gw; t < MTOT; t += nw) {
        const float* x = p.X + (size_t)t * D_MODEL;
        const float* mod = p.MOD + (size_t)(l * 2 + (t >= CTX ? 1 : 0)) * 6 * D_MODEL + (which ? 3 * D_MODEL : 0);
        float4 v[NJ]; float ss = 0.f;
#pragma unroll
        for (int j = 0; j < NJ; ++j) {
            const int e = j * 256 + lane * 4;
            if (e < D_MODEL) v[j] = *(const float4*)(x + e); else { v[j].x = 0.f; v[j].y = 0.f; v[j].z = 0.f; v[j].w = 0.f; }
            ss += v[j].x * v[j].x + v[j].y * v[j].y + v[j].z * v[j].z + v[j].w * v[j].w;
        }
        ss = wave_sum(ss);
        const float rstd = rsqrtf(ss / D_MODEL + 1e-6f);
#pragma unroll
        for (int j = 0; j < NJ; ++j) {
            const int e = j * 256 + lane * 4;
            if (e < D_MODEL) {
                const float4 gg = *(const float4*)(g + e), sc = *(const float4*)(mod + D_MODEL + e), sh = *(const float4*)(mod + e);
                *(u32x2*)(p.H + (size_t)t * D_MODEL + e) = pack4(v[j].x * rstd * gg.x * (1.0f + sc.x) + sh.x, v[j].y * rstd * gg.y * (1.0f + sc.y) + sh.y,
                                                                 v[j].z * rstd * gg.z * (1.0f + sc.z) + sh.z, v[j].w * rstd * gg.w * (1.0f + sc.w) + sh.w);
            }
        }
    }
}

__device__ __forceinline__ void phase_gemm_in(const P& p, int l, char* smem) {
    constexpr int NI = 4, MI = 8;
    const int ntn = NPAD192(D_IN) / 128, ntm = MTOT / 256;
    for (int it = 0;; ++it) {
        int mt_, nt_; if (!tile_map(it, ntm, ntn, 4, mt_, nt_)) break;
        const int m0 = mt_ * 256, n0 = nt_ * 128;
        f32x4 acc[NI][MI];
#pragma unroll
        for (int i = 0; i < NI; ++i)
#pragma unroll
            for (int j = 0; j < MI; ++j) acc[i][j] = (f32x4){0.f, 0.f, 0.f, 0.f};
        mfma_gemm_tile_t<NI, MI>(p.WT_IN, D_MODEL, (size_t)NPAD192(D_IN) * D_MODEL * 2, p.H, D_MODEL, (size_t)MTOT * D_MODEL * 2, D_MODEL, n0, m0, (bf16_t*)smem, acc);
        const int lane = otid() & 63, wave = otid() >> 6;
#pragma unroll
        for (int ni = 0; ni < NI; ++ni)
#pragma unroll
            for (int mi = 0; mi < MI; ++mi) {
                const int n = n0 + (wave >> 1) * 16 * NI + ni * 16 + (lane >> 4) * 4, m = m0 + (wave & 1) * 16 * MI + mi * 16 + (lane & 15);
                const u32x2 pk_ = pack4(acc[ni][mi][0], acc[ni][mi][1], acc[ni][mi][2], acc[ni][mi][3]);
                if (n < ZG) *(u32x2*)(p.Z + (size_t)m * ZLD + n) = pk_;
                else if (n < D_IN) *(u32x2*)(p.ZGT + ((((size_t)(m >> 4) * (3 * D_MODEL / 16) + ((n - ZG) >> 4)) * 64 + lane) * 4)) =
                    pack4(sigmoidf_(acc[ni][mi][0]), sigmoidf_(acc[ni][mi][1]), sigmoidf_(acc[ni][mi][2]), sigmoidf_(acc[ni][mi][3]));
            }
    }
}

__device__ __forceinline__ void unpack8(const u32x4 w, float (&f)[8]) {
    f[0] = LO16(w.x); f[1] = HI16(w.x); f[2] = LO16(w.y); f[3] = HI16(w.y); f[4] = LO16(w.z); f[5] = HI16(w.z); f[6] = LO16(w.w); f[7] = HI16(w.w);
}
__device__ __forceinline__ u32x4 pack8(const float (&f)[8]) {
    u32x4 o; o.x = pack2bf(f[0], f[1]); o.y = pack2bf(f[2], f[3]);
    o.z = pack2bf(f[4], f[5]); o.w = pack2bf(f[6], f[7]); return o;
}
__device__ __forceinline__ void load8f(const float* p, float (&f)[8]) {
    const float4 a = *(const float4*)p, b = *(const float4*)(p + 4);
    f[0] = a.x; f[1] = a.y; f[2] = a.z; f[3] = a.w; f[4] = b.x; f[5] = b.y; f[6] = b.z; f[7] = b.w;
}
__device__ __forceinline__ void store8f(float* p, const float (&f)[8]) {
    float4 a, b; a.x = f[0]; a.y = f[1]; a.z = f[2]; a.w = f[3]; b.x = f[4]; b.y = f[5]; b.z = f[6]; b.w = f[7];
    *(float4*)p = a; *(float4*)(p + 4) = b;
}
__device__ __forceinline__ void conv8(const bf16_t* zp, const float* conv, int c0, bool act, bool first, bool last, float (&out)[8]) {
    const u32x4 z4 = {0u, 0u, 0u, 0u};
    const u32x4 a0 = act ? *(const u32x4*)(zp + c0) : z4;
    const u32x4 am = (act && !first) ? *(const u32x4*)(zp + c0 - ZLD) : z4;
    const u32x4 an = (act && !last) ? *(const u32x4*)(zp + c0 + ZLD) : z4;
    float w0[8], w1[8], w2[8], f0[8], fm[8], fn[8];
    if (act) { load8f(conv + c0, w0); load8f(conv + RWKV_IN + c0, w1); load8f(conv + 2 * RWKV_IN + c0, w2); }
    else {
#pragma unroll
        for (int e = 0; e < 8; ++e) { w0[e] = 0.f; w1[e] = 0.f; w2[e] = 0.f; }
    }
    unpack8(a0, f0); unpack8(am, fm); unpack8(an, fn);
#pragma unroll
    for (int e = 0; e < 8; ++e) out[e] = w1[e] * f0[e] + w0[e] * fm[e] + w2[e] * fn[e];
}
__device__ __forceinline__ void phase_rwkv_prep1(const P& p, int l) {
    const int lane = otid() & 63;
    const int gw = (obid() * NTHREADS + otid()) >> 6, nw = (gridDim.x * NTHREADS) >> 6;
    const float* conv = p.in[I_RCONV] + (size_t)l * 3 * RWKV_IN;
    const float* k_k = p.in[I_RKK] + (size_t)l * RW;
    const bool act = lane * 8 < RW, act2 = lane * 8 < 384;
    float kkw[8];
    if (act) load8f(k_k + lane * 8, kkw);
    else {
#pragma unroll
        for (int e = 0; e < 8; ++e) kkw[e] = 0.f;
    }
    for (int t = gw; t < MTOT; t += nw) {
        const bool first = (t == 0) || (t == CTX), last = (t == CTX - 1) || (t == MTOT - 1);
        const bf16_t* zp = p.Z + (size_t)t * ZLD + ZR;
        float rv[8], kv[8], vv[8], lr[8];
        conv8(zp, conv, 0 * RW + lane * 8, act, first, last, rv);
        conv8(zp, conv, 1 * RW + lane * 8, act, first, last, kv);
        conv8(zp, conv, 2 * RW + lane * 8, act, first, last, vv);
        conv8(zp, conv, 3 * RW + lane * 8, act2, first, last, lr);
        float kk[8]; float ss = 0.f;
#pragma unroll
        for (int e = 0; e < 8; ++e) { kk[e] = kv[e] * kkw[e]; ss += kk[e] * kk[e]; }
        ss += __shfl_xor(ss, 1, 64); ss += __shfl_xor(ss, 2, 64); ss += __shfl_xor(ss, 4, 64);
        const float inv = 1.0f / fmaxf(sqrtf(ss), 1e-12f);
#pragma unroll
        for (int e = 0; e < 8; ++e) kk[e] *= inv;
        if (act) {
            const size_t o = (size_t)t * RW + lane * 8;
            *(u32x4*)(p.R + o) = pack8(rv); *(u32x4*)(p.KS + o) = pack8(kv); *(u32x4*)(p.V + o) = pack8(vv); *(u32x4*)(p.KK + o) = pack8(kk);
        }
        if (act2) {
            const int cc = lane * 8;
            if (cc < 128) {
#pragma unroll
                for (int e = 0; e < 8; ++e) lr[e] = tanhf_(lr[e]);
                *(u32x4*)(p.LR + (size_t)t * 256 + cc) = pack8(lr);
            } else if (cc < 256) {
                *(u32x4*)(p.LR + (size_t)t * 256 + cc) = pack8(lr);
            } else {
#pragma unroll
                for (int e = 0; e < 8; ++e) lr[e] = sigmoidf_(lr[e]);
                *(u32x4*)(p.GS + (size_t)t * 128 + cc - 256) = pack8(lr);
            }
        }
    }
}
__device__ __forceinline__ void phase_rwkv_prep2(const P& p, int l, char* smem) {
    const int ntm = MTOT / 128, ntn = NPAD(RW) / 128;
    const float* k_a = p.in[I_RKA] + (size_t)l * RW;
    const float* r_k = p.in[I_RRK] + (size_t)l * RW;
    for (int job = obid(); job < ntm * ntn * 2; job += gridDim.x) {
        const int d = job % 2, n0 = ((job / 2) % ntn) * 128, m0 = (job / (2 * ntn)) * 128;
        const float* w0 = p.in[I_RW0] + (size_t)(l * 2 + d) * RW;
        const float* a0 = p.in[I_RA0] + (size_t)(l * 2 + d) * RW;
        f32x4 accw[4][4], acca[4][4]; ZERO_ACC4(accw); ZERO_ACC4(acca);
        mfma_gemm_tile(p.WT_W2 + (size_t)d * NPAD(RW) * 64, 64, p.LR + d * 64, 256, 64, n0, m0, (bf16_t*)smem, accw);
        mfma_gemm_tile(p.WT_A2 + (size_t)d * NPAD(RW) * 64, 64, p.LR + 128 + d * 64, 256, 64, n0, m0, (bf16_t*)smem, acca);
        const int lane = otid() & 63, wave = otid() >> 6;
#pragma unroll
        for (int mi = 0; mi < 4; ++mi) {
            const int m = m0 + (wave & 1) * 64 + mi * 16 + (lane & 15);
            float bon = 0.f;
#pragma unroll
            for (int ni = 0; ni < 4; ++ni) {
                const int n = n0 + (wave >> 1) * 64 + ni * 16 + (lane >> 4) * 4;
                if (n < RW) {
                    const u32x2 kq = *(const u32x2*)(p.KS + (size_t)m * RW + n), kkq = *(const u32x2*)(p.KK + (size_t)m * RW + n), rq = *(const u32x2*)(p.R + (size_t)m * RW + n);
                    const float kv[4] = {LO16(kq.x), HI16(kq.x), LO16(kq.y), HI16(kq.y)};
                    const float kkv[4] = {LO16(kkq.x), HI16(kkq.x), LO16(kkq.y), HI16(kkq.y)};
                    const float rv[4] = {LO16(rq.x), HI16(rq.x), LO16(rq.y), HI16(rq.y)};
                    float lw[4], kd[4], bb[4];
#pragma unroll
                    for (int e = 0; e < 4; ++e) {
                        const float x = w0[n + e] + accw[ni][mi][e];
                        lw[e] = -fexp_(-softplusf_(-x) - 0.5f);
                        const float aa = sigmoidf_(a0[n + e] + acca[ni][mi][e]);
                        kd[e] = kv[e] * (1.0f + (aa - 1.0f) * k_a[n + e]);
                        bb[e] = kkv[e] * aa;
                        bon += rv[e] * kd[e] * r_k[n + e];
                    }
                    const size_t o = ((size_t)d * MTOT + m) * RW + n;
                    float4 lo4; lo4.x = lw[0]; lo4.y = lw[1]; lo4.z = lw[2]; lo4.w = lw[3];
                    *(float4*)(p.LW + o) = lo4;
                    *(u32x2*)(p.KD + o) = pack4(kd[0], kd[1], kd[2], kd[3]);
                    *(u32x2*)(p.BB + o) = pack4(bb[0], bb[1], bb[2], bb[3]);
                }
            }
            bon += __shfl_xor(bon, 16, 64); bon += __shfl_xor(bon, 32, 64);
            const int hh = (n0 + (wave >> 1) * 64) >> 6;
            if ((lane >> 4) == 0 && hh < RH) p.BONUS[((size_t)d * MTOT + m) * RH + hh] = bon;
        }
    }
}

#define CH_ROW 72
#define SEQ_REC 16640
#define CH_SLOT (64 * CH_ROW)
#define CH_XR_OFF (7 * CH_SLOT * 2)
#define CH_AAB_OFF (CH_XR_OFF + 64 * 132 * 4)
#define CH_GC_OFF (CH_AAB_OFF + 64 * 72 * 4)
template <int MT, int NT>
__device__ __forceinline__ void lds_mm(const bf16_t* A, int m0, const bf16_t* Bt, int n0, f32x4 (&acc)[MT][NT]) {
    const int lane = otid() & 63, q = lane >> 4, r = lane & 15;
#pragma unroll
    for (int s = 0; s < 2; ++s) {
        bf16x8 a[MT], b[NT];
#pragma unroll
        for (int i = 0; i < MT; ++i) a[i] = *(const bf16x8*)(A + (m0 + i * 16 + r) * CH_ROW + s * 32 + q * 8);
#pragma unroll
        for (int i = 0; i < NT; ++i) b[i] = *(const bf16x8*)(Bt + (n0 + i * 16 + r) * CH_ROW + s * 32 + q * 8);
#pragma unroll
        for (int i = 0; i < MT; ++i)
#pragma unroll
            for (int jj = 0; jj < NT; ++jj) acc[i][jj] = MFMA16(a[i], b[jj], acc[i][jj]);
    }
}
__device__ __forceinline__ void rwkv_chunk_job(const P& p, int job, char* smem) {
    const int tid = otid(), lane = tid & 63, wv = tid >> 6, q = lane >> 4, r = lane & 15;
    const int d = job / (NC * RH), n = (job / RH) % NC, h = job % RH;
    const size_t base = (size_t)(d * NC + n) * RH + h;
    bf16_t* S0 = (bf16_t*)smem; bf16_t* S1 = S0 + CH_SLOT; bf16_t* S2 = S1 + CH_SLOT; bf16_t* S3 = S2 + CH_SLOT;
    bf16_t* S4 = S3 + CH_SLOT; bf16_t* S5 = S4 + CH_SLOT; bf16_t* S6 = S5 + CH_SLOT;
    float* X = (float*)(smem + CH_XR_OFF);
    float* AABt = (float*)(smem + CH_AAB_OFF);
    bf16_t* U0t = (bf16_t*)(smem + CH_AAB_OFF);
    bf16_t* Aht = U0t + CH_SLOT;
    float* GC = (float*)(smem + CH_GC_OFF);
    __syncthreads();
    u32x4 gkk[2], gr[2], gv[2], gkd[2], gbb[2]; float lw[2][8];
#pragma unroll
    for (int it = 0; it < 2; ++it) {
        const int c = tid + 256 * it, i = c >> 3, k0 = (c & 7) * 8; const int tok = 64 * n + (d ? 63 - i : i);
        const size_t o1 = (size_t)tok * RW + h * 64 + k0, o2 = ((size_t)d * MTOT + tok) * RW + h * 64 + k0;
        load8f(p.LW + o2, lw[it]);
        gkk[it] = *(const u32x4*)(p.KK + o1); gr[it] = *(const u32x4*)(p.R + o1); gv[it] = *(const u32x4*)(p.V + o1);
        gkd[it] = *(const u32x4*)(p.KD + o2); gbb[it] = *(const u32x4*)(p.BB + o2);
    }
#pragma unroll
    for (int it = 0; it < 2; ++it) { const int c = tid + 256 * it; store8f(X + (c >> 3) * 132 + (c & 7) * 8, lw[it]); }
    __syncthreads();
    {
        const int k = tid & 63, seg = tid >> 6;
        float v[16]; float run = 0.f;
#pragma unroll
        for (int e = 0; e < 16; ++e) { run += X[(seg * 16 + e) * 132 + k]; v[e] = run; }
        AABt[seg * 64 + k] = run;
        __syncthreads();
        float off = 0.f;
        for (int s2 = 0; s2 < seg; ++s2) off += AABt[s2 * 64 + k];
#pragma unroll
        for (int e = 0; e < 16; ++e) X[(seg * 16 + e) * 132 + k] = v[e] + off;
    }
    __syncthreads();
#pragma unroll
    for (int it = 0; it < 2; ++it) {
        const int c = tid + 256 * it, i = c >> 3, k0 = (c & 7) * 8;
        float L[8], Lp[8], LC[8], kkv[8], rv[8], vv[8], kdv[8], bbv[8];
        load8f(X + i * 132 + k0, L); load8f(X + 63 * 132 + k0, LC);
        if (i > 0) load8f(X + (i - 1) * 132 + k0, Lp);
        else {
#pragma unroll
            for (int e = 0; e < 8; ++e) Lp[e] = 0.f;
        }
        unpack8(gkk[it], kkv); unpack8(gr[it], rv); unpack8(gv[it], vv); unpack8(gkd[it], kdv); unpack8(gbb[it], bbv);
        float at[8], rt[8], bt[8], kt[8], bh[8], kh[8];
#pragma unroll
        for (int e = 0; e < 8; ++e) {
            const float eL = fexp_(L[e]), eLp = fexp_(Lp[e]), eNL = fexp_(-L[e]), eCL = fexp_(LC[e] - L[e]);
            at[e] = -kkv[e] * eLp; rt[e] = rv[e] * eL; bt[e] = bbv[e] * eNL; kt[e] = kdv[e] * eNL; bh[e] = bbv[e] * eCL; kh[e] = kdv[e] * eCL;
            if (i == 63) GC[k0 + e] = eL;
        }
        *(u32x4*)(S0 + i * CH_ROW + k0) = pack8(at);
        store8f(X + i * 132 + 64 + k0, at);
        *(u32x4*)(S1 + i * CH_ROW + k0) = pack8(rt);
        *(u32x4*)(S2 + i * CH_ROW + k0) = pack8(bt);
        *(u32x4*)(S3 + i * CH_ROW + k0) = pack8(kt);
#pragma unroll
        for (int e = 0; e < 8; ++e) {
            S4[(k0 + e) * CH_ROW + i] = f2bf(vv[e]);
            S5[(k0 + e) * CH_ROW + i] = f2bf(bh[e]);
            S6[(k0 + e) * CH_ROW + i] = f2bf(kh[e]);
        }
    }
    __syncthreads();
    {
        f32x4 acc[4][4]; ZERO_ACC4(acc);
        lds_mm<4, 4>((wv < 2) ? S0 : S1, 0, (wv & 1) ? S3 : S2, 0, acc);
        __syncthreads();
#pragma unroll
        for (int mt = 0; mt < 4; ++mt)
#pragma unroll
            for (int nt = 0; nt < 4; ++nt) {
                const int jc = nt * 16 + r, i0 = mt * 16 + 4 * q;
                if (wv == 0) {
                    f32x4 o;
#pragma unroll
                    for (int e = 0; e < 4; ++e) o[e] = (jc < i0 + e) ? acc[mt][nt][e] : 0.f;
                    *(f32x4*)(AABt + jc * 72 + i0) = o;
                } else {
                    bf16_t* dst = (wv == 1) ? S0 : ((wv == 2) ? S2 : S3);
#pragma unroll
                    for (int e = 0; e < 4; ++e) {
                        const bool ok = (wv == 1) ? (jc < i0 + e) : (jc <= i0 + e);
                        dst[(i0 + e) * CH_ROW + jc] = f2bf(ok ? acc[mt][nt][e] : 0.f);
                    }
                }
            }
    }
    __syncthreads();
    {
        f32x4 acc[1][4];
#pragma unroll
        for (int nt = 0; nt < 4; ++nt) acc[0][nt] = (f32x4){0.f, 0.f, 0.f, 0.f};
        lds_mm<1, 4>(S0, 16 * wv, S4, 0, acc);
#pragma unroll
        for (int nt = 0; nt < 4; ++nt)
#pragma unroll
            for (int e = 0; e < 4; ++e) X[(16 * wv + 4 * q + e) * 132 + nt * 16 + r] = acc[0][nt][e];
    }
    __syncthreads();
    if (tid < 128) {
        const int c = tid;
        for (int bi = 0; bi < 4; ++bi) {
            float acc[16];
#pragma unroll
            for (int e = 0; e < 16; ++e) acc[e] = X[(16 * bi + e) * 132 + c];
            for (int jj = 0; jj < 16 * bi; ++jj) {
                const float uj = X[jj * 132 + c];
                const f32x4* ap = (const f32x4*)(AABt + jj * 72 + 16 * bi);
                const f32x4 a0 = ap[0], a1 = ap[1], a2 = ap[2], a3 = ap[3];
#pragma unroll
                for (int e = 0; e < 4; ++e) { acc[e] += a0[e] * uj; acc[4 + e] += a1[e] * uj; acc[8 + e] += a2[e] * uj; acc[12 + e] += a3[e] * uj; }
            }
#pragma unroll
            for (int e = 0; e < 16; ++e) {
                const float u = acc[e];
                X[(16 * bi + e) * 132 + c] = u;
                const f32x4* ap = (const f32x4*)(AABt + (16 * bi + e) * 72 + 16 * bi);
                const f32x4 a0 = ap[0], a1 = ap[1], a2 = ap[2], a3 = ap[3];
#pragma unroll
                for (int e2 = 0; e2 < 16; ++e2) if (e2 > e) acc[e2] += ((e2 < 4) ? a0[e2 & 3] : (e2 < 8) ? a1[e2 & 3] : (e2 < 12) ? a2[e2 & 3] : a3[e2 & 3]) * u;
            }
        }
    }
    __syncthreads();
    if (tid < 128) {
        const int c = tid;
        bf16_t* dst = (c < 64) ? (U0t + c * CH_ROW) : (Aht + (c - 64) * CH_ROW);
        u32x4 ov[8];
#pragma unroll
        for (int g = 0; g < 8; ++g) {
            float v[8];
#pragma unroll
            for (int e = 0; e < 8; ++e) v[e] = X[(g * 8 + e) * 132 + c];
            ov[g].x = pack2bf(v[0], v[1]); ov[g].y = pack2bf(v[2], v[3]);
            ov[g].z = pack2bf(v[4], v[5]); ov[g].w = pack2bf(v[6], v[7]);
        }
#pragma unroll
        for (int g = 0; g < 8; ++g) *(u32x4*)(dst + g * 8) = ov[g];
    }
    __syncthreads();
    {
        f32x4 acc[4][4]; ZERO_ACC4(acc);
        char* rec = p.REC + base * SEQ_REC;
        if (wv == 0) {
            lds_mm<4, 4>(Aht, 0, S5, 0, acc);
#pragma unroll
            for (int nt = 0; nt < 4; ++nt)
#pragma unroll
                for (int s2 = 0; s2 < 2; ++s2) {
                    u32x4 o;
                    o.x = pack2bf(acc[2 * s2][nt][0], acc[2 * s2][nt][1]); o.y = pack2bf(acc[2 * s2][nt][2], acc[2 * s2][nt][3]);
                    o.z = pack2bf(acc[2 * s2 + 1][nt][0], acc[2 * s2 + 1][nt][1]); o.w = pack2bf(acc[2 * s2 + 1][nt][2], acc[2 * s2 + 1][nt][3]);
                    *(u32x4*)(rec + (((nt * 2 + s2) * 64 + lane) * 8) * 2) = o;
                }
        } else if (wv == 1) {
            lds_mm<4, 4>(S5, 0, U0t, 0, acc);
            lds_mm<4, 4>(S6, 0, S4, 0, acc);
#pragma unroll
            for (int mt = 0; mt < 4; ++mt)
#pragma unroll
                for (int nt = 0; nt < 4; ++nt) *(u32x2*)(rec + 8192 + (((nt * 4 + mt) * 64 + lane) * 4) * 2) = pack4(acc[mt][nt][0], acc[mt][nt][1], acc[mt][nt][2], acc[mt][nt][3]);
        } else if (wv == 2) {
            lds_mm<4, 4>(S2, 0, Aht, 0, acc);
#pragma unroll
            for (int mt = 0; mt < 4; ++mt)
#pragma unroll
                for (int nt = 0; nt < 4; ++nt)
#pragma unroll
                    for (int e = 0; e < 4; ++e) {
                        const int t = mt * 16 + 4 * q + e, kc = nt * 16 + r;
                        p.QH[(base * 64 + t) * 64 + kc] = f2bf(acc[mt][nt][e] + bf2f(S1[t * CH_ROW + kc]));
                    }
        } else if (wv == 3) {
            lds_mm<4, 4>(S2, 0, U0t, 0, acc);
            lds_mm<4, 4>(S3, 0, S4, 0, acc);
#pragma unroll
            for (int mt = 0; mt < 4; ++mt)
#pragma unroll
                for (int nt = 0; nt < 4; ++nt) *(f32x4*)(p.Y0T + (((base * 4 + mt) * 4 + nt) * 64 + lane) * 4) = acc[mt][nt];
        }
        if (tid < 64) ((float*)(rec + 16384))[tid] = GC[tid];
    }
}

#define SEQ_SLOT 16896
__device__ __forceinline__ void rwkv_seq_gload(const P& p, size_t base, int tid, u32x4 (&g)[5]) {
    const u32x4* m = (const u32x4*)(p.REC + base * SEQ_REC);
#pragma unroll
    for (int i = 0; i < 4; ++i) g[i] = m[tid + 256 * i];
    if (tid < 16) g[4] = m[1024 + tid];
}
__device__ __forceinline__ void rwkv_seq_lstore(char* slot, int tid, const u32x4 (&g)[5]) {
    u32x4* d = (u32x4*)slot;
#pragma unroll
    for (int i = 0; i < 4; ++i) d[tid + 256 * i] = g[i];
    if (tid < 16) d[1024 + tid] = g[4];
}
__device__ __forceinline__ void rwkv_seq_step(const P& p, const char* slot, size_t base, int wv, int lane, f32x4 (&X)[4]) {
    const int q = lane >> 4, r = lane & 15;
    const bf16_t* mt = (const bf16_t*)slot; const bf16_t* ntb = (const bf16_t*)(slot + 8192); const float* gc = (const float*)(slot + 16384);
    unsigned xh[4][2];
#pragma unroll
    for (int kt = 0; kt < 4; ++kt) {
        xh[kt][0] = pack2bf(X[kt][0], X[kt][1]); xh[kt][1] = pack2bf(X[kt][2], X[kt][3]);
        *(u32x2*)(p.SN + (base * 64 + 16 * wv + r) * 64 + 16 * kt + 4 * q) = (u32x2){xh[kt][0], xh[kt][1]};
    }
    bf16x8 bh[2];
#pragma unroll
    for (int s2 = 0; s2 < 2; ++s2) bh[s2] = __builtin_bit_cast(bf16x8, ((u32x4){xh[2 * s2][0], xh[2 * s2][1], xh[2 * s2 + 1][0], xh[2 * s2 + 1][1]}));
#pragma unroll
    for (int tile = 0; tile < 4; ++tile) {
        const u32x2 nb = *(const u32x2*)(ntb + ((wv * 4 + tile) * 64 + lane) * 4);
        const f32x4 g4 = *(const f32x4*)(gc + tile * 16 + 4 * q);
        f32x4 acc;
        acc[0] = g4[0] * X[tile][0] + LO16(nb.x); acc[1] = g4[1] * X[tile][1] + HI16(nb.x);
        acc[2] = g4[2] * X[tile][2] + LO16(nb.y); acc[3] = g4[3] * X[tile][3] + HI16(nb.y);
#pragma unroll
        for (int s2 = 0; s2 < 2; ++s2) {
            const bf16x8 ah = *(const bf16x8*)(mt + ((tile * 2 + s2) * 64 + lane) * 8);
            acc = MFMA16(ah, bh[s2], acc);
        }
        X[tile] = acc;
    }
}
__device__ __forceinline__ void rwkv_seq_job(const P& p, int job, char* smem) {
    const int tid = otid(), lane = tid & 63, wv = tid >> 6;
    const int d = job / RH, h = job % RH;
    f32x4 X[4];
#pragma unroll
    for (int kt = 0; kt < 4; ++kt) X[kt] = (f32x4){0.f, 0.f, 0.f, 0.f};
    u32x4 g0[5], g1[5], g2[5];
#define SEQ_BASE(s_) ((size_t)(d * NC + chunk_order(d, ((s_) < NC) ? (s_) : NC - 1)) * RH + h)
    __syncthreads();
    rwkv_seq_gload(p, SEQ_BASE(0), tid, g0);
    rwkv_seq_gload(p, SEQ_BASE(1), tid, g1);
    rwkv_seq_gload(p, SEQ_BASE(2), tid, g2);
    rwkv_seq_lstore(smem, tid, g0);
    __syncthreads();
    for (int s = 0; s < NC; s += 6) {
#define SEQ_SUB(u, GFREE, GNEXT) \
        if (s + (u) < NC) { \
            rwkv_seq_gload(p, SEQ_BASE(s + (u) + 3), tid, GFREE); \
            rwkv_seq_step(p, smem + (((u) & 1) ? SEQ_SLOT : 0), SEQ_BASE(s + (u)), wv, lane, X); \
            rwkv_seq_lstore(smem + (((u) & 1) ? 0 : SEQ_SLOT), tid, GNEXT); \
        } \
        __syncthreads();
        SEQ_SUB(0, g0, g1)
        SEQ_SUB(1, g1, g2)
        SEQ_SUB(2, g2, g0)
        SEQ_SUB(3, g0, g1)
        SEQ_SUB(4, g1, g2)
        SEQ_SUB(5, g2, g0)
#undef SEQ_SUB
    }
#undef SEQ_BASE
}
struct RoBuf { bf16x8 a[2]; bf16x8 b[4][2]; f32x4 y0[4]; };
__device__ __forceinline__ void rwkv_out_load(const P& p, int job, int wv, int lane, RoBuf& o) {
    const int q = lane >> 4, r = lane & 15;
    const size_t base = (size_t)job;
#pragma unroll
    for (int s2 = 0; s2 < 2; ++s2) {
        o.a[s2] = *(const bf16x8*)(p.QH + (base * 64 + 16 * wv + r) * 64 + s2 * 32 + q * 8);
#pragma unroll
        for (int nt = 0; nt < 4; ++nt) o.b[nt][s2] = *(const bf16x8*)(p.SN + (base * 64 + nt * 16 + r) * 64 + s2 * 32 + q * 8);
    }
#pragma unroll
    for (int nt = 0; nt < 4; ++nt) o.y0[nt] = *(const f32x4*)(p.Y0T + (((base * 4 + wv) * 4 + nt) * 64 + lane) * 4);
}
__device__ __forceinline__ void rwkv_out_compute(const P& p, int job, int wv, int lane, const RoBuf& o) {
    const int q = lane >> 4, r = lane & 15;
    const int d = job / (NC * RH), n = (job / RH) % NC, h = job % RH;
#pragma unroll
    for (int nt = 0; nt < 4; ++nt) {
        f32x4 acc = o.y0[nt];
        acc = MFMA16(o.a[0], o.b[nt][0], acc);
        acc = MFMA16(o.a[1], o.b[nt][1], acc);
#pragma unroll
        for (int e = 0; e < 4; ++e) {
            const int t = 16 * wv + 4 * q + e; const int tok = 64 * n + (d ? 63 - t : t);
            p.Y[((size_t)d * MTOT + tok) * RW + h * 64 + nt * 16 + r] = acc[e];
        }
    }
}
__device__ __forceinline__ void phase_rwkv_out(const P& p) {
    const int tid = otid(), lane = tid & 63, wv = tid >> 6;
    if (wv >= 4) return;
    const int G = gridDim.x, total = 2 * NC * RH;
    int job = obid();
    if (job >= total) return;
    RoBuf b0, b1;
    rwkv_out_load(p, job, wv, lane, b0);
    for (; job < total; job += 2 * G) {
        if (job + G < total) rwkv_out_load(p, job + G, wv, lane, b1);
        rwkv_out_compute(p, job, wv, lane, b0);
        if (job + G < total) {
            if (job + 2 * G < total) rwkv_out_load(p, job + 2 * G, wv, lane, b0);
            rwkv_out_compute(p, job + G, wv, lane, b1);
        }
    }
}

#define GL_QR 0
#define GL_KR 9216
#define GL_VT 18432
#define GL_QI 36864
#define GL_KI 46080
#define GL_AT 55296
#define GL_CUM 64512
#define GL_ALR 81920
#define GL_WA 86016
__device__ __forceinline__ void gla_load_qkv(const P& p, int n, int h, char* smem) {
    const int tid = otid();
    bf16_t* Qr = (bf16_t*)(smem + GL_QR); bf16_t* Kr = (bf16_t*)(smem + GL_KR); bf16_t* Vt = (bf16_t*)(smem + GL_VT);
    for (int c = tid; c < 512; c += NTHREADS) {
        const int row = c >> 3, part = c & 7; const int t = gla_tok(n, row);
        const u32x4 qv = *(const u32x4*)(p.Z + (size_t)t * ZLD + ZQ + h * 64 + part * 8);
        const u32x4 kv = *(const u32x4*)(p.Z + (size_t)t * ZLD + ZK + h * 64 + part * 8);
        u32x4 qs;
        qs.x = pack2bf(LO16(qv.x) * 0.125f, HI16(qv.x) * 0.125f);
        qs.y = pack2bf(LO16(qv.y) * 0.125f, HI16(qv.y) * 0.125f);
        qs.z = pack2bf(LO16(qv.z) * 0.125f, HI16(qv.z) * 0.125f);
        qs.w = pack2bf(LO16(qv.w) * 0.125f, HI16(qv.w) * 0.125f);
        *(u32x4*)(Qr + row * CH_ROW + part * 8) = qs;
        *(u32x4*)(Kr + row * CH_ROW + part * 8) = kv;
    }
    for (int c = tid; c < 1024; c += NTHREADS) {
        const int row = c >> 4, part = c & 15; const int t = gla_tok(n, row);
        const u32x4 vv = *(const u32x4*)(p.Z + (size_t)t * ZLD + ZV + h * 128 + part * 8);
        bf16_t* dst = Vt + (part * 8) * CH_ROW + row;
        dst[0 * CH_ROW] = (bf16_t)(vv.x & 0xFFFF); dst[1 * CH_ROW] = (bf16_t)(vv.x >> 16);
        dst[2 * CH_ROW] = (bf16_t)(vv.y & 0xFFFF); dst[3 * CH_ROW] = (bf16_t)(vv.y >> 16);
        dst[4 * CH_ROW] = (bf16_t)(vv.z & 0xFFFF); dst[5 * CH_ROW] = (bf16_t)(vv.z >> 16);
        dst[6 * CH_ROW] = (bf16_t)(vv.w & 0xFFFF); dst[7 * CH_ROW] = (bf16_t)(vv.w >> 16);
    }
}
__device__ __forceinline__ void gla_cum(const P& p, int l, int n, int h, int d, char* smem) {
    const int tid = otid();
    float* CUM = (float*)(smem + GL_CUM); float* ALR = (float*)(smem + GL_ALR); float* WA = (float*)(smem + GL_WA);
    for (int c = tid; c < 256; c += NTHREADS) {
        const int row = c >> 2, part = c & 3; const int t = gla_tok(n, row);
        const u32x2 a = *(const u32x2*)(p.Z + (size_t)t * ZLD + (d ? ZAB : ZAF) + part * 4);
        float* dst = ALR + row * 16 + part * 4;
        dst[0] = LO16(a.x); dst[1] = HI16(a.x); dst[2] = LO16(a.y); dst[3] = HI16(a.y);
    }
    for (int c = tid; c < 16 * 64 + 64; c += NTHREADS) {
        if (c < 1024) WA[c] = p.in[I_GLA_WA2][((size_t)(l * 2 + d) * 16 + (c >> 6)) * GLA_K + h * 64 + (c & 63)];
        else WA[c] = p.in[I_GLA_BA][(size_t)(l * 2 + d) * GLA_K + h * 64 + (c - 1024)];
    }
    __syncthreads();
    for (int idx = tid; idx < 4096; idx += NTHREADS) {
        const int i = idx >> 6, k = idx & 63;
        float a = WA[1024 + k];
#pragma unroll
        for (int r = 0; r < 16; ++r) a += ALR[i * 16 + r] * WA[r * 64 + k];
        CUM[i * 68 + k] = (fminf(a, 0.f) - flog_(1.0f + fexp_(-fabsf(a)))) * (1.0f / 16.0f);
    }
    __syncthreads();
    {
        const int k = tid & 63, seg = (tid >> 6) & 3;
        float v[16]; float run = 0.f;
        if (tid < 256) {
#pragma unroll
            for (int e = 0; e < 16; ++e) { const int pos = seg * 16 + e; const int i = d ? 63 - pos : pos; run += CUM[i * 68 + k]; v[e] = run; }
            ALR[seg * 64 + k] = run;
        }
        __syncthreads();
        if (tid < 256) {
            float off = 0.f;
            for (int s2 = 0; s2 < seg; ++s2) off += ALR[s2 * 64 + k];
#pragma unroll
            for (int e = 0; e < 16; ++e) { const int pos = seg * 16 + e; const int i = d ? 63 - pos : pos; CUM[i * 68 + k] = v[e] + off; }
        }
    }
    __syncthreads();
}
__device__ __forceinline__ void phase_gla_kv(const P& p, int l, char* smem) {
    const int tid = otid(), lane = tid & 63, wv = tid >> 6, q = lane >> 4, r = lane & 15;
    bf16_t* Kr = (bf16_t*)(smem + GL_KR); bf16_t* Vt = (bf16_t*)(smem + GL_VT); bf16_t* KdT = (bf16_t*)(smem + GL_KI);
    float* CUM = (float*)(smem + GL_CUM);
    for (int job = obid(); job < NC * GH; job += gridDim.x) {
        const int n = job / GH, h = job % GH;
        __syncthreads();
        gla_load_qkv(p, n, h, smem);
        for (int d = 0; d < 2; ++d) {
            gla_cum(p, l, n, h, d, smem);
            const int li = d ? 0 : 63;
            for (int idx = tid; idx < 4096; idx += NTHREADS) {
                const int i = idx >> 6, k = idx & 63;
                KdT[k * CH_ROW + i] = f2bf(bf2f(Kr[i * CH_ROW + k]) * fexp_(CUM[li * 68 + k] - CUM[i * 68 + k]));
            }
            if (tid < 64) p.DEC[((size_t)(d * NC + n) * GH + h) * 64 + tid] = fexp_(CUM[li * 68 + tid]);
            __syncthreads();
            float* kvt = p.KV + ((size_t)(d * NC + n) * GH + h) * 8192;
            for (int mt = wv; mt < 4; mt += NTHREADS / 64) {
                f32x4 acc[1][8];
#pragma unroll
                for (int nt = 0; nt < 8; ++nt) acc[0][nt] = (f32x4){0.f, 0.f, 0.f, 0.f};
                lds_mm<1, 8>(KdT, 16 * mt, Vt, 0, acc);
#pragma unroll
                for (int nt = 0; nt < 8; ++nt) *(f32x4*)(kvt + (size_t)(nt * 16 + r) * 64 + 16 * mt + 4 * q) = acc[0][nt];
            }
            __syncthreads();
        }
    }
    __syncthreads();
}
__device__ __forceinline__ void gla_scan_job(const P& p, int job) {
    const int base = job * NTHREADS + otid();
    const int d = base / (GH * 8192), h = (base / 8192) % GH, e = base % 8192;
    const float* __restrict__ kvp = p.KV; const float* __restrict__ decp = p.DEC; bf16_t* __restrict__ sp = p.SP;
    float S = 0.f;
    for (int s = 0; s < NC; s += 4) {
        float kv[4], dc[4]; size_t oo[4];
#pragma unroll
        for (int u = 0; u < 4; ++u) {
            const int n = chunk_order(d, (s + u < NC) ? s + u : NC - 1);
            oo[u] = ((size_t)(d * NC + n) * GH + h);
            kv[u] = kvp[oo[u] * 8192 + e]; dc[u] = decp[oo[u] * 64 + (e & 63)];
        }
#pragma unroll
        for (int u = 0; u < 4; ++u) if (s + u < NC) { sp[oo[u] * 8192 + e] = f2bf(S); S = dc[u] * S + kv[u]; }
    }
}
__device__ __forceinline__ void phase_gla_out(const P& p, int l, char* smem) {
    const int tid = otid(), lane = tid & 63, wv = tid >> 6, q = lane >> 4, r = lane & 15;
    bf16_t* Qr = (bf16_t*)(smem + GL_QR); bf16_t* Kr = (bf16_t*)(smem + GL_KR); bf16_t* Vt = (bf16_t*)(smem + GL_VT);
    bf16_t* Qi = (bf16_t*)(smem + GL_QI); bf16_t* Ki = (bf16_t*)(smem + GL_KI); bf16_t* At = (bf16_t*)(smem + GL_AT);
    float* CUM = (float*)(smem + GL_CUM);
    for (int job = obid(); job < NC * GH; job += gridDim.x) {
        const int n = job / GH, h = job % GH;
        __syncthreads();
        gla_load_qkv(p, n, h, smem);
        f32x4 o[1][8];
#pragma unroll
        for (int nt = 0; nt < 8; ++nt) o[0][nt] = (f32x4){0.f, 0.f, 0.f, 0.f};
        for (int d = 0; d < 2; ++d) {
            gla_cum(p, l, n, h, d, smem);
            for (int idx = tid; idx < 4096; idx += NTHREADS) {
                const int i = idx >> 6, k = idx & 63; const float c = CUM[i * 68 + k];
                Qi[i * CH_ROW + k] = f2bf(bf2f(Qr[i * CH_ROW + k]) * fexp_(c));
                Ki[i * CH_ROW + k] = f2bf(bf2f(Kr[i * CH_ROW + k]) * fexp_(-c));
            }
            __syncthreads();
            if (wv < 4) {
                f32x4 a[1][4];
#pragma unroll
                for (int nt = 0; nt < 4; ++nt) a[0][nt] = (f32x4){0.f, 0.f, 0.f, 0.f};
                lds_mm<1, 4>(Qi, 16 * wv, Ki, 0, a);
#pragma unroll
                for (int nt = 0; nt < 4; ++nt)
#pragma unroll
                    for (int e = 0; e < 4; ++e) {
                        const int i = 16 * wv + 4 * q + e, j = nt * 16 + r;
                        const bool ok = d ? (j >= i) : (j <= i);
                        At[i * CH_ROW + j] = f2bf(ok ? a[0][nt][e] : 0.f);
                    }
                WAVE_SYNC();
                lds_mm<1, 8>(At, 16 * wv, Vt, 0, o);
                const bf16_t* sp = p.SP + ((size_t)(d * NC + n) * GH + h) * 8192;
#pragma unroll
                for (int s2 = 0; s2 < 2; ++s2) {
                    const bf16x8 af = *(const bf16x8*)(Qi + (16 * wv + r) * CH_ROW + s2 * 32 + q * 8);
#pragma unroll
                    for (int nt = 0; nt < 8; ++nt) {
                        const bf16x8 bfr = *(const bf16x8*)(sp + (size_t)(nt * 16 + r) * 64 + s2 * 32 + q * 8);
                        o[0][nt] = MFMA16(af, bfr, o[0][nt]);
                    }
                }
            }
            __syncthreads();
        }
        if (wv < 4) {
#pragma unroll
            for (int nt = 0; nt < 8; ++nt)
#pragma unroll
                for (int e = 0; e < 4; ++e) {
                    const int t = gla_tok(n, 16 * wv + 4 * q + e);
                    p.OGLA[(size_t)t * GLA_V + h * 128 + nt * 16 + r] = o[0][nt][e];
                }
        }
    }
    __syncthreads();
}

#define S5_XH_OFF (2 * 64 * 132 * 4)
#define S5_XL_OFF (S5_XH_OFF + 64 * 136 * 2)
#define S5_CT_OFF (S5_XL_OFF + 64 * 136 * 2)
__device__ __forceinline__ void phase_s5_pass(const P& p, int l, char* smem, bool with_out) {
    const int tid = otid(), lane = tid & 63, wv = tid >> 6, q = lane >> 4, r = lane & 15;
    float* BU = (float*)smem; bf16_t* XH = (bf16_t*)(smem + S5_XH_OFF); bf16_t* XL = (bf16_t*)(smem + S5_XL_OFF); bf16_t* CTp = (bf16_t*)(smem + S5_CT_OFF);
    const int dW = (wv >> 1) & 1, ntb = (wv & 1) * 4;
    const int dS = (tid >> 6) & 1, st = tid & 63;
    bf16x8 bhi[4], blo[4];
    float are = 0.f, aim = 0.f, dco = 0.f;
    int cur_g = -1;
    const bf16x8 zero8 = {0, 0, 0, 0, 0, 0, 0, 0};
    for (int job = obid(); job < NC * SG; job += gridDim.x) {
        const int n = job / SG, g = job % SG;
        __syncthreads();
        if (g != cur_g) {
            cur_g = g;
            if (wv < 4) {
#pragma unroll
                for (int jn = 0; jn < 4; ++jn) {
                    const int kk = 16 * (ntb + jn) + r; const size_t ci = ((size_t)dW * SG + g) * 64 + (kk >> 1);
                    float f[8], lo[8];
#pragma unroll
                    for (int e = 0; e < 8; ++e) f[e] = (q < 2) ? p.S5BB[(ci * 16 + 8 * q + e) * 2 + (kk & 1)] : 0.f;
                    const u32x4 hv = pack8(f);
                    float hf[8]; unpack8(hv, hf);
#pragma unroll
                    for (int e = 0; e < 8; ++e) lo[e] = f[e] - hf[e];
                    bhi[jn] = __builtin_bit_cast(bf16x8, hv); blo[jn] = __builtin_bit_cast(bf16x8, pack8(lo));
                }
            }
            if (tid < 128) { const size_t ci = ((size_t)dS * SG + g) * 64 + st; are = p.S5A[ci * 2]; aim = p.S5A[ci * 2 + 1]; }
            if (with_out) {
                for (int idx = tid; idx < 16 * 128; idx += NTHREADS) {
                    const int c = idx >> 7, kk = idx & 127;
                    const float v = (kk & 1) ? -p.in[I_S5CIM][((size_t)l * SG + g) * 1024 + c * 64 + (kk >> 1)] : p.in[I_S5CRE][((size_t)l * SG + g) * 1024 + c * 64 + (kk >> 1)];
                    CTp[c * 136 + kk] = f2bf(v);
                }
                dco = p.in[I_S5D][(size_t)l * SW + g * 16 + r];
            }
        }
        float xr = 0.f, xi = 0.f;
        const size_t eo = (((size_t)dS * NC + n) * SG + g) * 64 + st;
        if (with_out && tid < 128) { const float2 c2 = *(const float2*)(p.S5CAR + eo * 2); xr = c2.x; xi = c2.y; }
        if (wv < 4) {
#pragma unroll
            for (int mt = 0; mt < 4; ++mt) {
                const bf16x8 a = (q < 2) ? *(const bf16x8*)(p.Z + (size_t)(n * 64 + 16 * mt + r) * ZLD + ZS5 + g * 16 + 8 * q) : zero8;
#pragma unroll
                for (int jn = 0; jn < 4; ++jn) {
                    f32x4 acc = {0.f, 0.f, 0.f, 0.f};
                    acc = MFMA16(a, bhi[jn], acc);
                    acc = MFMA16(a, blo[jn], acc);
#pragma unroll
                    for (int e = 0; e < 4; ++e) BU[(dW * 64 + 16 * mt + 4 * q + e) * 132 + 16 * (ntb + jn) + r] = acc[e];
                }
            }
        }
        __syncthreads();
        if (tid < 128) {
#pragma unroll 8
            for (int ii = 0; ii < 64; ++ii) {
                const int i = dS ? 63 - ii : ii;
                float2* bp = (float2*)(BU + (dS * 64 + i) * 132 + st * 2);
                const float2 b = *bp;
                const float nr = are * xr - aim * xi + b.x, ni = are * xi + aim * xr + b.y;
                xr = nr; xi = ni;
                if (with_out) { float2 o; o.x = xr; o.y = xi; *bp = o; }
            }
            if (!with_out) { float2 o; o.x = xr; o.y = xi; *(float2*)(p.S5END + eo * 2) = o; }
        }
        if (with_out) {
            __syncthreads();
            for (int cidx = tid; cidx < 64 * 16; cidx += NTHREADS) {
                const int i = cidx >> 4, k0 = (cidx & 15) * 8;
                float a[8], b[8], lo[8];
                load8f(BU + (0 * 64 + i) * 132 + k0, a); load8f(BU + (1 * 64 + i) * 132 + k0, b);
#pragma unroll
                for (int e = 0; e < 8; ++e) a[e] += b[e];
                const u32x4 hv = pack8(a);
                float hf[8]; unpack8(hv, hf);
#pragma unroll
                for (int e = 0; e < 8; ++e) lo[e] = a[e] - hf[e];
                *(u32x4*)(XH + i * 136 + k0) = hv; *(u32x4*)(XL + i * 136 + k0) = pack8(lo);
            }
            __syncthreads();
            if (wv < 4) {
                f32x4 acc = {0.f, 0.f, 0.f, 0.f};
#pragma unroll
                for (int ks = 0; ks < 4; ++ks) {
                    const bf16x8 ah = *(const bf16x8*)(XH + (16 * wv + r) * 136 + ks * 32 + q * 8), al = *(const bf16x8*)(XL + (16 * wv + r) * 136 + ks * 32 + q * 8);
                    const bf16x8 b = *(const bf16x8*)(CTp + r * 136 + ks * 32 + q * 8);
                    acc = MFMA16(ah, b, acc);
                    acc = MFMA16(al, b, acc);
                }
#pragma unroll
                for (int e = 0; e < 4; ++e) {
                    const int i = 16 * wv + 4 * q + e;
                    const float u = bf2f(p.Z[(size_t)(n * 64 + i) * ZLD + ZS5 + g * 16 + r]);
                    p.GY[(size_t)(n * 64 + i) * SW + g * 16 + r] = f2bf(geluf_(acc[e] + dco * u));
                }
            }
        }
    }
    __syncthreads();
}
__device__ __forceinline__ void s5_carry_job(const P& p, int job) {
    const int base = job * NTHREADS + otid();
    if (base >= 2 * SG * 64) return;
    const int d = base / (SG * 64), g = (base / 64) % SG, st = base % 64;
    const size_t ci = ((size_t)d * SG + g) * 64 + st;
    float ar = p.S5A[ci * 2], ai = p.S5A[ci * 2 + 1];
    for (int i = 0; i < 6; ++i) { const float nr = ar * ar - ai * ai, ni = 2.f * ar * ai; ar = nr; ai = ni; }
    const float2* __restrict__ endp = (const float2*)p.S5END; float2* __restrict__ carp = (float2*)p.S5CAR;
    float cr = 0.f, cim = 0.f;
    for (int s = 0; s < NC; s += 4) {
        float2 ev[4]; size_t eo[4];
#pragma unroll
        for (int u = 0; u < 4; ++u) {
            const int n = chunk_order(d, (s + u < NC) ? s + u : NC - 1);
            eo[u] = (((size_t)d * NC + n) * SG + g) * 64 + st;
            ev[u] = endp[eo[u]];
        }
#pragma unroll
        for (int u = 0; u < 4; ++u) if (s + u < NC) {
            float2 c; c.x = cr; c.y = cim; carp[eo[u]] = c;
            const float nr = ar * cr - ai * cim + ev[u].x, ni = ar * cim + ai * cr + ev[u].y;
            cr = nr; cim = ni;
        }
    }
}

__device__ __forceinline__ void phase_side_elem(const P& p, int l) {
    const int lane = otid() & 63;
    const int gw = (obid() * NTHREADS + otid()) >> 6, nw = (gridDim.x * NTHREADS) >> 6;
    const bool actg = lane * 8 < GLA_V, actr = lane * 8 < RW;
    float gng[8], lnw[8], lnb[8];
#pragma unroll
    for (int e = 0; e < 8; ++e) { gng[e] = 0.f; lnw[e] = 0.f; lnb[e] = 0.f; }
    if (actg) load8f(p.in[I_GLA_NG] + (size_t)l * 128 + ((lane * 8) & 127), gng);
    if (actr) { load8f(p.in[I_RLNW] + (size_t)l * RW + lane * 8, lnw); load8f(p.in[I_RLNB] + (size_t)l * RW + lane * 8, lnb); }
    for (int t = gw; t < MTOT; t += nw) {
        float og[8], zo[8], y0[8], y1[8], vv[8];
        const u32x4 z4 = {0u, 0u, 0u, 0u};
#pragma unroll
        for (int e = 0; e < 8; ++e) { og[e] = 0.f; y0[e] = 0.f; y1[e] = 0.f; }
        if (actg) load8f(p.OGLA + (size_t)t * GLA_V + lane * 8, og);
        unpack8(actg ? *(const u32x4*)(p.Z + (size_t)t * ZLD + ZOG + lane * 8) : z4, zo);
        if (actr) { load8f(p.Y + (size_t)t * RW + lane * 8, y0); load8f(p.Y + ((size_t)MTOT + t) * RW + lane * 8, y1); }
        unpack8(actr ? *(const u32x4*)(p.V + (size_t)t * RW + lane * 8) : z4, vv);
        const int hh = (lane * 8) >> 6;
        const float bon = actr ? (p.BONUS[(size_t)t * RH + hh] + p.BONUS[((size_t)MTOT + t) * RH + hh]) : 0.f;
        float ss = 0.f;
#pragma unroll
        for (int e = 0; e < 8; ++e) ss += og[e] * og[e];
        ss += __shfl_xor(ss, 1, 64); ss += __shfl_xor(ss, 2, 64); ss += __shfl_xor(ss, 4, 64); ss += __shfl_xor(ss, 8, 64);
        const float rstd = rsqrtf(ss * (1.0f / 128.f) + 1e-6f);
        float br[8];
#pragma unroll
        for (int e = 0; e < 8; ++e) br[e] = og[e] * rstd * gng[e] * siluf_(zo[e]);
        if (actg) *(u32x4*)(p.BR + (size_t)t * 3 * BW + lane * 8) = pack8(br);
        float y[8]; float sm = 0.f;
#pragma unroll
        for (int e = 0; e < 8; ++e) { y[e] = y0[e] + y1[e]; sm += y[e]; }
        sm += __shfl_xor(sm, 1, 64); sm += __shfl_xor(sm, 2, 64); sm += __shfl_xor(sm, 4, 64);
        const float mu = sm * (1.0f / 64.f);
        float sv = 0.f;
#pragma unroll
        for (int e = 0; e < 8; ++e) { y[e] -= mu; sv += y[e] * y[e]; }
        sv += __shfl_xor(sv, 1, 64); sv += __shfl_xor(sv, 2, 64); sv += __shfl_xor(sv, 4, 64);
        const float rs = rsqrtf(sv * (1.0f / 64.f) + 64e-5f);
        float yn[8];
#pragma unroll
        for (int e = 0; e < 8; ++e) yn[e] = y[e] * rs * lnw[e] + lnb[e] + bon * vv[e];
        if (actr) store8f(p.YN + (size_t)t * RW + lane * 8, yn);
    }
}

__device__ __forceinline__ void phase_side_gemm(const P& p, int l, char* smem) {
    gemm_phase<4>(p.WT_G2, 128, (size_t)NPAD(RW) * 128 * 2, p.GS, 128, (size_t)MTOT * 128 * 2, 128, NPAD(RW), (bf16_t*)smem, NoPre(), NoPre(),
        [&](int, int, int m, int n, const f32x4 v) {
            if (n < RW) { const float4 y = *(const float4*)(p.YN + (size_t)m * RW + n);
                *(u32x2*)(p.BR + (size_t)m * 3 * BW + BW + n) = pack4(y.x * v[0], y.y * v[1], y.z * v[2], y.w * v[3]); }
        });
    gemm_phase<4>(p.WT_GLU, SW, (size_t)NPAD(2 * SW) * SW * 2, p.GY, SW, (size_t)MTOT * SW * 2, SW, 2 * SW, (bf16_t*)smem, NoPre(), NoPre(),
        [&](int, int, int m, int n, const f32x4 v) {
            *(unsigned*)(p.BR + (size_t)m * 3 * BW + 2 * BW + (n >> 1)) = pack2bf(v[0] * sigmoidf_(v[1]), v[2] * sigmoidf_(v[3]));
        });
}

__device__ __forceinline__ void phase_merge(const P& p, int l, char* smem) {
    const int ntn = D_MODEL / 128, ntm = (MTOT - 256) / 128;
    auto run = [&](auto mi_tag, int n0, int m0) {
        constexpr int MI = decltype(mi_tag)::value;
        f32x4 macc[4][MI];
#pragma unroll
        for (int i = 0; i < 4; ++i)
#pragma unroll
            for (int j = 0; j < MI; ++j) macc[i][j] = (f32x4){0.f, 0.f, 0.f, 0.f};
        const int lane = otid() & 63, wave = otid() >> 6;
        for (int b = 0; b < 3; ++b) {
            f32x4 acc[4][MI];
#pragma unroll
            for (int i = 0; i < 4; ++i)
#pragma unroll
                for (int j = 0; j < MI; ++j) acc[i][j] = (f32x4){0.f, 0.f, 0.f, 0.f};
            mfma_gemm_tile_t<4, MI>(p.WT_BR + (size_t)b * D_MODEL * BW, BW, (size_t)D_MODEL * BW * 2, p.BR + b * BW, 3 * BW, (size_t)MTOT * 3 * BW * 2 - b * BW * 2, BW, n0, m0, (bf16_t*)smem, acc);
#pragma unroll
            for (int ni = 0; ni < 4; ++ni)
#pragma unroll
                for (int mi = 0; mi < MI; ++mi) {
                    const int n = n0 + (wave >> 1) * 64 + ni * 16 + (lane >> 4) * 4, m = m0 + (wave & 1) * 16 * MI + mi * 16 + (lane & 15);
                    const u32x2 g = *(const u32x2*)(p.ZGT + ((((size_t)(m >> 4) * (3 * D_MODEL / 16) + ((b * D_MODEL + n) >> 4)) * 64 + lane) * 4));
                    macc[ni][mi][0] += LO16(g.x) * acc[ni][mi][0]; macc[ni][mi][1] += HI16(g.x) * acc[ni][mi][1];
                    macc[ni][mi][2] += LO16(g.y) * acc[ni][mi][2]; macc[ni][mi][3] += HI16(g.y) * acc[ni][mi][3];
                }
        }
#pragma unroll
        for (int ni = 0; ni < 4; ++ni)
#pragma unroll
            for (int mi = 0; mi < MI; ++mi) {
                const int n = n0 + (wave >> 1) * 64 + ni * 16 + (lane >> 4) * 4, m = m0 + (wave & 1) * 16 * MI + mi * 16 + (lane & 15);
                *(u32x2*)(p.M + (size_t)m * D_MODEL + n) = pack4(macc[ni][mi][0], macc[ni][mi][1], macc[ni][mi][2], macc[ni][mi][3]);
            }
    };
    for (int it = 0;; ++it) {
        int mt_, nt_; if (!tile_map(it, ntm, ntn, (ntn >= 8) ? 4 : 8, mt_, nt_)) break;
        run(std::integral_constant<int, 4>(), nt_ * 128, mt_ * 128);
    }
    for (int job = obid(); job < 4 * ntn; job += gridDim.x) run(std::integral_constant<int, 2>(), (job >> 2) * 128, MTOT - 256 + (job & 3) * 64);
}

__device__ __forceinline__ void phase_outproj(const P& p, int l, char* smem) {
    gemm_phase<4>(p.WT_OUT, D_MODEL, (size_t)D_MODEL * D_MODEL * 2, p.M, D_MODEL, (size_t)MTOT * D_MODEL * 2, D_MODEL, D_MODEL, (bf16_t*)smem, NoPre(), NoPre(),
        [&](int, int, int m, int n, const f32x4 v) {
            const float* g1 = p.MOD + (size_t)(l * 2 + (m >= CTX ? 1 : 0)) * 6 * D_MODEL + 2 * D_MODEL + n;
            float4* xp = (float4*)(p.X + (size_t)m * D_MODEL + n); float4 x = *xp;
            x.x += g1[0] * v[0]; x.y += g1[1] * v[1]; x.z += g1[2] * v[2]; x.w += g1[3] * v[3]; *xp = x;
        });
}

__device__ __forceinline__ void store_q_hilo(const P& p, int m, int n, const f32x4 v) {
    const bf16_t h0 = f2bf(v[0]), h1 = f2bf(v[1]), h2 = f2bf(v[2]), h3 = f2bf(v[3]);
    u32x2 hv; hv.x = (unsigned)h0 | ((unsigned)h1 << 16); hv.y = (unsigned)h2 | ((unsigned)h3 << 16);
    *(u32x2*)(p.QHI + (size_t)m * PQ + n) = hv;
    *(u32x2*)(p.QLO + (size_t)m * PQ + n) = pack4(v[0] - bf2f(h0), v[1] - bf2f(h1), v[2] - bf2f(h2), v[3] - bf2f(h3));
}
__device__ __forceinline__ void phase_peer_q(const P& p, int l, char* smem) {
    gemm_phase<4>(p.WT_Q, D_MODEL, (size_t)PQ * D_MODEL * 2, p.H, D_MODEL, (size_t)MTOT * D_MODEL * 2, D_MODEL, PQ, (bf16_t*)smem, NoPre(), NoPre(),
        [&](int, int, int m, int n, const f32x4 v) { store_q_hilo(p, m, n, v); });
}

#define TK_ROW 129
__device__ __forceinline__ unsigned tk_key(float f, unsigned lowmask, unsigned low) {
    unsigned u = __builtin_bit_cast(unsigned, f);
    u ^= (u & 0x80000000u) ? 0xFFFFFFFFu : 0x80000000u;
    return (u & ~lowmask) | low;
}
#define TK_INSERT(lv, xk) { unsigned x_ = (xk); _Pragma("unroll") for (int z_ = 0; z_ < 16; ++z_) { const unsigned hi_ = lv[z_] > x_ ? lv[z_] : x_; x_ = lv[z_] > x_ ? x_ : lv[z_]; lv[z_] = hi_; } }
__device__ __forceinline__ void phase_peer_topk(const P& p, int l, char* smem) {
    const int tid = otid(), lane = tid & 63, wv = tid >> 6, q = lane >> 4, r = lane & 15;
    float* sc = (float*)smem + wv * (64 * TK_ROW);
    const int gw = (obid() * NTHREADS + tid) >> 6, nw = (gridDim.x * NTHREADS) >> 6;
    const float NEG = -3.0e38f;
    for (int job = gw; job < (MTOT / 32) * PH; job += nw) {
        const int t0 = (job / PH) * 32, h = job % PH;
#pragma unroll
        for (int sd = 0; sd < 2; ++sd) {
            f32x4 acc[2][8];
#pragma unroll
            for (int mt = 0; mt < 2; ++mt)
#pragma unroll
                for (int nt = 0; nt < 8; ++nt) acc[mt][nt] = (f32x4){0.f, 0.f, 0.f, 0.f};
#pragma unroll
            for (int ks = 0; ks < 4; ++ks) {
                bf16x8 ah[2], al[2];
#pragma unroll
                for (int mt = 0; mt < 2; ++mt) {
                    const size_t qo = (size_t)(t0 + mt * 16 + r) * PQ + h * 256 + sd * 128 + ks * 32 + q * 8;
                    ah[mt] = *(const bf16x8*)(p.QHI + qo); al[mt] = *(const bf16x8*)(p.QLO + qo);
                }
#pragma unroll
                for (int nt = 0; nt < 8; ++nt) {
                    const size_t ko = ((size_t)(h * 2 + sd) * 128 + nt * 16 + r) * 128 + ks * 32 + q * 8;
                    const bf16x8 bh = *(const bf16x8*)(p.KHI + ko), bl = *(const bf16x8*)(p.KLO + ko);
#pragma unroll
                    for (int mt = 0; mt < 2; ++mt) {
                        acc[mt][nt] = MFMA16(ah[mt], bh, acc[mt][nt]);
                        acc[mt][nt] = MFMA16(al[mt], bh, acc[mt][nt]);
                        acc[mt][nt] = MFMA16(ah[mt], bl, acc[mt][nt]);
                    }
                }
            }
#pragma unroll
            for (int mt = 0; mt < 2; ++mt)
#pragma unroll
                for (int nt = 0; nt < 8; ++nt)
#pragma unroll
                    for (int e = 0; e < 4; ++e) sc[(sd * 32 + mt * 16 + 4 * q + e) * TK_ROW + nt * 16 + r] = acc[mt][nt][e];
        }
        WAVE_SYNC();
        unsigned lv[16];
#pragma unroll
        for (int z = 0; z < 16; ++z) lv[z] = 0u;
        {
            const float* row = sc + lane * TK_ROW;
#pragma unroll 4
            for (int k = 0; k < 128; ++k) TK_INSERT(lv, tk_key(row[k], 0x7Fu, (unsigned)(127 - k)));
        }
        float lvv[16]; int li[16];
        {
            const float* row = sc + lane * TK_ROW;
#pragma unroll
            for (int z = 0; z < 16; ++z) { li[z] = 127 - (int)(lv[z] & 0x7Fu); lvv[z] = row[li[z]]; }
        }
        WAVE_SYNC();
        {
            float* row = sc + lane * TK_ROW;
#pragma unroll
            for (int z = 0; z < 16; ++z) { row[z] = lvv[z]; ((int*)row)[16 + z] = li[z]; }
        }
        WAVE_SYNC();
        const float* r1 = sc + (lane & 31) * TK_ROW; const float* r2 = sc + (32 + (lane & 31)) * TK_ROW;
        unsigned tk[16];
#pragma unroll
        for (int z = 0; z < 16; ++z) tk[z] = 0u;
        for (int i = 0; i < 16; ++i) {
            const float a = r1[i];
            const int nj = 16 / (i + 1);
            for (int j = 0; j < nj; ++j) TK_INSERT(tk, tk_key(a + r2[j], 0xFFu, (unsigned)(255 - (i * 16 + j))));
        }
        int tc[16];
#pragma unroll
        for (int z = 0; z < 16; ++z) tc[z] = 255 - (int)(tk[z] & 0xFFu);
        if (lane < 32) {
            float vals[16]; float mx = 0.f; float ssum = 0.f;
#pragma unroll
            for (int z = 0; z < 16; ++z) { vals[z] = r1[tc[z] >> 4] + r2[tc[z] & 15]; if (z == 0) mx = vals[0]; vals[z] = fexp_(vals[z] - mx); ssum += vals[z]; }
            const float inv = 1.0f / ssum;
            const size_t o = (size_t)(t0 + lane) * PH * 16 + h * 16;
#pragma unroll
            for (int z = 0; z < 16; ++z) {
                const int ex_ = ((const int*)r1)[16 + (tc[z] >> 4)] * 128 + ((const int*)r2)[16 + (tc[z] & 15)];
                p.IDX[o + z] = ex_;
                p.G[o + z] = vals[z] * inv * p.VSC[ex_];
                p.GU[o + z] = p.USC[ex_];
            }
        }
        WAVE_SYNC();
    }
}

#define PEER_CONV_JOBS (2 * NEXP / 4)
__device__ __forceinline__ void peer_conv_job(const P& p, int l, int job) {
    const int tid = otid(), lane = tid & 63, wv = tid >> 6;
    if (wv >= 4) return;
    const int rowg = job * 4 + wv; const int which = rowg / NEXP, row = rowg % NEXP;
    const float* src = p.in[which ? I_PV : I_PU] + ((size_t)l * NEXP + row) * D_MODEL + lane * 16;
    const bool act = lane * 16 < D_MODEL;
    float v[16]; float amax = 0.f;
#pragma unroll
    for (int c = 0; c < 4; ++c) {
        float4 a; a.x = 0.f; a.y = 0.f; a.z = 0.f; a.w = 0.f;
        if (act) a = *(const float4*)(src + c * 4);
        v[c * 4 + 0] = a.x; v[c * 4 + 1] = a.y; v[c * 4 + 2] = a.z; v[c * 4 + 3] = a.w;
        amax = fmaxf(amax, fmaxf(fmaxf(fabsf(a.x), fabsf(a.y)), fmaxf(fabsf(a.z), fabsf(a.w))));
    }
#pragma unroll
    for (int m = 32; m >= 1; m >>= 1) amax = fmaxf(amax, __shfl_xor(amax, m, 64));
    int ex = 0;
    if (amax > 0.f) ex = 7 - (int)((__builtin_bit_cast(unsigned, amax) >> 23) & 0xFF) + 127;
    ex = ex < -100 ? -100 : (ex > 100 ? 100 : ex);
    const float sc = __builtin_bit_cast(float, (unsigned)(ex + 127) << 23), isc = __builtin_bit_cast(float, (unsigned)(127 - ex) << 23);
    u32x4 o;
    int w0 = 0, w1 = 0, w2 = 0, w3 = 0;
    w0 = CVT_PK_FP8(v[0] * sc, v[1] * sc, w0, false); w0 = CVT_PK_FP8(v[2] * sc, v[3] * sc, w0, true);
    w1 = CVT_PK_FP8(v[4] * sc, v[5] * sc, w1, false); w1 = CVT_PK_FP8(v[6] * sc, v[7] * sc, w1, true);
    w2 = CVT_PK_FP8(v[8] * sc, v[9] * sc, w2, false); w2 = CVT_PK_FP8(v[10] * sc, v[11] * sc, w2, true);
    w3 = CVT_PK_FP8(v[12] * sc, v[13] * sc, w3, false); w3 = CVT_PK_FP8(v[14] * sc, v[15] * sc, w3, true);
    o.x = (unsigned)w0; o.y = (unsigned)w1; o.z = (unsigned)w2; o.w = (unsigned)w3;
    unsigned char* dst = (which ? p.V8 : p.U8) + (size_t)row * D_MODEL + lane * 16;
    if (act) *(u32x4*)dst = o;
    if (lane == 0) (which ? p.VSC : p.USC)[row] = isc;
}
#define GE 4
struct GBuf { u32x4 u[GE]; u32x4 v[GE]; float gu; float gv; };
__device__ __forceinline__ void gather_load(const P& p, GBuf& b, int g, int idx0, int idx1, float g0, float g1, float u0, float u1, int lane) {
    const bool act = lane * 16 < D_MODEL;
#pragma unroll
    for (int q = 0; q < GE; ++q) {
        const int k = g * GE + q;
        const int ei = __shfl((k < 64) ? idx0 : idx1, k & 63, 64);
        b.u[q] = act ? *(const u32x4*)(p.U8 + (size_t)ei * D_MODEL + lane * 16) : (u32x4){0u, 0u, 0u, 0u};
        b.v[q] = act ? *(const u32x4*)(p.V8 + (size_t)ei * D_MODEL + lane * 16) : (u32x4){0u, 0u, 0u, 0u};
    }
    const int km = g * GE + ((lane >> 4) & 3);
    b.gv = __shfl((km < 64) ? g0 : g1, km & 63, 64);
    b.gu = __shfl((km < 64) ? u0 : u1, km & 63, 64);
}
__device__ __forceinline__ void gather_compute(const GBuf& b, const float (&hv)[16], float (&acc)[16], int lane) {
    float dt[GE];
#pragma unroll
    for (int q = 0; q < GE; ++q) {
        float d = 0.f;
#pragma unroll
        for (int c = 0; c < 4; ++c) {
            const f32x2 lo = CVT_PK_F32_FP8((int)b.u[q][c], false), hi = CVT_PK_F32_FP8((int)b.u[q][c], true);
            d += hv[c * 4 + 0] * lo.x + hv[c * 4 + 1] * lo.y + hv[c * 4 + 2] * hi.x + hv[c * 4 + 3] * hi.y;
        }
        dt[q] = d;
    }
    float r2[2], r1;
    {
        const bool up = (lane & 32) != 0;
#pragma unroll
        for (int q = 0; q < 2; ++q) { const float keep = up ? dt[2 + q] : dt[q], send = up ? dt[q] : dt[2 + q]; r2[q] = keep + __shfl_xor(send, 32, 64); }
    }
    {
        const bool up = (lane & 16) != 0;
        const float keep = up ? r2[1] : r2[0], send = up ? r2[0] : r2[1];
        r1 = keep + __shfl_xor(send, 16, 64);
    }
    r1 += __shfl_xor(r1, 8, 64); r1 += __shfl_xor(r1, 4, 64); r1 += __shfl_xor(r1, 2, 64); r1 += __shfl_xor(r1, 1, 64);
    const float coef_mine = b.gv * geluf_(r1 * b.gu);
#pragma unroll
    for (int q = 0; q < GE; ++q) {
        const float coef = __shfl(coef_mine, q * 16, 64);
#pragma unroll
        for (int c = 0; c < 4; ++c) {
            const f32x2 lo = CVT_PK_F32_FP8((int)b.v[q][c], false), hi = CVT_PK_F32_FP8((int)b.v[q][c], true);
            acc[c * 4 + 0] += coef * lo.x; acc[c * 4 + 1] += coef * lo.y; acc[c * 4 + 2] += coef * hi.x; acc[c * 4 + 3] += coef * hi.y;
        }
    }
}
__device__ __forceinline__ void phase_peer_gather(const P& p, int l) {
    const int lane = otid() & 63;
    const int gw = (obid() * NTHREADS + otid()) >> 6, nw = (gridDim.x * NTHREADS) >> 6;
    constexpr int NG = PH * 16 / GE;
    const bool act = lane * 16 < D_MODEL;
    for (int t = gw; t < MTOT; t += nw) {
        float hv[16], acc[16];
        {
            const u32x4 z4 = {0u, 0u, 0u, 0u};
            const u32x4 ha = act ? *(const u32x4*)(p.H + (size_t)t * D_MODEL + lane * 16) : z4;
            const u32x4 hb = act ? *(const u32x4*)(p.H + (size_t)t * D_MODEL + lane * 16 + 8) : z4;
            hv[0] = LO16(ha.x); hv[1] = HI16(ha.x); hv[2] = LO16(ha.y); hv[3] = HI16(ha.y); hv[4] = LO16(ha.z); hv[5] = HI16(ha.z); hv[6] = LO16(ha.w); hv[7] = HI16(ha.w);
            hv[8] = LO16(hb.x); hv[9] = HI16(hb.x); hv[10] = LO16(hb.y); hv[11] = HI16(hb.y); hv[12] = LO16(hb.z); hv[13] = HI16(hb.z); hv[14] = LO16(hb.w); hv[15] = HI16(hb.w);
#pragma unroll
            for (int j = 0; j < 16; ++j) acc[j] = 0.f;
        }
        int idx0 = 0, idx1 = 0; float g0 = 0.f, g1 = 0.f, u0 = 0.f, u1 = 0.f;
        if (lane < PH * 16) { idx0 = p.IDX[(size_t)t * PH * 16 + lane]; g0 = p.G[(size_t)t * PH * 16 + lane]; u0 = p.GU[(size_t)t * PH * 16 + lane]; }
        if (64 + lane < PH * 16) { idx1 = p.IDX[(size_t)t * PH * 16 + 64 + lane]; g1 = p.G[(size_t)t * PH * 16 + 64 + lane]; u1 = p.GU[(size_t)t * PH * 16 + 64 + lane]; }
        GBuf b0, b1, b2;
        gather_load(p, b0, 0, idx0, idx1, g0, g1, u0, u1, lane);
        gather_load(p, b1, 1, idx0, idx1, g0, g1, u0, u1, lane);
        for (int g = 0; g < NG; g += 3) {
            if (g + 2 < NG) gather_load(p, b2, g + 2, idx0, idx1, g0, g1, u0, u1, lane);
            gather_compute(b0, hv, acc, lane);
            if (g + 1 < NG) {
                if (g + 3 < NG) gather_load(p, b0, g + 3, idx0, idx1, g0, g1, u0, u1, lane);
                gather_compute(b1, hv, acc, lane);
            }
            if (g + 2 < NG) {
                if (g + 4 < NG) gather_load(p, b1, g + 4, idx0, idx1, g0, g1, u0, u1, lane);
                gather_compute(b2, hv, acc, lane);
            }
        }
        if (act) {
            const float* g2 = p.MOD + (size_t)(l * 2 + (t >= CTX ? 1 : 0)) * 6 * D_MODEL + 5 * D_MODEL + lane * 16;
            float* xp = p.X + (size_t)t * D_MODEL + lane * 16;
#pragma unroll
            for (int c = 0; c < 4; ++c) {
                float4 x = *(float4*)(xp + c * 4);
                x.x += g2[c * 4 + 0] * acc[c * 4 + 0]; x.y += g2[c * 4 + 1] * acc[c * 4 + 1]; x.z += g2[c * 4 + 2] * acc[c * 4 + 2]; x.w += g2[c * 4 + 3] * acc[c * 4 + 3];
                *(float4*)(xp + c * 4) = x;
            }
        }
    }
}

__device__ __forceinline__ void phase_final(const P& p) {
    const int lane = otid() & 63;
    const int gw = (obid() * NTHREADS + otid()) >> 6, nw = (gridDim.x * NTHREADS) >> 6;
    const float* g = p.in[I_FG];
    for (int t = gw; t < SEQ; t += nw) {
        const float* x = p.X + (size_t)(CTX + t) * D_MODEL;
        float v[D_MODEL / 64]; float ss = 0.f;
#pragma unroll
        for (int j = 0; j < D_MODEL / 64; ++j) { v[j] = x[lane + 64 * j]; ss += v[j] * v[j]; }
        ss = wave_sum(ss);
        float rstd = rsqrtf(ss / D_MODEL + 1e-6f);
#pragma unroll
        for (int j = 0; j < D_MODEL / 64; ++j) p.out[(size_t)t * D_MODEL + lane + 64 * j] = v[j] * rstd * g[lane + 64 * j];
    }
}

__global__ void __launch_bounds__(NTHREADS) fwd_megakernel(P p_arg) {
#ifdef EMU
    char* smem = emu_smem();
#else
    __shared__ __attribute__((aligned(16))) char smem_raw[SMEM_BYTES + 16];
    char* smem = smem_raw;
#endif
#ifndef EMU
    volatile LAS unsigned* xst = (volatile LAS unsigned*)(smem_raw + SMEM_BYTES);
    if (threadIdx.x == 0) { xst[0] = 0u; xst[1] = 0u; xst[2] = 0u; xst[3] = 0u; }
    __syncthreads();
    XcdBarrier xb = xcd_barrier_post(p_arg.bar, xst);
#endif
    { LOADP(); phase_init(p, smem); }
#ifndef EMU
    cg::this_grid().sync();
#endif
    GRID_SYNC();
#ifndef EMU
    if (threadIdx.x == 0) {
        unsigned base_ = 0;
        for (unsigned j = 0; j < xb.x; ++j) base_ += xb_ld(&p_arg.bar[XB_XCNT(j)]);
        xst[2] = base_ + xst[3];
    }
    __syncthreads();
#endif
    PROBE_INIT();
    for (int l = 0; l < DEPTH; ++l) {
        { LOADP(); phase_norm(p, l, 0); }
        { LOADP(); phase_s5const(p, l); }
        { LOADP(); phase_convert_weights(p, l, smem); }
        GRID_SYNC(); PROBE_AFTER(0);
        { LOADP(); phase_gemm_in(p, l, smem); }
        GRID_SYNC(); PROBE_AFTER(1);
        { LOADP(); phase_rwkv_prep1(p, l); }
        GRID_SYNC(); PROBE_AFTER(14);
        { LOADP(); phase_rwkv_prep2(p, l, smem); }
        GRID_SYNC(); PROBE_AFTER(2);
        { LOADP(); for (int job = obid(); job < 2 * NC * RH; job += gridDim.x) rwkv_chunk_job(p, job, smem); }
        __syncthreads();
        { LOADP(); phase_gla_kv(p, l, smem); }
        { LOADP(); phase_s5_pass(p, l, smem, false); }
        GRID_SYNC(); PROBE_AFTER(3);
        {
            LOADP();
            const int n_rw = 2 * RH, n_gla = 2 * GH * 8192 / NTHREADS, n_s5 = (2 * SG * 64 + NTHREADS - 1) / NTHREADS;
            for (int job = obid(); job < n_rw + n_gla + n_s5 + PEER_CONV_JOBS; job += gridDim.x) {
                if (job < n_rw) rwkv_seq_job(p, job, smem);
                else if (job < n_rw + n_gla) gla_scan_job(p, job - n_rw);
                else if (job < n_rw + n_gla + n_s5) s5_carry_job(p, job - n_rw - n_gla);
                else peer_conv_job(p, l, job - n_rw - n_gla - n_s5);
            }
        }
        GRID_SYNC(); PROBE_AFTER(4);
        { LOADP(); phase_rwkv_out(p); }
        { LOADP(); phase_gla_out(p, l, smem); }
        { LOADP(); phase_s5_pass(p, l, smem, true); }
        GRID_SYNC(); PROBE_AFTER(5);
        { LOADP(); phase_side_elem(p, l); }
        GRID_SYNC(); PROBE_AFTER(6);
        { LOADP(); phase_side_gemm(p, l, smem); }
        GRID_SYNC(); PROBE_AFTER(7);
        { LOADP(); phase_merge(p, l, smem); }
        GRID_SYNC(); PROBE_AFTER(8);
        { LOADP(); phase_outproj(p, l, smem); }
        GRID_SYNC(); PROBE_AFTER(9);
        { LOADP(); phase_norm(p, l, 1); }
        GRID_SYNC(); PROBE_AFTER(10);
        { LOADP(); phase_peer_q(p, l, smem); }
        GRID_SYNC(); PROBE_AFTER(11);
        { LOADP(); phase_peer_topk(p, l, smem); }
        GRID_SYNC(); PROBE_AFTER(12);
        { LOADP(); phase_peer_gather(p, l); }
        GRID_SYNC(); PROBE_AFTER(13);
    }
    { LOADP(); phase_final(p); }
}

static inline size_t align_up(size_t x) { return (x + 255) & ~(size_t)255; }

extern "C" void kernel_launch(void* const* d_in, const int* in_sizes, int n_in, void* d_out, int out_size, void* d_ws, size_t ws_size, hipStream_t stream) {
    P p;
    memset(&p, 0, sizeof(p));
    for (int i = 0; i < 39; ++i) p.in[i] = (const float*)d_in[i];
    p.out = (float*)d_out;
    char* w = (char*)d_ws; size_t off = 0;
    auto take = [&](size_t bytes) { void* r = w + off; off = align_up(off + bytes); return r; };
    p.bar = (unsigned*)take(16384);
    p.X = (float*)take((size_t)MTOT * D_MODEL * 4);
    p.H = (bf16_t*)take((size_t)MTOT * D_MODEL * 2);
    p.MOD = (float*)take((size_t)DEPTH * 2 * 6 * D_MODEL * 4);
    p.Z = (bf16_t*)take((size_t)MTOT * ZLD * 2);
    p.ZGT = (bf16_t*)take((size_t)MTOT * 3 * D_MODEL * 2);
    p.V = (bf16_t*)take((size_t)MTOT * RW * 2);
    {
        char* ra = (char*)take((size_t)MTOT * RW * 2 * 2 > (size_t)MTOT * GLA_V * 4 ? (size_t)MTOT * RW * 2 * 2 : (size_t)MTOT * GLA_V * 4);
        p.R = (bf16_t*)ra; p.KK = (bf16_t*)(ra + (size_t)MTOT * RW * 2);
        p.OGLA = (float*)ra;
    }
    {
        char* rb = (char*)take((size_t)2 * MTOT * RW * 2 > (size_t)3 * MTOT * PH * 16 * 4 ? (size_t)2 * MTOT * RW * 2 : (size_t)3 * MTOT * PH * 16 * 4);
        p.KD = (bf16_t*)rb;
        p.IDX = (int*)rb; p.G = (float*)(rb + (size_t)MTOT * PH * 16 * 4); p.GU = (float*)(rb + (size_t)2 * MTOT * PH * 16 * 4);
    }
    p.BB = (bf16_t*)take((size_t)2 * MTOT * RW * 2);
    p.LW = (float*)take((size_t)2 * MTOT * RW * 4);
    p.SP = (bf16_t*)p.LW;
    static_assert((size_t)2 * NC * GH * 8192 * 2 <= (size_t)2 * MTOT * RW * 4, "SP alias");
    p.BONUS = (float*)take((size_t)2 * MTOT * RH * 4);
    p.KS = (bf16_t*)take((size_t)MTOT * RW * 2);
    p.LR = (bf16_t*)take((size_t)MTOT * 256 * 2);
    p.WT_W2 = (bf16_t*)take((size_t)2 * NPAD(RW) * 64 * 2);
    p.WT_A2 = (bf16_t*)take((size_t)2 * NPAD(RW) * 64 * 2);
    p.GS = (bf16_t*)take((size_t)MTOT * 128 * 2);
    p.Y = (float*)take((size_t)2 * MTOT * RW * 4);
    p.Y0T = (float*)take((size_t)2 * NC * RH * 4096 * 4);
    p.KV = (float*)take((size_t)2 * NC * GH * 8192 * 4);
    p.DEC = (float*)take((size_t)2 * NC * GH * 64 * 4);
    p.S5A = (float*)take((size_t)2 * SG * 64 * 2 * 4);
    p.S5BB = (float*)take((size_t)2 * SG * 64 * 16 * 2 * 4);
    p.S5END = (float*)take((size_t)2 * NC * SG * 64 * 2 * 4);
    p.S5CAR = (float*)take((size_t)2 * NC * SG * 64 * 2 * 4);
    {
        const size_t szc1 = (size_t)2 * NC * RH * SEQ_REC;
        const size_t szc2 = (size_t)MTOT * SW * 2 + (size_t)MTOT * RW * 4 + (size_t)MTOT * 3 * BW * 2 + (size_t)MTOT * D_MODEL * 2 + 1024;
        char* rc = (char*)take(szc1 > szc2 ? szc1 : szc2);
        p.REC = rc;
        char* c2 = rc;
        p.GY = (bf16_t*)c2; c2 += align_up((size_t)MTOT * SW * 2);
        p.YN = (float*)c2; c2 += align_up((size_t)MTOT * RW * 4);
        p.BR = (bf16_t*)c2; c2 += align_up((size_t)MTOT * 3 * BW * 2);
        p.M = (bf16_t*)c2;
    }
    p.SN = (bf16_t*)take((size_t)2 * NC * RH * 4096 * 2);
    p.QH = (bf16_t*)take((size_t)2 * NC * RH * 4096 * 2);
    p.WT_IN = (bf16_t*)take((size_t)NPAD192(D_IN) * D_MODEL * 2);
    p.WT_G2 = (bf16_t*)take((size_t)NPAD(RW) * 128 * 2);
    p.WT_GLU = (bf16_t*)take((size_t)NPAD(2 * SW) * SW * 2);
    p.WT_BR = (bf16_t*)take((size_t)3 * D_MODEL * BW * 2);
    p.WT_OUT = (bf16_t*)take((size_t)D_MODEL * D_MODEL * 2);
    p.WT_Q = (bf16_t*)take((size_t)PQ * D_MODEL * 2);
    p.U8 = (unsigned char*)take((size_t)NEXP * D_MODEL);
    p.V8 = (unsigned char*)take((size_t)NEXP * D_MODEL);
    p.USC = (float*)take((size_t)NEXP * 4); p.VSC = (float*)take((size_t)NEXP * 4);
    p.QHI = p.Z; p.QLO = p.Z + (size_t)MTOT * PQ;
    p.KHI = (bf16_t*)take((size_t)PH * 2 * 128 * 128 * 2); p.KLO = (bf16_t*)take((size_t)PH * 2 * 128 * 128 * 2);
    static_assert((size_t)PQ * 4 <= (size_t)D_IN * 2 && ((size_t)MTOT * ZLD * 2) % 256 == 0, "Q alias");
    if (off > ws_size) { fprintf(stderr, "ws too small: need %zu have %zu\n", off, ws_size); return; }
#ifdef EMU
    fprintf(stderr, "ws used %zu MB\n", off >> 20);
    emu_launch([=] { fwd_megakernel(p); }, EMU_GRID, NTHREADS);
#else
    hipMemsetAsync(p.bar, 0, 16384, stream);
    static int grid_blocks = 0;
    if (!grid_blocks) {
        int dev = 0, cus = 0, per_cu = 0;
        hipGetDevice(&dev);
        hipDeviceGetAttribute(&cus, hipDeviceAttributeMultiprocessorCount, dev);
        hipOccupancyMaxActiveBlocksPerMultiprocessor(&per_cu, fwd_megakernel, NTHREADS, 0);
        if (per_cu > 1) per_cu = 1;
        grid_blocks = cus * per_cu;
    }
    void* args[] = {&p};
    hipError_t e = hipLaunchCooperativeKernel((void*)fwd_megakernel, dim3(grid_blocks), dim3(NTHREADS), args, 0, stream);
    if (e != hipSuccess) fprintf(stderr, "cooperative launch failed: %s (grid %d)\n", hipGetErrorString(e), grid_blocks);
#endif
}
```

```cpp
#include <hip/hip_runtime.h>
#ifndef EMU
#include <hip/hip_cooperative_groups.h>
namespace cg = cooperative_groups;
#endif
#include <cstdio>
#include <cstdint>
#include <cstring>
#include <type_traits>

#ifdef CFG_SMALL
#define D_MODEL 128
#define SEQ 640
#define DEPTH 2
#define GRID_W 10
#define CTX 128
#define GH 1
#define RH 2
#define SG 8
#define PH 2
#else
#define D_MODEL 1024
#define SEQ 16384
#define DEPTH 4
#define GRID_W 64
#define CTX 256
#define GH 4
#define RH 8
#define SG 32
#define PH 8
#endif
#define MTOT (CTX + SEQ)
#define ROWS (SEQ / GRID_W)
#define GLA_K (GH * 64)
#define GLA_V (GH * 128)
#define RW (RH * 64)
#define RWKV_IN (3 * RW + 4 * 64 + 128)
#define SW (SG * 16)
#define BW GLA_V
#define ZQ 0
#define ZK (GLA_K)
#define ZV (2 * GLA_K)
#define ZOG (ZV + GLA_V)
#define ZAF (ZOG + GLA_V)
#define ZAB (ZAF + 16)
#define ZR (ZAB + 16)
#define ZS5 (ZR + RWKV_IN)
#define ZG (ZS5 + SW)
#define D_IN (ZG + 3 * D_MODEL)
#define ZLD ZG
#define NC (MTOT / 64)
#define NCC (CTX / 64)
#define RB (ROWS / 64)
#define PQ (PH * 256)
#define NEXP 16384
#define NTHREADS 256
#define SMEM_BYTES 133120

typedef unsigned short bf16_t;
typedef short bf16x8 __attribute__((ext_vector_type(8)));
typedef float f32x4 __attribute__((ext_vector_type(4)));
typedef unsigned u32x4 __attribute__((ext_vector_type(4)));
typedef unsigned u32x2 __attribute__((ext_vector_type(2)));
#ifdef EMU
#define MFMA16(a, b, c) emu_mfma_16x16x32_bf16(a, b, c)
#else
#define MFMA16(a, b, c) __builtin_amdgcn_mfma_f32_16x16x32_bf16(a, b, c, 0, 0, 0)
#endif
typedef float f32x2 __attribute__((ext_vector_type(2)));
#ifdef EMU
#define CVT_PK_FP8(a, b, old, hi) emu_cvt_pk_fp8_f32(a, b, old, hi)
#define CVT_PK_F32_FP8(w, hi) emu_cvt_pk_f32_fp8(w, hi)
#else
#define CVT_PK_FP8(a, b, old, hi) __builtin_amdgcn_cvt_pk_fp8_f32(a, b, old, hi)
#define CVT_PK_F32_FP8(w, hi) __builtin_amdgcn_cvt_pk_f32_fp8(w, hi)
#endif
#ifdef EMU
#define MFMA16_ACC(a, b, c) c = emu_mfma_16x16x32_bf16(a, b, c)
#else
#define MFMA16_ACC(a, b, c) asm volatile("v_mfma_f32_16x16x32_bf16 %0, %1, %2, %0" : "+a"(c) : "v"(a), "v"(b))
#endif
#define NPAD(n) (((n) + 127) / 128 * 128)
#define NPAD192(n) (((n) + 383) / 384 * 384)

__device__ __forceinline__ float bf2f(bf16_t h) { return __builtin_bit_cast(float, ((unsigned)h) << 16); }
#ifdef EMU
__device__ __forceinline__ bf16_t f2bf(float f) { unsigned u = __builtin_bit_cast(unsigned, f); u += 0x7FFFu + ((u >> 16) & 1u); return (bf16_t)(u >> 16); }
__device__ __forceinline__ unsigned pack2bf(float a, float b) { return (unsigned)f2bf(a) | ((unsigned)f2bf(b) << 16); }
#else
typedef float f2v_t __attribute__((ext_vector_type(2))); typedef __bf16 b2v_t __attribute__((ext_vector_type(2)));
__device__ __forceinline__ bf16_t f2bf(float f) { return __builtin_bit_cast(unsigned short, (__bf16)f); }
__device__ __forceinline__ unsigned pack2bf(float a, float b) { f2v_t v = {a, b}; b2v_t r = __builtin_convertvector(v, b2v_t); return __builtin_bit_cast(unsigned, r); }
#endif
#ifdef EMU
#define fexp_(x) expf(x)
#define flog_(x) logf(x)
#else
#define fexp_(x) __expf(x)
#define flog_(x) __logf(x)
#endif
#define LO16(x) __builtin_bit_cast(float, (x) << 16)
#define HI16(x) __builtin_bit_cast(float, (x) & 0xFFFF0000u)
__device__ __forceinline__ float sigmoidf_(float x) { return 1.0f / (1.0f + fexp_(-x)); }
__device__ __forceinline__ float siluf_(float x) { return x * sigmoidf_(x); }
__device__ __forceinline__ float geluf_(float x) { const float y = 1.5957691216057308f * (x + 0.044715f * x * x * x); return x / (1.0f + fexp_(-y)); }
__device__ __forceinline__ float softplusf_(float x) { return fmaxf(x, 0.f) + flog_(1.0f + fexp_(-fabsf(x))); }
__device__ __forceinline__ float tanhf_(float x) { const float e = fexp_(-2.0f * fabsf(x)); const float t = (1.0f - e) / (1.0f + e); return x < 0.f ? -t : t; }
__device__ __forceinline__ float wave_sum(float v) {
#pragma unroll
    for (int m = 32; m >= 1; m >>= 1) v += __shfl_xor(v, m, 64);
    return v;
}

struct P {
    const float* in[39];
    float* out;
    float* X;
    bf16_t* H;
    bf16_t* Z;
    bf16_t* ZGT;
    float* MOD;
    bf16_t* R; bf16_t* V; bf16_t* KK; bf16_t* KD; bf16_t* BB;
    float* LW;
    char* REC;
    bf16_t* SN;
    bf16_t* QH;
    float* BONUS;
    bf16_t* KS;
    bf16_t* LR;
    bf16_t* WT_W2;
    bf16_t* WT_A2;
    bf16_t* GS;
    float* Y;
    float* Y0T;
    float* KV;
    bf16_t* SP;
    float* DEC;
    float* OGLA;
    float* S5A;
    float* S5BB;
    float* S5END;
    float* S5CAR;
    bf16_t* GY;
    float* YN;
    bf16_t* BR;
    bf16_t* M;
    bf16_t* QHI; bf16_t* QLO;
    bf16_t* KHI; bf16_t* KLO;
    int* IDX;
    float* G;
    float* GU;
    unsigned* bar;
    bf16_t* WT_IN;
    bf16_t* WT_G2;
    bf16_t* WT_GLU;
    bf16_t* WT_BR;
    bf16_t* WT_OUT;
    bf16_t* WT_Q;
    unsigned char* U8; unsigned char* V8;
    float* USC; float* VSC;
};

enum { I_X = 0, I_C, I_CTX, I_CCTX, I_WMOD, I_BMOD, I_N1G, I_N2G, I_WIN, I_GLA_WA2, I_GLA_BA, I_GLA_NG, I_RCONV, I_RW0, I_RW2, I_RA0, I_RA2, I_RG2,
       I_RKK, I_RKA, I_RRK, I_RLNW, I_RLNB, I_S5LRE, I_S5LIM, I_S5LS, I_S5BRE, I_S5BIM, I_S5CRE, I_S5CIM, I_S5D, I_S5GLU, I_WBR, I_WOUT, I_PWQ, I_PKEYS, I_PU, I_PV, I_FG };

#ifdef EMU
__device__ __forceinline__ int otid() { return threadIdx.x; }
__device__ __forceinline__ int obid() { return blockIdx.x; }
#else
__device__ __forceinline__ int otid() { int t = threadIdx.x; asm volatile("" : "+v"(t)); return t; }
__device__ __forceinline__ int obid() { int b = blockIdx.x; asm volatile("" : "+s"(b)); return b; }
#endif
#ifdef EMU
#define WAVE_SYNC() emu_wave_barrier()
#ifndef EMU_GRID
#define EMU_GRID 4
#endif
#else
#define WAVE_SYNC() __builtin_amdgcn_wave_barrier()
#endif
#ifndef EMU
#define XB_TMO      128
#define XB_XCNT(j)  (256  + 64 * (j))
#define XB_XSUB(j)  (1280 + 64 * (j))
#define XB_XGEN(j)  (2304 + 64 * (j))
#define XB_TOP      3328
#define XB_TOPGEN   3392
#define XCD_BAR_WORDS 3456
#define XB_SPIN_CAP (1u << 22)
#define LAS __attribute__((address_space(3)))
__device__ __forceinline__ unsigned xb_ld(unsigned* p)              { return __hip_atomic_load(p, __ATOMIC_RELAXED, __HIP_MEMORY_SCOPE_AGENT); }
__device__ __forceinline__ unsigned xb_add(unsigned* p, unsigned v) { return __hip_atomic_fetch_add(p, v, __ATOMIC_RELAXED, __HIP_MEMORY_SCOPE_AGENT); }
__device__ __forceinline__ unsigned xb_xcc_id() { return (unsigned)__builtin_amdgcn_s_getreg((3 << 11) | 20) & 0xFu; }
#define XB_SPIN(cond, bar) do { unsigned _sp = 0; while (cond) { __builtin_amdgcn_s_sleep(1); \
    if ((++_sp & 255u) == 0u) { if (xb_ld(&(bar)[XB_TMO])) break; if (_sp > XB_SPIN_CAP) { atomicAdd(&(bar)[XB_TMO], 1u); break; } } } } while (0)
struct XcdBarrier { unsigned* bar; unsigned x; volatile LAS unsigned* st; };
__device__ __forceinline__ XcdBarrier xcd_barrier_post(unsigned* bar, volatile LAS unsigned* st) {
    XcdBarrier b; b.bar = bar; b.x = xb_xcc_id(); b.st = st;
    if (threadIdx.x == 0) st[3] = xb_add(&bar[XB_XCNT(b.x)], 1u);
    return b;
}
__device__ __forceinline__ void xcd_barrier_complete(unsigned* bar, unsigned x, unsigned& nloc, unsigned& nx) {
    const unsigned G = gridDim.x * gridDim.y * gridDim.z;
    unsigned sum, cnt, mine, sp = 0u;
    for (;;) {
        sum = 0u; cnt = 0u; mine = 0u;
#pragma unroll
        for (unsigned j = 0; j < 16; ++j) { const unsigned c = xb_ld(&bar[XB_XCNT(j)]); sum += c; cnt += (c > 0u) ? 1u : 0u; mine = (j == x) ? c : mine; }
        if (sum == G) break;
        __builtin_amdgcn_s_sleep(1);
        if ((++sp & 255u) == 0u) { if (xb_ld(&bar[XB_TMO])) break; if (sp > XB_SPIN_CAP) { atomicAdd(&bar[XB_TMO], 1u); break; } }
    }
    nloc = mine > 0u ? mine : 1u; nx = cnt > 0u ? cnt : 1u;
}
__device__ __forceinline__ void xcd_barrier(const XcdBarrier& b) {
    asm volatile("s_waitcnt vmcnt(0)" ::: "memory");
    __syncthreads();
    if (threadIdx.x == 0) {
        unsigned* bar = b.bar;
        __builtin_amdgcn_s_waitcnt(0);
        unsigned nloc = b.st[0], nx = b.st[1];
        if (nloc == 0u) { xcd_barrier_complete(bar, b.x, nloc, nx); b.st[0] = nloc; b.st[1] = nx; }
        const unsigned old = xb_add(&bar[XB_XSUB(b.x)], 1u);
        const unsigned gen = old / nloc;
        if (old + 1u == (gen + 1u) * nloc) {
            __builtin_amdgcn_fence(__ATOMIC_RELEASE, "agent");
            asm volatile("s_waitcnt vmcnt(0)" ::: "memory");
            const unsigned og = xb_add(&bar[XB_TOP], 1u);
            const unsigned tg = og / nx;
            if (og + 1u == (tg + 1u) * nx) xb_add(&bar[XB_TOPGEN], 1u);
            else XB_SPIN(xb_ld(&bar[XB_TOPGEN]) == tg, bar);
            __builtin_amdgcn_fence(__ATOMIC_ACQUIRE, "agent");
            xb_add(&bar[XB_XGEN(b.x)], 1u);
            asm volatile("s_waitcnt vmcnt(0)" ::: "memory");
        } else {
            XB_SPIN(xb_ld(&bar[XB_XGEN(b.x)]) == gen, bar);
            __builtin_amdgcn_fence(__ATOMIC_ACQUIRE, "agent");
            asm volatile("s_waitcnt vmcnt(0)" ::: "memory");
        }
    }
    __syncthreads();
}
#define GRID_SYNC() xcd_barrier(xb)
#else
#define GRID_SYNC() emu_grid_sync()
#endif

#ifdef EMU
#define LOADP() const P& p = p_arg
#else
typedef __attribute__((address_space(4))) const unsigned long long cu64_t;
__device__ __forceinline__ void load_params(P& p) {
    cu64_t* q = (cu64_t*)__builtin_amdgcn_kernarg_segment_ptr();
    asm volatile("" : "+s"(q));
    unsigned long long w[sizeof(P) / 8];
#pragma unroll
    for (int i = 0; i < (int)(sizeof(P) / 8); ++i) w[i] = q[i];
    __builtin_memcpy(&p, w, sizeof(P));
}
#define LOADP() P p; load_params(p)
#endif
#define PROBE_MULT 3
#if defined(PROBE_ID) && !defined(EMU)
#define PROBE_INIT() unsigned long long probe_t0 = wall_clock64()
#define PROBE_AFTER(id) { if (blockIdx.x == 0) { unsigned long long now_ = wall_clock64(); if ((id) == PROBE_ID) { const unsigned long long dt_ = now_ - probe_t0; \
    while (wall_clock64() - now_ < dt_ * PROBE_MULT) __builtin_amdgcn_s_sleep(8); now_ = wall_clock64(); } probe_t0 = now_; } }
#else
#define PROBE_INIT()
#define PROBE_AFTER(id)
#endif
__device__ __forceinline__ int gla_tok(int n, int i) {
    if (n < NCC) return n * 64 + i;
    int m = n - NCC; int col = m / RB, rb = m % RB;
    return CTX + (rb * 64 + i) * GRID_W + col;
}
__device__ __forceinline__ int chunk_order(int d, int s) {
    if (d == 0) return s;
    return (s < NCC) ? (NCC - 1 - s) : (NC - 1 - (s - NCC));
}
__device__ __forceinline__ int tok_order(int d, int s) {
    if (d == 0) return s;
    return (s < CTX) ? (CTX - 1 - s) : (MTOT - 1 - (s - CTX));
}


#define LDS_ROW 72
__device__ __forceinline__ void mfma_gemm_tile(const bf16_t* Wt, int ldw, const bf16_t* Act, int lda, int K, int n0, int m0, bf16_t* lds, f32x4 (&acc)[4][4]) {
    bf16_t* Ws = lds; bf16_t* As = lds + 128 * LDS_ROW;
    const int tid = otid(), lane = tid & 63, wave = tid >> 6, wn = wave >> 1, wm = wave & 1;
    const int lrow = tid >> 3, lkc = (tid & 7) * 8;
    u32x4 pw[4], pa[4];
#pragma unroll
    for (int i = 0; i < 4; ++i) {
        pw[i] = *(const u32x4*)(Wt + (size_t)(n0 + lrow + 32 * i) * ldw + lkc);
        pa[i] = *(const u32x4*)(Act + (size_t)(m0 + lrow + 32 * i) * lda + lkc);
    }
    for (int k0 = 0; k0 < K; k0 += 64) {
        __syncthreads();
#pragma unroll
        for (int i = 0; i < 4; ++i) {
            *(u32x4*)(Ws + (lrow + 32 * i) * LDS_ROW + lkc) = pw[i];
            *(u32x4*)(As + (lrow + 32 * i) * LDS_ROW + lkc) = pa[i];
        }
        __syncthreads();
        if (k0 + 64 < K) {
#pragma unroll
            for (int i = 0; i < 4; ++i) {
                pw[i] = *(const u32x4*)(Wt + (size_t)(n0 + lrow + 32 * i) * ldw + k0 + 64 + lkc);
                pa[i] = *(const u32x4*)(Act + (size_t)(m0 + lrow + 32 * i) * lda + k0 + 64 + lkc);
            }
        }
#pragma unroll
        for (int ks = 0; ks < 2; ++ks) {
            bf16x8 a[4], b[4];
#pragma unroll
            for (int i = 0; i < 4; ++i) {
                a[i] = *(const bf16x8*)(Ws + (wn * 64 + i * 16 + (lane & 15)) * LDS_ROW + ks * 32 + (lane >> 4) * 8);
                b[i] = *(const bf16x8*)(As + (wm * 64 + i * 16 + (lane & 15)) * LDS_ROW + ks * 32 + (lane >> 4) * 8);
            }
#pragma unroll
            for (int ni = 0; ni < 4; ++ni)
#pragma unroll
                for (int mi = 0; mi < 4; ++mi) acc[ni][mi] = MFMA16(a[ni], b[mi], acc[ni][mi]);
        }
    }
}
#define L64_ROW 72
#ifdef EMU
struct BufRsrc { const char* base; };
__device__ __forceinline__ BufRsrc make_rsrc(const void* p, size_t) { BufRsrc r; r.base = (const char*)p; return r; }
__device__ __forceinline__ u32x4 buf_load16(const BufRsrc& r, unsigned voff, unsigned soff) { return *(const u32x4*)(r.base + voff + soff); }
#else
typedef __amdgpu_buffer_rsrc_t BufRsrc;
__device__ __forceinline__ BufRsrc make_rsrc(const void* p, size_t bytes) { return __builtin_amdgcn_make_buffer_rsrc((void*)p, 0, (int)bytes, 0x00020000); }
__device__ __forceinline__ u32x4 buf_load16(const BufRsrc& r, unsigned voff, unsigned soff) { return __builtin_bit_cast(u32x4, __builtin_amdgcn_raw_buffer_load_b128(r, voff, soff, 0)); }
#endif
template <int NI, int MI>
__device__ __forceinline__ void mfma_gemm_tile_t(const bf16_t* Wt, int ldw, size_t wbytes, const bf16_t* Act, int lda, size_t abytes, int K, int n0, int m0, bf16_t* lds, f32x4 (&acc)[NI][MI], unsigned long long* gacc = nullptr) {
    constexpr int WR = 32 * NI, AR = 32 * MI, BUF = (WR + AR) * L64_ROW;
    const int tid = otid(), lane = tid & 63, wave = tid >> 6, wn = wave >> 1, wm = wave & 1;
    const int lrow = tid >> 3, lkc = (tid & 7) * 8;
    const BufRsrc rw = make_rsrc(Wt, wbytes), ra = make_rsrc(Act, abytes);
    unsigned vw[NI], va[MI];
#pragma unroll
    for (int i = 0; i < NI; ++i) vw[i] = (unsigned)(((size_t)(n0 + lrow + 32 * i) * ldw + lkc) * 2);
#pragma unroll
    for (int i = 0; i < MI; ++i) va[i] = (unsigned)(((size_t)(m0 + lrow + 32 * i) * lda + lkc) * 2);
    u32x4 qw0[NI], qa0[MI];
    const int nk = K / 64;
#define GT_LOAD(QW, QA, KT) { const unsigned so_ = (unsigned)(((KT) < nk) ? (KT) : (nk - 1)) * 128u; \
    _Pragma("unroll") for (int i = 0; i < NI; ++i) QW[i] = buf_load16(rw, vw[i], so_); \
    _Pragma("unroll") for (int i = 0; i < MI; ++i) QA[i] = buf_load16(ra, va[i], so_); }
#define GT_STORE(QW, QA, DST) { \
    _Pragma("unroll") for (int i = 0; i < NI; ++i) *(u32x4*)((DST) + (lrow + 32 * i) * L64_ROW + lkc) = QW[i]; \
    _Pragma("unroll") for (int i = 0; i < MI; ++i) *(u32x4*)((DST) + (WR + lrow + 32 * i) * L64_ROW + lkc) = QA[i]; }
#define GT_COMPUTE(CUR) { _Pragma("unroll") for (int ks = 0; ks < 2; ++ks) { bf16x8 b[MI], a[NI]; \
    _Pragma("unroll") for (int i = 0; i < MI; ++i) b[i] = *(const bf16x8*)((CUR) + (WR + wm * 16 * MI + i * 16 + (lane & 15)) * L64_ROW + ks * 32 + (lane >> 4) * 8); \
    _Pragma("unroll") for (int i = 0; i < NI; ++i) a[i] = *(const bf16x8*)((CUR) + (wn * 16 * NI + i * 16 + (lane & 15)) * L64_ROW + ks * 32 + (lane >> 4) * 8); \
    _Pragma("unroll") for (int ni = 0; ni < NI; ++ni) { \
        _Pragma("unroll") for (int mi = 0; mi < MI; ++mi) MFMA16_ACC(a[ni], b[mi], acc[ni][mi]); } } }
    GT_LOAD(qw0, qa0, 0)
    __syncthreads();
    GT_STORE(qw0, qa0, lds)
    __syncthreads();
    for (int kt = 0; kt < nk; kt += 2) {
        GT_LOAD(qw0, qa0, kt + 1)
        GT_COMPUTE(lds)
        GT_STORE(qw0, qa0, lds + BUF)
        __syncthreads();
        GT_LOAD(qw0, qa0, kt + 2)
        GT_COMPUTE(lds + BUF)
        GT_STORE(qw0, qa0, lds)
        __syncthreads();
    }
#undef GT_LOAD
#undef GT_STORE
#undef GT_COMPUTE
}
#define ZERO_ACC4(acc) { _Pragma("unroll") for (int i_ = 0; i_ < 4; ++i_) _Pragma("unroll") for (int j_ = 0; j_ < 4; ++j_) acc[i_][j_] = (f32x4){0.f, 0.f, 0.f, 0.f}; }
#define FOR_ACC(acc, n0, m0, BODY) { const int lane_ = otid() & 63, wave_ = otid() >> 6; \
    _Pragma("unroll") for (int ni_ = 0; ni_ < 4; ++ni_) _Pragma("unroll") for (int mi_ = 0; mi_ < 4; ++mi_) { \
        const int n = (n0) + (wave_ >> 1) * 64 + ni_ * 16 + (lane_ >> 4) * 4; const int m = (m0) + (wave_ & 1) * 64 + mi_ * 16 + (lane_ & 15); const f32x4 v = acc[ni_][mi_]; BODY } }
__device__ __forceinline__ u32x2 pack4(float a, float b, float c, float d) { u32x2 r; r.x = pack2bf(a, b); r.y = pack2bf(c, d); return r; }

__device__ __forceinline__ void convert_wt_job(const float* W, int K, int N, int Npad, bf16_t* out, int job, float* T, int ilv) {
    const int tid = otid();
    const int nkt = K / 64;
    const int n0 = (job / nkt) * 64, k0 = (job % nkt) * 64;
    __syncthreads();
    for (int idx = tid; idx < 4096; idx += NTHREADS) {
        int kk = idx >> 6, nn = idx & 63;
        int nr = n0 + nn; int src = ilv ? ((nr & 1) ? (N / 2 + (nr >> 1)) : (nr >> 1)) : nr;
        T[kk * 65 + nn] = (nr < N) ? W[(size_t)(k0 + kk) * N + src] : 0.f;
    }
    __syncthreads();
    {
        int nn = tid >> 2, part = tid & 3;
        unsigned w[8];
#pragma unroll
        for (int j = 0; j < 8; ++j) w[j] = pack2bf(T[(part * 16 + 2 * j) * 65 + nn], T[(part * 16 + 2 * j + 1) * 65 + nn]);
        u32x4* o = (u32x4*)(out + (size_t)(n0 + nn) * K + k0 + part * 16);
        o[0] = (u32x4){w[0], w[1], w[2], w[3]}; o[1] = (u32x4){w[4], w[5], w[6], w[7]};
    }
}
__device__ __forceinline__ void phase_convert_weights(const P& p, int l, char* smem) {
    float* T = (float*)smem;
    struct Item { const float* W; int K, N, Npad; bf16_t* out; };
    const Item items[12] = {
        {p.in[I_RW2] + ((size_t)l * 2 + 0) * 64 * RW, 64, RW, NPAD(RW), p.WT_W2},
        {p.in[I_RW2] + ((size_t)l * 2 + 1) * 64 * RW, 64, RW, NPAD(RW), p.WT_W2 + (size_t)NPAD(RW) * 64},
        {p.in[I_RA2] + ((size_t)l * 2 + 0) * 64 * RW, 64, RW, NPAD(RW), p.WT_A2},
        {p.in[I_RA2] + ((size_t)l * 2 + 1) * 64 * RW, 64, RW, NPAD(RW), p.WT_A2 + (size_t)NPAD(RW) * 64},
        {p.in[I_WIN] + (size_t)l * D_MODEL * D_IN, D_MODEL, D_IN, NPAD192(D_IN), p.WT_IN},
        {p.in[I_RG2] + (size_t)l * 128 * RW, 128, RW, RW, p.WT_G2},
        {p.in[I_S5GLU] + (size_t)l * SW * 2 * SW, SW, 2 * SW, 2 * SW, p.WT_GLU},
        {p.in[I_WBR] + ((size_t)l * 3 + 0) * BW * D_MODEL, BW, D_MODEL, D_MODEL, p.WT_BR},
        {p.in[I_WBR] + ((size_t)l * 3 + 1) * BW * D_MODEL, BW, D_MODEL, D_MODEL, p.WT_BR + (size_t)D_MODEL * BW},
        {p.in[I_WBR] + ((size_t)l * 3 + 2) * BW * D_MODEL, BW, D_MODEL, D_MODEL, p.WT_BR + (size_t)2 * D_MODEL * BW},
        {p.in[I_WOUT] + (size_t)l * D_MODEL * D_MODEL, D_MODEL, D_MODEL, D_MODEL, p.WT_OUT},
        {p.in[I_PWQ] + (size_t)l * D_MODEL * PQ, D_MODEL, PQ, PQ, p.WT_Q}};
    int base = 0;
#pragma unroll
    for (int it = 0; it < 12; ++it) {
        const int nj = (items[it].Npad / 64) * (items[it].K / 64);
        for (int j = (int)((obid() + gridDim.x - (base % gridDim.x)) % gridDim.x); j < nj; j += gridDim.x)
            convert_wt_job(items[it].W, items[it].K, items[it].N, items[it].Npad, items[it].out, j, T, it == 6);
        base += nj;
    }
    __syncthreads();
    {
        const float* ks = p.in[I_PKEYS] + (size_t)l * PH * 2 * 128 * 128;
        for (size_t i = (size_t)obid() * NTHREADS + otid(); i < (size_t)PH * 2 * 128 * 128; i += (size_t)gridDim.x * NTHREADS) {
            const float v = ks[i]; const bf16_t hb = f2bf(v);
            p.KHI[i] = hb; p.KLO[i] = f2bf(v - bf2f(hb));
        }
    }
}

#ifdef EMU
__device__ __forceinline__ int xcd_rank() { return obid(); }
#else
__device__ __forceinline__ int xcd_rank() { return (int)((volatile LAS unsigned*)(unsigned)(SMEM_BYTES))[2]; }
#endif
__device__ __forceinline__ bool tile_map(int it, int ntm, int ntn, int PM, int& mt, int& nt) {
    const int G = gridDim.x;
    const long id = (long)it * G + xcd_rank();
    if (id >= (long)ntm * ntn) return false;
    const int full = ntm / PM; const long fullsz = (long)full * PM * ntn;
    if (id < fullsz) { const int p = (int)(id / (PM * ntn)), rem = (int)(id % (PM * ntn)); nt = rem / PM; mt = p * PM + rem % PM; }
    else { const int rem = (int)(id - fullsz), hh = ntm - full * PM; nt = rem / hh; mt = full * PM + rem % hh; }
    return true;
}

template <int NI, int MI, class Pre, class Post>
__device__ __forceinline__ void gemm_tile_run(const bf16_t* Wt, int ldw, size_t wbytes, const bf16_t* Act, int lda, size_t abytes, int K, int n0, int m0, bf16_t* lds, Pre pre, Post post) {
    f32x4 acc[NI][MI];
#pragma unroll
    for (int i = 0; i < NI; ++i)
#pragma unroll
        for (int j = 0; j < MI; ++j) acc[i][j] = (f32x4){0.f, 0.f, 0.f, 0.f};
    pre(m0, n0, acc, lds);
    mfma_gemm_tile_t<NI, MI>(Wt, ldw, wbytes, Act, lda, abytes, K, n0, m0, lds, acc);
    const int lane = otid() & 63, wave = otid() >> 6;
#pragma unroll
    for (int ni = 0; ni < NI; ++ni)
#pragma unroll
        for (int mi = 0; mi < MI; ++mi)
            post(ni, mi, m0 + (wave & 1) * 16 * MI + mi * 16 + (lane & 15), n0 + (wave >> 1) * 16 * NI + ni * 16 + (lane >> 4) * 4, acc[ni][mi]);
}
struct NoPre { template <class A> __device__ __forceinline__ void operator()(int, int, A&, bf16_t*) const {} };
template <int NI, class PreM, class PreT, class Post>
__device__ __forceinline__ void gemm_phase(const bf16_t* Wt, int ldw, size_t wbytes, const bf16_t* Act, int lda, size_t abytes, int K, int N, bf16_t* lds, PreM prem, PreT pret, Post post) {
    const int ntn = N / (32 * NI), ntm = MTOT / 256 - 1;
    const int PM = (ntn >= 16) ? 2 : ((ntn >= 8) ? 4 : 8);
    for (int it = 0;; ++it) {
        int mt_, nt_; if (!tile_map(it, ntm, ntn, PM, mt_, nt_)) break;
        gemm_tile_run<NI, 8>(Wt, ldw, wbytes, Act, lda, abytes, K, nt_ * 32 * NI, mt_ * 256, lds, prem, post);
    }
    for (int job = obid(); job < 4 * ntn; job += gridDim.x)
        gemm_tile_run<NI, 2>(Wt, ldw, wbytes, Act, lda, abytes, K, (job >> 2) * 32 * NI, MTOT - 256 + (job & 3) * 64, lds, pret, post);
}

__device__ __forceinline__ void phase_init(const P& p, char* smem) {
    const int tid = otid();
    float* sc = (float*)smem;
    for (int i = tid; i < D_MODEL; i += NTHREADS) { sc[i] = siluf_(p.in[I_CCTX][i]); sc[D_MODEL + i] = siluf_(p.in[I_C][i]); }
    __syncthreads();
    const int ncolblk = (6 * D_MODEL) / NTHREADS;
    for (int job = obid(); job < DEPTH * ncolblk; job += gridDim.x) {
        int l = job / ncolblk, n = (job % ncolblk) * NTHREADS + tid;
        const float* w = p.in[I_WMOD] + (size_t)l * D_MODEL * 6 * D_MODEL + n;
        float a0 = 0.f, a1 = 0.f;
        for (int k = 0; k < D_MODEL; ++k) { float wv = w[(size_t)k * 6 * D_MODEL]; a0 += sc[k] * wv; a1 += sc[D_MODEL + k] * wv; }
        float b = p.in[I_BMOD][l * 6 * D_MODEL + n];
        p.MOD[(size_t)(l * 2 + 0) * 6 * D_MODEL + n] = a0 + b;
        p.MOD[(size_t)(l * 2 + 1) * 6 * D_MODEL + n] = a1 + b;
    }
    const size_t gtid = (size_t)obid() * NTHREADS + tid, gn = (size_t)gridDim.x * NTHREADS;
    for (size_t i = gtid; i < (size_t)CTX * D_MODEL; i += gn) p.X[i] = p.in[I_CTX][i];
    for (size_t i = gtid; i < (size_t)SEQ * D_MODEL; i += gn) p.X[(size_t)CTX * D_MODEL + i] = p.in[I_X][i];
    __syncthreads();
}

__device__ __forceinline__ void phase_s5const(const P& p, int l) {
    const size_t gtid = (size_t)obid() * NTHREADS + otid(), gn = (size_t)gridDim.x * NTHREADS;
    for (size_t i = gtid; i < (size_t)2 * SG * 64; i += gn) {
        int d = (int)(i / (SG * 64)), g = (int)((i / 64) % SG), s = (int)(i % 64);
        size_t li = ((size_t)(l * 2 + d) * SG + g) * 64 + s;
        float lre = p.in[I_S5LRE][li], lim = p.in[I_S5LIM][li];
        float dt = expf(p.in[I_S5LS][(l * 2 + d) * SG + g]);
        float mag = expf(lre * dt);
        float are = mag * cosf(lim * dt), aim = mag * sinf(lim * dt);
        float den = lre * lre + lim * lim;
        float fre = ((are - 1.0f) * lre + aim * lim) / den;
        float fim = (aim * lre - (are - 1.0f) * lim) / den;
        p.S5A[i * 2 + 0] = are; p.S5A[i * 2 + 1] = aim;
        const float* bre = p.in[I_S5BRE] + (((size_t)l * SG + g) * 64 + s) * 16;
        const float* bim = p.in[I_S5BIM] + (((size_t)l * SG + g) * 64 + s) * 16;
        for (int c = 0; c < 16; ++c) {
            p.S5BB[(i * 16 + c) * 2 + 0] = fre * bre[c] - fim * bim[c];
            p.S5BB[(i * 16 + c) * 2 + 1] = fre * bim[c] + fim * bre[c];
        }
    }
}

__device__ __forceinline__ void phase_norm(const P& p, int l, int which) {
    const int lane = otid() & 63;
    const int gw = (obid() * NTHREADS + otid()) >> 6, nw = (gridDim.x * NTHREADS) >> 6;
    const float* g = p.in[which ? I_N2G : I_N1G] + l * D_MODEL;
    constexpr int NJ = (D_MODEL + 255) / 256;
    for (int t = gw; t < MTOT; t += nw) {
        const float* x = p.X + (size_t)t * D_MODEL;
        const float* mod = p.MOD + (size_t)(l * 2 + (t >= CTX ? 1 : 0)) * 6 * D_MODEL + (which ? 3 * D_MODEL : 0);
        float4 v[NJ]; float ss = 0.f;
#pragma unroll
        for (int j = 0; j < NJ; ++j) {
            const int e = j * 256 + lane * 4;
            if (e < D_MODEL) v[j] = *(const float4*)(x + e); else { v[j].x = 0.f; v[j].y = 0.f; v[j].z = 0.f; v[j].w = 0.f; }
            ss += v[j].x * v[j].x + v[j].y * v[j].y + v[j].z * v[j].z + v[j].w * v[j].w;
        }
        ss = wave_sum(ss);
        const float rstd = rsqrtf(ss / D_MODEL + 1e-6f);
#pragma unroll
        for (int j = 0; j < NJ; ++j) {
            const int e = j * 256 + lane * 4;
            if (e < D_MODEL) {
                const float4 gg = *(const float4*)(g + e), sc = *(const float4*)(mod + D_MODEL + e), sh = *(const float4*)(mod + e);
                *(u32x2*)(p.H + (size_t)t * D_MODEL + e) = pack4(v[j].x * rstd * gg.x * (1.0f + sc.x) + sh.x, v[j].y * rstd * gg.y * (1.0f + sc.y) + sh.y,
                                                                 v[j].z * rstd * gg.z * (1.0f + sc.z) + sh.z, v[j].w * rstd * gg.w * (1.0f + sc.w) + sh.w);
            }
        }
    }
}

__device__ __forceinline__ void phase_gemm_in(const P& p, int l, char* smem) {
    constexpr int NI = 4, MI = 8;
    const int ntn = NPAD192(D_IN) / 128, ntm = MTOT / 256;
    for (int it = 0;; ++it) {
        int mt_, nt_; if (!tile_map(it, ntm, ntn, 4, mt_, nt_)) break;
        const int m0 = mt_ * 256, n0 = nt_ * 128;
        f32x4 acc[NI][MI];
#pragma unroll
        for (int i = 0; i < NI; ++i)
#pragma unroll
            for (int j = 0; j < MI; ++j) acc[i][j] = (f32x4){0.f, 0.f, 0.f, 0.f};
        mfma_gemm_tile_t<NI, MI>(p.WT_IN, D_MODEL, (size_t)NPAD192(D_IN) * D_MODEL * 2, p.H, D_MODEL, (size_t)MTOT * D_MODEL * 2, D_MODEL, n0, m0, (bf16_t*)smem, acc);
        const int lane = otid() & 63, wave = otid() >> 6;
#pragma unroll
        for (int ni = 0; ni < NI; ++ni)
#pragma unroll
            for (int mi = 0; mi < MI; ++mi) {
                const int n = n0 + (wave >> 1) * 16 * NI + ni * 16 + (lane >> 4) * 4, m = m0 + (wave & 1) * 16 * MI + mi * 16 + (lane & 15);
                const u32x2 pk_ = pack4(acc[ni][mi][0], acc[ni][mi][1], acc[ni][mi][2], acc[ni][mi][3]);
                if (n < ZG) *(u32x2*)(p.Z + (size_t)m * ZLD + n) = pk_;
                else if (n < D_IN) *(u32x2*)(p.ZGT + ((((size_t)(m >> 4) * (3 * D_MODEL / 16) + ((n - ZG) >> 4)) * 64 + lane) * 4)) =
                    pack4(sigmoidf_(acc[ni][mi][0]), sigmoidf_(acc[ni][mi][1]), sigmoidf_(acc[ni][mi][2]), sigmoidf_(acc[ni][mi][3]));
            }
    }
}

__device__ __forceinline__ void unpack8(const u32x4 w, float (&f)[8]) {
    f[0] = LO16(w.x); f[1] = HI16(w.x); f[2] = LO16(w.y); f[3] = HI16(w.y); f[4] = LO16(w.z); f[5] = HI16(w.z); f[6] = LO16(w.w); f[7] = HI16(w.w);
}
__device__ __forceinline__ u32x4 pack8(const float (&f)[8]) {
    u32x4 o; o.x = pack2bf(f[0], f[1]); o.y = pack2bf(f[2], f[3]);
    o.z = pack2bf(f[4], f[5]); o.w = pack2bf(f[6], f[7]); return o;
}
__device__ __forceinline__ void load8f(const float* p, float (&f)[8]) {
    const float4 a = *(const float4*)p, b = *(const float4*)(p + 4);
    f[0] = a.x; f[1] = a.y; f[2] = a.z; f[3] = a.w; f[4] = b.x; f[5] = b.y; f[6] = b.z; f[7] = b.w;
}
__device__ __forceinline__ void store8f(float* p, const float (&f)[8]) {
    float4 a, b; a.x = f[0]; a.y = f[1]; a.z = f[2]; a.w = f[3]; b.x = f[4]; b.y = f[5]; b.z = f[6]; b.w = f[7];
    *(float4*)p = a; *(float4*)(p + 4) = b;
}
__device__ __forceinline__ void conv8(const bf16_t* zp, const float* conv, int c0, bool act, bool first, bool last, float (&out)[8]) {
    const u32x4 z4 = {0u, 0u, 0u, 0u};
    const u32x4 a0 = act ? *(const u32x4*)(zp + c0) : z4;
    const u32x4 am = (act && !first) ? *(const u32x4*)(zp + c0 - ZLD) : z4;
    const u32x4 an = (act && !last) ? *(const u32x4*)(zp + c0 + ZLD) : z4;
    float w0[8], w1[8], w2[8], f0[8], fm[8], fn[8];
    if (act) { load8f(conv + c0, w0); load8f(conv + RWKV_IN + c0, w1); load8f(conv + 2 * RWKV_IN + c0, w2); }
    else {
#pragma unroll
        for (int e = 0; e < 8; ++e) { w0[e] = 0.f; w1[e] = 0.f; w2[e] = 0.f; }
    }
    unpack8(a0, f0); unpack8(am, fm); unpack8(an, fn);
#pragma unroll
    for (int e = 0; e < 8; ++e) out[e] = w1[e] * f0[e] + w0[e] * fm[e] + w2[e] * fn[e];
}
__device__ __forceinline__ void phase_rwkv_prep1(const P& p, int l) {
    const int lane = otid() & 63;
    const int gw = (obid() * NTHREADS + otid()) >> 6, nw = (gridDim.x * NTHREADS) >> 6;
    const float* conv = p.in[I_RCONV] + (size_t)l * 3 * RWKV_IN;
    const float* k_k = p.in[I_RKK] + (size_t)l * RW;
    const bool act = lane * 8 < RW, act2 = lane * 8 < 384;
    float kkw[8];
    if (act) load8f(k_k + lane * 8, kkw);
    else {
#pragma unroll
        for (int e = 0; e < 8; ++e) kkw[e] = 0.f;
    }
    for (int t = gw; t < MTOT; t += nw) {
        const bool first = (t == 0) || (t == CTX), last = (t == CTX - 1) || (t == MTOT - 1);
        const bf16_t* zp = p.Z + (size_t)t * ZLD + ZR;
        float rv[8], kv[8], vv[8], lr[8];
        conv8(zp, conv, 0 * RW + lane * 8, act, first, last, rv);
        conv8(zp, conv, 1 * RW + lane * 8, act, first, last, kv);
        conv8(zp, conv, 2 * RW + lane * 8, act, first, last, vv);
        conv8(zp, conv, 3 * RW + lane * 8, act2, first, last, lr);
        float kk[8]; float ss = 0.f;
#pragma unroll
        for (int e = 0; e < 8; ++e) { kk[e] = kv[e] * kkw[e]; ss += kk[e] * kk[e]; }
        ss += __shfl_xor(ss, 1, 64); ss += __shfl_xor(ss, 2, 64); ss += __shfl_xor(ss, 4, 64);
        const float inv = 1.0f / fmaxf(sqrtf(ss), 1e-12f);
#pragma unroll
        for (int e = 0; e < 8; ++e) kk[e] *= inv;
        if (act) {
            const size_t o = (size_t)t * RW + lane * 8;
            *(u32x4*)(p.R + o) = pack8(rv); *(u32x4*)(p.KS + o) = pack8(kv); *(u32x4*)(p.V + o) = pack8(vv); *(u32x4*)(p.KK + o) = pack8(kk);
        }
        if (act2) {
            const int cc = lane * 8;
            if (cc < 128) {
#pragma unroll
                for (int e = 0; e < 8; ++e) lr[e] = tanhf_(lr[e]);
                *(u32x4*)(p.LR + (size_t)t * 256 + cc) = pack8(lr);
            } else if (cc < 256) {
                *(u32x4*)(p.LR + (size_t)t * 256 + cc) = pack8(lr);
            } else {
#pragma unroll
                for (int e = 0; e < 8; ++e) lr[e] = sigmoidf_(lr[e]);
                *(u32x4*)(p.GS + (size_t)t * 128 + cc - 256) = pack8(lr);
            }
        }
    }
}
__device__ __forceinline__ void phase_rwkv_prep2(const P& p, int l, char* smem) {
    const int ntm = MTOT / 128, ntn = NPAD(RW) / 128;
    const float* k_a = p.in[I_RKA] + (size_t)l * RW;
    const float* r_k = p.in[I_RRK] + (size_t)l * RW;
    for (int job = obid(); job < ntm * ntn * 2; job += gridDim.x) {
        const int d = job % 2, n0 = ((job / 2) % ntn) * 128, m0 = (job / (2 * ntn)) * 128;
        const float* w0 = p.in[I_RW0] + (size_t)(l * 2 + d) * RW;
        const float* a0 = p.in[I_RA0] + (size_t)(l * 2 + d) * RW;
        f32x4 accw[4][4], acca[4][4]; ZERO_ACC4(accw); ZERO_ACC4(acca);
        mfma_gemm_tile(p.WT_W2 + (size_t)d * NPAD(RW) * 64, 64, p.LR + d * 64, 256, 64, n0, m0, (bf16_t*)smem, accw);
        mfma_gemm_tile(p.WT_A2 + (size_t)d * NPAD(RW) * 64, 64, p.LR + 128 + d * 64, 256, 64, n0, m0, (bf16_t*)smem, acca);
        const int lane = otid() & 63, wave = otid() >> 6;
#pragma unroll
        for (int mi = 0; mi < 4; ++mi) {
            const int m = m0 + (wave & 1) * 64 + mi * 16 + (lane & 15);
            float bon = 0.f;
#pragma unroll
            for (int ni = 0; ni < 4; ++ni) {
                const int n = n0 + (wave >> 1) * 64 + ni * 16 + (lane >> 4) * 4;
                if (n < RW) {
                    const u32x2 kq = *(const u32x2*)(p.KS + (size_t)m * RW + n), kkq = *(const u32x2*)(p.KK + (size_t)m * RW + n), rq = *(const u32x2*)(p.R + (size_t)m * RW + n);
                    const float kv[4] = {LO16(kq.x), HI16(kq.x), LO16(kq.y), HI16(kq.y)};
                    const float kkv[4] = {LO16(kkq.x), HI16(kkq.x), LO16(kkq.y), HI16(kkq.y)};
                    const float rv[4] = {LO16(rq.x), HI16(rq.x), LO16(rq.y), HI16(rq.y)};
                    float lw[4], kd[4], bb[4];
#pragma unroll
                    for (int e = 0; e < 4; ++e) {
                        const float x = w0[n + e] + accw[ni][mi][e];
                        lw[e] = -fexp_(-softplusf_(-x) - 0.5f);
                        const float aa = sigmoidf_(a0[n + e] + acca[ni][mi][e]);
                        kd[e] = kv[e] * (1.0f + (aa - 1.0f) * k_a[n + e]);
                        bb[e] = kkv[e] * aa;
                        bon += rv[e] * kd[e] * r_k[n + e];
                    }
                    const size_t o = ((size_t)d * MTOT + m) * RW + n;
                    float4 lo4; lo4.x = lw[0]; lo4.y = lw[1]; lo4.z = lw[2]; lo4.w = lw[3];
                    *(float4*)(p.LW + o) = lo4;
                    *(u32x2*)(p.KD + o) = pack4(kd[0], kd[1], kd[2], kd[3]);
                    *(u32x2*)(p.BB + o) = pack4(bb[0], bb[1], bb[2], bb[3]);
                }
            }
            bon += __shfl_xor(bon, 16, 64); bon += __shfl_xor(bon, 32, 64);
            const int hh = (n0 + (wave >> 1) * 64) >> 6;
            if ((lane >> 4) == 0 && hh < RH) p.BONUS[((size_t)d * MTOT + m) * RH + hh] = bon;
        }
    }
}

#define CH_ROW 72
#define SEQ_REC 16640
#define CH_SLOT (64 * CH_ROW)
#define CH_XR_OFF (7 * CH_SLOT * 2)
#define CH_AAB_OFF (CH_XR_OFF + 64 * 132 * 4)
#define CH_GC_OFF (CH_AAB_OFF + 64 * 72 * 4)
template <int MT, int NT>
__device__ __forceinline__ void lds_mm(const bf16_t* A, int m0, const bf16_t* Bt, int n0, f32x4 (&acc)[MT][NT]) {
    const int lane = otid() & 63, q = lane >> 4, r = lane & 15;
#pragma unroll
    for (int s = 0; s < 2; ++s) {
        bf16x8 a[MT], b[NT];
#pragma unroll
        for (int i = 0; i < MT; ++i) a[i] = *(const bf16x8*)(A + (m0 + i * 16 + r) * CH_ROW + s * 32 + q * 8);
#pragma unroll
        for (int i = 0; i < NT; ++i) b[i] = *(const bf16x8*)(Bt + (n0 + i * 16 + r) * CH_ROW + s * 32 + q * 8);
#pragma unroll
        for (int i = 0; i < MT; ++i)
#pragma unroll
            for (int jj = 0; jj < NT; ++jj) acc[i][jj] = MFMA16(a[i], b[jj], acc[i][jj]);
    }
}
__device__ __forceinline__ void rwkv_chunk_job(const P& p, int job, char* smem) {
    const int tid = otid(), lane = tid & 63, wv = tid >> 6, q = lane >> 4, r = lane & 15;
    const int d = job / (NC * RH), n = (job / RH) % NC, h = job % RH;
    const size_t base = (size_t)(d * NC + n) * RH + h;
    bf16_t* S0 = (bf16_t*)smem; bf16_t* S1 = S0 + CH_SLOT; bf16_t* S2 = S1 + CH_SLOT; bf16_t* S3 = S2 + CH_SLOT;
    bf16_t* S4 = S3 + CH_SLOT; bf16_t* S5 = S4 + CH_SLOT; bf16_t* S6 = S5 + CH_SLOT;
    float* X = (float*)(smem + CH_XR_OFF);
    float* AABt = (float*)(smem + CH_AAB_OFF);
    bf16_t* U0t = (bf16_t*)(smem + CH_AAB_OFF);
    bf16_t* Aht = U0t + CH_SLOT;
    float* GC = (float*)(smem + CH_GC_OFF);
    __syncthreads();
    u32x4 gkk[2], gr[2], gv[2], gkd[2], gbb[2]; float lw[2][8];
#pragma unroll
    for (int it = 0; it < 2; ++it) {
        const int c = tid + 256 * it, i = c >> 3, k0 = (c & 7) * 8; const int tok = 64 * n + (d ? 63 - i : i);
        const size_t o1 = (size_t)tok * RW + h * 64 + k0, o2 = ((size_t)d * MTOT + tok) * RW + h * 64 + k0;
        load8f(p.LW + o2, lw[it]);
        gkk[it] = *(const u32x4*)(p.KK + o1); gr[it] = *(const u32x4*)(p.R + o1); gv[it] = *(const u32x4*)(p.V + o1);
        gkd[it] = *(const u32x4*)(p.KD + o2); gbb[it] = *(const u32x4*)(p.BB + o2);
    }
#pragma unroll
    for (int it = 0; it < 2; ++it) { const int c = tid + 256 * it; store8f(X + (c >> 3) * 132 + (c & 7) * 8, lw[it]); }
    __syncthreads();
    {
        const int k = tid & 63, seg = tid >> 6;
        float v[16]; float run = 0.f;
#pragma unroll
        for (int e = 0; e < 16; ++e) { run += X[(seg * 16 + e) * 132 + k]; v[e] = run; }
        AABt[seg * 64 + k] = run;
        __syncthreads();
        float off = 0.f;
        for (int s2 = 0; s2 < seg; ++s2) off += AABt[s2 * 64 + k];
#pragma unroll
        for (int e = 0; e < 16; ++e) X[(seg * 16 + e) * 132 + k] = v[e] + off;
    }
    __syncthreads();
#pragma unroll
    for (int it = 0; it < 2; ++it) {
        const int c = tid + 256 * it, i = c >> 3, k0 = (c & 7) * 8;
        float L[8], Lp[8], LC[8], kkv[8], rv[8], vv[8], kdv[8], bbv[8];
        load8f(X + i * 132 + k0, L); load8f(X + 63 * 132 + k0, LC);
        if (i > 0) load8f(X + (i - 1) * 132 + k0, Lp);
        else {
#pragma unroll
            for (int e = 0; e < 8; ++e) Lp[e] = 0.f;
        }
        unpack8(gkk[it], kkv); unpack8(gr[it], rv); unpack8(gv[it], vv); unpack8(gkd[it], kdv); unpack8(gbb[it], bbv);
        float at[8], rt[8], bt[8], kt[8], bh[8], kh[8];
#pragma unroll
        for (int e = 0; e < 8; ++e) {
            const float eL = fexp_(L[e]), eLp = fexp_(Lp[e]), eNL = fexp_(-L[e]), eCL = fexp_(LC[e] - L[e]);
            at[e] = -kkv[e] * eLp; rt[e] = rv[e] * eL; bt[e] = bbv[e] * eNL; kt[e] = kdv[e] * eNL; bh[e] = bbv[e] * eCL; kh[e] = kdv[e] * eCL;
            if (i == 63) GC[k0 + e] = eL;
        }
        *(u32x4*)(S0 + i * CH_ROW + k0) = pack8(at);
        store8f(X + i * 132 + 64 + k0, at);
        *(u32x4*)(S1 + i * CH_ROW + k0) = pack8(rt);
        *(u32x4*)(S2 + i * CH_ROW + k0) = pack8(bt);
        *(u32x4*)(S3 + i * CH_ROW + k0) = pack8(kt);
#pragma unroll
        for (int e = 0; e < 8; ++e) {
            S4[(k0 + e) * CH_ROW + i] = f2bf(vv[e]);
            S5[(k0 + e) * CH_ROW + i] = f2bf(bh[e]);
            S6[(k0 + e) * CH_ROW + i] = f2bf(kh[e]);
        }
    }
    __syncthreads();
    {
        f32x4 acc[4][4]; ZERO_ACC4(acc);
        lds_mm<4, 4>((wv < 2) ? S0 : S1, 0, (wv & 1) ? S3 : S2, 0, acc);
        __syncthreads();
#pragma unroll
        for (int mt = 0; mt < 4; ++mt)
#pragma unroll
            for (int nt = 0; nt < 4; ++nt) {
                const int jc = nt * 16 + r, i0 = mt * 16 + 4 * q;
                if (wv == 0) {
                    f32x4 o;
#pragma unroll
                    for (int e = 0; e < 4; ++e) o[e] = (jc < i0 + e) ? acc[mt][nt][e] : 0.f;
                    *(f32x4*)(AABt + jc * 72 + i0) = o;
                } else {
                    bf16_t* dst = (wv == 1) ? S0 : ((wv == 2) ? S2 : S3);
#pragma unroll
                    for (int e = 0; e < 4; ++e) {
                        const bool ok = (wv == 1) ? (jc < i0 + e) : (jc <= i0 + e);
                        dst[(i0 + e) * CH_ROW + jc] = f2bf(ok ? acc[mt][nt][e] : 0.f);
                    }
                }
            }
    }
    __syncthreads();
    {
        f32x4 acc[1][4];
#pragma unroll
        for (int nt = 0; nt < 4; ++nt) acc[0][nt] = (f32x4){0.f, 0.f, 0.f, 0.f};
        lds_mm<1, 4>(S0, 16 * wv, S4, 0, acc);
#pragma unroll
        for (int nt = 0; nt < 4; ++nt)
#pragma unroll
            for (int e = 0; e < 4; ++e) X[(16 * wv + 4 * q + e) * 132 + nt * 16 + r] = acc[0][nt][e];
    }
    __syncthreads();
    if (tid < 128) {
        const int c = tid;
        for (int bi = 0; bi < 4; ++bi) {
            float acc[16];
#pragma unroll
            for (int e = 0; e < 16; ++e) acc[e] = X[(16 * bi + e) * 132 + c];
            for (int jj = 0; jj < 16 * bi; ++jj) {
                const float uj = X[jj * 132 + c];
                const f32x4* ap = (const f32x4*)(AABt + jj * 72 + 16 * bi);
                const f32x4 a0 = ap[0], a1 = ap[1], a2 = ap[2], a3 = ap[3];
#pragma unroll
                for (int e = 0; e < 4; ++e) { acc[e] += a0[e] * uj; acc[4 + e] += a1[e] * uj; acc[8 + e] += a2[e] * uj; acc[12 + e] += a3[e] * uj; }
            }
#pragma unroll
            for (int e = 0; e < 16; ++e) {
                const float u = acc[e];
                X[(16 * bi + e) * 132 + c] = u;
                const f32x4* ap = (const f32x4*)(AABt + (16 * bi + e) * 72 + 16 * bi);
                const f32x4 a0 = ap[0], a1 = ap[1], a2 = ap[2], a3 = ap[3];
#pragma unroll
                for (int e2 = 0; e2 < 16; ++e2) if (e2 > e) acc[e2] += ((e2 < 4) ? a0[e2 & 3] : (e2 < 8) ? a1[e2 & 3] : (e2 < 12) ? a2[e2 & 3] : a3[e2 & 3]) * u;
            }
        }
    }
    __syncthreads();
    if (tid < 128) {
        const int c = tid;
        bf16_t* dst = (c < 64) ? (U0t + c * CH_ROW) : (Aht + (c - 64) * CH_ROW);
        u32x4 ov[8];
#pragma unroll
        for (int g = 0; g < 8; ++g) {
            float v[8];
#pragma unroll
            for (int e = 0; e < 8; ++e) v[e] = X[(g * 8 + e) * 132 + c];
            ov[g].x = pack2bf(v[0], v[1]); ov[g].y = pack2bf(v[2], v[3]);
            ov[g].z = pack2bf(v[4], v[5]); ov[g].w = pack2bf(v[6], v[7]);
        }
#pragma unroll
        for (int g = 0; g < 8; ++g) *(u32x4*)(dst + g * 8) = ov[g];
    }
    __syncthreads();
    {
        f32x4 acc[4][4]; ZERO_ACC4(acc);
        char* rec = p.REC + base * SEQ_REC;
        if (wv == 0) {
            lds_mm<4, 4>(Aht, 0, S5, 0, acc);
#pragma unroll
            for (int nt = 0; nt < 4; ++nt)
#pragma unroll
                for (int s2 = 0; s2 < 2; ++s2) {
                    u32x4 o;
                    o.x = pack2bf(acc[2 * s2][nt][0], acc[2 * s2][nt][1]); o.y = pack2bf(acc[2 * s2][nt][2], acc[2 * s2][nt][3]);
                    o.z = pack2bf(acc[2 * s2 + 1][nt][0], acc[2 * s2 + 1][nt][1]); o.w = pack2bf(acc[2 * s2 + 1][nt][2], acc[2 * s2 + 1][nt][3]);
                    *(u32x4*)(rec + (((nt * 2 + s2) * 64 + lane) * 8) * 2) = o;
                }
        } else if (wv == 1) {
            lds_mm<4, 4>(S5, 0, U0t, 0, acc);
            lds_mm<4, 4>(S6, 0, S4, 0, acc);
#pragma unroll
            for (int mt = 0; mt < 4; ++mt)
#pragma unroll
                for (int nt = 0; nt < 4; ++nt) *(u32x2*)(rec + 8192 + (((nt * 4 + mt) * 64 + lane) * 4) * 2) = pack4(acc[mt][nt][0], acc[mt][nt][1], acc[mt][nt][2], acc[mt][nt][3]);
        } else if (wv == 2) {
            lds_mm<4, 4>(S2, 0, Aht, 0, acc);
#pragma unroll
            for (int mt = 0; mt < 4; ++mt)
#pragma unroll
                for (int nt = 0; nt < 4; ++nt)
#pragma unroll
                    for (int e = 0; e < 4; ++e) {
                        const int t = mt * 16 + 4 * q + e, kc = nt * 16 + r;
                        p.QH[(base * 64 + t) * 64 + kc] = f2bf(acc[mt][nt][e] + bf2f(S1[t * CH_ROW + kc]));
                    }
        } else if (wv == 3) {
            lds_mm<4, 4>(S2, 0, U0t, 0, acc);
            lds_mm<4, 4>(S3, 0, S4, 0, acc);
#pragma unroll
            for (int mt = 0; mt < 4; ++mt)
#pragma unroll
                for (int nt = 0; nt < 4; ++nt) *(f32x4*)(p.Y0T + (((base * 4 + mt) * 4 + nt) * 64 + lane) * 4) = acc[mt][nt];
        }
        if (tid < 64) ((float*)(rec + 16384))[tid] = GC[tid];
    }
}

#define SEQ_SLOT 16896
__device__ __forceinline__ void rwkv_seq_gload(const P& p, size_t base, int tid, u32x4 (&g)[5]) {
    const u32x4* m = (const u32x4*)(p.REC + base * SEQ_REC);
#pragma unroll
    for (int i = 0; i < 4; ++i) g[i] = m[tid + 256 * i];
    if (tid < 16) g[4] = m[1024 + tid];
}
__device__ __forceinline__ void rwkv_seq_lstore(char* slot, int tid, const u32x4 (&g)[5]) {
    u32x4* d = (u32x4*)slot;
#pragma unroll
    for (int i = 0; i < 4; ++i) d[tid + 256 * i] = g[i];
    if (tid < 16) d[1024 + tid] = g[4];
}
__device__ __forceinline__ void rwkv_seq_step(const P& p, const char* slot, size_t base, int wv, int lane, f32x4 (&X)[4]) {
    const int q = lane >> 4, r = lane & 15;
    const bf16_t* mt = (const bf16_t*)slot; const bf16_t* ntb = (const bf16_t*)(slot + 8192); const float* gc = (const float*)(slot + 16384);
    unsigned xh[4][2];
#pragma unroll
    for (int kt = 0; kt < 4; ++kt) {
        xh[kt][0] = pack2bf(X[kt][0], X[kt][1]); xh[kt][1] = pack2bf(X[kt][2], X[kt][3]);
        *(u32x2*)(p.SN + (base * 64 + 16 * wv + r) * 64 + 16 * kt + 4 * q) = (u32x2){xh[kt][0], xh[kt][1]};
    }
    bf16x8 bh[2];
#pragma unroll
    for (int s2 = 0; s2 < 2; ++s2) bh[s2] = __builtin_bit_cast(bf16x8, ((u32x4){xh[2 * s2][0], xh[2 * s2][1], xh[2 * s2 + 1][0], xh[2 * s2 + 1][1]}));
#pragma unroll
    for (int tile = 0; tile < 4; ++tile) {
        const u32x2 nb = *(const u32x2*)(ntb + ((wv * 4 + tile) * 64 + lane) * 4);
        const f32x4 g4 = *(const f32x4*)(gc + tile * 16 + 4 * q);
        f32x4 acc;
        acc[0] = g4[0] * X[tile][0] + LO16(nb.x); acc[1] = g4[1] * X[tile][1] + HI16(nb.x);
        acc[2] = g4[2] * X[tile][2] + LO16(nb.y); acc[3] = g4[3] * X[tile][3] + HI16(nb.y);
#pragma unroll
        for (int s2 = 0; s2 < 2; ++s2) {
            const bf16x8 ah = *(const bf16x8*)(mt + ((tile * 2 + s2) * 64 + lane) * 8);
            acc = MFMA16(ah, bh[s2], acc);
        }
        X[tile] = acc;
    }
}
__device__ __forceinline__ void rwkv_seq_job(const P& p, int job, char* smem) {
    const int tid = otid(), lane = tid & 63, wv = tid >> 6;
    const int d = job / RH, h = job % RH;
    f32x4 X[4];
#pragma unroll
    for (int kt = 0; kt < 4; ++kt) X[kt] = (f32x4){0.f, 0.f, 0.f, 0.f};
    u32x4 g0[5], g1[5], g2[5];
#define SEQ_BASE(s_) ((size_t)(d * NC + chunk_order(d, ((s_) < NC) ? (s_) : NC - 1)) * RH + h)
    __syncthreads();
    rwkv_seq_gload(p, SEQ_BASE(0), tid, g0);
    rwkv_seq_gload(p, SEQ_BASE(1), tid, g1);
    rwkv_seq_gload(p, SEQ_BASE(2), tid, g2);
    rwkv_seq_lstore(smem, tid, g0);
    __syncthreads();
    for (int s = 0; s < NC; s += 6) {
#define SEQ_SUB(u, GFREE, GNEXT) \
        if (s + (u) < NC) { \
            rwkv_seq_gload(p, SEQ_BASE(s + (u) + 3), tid, GFREE); \
            rwkv_seq_step(p, smem + (((u) & 1) ? SEQ_SLOT : 0), SEQ_BASE(s + (u)), wv, lane, X); \
            rwkv_seq_lstore(smem + (((u) & 1) ? 0 : SEQ_SLOT), tid, GNEXT); \
        } \
        __syncthreads();
        SEQ_SUB(0, g0, g1)
        SEQ_SUB(1, g1, g2)
        SEQ_SUB(2, g2, g0)
        SEQ_SUB(3, g0, g1)
        SEQ_SUB(4, g1, g2)
        SEQ_SUB(5, g2, g0)
#undef SEQ_SUB
    }
#undef SEQ_BASE
}
struct RoBuf { bf16x8 a[2]; bf16x8 b[4][2]; f32x4 y0[4]; };
__device__ __forceinline__ void rwkv_out_load(const P& p, int job, int wv, int lane, RoBuf& o) {
    const int q = lane >> 4, r = lane & 15;
    const size_t base = (size_t)job;
#pragma unroll
    for (int s2 = 0; s2 < 2; ++s2) {
        o.a[s2] = *(const bf16x8*)(p.QH + (base * 64 + 16 * wv + r) * 64 + s2 * 32 + q * 8);
#pragma unroll
        for (int nt = 0; nt < 4; ++nt) o.b[nt][s2] = *(const bf16x8*)(p.SN + (base * 64 + nt * 16 + r) * 64 + s2 * 32 + q * 8);
    }
#pragma unroll
    for (int nt = 0; nt < 4; ++nt) o.y0[nt] = *(const f32x4*)(p.Y0T + (((base * 4 + wv) * 4 + nt) * 64 + lane) * 4);
}
__device__ __forceinline__ void rwkv_out_compute(const P& p, int job, int wv, int lane, const RoBuf& o) {
    const int q = lane >> 4, r = lane & 15;
    const int d = job / (NC * RH), n = (job / RH) % NC, h = job % RH;
#pragma unroll
    for (int nt = 0; nt < 4; ++nt) {
        f32x4 acc = o.y0[nt];
        acc = MFMA16(o.a[0], o.b[nt][0], acc);
        acc = MFMA16(o.a[1], o.b[nt][1], acc);
#pragma unroll
        for (int e = 0; e < 4; ++e) {
            const int t = 16 * wv + 4 * q + e; const int tok = 64 * n + (d ? 63 - t : t);
            p.Y[((size_t)d * MTOT + tok) * RW + h * 64 + nt * 16 + r] = acc[e];
        }
    }
}
__device__ __forceinline__ void phase_rwkv_out(const P& p) {
    const int tid = otid(), lane = tid & 63, wv = tid >> 6;
    if (wv >= 4) return;
    const int G = gridDim.x, total = 2 * NC * RH;
    int job = obid();
    if (job >= total) return;
    RoBuf b0, b1;
    rwkv_out_load(p, job, wv, lane, b0);
    for (; job < total; job += 2 * G) {
        if (job + G < total) rwkv_out_load(p, job + G, wv, lane, b1);
        rwkv_out_compute(p, job, wv, lane, b0);
        if (job + G < total) {
            if (job + 2 * G < total) rwkv_out_load(p, job + 2 * G, wv, lane, b0);
            rwkv_out_compute(p, job + G, wv, lane, b1);
        }
    }
}

#define GL_QR 0
#define GL_KR 9216
#define GL_VT 18432
#define GL_QI 36864
#define GL_KI 46080
#define GL_AT 55296
#define GL_CUM 64512
#define GL_ALR 81920
#define GL_WA 86016
__device__ __forceinline__ void gla_load_qkv(const P& p, int n, int h, char* smem) {
    const int tid = otid();
    bf16_t* Qr = (bf16_t*)(smem + GL_QR); bf16_t* Kr = (bf16_t*)(smem + GL_KR); bf16_t* Vt = (bf16_t*)(smem + GL_VT);
    for (int c = tid; c < 512; c += NTHREADS) {
        const int row = c >> 3, part = c & 7; const int t = gla_tok(n, row);
        const u32x4 qv = *(const u32x4*)(p.Z + (size_t)t * ZLD + ZQ + h * 64 + part * 8);
        const u32x4 kv = *(const u32x4*)(p.Z + (size_t)t * ZLD + ZK + h * 64 + part * 8);
        u32x4 qs;
        qs.x = pack2bf(LO16(qv.x) * 0.125f, HI16(qv.x) * 0.125f);
        qs.y = pack2bf(LO16(qv.y) * 0.125f, HI16(qv.y) * 0.125f);
        qs.z = pack2bf(LO16(qv.z) * 0.125f, HI16(qv.z) * 0.125f);
        qs.w = pack2bf(LO16(qv.w) * 0.125f, HI16(qv.w) * 0.125f);
        *(u32x4*)(Qr + row * CH_ROW + part * 8) = qs;
        *(u32x4*)(Kr + row * CH_ROW + part * 8) = kv;
    }
    for (int c = tid; c < 1024; c += NTHREADS) {
        const int row = c >> 4, part = c & 15; const int t = gla_tok(n, row);
        const u32x4 vv = *(const u32x4*)(p.Z + (size_t)t * ZLD + ZV + h * 128 + part * 8);
        bf16_t* dst = Vt + (part * 8) * CH_ROW + row;
        dst[0 * CH_ROW] = (bf16_t)(vv.x & 0xFFFF); dst[1 * CH_ROW] = (bf16_t)(vv.x >> 16);
        dst[2 * CH_ROW] = (bf16_t)(vv.y & 0xFFFF); dst[3 * CH_ROW] = (bf16_t)(vv.y >> 16);
        dst[4 * CH_ROW] = (bf16_t)(vv.z & 0xFFFF); dst[5 * CH_ROW] = (bf16_t)(vv.z >> 16);
        dst[6 * CH_ROW] = (bf16_t)(vv.w & 0xFFFF); dst[7 * CH_ROW] = (bf16_t)(vv.w >> 16);
    }
}
__device__ __forceinline__ void gla_cum(const P& p, int l, int n, int h, int d, char* smem) {
    const int tid = otid();
    float* CUM = (float*)(smem + GL_CUM); float* ALR = (float*)(smem + GL_ALR); float* WA = (float*)(smem + GL_WA);
    for (int c = tid; c < 256; c += NTHREADS) {
        const int row = c >> 2, part = c & 3; const int t = gla_tok(n, row);
        const u32x2 a = *(const u32x2*)(p.Z + (size_t)t * ZLD + (d ? ZAB : ZAF) + part * 4);
        float* dst = ALR + row * 16 + part * 4;
        dst[0] = LO16(a.x); dst[1] = HI16(a.x); dst[2] = LO16(a.y); dst[3] = HI16(a.y);
    }
    for (int c = tid; c < 16 * 64 + 64; c += NTHREADS) {
        if (c < 1024) WA[c] = p.in[I_GLA_WA2][((size_t)(l * 2 + d) * 16 + (c >> 6)) * GLA_K + h * 64 + (c & 63)];
        else WA[c] = p.in[I_GLA_BA][(size_t)(l * 2 + d) * GLA_K + h * 64 + (c - 1024)];
    }
    __syncthreads();
    for (int idx = tid; idx < 4096; idx += NTHREADS) {
        const int i = idx >> 6, k = idx & 63;
        float a = WA[1024 + k];
#pragma unroll
        for (int r = 0; r < 16; ++r) a += ALR[i * 16 + r] * WA[r * 64 + k];
        CUM[i * 68 + k] = (fminf(a, 0.f) - flog_(1.0f + fexp_(-fabsf(a)))) * (1.0f / 16.0f);
    }
    __syncthreads();
    {
        const int k = tid & 63, seg = (tid >> 6) & 3;
        float v[16]; float run = 0.f;
        if (tid < 256) {
#pragma unroll
            for (int e = 0; e < 16; ++e) { const int pos = seg * 16 + e; const int i = d ? 63 - pos : pos; run += CUM[i * 68 + k]; v[e] = run; }
            ALR[seg * 64 + k] = run;
        }
        __syncthreads();
        if (tid < 256) {
            float off = 0.f;
            for (int s2 = 0; s2 < seg; ++s2) off += ALR[s2 * 64 + k];
#pragma unroll
            for (int e = 0; e < 16; ++e) { const int pos = seg * 16 + e; const int i = d ? 63 - pos : pos; CUM[i * 68 + k] = v[e] + off; }
        }
    }
    __syncthreads();
}
__device__ __forceinline__ void phase_gla_kv(const P& p, int l, char* smem) {
    const int tid = otid(), lane = tid & 63, wv = tid >> 6, q = lane >> 4, r = lane & 15;
    bf16_t* Kr = (bf16_t*)(smem + GL_KR); bf16_t* Vt = (bf16_t*)(smem + GL_VT); bf16_t* KdT = (bf16_t*)(smem + GL_KI);
    float* CUM = (float*)(smem + GL_CUM);
    for (int job = obid(); job < NC * GH; job += gridDim.x) {
        const int n = job / GH, h = job % GH;
        __syncthreads();
        gla_load_qkv(p, n, h, smem);
        for (int d = 0; d < 2; ++d) {
            gla_cum(p, l, n, h, d, smem);
            const int li = d ? 0 : 63;
            for (int idx = tid; idx < 4096; idx += NTHREADS) {
                const int i = idx >> 6, k = idx & 63;
                KdT[k * CH_ROW + i] = f2bf(bf2f(Kr[i * CH_ROW + k]) * fexp_(CUM[li * 68 + k] - CUM[i * 68 + k]));
            }
            if (tid < 64) p.DEC[((size_t)(d * NC + n) * GH + h) * 64 + tid] = fexp_(CUM[li * 68 + tid]);
            __syncthreads();
            float* kvt = p.KV + ((size_t)(d * NC + n) * GH + h) * 8192;
            for (int mt = wv; mt < 4; mt += NTHREADS / 64) {
                f32x4 acc[1][8];
#pragma unroll
                for (int nt = 0; nt < 8; ++nt) acc[0][nt] = (f32x4){0.f, 0.f, 0.f, 0.f};
                lds_mm<1, 8>(KdT, 16 * mt, Vt, 0, acc);
#pragma unroll
                for (int nt = 0; nt < 8; ++nt) *(f32x4*)(kvt + (size_t)(nt * 16 + r) * 64 + 16 * mt + 4 * q) = acc[0][nt];
            }
            __syncthreads();
        }
    }
    __syncthreads();
}
__device__ __forceinline__ void gla_scan_job(const P& p, int job) {
    const int base = job * NTHREADS + otid();
    const int d = base / (GH * 8192), h = (base / 8192) % GH, e = base % 8192;
    const float* __restrict__ kvp = p.KV; const float* __restrict__ decp = p.DEC; bf16_t* __restrict__ sp = p.SP;
    float S = 0.f;
    for (int s = 0; s < NC; s += 4) {
        float kv[4], dc[4]; size_t oo[4];
#pragma unroll
        for (int u = 0; u < 4; ++u) {
            const int n = chunk_order(d, (s + u < NC) ? s + u : NC - 1);
            oo[u] = ((size_t)(d * NC + n) * GH + h);
            kv[u] = kvp[oo[u] * 8192 + e]; dc[u] = decp[oo[u] * 64 + (e & 63)];
        }
#pragma unroll
        for (int u = 0; u < 4; ++u) if (s + u < NC) { sp[oo[u] * 8192 + e] = f2bf(S); S = dc[u] * S + kv[u]; }
    }
}
__device__ __forceinline__ void phase_gla_out(const P& p, int l, char* smem) {
    const int tid = otid(), lane = tid & 63, wv = tid >> 6, q = lane >> 4, r = lane & 15;
    bf16_t* Qr = (bf16_t*)(smem + GL_QR); bf16_t* Kr = (bf16_t*)(smem + GL_KR); bf16_t* Vt = (bf16_t*)(smem + GL_VT);
    bf16_t* Qi = (bf16_t*)(smem + GL_QI); bf16_t* Ki = (bf16_t*)(smem + GL_KI); bf16_t* At = (bf16_t*)(smem + GL_AT);
    float* CUM = (float*)(smem + GL_CUM);
    for (int job = obid(); job < NC * GH; job += gridDim.x) {
        const int n = job / GH, h = job % GH;
        __syncthreads();
        gla_load_qkv(p, n, h, smem);
        f32x4 o[1][8];
#pragma unroll
        for (int nt = 0; nt < 8; ++nt) o[0][nt] = (f32x4){0.f, 0.f, 0.f, 0.f};
        for (int d = 0; d < 2; ++d) {
            gla_cum(p, l, n, h, d, smem);
            for (int idx = tid; idx < 4096; idx += NTHREADS) {
                const int i = idx >> 6, k = idx & 63; const float c = CUM[i * 68 + k];
                Qi[i * CH_ROW + k] = f2bf(bf2f(Qr[i * CH_ROW + k]) * fexp_(c));
                Ki[i * CH_ROW + k] = f2bf(bf2f(Kr[i * CH_ROW + k]) * fexp_(-c));
            }
            __syncthreads();
            if (wv < 4) {
                f32x4 a[1][4];
#pragma unroll
                for (int nt = 0; nt < 4; ++nt) a[0][nt] = (f32x4){0.f, 0.f, 0.f, 0.f};
                lds_mm<1, 4>(Qi, 16 * wv, Ki, 0, a);
#pragma unroll
                for (int nt = 0; nt < 4; ++nt)
#pragma unroll
                    for (int e = 0; e < 4; ++e) {
                        const int i = 16 * wv + 4 * q + e, j = nt * 16 + r;
                        const bool ok = d ? (j >= i) : (j <= i);
                        At[i * CH_ROW + j] = f2bf(ok ? a[0][nt][e] : 0.f);
                    }
                WAVE_SYNC();
                lds_mm<1, 8>(At, 16 * wv, Vt, 0, o);
                const bf16_t* sp = p.SP + ((size_t)(d * NC + n) * GH + h) * 8192;
#pragma unroll
                for (int s2 = 0; s2 < 2; ++s2) {
                    const bf16x8 af = *(const bf16x8*)(Qi + (16 * wv + r) * CH_ROW + s2 * 32 + q * 8);
#pragma unroll
                    for (int nt = 0; nt < 8; ++nt) {
                        const bf16x8 bfr = *(const bf16x8*)(sp + (size_t)(nt * 16 + r) * 64 + s2 * 32 + q * 8);
                        o[0][nt] = MFMA16(af, bfr, o[0][nt]);
                    }
                }
            }
            __syncthreads();
        }
        if (wv < 4) {
#pragma unroll
            for (int nt = 0; nt < 8; ++nt)
#pragma unroll
                for (int e = 0; e < 4; ++e) {
                    const int t = gla_tok(n, 16 * wv + 4 * q + e);
                    p.OGLA[(size_t)t * GLA_V + h * 128 + nt * 16 + r] = o[0][nt][e];
                }
        }
    }
    __syncthreads();
}

#define S5_XH_OFF (2 * 64 * 132 * 4)
#define S5_XL_OFF (S5_XH_OFF + 64 * 136 * 2)
#define S5_CT_OFF (S5_XL_OFF + 64 * 136 * 2)
__device__ __forceinline__ void phase_s5_pass(const P& p, int l, char* smem, bool with_out) {
    const int tid = otid(), lane = tid & 63, wv = tid >> 6, q = lane >> 4, r = lane & 15;
    float* BU = (float*)smem; bf16_t* XH = (bf16_t*)(smem + S5_XH_OFF); bf16_t* XL = (bf16_t*)(smem + S5_XL_OFF); bf16_t* CTp = (bf16_t*)(smem + S5_CT_OFF);
    const int dW = (wv >> 1) & 1, ntb = (wv & 1) * 4;
    const int dS = (tid >> 6) & 1, st = tid & 63;
    bf16x8 bhi[4], blo[4];
    float are = 0.f, aim = 0.f, dco = 0.f;
    int cur_g = -1;
    const bf16x8 zero8 = {0, 0, 0, 0, 0, 0, 0, 0};
    bf16x8 a_cur[4]; float2 car_cur = {0.f, 0.f};
#define S5_FETCH(JOB, A, CAR) { const int n_ = (JOB) / SG, g_ = (JOB) % SG; \
        if (wv < 4) { _Pragma("unroll") for (int mt = 0; mt < 4; ++mt) A[mt] = (q < 2) ? *(const bf16x8*)(p.Z + (size_t)(n_ * 64 + 16 * mt + r) * ZLD + ZS5 + g_ * 16 + 8 * q) : zero8; } \
        if (with_out && tid < 128) CAR = *(const float2*)(p.S5CAR + ((((size_t)dS * NC + n_) * SG + g_) * 64 + st) * 2); }
    if (obid() < NC * SG) S5_FETCH(obid(), a_cur, car_cur);
    for (int job = obid(); job < NC * SG; job += gridDim.x) {
        const int n = job / SG, g = job % SG;
        __syncthreads();
        if (g != cur_g) {
            cur_g = g;
            if (wv < 4) {
#pragma unroll
                for (int jn = 0; jn < 4; ++jn) {
                    const int kk = 16 * (ntb + jn) + r; const size_t ci = ((size_t)dW * SG + g) * 64 + (kk >> 1);
                    float f[8], lo[8];
#pragma unroll
                    for (int e = 0; e < 8; ++e) f[e] = (q < 2) ? p.S5BB[(ci * 16 + 8 * q + e) * 2 + (kk & 1)] : 0.f;
                    const u32x4 hv = pack8(f);
                    float hf[8]; unpack8(hv, hf);
#pragma unroll
                    for (int e = 0; e < 8; ++e) lo[e] = f[e] - hf[e];
                    bhi[jn] = __builtin_bit_cast(bf16x8, hv); blo[jn] = __builtin_bit_cast(bf16x8, pack8(lo));
                }
            }
            if (tid < 128) { const size_t ci = ((size_t)dS * SG + g) * 64 + st; are = p.S5A[ci * 2]; aim = p.S5A[ci * 2 + 1]; }
            if (with_out) {
                for (int idx = tid; idx < 16 * 128; idx += NTHREADS) {
                    const int c = idx >> 7, kk = idx & 127;
                    const float v = (kk & 1) ? -p.in[I_S5CIM][((size_t)l * SG + g) * 1024 + c * 64 + (kk >> 1)] : p.in[I_S5CRE][((size_t)l * SG + g) * 1024 + c * 64 + (kk >> 1)];
                    CTp[c * 136 + kk] = f2bf(v);
                }
                dco = p.in[I_S5D][(size_t)l * SW + g * 16 + r];
            }
        }
        float xr = car_cur.x, xi = car_cur.y;
        const size_t eo = (((size_t)dS * NC + n) * SG + g) * 64 + st;
        unsigned short uu[4] = {0, 0, 0, 0};
        if (with_out && wv < 4) {
#pragma unroll
            for (int e = 0; e < 4; ++e) uu[e] = p.Z[(size_t)(n * 64 + 16 * wv + 4 * q + e) * ZLD + ZS5 + g * 16 + r];
        }
        if (wv < 4) {
#pragma unroll
            for (int mt = 0; mt < 4; ++mt) {
                const bf16x8 a = a_cur[mt];
#pragma unroll
                for (int jn = 0; jn < 4; ++jn) {
                    f32x4 acc = {0.f, 0.f, 0.f, 0.f};
                    acc = MFMA16(a, bhi[jn], acc);
                    acc = MFMA16(a, blo[jn], acc);
#pragma unroll
                    for (int e = 0; e < 4; ++e) BU[(dW * 64 + 16 * mt + 4 * q + e) * 132 + 16 * (ntb + jn) + r] = acc[e];
                }
            }
        }
        if (job + (int)gridDim.x < NC * SG) S5_FETCH(job + (int)gridDim.x, a_cur, car_cur);
        __syncthreads();
        if (tid < 128) {
#pragma unroll 8
            for (int ii = 0; ii < 64; ++ii) {
                const int i = dS ? 63 - ii : ii;
                float2* bp = (float2*)(BU + (dS * 64 + i) * 132 + st * 2);
                const float2 b = *bp;
                const float nr = are * xr - aim * xi + b.x, ni = are * xi + aim * xr + b.y;
                xr = nr; xi = ni;
                if (with_out) { float2 o; o.x = xr; o.y = xi; *bp = o; }
            }
            if (!with_out) { float2 o; o.x = xr; o.y = xi; *(float2*)(p.S5END + eo * 2) = o; }
        }
        if (with_out) {
            __syncthreads();
            for (int cidx = tid; cidx < 64 * 16; cidx += NTHREADS) {
                const int i = cidx >> 4, k0 = (cidx & 15) * 8;
                float a[8], b[8], lo[8];
                load8f(BU + (0 * 64 + i) * 132 + k0, a); load8f(BU + (1 * 64 + i) * 132 + k0, b);
#pragma unroll
                for (int e = 0; e < 8; ++e) a[e] += b[e];
                const u32x4 hv = pack8(a);
                float hf[8]; unpack8(hv, hf);
#pragma unroll
                for (int e = 0; e < 8; ++e) lo[e] = a[e] - hf[e];
                *(u32x4*)(XH + i * 136 + k0) = hv; *(u32x4*)(XL + i * 136 + k0) = pack8(lo);
            }
            __syncthreads();
            if (wv < 4) {
                f32x4 acc = {0.f, 0.f, 0.f, 0.f};
#pragma unroll
                for (int ks = 0; ks < 4; ++ks) {
                    const bf16x8 ah = *(const bf16x8*)(XH + (16 * wv + r) * 136 + ks * 32 + q * 8), al = *(const bf16x8*)(XL + (16 * wv + r) * 136 + ks * 32 + q * 8);
                    const bf16x8 b = *(const bf16x8*)(CTp + r * 136 + ks * 32 + q * 8);
                    acc = MFMA16(ah, b, acc);
                    acc = MFMA16(al, b, acc);
                }
#pragma unroll
                for (int e = 0; e < 4; ++e) {
                    const int i = 16 * wv + 4 * q + e;
                    const float u = bf2f(uu[e]);
                    p.GY[(size_t)(n * 64 + i) * SW + g * 16 + r] = f2bf(geluf_(acc[e] + dco * u));
                }
            }
        }
    }
    __syncthreads();
}
__device__ __forceinline__ void s5_carry_job(const P& p, int job) {
    const int base = job * NTHREADS + otid();
    if (base >= 2 * SG * 64) return;
    const int d = base / (SG * 64), g = (base / 64) % SG, st = base % 64;
    const size_t ci = ((size_t)d * SG + g) * 64 + st;
    float ar = p.S5A[ci * 2], ai = p.S5A[ci * 2 + 1];
    for (int i = 0; i < 6; ++i) { const float nr = ar * ar - ai * ai, ni = 2.f * ar * ai; ar = nr; ai = ni; }
    const float2* __restrict__ endp = (const float2*)p.S5END; float2* __restrict__ carp = (float2*)p.S5CAR;
    float cr = 0.f, cim = 0.f;
    for (int s = 0; s < NC; s += 4) {
        float2 ev[4]; size_t eo[4];
#pragma unroll
        for (int u = 0; u < 4; ++u) {
            const int n = chunk_order(d, (s + u < NC) ? s + u : NC - 1);
            eo[u] = (((size_t)d * NC + n) * SG + g) * 64 + st;
            ev[u] = endp[eo[u]];
        }
#pragma unroll
        for (int u = 0; u < 4; ++u) if (s + u < NC) {
            float2 c; c.x = cr; c.y = cim; carp[eo[u]] = c;
            const float nr = ar * cr - ai * cim + ev[u].x, ni = ar * cim + ai * cr + ev[u].y;
            cr = nr; cim = ni;
        }
    }
}

__device__ __forceinline__ void phase_side_elem(const P& p, int l) {
    const int lane = otid() & 63;
    const int gw = (obid() * NTHREADS + otid()) >> 6, nw = (gridDim.x * NTHREADS) >> 6;
    const bool actg = lane * 8 < GLA_V, actr = lane * 8 < RW;
    float gng[8], lnw[8], lnb[8];
#pragma unroll
    for (int e = 0; e < 8; ++e) { gng[e] = 0.f; lnw[e] = 0.f; lnb[e] = 0.f; }
    if (actg) load8f(p.in[I_GLA_NG] + (size_t)l * 128 + ((lane * 8) & 127), gng);
    if (actr) { load8f(p.in[I_RLNW] + (size_t)l * RW + lane * 8, lnw); load8f(p.in[I_RLNB] + (size_t)l * RW + lane * 8, lnb); }
    for (int t = gw; t < MTOT; t += nw) {
        float og[8], zo[8], y0[8], y1[8], vv[8];
        const u32x4 z4 = {0u, 0u, 0u, 0u};
#pragma unroll
        for (int e = 0; e < 8; ++e) { og[e] = 0.f; y0[e] = 0.f; y1[e] = 0.f; }
        if (actg) load8f(p.OGLA + (size_t)t * GLA_V + lane * 8, og);
        unpack8(actg ? *(const u32x4*)(p.Z + (size_t)t * ZLD + ZOG + lane * 8) : z4, zo);
        if (actr) { load8f(p.Y + (size_t)t * RW + lane * 8, y0); load8f(p.Y + ((size_t)MTOT + t) * RW + lane * 8, y1); }
        unpack8(actr ? *(const u32x4*)(p.V + (size_t)t * RW + lane * 8) : z4, vv);
        const int hh = (lane * 8) >> 6;
        const float bon = actr ? (p.BONUS[(size_t)t * RH + hh] + p.BONUS[((size_t)MTOT + t) * RH + hh]) : 0.f;
        float ss = 0.f;
#pragma unroll
        for (int e = 0; e < 8; ++e) ss += og[e] * og[e];
        ss += __shfl_xor(ss, 1, 64); ss += __shfl_xor(ss, 2, 64); ss += __shfl_xor(ss, 4, 64); ss += __shfl_xor(ss, 8, 64);
        const float rstd = rsqrtf(ss * (1.0f / 128.f) + 1e-6f);
        float br[8];
#pragma unroll
        for (int e = 0; e < 8; ++e) br[e] = og[e] * rstd * gng[e] * siluf_(zo[e]);
        if (actg) *(u32x4*)(p.BR + (size_t)t * 3 * BW + lane * 8) = pack8(br);
        float y[8]; float sm = 0.f;
#pragma unroll
        for (int e = 0; e < 8; ++e) { y[e] = y0[e] + y1[e]; sm += y[e]; }
        sm += __shfl_xor(sm, 1, 64); sm += __shfl_xor(sm, 2, 64); sm += __shfl_xor(sm, 4, 64);
        const float mu = sm * (1.0f / 64.f);
        float sv = 0.f;
#pragma unroll
        for (int e = 0; e < 8; ++e) { y[e] -= mu; sv += y[e] * y[e]; }
        sv += __shfl_xor(sv, 1, 64); sv += __shfl_xor(sv, 2, 64); sv += __shfl_xor(sv, 4, 64);
        const float rs = rsqrtf(sv * (1.0f / 64.f) + 64e-5f);
        float yn[8];
#pragma unroll
        for (int e = 0; e < 8; ++e) yn[e] = y[e] * rs * lnw[e] + lnb[e] + bon * vv[e];
        if (actr) store8f(p.YN + (size_t)t * RW + lane * 8, yn);
    }
}

__device__ __forceinline__ void phase_side_gemm(const P& p, int l, char* smem) {
    gemm_phase<4>(p.WT_G2, 128, (size_t)NPAD(RW) * 128 * 2, p.GS, 128, (size_t)MTOT * 128 * 2, 128, NPAD(RW), (bf16_t*)smem, NoPre(), NoPre(),
        [&](int, int, int m, int n, const f32x4 v) {
            if (n < RW) { const float4 y = *(const float4*)(p.YN + (size_t)m * RW + n);
                *(u32x2*)(p.BR + (size_t)m * 3 * BW + BW + n) = pack4(y.x * v[0], y.y * v[1], y.z * v[2], y.w * v[3]); }
        });
    gemm_phase<4>(p.WT_GLU, SW, (size_t)NPAD(2 * SW) * SW * 2, p.GY, SW, (size_t)MTOT * SW * 2, SW, 2 * SW, (bf16_t*)smem, NoPre(), NoPre(),
        [&](int, int, int m, int n, const f32x4 v) {
            *(unsigned*)(p.BR + (size_t)m * 3 * BW + 2 * BW + (n >> 1)) = pack2bf(v[0] * sigmoidf_(v[1]), v[2] * sigmoidf_(v[3]));
        });
}

__device__ __forceinline__ void phase_merge(const P& p, int l, char* smem) {
    const int ntn = D_MODEL / 128, ntm = (MTOT - 256) / 128;
    auto run = [&](auto mi_tag, int n0, int m0) {
        constexpr int MI = decltype(mi_tag)::value;
        f32x4 macc[4][MI];
#pragma unroll
        for (int i = 0; i < 4; ++i)
#pragma unroll
            for (int j = 0; j < MI; ++j) macc[i][j] = (f32x4){0.f, 0.f, 0.f, 0.f};
        const int lane = otid() & 63, wave = otid() >> 6;
        for (int b = 0; b < 3; ++b) {
            f32x4 acc[4][MI];
#pragma unroll
            for (int i = 0; i < 4; ++i)
#pragma unroll
                for (int j = 0; j < MI; ++j) acc[i][j] = (f32x4){0.f, 0.f, 0.f, 0.f};
            mfma_gemm_tile_t<4, MI>(p.WT_BR + (size_t)b * D_MODEL * BW, BW, (size_t)D_MODEL * BW * 2, p.BR + b * BW, 3 * BW, (size_t)MTOT * 3 * BW * 2 - b * BW * 2, BW, n0, m0, (bf16_t*)smem, acc);
#pragma unroll
            for (int ni = 0; ni < 4; ++ni)
#pragma unroll
                for (int mi = 0; mi < MI; ++mi) {
                    const int n = n0 + (wave >> 1) * 64 + ni * 16 + (lane >> 4) * 4, m = m0 + (wave & 1) * 16 * MI + mi * 16 + (lane & 15);
                    const u32x2 g = *(const u32x2*)(p.ZGT + ((((size_t)(m >> 4) * (3 * D_MODEL / 16) + ((b * D_MODEL + n) >> 4)) * 64 + lane) * 4));
                    macc[ni][mi][0] += LO16(g.x) * acc[ni][mi][0]; macc[ni][mi][1] += HI16(g.x) * acc[ni][mi][1];
                    macc[ni][mi][2] += LO16(g.y) * acc[ni][mi][2]; macc[ni][mi][3] += HI16(g.y) * acc[ni][mi][3];
                }
        }
#pragma unroll
        for (int ni = 0; ni < 4; ++ni)
#pragma unroll
            for (int mi = 0; mi < MI; ++mi) {
                const int n = n0 + (wave >> 1) * 64 + ni * 16 + (lane >> 4) * 4, m = m0 + (wave & 1) * 16 * MI + mi * 16 + (lane & 15);
                *(u32x2*)(p.M + (size_t)m * D_MODEL + n) = pack4(macc[ni][mi][0], macc[ni][mi][1], macc[ni][mi][2], macc[ni][mi][3]);
            }
    };
    for (int it = 0;; ++it) {
        int mt_, nt_; if (!tile_map(it, ntm, ntn, (ntn >= 8) ? 4 : 8, mt_, nt_)) break;
        run(std::integral_constant<int, 4>(), nt_ * 128, mt_ * 128);
    }
    for (int job = obid(); job < 4 * ntn; job += gridDim.x) run(std::integral_constant<int, 2>(), (job >> 2) * 128, MTOT - 256 + (job & 3) * 64);
}

__device__ __forceinline__ void phase_outproj(const P& p, int l, char* smem) {
    gemm_phase<4>(p.WT_OUT, D_MODEL, (size_t)D_MODEL * D_MODEL * 2, p.M, D_MODEL, (size_t)MTOT * D_MODEL * 2, D_MODEL, D_MODEL, (bf16_t*)smem, NoPre(), NoPre(),
        [&](int, int, int m, int n, const f32x4 v) {
            const float* g1 = p.MOD + (size_t)(l * 2 + (m >= CTX ? 1 : 0)) * 6 * D_MODEL + 2 * D_MODEL + n;
            float4* xp = (float4*)(p.X + (size_t)m * D_MODEL + n); float4 x = *xp;
            x.x += g1[0] * v[0]; x.y += g1[1] * v[1]; x.z += g1[2] * v[2]; x.w += g1[3] * v[3]; *xp = x;
        });
}

__device__ __forceinline__ void store_q_hilo(const P& p, int m, int n, const f32x4 v) {
    const bf16_t h0 = f2bf(v[0]), h1 = f2bf(v[1]), h2 = f2bf(v[2]), h3 = f2bf(v[3]);
    u32x2 hv; hv.x = (unsigned)h0 | ((unsigned)h1 << 16); hv.y = (unsigned)h2 | ((unsigned)h3 << 16);
    *(u32x2*)(p.QHI + (size_t)m * PQ + n) = hv;
    *(u32x2*)(p.QLO + (size_t)m * PQ + n) = pack4(v[0] - bf2f(h0), v[1] - bf2f(h1), v[2] - bf2f(h2), v[3] - bf2f(h3));
}
__device__ __forceinline__ void phase_peer_q(const P& p, int l, char* smem) {
    gemm_phase<4>(p.WT_Q, D_MODEL, (size_t)PQ * D_MODEL * 2, p.H, D_MODEL, (size_t)MTOT * D_MODEL * 2, D_MODEL, PQ, (bf16_t*)smem, NoPre(), NoPre(),
        [&](int, int, int m, int n, const f32x4 v) { store_q_hilo(p, m, n, v); });
}

#define TK_ROW 129
__device__ __forceinline__ unsigned tk_key(float f, unsigned lowmask, unsigned low) {
    unsigned u = __builtin_bit_cast(unsigned, f);
    u ^= (u & 0x80000000u) ? 0xFFFFFFFFu : 0x80000000u;
    return (u & ~lowmask) | low;
}
#define TK_INSERT(lv, xk) { unsigned x_ = (xk); _Pragma("unroll") for (int z_ = 0; z_ < 16; ++z_) { const unsigned hi_ = lv[z_] > x_ ? lv[z_] : x_; x_ = lv[z_] > x_ ? x_ : lv[z_]; lv[z_] = hi_; } }
__device__ __forceinline__ void phase_peer_topk(const P& p, int l, char* smem) {
    const int tid = otid(), lane = tid & 63, wv = tid >> 6, q = lane >> 4, r = lane & 15;
    float* sc = (float*)smem + wv * (64 * TK_ROW);
    const int gw = (obid() * NTHREADS + tid) >> 6, nw = (gridDim.x * NTHREADS) >> 6;
    const float NEG = -3.0e38f;
    for (int job = gw; job < (MTOT / 32) * PH; job += nw) {
        const int t0 = (job / PH) * 32, h = job % PH;
#pragma unroll
        for (int sd = 0; sd < 2; ++sd) {
            f32x4 acc[2][8];
#pragma unroll
            for (int mt = 0; mt < 2; ++mt)
#pragma unroll
                for (int nt = 0; nt < 8; ++nt) acc[mt][nt] = (f32x4){0.f, 0.f, 0.f, 0.f};
#pragma unroll
            for (int ks = 0; ks < 4; ++ks) {
                bf16x8 ah[2], al[2];
#pragma unroll
                for (int mt = 0; mt < 2; ++mt) {
                    const size_t qo = (size_t)(t0 + mt * 16 + r) * PQ + h * 256 + sd * 128 + ks * 32 + q * 8;
                    ah[mt] = *(const bf16x8*)(p.QHI + qo); al[mt] = *(const bf16x8*)(p.QLO + qo);
                }
#pragma unroll
                for (int nt = 0; nt < 8; ++nt) {
                    const size_t ko = ((size_t)(h * 2 + sd) * 128 + nt * 16 + r) * 128 + ks * 32 + q * 8;
                    const bf16x8 bh = *(const bf16x8*)(p.KHI + ko), bl = *(const bf16x8*)(p.KLO + ko);
#pragma unroll
                    for (int mt = 0; mt < 2; ++mt) {
                        acc[mt][nt] = MFMA16(ah[mt], bh, acc[mt][nt]);
                        acc[mt][nt] = MFMA16(al[mt], bh, acc[mt][nt]);
                        acc[mt][nt] = MFMA16(ah[mt], bl, acc[mt][nt]);
                    }
                }
            }
#pragma unroll
            for (int mt = 0; mt < 2; ++mt)
#pragma unroll
                for (int nt = 0; nt < 8; ++nt)
#pragma unroll
                    for (int e = 0; e < 4; ++e) sc[(sd * 32 + mt * 16 + 4 * q + e) * TK_ROW + nt * 16 + r] = acc[mt][nt][e];
        }
        WAVE_SYNC();
        unsigned lv[16];
#pragma unroll
        for (int z = 0; z < 16; ++z) lv[z] = 0u;
        {
            const float* row = sc + lane * TK_ROW;
#pragma unroll 4
            for (int k = 0; k < 128; ++k) TK_INSERT(lv, tk_key(row[k], 0x7Fu, (unsigned)(127 - k)));
        }
        float lvv[16]; int li[16];
        {
            const float* row = sc + lane * TK_ROW;
#pragma unroll
            for (int z = 0; z < 16; ++z) { li[z] = 127 - (int)(lv[z] & 0x7Fu); lvv[z] = row[li[z]]; }
        }
        WAVE_SYNC();
        {
            float* row = sc + lane * TK_ROW;
#pragma unroll
            for (int z = 0; z < 16; ++z) { row[z] = lvv[z]; ((int*)row)[16 + z] = li[z]; }
        }
        WAVE_SYNC();
        const float* r1 = sc + (lane & 31) * TK_ROW; const float* r2 = sc + (32 + (lane & 31)) * TK_ROW;
        unsigned tk[16];
#pragma unroll
        for (int z = 0; z < 16; ++z) tk[z] = 0u;
        for (int i = 0; i < 16; ++i) {
            const float a = r1[i];
            const int nj = 16 / (i + 1);
            for (int j = 0; j < nj; ++j) TK_INSERT(tk, tk_key(a + r2[j], 0xFFu, (unsigned)(255 - (i * 16 + j))));
        }
        int tc[16];
#pragma unroll
        for (int z = 0; z < 16; ++z) tc[z] = 255 - (int)(tk[z] & 0xFFu);
        if (lane < 32) {
            float vals[16]; float mx = 0.f; float ssum = 0.f;
#pragma unroll
            for (int z = 0; z < 16; ++z) { vals[z] = r1[tc[z] >> 4] + r2[tc[z] & 15]; if (z == 0) mx = vals[0]; vals[z] = fexp_(vals[z] - mx); ssum += vals[z]; }
            const float inv = 1.0f / ssum;
            const size_t o = (size_t)(t0 + lane) * PH * 16 + h * 16;
#pragma unroll
            for (int z = 0; z < 16; ++z) {
                const int ex_ = ((const int*)r1)[16 + (tc[z] >> 4)] * 128 + ((const int*)r2)[16 + (tc[z] & 15)];
                p.IDX[o + z] = ex_;
                p.G[o + z] = vals[z] * inv * p.VSC[ex_];
                p.GU[o + z] = p.USC[ex_];
            }
        }
        WAVE_SYNC();
    }
}

#define PEER_CONV_JOBS (2 * NEXP / 4)
__device__ __forceinline__ void peer_conv_job(const P& p, int l, int job) {
    const int tid = otid(), lane = tid & 63, wv = tid >> 6;
    if (wv >= 4) return;
    const int rowg = job * 4 + wv; const int which = rowg / NEXP, row = rowg % NEXP;
    const float* src = p.in[which ? I_PV : I_PU] + ((size_t)l * NEXP + row) * D_MODEL + lane * 16;
    const bool act = lane * 16 < D_MODEL;
    float v[16]; float amax = 0.f;
#pragma unroll
    for (int c = 0; c < 4; ++c) {
        float4 a; a.x = 0.f; a.y = 0.f; a.z = 0.f; a.w = 0.f;
        if (act) a = *(const float4*)(src + c * 4);
        v[c * 4 + 0] = a.x; v[c * 4 + 1] = a.y; v[c * 4 + 2] = a.z; v[c * 4 + 3] = a.w;
        amax = fmaxf(amax, fmaxf(fmaxf(fabsf(a.x), fabsf(a.y)), fmaxf(fabsf(a.z), fabsf(a.w))));
    }
#pragma unroll
    for (int m = 32; m >= 1; m >>= 1) amax = fmaxf(amax, __shfl_xor(amax, m, 64));
    int ex = 0;
    if (amax > 0.f) ex = 7 - (int)((__builtin_bit_cast(unsigned, amax) >> 23) & 0xFF) + 127;
    ex = ex < -100 ? -100 : (ex > 100 ? 100 : ex);
    const float sc = __builtin_bit_cast(float, (unsigned)(ex + 127) << 23), isc = __builtin_bit_cast(float, (unsigned)(127 - ex) << 23);
    u32x4 o;
    int w0 = 0, w1 = 0, w2 = 0, w3 = 0;
    w0 = CVT_PK_FP8(v[0] * sc, v[1] * sc, w0, false); w0 = CVT_PK_FP8(v[2] * sc, v[3] * sc, w0, true);
    w1 = CVT_PK_FP8(v[4] * sc, v[5] * sc, w1, false); w1 = CVT_PK_FP8(v[6] * sc, v[7] * sc, w1, true);
    w2 = CVT_PK_FP8(v[8] * sc, v[9] * sc, w2, false); w2 = CVT_PK_FP8(v[10] * sc, v[11] * sc, w2, true);
    w3 = CVT_PK_FP8(v[12] * sc, v[13] * sc, w3, false); w3 = CVT_PK_FP8(v[14] * sc, v[15] * sc, w3, true);
    o.x = (unsigned)w0; o.y = (unsigned)w1; o.z = (unsigned)w2; o.w = (unsigned)w3;
    unsigned char* dst = (which ? p.V8 : p.U8) + (size_t)row * D_MODEL + lane * 16;
    if (act) *(u32x4*)dst = o;
    if (lane == 0) (which ? p.VSC : p.USC)[row] = isc;
}
#define GE 4
struct GBuf { u32x4 u[GE]; u32x4 v[GE]; float gu; float gv; };
__device__ __forceinline__ void gather_load(const P& p, GBuf& b, int g, int idx0, int idx1, float g0, float g1, float u0, float u1, int lane) {
    const bool act = lane * 16 < D_MODEL;
#pragma unroll
    for (int q = 0; q < GE; ++q) {
        const int k = g * GE + q;
        const int ei = __shfl((k < 64) ? idx0 : idx1, k & 63, 64);
        b.u[q] = act ? *(const u32x4*)(p.U8 + (size_t)ei * D_MODEL + lane * 16) : (u32x4){0u, 0u, 0u, 0u};
        b.v[q] = act ? *(const u32x4*)(p.V8 + (size_t)ei * D_MODEL + lane * 16) : (u32x4){0u, 0u, 0u, 0u};
    }
    const int km = g * GE + ((lane >> 4) & 3);
    b.gv = __shfl((km < 64) ? g0 : g1, km & 63, 64);
    b.gu = __shfl((km < 64) ? u0 : u1, km & 63, 64);
}
__device__ __forceinline__ void gather_compute(const GBuf& b, const float (&hv)[16], float (&acc)[16], int lane) {
    float dt[GE];
#pragma unroll
    for (int q = 0; q < GE; ++q) {
        float d = 0.f;
#pragma unroll
        for (int c = 0; c < 4; ++c) {
            const f32x2 lo = CVT_PK_F32_FP8((int)b.u[q][c], false), hi = CVT_PK_F32_FP8((int)b.u[q][c], true);
            d += hv[c * 4 + 0] * lo.x + hv[c * 4 + 1] * lo.y + hv[c * 4 + 2] * hi.x + hv[c * 4 + 3] * hi.y;
        }
        dt[q] = d;
    }
    float r2[2], r1;
    {
        const bool up = (lane & 32) != 0;
#pragma unroll
        for (int q = 0; q < 2; ++q) { const float keep = up ? dt[2 + q] : dt[q], send = up ? dt[q] : dt[2 + q]; r2[q] = keep + __shfl_xor(send, 32, 64); }
    }
    {
        const bool up = (lane & 16) != 0;
        const float keep = up ? r2[1] : r2[0], send = up ? r2[0] : r2[1];
        r1 = keep + __shfl_xor(send, 16, 64);
    }
    r1 += __shfl_xor(r1, 8, 64); r1 += __shfl_xor(r1, 4, 64); r1 += __shfl_xor(r1, 2, 64); r1 += __shfl_xor(r1, 1, 64);
    const float coef_mine = b.gv * geluf_(r1 * b.gu);
#pragma unroll
    for (int q = 0; q < GE; ++q) {
        const float coef = __shfl(coef_mine, q * 16, 64);
#pragma unroll
        for (int c = 0; c < 4; ++c) {
            const f32x2 lo = CVT_PK_F32_FP8((int)b.v[q][c], false), hi = CVT_PK_F32_FP8((int)b.v[q][c], true);
            acc[c * 4 + 0] += coef * lo.x; acc[c * 4 + 1] += coef * lo.y; acc[c * 4 + 2] += coef * hi.x; acc[c * 4 + 3] += coef * hi.y;
        }
    }
}
__device__ __forceinline__ void phase_peer_gather(const P& p, int l) {
    const int lane = otid() & 63;
    const int gw = (obid() * NTHREADS + otid()) >> 6, nw = (gridDim.x * NTHREADS) >> 6;
    constexpr int NG = PH * 16 / GE;
    const bool act = lane * 16 < D_MODEL;
    for (int t = gw; t < MTOT; t += nw) {
        float hv[16], acc[16];
        {
            const u32x4 z4 = {0u, 0u, 0u, 0u};
            const u32x4 ha = act ? *(const u32x4*)(p.H + (size_t)t * D_MODEL + lane * 16) : z4;
            const u32x4 hb = act ? *(const u32x4*)(p.H + (size_t)t * D_MODEL + lane * 16 + 8) : z4;
            hv[0] = LO16(ha.x); hv[1] = HI16(ha.x); hv[2] = LO16(ha.y); hv[3] = HI16(ha.y); hv[4] = LO16(ha.z); hv[5] = HI16(ha.z); hv[6] = LO16(ha.w); hv[7] = HI16(ha.w);
            hv[8] = LO16(hb.x); hv[9] = HI16(hb.x); hv[10] = LO16(hb.y); hv[11] = HI16(hb.y); hv[12] = LO16(hb.z); hv[13] = HI16(hb.z); hv[14] = LO16(hb.w); hv[15] = HI16(hb.w);
#pragma unroll
            for (int j = 0; j < 16; ++j) acc[j] = 0.f;
        }
        int idx0 = 0, idx1 = 0; float g0 = 0.f, g1 = 0.f, u0 = 0.f, u1 = 0.f;
        if (lane < PH * 16) { idx0 = p.IDX[(size_t)t * PH * 16 + lane]; g0 = p.G[(size_t)t * PH * 16 + lane]; u0 = p.GU[(size_t)t * PH * 16 + lane]; }
        if (64 + lane < PH * 16) { idx1 = p.IDX[(size_t)t * PH * 16 + 64 + lane]; g1 = p.G[(size_t)t * PH * 16 + 64 + lane]; u1 = p.GU[(size_t)t * PH * 16 + 64 + lane]; }
        GBuf b0, b1, b2;
        gather_load(p, b0, 0, idx0, idx1, g0, g1, u0, u1, lane);
        gather_load(p, b1, 1, idx0, idx1, g0, g1, u0, u1, lane);
        for (int g = 0; g < NG; g += 3) {
            if (g + 2 < NG) gather_load(p, b2, g + 2, idx0, idx1, g0, g1, u0, u1, lane);
            gather_compute(b0, hv, acc, lane);
            if (g + 1 < NG) {
                if (g + 3 < NG) gather_load(p, b0, g + 3, idx0, idx1, g0, g1, u0, u1, lane);
                gather_compute(b1, hv, acc, lane);
            }
            if (g + 2 < NG) {
                if (g + 4 < NG) gather_load(p, b1, g + 4, idx0, idx1, g0, g1, u0, u1, lane);
                gather_compute(b2, hv, acc, lane);
            }
        }
        if (act) {
            const float* g2 = p.MOD + (size_t)(l * 2 + (t >= CTX ? 1 : 0)) * 6 * D_MODEL + 5 * D_MODEL + lane * 16;
            float* xp = p.X + (size_t)t * D_MODEL + lane * 16;
#pragma unroll
            for (int c = 0; c < 4; ++c) {
                float4 x = *(float4*)(xp + c * 4);
                x.x += g2[c * 4 + 0] * acc[c * 4 + 0]; x.y += g2[c * 4 + 1] * acc[c * 4 + 1]; x.z += g2[c * 4 + 2] * acc[c * 4 + 2]; x.w += g2[c * 4 + 3] * acc[c * 4 + 3];
                *(float4*)(xp + c * 4) = x;
            }
        }
    }
}

__device__ __forceinline__ void phase_final(const P& p) {
    const int lane = otid() & 63;
    const int gw = (obid() * NTHREADS + otid()) >> 6, nw = (gridDim.x * NTHREADS) >> 6;
    const float* g = p.in[I_FG];
    for (int t = gw; t < SEQ; t += nw) {
        const float* x = p.X + (size_t)(CTX + t) * D_MODEL;
        float v[D_MODEL / 64]; float ss = 0.f;
#pragma unroll
        for (int j = 0; j < D_MODEL / 64; ++j) { v[j] = x[lane + 64 * j]; ss += v[j] * v[j]; }
        ss = wave_sum(ss);
        float rstd = rsqrtf(ss / D_MODEL + 1e-6f);
#pragma unroll
        for (int j = 0; j < D_MODEL / 64; ++j) p.out[(size_t)t * D_MODEL + lane + 64 * j] = v[j] * rstd * g[lane + 64 * j];
    }
}

__global__ void __launch_bounds__(NTHREADS) fwd_megakernel(P p_arg) {
#ifdef EMU
    char* smem = emu_smem();
#else
    __shared__ __attribute__((aligned(16))) char smem_raw[SMEM_BYTES + 16];
    char* smem = smem_raw;
#endif
#ifndef EMU
    volatile LAS unsigned* xst = (volatile LAS unsigned*)(smem_raw + SMEM_BYTES);
    if (threadIdx.x == 0) { xst[0] = 0u; xst[1] = 0u; xst[2] = 0u; xst[3] = 0u; }
    __syncthreads();
    XcdBarrier xb = xcd_barrier_post(p_arg.bar, xst);
#endif
    { LOADP(); phase_init(p, smem); }
#ifndef EMU
    cg::this_grid().sync();
#endif
    GRID_SYNC();
#ifndef EMU
    if (threadIdx.x == 0) {
        unsigned base_ = 0;
        for (unsigned j = 0; j < xb.x; ++j) base_ += xb_ld(&p_arg.bar[XB_XCNT(j)]);
        xst[2] = base_ + xst[3];
    }
    __syncthreads();
#endif
    PROBE_INIT();
    for (int l = 0; l < DEPTH; ++l) {
        { LOADP(); phase_norm(p, l, 0); }
        { LOADP(); phase_s5const(p, l); }
        { LOADP(); phase_convert_weights(p, l, smem); }
        GRID_SYNC(); PROBE_AFTER(0);
        { LOADP(); phase_gemm_in(p, l, smem); }
        GRID_SYNC(); PROBE_AFTER(1);
        { LOADP(); phase_rwkv_prep1(p, l); }
        GRID_SYNC(); PROBE_AFTER(14);
        { LOADP(); phase_rwkv_prep2(p, l, smem); }
        GRID_SYNC(); PROBE_AFTER(2);
        { LOADP(); for (int job = obid(); job < 2 * NC * RH; job += gridDim.x) rwkv_chunk_job(p, job, smem); }
        __syncthreads();
        { LOADP(); phase_gla_kv(p, l, smem); }
        { LOADP(); phase_s5_pass(p, l, smem, false); }
        GRID_SYNC(); PROBE_AFTER(3);
        {
            LOADP();
            const int n_rw = 2 * RH, n_gla = 2 * GH * 8192 / NTHREADS, n_s5 = (2 * SG * 64 + NTHREADS - 1) / NTHREADS;
            for (int job = obid(); job < n_rw + n_gla + n_s5 + PEER_CONV_JOBS; job += gridDim.x) {
                if (job < n_rw) rwkv_seq_job(p, job, smem);
                else if (job < n_rw + n_gla) gla_scan_job(p, job - n_rw);
                else if (job < n_rw + n_gla + n_s5) s5_carry_job(p, job - n_rw - n_gla);
                else peer_conv_job(p, l, job - n_rw - n_gla - n_s5);
            }
        }
        GRID_SYNC(); PROBE_AFTER(4);
        { LOADP(); phase_rwkv_out(p); }
        { LOADP(); phase_gla_out(p, l, smem); }
        { LOADP(); phase_s5_pass(p, l, smem, true); }
        GRID_SYNC(); PROBE_AFTER(5);
        { LOADP(); phase_side_elem(p, l); }
        GRID_SYNC(); PROBE_AFTER(6);
        { LOADP(); phase_side_gemm(p, l, smem); }
        GRID_SYNC(); PROBE_AFTER(7);
        { LOADP(); phase_merge(p, l, smem); }
        GRID_SYNC(); PROBE_AFTER(8);
        { LOADP(); phase_outproj(p, l, smem); }
        GRID_SYNC(); PROBE_AFTER(9);
        { LOADP(); phase_norm(p, l, 1); }
        GRID_SYNC(); PROBE_AFTER(10);
        { LOADP(); phase_peer_q(p, l, smem); }
        GRID_SYNC(); PROBE_AFTER(11);
        { LOADP(); phase_peer_topk(p, l, smem); }
        GRID_SYNC(); PROBE_AFTER(12);
        { LOADP(); phase_peer_gather(p, l); }
        GRID_SYNC(); PROBE_AFTER(13);
    }
    { LOADP(); phase_final(p); }
}

static inline size_t align_up(size_t x) { return (x + 255) & ~(size_t)255; }

extern "C" void kernel_launch(void* const* d_in, const int* in_sizes, int n_in, void* d_out, int out_size, void* d_ws, size_t ws_size, hipStream_t stream) {
    P p;
    memset(&p, 0, sizeof(p));
    for (int i = 0; i < 39; ++i) p.in[i] = (const float*)d_in[i];
    p.out = (float*)d_out;
    char* w = (char*)d_ws; size_t off = 0;
    auto take = [&](size_t bytes) { void* r = w + off; off = align_up(off + bytes); return r; };
    p.bar = (unsigned*)take(16384);
    p.X = (float*)take((size_t)MTOT * D_MODEL * 4);
    p.H = (bf16_t*)take((size_t)MTOT * D_MODEL * 2);
    p.MOD = (float*)take((size_t)DEPTH * 2 * 6 * D_MODEL * 4);
    p.Z = (bf16_t*)take((size_t)MTOT * ZLD * 2);
    p.ZGT = (bf16_t*)take((size_t)MTOT * 3 * D_MODEL * 2);
    p.V = (bf16_t*)take((size_t)MTOT * RW * 2);
    {
        char* ra = (char*)take((size_t)MTOT * RW * 2 * 2 > (size_t)MTOT * GLA_V * 4 ? (size_t)MTOT * RW * 2 * 2 : (size_t)MTOT * GLA_V * 4);
        p.R = (bf16_t*)ra; p.KK = (bf16_t*)(ra + (size_t)MTOT * RW * 2);
        p.OGLA = (float*)ra;
    }
    {
        char* rb = (char*)take((size_t)2 * MTOT * RW * 2 > (size_t)3 * MTOT * PH * 16 * 4 ? (size_t)2 * MTOT * RW * 2 : (size_t)3 * MTOT * PH * 16 * 4);
        p.KD = (bf16_t*)rb;
        p.IDX = (int*)rb; p.G = (float*)(rb + (size_t)MTOT * PH * 16 * 4); p.GU = (float*)(rb + (size_t)2 * MTOT * PH * 16 * 4);
    }
    p.BB = (bf16_t*)take((size_t)2 * MTOT * RW * 2);
    p.LW = (float*)take((size_t)2 * MTOT * RW * 4);
    p.SP = (bf16_t*)p.LW;
    static_assert((size_t)2 * NC * GH * 8192 * 2 <= (size_t)2 * MTOT * RW * 4, "SP alias");
    p.BONUS = (float*)take((size_t)2 * MTOT * RH * 4);
    p.KS = (bf16_t*)take((size_t)MTOT * RW * 2);
    p.LR = (bf16_t*)take((size_t)MTOT * 256 * 2);
    p.WT_W2 = (bf16_t*)take((size_t)2 * NPAD(RW) * 64 * 2);
    p.WT_A2 = (bf16_t*)take((size_t)2 * NPAD(RW) * 64 * 2);
    p.GS = (bf16_t*)take((size_t)MTOT * 128 * 2);
    p.Y = (float*)take((size_t)2 * MTOT * RW * 4);
    p.Y0T = (float*)take((size_t)2 * NC * RH * 4096 * 4);
    p.KV = (float*)take((size_t)2 * NC * GH * 8192 * 4);
    p.DEC = (float*)take((size_t)2 * NC * GH * 64 * 4);
    p.S5A = (float*)take((size_t)2 * SG * 64 * 2 * 4);
    p.S5BB = (float*)take((size_t)2 * SG * 64 * 16 * 2 * 4);
    p.S5END = (float*)take((size_t)2 * NC * SG * 64 * 2 * 4);
    p.S5CAR = (float*)take((size_t)2 * NC * SG * 64 * 2 * 4);
    {
        const size_t szc1 = (size_t)2 * NC * RH * SEQ_REC;
        const size_t szc2 = (size_t)MTOT * SW * 2 + (size_t)MTOT * RW * 4 + (size_t)MTOT * 3 * BW * 2 + (size_t)MTOT * D_MODEL * 2 + 1024;
        char* rc = (char*)take(szc1 > szc2 ? szc1 : szc2);
        p.REC = rc;
        char* c2 = rc;
        p.GY = (bf16_t*)c2; c2 += align_up((size_t)MTOT * SW * 2);
        p.YN = (float*)c2; c2 += align_up((size_t)MTOT * RW * 4);
        p.BR = (bf16_t*)c2; c2 += align_up((size_t)MTOT * 3 * BW * 2);
        p.M = (bf16_t*)c2;
    }
    p.SN = (bf16_t*)take((size_t)2 * NC * RH * 4096 * 2);
    p.QH = (bf16_t*)take((size_t)2 * NC * RH * 4096 * 2);
    p.WT_IN = (bf16_t*)take((size_t)NPAD192(D_IN) * D_MODEL * 2);
    p.WT_G2 = (bf16_t*)take((size_t)NPAD(RW) * 128 * 2);
    p.WT_GLU = (bf16_t*)take((size_t)NPAD(2 * SW) * SW * 2);
    p.WT_BR = (bf16_t*)take((size_t)3 * D_MODEL * BW * 2);
    p.WT_OUT = (bf16_t*)take((size_t)D_MODEL * D_MODEL * 2);
    p.WT_Q = (bf16_t*)take((size_t)PQ * D_MODEL * 2);
    p.U8 = (unsigned char*)take((size_t)NEXP * D_MODEL);
    p.V8 = (unsigned char*)take((size_t)NEXP * D_MODEL);
    p.USC = (float*)take((size_t)NEXP * 4); p.VSC = (float*)take((size_t)NEXP * 4);
    p.QHI = p.Z; p.QLO = p.Z + (size_t)MTOT * PQ;
    p.KHI = (bf16_t*)take((size_t)PH * 2 * 128 * 128 * 2); p.KLO = (bf16_t*)take((size_t)PH * 2 * 128 * 128 * 2);
    static_assert((size_t)PQ * 4 <= (size_t)D_IN * 2 && ((size_t)MTOT * ZLD * 2) % 256 == 0, "Q alias");
    if (off > ws_size) { fprintf(stderr, "ws too small: need %zu have %zu\n", off, ws_size); return; }
#ifdef EMU
    fprintf(stderr, "ws used %zu MB\n", off >> 20);
    emu_launch([=] { fwd_megakernel(p); }, EMU_GRID, NTHREADS);
#else
    hipMemsetAsync(p.bar, 0, 16384, stream);
    static int grid_blocks = 0;
    if (!grid_blocks) {
        int dev = 0, cus = 0, per_cu = 0;
        hipGetDevice(&dev);
        hipDeviceGetAttribute(&cus, hipDeviceAttributeMultiprocessorCount, dev);
        hipOccupancyMaxActiveBlocksPerMultiprocessor(&per_cu, fwd_megakernel, NTHREADS, 0);
        if (per_cu > 1) per_cu = 1;
        grid_blocks = cus * per_cu;
    }
    void* args[] = {&p};
    hipError_t e = hipLaunchCooperativeKernel((void*)fwd_megakernel, dim3(grid_blocks), dim3(NTHREADS), args, 0, stream);
    if (e != hipSuccess) fprintf(stderr, "cooperative launch failed: %s (grid %d)\n", hipGetErrorString(e), grid_blocks);
#endif
}
```

```cpp
#include <hip/hip_runtime.h>
#ifndef EMU
#include <hip/hip_cooperative_groups.h>
namespace cg = cooperative_groups;
#endif
#include <cstdio>
#include <cstdint>
#include <cstring>
#include <type_traits>

#ifdef CFG_SMALL
#define D_MODEL 128
#define SEQ 640
#define DEPTH 2
#define GRID_W 10
#define CTX 128
#define GH 1
#define RH 2
#define SG 8
#define PH 2
#else
#define D_MODEL 1024
#define SEQ 16384
#define DEPTH 4
#define GRID_W 64
#define CTX 256
#define GH 4
#define RH 8
#define SG 32
#define PH 8
#endif
#define MTOT (CTX + SEQ)
#define ROWS (SEQ / GRID_W)
#define GLA_K (GH * 64)
#define GLA_V (GH * 128)
#define RW (RH * 64)
#define RWKV_IN (3 * RW + 4 * 64 + 128)
#define SW (SG * 16)
#define BW GLA_V
#define ZQ 0
#define ZK (GLA_K)
#define ZV (2 * GLA_K)
#define ZOG (ZV + GLA_V)
#define ZAF (ZOG + GLA_V)
#define ZAB (ZAF + 16)
#define ZR (ZAB + 16)
#define ZS5 (ZR + RWKV_IN)
#define ZG (ZS5 + SW)
#define D_IN (ZG + 3 * D_MODEL)
#define ZLD ZG
#define NC (MTOT / 64)
#define NCC (CTX / 64)
#define RB (ROWS / 64)
#define PQ (PH * 256)
#define NEXP 16384
#define NTHREADS 256
#define SMEM_BYTES 133120

typedef unsigned short bf16_t;
typedef short bf16x8 __attribute__((ext_vector_type(8)));
typedef float f32x4 __attribute__((ext_vector_type(4)));
typedef unsigned u32x4 __attribute__((ext_vector_type(4)));
typedef unsigned u32x2 __attribute__((ext_vector_type(2)));
#ifdef EMU
#define MFMA16(a, b, c) emu_mfma_16x16x32_bf16(a, b, c)
#else
#define MFMA16(a, b, c) __builtin_amdgcn_mfma_f32_16x16x32_bf16(a, b, c, 0, 0, 0)
#endif
typedef float f32x2 __attribute__((ext_vector_type(2)));
#ifdef EMU
#define CVT_PK_FP8(a, b, old, hi) emu_cvt_pk_fp8_f32(a, b, old, hi)
#define CVT_PK_F32_FP8(w, hi) emu_cvt_pk_f32_fp8(w, hi)
#else
#define CVT_PK_FP8(a, b, old, hi) __builtin_amdgcn_cvt_pk_fp8_f32(a, b, old, hi)
#define CVT_PK_F32_FP8(w, hi) __builtin_amdgcn_cvt_pk_f32_fp8(w, hi)
#endif
#ifdef EMU
#define MFMA16_ACC(a, b, c) c = emu_mfma_16x16x32_bf16(a, b, c)
#else
#define MFMA16_ACC(a, b, c) asm volatile("v_mfma_f32_16x16x32_bf16 %0, %1, %2, %0" : "+a"(c) : "v"(a), "v"(b))
#endif
#define NPAD(n) (((n) + 127) / 128 * 128)
#define NPAD192(n) (((n) + 383) / 384 * 384)

__device__ __forceinline__ float bf2f(bf16_t h) { return __builtin_bit_cast(float, ((unsigned)h) << 16); }
#ifdef EMU
__device__ __forceinline__ bf16_t f2bf(float f) { unsigned u = __builtin_bit_cast(unsigned, f); u += 0x7FFFu + ((u >> 16) & 1u); return (bf16_t)(u >> 16); }
__device__ __forceinline__ unsigned pack2bf(float a, float b) { return (unsigned)f2bf(a) | ((unsigned)f2bf(b) << 16); }
#else
typedef float f2v_t __attribute__((ext_vector_type(2))); typedef __bf16 b2v_t __attribute__((ext_vector_type(2)));
__device__ __forceinline__ bf16_t f2bf(float f) { return __builtin_bit_cast(unsigned short, (__bf16)f); }
__device__ __forceinline__ unsigned pack2bf(float a, float b) { f2v_t v = {a, b}; b2v_t r = __builtin_convertvector(v, b2v_t); return __builtin_bit_cast(unsigned, r); }
#endif
#ifdef EMU
#define fexp_(x) expf(x)
#define flog_(x) logf(x)
#else
#define fexp_(x) __expf(x)
#define flog_(x) __logf(x)
#endif
#define LO16(x) __builtin_bit_cast(float, (x) << 16)
#define HI16(x) __builtin_bit_cast(float, (x) & 0xFFFF0000u)
__device__ __forceinline__ float sigmoidf_(float x) { return 1.0f / (1.0f + fexp_(-x)); }
__device__ __forceinline__ float siluf_(float x) { return x * sigmoidf_(x); }
__device__ __forceinline__ float geluf_(float x) { const float y = 1.5957691216057308f * (x + 0.044715f * x * x * x); return x / (1.0f + fexp_(-y)); }
__device__ __forceinline__ float softplusf_(float x) { return fmaxf(x, 0.f) + flog_(1.0f + fexp_(-fabsf(x))); }
__device__ __forceinline__ float tanhf_(float x) { const float e = fexp_(-2.0f * fabsf(x)); const float t = (1.0f - e) / (1.0f + e); return x < 0.f ? -t : t; }
__device__ __forceinline__ float wave_sum(float v) {
#pragma unroll
    for (int m = 32; m >= 1; m >>= 1) v += __shfl_xor(v, m, 64);
    return v;
}

struct P {
    const float* in[39];
    float* out;
    float* X;
    bf16_t* H;
    bf16_t* Z;
    bf16_t* ZGT;
    float* MOD;
    bf16_t* R; bf16_t* V; bf16_t* KK; bf16_t* KD; bf16_t* BB;
    float* LW;
    char* REC;
    bf16_t* SN;
    bf16_t* QH;
    float* BONUS;
    bf16_t* KS;
    bf16_t* LR;
    bf16_t* WT_W2;
    bf16_t* WT_A2;
    bf16_t* GS;
    float* Y;
    float* Y0T;
    float* KV;
    bf16_t* SP;
    float* DEC;
    float* OGLA;
    float* S5A;
    float* S5BB;
    float* S5END;
    float* S5CAR;
    bf16_t* GY;
    float* YN;
    bf16_t* BR;
    bf16_t* M;
    bf16_t* QHI; bf16_t* QLO;
    bf16_t* KHI; bf16_t* KLO;
    int* IDX;
    float* G;
    float* GU;
    unsigned* bar;
    bf16_t* WT_IN;
    bf16_t* WT_G2;
    bf16_t* WT_GLU;
    bf16_t* WT_BR;
    bf16_t* WT_OUT;
    bf16_t* WT_Q;
    unsigned char* U8; unsigned char* V8;
    float* USC; float* VSC;
};

enum { I_X = 0, I_C, I_CTX, I_CCTX, I_WMOD, I_BMOD, I_N1G, I_N2G, I_WIN, I_GLA_WA2, I_GLA_BA, I_GLA_NG, I_RCONV, I_RW0, I_RW2, I_RA0, I_RA2, I_RG2,
       I_RKK, I_RKA, I_RRK, I_RLNW, I_RLNB, I_S5LRE, I_S5LIM, I_S5LS, I_S5BRE, I_S5BIM, I_S5CRE, I_S5CIM, I_S5D, I_S5GLU, I_WBR, I_WOUT, I_PWQ, I_PKEYS, I_PU, I_PV, I_FG };

#define AL256(x) (((size_t)(x) + 255) & ~(size_t)255)
#define LATE_BYTES (AL256((size_t)NPAD(RW) * 128 * 2) + AL256((size_t)NPAD(2 * SW) * SW * 2) + AL256((size_t)3 * D_MODEL * BW * 2) + AL256((size_t)D_MODEL * D_MODEL * 2) + \
                    AL256((size_t)PQ * D_MODEL * 2) + 2 * AL256((size_t)PH * 2 * 128 * 128 * 2))
__device__ __forceinline__ void late_select(P& p, int par) {
    const size_t o = (size_t)par * (LATE_BYTES / 2);
    p.WT_G2 += o; p.WT_GLU += o; p.WT_BR += o; p.WT_OUT += o; p.WT_Q += o; p.KHI += o; p.KLO += o;
}
#ifdef EMU
__device__ __forceinline__ int otid() { return threadIdx.x; }
__device__ __forceinline__ int obid() { return blockIdx.x; }
#else
__device__ __forceinline__ int otid() { int t = threadIdx.x; asm volatile("" : "+v"(t)); return t; }
__device__ __forceinline__ int obid() { int b = blockIdx.x; asm volatile("" : "+s"(b)); return b; }
#endif
#ifdef EMU
#define WAVE_SYNC() emu_wave_barrier()
#ifndef EMU_GRID
#define EMU_GRID 4
#endif
#else
#define WAVE_SYNC() __builtin_amdgcn_wave_barrier()
#endif
#ifndef EMU
#define XB_TMO      128
#define XB_XCNT(j)  (256  + 64 * (j))
#define XB_XSUB(j)  (1280 + 64 * (j))
#define XB_XGEN(j)  (2304 + 64 * (j))
#define XB_TOP      3328
#define XB_TOPGEN   3392
#define XCD_BAR_WORDS 3456
#define XB_SPIN_CAP (1u << 22)
#define LAS __attribute__((address_space(3)))
__device__ __forceinline__ unsigned xb_ld(unsigned* p)              { return __hip_atomic_load(p, __ATOMIC_RELAXED, __HIP_MEMORY_SCOPE_AGENT); }
__device__ __forceinline__ unsigned xb_add(unsigned* p, unsigned v) { return __hip_atomic_fetch_add(p, v, __ATOMIC_RELAXED, __HIP_MEMORY_SCOPE_AGENT); }
__device__ __forceinline__ unsigned xb_xcc_id() { return (unsigned)__builtin_amdgcn_s_getreg((3 << 11) | 20) & 0xFu; }
#define XB_SPIN(cond, bar) do { unsigned _sp = 0; while (cond) { __builtin_amdgcn_s_sleep(1); \
    if ((++_sp & 255u) == 0u) { if (xb_ld(&(bar)[XB_TMO])) break; if (_sp > XB_SPIN_CAP) { atomicAdd(&(bar)[XB_TMO], 1u); break; } } } } while (0)
struct XcdBarrier { unsigned* bar; unsigned x; volatile LAS unsigned* st; };
__device__ __forceinline__ XcdBarrier xcd_barrier_post(unsigned* bar, volatile LAS unsigned* st) {
    XcdBarrier b; b.bar = bar; b.x = xb_xcc_id(); b.st = st;
    if (threadIdx.x == 0) st[3] = xb_add(&bar[XB_XCNT(b.x)], 1u);
    return b;
}
__device__ __forceinline__ void xcd_barrier_complete(unsigned* bar, unsigned x, unsigned& nloc, unsigned& nx) {
    const unsigned G = gridDim.x * gridDim.y * gridDim.z;
    unsigned sum, cnt, mine, sp = 0u;
    for (;;) {
        sum = 0u; cnt = 0u; mine = 0u;
#pragma unroll
        for (unsigned j = 0; j < 16; ++j) { const unsigned c = xb_ld(&bar[XB_XCNT(j)]); sum += c; cnt += (c > 0u) ? 1u : 0u; mine = (j == x) ? c : mine; }
        if (sum == G) break;
        __builtin_amdgcn_s_sleep(1);
        if ((++sp & 255u) == 0u) { if (xb_ld(&bar[XB_TMO])) break; if (sp > XB_SPIN_CAP) { atomicAdd(&bar[XB_TMO], 1u); break; } }
    }
    nloc = mine > 0u ? mine : 1u; nx = cnt > 0u ? cnt : 1u;
}
__device__ __forceinline__ void xcd_barrier(const XcdBarrier& b) {
    asm volatile("s_waitcnt vmcnt(0)" ::: "memory");
    __syncthreads();
    if (threadIdx.x == 0) {
        unsigned* bar = b.bar;
        __builtin_amdgcn_fence(__ATOMIC_RELEASE, "agent");
        asm volatile("s_waitcnt vmcnt(0)" ::: "memory");
        const unsigned G = gridDim.x;
        const unsigned old = xb_add(&bar[XB_TOP], 1u);
        const unsigned tg = old / G;
        if (old + 1u == (tg + 1u) * G) {
            const unsigned long long t0_ = wall_clock64(); while (wall_clock64() - t0_ < 1000ull) __builtin_amdgcn_s_sleep(8);
            xb_add(&bar[XB_TOPGEN], 1u);
        }
        else XB_SPIN(xb_ld(&bar[XB_TOPGEN]) == tg, bar);
        __builtin_amdgcn_fence(__ATOMIC_ACQUIRE, "agent");
        asm volatile("s_waitcnt vmcnt(0)" ::: "memory");
    }
    __syncthreads();
}
#define GRID_SYNC() { (void)xb; cg::this_grid().sync(); }
#else
#define GRID_SYNC() emu_grid_sync()
#endif

#ifdef EMU
#define LOADP() P p = p_arg
#else
typedef __attribute__((address_space(4))) const unsigned long long cu64_t;
__device__ __forceinline__ void load_params(P& p) {
    cu64_t* q = (cu64_t*)__builtin_amdgcn_kernarg_segment_ptr();
    asm volatile("" : "+s"(q));
    unsigned long long w[sizeof(P) / 8];
#pragma unroll
    for (int i = 0; i < (int)(sizeof(P) / 8); ++i) w[i] = q[i];
    __builtin_memcpy(&p, w, sizeof(P));
}
#define LOADP() P p; load_params(p)
#endif
#define PROBE_MULT 3
#if defined(PROBE_ID) && !defined(EMU)
#define PROBE_INIT() unsigned long long probe_t0 = wall_clock64()
#define PROBE_AFTER(id) { if (blockIdx.x == 0) { unsigned long long now_ = wall_clock64(); if ((id) == PROBE_ID || (id) == PROBE_ID2) { const unsigned long long dt_ = now_ - probe_t0; \
    while (wall_clock64() - now_ < dt_ * PROBE_MULT) __builtin_amdgcn_s_sleep(8); now_ = wall_clock64(); } probe_t0 = now_; } }
#else
#define PROBE_INIT()
#define PROBE_AFTER(id)
#endif
__device__ __forceinline__ int gla_tok(int n, int i) {
    if (n < NCC) return n * 64 + i;
    int m = n - NCC; int col = m / RB, rb = m % RB;
    return CTX + (rb * 64 + i) * GRID_W + col;
}
__device__ __forceinline__ int chunk_order(int d, int s) {
    if (d == 0) return s;
    return (s < NCC) ? (NCC - 1 - s) : (NC - 1 - (s - NCC));
}
__device__ __forceinline__ int tok_order(int d, int s) {
    if (d == 0) return s;
    return (s < CTX) ? (CTX - 1 - s) : (MTOT - 1 - (s - CTX));
}


#define LDS_ROW 72
__device__ __forceinline__ void mfma_gemm_tile(const bf16_t* Wt, int ldw, const bf16_t* Act, int lda, int K, int n0, int m0, bf16_t* lds, f32x4 (&acc)[4][4]) {
    bf16_t* Ws = lds; bf16_t* As = lds + 128 * LDS_ROW;
    const int tid = otid(), lane = tid & 63, wave = tid >> 6, wn = wave >> 1, wm = wave & 1;
    const int lrow = tid >> 3, lkc = (tid & 7) * 8;
    u32x4 pw[4], pa[4];
#pragma unroll
    for (int i = 0; i < 4; ++i) {
        pw[i] = *(const u32x4*)(Wt + (size_t)(n0 + lrow + 32 * i) * ldw + lkc);
        pa[i] = *(const u32x4*)(Act + (size_t)(m0 + lrow + 32 * i) * lda + lkc);
    }
    for (int k0 = 0; k0 < K; k0 += 64) {
        __syncthreads();
#pragma unroll
        for (int i = 0; i < 4; ++i) {
            *(u32x4*)(Ws + (lrow + 32 * i) * LDS_ROW + lkc) = pw[i];
            *(u32x4*)(As + (lrow + 32 * i) * LDS_ROW + lkc) = pa[i];
        }
        __syncthreads();
        if (k0 + 64 < K) {
#pragma unroll
            for (int i = 0; i < 4; ++i) {
                pw[i] = *(const u32x4*)(Wt + (size_t)(n0 + lrow + 32 * i) * ldw + k0 + 64 + lkc);
                pa[i] = *(const u32x4*)(Act + (size_t)(m0 + lrow + 32 * i) * lda + k0 + 64 + lkc);
            }
        }
#pragma unroll
        for (int ks = 0; ks < 2; ++ks) {
            bf16x8 a[4], b[4];
#pragma unroll
            for (int i = 0; i < 4; ++i) {
                a[i] = *(const bf16x8*)(Ws + (wn * 64 + i * 16 + (lane & 15)) * LDS_ROW + ks * 32 + (lane >> 4) * 8);
                b[i] = *(const bf16x8*)(As + (wm * 64 + i * 16 + (lane & 15)) * LDS_ROW + ks * 32 + (lane >> 4) * 8);
            }
#pragma unroll
            for (int ni = 0; ni < 4; ++ni)
#pragma unroll
                for (int mi = 0; mi < 4; ++mi) acc[ni][mi] = MFMA16(a[ni], b[mi], acc[ni][mi]);
        }
    }
}
#define L64_ROW 72
#ifdef EMU
struct BufRsrc { const char* base; };
__device__ __forceinline__ BufRsrc make_rsrc(const void* p, size_t) { BufRsrc r; r.base = (const char*)p; return r; }
__device__ __forceinline__ u32x4 buf_load16(const BufRsrc& r, unsigned voff, unsigned soff) { return *(const u32x4*)(r.base + voff + soff); }
#else
typedef __amdgpu_buffer_rsrc_t BufRsrc;
__device__ __forceinline__ BufRsrc make_rsrc(const void* p, size_t bytes) { return __builtin_amdgcn_make_buffer_rsrc((void*)p, 0, (int)bytes, 0x00020000); }
__device__ __forceinline__ u32x4 buf_load16(const BufRsrc& r, unsigned voff, unsigned soff) { return __builtin_bit_cast(u32x4, __builtin_amdgcn_raw_buffer_load_b128(r, voff, soff, 0)); }
#endif
template <int NI, int MI>
__device__ __forceinline__ void mfma_gemm_tile_t(const bf16_t* Wt, int ldw, size_t wbytes, const bf16_t* Act, int lda, size_t abytes, int K, int n0, int m0, bf16_t* lds, f32x4 (&acc)[NI][MI], unsigned long long* gacc = nullptr) {
    constexpr int WR = 32 * NI, AR = 32 * MI, BUF = (WR + AR) * L64_ROW;
    const int tid = otid(), lane = tid & 63, wave = tid >> 6, wn = wave >> 1, wm = wave & 1;
    const int lrow = tid >> 3, lkc = (tid & 7) * 8;
    const BufRsrc rw = make_rsrc(Wt, wbytes), ra = make_rsrc(Act, abytes);
    unsigned vw[NI], va[MI];
#pragma unroll
    for (int i = 0; i < NI; ++i) vw[i] = (unsigned)(((size_t)(n0 + lrow + 32 * i) * ldw + lkc) * 2);
#pragma unroll
    for (int i = 0; i < MI; ++i) va[i] = (unsigned)(((size_t)(m0 + lrow + 32 * i) * lda + lkc) * 2);
    u32x4 qw0[NI], qa0[MI];
    const int nk = K / 64;
#define GT_LOAD(QW, QA, KT) { const unsigned so_ = (unsigned)(((KT) < nk) ? (KT) : (nk - 1)) * 128u; \
    _Pragma("unroll") for (int i = 0; i < NI; ++i) QW[i] = buf_load16(rw, vw[i], so_); \
    _Pragma("unroll") for (int i = 0; i < MI; ++i) QA[i] = buf_load16(ra, va[i], so_); }
#define GT_STORE(QW, QA, DST) { \
    _Pragma("unroll") for (int i = 0; i < NI; ++i) *(u32x4*)((DST) + (lrow + 32 * i) * L64_ROW + lkc) = QW[i]; \
    _Pragma("unroll") for (int i = 0; i < MI; ++i) *(u32x4*)((DST) + (WR + lrow + 32 * i) * L64_ROW + lkc) = QA[i]; }
#define GT_COMPUTE(CUR) { _Pragma("unroll") for (int ks = 0; ks < 2; ++ks) { bf16x8 b[MI], a[NI]; \
    _Pragma("unroll") for (int i = 0; i < MI; ++i) b[i] = *(const bf16x8*)((CUR) + (WR + wm * 16 * MI + i * 16 + (lane & 15)) * L64_ROW + ks * 32 + (lane >> 4) * 8); \
    _Pragma("unroll") for (int i = 0; i < NI; ++i) a[i] = *(const bf16x8*)((CUR) + (wn * 16 * NI + i * 16 + (lane & 15)) * L64_ROW + ks * 32 + (lane >> 4) * 8); \
    _Pragma("unroll") for (int ni = 0; ni < NI; ++ni) { \
        _Pragma("unroll") for (int mi = 0; mi < MI; ++mi) MFMA16_ACC(a[ni], b[mi], acc[ni][mi]); } } }
    GT_LOAD(qw0, qa0, 0)
    __syncthreads();
    GT_STORE(qw0, qa0, lds)
    __syncthreads();
    for (int kt = 0; kt < nk; kt += 2) {
        GT_LOAD(qw0, qa0, kt + 1)
        GT_COMPUTE(lds)
        GT_STORE(qw0, qa0, lds + BUF)
        __syncthreads();
        GT_LOAD(qw0, qa0, kt + 2)
        GT_COMPUTE(lds + BUF)
        GT_STORE(qw0, qa0, lds)
        __syncthreads();
    }
#undef GT_LOAD
#undef GT_STORE
#undef GT_COMPUTE
}
#define ZERO_ACC4(acc) { _Pragma("unroll") for (int i_ = 0; i_ < 4; ++i_) _Pragma("unroll") for (int j_ = 0; j_ < 4; ++j_) acc[i_][j_] = (f32x4){0.f, 0.f, 0.f, 0.f}; }
#define FOR_ACC(acc, n0, m0, BODY) { const int lane_ = otid() & 63, wave_ = otid() >> 6; \
    _Pragma("unroll") for (int ni_ = 0; ni_ < 4; ++ni_) _Pragma("unroll") for (int mi_ = 0; mi_ < 4; ++mi_) { \
        const int n = (n0) + (wave_ >> 1) * 64 + ni_ * 16 + (lane_ >> 4) * 4; const int m = (m0) + (wave_ & 1) * 64 + mi_ * 16 + (lane_ & 15); const f32x4 v = acc[ni_][mi_]; BODY } }
__device__ __forceinline__ u32x2 pack4(float a, float b, float c, float d) { u32x2 r; r.x = pack2bf(a, b); r.y = pack2bf(c, d); return r; }

__device__ __forceinline__ void convert_wt_job(const float* W, int K, int N, int Npad, bf16_t* out, int job, float* T, int ilv) {
    const int tid = otid();
    const int nkt = K / 64;
    const int n0 = (job / nkt) * 64, k0 = (job % nkt) * 64;
    __syncthreads();
    for (int idx = tid; idx < 4096; idx += NTHREADS) {
        int kk = idx >> 6, nn = idx & 63;
        int nr = n0 + nn; int src = ilv ? ((nr & 1) ? (N / 2 + (nr >> 1)) : (nr >> 1)) : nr;
        T[kk * 65 + nn] = (nr < N) ? W[(size_t)(k0 + kk) * N + src] : 0.f;
    }
    __syncthreads();
    {
        int nn = tid >> 2, part = tid & 3;
        unsigned w[8];
#pragma unroll
        for (int j = 0; j < 8; ++j) w[j] = pack2bf(T[(part * 16 + 2 * j) * 65 + nn], T[(part * 16 + 2 * j + 1) * 65 + nn]);
        u32x4* o = (u32x4*)(out + (size_t)(n0 + nn) * K + k0 + part * 16);
        o[0] = (u32x4){w[0], w[1], w[2], w[3]}; o[1] = (u32x4){w[4], w[5], w[6], w[7]};
    }
}
__device__ __forceinline__ void phase_convert_weights(const P& p, int l, char* smem, int bid, int nb) {
    float* T = (float*)smem;
    struct Item { const float* W; int K, N, Npad; bf16_t* out; };
    const Item items[12] = {
        {p.in[I_RW2] + ((size_t)l * 2 + 0) * 64 * RW, 64, RW, NPAD(RW), p.WT_W2},
        {p.in[I_RW2] + ((size_t)l * 2 + 1) * 64 * RW, 64, RW, NPAD(RW), p.WT_W2 + (size_t)NPAD(RW) * 64},
        {p.in[I_RA2] + ((size_t)l * 2 + 0) * 64 * RW, 64, RW, NPAD(RW), p.WT_A2},
        {p.in[I_RA2] + ((size_t)l * 2 + 1) * 64 * RW, 64, RW, NPAD(RW), p.WT_A2 + (size_t)NPAD(RW) * 64},
        {p.in[I_WIN] + (size_t)l * D_MODEL * D_IN, D_MODEL, D_IN, NPAD192(D_IN), p.WT_IN},
        {p.in[I_RG2] + (size_t)l * 128 * RW, 128, RW, RW, p.WT_G2},
        {p.in[I_S5GLU] + (size_t)l * SW * 2 * SW, SW, 2 * SW, 2 * SW, p.WT_GLU},
        {p.in[I_WBR] + ((size_t)l * 3 + 0) * BW * D_MODEL, BW, D_MODEL, D_MODEL, p.WT_BR},
        {p.in[I_WBR] + ((size_t)l * 3 + 1) * BW * D_MODEL, BW, D_MODEL, D_MODEL, p.WT_BR + (size_t)D_MODEL * BW},
        {p.in[I_WBR] + ((size_t)l * 3 + 2) * BW * D_MODEL, BW, D_MODEL, D_MODEL, p.WT_BR + (size_t)2 * D_MODEL * BW},
        {p.in[I_WOUT] + (size_t)l * D_MODEL * D_MODEL, D_MODEL, D_MODEL, D_MODEL, p.WT_OUT},
        {p.in[I_PWQ] + (size_t)l * D_MODEL * PQ, D_MODEL, PQ, PQ, p.WT_Q}};
    int base = 0;
#pragma unroll
    for (int it = 0; it < 12; ++it) {
        const int nj = (items[it].Npad / 64) * (items[it].K / 64);
        for (int j = (bid + nb - (base % nb)) % nb; j < nj; j += nb)
            convert_wt_job(items[it].W, items[it].K, items[it].N, items[it].Npad, items[it].out, j, T, it == 6);
        base += nj;
    }
    __syncthreads();
    {
        const float* ks = p.in[I_PKEYS] + (size_t)l * PH * 2 * 128 * 128;
        for (size_t i = (size_t)bid * NTHREADS + otid(); i < (size_t)PH * 2 * 128 * 128; i += (size_t)nb * NTHREADS) {
            const float v = ks[i]; const bf16_t hb = f2bf(v);
            p.KHI[i] = hb; p.KLO[i] = f2bf(v - bf2f(hb));
        }
    }
}

#ifdef EMU
__device__ __forceinline__ int xcd_rank() { return obid(); }
#else
__device__ __forceinline__ int xcd_rank() { return (int)((volatile LAS unsigned*)(unsigned)(SMEM_BYTES))[2]; }
#endif
__device__ __forceinline__ bool tile_map(int it, int ntm, int ntn, int PM, int& mt, int& nt) {
    const int G = gridDim.x;
    const long id = (long)it * G + xcd_rank();
    if (id >= (long)ntm * ntn) return false;
    const int full = ntm / PM; const long fullsz = (long)full * PM * ntn;
    if (id < fullsz) { const int p = (int)(id / (PM * ntn)), rem = (int)(id % (PM * ntn)); nt = rem / PM; mt = p * PM + rem % PM; }
    else { const int rem = (int)(id - fullsz), hh = ntm - full * PM; nt = rem / hh; mt = full * PM + rem % hh; }
    return true;
}

template <int NI, int MI, class Pre, class Post>
__device__ __forceinline__ void gemm_tile_run(const bf16_t* Wt, int ldw, size_t wbytes, const bf16_t* Act, int lda, size_t abytes, int K, int n0, int m0, bf16_t* lds, Pre pre, Post post) {
    f32x4 acc[NI][MI];
#pragma unroll
    for (int i = 0; i < NI; ++i)
#pragma unroll
        for (int j = 0; j < MI; ++j) acc[i][j] = (f32x4){0.f, 0.f, 0.f, 0.f};
    pre(m0, n0, acc, lds);
    mfma_gemm_tile_t<NI, MI>(Wt, ldw, wbytes, Act, lda, abytes, K, n0, m0, lds, acc);
    const int lane = otid() & 63, wave = otid() >> 6;
#pragma unroll
    for (int ni = 0; ni < NI; ++ni)
#pragma unroll
        for (int mi = 0; mi < MI; ++mi)
            post(ni, mi, m0 + (wave & 1) * 16 * MI + mi * 16 + (lane & 15), n0 + (wave >> 1) * 16 * NI + ni * 16 + (lane >> 4) * 4, acc[ni][mi]);
}
struct NoPre { template <class A> __device__ __forceinline__ void operator()(int, int, A&, bf16_t*) const {} };
template <int NI, class PreM, class PreT, class Post>
__device__ __forceinline__ void gemm_phase(const bf16_t* Wt, int ldw, size_t wbytes, const bf16_t* Act, int lda, size_t abytes, int K, int N, bf16_t* lds, PreM prem, PreT pret, Post post) {
    const int ntn = N / (32 * NI), ntm = MTOT / 256 - 1;
    const int PM = (ntn >= 16) ? 2 : ((ntn >= 8) ? 4 : 8);
    for (int it = 0;; ++it) {
        int mt_, nt_; if (!tile_map(it, ntm, ntn, PM, mt_, nt_)) break;
        gemm_tile_run<NI, 8>(Wt, ldw, wbytes, Act, lda, abytes, K, nt_ * 32 * NI, mt_ * 256, lds, prem, post);
    }
    for (int job = obid(); job < 4 * ntn; job += gridDim.x)
        gemm_tile_run<NI, 2>(Wt, ldw, wbytes, Act, lda, abytes, K, (job >> 2) * 32 * NI, MTOT - 256 + (job & 3) * 64, lds, pret, post);
}

__device__ __forceinline__ void phase_init(const P& p, char* smem) {
    const int tid = otid();
    float* sc = (float*)smem;
    for (int i = tid; i < D_MODEL; i += NTHREADS) { sc[i] = siluf_(p.in[I_CCTX][i]); sc[D_MODEL + i] = siluf_(p.in[I_C][i]); }
    __syncthreads();
    const int ncolblk = (6 * D_MODEL) / NTHREADS;
    for (int job = obid(); job < DEPTH * ncolblk; job += gridDim.x) {
        int l = job / ncolblk, n = (job % ncolblk) * NTHREADS + tid;
        const float* w = p.in[I_WMOD] + (size_t)l * D_MODEL * 6 * D_MODEL + n;
        float a0 = 0.f, a1 = 0.f;
        for (int k = 0; k < D_MODEL; ++k) { float wv = w[(size_t)k * 6 * D_MODEL]; a0 += sc[k] * wv; a1 += sc[D_MODEL + k] * wv; }
        float b = p.in[I_BMOD][l * 6 * D_MODEL + n];
        p.MOD[(size_t)(l * 2 + 0) * 6 * D_MODEL + n] = a0 + b;
        p.MOD[(size_t)(l * 2 + 1) * 6 * D_MODEL + n] = a1 + b;
    }
    const size_t gtid = (size_t)obid() * NTHREADS + tid, gn = (size_t)gridDim.x * NTHREADS;
    for (size_t i = gtid; i < (size_t)CTX * D_MODEL; i += gn) p.X[i] = p.in[I_CTX][i];
    for (size_t i = gtid; i < (size_t)SEQ * D_MODEL; i += gn) p.X[(size_t)CTX * D_MODEL + i] = p.in[I_X][i];
    __syncthreads();
}

__device__ __forceinline__ void phase_s5const(const P& p, int l) {
    const size_t gtid = (size_t)obid() * NTHREADS + otid(), gn = (size_t)gridDim.x * NTHREADS;
    for (size_t i = gtid; i < (size_t)2 * SG * 64; i += gn) {
        int d = (int)(i / (SG * 64)), g = (int)((i / 64) % SG), s = (int)(i % 64);
        size_t li = ((size_t)(l * 2 + d) * SG + g) * 64 + s;
        float lre = p.in[I_S5LRE][li], lim = p.in[I_S5LIM][li];
        float dt = expf(p.in[I_S5LS][(l * 2 + d) * SG + g]);
        float mag = expf(lre * dt);
        float are = mag * cosf(lim * dt), aim = mag * sinf(lim * dt);
        float den = lre * lre + lim * lim;
        float fre = ((are - 1.0f) * lre + aim * lim) / den;
        float fim = (aim * lre - (are - 1.0f) * lim) / den;
        p.S5A[i * 2 + 0] = are; p.S5A[i * 2 + 1] = aim;
        const float* bre = p.in[I_S5BRE] + (((size_t)l * SG + g) * 64 + s) * 16;
        const float* bim = p.in[I_S5BIM] + (((size_t)l * SG + g) * 64 + s) * 16;
        for (int c = 0; c < 16; ++c) {
            p.S5BB[(i * 16 + c) * 2 + 0] = fre * bre[c] - fim * bim[c];
            p.S5BB[(i * 16 + c) * 2 + 1] = fre * bim[c] + fim * bre[c];
        }
    }
}

__device__ __forceinline__ void phase_norm(const P& p, int l, int which) {
    const int lane = otid() & 63;
    const int gw = (obid() * NTHREADS + otid()) >> 6, nw = (gridDim.x * NTHREADS) >> 6;
    const float* g = p.in[which ? I_N2G : I_N1G] + l * D_MODEL;
    constexpr int NJ = (D_MODEL + 255) / 256;
    for (int t = gw; t < MTOT; t += nw) {
        const float* x = p.X + (size_t)t * D_MODEL;
        const float* mod = p.MOD + (size_t)(l * 2 + (t >= CTX ? 1 : 0)) * 6 * D_MODEL + (which ? 3 * D_MODEL : 0);
        float4 v[NJ]; float ss = 0.f;
#pragma unroll
        for (int j = 0; j < NJ; ++j) {
            const int e = j * 256 + lane * 4;
            if (e < D_MODEL) v[j] = *(const float4*)(x + e); else { v[j].x = 0.f; v[j].y = 0.f; v[j].z = 0.f; v[j].w = 0.f; }
            ss += v[j].x * v[j].x + v[j].y * v[j].y + v[j].z * v[j].z + v[j].w * v[j].w;
        }
        ss = wave_sum(ss);
        const float rstd = rsqrtf(ss / D_MODEL + 1e-6f);
#pragma unroll
        for (int j = 0; j < NJ; ++j) {
            const int e = j * 256 + lane * 4;
            if (e < D_MODEL) {
                const float4 gg = *(const float4*)(g + e), sc = *(const float4*)(mod + D_MODEL + e), sh = *(const float4*)(mod + e);
                *(u32x2*)(p.H + (size_t)t * D_MODEL + e) = pack4(v[j].x * rstd * gg.x * (1.0f + sc.x) + sh.x, v[j].y * rstd * gg.y * (1.0f + sc.y) + sh.y,
                                                                 v[j].z * rstd * gg.z * (1.0f + sc.z) + sh.z, v[j].w * rstd * gg.w * (1.0f + sc.w) + sh.w);
            }
        }
    }
}

__device__ __forceinline__ void phase_gemm_in(const P& p, int l, char* smem) {
    constexpr int NI = 4, MI = 8;
    const int ntn = NPAD192(D_IN) / 128, ntm = MTOT / 256;
    for (int it = 0;; ++it) {
        int mt_, nt_; if (!tile_map(it, ntm, ntn, 4, mt_, nt_)) break;
        const int m0 = mt_ * 256, n0 = nt_ * 128;
        f32x4 acc[NI][MI];
#pragma unroll
        for (int i = 0; i < NI; ++i)
#pragma unroll
            for (int j = 0; j < MI; ++j) acc[i][j] = (f32x4){0.f, 0.f, 0.f, 0.f};
        mfma_gemm_tile_t<NI, MI>(p.WT_IN, D_MODEL, (size_t)NPAD192(D_IN) * D_MODEL * 2, p.H, D_MODEL, (size_t)MTOT * D_MODEL * 2, D_MODEL, n0, m0, (bf16_t*)smem, acc);
        const int lane = otid() & 63, wave = otid() >> 6;
#pragma unroll
        for (int ni = 0; ni < NI; ++ni)
#pragma unroll
            for (int mi = 0; mi < MI; ++mi) {
                const int n = n0 + (wave >> 1) * 16 * NI + ni * 16 + (lane >> 4) * 4, m = m0 + (wave & 1) * 16 * MI + mi * 16 + (lane & 15);
                const u32x2 pk_ = pack4(acc[ni][mi][0], acc[ni][mi][1], acc[ni][mi][2], acc[ni][mi][3]);
                if (n < ZG) *(u32x2*)(p.Z + (size_t)m * ZLD + n) = pk_;
                else if (n < D_IN) *(u32x2*)(p.ZGT + ((((size_t)(m >> 4) * (3 * D_MODEL / 16) + ((n - ZG) >> 4)) * 64 + lane) * 4)) =
                    pack4(sigmoidf_(acc[ni][mi][0]), sigmoidf_(acc[ni][mi][1]), sigmoidf_(acc[ni][mi][2]), sigmoidf_(acc[ni][mi][3]));
            }
    }
}

__device__ __forceinline__ void unpack8(const u32x4 w, float (&f)[8]) {
    f[0] = LO16(w.x); f[1] = HI16(w.x); f[2] = LO16(w.y); f[3] = HI16(w.y); f[4] = LO16(w.z); f[5] = HI16(w.z); f[6] = LO16(w.w); f[7] = HI16(w.w);
}
__device__ __forceinline__ u32x4 pack8(const float (&f)[8]) {
    u32x4 o; o.x = pack2bf(f[0], f[1]); o.y = pack2bf(f[2], f[3]);
    o.z = pack2bf(f[4], f[5]); o.w = pack2bf(f[6], f[7]); return o;
}
__device__ __forceinline__ void load8f(const float* p, float (&f)[8]) {
    const float4 a = *(const float4*)p, b = *(const float4*)(p + 4);
    f[0] = a.x; f[1] = a.y; f[2] = a.z; f[3] = a.w; f[4] = b.x; f[5] = b.y; f[6] = b.z; f[7] = b.w;
}
__device__ __forceinline__ void store8f(float* p, const float (&f)[8]) {
    float4 a, b; a.x = f[0]; a.y = f[1]; a.z = f[2]; a.w = f[3]; b.x = f[4]; b.y = f[5]; b.z = f[6]; b.w = f[7];
    *(float4*)p = a; *(float4*)(p + 4) = b;
}
__device__ __forceinline__ void conv8(const bf16_t* zp, const float* conv, int c0, bool act, bool first, bool last, float (&out)[8]) {
    const u32x4 z4 = {0u, 0u, 0u, 0u};
    const u32x4 a0 = act ? *(const u32x4*)(zp + c0) : z4;
    const u32x4 am = (act && !first) ? *(const u32x4*)(zp + c0 - ZLD) : z4;
    const u32x4 an = (act && !last) ? *(const u32x4*)(zp + c0 + ZLD) : z4;
    float w0[8], w1[8], w2[8], f0[8], fm[8], fn[8];
    if (act) { load8f(conv + c0, w0); load8f(conv + RWKV_IN + c0, w1); load8f(conv + 2 * RWKV_IN + c0, w2); }
    else {
#pragma unroll
        for (int e = 0; e < 8; ++e) { w0[e] = 0.f; w1[e] = 0.f; w2[e] = 0.f; }
    }
    unpack8(a0, f0); unpack8(am, fm); unpack8(an, fn);
#pragma unroll
    for (int e = 0; e < 8; ++e) out[e] = w1[e] * f0[e] + w0[e] * fm[e] + w2[e] * fn[e];
}
__device__ __forceinline__ void phase_rwkv_prep1(const P& p, int l) {
    const int lane = otid() & 63;
    const int gw = (obid() * NTHREADS + otid()) >> 6, nw = (gridDim.x * NTHREADS) >> 6;
    const float* conv = p.in[I_RCONV] + (size_t)l * 3 * RWKV_IN;
    const float* k_k = p.in[I_RKK] + (size_t)l * RW;
    const bool act = lane * 8 < RW, act2 = lane * 8 < 384;
    float kkw[8];
    if (act) load8f(k_k + lane * 8, kkw);
    else {
#pragma unroll
        for (int e = 0; e < 8; ++e) kkw[e] = 0.f;
    }
    for (int t = gw; t < MTOT; t += nw) {
        const bool first = (t == 0) || (t == CTX), last = (t == CTX - 1) || (t == MTOT - 1);
        const bf16_t* zp = p.Z + (size_t)t * ZLD + ZR;
        float rv[8], kv[8], vv[8], lr[8];
        conv8(zp, conv, 0 * RW + lane * 8, act, first, last, rv);
        conv8(zp, conv, 1 * RW + lane * 8, act, first, last, kv);
        conv8(zp, conv, 2 * RW + lane * 8, act, first, last, vv);
        conv8(zp, conv, 3 * RW + lane * 8, act2, first, last, lr);
        float kk[8]; float ss = 0.f;
#pragma unroll
        for (int e = 0; e < 8; ++e) { kk[e] = kv[e] * kkw[e]; ss += kk[e] * kk[e]; }
        ss += __shfl_xor(ss, 1, 64); ss += __shfl_xor(ss, 2, 64); ss += __shfl_xor(ss, 4, 64);
        const float inv = 1.0f / fmaxf(sqrtf(ss), 1e-12f);
#pragma unroll
        for (int e = 0; e < 8; ++e) kk[e] *= inv;
        if (act) {
            const size_t o = (size_t)t * RW + lane * 8;
            *(u32x4*)(p.R + o) = pack8(rv); *(u32x4*)(p.KS + o) = pack8(kv); *(u32x4*)(p.V + o) = pack8(vv); *(u32x4*)(p.KK + o) = pack8(kk);
        }
        if (act2) {
            const int cc = lane * 8;
            if (cc < 128) {
#pragma unroll
                for (int e = 0; e < 8; ++e) lr[e] = tanhf_(lr[e]);
                *(u32x4*)(p.LR + (size_t)t * 256 + cc) = pack8(lr);
            } else if (cc < 256) {
                *(u32x4*)(p.LR + (size_t)t * 256 + cc) = pack8(lr);
            } else {
#pragma unroll
                for (int e = 0; e < 8; ++e) lr[e] = sigmoidf_(lr[e]);
                *(u32x4*)(p.GS + (size_t)t * 128 + cc - 256) = pack8(lr);
            }
        }
    }
}
__device__ __forceinline__ void phase_rwkv_prep2(const P& p, int l, char* smem) {
    const int ntm = MTOT / 128, ntn = NPAD(RW) / 128;
    const float* k_a = p.in[I_RKA] + (size_t)l * RW;
    const float* r_k = p.in[I_RRK] + (size_t)l * RW;
    for (int job = obid(); job < ntm * ntn * 2; job += gridDim.x) {
        const int d = job % 2, n0 = ((job / 2) % ntn) * 128, m0 = (job / (2 * ntn)) * 128;
        const float* w0 = p.in[I_RW0] + (size_t)(l * 2 + d) * RW;
        const float* a0 = p.in[I_RA0] + (size_t)(l * 2 + d) * RW;
        f32x4 accw[4][4], acca[4][4]; ZERO_ACC4(accw); ZERO_ACC4(acca);
        mfma_gemm_tile(p.WT_W2 + (size_t)d * NPAD(RW) * 64, 64, p.LR + d * 64, 256, 64, n0, m0, (bf16_t*)smem, accw);
        mfma_gemm_tile(p.WT_A2 + (size_t)d * NPAD(RW) * 64, 64, p.LR + 128 + d * 64, 256, 64, n0, m0, (bf16_t*)smem, acca);
        const int lane = otid() & 63, wave = otid() >> 6;
#pragma unroll
        for (int mi = 0; mi < 4; ++mi) {
            const int m = m0 + (wave & 1) * 64 + mi * 16 + (lane & 15);
            float bon = 0.f;
#pragma unroll
            for (int ni = 0; ni < 4; ++ni) {
                const int n = n0 + (wave >> 1) * 64 + ni * 16 + (lane >> 4) * 4;
                if (n < RW) {
                    const u32x2 kq = *(const u32x2*)(p.KS + (size_t)m * RW + n), kkq = *(const u32x2*)(p.KK + (size_t)m * RW + n), rq = *(const u32x2*)(p.R + (size_t)m * RW + n);
                    const float kv[4] = {LO16(kq.x), HI16(kq.x), LO16(kq.y), HI16(kq.y)};
                    const float kkv[4] = {LO16(kkq.x), HI16(kkq.x), LO16(kkq.y), HI16(kkq.y)};
                    const float rv[4] = {LO16(rq.x), HI16(rq.x), LO16(rq.y), HI16(rq.y)};
                    float lw[4], kd[4], bb[4];
#pragma unroll
                    for (int e = 0; e < 4; ++e) {
                        const float x = w0[n + e] + accw[ni][mi][e];
                        lw[e] = -fexp_(-softplusf_(-x) - 0.5f);
                        const float aa = sigmoidf_(a0[n + e] + acca[ni][mi][e]);
                        kd[e] = kv[e] * (1.0f + (aa - 1.0f) * k_a[n + e]);
                        bb[e] = kkv[e] * aa;
                        bon += rv[e] * kd[e] * r_k[n + e];
                    }
                    const size_t o = ((size_t)d * MTOT + m) * RW + n;
                    float4 lo4; lo4.x = lw[0]; lo4.y = lw[1]; lo4.z = lw[2]; lo4.w = lw[3];
                    *(float4*)(p.LW + o) = lo4;
                    *(u32x2*)(p.KD + o) = pack4(kd[0], kd[1], kd[2], kd[3]);
                    *(u32x2*)(p.BB + o) = pack4(bb[0], bb[1], bb[2], bb[3]);
                }
            }
            bon += __shfl_xor(bon, 16, 64); bon += __shfl_xor(bon, 32, 64);
            const int hh = (n0 + (wave >> 1) * 64) >> 6;
            if ((lane >> 4) == 0 && hh < RH) p.BONUS[((size_t)d * MTOT + m) * RH + hh] = bon;
        }
    }
}

#define CH_ROW 72
#define SEQ_REC 16640
#define CH_SLOT (64 * CH_ROW)
#define CH_XR_OFF (7 * CH_SLOT * 2)
#define CH_AAB_OFF (CH_XR_OFF + 64 * 132 * 4)
#define CH_GC_OFF (CH_AAB_OFF + 64 * 72 * 4)
template <int MT, int NT>
__device__ __forceinline__ void lds_mm(const bf16_t* A, int m0, const bf16_t* Bt, int n0, f32x4 (&acc)[MT][NT]) {
    const int lane = otid() & 63, q = lane >> 4, r = lane & 15;
#pragma unroll
    for (int s = 0; s < 2; ++s) {
        bf16x8 a[MT], b[NT];
#pragma unroll
        for (int i = 0; i < MT; ++i) a[i] = *(const bf16x8*)(A + (m0 + i * 16 + r) * CH_ROW + s * 32 + q * 8);
#pragma unroll
        for (int i = 0; i < NT; ++i) b[i] = *(const bf16x8*)(Bt + (n0 + i * 16 + r) * CH_ROW + s * 32 + q * 8);
#pragma unroll
        for (int i = 0; i < MT; ++i)
#pragma unroll
            for (int jj = 0; jj < NT; ++jj) acc[i][jj] = MFMA16(a[i], b[jj], acc[i][jj]);
    }
}
__device__ __forceinline__ void rwkv_chunk_job(const P& p, int job, char* smem) {
    const int tid = otid(), lane = tid & 63, wv = tid >> 6, q = lane >> 4, r = lane & 15;
    const int d = job / (NC * RH), n = (job / RH) % NC, h = job % RH;
    const size_t base = (size_t)(d * NC + n) * RH + h;
    bf16_t* S0 = (bf16_t*)smem; bf16_t* S1 = S0 + CH_SLOT; bf16_t* S2 = S1 + CH_SLOT; bf16_t* S3 = S2 + CH_SLOT;
    bf16_t* S4 = S3 + CH_SLOT; bf16_t* S5 = S4 + CH_SLOT; bf16_t* S6 = S5 + CH_SLOT;
    float* X = (float*)(smem + CH_XR_OFF);
    float* AABt = (float*)(smem + CH_AAB_OFF);
    bf16_t* U0t = (bf16_t*)(smem + CH_AAB_OFF);
    bf16_t* Aht = U0t + CH_SLOT;
    float* GC = (float*)(smem + CH_GC_OFF);
    __syncthreads();
    u32x4 gkk[2], gr[2], gv[2], gkd[2], gbb[2]; float lw[2][8];
#pragma unroll
    for (int it = 0; it < 2; ++it) {
        const int c = tid + 256 * it, i = c >> 3, k0 = (c & 7) * 8; const int tok = 64 * n + (d ? 63 - i : i);
        const size_t o1 = (size_t)tok * RW + h * 64 + k0, o2 = ((size_t)d * MTOT + tok) * RW + h * 64 + k0;
        load8f(p.LW + o2, lw[it]);
        gkk[it] = *(const u32x4*)(p.KK + o1); gr[it] = *(const u32x4*)(p.R + o1); gv[it] = *(const u32x4*)(p.V + o1);
        gkd[it] = *(const u32x4*)(p.KD + o2); gbb[it] = *(const u32x4*)(p.BB + o2);
    }
#pragma unroll
    for (int it = 0; it < 2; ++it) { const int c = tid + 256 * it; store8f(X + (c >> 3) * 132 + (c & 7) * 8, lw[it]); }
    __syncthreads();
    {
        const int k = tid & 63, seg = tid >> 6;
        float v[16]; float run = 0.f;
#pragma unroll
        for (int e = 0; e < 16; ++e) { run += X[(seg * 16 + e) * 132 + k]; v[e] = run; }
        AABt[seg * 64 + k] = run;
        __syncthreads();
        float off = 0.f;
        for (int s2 = 0; s2 < seg; ++s2) off += AABt[s2 * 64 + k];
#pragma unroll
        for (int e = 0; e < 16; ++e) X[(seg * 16 + e) * 132 + k] = v[e] + off;
    }
    __syncthreads();
#pragma unroll
    for (int it = 0; it < 2; ++it) {
        const int c = tid + 256 * it, i = c >> 3, k0 = (c & 7) * 8;
        float L[8], Lp[8], LC[8], kkv[8], rv[8], vv[8], kdv[8], bbv[8];
        load8f(X + i * 132 + k0, L); load8f(X + 63 * 132 + k0, LC);
        if (i > 0) load8f(X + (i - 1) * 132 + k0, Lp);
        else {
#pragma unroll
            for (int e = 0; e < 8; ++e) Lp[e] = 0.f;
        }
        unpack8(gkk[it], kkv); unpack8(gr[it], rv); unpack8(gv[it], vv); unpack8(gkd[it], kdv); unpack8(gbb[it], bbv);
        float at[8], rt[8], bt[8], kt[8], bh[8], kh[8];
#pragma unroll
        for (int e = 0; e < 8; ++e) {
            const float eL = fexp_(L[e]), eLp = fexp_(Lp[e]), eNL = fexp_(-L[e]), eCL = fexp_(LC[e] - L[e]);
            at[e] = -kkv[e] * eLp; rt[e] = rv[e] * eL; bt[e] = bbv[e] * eNL; kt[e] = kdv[e] * eNL; bh[e] = bbv[e] * eCL; kh[e] = kdv[e] * eCL;
            if (i == 63) GC[k0 + e] = eL;
        }
        *(u32x4*)(S0 + i * CH_ROW + k0) = pack8(at);
        store8f(X + i * 132 + 64 + k0, at);
        *(u32x4*)(S1 + i * CH_ROW + k0) = pack8(rt);
        *(u32x4*)(S2 + i * CH_ROW + k0) = pack8(bt);
        *(u32x4*)(S3 + i * CH_ROW + k0) = pack8(kt);
#pragma unroll
        for (int e = 0; e < 8; ++e) {
            S4[(k0 + e) * CH_ROW + i] = f2bf(vv[e]);
            S5[(k0 + e) * CH_ROW + i] = f2bf(bh[e]);
            S6[(k0 + e) * CH_ROW + i] = f2bf(kh[e]);
        }
    }
    __syncthreads();
    {
        f32x4 acc[4][4]; ZERO_ACC4(acc);
        lds_mm<4, 4>((wv < 2) ? S0 : S1, 0, (wv & 1) ? S3 : S2, 0, acc);
        __syncthreads();
#pragma unroll
        for (int mt = 0; mt < 4; ++mt)
#pragma unroll
            for (int nt = 0; nt < 4; ++nt) {
                const int jc = nt * 16 + r, i0 = mt * 16 + 4 * q;
                if (wv == 0) {
                    f32x4 o;
#pragma unroll
                    for (int e = 0; e < 4; ++e) o[e] = (jc < i0 + e) ? acc[mt][nt][e] : 0.f;
                    *(f32x4*)(AABt + jc * 72 + i0) = o;
                } else {
                    bf16_t* dst = (wv == 1) ? S0 : ((wv == 2) ? S2 : S3);
#pragma unroll
                    for (int e = 0; e < 4; ++e) {
                        const bool ok = (wv == 1) ? (jc < i0 + e) : (jc <= i0 + e);
                        dst[(i0 + e) * CH_ROW + jc] = f2bf(ok ? acc[mt][nt][e] : 0.f);
                    }
                }
            }
    }
    __syncthreads();
    {
        f32x4 acc[1][4];
#pragma unroll
        for (int nt = 0; nt < 4; ++nt) acc[0][nt] = (f32x4){0.f, 0.f, 0.f, 0.f};
        lds_mm<1, 4>(S0, 16 * wv, S4, 0, acc);
#pragma unroll
        for (int nt = 0; nt < 4; ++nt)
#pragma unroll
            for (int e = 0; e < 4; ++e) X[(16 * wv + 4 * q + e) * 132 + nt * 16 + r] = acc[0][nt][e];
    }
    __syncthreads();
    if (tid < 128) {
        const int c = tid;
        for (int bi = 0; bi < 4; ++bi) {
            float acc[16];
#pragma unroll
            for (int e = 0; e < 16; ++e) acc[e] = X[(16 * bi + e) * 132 + c];
            for (int jj = 0; jj < 16 * bi; ++jj) {
                const float uj = X[jj * 132 + c];
                const f32x4* ap = (const f32x4*)(AABt + jj * 72 + 16 * bi);
                const f32x4 a0 = ap[0], a1 = ap[1], a2 = ap[2], a3 = ap[3];
#pragma unroll
                for (int e = 0; e < 4; ++e) { acc[e] += a0[e] * uj; acc[4 + e] += a1[e] * uj; acc[8 + e] += a2[e] * uj; acc[12 + e] += a3[e] * uj; }
            }
#pragma unroll
            for (int e = 0; e < 16; ++e) {
                const float u = acc[e];
                X[(16 * bi + e) * 132 + c] = u;
                const f32x4* ap = (const f32x4*)(AABt + (16 * bi + e) * 72 + 16 * bi);
                const f32x4 a0 = ap[0], a1 = ap[1], a2 = ap[2], a3 = ap[3];
#pragma unroll
                for (int e2 = 0; e2 < 16; ++e2) if (e2 > e) acc[e2] += ((e2 < 4) ? a0[e2 & 3] : (e2 < 8) ? a1[e2 & 3] : (e2 < 12) ? a2[e2 & 3] : a3[e2 & 3]) * u;
            }
        }
    }
    __syncthreads();
    if (tid < 128) {
        const int c = tid;
        bf16_t* dst = (c < 64) ? (U0t + c * CH_ROW) : (Aht + (c - 64) * CH_ROW);
        u32x4 ov[8];
#pragma unroll
        for (int g = 0; g < 8; ++g) {
            float v[8];
#pragma unroll
            for (int e = 0; e < 8; ++e) v[e] = X[(g * 8 + e) * 132 + c];
            ov[g].x = pack2bf(v[0], v[1]); ov[g].y = pack2bf(v[2], v[3]);
            ov[g].z = pack2bf(v[4], v[5]); ov[g].w = pack2bf(v[6], v[7]);
        }
#pragma unroll
        for (int g = 0; g < 8; ++g) *(u32x4*)(dst + g * 8) = ov[g];
    }
    __syncthreads();
    {
        f32x4 acc[4][4]; ZERO_ACC4(acc);
        char* rec = p.REC + base * SEQ_REC;
        if (wv == 0) {
            lds_mm<4, 4>(Aht, 0, S5, 0, acc);
#pragma unroll
            for (int nt = 0; nt < 4; ++nt)
#pragma unroll
                for (int s2 = 0; s2 < 2; ++s2) {
                    u32x4 o;
                    o.x = pack2bf(acc[2 * s2][nt][0], acc[2 * s2][nt][1]); o.y = pack2bf(acc[2 * s2][nt][2], acc[2 * s2][nt][3]);
                    o.z = pack2bf(acc[2 * s2 + 1][nt][0], acc[2 * s2 + 1][nt][1]); o.w = pack2bf(acc[2 * s2 + 1][nt][2], acc[2 * s2 + 1][nt][3]);
                    *(u32x4*)(rec + (((nt * 2 + s2) * 64 + lane) * 8) * 2) = o;
                }
        } else if (wv == 1) {
            lds_mm<4, 4>(S5, 0, U0t, 0, acc);
            lds_mm<4, 4>(S6, 0, S4, 0, acc);
#pragma unroll
            for (int mt = 0; mt < 4; ++mt)
#pragma unroll
                for (int nt = 0; nt < 4; ++nt) *(u32x2*)(rec + 8192 + (((nt * 4 + mt) * 64 + lane) * 4) * 2) = pack4(acc[mt][nt][0], acc[mt][nt][1], acc[mt][nt][2], acc[mt][nt][3]);
        } else if (wv == 2) {
            lds_mm<4, 4>(S2, 0, Aht, 0, acc);
#pragma unroll
            for (int mt = 0; mt < 4; ++mt)
#pragma unroll
                for (int nt = 0; nt < 4; ++nt)
#pragma unroll
                    for (int e = 0; e < 4; ++e) {
                        const int t = mt * 16 + 4 * q + e, kc = nt * 16 + r;
                        p.QH[(base * 64 + t) * 64 + kc] = f2bf(acc[mt][nt][e] + bf2f(S1[t * CH_ROW + kc]));
                    }
        } else if (wv == 3) {
            lds_mm<4, 4>(S2, 0, U0t, 0, acc);
            lds_mm<4, 4>(S3, 0, S4, 0, acc);
#pragma unroll
            for (int mt = 0; mt < 4; ++mt)
#pragma unroll
                for (int nt = 0; nt < 4; ++nt) *(f32x4*)(p.Y0T + (((base * 4 + mt) * 4 + nt) * 64 + lane) * 4) = acc[mt][nt];
        }
        if (tid < 64) ((float*)(rec + 16384))[tid] = GC[tid];
    }
}

#define SEQ_SLOT 16896
__device__ __forceinline__ void rwkv_seq_gload(const P& p, size_t base, int tid, u32x4 (&g)[5]) {
    const u32x4* m = (const u32x4*)(p.REC + base * SEQ_REC);
#pragma unroll
    for (int i = 0; i < 4; ++i) g[i] = m[tid + 256 * i];
    if (tid < 16) g[4] = m[1024 + tid];
}
__device__ __forceinline__ void rwkv_seq_lstore(char* slot, int tid, const u32x4 (&g)[5]) {
    u32x4* d = (u32x4*)slot;
#pragma unroll
    for (int i = 0; i < 4; ++i) d[tid + 256 * i] = g[i];
    if (tid < 16) d[1024 + tid] = g[4];
}
__device__ __forceinline__ void rwkv_seq_step(const P& p, const char* slot, size_t base, int wv, int lane, f32x4 (&X)[4]) {
    const int q = lane >> 4, r = lane & 15;
    const bf16_t* mt = (const bf16_t*)slot; const bf16_t* ntb = (const bf16_t*)(slot + 8192); const float* gc = (const float*)(slot + 16384);
    unsigned xh[4][2];
#pragma unroll
    for (int kt = 0; kt < 4; ++kt) {
        xh[kt][0] = pack2bf(X[kt][0], X[kt][1]); xh[kt][1] = pack2bf(X[kt][2], X[kt][3]);
        *(u32x2*)(p.SN + (base * 64 + 16 * wv + r) * 64 + 16 * kt + 4 * q) = (u32x2){xh[kt][0], xh[kt][1]};
    }
    bf16x8 bh[2];
#pragma unroll
    for (int s2 = 0; s2 < 2; ++s2) bh[s2] = __builtin_bit_cast(bf16x8, ((u32x4){xh[2 * s2][0], xh[2 * s2][1], xh[2 * s2 + 1][0], xh[2 * s2 + 1][1]}));
#pragma unroll
    for (int tile = 0; tile < 4; ++tile) {
        const u32x2 nb = *(const u32x2*)(ntb + ((wv * 4 + tile) * 64 + lane) * 4);
        const f32x4 g4 = *(const f32x4*)(gc + tile * 16 + 4 * q);
        f32x4 acc;
        acc[0] = g4[0] * X[tile][0] + LO16(nb.x); acc[1] = g4[1] * X[tile][1] + HI16(nb.x);
        acc[2] = g4[2] * X[tile][2] + LO16(nb.y); acc[3] = g4[3] * X[tile][3] + HI16(nb.y);
#pragma unroll
        for (int s2 = 0; s2 < 2; ++s2) {
            const bf16x8 ah = *(const bf16x8*)(mt + ((tile * 2 + s2) * 64 + lane) * 8);
            acc = MFMA16(ah, bh[s2], acc);
        }
        X[tile] = acc;
    }
}
__device__ __forceinline__ void rwkv_seq_job(const P& p, int job, char* smem) {
    const int tid = otid(), lane = tid & 63, wv = tid >> 6;
    const int d = job / RH, h = job % RH;
    f32x4 X[4];
#pragma unroll
    for (int kt = 0; kt < 4; ++kt) X[kt] = (f32x4){0.f, 0.f, 0.f, 0.f};
    u32x4 g0[5], g1[5], g2[5];
#define SEQ_BASE(s_) ((size_t)(d * NC + chunk_order(d, ((s_) < NC) ? (s_) : NC - 1)) * RH + h)
    __syncthreads();
    rwkv_seq_gload(p, SEQ_BASE(0), tid, g0);
    rwkv_seq_gload(p, SEQ_BASE(1), tid, g1);
    rwkv_seq_gload(p, SEQ_BASE(2), tid, g2);
    rwkv_seq_lstore(smem, tid, g0);
    __syncthreads();
    for (int s = 0; s < NC; s += 6) {
#define SEQ_SUB(u, GFREE, GNEXT) \
        if (s + (u) < NC) { \
            rwkv_seq_gload(p, SEQ_BASE(s + (u) + 3), tid, GFREE); \
            rwkv_seq_step(p, smem + (((u) & 1) ? SEQ_SLOT : 0), SEQ_BASE(s + (u)), wv, lane, X); \
            rwkv_seq_lstore(smem + (((u) & 1) ? 0 : SEQ_SLOT), tid, GNEXT); \
        } \
        __syncthreads();
        SEQ_SUB(0, g0, g1)
        SEQ_SUB(1, g1, g2)
        SEQ_SUB(2, g2, g0)
        SEQ_SUB(3, g0, g1)
        SEQ_SUB(4, g1, g2)
        SEQ_SUB(5, g2, g0)
#undef SEQ_SUB
    }
#undef SEQ_BASE
}
struct RoBuf { bf16x8 a[2]; bf16x8 b[4][2]; f32x4 y0[4]; };
__device__ __forceinline__ void rwkv_out_load(const P& p, int job, int wv, int lane, RoBuf& o) {
    const int q = lane >> 4, r = lane & 15;
    const size_t base = (size_t)job;
#pragma unroll
    for (int s2 = 0; s2 < 2; ++s2) {
        o.a[s2] = *(const bf16x8*)(p.QH + (base * 64 + 16 * wv + r) * 64 + s2 * 32 + q * 8);
#pragma unroll
        for (int nt = 0; nt < 4; ++nt) o.b[nt][s2] = *(const bf16x8*)(p.SN + (base * 64 + nt * 16 + r) * 64 + s2 * 32 + q * 8);
    }
#pragma unroll
    for (int nt = 0; nt < 4; ++nt) o.y0[nt] = *(const f32x4*)(p.Y0T + (((base * 4 + wv) * 4 + nt) * 64 + lane) * 4);
}
__device__ __forceinline__ void rwkv_out_compute(const P& p, int job, int wv, int lane, const RoBuf& o) {
    const int q = lane >> 4, r = lane & 15;
    const int d = job / (NC * RH), n = (job / RH) % NC, h = job % RH;
#pragma unroll
    for (int nt = 0; nt < 4; ++nt) {
        f32x4 acc = o.y0[nt];
        acc = MFMA16(o.a[0], o.b[nt][0], acc);
        acc = MFMA16(o.a[1], o.b[nt][1], acc);
#pragma unroll
        for (int e = 0; e < 4; ++e) {
            const int t = 16 * wv + 4 * q + e; const int tok = 64 * n + (d ? 63 - t : t);
            p.Y[((size_t)d * MTOT + tok) * RW + h * 64 + nt * 16 + r] = acc[e];
        }
    }
}
__device__ __forceinline__ void phase_rwkv_out(const P& p) {
    const int tid = otid(), lane = tid & 63, wv = tid >> 6;
    if (wv >= 4) return;
    const int G = gridDim.x, total = 2 * NC * RH;
    int job = obid();
    if (job >= total) return;
    RoBuf b0, b1;
    rwkv_out_load(p, job, wv, lane, b0);
    for (; job < total; job += 2 * G) {
        if (job + G < total) rwkv_out_load(p, job + G, wv, lane, b1);
        rwkv_out_compute(p, job, wv, lane, b0);
        if (job + G < total) {
            if (job + 2 * G < total) rwkv_out_load(p, job + 2 * G, wv, lane, b0);
            rwkv_out_compute(p, job + G, wv, lane, b1);
        }
    }
}

#define GL_QR 0
#define GL_KR 9216
#define GL_VT 18432
#define GL_QI 36864
#define GL_KI 46080
#define GL_AT 55296
#define GL_CUM 64512
#define GL_ALR 81920
#define GL_WA 86016
__device__ __forceinline__ void gla_load_qkv(const P& p, int n, int h, char* smem) {
    const int tid = otid();
    bf16_t* Qr = (bf16_t*)(smem + GL_QR); bf16_t* Kr = (bf16_t*)(smem + GL_KR); bf16_t* Vt = (bf16_t*)(smem + GL_VT);
    for (int c = tid; c < 512; c += NTHREADS) {
        const int row = c >> 3, part = c & 7; const int t = gla_tok(n, row);
        const u32x4 qv = *(const u32x4*)(p.Z + (size_t)t * ZLD + ZQ + h * 64 + part * 8);
        const u32x4 kv = *(const u32x4*)(p.Z + (size_t)t * ZLD + ZK + h * 64 + part * 8);
        u32x4 qs;
        qs.x = pack2bf(LO16(qv.x) * 0.125f, HI16(qv.x) * 0.125f);
        qs.y = pack2bf(LO16(qv.y) * 0.125f, HI16(qv.y) * 0.125f);
        qs.z = pack2bf(LO16(qv.z) * 0.125f, HI16(qv.z) * 0.125f);
        qs.w = pack2bf(LO16(qv.w) * 0.125f, HI16(qv.w) * 0.125f);
        *(u32x4*)(Qr + row * CH_ROW + part * 8) = qs;
        *(u32x4*)(Kr + row * CH_ROW + part * 8) = kv;
    }
    for (int c = tid; c < 1024; c += NTHREADS) {
        const int row = c >> 4, part = c & 15; const int t = gla_tok(n, row);
        const u32x4 vv = *(const u32x4*)(p.Z + (size_t)t * ZLD + ZV + h * 128 + part * 8);
        bf16_t* dst = Vt + (part * 8) * CH_ROW + row;
        dst[0 * CH_ROW] = (bf16_t)(vv.x & 0xFFFF); dst[1 * CH_ROW] = (bf16_t)(vv.x >> 16);
        dst[2 * CH_ROW] = (bf16_t)(vv.y & 0xFFFF); dst[3 * CH_ROW] = (bf16_t)(vv.y >> 16);
        dst[4 * CH_ROW] = (bf16_t)(vv.z & 0xFFFF); dst[5 * CH_ROW] = (bf16_t)(vv.z >> 16);
        dst[6 * CH_ROW] = (bf16_t)(vv.w & 0xFFFF); dst[7 * CH_ROW] = (bf16_t)(vv.w >> 16);
    }
}
__device__ __forceinline__ void gla_cum(const P& p, int l, int n, int h, int d, char* smem) {
    const int tid = otid();
    float* CUM = (float*)(smem + GL_CUM); float* ALR = (float*)(smem + GL_ALR); float* WA = (float*)(smem + GL_WA);
    for (int c = tid; c < 256; c += NTHREADS) {
        const int row = c >> 2, part = c & 3; const int t = gla_tok(n, row);
        const u32x2 a = *(const u32x2*)(p.Z + (size_t)t * ZLD + (d ? ZAB : ZAF) + part * 4);
        float* dst = ALR + row * 16 + part * 4;
        dst[0] = LO16(a.x); dst[1] = HI16(a.x); dst[2] = LO16(a.y); dst[3] = HI16(a.y);
    }
    for (int c = tid; c < 16 * 64 + 64; c += NTHREADS) {
        if (c < 1024) WA[c] = p.in[I_GLA_WA2][((size_t)(l * 2 + d) * 16 + (c >> 6)) * GLA_K + h * 64 + (c & 63)];
        else WA[c] = p.in[I_GLA_BA][(size_t)(l * 2 + d) * GLA_K + h * 64 + (c - 1024)];
    }
    __syncthreads();
    for (int idx = tid; idx < 4096; idx += NTHREADS) {
        const int i = idx >> 6, k = idx & 63;
        float a = WA[1024 + k];
#pragma unroll
        for (int r = 0; r < 16; ++r) a += ALR[i * 16 + r] * WA[r * 64 + k];
        CUM[i * 68 + k] = (fminf(a, 0.f) - flog_(1.0f + fexp_(-fabsf(a)))) * (1.0f / 16.0f);
    }
    __syncthreads();
    {
        const int k = tid & 63, seg = (tid >> 6) & 3;
        float v[16]; float run = 0.f;
        if (tid < 256) {
#pragma unroll
            for (int e = 0; e < 16; ++e) { const int pos = seg * 16 + e; const int i = d ? 63 - pos : pos; run += CUM[i * 68 + k]; v[e] = run; }
            ALR[seg * 64 + k] = run;
        }
        __syncthreads();
        if (tid < 256) {
            float off = 0.f;
            for (int s2 = 0; s2 < seg; ++s2) off += ALR[s2 * 64 + k];
#pragma unroll
            for (int e = 0; e < 16; ++e) { const int pos = seg * 16 + e; const int i = d ? 63 - pos : pos; CUM[i * 68 + k] = v[e] + off; }
        }
    }
    __syncthreads();
}
__device__ __forceinline__ void phase_gla_kv(const P& p, int l, char* smem) {
    const int tid = otid(), lane = tid & 63, wv = tid >> 6, q = lane >> 4, r = lane & 15;
    bf16_t* Kr = (bf16_t*)(smem + GL_KR); bf16_t* Vt = (bf16_t*)(smem + GL_VT); bf16_t* KdT = (bf16_t*)(smem + GL_KI);
    float* CUM = (float*)(smem + GL_CUM);
    for (int job = obid(); job < NC * GH; job += gridDim.x) {
        const int n = job / GH, h = job % GH;
        __syncthreads();
        gla_load_qkv(p, n, h, smem);
        for (int d = 0; d < 2; ++d) {
            gla_cum(p, l, n, h, d, smem);
            const int li = d ? 0 : 63;
            for (int idx = tid; idx < 4096; idx += NTHREADS) {
                const int i = idx >> 6, k = idx & 63;
                KdT[k * CH_ROW + i] = f2bf(bf2f(Kr[i * CH_ROW + k]) * fexp_(CUM[li * 68 + k] - CUM[i * 68 + k]));
            }
            if (tid < 64) p.DEC[((size_t)(d * NC + n) * GH + h) * 64 + tid] = fexp_(CUM[li * 68 + tid]);
            __syncthreads();
            float* kvt = p.KV + ((size_t)(d * NC + n) * GH + h) * 8192;
            for (int mt = wv; mt < 4; mt += NTHREADS / 64) {
                f32x4 acc[1][8];
#pragma unroll
                for (int nt = 0; nt < 8; ++nt) acc[0][nt] = (f32x4){0.f, 0.f, 0.f, 0.f};
                lds_mm<1, 8>(KdT, 16 * mt, Vt, 0, acc);
#pragma unroll
                for (int nt = 0; nt < 8; ++nt) *(f32x4*)(kvt + (size_t)(nt * 16 + r) * 64 + 16 * mt + 4 * q) = acc[0][nt];
            }
            __syncthreads();
        }
    }
    __syncthreads();
}
__device__ __forceinline__ void gla_scan_job(const P& p, int job) {
    const int base = job * NTHREADS + otid();
    const int d = base / (GH * 8192), h = (base / 8192) % GH, e = base % 8192;
    const float* __restrict__ kvp = p.KV; const float* __restrict__ decp = p.DEC; bf16_t* __restrict__ sp = p.SP;
    float S = 0.f;
    for (int s = 0; s < NC; s += 4) {
        float kv[4], dc[4]; size_t oo[4];
#pragma unroll
        for (int u = 0; u < 4; ++u) {
            const int n = chunk_order(d, (s + u < NC) ? s + u : NC - 1);
            oo[u] = ((size_t)(d * NC + n) * GH + h);
            kv[u] = kvp[oo[u] * 8192 + e]; dc[u] = decp[oo[u] * 64 + (e & 63)];
        }
#pragma unroll
        for (int u = 0; u < 4; ++u) if (s + u < NC) { sp[oo[u] * 8192 + e] = f2bf(S); S = dc[u] * S + kv[u]; }
    }
}
__device__ __forceinline__ void phase_gla_out(const P& p, int l, char* smem) {
    const int tid = otid(), lane = tid & 63, wv = tid >> 6, q = lane >> 4, r = lane & 15;
    bf16_t* Qr = (bf16_t*)(smem + GL_QR); bf16_t* Kr = (bf16_t*)(smem + GL_KR); bf16_t* Vt = (bf16_t*)(smem + GL_VT);
    bf16_t* Qi = (bf16_t*)(smem + GL_QI); bf16_t* Ki = (bf16_t*)(smem + GL_KI); bf16_t* At = (bf16_t*)(smem + GL_AT);
    float* CUM = (float*)(smem + GL_CUM);
    for (int job = obid(); job < NC * GH; job += gridDim.x) {
        const int n = job / GH, h = job % GH;
        __syncthreads();
        gla_load_qkv(p, n, h, smem);
        f32x4 o[1][8];
#pragma unroll
        for (int nt = 0; nt < 8; ++nt) o[0][nt] = (f32x4){0.f, 0.f, 0.f, 0.f};
        for (int d = 0; d < 2; ++d) {
            gla_cum(p, l, n, h, d, smem);
            for (int idx = tid; idx < 4096; idx += NTHREADS) {
                const int i = idx >> 6, k = idx & 63; const float c = CUM[i * 68 + k];
                Qi[i * CH_ROW + k] = f2bf(bf2f(Qr[i * CH_ROW + k]) * fexp_(c));
                Ki[i * CH_ROW + k] = f2bf(bf2f(Kr[i * CH_ROW + k]) * fexp_(-c));
            }
            __syncthreads();
            if (wv < 4) {
                f32x4 a[1][4];
#pragma unroll
                for (int nt = 0; nt < 4; ++nt) a[0][nt] = (f32x4){0.f, 0.f, 0.f, 0.f};
                lds_mm<1, 4>(Qi, 16 * wv, Ki, 0, a);
#pragma unroll
                for (int nt = 0; nt < 4; ++nt)
#pragma unroll
                    for (int e = 0; e < 4; ++e) {
                        const int i = 16 * wv + 4 * q + e, j = nt * 16 + r;
                        const bool ok = d ? (j >= i) : (j <= i);
                        At[i * CH_ROW + j] = f2bf(ok ? a[0][nt][e] : 0.f);
                    }
                WAVE_SYNC();
                lds_mm<1, 8>(At, 16 * wv, Vt, 0, o);
                const bf16_t* sp = p.SP + ((size_t)(d * NC + n) * GH + h) * 8192;
#pragma unroll
                for (int s2 = 0; s2 < 2; ++s2) {
                    const bf16x8 af = *(const bf16x8*)(Qi + (16 * wv + r) * CH_ROW + s2 * 32 + q * 8);
#pragma unroll
                    for (int nt = 0; nt < 8; ++nt) {
                        const bf16x8 bfr = *(const bf16x8*)(sp + (size_t)(nt * 16 + r) * 64 + s2 * 32 + q * 8);
                        o[0][nt] = MFMA16(af, bfr, o[0][nt]);
                    }
                }
            }
            __syncthreads();
        }
        if (wv < 4) {
#pragma unroll
            for (int nt = 0; nt < 8; ++nt)
#pragma unroll
                for (int e = 0; e < 4; ++e) {
                    const int t = gla_tok(n, 16 * wv + 4 * q + e);
                    p.OGLA[(size_t)t * GLA_V + h * 128 + nt * 16 + r] = o[0][nt][e];
                }
        }
    }
    __syncthreads();
}

#define S5_XH_OFF (2 * 64 * 132 * 4)
#define S5_XL_OFF (S5_XH_OFF + 64 * 136 * 2)
#define S5_CT_OFF (S5_XL_OFF + 64 * 136 * 2)
__device__ __forceinline__ void phase_s5_pass(const P& p, int l, char* smem, bool with_out) {
    const int tid = otid(), lane = tid & 63, wv = tid >> 6, q = lane >> 4, r = lane & 15;
    float* BU = (float*)smem; bf16_t* XH = (bf16_t*)(smem + S5_XH_OFF); bf16_t* XL = (bf16_t*)(smem + S5_XL_OFF); bf16_t* CTp = (bf16_t*)(smem + S5_CT_OFF);
    const int dW = (wv >> 1) & 1, ntb = (wv & 1) * 4;
    const int dS = (tid >> 6) & 1, st = tid & 63;
    bf16x8 bhi[4], blo[4];
    float are = 0.f, aim = 0.f, dco = 0.f;
    int cur_g = -1;
    const bf16x8 zero8 = {0, 0, 0, 0, 0, 0, 0, 0};
    bf16x8 a_cur[4]; float2 car_cur = {0.f, 0.f};
#define S5_FETCH(JOB, A, CAR) { const int n_ = (JOB) / SG, g_ = (JOB) % SG; \
        if (wv < 4) { _Pragma("unroll") for (int mt = 0; mt < 4; ++mt) A[mt] = (q < 2) ? *(const bf16x8*)(p.Z + (size_t)(n_ * 64 + 16 * mt + r) * ZLD + ZS5 + g_ * 16 + 8 * q) : zero8; } \
        if (with_out && tid < 128) CAR = *(const float2*)(p.S5CAR + ((((size_t)dS * NC + n_) * SG + g_) * 64 + st) * 2); }
    if (obid() < NC * SG) S5_FETCH(obid(), a_cur, car_cur);
    for (int job = obid(); job < NC * SG; job += gridDim.x) {
        const int n = job / SG, g = job % SG;
        __syncthreads();
        if (g != cur_g) {
            cur_g = g;
            if (wv < 4) {
#pragma unroll
                for (int jn = 0; jn < 4; ++jn) {
                    const int kk = 16 * (ntb + jn) + r; const size_t ci = ((size_t)dW * SG + g) * 64 + (kk >> 1);
                    float f[8], lo[8];
#pragma unroll
                    for (int e = 0; e < 8; ++e) f[e] = (q < 2) ? p.S5BB[(ci * 16 + 8 * q + e) * 2 + (kk & 1)] : 0.f;
                    const u32x4 hv = pack8(f);
                    float hf[8]; unpack8(hv, hf);
#pragma unroll
                    for (int e = 0; e < 8; ++e) lo[e] = f[e] - hf[e];
                    bhi[jn] = __builtin_bit_cast(bf16x8, hv); blo[jn] = __builtin_bit_cast(bf16x8, pack8(lo));
                }
            }
            if (tid < 128) { const size_t ci = ((size_t)dS * SG + g) * 64 + st; are = p.S5A[ci * 2]; aim = p.S5A[ci * 2 + 1]; }
            if (with_out) {
                for (int idx = tid; idx < 16 * 128; idx += NTHREADS) {
                    const int c = idx >> 7, kk = idx & 127;
                    const float v = (kk & 1) ? -p.in[I_S5CIM][((size_t)l * SG + g) * 1024 + c * 64 + (kk >> 1)] : p.in[I_S5CRE][((size_t)l * SG + g) * 1024 + c * 64 + (kk >> 1)];
                    CTp[c * 136 + kk] = f2bf(v);
                }
                dco = p.in[I_S5D][(size_t)l * SW + g * 16 + r];
            }
        }
        float xr = car_cur.x, xi = car_cur.y;
        const size_t eo = (((size_t)dS * NC + n) * SG + g) * 64 + st;
        unsigned short uu[4] = {0, 0, 0, 0};
        if (with_out && wv < 4) {
#pragma unroll
            for (int e = 0; e < 4; ++e) uu[e] = p.Z[(size_t)(n * 64 + 16 * wv + 4 * q + e) * ZLD + ZS5 + g * 16 + r];
        }
        if (wv < 4) {
#pragma unroll
            for (int mt = 0; mt < 4; ++mt) {
                const bf16x8 a = a_cur[mt];
#pragma unroll
                for (int jn = 0; jn < 4; ++jn) {
                    f32x4 acc = {0.f, 0.f, 0.f, 0.f};
                    acc = MFMA16(a, bhi[jn], acc);
                    acc = MFMA16(a, blo[jn], acc);
#pragma unroll
                    for (int e = 0; e < 4; ++e) BU[(dW * 64 + 16 * mt + 4 * q + e) * 132 + 16 * (ntb + jn) + r] = acc[e];
                }
            }
        }
        if (job + (int)gridDim.x < NC * SG) S5_FETCH(job + (int)gridDim.x, a_cur, car_cur);
        __syncthreads();
        if (tid < 128) {
            float2* bp0 = (float2*)(BU + (dS * 64 + (dS ? 63 : 0)) * 132 + st * 2);
#define S5_SCAN(SGN) { _Pragma("unroll 1") for (int ib = 0; ib < 4; ++ib) { float2 bv[16]; \
                _Pragma("unroll") for (int u = 0; u < 16; ++u) bv[u] = bp0[(SGN) * (ib * 16 + u) * 66]; \
                _Pragma("unroll") for (int u = 0; u < 16; ++u) { \
                    const float nr = are * xr - aim * xi + bv[u].x, ni = are * xi + aim * xr + bv[u].y; xr = nr; xi = ni; \
                    if (with_out) { float2 o; o.x = xr; o.y = xi; bp0[(SGN) * (ib * 16 + u) * 66] = o; } } } }
            if (dS) S5_SCAN(-1) else S5_SCAN(1)
            if (!with_out) { float2 o; o.x = xr; o.y = xi; *(float2*)(p.S5END + eo * 2) = o; }
        }
        if (with_out) {
            __syncthreads();
            for (int cidx = tid; cidx < 64 * 16; cidx += NTHREADS) {
                const int i = cidx >> 4, k0 = (cidx & 15) * 8;
                float a[8], b[8], lo[8];
                load8f(BU + (0 * 64 + i) * 132 + k0, a); load8f(BU + (1 * 64 + i) * 132 + k0, b);
#pragma unroll
                for (int e = 0; e < 8; ++e) a[e] += b[e];
                const u32x4 hv = pack8(a);
                float hf[8]; unpack8(hv, hf);
#pragma unroll
                for (int e = 0; e < 8; ++e) lo[e] = a[e] - hf[e];
                *(u32x4*)(XH + i * 136 + k0) = hv; *(u32x4*)(XL + i * 136 + k0) = pack8(lo);
            }
            __syncthreads();
            if (wv < 4) {
                f32x4 acc = {0.f, 0.f, 0.f, 0.f};
#pragma unroll
                for (int ks = 0; ks < 4; ++ks) {
                    const bf16x8 ah = *(const bf16x8*)(XH + (16 * wv + r) * 136 + ks * 32 + q * 8), al = *(const bf16x8*)(XL + (16 * wv + r) * 136 + ks * 32 + q * 8);
                    const bf16x8 b = *(const bf16x8*)(CTp + r * 136 + ks * 32 + q * 8);
                    acc = MFMA16(ah, b, acc);
                    acc = MFMA16(al, b, acc);
                }
#pragma unroll
                for (int e = 0; e < 4; ++e) {
                    const int i = 16 * wv + 4 * q + e;
                    const float u = bf2f(uu[e]);
                    p.GY[(size_t)(n * 64 + i) * SW + g * 16 + r] = f2bf(geluf_(acc[e] + dco * u));
                }
            }
        }
    }
    __syncthreads();
}
__device__ __forceinline__ void s5_carry_job(const P& p, int job) {
    const int base = job * NTHREADS + otid();
    if (base >= 2 * SG * 64) return;
    const int d = base / (SG * 64), g = (base / 64) % SG, st = base % 64;
    const size_t ci = ((size_t)d * SG + g) * 64 + st;
    float ar = p.S5A[ci * 2], ai = p.S5A[ci * 2 + 1];
    for (int i = 0; i < 6; ++i) { const float nr = ar * ar - ai * ai, ni = 2.f * ar * ai; ar = nr; ai = ni; }
    const float2* __restrict__ endp = (const float2*)p.S5END; float2* __restrict__ carp = (float2*)p.S5CAR;
    float cr = 0.f, cim = 0.f;
    for (int s = 0; s < NC; s += 4) {
        float2 ev[4]; size_t eo[4];
#pragma unroll
        for (int u = 0; u < 4; ++u) {
            const int n = chunk_order(d, (s + u < NC) ? s + u : NC - 1);
            eo[u] = (((size_t)d * NC + n) * SG + g) * 64 + st;
            ev[u] = endp[eo[u]];
        }
#pragma unroll
        for (int u = 0; u < 4; ++u) if (s + u < NC) {
            float2 c; c.x = cr; c.y = cim; carp[eo[u]] = c;
            const float nr = ar * cr - ai * cim + ev[u].x, ni = ar * cim + ai * cr + ev[u].y;
            cr = nr; cim = ni;
        }
    }
}

__device__ __forceinline__ void phase_side_elem(const P& p, int l) {
    const int lane = otid() & 63;
    const int gw = (obid() * NTHREADS + otid()) >> 6, nw = (gridDim.x * NTHREADS) >> 6;
    const bool actg = lane * 8 < GLA_V, actr = lane * 8 < RW;
    float gng[8], lnw[8], lnb[8];
#pragma unroll
    for (int e = 0; e < 8; ++e) { gng[e] = 0.f; lnw[e] = 0.f; lnb[e] = 0.f; }
    if (actg) load8f(p.in[I_GLA_NG] + (size_t)l * 128 + ((lane * 8) & 127), gng);
    if (actr) { load8f(p.in[I_RLNW] + (size_t)l * RW + lane * 8, lnw); load8f(p.in[I_RLNB] + (size_t)l * RW + lane * 8, lnb); }
    for (int t = gw; t < MTOT; t += nw) {
        float og[8], zo[8], y0[8], y1[8], vv[8];
        const u32x4 z4 = {0u, 0u, 0u, 0u};
#pragma unroll
        for (int e = 0; e < 8; ++e) { og[e] = 0.f; y0[e] = 0.f; y1[e] = 0.f; }
        if (actg) load8f(p.OGLA + (size_t)t * GLA_V + lane * 8, og);
        unpack8(actg ? *(const u32x4*)(p.Z + (size_t)t * ZLD + ZOG + lane * 8) : z4, zo);
        if (actr) { load8f(p.Y + (size_t)t * RW + lane * 8, y0); load8f(p.Y + ((size_t)MTOT + t) * RW + lane * 8, y1); }
        unpack8(actr ? *(const u32x4*)(p.V + (size_t)t * RW + lane * 8) : z4, vv);
        const int hh = (lane * 8) >> 6;
        const float bon = actr ? (p.BONUS[(size_t)t * RH + hh] + p.BONUS[((size_t)MTOT + t) * RH + hh]) : 0.f;
        float ss = 0.f;
#pragma unroll
        for (int e = 0; e < 8; ++e) ss += og[e] * og[e];
        ss += __shfl_xor(ss, 1, 64); ss += __shfl_xor(ss, 2, 64); ss += __shfl_xor(ss, 4, 64); ss += __shfl_xor(ss, 8, 64);
        const float rstd = rsqrtf(ss * (1.0f / 128.f) + 1e-6f);
        float br[8];
#pragma unroll
        for (int e = 0; e < 8; ++e) br[e] = og[e] * rstd * gng[e] * siluf_(zo[e]);
        if (actg) *(u32x4*)(p.BR + (size_t)t * 3 * BW + lane * 8) = pack8(br);
        float y[8]; float sm = 0.f;
#pragma unroll
        for (int e = 0; e < 8; ++e) { y[e] = y0[e] + y1[e]; sm += y[e]; }
        sm += __shfl_xor(sm, 1, 64); sm += __shfl_xor(sm, 2, 64); sm += __shfl_xor(sm, 4, 64);
        const float mu = sm * (1.0f / 64.f);
        float sv = 0.f;
#pragma unroll
        for (int e = 0; e < 8; ++e) { y[e] -= mu; sv += y[e] * y[e]; }
        sv += __shfl_xor(sv, 1, 64); sv += __shfl_xor(sv, 2, 64); sv += __shfl_xor(sv, 4, 64);
        const float rs = rsqrtf(sv * (1.0f / 64.f) + 64e-5f);
        float yn[8];
#pragma unroll
        for (int e = 0; e < 8; ++e) yn[e] = y[e] * rs * lnw[e] + lnb[e] + bon * vv[e];
        if (actr) store8f(p.YN + (size_t)t * RW + lane * 8, yn);
    }
}

__device__ __forceinline__ void phase_side_gemm(const P& p, int l, char* smem) {
    gemm_phase<4>(p.WT_G2, 128, (size_t)NPAD(RW) * 128 * 2, p.GS, 128, (size_t)MTOT * 128 * 2, 128, NPAD(RW), (bf16_t*)smem, NoPre(), NoPre(),
        [&](int, int, int m, int n, const f32x4 v) {
            if (n < RW) { const float4 y = *(const float4*)(p.YN + (size_t)m * RW + n);
                *(u32x2*)(p.BR + (size_t)m * 3 * BW + BW + n) = pack4(y.x * v[0], y.y * v[1], y.z * v[2], y.w * v[3]); }
        });
    gemm_phase<4>(p.WT_GLU, SW, (size_t)NPAD(2 * SW) * SW * 2, p.GY, SW, (size_t)MTOT * SW * 2, SW, 2 * SW, (bf16_t*)smem, NoPre(), NoPre(),
        [&](int, int, int m, int n, const f32x4 v) {
            *(unsigned*)(p.BR + (size_t)m * 3 * BW + 2 * BW + (n >> 1)) = pack2bf(v[0] * sigmoidf_(v[1]), v[2] * sigmoidf_(v[3]));
        });
}

__device__ __forceinline__ void phase_merge(const P& p, int l, char* smem) {
    const int ntn = D_MODEL / 128, ntm = (MTOT - 256) / 128;
    auto run = [&](auto mi_tag, int n0, int m0) {
        constexpr int MI = decltype(mi_tag)::value;
        f32x4 macc[4][MI];
#pragma unroll
        for (int i = 0; i < 4; ++i)
#pragma unroll
            for (int j = 0; j < MI; ++j) macc[i][j] = (f32x4){0.f, 0.f, 0.f, 0.f};
        const int lane = otid() & 63, wave = otid() >> 6;
        for (int b = 0; b < 3; ++b) {
            f32x4 acc[4][MI];
#pragma unroll
            for (int i = 0; i < 4; ++i)
#pragma unroll
                for (int j = 0; j < MI; ++j) acc[i][j] = (f32x4){0.f, 0.f, 0.f, 0.f};
            mfma_gemm_tile_t<4, MI>(p.WT_BR + (size_t)b * D_MODEL * BW, BW, (size_t)D_MODEL * BW * 2, p.BR + b * BW, 3 * BW, (size_t)MTOT * 3 * BW * 2 - b * BW * 2, BW, n0, m0, (bf16_t*)smem, acc);
#pragma unroll
            for (int ni = 0; ni < 4; ++ni)
#pragma unroll
                for (int mi = 0; mi < MI; ++mi) {
                    const int n = n0 + (wave >> 1) * 64 + ni * 16 + (lane >> 4) * 4, m = m0 + (wave & 1) * 16 * MI + mi * 16 + (lane & 15);
                    const u32x2 g = *(const u32x2*)(p.ZGT + ((((size_t)(m >> 4) * (3 * D_MODEL / 16) + ((b * D_MODEL + n) >> 4)) * 64 + lane) * 4));
                    macc[ni][mi][0] += LO16(g.x) * acc[ni][mi][0]; macc[ni][mi][1] += HI16(g.x) * acc[ni][mi][1];
                    macc[ni][mi][2] += LO16(g.y) * acc[ni][mi][2]; macc[ni][mi][3] += HI16(g.y) * acc[ni][mi][3];
                }
        }
#pragma unroll
        for (int ni = 0; ni < 4; ++ni)
#pragma unroll
            for (int mi = 0; mi < MI; ++mi) {
                const int n = n0 + (wave >> 1) * 64 + ni * 16 + (lane >> 4) * 4, m = m0 + (wave & 1) * 16 * MI + mi * 16 + (lane & 15);
                *(u32x2*)(p.M + (size_t)m * D_MODEL + n) = pack4(macc[ni][mi][0], macc[ni][mi][1], macc[ni][mi][2], macc[ni][mi][3]);
            }
    };
    for (int it = 0;; ++it) {
        int mt_, nt_; if (!tile_map(it, ntm, ntn, (ntn >= 8) ? 4 : 8, mt_, nt_)) break;
        run(std::integral_constant<int, 4>(), nt_ * 128, mt_ * 128);
    }
    for (int job = obid(); job < 4 * ntn; job += gridDim.x) run(std::integral_constant<int, 2>(), (job >> 2) * 128, MTOT - 256 + (job & 3) * 64);
}

__device__ __forceinline__ void phase_outproj(const P& p, int l, char* smem) {
    gemm_phase<4>(p.WT_OUT, D_MODEL, (size_t)D_MODEL * D_MODEL * 2, p.M, D_MODEL, (size_t)MTOT * D_MODEL * 2, D_MODEL, D_MODEL, (bf16_t*)smem, NoPre(), NoPre(),
        [&](int, int, int m, int n, const f32x4 v) {
            const float* g1 = p.MOD + (size_t)(l * 2 + (m >= CTX ? 1 : 0)) * 6 * D_MODEL + 2 * D_MODEL + n;
            float4* xp = (float4*)(p.X + (size_t)m * D_MODEL + n); float4 x = *xp;
            x.x += g1[0] * v[0]; x.y += g1[1] * v[1]; x.z += g1[2] * v[2]; x.w += g1[3] * v[3]; *xp = x;
        });
}

__device__ __forceinline__ void store_q_hilo(const P& p, int m, int n, const f32x4 v) {
    const bf16_t h0 = f2bf(v[0]), h1 = f2bf(v[1]), h2 = f2bf(v[2]), h3 = f2bf(v[3]);
    u32x2 hv; hv.x = (unsigned)h0 | ((unsigned)h1 << 16); hv.y = (unsigned)h2 | ((unsigned)h3 << 16);
    *(u32x2*)(p.QHI + (size_t)m * PQ + n) = hv;
    *(u32x2*)(p.QLO + (size_t)m * PQ + n) = pack4(v[0] - bf2f(h0), v[1] - bf2f(h1), v[2] - bf2f(h2), v[3] - bf2f(h3));
}
__device__ __forceinline__ void phase_peer_q(const P& p, int l, char* smem) {
    gemm_phase<4>(p.WT_Q, D_MODEL, (size_t)PQ * D_MODEL * 2, p.H, D_MODEL, (size_t)MTOT * D_MODEL * 2, D_MODEL, PQ, (bf16_t*)smem, NoPre(), NoPre(),
        [&](int, int, int m, int n, const f32x4 v) { store_q_hilo(p, m, n, v); });
}

#define TK_ROW 129
__device__ __forceinline__ unsigned tk_key(float f, unsigned lowmask, unsigned low) {
    unsigned u = __builtin_bit_cast(unsigned, f);
    u ^= (u & 0x80000000u) ? 0xFFFFFFFFu : 0x80000000u;
    return (u & ~lowmask) | low;
}
#define TK_INSERT(lv, xk) { unsigned x_ = (xk); _Pragma("unroll") for (int z_ = 0; z_ < 16; ++z_) { const unsigned hi_ = lv[z_] > x_ ? lv[z_] : x_; x_ = lv[z_] > x_ ? x_ : lv[z_]; lv[z_] = hi_; } }
__device__ __forceinline__ void phase_peer_topk(const P& p, int l, char* smem) {
    const int tid = otid(), lane = tid & 63, wv = tid >> 6, q = lane >> 4, r = lane & 15;
    float* sc = (float*)smem + wv * (64 * TK_ROW);
    const int gw = (obid() * NTHREADS + tid) >> 6, nw = (gridDim.x * NTHREADS) >> 6;
    const float NEG = -3.0e38f;
    for (int job = gw; job < (MTOT / 32) * PH; job += nw) {
        const int t0 = (job / PH) * 32, h = job % PH;
#pragma unroll
        for (int sd = 0; sd < 2; ++sd) {
            f32x4 acc[2][8];
#pragma unroll
            for (int mt = 0; mt < 2; ++mt)
#pragma unroll
                for (int nt = 0; nt < 8; ++nt) acc[mt][nt] = (f32x4){0.f, 0.f, 0.f, 0.f};
#pragma unroll
            for (int ks = 0; ks < 4; ++ks) {
                bf16x8 ah[2], al[2];
#pragma unroll
                for (int mt = 0; mt < 2; ++mt) {
                    const size_t qo = (size_t)(t0 + mt * 16 + r) * PQ + h * 256 + sd * 128 + ks * 32 + q * 8;
                    ah[mt] = *(const bf16x8*)(p.QHI + qo); al[mt] = *(const bf16x8*)(p.QLO + qo);
                }
#pragma unroll
                for (int nt = 0; nt < 8; ++nt) {
                    const size_t ko = ((size_t)(h * 2 + sd) * 128 + nt * 16 + r) * 128 + ks * 32 + q * 8;
                    const bf16x8 bh = *(const bf16x8*)(p.KHI + ko), bl = *(const bf16x8*)(p.KLO + ko);
#pragma unroll
                    for (int mt = 0; mt < 2; ++mt) {
                        acc[mt][nt] = MFMA16(ah[mt], bh, acc[mt][nt]);
                        acc[mt][nt] = MFMA16(al[mt], bh, acc[mt][nt]);
                        acc[mt][nt] = MFMA16(ah[mt], bl, acc[mt][nt]);
                    }
                }
            }
#pragma unroll
            for (int mt = 0; mt < 2; ++mt)
#pragma unroll
                for (int nt = 0; nt < 8; ++nt)
#pragma unroll
                    for (int e = 0; e < 4; ++e) sc[(sd * 32 + mt * 16 + 4 * q + e) * TK_ROW + nt * 16 + r] = acc[mt][nt][e];
        }
        WAVE_SYNC();
        unsigned lv[16];
#pragma unroll
        for (int z = 0; z < 16; ++z) lv[z] = 0u;
        {
            const float* row = sc + lane * TK_ROW;
#pragma unroll 4
            for (int k = 0; k < 128; ++k) TK_INSERT(lv, tk_key(row[k], 0x7Fu, (unsigned)(127 - k)));
        }
        float lvv[16]; int li[16];
        {
            const float* row = sc + lane * TK_ROW;
#pragma unroll
            for (int z = 0; z < 16; ++z) { li[z] = 127 - (int)(lv[z] & 0x7Fu); lvv[z] = row[li[z]]; }
        }
        WAVE_SYNC();
        {
            float* row = sc + lane * TK_ROW;
#pragma unroll
            for (int z = 0; z < 16; ++z) { row[z] = lvv[z]; ((int*)row)[16 + z] = li[z]; }
        }
        WAVE_SYNC();
        const float* r1 = sc + (lane & 31) * TK_ROW; const float* r2 = sc + (32 + (lane & 31)) * TK_ROW;
        unsigned tk[16];
#pragma unroll
        for (int z = 0; z < 16; ++z) tk[z] = 0u;
        for (int i = 0; i < 16; ++i) {
            const float a = r1[i];
            const int nj = 16 / (i + 1);
            for (int j = 0; j < nj; ++j) TK_INSERT(tk, tk_key(a + r2[j], 0xFFu, (unsigned)(255 - (i * 16 + j))));
        }
        int tc[16];
#pragma unroll
        for (int z = 0; z < 16; ++z) tc[z] = 255 - (int)(tk[z] & 0xFFu);
        if (lane < 32) {
            float vals[16]; float mx = 0.f; float ssum = 0.f;
#pragma unroll
            for (int z = 0; z < 16; ++z) { vals[z] = r1[tc[z] >> 4] + r2[tc[z] & 15]; if (z == 0) mx = vals[0]; vals[z] = fexp_(vals[z] - mx); ssum += vals[z]; }
            const float inv = 1.0f / ssum;
            const size_t o = (size_t)(t0 + lane) * PH * 16 + h * 16;
#pragma unroll
            for (int z = 0; z < 16; ++z) {
                const int ex_ = ((const int*)r1)[16 + (tc[z] >> 4)] * 128 + ((const int*)r2)[16 + (tc[z] & 15)];
                p.IDX[o + z] = ex_;
                p.G[o + z] = vals[z] * inv * p.VSC[ex_];
                p.GU[o + z] = p.USC[ex_];
            }
        }
        WAVE_SYNC();
    }
}

#define PEER_CONV_JOBS (2 * NEXP / 4)
__device__ __forceinline__ void peer_conv_job(const P& p, int l, int job) {
    const int tid = otid(), lane = tid & 63, wv = tid >> 6;
    if (wv >= 4) return;
    const int rowg = job * 4 + wv; const int which = rowg / NEXP, row = rowg % NEXP;
    const float* src = p.in[which ? I_PV : I_PU] + ((size_t)l * NEXP + row) * D_MODEL + lane * 16;
    const bool act = lane * 16 < D_MODEL;
    float v[16]; float amax = 0.f;
#pragma unroll
    for (int c = 0; c < 4; ++c) {
        float4 a; a.x = 0.f; a.y = 0.f; a.z = 0.f; a.w = 0.f;
        if (act) a = *(const float4*)(src + c * 4);
        v[c * 4 + 0] = a.x; v[c * 4 + 1] = a.y; v[c * 4 + 2] = a.z; v[c * 4 + 3] = a.w;
        amax = fmaxf(amax, fmaxf(fmaxf(fabsf(a.x), fabsf(a.y)), fmaxf(fabsf(a.z), fabsf(a.w))));
    }
#pragma unroll
    for (int m = 32; m >= 1; m >>= 1) amax = fmaxf(amax, __shfl_xor(amax, m, 64));
    int ex = 0;
    if (amax > 0.f) ex = 7 - (int)((__builtin_bit_cast(unsigned, amax) >> 23) & 0xFF) + 127;
    ex = ex < -100 ? -100 : (ex > 100 ? 100 : ex);
    const float sc = __builtin_bit_cast(float, (unsigned)(ex + 127) << 23), isc = __builtin_bit_cast(float, (unsigned)(127 - ex) << 23);
    u32x4 o;
    int w0 = 0, w1 = 0, w2 = 0, w3 = 0;
    w0 = CVT_PK_FP8(v[0] * sc, v[1] * sc, w0, false); w0 = CVT_PK_FP8(v[2] * sc, v[3] * sc, w0, true);
    w1 = CVT_PK_FP8(v[4] * sc, v[5] * sc, w1, false); w1 = CVT_PK_FP8(v[6] * sc, v[7] * sc, w1, true);
    w2 = CVT_PK_FP8(v[8] * sc, v[9] * sc, w2, false); w2 = CVT_PK_FP8(v[10] * sc, v[11] * sc, w2, true);
    w3 = CVT_PK_FP8(v[12] * sc, v[13] * sc, w3, false); w3 = CVT_PK_FP8(v[14] * sc, v[15] * sc, w3, true);
    o.x = (unsigned)w0; o.y = (unsigned)w1; o.z = (unsigned)w2; o.w = (unsigned)w3;
    unsigned char* dst = (which ? p.V8 : p.U8) + (size_t)row * D_MODEL + lane * 16;
    if (act) *(u32x4*)dst = o;
    if (lane == 0) (which ? p.VSC : p.USC)[row] = isc;
}
#define GE 4
struct GBuf { u32x4 u[GE]; u32x4 v[GE]; float gu; float gv; };
__device__ __forceinline__ void gather_load(const P& p, GBuf& b, int g, int idx0, int idx1, float g0, float g1, float u0, float u1, int lane) {
    const bool act = lane * 16 < D_MODEL;
#pragma unroll
    for (int q = 0; q < GE; ++q) {
        const int k = g * GE + q;
        const int ei = __shfl((k < 64) ? idx0 : idx1, k & 63, 64);
        b.u[q] = act ? *(const u32x4*)(p.U8 + (size_t)ei * D_MODEL + lane * 16) : (u32x4){0u, 0u, 0u, 0u};
        b.v[q] = act ? *(const u32x4*)(p.V8 + (size_t)ei * D_MODEL + lane * 16) : (u32x4){0u, 0u, 0u, 0u};
    }
    const int km = g * GE + ((lane >> 4) & 3);
    b.gv = __shfl((km < 64) ? g0 : g1, km & 63, 64);
    b.gu = __shfl((km < 64) ? u0 : u1, km & 63, 64);
}
__device__ __forceinline__ void gather_compute(const GBuf& b, const float (&hv)[16], float (&acc)[16], int lane) {
    float dt[GE];
#pragma unroll
    for (int q = 0; q < GE; ++q) {
        float d = 0.f;
#pragma unroll
        for (int c = 0; c < 4; ++c) {
            const f32x2 lo = CVT_PK_F32_FP8((int)b.u[q][c], false), hi = CVT_PK_F32_FP8((int)b.u[q][c], true);
            d += hv[c * 4 + 0] * lo.x + hv[c * 4 + 1] * lo.y + hv[c * 4 + 2] * hi.x + hv[c * 4 + 3] * hi.y;
        }
        dt[q] = d;
    }
    float r2[2], r1;
    {
        const bool up = (lane & 32) != 0;
#pragma unroll
        for (int q = 0; q < 2; ++q) { const float keep = up ? dt[2 + q] : dt[q], send = up ? dt[q] : dt[2 + q]; r2[q] = keep + __shfl_xor(send, 32, 64); }
    }
    {
        const bool up = (lane & 16) != 0;
        const float keep = up ? r2[1] : r2[0], send = up ? r2[0] : r2[1];
        r1 = keep + __shfl_xor(send, 16, 64);
    }
    r1 += __shfl_xor(r1, 8, 64); r1 += __shfl_xor(r1, 4, 64); r1 += __shfl_xor(r1, 2, 64); r1 += __shfl_xor(r1, 1, 64);
    const float coef_mine = b.gv * geluf_(r1 * b.gu);
#pragma unroll
    for (int q = 0; q < GE; ++q) {
        const float coef = __shfl(coef_mine, q * 16, 64);
#pragma unroll
        for (int c = 0; c < 4; ++c) {
            const f32x2 lo = CVT_PK_F32_FP8((int)b.v[q][c], false), hi = CVT_PK_F32_FP8((int)b.v[q][c], true);
            acc[c * 4 + 0] += coef * lo.x; acc[c * 4 + 1] += coef * lo.y; acc[c * 4 + 2] += coef * hi.x; acc[c * 4 + 3] += coef * hi.y;
        }
    }
}
__device__ __forceinline__ void phase_peer_gather(const P& p, int l) {
    const int lane = otid() & 63;
    const int gw = (obid() * NTHREADS + otid()) >> 6, nw = (gridDim.x * NTHREADS) >> 6;
    constexpr int NG = PH * 16 / GE;
    const bool act = lane * 16 < D_MODEL;
    for (int t = gw; t < MTOT; t += nw) {
        float hv[16], acc[16];
        {
            const u32x4 z4 = {0u, 0u, 0u, 0u};
            const u32x4 ha = act ? *(const u32x4*)(p.H + (size_t)t * D_MODEL + lane * 16) : z4;
            const u32x4 hb = act ? *(const u32x4*)(p.H + (size_t)t * D_MODEL + lane * 16 + 8) : z4;
            hv[0] = LO16(ha.x); hv[1] = HI16(ha.x); hv[2] = LO16(ha.y); hv[3] = HI16(ha.y); hv[4] = LO16(ha.z); hv[5] = HI16(ha.z); hv[6] = LO16(ha.w); hv[7] = HI16(ha.w);
            hv[8] = LO16(hb.x); hv[9] = HI16(hb.x); hv[10] = LO16(hb.y); hv[11] = HI16(hb.y); hv[12] = LO16(hb.z); hv[13] = HI16(hb.z); hv[14] = LO16(hb.w); hv[15] = HI16(hb.w);
#pragma unroll
            for (int j = 0; j < 16; ++j) acc[j] = 0.f;
        }
        int idx0 = 0, idx1 = 0; float g0 = 0.f, g1 = 0.f, u0 = 0.f, u1 = 0.f;
        if (lane < PH * 16) { idx0 = p.IDX[(size_t)t * PH * 16 + lane]; g0 = p.G[(size_t)t * PH * 16 + lane]; u0 = p.GU[(size_t)t * PH * 16 + lane]; }
        if (64 + lane < PH * 16) { idx1 = p.IDX[(size_t)t * PH * 16 + 64 + lane]; g1 = p.G[(size_t)t * PH * 16 + 64 + lane]; u1 = p.GU[(size_t)t * PH * 16 + 64 + lane]; }
        GBuf b0, b1, b2;
        gather_load(p, b0, 0, idx0, idx1, g0, g1, u0, u1, lane);
        gather_load(p, b1, 1, idx0, idx1, g0, g1, u0, u1, lane);
        for (int g = 0; g < NG; g += 3) {
            if (g + 2 < NG) gather_load(p, b2, g + 2, idx0, idx1, g0, g1, u0, u1, lane);
            gather_compute(b0, hv, acc, lane);
            if (g + 1 < NG) {
                if (g + 3 < NG) gather_load(p, b0, g + 3, idx0, idx1, g0, g1, u0, u1, lane);
                gather_compute(b1, hv, acc, lane);
            }
            if (g + 2 < NG) {
                if (g + 4 < NG) gather_load(p, b1, g + 4, idx0, idx1, g0, g1, u0, u1, lane);
                gather_compute(b2, hv, acc, lane);
            }
        }
        if (act) {
            const float* g2 = p.MOD + (size_t)(l * 2 + (t >= CTX ? 1 : 0)) * 6 * D_MODEL + 5 * D_MODEL + lane * 16;
            float* xp = p.X + (size_t)t * D_MODEL + lane * 16;
#pragma unroll
            for (int c = 0; c < 4; ++c) {
                float4 x = *(float4*)(xp + c * 4);
                x.x += g2[c * 4 + 0] * acc[c * 4 + 0]; x.y += g2[c * 4 + 1] * acc[c * 4 + 1]; x.z += g2[c * 4 + 2] * acc[c * 4 + 2]; x.w += g2[c * 4 + 3] * acc[c * 4 + 3];
                *(float4*)(xp + c * 4) = x;
            }
        }
    }
}

__device__ __forceinline__ void phase_final(const P& p) {
    const int lane = otid() & 63;
    const int gw = (obid() * NTHREADS + otid()) >> 6, nw = (gridDim.x * NTHREADS) >> 6;
    const float* g = p.in[I_FG];
    for (int t = gw; t < SEQ; t += nw) {
        const float* x = p.X + (size_t)(CTX + t) * D_MODEL;
        float v[D_MODEL / 64]; float ss = 0.f;
#pragma unroll
        for (int j = 0; j < D_MODEL / 64; ++j) { v[j] = x[lane + 64 * j]; ss += v[j] * v[j]; }
        ss = wave_sum(ss);
        float rstd = rsqrtf(ss / D_MODEL + 1e-6f);
#pragma unroll
        for (int j = 0; j < D_MODEL / 64; ++j) p.out[(size_t)t * D_MODEL + lane + 64 * j] = v[j] * rstd * g[lane + 64 * j];
    }
}

__global__ void __launch_bounds__(NTHREADS) fwd_megakernel(P p_arg) {
#ifdef EMU
    char* smem = emu_smem();
#else
    __shared__ __attribute__((aligned(16))) char smem_raw[SMEM_BYTES + 16];
    char* smem = smem_raw;
#endif
#ifndef EMU
    volatile LAS unsigned* xst = (volatile LAS unsigned*)(smem_raw + SMEM_BYTES);
    if (threadIdx.x == 0) { xst[0] = 0u; xst[1] = 0u; xst[2] = 0u; xst[3] = 0u; }
    __syncthreads();
    XcdBarrier xb = xcd_barrier_post(p_arg.bar, xst);
#endif
    { LOADP(); phase_init(p, smem); }
#ifndef EMU
#endif
    GRID_SYNC();
#ifndef EMU
    if (threadIdx.x == 0) {
        unsigned base_ = 0;
        for (unsigned j = 0; j < xb.x; ++j) base_ += xb_ld(&p_arg.bar[XB_XCNT(j)]);
        xst[2] = base_ + xst[3];
    }
    __syncthreads();
#endif
    PROBE_INIT();
    for (int l = 0; l < DEPTH; ++l) {
        { LOADP(); phase_norm(p, l, 0); }
        { LOADP(); phase_s5const(p, l); }
        if (l == 0) { LOADP(); phase_convert_weights(p, 0, smem, obid(), (int)gridDim.x); }
        GRID_SYNC(); PROBE_AFTER(0);
        { LOADP(); phase_gemm_in(p, l, smem); }
        GRID_SYNC(); PROBE_AFTER(1);
        { LOADP(); phase_rwkv_prep1(p, l); }
        GRID_SYNC(); PROBE_AFTER(14);
        { LOADP(); phase_rwkv_prep2(p, l, smem); }
        GRID_SYNC(); PROBE_AFTER(2);
        { LOADP(); for (int job = obid(); job < 2 * NC * RH; job += gridDim.x) rwkv_chunk_job(p, job, smem); }
        __syncthreads(); PROBE_AFTER(20);
        { LOADP(); phase_gla_kv(p, l, smem); }
        PROBE_AFTER(21);
        { LOADP(); phase_s5_pass(p, l, smem, false); }
        GRID_SYNC(); PROBE_AFTER(3);
        {
            LOADP();
            const int n_rw = 2 * RH, n_gla = 2 * GH * 8192 / NTHREADS, n_s5 = (2 * SG * 64 + NTHREADS - 1) / NTHREADS;
            const int G_ = (int)gridDim.x;
            if (G_ > 2 * n_rw) {
                if (obid() < n_rw) { rwkv_seq_job(p, obid(), smem); PROBE_AFTER(24); }
                else {
                    const int nb = G_ - n_rw, bid = obid() - n_rw;
                    for (int job = bid; job < n_gla + n_s5 + PEER_CONV_JOBS; job += nb) {
                        if (job < n_gla) gla_scan_job(p, job);
                        else if (job < n_gla + n_s5) s5_carry_job(p, job - n_gla);
                        else peer_conv_job(p, l, job - n_gla - n_s5);
                    }
                    if (l + 1 < DEPTH) { late_select(p, (l + 1) & 1); phase_convert_weights(p, l + 1, smem, bid, nb); }
                }
            } else {
                for (int job = obid(); job < n_rw + n_gla + n_s5 + PEER_CONV_JOBS; job += G_) {
                    if (job < n_rw) rwkv_seq_job(p, job, smem);
                    else if (job < n_rw + n_gla) gla_scan_job(p, job - n_rw);
                    else if (job < n_rw + n_gla + n_s5) s5_carry_job(p, job - n_rw - n_gla);
                    else peer_conv_job(p, l, job - n_rw - n_gla - n_s5);
                }
                __syncthreads();
                if (l + 1 < DEPTH) { late_select(p, (l + 1) & 1); phase_convert_weights(p, l + 1, smem, obid(), G_); }
            }
        }
        GRID_SYNC(); PROBE_AFTER(4);
        { LOADP(); phase_rwkv_out(p); }
        PROBE_AFTER(22);
        { LOADP(); phase_gla_out(p, l, smem); }
        PROBE_AFTER(23);
        { LOADP(); phase_s5_pass(p, l, smem, true); }
        GRID_SYNC(); PROBE_AFTER(5);
        { LOADP(); phase_side_elem(p, l); }
        GRID_SYNC(); PROBE_AFTER(6);
        { LOADP(); late_select(p, l & 1); phase_side_gemm(p, l, smem); }
        GRID_SYNC(); PROBE_AFTER(7);
        { LOADP(); late_select(p, l & 1); phase_merge(p, l, smem); }
        GRID_SYNC(); PROBE_AFTER(8);
        { LOADP(); late_select(p, l & 1); phase_outproj(p, l, smem); }
        GRID_SYNC(); PROBE_AFTER(9);
        { LOADP(); phase_norm(p, l, 1); }
        GRID_SYNC(); PROBE_AFTER(10);
        { LOADP(); late_select(p, l & 1); phase_peer_q(p, l, smem); }
        GRID_SYNC(); PROBE_AFTER(11);
        { LOADP(); late_select(p, l & 1); phase_peer_topk(p, l, smem); }
        GRID_SYNC(); PROBE_AFTER(12);
        { LOADP(); phase_peer_gather(p, l); }
        GRID_SYNC(); PROBE_AFTER(13);
    }
    { LOADP(); phase_final(p); }
}

static inline size_t align_up(size_t x) { return (x + 255) & ~(size_t)255; }

extern "C" void kernel_launch(void* const* d_in, const int* in_sizes, int n_in, void* d_out, int out_size, void* d_ws, size_t ws_size, hipStream_t stream) {
    P p;
    memset(&p, 0, sizeof(p));
    for (int i = 0; i < 39; ++i) p.in[i] = (const float*)d_in[i];
    p.out = (float*)d_out;
    char* w = (char*)d_ws; size_t off = 0;
    auto take = [&](size_t bytes) { void* r = w + off; off = align_up(off + bytes); return r; };
    p.bar = (unsigned*)take(16384);
    p.X = (float*)take((size_t)MTOT * D_MODEL * 4);
    p.H = (bf16_t*)take((size_t)MTOT * D_MODEL * 2);
    p.MOD = (float*)take((size_t)DEPTH * 2 * 6 * D_MODEL * 4);
    p.Z = (bf16_t*)take((size_t)MTOT * ZLD * 2);
    p.ZGT = (bf16_t*)take((size_t)MTOT * 3 * D_MODEL * 2);
    p.V = (bf16_t*)take((size_t)MTOT * RW * 2);
    {
        char* ra = (char*)take((size_t)MTOT * RW * 2 * 2 > (size_t)MTOT * GLA_V * 4 ? (size_t)MTOT * RW * 2 * 2 : (size_t)MTOT * GLA_V * 4);
        p.R = (bf16_t*)ra; p.KK = (bf16_t*)(ra + (size_t)MTOT * RW * 2);
        p.OGLA = (float*)ra;
    }
    {
        char* rb = (char*)take((size_t)2 * MTOT * RW * 2 > (size_t)3 * MTOT * PH * 16 * 4 ? (size_t)2 * MTOT * RW * 2 : (size_t)3 * MTOT * PH * 16 * 4);
        p.KD = (bf16_t*)rb;
        p.IDX = (int*)rb; p.G = (float*)(rb + (size_t)MTOT * PH * 16 * 4); p.GU = (float*)(rb + (size_t)2 * MTOT * PH * 16 * 4);
    }
    p.BB = (bf16_t*)take((size_t)2 * MTOT * RW * 2);
    p.LW = (float*)take((size_t)2 * MTOT * RW * 4);
    p.SP = (bf16_t*)p.LW;
    static_assert((size_t)2 * NC * GH * 8192 * 2 <= (size_t)2 * MTOT * RW * 4, "SP alias");
    p.BONUS = (float*)take((size_t)2 * MTOT * RH * 4);
    p.KS = (bf16_t*)take((size_t)MTOT * RW * 2);
    p.LR = (bf16_t*)take((size_t)MTOT * 256 * 2);
    p.WT_W2 = (bf16_t*)take((size_t)2 * NPAD(RW) * 64 * 2);
    p.WT_A2 = (bf16_t*)take((size_t)2 * NPAD(RW) * 64 * 2);
    p.GS = (bf16_t*)take((size_t)MTOT * 128 * 2);
    p.Y = (float*)take((size_t)2 * MTOT * RW * 4);
    p.Y0T = (float*)take((size_t)2 * NC * RH * 4096 * 4);
    p.KV = (float*)take((size_t)2 * NC * GH * 8192 * 4);
    p.DEC = (float*)take((size_t)2 * NC * GH * 64 * 4);
    p.S5A = (float*)take((size_t)2 * SG * 64 * 2 * 4);
    p.S5BB = (float*)take((size_t)2 * SG * 64 * 16 * 2 * 4);
    p.S5END = (float*)take((size_t)2 * NC * SG * 64 * 2 * 4);
    p.S5CAR = (float*)take((size_t)2 * NC * SG * 64 * 2 * 4);
    {
        const size_t szc1 = (size_t)2 * NC * RH * SEQ_REC;
        const size_t szc2 = (size_t)MTOT * SW * 2 + (size_t)MTOT * RW * 4 + (size_t)MTOT * 3 * BW * 2 + (size_t)MTOT * D_MODEL * 2 + 1024;
        char* rc = (char*)take(szc1 > szc2 ? szc1 : szc2);
        p.REC = rc;
        char* c2 = rc;
        p.GY = (bf16_t*)c2; c2 += align_up((size_t)MTOT * SW * 2);
        p.YN = (float*)c2; c2 += align_up((size_t)MTOT * RW * 4);
        p.BR = (bf16_t*)c2; c2 += align_up((size_t)MTOT * 3 * BW * 2);
        p.M = (bf16_t*)c2;
    }
    p.SN = (bf16_t*)take((size_t)2 * NC * RH * 4096 * 2);
    p.QH = (bf16_t*)take((size_t)2 * NC * RH * 4096 * 2);
    p.WT_IN = (bf16_t*)take((size_t)NPAD192(D_IN) * D_MODEL * 2);
    {
        char* lb = (char*)take(2 * LATE_BYTES); size_t lo = 0;
        auto ltake = [&](size_t bytes) { void* r = lb + lo; lo = AL256(lo + bytes); return r; };
        p.WT_G2 = (bf16_t*)ltake((size_t)NPAD(RW) * 128 * 2);
        p.WT_GLU = (bf16_t*)ltake((size_t)NPAD(2 * SW) * SW * 2);
        p.WT_BR = (bf16_t*)ltake((size_t)3 * D_MODEL * BW * 2);
        p.WT_OUT = (bf16_t*)ltake((size_t)D_MODEL * D_MODEL * 2);
        p.WT_Q = (bf16_t*)ltake((size_t)PQ * D_MODEL * 2);
        p.KHI = (bf16_t*)ltake((size_t)PH * 2 * 128 * 128 * 2); p.KLO = (bf16_t*)ltake((size_t)PH * 2 * 128 * 128 * 2);
        if (lo != LATE_BYTES) fprintf(stderr, "late weights layout mismatch\n");
    }
    p.U8 = (unsigned char*)take((size_t)NEXP * D_MODEL);
    p.V8 = (unsigned char*)take((size_t)NEXP * D_MODEL);
    p.USC = (float*)take((size_t)NEXP * 4); p.VSC = (float*)take((size_t)NEXP * 4);
    p.QHI = p.Z; p.QLO = p.Z + (size_t)MTOT * PQ;
    static_assert((size_t)PQ * 4 <= (size_t)D_IN * 2 && ((size_t)MTOT * ZLD * 2) % 256 == 0, "Q alias");
    if (off > ws_size) { fprintf(stderr, "ws too small: need %zu have %zu\n", off, ws_size); return; }
#ifdef EMU
    fprintf(stderr, "ws used %zu MB\n", off >> 20);
    emu_launch([=] { fwd_megakernel(p); }, EMU_GRID, NTHREADS);
#else
    hipMemsetAsync(p.bar, 0, 16384, stream);
    static int grid_blocks = 0;
    if (!grid_blocks) {
        int dev = 0, cus = 0, per_cu = 0;
        hipGetDevice(&dev);
        hipDeviceGetAttribute(&cus, hipDeviceAttributeMultiprocessorCount, dev);
        hipOccupancyMaxActiveBlocksPerMultiprocessor(&per_cu, fwd_megakernel, NTHREADS, 0);
        if (per_cu > 1) per_cu = 1;
        grid_blocks = cus * per_cu;
    }
    void* args[] = {&p};
    hipError_t e = hipLaunchCooperativeKernel((void*)fwd_megakernel, dim3(grid_blocks), dim3(NTHREADS), args, 0, stream);
    if (e != hipSuccess) fprintf(stderr, "cooperative launch failed: %s (grid %d)\n", hipGetErrorString(e), grid_blocks);
#endif
}
```

```cpp
#include <hip/hip_runtime.h>
#ifndef EMU
#include <hip/hip_cooperative_groups.h>
namespace cg = cooperative_groups;
#endif
#include <cstdio>
#include <cstdint>
#include <cstring>
#include <type_traits>

#ifdef CFG_SMALL
#define D_MODEL 128
#define SEQ 640
#define DEPTH 2
#define GRID_W 10
#define CTX 128
#define GH 1
#define RH 2
#define SG 8
#define PH 2
#else
#define D_MODEL 1024
#define SEQ 16384
#define DEPTH 4
#define GRID_W 64
#define CTX 256
#define GH 4
#define RH 8
#define SG 32
#define PH 8
#endif
#define MTOT (CTX + SEQ)
#define ROWS (SEQ / GRID_W)
#define GLA_K (GH * 64)
#define GLA_V (GH * 128)
#define RW (RH * 64)
#define RWKV_IN (3 * RW + 4 * 64 + 128)
#define SW (SG * 16)
#define BW GLA_V
#define ZQ 0
#define ZK (GLA_K)
#define ZV (2 * GLA_K)
#define ZOG (ZV + GLA_V)
#define ZAF (ZOG + GLA_V)
#define ZAB (ZAF + 16)
#define ZR (ZAB + 16)
#define ZS5 (ZR + RWKV_IN)
#define ZG (ZS5 + SW)
#define D_IN (ZG + 3 * D_MODEL)
#define ZLD ZG
#define NC (MTOT / 64)
#define NCC (CTX / 64)
#define RB (ROWS / 64)
#define PQ (PH * 256)
#define NEXP 16384
#define NTHREADS 256
#define SMEM_BYTES 133120

typedef unsigned short bf16_t;
typedef short bf16x8 __attribute__((ext_vector_type(8)));
typedef float f32x4 __attribute__((ext_vector_type(4)));
typedef unsigned u32x4 __attribute__((ext_vector_type(4)));
typedef unsigned u32x2 __attribute__((ext_vector_type(2)));
#ifdef EMU
#define MFMA16(a, b, c) emu_mfma_16x16x32_bf16(a, b, c)
#else
#define MFMA16(a, b, c) __builtin_amdgcn_mfma_f32_16x16x32_bf16(a, b, c, 0, 0, 0)
#endif
typedef float f32x2 __attribute__((ext_vector_type(2)));
#ifdef EMU
#define CVT_PK_FP8(a, b, old, hi) emu_cvt_pk_fp8_f32(a, b, old, hi)
#define CVT_PK_F32_FP8(w, hi) emu_cvt_pk_f32_fp8(w, hi)
#else
#define CVT_PK_FP8(a, b, old, hi) __builtin_amdgcn_cvt_pk_fp8_f32(a, b, old, hi)
#define CVT_PK_F32_FP8(w, hi) __builtin_amdgcn_cvt_pk_f32_fp8(w, hi)
#endif
#ifdef EMU
#define MFMA16_ACC(a, b, c) c = emu_mfma_16x16x32_bf16(a, b, c)
#else
#define MFMA16_ACC(a, b, c) asm volatile("v_mfma_f32_16x16x32_bf16 %0, %1, %2, %0" : "+a"(c) : "v"(a), "v"(b))
#endif
#define NPAD(n) (((n) + 127) / 128 * 128)
#define NPAD192(n) (((n) + 383) / 384 * 384)

__device__ __forceinline__ float bf2f(bf16_t h) { return __builtin_bit_cast(float, ((unsigned)h) << 16); }
#ifdef EMU
__device__ __forceinline__ bf16_t f2bf(float f) { unsigned u = __builtin_bit_cast(unsigned, f); u += 0x7FFFu + ((u >> 16) & 1u); return (bf16_t)(u >> 16); }
__device__ __forceinline__ unsigned pack2bf(float a, float b) { return (unsigned)f2bf(a) | ((unsigned)f2bf(b) << 16); }
#else
typedef float f2v_t __attribute__((ext_vector_type(2))); typedef __bf16 b2v_t __attribute__((ext_vector_type(2)));
__device__ __forceinline__ bf16_t f2bf(float f) { return __builtin_bit_cast(unsigned short, (__bf16)f); }
__device__ __forceinline__ unsigned pack2bf(float a, float b) { f2v_t v = {a, b}; b2v_t r = __builtin_convertvector(v, b2v_t); return __builtin_bit_cast(unsigned, r); }
#endif
#ifdef EMU
#define fexp_(x) expf(x)
#define flog_(x) logf(x)
#else
#define fexp_(x) __expf(x)
#define flog_(x) __logf(x)
#endif
#define LO16(x) __builtin_bit_cast(float, (x) << 16)
#define HI16(x) __builtin_bit_cast(float, (x) & 0xFFFF0000u)
__device__ __forceinline__ float sigmoidf_(float x) { return 1.0f / (1.0f + fexp_(-x)); }
__device__ __forceinline__ float siluf_(float x) { return x * sigmoidf_(x); }
__device__ __forceinline__ float geluf_(float x) { const float y = 1.5957691216057308f * (x + 0.044715f * x * x * x); return x / (1.0f + fexp_(-y)); }
__device__ __forceinline__ float softplusf_(float x) { return fmaxf(x, 0.f) + flog_(1.0f + fexp_(-fabsf(x))); }
__device__ __forceinline__ float tanhf_(float x) { const float e = fexp_(-2.0f * fabsf(x)); const float t = (1.0f - e) / (1.0f + e); return x < 0.f ? -t : t; }
__device__ __forceinline__ float wave_sum(float v) {
#pragma unroll
    for (int m = 32; m >= 1; m >>= 1) v += __shfl_xor(v, m, 64);
    return v;
}

struct P {
    const float* in[39];
    float* out;
    float* X;
    bf16_t* H;
    bf16_t* Z;
    bf16_t* ZGT;
    float* MOD;
    bf16_t* R; bf16_t* V; bf16_t* KK; bf16_t* KD; bf16_t* BB;
    float* LW;
    char* REC;
    bf16_t* SN;
    bf16_t* QH;
    float* BONUS;
    bf16_t* KS;
    bf16_t* LR;
    bf16_t* WT_W2;
    bf16_t* WT_A2;
    bf16_t* GS;
    float* Y;
    float* Y0T;
    float* KV;
    bf16_t* SP;
    float* DEC;
    float* OGLA;
    float* S5A;
    float* S5BB;
    float* S5END;
    float* S5CAR;
    bf16_t* GY;
    float* YN;
    bf16_t* BR;
    bf16_t* M;
    bf16_t* QHI; bf16_t* QLO;
    bf16_t* KHI; bf16_t* KLO;
    int* IDX;
    float* G;
    float* GU;
    unsigned* bar;
    bf16_t* WT_IN;
    bf16_t* WT_G2;
    bf16_t* WT_GLU;
    bf16_t* WT_BR;
    bf16_t* WT_OUT;
    bf16_t* WT_Q;
    unsigned char* U8; unsigned char* V8;
    float* USC; float* VSC;
};

enum { I_X = 0, I_C, I_CTX, I_CCTX, I_WMOD, I_BMOD, I_N1G, I_N2G, I_WIN, I_GLA_WA2, I_GLA_BA, I_GLA_NG, I_RCONV, I_RW0, I_RW2, I_RA0, I_RA2, I_RG2,
       I_RKK, I_RKA, I_RRK, I_RLNW, I_RLNB, I_S5LRE, I_S5LIM, I_S5LS, I_S5BRE, I_S5BIM, I_S5CRE, I_S5CIM, I_S5D, I_S5GLU, I_WBR, I_WOUT, I_PWQ, I_PKEYS, I_PU, I_PV, I_FG };

#define AL256(x) (((size_t)(x) + 255) & ~(size_t)255)
#define LATE_BYTES (AL256((size_t)NPAD(RW) * 128 * 2) + AL256((size_t)NPAD(2 * SW) * SW * 2) + AL256((size_t)3 * D_MODEL * BW * 2) + AL256((size_t)D_MODEL * D_MODEL * 2) + \
                    AL256((size_t)PQ * D_MODEL * 2) + 2 * AL256((size_t)PH * 2 * 128 * 128 * 2))
__device__ __forceinline__ void late_select(P& p, int par) {
    const size_t o = (size_t)par * (LATE_BYTES / 2);
    p.WT_G2 += o; p.WT_GLU += o; p.WT_BR += o; p.WT_OUT += o; p.WT_Q += o; p.KHI += o; p.KLO += o;
}
#ifdef EMU
__device__ __forceinline__ int otid() { return threadIdx.x; }
__device__ __forceinline__ int obid() { return blockIdx.x; }
#else
__device__ __forceinline__ int otid() { int t = threadIdx.x; asm volatile("" : "+v"(t)); return t; }
__device__ __forceinline__ int obid() { int b = blockIdx.x; asm volatile("" : "+s"(b)); return b; }
#endif
#ifdef EMU
#define WAVE_SYNC() emu_wave_barrier()
#ifndef EMU_GRID
#define EMU_GRID 4
#endif
#else
#define WAVE_SYNC() __builtin_amdgcn_wave_barrier()
#endif
#ifndef EMU
#define XB_TMO      128
#define XB_XCNT(j)  (256  + 64 * (j))
#define XB_XSUB(j)  (1280 + 64 * (j))
#define XB_XGEN(j)  (2304 + 64 * (j))
#define XB_TOP      3328
#define XB_TOPGEN   3392
#define XCD_BAR_WORDS 3456
#define XB_SPIN_CAP (1u << 22)
#define LAS __attribute__((address_space(3)))
__device__ __forceinline__ unsigned xb_ld(unsigned* p)              { return __hip_atomic_load(p, __ATOMIC_RELAXED, __HIP_MEMORY_SCOPE_AGENT); }
__device__ __forceinline__ unsigned xb_add(unsigned* p, unsigned v) { return __hip_atomic_fetch_add(p, v, __ATOMIC_RELAXED, __HIP_MEMORY_SCOPE_AGENT); }
__device__ __forceinline__ unsigned xb_xcc_id() { return (unsigned)__builtin_amdgcn_s_getreg((3 << 11) | 20) & 0xFu; }
#define XB_SPIN(cond, bar) do { unsigned _sp = 0; while (cond) { __builtin_amdgcn_s_sleep(1); \
    if ((++_sp & 255u) == 0u) { if (xb_ld(&(bar)[XB_TMO])) break; if (_sp > XB_SPIN_CAP) { atomicAdd(&(bar)[XB_TMO], 1u); break; } } } } while (0)
struct XcdBarrier { unsigned* bar; unsigned x; volatile LAS unsigned* st; };
__device__ __forceinline__ XcdBarrier xcd_barrier_post(unsigned* bar, volatile LAS unsigned* st) {
    XcdBarrier b; b.bar = bar; b.x = xb_xcc_id(); b.st = st;
    if (threadIdx.x == 0) st[3] = xb_add(&bar[XB_XCNT(b.x)], 1u);
    return b;
}
__device__ __forceinline__ void xcd_barrier_complete(unsigned* bar, unsigned x, unsigned& nloc, unsigned& nx) {
    const unsigned G = gridDim.x * gridDim.y * gridDim.z;
    unsigned sum, cnt, mine, sp = 0u;
    for (;;) {
        sum = 0u; cnt = 0u; mine = 0u;
#pragma unroll
        for (unsigned j = 0; j < 16; ++j) { const unsigned c = xb_ld(&bar[XB_XCNT(j)]); sum += c; cnt += (c > 0u) ? 1u : 0u; mine = (j == x) ? c : mine; }
        if (sum == G) break;
        __builtin_amdgcn_s_sleep(1);
        if ((++sp & 255u) == 0u) { if (xb_ld(&bar[XB_TMO])) break; if (sp > XB_SPIN_CAP) { atomicAdd(&bar[XB_TMO], 1u); break; } }
    }
    nloc = mine > 0u ? mine : 1u; nx = cnt > 0u ? cnt : 1u;
}
__device__ __forceinline__ void xcd_barrier(const XcdBarrier& b) {
    asm volatile("s_waitcnt vmcnt(0)" ::: "memory");
    __syncthreads();
    if (threadIdx.x == 0) {
        unsigned* bar = b.bar;
        __builtin_amdgcn_fence(__ATOMIC_RELEASE, "agent");
        asm volatile("s_waitcnt vmcnt(0)" ::: "memory");
        const unsigned G = gridDim.x;
        const unsigned old = xb_add(&bar[XB_TOP], 1u);
        const unsigned tg = old / G;
        if (old + 1u == (tg + 1u) * G) {
            const unsigned long long t0_ = wall_clock64(); while (wall_clock64() - t0_ < 1000ull) __builtin_amdgcn_s_sleep(8);
            xb_add(&bar[XB_TOPGEN], 1u);
        }
        else XB_SPIN(xb_ld(&bar[XB_TOPGEN]) == tg, bar);
        __builtin_amdgcn_fence(__ATOMIC_ACQUIRE, "agent");
        asm volatile("s_waitcnt vmcnt(0)" ::: "memory");
    }
    __syncthreads();
}
#define GRID_SYNC() { (void)xb; cg::this_grid().sync(); }
#else
#define GRID_SYNC() emu_grid_sync()
#endif

#ifdef EMU
#define LOADP() P p = p_arg
#else
typedef __attribute__((address_space(4))) const unsigned long long cu64_t;
__device__ __forceinline__ void load_params(P& p) {
    cu64_t* q = (cu64_t*)__builtin_amdgcn_kernarg_segment_ptr();
    asm volatile("" : "+s"(q));
    unsigned long long w[sizeof(P) / 8];
#pragma unroll
    for (int i = 0; i < (int)(sizeof(P) / 8); ++i) w[i] = q[i];
    __builtin_memcpy(&p, w, sizeof(P));
}
#define LOADP() P p; load_params(p)
#endif
#define PROBE_MULT 3
#if defined(PROBE_ID) && !defined(EMU)
#define PROBE_INIT() unsigned long long probe_t0 = wall_clock64()
#define PROBE_AFTER(id) { if (blockIdx.x == 0) { unsigned long long now_ = wall_clock64(); if ((id) == PROBE_ID || (id) == PROBE_ID2) { const unsigned long long dt_ = now_ - probe_t0; \
    while (wall_clock64() - now_ < dt_ * PROBE_MULT) __builtin_amdgcn_s_sleep(8); now_ = wall_clock64(); } probe_t0 = now_; } }
#else
#define PROBE_INIT()
#define PROBE_AFTER(id)
#endif
__device__ __forceinline__ int gla_tok(int n, int i) {
    if (n < NCC) return n * 64 + i;
    int m = n - NCC; int col = m / RB, rb = m % RB;
    return CTX + (rb * 64 + i) * GRID_W + col;
}
__device__ __forceinline__ int chunk_order(int d, int s) {
    if (d == 0) return s;
    return (s < NCC) ? (NCC - 1 - s) : (NC - 1 - (s - NCC));
}
__device__ __forceinline__ int tok_order(int d, int s) {
    if (d == 0) return s;
    return (s < CTX) ? (CTX - 1 - s) : (MTOT - 1 - (s - CTX));
}


#define LDS_ROW 72
__device__ __forceinline__ void mfma_gemm_tile(const bf16_t* Wt, int ldw, const bf16_t* Act, int lda, int K, int n0, int m0, bf16_t* lds, f32x4 (&acc)[4][4]) {
    bf16_t* Ws = lds; bf16_t* As = lds + 128 * LDS_ROW;
    const int tid = otid(), lane = tid & 63, wave = tid >> 6, wn = wave >> 1, wm = wave & 1;
    const int lrow = tid >> 3, lkc = (tid & 7) * 8;
    u32x4 pw[4], pa[4];
#pragma unroll
    for (int i = 0; i < 4; ++i) {
        pw[i] = *(const u32x4*)(Wt + (size_t)(n0 + lrow + 32 * i) * ldw + lkc);
        pa[i] = *(const u32x4*)(Act + (size_t)(m0 + lrow + 32 * i) * lda + lkc);
    }
    for (int k0 = 0; k0 < K; k0 += 64) {
        __syncthreads();
#pragma unroll
        for (int i = 0; i < 4; ++i) {
            *(u32x4*)(Ws + (lrow + 32 * i) * LDS_ROW + lkc) = pw[i];
            *(u32x4*)(As + (lrow + 32 * i) * LDS_ROW + lkc) = pa[i];
        }
        __syncthreads();
        if (k0 + 64 < K) {
#pragma unroll
            for (int i = 0; i < 4; ++i) {
                pw[i] = *(const u32x4*)(Wt + (size_t)(n0 + lrow + 32 * i) * ldw + k0 + 64 + lkc);
                pa[i] = *(const u32x4*)(Act + (size_t)(m0 + lrow + 32 * i) * lda + k0 + 64 + lkc);
            }
        }
#pragma unroll
        for (int ks = 0; ks < 2; ++ks) {
            bf16x8 a[4], b[4];
#pragma unroll
            for (int i = 0; i < 4; ++i) {
                a[i] = *(const bf16x8*)(Ws + (wn * 64 + i * 16 + (lane & 15)) * LDS_ROW + ks * 32 + (lane >> 4) * 8);
                b[i] = *(const bf16x8*)(As + (wm * 64 + i * 16 + (lane & 15)) * LDS_ROW + ks * 32 + (lane >> 4) * 8);
            }
#pragma unroll
            for (int ni = 0; ni < 4; ++ni)
#pragma unroll
                for (int mi = 0; mi < 4; ++mi) acc[ni][mi] = MFMA16(a[ni], b[mi], acc[ni][mi]);
        }
    }
}
#define L64_ROW 72
#ifdef EMU
struct BufRsrc { const char* base; };
__device__ __forceinline__ BufRsrc make_rsrc(const void* p, size_t) { BufRsrc r; r.base = (const char*)p; return r; }
__device__ __forceinline__ u32x4 buf_load16(const BufRsrc& r, unsigned voff, unsigned soff) { return *(const u32x4*)(r.base + voff + soff); }
#else
typedef __amdgpu_buffer_rsrc_t BufRsrc;
__device__ __forceinline__ BufRsrc make_rsrc(const void* p, size_t bytes) { return __builtin_amdgcn_make_buffer_rsrc((void*)p, 0, (int)bytes, 0x00020000); }
__device__ __forceinline__ u32x4 buf_load16(const BufRsrc& r, unsigned voff, unsigned soff) { return __builtin_bit_cast(u32x4, __builtin_amdgcn_raw_buffer_load_b128(r, voff, soff, 0)); }
#endif
template <int NI, int MI>
__device__ __forceinline__ void mfma_gemm_tile_t(const bf16_t* Wt, int ldw, size_t wbytes, const bf16_t* Act, int lda, size_t abytes, int K, int n0, int m0, bf16_t* lds, f32x4 (&acc)[NI][MI], unsigned long long* gacc = nullptr) {
    constexpr int WR = 32 * NI, AR = 32 * MI, BUF = (WR + AR) * L64_ROW;
    const int tid = otid(), lane = tid & 63, wave = tid >> 6, wn = wave >> 1, wm = wave & 1;
    const int lrow = tid >> 3, lkc = (tid & 7) * 8;
    const BufRsrc rw = make_rsrc(Wt, wbytes), ra = make_rsrc(Act, abytes);
    unsigned vw[NI], va[MI];
#pragma unroll
    for (int i = 0; i < NI; ++i) vw[i] = (unsigned)(((size_t)(n0 + lrow + 32 * i) * ldw + lkc) * 2);
#pragma unroll
    for (int i = 0; i < MI; ++i) va[i] = (unsigned)(((size_t)(m0 + lrow + 32 * i) * lda + lkc) * 2);
    u32x4 qw0[NI], qa0[MI];
    const int nk = K / 64;
#define GT_LOAD(QW, QA, KT) { const unsigned so_ = (unsigned)(((KT) < nk) ? (KT) : (nk - 1)) * 128u; \
    _Pragma("unroll") for (int i = 0; i < NI; ++i) QW[i] = buf_load16(rw, vw[i], so_); \
    _Pragma("unroll") for (int i = 0; i < MI; ++i) QA[i] = buf_load16(ra, va[i], so_); }
#define GT_STORE(QW, QA, DST) { \
    _Pragma("unroll") for (int i = 0; i < NI; ++i) *(u32x4*)((DST) + (lrow + 32 * i) * L64_ROW + lkc) = QW[i]; \
    _Pragma("unroll") for (int i = 0; i < MI; ++i) *(u32x4*)((DST) + (WR + lrow + 32 * i) * L64_ROW + lkc) = QA[i]; }
#define GT_COMPUTE(CUR) { _Pragma("unroll") for (int ks = 0; ks < 2; ++ks) { bf16x8 b[MI], a[NI]; \
    _Pragma("unroll") for (int i = 0; i < MI; ++i) b[i] = *(const bf16x8*)((CUR) + (WR + wm * 16 * MI + i * 16 + (lane & 15)) * L64_ROW + ks * 32 + (lane >> 4) * 8); \
    _Pragma("unroll") for (int i = 0; i < NI; ++i) a[i] = *(const bf16x8*)((CUR) + (wn * 16 * NI + i * 16 + (lane & 15)) * L64_ROW + ks * 32 + (lane >> 4) * 8); \
    _Pragma("unroll") for (int ni = 0; ni < NI; ++ni) { \
        _Pragma("unroll") for (int mi = 0; mi < MI; ++mi) MFMA16_ACC(a[ni], b[mi], acc[ni][mi]); } } }
    GT_LOAD(qw0, qa0, 0)
    __syncthreads();
    GT_STORE(qw0, qa0, lds)
    __syncthreads();
    for (int kt = 0; kt < nk; kt += 2) {
        GT_LOAD(qw0, qa0, kt + 1)
        GT_COMPUTE(lds)
        GT_STORE(qw0, qa0, lds + BUF)
        __syncthreads();
        GT_LOAD(qw0, qa0, kt + 2)
        GT_COMPUTE(lds + BUF)
        GT_STORE(qw0, qa0, lds)
        __syncthreads();
    }
#undef GT_LOAD
#undef GT_STORE
#undef GT_COMPUTE
}
#define ZERO_ACC4(acc) { _Pragma("unroll") for (int i_ = 0; i_ < 4; ++i_) _Pragma("unroll") for (int j_ = 0; j_ < 4; ++j_) acc[i_][j_] = (f32x4){0.f, 0.f, 0.f, 0.f}; }
#define FOR_ACC(acc, n0, m0, BODY) { const int lane_ = otid() & 63, wave_ = otid() >> 6; \
    _Pragma("unroll") for (int ni_ = 0; ni_ < 4; ++ni_) _Pragma("unroll") for (int mi_ = 0; mi_ < 4; ++mi_) { \
        const int n = (n0) + (wave_ >> 1) * 64 + ni_ * 16 + (lane_ >> 4) * 4; const int m = (m0) + (wave_ & 1) * 64 + mi_ * 16 + (lane_ & 15); const f32x4 v = acc[ni_][mi_]; BODY } }
__device__ __forceinline__ u32x2 pack4(float a, float b, float c, float d) { u32x2 r; r.x = pack2bf(a, b); r.y = pack2bf(c, d); return r; }

__device__ __forceinline__ void convert_wt_job(const float* W, int K, int N, int Npad, bf16_t* out, int job, float* T, int ilv) {
    const int tid = otid();
    const int nkt = K / 64;
    const int n0 = (job / nkt) * 64, k0 = (job % nkt) * 64;
    __syncthreads();
    for (int idx = tid; idx < 4096; idx += NTHREADS) {
        int kk = idx >> 6, nn = idx & 63;
        int nr = n0 + nn; int src = ilv ? ((nr & 1) ? (N / 2 + (nr >> 1)) : (nr >> 1)) : nr;
        T[kk * 65 + nn] = (nr < N) ? W[(size_t)(k0 + kk) * N + src] : 0.f;
    }
    __syncthreads();
    {
        int nn = tid >> 2, part = tid & 3;
        unsigned w[8];
#pragma unroll
        for (int j = 0; j < 8; ++j) w[j] = pack2bf(T[(part * 16 + 2 * j) * 65 + nn], T[(part * 16 + 2 * j + 1) * 65 + nn]);
        u32x4* o = (u32x4*)(out + (size_t)(n0 + nn) * K + k0 + part * 16);
        o[0] = (u32x4){w[0], w[1], w[2], w[3]}; o[1] = (u32x4){w[4], w[5], w[6], w[7]};
    }
}
__device__ __forceinline__ void phase_convert_weights(const P& p, int l, char* smem, int bid, int nb) {
    float* T = (float*)smem;
    struct Item { const float* W; int K, N, Npad; bf16_t* out; };
    const Item items[12] = {
        {p.in[I_RW2] + ((size_t)l * 2 + 0) * 64 * RW, 64, RW, NPAD(RW), p.WT_W2},
        {p.in[I_RW2] + ((size_t)l * 2 + 1) * 64 * RW, 64, RW, NPAD(RW), p.WT_W2 + (size_t)NPAD(RW) * 64},
        {p.in[I_RA2] + ((size_t)l * 2 + 0) * 64 * RW, 64, RW, NPAD(RW), p.WT_A2},
        {p.in[I_RA2] + ((size_t)l * 2 + 1) * 64 * RW, 64, RW, NPAD(RW), p.WT_A2 + (size_t)NPAD(RW) * 64},
        {p.in[I_WIN] + (size_t)l * D_MODEL * D_IN, D_MODEL, D_IN, NPAD192(D_IN), p.WT_IN},
        {p.in[I_RG2] + (size_t)l * 128 * RW, 128, RW, RW, p.WT_G2},
        {p.in[I_S5GLU] + (size_t)l * SW * 2 * SW, SW, 2 * SW, 2 * SW, p.WT_GLU},
        {p.in[I_WBR] + ((size_t)l * 3 + 0) * BW * D_MODEL, BW, D_MODEL, D_MODEL, p.WT_BR},
        {p.in[I_WBR] + ((size_t)l * 3 + 1) * BW * D_MODEL, BW, D_MODEL, D_MODEL, p.WT_BR + (size_t)D_MODEL * BW},
        {p.in[I_WBR] + ((size_t)l * 3 + 2) * BW * D_MODEL, BW, D_MODEL, D_MODEL, p.WT_BR + (size_t)2 * D_MODEL * BW},
        {p.in[I_WOUT] + (size_t)l * D_MODEL * D_MODEL, D_MODEL, D_MODEL, D_MODEL, p.WT_OUT},
        {p.in[I_PWQ] + (size_t)l * D_MODEL * PQ, D_MODEL, PQ, PQ, p.WT_Q}};
    int base = 0;
#pragma unroll
    for (int it = 0; it < 12; ++it) {
        const int nj = (items[it].Npad / 64) * (items[it].K / 64);
        for (int j = (bid + nb - (base % nb)) % nb; j < nj; j += nb)
            convert_wt_job(items[it].W, items[it].K, items[it].N, items[it].Npad, items[it].out, j, T, it == 6);
        base += nj;
    }
    __syncthreads();
    {
        const float* ks = p.in[I_PKEYS] + (size_t)l * PH * 2 * 128 * 128;
        for (size_t i = (size_t)bid * NTHREADS + otid(); i < (size_t)PH * 2 * 128 * 128; i += (size_t)nb * NTHREADS) {
            const float v = ks[i]; const bf16_t hb = f2bf(v);
            p.KHI[i] = hb; p.KLO[i] = f2bf(v - bf2f(hb));
        }
    }
}

#ifdef EMU
__device__ __forceinline__ int xcd_rank() { return obid(); }
#else
__device__ __forceinline__ int xcd_rank() { return (int)((volatile LAS unsigned*)(unsigned)(SMEM_BYTES))[2]; }
#endif
__device__ __forceinline__ bool tile_map(int it, int ntm, int ntn, int PM, int& mt, int& nt) {
    const int G = gridDim.x;
    const long id = (long)it * G + xcd_rank();
    if (id >= (long)ntm * ntn) return false;
    const int full = ntm / PM; const long fullsz = (long)full * PM * ntn;
    if (id < fullsz) { const int p = (int)(id / (PM * ntn)), rem = (int)(id % (PM * ntn)); nt = rem / PM; mt = p * PM + rem % PM; }
    else { const int rem = (int)(id - fullsz), hh = ntm - full * PM; nt = rem / hh; mt = full * PM + rem % hh; }
    return true;
}

template <int NI, int MI, class Pre, class Post>
__device__ __forceinline__ void gemm_tile_run(const bf16_t* Wt, int ldw, size_t wbytes, const bf16_t* Act, int lda, size_t abytes, int K, int n0, int m0, bf16_t* lds, Pre pre, Post post) {
    f32x4 acc[NI][MI];
#pragma unroll
    for (int i = 0; i < NI; ++i)
#pragma unroll
        for (int j = 0; j < MI; ++j) acc[i][j] = (f32x4){0.f, 0.f, 0.f, 0.f};
    pre(m0, n0, acc, lds);
    mfma_gemm_tile_t<NI, MI>(Wt, ldw, wbytes, Act, lda, abytes, K, n0, m0, lds, acc);
    const int lane = otid() & 63, wave = otid() >> 6;
#pragma unroll
    for (int ni = 0; ni < NI; ++ni)
#pragma unroll
        for (int mi = 0; mi < MI; ++mi)
            post(ni, mi, m0 + (wave & 1) * 16 * MI + mi * 16 + (lane & 15), n0 + (wave >> 1) * 16 * NI + ni * 16 + (lane >> 4) * 4, acc[ni][mi]);
}
struct NoPre { template <class A> __device__ __forceinline__ void operator()(int, int, A&, bf16_t*) const {} };
template <int NI, class PreM, class PreT, class Post>
__device__ __forceinline__ void gemm_phase(const bf16_t* Wt, int ldw, size_t wbytes, const bf16_t* Act, int lda, size_t abytes, int K, int N, bf16_t* lds, PreM prem, PreT pret, Post post) {
    const int ntn = N / (32 * NI), ntm = MTOT / 256 - 1;
    const int PM = (ntn >= 16) ? 2 : ((ntn >= 8) ? 4 : 8);
    for (int it = 0;; ++it) {
        int mt_, nt_; if (!tile_map(it, ntm, ntn, PM, mt_, nt_)) break;
        gemm_tile_run<NI, 8>(Wt, ldw, wbytes, Act, lda, abytes, K, nt_ * 32 * NI, mt_ * 256, lds, prem, post);
    }
    for (int job = obid(); job < 4 * ntn; job += gridDim.x)
        gemm_tile_run<NI, 2>(Wt, ldw, wbytes, Act, lda, abytes, K, (job >> 2) * 32 * NI, MTOT - 256 + (job & 3) * 64, lds, pret, post);
}

__device__ __forceinline__ void phase_init(const P& p, char* smem) {
    const int tid = otid();
    float* sc = (float*)smem;
    for (int i = tid; i < D_MODEL; i += NTHREADS) { sc[i] = siluf_(p.in[I_CCTX][i]); sc[D_MODEL + i] = siluf_(p.in[I_C][i]); }
    __syncthreads();
    const int ncolblk = (6 * D_MODEL) / NTHREADS;
    for (int job = obid(); job < DEPTH * ncolblk; job += gridDim.x) {
        int l = job / ncolblk, n = (job % ncolblk) * NTHREADS + tid;
        const float* w = p.in[I_WMOD] + (size_t)l * D_MODEL * 6 * D_MODEL + n;
        float a0 = 0.f, a1 = 0.f;
        for (int k = 0; k < D_MODEL; ++k) { float wv = w[(size_t)k * 6 * D_MODEL]; a0 += sc[k] * wv; a1 += sc[D_MODEL + k] * wv; }
        float b = p.in[I_BMOD][l * 6 * D_MODEL + n];
        p.MOD[(size_t)(l * 2 + 0) * 6 * D_MODEL + n] = a0 + b;
        p.MOD[(size_t)(l * 2 + 1) * 6 * D_MODEL + n] = a1 + b;
    }
    const size_t gtid = (size_t)obid() * NTHREADS + tid, gn = (size_t)gridDim.x * NTHREADS;
    for (size_t i = gtid; i < (size_t)CTX * D_MODEL; i += gn) p.X[i] = p.in[I_CTX][i];
    for (size_t i = gtid; i < (size_t)SEQ * D_MODEL; i += gn) p.X[(size_t)CTX * D_MODEL + i] = p.in[I_X][i];
    __syncthreads();
}

__device__ __forceinline__ void phase_s5const(const P& p, int l) {
    const size_t gtid = (size_t)obid() * NTHREADS + otid(), gn = (size_t)gridDim.x * NTHREADS;
    for (size_t i = gtid; i < (size_t)2 * SG * 64; i += gn) {
        int d = (int)(i / (SG * 64)), g = (int)((i / 64) % SG), s = (int)(i % 64);
        size_t li = ((size_t)(l * 2 + d) * SG + g) * 64 + s;
        float lre = p.in[I_S5LRE][li], lim = p.in[I_S5LIM][li];
        float dt = expf(p.in[I_S5LS][(l * 2 + d) * SG + g]);
        float mag = expf(lre * dt);
        float are = mag * cosf(lim * dt), aim = mag * sinf(lim * dt);
        float den = lre * lre + lim * lim;
        float fre = ((are - 1.0f) * lre + aim * lim) / den;
        float fim = (aim * lre - (are - 1.0f) * lim) / den;
        p.S5A[i * 2 + 0] = are; p.S5A[i * 2 + 1] = aim;
        const float* bre = p.in[I_S5BRE] + (((size_t)l * SG + g) * 64 + s) * 16;
        const float* bim = p.in[I_S5BIM] + (((size_t)l * SG + g) * 64 + s) * 16;
        for (int c = 0; c < 16; ++c) {
            p.S5BB[(i * 16 + c) * 2 + 0] = fre * bre[c] - fim * bim[c];
            p.S5BB[(i * 16 + c) * 2 + 1] = fre * bim[c] + fim * bre[c];
        }
    }
}

__device__ __forceinline__ void phase_norm(const P& p, int l, int which) {
    const int lane = otid() & 63;
    const int gw = (obid() * NTHREADS + otid()) >> 6, nw = (gridDim.x * NTHREADS) >> 6;
    const float* g = p.in[which ? I_N2G : I_N1G] + l * D_MODEL;
    constexpr int NJ = (D_MODEL + 255) / 256;
    for (int t = gw; t < MTOT; t += nw) {
        const float* x = p.X + (size_t)t * D_MODEL;
        const float* mod = p.MOD + (size_t)(l * 2 + (t >= CTX ? 1 : 0)) * 6 * D_MODEL + (which ? 3 * D_MODEL : 0);
        float4 v[NJ]; float ss = 0.f;
#pragma unroll
        for (int j = 0; j < NJ; ++j) {
            const int e = j * 256 + lane * 4;
            if (e < D_MODEL) v[j] = *(const float4*)(x + e); else { v[j].x = 0.f; v[j].y = 0.f; v[j].z = 0.f; v[j].w = 0.f; }
            ss += v[j].x * v[j].x + v[j].y * v[j].y + v[j].z * v[j].z + v[j].w * v[j].w;
        }
        ss = wave_sum(ss);
        const float rstd = rsqrtf(ss / D_MODEL + 1e-6f);
#pragma unroll
        for (int j = 0; j < NJ; ++j) {
            const int e = j * 256 + lane * 4;
            if (e < D_MODEL) {
                const float4 gg = *(const float4*)(g + e), sc = *(const float4*)(mod + D_MODEL + e), sh = *(const float4*)(mod + e);
                *(u32x2*)(p.H + (size_t)t * D_MODEL + e) = pack4(v[j].x * rstd * gg.x * (1.0f + sc.x) + sh.x, v[j].y * rstd * gg.y * (1.0f + sc.y) + sh.y,
                                                                 v[j].z * rstd * gg.z * (1.0f + sc.z) + sh.z, v[j].w * rstd * gg.w * (1.0f + sc.w) + sh.w);
            }
        }
    }
}

__device__ __forceinline__ void phase_gemm_in(const P& p, int l, char* smem) {
    constexpr int NI = 4, MI = 8;
    const int ntn = NPAD192(D_IN) / 128, ntm = MTOT / 256;
    for (int it = 0;; ++it) {
        int mt_, nt_; if (!tile_map(it, ntm, ntn, 4, mt_, nt_)) break;
        const int m0 = mt_ * 256, n0 = nt_ * 128;
        f32x4 acc[NI][MI];
#pragma unroll
        for (int i = 0; i < NI; ++i)
#pragma unroll
            for (int j = 0; j < MI; ++j) acc[i][j] = (f32x4){0.f, 0.f, 0.f, 0.f};
        mfma_gemm_tile_t<NI, MI>(p.WT_IN, D_MODEL, (size_t)NPAD192(D_IN) * D_MODEL * 2, p.H, D_MODEL, (size_t)MTOT * D_MODEL * 2, D_MODEL, n0, m0, (bf16_t*)smem, acc);
        const int lane = otid() & 63, wave = otid() >> 6;
#pragma unroll
        for (int ni = 0; ni < NI; ++ni)
#pragma unroll
            for (int mi = 0; mi < MI; ++mi) {
                const int n = n0 + (wave >> 1) * 16 * NI + ni * 16 + (lane >> 4) * 4, m = m0 + (wave & 1) * 16 * MI + mi * 16 + (lane & 15);
                const u32x2 pk_ = pack4(acc[ni][mi][0], acc[ni][mi][1], acc[ni][mi][2], acc[ni][mi][3]);
                if (n < ZG) *(u32x2*)(p.Z + (size_t)m * ZLD + n) = pk_;
                else if (n < D_IN) *(u32x2*)(p.ZGT + ((((size_t)(m >> 4) * (3 * D_MODEL / 16) + ((n - ZG) >> 4)) * 64 + lane) * 4)) =
                    pack4(sigmoidf_(acc[ni][mi][0]), sigmoidf_(acc[ni][mi][1]), sigmoidf_(acc[ni][mi][2]), sigmoidf_(acc[ni][mi][3]));
            }
    }
}

__device__ __forceinline__ void unpack8(const u32x4 w, float (&f)[8]) {
    f[0] = LO16(w.x); f[1] = HI16(w.x); f[2] = LO16(w.y); f[3] = HI16(w.y); f[4] = LO16(w.z); f[5] = HI16(w.z); f[6] = LO16(w.w); f[7] = HI16(w.w);
}
__device__ __forceinline__ u32x4 pack8(const float (&f)[8]) {
    u32x4 o; o.x = pack2bf(f[0], f[1]); o.y = pack2bf(f[2], f[3]);
    o.z = pack2bf(f[4], f[5]); o.w = pack2bf(f[6], f[7]); return o;
}
__device__ __forceinline__ void load8f(const float* p, float (&f)[8]) {
    const float4 a = *(const float4*)p, b = *(const float4*)(p + 4);
    f[0] = a.x; f[1] = a.y; f[2] = a.z; f[3] = a.w; f[4] = b.x; f[5] = b.y; f[6] = b.z; f[7] = b.w;
}
__device__ __forceinline__ void store8f(float* p, const float (&f)[8]) {
    float4 a, b; a.x = f[0]; a.y = f[1]; a.z = f[2]; a.w = f[3]; b.x = f[4]; b.y = f[5]; b.z = f[6]; b.w = f[7];
    *(float4*)p = a; *(float4*)(p + 4) = b;
}
__device__ __forceinline__ void conv8(const bf16_t* zp, const float* conv, int c0, bool act, bool first, bool last, float (&out)[8]) {
    const u32x4 z4 = {0u, 0u, 0u, 0u};
    const u32x4 a0 = act ? *(const u32x4*)(zp + c0) : z4;
    const u32x4 am = (act && !first) ? *(const u32x4*)(zp + c0 - ZLD) : z4;
    const u32x4 an = (act && !last) ? *(const u32x4*)(zp + c0 + ZLD) : z4;
    float w0[8], w1[8], w2[8], f0[8], fm[8], fn[8];
    if (act) { load8f(conv + c0, w0); load8f(conv + RWKV_IN + c0, w1); load8f(conv + 2 * RWKV_IN + c0, w2); }
    else {
#pragma unroll
        for (int e = 0; e < 8; ++e) { w0[e] = 0.f; w1[e] = 0.f; w2[e] = 0.f; }
    }
    unpack8(a0, f0); unpack8(am, fm); unpack8(an, fn);
#pragma unroll
    for (int e = 0; e < 8; ++e) out[e] = w1[e] * f0[e] + w0[e] * fm[e] + w2[e] * fn[e];
}
__device__ __forceinline__ void phase_rwkv_prep1(const P& p, int l) {
    const int lane = otid() & 63;
    const int gw = (obid() * NTHREADS + otid()) >> 6, nw = (gridDim.x * NTHREADS) >> 6;
    const float* conv = p.in[I_RCONV] + (size_t)l * 3 * RWKV_IN;
    const float* k_k = p.in[I_RKK] + (size_t)l * RW;
    const bool act = lane * 8 < RW, act2 = lane * 8 < 384;
    float kkw[8];
    if (act) load8f(k_k + lane * 8, kkw);
    else {
#pragma unroll
        for (int e = 0; e < 8; ++e) kkw[e] = 0.f;
    }
    for (int t = gw; t < MTOT; t += nw) {
        const bool first = (t == 0) || (t == CTX), last = (t == CTX - 1) || (t == MTOT - 1);
        const bf16_t* zp = p.Z + (size_t)t * ZLD + ZR;
        float rv[8], kv[8], vv[8], lr[8];
        conv8(zp, conv, 0 * RW + lane * 8, act, first, last, rv);
        conv8(zp, conv, 1 * RW + lane * 8, act, first, last, kv);
        conv8(zp, conv, 2 * RW + lane * 8, act, first, last, vv);
        conv8(zp, conv, 3 * RW + lane * 8, act2, first, last, lr);
        float kk[8]; float ss = 0.f;
#pragma unroll
        for (int e = 0; e < 8; ++e) { kk[e] = kv[e] * kkw[e]; ss += kk[e] * kk[e]; }
        ss += __shfl_xor(ss, 1, 64); ss += __shfl_xor(ss, 2, 64); ss += __shfl_xor(ss, 4, 64);
        const float inv = 1.0f / fmaxf(sqrtf(ss), 1e-12f);
#pragma unroll
        for (int e = 0; e < 8; ++e) kk[e] *= inv;
        if (act) {
            const size_t o = (size_t)t * RW + lane * 8;
            *(u32x4*)(p.R + o) = pack8(rv); *(u32x4*)(p.KS + o) = pack8(kv); *(u32x4*)(p.V + o) = pack8(vv); *(u32x4*)(p.KK + o) = pack8(kk);
        }
        if (act2) {
            const int cc = lane * 8;
            if (cc < 128) {
#pragma unroll
                for (int e = 0; e < 8; ++e) lr[e] = tanhf_(lr[e]);
                *(u32x4*)(p.LR + (size_t)t * 256 + cc) = pack8(lr);
            } else if (cc < 256) {
                *(u32x4*)(p.LR + (size_t)t * 256 + cc) = pack8(lr);
            } else {
#pragma unroll
                for (int e = 0; e < 8; ++e) lr[e] = sigmoidf_(lr[e]);
                *(u32x4*)(p.GS + (size_t)t * 128 + cc - 256) = pack8(lr);
            }
        }
    }
}
__device__ __forceinline__ void phase_rwkv_prep2(const P& p, int l, char* smem) {
    const int ntm = MTOT / 128, ntn = NPAD(RW) / 128;
    const float* k_a = p.in[I_RKA] + (size_t)l * RW;
    const float* r_k = p.in[I_RRK] + (size_t)l * RW;
    for (int job = obid(); job < ntm * ntn * 2; job += gridDim.x) {
        const int d = job % 2, n0 = ((job / 2) % ntn) * 128, m0 = (job / (2 * ntn)) * 128;
        const float* w0 = p.in[I_RW0] + (size_t)(l * 2 + d) * RW;
        const float* a0 = p.in[I_RA0] + (size_t)(l * 2 + d) * RW;
        f32x4 accw[4][4], acca[4][4]; ZERO_ACC4(accw); ZERO_ACC4(acca);
        mfma_gemm_tile(p.WT_W2 + (size_t)d * NPAD(RW) * 64, 64, p.LR + d * 64, 256, 64, n0, m0, (bf16_t*)smem, accw);
        mfma_gemm_tile(p.WT_A2 + (size_t)d * NPAD(RW) * 64, 64, p.LR + 128 + d * 64, 256, 64, n0, m0, (bf16_t*)smem, acca);
        const int lane = otid() & 63, wave = otid() >> 6;
#pragma unroll
        for (int mi = 0; mi < 4; ++mi) {
            const int m = m0 + (wave & 1) * 64 + mi * 16 + (lane & 15);
            float bon = 0.f;
#pragma unroll
            for (int ni = 0; ni < 4; ++ni) {
                const int n = n0 + (wave >> 1) * 64 + ni * 16 + (lane >> 4) * 4;
                if (n < RW) {
                    const u32x2 kq = *(const u32x2*)(p.KS + (size_t)m * RW + n), kkq = *(const u32x2*)(p.KK + (size_t)m * RW + n), rq = *(const u32x2*)(p.R + (size_t)m * RW + n);
                    const float kv[4] = {LO16(kq.x), HI16(kq.x), LO16(kq.y), HI16(kq.y)};
                    const float kkv[4] = {LO16(kkq.x), HI16(kkq.x), LO16(kkq.y), HI16(kkq.y)};
                    const float rv[4] = {LO16(rq.x), HI16(rq.x), LO16(rq.y), HI16(rq.y)};
                    float lw[4], kd[4], bb[4];
#pragma unroll
                    for (int e = 0; e < 4; ++e) {
                        const float x = w0[n + e] + accw[ni][mi][e];
                        lw[e] = -fexp_(-softplusf_(-x) - 0.5f);
                        const float aa = sigmoidf_(a0[n + e] + acca[ni][mi][e]);
                        kd[e] = kv[e] * (1.0f + (aa - 1.0f) * k_a[n + e]);
                        bb[e] = kkv[e] * aa;
                        bon += rv[e] * kd[e] * r_k[n + e];
                    }
                    const size_t o = ((size_t)d * MTOT + m) * RW + n;
                    float4 lo4; lo4.x = lw[0]; lo4.y = lw[1]; lo4.z = lw[2]; lo4.w = lw[3];
                    *(float4*)(p.LW + o) = lo4;
                    *(u32x2*)(p.KD + o) = pack4(kd[0], kd[1], kd[2], kd[3]);
                    *(u32x2*)(p.BB + o) = pack4(bb[0], bb[1], bb[2], bb[3]);
                }
            }
            bon += __shfl_xor(bon, 16, 64); bon += __shfl_xor(bon, 32, 64);
            const int hh = (n0 + (wave >> 1) * 64) >> 6;
            if ((lane >> 4) == 0 && hh < RH) p.BONUS[((size_t)d * MTOT + m) * RH + hh] = bon;
        }
    }
}

#define CH_ROW 72
#define SEQ_REC 16640
#define CH_SLOT (64 * CH_ROW)
#define CH_XR_OFF (7 * CH_SLOT * 2)
#define CH_AAB_OFF (CH_XR_OFF + 64 * 132 * 4)
#define CH_GC_OFF (CH_AAB_OFF + 64 * 72 * 4)
template <int MT, int NT>
__device__ __forceinline__ void lds_mm(const bf16_t* A, int m0, const bf16_t* Bt, int n0, f32x4 (&acc)[MT][NT]) {
    const int lane = otid() & 63, q = lane >> 4, r = lane & 15;
#pragma unroll
    for (int s = 0; s < 2; ++s) {
        bf16x8 a[MT], b[NT];
#pragma unroll
        for (int i = 0; i < MT; ++i) a[i] = *(const bf16x8*)(A + (m0 + i * 16 + r) * CH_ROW + s * 32 + q * 8);
#pragma unroll
        for (int i = 0; i < NT; ++i) b[i] = *(const bf16x8*)(Bt + (n0 + i * 16 + r) * CH_ROW + s * 32 + q * 8);
#pragma unroll
        for (int i = 0; i < MT; ++i)
#pragma unroll
            for (int jj = 0; jj < NT; ++jj) acc[i][jj] = MFMA16(a[i], b[jj], acc[i][jj]);
    }
}
__device__ __forceinline__ void rwkv_chunk_job(const P& p, int job, char* smem) {
    const int tid = otid(), lane = tid & 63, wv = tid >> 6, q = lane >> 4, r = lane & 15;
    const int d = job / (NC * RH), n = (job / RH) % NC, h = job % RH;
    const size_t base = (size_t)(d * NC + n) * RH + h;
    bf16_t* S0 = (bf16_t*)smem; bf16_t* S1 = S0 + CH_SLOT; bf16_t* S2 = S1 + CH_SLOT; bf16_t* S3 = S2 + CH_SLOT;
    bf16_t* S4 = S3 + CH_SLOT; bf16_t* S5 = S4 + CH_SLOT; bf16_t* S6 = S5 + CH_SLOT;
    float* X = (float*)(smem + CH_XR_OFF);
    float* AABt = (float*)(smem + CH_AAB_OFF);
    bf16_t* U0t = (bf16_t*)(smem + CH_AAB_OFF);
    bf16_t* Aht = U0t + CH_SLOT;
    float* GC = (float*)(smem + CH_GC_OFF);
    __syncthreads();
    u32x4 gkk[2], gr[2], gv[2], gkd[2], gbb[2]; float lw[2][8];
#pragma unroll
    for (int it = 0; it < 2; ++it) {
        const int c = tid + 256 * it, i = c >> 3, k0 = (c & 7) * 8; const int tok = 64 * n + (d ? 63 - i : i);
        const size_t o1 = (size_t)tok * RW + h * 64 + k0, o2 = ((size_t)d * MTOT + tok) * RW + h * 64 + k0;
        load8f(p.LW + o2, lw[it]);
        gkk[it] = *(const u32x4*)(p.KK + o1); gr[it] = *(const u32x4*)(p.R + o1); gv[it] = *(const u32x4*)(p.V + o1);
        gkd[it] = *(const u32x4*)(p.KD + o2); gbb[it] = *(const u32x4*)(p.BB + o2);
    }
#pragma unroll
    for (int it = 0; it < 2; ++it) { const int c = tid + 256 * it; store8f(X + (c >> 3) * 132 + (c & 7) * 8, lw[it]); }
    __syncthreads();
    {
        const int k = tid & 63, seg = tid >> 6;
        float v[16]; float run = 0.f;
#pragma unroll
        for (int e = 0; e < 16; ++e) { run += X[(seg * 16 + e) * 132 + k]; v[e] = run; }
        AABt[seg * 64 + k] = run;
        __syncthreads();
        float off = 0.f;
        for (int s2 = 0; s2 < seg; ++s2) off += AABt[s2 * 64 + k];
#pragma unroll
        for (int e = 0; e < 16; ++e) X[(seg * 16 + e) * 132 + k] = v[e] + off;
    }
    __syncthreads();
#pragma unroll
    for (int it = 0; it < 2; ++it) {
        const int c = tid + 256 * it, i = c >> 3, k0 = (c & 7) * 8;
        float L[8], Lp[8], LC[8], kkv[8], rv[8], vv[8], kdv[8], bbv[8];
        load8f(X + i * 132 + k0, L); load8f(X + 63 * 132 + k0, LC);
        if (i > 0) load8f(X + (i - 1) * 132 + k0, Lp);
        else {
#pragma unroll
            for (int e = 0; e < 8; ++e) Lp[e] = 0.f;
        }
        unpack8(gkk[it], kkv); unpack8(gr[it], rv); unpack8(gv[it], vv); unpack8(gkd[it], kdv); unpack8(gbb[it], bbv);
        float at[8], rt[8], bt[8], kt[8], bh[8], kh[8];
#pragma unroll
        for (int e = 0; e < 8; ++e) {
            const float eL = fexp_(L[e]), eLp = fexp_(Lp[e]), eNL = fexp_(-L[e]), eCL = fexp_(LC[e] - L[e]);
            at[e] = -kkv[e] * eLp; rt[e] = rv[e] * eL; bt[e] = bbv[e] * eNL; kt[e] = kdv[e] * eNL; bh[e] = bbv[e] * eCL; kh[e] = kdv[e] * eCL;
            if (i == 63) GC[k0 + e] = eL;
        }
        *(u32x4*)(S0 + i * CH_ROW + k0) = pack8(at);
        store8f(X + i * 132 + 64 + k0, at);
        *(u32x4*)(S1 + i * CH_ROW + k0) = pack8(rt);
        *(u32x4*)(S2 + i * CH_ROW + k0) = pack8(bt);
        *(u32x4*)(S3 + i * CH_ROW + k0) = pack8(kt);
#pragma unroll
        for (int e = 0; e < 8; ++e) {
            S4[(k0 + e) * CH_ROW + i] = f2bf(vv[e]);
            S5[(k0 + e) * CH_ROW + i] = f2bf(bh[e]);
            S6[(k0 + e) * CH_ROW + i] = f2bf(kh[e]);
        }
    }
    __syncthreads();
    {
        f32x4 acc[4][4]; ZERO_ACC4(acc);
        lds_mm<4, 4>((wv < 2) ? S0 : S1, 0, (wv & 1) ? S3 : S2, 0, acc);
        __syncthreads();
#pragma unroll
        for (int mt = 0; mt < 4; ++mt)
#pragma unroll
            for (int nt = 0; nt < 4; ++nt) {
                const int jc = nt * 16 + r, i0 = mt * 16 + 4 * q;
                if (wv == 0) {
                    f32x4 o;
#pragma unroll
                    for (int e = 0; e < 4; ++e) o[e] = (jc < i0 + e) ? acc[mt][nt][e] : 0.f;
                    *(f32x4*)(AABt + jc * 72 + i0) = o;
                } else {
                    bf16_t* dst = (wv == 1) ? S0 : ((wv == 2) ? S2 : S3);
#pragma unroll
                    for (int e = 0; e < 4; ++e) {
                        const bool ok = (wv == 1) ? (jc < i0 + e) : (jc <= i0 + e);
                        dst[(i0 + e) * CH_ROW + jc] = f2bf(ok ? acc[mt][nt][e] : 0.f);
                    }
                }
            }
    }
    __syncthreads();
    {
        f32x4 acc[1][4];
#pragma unroll
        for (int nt = 0; nt < 4; ++nt) acc[0][nt] = (f32x4){0.f, 0.f, 0.f, 0.f};
        lds_mm<1, 4>(S0, 16 * wv, S4, 0, acc);
#pragma unroll
        for (int nt = 0; nt < 4; ++nt)
#pragma unroll
            for (int e = 0; e < 4; ++e) X[(16 * wv + 4 * q + e) * 132 + nt * 16 + r] = acc[0][nt][e];
    }
    __syncthreads();
    if (tid < 128) {
        const int c = tid;
        for (int bi = 0; bi < 4; ++bi) {
            float acc[16];
#pragma unroll
            for (int e = 0; e < 16; ++e) acc[e] = X[(16 * bi + e) * 132 + c];
            for (int jj = 0; jj < 16 * bi; ++jj) {
                const float uj = X[jj * 132 + c];
                const f32x4* ap = (const f32x4*)(AABt + jj * 72 + 16 * bi);
                const f32x4 a0 = ap[0], a1 = ap[1], a2 = ap[2], a3 = ap[3];
#pragma unroll
                for (int e = 0; e < 4; ++e) { acc[e] += a0[e] * uj; acc[4 + e] += a1[e] * uj; acc[8 + e] += a2[e] * uj; acc[12 + e] += a3[e] * uj; }
            }
#pragma unroll
            for (int e = 0; e < 16; ++e) {
                const float u = acc[e];
                X[(16 * bi + e) * 132 + c] = u;
                const f32x4* ap = (const f32x4*)(AABt + (16 * bi + e) * 72 + 16 * bi);
                const f32x4 a0 = ap[0], a1 = ap[1], a2 = ap[2], a3 = ap[3];
#pragma unroll
                for (int e2 = 0; e2 < 16; ++e2) if (e2 > e) acc[e2] += ((e2 < 4) ? a0[e2 & 3] : (e2 < 8) ? a1[e2 & 3] : (e2 < 12) ? a2[e2 & 3] : a3[e2 & 3]) * u;
            }
        }
    }
    __syncthreads();
    if (tid < 128) {
        const int c = tid;
        bf16_t* dst = (c < 64) ? (U0t + c * CH_ROW) : (Aht + (c - 64) * CH_ROW);
        u32x4 ov[8];
#pragma unroll
        for (int g = 0; g < 8; ++g) {
            float v[8];
#pragma unroll
            for (int e = 0; e < 8; ++e) v[e] = X[(g * 8 + e) * 132 + c];
            ov[g].x = pack2bf(v[0], v[1]); ov[g].y = pack2bf(v[2], v[3]);
            ov[g].z = pack2bf(v[4], v[5]); ov[g].w = pack2bf(v[6], v[7]);
        }
#pragma unroll
        for (int g = 0; g < 8; ++g) *(u32x4*)(dst + g * 8) = ov[g];
    }
    __syncthreads();
    {
        f32x4 acc[4][4]; ZERO_ACC4(acc);
        char* rec = p.REC + base * SEQ_REC;
        if (wv == 0) {
            lds_mm<4, 4>(Aht, 0, S5, 0, acc);
#pragma unroll
            for (int nt = 0; nt < 4; ++nt)
#pragma unroll
                for (int s2 = 0; s2 < 2; ++s2) {
                    u32x4 o;
                    o.x = pack2bf(acc[2 * s2][nt][0], acc[2 * s2][nt][1]); o.y = pack2bf(acc[2 * s2][nt][2], acc[2 * s2][nt][3]);
                    o.z = pack2bf(acc[2 * s2 + 1][nt][0], acc[2 * s2 + 1][nt][1]); o.w = pack2bf(acc[2 * s2 + 1][nt][2], acc[2 * s2 + 1][nt][3]);
                    *(u32x4*)(rec + (((nt * 2 + s2) * 64 + lane) * 8) * 2) = o;
                }
        } else if (wv == 1) {
            lds_mm<4, 4>(S5, 0, U0t, 0, acc);
            lds_mm<4, 4>(S6, 0, S4, 0, acc);
#pragma unroll
            for (int mt = 0; mt < 4; ++mt)
#pragma unroll
                for (int nt = 0; nt < 4; ++nt) *(u32x2*)(rec + 8192 + (((nt * 4 + mt) * 64 + lane) * 4) * 2) = pack4(acc[mt][nt][0], acc[mt][nt][1], acc[mt][nt][2], acc[mt][nt][3]);
        } else if (wv == 2) {
            lds_mm<4, 4>(S2, 0, Aht, 0, acc);
#pragma unroll
            for (int mt = 0; mt < 4; ++mt)
#pragma unroll
                for (int nt = 0; nt < 4; ++nt)
#pragma unroll
                    for (int e = 0; e < 4; ++e) {
                        const int t = mt * 16 + 4 * q + e, kc = nt * 16 + r;
                        p.QH[(base * 64 + t) * 64 + kc] = f2bf(acc[mt][nt][e] + bf2f(S1[t * CH_ROW + kc]));
                    }
        } else if (wv == 3) {
            lds_mm<4, 4>(S2, 0, U0t, 0, acc);
            lds_mm<4, 4>(S3, 0, S4, 0, acc);
#pragma unroll
            for (int mt = 0; mt < 4; ++mt)
#pragma unroll
                for (int nt = 0; nt < 4; ++nt) *(f32x4*)(p.Y0T + (((base * 4 + mt) * 4 + nt) * 64 + lane) * 4) = acc[mt][nt];
        }
        if (tid < 64) ((float*)(rec + 16384))[tid] = GC[tid];
    }
}

#define SEQ_SLOT 16896
__device__ __forceinline__ void rwkv_seq_gload(const P& p, size_t base, int tid, u32x4 (&g)[5]) {
    const u32x4* m = (const u32x4*)(p.REC + base * SEQ_REC);
#pragma unroll
    for (int i = 0; i < 4; ++i) g[i] = m[tid + 256 * i];
    if (tid < 16) g[4] = m[1024 + tid];
}
__device__ __forceinline__ void rwkv_seq_lstore(char* slot, int tid, const u32x4 (&g)[5]) {
    u32x4* d = (u32x4*)slot;
#pragma unroll
    for (int i = 0; i < 4; ++i) d[tid + 256 * i] = g[i];
    if (tid < 16) d[1024 + tid] = g[4];
}
__device__ __forceinline__ void rwkv_seq_step(const P& p, const char* slot, size_t base, int wv, int lane, f32x4 (&X)[4]) {
    const int q = lane >> 4, r = lane & 15;
    const bf16_t* mt = (const bf16_t*)slot; const bf16_t* ntb = (const bf16_t*)(slot + 8192); const float* gc = (const float*)(slot + 16384);
    unsigned xh[4][2];
#pragma unroll
    for (int kt = 0; kt < 4; ++kt) {
        xh[kt][0] = pack2bf(X[kt][0], X[kt][1]); xh[kt][1] = pack2bf(X[kt][2], X[kt][3]);
        *(u32x2*)(p.SN + (base * 64 + 16 * wv + r) * 64 + 16 * kt + 4 * q) = (u32x2){xh[kt][0], xh[kt][1]};
    }
    bf16x8 bh[2];
#pragma unroll
    for (int s2 = 0; s2 < 2; ++s2) bh[s2] = __builtin_bit_cast(bf16x8, ((u32x4){xh[2 * s2][0], xh[2 * s2][1], xh[2 * s2 + 1][0], xh[2 * s2 + 1][1]}));
#pragma unroll
    for (int tile = 0; tile < 4; ++tile) {
        const u32x2 nb = *(const u32x2*)(ntb + ((wv * 4 + tile) * 64 + lane) * 4);
        const f32x4 g4 = *(const f32x4*)(gc + tile * 16 + 4 * q);
        f32x4 acc;
        acc[0] = g4[0] * X[tile][0] + LO16(nb.x); acc[1] = g4[1] * X[tile][1] + HI16(nb.x);
        acc[2] = g4[2] * X[tile][2] + LO16(nb.y); acc[3] = g4[3] * X[tile][3] + HI16(nb.y);
#pragma unroll
        for (int s2 = 0; s2 < 2; ++s2) {
            const bf16x8 ah = *(const bf16x8*)(mt + ((tile * 2 + s2) * 64 + lane) * 8);
            acc = MFMA16(ah, bh[s2], acc);
        }
        X[tile] = acc;
    }
}
__device__ __forceinline__ void rwkv_seq_job(const P& p, int job, char* smem) {
    const int tid = otid(), lane = tid & 63, wv = tid >> 6;
    const int d = job / RH, h = job % RH;
    f32x4 X[4];
#pragma unroll
    for (int kt = 0; kt < 4; ++kt) X[kt] = (f32x4){0.f, 0.f, 0.f, 0.f};
    u32x4 g0[5], g1[5], g2[5];
#define SEQ_BASE(s_) ((size_t)(d * NC + chunk_order(d, ((s_) < NC) ? (s_) : NC - 1)) * RH + h)
    __syncthreads();
    rwkv_seq_gload(p, SEQ_BASE(0), tid, g0);
    rwkv_seq_gload(p, SEQ_BASE(1), tid, g1);
    rwkv_seq_gload(p, SEQ_BASE(2), tid, g2);
    rwkv_seq_lstore(smem, tid, g0);
    __syncthreads();
    for (int s = 0; s < NC; s += 6) {
#define SEQ_SUB(u, GFREE, GNEXT) \
        if (s + (u) < NC) { \
            rwkv_seq_gload(p, SEQ_BASE(s + (u) + 3), tid, GFREE); \
            rwkv_seq_step(p, smem + (((u) & 1) ? SEQ_SLOT : 0), SEQ_BASE(s + (u)), wv, lane, X); \
            rwkv_seq_lstore(smem + (((u) & 1) ? 0 : SEQ_SLOT), tid, GNEXT); \
        } \
        __syncthreads();
        SEQ_SUB(0, g0, g1)
        SEQ_SUB(1, g1, g2)
        SEQ_SUB(2, g2, g0)
        SEQ_SUB(3, g0, g1)
        SEQ_SUB(4, g1, g2)
        SEQ_SUB(5, g2, g0)
#undef SEQ_SUB
    }
#undef SEQ_BASE
}
struct RoBuf { bf16x8 a[2]; bf16x8 b[4][2]; f32x4 y0[4]; };
__device__ __forceinline__ void rwkv_out_load(const P& p, int job, int wv, int lane, RoBuf& o) {
    const int q = lane >> 4, r = lane & 15;
    const size_t base = (size_t)job;
#pragma unroll
    for (int s2 = 0; s2 < 2; ++s2) {
        o.a[s2] = *(const bf16x8*)(p.QH + (base * 64 + 16 * wv + r) * 64 + s2 * 32 + q * 8);
#pragma unroll
        for (int nt = 0; nt < 4; ++nt) o.b[nt][s2] = *(const bf16x8*)(p.SN + (base * 64 + nt * 16 + r) * 64 + s2 * 32 + q * 8);
    }
#pragma unroll
    for (int nt = 0; nt < 4; ++nt) o.y0[nt] = *(const f32x4*)(p.Y0T + (((base * 4 + wv) * 4 + nt) * 64 + lane) * 4);
}
__device__ __forceinline__ void rwkv_out_compute(const P& p, int job, int wv, int lane, const RoBuf& o) {
    const int q = lane >> 4, r = lane & 15;
    const int d = job / (NC * RH), n = (job / RH) % NC, h = job % RH;
#pragma unroll
    for (int nt = 0; nt < 4; ++nt) {
        f32x4 acc = o.y0[nt];
        acc = MFMA16(o.a[0], o.b[nt][0], acc);
        acc = MFMA16(o.a[1], o.b[nt][1], acc);
#pragma unroll
        for (int e = 0; e < 4; ++e) {
            const int t = 16 * wv + 4 * q + e; const int tok = 64 * n + (d ? 63 - t : t);
            p.Y[((size_t)d * MTOT + tok) * RW + h * 64 + nt * 16 + r] = acc[e];
        }
    }
}
__device__ __forceinline__ void phase_rwkv_out(const P& p) {
    const int tid = otid(), lane = tid & 63, wv = tid >> 6;
    if (wv >= 4) return;
    const int G = gridDim.x, total = 2 * NC * RH;
    int job = obid();
    if (job >= total) return;
    RoBuf b0, b1;
    rwkv_out_load(p, job, wv, lane, b0);
    for (; job < total; job += 2 * G) {
        if (job + G < total) rwkv_out_load(p, job + G, wv, lane, b1);
        rwkv_out_compute(p, job, wv, lane, b0);
        if (job + G < total) {
            if (job + 2 * G < total) rwkv_out_load(p, job + 2 * G, wv, lane, b0);
            rwkv_out_compute(p, job + G, wv, lane, b1);
        }
    }
}

#define GL_QR 0
#define GL_KR 9216
#define GL_VT 18432
#define GL_QI 36864
#define GL_KI 46080
#define GL_AT 55296
#define GL_CUM 64512
#define GL_ALR 81920
#define GL_WA 86016
__device__ __forceinline__ void gla_load_qkv(const P& p, int n, int h, char* smem) {
    const int tid = otid();
    bf16_t* Qr = (bf16_t*)(smem + GL_QR); bf16_t* Kr = (bf16_t*)(smem + GL_KR); bf16_t* Vt = (bf16_t*)(smem + GL_VT);
    for (int c = tid; c < 512; c += NTHREADS) {
        const int row = c >> 3, part = c & 7; const int t = gla_tok(n, row);
        const u32x4 qv = *(const u32x4*)(p.Z + (size_t)t * ZLD + ZQ + h * 64 + part * 8);
        const u32x4 kv = *(const u32x4*)(p.Z + (size_t)t * ZLD + ZK + h * 64 + part * 8);
        u32x4 qs;
        qs.x = pack2bf(LO16(qv.x) * 0.125f, HI16(qv.x) * 0.125f);
        qs.y = pack2bf(LO16(qv.y) * 0.125f, HI16(qv.y) * 0.125f);
        qs.z = pack2bf(LO16(qv.z) * 0.125f, HI16(qv.z) * 0.125f);
        qs.w = pack2bf(LO16(qv.w) * 0.125f, HI16(qv.w) * 0.125f);
        *(u32x4*)(Qr + row * CH_ROW + part * 8) = qs;
        *(u32x4*)(Kr + row * CH_ROW + part * 8) = kv;
    }
    for (int c = tid; c < 1024; c += NTHREADS) {
        const int row = c >> 4, part = c & 15; const int t = gla_tok(n, row);
        const u32x4 vv = *(const u32x4*)(p.Z + (size_t)t * ZLD + ZV + h * 128 + part * 8);
        bf16_t* dst = Vt + (part * 8) * CH_ROW + row;
        dst[0 * CH_ROW] = (bf16_t)(vv.x & 0xFFFF); dst[1 * CH_ROW] = (bf16_t)(vv.x >> 16);
        dst[2 * CH_ROW] = (bf16_t)(vv.y & 0xFFFF); dst[3 * CH_ROW] = (bf16_t)(vv.y >> 16);
        dst[4 * CH_ROW] = (bf16_t)(vv.z & 0xFFFF); dst[5 * CH_ROW] = (bf16_t)(vv.z >> 16);
        dst[6 * CH_ROW] = (bf16_t)(vv.w & 0xFFFF); dst[7 * CH_ROW] = (bf16_t)(vv.w >> 16);
    }
}
__device__ __forceinline__ void gla_cum(const P& p, int l, int n, int h, int d, char* smem) {
    const int tid = otid();
    float* CUM = (float*)(smem + GL_CUM); float* ALR = (float*)(smem + GL_ALR); float* WA = (float*)(smem + GL_WA);
    for (int c = tid; c < 256; c += NTHREADS) {
        const int row = c >> 2, part = c & 3; const int t = gla_tok(n, row);
        const u32x2 a = *(const u32x2*)(p.Z + (size_t)t * ZLD + (d ? ZAB : ZAF) + part * 4);
        float* dst = ALR + row * 16 + part * 4;
        dst[0] = LO16(a.x); dst[1] = HI16(a.x); dst[2] = LO16(a.y); dst[3] = HI16(a.y);
    }
    for (int c = tid; c < 16 * 64 + 64; c += NTHREADS) {
        if (c < 1024) WA[c] = p.in[I_GLA_WA2][((size_t)(l * 2 + d) * 16 + (c >> 6)) * GLA_K + h * 64 + (c & 63)];
        else WA[c] = p.in[I_GLA_BA][(size_t)(l * 2 + d) * GLA_K + h * 64 + (c - 1024)];
    }
    __syncthreads();
    for (int idx = tid; idx < 4096; idx += NTHREADS) {
        const int i = idx >> 6, k = idx & 63;
        float a = WA[1024 + k];
#pragma unroll
        for (int r = 0; r < 16; ++r) a += ALR[i * 16 + r] * WA[r * 64 + k];
        CUM[i * 68 + k] = (fminf(a, 0.f) - flog_(1.0f + fexp_(-fabsf(a)))) * (1.0f / 16.0f);
    }
    __syncthreads();
    {
        const int k = tid & 63, seg = (tid >> 6) & 3;
        float v[16]; float run = 0.f;
        if (tid < 256) {
#pragma unroll
            for (int e = 0; e < 16; ++e) { const int pos = seg * 16 + e; const int i = d ? 63 - pos : pos; run += CUM[i * 68 + k]; v[e] = run; }
            ALR[seg * 64 + k] = run;
        }
        __syncthreads();
        if (tid < 256) {
            float off = 0.f;
            for (int s2 = 0; s2 < seg; ++s2) off += ALR[s2 * 64 + k];
#pragma unroll
            for (int e = 0; e < 16; ++e) { const int pos = seg * 16 + e; const int i = d ? 63 - pos : pos; CUM[i * 68 + k] = v[e] + off; }
        }
    }
    __syncthreads();
}
__device__ __forceinline__ void phase_gla_kv(const P& p, int l, char* smem) {
    const int tid = otid(), lane = tid & 63, wv = tid >> 6, q = lane >> 4, r = lane & 15;
    bf16_t* Kr = (bf16_t*)(smem + GL_KR); bf16_t* Vt = (bf16_t*)(smem + GL_VT); bf16_t* KdT = (bf16_t*)(smem + GL_KI);
    float* CUM = (float*)(smem + GL_CUM);
    for (int job = obid(); job < NC * GH; job += gridDim.x) {
        const int n = job / GH, h = job % GH;
        __syncthreads();
        gla_load_qkv(p, n, h, smem);
        for (int d = 0; d < 2; ++d) {
            gla_cum(p, l, n, h, d, smem);
            const int li = d ? 0 : 63;
            for (int idx = tid; idx < 4096; idx += NTHREADS) {
                const int i = idx >> 6, k = idx & 63;
                KdT[k * CH_ROW + i] = f2bf(bf2f(Kr[i * CH_ROW + k]) * fexp_(CUM[li * 68 + k] - CUM[i * 68 + k]));
            }
            if (tid < 64) p.DEC[((size_t)(d * NC + n) * GH + h) * 64 + tid] = fexp_(CUM[li * 68 + tid]);
            __syncthreads();
            float* kvt = p.KV + ((size_t)(d * NC + n) * GH + h) * 8192;
            for (int mt = wv; mt < 4; mt += NTHREADS / 64) {
                f32x4 acc[1][8];
#pragma unroll
                for (int nt = 0; nt < 8; ++nt) acc[0][nt] = (f32x4){0.f, 0.f, 0.f, 0.f};
                lds_mm<1, 8>(KdT, 16 * mt, Vt, 0, acc);
#pragma unroll
                for (int nt = 0; nt < 8; ++nt) *(f32x4*)(kvt + (size_t)(nt * 16 + r) * 64 + 16 * mt + 4 * q) = acc[0][nt];
            }
            __syncthreads();
        }
    }
    __syncthreads();
}
__device__ __forceinline__ void gla_scan_job(const P& p, int job) {
    const int base = job * NTHREADS + otid();
    const int d = base / (GH * 8192), h = (base / 8192) % GH, e = base % 8192;
    const float* __restrict__ kvp = p.KV; const float* __restrict__ decp = p.DEC; bf16_t* __restrict__ sp = p.SP;
    float S = 0.f;
    for (int s = 0; s < NC; s += 4) {
        float kv[4], dc[4]; size_t oo[4];
#pragma unroll
        for (int u = 0; u < 4; ++u) {
            const int n = chunk_order(d, (s + u < NC) ? s + u : NC - 1);
            oo[u] = ((size_t)(d * NC + n) * GH + h);
            kv[u] = kvp[oo[u] * 8192 + e]; dc[u] = decp[oo[u] * 64 + (e & 63)];
        }
#pragma unroll
        for (int u = 0; u < 4; ++u) if (s + u < NC) { sp[oo[u] * 8192 + e] = f2bf(S); S = dc[u] * S + kv[u]; }
    }
}
__device__ __forceinline__ void phase_gla_out(const P& p, int l, char* smem) {
    const int tid = otid(), lane = tid & 63, wv = tid >> 6, q = lane >> 4, r = lane & 15;
    bf16_t* Qr = (bf16_t*)(smem + GL_QR); bf16_t* Kr = (bf16_t*)(smem + GL_KR); bf16_t* Vt = (bf16_t*)(smem + GL_VT);
    bf16_t* Qi = (bf16_t*)(smem + GL_QI); bf16_t* Ki = (bf16_t*)(smem + GL_KI); bf16_t* At = (bf16_t*)(smem + GL_AT);
    float* CUM = (float*)(smem + GL_CUM);
    for (int job = obid(); job < NC * GH; job += gridDim.x) {
        const int n = job / GH, h = job % GH;
        __syncthreads();
        gla_load_qkv(p, n, h, smem);
        f32x4 o[1][8];
#pragma unroll
        for (int nt = 0; nt < 8; ++nt) o[0][nt] = (f32x4){0.f, 0.f, 0.f, 0.f};
        for (int d = 0; d < 2; ++d) {
            gla_cum(p, l, n, h, d, smem);
            for (int idx = tid; idx < 4096; idx += NTHREADS) {
                const int i = idx >> 6, k = idx & 63; const float c = CUM[i * 68 + k];
                Qi[i * CH_ROW + k] = f2bf(bf2f(Qr[i * CH_ROW + k]) * fexp_(c));
                Ki[i * CH_ROW + k] = f2bf(bf2f(Kr[i * CH_ROW + k]) * fexp_(-c));
            }
            __syncthreads();
            if (wv < 4) {
                f32x4 a[1][4];
#pragma unroll
                for (int nt = 0; nt < 4; ++nt) a[0][nt] = (f32x4){0.f, 0.f, 0.f, 0.f};
                lds_mm<1, 4>(Qi, 16 * wv, Ki, 0, a);
#pragma unroll
                for (int nt = 0; nt < 4; ++nt)
#pragma unroll
                    for (int e = 0; e < 4; ++e) {
                        const int i = 16 * wv + 4 * q + e, j = nt * 16 + r;
                        const bool ok = d ? (j >= i) : (j <= i);
                        At[i * CH_ROW + j] = f2bf(ok ? a[0][nt][e] : 0.f);
                    }
                WAVE_SYNC();
                lds_mm<1, 8>(At, 16 * wv, Vt, 0, o);
                const bf16_t* sp = p.SP + ((size_t)(d * NC + n) * GH + h) * 8192;
#pragma unroll
                for (int s2 = 0; s2 < 2; ++s2) {
                    const bf16x8 af = *(const bf16x8*)(Qi + (16 * wv + r) * CH_ROW + s2 * 32 + q * 8);
#pragma unroll
                    for (int nt = 0; nt < 8; ++nt) {
                        const bf16x8 bfr = *(const bf16x8*)(sp + (size_t)(nt * 16 + r) * 64 + s2 * 32 + q * 8);
                        o[0][nt] = MFMA16(af, bfr, o[0][nt]);
                    }
                }
            }
            __syncthreads();
        }
        if (wv < 4) {
#pragma unroll
            for (int nt = 0; nt < 8; ++nt)
#pragma unroll
                for (int e = 0; e < 4; ++e) {
                    const int t = gla_tok(n, 16 * wv + 4 * q + e);
                    p.OGLA[(size_t)t * GLA_V + h * 128 + nt * 16 + r] = o[0][nt][e];
                }
        }
    }
    __syncthreads();
}

#define S5_XH_OFF (2 * 64 * 132 * 4)
#define S5_XL_OFF (S5_XH_OFF + 64 * 136 * 2)
#define S5_CT_OFF (S5_XL_OFF + 64 * 136 * 2)
__device__ __forceinline__ void phase_s5_pass(const P& p, int l, char* smem, bool with_out) {
    const int tid = otid(), lane = tid & 63, wv = tid >> 6, q = lane >> 4, r = lane & 15;
    float* BU = (float*)smem; bf16_t* XH = (bf16_t*)(smem + S5_XH_OFF); bf16_t* XL = (bf16_t*)(smem + S5_XL_OFF); bf16_t* CTp = (bf16_t*)(smem + S5_CT_OFF);
    const int dW = (wv >> 1) & 1, ntb = (wv & 1) * 4;
    const int dS = (tid >> 6) & 1, st = tid & 63;
    bf16x8 bhi[4], blo[4];
    float are = 0.f, aim = 0.f, dco = 0.f;
    int cur_g = -1;
    const bf16x8 zero8 = {0, 0, 0, 0, 0, 0, 0, 0};
    bf16x8 a_cur[4]; float2 car_cur = {0.f, 0.f};
#define S5_FETCH(JOB, A, CAR) { const int n_ = (JOB) / SG, g_ = (JOB) % SG; \
        if (wv < 4) { _Pragma("unroll") for (int mt = 0; mt < 4; ++mt) A[mt] = (q < 2) ? *(const bf16x8*)(p.Z + (size_t)(n_ * 64 + 16 * mt + r) * ZLD + ZS5 + g_ * 16 + 8 * q) : zero8; } \
        if (with_out && tid < 128) CAR = *(const float2*)(p.S5CAR + ((((size_t)dS * NC + n_) * SG + g_) * 64 + st) * 2); }
    if (obid() < NC * SG) S5_FETCH(obid(), a_cur, car_cur);
    for (int job = obid(); job < NC * SG; job += gridDim.x) {
        const int n = job / SG, g = job % SG;
        __syncthreads();
        if (g != cur_g) {
            cur_g = g;
            if (wv < 4) {
#pragma unroll
                for (int jn = 0; jn < 4; ++jn) {
                    const int kk = 16 * (ntb + jn) + r; const size_t ci = ((size_t)dW * SG + g) * 64 + (kk >> 1);
                    float f[8], lo[8];
#pragma unroll
                    for (int e = 0; e < 8; ++e) f[e] = (q < 2) ? p.S5BB[(ci * 16 + 8 * q + e) * 2 + (kk & 1)] : 0.f;
                    const u32x4 hv = pack8(f);
                    float hf[8]; unpack8(hv, hf);
#pragma unroll
                    for (int e = 0; e < 8; ++e) lo[e] = f[e] - hf[e];
                    bhi[jn] = __builtin_bit_cast(bf16x8, hv); blo[jn] = __builtin_bit_cast(bf16x8, pack8(lo));
                }
            }
            if (tid < 128) { const size_t ci = ((size_t)dS * SG + g) * 64 + st; are = p.S5A[ci * 2]; aim = p.S5A[ci * 2 + 1]; }
            if (with_out) {
                for (int idx = tid; idx < 16 * 128; idx += NTHREADS) {
                    const int c = idx >> 7, kk = idx & 127;
                    const float v = (kk & 1) ? -p.in[I_S5CIM][((size_t)l * SG + g) * 1024 + c * 64 + (kk >> 1)] : p.in[I_S5CRE][((size_t)l * SG + g) * 1024 + c * 64 + (kk >> 1)];
                    CTp[c * 136 + kk] = f2bf(v);
                }
                dco = p.in[I_S5D][(size_t)l * SW + g * 16 + r];
            }
        }
        float xr = car_cur.x, xi = car_cur.y;
        const size_t eo = (((size_t)dS * NC + n) * SG + g) * 64 + st;
        unsigned short uu[4] = {0, 0, 0, 0};
        if (with_out && wv < 4) {
#pragma unroll
            for (int e = 0; e < 4; ++e) uu[e] = p.Z[(size_t)(n * 64 + 16 * wv + 4 * q + e) * ZLD + ZS5 + g * 16 + r];
        }
        if (wv < 4) {
#pragma unroll
            for (int mt = 0; mt < 4; ++mt) {
                const bf16x8 a = a_cur[mt];
#pragma unroll
                for (int jn = 0; jn < 4; ++jn) {
                    f32x4 acc = {0.f, 0.f, 0.f, 0.f};
                    acc = MFMA16(a, bhi[jn], acc);
                    acc = MFMA16(a, blo[jn], acc);
#pragma unroll
                    for (int e = 0; e < 4; ++e) BU[(dW * 64 + 16 * mt + 4 * q + e) * 132 + 16 * (ntb + jn) + r] = acc[e];
                }
            }
        }
        if (job + (int)gridDim.x < NC * SG) S5_FETCH(job + (int)gridDim.x, a_cur, car_cur);
        __syncthreads();
        if (tid < 128) {
            float2* bp0 = (float2*)(BU + (dS * 64 + (dS ? 63 : 0)) * 132 + st * 2);
#define S5_SCAN(SGN) { _Pragma("unroll 1") for (int ib = 0; ib < 4; ++ib) { float2 bv[16]; \
                _Pragma("unroll") for (int u = 0; u < 16; ++u) bv[u] = bp0[(SGN) * (ib * 16 + u) * 66]; \
                _Pragma("unroll") for (int u = 0; u < 16; ++u) { \
                    const float nr = are * xr - aim * xi + bv[u].x, ni = are * xi + aim * xr + bv[u].y; xr = nr; xi = ni; \
                    if (with_out) { float2 o; o.x = xr; o.y = xi; bp0[(SGN) * (ib * 16 + u) * 66] = o; } } } }
            if (dS) S5_SCAN(-1) else S5_SCAN(1)
            if (!with_out) { float2 o; o.x = xr; o.y = xi; *(float2*)(p.S5END + eo * 2) = o; }
        }
        if (with_out) {
            __syncthreads();
            for (int cidx = tid; cidx < 64 * 16; cidx += NTHREADS) {
                const int i = cidx >> 4, k0 = (cidx & 15) * 8;
                float a[8], b[8], lo[8];
                load8f(BU + (0 * 64 + i) * 132 + k0, a); load8f(BU + (1 * 64 + i) * 132 + k0, b);
#pragma unroll
                for (int e = 0; e < 8; ++e) a[e] += b[e];
                const u32x4 hv = pack8(a);
                float hf[8]; unpack8(hv, hf);
#pragma unroll
                for (int e = 0; e < 8; ++e) lo[e] = a[e] - hf[e];
                *(u32x4*)(XH + i * 136 + k0) = hv; *(u32x4*)(XL + i * 136 + k0) = pack8(lo);
            }
            __syncthreads();
            if (wv < 4) {
                f32x4 acc = {0.f, 0.f, 0.f, 0.f};
#pragma unroll
                for (int ks = 0; ks < 4; ++ks) {
                    const bf16x8 ah = *(const bf16x8*)(XH + (16 * wv + r) * 136 + ks * 32 + q * 8), al = *(const bf16x8*)(XL + (16 * wv + r) * 136 + ks * 32 + q * 8);
                    const bf16x8 b = *(const bf16x8*)(CTp + r * 136 + ks * 32 + q * 8);
                    acc = MFMA16(ah, b, acc);
                    acc = MFMA16(al, b, acc);
                }
#pragma unroll
                for (int e = 0; e < 4; ++e) {
                    const int i = 16 * wv + 4 * q + e;
                    const float u = bf2f(uu[e]);
                    p.GY[(size_t)(n * 64 + i) * SW + g * 16 + r] = f2bf(geluf_(acc[e] + dco * u));
                }
            }
        }
    }
    __syncthreads();
}
__device__ __forceinline__ void s5_carry_job(const P& p, int job) {
    const int base = job * NTHREADS + otid();
    if (base >= 2 * SG * 64) return;
    const int d = base / (SG * 64), g = (base / 64) % SG, st = base % 64;
    const size_t ci = ((size_t)d * SG + g) * 64 + st;
    float ar = p.S5A[ci * 2], ai = p.S5A[ci * 2 + 1];
    for (int i = 0; i < 6; ++i) { const float nr = ar * ar - ai * ai, ni = 2.f * ar * ai; ar = nr; ai = ni; }
    const float2* __restrict__ endp = (const float2*)p.S5END; float2* __restrict__ carp = (float2*)p.S5CAR;
    float cr = 0.f, cim = 0.f;
    for (int s = 0; s < NC; s += 4) {
        float2 ev[4]; size_t eo[4];
#pragma unroll
        for (int u = 0; u < 4; ++u) {
            const int n = chunk_order(d, (s + u < NC) ? s + u : NC - 1);
            eo[u] = (((size_t)d * NC + n) * SG + g) * 64 + st;
            ev[u] = endp[eo[u]];
        }
#pragma unroll
        for (int u = 0; u < 4; ++u) if (s + u < NC) {
            float2 c; c.x = cr; c.y = cim; carp[eo[u]] = c;
            const float nr = ar * cr - ai * cim + ev[u].x, ni = ar * cim + ai * cr + ev[u].y;
            cr = nr; cim = ni;
        }
    }
}

__device__ __forceinline__ void phase_side_elem(const P& p, int l) {
    const int lane = otid() & 63;
    const int gw = (obid() * NTHREADS + otid()) >> 6, nw = (gridDim.x * NTHREADS) >> 6;
    const bool actg = lane * 8 < GLA_V, actr = lane * 8 < RW;
    float gng[8], lnw[8], lnb[8];
#pragma unroll
    for (int e = 0; e < 8; ++e) { gng[e] = 0.f; lnw[e] = 0.f; lnb[e] = 0.f; }
    if (actg) load8f(p.in[I_GLA_NG] + (size_t)l * 128 + ((lane * 8) & 127), gng);
    if (actr) { load8f(p.in[I_RLNW] + (size_t)l * RW + lane * 8, lnw); load8f(p.in[I_RLNB] + (size_t)l * RW + lane * 8, lnb); }
    for (int t = gw; t < MTOT; t += nw) {
        float og[8], zo[8], y0[8], y1[8], vv[8];
        const u32x4 z4 = {0u, 0u, 0u, 0u};
#pragma unroll
        for (int e = 0; e < 8; ++e) { og[e] = 0.f; y0[e] = 0.f; y1[e] = 0.f; }
        if (actg) load8f(p.OGLA + (size_t)t * GLA_V + lane * 8, og);
        unpack8(actg ? *(const u32x4*)(p.Z + (size_t)t * ZLD + ZOG + lane * 8) : z4, zo);
        if (actr) { load8f(p.Y + (size_t)t * RW + lane * 8, y0); load8f(p.Y + ((size_t)MTOT + t) * RW + lane * 8, y1); }
        unpack8(actr ? *(const u32x4*)(p.V + (size_t)t * RW + lane * 8) : z4, vv);
        const int hh = (lane * 8) >> 6;
        const float bon = actr ? (p.BONUS[(size_t)t * RH + hh] + p.BONUS[((size_t)MTOT + t) * RH + hh]) : 0.f;
        float ss = 0.f;
#pragma unroll
        for (int e = 0; e < 8; ++e) ss += og[e] * og[e];
        ss += __shfl_xor(ss, 1, 64); ss += __shfl_xor(ss, 2, 64); ss += __shfl_xor(ss, 4, 64); ss += __shfl_xor(ss, 8, 64);
        const float rstd = rsqrtf(ss * (1.0f / 128.f) + 1e-6f);
        float br[8];
#pragma unroll
        for (int e = 0; e < 8; ++e) br[e] = og[e] * rstd * gng[e] * siluf_(zo[e]);
        if (actg) *(u32x4*)(p.BR + (size_t)t * 3 * BW + lane * 8) = pack8(br);
        float y[8]; float sm = 0.f;
#pragma unroll
        for (int e = 0; e < 8; ++e) { y[e] = y0[e] + y1[e]; sm += y[e]; }
        sm += __shfl_xor(sm, 1, 64); sm += __shfl_xor(sm, 2, 64); sm += __shfl_xor(sm, 4, 64);
        const float mu = sm * (1.0f / 64.f);
        float sv = 0.f;
#pragma unroll
        for (int e = 0; e < 8; ++e) { y[e] -= mu; sv += y[e] * y[e]; }
        sv += __shfl_xor(sv, 1, 64); sv += __shfl_xor(sv, 2, 64); sv += __shfl_xor(sv, 4, 64);
        const float rs = rsqrtf(sv * (1.0f / 64.f) + 64e-5f);
        float yn[8];
#pragma unroll
        for (int e = 0; e < 8; ++e) yn[e] = y[e] * rs * lnw[e] + lnb[e] + bon * vv[e];
        if (actr) store8f(p.YN + (size_t)t * RW + lane * 8, yn);
    }
}

__device__ __forceinline__ void phase_side_gemm(const P& p, int l, char* smem) {
    gemm_phase<4>(p.WT_G2, 128, (size_t)NPAD(RW) * 128 * 2, p.GS, 128, (size_t)MTOT * 128 * 2, 128, NPAD(RW), (bf16_t*)smem, NoPre(), NoPre(),
        [&](int, int, int m, int n, const f32x4 v) {
            if (n < RW) { const float4 y = *(const float4*)(p.YN + (size_t)m * RW + n);
                *(u32x2*)(p.BR + (size_t)m * 3 * BW + BW + n) = pack4(y.x * v[0], y.y * v[1], y.z * v[2], y.w * v[3]); }
        });
    gemm_phase<4>(p.WT_GLU, SW, (size_t)NPAD(2 * SW) * SW * 2, p.GY, SW, (size_t)MTOT * SW * 2, SW, 2 * SW, (bf16_t*)smem, NoPre(), NoPre(),
        [&](int, int, int m, int n, const f32x4 v) {
            *(unsigned*)(p.BR + (size_t)m * 3 * BW + 2 * BW + (n >> 1)) = pack2bf(v[0] * sigmoidf_(v[1]), v[2] * sigmoidf_(v[3]));
        });
}

__device__ __forceinline__ void phase_merge(const P& p, int l, char* smem) {
    const int ntn = D_MODEL / 128, ntm = (MTOT - 256) / 128;
    auto run = [&](auto mi_tag, int n0, int m0) {
        constexpr int MI = decltype(mi_tag)::value;
        f32x4 macc[4][MI];
#pragma unroll
        for (int i = 0; i < 4; ++i)
#pragma unroll
            for (int j = 0; j < MI; ++j) macc[i][j] = (f32x4){0.f, 0.f, 0.f, 0.f};
        const int lane = otid() & 63, wave = otid() >> 6;
        for (int b = 0; b < 3; ++b) {
            f32x4 acc[4][MI];
#pragma unroll
            for (int i = 0; i < 4; ++i)
#pragma unroll
                for (int j = 0; j < MI; ++j) acc[i][j] = (f32x4){0.f, 0.f, 0.f, 0.f};
            mfma_gemm_tile_t<4, MI>(p.WT_BR + (size_t)b * D_MODEL * BW, BW, (size_t)D_MODEL * BW * 2, p.BR + b * BW, 3 * BW, (size_t)MTOT * 3 * BW * 2 - b * BW * 2, BW, n0, m0, (bf16_t*)smem, acc);
#pragma unroll
            for (int ni = 0; ni < 4; ++ni)
#pragma unroll
                for (int mi = 0; mi < MI; ++mi) {
                    const int n = n0 + (wave >> 1) * 64 + ni * 16 + (lane >> 4) * 4, m = m0 + (wave & 1) * 16 * MI + mi * 16 + (lane & 15);
                    const u32x2 g = *(const u32x2*)(p.ZGT + ((((size_t)(m >> 4) * (3 * D_MODEL / 16) + ((b * D_MODEL + n) >> 4)) * 64 + lane) * 4));
                    macc[ni][mi][0] += LO16(g.x) * acc[ni][mi][0]; macc[ni][mi][1] += HI16(g.x) * acc[ni][mi][1];
                    macc[ni][mi][2] += LO16(g.y) * acc[ni][mi][2]; macc[ni][mi][3] += HI16(g.y) * acc[ni][mi][3];
                }
        }
#pragma unroll
        for (int ni = 0; ni < 4; ++ni)
#pragma unroll
            for (int mi = 0; mi < MI; ++mi) {
                const int n = n0 + (wave >> 1) * 64 + ni * 16 + (lane >> 4) * 4, m = m0 + (wave & 1) * 16 * MI + mi * 16 + (lane & 15);
                *(u32x2*)(p.M + (size_t)m * D_MODEL + n) = pack4(macc[ni][mi][0], macc[ni][mi][1], macc[ni][mi][2], macc[ni][mi][3]);
            }
    };
    for (int it = 0;; ++it) {
        int mt_, nt_; if (!tile_map(it, ntm, ntn, (ntn >= 8) ? 4 : 8, mt_, nt_)) break;
        run(std::integral_constant<int, 4>(), nt_ * 128, mt_ * 128);
    }
    for (int job = obid(); job < 4 * ntn; job += gridDim.x) run(std::integral_constant<int, 2>(), (job >> 2) * 128, MTOT - 256 + (job & 3) * 64);
}

__device__ __forceinline__ void phase_outproj(const P& p, int l, char* smem) {
    gemm_phase<4>(p.WT_OUT, D_MODEL, (size_t)D_MODEL * D_MODEL * 2, p.M, D_MODEL, (size_t)MTOT * D_MODEL * 2, D_MODEL, D_MODEL, (bf16_t*)smem, NoPre(), NoPre(),
        [&](int, int, int m, int n, const f32x4 v) {
            const float* g1 = p.MOD + (size_t)(l * 2 + (m >= CTX ? 1 : 0)) * 6 * D_MODEL + 2 * D_MODEL + n;
            float4* xp = (float4*)(p.X + (size_t)m * D_MODEL + n); float4 x = *xp;
            x.x += g1[0] * v[0]; x.y += g1[1] * v[1]; x.z += g1[2] * v[2]; x.w += g1[3] * v[3]; *xp = x;
        });
}

__device__ __forceinline__ void store_q_hilo(const P& p, int m, int n, const f32x4 v) {
    const bf16_t h0 = f2bf(v[0]), h1 = f2bf(v[1]), h2 = f2bf(v[2]), h3 = f2bf(v[3]);
    u32x2 hv; hv.x = (unsigned)h0 | ((unsigned)h1 << 16); hv.y = (unsigned)h2 | ((unsigned)h3 << 16);
    *(u32x2*)(p.QHI + (size_t)m * PQ + n) = hv;
    *(u32x2*)(p.QLO + (size_t)m * PQ + n) = pack4(v[0] - bf2f(h0), v[1] - bf2f(h1), v[2] - bf2f(h2), v[3] - bf2f(h3));
}
__device__ __forceinline__ void phase_peer_q(const P& p, int l, char* smem) {
    gemm_phase<4>(p.WT_Q, D_MODEL, (size_t)PQ * D_MODEL * 2, p.H, D_MODEL, (size_t)MTOT * D_MODEL * 2, D_MODEL, PQ, (bf16_t*)smem, NoPre(), NoPre(),
        [&](int, int, int m, int n, const f32x4 v) { store_q_hilo(p, m, n, v); });
}

#define TK_ROW 129
__device__ __forceinline__ unsigned tk_key(float f, unsigned lowmask, unsigned low) {
    unsigned u = __builtin_bit_cast(unsigned, f);
    u ^= (u & 0x80000000u) ? 0xFFFFFFFFu : 0x80000000u;
    return (u & ~lowmask) | low;
}
#define TK_INSERT(lv, xk) { unsigned x_ = (xk); _Pragma("unroll") for (int z_ = 0; z_ < 16; ++z_) { const unsigned hi_ = lv[z_] > x_ ? lv[z_] : x_; x_ = lv[z_] > x_ ? x_ : lv[z_]; lv[z_] = hi_; } }
__device__ __forceinline__ void phase_peer_topk(const P& p, int l, char* smem) {
    const int tid = otid(), lane = tid & 63, wv = tid >> 6, q = lane >> 4, r = lane & 15;
    float* sc = (float*)smem + wv * (64 * TK_ROW);
    const int gw = (obid() * NTHREADS + tid) >> 6, nw = (gridDim.x * NTHREADS) >> 6;
    const float NEG = -3.0e38f;
    for (int job = gw; job < (MTOT / 32) * PH; job += nw) {
        const int t0 = (job / PH) * 32, h = job % PH;
#pragma unroll
        for (int sd = 0; sd < 2; ++sd) {
            f32x4 acc[2][8];
#pragma unroll
            for (int mt = 0; mt < 2; ++mt)
#pragma unroll
                for (int nt = 0; nt < 8; ++nt) acc[mt][nt] = (f32x4){0.f, 0.f, 0.f, 0.f};
#pragma unroll
            for (int ks = 0; ks < 4; ++ks) {
                bf16x8 ah[2], al[2];
#pragma unroll
                for (int mt = 0; mt < 2; ++mt) {
                    const size_t qo = (size_t)(t0 + mt * 16 + r) * PQ + h * 256 + sd * 128 + ks * 32 + q * 8;
                    ah[mt] = *(const bf16x8*)(p.QHI + qo); al[mt] = *(const bf16x8*)(p.QLO + qo);
                }
#pragma unroll
                for (int nt = 0; nt < 8; ++nt) {
                    const size_t ko = ((size_t)(h * 2 + sd) * 128 + nt * 16 + r) * 128 + ks * 32 + q * 8;
                    const bf16x8 bh = *(const bf16x8*)(p.KHI + ko), bl = *(const bf16x8*)(p.KLO + ko);
#pragma unroll
                    for (int mt = 0; mt < 2; ++mt) {
                        acc[mt][nt] = MFMA16(ah[mt], bh, acc[mt][nt]);
                        acc[mt][nt] = MFMA16(al[mt], bh, acc[mt][nt]);
                        acc[mt][nt] = MFMA16(ah[mt], bl, acc[mt][nt]);
                    }
                }
            }
#pragma unroll
            for (int mt = 0; mt < 2; ++mt)
#pragma unroll
                for (int nt = 0; nt < 8; ++nt)
#pragma unroll
                    for (int e = 0; e < 4; ++e) sc[(sd * 32 + mt * 16 + 4 * q + e) * TK_ROW + nt * 16 + r] = acc[mt][nt][e];
        }
        WAVE_SYNC();
        unsigned lv[16];
#pragma unroll
        for (int z = 0; z < 16; ++z) lv[z] = 0u;
        {
            const float* row = sc + lane * TK_ROW;
#pragma unroll 4
            for (int k = 0; k < 128; ++k) TK_INSERT(lv, tk_key(row[k], 0x7Fu, (unsigned)(127 - k)));
        }
        float lvv[16]; int li[16];
        {
            const float* row = sc + lane * TK_ROW;
#pragma unroll
            for (int z = 0; z < 16; ++z) { li[z] = 127 - (int)(lv[z] & 0x7Fu); lvv[z] = row[li[z]]; }
        }
        WAVE_SYNC();
        {
            float* row = sc + lane * TK_ROW;
#pragma unroll
            for (int z = 0; z < 16; ++z) { row[z] = lvv[z]; ((int*)row)[16 + z] = li[z]; }
        }
        WAVE_SYNC();
        const float* r1 = sc + (lane & 31) * TK_ROW; const float* r2 = sc + (32 + (lane & 31)) * TK_ROW;
        unsigned tk[16];
#pragma unroll
        for (int z = 0; z < 16; ++z) tk[z] = 0u;
        for (int i = 0; i < 16; ++i) {
            const float a = r1[i];
            const int nj = 16 / (i + 1);
            for (int j = 0; j < nj; ++j) TK_INSERT(tk, tk_key(a + r2[j], 0xFFu, (unsigned)(255 - (i * 16 + j))));
        }
        int tc[16];
#pragma unroll
        for (int z = 0; z < 16; ++z) tc[z] = 255 - (int)(tk[z] & 0xFFu);
        if (lane < 32) {
            float vals[16]; float mx = 0.f; float ssum = 0.f;
#pragma unroll
            for (int z = 0; z < 16; ++z) { vals[z] = r1[tc[z] >> 4] + r2[tc[z] & 15]; if (z == 0) mx = vals[0]; vals[z] = fexp_(vals[z] - mx); ssum += vals[z]; }
            const float inv = 1.0f / ssum;
            const size_t o = (size_t)(t0 + lane) * PH * 16 + h * 16;
#pragma unroll
            for (int z = 0; z < 16; ++z) {
                const int ex_ = ((const int*)r1)[16 + (tc[z] >> 4)] * 128 + ((const int*)r2)[16 + (tc[z] & 15)];
                p.IDX[o + z] = ex_;
                p.G[o + z] = vals[z] * inv * p.VSC[ex_];
                p.GU[o + z] = p.USC[ex_];
            }
        }
        WAVE_SYNC();
    }
}

#define PEER_CONV_JOBS (2 * NEXP / 4)
__device__ __forceinline__ void peer_conv_job(const P& p, int l, int job) {
    const int tid = otid(), lane = tid & 63, wv = tid >> 6;
    if (wv >= 4) return;
    const int rowg = job * 4 + wv; const int which = rowg / NEXP, row = rowg % NEXP;
    const float* src = p.in[which ? I_PV : I_PU] + ((size_t)l * NEXP + row) * D_MODEL + lane * 16;
    const bool act = lane * 16 < D_MODEL;
    float v[16]; float amax = 0.f;
#pragma unroll
    for (int c = 0; c < 4; ++c) {
        float4 a; a.x = 0.f; a.y = 0.f; a.z = 0.f; a.w = 0.f;
        if (act) a = *(const float4*)(src + c * 4);
        v[c * 4 + 0] = a.x; v[c * 4 + 1] = a.y; v[c * 4 + 2] = a.z; v[c * 4 + 3] = a.w;
        amax = fmaxf(amax, fmaxf(fmaxf(fabsf(a.x), fabsf(a.y)), fmaxf(fabsf(a.z), fabsf(a.w))));
    }
#pragma unroll
    for (int m = 32; m >= 1; m >>= 1) amax = fmaxf(amax, __shfl_xor(amax, m, 64));
    int ex = 0;
    if (amax > 0.f) ex = 7 - (int)((__builtin_bit_cast(unsigned, amax) >> 23) & 0xFF) + 127;
    ex = ex < -100 ? -100 : (ex > 100 ? 100 : ex);
    const float sc = __builtin_bit_cast(float, (unsigned)(ex + 127) << 23), isc = __builtin_bit_cast(float, (unsigned)(127 - ex) << 23);
    u32x4 o;
    int w0 = 0, w1 = 0, w2 = 0, w3 = 0;
    w0 = CVT_PK_FP8(v[0] * sc, v[1] * sc, w0, false); w0 = CVT_PK_FP8(v[2] * sc, v[3] * sc, w0, true);
    w1 = CVT_PK_FP8(v[4] * sc, v[5] * sc, w1, false); w1 = CVT_PK_FP8(v[6] * sc, v[7] * sc, w1, true);
    w2 = CVT_PK_FP8(v[8] * sc, v[9] * sc, w2, false); w2 = CVT_PK_FP8(v[10] * sc, v[11] * sc, w2, true);
    w3 = CVT_PK_FP8(v[12] * sc, v[13] * sc, w3, false); w3 = CVT_PK_FP8(v[14] * sc, v[15] * sc, w3, true);
    o.x = (unsigned)w0; o.y = (unsigned)w1; o.z = (unsigned)w2; o.w = (unsigned)w3;
    unsigned char* dst = (which ? p.V8 : p.U8) + (size_t)row * D_MODEL + lane * 16;
    if (act) *(u32x4*)dst = o;
    if (lane == 0) (which ? p.VSC : p.USC)[row] = isc;
}
#define GE 4
struct GBuf { u32x4 u[GE]; u32x4 v[GE]; float gu; float gv; };
__device__ __forceinline__ void gather_load(const P& p, GBuf& b, int g, int idx0, int idx1, float g0, float g1, float u0, float u1, int lane) {
    const bool act = lane * 16 < D_MODEL;
#pragma unroll
    for (int q = 0; q < GE; ++q) {
        const int k = g * GE + q;
        const int ei = __shfl((k < 64) ? idx0 : idx1, k & 63, 64);
        b.u[q] = act ? *(const u32x4*)(p.U8 + (size_t)ei * D_MODEL + lane * 16) : (u32x4){0u, 0u, 0u, 0u};
        b.v[q] = act ? *(const u32x4*)(p.V8 + (size_t)ei * D_MODEL + lane * 16) : (u32x4){0u, 0u, 0u, 0u};
    }
    const int km = g * GE + ((lane >> 4) & 3);
    b.gv = __shfl((km < 64) ? g0 : g1, km & 63, 64);
    b.gu = __shfl((km < 64) ? u0 : u1, km & 63, 64);
}
__device__ __forceinline__ void gather_compute(const GBuf& b, const float (&hv)[16], float (&acc)[16], int lane) {
    float dt[GE];
#pragma unroll
    for (int q = 0; q < GE; ++q) {
        float d = 0.f;
#pragma unroll
        for (int c = 0; c < 4; ++c) {
            const f32x2 lo = CVT_PK_F32_FP8((int)b.u[q][c], false), hi = CVT_PK_F32_FP8((int)b.u[q][c], true);
            d += hv[c * 4 + 0] * lo.x + hv[c * 4 + 1] * lo.y + hv[c * 4 + 2] * hi.x + hv[c * 4 + 3] * hi.y;
        }
        dt[q] = d;
    }
    float r2[2], r1;
    {
        const bool up = (lane & 32) != 0;
#pragma unroll
        for (int q = 0; q < 2; ++q) { const float keep = up ? dt[2 + q] : dt[q], send = up ? dt[q] : dt[2 + q]; r2[q] = keep + __shfl_xor(send, 32, 64); }
    }
    {
        const bool up = (lane & 16) != 0;
        const float keep = up ? r2[1] : r2[0], send = up ? r2[0] : r2[1];
        r1 = keep + __shfl_xor(send, 16, 64);
    }
    r1 += __shfl_xor(r1, 8, 64); r1 += __shfl_xor(r1, 4, 64); r1 += __shfl_xor(r1, 2, 64); r1 += __shfl_xor(r1, 1, 64);
    const float coef_mine = b.gv * geluf_(r1 * b.gu);
#pragma unroll
    for (int q = 0; q < GE; ++q) {
        const float coef = __shfl(coef_mine, q * 16, 64);
#pragma unroll
        for (int c = 0; c < 4; ++c) {
            const f32x2 lo = CVT_PK_F32_FP8((int)b.v[q][c], false), hi = CVT_PK_F32_FP8((int)b.v[q][c], true);
            acc[c * 4 + 0] += coef * lo.x; acc[c * 4 + 1] += coef * lo.y; acc[c * 4 + 2] += coef * hi.x; acc[c * 4 + 3] += coef * hi.y;
        }
    }
}
__device__ __forceinline__ void phase_peer_gather(const P& p, int l) {
    const int lane = otid() & 63;
    const int gw = (obid() * NTHREADS + otid()) >> 6, nw = (gridDim.x * NTHREADS) >> 6;
    constexpr int NG = PH * 16 / GE;
    const bool act = lane * 16 < D_MODEL;
    for (int t = gw; t < MTOT; t += nw) {
        float hv[16], acc[16];
        {
            const u32x4 z4 = {0u, 0u, 0u, 0u};
            const u32x4 ha = act ? *(const u32x4*)(p.H + (size_t)t * D_MODEL + lane * 16) : z4;
            const u32x4 hb = act ? *(const u32x4*)(p.H + (size_t)t * D_MODEL + lane * 16 + 8) : z4;
            hv[0] = LO16(ha.x); hv[1] = HI16(ha.x); hv[2] = LO16(ha.y); hv[3] = HI16(ha.y); hv[4] = LO16(ha.z); hv[5] = HI16(ha.z); hv[6] = LO16(ha.w); hv[7] = HI16(ha.w);
            hv[8] = LO16(hb.x); hv[9] = HI16(hb.x); hv[10] = LO16(hb.y); hv[11] = HI16(hb.y); hv[12] = LO16(hb.z); hv[13] = HI16(hb.z); hv[14] = LO16(hb.w); hv[15] = HI16(hb.w);
#pragma unroll
            for (int j = 0; j < 16; ++j) acc[j] = 0.f;
        }
        int idx0 = 0, idx1 = 0; float g0 = 0.f, g1 = 0.f, u0 = 0.f, u1 = 0.f;
        if (lane < PH * 16) { idx0 = p.IDX[(size_t)t * PH * 16 + lane]; g0 = p.G[(size_t)t * PH * 16 + lane]; u0 = p.GU[(size_t)t * PH * 16 + lane]; }
        if (64 + lane < PH * 16) { idx1 = p.IDX[(size_t)t * PH * 16 + 64 + lane]; g1 = p.G[(size_t)t * PH * 16 + 64 + lane]; u1 = p.GU[(size_t)t * PH * 16 + 64 + lane]; }
        GBuf b0, b1, b2;
        gather_load(p, b0, 0, idx0, idx1, g0, g1, u0, u1, lane);
        gather_load(p, b1, 1, idx0, idx1, g0, g1, u0, u1, lane);
        for (int g = 0; g < NG; g += 3) {
            if (g + 2 < NG) gather_load(p, b2, g + 2, idx0, idx1, g0, g1, u0, u1, lane);
            gather_compute(b0, hv, acc, lane);
            if (g + 1 < NG) {
                if (g + 3 < NG) gather_load(p, b0, g + 3, idx0, idx1, g0, g1, u0, u1, lane);
                gather_compute(b1, hv, acc, lane);
            }
            if (g + 2 < NG) {
                if (g + 4 < NG) gather_load(p, b1, g + 4, idx0, idx1, g0, g1, u0, u1, lane);
                gather_compute(b2, hv, acc, lane);
            }
        }
        float xn[16]; float ss = 0.f;
#pragma unroll
        for (int j = 0; j < 16; ++j) xn[j] = 0.f;
        if (act) {
            const float* g2 = p.MOD + (size_t)(l * 2 + (t >= CTX ? 1 : 0)) * 6 * D_MODEL + 5 * D_MODEL + lane * 16;
            float* xp = p.X + (size_t)t * D_MODEL + lane * 16;
#pragma unroll
            for (int c = 0; c < 4; ++c) {
                float4 x = *(float4*)(xp + c * 4);
                x.x += g2[c * 4 + 0] * acc[c * 4 + 0]; x.y += g2[c * 4 + 1] * acc[c * 4 + 1]; x.z += g2[c * 4 + 2] * acc[c * 4 + 2]; x.w += g2[c * 4 + 3] * acc[c * 4 + 3];
                if (l + 1 < DEPTH) *(float4*)(xp + c * 4) = x;
                xn[c * 4 + 0] = x.x; xn[c * 4 + 1] = x.y; xn[c * 4 + 2] = x.z; xn[c * 4 + 3] = x.w;
                ss += x.x * x.x + x.y * x.y + x.z * x.z + x.w * x.w;
            }
        }
        ss = wave_sum(ss);
        const float rstd = rsqrtf(ss / D_MODEL + 1e-6f);
        if (act) {
            if (l + 1 < DEPTH) {
                const float* gn = p.in[I_N1G] + (size_t)(l + 1) * D_MODEL + lane * 16;
                const float* mod = p.MOD + (size_t)((l + 1) * 2 + (t >= CTX ? 1 : 0)) * 6 * D_MODEL + lane * 16;
                float o[16];
#pragma unroll
                for (int j = 0; j < 16; ++j) o[j] = xn[j] * rstd * gn[j] * (1.0f + mod[D_MODEL + j]) + mod[j];
                u32x4 w0, w1;
                w0.x = pack2bf(o[0], o[1]); w0.y = pack2bf(o[2], o[3]); w0.z = pack2bf(o[4], o[5]); w0.w = pack2bf(o[6], o[7]);
                w1.x = pack2bf(o[8], o[9]); w1.y = pack2bf(o[10], o[11]); w1.z = pack2bf(o[12], o[13]); w1.w = pack2bf(o[14], o[15]);
                *(u32x4*)(p.H + (size_t)t * D_MODEL + lane * 16) = w0; *(u32x4*)(p.H + (size_t)t * D_MODEL + lane * 16 + 8) = w1;
            } else if (t >= CTX) {
                const float* fg = p.in[I_FG] + lane * 16;
                float* op = p.out + (size_t)(t - CTX) * D_MODEL + lane * 16;
#pragma unroll
                for (int c = 0; c < 4; ++c) {
                    float4 o; o.x = xn[c * 4 + 0] * rstd * fg[c * 4 + 0]; o.y = xn[c * 4 + 1] * rstd * fg[c * 4 + 1]; o.z = xn[c * 4 + 2] * rstd * fg[c * 4 + 2]; o.w = xn[c * 4 + 3] * rstd * fg[c * 4 + 3];
                    *(float4*)(op + c * 4) = o;
                }
            }
        }
    }
}
__device__ __forceinline__ void phase_final(const P& p) {
    const int lane = otid() & 63;
    const int gw = (obid() * NTHREADS + otid()) >> 6, nw = (gridDim.x * NTHREADS) >> 6;
    const float* g = p.in[I_FG];
    for (int t = gw; t < SEQ; t += nw) {
        const float* x = p.X + (size_t)(CTX + t) * D_MODEL;
        float v[D_MODEL / 64]; float ss = 0.f;
#pragma unroll
        for (int j = 0; j < D_MODEL / 64; ++j) { v[j] = x[lane + 64 * j]; ss += v[j] * v[j]; }
        ss = wave_sum(ss);
        float rstd = rsqrtf(ss / D_MODEL + 1e-6f);
#pragma unroll
        for (int j = 0; j < D_MODEL / 64; ++j) p.out[(size_t)t * D_MODEL + lane + 64 * j] = v[j] * rstd * g[lane + 64 * j];
    }
}

__global__ void __launch_bounds__(NTHREADS) fwd_megakernel(P p_arg) {
#ifdef EMU
    char* smem = emu_smem();
#else
    __shared__ __attribute__((aligned(16))) char smem_raw[SMEM_BYTES + 16];
    char* smem = smem_raw;
#endif
#ifndef EMU
    volatile LAS unsigned* xst = (volatile LAS unsigned*)(smem_raw + SMEM_BYTES);
    if (threadIdx.x == 0) { xst[0] = 0u; xst[1] = 0u; xst[2] = 0u; xst[3] = 0u; }
    __syncthreads();
    XcdBarrier xb = xcd_barrier_post(p_arg.bar, xst);
#endif
    { LOADP(); phase_init(p, smem); }
#ifndef EMU
#endif
    GRID_SYNC();
#ifndef EMU
    if (threadIdx.x == 0) {
        unsigned base_ = 0;
        for (unsigned j = 0; j < xb.x; ++j) base_ += xb_ld(&p_arg.bar[XB_XCNT(j)]);
        xst[2] = base_ + xst[3];
    }
    __syncthreads();
#endif
    PROBE_INIT();
    for (int l = 0; l < DEPTH; ++l) {
        if (l == 0) {
            { LOADP(); phase_norm(p, 0, 0); }
            { LOADP(); phase_s5const(p, 0); }
            { LOADP(); phase_convert_weights(p, 0, smem, obid(), (int)gridDim.x); }
            GRID_SYNC(); PROBE_AFTER(0);
        }
        { LOADP(); phase_gemm_in(p, l, smem); }
        GRID_SYNC(); PROBE_AFTER(1);
        { LOADP(); phase_rwkv_prep1(p, l); }
        GRID_SYNC(); PROBE_AFTER(14);
        { LOADP(); phase_rwkv_prep2(p, l, smem); }
        GRID_SYNC(); PROBE_AFTER(2);
        { LOADP(); for (int job = obid(); job < 2 * NC * RH; job += gridDim.x) rwkv_chunk_job(p, job, smem); }
        __syncthreads(); PROBE_AFTER(20);
        { LOADP(); phase_gla_kv(p, l, smem); }
        PROBE_AFTER(21);
        { LOADP(); phase_s5_pass(p, l, smem, false); }
        GRID_SYNC(); PROBE_AFTER(3);
        {
            LOADP();
            const int n_rw = 2 * RH, n_gla = 2 * GH * 8192 / NTHREADS, n_s5 = (2 * SG * 64 + NTHREADS - 1) / NTHREADS;
            const int G_ = (int)gridDim.x;
            if (G_ > 2 * n_rw) {
                if (obid() < n_rw) { rwkv_seq_job(p, obid(), smem); PROBE_AFTER(24); }
                else {
                    const int nb = G_ - n_rw, bid = obid() - n_rw;
                    for (int job = bid; job < n_gla + n_s5 + PEER_CONV_JOBS; job += nb) {
                        if (job < n_gla) gla_scan_job(p, job);
                        else if (job < n_gla + n_s5) s5_carry_job(p, job - n_gla);
                        else peer_conv_job(p, l, job - n_gla - n_s5);
                    }
                    if (l + 1 < DEPTH) { late_select(p, (l + 1) & 1); phase_convert_weights(p, l + 1, smem, bid, nb); }
                }
            } else {
                for (int job = obid(); job < n_rw + n_gla + n_s5 + PEER_CONV_JOBS; job += G_) {
                    if (job < n_rw) rwkv_seq_job(p, job, smem);
                    else if (job < n_rw + n_gla) gla_scan_job(p, job - n_rw);
                    else if (job < n_rw + n_gla + n_s5) s5_carry_job(p, job - n_rw - n_gla);
                    else peer_conv_job(p, l, job - n_rw - n_gla - n_s5);
                }
                __syncthreads();
                if (l + 1 < DEPTH) { late_select(p, (l + 1) & 1); phase_convert_weights(p, l + 1, smem, obid(), G_); }
            }
        }
        GRID_SYNC(); PROBE_AFTER(4);
        { LOADP(); phase_rwkv_out(p); }
        PROBE_AFTER(22);
        { LOADP(); phase_gla_out(p, l, smem); }
        PROBE_AFTER(23);
        { LOADP(); phase_s5_pass(p, l, smem, true); }
        GRID_SYNC(); PROBE_AFTER(5);
        { LOADP(); phase_side_elem(p, l); }
        if (l + 1 < DEPTH) { LOADP(); phase_s5const(p, l + 1); }
        GRID_SYNC(); PROBE_AFTER(6);
        { LOADP(); late_select(p, l & 1); phase_side_gemm(p, l, smem); }
        GRID_SYNC(); PROBE_AFTER(7);
        { LOADP(); late_select(p, l & 1); phase_merge(p, l, smem); }
        GRID_SYNC(); PROBE_AFTER(8);
        { LOADP(); late_select(p, l & 1); phase_outproj(p, l, smem); }
        GRID_SYNC(); PROBE_AFTER(9);
        { LOADP(); phase_norm(p, l, 1); }
        GRID_SYNC(); PROBE_AFTER(10);
        { LOADP(); late_select(p, l & 1); phase_peer_q(p, l, smem); }
        GRID_SYNC(); PROBE_AFTER(11);
        { LOADP(); late_select(p, l & 1); phase_peer_topk(p, l, smem); }
        GRID_SYNC(); PROBE_AFTER(12);
        { LOADP(); phase_peer_gather(p, l); }
        if (l + 1 < DEPTH) { GRID_SYNC(); PROBE_AFTER(13); }
    }
}

static inline size_t align_up(size_t x) { return (x + 255) & ~(size_t)255; }

extern "C" void kernel_launch(void* const* d_in, const int* in_sizes, int n_in, void* d_out, int out_size, void* d_ws, size_t ws_size, hipStream_t stream) {
    P p;
    memset(&p, 0, sizeof(p));
    for (int i = 0; i < 39; ++i) p.in[i] = (const float*)d_in[i];
    p.out = (float*)d_out;
    char* w = (char*)d_ws; size_t off = 0;
    auto take = [&](size_t bytes) { void* r = w + off; off = align_up(off + bytes); return r; };
    p.bar = (unsigned*)take(16384);
    p.X = (float*)take((size_t)MTOT * D_MODEL * 4);
    p.H = (bf16_t*)take((size_t)MTOT * D_MODEL * 2);
    p.MOD = (float*)take((size_t)DEPTH * 2 * 6 * D_MODEL * 4);
    p.Z = (bf16_t*)take((size_t)MTOT * ZLD * 2);
    p.ZGT = (bf16_t*)take((size_t)MTOT * 3 * D_MODEL * 2);
    p.V = (bf16_t*)take((size_t)MTOT * RW * 2);
    {
        char* ra = (char*)take((size_t)MTOT * RW * 2 * 2 > (size_t)MTOT * GLA_V * 4 ? (size_t)MTOT * RW * 2 * 2 : (size_t)MTOT * GLA_V * 4);
        p.R = (bf16_t*)ra; p.KK = (bf16_t*)(ra + (size_t)MTOT * RW * 2);
        p.OGLA = (float*)ra;
    }
    {
        char* rb = (char*)take((size_t)2 * MTOT * RW * 2 > (size_t)3 * MTOT * PH * 16 * 4 ? (size_t)2 * MTOT * RW * 2 : (size_t)3 * MTOT * PH * 16 * 4);
        p.KD = (bf16_t*)rb;
        p.IDX = (int*)rb; p.G = (float*)(rb + (size_t)MTOT * PH * 16 * 4); p.GU = (float*)(rb + (size_t)2 * MTOT * PH * 16 * 4);
    }
    p.BB = (bf16_t*)take((size_t)2 * MTOT * RW * 2);
    p.LW = (float*)take((size_t)2 * MTOT * RW * 4);
    p.SP = (bf16_t*)p.LW;
    static_assert((size_t)2 * NC * GH * 8192 * 2 <= (size_t)2 * MTOT * RW * 4, "SP alias");
    p.BONUS = (float*)take((size_t)2 * MTOT * RH * 4);
    p.KS = (bf16_t*)take((size_t)MTOT * RW * 2);
    p.LR = (bf16_t*)take((size_t)MTOT * 256 * 2);
    p.WT_W2 = (bf16_t*)take((size_t)2 * NPAD(RW) * 64 * 2);
    p.WT_A2 = (bf16_t*)take((size_t)2 * NPAD(RW) * 64 * 2);
    p.GS = (bf16_t*)take((size_t)MTOT * 128 * 2);
    p.Y = (float*)take((size_t)2 * MTOT * RW * 4);
    p.Y0T = (float*)take((size_t)2 * NC * RH * 4096 * 4);
    p.KV = (float*)take((size_t)2 * NC * GH * 8192 * 4);
    p.DEC = (float*)take((size_t)2 * NC * GH * 64 * 4);
    p.S5A = (float*)take((size_t)2 * SG * 64 * 2 * 4);
    p.S5BB = (float*)take((size_t)2 * SG * 64 * 16 * 2 * 4);
    p.S5END = (float*)take((size_t)2 * NC * SG * 64 * 2 * 4);
    p.S5CAR = (float*)take((size_t)2 * NC * SG * 64 * 2 * 4);
    {
        const size_t szc1 = (size_t)2 * NC * RH * SEQ_REC;
        const size_t szc2 = (size_t)MTOT * SW * 2 + (size_t)MTOT * RW * 4 + (size_t)MTOT * 3 * BW * 2 + (size_t)MTOT * D_MODEL * 2 + 1024;
        char* rc = (char*)take(szc1 > szc2 ? szc1 : szc2);
        p.REC = rc;
        char* c2 = rc;
        p.GY = (bf16_t*)c2; c2 += align_up((size_t)MTOT * SW * 2);
        p.YN = (float*)c2; c2 += align_up((size_t)MTOT * RW * 4);
        p.BR = (bf16_t*)c2; c2 += align_up((size_t)MTOT * 3 * BW * 2);
        p.M = (bf16_t*)c2;
    }
    p.SN = (bf16_t*)take((size_t)2 * NC * RH * 4096 * 2);
    p.QH = (bf16_t*)take((size_t)2 * NC * RH * 4096 * 2);
    p.WT_IN = (bf16_t*)take((size_t)NPAD192(D_IN) * D_MODEL * 2);
    {
        char* lb = (char*)take(2 * LATE_BYTES); size_t lo = 0;
        auto ltake = [&](size_t bytes) { void* r = lb + lo; lo = AL256(lo + bytes); return r; };
        p.WT_G2 = (bf16_t*)ltake((size_t)NPAD(RW) * 128 * 2);
        p.WT_GLU = (bf16_t*)ltake((size_t)NPAD(2 * SW) * SW * 2);
        p.WT_BR = (bf16_t*)ltake((size_t)3 * D_MODEL * BW * 2);
        p.WT_OUT = (bf16_t*)ltake((size_t)D_MODEL * D_MODEL * 2);
        p.WT_Q = (bf16_t*)ltake((size_t)PQ * D_MODEL * 2);
        p.KHI = (bf16_t*)ltake((size_t)PH * 2 * 128 * 128 * 2); p.KLO = (bf16_t*)ltake((size_t)PH * 2 * 128 * 128 * 2);
        if (lo != LATE_BYTES) fprintf(stderr, "late weights layout mismatch\n");
    }
    p.U8 = (unsigned char*)take((size_t)NEXP * D_MODEL);
    p.V8 = (unsigned char*)take((size_t)NEXP * D_MODEL);
    p.USC = (float*)take((size_t)NEXP * 4); p.VSC = (float*)take((size_t)NEXP * 4);
    p.QHI = p.Z; p.QLO = p.Z + (size_t)MTOT * PQ;
    static_assert((size_t)PQ * 4 <= (size_t)D_IN * 2 && ((size_t)MTOT * ZLD * 2) % 256 == 0, "Q alias");
    if (off > ws_size) { fprintf(stderr, "ws too small: need %zu have %zu\n", off, ws_size); return; }
#ifdef EMU
    fprintf(stderr, "ws used %zu MB\n", off >> 20);
    emu_launch([=] { fwd_megakernel(p); }, EMU_GRID, NTHREADS);
#else
    hipMemsetAsync(p.bar, 0, 16384, stream);
    static int grid_blocks = 0;
    if (!grid_blocks) {
        int dev = 0, cus = 0, per_cu = 0;
        hipGetDevice(&dev);
        hipDeviceGetAttribute(&cus, hipDeviceAttributeMultiprocessorCount, dev);
        hipOccupancyMaxActiveBlocksPerMultiprocessor(&per_cu, fwd_megakernel, NTHREADS, 0);
        if (per_cu > 1) per_cu = 1;
        grid_blocks = cus * per_cu;
    }
    void* args[] = {&p};
    hipError_t e = hipLaunchCooperativeKernel((void*)fwd_megakernel, dim3(grid_blocks), dim3(NTHREADS), args, 0, stream);
    if (e != hipSuccess) fprintf(stderr, "cooperative launch failed: %s (grid %d)\n", hipGetErrorString(e), grid_blocks);
#endif
}
```

```cpp
#include <hip/hip_runtime.h>
#ifndef EMU
#include <hip/hip_cooperative_groups.h>
namespace cg = cooperative_groups;
#endif
#include <cstdio>
#include <cstdint>
#include <cstring>
#include <type_traits>

#ifdef CFG_SMALL
#define D_MODEL 128
#define SEQ 640
#define DEPTH 2
#define GRID_W 10
#define CTX 128
#define GH 1
#define RH 2
#define SG 8
#define PH 2
#else
#define D_MODEL 1024
#define SEQ 16384
#define DEPTH 4
#define GRID_W 64
#define CTX 256
#define GH 4
#define RH 8
#define SG 32
#define PH 8
#endif
#define MTOT (CTX + SEQ)
#define ROWS (SEQ / GRID_W)
#define GLA_K (GH * 64)
#define GLA_V (GH * 128)
#define RW (RH * 64)
#define RWKV_IN (3 * RW + 4 * 64 + 128)
#define SW (SG * 16)
#define BW GLA_V
#define ZQ 0
#define ZK (GLA_K)
#define ZV (2 * GLA_K)
#define ZOG (ZV + GLA_V)
#define ZAF (ZOG + GLA_V)
#define ZAB (ZAF + 16)
#define ZR (ZAB + 16)
#define ZS5 (ZR + RWKV_IN)
#define ZG (ZS5 + SW)
#define D_IN (ZG + 3 * D_MODEL)
#define ZLD ZG
#define NC (MTOT / 64)
#define NCC (CTX / 64)
#define RB (ROWS / 64)
#define PQ (PH * 256)
#define NEXP 16384
#define NTHREADS 256
#define SMEM_BYTES 133120

typedef unsigned short bf16_t;
typedef short bf16x8 __attribute__((ext_vector_type(8)));
typedef float f32x4 __attribute__((ext_vector_type(4)));
typedef unsigned u32x4 __attribute__((ext_vector_type(4)));
typedef unsigned u32x2 __attribute__((ext_vector_type(2)));
#ifdef EMU
#define MFMA16(a, b, c) emu_mfma_16x16x32_bf16(a, b, c)
#else
#define MFMA16(a, b, c) __builtin_amdgcn_mfma_f32_16x16x32_bf16(a, b, c, 0, 0, 0)
#endif
typedef float f32x2 __attribute__((ext_vector_type(2)));
#ifdef EMU
#define CVT_PK_FP8(a, b, old, hi) emu_cvt_pk_fp8_f32(a, b, old, hi)
#define CVT_PK_F32_FP8(w, hi) emu_cvt_pk_f32_fp8(w, hi)
#else
#define CVT_PK_FP8(a, b, old, hi) __builtin_amdgcn_cvt_pk_fp8_f32(a, b, old, hi)
#define CVT_PK_F32_FP8(w, hi) __builtin_amdgcn_cvt_pk_f32_fp8(w, hi)
#endif
#ifdef EMU
#define MFMA16_ACC(a, b, c) c = emu_mfma_16x16x32_bf16(a, b, c)
#else
#define MFMA16_ACC(a, b, c) asm volatile("v_mfma_f32_16x16x32_bf16 %0, %1, %2, %0" : "+a"(c) : "v"(a), "v"(b))
#endif
#define NPAD(n) (((n) + 127) / 128 * 128)
#define NPAD192(n) (((n) + 383) / 384 * 384)

__device__ __forceinline__ float bf2f(bf16_t h) { return __builtin_bit_cast(float, ((unsigned)h) << 16); }
#ifdef EMU
__device__ __forceinline__ bf16_t f2bf(float f) { unsigned u = __builtin_bit_cast(unsigned, f); u += 0x7FFFu + ((u >> 16) & 1u); return (bf16_t)(u >> 16); }
__device__ __forceinline__ unsigned pack2bf(float a, float b) { return (unsigned)f2bf(a) | ((unsigned)f2bf(b) << 16); }
#else
typedef float f2v_t __attribute__((ext_vector_type(2))); typedef __bf16 b2v_t __attribute__((ext_vector_type(2)));
__device__ __forceinline__ bf16_t f2bf(float f) { return __builtin_bit_cast(unsigned short, (__bf16)f); }
__device__ __forceinline__ unsigned pack2bf(float a, float b) { f2v_t v = {a, b}; b2v_t r = __builtin_convertvector(v, b2v_t); return __builtin_bit_cast(unsigned, r); }
#endif
#ifdef EMU
#define fexp_(x) expf(x)
#define flog_(x) logf(x)
#else
#define fexp_(x) __expf(x)
#define flog_(x) __logf(x)
#endif
#define LO16(x) __builtin_bit_cast(float, (x) << 16)
#define HI16(x) __builtin_bit_cast(float, (x) & 0xFFFF0000u)
__device__ __forceinline__ float sigmoidf_(float x) { return 1.0f / (1.0f + fexp_(-x)); }
__device__ __forceinline__ float siluf_(float x) { return x * sigmoidf_(x); }
__device__ __forceinline__ float geluf_(float x) { const float y = 1.5957691216057308f * (x + 0.044715f * x * x * x); return x / (1.0f + fexp_(-y)); }
__device__ __forceinline__ float softplusf_(float x) { return fmaxf(x, 0.f) + flog_(1.0f + fexp_(-fabsf(x))); }
__device__ __forceinline__ float tanhf_(float x) { const float e = fexp_(-2.0f * fabsf(x)); const float t = (1.0f - e) / (1.0f + e); return x < 0.f ? -t : t; }
__device__ __forceinline__ float wave_sum(float v) {
#pragma unroll
    for (int m = 32; m >= 1; m >>= 1) v += __shfl_xor(v, m, 64);
    return v;
}

struct P {
    const float* in[39];
    float* out;
    float* X;
    bf16_t* H;
    bf16_t* Z;
    bf16_t* ZGT;
    float* MOD;
    bf16_t* R; bf16_t* V; bf16_t* KK; bf16_t* KD; bf16_t* BB;
    float* LW;
    char* REC;
    bf16_t* SN;
    bf16_t* QH;
    float* BONUS;
    bf16_t* KS;
    bf16_t* LR;
    bf16_t* WT_W2;
    bf16_t* WT_A2;
    bf16_t* GS;
    float* Y;
    bf16_t* G2B;
    float* Y0T;
    float* KV;
    bf16_t* SP;
    float* DEC;
    float* OGLA;
    float* S5A;
    float* S5BB;
    float* S5END;
    float* S5CAR;
    bf16_t* GY;
    float* YN;
    bf16_t* BR;
    bf16_t* M;
    bf16_t* QHI; bf16_t* QLO;
    bf16_t* KHI; bf16_t* KLO;
    int* IDX;
    float* G;
    float* GU;
    unsigned* bar;
    bf16_t* WT_IN;
    bf16_t* WT_G2;
    bf16_t* WT_GLU;
    bf16_t* WT_BR;
    bf16_t* WT_OUT;
    bf16_t* WT_Q;
    unsigned char* U8; unsigned char* V8;
    float* USC; float* VSC;
};

enum { I_X = 0, I_C, I_CTX, I_CCTX, I_WMOD, I_BMOD, I_N1G, I_N2G, I_WIN, I_GLA_WA2, I_GLA_BA, I_GLA_NG, I_RCONV, I_RW0, I_RW2, I_RA0, I_RA2, I_RG2,
       I_RKK, I_RKA, I_RRK, I_RLNW, I_RLNB, I_S5LRE, I_S5LIM, I_S5LS, I_S5BRE, I_S5BIM, I_S5CRE, I_S5CIM, I_S5D, I_S5GLU, I_WBR, I_WOUT, I_PWQ, I_PKEYS, I_PU, I_PV, I_FG };

#define AL256(x) (((size_t)(x) + 255) & ~(size_t)255)
#define LATE_BYTES (AL256((size_t)NPAD(RW) * 128 * 2) + AL256((size_t)NPAD(2 * SW) * SW * 2) + AL256((size_t)3 * D_MODEL * BW * 2) + AL256((size_t)D_MODEL * D_MODEL * 2) + \
                    AL256((size_t)PQ * D_MODEL * 2) + 2 * AL256((size_t)PH * 2 * 128 * 128 * 2))
__device__ __forceinline__ void late_select(P& p, int par) {
    const size_t o = (size_t)par * (LATE_BYTES / 2);
    p.WT_G2 += o; p.WT_GLU += o; p.WT_BR += o; p.WT_OUT += o; p.WT_Q += o; p.KHI += o; p.KLO += o;
}
#ifdef EMU
__device__ __forceinline__ int otid() { return threadIdx.x; }
__device__ __forceinline__ int obid() { return blockIdx.x; }
#else
__device__ __forceinline__ int otid() { int t = threadIdx.x; asm volatile("" : "+v"(t)); return t; }
__device__ __forceinline__ int obid() { int b = blockIdx.x; asm volatile("" : "+s"(b)); return b; }
#endif
#ifdef EMU
#define WAVE_SYNC() emu_wave_barrier()
#ifndef EMU_GRID
#define EMU_GRID 4
#endif
#else
#define WAVE_SYNC() __builtin_amdgcn_wave_barrier()
#endif
#ifndef EMU
#define XB_TMO      128
#define XB_XCNT(j)  (256  + 64 * (j))
#define XB_XSUB(j)  (1280 + 64 * (j))
#define XB_XGEN(j)  (2304 + 64 * (j))
#define XB_TOP      3328
#define XB_TOPGEN   3392
#define XCD_BAR_WORDS 3456
#define XB_SPIN_CAP (1u << 22)
#define LAS __attribute__((address_space(3)))
__device__ __forceinline__ unsigned xb_ld(unsigned* p)              { return __hip_atomic_load(p, __ATOMIC_RELAXED, __HIP_MEMORY_SCOPE_AGENT); }
__device__ __forceinline__ unsigned xb_add(unsigned* p, unsigned v) { return __hip_atomic_fetch_add(p, v, __ATOMIC_RELAXED, __HIP_MEMORY_SCOPE_AGENT); }
__device__ __forceinline__ unsigned xb_xcc_id() { return (unsigned)__builtin_amdgcn_s_getreg((3 << 11) | 20) & 0xFu; }
#define XB_SPIN(cond, bar) do { unsigned _sp = 0; while (cond) { __builtin_amdgcn_s_sleep(1); \
    if ((++_sp & 255u) == 0u) { if (xb_ld(&(bar)[XB_TMO])) break; if (_sp > XB_SPIN_CAP) { atomicAdd(&(bar)[XB_TMO], 1u); break; } } } } while (0)
struct XcdBarrier { unsigned* bar; unsigned x; volatile LAS unsigned* st; };
__device__ __forceinline__ XcdBarrier xcd_barrier_post(unsigned* bar, volatile LAS unsigned* st) {
    XcdBarrier b; b.bar = bar; b.x = xb_xcc_id(); b.st = st;
    if (threadIdx.x == 0) st[3] = xb_add(&bar[XB_XCNT(b.x)], 1u);
    return b;
}
__device__ __forceinline__ void xcd_barrier_complete(unsigned* bar, unsigned x, unsigned& nloc, unsigned& nx) {
    const unsigned G = gridDim.x * gridDim.y * gridDim.z;
    unsigned sum, cnt, mine, sp = 0u;
    for (;;) {
        sum = 0u; cnt = 0u; mine = 0u;
#pragma unroll
        for (unsigned j = 0; j < 16; ++j) { const unsigned c = xb_ld(&bar[XB_XCNT(j)]); sum += c; cnt += (c > 0u) ? 1u : 0u; mine = (j == x) ? c : mine; }
        if (sum == G) break;
        __builtin_amdgcn_s_sleep(1);
        if ((++sp & 255u) == 0u) { if (xb_ld(&bar[XB_TMO])) break; if (sp > XB_SPIN_CAP) { atomicAdd(&bar[XB_TMO], 1u); break; } }
    }
    nloc = mine > 0u ? mine : 1u; nx = cnt > 0u ? cnt : 1u;
}
__device__ __forceinline__ void xcd_barrier(const XcdBarrier& b) {
    asm volatile("s_waitcnt vmcnt(0)" ::: "memory");
    __syncthreads();
    if (threadIdx.x == 0) {
        unsigned* bar = b.bar;
        __builtin_amdgcn_fence(__ATOMIC_RELEASE, "agent");
        asm volatile("s_waitcnt vmcnt(0)" ::: "memory");
        const unsigned G = gridDim.x;
        const unsigned old = xb_add(&bar[XB_TOP], 1u);
        const unsigned tg = old / G;
        if (old + 1u == (tg + 1u) * G) {
            const unsigned long long t0_ = wall_clock64(); while (wall_clock64() - t0_ < 1000ull) __builtin_amdgcn_s_sleep(8);
            xb_add(&bar[XB_TOPGEN], 1u);
        }
        else XB_SPIN(xb_ld(&bar[XB_TOPGEN]) == tg, bar);
        __builtin_amdgcn_fence(__ATOMIC_ACQUIRE, "agent");
        asm volatile("s_waitcnt vmcnt(0)" ::: "memory");
    }
    __syncthreads();
}
#define GRID_SYNC() { (void)xb; cg::this_grid().sync(); }
#else
#define GRID_SYNC() emu_grid_sync()
#endif

#ifdef EMU
#define LOADP() P p = p_arg
#else
typedef __attribute__((address_space(4))) const unsigned long long cu64_t;
__device__ __forceinline__ void load_params(P& p) {
    cu64_t* q = (cu64_t*)__builtin_amdgcn_kernarg_segment_ptr();
    asm volatile("" : "+s"(q));
    unsigned long long w[sizeof(P) / 8];
#pragma unroll
    for (int i = 0; i < (int)(sizeof(P) / 8); ++i) w[i] = q[i];
    __builtin_memcpy(&p, w, sizeof(P));
}
#define LOADP() P p; load_params(p)
#endif
#define PROBE_MULT 3
#if defined(PROBE_ID) && !defined(EMU)
#define PROBE_INIT() unsigned long long probe_t0 = wall_clock64()
#define PROBE_AFTER(id) { if (blockIdx.x == 0) { unsigned long long now_ = wall_clock64(); if ((id) == PROBE_ID || (id) == PROBE_ID2) { const unsigned long long dt_ = now_ - probe_t0; \
    while (wall_clock64() - now_ < dt_ * PROBE_MULT) __builtin_amdgcn_s_sleep(8); now_ = wall_clock64(); } probe_t0 = now_; } }
#else
#define PROBE_INIT()
#define PROBE_AFTER(id)
#endif
__device__ __forceinline__ int gla_tok(int n, int i) {
    if (n < NCC) return n * 64 + i;
    int m = n - NCC; int col = m / RB, rb = m % RB;
    return CTX + (rb * 64 + i) * GRID_W + col;
}
__device__ __forceinline__ int chunk_order(int d, int s) {
    if (d == 0) return s;
    return (s < NCC) ? (NCC - 1 - s) : (NC - 1 - (s - NCC));
}
__device__ __forceinline__ int tok_order(int d, int s) {
    if (d == 0) return s;
    return (s < CTX) ? (CTX - 1 - s) : (MTOT - 1 - (s - CTX));
}


#define LDS_ROW 72
__device__ __forceinline__ void mfma_gemm_tile(const bf16_t* Wt, int ldw, const bf16_t* Act, int lda, int K, int n0, int m0, bf16_t* lds, f32x4 (&acc)[4][4]) {
    bf16_t* Ws = lds; bf16_t* As = lds + 128 * LDS_ROW;
    const int tid = otid(), lane = tid & 63, wave = tid >> 6, wn = wave >> 1, wm = wave & 1;
    const int lrow = tid >> 3, lkc = (tid & 7) * 8;
    u32x4 pw[4], pa[4];
#pragma unroll
    for (int i = 0; i < 4; ++i) {
        pw[i] = *(const u32x4*)(Wt + (size_t)(n0 + lrow + 32 * i) * ldw + lkc);
        pa[i] = *(const u32x4*)(Act + (size_t)(m0 + lrow + 32 * i) * lda + lkc);
    }
    for (int k0 = 0; k0 < K; k0 += 64) {
        __syncthreads();
#pragma unroll
        for (int i = 0; i < 4; ++i) {
            *(u32x4*)(Ws + (lrow + 32 * i) * LDS_ROW + lkc) = pw[i];
            *(u32x4*)(As + (lrow + 32 * i) * LDS_ROW + lkc) = pa[i];
        }
        __syncthreads();
        if (k0 + 64 < K) {
#pragma unroll
            for (int i = 0; i < 4; ++i) {
                pw[i] = *(const u32x4*)(Wt + (size_t)(n0 + lrow + 32 * i) * ldw + k0 + 64 + lkc);
                pa[i] = *(const u32x4*)(Act + (size_t)(m0 + lrow + 32 * i) * lda + k0 + 64 + lkc);
            }
        }
#pragma unroll
        for (int ks = 0; ks < 2; ++ks) {
            bf16x8 a[4], b[4];
#pragma unroll
            for (int i = 0; i < 4; ++i) {
                a[i] = *(const bf16x8*)(Ws + (wn * 64 + i * 16 + (lane & 15)) * LDS_ROW + ks * 32 + (lane >> 4) * 8);
                b[i] = *(const bf16x8*)(As + (wm * 64 + i * 16 + (lane & 15)) * LDS_ROW + ks * 32 + (lane >> 4) * 8);
            }
#pragma unroll
            for (int ni = 0; ni < 4; ++ni)
#pragma unroll
                for (int mi = 0; mi < 4; ++mi) acc[ni][mi] = MFMA16(a[ni], b[mi], acc[ni][mi]);
        }
    }
}
#define L64_ROW 72
#ifdef EMU
struct BufRsrc { const char* base; };
__device__ __forceinline__ BufRsrc make_rsrc(const void* p, size_t) { BufRsrc r; r.base = (const char*)p; return r; }
__device__ __forceinline__ u32x4 buf_load16(const BufRsrc& r, unsigned voff, unsigned soff) { return *(const u32x4*)(r.base + voff + soff); }
#else
typedef __amdgpu_buffer_rsrc_t BufRsrc;
__device__ __forceinline__ BufRsrc make_rsrc(const void* p, size_t bytes) { return __builtin_amdgcn_make_buffer_rsrc((void*)p, 0, (int)bytes, 0x00020000); }
__device__ __forceinline__ u32x4 buf_load16(const BufRsrc& r, unsigned voff, unsigned soff) { return __builtin_bit_cast(u32x4, __builtin_amdgcn_raw_buffer_load_b128(r, voff, soff, 0)); }
#endif
template <int NI, int MI>
__device__ __forceinline__ void mfma_gemm_tile_t(const bf16_t* Wt, int ldw, size_t wbytes, const bf16_t* Act, int lda, size_t abytes, int K, int n0, int m0, bf16_t* lds, f32x4 (&acc)[NI][MI], unsigned long long* gacc = nullptr) {
    constexpr int WR = 32 * NI, AR = 32 * MI, BUF = (WR + AR) * L64_ROW;
    const int tid = otid(), lane = tid & 63, wave = tid >> 6, wn = wave >> 1, wm = wave & 1;
    const int lrow = tid >> 3, lkc = (tid & 7) * 8;
    const BufRsrc rw = make_rsrc(Wt, wbytes), ra = make_rsrc(Act, abytes);
    unsigned vw[NI], va[MI];
#pragma unroll
    for (int i = 0; i < NI; ++i) vw[i] = (unsigned)(((size_t)(n0 + lrow + 32 * i) * ldw + lkc) * 2);
#pragma unroll
    for (int i = 0; i < MI; ++i) va[i] = (unsigned)(((size_t)(m0 + lrow + 32 * i) * lda + lkc) * 2);
    u32x4 qw0[NI], qa0[MI];
    const int nk = K / 64;
#define GT_LOAD(QW, QA, KT) { const unsigned so_ = (unsigned)(((KT) < nk) ? (KT) : (nk - 1)) * 128u; \
    _Pragma("unroll") for (int i = 0; i < NI; ++i) QW[i] = buf_load16(rw, vw[i], so_); \
    _Pragma("unroll") for (int i = 0; i < MI; ++i) QA[i] = buf_load16(ra, va[i], so_); }
#define GT_STORE(QW, QA, DST) { \
    _Pragma("unroll") for (int i = 0; i < NI; ++i) *(u32x4*)((DST) + (lrow + 32 * i) * L64_ROW + lkc) = QW[i]; \
    _Pragma("unroll") for (int i = 0; i < MI; ++i) *(u32x4*)((DST) + (WR + lrow + 32 * i) * L64_ROW + lkc) = QA[i]; }
#define GT_COMPUTE(CUR) { _Pragma("unroll") for (int ks = 0; ks < 2; ++ks) { bf16x8 b[MI], a[NI]; \
    _Pragma("unroll") for (int i = 0; i < MI; ++i) b[i] = *(const bf16x8*)((CUR) + (WR + wm * 16 * MI + i * 16 + (lane & 15)) * L64_ROW + ks * 32 + (lane >> 4) * 8); \
    _Pragma("unroll") for (int i = 0; i < NI; ++i) a[i] = *(const bf16x8*)((CUR) + (wn * 16 * NI + i * 16 + (lane & 15)) * L64_ROW + ks * 32 + (lane >> 4) * 8); \
    _Pragma("unroll") for (int ni = 0; ni < NI; ++ni) { \
        _Pragma("unroll") for (int mi = 0; mi < MI; ++mi) MFMA16_ACC(a[ni], b[mi], acc[ni][mi]); } } }
    GT_LOAD(qw0, qa0, 0)
    __syncthreads();
    GT_STORE(qw0, qa0, lds)
    __syncthreads();
    for (int kt = 0; kt < nk; kt += 2) {
        GT_LOAD(qw0, qa0, kt + 1)
        GT_COMPUTE(lds)
        GT_STORE(qw0, qa0, lds + BUF)
        __syncthreads();
        GT_LOAD(qw0, qa0, kt + 2)
        GT_COMPUTE(lds + BUF)
        GT_STORE(qw0, qa0, lds)
        __syncthreads();
    }
#undef GT_LOAD
#undef GT_STORE
#undef GT_COMPUTE
}
#define ZERO_ACC4(acc) { _Pragma("unroll") for (int i_ = 0; i_ < 4; ++i_) _Pragma("unroll") for (int j_ = 0; j_ < 4; ++j_) acc[i_][j_] = (f32x4){0.f, 0.f, 0.f, 0.f}; }
#define FOR_ACC(acc, n0, m0, BODY) { const int lane_ = otid() & 63, wave_ = otid() >> 6; \
    _Pragma("unroll") for (int ni_ = 0; ni_ < 4; ++ni_) _Pragma("unroll") for (int mi_ = 0; mi_ < 4; ++mi_) { \
        const int n = (n0) + (wave_ >> 1) * 64 + ni_ * 16 + (lane_ >> 4) * 4; const int m = (m0) + (wave_ & 1) * 64 + mi_ * 16 + (lane_ & 15); const f32x4 v = acc[ni_][mi_]; BODY } }
__device__ __forceinline__ u32x2 pack4(float a, float b, float c, float d) { u32x2 r; r.x = pack2bf(a, b); r.y = pack2bf(c, d); return r; }

__device__ __forceinline__ void convert_wt_job(const float* W, int K, int N, int Npad, bf16_t* out, int job, float* T, int ilv) {
    const int tid = otid();
    const int nkt = K / 64;
    const int n0 = (job / nkt) * 64, k0 = (job % nkt) * 64;
    __syncthreads();
    for (int idx = tid; idx < 4096; idx += NTHREADS) {
        int kk = idx >> 6, nn = idx & 63;
        int nr = n0 + nn; int src = ilv ? ((nr & 1) ? (N / 2 + (nr >> 1)) : (nr >> 1)) : nr;
        T[kk * 65 + nn] = (nr < N) ? W[(size_t)(k0 + kk) * N + src] : 0.f;
    }
    __syncthreads();
    {
        int nn = tid >> 2, part = tid & 3;
        unsigned w[8];
#pragma unroll
        for (int j = 0; j < 8; ++j) w[j] = pack2bf(T[(part * 16 + 2 * j) * 65 + nn], T[(part * 16 + 2 * j + 1) * 65 + nn]);
        u32x4* o = (u32x4*)(out + (size_t)(n0 + nn) * K + k0 + part * 16);
        o[0] = (u32x4){w[0], w[1], w[2], w[3]}; o[1] = (u32x4){w[4], w[5], w[6], w[7]};
    }
}
__device__ __forceinline__ void phase_convert_weights(const P& p, int l, char* smem, int bid, int nb) {
    float* T = (float*)smem;
    struct Item { const float* W; int K, N, Npad; bf16_t* out; };
    const Item items[12] = {
        {p.in[I_RW2] + ((size_t)l * 2 + 0) * 64 * RW, 64, RW, NPAD(RW), p.WT_W2},
        {p.in[I_RW2] + ((size_t)l * 2 + 1) * 64 * RW, 64, RW, NPAD(RW), p.WT_W2 + (size_t)NPAD(RW) * 64},
        {p.in[I_RA2] + ((size_t)l * 2 + 0) * 64 * RW, 64, RW, NPAD(RW), p.WT_A2},
        {p.in[I_RA2] + ((size_t)l * 2 + 1) * 64 * RW, 64, RW, NPAD(RW), p.WT_A2 + (size_t)NPAD(RW) * 64},
        {p.in[I_WIN] + (size_t)l * D_MODEL * D_IN, D_MODEL, D_IN, NPAD192(D_IN), p.WT_IN},
        {p.in[I_RG2] + (size_t)l * 128 * RW, 128, RW, RW, p.WT_G2},
        {p.in[I_S5GLU] + (size_t)l * SW * 2 * SW, SW, 2 * SW, 2 * SW, p.WT_GLU},
        {p.in[I_WBR] + ((size_t)l * 3 + 0) * BW * D_MODEL, BW, D_MODEL, D_MODEL, p.WT_BR},
        {p.in[I_WBR] + ((size_t)l * 3 + 1) * BW * D_MODEL, BW, D_MODEL, D_MODEL, p.WT_BR + (size_t)D_MODEL * BW},
        {p.in[I_WBR] + ((size_t)l * 3 + 2) * BW * D_MODEL, BW, D_MODEL, D_MODEL, p.WT_BR + (size_t)2 * D_MODEL * BW},
        {p.in[I_WOUT] + (size_t)l * D_MODEL * D_MODEL, D_MODEL, D_MODEL, D_MODEL, p.WT_OUT},
        {p.in[I_PWQ] + (size_t)l * D_MODEL * PQ, D_MODEL, PQ, PQ, p.WT_Q}};
    int base = 0;
#pragma unroll
    for (int it = 0; it < 12; ++it) {
        const int nj = (items[it].Npad / 64) * (items[it].K / 64);
        for (int j = (bid + nb - (base % nb)) % nb; j < nj; j += nb)
            convert_wt_job(items[it].W, items[it].K, items[it].N, items[it].Npad, items[it].out, j, T, it == 6);
        base += nj;
    }
    __syncthreads();
    {
        const float* ks = p.in[I_PKEYS] + (size_t)l * PH * 2 * 128 * 128;
        for (size_t i = (size_t)bid * NTHREADS + otid(); i < (size_t)PH * 2 * 128 * 128; i += (size_t)nb * NTHREADS) {
            const float v = ks[i]; const bf16_t hb = f2bf(v);
            p.KHI[i] = hb; p.KLO[i] = f2bf(v - bf2f(hb));
        }
    }
}

#ifdef EMU
__device__ __forceinline__ int xcd_rank() { return obid(); }
#else
__device__ __forceinline__ int xcd_rank() { return (int)((volatile LAS unsigned*)(unsigned)(SMEM_BYTES))[2]; }
#endif
__device__ __forceinline__ bool tile_map(int it, int ntm, int ntn, int PM, int& mt, int& nt) {
    const int G = gridDim.x;
    const long id = (long)it * G + xcd_rank();
    if (id >= (long)ntm * ntn) return false;
    const int full = ntm / PM; const long fullsz = (long)full * PM * ntn;
    if (id < fullsz) { const int p = (int)(id / (PM * ntn)), rem = (int)(id % (PM * ntn)); nt = rem / PM; mt = p * PM + rem % PM; }
    else { const int rem = (int)(id - fullsz), hh = ntm - full * PM; nt = rem / hh; mt = full * PM + rem % hh; }
    return true;
}

template <int NI, int MI, class Pre, class Post>
__device__ __forceinline__ void gemm_tile_run(const bf16_t* Wt, int ldw, size_t wbytes, const bf16_t* Act, int lda, size_t abytes, int K, int n0, int m0, bf16_t* lds, Pre pre, Post post) {
    f32x4 acc[NI][MI];
#pragma unroll
    for (int i = 0; i < NI; ++i)
#pragma unroll
        for (int j = 0; j < MI; ++j) acc[i][j] = (f32x4){0.f, 0.f, 0.f, 0.f};
    pre(m0, n0, acc, lds);
    mfma_gemm_tile_t<NI, MI>(Wt, ldw, wbytes, Act, lda, abytes, K, n0, m0, lds, acc);
    const int lane = otid() & 63, wave = otid() >> 6;
#pragma unroll
    for (int ni = 0; ni < NI; ++ni)
#pragma unroll
        for (int mi = 0; mi < MI; ++mi)
            post(ni, mi, m0 + (wave & 1) * 16 * MI + mi * 16 + (lane & 15), n0 + (wave >> 1) * 16 * NI + ni * 16 + (lane >> 4) * 4, acc[ni][mi]);
}
struct NoPre { template <class A> __device__ __forceinline__ void operator()(int, int, A&, bf16_t*) const {} };
template <int NI, class PreM, class PreT, class Post>
__device__ __forceinline__ void gemm_phase(const bf16_t* Wt, int ldw, size_t wbytes, const bf16_t* Act, int lda, size_t abytes, int K, int N, bf16_t* lds, PreM prem, PreT pret, Post post) {
    const int ntn = N / (32 * NI), ntm = MTOT / 256 - 1;
    const int PM = (ntn >= 16) ? 2 : ((ntn >= 8) ? 4 : 8);
    for (int it = 0;; ++it) {
        int mt_, nt_; if (!tile_map(it, ntm, ntn, PM, mt_, nt_)) break;
        gemm_tile_run<NI, 8>(Wt, ldw, wbytes, Act, lda, abytes, K, nt_ * 32 * NI, mt_ * 256, lds, prem, post);
    }
    for (int job = obid(); job < 4 * ntn; job += gridDim.x)
        gemm_tile_run<NI, 2>(Wt, ldw, wbytes, Act, lda, abytes, K, (job >> 2) * 32 * NI, MTOT - 256 + (job & 3) * 64, lds, pret, post);
}

__device__ __forceinline__ void phase_init(const P& p, char* smem) {
    const int tid = otid();
    float* sc = (float*)smem;
    for (int i = tid; i < D_MODEL; i += NTHREADS) { sc[i] = siluf_(p.in[I_CCTX][i]); sc[D_MODEL + i] = siluf_(p.in[I_C][i]); }
    __syncthreads();
    const int ncolblk = (6 * D_MODEL) / NTHREADS;
    for (int job = obid(); job < DEPTH * ncolblk; job += gridDim.x) {
        int l = job / ncolblk, n = (job % ncolblk) * NTHREADS + tid;
        const float* w = p.in[I_WMOD] + (size_t)l * D_MODEL * 6 * D_MODEL + n;
        float a0 = 0.f, a1 = 0.f;
        for (int k = 0; k < D_MODEL; ++k) { float wv = w[(size_t)k * 6 * D_MODEL]; a0 += sc[k] * wv; a1 += sc[D_MODEL + k] * wv; }
        float b = p.in[I_BMOD][l * 6 * D_MODEL + n];
        p.MOD[(size_t)(l * 2 + 0) * 6 * D_MODEL + n] = a0 + b;
        p.MOD[(size_t)(l * 2 + 1) * 6 * D_MODEL + n] = a1 + b;
    }
    const size_t gtid = (size_t)obid() * NTHREADS + tid, gn = (size_t)gridDim.x * NTHREADS;
    for (size_t i = gtid; i < (size_t)CTX * D_MODEL; i += gn) p.X[i] = p.in[I_CTX][i];
    for (size_t i = gtid; i < (size_t)SEQ * D_MODEL; i += gn) p.X[(size_t)CTX * D_MODEL + i] = p.in[I_X][i];
    __syncthreads();
}

__device__ __forceinline__ void phase_s5const(const P& p, int l) {
    const size_t gtid = (size_t)obid() * NTHREADS + otid(), gn = (size_t)gridDim.x * NTHREADS;
    for (size_t i = gtid; i < (size_t)2 * SG * 64; i += gn) {
        int d = (int)(i / (SG * 64)), g = (int)((i / 64) % SG), s = (int)(i % 64);
        size_t li = ((size_t)(l * 2 + d) * SG + g) * 64 + s;
        float lre = p.in[I_S5LRE][li], lim = p.in[I_S5LIM][li];
        float dt = expf(p.in[I_S5LS][(l * 2 + d) * SG + g]);
        float mag = expf(lre * dt);
        float are = mag * cosf(lim * dt), aim = mag * sinf(lim * dt);
        float den = lre * lre + lim * lim;
        float fre = ((are - 1.0f) * lre + aim * lim) / den;
        float fim = (aim * lre - (are - 1.0f) * lim) / den;
        p.S5A[i * 2 + 0] = are; p.S5A[i * 2 + 1] = aim;
        const float* bre = p.in[I_S5BRE] + (((size_t)l * SG + g) * 64 + s) * 16;
        const float* bim = p.in[I_S5BIM] + (((size_t)l * SG + g) * 64 + s) * 16;
        for (int c = 0; c < 16; ++c) {
            p.S5BB[(i * 16 + c) * 2 + 0] = fre * bre[c] - fim * bim[c];
            p.S5BB[(i * 16 + c) * 2 + 1] = fre * bim[c] + fim * bre[c];
        }
    }
}

__device__ __forceinline__ void phase_norm(const P& p, int l, int which) {
    const int lane = otid() & 63;
    const int gw = (obid() * NTHREADS + otid()) >> 6, nw = (gridDim.x * NTHREADS) >> 6;
    const float* g = p.in[which ? I_N2G : I_N1G] + l * D_MODEL;
    constexpr int NJ = (D_MODEL + 255) / 256;
    for (int t = gw; t < MTOT; t += nw) {
        const float* x = p.X + (size_t)t * D_MODEL;
        const float* mod = p.MOD + (size_t)(l * 2 + (t >= CTX ? 1 : 0)) * 6 * D_MODEL + (which ? 3 * D_MODEL : 0);
        float4 v[NJ]; float ss = 0.f;
#pragma unroll
        for (int j = 0; j < NJ; ++j) {
            const int e = j * 256 + lane * 4;
            if (e < D_MODEL) v[j] = *(const float4*)(x + e); else { v[j].x = 0.f; v[j].y = 0.f; v[j].z = 0.f; v[j].w = 0.f; }
            ss += v[j].x * v[j].x + v[j].y * v[j].y + v[j].z * v[j].z + v[j].w * v[j].w;
        }
        ss = wave_sum(ss);
        const float rstd = rsqrtf(ss / D_MODEL + 1e-6f);
#pragma unroll
        for (int j = 0; j < NJ; ++j) {
            const int e = j * 256 + lane * 4;
            if (e < D_MODEL) {
                const float4 gg = *(const float4*)(g + e), sc = *(const float4*)(mod + D_MODEL + e), sh = *(const float4*)(mod + e);
                *(u32x2*)(p.H + (size_t)t * D_MODEL + e) = pack4(v[j].x * rstd * gg.x * (1.0f + sc.x) + sh.x, v[j].y * rstd * gg.y * (1.0f + sc.y) + sh.y,
                                                                 v[j].z * rstd * gg.z * (1.0f + sc.z) + sh.z, v[j].w * rstd * gg.w * (1.0f + sc.w) + sh.w);
            }
        }
    }
}

__device__ __forceinline__ void phase_gemm_in(const P& p, int l, char* smem) {
    constexpr int NI = 4, MI = 8;
    const int ntn = NPAD192(D_IN) / 128, ntm = MTOT / 256;
    for (int it = 0;; ++it) {
        int mt_, nt_; if (!tile_map(it, ntm, ntn, 4, mt_, nt_)) break;
        const int m0 = mt_ * 256, n0 = nt_ * 128;
        f32x4 acc[NI][MI];
#pragma unroll
        for (int i = 0; i < NI; ++i)
#pragma unroll
            for (int j = 0; j < MI; ++j) acc[i][j] = (f32x4){0.f, 0.f, 0.f, 0.f};
        mfma_gemm_tile_t<NI, MI>(p.WT_IN, D_MODEL, (size_t)NPAD192(D_IN) * D_MODEL * 2, p.H, D_MODEL, (size_t)MTOT * D_MODEL * 2, D_MODEL, n0, m0, (bf16_t*)smem, acc);
        const int lane = otid() & 63, wave = otid() >> 6;
#pragma unroll
        for (int ni = 0; ni < NI; ++ni)
#pragma unroll
            for (int mi = 0; mi < MI; ++mi) {
                const int n = n0 + (wave >> 1) * 16 * NI + ni * 16 + (lane >> 4) * 4, m = m0 + (wave & 1) * 16 * MI + mi * 16 + (lane & 15);
                const u32x2 pk_ = pack4(acc[ni][mi][0], acc[ni][mi][1], acc[ni][mi][2], acc[ni][mi][3]);
                if (n < ZG) *(u32x2*)(p.Z + (size_t)m * ZLD + n) = pk_;
                else if (n < D_IN) *(u32x2*)(p.ZGT + ((((size_t)(m >> 4) * (3 * D_MODEL / 16) + ((n - ZG) >> 4)) * 64 + lane) * 4)) =
                    pack4(sigmoidf_(acc[ni][mi][0]), sigmoidf_(acc[ni][mi][1]), sigmoidf_(acc[ni][mi][2]), sigmoidf_(acc[ni][mi][3]));
            }
    }
}

__device__ __forceinline__ void unpack8(const u32x4 w, float (&f)[8]) {
    f[0] = LO16(w.x); f[1] = HI16(w.x); f[2] = LO16(w.y); f[3] = HI16(w.y); f[4] = LO16(w.z); f[5] = HI16(w.z); f[6] = LO16(w.w); f[7] = HI16(w.w);
}
__device__ __forceinline__ u32x4 pack8(const float (&f)[8]) {
    u32x4 o; o.x = pack2bf(f[0], f[1]); o.y = pack2bf(f[2], f[3]);
    o.z = pack2bf(f[4], f[5]); o.w = pack2bf(f[6], f[7]); return o;
}
__device__ __forceinline__ void load8f(const float* p, float (&f)[8]) {
    const float4 a = *(const float4*)p, b = *(const float4*)(p + 4);
    f[0] = a.x; f[1] = a.y; f[2] = a.z; f[3] = a.w; f[4] = b.x; f[5] = b.y; f[6] = b.z; f[7] = b.w;
}
__device__ __forceinline__ void store8f(float* p, const float (&f)[8]) {
    float4 a, b; a.x = f[0]; a.y = f[1]; a.z = f[2]; a.w = f[3]; b.x = f[4]; b.y = f[5]; b.z = f[6]; b.w = f[7];
    *(float4*)p = a; *(float4*)(p + 4) = b;
}
__device__ __forceinline__ void conv8(const bf16_t* zp, const float* conv, int c0, bool act, bool first, bool last, float (&out)[8]) {
    const u32x4 z4 = {0u, 0u, 0u, 0u};
    const u32x4 a0 = act ? *(const u32x4*)(zp + c0) : z4;
    const u32x4 am = (act && !first) ? *(const u32x4*)(zp + c0 - ZLD) : z4;
    const u32x4 an = (act && !last) ? *(const u32x4*)(zp + c0 + ZLD) : z4;
    float w0[8], w1[8], w2[8], f0[8], fm[8], fn[8];
    if (act) { load8f(conv + c0, w0); load8f(conv + RWKV_IN + c0, w1); load8f(conv + 2 * RWKV_IN + c0, w2); }
    else {
#pragma unroll
        for (int e = 0; e < 8; ++e) { w0[e] = 0.f; w1[e] = 0.f; w2[e] = 0.f; }
    }
    unpack8(a0, f0); unpack8(am, fm); unpack8(an, fn);
#pragma unroll
    for (int e = 0; e < 8; ++e) out[e] = w1[e] * f0[e] + w0[e] * fm[e] + w2[e] * fn[e];
}
__device__ __forceinline__ void phase_rwkv_prep1(const P& p, int l) {
    const int lane = otid() & 63;
    const int gw = (obid() * NTHREADS + otid()) >> 6, nw = (gridDim.x * NTHREADS) >> 6;
    const float* conv = p.in[I_RCONV] + (size_t)l * 3 * RWKV_IN;
    const float* k_k = p.in[I_RKK] + (size_t)l * RW;
    const bool act = lane * 8 < RW, act2 = lane * 8 < 384;
    float kkw[8];
    if (act) load8f(k_k + lane * 8, kkw);
    else {
#pragma unroll
        for (int e = 0; e < 8; ++e) kkw[e] = 0.f;
    }
    for (int t = gw; t < MTOT; t += nw) {
        const bool first = (t == 0) || (t == CTX), last = (t == CTX - 1) || (t == MTOT - 1);
        const bf16_t* zp = p.Z + (size_t)t * ZLD + ZR;
        float rv[8], kv[8], vv[8], lr[8];
        conv8(zp, conv, 0 * RW + lane * 8, act, first, last, rv);
        conv8(zp, conv, 1 * RW + lane * 8, act, first, last, kv);
        conv8(zp, conv, 2 * RW + lane * 8, act, first, last, vv);
        conv8(zp, conv, 3 * RW + lane * 8, act2, first, last, lr);
        float kk[8]; float ss = 0.f;
#pragma unroll
        for (int e = 0; e < 8; ++e) { kk[e] = kv[e] * kkw[e]; ss += kk[e] * kk[e]; }
        ss += __shfl_xor(ss, 1, 64); ss += __shfl_xor(ss, 2, 64); ss += __shfl_xor(ss, 4, 64);
        const float inv = 1.0f / fmaxf(sqrtf(ss), 1e-12f);
#pragma unroll
        for (int e = 0; e < 8; ++e) kk[e] *= inv;
        if (act) {
            const size_t o = (size_t)t * RW + lane * 8;
            *(u32x4*)(p.R + o) = pack8(rv); *(u32x4*)(p.KS + o) = pack8(kv); *(u32x4*)(p.V + o) = pack8(vv); *(u32x4*)(p.KK + o) = pack8(kk);
        }
        if (act2) {
            const int cc = lane * 8;
            if (cc < 128) {
#pragma unroll
                for (int e = 0; e < 8; ++e) lr[e] = tanhf_(lr[e]);
                *(u32x4*)(p.LR + (size_t)t * 256 + cc) = pack8(lr);
            } else if (cc < 256) {
                *(u32x4*)(p.LR + (size_t)t * 256 + cc) = pack8(lr);
            } else {
#pragma unroll
                for (int e = 0; e < 8; ++e) lr[e] = sigmoidf_(lr[e]);
                *(u32x4*)(p.GS + (size_t)t * 128 + cc - 256) = pack8(lr);
            }
        }
    }
}
__device__ __forceinline__ void phase_rwkv_prep2(const P& p, int l, char* smem) {
    const int ntm = MTOT / 128, ntn = NPAD(RW) / 128;
    const float* k_a = p.in[I_RKA] + (size_t)l * RW;
    const float* r_k = p.in[I_RRK] + (size_t)l * RW;
    for (int job = obid(); job < ntm * ntn * 2; job += gridDim.x) {
        const int d = job % 2, n0 = ((job / 2) % ntn) * 128, m0 = (job / (2 * ntn)) * 128;
        const float* w0 = p.in[I_RW0] + (size_t)(l * 2 + d) * RW;
        const float* a0 = p.in[I_RA0] + (size_t)(l * 2 + d) * RW;
        f32x4 accw[4][4], acca[4][4]; ZERO_ACC4(accw); ZERO_ACC4(acca);
        mfma_gemm_tile(p.WT_W2 + (size_t)d * NPAD(RW) * 64, 64, p.LR + d * 64, 256, 64, n0, m0, (bf16_t*)smem, accw);
        mfma_gemm_tile(p.WT_A2 + (size_t)d * NPAD(RW) * 64, 64, p.LR + 128 + d * 64, 256, 64, n0, m0, (bf16_t*)smem, acca);
        const int lane = otid() & 63, wave = otid() >> 6;
#pragma unroll
        for (int mi = 0; mi < 4; ++mi) {
            const int m = m0 + (wave & 1) * 64 + mi * 16 + (lane & 15);
            float bon = 0.f;
#pragma unroll
            for (int ni = 0; ni < 4; ++ni) {
                const int n = n0 + (wave >> 1) * 64 + ni * 16 + (lane >> 4) * 4;
                if (n < RW) {
                    const u32x2 kq = *(const u32x2*)(p.KS + (size_t)m * RW + n), kkq = *(const u32x2*)(p.KK + (size_t)m * RW + n), rq = *(const u32x2*)(p.R + (size_t)m * RW + n);
                    const float kv[4] = {LO16(kq.x), HI16(kq.x), LO16(kq.y), HI16(kq.y)};
                    const float kkv[4] = {LO16(kkq.x), HI16(kkq.x), LO16(kkq.y), HI16(kkq.y)};
                    const float rv[4] = {LO16(rq.x), HI16(rq.x), LO16(rq.y), HI16(rq.y)};
                    float lw[4], kd[4], bb[4];
#pragma unroll
                    for (int e = 0; e < 4; ++e) {
                        const float x = w0[n + e] + accw[ni][mi][e];
                        lw[e] = -fexp_(-softplusf_(-x) - 0.5f);
                        const float aa = sigmoidf_(a0[n + e] + acca[ni][mi][e]);
                        kd[e] = kv[e] * (1.0f + (aa - 1.0f) * k_a[n + e]);
                        bb[e] = kkv[e] * aa;
                        bon += rv[e] * kd[e] * r_k[n + e];
                    }
                    const size_t o = ((size_t)d * MTOT + m) * RW + n;
                    float4 lo4; lo4.x = lw[0]; lo4.y = lw[1]; lo4.z = lw[2]; lo4.w = lw[3];
                    *(float4*)(p.LW + o) = lo4;
                    *(u32x2*)(p.KD + o) = pack4(kd[0], kd[1], kd[2], kd[3]);
                    *(u32x2*)(p.BB + o) = pack4(bb[0], bb[1], bb[2], bb[3]);
                }
            }
            bon += __shfl_xor(bon, 16, 64); bon += __shfl_xor(bon, 32, 64);
            const int hh = (n0 + (wave >> 1) * 64) >> 6;
            if ((lane >> 4) == 0 && hh < RH) p.BONUS[((size_t)d * MTOT + m) * RH + hh] = bon;
        }
    }
}

#define CH_ROW 72
#define SEQ_REC 16640
#define CH_SLOT (64 * CH_ROW)
#define CH_XR_OFF (7 * CH_SLOT * 2)
#define CH_AAB_OFF (CH_XR_OFF + 64 * 132 * 4)
#define CH_GC_OFF (CH_AAB_OFF + 64 * 72 * 4)
template <int MT, int NT>
__device__ __forceinline__ void lds_mm(const bf16_t* A, int m0, const bf16_t* Bt, int n0, f32x4 (&acc)[MT][NT]) {
    const int lane = otid() & 63, q = lane >> 4, r = lane & 15;
#pragma unroll
    for (int s = 0; s < 2; ++s) {
        bf16x8 a[MT], b[NT];
#pragma unroll
        for (int i = 0; i < MT; ++i) a[i] = *(const bf16x8*)(A + (m0 + i * 16 + r) * CH_ROW + s * 32 + q * 8);
#pragma unroll
        for (int i = 0; i < NT; ++i) b[i] = *(const bf16x8*)(Bt + (n0 + i * 16 + r) * CH_ROW + s * 32 + q * 8);
#pragma unroll
        for (int i = 0; i < MT; ++i)
#pragma unroll
            for (int jj = 0; jj < NT; ++jj) acc[i][jj] = MFMA16(a[i], b[jj], acc[i][jj]);
    }
}
__device__ __forceinline__ void rwkv_chunk_job(const P& p, int job, char* smem) {
    const int tid = otid(), lane = tid & 63, wv = tid >> 6, q = lane >> 4, r = lane & 15;
    const int d = job / (NC * RH), n = (job / RH) % NC, h = job % RH;
    const size_t base = (size_t)(d * NC + n) * RH + h;
    bf16_t* S0 = (bf16_t*)smem; bf16_t* S1 = S0 + CH_SLOT; bf16_t* S2 = S1 + CH_SLOT; bf16_t* S3 = S2 + CH_SLOT;
    bf16_t* S4 = S3 + CH_SLOT; bf16_t* S5 = S4 + CH_SLOT; bf16_t* S6 = S5 + CH_SLOT;
    float* X = (float*)(smem + CH_XR_OFF);
    float* AABt = (float*)(smem + CH_AAB_OFF);
    bf16_t* U0t = (bf16_t*)(smem + CH_AAB_OFF);
    bf16_t* Aht = U0t + CH_SLOT;
    float* GC = (float*)(smem + CH_GC_OFF);
    __syncthreads();
    u32x4 gkk[2], gr[2], gv[2], gkd[2], gbb[2]; float lw[2][8];
#pragma unroll
    for (int it = 0; it < 2; ++it) {
        const int c = tid + 256 * it, i = c >> 3, k0 = (c & 7) * 8; const int tok = 64 * n + (d ? 63 - i : i);
        const size_t o1 = (size_t)tok * RW + h * 64 + k0, o2 = ((size_t)d * MTOT + tok) * RW + h * 64 + k0;
        load8f(p.LW + o2, lw[it]);
        gkk[it] = *(const u32x4*)(p.KK + o1); gr[it] = *(const u32x4*)(p.R + o1); gv[it] = *(const u32x4*)(p.V + o1);
        gkd[it] = *(const u32x4*)(p.KD + o2); gbb[it] = *(const u32x4*)(p.BB + o2);
    }
#pragma unroll
    for (int it = 0; it < 2; ++it) { const int c = tid + 256 * it; store8f(X + (c >> 3) * 132 + (c & 7) * 8, lw[it]); }
    __syncthreads();
    {
        const int k = tid & 63, seg = tid >> 6;
        float v[16]; float run = 0.f;
#pragma unroll
        for (int e = 0; e < 16; ++e) { run += X[(seg * 16 + e) * 132 + k]; v[e] = run; }
        AABt[seg * 64 + k] = run;
        __syncthreads();
        float off = 0.f;
        for (int s2 = 0; s2 < seg; ++s2) off += AABt[s2 * 64 + k];
#pragma unroll
        for (int e = 0; e < 16; ++e) X[(seg * 16 + e) * 132 + k] = v[e] + off;
    }
    __syncthreads();
#pragma unroll
    for (int it = 0; it < 2; ++it) {
        const int c = tid + 256 * it, i = c >> 3, k0 = (c & 7) * 8;
        float L[8], Lp[8], LC[8], kkv[8], rv[8], vv[8], kdv[8], bbv[8];
        load8f(X + i * 132 + k0, L); load8f(X + 63 * 132 + k0, LC);
        if (i > 0) load8f(X + (i - 1) * 132 + k0, Lp);
        else {
#pragma unroll
            for (int e = 0; e < 8; ++e) Lp[e] = 0.f;
        }
        unpack8(gkk[it], kkv); unpack8(gr[it], rv); unpack8(gv[it], vv); unpack8(gkd[it], kdv); unpack8(gbb[it], bbv);
        float at[8], rt[8], bt[8], kt[8], bh[8], kh[8];
#pragma unroll
        for (int e = 0; e < 8; ++e) {
            const float eL = fexp_(L[e]), eLp = fexp_(Lp[e]), eNL = fexp_(-L[e]), eCL = fexp_(LC[e] - L[e]);
            at[e] = -kkv[e] * eLp; rt[e] = rv[e] * eL; bt[e] = bbv[e] * eNL; kt[e] = kdv[e] * eNL; bh[e] = bbv[e] * eCL; kh[e] = kdv[e] * eCL;
            if (i == 63) GC[k0 + e] = eL;
        }
        *(u32x4*)(S0 + i * CH_ROW + k0) = pack8(at);
        store8f(X + i * 132 + 64 + k0, at);
        *(u32x4*)(S1 + i * CH_ROW + k0) = pack8(rt);
        *(u32x4*)(S2 + i * CH_ROW + k0) = pack8(bt);
        *(u32x4*)(S3 + i * CH_ROW + k0) = pack8(kt);
#pragma unroll
        for (int e = 0; e < 8; ++e) {
            S4[(k0 + e) * CH_ROW + i] = f2bf(vv[e]);
            S5[(k0 + e) * CH_ROW + i] = f2bf(bh[e]);
            S6[(k0 + e) * CH_ROW + i] = f2bf(kh[e]);
        }
    }
    __syncthreads();
    {
        f32x4 acc[4][4]; ZERO_ACC4(acc);
        lds_mm<4, 4>((wv < 2) ? S0 : S1, 0, (wv & 1) ? S3 : S2, 0, acc);
        __syncthreads();
#pragma unroll
        for (int mt = 0; mt < 4; ++mt)
#pragma unroll
            for (int nt = 0; nt < 4; ++nt) {
                const int jc = nt * 16 + r, i0 = mt * 16 + 4 * q;
                if (wv == 0) {
                    f32x4 o;
#pragma unroll
                    for (int e = 0; e < 4; ++e) o[e] = (jc < i0 + e) ? acc[mt][nt][e] : 0.f;
                    *(f32x4*)(AABt + jc * 72 + i0) = o;
                } else {
                    bf16_t* dst = (wv == 1) ? S0 : ((wv == 2) ? S2 : S3);
#pragma unroll
                    for (int e = 0; e < 4; ++e) {
                        const bool ok = (wv == 1) ? (jc < i0 + e) : (jc <= i0 + e);
                        dst[(i0 + e) * CH_ROW + jc] = f2bf(ok ? acc[mt][nt][e] : 0.f);
                    }
                }
            }
    }
    __syncthreads();
    {
        f32x4 acc[1][4];
#pragma unroll
        for (int nt = 0; nt < 4; ++nt) acc[0][nt] = (f32x4){0.f, 0.f, 0.f, 0.f};
        lds_mm<1, 4>(S0, 16 * wv, S4, 0, acc);
#pragma unroll
        for (int nt = 0; nt < 4; ++nt)
#pragma unroll
            for (int e = 0; e < 4; ++e) X[(16 * wv + 4 * q + e) * 132 + nt * 16 + r] = acc[0][nt][e];
    }
    __syncthreads();
    if (tid < 128) {
        const int c = tid;
        for (int bi = 0; bi < 4; ++bi) {
            float acc[16];
#pragma unroll
            for (int e = 0; e < 16; ++e) acc[e] = X[(16 * bi + e) * 132 + c];
            for (int jj = 0; jj < 16 * bi; ++jj) {
                const float uj = X[jj * 132 + c];
                const f32x4* ap = (const f32x4*)(AABt + jj * 72 + 16 * bi);
                const f32x4 a0 = ap[0], a1 = ap[1], a2 = ap[2], a3 = ap[3];
#pragma unroll
                for (int e = 0; e < 4; ++e) { acc[e] += a0[e] * uj; acc[4 + e] += a1[e] * uj; acc[8 + e] += a2[e] * uj; acc[12 + e] += a3[e] * uj; }
            }
#pragma unroll
            for (int e = 0; e < 16; ++e) {
                const float u = acc[e];
                X[(16 * bi + e) * 132 + c] = u;
                const f32x4* ap = (const f32x4*)(AABt + (16 * bi + e) * 72 + 16 * bi);
                const f32x4 a0 = ap[0], a1 = ap[1], a2 = ap[2], a3 = ap[3];
#pragma unroll
                for (int e2 = 0; e2 < 16; ++e2) if (e2 > e) acc[e2] += ((e2 < 4) ? a0[e2 & 3] : (e2 < 8) ? a1[e2 & 3] : (e2 < 12) ? a2[e2 & 3] : a3[e2 & 3]) * u;
            }
        }
    }
    __syncthreads();
    if (tid < 128) {
        const int c = tid;
        bf16_t* dst = (c < 64) ? (U0t + c * CH_ROW) : (Aht + (c - 64) * CH_ROW);
        u32x4 ov[8];
#pragma unroll
        for (int g = 0; g < 8; ++g) {
            float v[8];
#pragma unroll
            for (int e = 0; e < 8; ++e) v[e] = X[(g * 8 + e) * 132 + c];
            ov[g].x = pack2bf(v[0], v[1]); ov[g].y = pack2bf(v[2], v[3]);
            ov[g].z = pack2bf(v[4], v[5]); ov[g].w = pack2bf(v[6], v[7]);
        }
#pragma unroll
        for (int g = 0; g < 8; ++g) *(u32x4*)(dst + g * 8) = ov[g];
    }
    __syncthreads();
    {
        f32x4 acc[4][4]; ZERO_ACC4(acc);
        char* rec = p.REC + base * SEQ_REC;
        if (wv == 0) {
            lds_mm<4, 4>(Aht, 0, S5, 0, acc);
#pragma unroll
            for (int nt = 0; nt < 4; ++nt)
#pragma unroll
                for (int s2 = 0; s2 < 2; ++s2) {
                    u32x4 o;
                    o.x = pack2bf(acc[2 * s2][nt][0], acc[2 * s2][nt][1]); o.y = pack2bf(acc[2 * s2][nt][2], acc[2 * s2][nt][3]);
                    o.z = pack2bf(acc[2 * s2 + 1][nt][0], acc[2 * s2 + 1][nt][1]); o.w = pack2bf(acc[2 * s2 + 1][nt][2], acc[2 * s2 + 1][nt][3]);
                    *(u32x4*)(rec + (((nt * 2 + s2) * 64 + lane) * 8) * 2) = o;
                }
        } else if (wv == 1) {
            lds_mm<4, 4>(S5, 0, U0t, 0, acc);
            lds_mm<4, 4>(S6, 0, S4, 0, acc);
#pragma unroll
            for (int mt = 0; mt < 4; ++mt)
#pragma unroll
                for (int nt = 0; nt < 4; ++nt) *(u32x2*)(rec + 8192 + (((nt * 4 + mt) * 64 + lane) * 4) * 2) = pack4(acc[mt][nt][0], acc[mt][nt][1], acc[mt][nt][2], acc[mt][nt][3]);
        } else if (wv == 2) {
            lds_mm<4, 4>(S2, 0, Aht, 0, acc);
#pragma unroll
            for (int mt = 0; mt < 4; ++mt)
#pragma unroll
                for (int nt = 0; nt < 4; ++nt)
#pragma unroll
                    for (int e = 0; e < 4; ++e) {
                        const int t = mt * 16 + 4 * q + e, kc = nt * 16 + r;
                        p.QH[(base * 64 + t) * 64 + kc] = f2bf(acc[mt][nt][e] + bf2f(S1[t * CH_ROW + kc]));
                    }
        } else if (wv == 3) {
            lds_mm<4, 4>(S2, 0, U0t, 0, acc);
            lds_mm<4, 4>(S3, 0, S4, 0, acc);
#pragma unroll
            for (int mt = 0; mt < 4; ++mt)
#pragma unroll
                for (int nt = 0; nt < 4; ++nt) *(f32x4*)(p.Y0T + (((base * 4 + mt) * 4 + nt) * 64 + lane) * 4) = acc[mt][nt];
        }
        if (tid < 64) ((float*)(rec + 16384))[tid] = GC[tid];
    }
}

#define SEQ_SLOT 16896
__device__ __forceinline__ void rwkv_seq_gload(const P& p, size_t base, int tid, u32x4 (&g)[5]) {
    const u32x4* m = (const u32x4*)(p.REC + base * SEQ_REC);
#pragma unroll
    for (int i = 0; i < 4; ++i) g[i] = m[tid + 256 * i];
    if (tid < 16) g[4] = m[1024 + tid];
}
__device__ __forceinline__ void rwkv_seq_lstore(char* slot, int tid, const u32x4 (&g)[5]) {
    u32x4* d = (u32x4*)slot;
#pragma unroll
    for (int i = 0; i < 4; ++i) d[tid + 256 * i] = g[i];
    if (tid < 16) d[1024 + tid] = g[4];
}
__device__ __forceinline__ void rwkv_seq_step(const P& p, const char* slot, size_t base, int wv, int lane, f32x4 (&X)[4]) {
    const int q = lane >> 4, r = lane & 15;
    const bf16_t* mt = (const bf16_t*)slot; const bf16_t* ntb = (const bf16_t*)(slot + 8192); const float* gc = (const float*)(slot + 16384);
    unsigned xh[4][2];
#pragma unroll
    for (int kt = 0; kt < 4; ++kt) {
        xh[kt][0] = pack2bf(X[kt][0], X[kt][1]); xh[kt][1] = pack2bf(X[kt][2], X[kt][3]);
        *(u32x2*)(p.SN + (base * 64 + 16 * wv + r) * 64 + 16 * kt + 4 * q) = (u32x2){xh[kt][0], xh[kt][1]};
    }
    bf16x8 bh[2];
#pragma unroll
    for (int s2 = 0; s2 < 2; ++s2) bh[s2] = __builtin_bit_cast(bf16x8, ((u32x4){xh[2 * s2][0], xh[2 * s2][1], xh[2 * s2 + 1][0], xh[2 * s2 + 1][1]}));
#pragma unroll
    for (int tile = 0; tile < 4; ++tile) {
        const u32x2 nb = *(const u32x2*)(ntb + ((wv * 4 + tile) * 64 + lane) * 4);
        const f32x4 g4 = *(const f32x4*)(gc + tile * 16 + 4 * q);
        f32x4 acc;
        acc[0] = g4[0] * X[tile][0] + LO16(nb.x); acc[1] = g4[1] * X[tile][1] + HI16(nb.x);
        acc[2] = g4[2] * X[tile][2] + LO16(nb.y); acc[3] = g4[3] * X[tile][3] + HI16(nb.y);
#pragma unroll
        for (int s2 = 0; s2 < 2; ++s2) {
            const bf16x8 ah = *(const bf16x8*)(mt + ((tile * 2 + s2) * 64 + lane) * 8);
            acc = MFMA16(ah, bh[s2], acc);
        }
        X[tile] = acc;
    }
}
__device__ __forceinline__ void rwkv_seq_job(const P& p, int job, char* smem) {
    const int tid = otid(), lane = tid & 63, wv = tid >> 6;
    const int d = job / RH, h = job % RH;
    f32x4 X[4];
#pragma unroll
    for (int kt = 0; kt < 4; ++kt) X[kt] = (f32x4){0.f, 0.f, 0.f, 0.f};
    u32x4 g0[5], g1[5], g2[5];
#define SEQ_BASE(s_) ((size_t)(d * NC + chunk_order(d, ((s_) < NC) ? (s_) : NC - 1)) * RH + h)
    __syncthreads();
    rwkv_seq_gload(p, SEQ_BASE(0), tid, g0);
    rwkv_seq_gload(p, SEQ_BASE(1), tid, g1);
    rwkv_seq_gload(p, SEQ_BASE(2), tid, g2);
    rwkv_seq_lstore(smem, tid, g0);
    __syncthreads();
    for (int s = 0; s < NC; s += 6) {
#define SEQ_SUB(u, GFREE, GNEXT) \
        if (s + (u) < NC) { \
            rwkv_seq_gload(p, SEQ_BASE(s + (u) + 3), tid, GFREE); \
            rwkv_seq_step(p, smem + (((u) & 1) ? SEQ_SLOT : 0), SEQ_BASE(s + (u)), wv, lane, X); \
            rwkv_seq_lstore(smem + (((u) & 1) ? 0 : SEQ_SLOT), tid, GNEXT); \
        } \
        __syncthreads();
        SEQ_SUB(0, g0, g1)
        SEQ_SUB(1, g1, g2)
        SEQ_SUB(2, g2, g0)
        SEQ_SUB(3, g0, g1)
        SEQ_SUB(4, g1, g2)
        SEQ_SUB(5, g2, g0)
#undef SEQ_SUB
    }
#undef SEQ_BASE
}
struct RoBuf { bf16x8 a[2]; bf16x8 b[4][2]; f32x4 y0[4]; };
__device__ __forceinline__ void rwkv_out_load(const P& p, int job, int wv, int lane, RoBuf& o) {
    const int q = lane >> 4, r = lane & 15;
    const size_t base = (size_t)job;
#pragma unroll
    for (int s2 = 0; s2 < 2; ++s2) {
        o.a[s2] = *(const bf16x8*)(p.QH + (base * 64 + 16 * wv + r) * 64 + s2 * 32 + q * 8);
#pragma unroll
        for (int nt = 0; nt < 4; ++nt) o.b[nt][s2] = *(const bf16x8*)(p.SN + (base * 64 + nt * 16 + r) * 64 + s2 * 32 + q * 8);
    }
#pragma unroll
    for (int nt = 0; nt < 4; ++nt) o.y0[nt] = *(const f32x4*)(p.Y0T + (((base * 4 + wv) * 4 + nt) * 64 + lane) * 4);
}
__device__ __forceinline__ void rwkv_out_compute(const P& p, int job, int wv, int lane, const RoBuf& o) {
    const int q = lane >> 4, r = lane & 15;
    const int d = job / (NC * RH), n = (job / RH) % NC, h = job % RH;
#pragma unroll
    for (int nt = 0; nt < 4; ++nt) {
        f32x4 acc = o.y0[nt];
        acc = MFMA16(o.a[0], o.b[nt][0], acc);
        acc = MFMA16(o.a[1], o.b[nt][1], acc);
#pragma unroll
        for (int e = 0; e < 4; ++e) {
            const int t = 16 * wv + 4 * q + e; const int tok = 64 * n + (d ? 63 - t : t);
            p.Y[((size_t)d * MTOT + tok) * RW + h * 64 + nt * 16 + r] = acc[e];
        }
    }
}
__device__ __forceinline__ void phase_rwkv_out(const P& p) {
    const int tid = otid(), lane = tid & 63, wv = tid >> 6;
    if (wv >= 4) return;
    const int G = gridDim.x, total = 2 * NC * RH;
    int job = obid();
    if (job >= total) return;
    RoBuf b0, b1;
    rwkv_out_load(p, job, wv, lane, b0);
    for (; job < total; job += 2 * G) {
        if (job + G < total) rwkv_out_load(p, job + G, wv, lane, b1);
        rwkv_out_compute(p, job, wv, lane, b0);
        if (job + G < total) {
            if (job + 2 * G < total) rwkv_out_load(p, job + 2 * G, wv, lane, b0);
            rwkv_out_compute(p, job + G, wv, lane, b1);
        }
    }
}

#define GL_QR 0
#define GL_KR 9216
#define GL_VT 18432
#define GL_QI 36864
#define GL_KI 46080
#define GL_AT 55296
#define GL_CUM 64512
#define GL_ALR 81920
#define GL_WA 86016
__device__ __forceinline__ void gla_load_qkv(const P& p, int n, int h, char* smem) {
    const int tid = otid();
    bf16_t* Qr = (bf16_t*)(smem + GL_QR); bf16_t* Kr = (bf16_t*)(smem + GL_KR); bf16_t* Vt = (bf16_t*)(smem + GL_VT);
    for (int c = tid; c < 512; c += NTHREADS) {
        const int row = c >> 3, part = c & 7; const int t = gla_tok(n, row);
        const u32x4 qv = *(const u32x4*)(p.Z + (size_t)t * ZLD + ZQ + h * 64 + part * 8);
        const u32x4 kv = *(const u32x4*)(p.Z + (size_t)t * ZLD + ZK + h * 64 + part * 8);
        u32x4 qs;
        qs.x = pack2bf(LO16(qv.x) * 0.125f, HI16(qv.x) * 0.125f);
        qs.y = pack2bf(LO16(qv.y) * 0.125f, HI16(qv.y) * 0.125f);
        qs.z = pack2bf(LO16(qv.z) * 0.125f, HI16(qv.z) * 0.125f);
        qs.w = pack2bf(LO16(qv.w) * 0.125f, HI16(qv.w) * 0.125f);
        *(u32x4*)(Qr + row * CH_ROW + part * 8) = qs;
        *(u32x4*)(Kr + row * CH_ROW + part * 8) = kv;
    }
    for (int c = tid; c < 1024; c += NTHREADS) {
        const int row = c >> 4, part = c & 15; const int t = gla_tok(n, row);
        const u32x4 vv = *(const u32x4*)(p.Z + (size_t)t * ZLD + ZV + h * 128 + part * 8);
        bf16_t* dst = Vt + (part * 8) * CH_ROW + row;
        dst[0 * CH_ROW] = (bf16_t)(vv.x & 0xFFFF); dst[1 * CH_ROW] = (bf16_t)(vv.x >> 16);
        dst[2 * CH_ROW] = (bf16_t)(vv.y & 0xFFFF); dst[3 * CH_ROW] = (bf16_t)(vv.y >> 16);
        dst[4 * CH_ROW] = (bf16_t)(vv.z & 0xFFFF); dst[5 * CH_ROW] = (bf16_t)(vv.z >> 16);
        dst[6 * CH_ROW] = (bf16_t)(vv.w & 0xFFFF); dst[7 * CH_ROW] = (bf16_t)(vv.w >> 16);
    }
}
__device__ __forceinline__ void gla_cum(const P& p, int l, int n, int h, int d, char* smem) {
    const int tid = otid();
    float* CUM = (float*)(smem + GL_CUM); float* ALR = (float*)(smem + GL_ALR); float* WA = (float*)(smem + GL_WA);
    for (int c = tid; c < 256; c += NTHREADS) {
        const int row = c >> 2, part = c & 3; const int t = gla_tok(n, row);
        const u32x2 a = *(const u32x2*)(p.Z + (size_t)t * ZLD + (d ? ZAB : ZAF) + part * 4);
        float* dst = ALR + row * 16 + part * 4;
        dst[0] = LO16(a.x); dst[1] = HI16(a.x); dst[2] = LO16(a.y); dst[3] = HI16(a.y);
    }
    for (int c = tid; c < 16 * 64 + 64; c += NTHREADS) {
        if (c < 1024) WA[c] = p.in[I_GLA_WA2][((size_t)(l * 2 + d) * 16 + (c >> 6)) * GLA_K + h * 64 + (c & 63)];
        else WA[c] = p.in[I_GLA_BA][(size_t)(l * 2 + d) * GLA_K + h * 64 + (c - 1024)];
    }
    __syncthreads();
    for (int idx = tid; idx < 4096; idx += NTHREADS) {
        const int i = idx >> 6, k = idx & 63;
        float a = WA[1024 + k];
#pragma unroll
        for (int r = 0; r < 16; ++r) a += ALR[i * 16 + r] * WA[r * 64 + k];
        CUM[i * 68 + k] = (fminf(a, 0.f) - flog_(1.0f + fexp_(-fabsf(a)))) * (1.0f / 16.0f);
    }
    __syncthreads();
    {
        const int k = tid & 63, seg = (tid >> 6) & 3;
        float v[16]; float run = 0.f;
        if (tid < 256) {
#pragma unroll
            for (int e = 0; e < 16; ++e) { const int pos = seg * 16 + e; const int i = d ? 63 - pos : pos; run += CUM[i * 68 + k]; v[e] = run; }
            ALR[seg * 64 + k] = run;
        }
        __syncthreads();
        if (tid < 256) {
            float off = 0.f;
            for (int s2 = 0; s2 < seg; ++s2) off += ALR[s2 * 64 + k];
#pragma unroll
            for (int e = 0; e < 16; ++e) { const int pos = seg * 16 + e; const int i = d ? 63 - pos : pos; CUM[i * 68 + k] = v[e] + off; }
        }
    }
    __syncthreads();
}
__device__ __forceinline__ void phase_gla_kv(const P& p, int l, char* smem) {
    const int tid = otid(), lane = tid & 63, wv = tid >> 6, q = lane >> 4, r = lane & 15;
    bf16_t* Kr = (bf16_t*)(smem + GL_KR); bf16_t* Vt = (bf16_t*)(smem + GL_VT); bf16_t* KdT = (bf16_t*)(smem + GL_KI);
    float* CUM = (float*)(smem + GL_CUM);
    for (int job = obid(); job < NC * GH; job += gridDim.x) {
        const int n = job / GH, h = job % GH;
        __syncthreads();
        gla_load_qkv(p, n, h, smem);
        for (int d = 0; d < 2; ++d) {
            gla_cum(p, l, n, h, d, smem);
            const int li = d ? 0 : 63;
            for (int idx = tid; idx < 4096; idx += NTHREADS) {
                const int i = idx >> 6, k = idx & 63;
                KdT[k * CH_ROW + i] = f2bf(bf2f(Kr[i * CH_ROW + k]) * fexp_(CUM[li * 68 + k] - CUM[i * 68 + k]));
            }
            if (tid < 64) p.DEC[((size_t)(d * NC + n) * GH + h) * 64 + tid] = fexp_(CUM[li * 68 + tid]);
            __syncthreads();
            float* kvt = p.KV + ((size_t)(d * NC + n) * GH + h) * 8192;
            for (int mt = wv; mt < 4; mt += NTHREADS / 64) {
                f32x4 acc[1][8];
#pragma unroll
                for (int nt = 0; nt < 8; ++nt) acc[0][nt] = (f32x4){0.f, 0.f, 0.f, 0.f};
                lds_mm<1, 8>(KdT, 16 * mt, Vt, 0, acc);
#pragma unroll
                for (int nt = 0; nt < 8; ++nt) *(f32x4*)(kvt + (size_t)(nt * 16 + r) * 64 + 16 * mt + 4 * q) = acc[0][nt];
            }
            __syncthreads();
        }
    }
    __syncthreads();
}
__device__ __forceinline__ void gla_scan_job(const P& p, int job) {
    const int base = job * NTHREADS + otid();
    const int d = base / (GH * 8192), h = (base / 8192) % GH, e = base % 8192;
    const float* __restrict__ kvp = p.KV; const float* __restrict__ decp = p.DEC; bf16_t* __restrict__ sp = p.SP;
    float S = 0.f;
    for (int s = 0; s < NC; s += 4) {
        float kv[4], dc[4]; size_t oo[4];
#pragma unroll
        for (int u = 0; u < 4; ++u) {
            const int n = chunk_order(d, (s + u < NC) ? s + u : NC - 1);
            oo[u] = ((size_t)(d * NC + n) * GH + h);
            kv[u] = kvp[oo[u] * 8192 + e]; dc[u] = decp[oo[u] * 64 + (e & 63)];
        }
#pragma unroll
        for (int u = 0; u < 4; ++u) if (s + u < NC) { sp[oo[u] * 8192 + e] = f2bf(S); S = dc[u] * S + kv[u]; }
    }
}
__device__ __forceinline__ void phase_gla_out(const P& p, int l, char* smem) {
    const int tid = otid(), lane = tid & 63, wv = tid >> 6, q = lane >> 4, r = lane & 15;
    bf16_t* Qr = (bf16_t*)(smem + GL_QR); bf16_t* Kr = (bf16_t*)(smem + GL_KR); bf16_t* Vt = (bf16_t*)(smem + GL_VT);
    bf16_t* Qi = (bf16_t*)(smem + GL_QI); bf16_t* Ki = (bf16_t*)(smem + GL_KI); bf16_t* At = (bf16_t*)(smem + GL_AT);
    float* CUM = (float*)(smem + GL_CUM);
    for (int job = obid(); job < NC * GH; job += gridDim.x) {
        const int n = job / GH, h = job % GH;
        __syncthreads();
        gla_load_qkv(p, n, h, smem);
        f32x4 o[1][8];
#pragma unroll
        for (int nt = 0; nt < 8; ++nt) o[0][nt] = (f32x4){0.f, 0.f, 0.f, 0.f};
        for (int d = 0; d < 2; ++d) {
            gla_cum(p, l, n, h, d, smem);
            for (int idx = tid; idx < 4096; idx += NTHREADS) {
                const int i = idx >> 6, k = idx & 63; const float c = CUM[i * 68 + k];
                Qi[i * CH_ROW + k] = f2bf(bf2f(Qr[i * CH_ROW + k]) * fexp_(c));
                Ki[i * CH_ROW + k] = f2bf(bf2f(Kr[i * CH_ROW + k]) * fexp_(-c));
            }
            __syncthreads();
            if (wv < 4) {
                f32x4 a[1][4];
#pragma unroll
                for (int nt = 0; nt < 4; ++nt) a[0][nt] = (f32x4){0.f, 0.f, 0.f, 0.f};
                lds_mm<1, 4>(Qi, 16 * wv, Ki, 0, a);
#pragma unroll
                for (int nt = 0; nt < 4; ++nt)
#pragma unroll
                    for (int e = 0; e < 4; ++e) {
                        const int i = 16 * wv + 4 * q + e, j = nt * 16 + r;
                        const bool ok = d ? (j >= i) : (j <= i);
                        At[i * CH_ROW + j] = f2bf(ok ? a[0][nt][e] : 0.f);
                    }
                WAVE_SYNC();
                lds_mm<1, 8>(At, 16 * wv, Vt, 0, o);
                const bf16_t* sp = p.SP + ((size_t)(d * NC + n) * GH + h) * 8192;
#pragma unroll
                for (int s2 = 0; s2 < 2; ++s2) {
                    const bf16x8 af = *(const bf16x8*)(Qi + (16 * wv + r) * CH_ROW + s2 * 32 + q * 8);
#pragma unroll
                    for (int nt = 0; nt < 8; ++nt) {
                        const bf16x8 bfr = *(const bf16x8*)(sp + (size_t)(nt * 16 + r) * 64 + s2 * 32 + q * 8);
                        o[0][nt] = MFMA16(af, bfr, o[0][nt]);
                    }
                }
            }
            __syncthreads();
        }
        if (wv < 4) {
#pragma unroll
            for (int nt = 0; nt < 8; ++nt)
#pragma unroll
                for (int e = 0; e < 4; ++e) {
                    const int t = gla_tok(n, 16 * wv + 4 * q + e);
                    p.OGLA[(size_t)t * GLA_V + h * 128 + nt * 16 + r] = o[0][nt][e];
                }
        }
    }
    __syncthreads();
}

#define S5_XH_OFF (2 * 64 * 132 * 4)
#define S5_XL_OFF (S5_XH_OFF + 64 * 136 * 2)
#define S5_CT_OFF (S5_XL_OFF + 64 * 136 * 2)
__device__ __forceinline__ void phase_s5_pass(const P& p, int l, char* smem, bool with_out) {
    const int tid = otid(), lane = tid & 63, wv = tid >> 6, q = lane >> 4, r = lane & 15;
    float* BU = (float*)smem; bf16_t* XH = (bf16_t*)(smem + S5_XH_OFF); bf16_t* XL = (bf16_t*)(smem + S5_XL_OFF); bf16_t* CTp = (bf16_t*)(smem + S5_CT_OFF);
    const int dW = (wv >> 1) & 1, ntb = (wv & 1) * 4;
    const int dS = (tid >> 6) & 1, st = tid & 63;
    bf16x8 bhi[4], blo[4];
    float are = 0.f, aim = 0.f, dco = 0.f;
    int cur_g = -1;
    const bf16x8 zero8 = {0, 0, 0, 0, 0, 0, 0, 0};
    bf16x8 a_cur[4]; float2 car_cur = {0.f, 0.f};
#define S5_FETCH(JOB, A, CAR) { const int n_ = (JOB) / SG, g_ = (JOB) % SG; \
        if (wv < 4) { _Pragma("unroll") for (int mt = 0; mt < 4; ++mt) A[mt] = (q < 2) ? *(const bf16x8*)(p.Z + (size_t)(n_ * 64 + 16 * mt + r) * ZLD + ZS5 + g_ * 16 + 8 * q) : zero8; } \
        if (with_out && tid < 128) CAR = *(const float2*)(p.S5CAR + ((((size_t)dS * NC + n_) * SG + g_) * 64 + st) * 2); }
    if (obid() < NC * SG) S5_FETCH(obid(), a_cur, car_cur);
    for (int job = obid(); job < NC * SG; job += gridDim.x) {
        const int n = job / SG, g = job % SG;
        __syncthreads();
        if (g != cur_g) {
            cur_g = g;
            if (wv < 4) {
#pragma unroll
                for (int jn = 0; jn < 4; ++jn) {
                    const int kk = 16 * (ntb + jn) + r; const size_t ci = ((size_t)dW * SG + g) * 64 + (kk >> 1);
                    float f[8], lo[8];
#pragma unroll
                    for (int e = 0; e < 8; ++e) f[e] = (q < 2) ? p.S5BB[(ci * 16 + 8 * q + e) * 2 + (kk & 1)] : 0.f;
                    const u32x4 hv = pack8(f);
                    float hf[8]; unpack8(hv, hf);
#pragma unroll
                    for (int e = 0; e < 8; ++e) lo[e] = f[e] - hf[e];
                    bhi[jn] = __builtin_bit_cast(bf16x8, hv); blo[jn] = __builtin_bit_cast(bf16x8, pack8(lo));
                }
            }
            if (tid < 128) { const size_t ci = ((size_t)dS * SG + g) * 64 + st; are = p.S5A[ci * 2]; aim = p.S5A[ci * 2 + 1]; }
            if (with_out) {
                for (int idx = tid; idx < 16 * 128; idx += NTHREADS) {
                    const int c = idx >> 7, kk = idx & 127;
                    const float v = (kk & 1) ? -p.in[I_S5CIM][((size_t)l * SG + g) * 1024 + c * 64 + (kk >> 1)] : p.in[I_S5CRE][((size_t)l * SG + g) * 1024 + c * 64 + (kk >> 1)];
                    CTp[c * 136 + kk] = f2bf(v);
                }
                dco = p.in[I_S5D][(size_t)l * SW + g * 16 + r];
            }
        }
        float xr = car_cur.x, xi = car_cur.y;
        const size_t eo = (((size_t)dS * NC + n) * SG + g) * 64 + st;
        unsigned short uu[4] = {0, 0, 0, 0};
        if (with_out && wv < 4) {
#pragma unroll
            for (int e = 0; e < 4; ++e) uu[e] = p.Z[(size_t)(n * 64 + 16 * wv + 4 * q + e) * ZLD + ZS5 + g * 16 + r];
        }
        if (wv < 4) {
#pragma unroll
            for (int mt = 0; mt < 4; ++mt) {
                const bf16x8 a = a_cur[mt];
#pragma unroll
                for (int jn = 0; jn < 4; ++jn) {
                    f32x4 acc = {0.f, 0.f, 0.f, 0.f};
                    acc = MFMA16(a, bhi[jn], acc);
                    acc = MFMA16(a, blo[jn], acc);
#pragma unroll
                    for (int e = 0; e < 4; ++e) BU[(dW * 64 + 16 * mt + 4 * q + e) * 132 + 16 * (ntb + jn) + r] = acc[e];
                }
            }
        }
        if (job + (int)gridDim.x < NC * SG) S5_FETCH(job + (int)gridDim.x, a_cur, car_cur);
        __syncthreads();
        if (tid < 128) {
            float2* bp0 = (float2*)(BU + (dS * 64 + (dS ? 63 : 0)) * 132 + st * 2);
#define S5_SCAN(SGN) { _Pragma("unroll 1") for (int ib = 0; ib < 4; ++ib) { float2 bv[16]; \
                _Pragma("unroll") for (int u = 0; u < 16; ++u) bv[u] = bp0[(SGN) * (ib * 16 + u) * 66]; \
                _Pragma("unroll") for (int u = 0; u < 16; ++u) { \
                    const float nr = are * xr - aim * xi + bv[u].x, ni = are * xi + aim * xr + bv[u].y; xr = nr; xi = ni; \
                    if (with_out) { float2 o; o.x = xr; o.y = xi; bp0[(SGN) * (ib * 16 + u) * 66] = o; } } } }
            if (dS) S5_SCAN(-1) else S5_SCAN(1)
            if (!with_out) { float2 o; o.x = xr; o.y = xi; *(float2*)(p.S5END + eo * 2) = o; }
        }
        if (with_out) {
            __syncthreads();
            for (int cidx = tid; cidx < 64 * 16; cidx += NTHREADS) {
                const int i = cidx >> 4, k0 = (cidx & 15) * 8;
                float a[8], b[8], lo[8];
                load8f(BU + (0 * 64 + i) * 132 + k0, a); load8f(BU + (1 * 64 + i) * 132 + k0, b);
#pragma unroll
                for (int e = 0; e < 8; ++e) a[e] += b[e];
                const u32x4 hv = pack8(a);
                float hf[8]; unpack8(hv, hf);
#pragma unroll
                for (int e = 0; e < 8; ++e) lo[e] = a[e] - hf[e];
                *(u32x4*)(XH + i * 136 + k0) = hv; *(u32x4*)(XL + i * 136 + k0) = pack8(lo);
            }
            __syncthreads();
            if (wv < 4) {
                f32x4 acc = {0.f, 0.f, 0.f, 0.f};
#pragma unroll
                for (int ks = 0; ks < 4; ++ks) {
                    const bf16x8 ah = *(const bf16x8*)(XH + (16 * wv + r) * 136 + ks * 32 + q * 8), al = *(const bf16x8*)(XL + (16 * wv + r) * 136 + ks * 32 + q * 8);
                    const bf16x8 b = *(const bf16x8*)(CTp + r * 136 + ks * 32 + q * 8);
                    acc = MFMA16(ah, b, acc);
                    acc = MFMA16(al, b, acc);
                }
#pragma unroll
                for (int e = 0; e < 4; ++e) {
                    const int i = 16 * wv + 4 * q + e;
                    const float u = bf2f(uu[e]);
                    p.GY[(size_t)(n * 64 + i) * SW + g * 16 + r] = f2bf(geluf_(acc[e] + dco * u));
                }
            }
        }
    }
    __syncthreads();
}
__device__ __forceinline__ void s5_carry_job(const P& p, int job) {
    const int base = job * NTHREADS + otid();
    if (base >= 2 * SG * 64) return;
    const int d = base / (SG * 64), g = (base / 64) % SG, st = base % 64;
    const size_t ci = ((size_t)d * SG + g) * 64 + st;
    float ar = p.S5A[ci * 2], ai = p.S5A[ci * 2 + 1];
    for (int i = 0; i < 6; ++i) { const float nr = ar * ar - ai * ai, ni = 2.f * ar * ai; ar = nr; ai = ni; }
    const float2* __restrict__ endp = (const float2*)p.S5END; float2* __restrict__ carp = (float2*)p.S5CAR;
    float cr = 0.f, cim = 0.f;
    for (int s = 0; s < NC; s += 4) {
        float2 ev[4]; size_t eo[4];
#pragma unroll
        for (int u = 0; u < 4; ++u) {
            const int n = chunk_order(d, (s + u < NC) ? s + u : NC - 1);
            eo[u] = (((size_t)d * NC + n) * SG + g) * 64 + st;
            ev[u] = endp[eo[u]];
        }
#pragma unroll
        for (int u = 0; u < 4; ++u) if (s + u < NC) {
            float2 c; c.x = cr; c.y = cim; carp[eo[u]] = c;
            const float nr = ar * cr - ai * cim + ev[u].x, ni = ar * cim + ai * cr + ev[u].y;
            cr = nr; cim = ni;
        }
    }
}

__device__ __forceinline__ void phase_side_elem(const P& p, int l) {
    const int lane = otid() & 63;
    const int gw = (obid() * NTHREADS + otid()) >> 6, nw = (gridDim.x * NTHREADS) >> 6;
    const bool actg = lane * 8 < GLA_V, actr = lane * 8 < RW;
    float gng[8], lnw[8], lnb[8];
#pragma unroll
    for (int e = 0; e < 8; ++e) { gng[e] = 0.f; lnw[e] = 0.f; lnb[e] = 0.f; }
    if (actg) load8f(p.in[I_GLA_NG] + (size_t)l * 128 + ((lane * 8) & 127), gng);
    if (actr) { load8f(p.in[I_RLNW] + (size_t)l * RW + lane * 8, lnw); load8f(p.in[I_RLNB] + (size_t)l * RW + lane * 8, lnb); }
    for (int t = gw; t < MTOT; t += nw) {
        float og[8], zo[8], y0[8], y1[8], vv[8];
        const u32x4 z4 = {0u, 0u, 0u, 0u};
#pragma unroll
        for (int e = 0; e < 8; ++e) { og[e] = 0.f; y0[e] = 0.f; y1[e] = 0.f; }
        if (actg) load8f(p.OGLA + (size_t)t * GLA_V + lane * 8, og);
        unpack8(actg ? *(const u32x4*)(p.Z + (size_t)t * ZLD + ZOG + lane * 8) : z4, zo);
        if (actr) { load8f(p.Y + (size_t)t * RW + lane * 8, y0); load8f(p.Y + ((size_t)MTOT + t) * RW + lane * 8, y1); }
        unpack8(actr ? *(const u32x4*)(p.V + (size_t)t * RW + lane * 8) : z4, vv);
        float g2v[8]; unpack8(actr ? *(const u32x4*)(p.G2B + (size_t)t * RW + lane * 8) : z4, g2v);
        const int hh = (lane * 8) >> 6;
        const float bon = actr ? (p.BONUS[(size_t)t * RH + hh] + p.BONUS[((size_t)MTOT + t) * RH + hh]) : 0.f;
        float ss = 0.f;
#pragma unroll
        for (int e = 0; e < 8; ++e) ss += og[e] * og[e];
        ss += __shfl_xor(ss, 1, 64); ss += __shfl_xor(ss, 2, 64); ss += __shfl_xor(ss, 4, 64); ss += __shfl_xor(ss, 8, 64);
        const float rstd = rsqrtf(ss * (1.0f / 128.f) + 1e-6f);
        float br[8];
#pragma unroll
        for (int e = 0; e < 8; ++e) br[e] = og[e] * rstd * gng[e] * siluf_(zo[e]);
        if (actg) *(u32x4*)(p.BR + (size_t)t * 3 * BW + lane * 8) = pack8(br);
        float y[8]; float sm = 0.f;
#pragma unroll
        for (int e = 0; e < 8; ++e) { y[e] = y0[e] + y1[e]; sm += y[e]; }
        sm += __shfl_xor(sm, 1, 64); sm += __shfl_xor(sm, 2, 64); sm += __shfl_xor(sm, 4, 64);
        const float mu = sm * (1.0f / 64.f);
        float sv = 0.f;
#pragma unroll
        for (int e = 0; e < 8; ++e) { y[e] -= mu; sv += y[e] * y[e]; }
        sv += __shfl_xor(sv, 1, 64); sv += __shfl_xor(sv, 2, 64); sv += __shfl_xor(sv, 4, 64);
        const float rs = rsqrtf(sv * (1.0f / 64.f) + 64e-5f);
        float yn[8];
#pragma unroll
        for (int e = 0; e < 8; ++e) yn[e] = y[e] * rs * lnw[e] + lnb[e] + bon * vv[e];
#pragma unroll
        for (int e = 0; e < 8; ++e) yn[e] *= g2v[e];
        if (actr) *(u32x4*)(p.BR + (size_t)t * 3 * BW + BW + lane * 8) = pack8(yn);
    }
}

__device__ __forceinline__ void g2_gemm_job(const P& p, int job, char* smem) {
    const int ntn = NPAD(RW) / 128;
    gemm_tile_run<4, 8>(p.WT_G2, 128, (size_t)NPAD(RW) * 128 * 2, p.GS, 128, (size_t)MTOT * 128 * 2, 128, (job % ntn) * 128, (job / ntn) * 256, (bf16_t*)smem, NoPre(),
        [&](int, int, int m, int n, const f32x4 v) { if (n < RW) *(u32x2*)(p.G2B + (size_t)m * RW + n) = pack4(v[0], v[1], v[2], v[3]); });
}
#define G2_JOBS ((MTOT / 256) * (NPAD(RW) / 128))
__device__ __forceinline__ void phase_glu_gemm(const P& p, int l, char* smem) {
    gemm_phase<4>(p.WT_GLU, SW, (size_t)NPAD(2 * SW) * SW * 2, p.GY, SW, (size_t)MTOT * SW * 2, SW, 2 * SW, (bf16_t*)smem, NoPre(), NoPre(),
        [&](int, int, int m, int n, const f32x4 v) {
            *(unsigned*)(p.BR + (size_t)m * 3 * BW + 2 * BW + (n >> 1)) = pack2bf(v[0] * sigmoidf_(v[1]), v[2] * sigmoidf_(v[3]));
        });
}
__device__ __forceinline__ void phase_merge(const P& p, int l, char* smem) {
    const int ntn = D_MODEL / 128, ntm = (MTOT - 256) / 128;
    auto run = [&](auto mi_tag, int n0, int m0) {
        constexpr int MI = decltype(mi_tag)::value;
        f32x4 macc[4][MI];
#pragma unroll
        for (int i = 0; i < 4; ++i)
#pragma unroll
            for (int j = 0; j < MI; ++j) macc[i][j] = (f32x4){0.f, 0.f, 0.f, 0.f};
        const int lane = otid() & 63, wave = otid() >> 6;
        for (int b = 0; b < 3; ++b) {
            f32x4 acc[4][MI];
#pragma unroll
            for (int i = 0; i < 4; ++i)
#pragma unroll
                for (int j = 0; j < MI; ++j) acc[i][j] = (f32x4){0.f, 0.f, 0.f, 0.f};
            mfma_gemm_tile_t<4, MI>(p.WT_BR + (size_t)b * D_MODEL * BW, BW, (size_t)D_MODEL * BW * 2, p.BR + b * BW, 3 * BW, (size_t)MTOT * 3 * BW * 2 - b * BW * 2, BW, n0, m0, (bf16_t*)smem, acc);
#pragma unroll
            for (int ni = 0; ni < 4; ++ni)
#pragma unroll
                for (int mi = 0; mi < MI; ++mi) {
                    const int n = n0 + (wave >> 1) * 64 + ni * 16 + (lane >> 4) * 4, m = m0 + (wave & 1) * 16 * MI + mi * 16 + (lane & 15);
                    const u32x2 g = *(const u32x2*)(p.ZGT + ((((size_t)(m >> 4) * (3 * D_MODEL / 16) + ((b * D_MODEL + n) >> 4)) * 64 + lane) * 4));
                    macc[ni][mi][0] += LO16(g.x) * acc[ni][mi][0]; macc[ni][mi][1] += HI16(g.x) * acc[ni][mi][1];
                    macc[ni][mi][2] += LO16(g.y) * acc[ni][mi][2]; macc[ni][mi][3] += HI16(g.y) * acc[ni][mi][3];
                }
        }
#pragma unroll
        for (int ni = 0; ni < 4; ++ni)
#pragma unroll
            for (int mi = 0; mi < MI; ++mi) {
                const int n = n0 + (wave >> 1) * 64 + ni * 16 + (lane >> 4) * 4, m = m0 + (wave & 1) * 16 * MI + mi * 16 + (lane & 15);
                *(u32x2*)(p.M + (size_t)m * D_MODEL + n) = pack4(macc[ni][mi][0], macc[ni][mi][1], macc[ni][mi][2], macc[ni][mi][3]);
            }
    };
    for (int it = 0;; ++it) {
        int mt_, nt_; if (!tile_map(it, ntm, ntn, (ntn >= 8) ? 4 : 8, mt_, nt_)) break;
        run(std::integral_constant<int, 4>(), nt_ * 128, mt_ * 128);
    }
    for (int job = obid(); job < 4 * ntn; job += gridDim.x) run(std::integral_constant<int, 2>(), (job >> 2) * 128, MTOT - 256 + (job & 3) * 64);
}

__device__ __forceinline__ void phase_outproj(const P& p, int l, char* smem) {
    gemm_phase<4>(p.WT_OUT, D_MODEL, (size_t)D_MODEL * D_MODEL * 2, p.M, D_MODEL, (size_t)MTOT * D_MODEL * 2, D_MODEL, D_MODEL, (bf16_t*)smem, NoPre(), NoPre(),
        [&](int, int, int m, int n, const f32x4 v) {
            const float* g1 = p.MOD + (size_t)(l * 2 + (m >= CTX ? 1 : 0)) * 6 * D_MODEL + 2 * D_MODEL + n;
            float4* xp = (float4*)(p.X + (size_t)m * D_MODEL + n); float4 x = *xp;
            x.x += g1[0] * v[0]; x.y += g1[1] * v[1]; x.z += g1[2] * v[2]; x.w += g1[3] * v[3]; *xp = x;
        });
}

__device__ __forceinline__ void store_q_hilo(const P& p, int m, int n, const f32x4 v) {
    const bf16_t h0 = f2bf(v[0]), h1 = f2bf(v[1]), h2 = f2bf(v[2]), h3 = f2bf(v[3]);
    u32x2 hv; hv.x = (unsigned)h0 | ((unsigned)h1 << 16); hv.y = (unsigned)h2 | ((unsigned)h3 << 16);
    *(u32x2*)(p.QHI + (size_t)m * PQ + n) = hv;
    *(u32x2*)(p.QLO + (size_t)m * PQ + n) = pack4(v[0] - bf2f(h0), v[1] - bf2f(h1), v[2] - bf2f(h2), v[3] - bf2f(h3));
}
__device__ __forceinline__ void phase_peer_q(const P& p, int l, char* smem) {
    gemm_phase<4>(p.WT_Q, D_MODEL, (size_t)PQ * D_MODEL * 2, p.H, D_MODEL, (size_t)MTOT * D_MODEL * 2, D_MODEL, PQ, (bf16_t*)smem, NoPre(), NoPre(),
        [&](int, int, int m, int n, const f32x4 v) { store_q_hilo(p, m, n, v); });
}

#define TK_ROW 129
__device__ __forceinline__ unsigned tk_key(float f, unsigned lowmask, unsigned low) {
    unsigned u = __builtin_bit_cast(unsigned, f);
    u ^= (u & 0x80000000u) ? 0xFFFFFFFFu : 0x80000000u;
    return (u & ~lowmask) | low;
}
#define TK_INSERT(lv, xk) { unsigned x_ = (xk); _Pragma("unroll") for (int z_ = 0; z_ < 16; ++z_) { const unsigned hi_ = lv[z_] > x_ ? lv[z_] : x_; x_ = lv[z_] > x_ ? x_ : lv[z_]; lv[z_] = hi_; } }
__device__ __forceinline__ void phase_peer_topk(const P& p, int l, char* smem) {
    const int tid = otid(), lane = tid & 63, wv = tid >> 6, q = lane >> 4, r = lane & 15;
    float* sc = (float*)smem + wv * (64 * TK_ROW);
    const int gw = (obid() * NTHREADS + tid) >> 6, nw = (gridDim.x * NTHREADS) >> 6;
    const float NEG = -3.0e38f;
    for (int job = gw; job < (MTOT / 32) * PH; job += nw) {
        const int t0 = (job / PH) * 32, h = job % PH;
#pragma unroll
        for (int sd = 0; sd < 2; ++sd) {
            f32x4 acc[2][8];
#pragma unroll
            for (int mt = 0; mt < 2; ++mt)
#pragma unroll
                for (int nt = 0; nt < 8; ++nt) acc[mt][nt] = (f32x4){0.f, 0.f, 0.f, 0.f};
#pragma unroll
            for (int ks = 0; ks < 4; ++ks) {
                bf16x8 ah[2], al[2];
#pragma unroll
                for (int mt = 0; mt < 2; ++mt) {
                    const size_t qo = (size_t)(t0 + mt * 16 + r) * PQ + h * 256 + sd * 128 + ks * 32 + q * 8;
                    ah[mt] = *(const bf16x8*)(p.QHI + qo); al[mt] = *(const bf16x8*)(p.QLO + qo);
                }
#pragma unroll
                for (int nt = 0; nt < 8; ++nt) {
                    const size_t ko = ((size_t)(h * 2 + sd) * 128 + nt * 16 + r) * 128 + ks * 32 + q * 8;
                    const bf16x8 bh = *(const bf16x8*)(p.KHI + ko), bl = *(const bf16x8*)(p.KLO + ko);
#pragma unroll
                    for (int mt = 0; mt < 2; ++mt) {
                        acc[mt][nt] = MFMA16(ah[mt], bh, acc[mt][nt]);
                        acc[mt][nt] = MFMA16(al[mt], bh, acc[mt][nt]);
                        acc[mt][nt] = MFMA16(ah[mt], bl, acc[mt][nt]);
                    }
                }
            }
#pragma unroll
            for (int mt = 0; mt < 2; ++mt)
#pragma unroll
                for (int nt = 0; nt < 8; ++nt)
#pragma unroll
                    for (int e = 0; e < 4; ++e) sc[(sd * 32 + mt * 16 + 4 * q + e) * TK_ROW + nt * 16 + r] = acc[mt][nt][e];
        }
        WAVE_SYNC();
        unsigned lv[16];
#pragma unroll
        for (int z = 0; z < 16; ++z) lv[z] = 0u;
        {
            const float* row = sc + lane * TK_ROW;
#pragma unroll 4
            for (int k = 0; k < 128; ++k) TK_INSERT(lv, tk_key(row[k], 0x7Fu, (unsigned)(127 - k)));
        }
        float lvv[16]; int li[16];
        {
            const float* row = sc + lane * TK_ROW;
#pragma unroll
            for (int z = 0; z < 16; ++z) { li[z] = 127 - (int)(lv[z] & 0x7Fu); lvv[z] = row[li[z]]; }
        }
        WAVE_SYNC();
        {
            float* row = sc + lane * TK_ROW;
#pragma unroll
            for (int z = 0; z < 16; ++z) { row[z] = lvv[z]; ((int*)row)[16 + z] = li[z]; }
        }
        WAVE_SYNC();
        const float* r1 = sc + (lane & 31) * TK_ROW; const float* r2 = sc + (32 + (lane & 31)) * TK_ROW;
        unsigned tk[16];
#pragma unroll
        for (int z = 0; z < 16; ++z) tk[z] = 0u;
        for (int i = 0; i < 16; ++i) {
            const float a = r1[i];
            const int nj = 16 / (i + 1);
            for (int j = 0; j < nj; ++j) TK_INSERT(tk, tk_key(a + r2[j], 0xFFu, (unsigned)(255 - (i * 16 + j))));
        }
        int tc[16];
#pragma unroll
        for (int z = 0; z < 16; ++z) tc[z] = 255 - (int)(tk[z] & 0xFFu);
        if (lane < 32) {
            float vals[16]; float mx = 0.f; float ssum = 0.f;
#pragma unroll
            for (int z = 0; z < 16; ++z) { vals[z] = r1[tc[z] >> 4] + r2[tc[z] & 15]; if (z == 0) mx = vals[0]; vals[z] = fexp_(vals[z] - mx); ssum += vals[z]; }
            const float inv = 1.0f / ssum;
            const size_t o = (size_t)(t0 + lane) * PH * 16 + h * 16;
#pragma unroll
            for (int z = 0; z < 16; ++z) {
                const int ex_ = ((const int*)r1)[16 + (tc[z] >> 4)] * 128 + ((const int*)r2)[16 + (tc[z] & 15)];
                p.IDX[o + z] = ex_;
                p.G[o + z] = vals[z] * inv * p.VSC[ex_];
                p.GU[o + z] = p.USC[ex_];
            }
        }
        WAVE_SYNC();
    }
}

#define PEER_CONV_JOBS (2 * NEXP / 4)
__device__ __forceinline__ void peer_conv_job(const P& p, int l, int job) {
    const int tid = otid(), lane = tid & 63, wv = tid >> 6;
    if (wv >= 4) return;
    const int rowg = job * 4 + wv; const int which = rowg / NEXP, row = rowg % NEXP;
    const float* src = p.in[which ? I_PV : I_PU] + ((size_t)l * NEXP + row) * D_MODEL + lane * 16;
    const bool act = lane * 16 < D_MODEL;
    float v[16]; float amax = 0.f;
#pragma unroll
    for (int c = 0; c < 4; ++c) {
        float4 a; a.x = 0.f; a.y = 0.f; a.z = 0.f; a.w = 0.f;
        if (act) a = *(const float4*)(src + c * 4);
        v[c * 4 + 0] = a.x; v[c * 4 + 1] = a.y; v[c * 4 + 2] = a.z; v[c * 4 + 3] = a.w;
        amax = fmaxf(amax, fmaxf(fmaxf(fabsf(a.x), fabsf(a.y)), fmaxf(fabsf(a.z), fabsf(a.w))));
    }
#pragma unroll
    for (int m = 32; m >= 1; m >>= 1) amax = fmaxf(amax, __shfl_xor(amax, m, 64));
    int ex = 0;
    if (amax > 0.f) ex = 7 - (int)((__builtin_bit_cast(unsigned, amax) >> 23) & 0xFF) + 127;
    ex = ex < -100 ? -100 : (ex > 100 ? 100 : ex);
    const float sc = __builtin_bit_cast(float, (unsigned)(ex + 127) << 23), isc = __builtin_bit_cast(float, (unsigned)(127 - ex) << 23);
    u32x4 o;
    int w0 = 0, w1 = 0, w2 = 0, w3 = 0;
    w0 = CVT_PK_FP8(v[0] * sc, v[1] * sc, w0, false); w0 = CVT_PK_FP8(v[2] * sc, v[3] * sc, w0, true);
    w1 = CVT_PK_FP8(v[4] * sc, v[5] * sc, w1, false); w1 = CVT_PK_FP8(v[6] * sc, v[7] * sc, w1, true);
    w2 = CVT_PK_FP8(v[8] * sc, v[9] * sc, w2, false); w2 = CVT_PK_FP8(v[10] * sc, v[11] * sc, w2, true);
    w3 = CVT_PK_FP8(v[12] * sc, v[13] * sc, w3, false); w3 = CVT_PK_FP8(v[14] * sc, v[15] * sc, w3, true);
    o.x = (unsigned)w0; o.y = (unsigned)w1; o.z = (unsigned)w2; o.w = (unsigned)w3;
    unsigned char* dst = (which ? p.V8 : p.U8) + (size_t)row * D_MODEL + lane * 16;
    if (act) *(u32x4*)dst = o;
    if (lane == 0) (which ? p.VSC : p.USC)[row] = isc;
}
#define GE 4
struct GBuf { u32x4 u[GE]; u32x4 v[GE]; float gu; float gv; };
__device__ __forceinline__ void gather_load(const P& p, GBuf& b, int g, int idx0, int idx1, float g0, float g1, float u0, float u1, int lane) {
    const bool act = lane * 16 < D_MODEL;
#pragma unroll
    for (int q = 0; q < GE; ++q) {
        const int k = g * GE + q;
        const int ei = __shfl((k < 64) ? idx0 : idx1, k & 63, 64);
        b.u[q] = act ? *(const u32x4*)(p.U8 + (size_t)ei * D_MODEL + lane * 16) : (u32x4){0u, 0u, 0u, 0u};
        b.v[q] = act ? *(const u32x4*)(p.V8 + (size_t)ei * D_MODEL + lane * 16) : (u32x4){0u, 0u, 0u, 0u};
    }
    const int km = g * GE + ((lane >> 4) & 3);
    b.gv = __shfl((km < 64) ? g0 : g1, km & 63, 64);
    b.gu = __shfl((km < 64) ? u0 : u1, km & 63, 64);
}
__device__ __forceinline__ void gather_compute(const GBuf& b, const float (&hv)[16], float (&acc)[16], int lane) {
    float dt[GE];
#pragma unroll
    for (int q = 0; q < GE; ++q) {
        float d = 0.f;
#pragma unroll
        for (int c = 0; c < 4; ++c) {
            const f32x2 lo = CVT_PK_F32_FP8((int)b.u[q][c], false), hi = CVT_PK_F32_FP8((int)b.u[q][c], true);
            d += hv[c * 4 + 0] * lo.x + hv[c * 4 + 1] * lo.y + hv[c * 4 + 2] * hi.x + hv[c * 4 + 3] * hi.y;
        }
        dt[q] = d;
    }
    float r2[2], r1;
    {
        const bool up = (lane & 32) != 0;
#pragma unroll
        for (int q = 0; q < 2; ++q) { const float keep = up ? dt[2 + q] : dt[q], send = up ? dt[q] : dt[2 + q]; r2[q] = keep + __shfl_xor(send, 32, 64); }
    }
    {
        const bool up = (lane & 16) != 0;
        const float keep = up ? r2[1] : r2[0], send = up ? r2[0] : r2[1];
        r1 = keep + __shfl_xor(send, 16, 64);
    }
    r1 += __shfl_xor(r1, 8, 64); r1 += __shfl_xor(r1, 4, 64); r1 += __shfl_xor(r1, 2, 64); r1 += __shfl_xor(r1, 1, 64);
    const float coef_mine = b.gv * geluf_(r1 * b.gu);
#pragma unroll
    for (int q = 0; q < GE; ++q) {
        const float coef = __shfl(coef_mine, q * 16, 64);
#pragma unroll
        for (int c = 0; c < 4; ++c) {
            const f32x2 lo = CVT_PK_F32_FP8((int)b.v[q][c], false), hi = CVT_PK_F32_FP8((int)b.v[q][c], true);
            acc[c * 4 + 0] += coef * lo.x; acc[c * 4 + 1] += coef * lo.y; acc[c * 4 + 2] += coef * hi.x; acc[c * 4 + 3] += coef * hi.y;
        }
    }
}
__device__ __forceinline__ void phase_peer_gather(const P& p, int l) {
    const int lane = otid() & 63;
    const int gw = (obid() * NTHREADS + otid()) >> 6, nw = (gridDim.x * NTHREADS) >> 6;
    constexpr int NG = PH * 16 / GE;
    const bool act = lane * 16 < D_MODEL;
    for (int t = gw; t < MTOT; t += nw) {
        float hv[16], acc[16];
        {
            const u32x4 z4 = {0u, 0u, 0u, 0u};
            const u32x4 ha = act ? *(const u32x4*)(p.H + (size_t)t * D_MODEL + lane * 16) : z4;
            const u32x4 hb = act ? *(const u32x4*)(p.H + (size_t)t * D_MODEL + lane * 16 + 8) : z4;
            hv[0] = LO16(ha.x); hv[1] = HI16(ha.x); hv[2] = LO16(ha.y); hv[3] = HI16(ha.y); hv[4] = LO16(ha.z); hv[5] = HI16(ha.z); hv[6] = LO16(ha.w); hv[7] = HI16(ha.w);
            hv[8] = LO16(hb.x); hv[9] = HI16(hb.x); hv[10] = LO16(hb.y); hv[11] = HI16(hb.y); hv[12] = LO16(hb.z); hv[13] = HI16(hb.z); hv[14] = LO16(hb.w); hv[15] = HI16(hb.w);
#pragma unroll
            for (int j = 0; j < 16; ++j) acc[j] = 0.f;
        }
        int idx0 = 0, idx1 = 0; float g0 = 0.f, g1 = 0.f, u0 = 0.f, u1 = 0.f;
        if (lane < PH * 16) { idx0 = p.IDX[(size_t)t * PH * 16 + lane]; g0 = p.G[(size_t)t * PH * 16 + lane]; u0 = p.GU[(size_t)t * PH * 16 + lane]; }
        if (64 + lane < PH * 16) { idx1 = p.IDX[(size_t)t * PH * 16 + 64 + lane]; g1 = p.G[(size_t)t * PH * 16 + 64 + lane]; u1 = p.GU[(size_t)t * PH * 16 + 64 + lane]; }
        GBuf b0, b1, b2;
        gather_load(p, b0, 0, idx0, idx1, g0, g1, u0, u1, lane);
        gather_load(p, b1, 1, idx0, idx1, g0, g1, u0, u1, lane);
        for (int g = 0; g < NG; g += 3) {
            if (g + 2 < NG) gather_load(p, b2, g + 2, idx0, idx1, g0, g1, u0, u1, lane);
            gather_compute(b0, hv, acc, lane);
            if (g + 1 < NG) {
                if (g + 3 < NG) gather_load(p, b0, g + 3, idx0, idx1, g0, g1, u0, u1, lane);
                gather_compute(b1, hv, acc, lane);
            }
            if (g + 2 < NG) {
                if (g + 4 < NG) gather_load(p, b1, g + 4, idx0, idx1, g0, g1, u0, u1, lane);
                gather_compute(b2, hv, acc, lane);
            }
        }
        float xn[16]; float ss = 0.f;
#pragma unroll
        for (int j = 0; j < 16; ++j) xn[j] = 0.f;
        if (act) {
            const float* g2 = p.MOD + (size_t)(l * 2 + (t >= CTX ? 1 : 0)) * 6 * D_MODEL + 5 * D_MODEL + lane * 16;
            float* xp = p.X + (size_t)t * D_MODEL + lane * 16;
#pragma unroll
            for (int c = 0; c < 4; ++c) {
                float4 x = *(float4*)(xp + c * 4);
                x.x += g2[c * 4 + 0] * acc[c * 4 + 0]; x.y += g2[c * 4 + 1] * acc[c * 4 + 1]; x.z += g2[c * 4 + 2] * acc[c * 4 + 2]; x.w += g2[c * 4 + 3] * acc[c * 4 + 3];
                if (l + 1 < DEPTH) *(float4*)(xp + c * 4) = x;
                xn[c * 4 + 0] = x.x; xn[c * 4 + 1] = x.y; xn[c * 4 + 2] = x.z; xn[c * 4 + 3] = x.w;
                ss += x.x * x.x + x.y * x.y + x.z * x.z + x.w * x.w;
            }
        }
        ss = wave_sum(ss);
        const float rstd = rsqrtf(ss / D_MODEL + 1e-6f);
        if (act) {
            if (l + 1 < DEPTH) {
                const float* gn = p.in[I_N1G] + (size_t)(l + 1) * D_MODEL + lane * 16;
                const float* mod = p.MOD + (size_t)((l + 1) * 2 + (t >= CTX ? 1 : 0)) * 6 * D_MODEL + lane * 16;
                float o[16];
#pragma unroll
                for (int j = 0; j < 16; ++j) o[j] = xn[j] * rstd * gn[j] * (1.0f + mod[D_MODEL + j]) + mod[j];
                u32x4 w0, w1;
                w0.x = pack2bf(o[0], o[1]); w0.y = pack2bf(o[2], o[3]); w0.z = pack2bf(o[4], o[5]); w0.w = pack2bf(o[6], o[7]);
                w1.x = pack2bf(o[8], o[9]); w1.y = pack2bf(o[10], o[11]); w1.z = pack2bf(o[12], o[13]); w1.w = pack2bf(o[14], o[15]);
                *(u32x4*)(p.H + (size_t)t * D_MODEL + lane * 16) = w0; *(u32x4*)(p.H + (size_t)t * D_MODEL + lane * 16 + 8) = w1;
            } else if (t >= CTX) {
                const float* fg = p.in[I_FG] + lane * 16;
                float* op = p.out + (size_t)(t - CTX) * D_MODEL + lane * 16;
#pragma unroll
                for (int c = 0; c < 4; ++c) {
                    float4 o; o.x = xn[c * 4 + 0] * rstd * fg[c * 4 + 0]; o.y = xn[c * 4 + 1] * rstd * fg[c * 4 + 1]; o.z = xn[c * 4 + 2] * rstd * fg[c * 4 + 2]; o.w = xn[c * 4 + 3] * rstd * fg[c * 4 + 3];
                    *(float4*)(op + c * 4) = o;
                }
            }
        }
    }
}
__device__ __forceinline__ void phase_final(const P& p) {
    const int lane = otid() & 63;
    const int gw = (obid() * NTHREADS + otid()) >> 6, nw = (gridDim.x * NTHREADS) >> 6;
    const float* g = p.in[I_FG];
    for (int t = gw; t < SEQ; t += nw) {
        const float* x = p.X + (size_t)(CTX + t) * D_MODEL;
        float v[D_MODEL / 64]; float ss = 0.f;
#pragma unroll
        for (int j = 0; j < D_MODEL / 64; ++j) { v[j] = x[lane + 64 * j]; ss += v[j] * v[j]; }
        ss = wave_sum(ss);
        float rstd = rsqrtf(ss / D_MODEL + 1e-6f);
#pragma unroll
        for (int j = 0; j < D_MODEL / 64; ++j) p.out[(size_t)t * D_MODEL + lane + 64 * j] = v[j] * rstd * g[lane + 64 * j];
    }
}

__global__ void __launch_bounds__(NTHREADS) fwd_megakernel(P p_arg) {
#ifdef EMU
    char* smem = emu_smem();
#else
    __shared__ __attribute__((aligned(16))) char smem_raw[SMEM_BYTES + 16];
    char* smem = smem_raw;
#endif
#ifndef EMU
    volatile LAS unsigned* xst = (volatile LAS unsigned*)(smem_raw + SMEM_BYTES);
    if (threadIdx.x == 0) { xst[0] = 0u; xst[1] = 0u; xst[2] = 0u; xst[3] = 0u; }
    __syncthreads();
    XcdBarrier xb = xcd_barrier_post(p_arg.bar, xst);
#endif
    { LOADP(); phase_init(p, smem); }
#ifndef EMU
#endif
    GRID_SYNC();
#ifndef EMU
    if (threadIdx.x == 0) {
        unsigned base_ = 0;
        for (unsigned j = 0; j < xb.x; ++j) base_ += xb_ld(&p_arg.bar[XB_XCNT(j)]);
        xst[2] = base_ + xst[3];
    }
    __syncthreads();
#endif
    PROBE_INIT();
    for (int l = 0; l < DEPTH; ++l) {
        if (l == 0) {
            { LOADP(); phase_norm(p, 0, 0); }
            { LOADP(); phase_s5const(p, 0); }
            { LOADP(); phase_convert_weights(p, 0, smem, obid(), (int)gridDim.x); }
            GRID_SYNC(); PROBE_AFTER(0);
        }
        { LOADP(); phase_gemm_in(p, l, smem); }
        GRID_SYNC(); PROBE_AFTER(1);
        { LOADP(); phase_rwkv_prep1(p, l); }
        GRID_SYNC(); PROBE_AFTER(14);
        { LOADP(); phase_rwkv_prep2(p, l, smem); }
        GRID_SYNC(); PROBE_AFTER(2);
        { LOADP(); for (int job = obid(); job < 2 * NC * RH; job += gridDim.x) rwkv_chunk_job(p, job, smem); }
        __syncthreads(); PROBE_AFTER(20);
        { LOADP(); phase_gla_kv(p, l, smem); }
        PROBE_AFTER(21);
        { LOADP(); phase_s5_pass(p, l, smem, false); }
        GRID_SYNC(); PROBE_AFTER(3);
        {
            LOADP();
            const int n_rw = 2 * RH, n_gla = 2 * GH * 8192 / NTHREADS, n_s5 = (2 * SG * 64 + NTHREADS - 1) / NTHREADS;
            const int G_ = (int)gridDim.x;
            if (G_ > 2 * n_rw) {
                if (obid() < n_rw) { rwkv_seq_job(p, obid(), smem); PROBE_AFTER(24); }
                else {
                    const int nb = G_ - n_rw, bid = obid() - n_rw;
                    for (int job = bid; job < n_gla + n_s5 + PEER_CONV_JOBS; job += nb) {
                        if (job < n_gla) gla_scan_job(p, job);
                        else if (job < n_gla + n_s5) s5_carry_job(p, job - n_gla);
                        else peer_conv_job(p, l, job - n_gla - n_s5);
                    }
                    { P pg = p; late_select(pg, l & 1); for (int job = bid; job < G2_JOBS; job += nb) g2_gemm_job(pg, job, smem); }
                    if (l + 1 < DEPTH) { late_select(p, (l + 1) & 1); phase_convert_weights(p, l + 1, smem, bid, nb); }
                }
            } else {
                for (int job = obid(); job < n_rw + n_gla + n_s5 + PEER_CONV_JOBS; job += G_) {
                    if (job < n_rw) rwkv_seq_job(p, job, smem);
                    else if (job < n_rw + n_gla) gla_scan_job(p, job - n_rw);
                    else if (job < n_rw + n_gla + n_s5) s5_carry_job(p, job - n_rw - n_gla);
                    else peer_conv_job(p, l, job - n_rw - n_gla - n_s5);
                }
                __syncthreads();
                { P pg = p; late_select(pg, l & 1); for (int job = obid(); job < G2_JOBS; job += G_) g2_gemm_job(pg, job, smem); }
                if (l + 1 < DEPTH) { late_select(p, (l + 1) & 1); phase_convert_weights(p, l + 1, smem, obid(), G_); }
            }
        }
        GRID_SYNC(); PROBE_AFTER(4);
        { LOADP(); phase_rwkv_out(p); }
        PROBE_AFTER(22);
        { LOADP(); phase_gla_out(p, l, smem); }
        PROBE_AFTER(23);
        { LOADP(); phase_s5_pass(p, l, smem, true); }
        GRID_SYNC(); PROBE_AFTER(5);
        { LOADP(); phase_side_elem(p, l); }
        if (l + 1 < DEPTH) { LOADP(); phase_s5const(p, l + 1); }
        { LOADP(); late_select(p, l & 1); phase_glu_gemm(p, l, smem); }
        GRID_SYNC(); PROBE_AFTER(7);
        { LOADP(); late_select(p, l & 1); phase_merge(p, l, smem); }
        GRID_SYNC(); PROBE_AFTER(8);
        { LOADP(); late_select(p, l & 1); phase_outproj(p, l, smem); }
        GRID_SYNC(); PROBE_AFTER(9);
        { LOADP(); phase_norm(p, l, 1); }
        GRID_SYNC(); PROBE_AFTER(10);
        { LOADP(); late_select(p, l & 1); phase_peer_q(p, l, smem); }
        GRID_SYNC(); PROBE_AFTER(11);
        { LOADP(); late_select(p, l & 1); phase_peer_topk(p, l, smem); }
        GRID_SYNC(); PROBE_AFTER(12);
        { LOADP(); phase_peer_gather(p, l); }
        if (l + 1 < DEPTH) { GRID_SYNC(); PROBE_AFTER(13); }
    }
}

static inline size_t align_up(size_t x) { return (x + 255) & ~(size_t)255; }

extern "C" void kernel_launch(void* const* d_in, const int* in_sizes, int n_in, void* d_out, int out_size, void* d_ws, size_t ws_size, hipStream_t stream) {
    P p;
    memset(&p, 0, sizeof(p));
    for (int i = 0; i < 39; ++i) p.in[i] = (const float*)d_in[i];
    p.out = (float*)d_out;
    char* w = (char*)d_ws; size_t off = 0;
    auto take = [&](size_t bytes) { void* r = w + off; off = align_up(off + bytes); return r; };
    p.bar = (unsigned*)take(16384);
    p.X = (float*)take((size_t)MTOT * D_MODEL * 4);
    p.H = (bf16_t*)take((size_t)MTOT * D_MODEL * 2);
    p.MOD = (float*)take((size_t)DEPTH * 2 * 6 * D_MODEL * 4);
    p.Z = (bf16_t*)take((size_t)MTOT * ZLD * 2);
    p.ZGT = (bf16_t*)take((size_t)MTOT * 3 * D_MODEL * 2);
    p.V = (bf16_t*)take((size_t)MTOT * RW * 2);
    {
        char* ra = (char*)take((size_t)MTOT * RW * 2 * 2 > (size_t)MTOT * GLA_V * 4 ? (size_t)MTOT * RW * 2 * 2 : (size_t)MTOT * GLA_V * 4);
        p.R = (bf16_t*)ra; p.KK = (bf16_t*)(ra + (size_t)MTOT * RW * 2);
        p.OGLA = (float*)ra;
    }
    {
        char* rb = (char*)take((size_t)2 * MTOT * RW * 2 > (size_t)3 * MTOT * PH * 16 * 4 ? (size_t)2 * MTOT * RW * 2 : (size_t)3 * MTOT * PH * 16 * 4);
        p.KD = (bf16_t*)rb;
        p.IDX = (int*)rb; p.G = (float*)(rb + (size_t)MTOT * PH * 16 * 4); p.GU = (float*)(rb + (size_t)2 * MTOT * PH * 16 * 4);
    }
    p.BB = (bf16_t*)take((size_t)2 * MTOT * RW * 2);
    p.G2B = p.BB;
    p.LW = (float*)take((size_t)2 * MTOT * RW * 4);
    p.SP = (bf16_t*)p.LW;
    static_assert((size_t)2 * NC * GH * 8192 * 2 <= (size_t)2 * MTOT * RW * 4, "SP alias");
    p.BONUS = (float*)take((size_t)2 * MTOT * RH * 4);
    p.KS = (bf16_t*)take((size_t)MTOT * RW * 2);
    p.LR = (bf16_t*)take((size_t)MTOT * 256 * 2);
    p.WT_W2 = (bf16_t*)take((size_t)2 * NPAD(RW) * 64 * 2);
    p.WT_A2 = (bf16_t*)take((size_t)2 * NPAD(RW) * 64 * 2);
    p.GS = (bf16_t*)take((size_t)MTOT * 128 * 2);
    p.Y = (float*)take((size_t)2 * MTOT * RW * 4);
    p.Y0T = (float*)take((size_t)2 * NC * RH * 4096 * 4);
    p.KV = (float*)take((size_t)2 * NC * GH * 8192 * 4);
    p.DEC = (float*)take((size_t)2 * NC * GH * 64 * 4);
    p.S5A = (float*)take((size_t)2 * SG * 64 * 2 * 4);
    p.S5BB = (float*)take((size_t)2 * SG * 64 * 16 * 2 * 4);
    p.S5END = (float*)take((size_t)2 * NC * SG * 64 * 2 * 4);
    p.S5CAR = (float*)take((size_t)2 * NC * SG * 64 * 2 * 4);
    {
        const size_t szc1 = (size_t)2 * NC * RH * SEQ_REC;
        const size_t szc2 = (size_t)MTOT * SW * 2 + (size_t)MTOT * RW * 4 + (size_t)MTOT * 3 * BW * 2 + (size_t)MTOT * D_MODEL * 2 + 1024;
        char* rc = (char*)take(szc1 > szc2 ? szc1 : szc2);
        p.REC = rc;
        char* c2 = rc;
        p.GY = (bf16_t*)c2; c2 += align_up((size_t)MTOT * SW * 2);
        p.YN = (float*)c2; c2 += align_up((size_t)MTOT * RW * 4);
        p.BR = (bf16_t*)c2; c2 += align_up((size_t)MTOT * 3 * BW * 2);
        p.M = (bf16_t*)c2;
    }
    p.SN = (bf16_t*)take((size_t)2 * NC * RH * 4096 * 2);
    p.QH = (bf16_t*)take((size_t)2 * NC * RH * 4096 * 2);
    p.WT_IN = (bf16_t*)take((size_t)NPAD192(D_IN) * D_MODEL * 2);
    {
        char* lb = (char*)take(2 * LATE_BYTES); size_t lo = 0;
        auto ltake = [&](size_t bytes) { void* r = lb + lo; lo = AL256(lo + bytes); return r; };
        p.WT_G2 = (bf16_t*)ltake((size_t)NPAD(RW) * 128 * 2);
        p.WT_GLU = (bf16_t*)ltake((size_t)NPAD(2 * SW) * SW * 2);
        p.WT_BR = (bf16_t*)ltake((size_t)3 * D_MODEL * BW * 2);
        p.WT_OUT = (bf16_t*)ltake((size_t)D_MODEL * D_MODEL * 2);
        p.WT_Q = (bf16_t*)ltake((size_t)PQ * D_MODEL * 2);
        p.KHI = (bf16_t*)ltake((size_t)PH * 2 * 128 * 128 * 2); p.KLO = (bf16_t*)ltake((size_t)PH * 2 * 128 * 128 * 2);
        if (lo != LATE_BYTES) fprintf(stderr, "late weights layout mismatch\n");
    }
    p.U8 = (unsigned char*)take((size_t)NEXP * D_MODEL);
    p.V8 = (unsigned char*)take((size_t)NEXP * D_MODEL);
    p.USC = (float*)take((size_t)NEXP * 4); p.VSC = (float*)take((size_t)NEXP * 4);
    p.QHI = p.Z; p.QLO = p.Z + (size_t)MTOT * PQ;
    static_assert((size_t)PQ * 4 <= (size_t)D_IN * 2 && ((size_t)MTOT * ZLD * 2) % 256 == 0, "Q alias");
    if (off > ws_size) { fprintf(stderr, "ws too small: need %zu have %zu\n", off, ws_size); return; }
#ifdef EMU
    fprintf(stderr, "ws used %zu MB\n", off >> 20);
    emu_launch([=] { fwd_megakernel(p); }, EMU_GRID, NTHREADS);
#else
    hipMemsetAsync(p.bar, 0, 16384, stream);
    static int grid_blocks = 0;
    if (!grid_blocks) {
        int dev = 0, cus = 0, per_cu = 0;
        hipGetDevice(&dev);
        hipDeviceGetAttribute(&cus, hipDeviceAttributeMultiprocessorCount, dev);
        hipOccupancyMaxActiveBlocksPerMultiprocessor(&per_cu, fwd_megakernel, NTHREADS, 0);
        if (per_cu > 1) per_cu = 1;
        grid_blocks = cus * per_cu;
    }
    void* args[] = {&p};
    hipError_t e = hipLaunchCooperativeKernel((void*)fwd_megakernel, dim3(grid_blocks), dim3(NTHREADS), args, 0, stream);
    if (e != hipSuccess) fprintf(stderr, "cooperative launch failed: %s (grid %d)\n", hipGetErrorString(e), grid_blocks);
#endif
}
```

```cpp
#include <hip/hip_runtime.h>
#ifndef EMU
#include <hip/hip_cooperative_groups.h>
namespace cg = cooperative_groups;
#endif
#include <cstdio>
#include <cstdint>
#include <cstring>
#include <type_traits>

#ifdef CFG_SMALL
#define D_MODEL 128
#define SEQ 640
#define DEPTH 2
#define GRID_W 10
#define CTX 128
#define GH 1
#define RH 2
#define SG 8
#define PH 2
#else
#define D_MODEL 1024
#define SEQ 16384
#define DEPTH 4
#define GRID_W 64
#define CTX 256
#define GH 4
#define RH 8
#define SG 32
#define PH 8
#endif
#define MTOT (CTX + SEQ)
#define ROWS (SEQ / GRID_W)
#define GLA_K (GH * 64)
#define GLA_V (GH * 128)
#define RW (RH * 64)
#define RWKV_IN (3 * RW + 4 * 64 + 128)
#define SW (SG * 16)
#define BW GLA_V
#define ZQ 0
#define ZK (GLA_K)
#define ZV (2 * GLA_K)
#define ZOG (ZV + GLA_V)
#define ZAF (ZOG + GLA_V)
#define ZAB (ZAF + 16)
#define ZR (ZAB + 16)
#define ZS5 (ZR + RWKV_IN)
#define ZG (ZS5 + SW)
#define D_IN (ZG + 3 * D_MODEL)
#define ZLD ZG
#define NC (MTOT / 64)
#define NCC (CTX / 64)
#define RB (ROWS / 64)
#define PQ (PH * 256)
#define NEXP 16384
#define NTHREADS 256
#define SMEM_BYTES 133120

typedef unsigned short bf16_t;
typedef short bf16x8 __attribute__((ext_vector_type(8)));
typedef float f32x4 __attribute__((ext_vector_type(4)));
typedef unsigned u32x4 __attribute__((ext_vector_type(4)));
typedef unsigned u32x2 __attribute__((ext_vector_type(2)));
#ifdef EMU
#define MFMA16(a, b, c) emu_mfma_16x16x32_bf16(a, b, c)
#else
#define MFMA16(a, b, c) __builtin_amdgcn_mfma_f32_16x16x32_bf16(a, b, c, 0, 0, 0)
#endif
typedef float f32x2 __attribute__((ext_vector_type(2)));
#ifdef EMU
#define CVT_PK_FP8(a, b, old, hi) emu_cvt_pk_fp8_f32(a, b, old, hi)
#define CVT_PK_F32_FP8(w, hi) emu_cvt_pk_f32_fp8(w, hi)
#else
#define CVT_PK_FP8(a, b, old, hi) __builtin_amdgcn_cvt_pk_fp8_f32(a, b, old, hi)
#define CVT_PK_F32_FP8(w, hi) __builtin_amdgcn_cvt_pk_f32_fp8(w, hi)
#endif
#ifdef EMU
#define MFMA16_ACC(a, b, c) c = emu_mfma_16x16x32_bf16(a, b, c)
#else
#define MFMA16_ACC(a, b, c) asm volatile("v_mfma_f32_16x16x32_bf16 %0, %1, %2, %0" : "+a"(c) : "v"(a), "v"(b))
#endif
#define NPAD(n) (((n) + 127) / 128 * 128)
#define NPAD192(n) (((n) + 383) / 384 * 384)

__device__ __forceinline__ float bf2f(bf16_t h) { return __builtin_bit_cast(float, ((unsigned)h) << 16); }
#ifdef EMU
__device__ __forceinline__ bf16_t f2bf(float f) { unsigned u = __builtin_bit_cast(unsigned, f); u += 0x7FFFu + ((u >> 16) & 1u); return (bf16_t)(u >> 16); }
__device__ __forceinline__ unsigned pack2bf(float a, float b) { return (unsigned)f2bf(a) | ((unsigned)f2bf(b) << 16); }
#else
typedef float f2v_t __attribute__((ext_vector_type(2))); typedef __bf16 b2v_t __attribute__((ext_vector_type(2)));
__device__ __forceinline__ bf16_t f2bf(float f) { return __builtin_bit_cast(unsigned short, (__bf16)f); }
__device__ __forceinline__ unsigned pack2bf(float a, float b) { f2v_t v = {a, b}; b2v_t r = __builtin_convertvector(v, b2v_t); return __builtin_bit_cast(unsigned, r); }
#endif
#ifdef EMU
#define fexp_(x) expf(x)
#define flog_(x) logf(x)
#else
#define fexp_(x) __expf(x)
#define flog_(x) __logf(x)
#endif
#define LO16(x) __builtin_bit_cast(float, (x) << 16)
#define HI16(x) __builtin_bit_cast(float, (x) & 0xFFFF0000u)
__device__ __forceinline__ float sigmoidf_(float x) { return 1.0f / (1.0f + fexp_(-x)); }
__device__ __forceinline__ float siluf_(float x) { return x * sigmoidf_(x); }
__device__ __forceinline__ float geluf_(float x) { const float y = 1.5957691216057308f * (x + 0.044715f * x * x * x); return x / (1.0f + fexp_(-y)); }
__device__ __forceinline__ float softplusf_(float x) { return fmaxf(x, 0.f) + flog_(1.0f + fexp_(-fabsf(x))); }
__device__ __forceinline__ float tanhf_(float x) { const float e = fexp_(-2.0f * fabsf(x)); const float t = (1.0f - e) / (1.0f + e); return x < 0.f ? -t : t; }
__device__ __forceinline__ float wave_sum(float v) {
#pragma unroll
    for (int m = 32; m >= 1; m >>= 1) v += __shfl_xor(v, m, 64);
    return v;
}

struct P {
    const float* in[39];
    float* out;
    float* X;
    bf16_t* H;
    bf16_t* Z;
    bf16_t* ZGT;
    float* MOD;
    bf16_t* R; bf16_t* V; bf16_t* KK; bf16_t* KD; bf16_t* BB;
    float* LW;
    char* REC;
    bf16_t* SN;
    bf16_t* QH;
    float* BONUS;
    bf16_t* KS;
    bf16_t* LR;
    bf16_t* WT_W2;
    bf16_t* WT_A2;
    bf16_t* GS;
    float* Y;
    bf16_t* G2B;
    float* Y0T;
    float* KV;
    bf16_t* SP;
    float* DEC;
    float* OGLA;
    float* S5A;
    float* S5BB;
    float* S5END;
    float* S5CAR;
    bf16_t* GY;
    float* YN;
    bf16_t* BR;
    bf16_t* M;
    bf16_t* QHI; bf16_t* QLO;
    bf16_t* KHI; bf16_t* KLO;
    int* IDX;
    float* G;
    float* GU;
    unsigned* bar;
    bf16_t* WT_IN;
    bf16_t* WT_G2;
    bf16_t* WT_GLU;
    bf16_t* WT_BR;
    bf16_t* WT_OUT;
    bf16_t* WT_Q;
    unsigned char* U8; unsigned char* V8;
    float* USC; float* VSC;
};

enum { I_X = 0, I_C, I_CTX, I_CCTX, I_WMOD, I_BMOD, I_N1G, I_N2G, I_WIN, I_GLA_WA2, I_GLA_BA, I_GLA_NG, I_RCONV, I_RW0, I_RW2, I_RA0, I_RA2, I_RG2,
       I_RKK, I_RKA, I_RRK, I_RLNW, I_RLNB, I_S5LRE, I_S5LIM, I_S5LS, I_S5BRE, I_S5BIM, I_S5CRE, I_S5CIM, I_S5D, I_S5GLU, I_WBR, I_WOUT, I_PWQ, I_PKEYS, I_PU, I_PV, I_FG };

#define AL256(x) (((size_t)(x) + 255) & ~(size_t)255)
#define LATE_BYTES (AL256((size_t)NPAD(RW) * 128 * 2) + AL256((size_t)NPAD(2 * SW) * SW * 2) + AL256((size_t)3 * D_MODEL * BW * 2) + AL256((size_t)D_MODEL * D_MODEL * 2) + \
                    AL256((size_t)PQ * D_MODEL * 2) + 2 * AL256((size_t)PH * 2 * 128 * 128 * 2))
__device__ __forceinline__ void late_select(P& p, int par) {
    const size_t o = (size_t)par * (LATE_BYTES / 2);
    p.WT_G2 += o; p.WT_GLU += o; p.WT_BR += o; p.WT_OUT += o; p.WT_Q += o; p.KHI += o; p.KLO += o;
}
#ifdef EMU
__device__ __forceinline__ int otid() { return threadIdx.x; }
__device__ __forceinline__ int obid() { return blockIdx.x; }
#else
__device__ __forceinline__ int otid() { int t = threadIdx.x; asm volatile("" : "+v"(t)); return t; }
__device__ __forceinline__ int obid() { int b = blockIdx.x; asm volatile("" : "+s"(b)); return b; }
#endif
#ifdef EMU
#define WAVE_SYNC() emu_wave_barrier()
#ifndef EMU_GRID
#define EMU_GRID 4
#endif
#else
#define WAVE_SYNC() __builtin_amdgcn_wave_barrier()
#endif
#ifndef EMU
#define XB_TMO      128
#define XB_XCNT(j)  (256  + 64 * (j))
#define XB_XSUB(j)  (1280 + 64 * (j))
#define XB_XGEN(j)  (2304 + 64 * (j))
#define XB_TOP      3328
#define XB_TOPGEN   3392
#define XCD_BAR_WORDS 3456
#define XB_SPIN_CAP (1u << 22)
#define LAS __attribute__((address_space(3)))
__device__ __forceinline__ unsigned xb_ld(unsigned* p)              { return __hip_atomic_load(p, __ATOMIC_RELAXED, __HIP_MEMORY_SCOPE_AGENT); }
__device__ __forceinline__ unsigned xb_add(unsigned* p, unsigned v) { return __hip_atomic_fetch_add(p, v, __ATOMIC_RELAXED, __HIP_MEMORY_SCOPE_AGENT); }
__device__ __forceinline__ unsigned xb_xcc_id() { return (unsigned)__builtin_amdgcn_s_getreg((3 << 11) | 20) & 0xFu; }
#define XB_SPIN(cond, bar) do { unsigned _sp = 0; while (cond) { __builtin_amdgcn_s_sleep(1); \
    if ((++_sp & 255u) == 0u) { if (xb_ld(&(bar)[XB_TMO])) break; if (_sp > XB_SPIN_CAP) { atomicAdd(&(bar)[XB_TMO], 1u); break; } } } } while (0)
struct XcdBarrier { unsigned* bar; unsigned x; volatile LAS unsigned* st; };
__device__ __forceinline__ XcdBarrier xcd_barrier_post(unsigned* bar, volatile LAS unsigned* st) {
    XcdBarrier b; b.bar = bar; b.x = xb_xcc_id(); b.st = st;
    if (threadIdx.x == 0) st[3] = xb_add(&bar[XB_XCNT(b.x)], 1u);
    return b;
}
__device__ __forceinline__ void xcd_barrier_complete(unsigned* bar, unsigned x, unsigned& nloc, unsigned& nx) {
    const unsigned G = gridDim.x * gridDim.y * gridDim.z;
    unsigned sum, cnt, mine, sp = 0u;
    for (;;) {
        sum = 0u; cnt = 0u; mine = 0u;
#pragma unroll
        for (unsigned j = 0; j < 16; ++j) { const unsigned c = xb_ld(&bar[XB_XCNT(j)]); sum += c; cnt += (c > 0u) ? 1u : 0u; mine = (j == x) ? c : mine; }
        if (sum == G) break;
        __builtin_amdgcn_s_sleep(1);
        if ((++sp & 255u) == 0u) { if (xb_ld(&bar[XB_TMO])) break; if (sp > XB_SPIN_CAP) { atomicAdd(&bar[XB_TMO], 1u); break; } }
    }
    nloc = mine > 0u ? mine : 1u; nx = cnt > 0u ? cnt : 1u;
}
__device__ __forceinline__ void xcd_barrier(const XcdBarrier& b) {
    asm volatile("s_waitcnt vmcnt(0)" ::: "memory");
    __syncthreads();
    if (threadIdx.x == 0) {
        unsigned* bar = b.bar;
        __builtin_amdgcn_fence(__ATOMIC_RELEASE, "agent");
        asm volatile("s_waitcnt vmcnt(0)" ::: "memory");
        const unsigned G = gridDim.x;
        const unsigned old = xb_add(&bar[XB_TOP], 1u);
        const unsigned tg = old / G;
        if (old + 1u == (tg + 1u) * G) {
            const unsigned long long t0_ = wall_clock64(); while (wall_clock64() - t0_ < 1000ull) __builtin_amdgcn_s_sleep(8);
            xb_add(&bar[XB_TOPGEN], 1u);
        }
        else XB_SPIN(xb_ld(&bar[XB_TOPGEN]) == tg, bar);
        __builtin_amdgcn_fence(__ATOMIC_ACQUIRE, "agent");
        asm volatile("s_waitcnt vmcnt(0)" ::: "memory");
    }
    __syncthreads();
}
#define GRID_SYNC() { (void)xb; asm volatile("s_waitcnt vmcnt(0)" ::: "memory"); cg::this_grid().sync(); }
#else
#define GRID_SYNC() emu_grid_sync()
#endif

#ifdef EMU
#define LOADP() P p = p_arg
#else
typedef __attribute__((address_space(4))) const unsigned long long cu64_t;
__device__ __forceinline__ void load_params(P& p) {
    cu64_t* q = (cu64_t*)__builtin_amdgcn_kernarg_segment_ptr();
    asm volatile("" : "+s"(q));
    typedef __attribute__((address_space(1))) char gchar_t;
    char* w[sizeof(P) / 8];
#pragma unroll
    for (int i = 0; i < (int)(sizeof(P) / 8); ++i) w[i] = (char*)(gchar_t*)q[i];
    __builtin_memcpy(&p, w, sizeof(P));
}
#define LOADP() P p; load_params(p)
#endif
#define PROBE_MULT 3
#if defined(PROBE_ID) && !defined(EMU)
#define PROBE_INIT() unsigned long long probe_t0 = wall_clock64()
#define PROBE_AFTER(id) { if (blockIdx.x == 0) { unsigned long long now_ = wall_clock64(); if ((id) == PROBE_ID || (id) == PROBE_ID2) { const unsigned long long dt_ = now_ - probe_t0; \
    while (wall_clock64() - now_ < dt_ * PROBE_MULT) __builtin_amdgcn_s_sleep(8); now_ = wall_clock64(); } probe_t0 = now_; } }
#else
#define PROBE_INIT()
#define PROBE_AFTER(id)
#endif
__device__ __forceinline__ int gla_tok(int n, int i) {
    if (n < NCC) return n * 64 + i;
    int m = n - NCC; int col = m / RB, rb = m % RB;
    return CTX + (rb * 64 + i) * GRID_W + col;
}
__device__ __forceinline__ int chunk_order(int d, int s) {
    if (d == 0) return s;
    return (s < NCC) ? (NCC - 1 - s) : (NC - 1 - (s - NCC));
}
__device__ __forceinline__ int tok_order(int d, int s) {
    if (d == 0) return s;
    return (s < CTX) ? (CTX - 1 - s) : (MTOT - 1 - (s - CTX));
}


#define LDS_ROW 72
__device__ __forceinline__ void mfma_gemm_tile(const bf16_t* Wt, int ldw, const bf16_t* Act, int lda, int K, int n0, int m0, bf16_t* lds, f32x4 (&acc)[4][4]) {
    bf16_t* Ws = lds; bf16_t* As = lds + 128 * LDS_ROW;
    const int tid = otid(), lane = tid & 63, wave = tid >> 6, wn = wave >> 1, wm = wave & 1;
    const int lrow = tid >> 3, lkc = (tid & 7) * 8;
    u32x4 pw[4], pa[4];
#pragma unroll
    for (int i = 0; i < 4; ++i) {
        pw[i] = *(const u32x4*)(Wt + (size_t)(n0 + lrow + 32 * i) * ldw + lkc);
        pa[i] = *(const u32x4*)(Act + (size_t)(m0 + lrow + 32 * i) * lda + lkc);
    }
    for (int k0 = 0; k0 < K; k0 += 64) {
        __syncthreads();
#pragma unroll
        for (int i = 0; i < 4; ++i) {
            *(u32x4*)(Ws + (lrow + 32 * i) * LDS_ROW + lkc) = pw[i];
            *(u32x4*)(As + (lrow + 32 * i) * LDS_ROW + lkc) = pa[i];
        }
        __syncthreads();
        if (k0 + 64 < K) {
#pragma unroll
            for (int i = 0; i < 4; ++i) {
                pw[i] = *(const u32x4*)(Wt + (size_t)(n0 + lrow + 32 * i) * ldw + k0 + 64 + lkc);
                pa[i] = *(const u32x4*)(Act + (size_t)(m0 + lrow + 32 * i) * lda + k0 + 64 + lkc);
            }
        }
#pragma unroll
        for (int ks = 0; ks < 2; ++ks) {
            bf16x8 a[4], b[4];
#pragma unroll
            for (int i = 0; i < 4; ++i) {
                a[i] = *(const bf16x8*)(Ws + (wn * 64 + i * 16 + (lane & 15)) * LDS_ROW + ks * 32 + (lane >> 4) * 8);
                b[i] = *(const bf16x8*)(As + (wm * 64 + i * 16 + (lane & 15)) * LDS_ROW + ks * 32 + (lane >> 4) * 8);
            }
#pragma unroll
            for (int ni = 0; ni < 4; ++ni)
#pragma unroll
                for (int mi = 0; mi < 4; ++mi) acc[ni][mi] = MFMA16(a[ni], b[mi], acc[ni][mi]);
        }
    }
}
#define L64_ROW 72
#ifdef EMU
struct BufRsrc { const char* base; };
__device__ __forceinline__ BufRsrc make_rsrc(const void* p, size_t) { BufRsrc r; r.base = (const char*)p; return r; }
__device__ __forceinline__ u32x4 buf_load16(const BufRsrc& r, unsigned voff, unsigned soff) { return *(const u32x4*)(r.base + voff + soff); }
#else
typedef __amdgpu_buffer_rsrc_t BufRsrc;
__device__ __forceinline__ BufRsrc make_rsrc(const void* p, size_t bytes) { return __builtin_amdgcn_make_buffer_rsrc((void*)p, 0, (int)bytes, 0x00020000); }
__device__ __forceinline__ u32x4 buf_load16(const BufRsrc& r, unsigned voff, unsigned soff) { return __builtin_bit_cast(u32x4, __builtin_amdgcn_raw_buffer_load_b128(r, voff, soff, 0)); }
#endif
template <int NI, int MI>
__device__ __forceinline__ void mfma_gemm_tile_t(const bf16_t* Wt, int ldw, size_t wbytes, const bf16_t* Act, int lda, size_t abytes, int K, int n0, int m0, bf16_t* lds, f32x4 (&acc)[NI][MI], unsigned long long* gacc = nullptr) {
    constexpr int WR = 32 * NI, AR = 32 * MI, BUF = (WR + AR) * L64_ROW;
    const int tid = otid(), lane = tid & 63, wave = tid >> 6, wn = wave >> 1, wm = wave & 1;
    const int lrow = tid >> 3, lkc = (tid & 7) * 8;
    const BufRsrc rw = make_rsrc(Wt, wbytes), ra = make_rsrc(Act, abytes);
    unsigned vw[NI], va[MI];
#pragma unroll
    for (int i = 0; i < NI; ++i) vw[i] = (unsigned)(((size_t)(n0 + lrow + 32 * i) * ldw + lkc) * 2);
#pragma unroll
    for (int i = 0; i < MI; ++i) va[i] = (unsigned)(((size_t)(m0 + lrow + 32 * i) * lda + lkc) * 2);
    u32x4 qw0[NI], qa0[MI];
    const int nk = K / 64;
#define GT_LOAD(QW, QA, KT) { const unsigned so_ = (unsigned)(((KT) < nk) ? (KT) : (nk - 1)) * 128u; \
    _Pragma("unroll") for (int i = 0; i < NI; ++i) QW[i] = buf_load16(rw, vw[i], so_); \
    _Pragma("unroll") for (int i = 0; i < MI; ++i) QA[i] = buf_load16(ra, va[i], so_); }
#define GT_STORE(QW, QA, DST) { \
    _Pragma("unroll") for (int i = 0; i < NI; ++i) *(u32x4*)((DST) + (lrow + 32 * i) * L64_ROW + lkc) = QW[i]; \
    _Pragma("unroll") for (int i = 0; i < MI; ++i) *(u32x4*)((DST) + (WR + lrow + 32 * i) * L64_ROW + lkc) = QA[i]; }
#define GT_COMPUTE(CUR) { _Pragma("unroll") for (int ks = 0; ks < 2; ++ks) { bf16x8 b[MI], a[NI]; \
    _Pragma("unroll") for (int i = 0; i < MI; ++i) b[i] = *(const bf16x8*)((CUR) + (WR + wm * 16 * MI + i * 16 + (lane & 15)) * L64_ROW + ks * 32 + (lane >> 4) * 8); \
    _Pragma("unroll") for (int i = 0; i < NI; ++i) a[i] = *(const bf16x8*)((CUR) + (wn * 16 * NI + i * 16 + (lane & 15)) * L64_ROW + ks * 32 + (lane >> 4) * 8); \
    _Pragma("unroll") for (int ni = 0; ni < NI; ++ni) { \
        _Pragma("unroll") for (int mi = 0; mi < MI; ++mi) MFMA16_ACC(a[ni], b[mi], acc[ni][mi]); } } }
    GT_LOAD(qw0, qa0, 0)
    __syncthreads();
    GT_STORE(qw0, qa0, lds)
    __syncthreads();
    for (int kt = 0; kt < nk; kt += 2) {
        GT_LOAD(qw0, qa0, kt + 1)
        GT_COMPUTE(lds)
        GT_STORE(qw0, qa0, lds + BUF)
        __syncthreads();
        GT_LOAD(qw0, qa0, kt + 2)
        GT_COMPUTE(lds + BUF)
        GT_STORE(qw0, qa0, lds)
        __syncthreads();
    }
#undef GT_LOAD
#undef GT_STORE
#undef GT_COMPUTE
}
#define ZERO_ACC4(acc) { _Pragma("unroll") for (int i_ = 0; i_ < 4; ++i_) _Pragma("unroll") for (int j_ = 0; j_ < 4; ++j_) acc[i_][j_] = (f32x4){0.f, 0.f, 0.f, 0.f}; }
#define FOR_ACC(acc, n0, m0, BODY) { const int lane_ = otid() & 63, wave_ = otid() >> 6; \
    _Pragma("unroll") for (int ni_ = 0; ni_ < 4; ++ni_) _Pragma("unroll") for (int mi_ = 0; mi_ < 4; ++mi_) { \
        const int n = (n0) + (wave_ >> 1) * 64 + ni_ * 16 + (lane_ >> 4) * 4; const int m = (m0) + (wave_ & 1) * 64 + mi_ * 16 + (lane_ & 15); const f32x4 v = acc[ni_][mi_]; BODY } }
__device__ __forceinline__ u32x2 pack4(float a, float b, float c, float d) { u32x2 r; r.x = pack2bf(a, b); r.y = pack2bf(c, d); return r; }

__device__ __forceinline__ void convert_wt_job(const float* W, int K, int N, int Npad, bf16_t* out, int job, float* T, int ilv) {
    const int tid = otid();
    const int nkt = K / 64;
    const int n0 = (job / nkt) * 64, k0 = (job % nkt) * 64;
    __syncthreads();
    for (int idx = tid; idx < 4096; idx += NTHREADS) {
        int kk = idx >> 6, nn = idx & 63;
        int nr = n0 + nn; int src = ilv ? ((nr & 1) ? (N / 2 + (nr >> 1)) : (nr >> 1)) : nr;
        T[kk * 65 + nn] = (nr < N) ? W[(size_t)(k0 + kk) * N + src] : 0.f;
    }
    __syncthreads();
    {
        int nn = tid >> 2, part = tid & 3;
        unsigned w[8];
#pragma unroll
        for (int j = 0; j < 8; ++j) w[j] = pack2bf(T[(part * 16 + 2 * j) * 65 + nn], T[(part * 16 + 2 * j + 1) * 65 + nn]);
        u32x4* o = (u32x4*)(out + (size_t)(n0 + nn) * K + k0 + part * 16);
        o[0] = (u32x4){w[0], w[1], w[2], w[3]}; o[1] = (u32x4){w[4], w[5], w[6], w[7]};
    }
}
__device__ __forceinline__ void phase_convert_weights(const P& p, int l, char* smem, int bid, int nb) {
    float* T = (float*)smem;
    struct Item { const float* W; int K, N, Npad; bf16_t* out; };
    const Item items[12] = {
        {p.in[I_RW2] + ((size_t)l * 2 + 0) * 64 * RW, 64, RW, NPAD(RW), p.WT_W2},
        {p.in[I_RW2] + ((size_t)l * 2 + 1) * 64 * RW, 64, RW, NPAD(RW), p.WT_W2 + (size_t)NPAD(RW) * 64},
        {p.in[I_RA2] + ((size_t)l * 2 + 0) * 64 * RW, 64, RW, NPAD(RW), p.WT_A2},
        {p.in[I_RA2] + ((size_t)l * 2 + 1) * 64 * RW, 64, RW, NPAD(RW), p.WT_A2 + (size_t)NPAD(RW) * 64},
        {p.in[I_WIN] + (size_t)l * D_MODEL * D_IN, D_MODEL, D_IN, NPAD192(D_IN), p.WT_IN},
        {p.in[I_RG2] + (size_t)l * 128 * RW, 128, RW, RW, p.WT_G2},
        {p.in[I_S5GLU] + (size_t)l * SW * 2 * SW, SW, 2 * SW, 2 * SW, p.WT_GLU},
        {p.in[I_WBR] + ((size_t)l * 3 + 0) * BW * D_MODEL, BW, D_MODEL, D_MODEL, p.WT_BR},
        {p.in[I_WBR] + ((size_t)l * 3 + 1) * BW * D_MODEL, BW, D_MODEL, D_MODEL, p.WT_BR + (size_t)D_MODEL * BW},
        {p.in[I_WBR] + ((size_t)l * 3 + 2) * BW * D_MODEL, BW, D_MODEL, D_MODEL, p.WT_BR + (size_t)2 * D_MODEL * BW},
        {p.in[I_WOUT] + (size_t)l * D_MODEL * D_MODEL, D_MODEL, D_MODEL, D_MODEL, p.WT_OUT},
        {p.in[I_PWQ] + (size_t)l * D_MODEL * PQ, D_MODEL, PQ, PQ, p.WT_Q}};
    int base = 0;
#pragma unroll
    for (int it = 0; it < 12; ++it) {
        const int nj = (items[it].Npad / 64) * (items[it].K / 64);
        for (int j = (bid + nb - (base % nb)) % nb; j < nj; j += nb)
            convert_wt_job(items[it].W, items[it].K, items[it].N, items[it].Npad, items[it].out, j, T, it == 6);
        base += nj;
    }
    __syncthreads();
    {
        const float* ks = p.in[I_PKEYS] + (size_t)l * PH * 2 * 128 * 128;
        for (size_t i = (size_t)bid * NTHREADS + otid(); i < (size_t)PH * 2 * 128 * 128; i += (size_t)nb * NTHREADS) {
            const float v = ks[i]; const bf16_t hb = f2bf(v);
            p.KHI[i] = hb; p.KLO[i] = f2bf(v - bf2f(hb));
        }
    }
}

#ifdef EMU
__device__ __forceinline__ int xcd_rank() { return obid(); }
#else
__device__ __forceinline__ int xcd_rank() { return (int)((volatile LAS unsigned*)(unsigned)(SMEM_BYTES))[2]; }
#endif
__device__ __forceinline__ bool tile_map(int it, int ntm, int ntn, int PM, int& mt, int& nt) {
    const int G = gridDim.x;
    const long id = (long)it * G + xcd_rank();
    if (id >= (long)ntm * ntn) return false;
    const int full = ntm / PM; const long fullsz = (long)full * PM * ntn;
    if (id < fullsz) { const int p = (int)(id / (PM * ntn)), rem = (int)(id % (PM * ntn)); nt = rem / PM; mt = p * PM + rem % PM; }
    else { const int rem = (int)(id - fullsz), hh = ntm - full * PM; nt = rem / hh; mt = full * PM + rem % hh; }
    return true;
}

template <int NI, int MI, class Pre, class Post>
__device__ __forceinline__ void gemm_tile_run(const bf16_t* Wt, int ldw, size_t wbytes, const bf16_t* Act, int lda, size_t abytes, int K, int n0, int m0, bf16_t* lds, Pre pre, Post post) {
    f32x4 acc[NI][MI];
#pragma unroll
    for (int i = 0; i < NI; ++i)
#pragma unroll
        for (int j = 0; j < MI; ++j) acc[i][j] = (f32x4){0.f, 0.f, 0.f, 0.f};
    pre(m0, n0, acc, lds);
    mfma_gemm_tile_t<NI, MI>(Wt, ldw, wbytes, Act, lda, abytes, K, n0, m0, lds, acc);
    const int lane = otid() & 63, wave = otid() >> 6;
#pragma unroll
    for (int ni = 0; ni < NI; ++ni)
#pragma unroll
        for (int mi = 0; mi < MI; ++mi)
            post(ni, mi, m0 + (wave & 1) * 16 * MI + mi * 16 + (lane & 15), n0 + (wave >> 1) * 16 * NI + ni * 16 + (lane >> 4) * 4, acc[ni][mi]);
}
struct NoPre { template <class A> __device__ __forceinline__ void operator()(int, int, A&, bf16_t*) const {} };
template <int NI, class PreM, class PreT, class Post>
__device__ __forceinline__ void gemm_phase(const bf16_t* Wt, int ldw, size_t wbytes, const bf16_t* Act, int lda, size_t abytes, int K, int N, bf16_t* lds, PreM prem, PreT pret, Post post) {
    const int ntn = N / (32 * NI), ntm = MTOT / 256 - 1;
    const int PM = (ntn >= 16) ? 2 : ((ntn >= 8) ? 4 : 8);
    for (int it = 0;; ++it) {
        int mt_, nt_; if (!tile_map(it, ntm, ntn, PM, mt_, nt_)) break;
        gemm_tile_run<NI, 8>(Wt, ldw, wbytes, Act, lda, abytes, K, nt_ * 32 * NI, mt_ * 256, lds, prem, post);
    }
    for (int job = obid(); job < 4 * ntn; job += gridDim.x)
        gemm_tile_run<NI, 2>(Wt, ldw, wbytes, Act, lda, abytes, K, (job >> 2) * 32 * NI, MTOT - 256 + (job & 3) * 64, lds, pret, post);
}

__device__ __forceinline__ void phase_init(const P& p, char* smem) {
    const int tid = otid();
    float* sc = (float*)smem;
    for (int i = tid; i < D_MODEL; i += NTHREADS) { sc[i] = siluf_(p.in[I_CCTX][i]); sc[D_MODEL + i] = siluf_(p.in[I_C][i]); }
    __syncthreads();
    const int ncolblk = (6 * D_MODEL) / NTHREADS;
    for (int job = obid(); job < DEPTH * ncolblk; job += gridDim.x) {
        int l = job / ncolblk, n = (job % ncolblk) * NTHREADS + tid;
        const float* w = p.in[I_WMOD] + (size_t)l * D_MODEL * 6 * D_MODEL + n;
        float a0 = 0.f, a1 = 0.f;
        for (int k = 0; k < D_MODEL; ++k) { float wv = w[(size_t)k * 6 * D_MODEL]; a0 += sc[k] * wv; a1 += sc[D_MODEL + k] * wv; }
        float b = p.in[I_BMOD][l * 6 * D_MODEL + n];
        p.MOD[(size_t)(l * 2 + 0) * 6 * D_MODEL + n] = a0 + b;
        p.MOD[(size_t)(l * 2 + 1) * 6 * D_MODEL + n] = a1 + b;
    }
    const size_t gtid = (size_t)obid() * NTHREADS + tid, gn = (size_t)gridDim.x * NTHREADS;
    for (size_t i = gtid; i < (size_t)CTX * D_MODEL; i += gn) p.X[i] = p.in[I_CTX][i];
    for (size_t i = gtid; i < (size_t)SEQ * D_MODEL; i += gn) p.X[(size_t)CTX * D_MODEL + i] = p.in[I_X][i];
    __syncthreads();
}

__device__ __forceinline__ void phase_s5const(const P& p, int l) {
    const size_t gtid = (size_t)obid() * NTHREADS + otid(), gn = (size_t)gridDim.x * NTHREADS;
    for (size_t i = gtid; i < (size_t)2 * SG * 64; i += gn) {
        int d = (int)(i / (SG * 64)), g = (int)((i / 64) % SG), s = (int)(i % 64);
        size_t li = ((size_t)(l * 2 + d) * SG + g) * 64 + s;
        float lre = p.in[I_S5LRE][li], lim = p.in[I_S5LIM][li];
        float dt = expf(p.in[I_S5LS][(l * 2 + d) * SG + g]);
        float mag = expf(lre * dt);
        float are = mag * cosf(lim * dt), aim = mag * sinf(lim * dt);
        float den = lre * lre + lim * lim;
        float fre = ((are - 1.0f) * lre + aim * lim) / den;
        float fim = (aim * lre - (are - 1.0f) * lim) / den;
        p.S5A[i * 2 + 0] = are; p.S5A[i * 2 + 1] = aim;
        const float* bre = p.in[I_S5BRE] + (((size_t)l * SG + g) * 64 + s) * 16;
        const float* bim = p.in[I_S5BIM] + (((size_t)l * SG + g) * 64 + s) * 16;
        for (int c = 0; c < 16; ++c) {
            p.S5BB[(i * 16 + c) * 2 + 0] = fre * bre[c] - fim * bim[c];
            p.S5BB[(i * 16 + c) * 2 + 1] = fre * bim[c] + fim * bre[c];
        }
    }
}

__device__ __forceinline__ void phase_norm(const P& p, int l, int which) {
    const int lane = otid() & 63;
    const int gw = (obid() * NTHREADS + otid()) >> 6, nw = (gridDim.x * NTHREADS) >> 6;
    const float* g = p.in[which ? I_N2G : I_N1G] + l * D_MODEL;
    constexpr int NJ = (D_MODEL + 255) / 256;
    for (int t = gw; t < MTOT; t += nw) {
        const float* x = p.X + (size_t)t * D_MODEL;
        const float* mod = p.MOD + (size_t)(l * 2 + (t >= CTX ? 1 : 0)) * 6 * D_MODEL + (which ? 3 * D_MODEL : 0);
        float4 v[NJ]; float ss = 0.f;
#pragma unroll
        for (int j = 0; j < NJ; ++j) {
            const int e = j * 256 + lane * 4;
            if (e < D_MODEL) v[j] = *(const float4*)(x + e); else { v[j].x = 0.f; v[j].y = 0.f; v[j].z = 0.f; v[j].w = 0.f; }
            ss += v[j].x * v[j].x + v[j].y * v[j].y + v[j].z * v[j].z + v[j].w * v[j].w;
        }
        ss = wave_sum(ss);
        const float rstd = rsqrtf(ss / D_MODEL + 1e-6f);
#pragma unroll
        for (int j = 0; j < NJ; ++j) {
            const int e = j * 256 + lane * 4;
            if (e < D_MODEL) {
                const float4 gg = *(const float4*)(g + e), sc = *(const float4*)(mod + D_MODEL + e), sh = *(const float4*)(mod + e);
                *(u32x2*)(p.H + (size_t)t * D_MODEL + e) = pack4(v[j].x * rstd * gg.x * (1.0f + sc.x) + sh.x, v[j].y * rstd * gg.y * (1.0f + sc.y) + sh.y,
                                                                 v[j].z * rstd * gg.z * (1.0f + sc.z) + sh.z, v[j].w * rstd * gg.w * (1.0f + sc.w) + sh.w);
            }
        }
    }
}

__device__ __forceinline__ void phase_gemm_in(const P& p, int l, char* smem) {
    constexpr int NI = 4, MI = 8;
    const int ntn = NPAD192(D_IN) / 128, ntm = MTOT / 256;
    for (int it = 0;; ++it) {
        int mt_, nt_; if (!tile_map(it, ntm, ntn, 4, mt_, nt_)) break;
        const int m0 = mt_ * 256, n0 = nt_ * 128;
        f32x4 acc[NI][MI];
#pragma unroll
        for (int i = 0; i < NI; ++i)
#pragma unroll
            for (int j = 0; j < MI; ++j) acc[i][j] = (f32x4){0.f, 0.f, 0.f, 0.f};
        mfma_gemm_tile_t<NI, MI>(p.WT_IN, D_MODEL, (size_t)NPAD192(D_IN) * D_MODEL * 2, p.H, D_MODEL, (size_t)MTOT * D_MODEL * 2, D_MODEL, n0, m0, (bf16_t*)smem, acc);
        const int lane = otid() & 63, wave = otid() >> 6;
#pragma unroll
        for (int ni = 0; ni < NI; ++ni)
#pragma unroll
            for (int mi = 0; mi < MI; ++mi) {
                const int n = n0 + (wave >> 1) * 16 * NI + ni * 16 + (lane >> 4) * 4, m = m0 + (wave & 1) * 16 * MI + mi * 16 + (lane & 15);
                const u32x2 pk_ = pack4(acc[ni][mi][0], acc[ni][mi][1], acc[ni][mi][2], acc[ni][mi][3]);
                if (n < ZG) *(u32x2*)(p.Z + (size_t)m * ZLD + n) = pk_;
                else if (n < D_IN) *(u32x2*)(p.ZGT + ((((size_t)(m >> 4) * (3 * D_MODEL / 16) + ((n - ZG) >> 4)) * 64 + lane) * 4)) =
                    pack4(sigmoidf_(acc[ni][mi][0]), sigmoidf_(acc[ni][mi][1]), sigmoidf_(acc[ni][mi][2]), sigmoidf_(acc[ni][mi][3]));
            }
    }
}

__device__ __forceinline__ void unpack8(const u32x4 w, float (&f)[8]) {
    f[0] = LO16(w.x); f[1] = HI16(w.x); f[2] = LO16(w.y); f[3] = HI16(w.y); f[4] = LO16(w.z); f[5] = HI16(w.z); f[6] = LO16(w.w); f[7] = HI16(w.w);
}
__device__ __forceinline__ u32x4 pack8(const float (&f)[8]) {
    u32x4 o; o.x = pack2bf(f[0], f[1]); o.y = pack2bf(f[2], f[3]);
    o.z = pack2bf(f[4], f[5]); o.w = pack2bf(f[6], f[7]); return o;
}
__device__ __forceinline__ void load8f(const float* p, float (&f)[8]) {
    const float4 a = *(const float4*)p, b = *(const float4*)(p + 4);
    f[0] = a.x; f[1] = a.y; f[2] = a.z; f[3] = a.w; f[4] = b.x; f[5] = b.y; f[6] = b.z; f[7] = b.w;
}
__device__ __forceinline__ void store8f(float* p, const float (&f)[8]) {
    float4 a, b; a.x = f[0]; a.y = f[1]; a.z = f[2]; a.w = f[3]; b.x = f[4]; b.y = f[5]; b.z = f[6]; b.w = f[7];
    *(float4*)p = a; *(float4*)(p + 4) = b;
}
__device__ __forceinline__ void conv8(const bf16_t* zp, const float* conv, int c0, bool act, bool first, bool last, float (&out)[8]) {
    const u32x4 z4 = {0u, 0u, 0u, 0u};
    const u32x4 a0 = act ? *(const u32x4*)(zp + c0) : z4;
    const u32x4 am = (act && !first) ? *(const u32x4*)(zp + c0 - ZLD) : z4;
    const u32x4 an = (act && !last) ? *(const u32x4*)(zp + c0 + ZLD) : z4;
    float w0[8], w1[8], w2[8], f0[8], fm[8], fn[8];
    if (act) { load8f(conv + c0, w0); load8f(conv + RWKV_IN + c0, w1); load8f(conv + 2 * RWKV_IN + c0, w2); }
    else {
#pragma unroll
        for (int e = 0; e < 8; ++e) { w0[e] = 0.f; w1[e] = 0.f; w2[e] = 0.f; }
    }
    unpack8(a0, f0); unpack8(am, fm); unpack8(an, fn);
#pragma unroll
    for (int e = 0; e < 8; ++e) out[e] = w1[e] * f0[e] + w0[e] * fm[e] + w2[e] * fn[e];
}
__device__ __forceinline__ void phase_rwkv_prep1(const P& p, int l) {
    const int lane = otid() & 63;
    const int gw = (obid() * NTHREADS + otid()) >> 6, nw = (gridDim.x * NTHREADS) >> 6;
    const float* conv = p.in[I_RCONV] + (size_t)l * 3 * RWKV_IN;
    const float* k_k = p.in[I_RKK] + (size_t)l * RW;
    const bool act = lane * 8 < RW, act2 = lane * 8 < 384;
    float kkw[8];
    if (act) load8f(k_k + lane * 8, kkw);
    else {
#pragma unroll
        for (int e = 0; e < 8; ++e) kkw[e] = 0.f;
    }
    for (int t = gw; t < MTOT; t += nw) {
        const bool first = (t == 0) || (t == CTX), last = (t == CTX - 1) || (t == MTOT - 1);
        const bf16_t* zp = p.Z + (size_t)t * ZLD + ZR;
        float rv[8], kv[8], vv[8], lr[8];
        conv8(zp, conv, 0 * RW + lane * 8, act, first, last, rv);
        conv8(zp, conv, 1 * RW + lane * 8, act, first, last, kv);
        conv8(zp, conv, 2 * RW + lane * 8, act, first, last, vv);
        conv8(zp, conv, 3 * RW + lane * 8, act2, first, last, lr);
        float kk[8]; float ss = 0.f;
#pragma unroll
        for (int e = 0; e < 8; ++e) { kk[e] = kv[e] * kkw[e]; ss += kk[e] * kk[e]; }
        ss += __shfl_xor(ss, 1, 64); ss += __shfl_xor(ss, 2, 64); ss += __shfl_xor(ss, 4, 64);
        const float inv = 1.0f / fmaxf(sqrtf(ss), 1e-12f);
#pragma unroll
        for (int e = 0; e < 8; ++e) kk[e] *= inv;
        if (act) {
            const size_t o = (size_t)t * RW + lane * 8;
            *(u32x4*)(p.R + o) = pack8(rv); *(u32x4*)(p.KS + o) = pack8(kv); *(u32x4*)(p.V + o) = pack8(vv); *(u32x4*)(p.KK + o) = pack8(kk);
        }
        if (act2) {
            const int cc = lane * 8;
            if (cc < 128) {
#pragma unroll
                for (int e = 0; e < 8; ++e) lr[e] = tanhf_(lr[e]);
                *(u32x4*)(p.LR + (size_t)t * 256 + cc) = pack8(lr);
            } else if (cc < 256) {
                *(u32x4*)(p.LR + (size_t)t * 256 + cc) = pack8(lr);
            } else {
#pragma unroll
                for (int e = 0; e < 8; ++e) lr[e] = sigmoidf_(lr[e]);
                *(u32x4*)(p.GS + (size_t)t * 128 + cc - 256) = pack8(lr);
            }
        }
    }
}
__device__ __forceinline__ void phase_rwkv_prep2(const P& p, int l, char* smem) {
    const int ntm = MTOT / 128, ntn = NPAD(RW) / 128;
    const float* k_a = p.in[I_RKA] + (size_t)l * RW;
    const float* r_k = p.in[I_RRK] + (size_t)l * RW;
    for (int job = obid(); job < ntm * ntn * 2; job += gridDim.x) {
        const int d = job % 2, n0 = ((job / 2) % ntn) * 128, m0 = (job / (2 * ntn)) * 128;
        const float* w0 = p.in[I_RW0] + (size_t)(l * 2 + d) * RW;
        const float* a0 = p.in[I_RA0] + (size_t)(l * 2 + d) * RW;
        f32x4 accw[4][4], acca[4][4]; ZERO_ACC4(accw); ZERO_ACC4(acca);
        mfma_gemm_tile(p.WT_W2 + (size_t)d * NPAD(RW) * 64, 64, p.LR + d * 64, 256, 64, n0, m0, (bf16_t*)smem, accw);
        mfma_gemm_tile(p.WT_A2 + (size_t)d * NPAD(RW) * 64, 64, p.LR + 128 + d * 64, 256, 64, n0, m0, (bf16_t*)smem, acca);
        const int lane = otid() & 63, wave = otid() >> 6;
#pragma unroll
        for (int mi = 0; mi < 4; ++mi) {
            const int m = m0 + (wave & 1) * 64 + mi * 16 + (lane & 15);
            float bon = 0.f;
#pragma unroll
            for (int ni = 0; ni < 4; ++ni) {
                const int n = n0 + (wave >> 1) * 64 + ni * 16 + (lane >> 4) * 4;
                if (n < RW) {
                    const u32x2 kq = *(const u32x2*)(p.KS + (size_t)m * RW + n), kkq = *(const u32x2*)(p.KK + (size_t)m * RW + n), rq = *(const u32x2*)(p.R + (size_t)m * RW + n);
                    const float kv[4] = {LO16(kq.x), HI16(kq.x), LO16(kq.y), HI16(kq.y)};
                    const float kkv[4] = {LO16(kkq.x), HI16(kkq.x), LO16(kkq.y), HI16(kkq.y)};
                    const float rv[4] = {LO16(rq.x), HI16(rq.x), LO16(rq.y), HI16(rq.y)};
                    float lw[4], kd[4], bb[4];
#pragma unroll
                    for (int e = 0; e < 4; ++e) {
                        const float x = w0[n + e] + accw[ni][mi][e];
                        lw[e] = -fexp_(-softplusf_(-x) - 0.5f);
                        const float aa = sigmoidf_(a0[n + e] + acca[ni][mi][e]);
                        kd[e] = kv[e] * (1.0f + (aa - 1.0f) * k_a[n + e]);
                        bb[e] = kkv[e] * aa;
                        bon += rv[e] * kd[e] * r_k[n + e];
                    }
                    const size_t o = ((size_t)d * MTOT + m) * RW + n;
                    float4 lo4; lo4.x = lw[0]; lo4.y = lw[1]; lo4.z = lw[2]; lo4.w = lw[3];
                    *(float4*)(p.LW + o) = lo4;
                    *(u32x2*)(p.KD + o) = pack4(kd[0], kd[1], kd[2], kd[3]);
                    *(u32x2*)(p.BB + o) = pack4(bb[0], bb[1], bb[2], bb[3]);
                }
            }
            bon += __shfl_xor(bon, 16, 64); bon += __shfl_xor(bon, 32, 64);
            const int hh = (n0 + (wave >> 1) * 64) >> 6;
            if ((lane >> 4) == 0 && hh < RH) p.BONUS[((size_t)d * MTOT + m) * RH + hh] = bon;
        }
    }
}

#define CH_ROW 72
#define SEQ_REC 16640
#define CH_SLOT (64 * CH_ROW)
#define CH_XR_OFF (7 * CH_SLOT * 2)
#define CH_AAB_OFF (CH_XR_OFF + 64 * 132 * 4)
#define CH_GC_OFF (CH_AAB_OFF + 64 * 72 * 4)
template <int MT, int NT>
__device__ __forceinline__ void lds_mm(const bf16_t* A, int m0, const bf16_t* Bt, int n0, f32x4 (&acc)[MT][NT]) {
    const int lane = otid() & 63, q = lane >> 4, r = lane & 15;
#pragma unroll
    for (int s = 0; s < 2; ++s) {
        bf16x8 a[MT], b[NT];
#pragma unroll
        for (int i = 0; i < MT; ++i) a[i] = *(const bf16x8*)(A + (m0 + i * 16 + r) * CH_ROW + s * 32 + q * 8);
#pragma unroll
        for (int i = 0; i < NT; ++i) b[i] = *(const bf16x8*)(Bt + (n0 + i * 16 + r) * CH_ROW + s * 32 + q * 8);
#pragma unroll
        for (int i = 0; i < MT; ++i)
#pragma unroll
            for (int jj = 0; jj < NT; ++jj) acc[i][jj] = MFMA16(a[i], b[jj], acc[i][jj]);
    }
}
__device__ __forceinline__ void rwkv_chunk_job(const P& p, int job, char* smem) {
    const int tid = otid(), lane = tid & 63, wv = tid >> 6, q = lane >> 4, r = lane & 15;
    const int d = job / (NC * RH), n = (job / RH) % NC, h = job % RH;
    const size_t base = (size_t)(d * NC + n) * RH + h;
    bf16_t* S0 = (bf16_t*)smem; bf16_t* S1 = S0 + CH_SLOT; bf16_t* S2 = S1 + CH_SLOT; bf16_t* S3 = S2 + CH_SLOT;
    bf16_t* S4 = S3 + CH_SLOT; bf16_t* S5 = S4 + CH_SLOT; bf16_t* S6 = S5 + CH_SLOT;
    float* X = (float*)(smem + CH_XR_OFF);
    float* AABt = (float*)(smem + CH_AAB_OFF);
    bf16_t* U0t = (bf16_t*)(smem + CH_AAB_OFF);
    bf16_t* Aht = U0t + CH_SLOT;
    float* GC = (float*)(smem + CH_GC_OFF);
    __syncthreads();
    u32x4 gkk[2], gr[2], gv[2], gkd[2], gbb[2]; float lw[2][8];
#pragma unroll
    for (int it = 0; it < 2; ++it) {
        const int c = tid + 256 * it, i = c >> 3, k0 = (c & 7) * 8; const int tok = 64 * n + (d ? 63 - i : i);
        const size_t o1 = (size_t)tok * RW + h * 64 + k0, o2 = ((size_t)d * MTOT + tok) * RW + h * 64 + k0;
        load8f(p.LW + o2, lw[it]);
        gkk[it] = *(const u32x4*)(p.KK + o1); gr[it] = *(const u32x4*)(p.R + o1); gv[it] = *(const u32x4*)(p.V + o1);
        gkd[it] = *(const u32x4*)(p.KD + o2); gbb[it] = *(const u32x4*)(p.BB + o2);
    }
#pragma unroll
    for (int it = 0; it < 2; ++it) { const int c = tid + 256 * it; store8f(X + (c >> 3) * 132 + (c & 7) * 8, lw[it]); }
    __syncthreads();
    {
        const int k = tid & 63, seg = tid >> 6;
        float v[16]; float run = 0.f;
#pragma unroll
        for (int e = 0; e < 16; ++e) { run += X[(seg * 16 + e) * 132 + k]; v[e] = run; }
        AABt[seg * 64 + k] = run;
        __syncthreads();
        float off = 0.f;
        for (int s2 = 0; s2 < seg; ++s2) off += AABt[s2 * 64 + k];
#pragma unroll
        for (int e = 0; e < 16; ++e) X[(seg * 16 + e) * 132 + k] = v[e] + off;
    }
    __syncthreads();
#pragma unroll
    for (int it = 0; it < 2; ++it) {
        const int c = tid + 256 * it, i = c >> 3, k0 = (c & 7) * 8;
        float L[8], Lp[8], LC[8], kkv[8], rv[8], vv[8], kdv[8], bbv[8];
        load8f(X + i * 132 + k0, L); load8f(X + 63 * 132 + k0, LC);
        if (i > 0) load8f(X + (i - 1) * 132 + k0, Lp);
        else {
#pragma unroll
            for (int e = 0; e < 8; ++e) Lp[e] = 0.f;
        }
        unpack8(gkk[it], kkv); unpack8(gr[it], rv); unpack8(gv[it], vv); unpack8(gkd[it], kdv); unpack8(gbb[it], bbv);
        float at[8], rt[8], bt[8], kt[8], bh[8], kh[8];
#pragma unroll
        for (int e = 0; e < 8; ++e) {
            const float eL = fexp_(L[e]), eLp = fexp_(Lp[e]), eNL = fexp_(-L[e]), eCL = fexp_(LC[e] - L[e]);
            at[e] = -kkv[e] * eLp; rt[e] = rv[e] * eL; bt[e] = bbv[e] * eNL; kt[e] = kdv[e] * eNL; bh[e] = bbv[e] * eCL; kh[e] = kdv[e] * eCL;
            if (i == 63) GC[k0 + e] = eL;
        }
        *(u32x4*)(S0 + i * CH_ROW + k0) = pack8(at);
        store8f(X + i * 132 + 64 + k0, at);
        *(u32x4*)(S1 + i * CH_ROW + k0) = pack8(rt);
        *(u32x4*)(S2 + i * CH_ROW + k0) = pack8(bt);
        *(u32x4*)(S3 + i * CH_ROW + k0) = pack8(kt);
#pragma unroll
        for (int e = 0; e < 8; ++e) {
            S4[(k0 + e) * CH_ROW + i] = f2bf(vv[e]);
            S5[(k0 + e) * CH_ROW + i] = f2bf(bh[e]);
            S6[(k0 + e) * CH_ROW + i] = f2bf(kh[e]);
        }
    }
    __syncthreads();
    {
        f32x4 acc[4][4]; ZERO_ACC4(acc);
        lds_mm<4, 4>((wv < 2) ? S0 : S1, 0, (wv & 1) ? S3 : S2, 0, acc);
        __syncthreads();
#pragma unroll
        for (int mt = 0; mt < 4; ++mt)
#pragma unroll
            for (int nt = 0; nt < 4; ++nt) {
                const int jc = nt * 16 + r, i0 = mt * 16 + 4 * q;
                if (wv == 0) {
                    f32x4 o;
#pragma unroll
                    for (int e = 0; e < 4; ++e) o[e] = (jc < i0 + e) ? acc[mt][nt][e] : 0.f;
                    *(f32x4*)(AABt + jc * 72 + i0) = o;
                } else {
                    bf16_t* dst = (wv == 1) ? S0 : ((wv == 2) ? S2 : S3);
#pragma unroll
                    for (int e = 0; e < 4; ++e) {
                        const bool ok = (wv == 1) ? (jc < i0 + e) : (jc <= i0 + e);
                        dst[(i0 + e) * CH_ROW + jc] = f2bf(ok ? acc[mt][nt][e] : 0.f);
                    }
                }
            }
    }
    __syncthreads();
    {
        f32x4 acc[1][4];
#pragma unroll
        for (int nt = 0; nt < 4; ++nt) acc[0][nt] = (f32x4){0.f, 0.f, 0.f, 0.f};
        lds_mm<1, 4>(S0, 16 * wv, S4, 0, acc);
#pragma unroll
        for (int nt = 0; nt < 4; ++nt)
#pragma unroll
            for (int e = 0; e < 4; ++e) X[(16 * wv + 4 * q + e) * 132 + nt * 16 + r] = acc[0][nt][e];
    }
    __syncthreads();
    if (tid < 128) {
        const int c = tid;
        for (int bi = 0; bi < 4; ++bi) {
            float acc[16];
#pragma unroll
            for (int e = 0; e < 16; ++e) acc[e] = X[(16 * bi + e) * 132 + c];
            for (int jj = 0; jj < 16 * bi; ++jj) {
                const float uj = X[jj * 132 + c];
                const f32x4* ap = (const f32x4*)(AABt + jj * 72 + 16 * bi);
                const f32x4 a0 = ap[0], a1 = ap[1], a2 = ap[2], a3 = ap[3];
#pragma unroll
                for (int e = 0; e < 4; ++e) { acc[e] += a0[e] * uj; acc[4 + e] += a1[e] * uj; acc[8 + e] += a2[e] * uj; acc[12 + e] += a3[e] * uj; }
            }
#pragma unroll
            for (int e = 0; e < 16; ++e) {
                const float u = acc[e];
                X[(16 * bi + e) * 132 + c] = u;
                const f32x4* ap = (const f32x4*)(AABt + (16 * bi + e) * 72 + 16 * bi);
                const f32x4 a0 = ap[0], a1 = ap[1], a2 = ap[2], a3 = ap[3];
#pragma unroll
                for (int e2 = 0; e2 < 16; ++e2) if (e2 > e) acc[e2] += ((e2 < 4) ? a0[e2 & 3] : (e2 < 8) ? a1[e2 & 3] : (e2 < 12) ? a2[e2 & 3] : a3[e2 & 3]) * u;
            }
        }
    }
    __syncthreads();
    if (tid < 128) {
        const int c = tid;
        bf16_t* dst = (c < 64) ? (U0t + c * CH_ROW) : (Aht + (c - 64) * CH_ROW);
        u32x4 ov[8];
#pragma unroll
        for (int g = 0; g < 8; ++g) {
            float v[8];
#pragma unroll
            for (int e = 0; e < 8; ++e) v[e] = X[(g * 8 + e) * 132 + c];
            ov[g].x = pack2bf(v[0], v[1]); ov[g].y = pack2bf(v[2], v[3]);
            ov[g].z = pack2bf(v[4], v[5]); ov[g].w = pack2bf(v[6], v[7]);
        }
#pragma unroll
        for (int g = 0; g < 8; ++g) *(u32x4*)(dst + g * 8) = ov[g];
    }
    __syncthreads();
    {
        f32x4 acc[4][4]; ZERO_ACC4(acc);
        char* rec = p.REC + base * SEQ_REC;
        if (wv == 0) {
            lds_mm<4, 4>(Aht, 0, S5, 0, acc);
#pragma unroll
            for (int nt = 0; nt < 4; ++nt)
#pragma unroll
                for (int s2 = 0; s2 < 2; ++s2) {
                    u32x4 o;
                    o.x = pack2bf(acc[2 * s2][nt][0], acc[2 * s2][nt][1]); o.y = pack2bf(acc[2 * s2][nt][2], acc[2 * s2][nt][3]);
                    o.z = pack2bf(acc[2 * s2 + 1][nt][0], acc[2 * s2 + 1][nt][1]); o.w = pack2bf(acc[2 * s2 + 1][nt][2], acc[2 * s2 + 1][nt][3]);
                    *(u32x4*)(rec + (((nt * 2 + s2) * 64 + lane) * 8) * 2) = o;
                }
        } else if (wv == 1) {
            lds_mm<4, 4>(S5, 0, U0t, 0, acc);
            lds_mm<4, 4>(S6, 0, S4, 0, acc);
#pragma unroll
            for (int mt = 0; mt < 4; ++mt)
#pragma unroll
                for (int nt = 0; nt < 4; ++nt) *(u32x2*)(rec + 8192 + (((nt * 4 + mt) * 64 + lane) * 4) * 2) = pack4(acc[mt][nt][0], acc[mt][nt][1], acc[mt][nt][2], acc[mt][nt][3]);
        } else if (wv == 2) {
            lds_mm<4, 4>(S2, 0, Aht, 0, acc);
#pragma unroll
            for (int mt = 0; mt < 4; ++mt)
#pragma unroll
                for (int nt = 0; nt < 4; ++nt)
#pragma unroll
                    for (int e = 0; e < 4; ++e) {
                        const int t = mt * 16 + 4 * q + e, kc = nt * 16 + r;
                        p.QH[(base * 64 + t) * 64 + kc] = f2bf(acc[mt][nt][e] + bf2f(S1[t * CH_ROW + kc]));
                    }
        } else if (wv == 3) {
            lds_mm<4, 4>(S2, 0, U0t, 0, acc);
            lds_mm<4, 4>(S3, 0, S4, 0, acc);
#pragma unroll
            for (int mt = 0; mt < 4; ++mt)
#pragma unroll
                for (int nt = 0; nt < 4; ++nt) *(f32x4*)(p.Y0T + (((base * 4 + mt) * 4 + nt) * 64 + lane) * 4) = acc[mt][nt];
        }
        if (tid < 64) ((float*)(rec + 16384))[tid] = GC[tid];
    }
}

#define SEQ_SLOT 16896
__device__ __forceinline__ void rwkv_seq_gload(const P& p, size_t base, int tid, u32x4 (&g)[5]) {
    const u32x4* m = (const u32x4*)(p.REC + base * SEQ_REC);
#pragma unroll
    for (int i = 0; i < 4; ++i) g[i] = m[tid + 256 * i];
    if (tid < 16) g[4] = m[1024 + tid];
}
__device__ __forceinline__ void rwkv_seq_lstore(char* slot, int tid, const u32x4 (&g)[5]) {
    u32x4* d = (u32x4*)slot;
#pragma unroll
    for (int i = 0; i < 4; ++i) d[tid + 256 * i] = g[i];
    if (tid < 16) d[1024 + tid] = g[4];
}
__device__ __forceinline__ void rwkv_seq_step(const P& p, const char* slot, size_t base, int wv, int lane, f32x4 (&X)[4]) {
    const int q = lane >> 4, r = lane & 15;
    const bf16_t* mt = (const bf16_t*)slot; const bf16_t* ntb = (const bf16_t*)(slot + 8192); const float* gc = (const float*)(slot + 16384);
    unsigned xh[4][2];
#pragma unroll
    for (int kt = 0; kt < 4; ++kt) {
        xh[kt][0] = pack2bf(X[kt][0], X[kt][1]); xh[kt][1] = pack2bf(X[kt][2], X[kt][3]);
        *(u32x2*)(p.SN + (base * 64 + 16 * wv + r) * 64 + 16 * kt + 4 * q) = (u32x2){xh[kt][0], xh[kt][1]};
    }
    bf16x8 bh[2];
#pragma unroll
    for (int s2 = 0; s2 < 2; ++s2) bh[s2] = __builtin_bit_cast(bf16x8, ((u32x4){xh[2 * s2][0], xh[2 * s2][1], xh[2 * s2 + 1][0], xh[2 * s2 + 1][1]}));
#pragma unroll
    for (int tile = 0; tile < 4; ++tile) {
        const u32x2 nb = *(const u32x2*)(ntb + ((wv * 4 + tile) * 64 + lane) * 4);
        const f32x4 g4 = *(const f32x4*)(gc + tile * 16 + 4 * q);
        f32x4 acc;
        acc[0] = g4[0] * X[tile][0] + LO16(nb.x); acc[1] = g4[1] * X[tile][1] + HI16(nb.x);
        acc[2] = g4[2] * X[tile][2] + LO16(nb.y); acc[3] = g4[3] * X[tile][3] + HI16(nb.y);
#pragma unroll
        for (int s2 = 0; s2 < 2; ++s2) {
            const bf16x8 ah = *(const bf16x8*)(mt + ((tile * 2 + s2) * 64 + lane) * 8);
            acc = MFMA16(ah, bh[s2], acc);
        }
        X[tile] = acc;
    }
}
__device__ __forceinline__ void rwkv_seq_job(const P& p, int job, char* smem) {
    const int tid = otid(), lane = tid & 63, wv = tid >> 6;
    const int d = job / RH, h = job % RH;
    f32x4 X[4];
#pragma unroll
    for (int kt = 0; kt < 4; ++kt) X[kt] = (f32x4){0.f, 0.f, 0.f, 0.f};
    u32x4 g0[5], g1[5], g2[5];
#define SEQ_BASE(s_) ((size_t)(d * NC + chunk_order(d, ((s_) < NC) ? (s_) : NC - 1)) * RH + h)
    __syncthreads();
    rwkv_seq_gload(p, SEQ_BASE(0), tid, g0);
    rwkv_seq_gload(p, SEQ_BASE(1), tid, g1);
    rwkv_seq_gload(p, SEQ_BASE(2), tid, g2);
    rwkv_seq_lstore(smem, tid, g0);
    __syncthreads();
    for (int s = 0; s < NC; s += 6) {
#define SEQ_SUB(u, GFREE, GNEXT) \
        if (s + (u) < NC) { \
            rwkv_seq_gload(p, SEQ_BASE(s + (u) + 3), tid, GFREE); \
            rwkv_seq_step(p, smem + (((u) & 1) ? SEQ_SLOT : 0), SEQ_BASE(s + (u)), wv, lane, X); \
            rwkv_seq_lstore(smem + (((u) & 1) ? 0 : SEQ_SLOT), tid, GNEXT); \
        } \
        __syncthreads();
        SEQ_SUB(0, g0, g1)
        SEQ_SUB(1, g1, g2)
        SEQ_SUB(2, g2, g0)
        SEQ_SUB(3, g0, g1)
        SEQ_SUB(4, g1, g2)
        SEQ_SUB(5, g2, g0)
#undef SEQ_SUB
    }
#undef SEQ_BASE
}
struct RoBuf { bf16x8 a[2]; bf16x8 b[4][2]; f32x4 y0[4]; };
__device__ __forceinline__ void rwkv_out_load(const P& p, int job, int wv, int lane, RoBuf& o) {
    const int q = lane >> 4, r = lane & 15;
    const size_t base = (size_t)job;
#pragma unroll
    for (int s2 = 0; s2 < 2; ++s2) {
        o.a[s2] = *(const bf16x8*)(p.QH + (base * 64 + 16 * wv + r) * 64 + s2 * 32 + q * 8);
#pragma unroll
        for (int nt = 0; nt < 4; ++nt) o.b[nt][s2] = *(const bf16x8*)(p.SN + (base * 64 + nt * 16 + r) * 64 + s2 * 32 + q * 8);
    }
#pragma unroll
    for (int nt = 0; nt < 4; ++nt) o.y0[nt] = *(const f32x4*)(p.Y0T + (((base * 4 + wv) * 4 + nt) * 64 + lane) * 4);
}
__device__ __forceinline__ void rwkv_out_compute(const P& p, int job, int wv, int lane, const RoBuf& o) {
    const int q = lane >> 4, r = lane & 15;
    const int d = job / (NC * RH), n = (job / RH) % NC, h = job % RH;
#pragma unroll
    for (int nt = 0; nt < 4; ++nt) {
        f32x4 acc = o.y0[nt];
        acc = MFMA16(o.a[0], o.b[nt][0], acc);
        acc = MFMA16(o.a[1], o.b[nt][1], acc);
#pragma unroll
        for (int e = 0; e < 4; ++e) {
            const int t = 16 * wv + 4 * q + e; const int tok = 64 * n + (d ? 63 - t : t);
            p.Y[((size_t)d * MTOT + tok) * RW + h * 64 + nt * 16 + r] = acc[e];
        }
    }
}
__device__ __forceinline__ void phase_rwkv_out(const P& p) {
    const int tid = otid(), lane = tid & 63, wv = tid >> 6;
    if (wv >= 4) return;
    const int G = gridDim.x, total = 2 * NC * RH;
    int job = obid();
    if (job >= total) return;
    RoBuf b0, b1;
    rwkv_out_load(p, job, wv, lane, b0);
    for (; job < total; job += 2 * G) {
        if (job + G < total) rwkv_out_load(p, job + G, wv, lane, b1);
        rwkv_out_compute(p, job, wv, lane, b0);
        if (job + G < total) {
            if (job + 2 * G < total) rwkv_out_load(p, job + 2 * G, wv, lane, b0);
            rwkv_out_compute(p, job + G, wv, lane, b1);
        }
    }
}

#define GL_QR 0
#define GL_KR 9216
#define GL_VT 18432
#define GL_QI 36864
#define GL_KI 46080
#define GL_AT 55296
#define GL_CUM 64512
#define GL_ALR 81920
#define GL_WA 86016
__device__ __forceinline__ void gla_load_qkv(const P& p, int n, int h, char* smem) {
    const int tid = otid();
    bf16_t* Qr = (bf16_t*)(smem + GL_QR); bf16_t* Kr = (bf16_t*)(smem + GL_KR); bf16_t* Vt = (bf16_t*)(smem + GL_VT);
    for (int c = tid; c < 512; c += NTHREADS) {
        const int row = c >> 3, part = c & 7; const int t = gla_tok(n, row);
        const u32x4 qv = *(const u32x4*)(p.Z + (size_t)t * ZLD + ZQ + h * 64 + part * 8);
        const u32x4 kv = *(const u32x4*)(p.Z + (size_t)t * ZLD + ZK + h * 64 + part * 8);
        u32x4 qs;
        qs.x = pack2bf(LO16(qv.x) * 0.125f, HI16(qv.x) * 0.125f);
        qs.y = pack2bf(LO16(qv.y) * 0.125f, HI16(qv.y) * 0.125f);
        qs.z = pack2bf(LO16(qv.z) * 0.125f, HI16(qv.z) * 0.125f);
        qs.w = pack2bf(LO16(qv.w) * 0.125f, HI16(qv.w) * 0.125f);
        *(u32x4*)(Qr + row * CH_ROW + part * 8) = qs;
        *(u32x4*)(Kr + row * CH_ROW + part * 8) = kv;
    }
    for (int c = tid; c < 1024; c += NTHREADS) {
        const int row = c >> 4, part = c & 15; const int t = gla_tok(n, row);
        const u32x4 vv = *(const u32x4*)(p.Z + (size_t)t * ZLD + ZV + h * 128 + part * 8);
        bf16_t* dst = Vt + (part * 8) * CH_ROW + row;
        dst[0 * CH_ROW] = (bf16_t)(vv.x & 0xFFFF); dst[1 * CH_ROW] = (bf16_t)(vv.x >> 16);
        dst[2 * CH_ROW] = (bf16_t)(vv.y & 0xFFFF); dst[3 * CH_ROW] = (bf16_t)(vv.y >> 16);
        dst[4 * CH_ROW] = (bf16_t)(vv.z & 0xFFFF); dst[5 * CH_ROW] = (bf16_t)(vv.z >> 16);
        dst[6 * CH_ROW] = (bf16_t)(vv.w & 0xFFFF); dst[7 * CH_ROW] = (bf16_t)(vv.w >> 16);
    }
}
__device__ __forceinline__ void gla_cum(const P& p, int l, int n, int h, int d, char* smem) {
    const int tid = otid();
    float* CUM = (float*)(smem + GL_CUM); float* ALR = (float*)(smem + GL_ALR); float* WA = (float*)(smem + GL_WA);
    for (int c = tid; c < 256; c += NTHREADS) {
        const int row = c >> 2, part = c & 3; const int t = gla_tok(n, row);
        const u32x2 a = *(const u32x2*)(p.Z + (size_t)t * ZLD + (d ? ZAB : ZAF) + part * 4);
        float* dst = ALR + row * 16 + part * 4;
        dst[0] = LO16(a.x); dst[1] = HI16(a.x); dst[2] = LO16(a.y); dst[3] = HI16(a.y);
    }
    for (int c = tid; c < 16 * 64 + 64; c += NTHREADS) {
        if (c < 1024) WA[c] = p.in[I_GLA_WA2][((size_t)(l * 2 + d) * 16 + (c >> 6)) * GLA_K + h * 64 + (c & 63)];
        else WA[c] = p.in[I_GLA_BA][(size_t)(l * 2 + d) * GLA_K + h * 64 + (c - 1024)];
    }
    __syncthreads();
    for (int idx = tid; idx < 4096; idx += NTHREADS) {
        const int i = idx >> 6, k = idx & 63;
        float a = WA[1024 + k];
#pragma unroll
        for (int r = 0; r < 16; ++r) a += ALR[i * 16 + r] * WA[r * 64 + k];
        CUM[i * 68 + k] = (fminf(a, 0.f) - flog_(1.0f + fexp_(-fabsf(a)))) * (1.0f / 16.0f);
    }
    __syncthreads();
    {
        const int k = tid & 63, seg = (tid >> 6) & 3;
        float v[16]; float run = 0.f;
        if (tid < 256) {
#pragma unroll
            for (int e = 0; e < 16; ++e) { const int pos = seg * 16 + e; const int i = d ? 63 - pos : pos; run += CUM[i * 68 + k]; v[e] = run; }
            ALR[seg * 64 + k] = run;
        }
        __syncthreads();
        if (tid < 256) {
            float off = 0.f;
            for (int s2 = 0; s2 < seg; ++s2) off += ALR[s2 * 64 + k];
#pragma unroll
            for (int e = 0; e < 16; ++e) { const int pos = seg * 16 + e; const int i = d ? 63 - pos : pos; CUM[i * 68 + k] = v[e] + off; }
        }
    }
    __syncthreads();
}
__device__ __forceinline__ void phase_gla_kv(const P& p, int l, char* smem) {
    const int tid = otid(), lane = tid & 63, wv = tid >> 6, q = lane >> 4, r = lane & 15;
    bf16_t* Kr = (bf16_t*)(smem + GL_KR); bf16_t* Vt = (bf16_t*)(smem + GL_VT); bf16_t* KdT = (bf16_t*)(smem + GL_KI);
    float* CUM = (float*)(smem + GL_CUM);
    for (int job = obid(); job < NC * GH; job += gridDim.x) {
        const int n = job / GH, h = job % GH;
        __syncthreads();
        gla_load_qkv(p, n, h, smem);
        for (int d = 0; d < 2; ++d) {
            gla_cum(p, l, n, h, d, smem);
            const int li = d ? 0 : 63;
            for (int idx = tid; idx < 4096; idx += NTHREADS) {
                const int i = idx >> 6, k = idx & 63;
                KdT[k * CH_ROW + i] = f2bf(bf2f(Kr[i * CH_ROW + k]) * fexp_(CUM[li * 68 + k] - CUM[i * 68 + k]));
            }
            if (tid < 64) p.DEC[((size_t)(d * NC + n) * GH + h) * 64 + tid] = fexp_(CUM[li * 68 + tid]);
            __syncthreads();
            float* kvt = p.KV + ((size_t)(d * NC + n) * GH + h) * 8192;
            for (int mt = wv; mt < 4; mt += NTHREADS / 64) {
                f32x4 acc[1][8];
#pragma unroll
                for (int nt = 0; nt < 8; ++nt) acc[0][nt] = (f32x4){0.f, 0.f, 0.f, 0.f};
                lds_mm<1, 8>(KdT, 16 * mt, Vt, 0, acc);
#pragma unroll
                for (int nt = 0; nt < 8; ++nt) *(f32x4*)(kvt + (size_t)(nt * 16 + r) * 64 + 16 * mt + 4 * q) = acc[0][nt];
            }
            __syncthreads();
        }
    }
    __syncthreads();
}
__device__ __forceinline__ void gla_scan_job(const P& p, int job) {
    const int base = job * NTHREADS + otid();
    const int d = base / (GH * 8192), h = (base / 8192) % GH, e = base % 8192;
    const float* __restrict__ kvp = p.KV; const float* __restrict__ decp = p.DEC; bf16_t* __restrict__ sp = p.SP;
    float S = 0.f;
    for (int s = 0; s < NC; s += 4) {
        float kv[4], dc[4]; size_t oo[4];
#pragma unroll
        for (int u = 0; u < 4; ++u) {
            const int n = chunk_order(d, (s + u < NC) ? s + u : NC - 1);
            oo[u] = ((size_t)(d * NC + n) * GH + h);
            kv[u] = kvp[oo[u] * 8192 + e]; dc[u] = decp[oo[u] * 64 + (e & 63)];
        }
#pragma unroll
        for (int u = 0; u < 4; ++u) if (s + u < NC) { sp[oo[u] * 8192 + e] = f2bf(S); S = dc[u] * S + kv[u]; }
    }
}
__device__ __forceinline__ void phase_gla_out(const P& p, int l, char* smem) {
    const int tid = otid(), lane = tid & 63, wv = tid >> 6, q = lane >> 4, r = lane & 15;
    bf16_t* Qr = (bf16_t*)(smem + GL_QR); bf16_t* Kr = (bf16_t*)(smem + GL_KR); bf16_t* Vt = (bf16_t*)(smem + GL_VT);
    bf16_t* Qi = (bf16_t*)(smem + GL_QI); bf16_t* Ki = (bf16_t*)(smem + GL_KI); bf16_t* At = (bf16_t*)(smem + GL_AT);
    float* CUM = (float*)(smem + GL_CUM);
    for (int job = obid(); job < NC * GH; job += gridDim.x) {
        const int n = job / GH, h = job % GH;
        __syncthreads();
        gla_load_qkv(p, n, h, smem);
        f32x4 o[1][8];
#pragma unroll
        for (int nt = 0; nt < 8; ++nt) o[0][nt] = (f32x4){0.f, 0.f, 0.f, 0.f};
        for (int d = 0; d < 2; ++d) {
            gla_cum(p, l, n, h, d, smem);
            for (int idx = tid; idx < 4096; idx += NTHREADS) {
                const int i = idx >> 6, k = idx & 63; const float c = CUM[i * 68 + k];
                Qi[i * CH_ROW + k] = f2bf(bf2f(Qr[i * CH_ROW + k]) * fexp_(c));
                Ki[i * CH_ROW + k] = f2bf(bf2f(Kr[i * CH_ROW + k]) * fexp_(-c));
            }
            __syncthreads();
            if (wv < 4) {
                f32x4 a[1][4];
#pragma unroll
                for (int nt = 0; nt < 4; ++nt) a[0][nt] = (f32x4){0.f, 0.f, 0.f, 0.f};
                lds_mm<1, 4>(Qi, 16 * wv, Ki, 0, a);
#pragma unroll
                for (int nt = 0; nt < 4; ++nt)
#pragma unroll
                    for (int e = 0; e < 4; ++e) {
                        const int i = 16 * wv + 4 * q + e, j = nt * 16 + r;
                        const bool ok = d ? (j >= i) : (j <= i);
                        At[i * CH_ROW + j] = f2bf(ok ? a[0][nt][e] : 0.f);
                    }
                WAVE_SYNC();
                lds_mm<1, 8>(At, 16 * wv, Vt, 0, o);
                const bf16_t* sp = p.SP + ((size_t)(d * NC + n) * GH + h) * 8192;
#pragma unroll
                for (int s2 = 0; s2 < 2; ++s2) {
                    const bf16x8 af = *(const bf16x8*)(Qi + (16 * wv + r) * CH_ROW + s2 * 32 + q * 8);
#pragma unroll
                    for (int nt = 0; nt < 8; ++nt) {
                        const bf16x8 bfr = *(const bf16x8*)(sp + (size_t)(nt * 16 + r) * 64 + s2 * 32 + q * 8);
                        o[0][nt] = MFMA16(af, bfr, o[0][nt]);
                    }
                }
            }
            __syncthreads();
        }
        if (wv < 4) {
#pragma unroll
            for (int nt = 0; nt < 8; ++nt)
#pragma unroll
                for (int e = 0; e < 4; ++e) {
                    const int t = gla_tok(n, 16 * wv + 4 * q + e);
                    p.OGLA[(size_t)t * GLA_V + h * 128 + nt * 16 + r] = o[0][nt][e];
                }
        }
    }
    __syncthreads();
}

#define S5_XH_OFF (2 * 64 * 132 * 4)
#define S5_XL_OFF (S5_XH_OFF + 64 * 136 * 2)
#define S5_CT_OFF (S5_XL_OFF + 64 * 136 * 2)
__device__ __forceinline__ void phase_s5_pass(const P& p, int l, char* smem, bool with_out) {
    const int tid = otid(), lane = tid & 63, wv = tid >> 6, q = lane >> 4, r = lane & 15;
    float* BU = (float*)smem; bf16_t* XH = (bf16_t*)(smem + S5_XH_OFF); bf16_t* XL = (bf16_t*)(smem + S5_XL_OFF); bf16_t* CTp = (bf16_t*)(smem + S5_CT_OFF);
    const int dW = (wv >> 1) & 1, ntb = (wv & 1) * 4;
    const int dS = (tid >> 6) & 1, st = tid & 63;
    bf16x8 bhi[4], blo[4];
    float are = 0.f, aim = 0.f, dco = 0.f;
    int cur_g = -1;
    const bf16x8 zero8 = {0, 0, 0, 0, 0, 0, 0, 0};
    bf16x8 a_cur[4]; float2 car_cur = {0.f, 0.f};
#define S5_FETCH(JOB, A, CAR) { const int n_ = (JOB) / SG, g_ = (JOB) % SG; \
        if (wv < 4) { _Pragma("unroll") for (int mt = 0; mt < 4; ++mt) A[mt] = (q < 2) ? *(const bf16x8*)(p.Z + (size_t)(n_ * 64 + 16 * mt + r) * ZLD + ZS5 + g_ * 16 + 8 * q) : zero8; } \
        if (with_out && tid < 128) CAR = *(const float2*)(p.S5CAR + ((((size_t)dS * NC + n_) * SG + g_) * 64 + st) * 2); }
    if (obid() < NC * SG) S5_FETCH(obid(), a_cur, car_cur);
    for (int job = obid(); job < NC * SG; job += gridDim.x) {
        const int n = job / SG, g = job % SG;
        __syncthreads();
        if (g != cur_g) {
            cur_g = g;
            if (wv < 4) {
#pragma unroll
                for (int jn = 0; jn < 4; ++jn) {
                    const int kk = 16 * (ntb + jn) + r; const size_t ci = ((size_t)dW * SG + g) * 64 + (kk >> 1);
                    float f[8], lo[8];
#pragma unroll
                    for (int e = 0; e < 8; ++e) f[e] = (q < 2) ? p.S5BB[(ci * 16 + 8 * q + e) * 2 + (kk & 1)] : 0.f;
                    const u32x4 hv = pack8(f);
                    float hf[8]; unpack8(hv, hf);
#pragma unroll
                    for (int e = 0; e < 8; ++e) lo[e] = f[e] - hf[e];
                    bhi[jn] = __builtin_bit_cast(bf16x8, hv); blo[jn] = __builtin_bit_cast(bf16x8, pack8(lo));
                }
            }
            if (tid < 128) { const size_t ci = ((size_t)dS * SG + g) * 64 + st; are = p.S5A[ci * 2]; aim = p.S5A[ci * 2 + 1]; }
            if (with_out) {
                for (int idx = tid; idx < 16 * 128; idx += NTHREADS) {
                    const int c = idx >> 7, kk = idx & 127;
                    const float v = (kk & 1) ? -p.in[I_S5CIM][((size_t)l * SG + g) * 1024 + c * 64 + (kk >> 1)] : p.in[I_S5CRE][((size_t)l * SG + g) * 1024 + c * 64 + (kk >> 1)];
                    CTp[c * 136 + kk] = f2bf(v);
                }
                dco = p.in[I_S5D][(size_t)l * SW + g * 16 + r];
            }
        }
        float xr = car_cur.x, xi = car_cur.y;
        const size_t eo = (((size_t)dS * NC + n) * SG + g) * 64 + st;
        unsigned short uu[4] = {0, 0, 0, 0};
        if (with_out && wv < 4) {
#pragma unroll
            for (int e = 0; e < 4; ++e) uu[e] = p.Z[(size_t)(n * 64 + 16 * wv + 4 * q + e) * ZLD + ZS5 + g * 16 + r];
        }
        if (wv < 4) {
#pragma unroll
            for (int mt = 0; mt < 4; ++mt) {
                const bf16x8 a = a_cur[mt];
#pragma unroll
                for (int jn = 0; jn < 4; ++jn) {
                    f32x4 acc = {0.f, 0.f, 0.f, 0.f};
                    acc = MFMA16(a, bhi[jn], acc);
                    acc = MFMA16(a, blo[jn], acc);
#pragma unroll
                    for (int e = 0; e < 4; ++e) BU[(dW * 64 + 16 * mt + 4 * q + e) * 132 + 16 * (ntb + jn) + r] = acc[e];
                }
            }
        }
        if (job + (int)gridDim.x < NC * SG) S5_FETCH(job + (int)gridDim.x, a_cur, car_cur);
        __syncthreads();
        if (tid < 128) {
            float2* bp0 = (float2*)(BU + (dS * 64 + (dS ? 63 : 0)) * 132 + st * 2);
#define S5_SCAN(SGN) { _Pragma("unroll 1") for (int ib = 0; ib < 4; ++ib) { float2 bv[16]; \
                _Pragma("unroll") for (int u = 0; u < 16; ++u) bv[u] = bp0[(SGN) * (ib * 16 + u) * 66]; \
                _Pragma("unroll") for (int u = 0; u < 16; ++u) { \
                    const float nr = are * xr - aim * xi + bv[u].x, ni = are * xi + aim * xr + bv[u].y; xr = nr; xi = ni; \
                    if (with_out) { float2 o; o.x = xr; o.y = xi; bp0[(SGN) * (ib * 16 + u) * 66] = o; } } } }
            if (dS) S5_SCAN(-1) else S5_SCAN(1)
            if (!with_out) { float2 o; o.x = xr; o.y = xi; *(float2*)(p.S5END + eo * 2) = o; }
        }
        if (with_out) {
            __syncthreads();
            for (int cidx = tid; cidx < 64 * 16; cidx += NTHREADS) {
                const int i = cidx >> 4, k0 = (cidx & 15) * 8;
                float a[8], b[8], lo[8];
                load8f(BU + (0 * 64 + i) * 132 + k0, a); load8f(BU + (1 * 64 + i) * 132 + k0, b);
#pragma unroll
                for (int e = 0; e < 8; ++e) a[e] += b[e];
                const u32x4 hv = pack8(a);
                float hf[8]; unpack8(hv, hf);
#pragma unroll
                for (int e = 0; e < 8; ++e) lo[e] = a[e] - hf[e];
                *(u32x4*)(XH + i * 136 + k0) = hv; *(u32x4*)(XL + i * 136 + k0) = pack8(lo);
            }
            __syncthreads();
            if (wv < 4) {
                f32x4 acc = {0.f, 0.f, 0.f, 0.f};
#pragma unroll
                for (int ks = 0; ks < 4; ++ks) {
                    const bf16x8 ah = *(const bf16x8*)(XH + (16 * wv + r) * 136 + ks * 32 + q * 8), al = *(const bf16x8*)(XL + (16 * wv + r) * 136 + ks * 32 + q * 8);
                    const bf16x8 b = *(const bf16x8*)(CTp + r * 136 + ks * 32 + q * 8);
                    acc = MFMA16(ah, b, acc);
                    acc = MFMA16(al, b, acc);
                }
#pragma unroll
                for (int e = 0; e < 4; ++e) {
                    const int i = 16 * wv + 4 * q + e;
                    const float u = bf2f(uu[e]);
                    p.GY[(size_t)(n * 64 + i) * SW + g * 16 + r] = f2bf(geluf_(acc[e] + dco * u));
                }
            }
        }
    }
    __syncthreads();
}
__device__ __forceinline__ void s5_carry_job(const P& p, int job) {
    const int base = job * NTHREADS + otid();
    if (base >= 2 * SG * 64) return;
    const int d = base / (SG * 64), g = (base / 64) % SG, st = base % 64;
    const size_t ci = ((size_t)d * SG + g) * 64 + st;
    float ar = p.S5A[ci * 2], ai = p.S5A[ci * 2 + 1];
    for (int i = 0; i < 6; ++i) { const float nr = ar * ar - ai * ai, ni = 2.f * ar * ai; ar = nr; ai = ni; }
    const float2* __restrict__ endp = (const float2*)p.S5END; float2* __restrict__ carp = (float2*)p.S5CAR;
    float cr = 0.f, cim = 0.f;
    for (int s = 0; s < NC; s += 4) {
        float2 ev[4]; size_t eo[4];
#pragma unroll
        for (int u = 0; u < 4; ++u) {
            const int n = chunk_order(d, (s + u < NC) ? s + u : NC - 1);
            eo[u] = (((size_t)d * NC + n) * SG + g) * 64 + st;
            ev[u] = endp[eo[u]];
        }
#pragma unroll
        for (int u = 0; u < 4; ++u) if (s + u < NC) {
            float2 c; c.x = cr; c.y = cim; carp[eo[u]] = c;
            const float nr = ar * cr - ai * cim + ev[u].x, ni = ar * cim + ai * cr + ev[u].y;
            cr = nr; cim = ni;
        }
    }
}

__device__ __forceinline__ void phase_side_elem(const P& p, int l) {
    const int lane = otid() & 63;
    const int gw = (obid() * NTHREADS + otid()) >> 6, nw = (gridDim.x * NTHREADS) >> 6;
    const bool actg = lane * 8 < GLA_V, actr = lane * 8 < RW;
    float gng[8], lnw[8], lnb[8];
#pragma unroll
    for (int e = 0; e < 8; ++e) { gng[e] = 0.f; lnw[e] = 0.f; lnb[e] = 0.f; }
    if (actg) load8f(p.in[I_GLA_NG] + (size_t)l * 128 + ((lane * 8) & 127), gng);
    if (actr) { load8f(p.in[I_RLNW] + (size_t)l * RW + lane * 8, lnw); load8f(p.in[I_RLNB] + (size_t)l * RW + lane * 8, lnb); }
    for (int t = gw; t < MTOT; t += nw) {
        float og[8], zo[8], y0[8], y1[8], vv[8];
        const u32x4 z4 = {0u, 0u, 0u, 0u};
#pragma unroll
        for (int e = 0; e < 8; ++e) { og[e] = 0.f; y0[e] = 0.f; y1[e] = 0.f; }
        if (actg) load8f(p.OGLA + (size_t)t * GLA_V + lane * 8, og);
        unpack8(actg ? *(const u32x4*)(p.Z + (size_t)t * ZLD + ZOG + lane * 8) : z4, zo);
        if (actr) { load8f(p.Y + (size_t)t * RW + lane * 8, y0); load8f(p.Y + ((size_t)MTOT + t) * RW + lane * 8, y1); }
        unpack8(actr ? *(const u32x4*)(p.V + (size_t)t * RW + lane * 8) : z4, vv);
        float g2v[8]; unpack8(actr ? *(const u32x4*)(p.G2B + (size_t)t * RW + lane * 8) : z4, g2v);
        const int hh = (lane * 8) >> 6;
        const float bon = actr ? (p.BONUS[(size_t)t * RH + hh] + p.BONUS[((size_t)MTOT + t) * RH + hh]) : 0.f;
        float ss = 0.f;
#pragma unroll
        for (int e = 0; e < 8; ++e) ss += og[e] * og[e];
        ss += __shfl_xor(ss, 1, 64); ss += __shfl_xor(ss, 2, 64); ss += __shfl_xor(ss, 4, 64); ss += __shfl_xor(ss, 8, 64);
        const float rstd = rsqrtf(ss * (1.0f / 128.f) + 1e-6f);
        float br[8];
#pragma unroll
        for (int e = 0; e < 8; ++e) br[e] = og[e] * rstd * gng[e] * siluf_(zo[e]);
        if (actg) *(u32x4*)(p.BR + (size_t)t * 3 * BW + lane * 8) = pack8(br);
        float y[8]; float sm = 0.f;
#pragma unroll
        for (int e = 0; e < 8; ++e) { y[e] = y0[e] + y1[e]; sm += y[e]; }
        sm += __shfl_xor(sm, 1, 64); sm += __shfl_xor(sm, 2, 64); sm += __shfl_xor(sm, 4, 64);
        const float mu = sm * (1.0f / 64.f);
        float sv = 0.f;
#pragma unroll
        for (int e = 0; e < 8; ++e) { y[e] -= mu; sv += y[e] * y[e]; }
        sv += __shfl_xor(sv, 1, 64); sv += __shfl_xor(sv, 2, 64); sv += __shfl_xor(sv, 4, 64);
        const float rs = rsqrtf(sv * (1.0f / 64.f) + 64e-5f);
        float yn[8];
#pragma unroll
        for (int e = 0; e < 8; ++e) yn[e] = y[e] * rs * lnw[e] + lnb[e] + bon * vv[e];
#pragma unroll
        for (int e = 0; e < 8; ++e) yn[e] *= g2v[e];
        if (actr) *(u32x4*)(p.BR + (size_t)t * 3 * BW + BW + lane * 8) = pack8(yn);
    }
}

__device__ __forceinline__ void g2_gemm_job(const P& p, int job, char* smem) {
    const int ntn = NPAD(RW) / 128;
    gemm_tile_run<4, 8>(p.WT_G2, 128, (size_t)NPAD(RW) * 128 * 2, p.GS, 128, (size_t)MTOT * 128 * 2, 128, (job % ntn) * 128, (job / ntn) * 256, (bf16_t*)smem, NoPre(),
        [&](int, int, int m, int n, const f32x4 v) { if (n < RW) *(u32x2*)(p.G2B + (size_t)m * RW + n) = pack4(v[0], v[1], v[2], v[3]); });
}
#define G2_JOBS ((MTOT / 256) * (NPAD(RW) / 128))
__device__ __forceinline__ void phase_glu_gemm(const P& p, int l, char* smem) {
    gemm_phase<4>(p.WT_GLU, SW, (size_t)NPAD(2 * SW) * SW * 2, p.GY, SW, (size_t)MTOT * SW * 2, SW, 2 * SW, (bf16_t*)smem, NoPre(), NoPre(),
        [&](int, int, int m, int n, const f32x4 v) {
            *(unsigned*)(p.BR + (size_t)m * 3 * BW + 2 * BW + (n >> 1)) = pack2bf(v[0] * sigmoidf_(v[1]), v[2] * sigmoidf_(v[3]));
        });
}
__device__ __forceinline__ void phase_merge(const P& p, int l, char* smem) {
    const int ntn = D_MODEL / 128, ntm = (MTOT - 256) / 128;
    auto run = [&](auto mi_tag, int n0, int m0) {
        constexpr int MI = decltype(mi_tag)::value;
        f32x4 macc[4][MI];
#pragma unroll
        for (int i = 0; i < 4; ++i)
#pragma unroll
            for (int j = 0; j < MI; ++j) macc[i][j] = (f32x4){0.f, 0.f, 0.f, 0.f};
        const int lane = otid() & 63, wave = otid() >> 6;
        for (int b = 0; b < 3; ++b) {
            f32x4 acc[4][MI];
#pragma unroll
            for (int i = 0; i < 4; ++i)
#pragma unroll
                for (int j = 0; j < MI; ++j) acc[i][j] = (f32x4){0.f, 0.f, 0.f, 0.f};
            mfma_gemm_tile_t<4, MI>(p.WT_BR + (size_t)b * D_MODEL * BW, BW, (size_t)D_MODEL * BW * 2, p.BR + b * BW, 3 * BW, (size_t)MTOT * 3 * BW * 2 - b * BW * 2, BW, n0, m0, (bf16_t*)smem, acc);
#pragma unroll
            for (int ni = 0; ni < 4; ++ni)
#pragma unroll
                for (int mi = 0; mi < MI; ++mi) {
                    const int n = n0 + (wave >> 1) * 64 + ni * 16 + (lane >> 4) * 4, m = m0 + (wave & 1) * 16 * MI + mi * 16 + (lane & 15);
                    const u32x2 g = *(const u32x2*)(p.ZGT + ((((size_t)(m >> 4) * (3 * D_MODEL / 16) + ((b * D_MODEL + n) >> 4)) * 64 + lane) * 4));
                    macc[ni][mi][0] += LO16(g.x) * acc[ni][mi][0]; macc[ni][mi][1] += HI16(g.x) * acc[ni][mi][1];
                    macc[ni][mi][2] += LO16(g.y) * acc[ni][mi][2]; macc[ni][mi][3] += HI16(g.y) * acc[ni][mi][3];
                }
        }
#pragma unroll
        for (int ni = 0; ni < 4; ++ni)
#pragma unroll
            for (int mi = 0; mi < MI; ++mi) {
                const int n = n0 + (wave >> 1) * 64 + ni * 16 + (lane >> 4) * 4, m = m0 + (wave & 1) * 16 * MI + mi * 16 + (lane & 15);
                *(u32x2*)(p.M + (size_t)m * D_MODEL + n) = pack4(macc[ni][mi][0], macc[ni][mi][1], macc[ni][mi][2], macc[ni][mi][3]);
            }
    };
    for (int it = 0;; ++it) {
        int mt_, nt_; if (!tile_map(it, ntm, ntn, (ntn >= 8) ? 4 : 8, mt_, nt_)) break;
        run(std::integral_constant<int, 4>(), nt_ * 128, mt_ * 128);
    }
    for (int job = obid(); job < 4 * ntn; job += gridDim.x) run(std::integral_constant<int, 2>(), (job >> 2) * 128, MTOT - 256 + (job & 3) * 64);
}

__device__ __forceinline__ void phase_outproj(const P& p, int l, char* smem) {
    gemm_phase<4>(p.WT_OUT, D_MODEL, (size_t)D_MODEL * D_MODEL * 2, p.M, D_MODEL, (size_t)MTOT * D_MODEL * 2, D_MODEL, D_MODEL, (bf16_t*)smem, NoPre(), NoPre(),
        [&](int, int, int m, int n, const f32x4 v) {
            const float* g1 = p.MOD + (size_t)(l * 2 + (m >= CTX ? 1 : 0)) * 6 * D_MODEL + 2 * D_MODEL + n;
            float4* xp = (float4*)(p.X + (size_t)m * D_MODEL + n); float4 x = *xp;
            x.x += g1[0] * v[0]; x.y += g1[1] * v[1]; x.z += g1[2] * v[2]; x.w += g1[3] * v[3]; *xp = x;
        });
}

__device__ __forceinline__ void store_q_hilo(const P& p, int m, int n, const f32x4 v) {
    const bf16_t h0 = f2bf(v[0]), h1 = f2bf(v[1]), h2 = f2bf(v[2]), h3 = f2bf(v[3]);
    u32x2 hv; hv.x = (unsigned)h0 | ((unsigned)h1 << 16); hv.y = (unsigned)h2 | ((unsigned)h3 << 16);
    *(u32x2*)(p.QHI + (size_t)m * PQ + n) = hv;
    *(u32x2*)(p.QLO + (size_t)m * PQ + n) = pack4(v[0] - bf2f(h0), v[1] - bf2f(h1), v[2] - bf2f(h2), v[3] - bf2f(h3));
}
__device__ __forceinline__ void phase_peer_q(const P& p, int l, char* smem) {
    gemm_phase<4>(p.WT_Q, D_MODEL, (size_t)PQ * D_MODEL * 2, p.H, D_MODEL, (size_t)MTOT * D_MODEL * 2, D_MODEL, PQ, (bf16_t*)smem, NoPre(), NoPre(),
        [&](int, int, int m, int n, const f32x4 v) { store_q_hilo(p, m, n, v); });
}

#define TK_ROW 129
__device__ __forceinline__ unsigned tk_key(float f, unsigned lowmask, unsigned low) {
    unsigned u = __builtin_bit_cast(unsigned, f);
    u ^= (u & 0x80000000u) ? 0xFFFFFFFFu : 0x80000000u;
    return (u & ~lowmask) | low;
}
#define TK_INSERT(lv, xk) { unsigned x_ = (xk); _Pragma("unroll") for (int z_ = 0; z_ < 16; ++z_) { const unsigned hi_ = lv[z_] > x_ ? lv[z_] : x_; x_ = lv[z_] > x_ ? x_ : lv[z_]; lv[z_] = hi_; } }
__device__ __forceinline__ void phase_peer_topk(const P& p, int l, char* smem) {
    const int tid = otid(), lane = tid & 63, wv = tid >> 6, q = lane >> 4, r = lane & 15;
    float* sc = (float*)smem + wv * (64 * TK_ROW);
    const int gw = (obid() * NTHREADS + tid) >> 6, nw = (gridDim.x * NTHREADS) >> 6;
    const float NEG = -3.0e38f;
    for (int job = gw; job < (MTOT / 32) * PH; job += nw) {
        const int t0 = (job / PH) * 32, h = job % PH;
#pragma unroll
        for (int sd = 0; sd < 2; ++sd) {
            f32x4 acc[2][8];
#pragma unroll
            for (int mt = 0; mt < 2; ++mt)
#pragma unroll
                for (int nt = 0; nt < 8; ++nt) acc[mt][nt] = (f32x4){0.f, 0.f, 0.f, 0.f};
#pragma unroll
            for (int ks = 0; ks < 4; ++ks) {
                bf16x8 ah[2], al[2];
#pragma unroll
                for (int mt = 0; mt < 2; ++mt) {
                    const size_t qo = (size_t)(t0 + mt * 16 + r) * PQ + h * 256 + sd * 128 + ks * 32 + q * 8;
                    ah[mt] = *(const bf16x8*)(p.QHI + qo); al[mt] = *(const bf16x8*)(p.QLO + qo);
                }
#pragma unroll
                for (int nt = 0; nt < 8; ++nt) {
                    const size_t ko = ((size_t)(h * 2 + sd) * 128 + nt * 16 + r) * 128 + ks * 32 + q * 8;
                    const bf16x8 bh = *(const bf16x8*)(p.KHI + ko), bl = *(const bf16x8*)(p.KLO + ko);
#pragma unroll
                    for (int mt = 0; mt < 2; ++mt) {
                        acc[mt][nt] = MFMA16(ah[mt], bh, acc[mt][nt]);
                        acc[mt][nt] = MFMA16(al[mt], bh, acc[mt][nt]);
                        acc[mt][nt] = MFMA16(ah[mt], bl, acc[mt][nt]);
                    }
                }
            }
#pragma unroll
            for (int mt = 0; mt < 2; ++mt)
#pragma unroll
                for (int nt = 0; nt < 8; ++nt)
#pragma unroll
                    for (int e = 0; e < 4; ++e) sc[(sd * 32 + mt * 16 + 4 * q + e) * TK_ROW + nt * 16 + r] = acc[mt][nt][e];
        }
        WAVE_SYNC();
        unsigned lv[16];
#pragma unroll
        for (int z = 0; z < 16; ++z) lv[z] = 0u;
        {
            const float* row = sc + lane * TK_ROW;
#pragma unroll 4
            for (int k = 0; k < 128; ++k) TK_INSERT(lv, tk_key(row[k], 0x7Fu, (unsigned)(127 - k)));
        }
        float lvv[16]; int li[16];
        {
            const float* row = sc + lane * TK_ROW;
#pragma unroll
            for (int z = 0; z < 16; ++z) { li[z] = 127 - (int)(lv[z] & 0x7Fu); lvv[z] = row[li[z]]; }
        }
        WAVE_SYNC();
        {
            float* row = sc + lane * TK_ROW;
#pragma unroll
            for (int z = 0; z < 16; ++z) { row[z] = lvv[z]; ((int*)row)[16 + z] = li[z]; }
        }
        WAVE_SYNC();
        const float* r1 = sc + (lane & 31) * TK_ROW; const float* r2 = sc + (32 + (lane & 31)) * TK_ROW;
        unsigned tk[16];
#pragma unroll
        for (int z = 0; z < 16; ++z) tk[z] = 0u;
        for (int i = 0; i < 16; ++i) {
            const float a = r1[i];
            const int nj = 16 / (i + 1);
            for (int j = 0; j < nj; ++j) TK_INSERT(tk, tk_key(a + r2[j], 0xFFu, (unsigned)(255 - (i * 16 + j))));
        }
        int tc[16];
#pragma unroll
        for (int z = 0; z < 16; ++z) tc[z] = 255 - (int)(tk[z] & 0xFFu);
        if (lane < 32) {
            float vals[16]; float mx = 0.f; float ssum = 0.f;
#pragma unroll
            for (int z = 0; z < 16; ++z) { vals[z] = r1[tc[z] >> 4] + r2[tc[z] & 15]; if (z == 0) mx = vals[0]; vals[z] = fexp_(vals[z] - mx); ssum += vals[z]; }
            const float inv = 1.0f / ssum;
            const size_t o = (size_t)(t0 + lane) * PH * 16 + h * 16;
#pragma unroll
            for (int z = 0; z < 16; ++z) {
                const int ex_ = ((const int*)r1)[16 + (tc[z] >> 4)] * 128 + ((const int*)r2)[16 + (tc[z] & 15)];
                p.IDX[o + z] = ex_;
                p.G[o + z] = vals[z] * inv * p.VSC[ex_];
                p.GU[o + z] = p.USC[ex_];
            }
        }
        WAVE_SYNC();
    }
}

#define PEER_CONV_JOBS (2 * NEXP / 4)
__device__ __forceinline__ void peer_conv_job(const P& p, int l, int job) {
    const int tid = otid(), lane = tid & 63, wv = tid >> 6;
    if (wv >= 4) return;
    const int rowg = job * 4 + wv; const int which = rowg / NEXP, row = rowg % NEXP;
    const float* src = p.in[which ? I_PV : I_PU] + ((size_t)l * NEXP + row) * D_MODEL + lane * 16;
    const bool act = lane * 16 < D_MODEL;
    float v[16]; float amax = 0.f;
#pragma unroll
    for (int c = 0; c < 4; ++c) {
        float4 a; a.x = 0.f; a.y = 0.f; a.z = 0.f; a.w = 0.f;
        if (act) a = *(const float4*)(src + c * 4);
        v[c * 4 + 0] = a.x; v[c * 4 + 1] = a.y; v[c * 4 + 2] = a.z; v[c * 4 + 3] = a.w;
        amax = fmaxf(amax, fmaxf(fmaxf(fabsf(a.x), fabsf(a.y)), fmaxf(fabsf(a.z), fabsf(a.w))));
    }
#pragma unroll
    for (int m = 32; m >= 1; m >>= 1) amax = fmaxf(amax, __shfl_xor(amax, m, 64));
    int ex = 0;
    if (amax > 0.f) ex = 7 - (int)((__builtin_bit_cast(unsigned, amax) >> 23) & 0xFF) + 127;
    ex = ex < -100 ? -100 : (ex > 100 ? 100 : ex);
    const float sc = __builtin_bit_cast(float, (unsigned)(ex + 127) << 23), isc = __builtin_bit_cast(float, (unsigned)(127 - ex) << 23);
    u32x4 o;
    int w0 = 0, w1 = 0, w2 = 0, w3 = 0;
    w0 = CVT_PK_FP8(v[0] * sc, v[1] * sc, w0, false); w0 = CVT_PK_FP8(v[2] * sc, v[3] * sc, w0, true);
    w1 = CVT_PK_FP8(v[4] * sc, v[5] * sc, w1, false); w1 = CVT_PK_FP8(v[6] * sc, v[7] * sc, w1, true);
    w2 = CVT_PK_FP8(v[8] * sc, v[9] * sc, w2, false); w2 = CVT_PK_FP8(v[10] * sc, v[11] * sc, w2, true);
    w3 = CVT_PK_FP8(v[12] * sc, v[13] * sc, w3, false); w3 = CVT_PK_FP8(v[14] * sc, v[15] * sc, w3, true);
    o.x = (unsigned)w0; o.y = (unsigned)w1; o.z = (unsigned)w2; o.w = (unsigned)w3;
    unsigned char* dst = (which ? p.V8 : p.U8) + (size_t)row * D_MODEL + lane * 16;
    if (act) *(u32x4*)dst = o;
    if (lane == 0) (which ? p.VSC : p.USC)[row] = isc;
}
#define GE 4
struct GBuf { u32x4 u[GE]; u32x4 v[GE]; float gu; float gv; };
__device__ __forceinline__ void gather_load(const P& p, GBuf& b, int g, int idx0, int idx1, float g0, float g1, float u0, float u1, int lane) {
    const bool act = lane * 16 < D_MODEL;
#pragma unroll
    for (int q = 0; q < GE; ++q) {
        const int k = g * GE + q;
        const int ei = __shfl((k < 64) ? idx0 : idx1, k & 63, 64);
        b.u[q] = act ? *(const u32x4*)(p.U8 + (size_t)ei * D_MODEL + lane * 16) : (u32x4){0u, 0u, 0u, 0u};
        b.v[q] = act ? *(const u32x4*)(p.V8 + (size_t)ei * D_MODEL + lane * 16) : (u32x4){0u, 0u, 0u, 0u};
    }
    const int km = g * GE + ((lane >> 4) & 3);
    b.gv = __shfl((km < 64) ? g0 : g1, km & 63, 64);
    b.gu = __shfl((km < 64) ? u0 : u1, km & 63, 64);
}
__device__ __forceinline__ void gather_compute(const GBuf& b, const float (&hv)[16], float (&acc)[16], int lane) {
    float dt[GE];
#pragma unroll
    for (int q = 0; q < GE; ++q) {
        float d = 0.f;
#pragma unroll
        for (int c = 0; c < 4; ++c) {
            const f32x2 lo = CVT_PK_F32_FP8((int)b.u[q][c], false), hi = CVT_PK_F32_FP8((int)b.u[q][c], true);
            d += hv[c * 4 + 0] * lo.x + hv[c * 4 + 1] * lo.y + hv[c * 4 + 2] * hi.x + hv[c * 4 + 3] * hi.y;
        }
        dt[q] = d;
    }
    float r2[2], r1;
    {
        const bool up = (lane & 32) != 0;
#pragma unroll
        for (int q = 0; q < 2; ++q) { const float keep = up ? dt[2 + q] : dt[q], send = up ? dt[q] : dt[2 + q]; r2[q] = keep + __shfl_xor(send, 32, 64); }
    }
    {
        const bool up = (lane & 16) != 0;
        const float keep = up ? r2[1] : r2[0], send = up ? r2[0] : r2[1];
        r1 = keep + __shfl_xor(send, 16, 64);
    }
    r1 += __shfl_xor(r1, 8, 64); r1 += __shfl_xor(r1, 4, 64); r1 += __shfl_xor(r1, 2, 64); r1 += __shfl_xor(r1, 1, 64);
    const float coef_mine = b.gv * geluf_(r1 * b.gu);
#pragma unroll
    for (int q = 0; q < GE; ++q) {
        const float coef = __shfl(coef_mine, q * 16, 64);
#pragma unroll
        for (int c = 0; c < 4; ++c) {
            const f32x2 lo = CVT_PK_F32_FP8((int)b.v[q][c], false), hi = CVT_PK_F32_FP8((int)b.v[q][c], true);
            acc[c * 4 + 0] += coef * lo.x; acc[c * 4 + 1] += coef * lo.y; acc[c * 4 + 2] += coef * hi.x; acc[c * 4 + 3] += coef * hi.y;
        }
    }
}
__device__ __forceinline__ void phase_peer_gather(const P& p, int l) {
    const int lane = otid() & 63;
    const int gw = (obid() * NTHREADS + otid()) >> 6, nw = (gridDim.x * NTHREADS) >> 6;
    constexpr int NG = PH * 16 / GE;
    const bool act = lane * 16 < D_MODEL;
    for (int t = gw; t < MTOT; t += nw) {
        float hv[16], acc[16];
        {
            const u32x4 z4 = {0u, 0u, 0u, 0u};
            const u32x4 ha = act ? *(const u32x4*)(p.H + (size_t)t * D_MODEL + lane * 16) : z4;
            const u32x4 hb = act ? *(const u32x4*)(p.H + (size_t)t * D_MODEL + lane * 16 + 8) : z4;
            hv[0] = LO16(ha.x); hv[1] = HI16(ha.x); hv[2] = LO16(ha.y); hv[3] = HI16(ha.y); hv[4] = LO16(ha.z); hv[5] = HI16(ha.z); hv[6] = LO16(ha.w); hv[7] = HI16(ha.w);
            hv[8] = LO16(hb.x); hv[9] = HI16(hb.x); hv[10] = LO16(hb.y); hv[11] = HI16(hb.y); hv[12] = LO16(hb.z); hv[13] = HI16(hb.z); hv[14] = LO16(hb.w); hv[15] = HI16(hb.w);
#pragma unroll
            for (int j = 0; j < 16; ++j) acc[j] = 0.f;
        }
        int idx0 = 0, idx1 = 0; float g0 = 0.f, g1 = 0.f, u0 = 0.f, u1 = 0.f;
        if (lane < PH * 16) { idx0 = p.IDX[(size_t)t * PH * 16 + lane]; g0 = p.G[(size_t)t * PH * 16 + lane]; u0 = p.GU[(size_t)t * PH * 16 + lane]; }
        if (64 + lane < PH * 16) { idx1 = p.IDX[(size_t)t * PH * 16 + 64 + lane]; g1 = p.G[(size_t)t * PH * 16 + 64 + lane]; u1 = p.GU[(size_t)t * PH * 16 + 64 + lane]; }
        GBuf b0, b1, b2;
        gather_load(p, b0, 0, idx0, idx1, g0, g1, u0, u1, lane);
        gather_load(p, b1, 1, idx0, idx1, g0, g1, u0, u1, lane);
        for (int g = 0; g < NG; g += 3) {
            if (g + 2 < NG) gather_load(p, b2, g + 2, idx0, idx1, g0, g1, u0, u1, lane);
            gather_compute(b0, hv, acc, lane);
            if (g + 1 < NG) {
                if (g + 3 < NG) gather_load(p, b0, g + 3, idx0, idx1, g0, g1, u0, u1, lane);
                gather_compute(b1, hv, acc, lane);
            }
            if (g + 2 < NG) {
                if (g + 4 < NG) gather_load(p, b1, g + 4, idx0, idx1, g0, g1, u0, u1, lane);
                gather_compute(b2, hv, acc, lane);
            }
        }
        float xn[16]; float ss = 0.f;
#pragma unroll
        for (int j = 0; j < 16; ++j) xn[j] = 0.f;
        if (act) {
            const float* g2 = p.MOD + (size_t)(l * 2 + (t >= CTX ? 1 : 0)) * 6 * D_MODEL + 5 * D_MODEL + lane * 16;
            float* xp = p.X + (size_t)t * D_MODEL + lane * 16;
#pragma unroll
            for (int c = 0; c < 4; ++c) {
                float4 x = *(float4*)(xp + c * 4);
                x.x += g2[c * 4 + 0] * acc[c * 4 + 0]; x.y += g2[c * 4 + 1] * acc[c * 4 + 1]; x.z += g2[c * 4 + 2] * acc[c * 4 + 2]; x.w += g2[c * 4 + 3] * acc[c * 4 + 3];
                if (l + 1 < DEPTH) *(float4*)(xp + c * 4) = x;
                xn[c * 4 + 0] = x.x; xn[c * 4 + 1] = x.y; xn[c * 4 + 2] = x.z; xn[c * 4 + 3] = x.w;
                ss += x.x * x.x + x.y * x.y + x.z * x.z + x.w * x.w;
            }
        }
        ss = wave_sum(ss);
        const float rstd = rsqrtf(ss / D_MODEL + 1e-6f);
        if (act) {
            if (l + 1 < DEPTH) {
                const float* gn = p.in[I_N1G] + (size_t)(l + 1) * D_MODEL + lane * 16;
                const float* mod = p.MOD + (size_t)((l + 1) * 2 + (t >= CTX ? 1 : 0)) * 6 * D_MODEL + lane * 16;
                float o[16];
#pragma unroll
                for (int j = 0; j < 16; ++j) o[j] = xn[j] * rstd * gn[j] * (1.0f + mod[D_MODEL + j]) + mod[j];
                u32x4 w0, w1;
                w0.x = pack2bf(o[0], o[1]); w0.y = pack2bf(o[2], o[3]); w0.z = pack2bf(o[4], o[5]); w0.w = pack2bf(o[6], o[7]);
                w1.x = pack2bf(o[8], o[9]); w1.y = pack2bf(o[10], o[11]); w1.z = pack2bf(o[12], o[13]); w1.w = pack2bf(o[14], o[15]);
                *(u32x4*)(p.H + (size_t)t * D_MODEL + lane * 16) = w0; *(u32x4*)(p.H + (size_t)t * D_MODEL + lane * 16 + 8) = w1;
            } else if (t >= CTX) {
                const float* fg = p.in[I_FG] + lane * 16;
                float* op = p.out + (size_t)(t - CTX) * D_MODEL + lane * 16;
#pragma unroll
                for (int c = 0; c < 4; ++c) {
                    float4 o; o.x = xn[c * 4 + 0] * rstd * fg[c * 4 + 0]; o.y = xn[c * 4 + 1] * rstd * fg[c * 4 + 1]; o.z = xn[c * 4 + 2] * rstd * fg[c * 4 + 2]; o.w = xn[c * 4 + 3] * rstd * fg[c * 4 + 3];
                    *(float4*)(op + c * 4) = o;
                }
            }
        }
    }
}
__device__ __forceinline__ void phase_final(const P& p) {
    const int lane = otid() & 63;
    const int gw = (obid() * NTHREADS + otid()) >> 6, nw = (gridDim.x * NTHREADS) >> 6;
    const float* g = p.in[I_FG];
    for (int t = gw; t < SEQ; t += nw) {
        const float* x = p.X + (size_t)(CTX + t) * D_MODEL;
        float v[D_MODEL / 64]; float ss = 0.f;
#pragma unroll
        for (int j = 0; j < D_MODEL / 64; ++j) { v[j] = x[lane + 64 * j]; ss += v[j] * v[j]; }
        ss = wave_sum(ss);
        float rstd = rsqrtf(ss / D_MODEL + 1e-6f);
#pragma unroll
        for (int j = 0; j < D_MODEL / 64; ++j) p.out[(size_t)t * D_MODEL + lane + 64 * j] = v[j] * rstd * g[lane + 64 * j];
    }
}

__global__ void __launch_bounds__(NTHREADS) fwd_megakernel(P p_arg) {
#ifdef EMU
    char* smem = emu_smem();
#else
    __shared__ __attribute__((aligned(16))) char smem_raw[SMEM_BYTES + 16];
    char* smem = smem_raw;
#endif
#ifndef EMU
    volatile LAS unsigned* xst = (volatile LAS unsigned*)(smem_raw + SMEM_BYTES);
    if (threadIdx.x == 0) { xst[0] = 0u; xst[1] = 0u; xst[2] = 0u; xst[3] = 0u; }
    __syncthreads();
    XcdBarrier xb = xcd_barrier_post(p_arg.bar, xst);
#endif
    { LOADP(); phase_init(p, smem); }
#ifndef EMU
#endif
    GRID_SYNC();
#ifndef EMU
    if (threadIdx.x == 0) {
        unsigned base_ = 0;
        for (unsigned j = 0; j < xb.x; ++j) base_ += xb_ld(&p_arg.bar[XB_XCNT(j)]);
        xst[2] = base_ + xst[3];
    }
    __syncthreads();
#endif
    PROBE_INIT();
    for (int l = 0; l < DEPTH; ++l) {
        if (l == 0) {
            { LOADP(); phase_norm(p, 0, 0); }
            { LOADP(); phase_s5const(p, 0); }
            { LOADP(); phase_convert_weights(p, 0, smem, obid(), (int)gridDim.x); }
            GRID_SYNC(); PROBE_AFTER(0);
        }
        { LOADP(); phase_gemm_in(p, l, smem); }
        GRID_SYNC(); PROBE_AFTER(1);
        { LOADP(); phase_rwkv_prep1(p, l); }
        GRID_SYNC(); PROBE_AFTER(14);
        { LOADP(); phase_rwkv_prep2(p, l, smem); }
        GRID_SYNC(); PROBE_AFTER(2);
        { LOADP(); for (int job = obid(); job < 2 * NC * RH; job += gridDim.x) rwkv_chunk_job(p, job, smem); }
        __syncthreads(); PROBE_AFTER(20);
        { LOADP(); phase_gla_kv(p, l, smem); }
        PROBE_AFTER(21);
        { LOADP(); phase_s5_pass(p, l, smem, false); }
        GRID_SYNC(); PROBE_AFTER(3);
        {
            LOADP();
            const int n_rw = 2 * RH, n_gla = 2 * GH * 8192 / NTHREADS, n_s5 = (2 * SG * 64 + NTHREADS - 1) / NTHREADS;
            const int G_ = (int)gridDim.x;
            if (G_ > 2 * n_rw) {
                if (obid() < n_rw) { rwkv_seq_job(p, obid(), smem); PROBE_AFTER(24); }
                else {
                    const int nb = G_ - n_rw, bid = obid() - n_rw;
                    for (int job = bid; job < n_gla + n_s5 + PEER_CONV_JOBS; job += nb) {
                        if (job < n_gla) gla_scan_job(p, job);
                        else if (job < n_gla + n_s5) s5_carry_job(p, job - n_gla);
                        else peer_conv_job(p, l, job - n_gla - n_s5);
                    }
                    { P pg = p; late_select(pg, l & 1); for (int job = bid; job < G2_JOBS; job += nb) g2_gemm_job(pg, job, smem); }
                    if (l + 1 < DEPTH) { late_select(p, (l + 1) & 1); phase_convert_weights(p, l + 1, smem, bid, nb); }
                }
            } else {
                for (int job = obid(); job < n_rw + n_gla + n_s5 + PEER_CONV_JOBS; job += G_) {
                    if (job < n_rw) rwkv_seq_job(p, job, smem);
                    else if (job < n_rw + n_gla) gla_scan_job(p, job - n_rw);
                    else if (job < n_rw + n_gla + n_s5) s5_carry_job(p, job - n_rw - n_gla);
                    else peer_conv_job(p, l, job - n_rw - n_gla - n_s5);
                }
                __syncthreads();
                { P pg = p; late_select(pg, l & 1); for (int job = obid(); job < G2_JOBS; job += G_) g2_gemm_job(pg, job, smem); }
                if (l + 1 < DEPTH) { late_select(p, (l + 1) & 1); phase_convert_weights(p, l + 1, smem, obid(), G_); }
            }
        }
        GRID_SYNC(); PROBE_AFTER(4);
        { LOADP(); phase_rwkv_out(p); }
        PROBE_AFTER(22);
        { LOADP(); phase_gla_out(p, l, smem); }
        PROBE_AFTER(23);
        { LOADP(); phase_s5_pass(p, l, smem, true); }
        GRID_SYNC(); PROBE_AFTER(5);
        { LOADP(); phase_side_elem(p, l); }
        if (l + 1 < DEPTH) { LOADP(); phase_s5const(p, l + 1); }
        { LOADP(); late_select(p, l & 1); phase_glu_gemm(p, l, smem); }
        GRID_SYNC(); PROBE_AFTER(7);
        { LOADP(); late_select(p, l & 1); phase_merge(p, l, smem); }
        GRID_SYNC(); PROBE_AFTER(8);
        { LOADP(); late_select(p, l & 1); phase_outproj(p, l, smem); }
        GRID_SYNC(); PROBE_AFTER(9);
        { LOADP(); phase_norm(p, l, 1); }
        GRID_SYNC(); PROBE_AFTER(10);
        { LOADP(); late_select(p, l & 1); phase_peer_q(p, l, smem); }
        GRID_SYNC(); PROBE_AFTER(11);
        { LOADP(); late_select(p, l & 1); phase_peer_topk(p, l, smem); }
        GRID_SYNC(); PROBE_AFTER(12);
        { LOADP(); phase_peer_gather(p, l); }
        if (l + 1 < DEPTH) { GRID_SYNC(); PROBE_AFTER(13); }
    }
}

static inline size_t align_up(size_t x) { return (x + 255) & ~(size_t)255; }

extern "C" void kernel_launch(void* const* d_in, const int* in_sizes, int n_in, void* d_out, int out_size, void* d_ws, size_t ws_size, hipStream_t stream) {
    P p;
    memset(&p, 0, sizeof(p));
    for (int i = 0; i < 39; ++i) p.in[i] = (const float*)d_in[i];
    p.out = (float*)d_out;
    char* w = (char*)d_ws; size_t off = 0;
    auto take = [&](size_t bytes) { void* r = w + off; off = align_up(off + bytes); return r; };
    p.bar = (unsigned*)take(16384);
    p.X = (float*)take((size_t)MTOT * D_MODEL * 4);
    p.H = (bf16_t*)take((size_t)MTOT * D_MODEL * 2);
    p.MOD = (float*)take((size_t)DEPTH * 2 * 6 * D_MODEL * 4);
    p.Z = (bf16_t*)take((size_t)MTOT * ZLD * 2);
    p.ZGT = (bf16_t*)take((size_t)MTOT * 3 * D_MODEL * 2);
    p.V = (bf16_t*)take((size_t)MTOT * RW * 2);
    {
        char* ra = (char*)take((size_t)MTOT * RW * 2 * 2 > (size_t)MTOT * GLA_V * 4 ? (size_t)MTOT * RW * 2 * 2 : (size_t)MTOT * GLA_V * 4);
        p.R = (bf16_t*)ra; p.KK = (bf16_t*)(ra + (size_t)MTOT * RW * 2);
        p.OGLA = (float*)ra;
    }
    {
        char* rb = (char*)take((size_t)2 * MTOT * RW * 2 > (size_t)3 * MTOT * PH * 16 * 4 ? (size_t)2 * MTOT * RW * 2 : (size_t)3 * MTOT * PH * 16 * 4);
        p.KD = (bf16_t*)rb;
        p.IDX = (int*)rb; p.G = (float*)(rb + (size_t)MTOT * PH * 16 * 4); p.GU = (float*)(rb + (size_t)2 * MTOT * PH * 16 * 4);
    }
    p.BB = (bf16_t*)take((size_t)2 * MTOT * RW * 2);
    p.G2B = p.BB;
    p.LW = (float*)take((size_t)2 * MTOT * RW * 4);
    p.SP = (bf16_t*)p.LW;
    static_assert((size_t)2 * NC * GH * 8192 * 2 <= (size_t)2 * MTOT * RW * 4, "SP alias");
    p.BONUS = (float*)take((size_t)2 * MTOT * RH * 4);
    p.KS = (bf16_t*)take((size_t)MTOT * RW * 2);
    p.LR = (bf16_t*)take((size_t)MTOT * 256 * 2);
    p.WT_W2 = (bf16_t*)take((size_t)2 * NPAD(RW) * 64 * 2);
    p.WT_A2 = (bf16_t*)take((size_t)2 * NPAD(RW) * 64 * 2);
    p.GS = (bf16_t*)take((size_t)MTOT * 128 * 2);
    p.Y = (float*)take((size_t)2 * MTOT * RW * 4);
    p.Y0T = (float*)take((size_t)2 * NC * RH * 4096 * 4);
    p.KV = (float*)take((size_t)2 * NC * GH * 8192 * 4);
    p.DEC = (float*)take((size_t)2 * NC * GH * 64 * 4);
    p.S5A = (float*)take((size_t)2 * SG * 64 * 2 * 4);
    p.S5BB = (float*)take((size_t)2 * SG * 64 * 16 * 2 * 4);
    p.S5END = (float*)take((size_t)2 * NC * SG * 64 * 2 * 4);
    p.S5CAR = (float*)take((size_t)2 * NC * SG * 64 * 2 * 4);
    {
        const size_t szc1 = (size_t)2 * NC * RH * SEQ_REC;
        const size_t szc2 = (size_t)MTOT * SW * 2 + (size_t)MTOT * RW * 4 + (size_t)MTOT * 3 * BW * 2 + (size_t)MTOT * D_MODEL * 2 + 1024;
        char* rc = (char*)take(szc1 > szc2 ? szc1 : szc2);
        p.REC = rc;
        char* c2 = rc;
        p.GY = (bf16_t*)c2; c2 += align_up((size_t)MTOT * SW * 2);
        p.YN = (float*)c2; c2 += align_up((size_t)MTOT * RW * 4);
        p.BR = (bf16_t*)c2; c2 += align_up((size_t)MTOT * 3 * BW * 2);
        p.M = (bf16_t*)c2;
    }
    p.SN = (bf16_t*)take((size_t)2 * NC * RH * 4096 * 2);
    p.QH = (bf16_t*)take((size_t)2 * NC * RH * 4096 * 2);
    p.WT_IN = (bf16_t*)take((size_t)NPAD192(D_IN) * D_MODEL * 2);
    {
        char* lb = (char*)take(2 * LATE_BYTES); size_t lo = 0;
        auto ltake = [&](size_t bytes) { void* r = lb + lo; lo = AL256(lo + bytes); return r; };
        p.WT_G2 = (bf16_t*)ltake((size_t)NPAD(RW) * 128 * 2);
        p.WT_GLU = (bf16_t*)ltake((size_t)NPAD(2 * SW) * SW * 2);
        p.WT_BR = (bf16_t*)ltake((size_t)3 * D_MODEL * BW * 2);
        p.WT_OUT = (bf16_t*)ltake((size_t)D_MODEL * D_MODEL * 2);
        p.WT_Q = (bf16_t*)ltake((size_t)PQ * D_MODEL * 2);
        p.KHI = (bf16_t*)ltake((size_t)PH * 2 * 128 * 128 * 2); p.KLO = (bf16_t*)ltake((size_t)PH * 2 * 128 * 128 * 2);
        if (lo != LATE_BYTES) fprintf(stderr, "late weights layout mismatch\n");
    }
    p.U8 = (unsigned char*)take((size_t)NEXP * D_MODEL);
    p.V8 = (unsigned char*)take((size_t)NEXP * D_MODEL);
    p.USC = (float*)take((size_t)NEXP * 4); p.VSC = (float*)take((size_t)NEXP * 4);
    p.QHI = p.Z; p.QLO = p.Z + (size_t)MTOT * PQ;
    static_assert((size_t)PQ * 4 <= (size_t)D_IN * 2 && ((size_t)MTOT * ZLD * 2) % 256 == 0, "Q alias");
    if (off > ws_size) { fprintf(stderr, "ws too small: need %zu have %zu\n", off, ws_size); return; }
#ifdef EMU
    fprintf(stderr, "ws used %zu MB\n", off >> 20);
    emu_launch([=] { fwd_megakernel(p); }, EMU_GRID, NTHREADS);
#else
    hipMemsetAsync(p.bar, 0, 16384, stream);
    static int grid_blocks = 0;
    if (!grid_blocks) {
        int dev = 0, cus = 0, per_cu = 0;
        hipGetDevice(&dev);
        hipDeviceGetAttribute(&cus, hipDeviceAttributeMultiprocessorCount, dev);
        hipOccupancyMaxActiveBlocksPerMultiprocessor(&per_cu, fwd_megakernel, NTHREADS, 0);
        if (per_cu > 1) per_cu = 1;
        grid_blocks = cus * per_cu;
    }
    void* args[] = {&p};
    hipError_t e = hipLaunchCooperativeKernel((void*)fwd_megakernel, dim3(grid_blocks), dim3(NTHREADS), args, 0, stream);
    if (e != hipSuccess) fprintf(stderr, "cooperative launch failed: %s (grid %d)\n", hipGetErrorString(e), grid_blocks);
#endif
}
```

```cpp
#include <hip/hip_runtime.h>
#ifndef EMU
#include <hip/hip_cooperative_groups.h>
namespace cg = cooperative_groups;
#endif
#include <cstdio>
#include <cstdint>
#include <cstring>
#include <type_traits>

#ifdef CFG_SMALL
#define D_MODEL 128
#define SEQ 640
#define DEPTH 2
#define GRID_W 10
#define CTX 128
#define GH 1
#define RH 2
#define SG 8
#define PH 2
#else
#define D_MODEL 1024
#define SEQ 16384
#define DEPTH 4
#define GRID_W 64
#define CTX 256
#define GH 4
#define RH 8
#define SG 32
#define PH 8
#endif
#define MTOT (CTX + SEQ)
#define ROWS (SEQ / GRID_W)
#define GLA_K (GH * 64)
#define GLA_V (GH * 128)
#define RW (RH * 64)
#define RWKV_IN (3 * RW + 4 * 64 + 128)
#define SW (SG * 16)
#define BW GLA_V
#define ZQ 0
#define ZK (GLA_K)
#define ZV (2 * GLA_K)
#define ZOG (ZV + GLA_V)
#define ZAF (ZOG + GLA_V)
#define ZAB (ZAF + 16)
#define ZR (ZAB + 16)
#define ZS5 (ZR + RWKV_IN)
#define ZG (ZS5 + SW)
#define D_IN (ZG + 3 * D_MODEL)
#define ZLD ZG
#define NC (MTOT / 64)
#define NCC (CTX / 64)
#define RB (ROWS / 64)
#define PQ (PH * 256)
#define NEXP 16384
#define NTHREADS 256
#define SMEM_BYTES 133120

typedef unsigned short bf16_t;
typedef short bf16x8 __attribute__((ext_vector_type(8)));
typedef float f32x4 __attribute__((ext_vector_type(4)));
typedef unsigned u32x4 __attribute__((ext_vector_type(4)));
typedef unsigned u32x2 __attribute__((ext_vector_type(2)));
#ifdef EMU
#define MFMA16(a, b, c) emu_mfma_16x16x32_bf16(a, b, c)
#else
#define MFMA16(a, b, c) __builtin_amdgcn_mfma_f32_16x16x32_bf16(a, b, c, 0, 0, 0)
#endif
typedef float f32x2 __attribute__((ext_vector_type(2)));
#ifdef EMU
#define CVT_PK_FP8(a, b, old, hi) emu_cvt_pk_fp8_f32(a, b, old, hi)
#define CVT_PK_F32_FP8(w, hi) emu_cvt_pk_f32_fp8(w, hi)
#else
#define CVT_PK_FP8(a, b, old, hi) __builtin_amdgcn_cvt_pk_fp8_f32(a, b, old, hi)
#define CVT_PK_F32_FP8(w, hi) __builtin_amdgcn_cvt_pk_f32_fp8(w, hi)
#endif
#ifdef EMU
#define MFMA16_ACC(a, b, c) c = emu_mfma_16x16x32_bf16(a, b, c)
#else
#define MFMA16_ACC(a, b, c) asm volatile("v_mfma_f32_16x16x32_bf16 %0, %1, %2, %0" : "+a"(c) : "v"(a), "v"(b))
#endif
#define NPAD(n) (((n) + 127) / 128 * 128)
#define NPAD192(n) (((n) + 383) / 384 * 384)

__device__ __forceinline__ float bf2f(bf16_t h) { return __builtin_bit_cast(float, ((unsigned)h) << 16); }
#ifdef EMU
__device__ __forceinline__ bf16_t f2bf(float f) { unsigned u = __builtin_bit_cast(unsigned, f); u += 0x7FFFu + ((u >> 16) & 1u); return (bf16_t)(u >> 16); }
__device__ __forceinline__ unsigned pack2bf(float a, float b) { return (unsigned)f2bf(a) | ((unsigned)f2bf(b) << 16); }
#else
typedef float f2v_t __attribute__((ext_vector_type(2))); typedef __bf16 b2v_t __attribute__((ext_vector_type(2)));
__device__ __forceinline__ bf16_t f2bf(float f) { return __builtin_bit_cast(unsigned short, (__bf16)f); }
__device__ __forceinline__ unsigned pack2bf(float a, float b) { f2v_t v = {a, b}; b2v_t r = __builtin_convertvector(v, b2v_t); return __builtin_bit_cast(unsigned, r); }
#endif
#ifdef EMU
#define fexp_(x) expf(x)
#define flog_(x) logf(x)
#else
#define fexp_(x) __expf(x)
#define flog_(x) __logf(x)
#endif
#define LO16(x) __builtin_bit_cast(float, (x) << 16)
#define HI16(x) __builtin_bit_cast(float, (x) & 0xFFFF0000u)
__device__ __forceinline__ float sigmoidf_(float x) { return 1.0f / (1.0f + fexp_(-x)); }
__device__ __forceinline__ float siluf_(float x) { return x * sigmoidf_(x); }
__device__ __forceinline__ float geluf_(float x) { const float y = 1.5957691216057308f * (x + 0.044715f * x * x * x); return x / (1.0f + fexp_(-y)); }
__device__ __forceinline__ float softplusf_(float x) { return fmaxf(x, 0.f) + flog_(1.0f + fexp_(-fabsf(x))); }
__device__ __forceinline__ float tanhf_(float x) { const float e = fexp_(-2.0f * fabsf(x)); const float t = (1.0f - e) / (1.0f + e); return x < 0.f ? -t : t; }
__device__ __forceinline__ float wave_sum(float v) {
#pragma unroll
    for (int m = 32; m >= 1; m >>= 1) v += __shfl_xor(v, m, 64);
    return v;
}

struct P {
    const float* in[39];
    float* out;
    float* X;
    bf16_t* H;
    bf16_t* Z;
    bf16_t* ZGT;
    float* MOD;
    bf16_t* R; bf16_t* V; bf16_t* KK; bf16_t* KD; bf16_t* BB;
    float* LW;
    char* REC;
    bf16_t* SN;
    bf16_t* QH;
    float* BONUS;
    bf16_t* KS;
    bf16_t* LR;
    bf16_t* WT_W2;
    bf16_t* WT_A2;
    bf16_t* GS;
    float* Y;
    bf16_t* G2B;
    float* Y0T;
    float* KV;
    bf16_t* SP;
    float* DEC;
    float* OGLA;
    float* S5A;
    float* S5BB;
    float* S5END;
    float* S5CAR;
    bf16_t* GY;
    float* YN;
    bf16_t* BR;
    bf16_t* M;
    bf16_t* QHI; bf16_t* QLO;
    bf16_t* KHI; bf16_t* KLO;
    int* IDX;
    float* G;
    float* GU;
    unsigned* bar;
    bf16_t* WT_IN;
    bf16_t* WT_G2;
    bf16_t* WT_GLU;
    bf16_t* WT_BR;
    bf16_t* WT_OUT;
    bf16_t* WT_Q;
    unsigned char* U8; unsigned char* V8;
    float* USC; float* VSC;
};

enum { I_X = 0, I_C, I_CTX, I_CCTX, I_WMOD, I_BMOD, I_N1G, I_N2G, I_WIN, I_GLA_WA2, I_GLA_BA, I_GLA_NG, I_RCONV, I_RW0, I_RW2, I_RA0, I_RA2, I_RG2,
       I_RKK, I_RKA, I_RRK, I_RLNW, I_RLNB, I_S5LRE, I_S5LIM, I_S5LS, I_S5BRE, I_S5BIM, I_S5CRE, I_S5CIM, I_S5D, I_S5GLU, I_WBR, I_WOUT, I_PWQ, I_PKEYS, I_PU, I_PV, I_FG };

#define AL256(x) (((size_t)(x) + 255) & ~(size_t)255)
#define LATE_BYTES (AL256((size_t)NPAD(RW) * 128 * 2) + AL256((size_t)NPAD(2 * SW) * SW * 2) + AL256((size_t)3 * D_MODEL * BW * 2) + AL256((size_t)D_MODEL * D_MODEL * 2) + \
                    AL256((size_t)PQ * D_MODEL * 2) + 2 * AL256((size_t)PH * 2 * 128 * 128 * 2))
__device__ __forceinline__ void late_select(P& p, int par) {
    const size_t o = (size_t)par * (LATE_BYTES / 2);
    p.WT_G2 += o; p.WT_GLU += o; p.WT_BR += o; p.WT_OUT += o; p.WT_Q += o; p.KHI += o; p.KLO += o;
}
#ifdef EMU
__device__ __forceinline__ int otid() { return threadIdx.x; }
__device__ __forceinline__ int obid() { return blockIdx.x; }
#else
__device__ __forceinline__ int otid() { int t = threadIdx.x; asm volatile("" : "+v"(t)); return t; }
__device__ __forceinline__ int obid() { int b = blockIdx.x; asm volatile("" : "+s"(b)); return b; }
#endif
#ifdef EMU
#define WAVE_SYNC() emu_wave_barrier()
#ifndef EMU_GRID
#define EMU_GRID 4
#endif
#else
#define WAVE_SYNC() __builtin_amdgcn_wave_barrier()
#endif
#ifndef EMU
#define XB_TMO      128
#define XB_XCNT(j)  (256  + 64 * (j))
#define XB_XSUB(j)  (1280 + 64 * (j))
#define XB_XGEN(j)  (2304 + 64 * (j))
#define XB_TOP      3328
#define XB_TOPGEN   3392
#define XCD_BAR_WORDS 3456
#define XB_SPIN_CAP (1u << 22)
#define LAS __attribute__((address_space(3)))
__device__ __forceinline__ unsigned xb_ld(unsigned* p)              { return __hip_atomic_load(p, __ATOMIC_RELAXED, __HIP_MEMORY_SCOPE_AGENT); }
__device__ __forceinline__ unsigned xb_add(unsigned* p, unsigned v) { return __hip_atomic_fetch_add(p, v, __ATOMIC_RELAXED, __HIP_MEMORY_SCOPE_AGENT); }
__device__ __forceinline__ unsigned xb_xcc_id() { return (unsigned)__builtin_amdgcn_s_getreg((3 << 11) | 20) & 0xFu; }
#define XB_SPIN(cond, bar) do { unsigned _sp = 0; while (cond) { __builtin_amdgcn_s_sleep(1); \
    if ((++_sp & 255u) == 0u) { if (xb_ld(&(bar)[XB_TMO])) break; if (_sp > XB_SPIN_CAP) { atomicAdd(&(bar)[XB_TMO], 1u); break; } } } } while (0)
struct XcdBarrier { unsigned* bar; unsigned x; volatile LAS unsigned* st; };
__device__ __forceinline__ XcdBarrier xcd_barrier_post(unsigned* bar, volatile LAS unsigned* st) {
    XcdBarrier b; b.bar = bar; b.x = xb_xcc_id(); b.st = st;
    if (threadIdx.x == 0) st[3] = xb_add(&bar[XB_XCNT(b.x)], 1u);
    return b;
}
__device__ __forceinline__ void xcd_barrier_complete(unsigned* bar, unsigned x, unsigned& nloc, unsigned& nx) {
    const unsigned G = gridDim.x * gridDim.y * gridDim.z;
    unsigned sum, cnt, mine, sp = 0u;
    for (;;) {
        sum = 0u; cnt = 0u; mine = 0u;
#pragma unroll
        for (unsigned j = 0; j < 16; ++j) { const unsigned c = xb_ld(&bar[XB_XCNT(j)]); sum += c; cnt += (c > 0u) ? 1u : 0u; mine = (j == x) ? c : mine; }
        if (sum == G) break;
        __builtin_amdgcn_s_sleep(1);
        if ((++sp & 255u) == 0u) { if (xb_ld(&bar[XB_TMO])) break; if (sp > XB_SPIN_CAP) { atomicAdd(&bar[XB_TMO], 1u); break; } }
    }
    nloc = mine > 0u ? mine : 1u; nx = cnt > 0u ? cnt : 1u;
}
__device__ __forceinline__ void xcd_barrier(const XcdBarrier& b) {
    asm volatile("s_waitcnt vmcnt(0)" ::: "memory");
    __syncthreads();
    if (threadIdx.x == 0) {
        unsigned* bar = b.bar;
        __builtin_amdgcn_fence(__ATOMIC_RELEASE, "agent");
        asm volatile("s_waitcnt vmcnt(0)" ::: "memory");
        const unsigned G = gridDim.x;
        const unsigned old = xb_add(&bar[XB_TOP], 1u);
        const unsigned tg = old / G;
        if (old + 1u == (tg + 1u) * G) {
            const unsigned long long t0_ = wall_clock64(); while (wall_clock64() - t0_ < 1000ull) __builtin_amdgcn_s_sleep(8);
            xb_add(&bar[XB_TOPGEN], 1u);
        }
        else XB_SPIN(xb_ld(&bar[XB_TOPGEN]) == tg, bar);
        __builtin_amdgcn_fence(__ATOMIC_ACQUIRE, "agent");
        asm volatile("s_waitcnt vmcnt(0)" ::: "memory");
    }
    __syncthreads();
}
#define GRID_SYNC() { (void)xb; asm volatile("s_waitcnt vmcnt(0)" ::: "memory"); cg::this_grid().sync(); }
#else
#define GRID_SYNC() emu_grid_sync()
#endif

#ifdef EMU
#define LOADP() P p = p_arg
#else
typedef __attribute__((address_space(4))) const unsigned long long cu64_t;
__device__ __forceinline__ void load_params(P& p) {
    cu64_t* q = (cu64_t*)__builtin_amdgcn_kernarg_segment_ptr();
    asm volatile("" : "+s"(q));
    typedef __attribute__((address_space(1))) char gchar_t;
    char* w[sizeof(P) / 8];
#pragma unroll
    for (int i = 0; i < (int)(sizeof(P) / 8); ++i) w[i] = (char*)(gchar_t*)q[i];
    __builtin_memcpy(&p, w, sizeof(P));
}
#define LOADP() P p; load_params(p)
#endif
#define PROBE_MULT 3
#if defined(PROBE_ID) && !defined(EMU)
#define PROBE_INIT() unsigned long long probe_t0 = wall_clock64()
#define PROBE_AFTER(id) { if (blockIdx.x == 0) { unsigned long long now_ = wall_clock64(); if ((id) == PROBE_ID || (id) == PROBE_ID2) { const unsigned long long dt_ = now_ - probe_t0; \
    while (wall_clock64() - now_ < dt_ * PROBE_MULT) __builtin_amdgcn_s_sleep(8); now_ = wall_clock64(); } probe_t0 = now_; } }
#else
#define PROBE_INIT()
#define PROBE_AFTER(id)
#endif
__device__ __forceinline__ int gla_tok(int n, int i) {
    if (n < NCC) return n * 64 + i;
    int m = n - NCC; int col = m / RB, rb = m % RB;
    return CTX + (rb * 64 + i) * GRID_W + col;
}
__device__ __forceinline__ int chunk_order(int d, int s) {
    if (d == 0) return s;
    return (s < NCC) ? (NCC - 1 - s) : (NC - 1 - (s - NCC));
}
__device__ __forceinline__ int tok_order(int d, int s) {
    if (d == 0) return s;
    return (s < CTX) ? (CTX - 1 - s) : (MTOT - 1 - (s - CTX));
}


#define LDS_ROW 72
__device__ __forceinline__ void mfma_gemm_tile(const bf16_t* Wt, int ldw, const bf16_t* Act, int lda, int K, int n0, int m0, bf16_t* lds, f32x4 (&acc)[4][4]) {
    bf16_t* Ws = lds; bf16_t* As = lds + 128 * LDS_ROW;
    const int tid = otid(), lane = tid & 63, wave = tid >> 6, wn = wave >> 1, wm = wave & 1;
    const int lrow = tid >> 3, lkc = (tid & 7) * 8;
    u32x4 pw[4], pa[4];
#pragma unroll
    for (int i = 0; i < 4; ++i) {
        pw[i] = *(const u32x4*)(Wt + (size_t)(n0 + lrow + 32 * i) * ldw + lkc);
        pa[i] = *(const u32x4*)(Act + (size_t)(m0 + lrow + 32 * i) * lda + lkc);
    }
    for (int k0 = 0; k0 < K; k0 += 64) {
        __syncthreads();
#pragma unroll
        for (int i = 0; i < 4; ++i) {
            *(u32x4*)(Ws + (lrow + 32 * i) * LDS_ROW + lkc) = pw[i];
            *(u32x4*)(As + (lrow + 32 * i) * LDS_ROW + lkc) = pa[i];
        }
        __syncthreads();
        if (k0 + 64 < K) {
#pragma unroll
            for (int i = 0; i < 4; ++i) {
                pw[i] = *(const u32x4*)(Wt + (size_t)(n0 + lrow + 32 * i) * ldw + k0 + 64 + lkc);
                pa[i] = *(const u32x4*)(Act + (size_t)(m0 + lrow + 32 * i) * lda + k0 + 64 + lkc);
            }
        }
#pragma unroll
        for (int ks = 0; ks < 2; ++ks) {
            bf16x8 a[4], b[4];
#pragma unroll
            for (int i = 0; i < 4; ++i) {
                a[i] = *(const bf16x8*)(Ws + (wn * 64 + i * 16 + (lane & 15)) * LDS_ROW + ks * 32 + (lane >> 4) * 8);
                b[i] = *(const bf16x8*)(As + (wm * 64 + i * 16 + (lane & 15)) * LDS_ROW + ks * 32 + (lane >> 4) * 8);
            }
#pragma unroll
            for (int ni = 0; ni < 4; ++ni)
#pragma unroll
                for (int mi = 0; mi < 4; ++mi) acc[ni][mi] = MFMA16(a[ni], b[mi], acc[ni][mi]);
        }
    }
}
#define L64_ROW 72
#ifdef EMU
struct BufRsrc { const char* base; };
__device__ __forceinline__ BufRsrc make_rsrc(const void* p, size_t) { BufRsrc r; r.base = (const char*)p; return r; }
__device__ __forceinline__ u32x4 buf_load16(const BufRsrc& r, unsigned voff, unsigned soff) { return *(const u32x4*)(r.base + voff + soff); }
#else
typedef __amdgpu_buffer_rsrc_t BufRsrc;
__device__ __forceinline__ BufRsrc make_rsrc(const void* p, size_t bytes) { return __builtin_amdgcn_make_buffer_rsrc((void*)p, 0, (int)bytes, 0x00020000); }
__device__ __forceinline__ u32x4 buf_load16(const BufRsrc& r, unsigned voff, unsigned soff) { return __builtin_bit_cast(u32x4, __builtin_amdgcn_raw_buffer_load_b128(r, voff, soff, 0)); }
#endif
template <int NI, int MI>
__device__ __forceinline__ void mfma_gemm_tile_t(const bf16_t* Wt, int ldw, size_t wbytes, const bf16_t* Act, int lda, size_t abytes, int K, int n0, int m0, bf16_t* lds, f32x4 (&acc)[NI][MI], unsigned long long* gacc = nullptr) {
    constexpr int WR = 32 * NI, AR = 32 * MI, BUF = (WR + AR) * L64_ROW;
    const int tid = otid(), lane = tid & 63, wave = tid >> 6, wn = wave >> 1, wm = wave & 1;
    const int lrow = tid >> 3, lkc = (tid & 7) * 8;
    const BufRsrc rw = make_rsrc(Wt, wbytes), ra = make_rsrc(Act, abytes);
    unsigned vw[NI], va[MI];
#pragma unroll
    for (int i = 0; i < NI; ++i) vw[i] = (unsigned)(((size_t)(n0 + lrow + 32 * i) * ldw + lkc) * 2);
#pragma unroll
    for (int i = 0; i < MI; ++i) va[i] = (unsigned)(((size_t)(m0 + lrow + 32 * i) * lda + lkc) * 2);
    u32x4 qw0[NI], qa0[MI];
    const int nk = K / 64;
#define GT_LOAD(QW, QA, KT) { const unsigned so_ = (unsigned)(((KT) < nk) ? (KT) : (nk - 1)) * 128u; \
    _Pragma("unroll") for (int i = 0; i < NI; ++i) QW[i] = buf_load16(rw, vw[i], so_); \
    _Pragma("unroll") for (int i = 0; i < MI; ++i) QA[i] = buf_load16(ra, va[i], so_); }
#define GT_STORE(QW, QA, DST) { \
    _Pragma("unroll") for (int i = 0; i < NI; ++i) *(u32x4*)((DST) + (lrow + 32 * i) * L64_ROW + lkc) = QW[i]; \
    _Pragma("unroll") for (int i = 0; i < MI; ++i) *(u32x4*)((DST) + (WR + lrow + 32 * i) * L64_ROW + lkc) = QA[i]; }
#define GT_COMPUTE(CUR) { _Pragma("unroll") for (int ks = 0; ks < 2; ++ks) { bf16x8 b[MI], a[NI]; \
    _Pragma("unroll") for (int i = 0; i < MI; ++i) b[i] = *(const bf16x8*)((CUR) + (WR + wm * 16 * MI + i * 16 + (lane & 15)) * L64_ROW + ks * 32 + (lane >> 4) * 8); \
    _Pragma("unroll") for (int i = 0; i < NI; ++i) a[i] = *(const bf16x8*)((CUR) + (wn * 16 * NI + i * 16 + (lane & 15)) * L64_ROW + ks * 32 + (lane >> 4) * 8); \
    _Pragma("unroll") for (int ni = 0; ni < NI; ++ni) { \
        _Pragma("unroll") for (int mi = 0; mi < MI; ++mi) MFMA16_ACC(a[ni], b[mi], acc[ni][mi]); } } }
    GT_LOAD(qw0, qa0, 0)
    __syncthreads();
    GT_STORE(qw0, qa0, lds)
    __syncthreads();
    for (int kt = 0; kt < nk; kt += 2) {
        GT_LOAD(qw0, qa0, kt + 1)
        GT_COMPUTE(lds)
        GT_STORE(qw0, qa0, lds + BUF)
        __syncthreads();
        GT_LOAD(qw0, qa0, kt + 2)
        GT_COMPUTE(lds + BUF)
        GT_STORE(qw0, qa0, lds)
        __syncthreads();
    }
#undef GT_LOAD
#undef GT_STORE
#undef GT_COMPUTE
}
#define ZERO_ACC4(acc) { _Pragma("unroll") for (int i_ = 0; i_ < 4; ++i_) _Pragma("unroll") for (int j_ = 0; j_ < 4; ++j_) acc[i_][j_] = (f32x4){0.f, 0.f, 0.f, 0.f}; }
#define FOR_ACC(acc, n0, m0, BODY) { const int lane_ = otid() & 63, wave_ = otid() >> 6; \
    _Pragma("unroll") for (int ni_ = 0; ni_ < 4; ++ni_) _Pragma("unroll") for (int mi_ = 0; mi_ < 4; ++mi_) { \
        const int n = (n0) + (wave_ >> 1) * 64 + ni_ * 16 + (lane_ >> 4) * 4; const int m = (m0) + (wave_ & 1) * 64 + mi_ * 16 + (lane_ & 15); const f32x4 v = acc[ni_][mi_]; BODY } }
__device__ __forceinline__ u32x2 pack4(float a, float b, float c, float d) { u32x2 r; r.x = pack2bf(a, b); r.y = pack2bf(c, d); return r; }

__device__ __forceinline__ void convert_wt_job(const float* W, int K, int N, int Npad, bf16_t* out, int job, float* T, int ilv) {
    const int tid = otid();
    const int nkt = K / 64;
    const int n0 = (job / nkt) * 64, k0 = (job % nkt) * 64;
    __syncthreads();
    for (int idx = tid; idx < 4096; idx += NTHREADS) {
        int kk = idx >> 6, nn = idx & 63;
        int nr = n0 + nn; int src = ilv ? ((nr & 1) ? (N / 2 + (nr >> 1)) : (nr >> 1)) : nr;
        T[kk * 65 + nn] = (nr < N) ? W[(size_t)(k0 + kk) * N + src] : 0.f;
    }
    __syncthreads();
    {
        int nn = tid >> 2, part = tid & 3;
        unsigned w[8];
#pragma unroll
        for (int j = 0; j < 8; ++j) w[j] = pack2bf(T[(part * 16 + 2 * j) * 65 + nn], T[(part * 16 + 2 * j + 1) * 65 + nn]);
        u32x4* o = (u32x4*)(out + (size_t)(n0 + nn) * K + k0 + part * 16);
        o[0] = (u32x4){w[0], w[1], w[2], w[3]}; o[1] = (u32x4){w[4], w[5], w[6], w[7]};
    }
}
__device__ __forceinline__ void phase_convert_weights(const P& p, int l, char* smem, int bid, int nb) {
    float* T = (float*)smem;
    struct Item { const float* W; int K, N, Npad; bf16_t* out; };
    const Item items[12] = {
        {p.in[I_RW2] + ((size_t)l * 2 + 0) * 64 * RW, 64, RW, NPAD(RW), p.WT_W2},
        {p.in[I_RW2] + ((size_t)l * 2 + 1) * 64 * RW, 64, RW, NPAD(RW), p.WT_W2 + (size_t)NPAD(RW) * 64},
        {p.in[I_RA2] + ((size_t)l * 2 + 0) * 64 * RW, 64, RW, NPAD(RW), p.WT_A2},
        {p.in[I_RA2] + ((size_t)l * 2 + 1) * 64 * RW, 64, RW, NPAD(RW), p.WT_A2 + (size_t)NPAD(RW) * 64},
        {p.in[I_WIN] + (size_t)l * D_MODEL * D_IN, D_MODEL, D_IN, NPAD192(D_IN), p.WT_IN},
        {p.in[I_RG2] + (size_t)l * 128 * RW, 128, RW, RW, p.WT_G2},
        {p.in[I_S5GLU] + (size_t)l * SW * 2 * SW, SW, 2 * SW, 2 * SW, p.WT_GLU},
        {p.in[I_WBR] + ((size_t)l * 3 + 0) * BW * D_MODEL, BW, D_MODEL, D_MODEL, p.WT_BR},
        {p.in[I_WBR] + ((size_t)l * 3 + 1) * BW * D_MODEL, BW, D_MODEL, D_MODEL, p.WT_BR + (size_t)D_MODEL * BW},
        {p.in[I_WBR] + ((size_t)l * 3 + 2) * BW * D_MODEL, BW, D_MODEL, D_MODEL, p.WT_BR + (size_t)2 * D_MODEL * BW},
        {p.in[I_WOUT] + (size_t)l * D_MODEL * D_MODEL, D_MODEL, D_MODEL, D_MODEL, p.WT_OUT},
        {p.in[I_PWQ] + (size_t)l * D_MODEL * PQ, D_MODEL, PQ, PQ, p.WT_Q}};
    int base = 0;
#pragma unroll
    for (int it = 0; it < 12; ++it) {
        const int nj = (items[it].Npad / 64) * (items[it].K / 64);
        for (int j = (bid + nb - (base % nb)) % nb; j < nj; j += nb)
            convert_wt_job(items[it].W, items[it].K, items[it].N, items[it].Npad, items[it].out, j, T, it == 6);
        base += nj;
    }
    __syncthreads();
    {
        const float* ks = p.in[I_PKEYS] + (size_t)l * PH * 2 * 128 * 128;
        for (size_t i = (size_t)bid * NTHREADS + otid(); i < (size_t)PH * 2 * 128 * 128; i += (size_t)nb * NTHREADS) {
            const float v = ks[i]; const bf16_t hb = f2bf(v);
            p.KHI[i] = hb; p.KLO[i] = f2bf(v - bf2f(hb));
        }
    }
}

#ifdef EMU
__device__ __forceinline__ int xcd_rank() { return obid(); }
#else
__device__ __forceinline__ int xcd_rank() { return (int)((volatile LAS unsigned*)(unsigned)(SMEM_BYTES))[2]; }
#endif
__device__ __forceinline__ bool tile_map(int it, int ntm, int ntn, int PM, int& mt, int& nt) {
    const int G = gridDim.x;
    const long id = (long)it * G + xcd_rank();
    if (id >= (long)ntm * ntn) return false;
    const int full = ntm / PM; const long fullsz = (long)full * PM * ntn;
    if (id < fullsz) { const int p = (int)(id / (PM * ntn)), rem = (int)(id % (PM * ntn)); nt = rem / PM; mt = p * PM + rem % PM; }
    else { const int rem = (int)(id - fullsz), hh = ntm - full * PM; nt = rem / hh; mt = full * PM + rem % hh; }
    return true;
}

template <int NI, int MI, class Pre, class Post>
__device__ __forceinline__ void gemm_tile_run(const bf16_t* Wt, int ldw, size_t wbytes, const bf16_t* Act, int lda, size_t abytes, int K, int n0, int m0, bf16_t* lds, Pre pre, Post post) {
    f32x4 acc[NI][MI];
#pragma unroll
    for (int i = 0; i < NI; ++i)
#pragma unroll
        for (int j = 0; j < MI; ++j) acc[i][j] = (f32x4){0.f, 0.f, 0.f, 0.f};
    pre(m0, n0, acc, lds);
    mfma_gemm_tile_t<NI, MI>(Wt, ldw, wbytes, Act, lda, abytes, K, n0, m0, lds, acc);
    const int lane = otid() & 63, wave = otid() >> 6;
#pragma unroll
    for (int ni = 0; ni < NI; ++ni)
#pragma unroll
        for (int mi = 0; mi < MI; ++mi)
            post(ni, mi, m0 + (wave & 1) * 16 * MI + mi * 16 + (lane & 15), n0 + (wave >> 1) * 16 * NI + ni * 16 + (lane >> 4) * 4, acc[ni][mi]);
}
struct NoPre { template <class A> __device__ __forceinline__ void operator()(int, int, A&, bf16_t*) const {} };
template <int NI, class PreM, class PreT, class Post>
__device__ __forceinline__ void gemm_phase(const bf16_t* Wt, int ldw, size_t wbytes, const bf16_t* Act, int lda, size_t abytes, int K, int N, bf16_t* lds, PreM prem, PreT pret, Post post) {
    const int ntn = N / (32 * NI), ntm = MTOT / 256 - 1;
    const int PM = (ntn >= 16) ? 2 : ((ntn >= 8) ? 4 : 8);
    for (int it = 0;; ++it) {
        int mt_, nt_; if (!tile_map(it, ntm, ntn, PM, mt_, nt_)) break;
        gemm_tile_run<NI, 8>(Wt, ldw, wbytes, Act, lda, abytes, K, nt_ * 32 * NI, mt_ * 256, lds, prem, post);
    }
    for (int job = obid(); job < 4 * ntn; job += gridDim.x)
        gemm_tile_run<NI, 2>(Wt, ldw, wbytes, Act, lda, abytes, K, (job >> 2) * 32 * NI, MTOT - 256 + (job & 3) * 64, lds, pret, post);
}

__device__ __forceinline__ void phase_init(const P& p, char* smem) {
    const int tid = otid();
    float* sc = (float*)smem;
    for (int i = tid; i < D_MODEL; i += NTHREADS) { sc[i] = siluf_(p.in[I_CCTX][i]); sc[D_MODEL + i] = siluf_(p.in[I_C][i]); }
    __syncthreads();
    const int ncolblk = (6 * D_MODEL) / NTHREADS;
    for (int job = obid(); job < DEPTH * ncolblk; job += gridDim.x) {
        int l = job / ncolblk, n = (job % ncolblk) * NTHREADS + tid;
        const float* w = p.in[I_WMOD] + (size_t)l * D_MODEL * 6 * D_MODEL + n;
        float a0 = 0.f, a1 = 0.f;
        for (int k = 0; k < D_MODEL; ++k) { float wv = w[(size_t)k * 6 * D_MODEL]; a0 += sc[k] * wv; a1 += sc[D_MODEL + k] * wv; }
        float b = p.in[I_BMOD][l * 6 * D_MODEL + n];
        p.MOD[(size_t)(l * 2 + 0) * 6 * D_MODEL + n] = a0 + b;
        p.MOD[(size_t)(l * 2 + 1) * 6 * D_MODEL + n] = a1 + b;
    }
    const size_t gtid = (size_t)obid() * NTHREADS + tid, gn = (size_t)gridDim.x * NTHREADS;
    for (size_t i = gtid; i < (size_t)CTX * D_MODEL; i += gn) p.X[i] = p.in[I_CTX][i];
    for (size_t i = gtid; i < (size_t)SEQ * D_MODEL; i += gn) p.X[(size_t)CTX * D_MODEL + i] = p.in[I_X][i];
    __syncthreads();
}

__device__ __forceinline__ void phase_s5const(const P& p, int l) {
    const size_t gtid = (size_t)obid() * NTHREADS + otid(), gn = (size_t)gridDim.x * NTHREADS;
    for (size_t i = gtid; i < (size_t)2 * SG * 64; i += gn) {
        int d = (int)(i / (SG * 64)), g = (int)((i / 64) % SG), s = (int)(i % 64);
        size_t li = ((size_t)(l * 2 + d) * SG + g) * 64 + s;
        float lre = p.in[I_S5LRE][li], lim = p.in[I_S5LIM][li];
        float dt = expf(p.in[I_S5LS][(l * 2 + d) * SG + g]);
        float mag = expf(lre * dt);
        float are = mag * cosf(lim * dt), aim = mag * sinf(lim * dt);
        float den = lre * lre + lim * lim;
        float fre = ((are - 1.0f) * lre + aim * lim) / den;
        float fim = (aim * lre - (are - 1.0f) * lim) / den;
        p.S5A[i * 2 + 0] = are; p.S5A[i * 2 + 1] = aim;
        const float* bre = p.in[I_S5BRE] + (((size_t)l * SG + g) * 64 + s) * 16;
        const float* bim = p.in[I_S5BIM] + (((size_t)l * SG + g) * 64 + s) * 16;
        for (int c = 0; c < 16; ++c) {
            p.S5BB[(i * 16 + c) * 2 + 0] = fre * bre[c] - fim * bim[c];
            p.S5BB[(i * 16 + c) * 2 + 1] = fre * bim[c] + fim * bre[c];
        }
    }
}

__device__ __forceinline__ void phase_norm(const P& p, int l, int which) {
    const int lane = otid() & 63;
    const int gw = (obid() * NTHREADS + otid()) >> 6, nw = (gridDim.x * NTHREADS) >> 6;
    const float* g = p.in[which ? I_N2G : I_N1G] + l * D_MODEL;
    constexpr int NJ = (D_MODEL + 255) / 256;
    for (int t = gw; t < MTOT; t += nw) {
        const float* x = p.X + (size_t)t * D_MODEL;
        const float* mod = p.MOD + (size_t)(l * 2 + (t >= CTX ? 1 : 0)) * 6 * D_MODEL + (which ? 3 * D_MODEL : 0);
        float4 v[NJ]; float ss = 0.f;
#pragma unroll
        for (int j = 0; j < NJ; ++j) {
            const int e = j * 256 + lane * 4;
            if (e < D_MODEL) v[j] = *(const float4*)(x + e); else { v[j].x = 0.f; v[j].y = 0.f; v[j].z = 0.f; v[j].w = 0.f; }
            ss += v[j].x * v[j].x + v[j].y * v[j].y + v[j].z * v[j].z + v[j].w * v[j].w;
        }
        ss = wave_sum(ss);
        const float rstd = rsqrtf(ss / D_MODEL + 1e-6f);
#pragma unroll
        for (int j = 0; j < NJ; ++j) {
            const int e = j * 256 + lane * 4;
            if (e < D_MODEL) {
                const float4 gg = *(const float4*)(g + e), sc = *(const float4*)(mod + D_MODEL + e), sh = *(const float4*)(mod + e);
                *(u32x2*)(p.H + (size_t)t * D_MODEL + e) = pack4(v[j].x * rstd * gg.x * (1.0f + sc.x) + sh.x, v[j].y * rstd * gg.y * (1.0f + sc.y) + sh.y,
                                                                 v[j].z * rstd * gg.z * (1.0f + sc.z) + sh.z, v[j].w * rstd * gg.w * (1.0f + sc.w) + sh.w);
            }
        }
    }
}

__device__ __forceinline__ void phase_gemm_in(const P& p, int l, char* smem) {
    constexpr int NI = 6, MI = 8;
    const int ntn = NPAD192(D_IN) / 192, ntm = MTOT / 256;
    for (int it = 0;; ++it) {
        int mt_, nt_; if (!tile_map(it, ntm, ntn, 4, mt_, nt_)) break;
        const int m0 = mt_ * 256, n0 = nt_ * 192;
        f32x4 acc[NI][MI];
#pragma unroll
        for (int i = 0; i < NI; ++i)
#pragma unroll
            for (int j = 0; j < MI; ++j) acc[i][j] = (f32x4){0.f, 0.f, 0.f, 0.f};
        mfma_gemm_tile_t<NI, MI>(p.WT_IN, D_MODEL, (size_t)NPAD192(D_IN) * D_MODEL * 2, p.H, D_MODEL, (size_t)MTOT * D_MODEL * 2, D_MODEL, n0, m0, (bf16_t*)smem, acc);
        const int lane = otid() & 63, wave = otid() >> 6;
#pragma unroll
        for (int ni = 0; ni < NI; ++ni)
#pragma unroll
            for (int mi = 0; mi < MI; ++mi) {
                const int n = n0 + (wave >> 1) * 16 * NI + ni * 16 + (lane >> 4) * 4, m = m0 + (wave & 1) * 16 * MI + mi * 16 + (lane & 15);
                const u32x2 pk_ = pack4(acc[ni][mi][0], acc[ni][mi][1], acc[ni][mi][2], acc[ni][mi][3]);
                if (n < ZG) *(u32x2*)(p.Z + (size_t)m * ZLD + n) = pk_;
                else if (n < D_IN) *(u32x2*)(p.ZGT + ((((size_t)(m >> 4) * (3 * D_MODEL / 16) + ((n - ZG) >> 4)) * 64 + lane) * 4)) =
                    pack4(sigmoidf_(acc[ni][mi][0]), sigmoidf_(acc[ni][mi][1]), sigmoidf_(acc[ni][mi][2]), sigmoidf_(acc[ni][mi][3]));
            }
    }
}

__device__ __forceinline__ void unpack8(const u32x4 w, float (&f)[8]) {
    f[0] = LO16(w.x); f[1] = HI16(w.x); f[2] = LO16(w.y); f[3] = HI16(w.y); f[4] = LO16(w.z); f[5] = HI16(w.z); f[6] = LO16(w.w); f[7] = HI16(w.w);
}
__device__ __forceinline__ u32x4 pack8(const float (&f)[8]) {
    u32x4 o; o.x = pack2bf(f[0], f[1]); o.y = pack2bf(f[2], f[3]);
    o.z = pack2bf(f[4], f[5]); o.w = pack2bf(f[6], f[7]); return o;
}
__device__ __forceinline__ void load8f(const float* p, float (&f)[8]) {
    const float4 a = *(const float4*)p, b = *(const float4*)(p + 4);
    f[0] = a.x; f[1] = a.y; f[2] = a.z; f[3] = a.w; f[4] = b.x; f[5] = b.y; f[6] = b.z; f[7] = b.w;
}
__device__ __forceinline__ void store8f(float* p, const float (&f)[8]) {
    float4 a, b; a.x = f[0]; a.y = f[1]; a.z = f[2]; a.w = f[3]; b.x = f[4]; b.y = f[5]; b.z = f[6]; b.w = f[7];
    *(float4*)p = a; *(float4*)(p + 4) = b;
}
__device__ __forceinline__ void conv8(const bf16_t* zp, const float* conv, int c0, bool act, bool first, bool last, float (&out)[8]) {
    const u32x4 z4 = {0u, 0u, 0u, 0u};
    const u32x4 a0 = act ? *(const u32x4*)(zp + c0) : z4;
    const u32x4 am = (act && !first) ? *(const u32x4*)(zp + c0 - ZLD) : z4;
    const u32x4 an = (act && !last) ? *(const u32x4*)(zp + c0 + ZLD) : z4;
    float w0[8], w1[8], w2[8], f0[8], fm[8], fn[8];
    if (act) { load8f(conv + c0, w0); load8f(conv + RWKV_IN + c0, w1); load8f(conv + 2 * RWKV_IN + c0, w2); }
    else {
#pragma unroll
        for (int e = 0; e < 8; ++e) { w0[e] = 0.f; w1[e] = 0.f; w2[e] = 0.f; }
    }
    unpack8(a0, f0); unpack8(am, fm); unpack8(an, fn);
#pragma unroll
    for (int e = 0; e < 8; ++e) out[e] = w1[e] * f0[e] + w0[e] * fm[e] + w2[e] * fn[e];
}
__device__ __forceinline__ void phase_rwkv_prep1(const P& p, int l) {
    const int lane = otid() & 63;
    const int gw = (obid() * NTHREADS + otid()) >> 6, nw = (gridDim.x * NTHREADS) >> 6;
    const float* conv = p.in[I_RCONV] + (size_t)l * 3 * RWKV_IN;
    const float* k_k = p.in[I_RKK] + (size_t)l * RW;
    const bool act = lane * 8 < RW, act2 = lane * 8 < 384;
    float kkw[8];
    if (act) load8f(k_k + lane * 8, kkw);
    else {
#pragma unroll
        for (int e = 0; e < 8; ++e) kkw[e] = 0.f;
    }
    for (int t = gw; t < MTOT; t += nw) {
        const bool first = (t == 0) || (t == CTX), last = (t == CTX - 1) || (t == MTOT - 1);
        const bf16_t* zp = p.Z + (size_t)t * ZLD + ZR;
        float rv[8], kv[8], vv[8], lr[8];
        conv8(zp, conv, 0 * RW + lane * 8, act, first, last, rv);
        conv8(zp, conv, 1 * RW + lane * 8, act, first, last, kv);
        conv8(zp, conv, 2 * RW + lane * 8, act, first, last, vv);
        conv8(zp, conv, 3 * RW + lane * 8, act2, first, last, lr);
        float kk[8]; float ss = 0.f;
#pragma unroll
        for (int e = 0; e < 8; ++e) { kk[e] = kv[e] * kkw[e]; ss += kk[e] * kk[e]; }
        ss += __shfl_xor(ss, 1, 64); ss += __shfl_xor(ss, 2, 64); ss += __shfl_xor(ss, 4, 64);
        const float inv = 1.0f / fmaxf(sqrtf(ss), 1e-12f);
#pragma unroll
        for (int e = 0; e < 8; ++e) kk[e] *= inv;
        if (act) {
            const size_t o = (size_t)t * RW + lane * 8;
            *(u32x4*)(p.R + o) = pack8(rv); *(u32x4*)(p.KS + o) = pack8(kv); *(u32x4*)(p.V + o) = pack8(vv); *(u32x4*)(p.KK + o) = pack8(kk);
        }
        if (act2) {
            const int cc = lane * 8;
            if (cc < 128) {
#pragma unroll
                for (int e = 0; e < 8; ++e) lr[e] = tanhf_(lr[e]);
                *(u32x4*)(p.LR + (size_t)t * 256 + cc) = pack8(lr);
            } else if (cc < 256) {
                *(u32x4*)(p.LR + (size_t)t * 256 + cc) = pack8(lr);
            } else {
#pragma unroll
                for (int e = 0; e < 8; ++e) lr[e] = sigmoidf_(lr[e]);
                *(u32x4*)(p.GS + (size_t)t * 128 + cc - 256) = pack8(lr);
            }
        }
    }
}
__device__ __forceinline__ void phase_rwkv_prep2(const P& p, int l, char* smem) {
    const int ntm = MTOT / 128, ntn = NPAD(RW) / 128;
    const float* k_a = p.in[I_RKA] + (size_t)l * RW;
    const float* r_k = p.in[I_RRK] + (size_t)l * RW;
    for (int job = obid(); job < ntm * ntn * 2; job += gridDim.x) {
        const int d = job % 2, n0 = ((job / 2) % ntn) * 128, m0 = (job / (2 * ntn)) * 128;
        const float* w0 = p.in[I_RW0] + (size_t)(l * 2 + d) * RW;
        const float* a0 = p.in[I_RA0] + (size_t)(l * 2 + d) * RW;
        f32x4 accw[4][4], acca[4][4]; ZERO_ACC4(accw); ZERO_ACC4(acca);
        mfma_gemm_tile(p.WT_W2 + (size_t)d * NPAD(RW) * 64, 64, p.LR + d * 64, 256, 64, n0, m0, (bf16_t*)smem, accw);
        mfma_gemm_tile(p.WT_A2 + (size_t)d * NPAD(RW) * 64, 64, p.LR + 128 + d * 64, 256, 64, n0, m0, (bf16_t*)smem, acca);
        const int lane = otid() & 63, wave = otid() >> 6;
#pragma unroll
        for (int mi = 0; mi < 4; ++mi) {
            const int m = m0 + (wave & 1) * 64 + mi * 16 + (lane & 15);
            float bon = 0.f;
#pragma unroll
            for (int ni = 0; ni < 4; ++ni) {
                const int n = n0 + (wave >> 1) * 64 + ni * 16 + (lane >> 4) * 4;
                if (n < RW) {
                    const u32x2 kq = *(const u32x2*)(p.KS + (size_t)m * RW + n), kkq = *(const u32x2*)(p.KK + (size_t)m * RW + n), rq = *(const u32x2*)(p.R + (size_t)m * RW + n);
                    const float kv[4] = {LO16(kq.x), HI16(kq.x), LO16(kq.y), HI16(kq.y)};
                    const float kkv[4] = {LO16(kkq.x), HI16(kkq.x), LO16(kkq.y), HI16(kkq.y)};
                    const float rv[4] = {LO16(rq.x), HI16(rq.x), LO16(rq.y), HI16(rq.y)};
                    float lw[4], kd[4], bb[4];
#pragma unroll
                    for (int e = 0; e < 4; ++e) {
                        const float x = w0[n + e] + accw[ni][mi][e];
                        lw[e] = -fexp_(-softplusf_(-x) - 0.5f);
                        const float aa = sigmoidf_(a0[n + e] + acca[ni][mi][e]);
                        kd[e] = kv[e] * (1.0f + (aa - 1.0f) * k_a[n + e]);
                        bb[e] = kkv[e] * aa;
                        bon += rv[e] * kd[e] * r_k[n + e];
                    }
                    const size_t o = ((size_t)d * MTOT + m) * RW + n;
                    float4 lo4; lo4.x = lw[0]; lo4.y = lw[1]; lo4.z = lw[2]; lo4.w = lw[3];
                    *(float4*)(p.LW + o) = lo4;
                    *(u32x2*)(p.KD + o) = pack4(kd[0], kd[1], kd[2], kd[3]);
                    *(u32x2*)(p.BB + o) = pack4(bb[0], bb[1], bb[2], bb[3]);
                }
            }
            bon += __shfl_xor(bon, 16, 64); bon += __shfl_xor(bon, 32, 64);
            const int hh = (n0 + (wave >> 1) * 64) >> 6;
            if ((lane >> 4) == 0 && hh < RH) p.BONUS[((size_t)d * MTOT + m) * RH + hh] = bon;
        }
    }
}

#define CH_ROW 72
#define SEQ_REC 16640
#define CH_SLOT (64 * CH_ROW)
#define CH_XR_OFF (7 * CH_SLOT * 2)
#define CH_AAB_OFF (CH_XR_OFF + 64 * 132 * 4)
#define CH_GC_OFF (CH_AAB_OFF + 64 * 72 * 4)
template <int MT, int NT>
__device__ __forceinline__ void lds_mm(const bf16_t* A, int m0, const bf16_t* Bt, int n0, f32x4 (&acc)[MT][NT]) {
    const int lane = otid() & 63, q = lane >> 4, r = lane & 15;
#pragma unroll
    for (int s = 0; s < 2; ++s) {
        bf16x8 a[MT], b[NT];
#pragma unroll
        for (int i = 0; i < MT; ++i) a[i] = *(const bf16x8*)(A + (m0 + i * 16 + r) * CH_ROW + s * 32 + q * 8);
#pragma unroll
        for (int i = 0; i < NT; ++i) b[i] = *(const bf16x8*)(Bt + (n0 + i * 16 + r) * CH_ROW + s * 32 + q * 8);
#pragma unroll
        for (int i = 0; i < MT; ++i)
#pragma unroll
            for (int jj = 0; jj < NT; ++jj) acc[i][jj] = MFMA16(a[i], b[jj], acc[i][jj]);
    }
}
__device__ __forceinline__ void rwkv_chunk_job(const P& p, int job, char* smem) {
    const int tid = otid(), lane = tid & 63, wv = tid >> 6, q = lane >> 4, r = lane & 15;
    const int d = job / (NC * RH), n = (job / RH) % NC, h = job % RH;
    const size_t base = (size_t)(d * NC + n) * RH + h;
    bf16_t* S0 = (bf16_t*)smem; bf16_t* S1 = S0 + CH_SLOT; bf16_t* S2 = S1 + CH_SLOT; bf16_t* S3 = S2 + CH_SLOT;
    bf16_t* S4 = S3 + CH_SLOT; bf16_t* S5 = S4 + CH_SLOT; bf16_t* S6 = S5 + CH_SLOT;
    float* X = (float*)(smem + CH_XR_OFF);
    float* AABt = (float*)(smem + CH_AAB_OFF);
    bf16_t* U0t = (bf16_t*)(smem + CH_AAB_OFF);
    bf16_t* Aht = U0t + CH_SLOT;
    float* GC = (float*)(smem + CH_GC_OFF);
    __syncthreads();
    u32x4 gkk[2], gr[2], gv[2], gkd[2], gbb[2]; float lw[2][8];
#pragma unroll
    for (int it = 0; it < 2; ++it) {
        const int c = tid + 256 * it, i = c >> 3, k0 = (c & 7) * 8; const int tok = 64 * n + (d ? 63 - i : i);
        const size_t o1 = (size_t)tok * RW + h * 64 + k0, o2 = ((size_t)d * MTOT + tok) * RW + h * 64 + k0;
        load8f(p.LW + o2, lw[it]);
        gkk[it] = *(const u32x4*)(p.KK + o1); gr[it] = *(const u32x4*)(p.R + o1); gv[it] = *(const u32x4*)(p.V + o1);
        gkd[it] = *(const u32x4*)(p.KD + o2); gbb[it] = *(const u32x4*)(p.BB + o2);
    }
#pragma unroll
    for (int it = 0; it < 2; ++it) { const int c = tid + 256 * it; store8f(X + (c >> 3) * 132 + (c & 7) * 8, lw[it]); }
    __syncthreads();
    {
        const int k = tid & 63, seg = tid >> 6;
        float v[16]; float run = 0.f;
#pragma unroll
        for (int e = 0; e < 16; ++e) { run += X[(seg * 16 + e) * 132 + k]; v[e] = run; }
        AABt[seg * 64 + k] = run;
        __syncthreads();
        float off = 0.f;
        for (int s2 = 0; s2 < seg; ++s2) off += AABt[s2 * 64 + k];
#pragma unroll
        for (int e = 0; e < 16; ++e) X[(seg * 16 + e) * 132 + k] = v[e] + off;
    }
    __syncthreads();
#pragma unroll
    for (int it = 0; it < 2; ++it) {
        const int c = tid + 256 * it, i = c >> 3, k0 = (c & 7) * 8;
        float L[8], Lp[8], LC[8], kkv[8], rv[8], vv[8], kdv[8], bbv[8];
        load8f(X + i * 132 + k0, L); load8f(X + 63 * 132 + k0, LC);
        if (i > 0) load8f(X + (i - 1) * 132 + k0, Lp);
        else {
#pragma unroll
            for (int e = 0; e < 8; ++e) Lp[e] = 0.f;
        }
        unpack8(gkk[it], kkv); unpack8(gr[it], rv); unpack8(gv[it], vv); unpack8(gkd[it], kdv); unpack8(gbb[it], bbv);
        float at[8], rt[8], bt[8], kt[8], bh[8], kh[8];
#pragma unroll
        for (int e = 0; e < 8; ++e) {
            const float eL = fexp_(L[e]), eLp = fexp_(Lp[e]), eNL = fexp_(-L[e]), eCL = fexp_(LC[e] - L[e]);
            at[e] = -kkv[e] * eLp; rt[e] = rv[e] * eL; bt[e] = bbv[e] * eNL; kt[e] = kdv[e] * eNL; bh[e] = bbv[e] * eCL; kh[e] = kdv[e] * eCL;
            if (i == 63) GC[k0 + e] = eL;
        }
        *(u32x4*)(S0 + i * CH_ROW + k0) = pack8(at);
        store8f(X + i * 132 + 64 + k0, at);
        *(u32x4*)(S1 + i * CH_ROW + k0) = pack8(rt);
        *(u32x4*)(S2 + i * CH_ROW + k0) = pack8(bt);
        *(u32x4*)(S3 + i * CH_ROW + k0) = pack8(kt);
#pragma unroll
        for (int e = 0; e < 8; ++e) {
            S4[(k0 + e) * CH_ROW + i] = f2bf(vv[e]);
            S5[(k0 + e) * CH_ROW + i] = f2bf(bh[e]);
            S6[(k0 + e) * CH_ROW + i] = f2bf(kh[e]);
        }
    }
    __syncthreads();
    {
        f32x4 acc[4][4]; ZERO_ACC4(acc);
        lds_mm<4, 4>((wv < 2) ? S0 : S1, 0, (wv & 1) ? S3 : S2, 0, acc);
        __syncthreads();
#pragma unroll
        for (int mt = 0; mt < 4; ++mt)
#pragma unroll
            for (int nt = 0; nt < 4; ++nt) {
                const int jc = nt * 16 + r, i0 = mt * 16 + 4 * q;
                if (wv == 0) {
                    f32x4 o;
#pragma unroll
                    for (int e = 0; e < 4; ++e) o[e] = (jc < i0 + e) ? acc[mt][nt][e] : 0.f;
                    *(f32x4*)(AABt + jc * 72 + i0) = o;
                } else {
                    bf16_t* dst = (wv == 1) ? S0 : ((wv == 2) ? S2 : S3);
#pragma unroll
                    for (int e = 0; e < 4; ++e) {
                        const bool ok = (wv == 1) ? (jc < i0 + e) : (jc <= i0 + e);
                        dst[(i0 + e) * CH_ROW + jc] = f2bf(ok ? acc[mt][nt][e] : 0.f);
                    }
                }
            }
    }
    __syncthreads();
    {
        f32x4 acc[1][4];
#pragma unroll
        for (int nt = 0; nt < 4; ++nt) acc[0][nt] = (f32x4){0.f, 0.f, 0.f, 0.f};
        lds_mm<1, 4>(S0, 16 * wv, S4, 0, acc);
#pragma unroll
        for (int nt = 0; nt < 4; ++nt)
#pragma unroll
            for (int e = 0; e < 4; ++e) X[(16 * wv + 4 * q + e) * 132 + nt * 16 + r] = acc[0][nt][e];
    }
    __syncthreads();
    if (tid < 128) {
        const int c = tid;
        for (int bi = 0; bi < 4; ++bi) {
            float acc[16];
#pragma unroll
            for (int e = 0; e < 16; ++e) acc[e] = X[(16 * bi + e) * 132 + c];
            for (int jj = 0; jj < 16 * bi; ++jj) {
                const float uj = X[jj * 132 + c];
                const f32x4* ap = (const f32x4*)(AABt + jj * 72 + 16 * bi);
                const f32x4 a0 = ap[0], a1 = ap[1], a2 = ap[2], a3 = ap[3];
#pragma unroll
                for (int e = 0; e < 4; ++e) { acc[e] += a0[e] * uj; acc[4 + e] += a1[e] * uj; acc[8 + e] += a2[e] * uj; acc[12 + e] += a3[e] * uj; }
            }
#pragma unroll
            for (int e = 0; e < 16; ++e) {
                const float u = acc[e];
                X[(16 * bi + e) * 132 + c] = u;
                const f32x4* ap = (const f32x4*)(AABt + (16 * bi + e) * 72 + 16 * bi);
                const f32x4 a0 = ap[0], a1 = ap[1], a2 = ap[2], a3 = ap[3];
#pragma unroll
                for (int e2 = 0; e2 < 16; ++e2) if (e2 > e) acc[e2] += ((e2 < 4) ? a0[e2 & 3] : (e2 < 8) ? a1[e2 & 3] : (e2 < 12) ? a2[e2 & 3] : a3[e2 & 3]) * u;
            }
        }
    }
    __syncthreads();
    if (tid < 128) {
        const int c = tid;
        bf16_t* dst = (c < 64) ? (U0t + c * CH_ROW) : (Aht + (c - 64) * CH_ROW);
        u32x4 ov[8];
#pragma unroll
        for (int g = 0; g < 8; ++g) {
            float v[8];
#pragma unroll
            for (int e = 0; e < 8; ++e) v[e] = X[(g * 8 + e) * 132 + c];
            ov[g].x = pack2bf(v[0], v[1]); ov[g].y = pack2bf(v[2], v[3]);
            ov[g].z = pack2bf(v[4], v[5]); ov[g].w = pack2bf(v[6], v[7]);
        }
#pragma unroll
        for (int g = 0; g < 8; ++g) *(u32x4*)(dst + g * 8) = ov[g];
    }
    __syncthreads();
    {
        f32x4 acc[4][4]; ZERO_ACC4(acc);
        char* rec = p.REC + base * SEQ_REC;
        if (wv == 0) {
            lds_mm<4, 4>(Aht, 0, S5, 0, acc);
#pragma unroll
            for (int nt = 0; nt < 4; ++nt)
#pragma unroll
                for (int s2 = 0; s2 < 2; ++s2) {
                    u32x4 o;
                    o.x = pack2bf(acc[2 * s2][nt][0], acc[2 * s2][nt][1]); o.y = pack2bf(acc[2 * s2][nt][2], acc[2 * s2][nt][3]);
                    o.z = pack2bf(acc[2 * s2 + 1][nt][0], acc[2 * s2 + 1][nt][1]); o.w = pack2bf(acc[2 * s2 + 1][nt][2], acc[2 * s2 + 1][nt][3]);
                    *(u32x4*)(rec + (((nt * 2 + s2) * 64 + lane) * 8) * 2) = o;
                }
        } else if (wv == 1) {
            lds_mm<4, 4>(S5, 0, U0t, 0, acc);
            lds_mm<4, 4>(S6, 0, S4, 0, acc);
#pragma unroll
            for (int mt = 0; mt < 4; ++mt)
#pragma unroll
                for (int nt = 0; nt < 4; ++nt) *(u32x2*)(rec + 8192 + (((nt * 4 + mt) * 64 + lane) * 4) * 2) = pack4(acc[mt][nt][0], acc[mt][nt][1], acc[mt][nt][2], acc[mt][nt][3]);
        } else if (wv == 2) {
            lds_mm<4, 4>(S2, 0, Aht, 0, acc);
#pragma unroll
            for (int mt = 0; mt < 4; ++mt)
#pragma unroll
                for (int nt = 0; nt < 4; ++nt)
#pragma unroll
                    for (int e = 0; e < 4; ++e) {
                        const int t = mt * 16 + 4 * q + e, kc = nt * 16 + r;
                        p.QH[(base * 64 + t) * 64 + kc] = f2bf(acc[mt][nt][e] + bf2f(S1[t * CH_ROW + kc]));
                    }
        } else if (wv == 3) {
            lds_mm<4, 4>(S2, 0, U0t, 0, acc);
            lds_mm<4, 4>(S3, 0, S4, 0, acc);
#pragma unroll
            for (int mt = 0; mt < 4; ++mt)
#pragma unroll
                for (int nt = 0; nt < 4; ++nt) *(f32x4*)(p.Y0T + (((base * 4 + mt) * 4 + nt) * 64 + lane) * 4) = acc[mt][nt];
        }
        if (tid < 64) ((float*)(rec + 16384))[tid] = GC[tid];
    }
}

#define SEQ_SLOT 16896
__device__ __forceinline__ void rwkv_seq_gload(const P& p, size_t base, int tid, u32x4 (&g)[5]) {
    const u32x4* m = (const u32x4*)(p.REC + base * SEQ_REC);
#pragma unroll
    for (int i = 0; i < 4; ++i) g[i] = m[tid + 256 * i];
    if (tid < 16) g[4] = m[1024 + tid];
}
__device__ __forceinline__ void rwkv_seq_lstore(char* slot, int tid, const u32x4 (&g)[5]) {
    u32x4* d = (u32x4*)slot;
#pragma unroll
    for (int i = 0; i < 4; ++i) d[tid + 256 * i] = g[i];
    if (tid < 16) d[1024 + tid] = g[4];
}
__device__ __forceinline__ void rwkv_seq_step(const P& p, const char* slot, size_t base, int wv, int lane, f32x4 (&X)[4]) {
    const int q = lane >> 4, r = lane & 15;
    const bf16_t* mt = (const bf16_t*)slot; const bf16_t* ntb = (const bf16_t*)(slot + 8192); const float* gc = (const float*)(slot + 16384);
    unsigned xh[4][2];
#pragma unroll
    for (int kt = 0; kt < 4; ++kt) {
        xh[kt][0] = pack2bf(X[kt][0], X[kt][1]); xh[kt][1] = pack2bf(X[kt][2], X[kt][3]);
        *(u32x2*)(p.SN + (base * 64 + 16 * wv + r) * 64 + 16 * kt + 4 * q) = (u32x2){xh[kt][0], xh[kt][1]};
    }
    bf16x8 bh[2];
#pragma unroll
    for (int s2 = 0; s2 < 2; ++s2) bh[s2] = __builtin_bit_cast(bf16x8, ((u32x4){xh[2 * s2][0], xh[2 * s2][1], xh[2 * s2 + 1][0], xh[2 * s2 + 1][1]}));
#pragma unroll
    for (int tile = 0; tile < 4; ++tile) {
        const u32x2 nb = *(const u32x2*)(ntb + ((wv * 4 + tile) * 64 + lane) * 4);
        const f32x4 g4 = *(const f32x4*)(gc + tile * 16 + 4 * q);
        f32x4 acc;
        acc[0] = g4[0] * X[tile][0] + LO16(nb.x); acc[1] = g4[1] * X[tile][1] + HI16(nb.x);
        acc[2] = g4[2] * X[tile][2] + LO16(nb.y); acc[3] = g4[3] * X[tile][3] + HI16(nb.y);
#pragma unroll
        for (int s2 = 0; s2 < 2; ++s2) {
            const bf16x8 ah = *(const bf16x8*)(mt + ((tile * 2 + s2) * 64 + lane) * 8);
            acc = MFMA16(ah, bh[s2], acc);
        }
        X[tile] = acc;
    }
}
__device__ __forceinline__ void rwkv_seq_job(const P& p, int job, char* smem) {
    const int tid = otid(), lane = tid & 63, wv = tid >> 6;
    const int d = job / RH, h = job % RH;
    f32x4 X[4];
#pragma unroll
    for (int kt = 0; kt < 4; ++kt) X[kt] = (f32x4){0.f, 0.f, 0.f, 0.f};
    u32x4 g0[5], g1[5], g2[5];
#define SEQ_BASE(s_) ((size_t)(d * NC + chunk_order(d, ((s_) < NC) ? (s_) : NC - 1)) * RH + h)
    __syncthreads();
    rwkv_seq_gload(p, SEQ_BASE(0), tid, g0);
    rwkv_seq_gload(p, SEQ_BASE(1), tid, g1);
    rwkv_seq_gload(p, SEQ_BASE(2), tid, g2);
    rwkv_seq_lstore(smem, tid, g0);
    __syncthreads();
    for (int s = 0; s < NC; s += 6) {
#define SEQ_SUB(u, GFREE, GNEXT) \
        if (s + (u) < NC) { \
            rwkv_seq_gload(p, SEQ_BASE(s + (u) + 3), tid, GFREE); \
            rwkv_seq_step(p, smem + (((u) & 1) ? SEQ_SLOT : 0), SEQ_BASE(s + (u)), wv, lane, X); \
            rwkv_seq_lstore(smem + (((u) & 1) ? 0 : SEQ_SLOT), tid, GNEXT); \
        } \
        __syncthreads();
        SEQ_SUB(0, g0, g1)
        SEQ_SUB(1, g1, g2)
        SEQ_SUB(2, g2, g0)
        SEQ_SUB(3, g0, g1)
        SEQ_SUB(4, g1, g2)
        SEQ_SUB(5, g2, g0)
#undef SEQ_SUB
    }
#undef SEQ_BASE
}
struct RoBuf { bf16x8 a[2]; bf16x8 b[4][2]; f32x4 y0[4]; };
__device__ __forceinline__ void rwkv_out_load(const P& p, int job, int wv, int lane, RoBuf& o) {
    const int q = lane >> 4, r = lane & 15;
    const size_t base = (size_t)job;
#pragma unroll
    for (int s2 = 0; s2 < 2; ++s2) {
        o.a[s2] = *(const bf16x8*)(p.QH + (base * 64 + 16 * wv + r) * 64 + s2 * 32 + q * 8);
#pragma unroll
        for (int nt = 0; nt < 4; ++nt) o.b[nt][s2] = *(const bf16x8*)(p.SN + (base * 64 + nt * 16 + r) * 64 + s2 * 32 + q * 8);
    }
#pragma unroll
    for (int nt = 0; nt < 4; ++nt) o.y0[nt] = *(const f32x4*)(p.Y0T + (((base * 4 + wv) * 4 + nt) * 64 + lane) * 4);
}
__device__ __forceinline__ void rwkv_out_compute(const P& p, int job, int wv, int lane, const RoBuf& o) {
    const int q = lane >> 4, r = lane & 15;
    const int d = job / (NC * RH), n = (job / RH) % NC, h = job % RH;
#pragma unroll
    for (int nt = 0; nt < 4; ++nt) {
        f32x4 acc = o.y0[nt];
        acc = MFMA16(o.a[0], o.b[nt][0], acc);
        acc = MFMA16(o.a[1], o.b[nt][1], acc);
#pragma unroll
        for (int e = 0; e < 4; ++e) {
            const int t = 16 * wv + 4 * q + e; const int tok = 64 * n + (d ? 63 - t : t);
            p.Y[((size_t)d * MTOT + tok) * RW + h * 64 + nt * 16 + r] = acc[e];
        }
    }
}
__device__ __forceinline__ void phase_rwkv_out(const P& p) {
    const int tid = otid(), lane = tid & 63, wv = tid >> 6;
    if (wv >= 4) return;
    const int G = gridDim.x, total = 2 * NC * RH;
    int job = obid();
    if (job >= total) return;
    RoBuf b0, b1;
    rwkv_out_load(p, job, wv, lane, b0);
    for (; job < total; job += 2 * G) {
        if (job + G < total) rwkv_out_load(p, job + G, wv, lane, b1);
        rwkv_out_compute(p, job, wv, lane, b0);
        if (job + G < total) {
            if (job + 2 * G < total) rwkv_out_load(p, job + 2 * G, wv, lane, b0);
            rwkv_out_compute(p, job + G, wv, lane, b1);
        }
    }
}

#define GL_QR 0
#define GL_KR 9216
#define GL_VT 18432
#define GL_QI 36864
#define GL_KI 46080
#define GL_AT 55296
#define GL_CUM 64512
#define GL_ALR 81920
#define GL_WA 86016
__device__ __forceinline__ void gla_load_qkv(const P& p, int n, int h, char* smem) {
    const int tid = otid();
    bf16_t* Qr = (bf16_t*)(smem + GL_QR); bf16_t* Kr = (bf16_t*)(smem + GL_KR); bf16_t* Vt = (bf16_t*)(smem + GL_VT);
    for (int c = tid; c < 512; c += NTHREADS) {
        const int row = c >> 3, part = c & 7; const int t = gla_tok(n, row);
        const u32x4 qv = *(const u32x4*)(p.Z + (size_t)t * ZLD + ZQ + h * 64 + part * 8);
        const u32x4 kv = *(const u32x4*)(p.Z + (size_t)t * ZLD + ZK + h * 64 + part * 8);
        u32x4 qs;
        qs.x = pack2bf(LO16(qv.x) * 0.125f, HI16(qv.x) * 0.125f);
        qs.y = pack2bf(LO16(qv.y) * 0.125f, HI16(qv.y) * 0.125f);
        qs.z = pack2bf(LO16(qv.z) * 0.125f, HI16(qv.z) * 0.125f);
        qs.w = pack2bf(LO16(qv.w) * 0.125f, HI16(qv.w) * 0.125f);
        *(u32x4*)(Qr + row * CH_ROW + part * 8) = qs;
        *(u32x4*)(Kr + row * CH_ROW + part * 8) = kv;
    }
    for (int c = tid; c < 1024; c += NTHREADS) {
        const int row = c >> 4, part = c & 15; const int t = gla_tok(n, row);
        const u32x4 vv = *(const u32x4*)(p.Z + (size_t)t * ZLD + ZV + h * 128 + part * 8);
        bf16_t* dst = Vt + (part * 8) * CH_ROW + row;
        dst[0 * CH_ROW] = (bf16_t)(vv.x & 0xFFFF); dst[1 * CH_ROW] = (bf16_t)(vv.x >> 16);
        dst[2 * CH_ROW] = (bf16_t)(vv.y & 0xFFFF); dst[3 * CH_ROW] = (bf16_t)(vv.y >> 16);
        dst[4 * CH_ROW] = (bf16_t)(vv.z & 0xFFFF); dst[5 * CH_ROW] = (bf16_t)(vv.z >> 16);
        dst[6 * CH_ROW] = (bf16_t)(vv.w & 0xFFFF); dst[7 * CH_ROW] = (bf16_t)(vv.w >> 16);
    }
}
__device__ __forceinline__ void gla_cum(const P& p, int l, int n, int h, int d, char* smem) {
    const int tid = otid();
    float* CUM = (float*)(smem + GL_CUM); float* ALR = (float*)(smem + GL_ALR); float* WA = (float*)(smem + GL_WA);
    for (int c = tid; c < 256; c += NTHREADS) {
        const int row = c >> 2, part = c & 3; const int t = gla_tok(n, row);
        const u32x2 a = *(const u32x2*)(p.Z + (size_t)t * ZLD + (d ? ZAB : ZAF) + part * 4);
        float* dst = ALR + row * 16 + part * 4;
        dst[0] = LO16(a.x); dst[1] = HI16(a.x); dst[2] = LO16(a.y); dst[3] = HI16(a.y);
    }
    for (int c = tid; c < 16 * 64 + 64; c += NTHREADS) {
        if (c < 1024) WA[c] = p.in[I_GLA_WA2][((size_t)(l * 2 + d) * 16 + (c >> 6)) * GLA_K + h * 64 + (c & 63)];
        else WA[c] = p.in[I_GLA_BA][(size_t)(l * 2 + d) * GLA_K + h * 64 + (c - 1024)];
    }
    __syncthreads();
    for (int idx = tid; idx < 4096; idx += NTHREADS) {
        const int i = idx >> 6, k = idx & 63;
        float a = WA[1024 + k];
#pragma unroll
        for (int r = 0; r < 16; ++r) a += ALR[i * 16 + r] * WA[r * 64 + k];
        CUM[i * 68 + k] = (fminf(a, 0.f) - flog_(1.0f + fexp_(-fabsf(a)))) * (1.0f / 16.0f);
    }
    __syncthreads();
    {
        const int k = tid & 63, seg = (tid >> 6) & 3;
        float v[16]; float run = 0.f;
        if (tid < 256) {
#pragma unroll
            for (int e = 0; e < 16; ++e) { const int pos = seg * 16 + e; const int i = d ? 63 - pos : pos; run += CUM[i * 68 + k]; v[e] = run; }
            ALR[seg * 64 + k] = run;
        }
        __syncthreads();
        if (tid < 256) {
            float off = 0.f;
            for (int s2 = 0; s2 < seg; ++s2) off += ALR[s2 * 64 + k];
#pragma unroll
            for (int e = 0; e < 16; ++e) { const int pos = seg * 16 + e; const int i = d ? 63 - pos : pos; CUM[i * 68 + k] = v[e] + off; }
        }
    }
    __syncthreads();
}
__device__ __forceinline__ void phase_gla_kv(const P& p, int l, char* smem) {
    const int tid = otid(), lane = tid & 63, wv = tid >> 6, q = lane >> 4, r = lane & 15;
    bf16_t* Kr = (bf16_t*)(smem + GL_KR); bf16_t* Vt = (bf16_t*)(smem + GL_VT); bf16_t* KdT = (bf16_t*)(smem + GL_KI);
    float* CUM = (float*)(smem + GL_CUM);
    for (int job = obid(); job < NC * GH; job += gridDim.x) {
        const int n = job / GH, h = job % GH;
        __syncthreads();
        gla_load_qkv(p, n, h, smem);
        for (int d = 0; d < 2; ++d) {
            gla_cum(p, l, n, h, d, smem);
            const int li = d ? 0 : 63;
            for (int idx = tid; idx < 4096; idx += NTHREADS) {
                const int i = idx >> 6, k = idx & 63;
                KdT[k * CH_ROW + i] = f2bf(bf2f(Kr[i * CH_ROW + k]) * fexp_(CUM[li * 68 + k] - CUM[i * 68 + k]));
            }
            if (tid < 64) p.DEC[((size_t)(d * NC + n) * GH + h) * 64 + tid] = fexp_(CUM[li * 68 + tid]);
            __syncthreads();
            float* kvt = p.KV + ((size_t)(d * NC + n) * GH + h) * 8192;
            for (int mt = wv; mt < 4; mt += NTHREADS / 64) {
                f32x4 acc[1][8];
#pragma unroll
                for (int nt = 0; nt < 8; ++nt) acc[0][nt] = (f32x4){0.f, 0.f, 0.f, 0.f};
                lds_mm<1, 8>(KdT, 16 * mt, Vt, 0, acc);
#pragma unroll
                for (int nt = 0; nt < 8; ++nt) *(f32x4*)(kvt + (size_t)(nt * 16 + r) * 64 + 16 * mt + 4 * q) = acc[0][nt];
            }
            __syncthreads();
        }
    }
    __syncthreads();
}
__device__ __forceinline__ void gla_scan_job(const P& p, int job) {
    const int base = job * NTHREADS + otid();
    const int d = base / (GH * 8192), h = (base / 8192) % GH, e = base % 8192;
    const float* __restrict__ kvp = p.KV; const float* __restrict__ decp = p.DEC; bf16_t* __restrict__ sp = p.SP;
    float S = 0.f;
    for (int s = 0; s < NC; s += 4) {
        float kv[4], dc[4]; size_t oo[4];
#pragma unroll
        for (int u = 0; u < 4; ++u) {
            const int n = chunk_order(d, (s + u < NC) ? s + u : NC - 1);
            oo[u] = ((size_t)(d * NC + n) * GH + h);
            kv[u] = kvp[oo[u] * 8192 + e]; dc[u] = decp[oo[u] * 64 + (e & 63)];
        }
#pragma unroll
        for (int u = 0; u < 4; ++u) if (s + u < NC) { sp[oo[u] * 8192 + e] = f2bf(S); S = dc[u] * S + kv[u]; }
    }
}
__device__ __forceinline__ void phase_gla_out(const P& p, int l, char* smem) {
    const int tid = otid(), lane = tid & 63, wv = tid >> 6, q = lane >> 4, r = lane & 15;
    bf16_t* Qr = (bf16_t*)(smem + GL_QR); bf16_t* Kr = (bf16_t*)(smem + GL_KR); bf16_t* Vt = (bf16_t*)(smem + GL_VT);
    bf16_t* Qi = (bf16_t*)(smem + GL_QI); bf16_t* Ki = (bf16_t*)(smem + GL_KI); bf16_t* At = (bf16_t*)(smem + GL_AT);
    float* CUM = (float*)(smem + GL_CUM);
    for (int job = obid(); job < NC * GH; job += gridDim.x) {
        const int n = job / GH, h = job % GH;
        __syncthreads();
        gla_load_qkv(p, n, h, smem);
        f32x4 o[1][8];
#pragma unroll
        for (int nt = 0; nt < 8; ++nt) o[0][nt] = (f32x4){0.f, 0.f, 0.f, 0.f};
        for (int d = 0; d < 2; ++d) {
            gla_cum(p, l, n, h, d, smem);
            for (int idx = tid; idx < 4096; idx += NTHREADS) {
                const int i = idx >> 6, k = idx & 63; const float c = CUM[i * 68 + k];
                Qi[i * CH_ROW + k] = f2bf(bf2f(Qr[i * CH_ROW + k]) * fexp_(c));
                Ki[i * CH_ROW + k] = f2bf(bf2f(Kr[i * CH_ROW + k]) * fexp_(-c));
            }
            __syncthreads();
            if (wv < 4) {
                f32x4 a[1][4];
#pragma unroll
                for (int nt = 0; nt < 4; ++nt) a[0][nt] = (f32x4){0.f, 0.f, 0.f, 0.f};
                lds_mm<1, 4>(Qi, 16 * wv, Ki, 0, a);
#pragma unroll
                for (int nt = 0; nt < 4; ++nt)
#pragma unroll
                    for (int e = 0; e < 4; ++e) {
                        const int i = 16 * wv + 4 * q + e, j = nt * 16 + r;
                        const bool ok = d ? (j >= i) : (j <= i);
                        At[i * CH_ROW + j] = f2bf(ok ? a[0][nt][e] : 0.f);
                    }
                WAVE_SYNC();
                lds_mm<1, 8>(At, 16 * wv, Vt, 0, o);
                const bf16_t* sp = p.SP + ((size_t)(d * NC + n) * GH + h) * 8192;
#pragma unroll
                for (int s2 = 0; s2 < 2; ++s2) {
                    const bf16x8 af = *(const bf16x8*)(Qi + (16 * wv + r) * CH_ROW + s2 * 32 + q * 8);
#pragma unroll
                    for (int nt = 0; nt < 8; ++nt) {
                        const bf16x8 bfr = *(const bf16x8*)(sp + (size_t)(nt * 16 + r) * 64 + s2 * 32 + q * 8);
                        o[0][nt] = MFMA16(af, bfr, o[0][nt]);
                    }
                }
            }
            __syncthreads();
        }
        if (wv < 4) {
#pragma unroll
            for (int nt = 0; nt < 8; ++nt)
#pragma unroll
                for (int e = 0; e < 4; ++e) {
                    const int t = gla_tok(n, 16 * wv + 4 * q + e);
                    p.OGLA[(size_t)t * GLA_V + h * 128 + nt * 16 + r] = o[0][nt][e];
                }
        }
    }
    __syncthreads();
}

#define S5_XH_OFF (2 * 64 * 132 * 4)
#define S5_XL_OFF (S5_XH_OFF + 64 * 136 * 2)
#define S5_CT_OFF (S5_XL_OFF + 64 * 136 * 2)
__device__ __forceinline__ void phase_s5_pass(const P& p, int l, char* smem, bool with_out) {
    const int tid = otid(), lane = tid & 63, wv = tid >> 6, q = lane >> 4, r = lane & 15;
    float* BU = (float*)smem; bf16_t* XH = (bf16_t*)(smem + S5_XH_OFF); bf16_t* XL = (bf16_t*)(smem + S5_XL_OFF); bf16_t* CTp = (bf16_t*)(smem + S5_CT_OFF);
    const int dW = (wv >> 1) & 1, ntb = (wv & 1) * 4;
    const int dS = (tid >> 6) & 1, st = tid & 63;
    bf16x8 bhi[4], blo[4];
    float are = 0.f, aim = 0.f, dco = 0.f;
    int cur_g = -1;
    const bf16x8 zero8 = {0, 0, 0, 0, 0, 0, 0, 0};
    bf16x8 a_cur[4]; float2 car_cur = {0.f, 0.f};
#define S5_FETCH(JOB, A, CAR) { const int n_ = (JOB) / SG, g_ = (JOB) % SG; \
        if (wv < 4) { _Pragma("unroll") for (int mt = 0; mt < 4; ++mt) A[mt] = (q < 2) ? *(const bf16x8*)(p.Z + (size_t)(n_ * 64 + 16 * mt + r) * ZLD + ZS5 + g_ * 16 + 8 * q) : zero8; } \
        if (with_out && tid < 128) CAR = *(const float2*)(p.S5CAR + ((((size_t)dS * NC + n_) * SG + g_) * 64 + st) * 2); }
    if (obid() < NC * SG) S5_FETCH(obid(), a_cur, car_cur);
    for (int job = obid(); job < NC * SG; job += gridDim.x) {
        const int n = job / SG, g = job % SG;
        __syncthreads();
        if (g != cur_g) {
            cur_g = g;
            if (wv < 4) {
#pragma unroll
                for (int jn = 0; jn < 4; ++jn) {
                    const int kk = 16 * (ntb + jn) + r; const size_t ci = ((size_t)dW * SG + g) * 64 + (kk >> 1);
                    float f[8], lo[8];
#pragma unroll
                    for (int e = 0; e < 8; ++e) f[e] = (q < 2) ? p.S5BB[(ci * 16 + 8 * q + e) * 2 + (kk & 1)] : 0.f;
                    const u32x4 hv = pack8(f);
                    float hf[8]; unpack8(hv, hf);
#pragma unroll
                    for (int e = 0; e < 8; ++e) lo[e] = f[e] - hf[e];
                    bhi[jn] = __builtin_bit_cast(bf16x8, hv); blo[jn] = __builtin_bit_cast(bf16x8, pack8(lo));
                }
            }
            if (tid < 128) { const size_t ci = ((size_t)dS * SG + g) * 64 + st; are = p.S5A[ci * 2]; aim = p.S5A[ci * 2 + 1]; }
            if (with_out) {
                for (int idx = tid; idx < 16 * 128; idx += NTHREADS) {
                    const int c = idx >> 7, kk = idx & 127;
                    const float v = (kk & 1) ? -p.in[I_S5CIM][((size_t)l * SG + g) * 1024 + c * 64 + (kk >> 1)] : p.in[I_S5CRE][((size_t)l * SG + g) * 1024 + c * 64 + (kk >> 1)];
                    CTp[c * 136 + kk] = f2bf(v);
                }
                dco = p.in[I_S5D][(size_t)l * SW + g * 16 + r];
            }
        }
        float xr = car_cur.x, xi = car_cur.y;
        const size_t eo = (((size_t)dS * NC + n) * SG + g) * 64 + st;
        unsigned short uu[4] = {0, 0, 0, 0};
        if (with_out && wv < 4) {
#pragma unroll
            for (int e = 0; e < 4; ++e) uu[e] = p.Z[(size_t)(n * 64 + 16 * wv + 4 * q + e) * ZLD + ZS5 + g * 16 + r];
        }
        if (wv < 4) {
#pragma unroll
            for (int mt = 0; mt < 4; ++mt) {
                const bf16x8 a = a_cur[mt];
#pragma unroll
                for (int jn = 0; jn < 4; ++jn) {
                    f32x4 acc = {0.f, 0.f, 0.f, 0.f};
                    acc = MFMA16(a, bhi[jn], acc);
                    acc = MFMA16(a, blo[jn], acc);
#pragma unroll
                    for (int e = 0; e < 4; ++e) BU[(dW * 64 + 16 * mt + 4 * q + e) * 132 + 16 * (ntb + jn) + r] = acc[e];
                }
            }
        }
        if (job + (int)gridDim.x < NC * SG) S5_FETCH(job + (int)gridDim.x, a_cur, car_cur);
        __syncthreads();
        if (tid < 128) {
            float2* bp0 = (float2*)(BU + (dS * 64 + (dS ? 63 : 0)) * 132 + st * 2);
#define S5_SCAN(SGN) { _Pragma("unroll 1") for (int ib = 0; ib < 4; ++ib) { float2 bv[16]; \
                _Pragma("unroll") for (int u = 0; u < 16; ++u) bv[u] = bp0[(SGN) * (ib * 16 + u) * 66]; \
                _Pragma("unroll") for (int u = 0; u < 16; ++u) { \
                    const float nr = are * xr - aim * xi + bv[u].x, ni = are * xi + aim * xr + bv[u].y; xr = nr; xi = ni; \
                    if (with_out) { float2 o; o.x = xr; o.y = xi; bp0[(SGN) * (ib * 16 + u) * 66] = o; } } } }
            if (dS) S5_SCAN(-1) else S5_SCAN(1)
            if (!with_out) { float2 o; o.x = xr; o.y = xi; *(float2*)(p.S5END + eo * 2) = o; }
        }
        if (with_out) {
            __syncthreads();
            for (int cidx = tid; cidx < 64 * 16; cidx += NTHREADS) {
                const int i = cidx >> 4, k0 = (cidx & 15) * 8;
                float a[8], b[8], lo[8];
                load8f(BU + (0 * 64 + i) * 132 + k0, a); load8f(BU + (1 * 64 + i) * 132 + k0, b);
#pragma unroll
                for (int e = 0; e < 8; ++e) a[e] += b[e];
                const u32x4 hv = pack8(a);
                float hf[8]; unpack8(hv, hf);
#pragma unroll
                for (int e = 0; e < 8; ++e) lo[e] = a[e] - hf[e];
                *(u32x4*)(XH + i * 136 + k0) = hv; *(u32x4*)(XL + i * 136 + k0) = pack8(lo);
            }
            __syncthreads();
            if (wv < 4) {
                f32x4 acc = {0.f, 0.f, 0.f, 0.f};
#pragma unroll
                for (int ks = 0; ks < 4; ++ks) {
                    const bf16x8 ah = *(const bf16x8*)(XH + (16 * wv + r) * 136 + ks * 32 + q * 8), al = *(const bf16x8*)(XL + (16 * wv + r) * 136 + ks * 32 + q * 8);
                    const bf16x8 b = *(const bf16x8*)(CTp + r * 136 + ks * 32 + q * 8);
                    acc = MFMA16(ah, b, acc);
                    acc = MFMA16(al, b, acc);
                }
#pragma unroll
                for (int e = 0; e < 4; ++e) {
                    const int i = 16 * wv + 4 * q + e;
                    const float u = bf2f(uu[e]);
                    p.GY[(size_t)(n * 64 + i) * SW + g * 16 + r] = f2bf(geluf_(acc[e] + dco * u));
                }
            }
        }
    }
    __syncthreads();
}
__device__ __forceinline__ void s5_carry_job(const P& p, int job) {
    const int base = job * NTHREADS + otid();
    if (base >= 2 * SG * 64) return;
    const int d = base / (SG * 64), g = (base / 64) % SG, st = base % 64;
    const size_t ci = ((size_t)d * SG + g) * 64 + st;
    float ar = p.S5A[ci * 2], ai = p.S5A[ci * 2 + 1];
    for (int i = 0; i < 6; ++i) { const float nr = ar * ar - ai * ai, ni = 2.f * ar * ai; ar = nr; ai = ni; }
    const float2* __restrict__ endp = (const float2*)p.S5END; float2* __restrict__ carp = (float2*)p.S5CAR;
    float cr = 0.f, cim = 0.f;
    for (int s = 0; s < NC; s += 4) {
        float2 ev[4]; size_t eo[4];
#pragma unroll
        for (int u = 0; u < 4; ++u) {
            const int n = chunk_order(d, (s + u < NC) ? s + u : NC - 1);
            eo[u] = (((size_t)d * NC + n) * SG + g) * 64 + st;
            ev[u] = endp[eo[u]];
        }
#pragma unroll
        for (int u = 0; u < 4; ++u) if (s + u < NC) {
            float2 c; c.x = cr; c.y = cim; carp[eo[u]] = c;
            const float nr = ar * cr - ai * cim + ev[u].x, ni = ar * cim + ai * cr + ev[u].y;
            cr = nr; cim = ni;
        }
    }
}

__device__ __forceinline__ void phase_side_elem(const P& p, int l) {
    const int lane = otid() & 63;
    const int gw = (obid() * NTHREADS + otid()) >> 6, nw = (gridDim.x * NTHREADS) >> 6;
    const bool actg = lane * 8 < GLA_V, actr = lane * 8 < RW;
    float gng[8], lnw[8], lnb[8];
#pragma unroll
    for (int e = 0; e < 8; ++e) { gng[e] = 0.f; lnw[e] = 0.f; lnb[e] = 0.f; }
    if (actg) load8f(p.in[I_GLA_NG] + (size_t)l * 128 + ((lane * 8) & 127), gng);
    if (actr) { load8f(p.in[I_RLNW] + (size_t)l * RW + lane * 8, lnw); load8f(p.in[I_RLNB] + (size_t)l * RW + lane * 8, lnb); }
    for (int t = gw; t < MTOT; t += nw) {
        float og[8], zo[8], y0[8], y1[8], vv[8];
        const u32x4 z4 = {0u, 0u, 0u, 0u};
#pragma unroll
        for (int e = 0; e < 8; ++e) { og[e] = 0.f; y0[e] = 0.f; y1[e] = 0.f; }
        if (actg) load8f(p.OGLA + (size_t)t * GLA_V + lane * 8, og);
        unpack8(actg ? *(const u32x4*)(p.Z + (size_t)t * ZLD + ZOG + lane * 8) : z4, zo);
        if (actr) { load8f(p.Y + (size_t)t * RW + lane * 8, y0); load8f(p.Y + ((size_t)MTOT + t) * RW + lane * 8, y1); }
        unpack8(actr ? *(const u32x4*)(p.V + (size_t)t * RW + lane * 8) : z4, vv);
        float g2v[8]; unpack8(actr ? *(const u32x4*)(p.G2B + (size_t)t * RW + lane * 8) : z4, g2v);
        const int hh = (lane * 8) >> 6;
        const float bon = actr ? (p.BONUS[(size_t)t * RH + hh] + p.BONUS[((size_t)MTOT + t) * RH + hh]) : 0.f;
        float ss = 0.f;
#pragma unroll
        for (int e = 0; e < 8; ++e) ss += og[e] * og[e];
        ss += __shfl_xor(ss, 1, 64); ss += __shfl_xor(ss, 2, 64); ss += __shfl_xor(ss, 4, 64); ss += __shfl_xor(ss, 8, 64);
        const float rstd = rsqrtf(ss * (1.0f / 128.f) + 1e-6f);
        float br[8];
#pragma unroll
        for (int e = 0; e < 8; ++e) br[e] = og[e] * rstd * gng[e] * siluf_(zo[e]);
        if (actg) *(u32x4*)(p.BR + (size_t)t * 3 * BW + lane * 8) = pack8(br);
        float y[8]; float sm = 0.f;
#pragma unroll
        for (int e = 0; e < 8; ++e) { y[e] = y0[e] + y1[e]; sm += y[e]; }
        sm += __shfl_xor(sm, 1, 64); sm += __shfl_xor(sm, 2, 64); sm += __shfl_xor(sm, 4, 64);
        const float mu = sm * (1.0f / 64.f);
        float sv = 0.f;
#pragma unroll
        for (int e = 0; e < 8; ++e) { y[e] -= mu; sv += y[e] * y[e]; }
        sv += __shfl_xor(sv, 1, 64); sv += __shfl_xor(sv, 2, 64); sv += __shfl_xor(sv, 4, 64);
        const float rs = rsqrtf(sv * (1.0f / 64.f) + 64e-5f);
        float yn[8];
#pragma unroll
        for (int e = 0; e < 8; ++e) yn[e] = y[e] * rs * lnw[e] + lnb[e] + bon * vv[e];
#pragma unroll
        for (int e = 0; e < 8; ++e) yn[e] *= g2v[e];
        if (actr) *(u32x4*)(p.BR + (size_t)t * 3 * BW + BW + lane * 8) = pack8(yn);
    }
}

__device__ __forceinline__ void g2_gemm_job(const P& p, int job, char* smem) {
    const int ntn = NPAD(RW) / 128;
    gemm_tile_run<4, 8>(p.WT_G2, 128, (size_t)NPAD(RW) * 128 * 2, p.GS, 128, (size_t)MTOT * 128 * 2, 128, (job % ntn) * 128, (job / ntn) * 256, (bf16_t*)smem, NoPre(),
        [&](int, int, int m, int n, const f32x4 v) { if (n < RW) *(u32x2*)(p.G2B + (size_t)m * RW + n) = pack4(v[0], v[1], v[2], v[3]); });
}
#define G2_JOBS ((MTOT / 256) * (NPAD(RW) / 128))
__device__ __forceinline__ void phase_glu_gemm(const P& p, int l, char* smem) {
    gemm_phase<4>(p.WT_GLU, SW, (size_t)NPAD(2 * SW) * SW * 2, p.GY, SW, (size_t)MTOT * SW * 2, SW, 2 * SW, (bf16_t*)smem, NoPre(), NoPre(),
        [&](int, int, int m, int n, const f32x4 v) {
            *(unsigned*)(p.BR + (size_t)m * 3 * BW + 2 * BW + (n >> 1)) = pack2bf(v[0] * sigmoidf_(v[1]), v[2] * sigmoidf_(v[3]));
        });
}
__device__ __forceinline__ void phase_merge(const P& p, int l, char* smem) {
    const int ntn = D_MODEL / 128, ntm = (MTOT - 256) / 128;
    auto run = [&](auto mi_tag, int n0, int m0) {
        constexpr int MI = decltype(mi_tag)::value;
        f32x4 macc[4][MI];
#pragma unroll
        for (int i = 0; i < 4; ++i)
#pragma unroll
            for (int j = 0; j < MI; ++j) macc[i][j] = (f32x4){0.f, 0.f, 0.f, 0.f};
        const int lane = otid() & 63, wave = otid() >> 6;
        for (int b = 0; b < 3; ++b) {
            f32x4 acc[4][MI];
#pragma unroll
            for (int i = 0; i < 4; ++i)
#pragma unroll
                for (int j = 0; j < MI; ++j) acc[i][j] = (f32x4){0.f, 0.f, 0.f, 0.f};
            mfma_gemm_tile_t<4, MI>(p.WT_BR + (size_t)b * D_MODEL * BW, BW, (size_t)D_MODEL * BW * 2, p.BR + b * BW, 3 * BW, (size_t)MTOT * 3 * BW * 2 - b * BW * 2, BW, n0, m0, (bf16_t*)smem, acc);
#pragma unroll
            for (int ni = 0; ni < 4; ++ni)
#pragma unroll
                for (int mi = 0; mi < MI; ++mi) {
                    const int n = n0 + (wave >> 1) * 64 + ni * 16 + (lane >> 4) * 4, m = m0 + (wave & 1) * 16 * MI + mi * 16 + (lane & 15);
                    const u32x2 g = *(const u32x2*)(p.ZGT + ((((size_t)(m >> 4) * (3 * D_MODEL / 16) + ((b * D_MODEL + n) >> 4)) * 64 + lane) * 4));
                    macc[ni][mi][0] += LO16(g.x) * acc[ni][mi][0]; macc[ni][mi][1] += HI16(g.x) * acc[ni][mi][1];
                    macc[ni][mi][2] += LO16(g.y) * acc[ni][mi][2]; macc[ni][mi][3] += HI16(g.y) * acc[ni][mi][3];
                }
        }
#pragma unroll
        for (int ni = 0; ni < 4; ++ni)
#pragma unroll
            for (int mi = 0; mi < MI; ++mi) {
                const int n = n0 + (wave >> 1) * 64 + ni * 16 + (lane >> 4) * 4, m = m0 + (wave & 1) * 16 * MI + mi * 16 + (lane & 15);
                *(u32x2*)(p.M + (size_t)m * D_MODEL + n) = pack4(macc[ni][mi][0], macc[ni][mi][1], macc[ni][mi][2], macc[ni][mi][3]);
            }
    };
    for (int it = 0;; ++it) {
        int mt_, nt_; if (!tile_map(it, ntm, ntn, (ntn >= 8) ? 4 : 8, mt_, nt_)) break;
        run(std::integral_constant<int, 4>(), nt_ * 128, mt_ * 128);
    }
    for (int job = obid(); job < 4 * ntn; job += gridDim.x) run(std::integral_constant<int, 2>(), (job >> 2) * 128, MTOT - 256 + (job & 3) * 64);
}

__device__ __forceinline__ void phase_outproj(const P& p, int l, char* smem) {
    gemm_phase<4>(p.WT_OUT, D_MODEL, (size_t)D_MODEL * D_MODEL * 2, p.M, D_MODEL, (size_t)MTOT * D_MODEL * 2, D_MODEL, D_MODEL, (bf16_t*)smem, NoPre(), NoPre(),
        [&](int, int, int m, int n, const f32x4 v) {
            const float* g1 = p.MOD + (size_t)(l * 2 + (m >= CTX ? 1 : 0)) * 6 * D_MODEL + 2 * D_MODEL + n;
            float4* xp = (float4*)(p.X + (size_t)m * D_MODEL + n); float4 x = *xp;
            x.x += g1[0] * v[0]; x.y += g1[1] * v[1]; x.z += g1[2] * v[2]; x.w += g1[3] * v[3]; *xp = x;
        });
}

__device__ __forceinline__ void store_q_hilo(const P& p, int m, int n, const f32x4 v) {
    const bf16_t h0 = f2bf(v[0]), h1 = f2bf(v[1]), h2 = f2bf(v[2]), h3 = f2bf(v[3]);
    u32x2 hv; hv.x = (unsigned)h0 | ((unsigned)h1 << 16); hv.y = (unsigned)h2 | ((unsigned)h3 << 16);
    *(u32x2*)(p.QHI + (size_t)m * PQ + n) = hv;
    *(u32x2*)(p.QLO + (size_t)m * PQ + n) = pack4(v[0] - bf2f(h0), v[1] - bf2f(h1), v[2] - bf2f(h2), v[3] - bf2f(h3));
}
__device__ __forceinline__ void phase_peer_q(const P& p, int l, char* smem) {
    gemm_phase<4>(p.WT_Q, D_MODEL, (size_t)PQ * D_MODEL * 2, p.H, D_MODEL, (size_t)MTOT * D_MODEL * 2, D_MODEL, PQ, (bf16_t*)smem, NoPre(), NoPre(),
        [&](int, int, int m, int n, const f32x4 v) { store_q_hilo(p, m, n, v); });
}

#define TK_ROW 129
__device__ __forceinline__ unsigned tk_key(float f, unsigned lowmask, unsigned low) {
    unsigned u = __builtin_bit_cast(unsigned, f);
    u ^= (u & 0x80000000u) ? 0xFFFFFFFFu : 0x80000000u;
    return (u & ~lowmask) | low;
}
#define TK_INSERT(lv, xk) { unsigned x_ = (xk); _Pragma("unroll") for (int z_ = 0; z_ < 16; ++z_) { const unsigned hi_ = lv[z_] > x_ ? lv[z_] : x_; x_ = lv[z_] > x_ ? x_ : lv[z_]; lv[z_] = hi_; } }
__device__ __forceinline__ void phase_peer_topk(const P& p, int l, char* smem) {
    const int tid = otid(), lane = tid & 63, wv = tid >> 6, q = lane >> 4, r = lane & 15;
    float* sc = (float*)smem + wv * (64 * TK_ROW);
    const int gw = (obid() * NTHREADS + tid) >> 6, nw = (gridDim.x * NTHREADS) >> 6;
    const float NEG = -3.0e38f;
    for (int job = gw; job < (MTOT / 32) * PH; job += nw) {
        const int t0 = (job / PH) * 32, h = job % PH;
#pragma unroll
        for (int sd = 0; sd < 2; ++sd) {
            f32x4 acc[2][8];
#pragma unroll
            for (int mt = 0; mt < 2; ++mt)
#pragma unroll
                for (int nt = 0; nt < 8; ++nt) acc[mt][nt] = (f32x4){0.f, 0.f, 0.f, 0.f};
#pragma unroll
            for (int ks = 0; ks < 4; ++ks) {
                bf16x8 ah[2], al[2];
#pragma unroll
                for (int mt = 0; mt < 2; ++mt) {
                    const size_t qo = (size_t)(t0 + mt * 16 + r) * PQ + h * 256 + sd * 128 + ks * 32 + q * 8;
                    ah[mt] = *(const bf16x8*)(p.QHI + qo); al[mt] = *(const bf16x8*)(p.QLO + qo);
                }
#pragma unroll
                for (int nt = 0; nt < 8; ++nt) {
                    const size_t ko = ((size_t)(h * 2 + sd) * 128 + nt * 16 + r) * 128 + ks * 32 + q * 8;
                    const bf16x8 bh = *(const bf16x8*)(p.KHI + ko), bl = *(const bf16x8*)(p.KLO + ko);
#pragma unroll
                    for (int mt = 0; mt < 2; ++mt) {
                        acc[mt][nt] = MFMA16(ah[mt], bh, acc[mt][nt]);
                        acc[mt][nt] = MFMA16(al[mt], bh, acc[mt][nt]);
                        acc[mt][nt] = MFMA16(ah[mt], bl, acc[mt][nt]);
                    }
                }
            }
#pragma unroll
            for (int mt = 0; mt < 2; ++mt)
#pragma unroll
                for (int nt = 0; nt < 8; ++nt)
#pragma unroll
                    for (int e = 0; e < 4; ++e) sc[(sd * 32 + mt * 16 + 4 * q + e) * TK_ROW + nt * 16 + r] = acc[mt][nt][e];
        }
        WAVE_SYNC();
        unsigned lv[16];
#pragma unroll
        for (int z = 0; z < 16; ++z) lv[z] = 0u;
        {
            const float* row = sc + lane * TK_ROW;
#pragma unroll 4
            for (int k = 0; k < 128; ++k) TK_INSERT(lv, tk_key(row[k], 0x7Fu, (unsigned)(127 - k)));
        }
        float lvv[16]; int li[16];
        {
            const float* row = sc + lane * TK_ROW;
#pragma unroll
            for (int z = 0; z < 16; ++z) { li[z] = 127 - (int)(lv[z] & 0x7Fu); lvv[z] = row[li[z]]; }
        }
        WAVE_SYNC();
        {
            float* row = sc + lane * TK_ROW;
#pragma unroll
            for (int z = 0; z < 16; ++z) { row[z] = lvv[z]; ((int*)row)[16 + z] = li[z]; }
        }
        WAVE_SYNC();
        const float* r1 = sc + (lane & 31) * TK_ROW; const float* r2 = sc + (32 + (lane & 31)) * TK_ROW;
        unsigned tk[16];
#pragma unroll
        for (int z = 0; z < 16; ++z) tk[z] = 0u;
        for (int i = 0; i < 16; ++i) {
            const float a = r1[i];
            const int nj = 16 / (i + 1);
            for (int j = 0; j < nj; ++j) TK_INSERT(tk, tk_key(a + r2[j], 0xFFu, (unsigned)(255 - (i * 16 + j))));
        }
        int tc[16];
#pragma unroll
        for (int z = 0; z < 16; ++z) tc[z] = 255 - (int)(tk[z] & 0xFFu);
        if (lane < 32) {
            float vals[16]; float mx = 0.f; float ssum = 0.f;
#pragma unroll
            for (int z = 0; z < 16; ++z) { vals[z] = r1[tc[z] >> 4] + r2[tc[z] & 15]; if (z == 0) mx = vals[0]; vals[z] = fexp_(vals[z] - mx); ssum += vals[z]; }
            const float inv = 1.0f / ssum;
            const size_t o = (size_t)(t0 + lane) * PH * 16 + h * 16;
#pragma unroll
            for (int z = 0; z < 16; ++z) {
                const int ex_ = ((const int*)r1)[16 + (tc[z] >> 4)] * 128 + ((const int*)r2)[16 + (tc[z] & 15)];
                p.IDX[o + z] = ex_;
                p.G[o + z] = vals[z] * inv * p.VSC[ex_];
                p.GU[o + z] = p.USC[ex_];
            }
        }
        WAVE_SYNC();
    }
}

#define PEER_CONV_JOBS (2 * NEXP / 4)
__device__ __forceinline__ void peer_conv_job(const P& p, int l, int job) {
    const int tid = otid(), lane = tid & 63, wv = tid >> 6;
    if (wv >= 4) return;
    const int rowg = job * 4 + wv; const int which = rowg / NEXP, row = rowg % NEXP;
    const float* src = p.in[which ? I_PV : I_PU] + ((size_t)l * NEXP + row) * D_MODEL + lane * 16;
    const bool act = lane * 16 < D_MODEL;
    float v[16]; float amax = 0.f;
#pragma unroll
    for (int c = 0; c < 4; ++c) {
        float4 a; a.x = 0.f; a.y = 0.f; a.z = 0.f; a.w = 0.f;
        if (act) a = *(const float4*)(src + c * 4);
        v[c * 4 + 0] = a.x; v[c * 4 + 1] = a.y; v[c * 4 + 2] = a.z; v[c * 4 + 3] = a.w;
        amax = fmaxf(amax, fmaxf(fmaxf(fabsf(a.x), fabsf(a.y)), fmaxf(fabsf(a.z), fabsf(a.w))));
    }
#pragma unroll
    for (int m = 32; m >= 1; m >>= 1) amax = fmaxf(amax, __shfl_xor(amax, m, 64));
    int ex = 0;
    if (amax > 0.f) ex = 7 - (int)((__builtin_bit_cast(unsigned, amax) >> 23) & 0xFF) + 127;
    ex = ex < -100 ? -100 : (ex > 100 ? 100 : ex);
    const float sc = __builtin_bit_cast(float, (unsigned)(ex + 127) << 23), isc = __builtin_bit_cast(float, (unsigned)(127 - ex) << 23);
    u32x4 o;
    int w0 = 0, w1 = 0, w2 = 0, w3 = 0;
    w0 = CVT_PK_FP8(v[0] * sc, v[1] * sc, w0, false); w0 = CVT_PK_FP8(v[2] * sc, v[3] * sc, w0, true);
    w1 = CVT_PK_FP8(v[4] * sc, v[5] * sc, w1, false); w1 = CVT_PK_FP8(v[6] * sc, v[7] * sc, w1, true);
    w2 = CVT_PK_FP8(v[8] * sc, v[9] * sc, w2, false); w2 = CVT_PK_FP8(v[10] * sc, v[11] * sc, w2, true);
    w3 = CVT_PK_FP8(v[12] * sc, v[13] * sc, w3, false); w3 = CVT_PK_FP8(v[14] * sc, v[15] * sc, w3, true);
    o.x = (unsigned)w0; o.y = (unsigned)w1; o.z = (unsigned)w2; o.w = (unsigned)w3;
    unsigned char* dst = (which ? p.V8 : p.U8) + (size_t)row * D_MODEL + lane * 16;
    if (act) *(u32x4*)dst = o;
    if (lane == 0) (which ? p.VSC : p.USC)[row] = isc;
}
#define GE 4
struct GBuf { u32x4 u[GE]; u32x4 v[GE]; float gu; float gv; };
__device__ __forceinline__ void gather_load(const P& p, GBuf& b, int g, int idx0, int idx1, float g0, float g1, float u0, float u1, int lane) {
    const bool act = lane * 16 < D_MODEL;
#pragma unroll
    for (int q = 0; q < GE; ++q) {
        const int k = g * GE + q;
        const int ei = __shfl((k < 64) ? idx0 : idx1, k & 63, 64);
        b.u[q] = act ? *(const u32x4*)(p.U8 + (size_t)ei * D_MODEL + lane * 16) : (u32x4){0u, 0u, 0u, 0u};
        b.v[q] = act ? *(const u32x4*)(p.V8 + (size_t)ei * D_MODEL + lane * 16) : (u32x4){0u, 0u, 0u, 0u};
    }
    const int km = g * GE + ((lane >> 4) & 3);
    b.gv = __shfl((km < 64) ? g0 : g1, km & 63, 64);
    b.gu = __shfl((km < 64) ? u0 : u1, km & 63, 64);
}
__device__ __forceinline__ void gather_compute(const GBuf& b, const float (&hv)[16], float (&acc)[16], int lane) {
    float dt[GE];
#pragma unroll
    for (int q = 0; q < GE; ++q) {
        float d = 0.f;
#pragma unroll
        for (int c = 0; c < 4; ++c) {
            const f32x2 lo = CVT_PK_F32_FP8((int)b.u[q][c], false), hi = CVT_PK_F32_FP8((int)b.u[q][c], true);
            d += hv[c * 4 + 0] * lo.x + hv[c * 4 + 1] * lo.y + hv[c * 4 + 2] * hi.x + hv[c * 4 + 3] * hi.y;
        }
        dt[q] = d;
    }
    float r2[2], r1;
    {
        const bool up = (lane & 32) != 0;
#pragma unroll
        for (int q = 0; q < 2; ++q) { const float keep = up ? dt[2 + q] : dt[q], send = up ? dt[q] : dt[2 + q]; r2[q] = keep + __shfl_xor(send, 32, 64); }
    }
    {
        const bool up = (lane & 16) != 0;
        const float keep = up ? r2[1] : r2[0], send = up ? r2[0] : r2[1];
        r1 = keep + __shfl_xor(send, 16, 64);
    }
    r1 += __shfl_xor(r1, 8, 64); r1 += __shfl_xor(r1, 4, 64); r1 += __shfl_xor(r1, 2, 64); r1 += __shfl_xor(r1, 1, 64);
    const float coef_mine = b.gv * geluf_(r1 * b.gu);
#pragma unroll
    for (int q = 0; q < GE; ++q) {
        const float coef = __shfl(coef_mine, q * 16, 64);
#pragma unroll
        for (int c = 0; c < 4; ++c) {
            const f32x2 lo = CVT_PK_F32_FP8((int)b.v[q][c], false), hi = CVT_PK_F32_FP8((int)b.v[q][c], true);
            acc[c * 4 + 0] += coef * lo.x; acc[c * 4 + 1] += coef * lo.y; acc[c * 4 + 2] += coef * hi.x; acc[c * 4 + 3] += coef * hi.y;
        }
    }
}
__device__ __forceinline__ void phase_peer_gather(const P& p, int l) {
    const int lane = otid() & 63;
    const int gw = (obid() * NTHREADS + otid()) >> 6, nw = (gridDim.x * NTHREADS) >> 6;
    constexpr int NG = PH * 16 / GE;
    const bool act = lane * 16 < D_MODEL;
    for (int t = gw; t < MTOT; t += nw) {
        float hv[16], acc[16];
        {
            const u32x4 z4 = {0u, 0u, 0u, 0u};
            const u32x4 ha = act ? *(const u32x4*)(p.H + (size_t)t * D_MODEL + lane * 16) : z4;
            const u32x4 hb = act ? *(const u32x4*)(p.H + (size_t)t * D_MODEL + lane * 16 + 8) : z4;
            hv[0] = LO16(ha.x); hv[1] = HI16(ha.x); hv[2] = LO16(ha.y); hv[3] = HI16(ha.y); hv[4] = LO16(ha.z); hv[5] = HI16(ha.z); hv[6] = LO16(ha.w); hv[7] = HI16(ha.w);
            hv[8] = LO16(hb.x); hv[9] = HI16(hb.x); hv[10] = LO16(hb.y); hv[11] = HI16(hb.y); hv[12] = LO16(hb.z); hv[13] = HI16(hb.z); hv[14] = LO16(hb.w); hv[15] = HI16(hb.w);
#pragma unroll
            for (int j = 0; j < 16; ++j) acc[j] = 0.f;
        }
        int idx0 = 0, idx1 = 0; float g0 = 0.f, g1 = 0.f, u0 = 0.f, u1 = 0.f;
        if (lane < PH * 16) { idx0 = p.IDX[(size_t)t * PH * 16 + lane]; g0 = p.G[(size_t)t * PH * 16 + lane]; u0 = p.GU[(size_t)t * PH * 16 + lane]; }
        if (64 + lane < PH * 16) { idx1 = p.IDX[(size_t)t * PH * 16 + 64 + lane]; g1 = p.G[(size_t)t * PH * 16 + 64 + lane]; u1 = p.GU[(size_t)t * PH * 16 + 64 + lane]; }
        GBuf b0, b1, b2;
        gather_load(p, b0, 0, idx0, idx1, g0, g1, u0, u1, lane);
        gather_load(p, b1, 1, idx0, idx1, g0, g1, u0, u1, lane);
        for (int g = 0; g < NG; g += 3) {
            if (g + 2 < NG) gather_load(p, b2, g + 2, idx0, idx1, g0, g1, u0, u1, lane);
            gather_compute(b0, hv, acc, lane);
            if (g + 1 < NG) {
                if (g + 3 < NG) gather_load(p, b0, g + 3, idx0, idx1, g0, g1, u0, u1, lane);
                gather_compute(b1, hv, acc, lane);
            }
            if (g + 2 < NG) {
                if (g + 4 < NG) gather_load(p, b1, g + 4, idx0, idx1, g0, g1, u0, u1, lane);
                gather_compute(b2, hv, acc, lane);
            }
        }
        float xn[16]; float ss = 0.f;
#pragma unroll
        for (int j = 0; j < 16; ++j) xn[j] = 0.f;
        if (act) {
            const float* g2 = p.MOD + (size_t)(l * 2 + (t >= CTX ? 1 : 0)) * 6 * D_MODEL + 5 * D_MODEL + lane * 16;
            float* xp = p.X + (size_t)t * D_MODEL + lane * 16;
#pragma unroll
            for (int c = 0; c < 4; ++c) {
                float4 x = *(float4*)(xp + c * 4);
                x.x += g2[c * 4 + 0] * acc[c * 4 + 0]; x.y += g2[c * 4 + 1] * acc[c * 4 + 1]; x.z += g2[c * 4 + 2] * acc[c * 4 + 2]; x.w += g2[c * 4 + 3] * acc[c * 4 + 3];
                if (l + 1 < DEPTH) *(float4*)(xp + c * 4) = x;
                xn[c * 4 + 0] = x.x; xn[c * 4 + 1] = x.y; xn[c * 4 + 2] = x.z; xn[c * 4 + 3] = x.w;
                ss += x.x * x.x + x.y * x.y + x.z * x.z + x.w * x.w;
            }
        }
        ss = wave_sum(ss);
        const float rstd = rsqrtf(ss / D_MODEL + 1e-6f);
        if (act) {
            if (l + 1 < DEPTH) {
                const float* gn = p.in[I_N1G] + (size_t)(l + 1) * D_MODEL + lane * 16;
                const float* mod = p.MOD + (size_t)((l + 1) * 2 + (t >= CTX ? 1 : 0)) * 6 * D_MODEL + lane * 16;
                float o[16];
#pragma unroll
                for (int j = 0; j < 16; ++j) o[j] = xn[j] * rstd * gn[j] * (1.0f + mod[D_MODEL + j]) + mod[j];
                u32x4 w0, w1;
                w0.x = pack2bf(o[0], o[1]); w0.y = pack2bf(o[2], o[3]); w0.z = pack2bf(o[4], o[5]); w0.w = pack2bf(o[6], o[7]);
                w1.x = pack2bf(o[8], o[9]); w1.y = pack2bf(o[10], o[11]); w1.z = pack2bf(o[12], o[13]); w1.w = pack2bf(o[14], o[15]);
                *(u32x4*)(p.H + (size_t)t * D_MODEL + lane * 16) = w0; *(u32x4*)(p.H + (size_t)t * D_MODEL + lane * 16 + 8) = w1;
            } else if (t >= CTX) {
                const float* fg = p.in[I_FG] + lane * 16;
                float* op = p.out + (size_t)(t - CTX) * D_MODEL + lane * 16;
#pragma unroll
                for (int c = 0; c < 4; ++c) {
                    float4 o; o.x = xn[c * 4 + 0] * rstd * fg[c * 4 + 0]; o.y = xn[c * 4 + 1] * rstd * fg[c * 4 + 1]; o.z = xn[c * 4 + 2] * rstd * fg[c * 4 + 2]; o.w = xn[c * 4 + 3] * rstd * fg[c * 4 + 3];
                    *(float4*)(op + c * 4) = o;
                }
            }
        }
    }
}
__device__ __forceinline__ void phase_final(const P& p) {
    const int lane = otid() & 63;
    const int gw = (obid() * NTHREADS + otid()) >> 6, nw = (gridDim.x * NTHREADS) >> 6;
    const float* g = p.in[I_FG];
    for (int t = gw; t < SEQ; t += nw) {
        const float* x = p.X + (size_t)(CTX + t) * D_MODEL;
        float v[D_MODEL / 64]; float ss = 0.f;
#pragma unroll
        for (int j = 0; j < D_MODEL / 64; ++j) { v[j] = x[lane + 64 * j]; ss += v[j] * v[j]; }
        ss = wave_sum(ss);
        float rstd = rsqrtf(ss / D_MODEL + 1e-6f);
#pragma unroll
        for (int j = 0; j < D_MODEL / 64; ++j) p.out[(size_t)t * D_MODEL + lane + 64 * j] = v[j] * rstd * g[lane + 64 * j];
    }
}

__global__ void __launch_bounds__(NTHREADS) fwd_megakernel(P p_arg) {
#ifdef EMU
    char* smem = emu_smem();
#else
    __shared__ __attribute__((aligned(16))) char smem_raw[SMEM_BYTES + 16];
    char* smem = smem_raw;
#endif
#ifndef EMU
    volatile LAS unsigned* xst = (volatile LAS unsigned*)(smem_raw + SMEM_BYTES);
    if (threadIdx.x == 0) { xst[0] = 0u; xst[1] = 0u; xst[2] = 0u; xst[3] = 0u; }
    __syncthreads();
    XcdBarrier xb = xcd_barrier_post(p_arg.bar, xst);
#endif
    { LOADP(); phase_init(p, smem); }
#ifndef EMU
#endif
    GRID_SYNC();
#ifndef EMU
    if (threadIdx.x == 0) {
        unsigned base_ = 0;
        for (unsigned j = 0; j < xb.x; ++j) base_ += xb_ld(&p_arg.bar[XB_XCNT(j)]);
        xst[2] = base_ + xst[3];
    }
    __syncthreads();
#endif
    PROBE_INIT();
    for (int l = 0; l < DEPTH; ++l) {
        if (l == 0) {
            { LOADP(); phase_norm(p, 0, 0); }
            { LOADP(); phase_s5const(p, 0); }
            { LOADP(); phase_convert_weights(p, 0, smem, obid(), (int)gridDim.x); }
            GRID_SYNC(); PROBE_AFTER(0);
        }
        { LOADP(); phase_gemm_in(p, l, smem); }
        GRID_SYNC(); PROBE_AFTER(1);
        { LOADP(); phase_rwkv_prep1(p, l); }
        GRID_SYNC(); PROBE_AFTER(14);
        { LOADP(); phase_rwkv_prep2(p, l, smem); }
        GRID_SYNC(); PROBE_AFTER(2);
        { LOADP(); for (int job = obid(); job < 2 * NC * RH; job += gridDim.x) rwkv_chunk_job(p, job, smem); }
        __syncthreads(); PROBE_AFTER(20);
        { LOADP(); phase_gla_kv(p, l, smem); }
        PROBE_AFTER(21);
        { LOADP(); phase_s5_pass(p, l, smem, false); }
        GRID_SYNC(); PROBE_AFTER(3);
        {
            LOADP();
            const int n_rw = 2 * RH, n_gla = 2 * GH * 8192 / NTHREADS, n_s5 = (2 * SG * 64 + NTHREADS - 1) / NTHREADS;
            const int G_ = (int)gridDim.x;
            if (G_ > 2 * n_rw) {
                if (obid() < n_rw) { rwkv_seq_job(p, obid(), smem); PROBE_AFTER(24); }
                else {
                    const int nb = G_ - n_rw, bid = obid() - n_rw;
                    for (int job = bid; job < n_gla + n_s5 + PEER_CONV_JOBS; job += nb) {
                        if (job < n_gla) gla_scan_job(p, job);
                        else if (job < n_gla + n_s5) s5_carry_job(p, job - n_gla);
                        else peer_conv_job(p, l, job - n_gla - n_s5);
                    }
                    { P pg = p; late_select(pg, l & 1); for (int job = bid; job < G2_JOBS; job += nb) g2_gemm_job(pg, job, smem); }
                    if (l + 1 < DEPTH) { late_select(p, (l + 1) & 1); phase_convert_weights(p, l + 1, smem, bid, nb); }
                }
            } else {
                for (int job = obid(); job < n_rw + n_gla + n_s5 + PEER_CONV_JOBS; job += G_) {
                    if (job < n_rw) rwkv_seq_job(p, job, smem);
                    else if (job < n_rw + n_gla) gla_scan_job(p, job - n_rw);
                    else if (job < n_rw + n_gla + n_s5) s5_carry_job(p, job - n_rw - n_gla);
                    else peer_conv_job(p, l, job - n_rw - n_gla - n_s5);
                }
                __syncthreads();
                { P pg = p; late_select(pg, l & 1); for (int job = obid(); job < G2_JOBS; job += G_) g2_gemm_job(pg, job, smem); }
                if (l + 1 < DEPTH) { late_select(p, (l + 1) & 1); phase_convert_weights(p, l + 1, smem, obid(), G_); }
            }
        }
        GRID_SYNC(); PROBE_AFTER(4);
        { LOADP(); phase_rwkv_out(p); }
        PROBE_AFTER(22);
        { LOADP(); phase_gla_out(p, l, smem); }
        PROBE_AFTER(23);
        { LOADP(); phase_s5_pass(p, l, smem, true); }
        GRID_SYNC(); PROBE_AFTER(5);
        { LOADP(); phase_side_elem(p, l); }
        if (l + 1 < DEPTH) { LOADP(); phase_s5const(p, l + 1); }
        { LOADP(); late_select(p, l & 1); phase_glu_gemm(p, l, smem); }
        GRID_SYNC(); PROBE_AFTER(7);
        { LOADP(); late_select(p, l & 1); phase_merge(p, l, smem); }
        GRID_SYNC(); PROBE_AFTER(8);
        { LOADP(); late_select(p, l & 1); phase_outproj(p, l, smem); }
        GRID_SYNC(); PROBE_AFTER(9);
        { LOADP(); phase_norm(p, l, 1); }
        GRID_SYNC(); PROBE_AFTER(10);
        { LOADP(); late_select(p, l & 1); phase_peer_q(p, l, smem); }
        GRID_SYNC(); PROBE_AFTER(11);
        { LOADP(); late_select(p, l & 1); phase_peer_topk(p, l, smem); }
        GRID_SYNC(); PROBE_AFTER(12);
        { LOADP(); phase_peer_gather(p, l); }
        if (l + 1 < DEPTH) { GRID_SYNC(); PROBE_AFTER(13); }
    }
}

static inline size_t align_up(size_t x) { return (x + 255) & ~(size_t)255; }

extern "C" void kernel_launch(void* const* d_in, const int* in_sizes, int n_in, void* d_out, int out_size, void* d_ws, size_t ws_size, hipStream_t stream) {
    P p;
    memset(&p, 0, sizeof(p));
    for (int i = 0; i < 39; ++i) p.in[i] = (const float*)d_in[i];
    p.out = (float*)d_out;
    char* w = (char*)d_ws; size_t off = 0;
    auto take = [&](size_t bytes) { void* r = w + off; off = align_up(off + bytes); return r; };
    p.bar = (unsigned*)take(16384);
    p.X = (float*)take((size_t)MTOT * D_MODEL * 4);
    p.H = (bf16_t*)take((size_t)MTOT * D_MODEL * 2);
    p.MOD = (float*)take((size_t)DEPTH * 2 * 6 * D_MODEL * 4);
    p.Z = (bf16_t*)take((size_t)MTOT * ZLD * 2);
    p.ZGT = (bf16_t*)take((size_t)MTOT * 3 * D_MODEL * 2);
    p.V = (bf16_t*)take((size_t)MTOT * RW * 2);
    {
        char* ra = (char*)take((size_t)MTOT * RW * 2 * 2 > (size_t)MTOT * GLA_V * 4 ? (size_t)MTOT * RW * 2 * 2 : (size_t)MTOT * GLA_V * 4);
        p.R = (bf16_t*)ra; p.KK = (bf16_t*)(ra + (size_t)MTOT * RW * 2);
        p.OGLA = (float*)ra;
    }
    {
        char* rb = (char*)take((size_t)2 * MTOT * RW * 2 > (size_t)3 * MTOT * PH * 16 * 4 ? (size_t)2 * MTOT * RW * 2 : (size_t)3 * MTOT * PH * 16 * 4);
        p.KD = (bf16_t*)rb;
        p.IDX = (int*)rb; p.G = (float*)(rb + (size_t)MTOT * PH * 16 * 4); p.GU = (float*)(rb + (size_t)2 * MTOT * PH * 16 * 4);
    }
    p.BB = (bf16_t*)take((size_t)2 * MTOT * RW * 2);
    p.G2B = p.BB;
    p.LW = (float*)take((size_t)2 * MTOT * RW * 4);
    p.SP = (bf16_t*)p.LW;
    static_assert((size_t)2 * NC * GH * 8192 * 2 <= (size_t)2 * MTOT * RW * 4, "SP alias");
    p.BONUS = (float*)take((size_t)2 * MTOT * RH * 4);
    p.KS = (bf16_t*)take((size_t)MTOT * RW * 2);
    p.LR = (bf16_t*)take((size_t)MTOT * 256 * 2);
    p.WT_W2 = (bf16_t*)take((size_t)2 * NPAD(RW) * 64 * 2);
    p.WT_A2 = (bf16_t*)take((size_t)2 * NPAD(RW) * 64 * 2);
    p.GS = (bf16_t*)take((size_t)MTOT * 128 * 2);
    p.Y = (float*)take((size_t)2 * MTOT * RW * 4);
    p.Y0T = (float*)take((size_t)2 * NC * RH * 4096 * 4);
    p.KV = (float*)take((size_t)2 * NC * GH * 8192 * 4);
    p.DEC = (float*)take((size_t)2 * NC * GH * 64 * 4);
    p.S5A = (float*)take((size_t)2 * SG * 64 * 2 * 4);
    p.S5BB = (float*)take((size_t)2 * SG * 64 * 16 * 2 * 4);
    p.S5END = (float*)take((size_t)2 * NC * SG * 64 * 2 * 4);
    p.S5CAR = (float*)take((size_t)2 * NC * SG * 64 * 2 * 4);
    {
        const size_t szc1 = (size_t)2 * NC * RH * SEQ_REC;
        const size_t szc2 = (size_t)MTOT * SW * 2 + (size_t)MTOT * RW * 4 + (size_t)MTOT * 3 * BW * 2 + (size_t)MTOT * D_MODEL * 2 + 1024;
        char* rc = (char*)take(szc1 > szc2 ? szc1 : szc2);
        p.REC = rc;
        char* c2 = rc;
        p.GY = (bf16_t*)c2; c2 += align_up((size_t)MTOT * SW * 2);
        p.YN = (float*)c2; c2 += align_up((size_t)MTOT * RW * 4);
        p.BR = (bf16_t*)c2; c2 += align_up((size_t)MTOT * 3 * BW * 2);
        p.M = (bf16_t*)c2;
    }
    p.SN = (bf16_t*)take((size_t)2 * NC * RH * 4096 * 2);
    p.QH = (bf16_t*)take((size_t)2 * NC * RH * 4096 * 2);
    p.WT_IN = (bf16_t*)take((size_t)NPAD192(D_IN) * D_MODEL * 2);
    {
        char* lb = (char*)take(2 * LATE_BYTES); size_t lo = 0;
        auto ltake = [&](size_t bytes) { void* r = lb + lo; lo = AL256(lo + bytes); return r; };
        p.WT_G2 = (bf16_t*)ltake((size_t)NPAD(RW) * 128 * 2);
        p.WT_GLU = (bf16_t*)ltake((size_t)NPAD(2 * SW) * SW * 2);
        p.WT_BR = (bf16_t*)ltake((size_t)3 * D_MODEL * BW * 2);
        p.WT_OUT = (bf16_t*)ltake((size_t)D_MODEL * D_MODEL * 2);
        p.WT_Q = (bf16_t*)ltake((size_t)PQ * D_MODEL * 2);
        p.KHI = (bf16_t*)ltake((size_t)PH * 2 * 128 * 128 * 2); p.KLO = (bf16_t*)ltake((size_t)PH * 2 * 128 * 128 * 2);
        if (lo != LATE_BYTES) fprintf(stderr, "late weights layout mismatch\n");
    }
    p.U8 = (unsigned char*)take((size_t)NEXP * D_MODEL);
    p.V8 = (unsigned char*)take((size_t)NEXP * D_MODEL);
    p.USC = (float*)take((size_t)NEXP * 4); p.VSC = (float*)take((size_t)NEXP * 4);
    p.QHI = p.Z; p.QLO = p.Z + (size_t)MTOT * PQ;
    static_assert((size_t)PQ * 4 <= (size_t)D_IN * 2 && ((size_t)MTOT * ZLD * 2) % 256 == 0, "Q alias");
    if (off > ws_size) { fprintf(stderr, "ws too small: need %zu have %zu\n", off, ws_size); return; }
#ifdef EMU
    fprintf(stderr, "ws used %zu MB\n", off >> 20);
    emu_launch([=] { fwd_megakernel(p); }, EMU_GRID, NTHREADS);
#else
    hipMemsetAsync(p.bar, 0, 16384, stream);
    static int grid_blocks = 0;
    if (!grid_blocks) {
        int dev = 0, cus = 0, per_cu = 0;
        hipGetDevice(&dev);
        hipDeviceGetAttribute(&cus, hipDeviceAttributeMultiprocessorCount, dev);
        hipOccupancyMaxActiveBlocksPerMultiprocessor(&per_cu, fwd_megakernel, NTHREADS, 0);
        if (per_cu > 1) per_cu = 1;
        grid_blocks = cus * per_cu;
    }
    void* args[] = {&p};
    hipError_t e = hipLaunchCooperativeKernel((void*)fwd_megakernel, dim3(grid_blocks), dim3(NTHREADS), args, 0, stream);
    if (e != hipSuccess) fprintf(stderr, "cooperative launch failed: %s (grid %d)\n", hipGetErrorString(e), grid_blocks);
#endif
}
```

```cpp
#include <hip/hip_runtime.h>
#ifndef EMU
#include <hip/hip_cooperative_groups.h>
namespace cg = cooperative_groups;
#endif
#include <cstdio>
#include <cstdint>
#include <cstring>
#include <type_traits>

#ifdef CFG_SMALL
#define D_MODEL 128
#define SEQ 640
#define DEPTH 2
#define GRID_W 10
#define CTX 128
#define GH 1
#define RH 2
#define SG 8
#define PH 2
#else
#define D_MODEL 1024
#define SEQ 16384
#define DEPTH 4
#define GRID_W 64
#define CTX 256
#define GH 4
#define RH 8
#define SG 32
#define PH 8
#endif
#define MTOT (CTX + SEQ)
#define ROWS (SEQ / GRID_W)
#define GLA_K (GH * 64)
#define GLA_V (GH * 128)
#define RW (RH * 64)
#define RWKV_IN (3 * RW + 4 * 64 + 128)
#define SW (SG * 16)
#define BW GLA_V
#define ZQ 0
#define ZK (GLA_K)
#define ZV (2 * GLA_K)
#define ZOG (ZV + GLA_V)
#define ZAF (ZOG + GLA_V)
#define ZAB (ZAF + 16)
#define ZR (ZAB + 16)
#define ZS5 (ZR + RWKV_IN)
#define ZG (ZS5 + SW)
#define D_IN (ZG + 3 * D_MODEL)
#define ZLD ZG
#define NC (MTOT / 64)
#define NCC (CTX / 64)
#define RB (ROWS / 64)
#define PQ (PH * 256)
#define NEXP 16384
#define NTHREADS 256
#define SMEM_BYTES 133120

typedef unsigned short bf16_t;
typedef short bf16x8 __attribute__((ext_vector_type(8)));
typedef float f32x4 __attribute__((ext_vector_type(4)));
typedef unsigned u32x4 __attribute__((ext_vector_type(4)));
typedef unsigned u32x2 __attribute__((ext_vector_type(2)));
#ifdef EMU
#define MFMA16(a, b, c) emu_mfma_16x16x32_bf16(a, b, c)
#else
#define MFMA16(a, b, c) __builtin_amdgcn_mfma_f32_16x16x32_bf16(a, b, c, 0, 0, 0)
#endif
typedef float f32x2 __attribute__((ext_vector_type(2)));
#ifdef EMU
#define CVT_PK_FP8(a, b, old, hi) emu_cvt_pk_fp8_f32(a, b, old, hi)
#define CVT_PK_F32_FP8(w, hi) emu_cvt_pk_f32_fp8(w, hi)
#else
#define CVT_PK_FP8(a, b, old, hi) __builtin_amdgcn_cvt_pk_fp8_f32(a, b, old, hi)
#define CVT_PK_F32_FP8(w, hi) __builtin_amdgcn_cvt_pk_f32_fp8(w, hi)
#endif
#ifdef EMU
#define MFMA16_ACC(a, b, c) c = emu_mfma_16x16x32_bf16(a, b, c)
#else
#define MFMA16_ACC(a, b, c) asm volatile("v_mfma_f32_16x16x32_bf16 %0, %1, %2, %0" : "+a"(c) : "v"(a), "v"(b))
#endif
#define NPAD(n) (((n) + 127) / 128 * 128)
#define NPAD192(n) (((n) + 383) / 384 * 384)

__device__ __forceinline__ float bf2f(bf16_t h) { return __builtin_bit_cast(float, ((unsigned)h) << 16); }
#ifdef EMU
__device__ __forceinline__ bf16_t f2bf(float f) { unsigned u = __builtin_bit_cast(unsigned, f); u += 0x7FFFu + ((u >> 16) & 1u); return (bf16_t)(u >> 16); }
__device__ __forceinline__ unsigned pack2bf(float a, float b) { return (unsigned)f2bf(a) | ((unsigned)f2bf(b) << 16); }
#else
typedef float f2v_t __attribute__((ext_vector_type(2))); typedef __bf16 b2v_t __attribute__((ext_vector_type(2)));
__device__ __forceinline__ bf16_t f2bf(float f) { return __builtin_bit_cast(unsigned short, (__bf16)f); }
__device__ __forceinline__ unsigned pack2bf(float a, float b) { f2v_t v = {a, b}; b2v_t r = __builtin_convertvector(v, b2v_t); return __builtin_bit_cast(unsigned, r); }
#endif
#ifdef EMU
#define fexp_(x) expf(x)
#define flog_(x) logf(x)
#else
#define fexp_(x) __expf(x)
#define flog_(x) __logf(x)
#endif
#define LO16(x) __builtin_bit_cast(float, (x) << 16)
#define HI16(x) __builtin_bit_cast(float, (x) & 0xFFFF0000u)
__device__ __forceinline__ float sigmoidf_(float x) { return 1.0f / (1.0f + fexp_(-x)); }
__device__ __forceinline__ float siluf_(float x) { return x * sigmoidf_(x); }
__device__ __forceinline__ float geluf_(float x) { const float y = 1.5957691216057308f * (x + 0.044715f * x * x * x); return x / (1.0f + fexp_(-y)); }
__device__ __forceinline__ float softplusf_(float x) { return fmaxf(x, 0.f) + flog_(1.0f + fexp_(-fabsf(x))); }
__device__ __forceinline__ float tanhf_(float x) { const float e = fexp_(-2.0f * fabsf(x)); const float t = (1.0f - e) / (1.0f + e); return x < 0.f ? -t : t; }
__device__ __forceinline__ float wave_sum(float v) {
#pragma unroll
    for (int m = 32; m >= 1; m >>= 1) v += __shfl_xor(v, m, 64);
    return v;
}

struct P {
    const float* in[39];
    float* out;
    float* X;
    bf16_t* H;
    bf16_t* Z;
    bf16_t* ZGT;
    float* MOD;
    bf16_t* R; bf16_t* V; bf16_t* KK; bf16_t* KD; bf16_t* BB;
    float* LW;
    char* REC;
    bf16_t* SN;
    bf16_t* QH;
    float* BONUS;
    bf16_t* KS;
    bf16_t* LR;
    bf16_t* WT_W2;
    bf16_t* WT_A2;
    bf16_t* GS;
    float* Y;
    bf16_t* G2B;
    float* Y0T;
    float* KV;
    bf16_t* SP;
    float* DEC;
    float* OGLA;
    float* S5A;
    float* S5BB;
    float* S5END;
    float* S5CAR;
    bf16_t* GY;
    float* YN;
    bf16_t* BR;
    bf16_t* M;
    bf16_t* QHI; bf16_t* QLO;
    bf16_t* KHI; bf16_t* KLO;
    int* IDX;
    float* G;
    float* GU;
    unsigned* bar;
    bf16_t* WT_IN;
    bf16_t* WT_G2;
    bf16_t* WT_GLU;
    bf16_t* WT_BR;
    bf16_t* WT_OUT;
    bf16_t* WT_Q;
    unsigned char* U8; unsigned char* V8;
    float* USC; float* VSC;
};

enum { I_X = 0, I_C, I_CTX, I_CCTX, I_WMOD, I_BMOD, I_N1G, I_N2G, I_WIN, I_GLA_WA2, I_GLA_BA, I_GLA_NG, I_RCONV, I_RW0, I_RW2, I_RA0, I_RA2, I_RG2,
       I_RKK, I_RKA, I_RRK, I_RLNW, I_RLNB, I_S5LRE, I_S5LIM, I_S5LS, I_S5BRE, I_S5BIM, I_S5CRE, I_S5CIM, I_S5D, I_S5GLU, I_WBR, I_WOUT, I_PWQ, I_PKEYS, I_PU, I_PV, I_FG };

#define AL256(x) (((size_t)(x) + 255) & ~(size_t)255)
#define LATE_BYTES (AL256((size_t)NPAD(RW) * 128 * 2) + AL256((size_t)NPAD(2 * SW) * SW * 2) + AL256((size_t)3 * D_MODEL * BW * 2) + AL256((size_t)D_MODEL * D_MODEL * 2) + \
                    AL256((size_t)PQ * D_MODEL * 2) + 2 * AL256((size_t)PH * 2 * 128 * 128 * 2))
__device__ __forceinline__ void late_select(P& p, int par) {
    const size_t o = (size_t)par * (LATE_BYTES / 2);
    p.WT_G2 += o; p.WT_GLU += o; p.WT_BR += o; p.WT_OUT += o; p.WT_Q += o; p.KHI += o; p.KLO += o;
}
#ifdef EMU
__device__ __forceinline__ int otid() { return threadIdx.x; }
__device__ __forceinline__ int obid() { return blockIdx.x; }
#else
__device__ __forceinline__ int otid() { int t = threadIdx.x; asm volatile("" : "+v"(t)); return t; }
__device__ __forceinline__ int obid() { int b = blockIdx.x; asm volatile("" : "+s"(b)); return b; }
#endif
#ifdef EMU
#define WAVE_SYNC() emu_wave_barrier()
#ifndef EMU_GRID
#define EMU_GRID 4
#endif
#else
#define WAVE_SYNC() __builtin_amdgcn_wave_barrier()
#endif
#ifndef EMU
#define XB_TMO      128
#define XB_XCNT(j)  (256  + 64 * (j))
#define XB_XSUB(j)  (1280 + 64 * (j))
#define XB_XGEN(j)  (2304 + 64 * (j))
#define XB_TOP      3328
#define XB_TOPGEN   3392
#define XCD_BAR_WORDS 3456
#define XB_SPIN_CAP (1u << 22)
#define LAS __attribute__((address_space(3)))
__device__ __forceinline__ unsigned xb_ld(unsigned* p)              { return __hip_atomic_load(p, __ATOMIC_RELAXED, __HIP_MEMORY_SCOPE_SYSTEM); }
__device__ __forceinline__ unsigned xb_add(unsigned* p, unsigned v) { return __hip_atomic_fetch_add(p, v, __ATOMIC_RELAXED, __HIP_MEMORY_SCOPE_SYSTEM); }
__device__ __forceinline__ unsigned xb_xcc_id() { return (unsigned)__builtin_amdgcn_s_getreg((3 << 11) | 20) & 0xFu; }
#define XB_SPIN(cond, bar) do { unsigned _sp = 0; while (cond) { __builtin_amdgcn_s_sleep(1); \
    if ((++_sp & 255u) == 0u) { if (xb_ld(&(bar)[XB_TMO])) break; if (_sp > XB_SPIN_CAP) { atomicAdd(&(bar)[XB_TMO], 1u); break; } } } } while (0)
struct XcdBarrier { unsigned* bar; unsigned x; volatile LAS unsigned* st; };
__device__ __forceinline__ XcdBarrier xcd_barrier_post(unsigned* bar, volatile LAS unsigned* st) {
    XcdBarrier b; b.bar = bar; b.x = xb_xcc_id(); b.st = st;
    if (threadIdx.x == 0) st[3] = xb_add(&bar[XB_XCNT(b.x)], 1u);
    return b;
}
__device__ __forceinline__ void xcd_barrier_complete(unsigned* bar, unsigned x, unsigned& nloc, unsigned& nx) {
    const unsigned G = gridDim.x * gridDim.y * gridDim.z;
    unsigned sum, cnt, mine, sp = 0u;
    for (;;) {
        sum = 0u; cnt = 0u; mine = 0u;
#pragma unroll
        for (unsigned j = 0; j < 16; ++j) { const unsigned c = xb_ld(&bar[XB_XCNT(j)]); sum += c; cnt += (c > 0u) ? 1u : 0u; mine = (j == x) ? c : mine; }
        if (sum == G) break;
        __builtin_amdgcn_s_sleep(1);
        if ((++sp & 255u) == 0u) { if (xb_ld(&bar[XB_TMO])) break; if (sp > XB_SPIN_CAP) { atomicAdd(&bar[XB_TMO], 1u); break; } }
    }
    nloc = mine > 0u ? mine : 1u; nx = cnt > 0u ? cnt : 1u;
}
__device__ __forceinline__ void xcd_barrier(const XcdBarrier& b) {
    asm volatile("s_waitcnt vmcnt(0)" ::: "memory");
    __syncthreads();
    if (threadIdx.x == 0) {
        unsigned* bar = b.bar;
        __builtin_amdgcn_fence(__ATOMIC_RELEASE, "agent");
        asm volatile("s_waitcnt vmcnt(0)" ::: "memory");
        const unsigned G = gridDim.x;
        const unsigned old = xb_add(&bar[XB_TOP], 1u);
        const unsigned tg = old / G;
        if (old + 1u == (tg + 1u) * G) xb_add(&bar[XB_TOPGEN], 1u);
        else XB_SPIN(xb_ld(&bar[XB_TOPGEN]) == tg, bar);
        __builtin_amdgcn_fence(__ATOMIC_ACQUIRE, "agent");
        asm volatile("s_waitcnt vmcnt(0)" ::: "memory");
    }
    __syncthreads();
}
#define GRID_SYNC_CG() { (void)xb; asm volatile("s_waitcnt vmcnt(0)" ::: "memory"); cg::this_grid().sync(); }
#define GRID_SYNC() xcd_barrier(xb)
#else
#define GRID_SYNC() emu_grid_sync()
#endif

#ifdef EMU
#define LOADP() P p = p_arg
#else
typedef __attribute__((address_space(4))) const unsigned long long cu64_t;
__device__ __forceinline__ void load_params(P& p) {
    cu64_t* q = (cu64_t*)__builtin_amdgcn_kernarg_segment_ptr();
    asm volatile("" : "+s"(q));
    typedef __attribute__((address_space(1))) char gchar_t;
    char* w[sizeof(P) / 8];
#pragma unroll
    for (int i = 0; i < (int)(sizeof(P) / 8); ++i) w[i] = (char*)(gchar_t*)q[i];
    __builtin_memcpy(&p, w, sizeof(P));
}
#define LOADP() P p; load_params(p)
#endif
#define PROBE_MULT 3
#if defined(PROBE_ID) && !defined(EMU)
#define PROBE_INIT() unsigned long long probe_t0 = wall_clock64()
#define PROBE_AFTER(id) { if (blockIdx.x == 0) { unsigned long long now_ = wall_clock64(); if ((id) == PROBE_ID || (id) == PROBE_ID2) { const unsigned long long dt_ = now_ - probe_t0; \
    while (wall_clock64() - now_ < dt_ * PROBE_MULT) __builtin_amdgcn_s_sleep(8); now_ = wall_clock64(); } probe_t0 = now_; } }
#else
#define PROBE_INIT()
#define PROBE_AFTER(id)
#endif
__device__ __forceinline__ int gla_tok(int n, int i) {
    if (n < NCC) return n * 64 + i;
    int m = n - NCC; int col = m / RB, rb = m % RB;
    return CTX + (rb * 64 + i) * GRID_W + col;
}
__device__ __forceinline__ int chunk_order(int d, int s) {
    if (d == 0) return s;
    return (s < NCC) ? (NCC - 1 - s) : (NC - 1 - (s - NCC));
}
__device__ __forceinline__ int tok_order(int d, int s) {
    if (d == 0) return s;
    return (s < CTX) ? (CTX - 1 - s) : (MTOT - 1 - (s - CTX));
}


#define LDS_ROW 72
__device__ __forceinline__ void mfma_gemm_tile(const bf16_t* Wt, int ldw, const bf16_t* Act, int lda, int K, int n0, int m0, bf16_t* lds, f32x4 (&acc)[4][4]) {
    bf16_t* Ws = lds; bf16_t* As = lds + 128 * LDS_ROW;
    const int tid = otid(), lane = tid & 63, wave = tid >> 6, wn = wave >> 1, wm = wave & 1;
    const int lrow = tid >> 3, lkc = (tid & 7) * 8;
    u32x4 pw[4], pa[4];
#pragma unroll
    for (int i = 0; i < 4; ++i) {
        pw[i] = *(const u32x4*)(Wt + (size_t)(n0 + lrow + 32 * i) * ldw + lkc);
        pa[i] = *(const u32x4*)(Act + (size_t)(m0 + lrow + 32 * i) * lda + lkc);
    }
    for (int k0 = 0; k0 < K; k0 += 64) {
        __syncthreads();
#pragma unroll
        for (int i = 0; i < 4; ++i) {
            *(u32x4*)(Ws + (lrow + 32 * i) * LDS_ROW + lkc) = pw[i];
            *(u32x4*)(As + (lrow + 32 * i) * LDS_ROW + lkc) = pa[i];
        }
        __syncthreads();
        if (k0 + 64 < K) {
#pragma unroll
            for (int i = 0; i < 4; ++i) {
                pw[i] = *(const u32x4*)(Wt + (size_t)(n0 + lrow + 32 * i) * ldw + k0 + 64 + lkc);
                pa[i] = *(const u32x4*)(Act + (size_t)(m0 + lrow + 32 * i) * lda + k0 + 64 + lkc);
            }
        }
#pragma unroll
        for (int ks = 0; ks < 2; ++ks) {
            bf16x8 a[4], b[4];
#pragma unroll
            for (int i = 0; i < 4; ++i) {
                a[i] = *(const bf16x8*)(Ws + (wn * 64 + i * 16 + (lane & 15)) * LDS_ROW + ks * 32 + (lane >> 4) * 8);
                b[i] = *(const bf16x8*)(As + (wm * 64 + i * 16 + (lane & 15)) * LDS_ROW + ks * 32 + (lane >> 4) * 8);
            }
#pragma unroll
            for (int ni = 0; ni < 4; ++ni)
#pragma unroll
                for (int mi = 0; mi < 4; ++mi) acc[ni][mi] = MFMA16(a[ni], b[mi], acc[ni][mi]);
        }
    }
}
#define L64_ROW 72
#ifdef EMU
struct BufRsrc { const char* base; };
__device__ __forceinline__ BufRsrc make_rsrc(const void* p, size_t) { BufRsrc r; r.base = (const char*)p; return r; }
__device__ __forceinline__ u32x4 buf_load16(const BufRsrc& r, unsigned voff, unsigned soff) { return *(const u32x4*)(r.base + voff + soff); }
#else
typedef __amdgpu_buffer_rsrc_t BufRsrc;
__device__ __forceinline__ BufRsrc make_rsrc(const void* p, size_t bytes) { return __builtin_amdgcn_make_buffer_rsrc((void*)p, 0, (int)bytes, 0x00020000); }
__device__ __forceinline__ u32x4 buf_load16(const BufRsrc& r, unsigned voff, unsigned soff) { return __builtin_bit_cast(u32x4, __builtin_amdgcn_raw_buffer_load_b128(r, voff, soff, 0)); }
#endif
template <int NI, int MI>
__device__ __forceinline__ void mfma_gemm_tile_t(const bf16_t* Wt, int ldw, size_t wbytes, const bf16_t* Act, int lda, size_t abytes, int K, int n0, int m0, bf16_t* lds, f32x4 (&acc)[NI][MI], unsigned long long* gacc = nullptr) {
    constexpr int WR = 32 * NI, AR = 32 * MI, BUF = (WR + AR) * L64_ROW;
    const int tid = otid(), lane = tid & 63, wave = tid >> 6, wn = wave >> 1, wm = wave & 1;
    const int lrow = tid >> 3, lkc = (tid & 7) * 8;
    const BufRsrc rw = make_rsrc(Wt, wbytes), ra = make_rsrc(Act, abytes);
    unsigned vw[NI], va[MI];
#pragma unroll
    for (int i = 0; i < NI; ++i) vw[i] = (unsigned)(((size_t)(n0 + lrow + 32 * i) * ldw + lkc) * 2);
#pragma unroll
    for (int i = 0; i < MI; ++i) va[i] = (unsigned)(((size_t)(m0 + lrow + 32 * i) * lda + lkc) * 2);
    u32x4 qw0[NI], qa0[MI];
    const int nk = K / 64;
#define GT_LOAD(QW, QA, KT) { const unsigned so_ = (unsigned)(((KT) < nk) ? (KT) : (nk - 1)) * 128u; \
    _Pragma("unroll") for (int i = 0; i < NI; ++i) QW[i] = buf_load16(rw, vw[i], so_); \
    _Pragma("unroll") for (int i = 0; i < MI; ++i) QA[i] = buf_load16(ra, va[i], so_); }
#define GT_STORE(QW, QA, DST) { \
    _Pragma("unroll") for (int i = 0; i < NI; ++i) *(u32x4*)((DST) + (lrow + 32 * i) * L64_ROW + lkc) = QW[i]; \
    _Pragma("unroll") for (int i = 0; i < MI; ++i) *(u32x4*)((DST) + (WR + lrow + 32 * i) * L64_ROW + lkc) = QA[i]; }
#define GT_COMPUTE(CUR) { _Pragma("unroll") for (int ks = 0; ks < 2; ++ks) { bf16x8 b[MI], a[NI]; \
    _Pragma("unroll") for (int i = 0; i < MI; ++i) b[i] = *(const bf16x8*)((CUR) + (WR + wm * 16 * MI + i * 16 + (lane & 15)) * L64_ROW + ks * 32 + (lane >> 4) * 8); \
    _Pragma("unroll") for (int i = 0; i < NI; ++i) a[i] = *(const bf16x8*)((CUR) + (wn * 16 * NI + i * 16 + (lane & 15)) * L64_ROW + ks * 32 + (lane >> 4) * 8); \
    _Pragma("unroll") for (int ni = 0; ni < NI; ++ni) { \
        _Pragma("unroll") for (int mi = 0; mi < MI; ++mi) MFMA16_ACC(a[ni], b[mi], acc[ni][mi]); } } }
    GT_LOAD(qw0, qa0, 0)
    __syncthreads();
    GT_STORE(qw0, qa0, lds)
    __syncthreads();
    for (int kt = 0; kt < nk; kt += 2) {
        GT_LOAD(qw0, qa0, kt + 1)
        GT_COMPUTE(lds)
        GT_STORE(qw0, qa0, lds + BUF)
        __syncthreads();
        GT_LOAD(qw0, qa0, kt + 2)
        GT_COMPUTE(lds + BUF)
        GT_STORE(qw0, qa0, lds)
        __syncthreads();
    }
#undef GT_LOAD
#undef GT_STORE
#undef GT_COMPUTE
}
#define ZERO_ACC4(acc) { _Pragma("unroll") for (int i_ = 0; i_ < 4; ++i_) _Pragma("unroll") for (int j_ = 0; j_ < 4; ++j_) acc[i_][j_] = (f32x4){0.f, 0.f, 0.f, 0.f}; }
#define FOR_ACC(acc, n0, m0, BODY) { const int lane_ = otid() & 63, wave_ = otid() >> 6; \
    _Pragma("unroll") for (int ni_ = 0; ni_ < 4; ++ni_) _Pragma("unroll") for (int mi_ = 0; mi_ < 4; ++mi_) { \
        const int n = (n0) + (wave_ >> 1) * 64 + ni_ * 16 + (lane_ >> 4) * 4; const int m = (m0) + (wave_ & 1) * 64 + mi_ * 16 + (lane_ & 15); const f32x4 v = acc[ni_][mi_]; BODY } }
__device__ __forceinline__ u32x2 pack4(float a, float b, float c, float d) { u32x2 r; r.x = pack2bf(a, b); r.y = pack2bf(c, d); return r; }

__device__ __forceinline__ void convert_wt_job(const float* W, int K, int N, int Npad, bf16_t* out, int job, float* T, int ilv) {
    const int tid = otid();
    const int nkt = K / 64;
    const int n0 = (job / nkt) * 64, k0 = (job % nkt) * 64;
    __syncthreads();
    for (int idx = tid; idx < 4096; idx += NTHREADS) {
        int kk = idx >> 6, nn = idx & 63;
        int nr = n0 + nn; int src = ilv ? ((nr & 1) ? (N / 2 + (nr >> 1)) : (nr >> 1)) : nr;
        T[kk * 65 + nn] = (nr < N) ? W[(size_t)(k0 + kk) * N + src] : 0.f;
    }
    __syncthreads();
    {
        int nn = tid >> 2, part = tid & 3;
        unsigned w[8];
#pragma unroll
        for (int j = 0; j < 8; ++j) w[j] = pack2bf(T[(part * 16 + 2 * j) * 65 + nn], T[(part * 16 + 2 * j + 1) * 65 + nn]);
        u32x4* o = (u32x4*)(out + (size_t)(n0 + nn) * K + k0 + part * 16);
        o[0] = (u32x4){w[0], w[1], w[2], w[3]}; o[1] = (u32x4){w[4], w[5], w[6], w[7]};
    }
}
__device__ __forceinline__ void phase_convert_weights(const P& p, int l, char* smem, int bid, int nb) {
    float* T = (float*)smem;
    struct Item { const float* W; int K, N, Npad; bf16_t* out; };
    const Item items[12] = {
        {p.in[I_RW2] + ((size_t)l * 2 + 0) * 64 * RW, 64, RW, NPAD(RW), p.WT_W2},
        {p.in[I_RW2] + ((size_t)l * 2 + 1) * 64 * RW, 64, RW, NPAD(RW), p.WT_W2 + (size_t)NPAD(RW) * 64},
        {p.in[I_RA2] + ((size_t)l * 2 + 0) * 64 * RW, 64, RW, NPAD(RW), p.WT_A2},
        {p.in[I_RA2] + ((size_t)l * 2 + 1) * 64 * RW, 64, RW, NPAD(RW), p.WT_A2 + (size_t)NPAD(RW) * 64},
        {p.in[I_WIN] + (size_t)l * D_MODEL * D_IN, D_MODEL, D_IN, NPAD192(D_IN), p.WT_IN},
        {p.in[I_RG2] + (size_t)l * 128 * RW, 128, RW, RW, p.WT_G2},
        {p.in[I_S5GLU] + (size_t)l * SW * 2 * SW, SW, 2 * SW, 2 * SW, p.WT_GLU},
        {p.in[I_WBR] + ((size_t)l * 3 + 0) * BW * D_MODEL, BW, D_MODEL, D_MODEL, p.WT_BR},
        {p.in[I_WBR] + ((size_t)l * 3 + 1) * BW * D_MODEL, BW, D_MODEL, D_MODEL, p.WT_BR + (size_t)D_MODEL * BW},
        {p.in[I_WBR] + ((size_t)l * 3 + 2) * BW * D_MODEL, BW, D_MODEL, D_MODEL, p.WT_BR + (size_t)2 * D_MODEL * BW},
        {p.in[I_WOUT] + (size_t)l * D_MODEL * D_MODEL, D_MODEL, D_MODEL, D_MODEL, p.WT_OUT},
        {p.in[I_PWQ] + (size_t)l * D_MODEL * PQ, D_MODEL, PQ, PQ, p.WT_Q}};
    int base = 0;
#pragma unroll
    for (int it = 0; it < 12; ++it) {
        const int nj = (items[it].Npad / 64) * (items[it].K / 64);
        for (int j = (bid + nb - (base % nb)) % nb; j < nj; j += nb)
            convert_wt_job(items[it].W, items[it].K, items[it].N, items[it].Npad, items[it].out, j, T, it == 6);
        base += nj;
    }
    __syncthreads();
    {
        const float* ks = p.in[I_PKEYS] + (size_t)l * PH * 2 * 128 * 128;
        for (size_t i = (size_t)bid * NTHREADS + otid(); i < (size_t)PH * 2 * 128 * 128; i += (size_t)nb * NTHREADS) {
            const float v = ks[i]; const bf16_t hb = f2bf(v);
            p.KHI[i] = hb; p.KLO[i] = f2bf(v - bf2f(hb));
        }
    }
}

#ifdef EMU
__device__ __forceinline__ int xcd_rank() { return obid(); }
#else
__device__ __forceinline__ int xcd_rank() { return (int)((volatile LAS unsigned*)(unsigned)(SMEM_BYTES))[2]; }
#endif
__device__ __forceinline__ bool tile_map(int it, int ntm, int ntn, int PM, int& mt, int& nt) {
    const int G = gridDim.x;
    const long id = (long)it * G + xcd_rank();
    if (id >= (long)ntm * ntn) return false;
    const int full = ntm / PM; const long fullsz = (long)full * PM * ntn;
    if (id < fullsz) { const int p = (int)(id / (PM * ntn)), rem = (int)(id % (PM * ntn)); nt = rem / PM; mt = p * PM + rem % PM; }
    else { const int rem = (int)(id - fullsz), hh = ntm - full * PM; nt = rem / hh; mt = full * PM + rem % hh; }
    return true;
}

template <int NI, int MI, class Pre, class Post>
__device__ __forceinline__ void gemm_tile_run(const bf16_t* Wt, int ldw, size_t wbytes, const bf16_t* Act, int lda, size_t abytes, int K, int n0, int m0, bf16_t* lds, Pre pre, Post post) {
    f32x4 acc[NI][MI];
#pragma unroll
    for (int i = 0; i < NI; ++i)
#pragma unroll
        for (int j = 0; j < MI; ++j) acc[i][j] = (f32x4){0.f, 0.f, 0.f, 0.f};
    pre(m0, n0, acc, lds);
    mfma_gemm_tile_t<NI, MI>(Wt, ldw, wbytes, Act, lda, abytes, K, n0, m0, lds, acc);
    const int lane = otid() & 63, wave = otid() >> 6;
#pragma unroll
    for (int ni = 0; ni < NI; ++ni)
#pragma unroll
        for (int mi = 0; mi < MI; ++mi)
            post(ni, mi, m0 + (wave & 1) * 16 * MI + mi * 16 + (lane & 15), n0 + (wave >> 1) * 16 * NI + ni * 16 + (lane >> 4) * 4, acc[ni][mi]);
}
struct NoPre { template <class A> __device__ __forceinline__ void operator()(int, int, A&, bf16_t*) const {} };
template <int NI, class PreM, class PreT, class Post>
__device__ __forceinline__ void gemm_phase(const bf16_t* Wt, int ldw, size_t wbytes, const bf16_t* Act, int lda, size_t abytes, int K, int N, bf16_t* lds, PreM prem, PreT pret, Post post) {
    const int ntn = N / (32 * NI), ntm = MTOT / 256 - 1;
    const int PM = (ntn >= 16) ? 2 : ((ntn >= 8) ? 4 : 8);
    for (int it = 0;; ++it) {
        int mt_, nt_; if (!tile_map(it, ntm, ntn, PM, mt_, nt_)) break;
        gemm_tile_run<NI, 8>(Wt, ldw, wbytes, Act, lda, abytes, K, nt_ * 32 * NI, mt_ * 256, lds, prem, post);
    }
    for (int job = obid(); job < 4 * ntn; job += gridDim.x)
        gemm_tile_run<NI, 2>(Wt, ldw, wbytes, Act, lda, abytes, K, (job >> 2) * 32 * NI, MTOT - 256 + (job & 3) * 64, lds, pret, post);
}

__device__ __forceinline__ void phase_init(const P& p, char* smem) {
    const int tid = otid();
    float* sc = (float*)smem;
    for (int i = tid; i < D_MODEL; i += NTHREADS) { sc[i] = siluf_(p.in[I_CCTX][i]); sc[D_MODEL + i] = siluf_(p.in[I_C][i]); }
    __syncthreads();
    const int ncolblk = (6 * D_MODEL) / NTHREADS;
    for (int job = obid(); job < DEPTH * ncolblk; job += gridDim.x) {
        int l = job / ncolblk, n = (job % ncolblk) * NTHREADS + tid;
        const float* w = p.in[I_WMOD] + (size_t)l * D_MODEL * 6 * D_MODEL + n;
        float a0 = 0.f, a1 = 0.f;
        for (int k = 0; k < D_MODEL; ++k) { float wv = w[(size_t)k * 6 * D_MODEL]; a0 += sc[k] * wv; a1 += sc[D_MODEL + k] * wv; }
        float b = p.in[I_BMOD][l * 6 * D_MODEL + n];
        p.MOD[(size_t)(l * 2 + 0) * 6 * D_MODEL + n] = a0 + b;
        p.MOD[(size_t)(l * 2 + 1) * 6 * D_MODEL + n] = a1 + b;
    }
    const size_t gtid = (size_t)obid() * NTHREADS + tid, gn = (size_t)gridDim.x * NTHREADS;
    for (size_t i = gtid; i < (size_t)CTX * D_MODEL; i += gn) p.X[i] = p.in[I_CTX][i];
    for (size_t i = gtid; i < (size_t)SEQ * D_MODEL; i += gn) p.X[(size_t)CTX * D_MODEL + i] = p.in[I_X][i];
    __syncthreads();
}

__device__ __forceinline__ void phase_s5const(const P& p, int l) {
    const size_t gtid = (size_t)obid() * NTHREADS + otid(), gn = (size_t)gridDim.x * NTHREADS;
    for (size_t i = gtid; i < (size_t)2 * SG * 64; i += gn) {
        int d = (int)(i / (SG * 64)), g = (int)((i / 64) % SG), s = (int)(i % 64);
        size_t li = ((size_t)(l * 2 + d) * SG + g) * 64 + s;
        float lre = p.in[I_S5LRE][li], lim = p.in[I_S5LIM][li];
        float dt = expf(p.in[I_S5LS][(l * 2 + d) * SG + g]);
        float mag = expf(lre * dt);
        float are = mag * cosf(lim * dt), aim = mag * sinf(lim * dt);
        float den = lre * lre + lim * lim;
        float fre = ((are - 1.0f) * lre + aim * lim) / den;
        float fim = (aim * lre - (are - 1.0f) * lim) / den;
        p.S5A[i * 2 + 0] = are; p.S5A[i * 2 + 1] = aim;
        const float* bre = p.in[I_S5BRE] + (((size_t)l * SG + g) * 64 + s) * 16;
        const float* bim = p.in[I_S5BIM] + (((size_t)l * SG + g) * 64 + s) * 16;
        for (int c = 0; c < 16; ++c) {
            p.S5BB[(i * 16 + c) * 2 + 0] = fre * bre[c] - fim * bim[c];
            p.S5BB[(i * 16 + c) * 2 + 1] = fre * bim[c] + fim * bre[c];
        }
    }
}

__device__ __forceinline__ void phase_norm(const P& p, int l, int which) {
    const int lane = otid() & 63;
    const int gw = (obid() * NTHREADS + otid()) >> 6, nw = (gridDim.x * NTHREADS) >> 6;
    const float* g = p.in[which ? I_N2G : I_N1G] + l * D_MODEL;
    constexpr int NJ = (D_MODEL + 255) / 256;
    for (int t = gw; t < MTOT; t += nw) {
        const float* x = p.X + (size_t)t * D_MODEL;
        const float* mod = p.MOD + (size_t)(l * 2 + (t >= CTX ? 1 : 0)) * 6 * D_MODEL + (which ? 3 * D_MODEL : 0);
        float4 v[NJ]; float ss = 0.f;
#pragma unroll
        for (int j = 0; j < NJ; ++j) {
            const int e = j * 256 + lane * 4;
            if (e < D_MODEL) v[j] = *(const float4*)(x + e); else { v[j].x = 0.f; v[j].y = 0.f; v[j].z = 0.f; v[j].w = 0.f; }
            ss += v[j].x * v[j].x + v[j].y * v[j].y + v[j].z * v[j].z + v[j].w * v[j].w;
        }
        ss = wave_sum(ss);
        const float rstd = rsqrtf(ss / D_MODEL + 1e-6f);
#pragma unroll
        for (int j = 0; j < NJ; ++j) {
            const int e = j * 256 + lane * 4;
            if (e < D_MODEL) {
                const float4 gg = *(const float4*)(g + e), sc = *(const float4*)(mod + D_MODEL + e), sh = *(const float4*)(mod + e);
                *(u32x2*)(p.H + (size_t)t * D_MODEL + e) = pack4(v[j].x * rstd * gg.x * (1.0f + sc.x) + sh.x, v[j].y * rstd * gg.y * (1.0f + sc.y) + sh.y,
                                                                 v[j].z * rstd * gg.z * (1.0f + sc.z) + sh.z, v[j].w * rstd * gg.w * (1.0f + sc.w) + sh.w);
            }
        }
    }
}

__device__ __forceinline__ void phase_gemm_in(const P& p, int l, char* smem) {
    constexpr int NI = 6, MI = 8;
    const int ntn = NPAD192(D_IN) / 192, ntm = MTOT / 256;
    for (int it = 0;; ++it) {
        int mt_, nt_; if (!tile_map(it, ntm, ntn, 4, mt_, nt_)) break;
        const int m0 = mt_ * 256, n0 = nt_ * 192;
        f32x4 acc[NI][MI];
#pragma unroll
        for (int i = 0; i < NI; ++i)
#pragma unroll
            for (int j = 0; j < MI; ++j) acc[i][j] = (f32x4){0.f, 0.f, 0.f, 0.f};
        mfma_gemm_tile_t<NI, MI>(p.WT_IN, D_MODEL, (size_t)NPAD192(D_IN) * D_MODEL * 2, p.H, D_MODEL, (size_t)MTOT * D_MODEL * 2, D_MODEL, n0, m0, (bf16_t*)smem, acc);
        const int lane = otid() & 63, wave = otid() >> 6;
#pragma unroll
        for (int ni = 0; ni < NI; ++ni)
#pragma unroll
            for (int mi = 0; mi < MI; ++mi) {
                const int n = n0 + (wave >> 1) * 16 * NI + ni * 16 + (lane >> 4) * 4, m = m0 + (wave & 1) * 16 * MI + mi * 16 + (lane & 15);
                const u32x2 pk_ = pack4(acc[ni][mi][0], acc[ni][mi][1], acc[ni][mi][2], acc[ni][mi][3]);
                if (n < ZG) *(u32x2*)(p.Z + (size_t)m * ZLD + n) = pk_;
                else if (n < D_IN) *(u32x2*)(p.ZGT + ((((size_t)(m >> 4) * (3 * D_MODEL / 16) + ((n - ZG) >> 4)) * 64 + lane) * 4)) =
                    pack4(sigmoidf_(acc[ni][mi][0]), sigmoidf_(acc[ni][mi][1]), sigmoidf_(acc[ni][mi][2]), sigmoidf_(acc[ni][mi][3]));
            }
    }
}

__device__ __forceinline__ void unpack8(const u32x4 w, float (&f)[8]) {
    f[0] = LO16(w.x); f[1] = HI16(w.x); f[2] = LO16(w.y); f[3] = HI16(w.y); f[4] = LO16(w.z); f[5] = HI16(w.z); f[6] = LO16(w.w); f[7] = HI16(w.w);
}
__device__ __forceinline__ u32x4 pack8(const float (&f)[8]) {
    u32x4 o; o.x = pack2bf(f[0], f[1]); o.y = pack2bf(f[2], f[3]);
    o.z = pack2bf(f[4], f[5]); o.w = pack2bf(f[6], f[7]); return o;
}
__device__ __forceinline__ void load8f(const float* p, float (&f)[8]) {
    const float4 a = *(const float4*)p, b = *(const float4*)(p + 4);
    f[0] = a.x; f[1] = a.y; f[2] = a.z; f[3] = a.w; f[4] = b.x; f[5] = b.y; f[6] = b.z; f[7] = b.w;
}
__device__ __forceinline__ void store8f(float* p, const float (&f)[8]) {
    float4 a, b; a.x = f[0]; a.y = f[1]; a.z = f[2]; a.w = f[3]; b.x = f[4]; b.y = f[5]; b.z = f[6]; b.w = f[7];
    *(float4*)p = a; *(float4*)(p + 4) = b;
}
__device__ __forceinline__ void conv8(const bf16_t* zp, const float* conv, int c0, bool act, bool first, bool last, float (&out)[8]) {
    const u32x4 z4 = {0u, 0u, 0u, 0u};
    const u32x4 a0 = act ? *(const u32x4*)(zp + c0) : z4;
    const u32x4 am = (act && !first) ? *(const u32x4*)(zp + c0 - ZLD) : z4;
    const u32x4 an = (act && !last) ? *(const u32x4*)(zp + c0 + ZLD) : z4;
    float w0[8], w1[8], w2[8], f0[8], fm[8], fn[8];
    if (act) { load8f(conv + c0, w0); load8f(conv + RWKV_IN + c0, w1); load8f(conv + 2 * RWKV_IN + c0, w2); }
    else {
#pragma unroll
        for (int e = 0; e < 8; ++e) { w0[e] = 0.f; w1[e] = 0.f; w2[e] = 0.f; }
    }
    unpack8(a0, f0); unpack8(am, fm); unpack8(an, fn);
#pragma unroll
    for (int e = 0; e < 8; ++e) out[e] = w1[e] * f0[e] + w0[e] * fm[e] + w2[e] * fn[e];
}
__device__ __forceinline__ void phase_rwkv_prep1(const P& p, int l) {
    const int lane = otid() & 63;
    const int gw = (obid() * NTHREADS + otid()) >> 6, nw = (gridDim.x * NTHREADS) >> 6;
    const float* conv = p.in[I_RCONV] + (size_t)l * 3 * RWKV_IN;
    const float* k_k = p.in[I_RKK] + (size_t)l * RW;
    const bool act = lane * 8 < RW, act2 = lane * 8 < 384;
    float kkw[8];
    if (act) load8f(k_k + lane * 8, kkw);
    else {
#pragma unroll
        for (int e = 0; e < 8; ++e) kkw[e] = 0.f;
    }
    for (int t = gw; t < MTOT; t += nw) {
        const bool first = (t == 0) || (t == CTX), last = (t == CTX - 1) || (t == MTOT - 1);
        const bf16_t* zp = p.Z + (size_t)t * ZLD + ZR;
        float rv[8], kv[8], vv[8], lr[8];
        conv8(zp, conv, 0 * RW + lane * 8, act, first, last, rv);
        conv8(zp, conv, 1 * RW + lane * 8, act, first, last, kv);
        conv8(zp, conv, 2 * RW + lane * 8, act, first, last, vv);
        conv8(zp, conv, 3 * RW + lane * 8, act2, first, last, lr);
        float kk[8]; float ss = 0.f;
#pragma unroll
        for (int e = 0; e < 8; ++e) { kk[e] = kv[e] * kkw[e]; ss += kk[e] * kk[e]; }
        ss += __shfl_xor(ss, 1, 64); ss += __shfl_xor(ss, 2, 64); ss += __shfl_xor(ss, 4, 64);
        const float inv = 1.0f / fmaxf(sqrtf(ss), 1e-12f);
#pragma unroll
        for (int e = 0; e < 8; ++e) kk[e] *= inv;
        if (act) {
            const size_t o = (size_t)t * RW + lane * 8;
            *(u32x4*)(p.R + o) = pack8(rv); *(u32x4*)(p.KS + o) = pack8(kv); *(u32x4*)(p.V + o) = pack8(vv); *(u32x4*)(p.KK + o) = pack8(kk);
        }
        if (act2) {
            const int cc = lane * 8;
            if (cc < 128) {
#pragma unroll
                for (int e = 0; e < 8; ++e) lr[e] = tanhf_(lr[e]);
                *(u32x4*)(p.LR + (size_t)t * 256 + cc) = pack8(lr);
            } else if (cc < 256) {
                *(u32x4*)(p.LR + (size_t)t * 256 + cc) = pack8(lr);
            } else {
#pragma unroll
                for (int e = 0; e < 8; ++e) lr[e] = sigmoidf_(lr[e]);
                *(u32x4*)(p.GS + (size_t)t * 128 + cc - 256) = pack8(lr);
            }
        }
    }
}
__device__ __forceinline__ void phase_rwkv_prep2(const P& p, int l, char* smem) {
    const int ntm = MTOT / 128, ntn = NPAD(RW) / 128;
    const float* k_a = p.in[I_RKA] + (size_t)l * RW;
    const float* r_k = p.in[I_RRK] + (size_t)l * RW;
    for (int job = obid(); job < ntm * ntn * 2; job += gridDim.x) {
        const int d = job % 2, n0 = ((job / 2) % ntn) * 128, m0 = (job / (2 * ntn)) * 128;
        const float* w0 = p.in[I_RW0] + (size_t)(l * 2 + d) * RW;
        const float* a0 = p.in[I_RA0] + (size_t)(l * 2 + d) * RW;
        f32x4 accw[4][4], acca[4][4]; ZERO_ACC4(accw); ZERO_ACC4(acca);
        mfma_gemm_tile(p.WT_W2 + (size_t)d * NPAD(RW) * 64, 64, p.LR + d * 64, 256, 64, n0, m0, (bf16_t*)smem, accw);
        mfma_gemm_tile(p.WT_A2 + (size_t)d * NPAD(RW) * 64, 64, p.LR + 128 + d * 64, 256, 64, n0, m0, (bf16_t*)smem, acca);
        const int lane = otid() & 63, wave = otid() >> 6;
#pragma unroll
        for (int mi = 0; mi < 4; ++mi) {
            const int m = m0 + (wave & 1) * 64 + mi * 16 + (lane & 15);
            float bon = 0.f;
#pragma unroll
            for (int ni = 0; ni < 4; ++ni) {
                const int n = n0 + (wave >> 1) * 64 + ni * 16 + (lane >> 4) * 4;
                if (n < RW) {
                    const u32x2 kq = *(const u32x2*)(p.KS + (size_t)m * RW + n), kkq = *(const u32x2*)(p.KK + (size_t)m * RW + n), rq = *(const u32x2*)(p.R + (size_t)m * RW + n);
                    const float kv[4] = {LO16(kq.x), HI16(kq.x), LO16(kq.y), HI16(kq.y)};
                    const float kkv[4] = {LO16(kkq.x), HI16(kkq.x), LO16(kkq.y), HI16(kkq.y)};
                    const float rv[4] = {LO16(rq.x), HI16(rq.x), LO16(rq.y), HI16(rq.y)};
                    float lw[4], kd[4], bb[4];
#pragma unroll
                    for (int e = 0; e < 4; ++e) {
                        const float x = w0[n + e] + accw[ni][mi][e];
                        lw[e] = -fexp_(-softplusf_(-x) - 0.5f);
                        const float aa = sigmoidf_(a0[n + e] + acca[ni][mi][e]);
                        kd[e] = kv[e] * (1.0f + (aa - 1.0f) * k_a[n + e]);
                        bb[e] = kkv[e] * aa;
                        bon += rv[e] * kd[e] * r_k[n + e];
                    }
                    const size_t o = ((size_t)d * MTOT + m) * RW + n;
                    float4 lo4; lo4.x = lw[0]; lo4.y = lw[1]; lo4.z = lw[2]; lo4.w = lw[3];
                    *(float4*)(p.LW + o) = lo4;
                    *(u32x2*)(p.KD + o) = pack4(kd[0], kd[1], kd[2], kd[3]);
                    *(u32x2*)(p.BB + o) = pack4(bb[0], bb[1], bb[2], bb[3]);
                }
            }
            bon += __shfl_xor(bon, 16, 64); bon += __shfl_xor(bon, 32, 64);
            const int hh = (n0 + (wave >> 1) * 64) >> 6;
            if ((lane >> 4) == 0 && hh < RH) p.BONUS[((size_t)d * MTOT + m) * RH + hh] = bon;
        }
    }
}

#define CH_ROW 72
#define SEQ_REC 16640
#define CH_SLOT (64 * CH_ROW)
#define CH_XR_OFF (7 * CH_SLOT * 2)
#define CH_AAB_OFF (CH_XR_OFF + 64 * 132 * 4)
#define CH_GC_OFF (CH_AAB_OFF + 64 * 72 * 4)
template <int MT, int NT>
__device__ __forceinline__ void lds_mm(const bf16_t* A, int m0, const bf16_t* Bt, int n0, f32x4 (&acc)[MT][NT]) {
    const int lane = otid() & 63, q = lane >> 4, r = lane & 15;
#pragma unroll
    for (int s = 0; s < 2; ++s) {
        bf16x8 a[MT], b[NT];
#pragma unroll
        for (int i = 0; i < MT; ++i) a[i] = *(const bf16x8*)(A + (m0 + i * 16 + r) * CH_ROW + s * 32 + q * 8);
#pragma unroll
        for (int i = 0; i < NT; ++i) b[i] = *(const bf16x8*)(Bt + (n0 + i * 16 + r) * CH_ROW + s * 32 + q * 8);
#pragma unroll
        for (int i = 0; i < MT; ++i)
#pragma unroll
            for (int jj = 0; jj < NT; ++jj) acc[i][jj] = MFMA16(a[i], b[jj], acc[i][jj]);
    }
}
__device__ __forceinline__ void rwkv_chunk_job(const P& p, int job, char* smem) {
    const int tid = otid(), lane = tid & 63, wv = tid >> 6, q = lane >> 4, r = lane & 15;
    const int d = job / (NC * RH), n = (job / RH) % NC, h = job % RH;
    const size_t base = (size_t)(d * NC + n) * RH + h;
    bf16_t* S0 = (bf16_t*)smem; bf16_t* S1 = S0 + CH_SLOT; bf16_t* S2 = S1 + CH_SLOT; bf16_t* S3 = S2 + CH_SLOT;
    bf16_t* S4 = S3 + CH_SLOT; bf16_t* S5 = S4 + CH_SLOT; bf16_t* S6 = S5 + CH_SLOT;
    float* X = (float*)(smem + CH_XR_OFF);
    float* AABt = (float*)(smem + CH_AAB_OFF);
    bf16_t* U0t = (bf16_t*)(smem + CH_AAB_OFF);
    bf16_t* Aht = U0t + CH_SLOT;
    float* GC = (float*)(smem + CH_GC_OFF);
    __syncthreads();
    u32x4 gkk[2], gr[2], gv[2], gkd[2], gbb[2]; float lw[2][8];
#pragma unroll
    for (int it = 0; it < 2; ++it) {
        const int c = tid + 256 * it, i = c >> 3, k0 = (c & 7) * 8; const int tok = 64 * n + (d ? 63 - i : i);
        const size_t o1 = (size_t)tok * RW + h * 64 + k0, o2 = ((size_t)d * MTOT + tok) * RW + h * 64 + k0;
        load8f(p.LW + o2, lw[it]);
        gkk[it] = *(const u32x4*)(p.KK + o1); gr[it] = *(const u32x4*)(p.R + o1); gv[it] = *(const u32x4*)(p.V + o1);
        gkd[it] = *(const u32x4*)(p.KD + o2); gbb[it] = *(const u32x4*)(p.BB + o2);
    }
#pragma unroll
    for (int it = 0; it < 2; ++it) { const int c = tid + 256 * it; store8f(X + (c >> 3) * 132 + (c & 7) * 8, lw[it]); }
    __syncthreads();
    {
        const int k = tid & 63, seg = tid >> 6;
        float v[16]; float run = 0.f;
#pragma unroll
        for (int e = 0; e < 16; ++e) { run += X[(seg * 16 + e) * 132 + k]; v[e] = run; }
        AABt[seg * 64 + k] = run;
        __syncthreads();
        float off = 0.f;
        for (int s2 = 0; s2 < seg; ++s2) off += AABt[s2 * 64 + k];
#pragma unroll
        for (int e = 0; e < 16; ++e) X[(seg * 16 + e) * 132 + k] = v[e] + off;
    }
    __syncthreads();
#pragma unroll
    for (int it = 0; it < 2; ++it) {
        const int c = tid + 256 * it, i = c >> 3, k0 = (c & 7) * 8;
        float L[8], Lp[8], LC[8], kkv[8], rv[8], vv[8], kdv[8], bbv[8];
        load8f(X + i * 132 + k0, L); load8f(X + 63 * 132 + k0, LC);
        if (i > 0) load8f(X + (i - 1) * 132 + k0, Lp);
        else {
#pragma unroll
            for (int e = 0; e < 8; ++e) Lp[e] = 0.f;
        }
        unpack8(gkk[it], kkv); unpack8(gr[it], rv); unpack8(gv[it], vv); unpack8(gkd[it], kdv); unpack8(gbb[it], bbv);
        float at[8], rt[8], bt[8], kt[8], bh[8], kh[8];
#pragma unroll
        for (int e = 0; e < 8; ++e) {
            const float eL = fexp_(L[e]), eLp = fexp_(Lp[e]), eNL = fexp_(-L[e]), eCL = fexp_(LC[e] - L[e]);
            at[e] = -kkv[e] * eLp; rt[e] = rv[e] * eL; bt[e] = bbv[e] * eNL; kt[e] = kdv[e] * eNL; bh[e] = bbv[e] * eCL; kh[e] = kdv[e] * eCL;
            if (i == 63) GC[k0 + e] = eL;
        }
        *(u32x4*)(S0 + i * CH_ROW + k0) = pack8(at);
        store8f(X + i * 132 + 64 + k0, at);
        *(u32x4*)(S1 + i * CH_ROW + k0) = pack8(rt);
        *(u32x4*)(S2 + i * CH_ROW + k0) = pack8(bt);
        *(u32x4*)(S3 + i * CH_ROW + k0) = pack8(kt);
#pragma unroll
        for (int e = 0; e < 8; ++e) {
            S4[(k0 + e) * CH_ROW + i] = f2bf(vv[e]);
            S5[(k0 + e) * CH_ROW + i] = f2bf(bh[e]);
            S6[(k0 + e) * CH_ROW + i] = f2bf(kh[e]);
        }
    }
    __syncthreads();
    {
        f32x4 acc[4][4]; ZERO_ACC4(acc);
        lds_mm<4, 4>((wv < 2) ? S0 : S1, 0, (wv & 1) ? S3 : S2, 0, acc);
        __syncthreads();
#pragma unroll
        for (int mt = 0; mt < 4; ++mt)
#pragma unroll
            for (int nt = 0; nt < 4; ++nt) {
                const int jc = nt * 16 + r, i0 = mt * 16 + 4 * q;
                if (wv == 0) {
                    f32x4 o;
#pragma unroll
                    for (int e = 0; e < 4; ++e) o[e] = (jc < i0 + e) ? acc[mt][nt][e] : 0.f;
                    *(f32x4*)(AABt + jc * 72 + i0) = o;
                } else {
                    bf16_t* dst = (wv == 1) ? S0 : ((wv == 2) ? S2 : S3);
#pragma unroll
                    for (int e = 0; e < 4; ++e) {
                        const bool ok = (wv == 1) ? (jc < i0 + e) : (jc <= i0 + e);
                        dst[(i0 + e) * CH_ROW + jc] = f2bf(ok ? acc[mt][nt][e] : 0.f);
                    }
                }
            }
    }
    __syncthreads();
    {
        f32x4 acc[1][4];
#pragma unroll
        for (int nt = 0; nt < 4; ++nt) acc[0][nt] = (f32x4){0.f, 0.f, 0.f, 0.f};
        lds_mm<1, 4>(S0, 16 * wv, S4, 0, acc);
#pragma unroll
        for (int nt = 0; nt < 4; ++nt)
#pragma unroll
            for (int e = 0; e < 4; ++e) X[(16 * wv + 4 * q + e) * 132 + nt * 16 + r] = acc[0][nt][e];
    }
    __syncthreads();
    if (tid < 128) {
        const int c = tid;
        for (int bi = 0; bi < 4; ++bi) {
            float acc[16];
#pragma unroll
            for (int e = 0; e < 16; ++e) acc[e] = X[(16 * bi + e) * 132 + c];
            for (int jj = 0; jj < 16 * bi; ++jj) {
                const float uj = X[jj * 132 + c];
                const f32x4* ap = (const f32x4*)(AABt + jj * 72 + 16 * bi);
                const f32x4 a0 = ap[0], a1 = ap[1], a2 = ap[2], a3 = ap[3];
#pragma unroll
                for (int e = 0; e < 4; ++e) { acc[e] += a0[e] * uj; acc[4 + e] += a1[e] * uj; acc[8 + e] += a2[e] * uj; acc[12 + e] += a3[e] * uj; }
            }
#pragma unroll
            for (int e = 0; e < 16; ++e) {
                const float u = acc[e];
                X[(16 * bi + e) * 132 + c] = u;
                const f32x4* ap = (const f32x4*)(AABt + (16 * bi + e) * 72 + 16 * bi);
                const f32x4 a0 = ap[0], a1 = ap[1], a2 = ap[2], a3 = ap[3];
#pragma unroll
                for (int e2 = 0; e2 < 16; ++e2) if (e2 > e) acc[e2] += ((e2 < 4) ? a0[e2 & 3] : (e2 < 8) ? a1[e2 & 3] : (e2 < 12) ? a2[e2 & 3] : a3[e2 & 3]) * u;
            }
        }
    }
    __syncthreads();
    if (tid < 128) {
        const int c = tid;
        bf16_t* dst = (c < 64) ? (U0t + c * CH_ROW) : (Aht + (c - 64) * CH_ROW);
        u32x4 ov[8];
#pragma unroll
        for (int g = 0; g < 8; ++g) {
            float v[8];
#pragma unroll
            for (int e = 0; e < 8; ++e) v[e] = X[(g * 8 + e) * 132 + c];
            ov[g].x = pack2bf(v[0], v[1]); ov[g].y = pack2bf(v[2], v[3]);
            ov[g].z = pack2bf(v[4], v[5]); ov[g].w = pack2bf(v[6], v[7]);
        }
#pragma unroll
        for (int g = 0; g < 8; ++g) *(u32x4*)(dst + g * 8) = ov[g];
    }
    __syncthreads();
    {
        f32x4 acc[4][4]; ZERO_ACC4(acc);
        char* rec = p.REC + base * SEQ_REC;
        if (wv == 0) {
            lds_mm<4, 4>(Aht, 0, S5, 0, acc);
#pragma unroll
            for (int nt = 0; nt < 4; ++nt)
#pragma unroll
                for (int s2 = 0; s2 < 2; ++s2) {
                    u32x4 o;
                    o.x = pack2bf(acc[2 * s2][nt][0], acc[2 * s2][nt][1]); o.y = pack2bf(acc[2 * s2][nt][2], acc[2 * s2][nt][3]);
                    o.z = pack2bf(acc[2 * s2 + 1][nt][0], acc[2 * s2 + 1][nt][1]); o.w = pack2bf(acc[2 * s2 + 1][nt][2], acc[2 * s2 + 1][nt][3]);
                    *(u32x4*)(rec + (((nt * 2 + s2) * 64 + lane) * 8) * 2) = o;
                }
        } else if (wv == 1) {
            lds_mm<4, 4>(S5, 0, U0t, 0, acc);
            lds_mm<4, 4>(S6, 0, S4, 0, acc);
#pragma unroll
            for (int mt = 0; mt < 4; ++mt)
#pragma unroll
                for (int nt = 0; nt < 4; ++nt) *(u32x2*)(rec + 8192 + (((nt * 4 + mt) * 64 + lane) * 4) * 2) = pack4(acc[mt][nt][0], acc[mt][nt][1], acc[mt][nt][2], acc[mt][nt][3]);
        } else if (wv == 2) {
            lds_mm<4, 4>(S2, 0, Aht, 0, acc);
#pragma unroll
            for (int mt = 0; mt < 4; ++mt)
#pragma unroll
                for (int nt = 0; nt < 4; ++nt)
#pragma unroll
                    for (int e = 0; e < 4; ++e) {
                        const int t = mt * 16 + 4 * q + e, kc = nt * 16 + r;
                        p.QH[(base * 64 + t) * 64 + kc] = f2bf(acc[mt][nt][e] + bf2f(S1[t * CH_ROW + kc]));
                    }
        } else if (wv == 3) {
            lds_mm<4, 4>(S2, 0, U0t, 0, acc);
            lds_mm<4, 4>(S3, 0, S4, 0, acc);
#pragma unroll
            for (int mt = 0; mt < 4; ++mt)
#pragma unroll
                for (int nt = 0; nt < 4; ++nt) *(f32x4*)(p.Y0T + (((base * 4 + mt) * 4 + nt) * 64 + lane) * 4) = acc[mt][nt];
        }
        if (tid < 64) ((float*)(rec + 16384))[tid] = GC[tid];
    }
}

#define SEQ_SLOT 16896
__device__ __forceinline__ void rwkv_seq_gload(const P& p, size_t base, int tid, u32x4 (&g)[5]) {
    const u32x4* m = (const u32x4*)(p.REC + base * SEQ_REC);
#pragma unroll
    for (int i = 0; i < 4; ++i) g[i] = m[tid + 256 * i];
    if (tid < 16) g[4] = m[1024 + tid];
}
__device__ __forceinline__ void rwkv_seq_lstore(char* slot, int tid, const u32x4 (&g)[5]) {
    u32x4* d = (u32x4*)slot;
#pragma unroll
    for (int i = 0; i < 4; ++i) d[tid + 256 * i] = g[i];
    if (tid < 16) d[1024 + tid] = g[4];
}
__device__ __forceinline__ void rwkv_seq_step(const P& p, const char* slot, size_t base, int wv, int lane, f32x4 (&X)[4]) {
    const int q = lane >> 4, r = lane & 15;
    const bf16_t* mt = (const bf16_t*)slot; const bf16_t* ntb = (const bf16_t*)(slot + 8192); const float* gc = (const float*)(slot + 16384);
    unsigned xh[4][2];
#pragma unroll
    for (int kt = 0; kt < 4; ++kt) {
        xh[kt][0] = pack2bf(X[kt][0], X[kt][1]); xh[kt][1] = pack2bf(X[kt][2], X[kt][3]);
        *(u32x2*)(p.SN + (base * 64 + 16 * wv + r) * 64 + 16 * kt + 4 * q) = (u32x2){xh[kt][0], xh[kt][1]};
    }
    bf16x8 bh[2];
#pragma unroll
    for (int s2 = 0; s2 < 2; ++s2) bh[s2] = __builtin_bit_cast(bf16x8, ((u32x4){xh[2 * s2][0], xh[2 * s2][1], xh[2 * s2 + 1][0], xh[2 * s2 + 1][1]}));
#pragma unroll
    for (int tile = 0; tile < 4; ++tile) {
        const u32x2 nb = *(const u32x2*)(ntb + ((wv * 4 + tile) * 64 + lane) * 4);
        const f32x4 g4 = *(const f32x4*)(gc + tile * 16 + 4 * q);
        f32x4 acc;
        acc[0] = g4[0] * X[tile][0] + LO16(nb.x); acc[1] = g4[1] * X[tile][1] + HI16(nb.x);
        acc[2] = g4[2] * X[tile][2] + LO16(nb.y); acc[3] = g4[3] * X[tile][3] + HI16(nb.y);
#pragma unroll
        for (int s2 = 0; s2 < 2; ++s2) {
            const bf16x8 ah = *(const bf16x8*)(mt + ((tile * 2 + s2) * 64 + lane) * 8);
            acc = MFMA16(ah, bh[s2], acc);
        }
        X[tile] = acc;
    }
}
__device__ __forceinline__ void rwkv_seq_job(const P& p, int job, char* smem) {
    const int tid = otid(), lane = tid & 63, wv = tid >> 6;
    const int d = job / RH, h = job % RH;
    f32x4 X[4];
#pragma unroll
    for (int kt = 0; kt < 4; ++kt) X[kt] = (f32x4){0.f, 0.f, 0.f, 0.f};
    u32x4 g0[5], g1[5], g2[5];
#define SEQ_BASE(s_) ((size_t)(d * NC + chunk_order(d, ((s_) < NC) ? (s_) : NC - 1)) * RH + h)
    __syncthreads();
    rwkv_seq_gload(p, SEQ_BASE(0), tid, g0);
    rwkv_seq_gload(p, SEQ_BASE(1), tid, g1);
    rwkv_seq_gload(p, SEQ_BASE(2), tid, g2);
    rwkv_seq_lstore(smem, tid, g0);
    __syncthreads();
    for (int s = 0; s < NC; s += 6) {
#define SEQ_SUB(u, GFREE, GNEXT) \
        if (s + (u) < NC) { \
            rwkv_seq_gload(p, SEQ_BASE(s + (u) + 3), tid, GFREE); \
            rwkv_seq_step(p, smem + (((u) & 1) ? SEQ_SLOT : 0), SEQ_BASE(s + (u)), wv, lane, X); \
            rwkv_seq_lstore(smem + (((u) & 1) ? 0 : SEQ_SLOT), tid, GNEXT); \
        } \
        __syncthreads();
        SEQ_SUB(0, g0, g1)
        SEQ_SUB(1, g1, g2)
        SEQ_SUB(2, g2, g0)
        SEQ_SUB(3, g0, g1)
        SEQ_SUB(4, g1, g2)
        SEQ_SUB(5, g2, g0)
#undef SEQ_SUB
    }
#undef SEQ_BASE
}
struct RoBuf { bf16x8 a[2]; bf16x8 b[4][2]; f32x4 y0[4]; };
__device__ __forceinline__ void rwkv_out_load(const P& p, int job, int wv, int lane, RoBuf& o) {
    const int q = lane >> 4, r = lane & 15;
    const size_t base = (size_t)job;
#pragma unroll
    for (int s2 = 0; s2 < 2; ++s2) {
        o.a[s2] = *(const bf16x8*)(p.QH + (base * 64 + 16 * wv + r) * 64 + s2 * 32 + q * 8);
#pragma unroll
        for (int nt = 0; nt < 4; ++nt) o.b[nt][s2] = *(const bf16x8*)(p.SN + (base * 64 + nt * 16 + r) * 64 + s2 * 32 + q * 8);
    }
#pragma unroll
    for (int nt = 0; nt < 4; ++nt) o.y0[nt] = *(const f32x4*)(p.Y0T + (((base * 4 + wv) * 4 + nt) * 64 + lane) * 4);
}
__device__ __forceinline__ void rwkv_out_compute(const P& p, int job, int wv, int lane, const RoBuf& o) {
    const int q = lane >> 4, r = lane & 15;
    const int d = job / (NC * RH), n = (job / RH) % NC, h = job % RH;
#pragma unroll
    for (int nt = 0; nt < 4; ++nt) {
        f32x4 acc = o.y0[nt];
        acc = MFMA16(o.a[0], o.b[nt][0], acc);
        acc = MFMA16(o.a[1], o.b[nt][1], acc);
#pragma unroll
        for (int e = 0; e < 4; ++e) {
            const int t = 16 * wv + 4 * q + e; const int tok = 64 * n + (d ? 63 - t : t);
            p.Y[((size_t)d * MTOT + tok) * RW + h * 64 + nt * 16 + r] = acc[e];
        }
    }
}
__device__ __forceinline__ void phase_rwkv_out(const P& p) {
    const int tid = otid(), lane = tid & 63, wv = tid >> 6;
    if (wv >= 4) return;
    const int G = gridDim.x, total = 2 * NC * RH;
    int job = obid();
    if (job >= total) return;
    RoBuf b0, b1;
    rwkv_out_load(p, job, wv, lane, b0);
    for (; job < total; job += 2 * G) {
        if (job + G < total) rwkv_out_load(p, job + G, wv, lane, b1);
        rwkv_out_compute(p, job, wv, lane, b0);
        if (job + G < total) {
            if (job + 2 * G < total) rwkv_out_load(p, job + 2 * G, wv, lane, b0);
            rwkv_out_compute(p, job + G, wv, lane, b1);
        }
    }
}

#define GL_QR 0
#define GL_KR 9216
#define GL_VT 18432
#define GL_QI 36864
#define GL_KI 46080
#define GL_AT 55296
#define GL_CUM 64512
#define GL_ALR 81920
#define GL_WA 86016
__device__ __forceinline__ void gla_load_qkv(const P& p, int n, int h, char* smem) {
    const int tid = otid();
    bf16_t* Qr = (bf16_t*)(smem + GL_QR); bf16_t* Kr = (bf16_t*)(smem + GL_KR); bf16_t* Vt = (bf16_t*)(smem + GL_VT);
    for (int c = tid; c < 512; c += NTHREADS) {
        const int row = c >> 3, part = c & 7; const int t = gla_tok(n, row);
        const u32x4 qv = *(const u32x4*)(p.Z + (size_t)t * ZLD + ZQ + h * 64 + part * 8);
        const u32x4 kv = *(const u32x4*)(p.Z + (size_t)t * ZLD + ZK + h * 64 + part * 8);
        u32x4 qs;
        qs.x = pack2bf(LO16(qv.x) * 0.125f, HI16(qv.x) * 0.125f);
        qs.y = pack2bf(LO16(qv.y) * 0.125f, HI16(qv.y) * 0.125f);
        qs.z = pack2bf(LO16(qv.z) * 0.125f, HI16(qv.z) * 0.125f);
        qs.w = pack2bf(LO16(qv.w) * 0.125f, HI16(qv.w) * 0.125f);
        *(u32x4*)(Qr + row * CH_ROW + part * 8) = qs;
        *(u32x4*)(Kr + row * CH_ROW + part * 8) = kv;
    }
    for (int c = tid; c < 1024; c += NTHREADS) {
        const int row = c >> 4, part = c & 15; const int t = gla_tok(n, row);
        const u32x4 vv = *(const u32x4*)(p.Z + (size_t)t * ZLD + ZV + h * 128 + part * 8);
        bf16_t* dst = Vt + (part * 8) * CH_ROW + row;
        dst[0 * CH_ROW] = (bf16_t)(vv.x & 0xFFFF); dst[1 * CH_ROW] = (bf16_t)(vv.x >> 16);
        dst[2 * CH_ROW] = (bf16_t)(vv.y & 0xFFFF); dst[3 * CH_ROW] = (bf16_t)(vv.y >> 16);
        dst[4 * CH_ROW] = (bf16_t)(vv.z & 0xFFFF); dst[5 * CH_ROW] = (bf16_t)(vv.z >> 16);
        dst[6 * CH_ROW] = (bf16_t)(vv.w & 0xFFFF); dst[7 * CH_ROW] = (bf16_t)(vv.w >> 16);
    }
}
__device__ __forceinline__ void gla_cum(const P& p, int l, int n, int h, int d, char* smem) {
    const int tid = otid();
    float* CUM = (float*)(smem + GL_CUM); float* ALR = (float*)(smem + GL_ALR); float* WA = (float*)(smem + GL_WA);
    for (int c = tid; c < 256; c += NTHREADS) {
        const int row = c >> 2, part = c & 3; const int t = gla_tok(n, row);
        const u32x2 a = *(const u32x2*)(p.Z + (size_t)t * ZLD + (d ? ZAB : ZAF) + part * 4);
        float* dst = ALR + row * 16 + part * 4;
        dst[0] = LO16(a.x); dst[1] = HI16(a.x); dst[2] = LO16(a.y); dst[3] = HI16(a.y);
    }
    for (int c = tid; c < 16 * 64 + 64; c += NTHREADS) {
        if (c < 1024) WA[c] = p.in[I_GLA_WA2][((size_t)(l * 2 + d) * 16 + (c >> 6)) * GLA_K + h * 64 + (c & 63)];
        else WA[c] = p.in[I_GLA_BA][(size_t)(l * 2 + d) * GLA_K + h * 64 + (c - 1024)];
    }
    __syncthreads();
    for (int idx = tid; idx < 4096; idx += NTHREADS) {
        const int i = idx >> 6, k = idx & 63;
        float a = WA[1024 + k];
#pragma unroll
        for (int r = 0; r < 16; ++r) a += ALR[i * 16 + r] * WA[r * 64 + k];
        CUM[i * 68 + k] = (fminf(a, 0.f) - flog_(1.0f + fexp_(-fabsf(a)))) * (1.0f / 16.0f);
    }
    __syncthreads();
    {
        const int k = tid & 63, seg = (tid >> 6) & 3;
        float v[16]; float run = 0.f;
        if (tid < 256) {
#pragma unroll
            for (int e = 0; e < 16; ++e) { const int pos = seg * 16 + e; const int i = d ? 63 - pos : pos; run += CUM[i * 68 + k]; v[e] = run; }
            ALR[seg * 64 + k] = run;
        }
        __syncthreads();
        if (tid < 256) {
            float off = 0.f;
            for (int s2 = 0; s2 < seg; ++s2) off += ALR[s2 * 64 + k];
#pragma unroll
            for (int e = 0; e < 16; ++e) { const int pos = seg * 16 + e; const int i = d ? 63 - pos : pos; CUM[i * 68 + k] = v[e] + off; }
        }
    }
    __syncthreads();
}
__device__ __forceinline__ void phase_gla_kv(const P& p, int l, char* smem) {
    const int tid = otid(), lane = tid & 63, wv = tid >> 6, q = lane >> 4, r = lane & 15;
    bf16_t* Kr = (bf16_t*)(smem + GL_KR); bf16_t* Vt = (bf16_t*)(smem + GL_VT); bf16_t* KdT = (bf16_t*)(smem + GL_KI);
    float* CUM = (float*)(smem + GL_CUM);
    for (int job = obid(); job < NC * GH; job += gridDim.x) {
        const int n = job / GH, h = job % GH;
        __syncthreads();
        gla_load_qkv(p, n, h, smem);
        for (int d = 0; d < 2; ++d) {
            gla_cum(p, l, n, h, d, smem);
            const int li = d ? 0 : 63;
            for (int idx = tid; idx < 4096; idx += NTHREADS) {
                const int i = idx >> 6, k = idx & 63;
                KdT[k * CH_ROW + i] = f2bf(bf2f(Kr[i * CH_ROW + k]) * fexp_(CUM[li * 68 + k] - CUM[i * 68 + k]));
            }
            if (tid < 64) p.DEC[((size_t)(d * NC + n) * GH + h) * 64 + tid] = fexp_(CUM[li * 68 + tid]);
            __syncthreads();
            float* kvt = p.KV + ((size_t)(d * NC + n) * GH + h) * 8192;
            for (int mt = wv; mt < 4; mt += NTHREADS / 64) {
                f32x4 acc[1][8];
#pragma unroll
                for (int nt = 0; nt < 8; ++nt) acc[0][nt] = (f32x4){0.f, 0.f, 0.f, 0.f};
                lds_mm<1, 8>(KdT, 16 * mt, Vt, 0, acc);
#pragma unroll
                for (int nt = 0; nt < 8; ++nt) *(f32x4*)(kvt + (size_t)(nt * 16 + r) * 64 + 16 * mt + 4 * q) = acc[0][nt];
            }
            __syncthreads();
        }
    }
    __syncthreads();
}
__device__ __forceinline__ void gla_scan_job(const P& p, int job) {
    const int base = job * NTHREADS + otid();
    const int d = base / (GH * 8192), h = (base / 8192) % GH, e = base % 8192;
    const float* __restrict__ kvp = p.KV; const float* __restrict__ decp = p.DEC; bf16_t* __restrict__ sp = p.SP;
    float S = 0.f;
    for (int s = 0; s < NC; s += 4) {
        float kv[4], dc[4]; size_t oo[4];
#pragma unroll
        for (int u = 0; u < 4; ++u) {
            const int n = chunk_order(d, (s + u < NC) ? s + u : NC - 1);
            oo[u] = ((size_t)(d * NC + n) * GH + h);
            kv[u] = kvp[oo[u] * 8192 + e]; dc[u] = decp[oo[u] * 64 + (e & 63)];
        }
#pragma unroll
        for (int u = 0; u < 4; ++u) if (s + u < NC) { sp[oo[u] * 8192 + e] = f2bf(S); S = dc[u] * S + kv[u]; }
    }
}
__device__ __forceinline__ void phase_gla_out(const P& p, int l, char* smem) {
    const int tid = otid(), lane = tid & 63, wv = tid >> 6, q = lane >> 4, r = lane & 15;
    bf16_t* Qr = (bf16_t*)(smem + GL_QR); bf16_t* Kr = (bf16_t*)(smem + GL_KR); bf16_t* Vt = (bf16_t*)(smem + GL_VT);
    bf16_t* Qi = (bf16_t*)(smem + GL_QI); bf16_t* Ki = (bf16_t*)(smem + GL_KI); bf16_t* At = (bf16_t*)(smem + GL_AT);
    float* CUM = (float*)(smem + GL_CUM);
    for (int job = obid(); job < NC * GH; job += gridDim.x) {
        const int n = job / GH, h = job % GH;
        __syncthreads();
        gla_load_qkv(p, n, h, smem);
        f32x4 o[1][8];
#pragma unroll
        for (int nt = 0; nt < 8; ++nt) o[0][nt] = (f32x4){0.f, 0.f, 0.f, 0.f};
        for (int d = 0; d < 2; ++d) {
            gla_cum(p, l, n, h, d, smem);
            for (int idx = tid; idx < 4096; idx += NTHREADS) {
                const int i = idx >> 6, k = idx & 63; const float c = CUM[i * 68 + k];
                Qi[i * CH_ROW + k] = f2bf(bf2f(Qr[i * CH_ROW + k]) * fexp_(c));
                Ki[i * CH_ROW + k] = f2bf(bf2f(Kr[i * CH_ROW + k]) * fexp_(-c));
            }
            __syncthreads();
            if (wv < 4) {
                f32x4 a[1][4];
#pragma unroll
                for (int nt = 0; nt < 4; ++nt) a[0][nt] = (f32x4){0.f, 0.f, 0.f, 0.f};
                lds_mm<1, 4>(Qi, 16 * wv, Ki, 0, a);
#pragma unroll
                for (int nt = 0; nt < 4; ++nt)
#pragma unroll
                    for (int e = 0; e < 4; ++e) {
                        const int i = 16 * wv + 4 * q + e, j = nt * 16 + r;
                        const bool ok = d ? (j >= i) : (j <= i);
                        At[i * CH_ROW + j] = f2bf(ok ? a[0][nt][e] : 0.f);
                    }
                WAVE_SYNC();
                lds_mm<1, 8>(At, 16 * wv, Vt, 0, o);
                const bf16_t* sp = p.SP + ((size_t)(d * NC + n) * GH + h) * 8192;
#pragma unroll
                for (int s2 = 0; s2 < 2; ++s2) {
                    const bf16x8 af = *(const bf16x8*)(Qi + (16 * wv + r) * CH_ROW + s2 * 32 + q * 8);
#pragma unroll
                    for (int nt = 0; nt < 8; ++nt) {
                        const bf16x8 bfr = *(const bf16x8*)(sp + (size_t)(nt * 16 + r) * 64 + s2 * 32 + q * 8);
                        o[0][nt] = MFMA16(af, bfr, o[0][nt]);
                    }
                }
            }
            __syncthreads();
        }
        if (wv < 4) {
#pragma unroll
            for (int nt = 0; nt < 8; ++nt)
#pragma unroll
                for (int e = 0; e < 4; ++e) {
                    const int t = gla_tok(n, 16 * wv + 4 * q + e);
                    p.OGLA[(size_t)t * GLA_V + h * 128 + nt * 16 + r] = o[0][nt][e];
                }
        }
    }
    __syncthreads();
}

#define S5_XH_OFF (2 * 64 * 132 * 4)
#define S5_XL_OFF (S5_XH_OFF + 64 * 136 * 2)
#define S5_CT_OFF (S5_XL_OFF + 64 * 136 * 2)
__device__ __forceinline__ void phase_s5_pass(const P& p, int l, char* smem, bool with_out) {
    const int tid = otid(), lane = tid & 63, wv = tid >> 6, q = lane >> 4, r = lane & 15;
    float* BU = (float*)smem; bf16_t* XH = (bf16_t*)(smem + S5_XH_OFF); bf16_t* XL = (bf16_t*)(smem + S5_XL_OFF); bf16_t* CTp = (bf16_t*)(smem + S5_CT_OFF);
    const int dW = (wv >> 1) & 1, ntb = (wv & 1) * 4;
    const int dS = (tid >> 6) & 1, st = tid & 63;
    bf16x8 bhi[4], blo[4];
    float are = 0.f, aim = 0.f, dco = 0.f;
    int cur_g = -1;
    const bf16x8 zero8 = {0, 0, 0, 0, 0, 0, 0, 0};
    bf16x8 a_cur[4]; float2 car_cur = {0.f, 0.f};
#define S5_FETCH(JOB, A, CAR) { const int n_ = (JOB) / SG, g_ = (JOB) % SG; \
        if (wv < 4) { _Pragma("unroll") for (int mt = 0; mt < 4; ++mt) A[mt] = (q < 2) ? *(const bf16x8*)(p.Z + (size_t)(n_ * 64 + 16 * mt + r) * ZLD + ZS5 + g_ * 16 + 8 * q) : zero8; } \
        if (with_out && tid < 128) CAR = *(const float2*)(p.S5CAR + ((((size_t)dS * NC + n_) * SG + g_) * 64 + st) * 2); }
    if (obid() < NC * SG) S5_FETCH(obid(), a_cur, car_cur);
    for (int job = obid(); job < NC * SG; job += gridDim.x) {
        const int n = job / SG, g = job % SG;
        __syncthreads();
        if (g != cur_g) {
            cur_g = g;
            if (wv < 4) {
#pragma unroll
                for (int jn = 0; jn < 4; ++jn) {
                    const int kk = 16 * (ntb + jn) + r; const size_t ci = ((size_t)dW * SG + g) * 64 + (kk >> 1);
                    float f[8], lo[8];
#pragma unroll
                    for (int e = 0; e < 8; ++e) f[e] = (q < 2) ? p.S5BB[(ci * 16 + 8 * q + e) * 2 + (kk & 1)] : 0.f;
                    const u32x4 hv = pack8(f);
                    float hf[8]; unpack8(hv, hf);
#pragma unroll
                    for (int e = 0; e < 8; ++e) lo[e] = f[e] - hf[e];
                    bhi[jn] = __builtin_bit_cast(bf16x8, hv); blo[jn] = __builtin_bit_cast(bf16x8, pack8(lo));
                }
            }
            if (tid < 128) { const size_t ci = ((size_t)dS * SG + g) * 64 + st; are = p.S5A[ci * 2]; aim = p.S5A[ci * 2 + 1]; }
            if (with_out) {
                for (int idx = tid; idx < 16 * 128; idx += NTHREADS) {
                    const int c = idx >> 7, kk = idx & 127;
                    const float v = (kk & 1) ? -p.in[I_S5CIM][((size_t)l * SG + g) * 1024 + c * 64 + (kk >> 1)] : p.in[I_S5CRE][((size_t)l * SG + g) * 1024 + c * 64 + (kk >> 1)];
                    CTp[c * 136 + kk] = f2bf(v);
                }
                dco = p.in[I_S5D][(size_t)l * SW + g * 16 + r];
            }
        }
        float xr = car_cur.x, xi = car_cur.y;
        const size_t eo = (((size_t)dS * NC + n) * SG + g) * 64 + st;
        unsigned short uu[4] = {0, 0, 0, 0};
        if (with_out && wv < 4) {
#pragma unroll
            for (int e = 0; e < 4; ++e) uu[e] = p.Z[(size_t)(n * 64 + 16 * wv + 4 * q + e) * ZLD + ZS5 + g * 16 + r];
        }
        if (wv < 4) {
#pragma unroll
            for (int mt = 0; mt < 4; ++mt) {
                const bf16x8 a = a_cur[mt];
#pragma unroll
                for (int jn = 0; jn < 4; ++jn) {
                    f32x4 acc = {0.f, 0.f, 0.f, 0.f};
                    acc = MFMA16(a, bhi[jn], acc);
                    acc = MFMA16(a, blo[jn], acc);
#pragma unroll
                    for (int e = 0; e < 4; ++e) BU[(dW * 64 + 16 * mt + 4 * q + e) * 132 + 16 * (ntb + jn) + r] = acc[e];
                }
            }
        }
        if (job + (int)gridDim.x < NC * SG) S5_FETCH(job + (int)gridDim.x, a_cur, car_cur);
        __syncthreads();
        if (tid < 128) {
            float2* bp0 = (float2*)(BU + (dS * 64 + (dS ? 63 : 0)) * 132 + st * 2);
#define S5_SCAN(SGN) { _Pragma("unroll 1") for (int ib = 0; ib < 4; ++ib) { float2 bv[16]; \
                _Pragma("unroll") for (int u = 0; u < 16; ++u) bv[u] = bp0[(SGN) * (ib * 16 + u) * 66]; \
                _Pragma("unroll") for (int u = 0; u < 16; ++u) { \
                    const float nr = are * xr - aim * xi + bv[u].x, ni = are * xi + aim * xr + bv[u].y; xr = nr; xi = ni; \
                    if (with_out) { float2 o; o.x = xr; o.y = xi; bp0[(SGN) * (ib * 16 + u) * 66] = o; } } } }
            if (dS) S5_SCAN(-1) else S5_SCAN(1)
            if (!with_out) { float2 o; o.x = xr; o.y = xi; *(float2*)(p.S5END + eo * 2) = o; }
        }
        if (with_out) {
            __syncthreads();
            for (int cidx = tid; cidx < 64 * 16; cidx += NTHREADS) {
                const int i = cidx >> 4, k0 = (cidx & 15) * 8;
                float a[8], b[8], lo[8];
                load8f(BU + (0 * 64 + i) * 132 + k0, a); load8f(BU + (1 * 64 + i) * 132 + k0, b);
#pragma unroll
                for (int e = 0; e < 8; ++e) a[e] += b[e];
                const u32x4 hv = pack8(a);
                float hf[8]; unpack8(hv, hf);
#pragma unroll
                for (int e = 0; e < 8; ++e) lo[e] = a[e] - hf[e];
                *(u32x4*)(XH + i * 136 + k0) = hv; *(u32x4*)(XL + i * 136 + k0) = pack8(lo);
            }
            __syncthreads();
            if (wv < 4) {
                f32x4 acc = {0.f, 0.f, 0.f, 0.f};
#pragma unroll
                for (int ks = 0; ks < 4; ++ks) {
                    const bf16x8 ah = *(const bf16x8*)(XH + (16 * wv + r) * 136 + ks * 32 + q * 8), al = *(const bf16x8*)(XL + (16 * wv + r) * 136 + ks * 32 + q * 8);
                    const bf16x8 b = *(const bf16x8*)(CTp + r * 136 + ks * 32 + q * 8);
                    acc = MFMA16(ah, b, acc);
                    acc = MFMA16(al, b, acc);
                }
#pragma unroll
                for (int e = 0; e < 4; ++e) {
                    const int i = 16 * wv + 4 * q + e;
                    const float u = bf2f(uu[e]);
                    p.GY[(size_t)(n * 64 + i) * SW + g * 16 + r] = f2bf(geluf_(acc[e] + dco * u));
                }
            }
        }
    }
    __syncthreads();
}
__device__ __forceinline__ void s5_carry_job(const P& p, int job) {
    const int base = job * NTHREADS + otid();
    if (base >= 2 * SG * 64) return;
    const int d = base / (SG * 64), g = (base / 64) % SG, st = base % 64;
    const size_t ci = ((size_t)d * SG + g) * 64 + st;
    float ar = p.S5A[ci * 2], ai = p.S5A[ci * 2 + 1];
    for (int i = 0; i < 6; ++i) { const float nr = ar * ar - ai * ai, ni = 2.f * ar * ai; ar = nr; ai = ni; }
    const float2* __restrict__ endp = (const float2*)p.S5END; float2* __restrict__ carp = (float2*)p.S5CAR;
    float cr = 0.f, cim = 0.f;
    for (int s = 0; s < NC; s += 4) {
        float2 ev[4]; size_t eo[4];
#pragma unroll
        for (int u = 0; u < 4; ++u) {
            const int n = chunk_order(d, (s + u < NC) ? s + u : NC - 1);
            eo[u] = (((size_t)d * NC + n) * SG + g) * 64 + st;
            ev[u] = endp[eo[u]];
        }
#pragma unroll
        for (int u = 0; u < 4; ++u) if (s + u < NC) {
            float2 c; c.x = cr; c.y = cim; carp[eo[u]] = c;
            const float nr = ar * cr - ai * cim + ev[u].x, ni = ar * cim + ai * cr + ev[u].y;
            cr = nr; cim = ni;
        }
    }
}

__device__ __forceinline__ void phase_side_elem(const P& p, int l) {
    const int lane = otid() & 63;
    const int gw = (obid() * NTHREADS + otid()) >> 6, nw = (gridDim.x * NTHREADS) >> 6;
    const bool actg = lane * 8 < GLA_V, actr = lane * 8 < RW;
    float gng[8], lnw[8], lnb[8];
#pragma unroll
    for (int e = 0; e < 8; ++e) { gng[e] = 0.f; lnw[e] = 0.f; lnb[e] = 0.f; }
    if (actg) load8f(p.in[I_GLA_NG] + (size_t)l * 128 + ((lane * 8) & 127), gng);
    if (actr) { load8f(p.in[I_RLNW] + (size_t)l * RW + lane * 8, lnw); load8f(p.in[I_RLNB] + (size_t)l * RW + lane * 8, lnb); }
    for (int t = gw; t < MTOT; t += nw) {
        float og[8], zo[8], y0[8], y1[8], vv[8];
        const u32x4 z4 = {0u, 0u, 0u, 0u};
#pragma unroll
        for (int e = 0; e < 8; ++e) { og[e] = 0.f; y0[e] = 0.f; y1[e] = 0.f; }
        if (actg) load8f(p.OGLA + (size_t)t * GLA_V + lane * 8, og);
        unpack8(actg ? *(const u32x4*)(p.Z + (size_t)t * ZLD + ZOG + lane * 8) : z4, zo);
        if (actr) { load8f(p.Y + (size_t)t * RW + lane * 8, y0); load8f(p.Y + ((size_t)MTOT + t) * RW + lane * 8, y1); }
        unpack8(actr ? *(const u32x4*)(p.V + (size_t)t * RW + lane * 8) : z4, vv);
        float g2v[8]; unpack8(actr ? *(const u32x4*)(p.G2B + (size_t)t * RW + lane * 8) : z4, g2v);
        const int hh = (lane * 8) >> 6;
        const float bon = actr ? (p.BONUS[(size_t)t * RH + hh] + p.BONUS[((size_t)MTOT + t) * RH + hh]) : 0.f;
        float ss = 0.f;
#pragma unroll
        for (int e = 0; e < 8; ++e) ss += og[e] * og[e];
        ss += __shfl_xor(ss, 1, 64); ss += __shfl_xor(ss, 2, 64); ss += __shfl_xor(ss, 4, 64); ss += __shfl_xor(ss, 8, 64);
        const float rstd = rsqrtf(ss * (1.0f / 128.f) + 1e-6f);
        float br[8];
#pragma unroll
        for (int e = 0; e < 8; ++e) br[e] = og[e] * rstd * gng[e] * siluf_(zo[e]);
        if (actg) *(u32x4*)(p.BR + (size_t)t * 3 * BW + lane * 8) = pack8(br);
        float y[8]; float sm = 0.f;
#pragma unroll
        for (int e = 0; e < 8; ++e) { y[e] = y0[e] + y1[e]; sm += y[e]; }
        sm += __shfl_xor(sm, 1, 64); sm += __shfl_xor(sm, 2, 64); sm += __shfl_xor(sm, 4, 64);
        const float mu = sm * (1.0f / 64.f);
        float sv = 0.f;
#pragma unroll
        for (int e = 0; e < 8; ++e) { y[e] -= mu; sv += y[e] * y[e]; }
        sv += __shfl_xor(sv, 1, 64); sv += __shfl_xor(sv, 2, 64); sv += __shfl_xor(sv, 4, 64);
        const float rs = rsqrtf(sv * (1.0f / 64.f) + 64e-5f);
        float yn[8];
#pragma unroll
        for (int e = 0; e < 8; ++e) yn[e] = y[e] * rs * lnw[e] + lnb[e] + bon * vv[e];
#pragma unroll
        for (int e = 0; e < 8; ++e) yn[e] *= g2v[e];
        if (actr) *(u32x4*)(p.BR + (size_t)t * 3 * BW + BW + lane * 8) = pack8(yn);
    }
}

__device__ __forceinline__ void g2_gemm_job(const P& p, int job, char* smem) {
    const int ntn = NPAD(RW) / 128;
    gemm_tile_run<4, 8>(p.WT_G2, 128, (size_t)NPAD(RW) * 128 * 2, p.GS, 128, (size_t)MTOT * 128 * 2, 128, (job % ntn) * 128, (job / ntn) * 256, (bf16_t*)smem, NoPre(),
        [&](int, int, int m, int n, const f32x4 v) { if (n < RW) *(u32x2*)(p.G2B + (size_t)m * RW + n) = pack4(v[0], v[1], v[2], v[3]); });
}
#define G2_JOBS ((MTOT / 256) * (NPAD(RW) / 128))
__device__ __forceinline__ void phase_glu_gemm(const P& p, int l, char* smem) {
    gemm_phase<4>(p.WT_GLU, SW, (size_t)NPAD(2 * SW) * SW * 2, p.GY, SW, (size_t)MTOT * SW * 2, SW, 2 * SW, (bf16_t*)smem, NoPre(), NoPre(),
        [&](int, int, int m, int n, const f32x4 v) {
            *(unsigned*)(p.BR + (size_t)m * 3 * BW + 2 * BW + (n >> 1)) = pack2bf(v[0] * sigmoidf_(v[1]), v[2] * sigmoidf_(v[3]));
        });
}
__device__ __forceinline__ void phase_merge(const P& p, int l, char* smem) {
    const int ntn = D_MODEL / 128, ntm = (MTOT - 256) / 128;
    auto run = [&](auto mi_tag, int n0, int m0) {
        constexpr int MI = decltype(mi_tag)::value;
        f32x4 macc[4][MI];
#pragma unroll
        for (int i = 0; i < 4; ++i)
#pragma unroll
            for (int j = 0; j < MI; ++j) macc[i][j] = (f32x4){0.f, 0.f, 0.f, 0.f};
        const int lane = otid() & 63, wave = otid() >> 6;
        for (int b = 0; b < 3; ++b) {
            f32x4 acc[4][MI];
#pragma unroll
            for (int i = 0; i < 4; ++i)
#pragma unroll
                for (int j = 0; j < MI; ++j) acc[i][j] = (f32x4){0.f, 0.f, 0.f, 0.f};
            mfma_gemm_tile_t<4, MI>(p.WT_BR + (size_t)b * D_MODEL * BW, BW, (size_t)D_MODEL * BW * 2, p.BR + b * BW, 3 * BW, (size_t)MTOT * 3 * BW * 2 - b * BW * 2, BW, n0, m0, (bf16_t*)smem, acc);
#pragma unroll
            for (int ni = 0; ni < 4; ++ni)
#pragma unroll
                for (int mi = 0; mi < MI; ++mi) {
                    const int n = n0 + (wave >> 1) * 64 + ni * 16 + (lane >> 4) * 4, m = m0 + (wave & 1) * 16 * MI + mi * 16 + (lane & 15);
                    const u32x2 g = *(const u32x2*)(p.ZGT + ((((size_t)(m >> 4) * (3 * D_MODEL / 16) + ((b * D_MODEL + n) >> 4)) * 64 + lane) * 4));
                    macc[ni][mi][0] += LO16(g.x) * acc[ni][mi][0]; macc[ni][mi][1] += HI16(g.x) * acc[ni][mi][1];
                    macc[ni][mi][2] += LO16(g.y) * acc[ni][mi][2]; macc[ni][mi][3] += HI16(g.y) * acc[ni][mi][3];
                }
        }
#pragma unroll
        for (int ni = 0; ni < 4; ++ni)
#pragma unroll
            for (int mi = 0; mi < MI; ++mi) {
                const int n = n0 + (wave >> 1) * 64 + ni * 16 + (lane >> 4) * 4, m = m0 + (wave & 1) * 16 * MI + mi * 16 + (lane & 15);
                *(u32x2*)(p.M + (size_t)m * D_MODEL + n) = pack4(macc[ni][mi][0], macc[ni][mi][1], macc[ni][mi][2], macc[ni][mi][3]);
            }
    };
    for (int it = 0;; ++it) {
        int mt_, nt_; if (!tile_map(it, ntm, ntn, (ntn >= 8) ? 4 : 8, mt_, nt_)) break;
        run(std::integral_constant<int, 4>(), nt_ * 128, mt_ * 128);
    }
    for (int job = obid(); job < 4 * ntn; job += gridDim.x) run(std::integral_constant<int, 2>(), (job >> 2) * 128, MTOT - 256 + (job & 3) * 64);
}

__device__ __forceinline__ void phase_outproj(const P& p, int l, char* smem) {
    gemm_phase<4>(p.WT_OUT, D_MODEL, (size_t)D_MODEL * D_MODEL * 2, p.M, D_MODEL, (size_t)MTOT * D_MODEL * 2, D_MODEL, D_MODEL, (bf16_t*)smem, NoPre(), NoPre(),
        [&](int, int, int m, int n, const f32x4 v) {
            const float* g1 = p.MOD + (size_t)(l * 2 + (m >= CTX ? 1 : 0)) * 6 * D_MODEL + 2 * D_MODEL + n;
            float4* xp = (float4*)(p.X + (size_t)m * D_MODEL + n); float4 x = *xp;
            x.x += g1[0] * v[0]; x.y += g1[1] * v[1]; x.z += g1[2] * v[2]; x.w += g1[3] * v[3]; *xp = x;
        });
}

__device__ __forceinline__ void store_q_hilo(const P& p, int m, int n, const f32x4 v) {
    const bf16_t h0 = f2bf(v[0]), h1 = f2bf(v[1]), h2 = f2bf(v[2]), h3 = f2bf(v[3]);
    u32x2 hv; hv.x = (unsigned)h0 | ((unsigned)h1 << 16); hv.y = (unsigned)h2 | ((unsigned)h3 << 16);
    *(u32x2*)(p.QHI + (size_t)m * PQ + n) = hv;
    *(u32x2*)(p.QLO + (size_t)m * PQ + n) = pack4(v[0] - bf2f(h0), v[1] - bf2f(h1), v[2] - bf2f(h2), v[3] - bf2f(h3));
}
__device__ __forceinline__ void phase_peer_q(const P& p, int l, char* smem) {
    gemm_phase<4>(p.WT_Q, D_MODEL, (size_t)PQ * D_MODEL * 2, p.H, D_MODEL, (size_t)MTOT * D_MODEL * 2, D_MODEL, PQ, (bf16_t*)smem, NoPre(), NoPre(),
        [&](int, int, int m, int n, const f32x4 v) { store_q_hilo(p, m, n, v); });
}

#define TK_ROW 129
__device__ __forceinline__ unsigned tk_key(float f, unsigned lowmask, unsigned low) {
    unsigned u = __builtin_bit_cast(unsigned, f);
    u ^= (u & 0x80000000u) ? 0xFFFFFFFFu : 0x80000000u;
    return (u & ~lowmask) | low;
}
#define TK_INSERT(lv, xk) { unsigned x_ = (xk); _Pragma("unroll") for (int z_ = 0; z_ < 16; ++z_) { const unsigned hi_ = lv[z_] > x_ ? lv[z_] : x_; x_ = lv[z_] > x_ ? x_ : lv[z_]; lv[z_] = hi_; } }
__device__ __forceinline__ void phase_peer_topk(const P& p, int l, char* smem) {
    const int tid = otid(), lane = tid & 63, wv = tid >> 6, q = lane >> 4, r = lane & 15;
    float* sc = (float*)smem + wv * (64 * TK_ROW);
    const int gw = (obid() * NTHREADS + tid) >> 6, nw = (gridDim.x * NTHREADS) >> 6;
    const float NEG = -3.0e38f;
    for (int job = gw; job < (MTOT / 32) * PH; job += nw) {
        const int t0 = (job / PH) * 32, h = job % PH;
#pragma unroll
        for (int sd = 0; sd < 2; ++sd) {
            f32x4 acc[2][8];
#pragma unroll
            for (int mt = 0; mt < 2; ++mt)
#pragma unroll
                for (int nt = 0; nt < 8; ++nt) acc[mt][nt] = (f32x4){0.f, 0.f, 0.f, 0.f};
#pragma unroll
            for (int ks = 0; ks < 4; ++ks) {
                bf16x8 ah[2], al[2];
#pragma unroll
                for (int mt = 0; mt < 2; ++mt) {
                    const size_t qo = (size_t)(t0 + mt * 16 + r) * PQ + h * 256 + sd * 128 + ks * 32 + q * 8;
                    ah[mt] = *(const bf16x8*)(p.QHI + qo); al[mt] = *(const bf16x8*)(p.QLO + qo);
                }
#pragma unroll
                for (int nt = 0; nt < 8; ++nt) {
                    const size_t ko = ((size_t)(h * 2 + sd) * 128 + nt * 16 + r) * 128 + ks * 32 + q * 8;
                    const bf16x8 bh = *(const bf16x8*)(p.KHI + ko), bl = *(const bf16x8*)(p.KLO + ko);
#pragma unroll
                    for (int mt = 0; mt < 2; ++mt) {
                        acc[mt][nt] = MFMA16(ah[mt], bh, acc[mt][nt]);
                        acc[mt][nt] = MFMA16(al[mt], bh, acc[mt][nt]);
                        acc[mt][nt] = MFMA16(ah[mt], bl, acc[mt][nt]);
                    }
                }
            }
#pragma unroll
            for (int mt = 0; mt < 2; ++mt)
#pragma unroll
                for (int nt = 0; nt < 8; ++nt)
#pragma unroll
                    for (int e = 0; e < 4; ++e) sc[(sd * 32 + mt * 16 + 4 * q + e) * TK_ROW + nt * 16 + r] = acc[mt][nt][e];
        }
        WAVE_SYNC();
        unsigned lv[16];
#pragma unroll
        for (int z = 0; z < 16; ++z) lv[z] = 0u;
        {
            const float* row = sc + lane * TK_ROW;
#pragma unroll 4
            for (int k = 0; k < 128; ++k) TK_INSERT(lv, tk_key(row[k], 0x7Fu, (unsigned)(127 - k)));
        }
        float lvv[16]; int li[16];
        {
            const float* row = sc + lane * TK_ROW;
#pragma unroll
            for (int z = 0; z < 16; ++z) { li[z] = 127 - (int)(lv[z] & 0x7Fu); lvv[z] = row[li[z]]; }
        }
        WAVE_SYNC();
        {
            float* row = sc + lane * TK_ROW;
#pragma unroll
            for (int z = 0; z < 16; ++z) { row[z] = lvv[z]; ((int*)row)[16 + z] = li[z]; }
        }
        WAVE_SYNC();
        const float* r1 = sc + (lane & 31) * TK_ROW; const float* r2 = sc + (32 + (lane & 31)) * TK_ROW;
        unsigned tk[16];
#pragma unroll
        for (int z = 0; z < 16; ++z) tk[z] = 0u;
        for (int i = 0; i < 16; ++i) {
            const float a = r1[i];
            const int nj = 16 / (i + 1);
            for (int j = 0; j < nj; ++j) TK_INSERT(tk, tk_key(a + r2[j], 0xFFu, (unsigned)(255 - (i * 16 + j))));
        }
        int tc[16];
#pragma unroll
        for (int z = 0; z < 16; ++z) tc[z] = 255 - (int)(tk[z] & 0xFFu);
        if (lane < 32) {
            float vals[16]; float mx = 0.f; float ssum = 0.f;
#pragma unroll
            for (int z = 0; z < 16; ++z) { vals[z] = r1[tc[z] >> 4] + r2[tc[z] & 15]; if (z == 0) mx = vals[0]; vals[z] = fexp_(vals[z] - mx); ssum += vals[z]; }
            const float inv = 1.0f / ssum;
            const size_t o = (size_t)(t0 + lane) * PH * 16 + h * 16;
#pragma unroll
            for (int z = 0; z < 16; ++z) {
                const int ex_ = ((const int*)r1)[16 + (tc[z] >> 4)] * 128 + ((const int*)r2)[16 + (tc[z] & 15)];
                p.IDX[o + z] = ex_;
                p.G[o + z] = vals[z] * inv * p.VSC[ex_];
                p.GU[o + z] = p.USC[ex_];
            }
        }
        WAVE_SYNC();
    }
}

#define PEER_CONV_JOBS (2 * NEXP / 4)
__device__ __forceinline__ void peer_conv_job(const P& p, int l, int job) {
    const int tid = otid(), lane = tid & 63, wv = tid >> 6;
    if (wv >= 4) return;
    const int rowg = job * 4 + wv; const int which = rowg / NEXP, row = rowg % NEXP;
    const float* src = p.in[which ? I_PV : I_PU] + ((size_t)l * NEXP + row) * D_MODEL + lane * 16;
    const bool act = lane * 16 < D_MODEL;
    float v[16]; float amax = 0.f;
#pragma unroll
    for (int c = 0; c < 4; ++c) {
        float4 a; a.x = 0.f; a.y = 0.f; a.z = 0.f; a.w = 0.f;
        if (act) a = *(const float4*)(src + c * 4);
        v[c * 4 + 0] = a.x; v[c * 4 + 1] = a.y; v[c * 4 + 2] = a.z; v[c * 4 + 3] = a.w;
        amax = fmaxf(amax, fmaxf(fmaxf(fabsf(a.x), fabsf(a.y)), fmaxf(fabsf(a.z), fabsf(a.w))));
    }
#pragma unroll
    for (int m = 32; m >= 1; m >>= 1) amax = fmaxf(amax, __shfl_xor(amax, m, 64));
    int ex = 0;
    if (amax > 0.f) ex = 7 - (int)((__builtin_bit_cast(unsigned, amax) >> 23) & 0xFF) + 127;
    ex = ex < -100 ? -100 : (ex > 100 ? 100 : ex);
    const float sc = __builtin_bit_cast(float, (unsigned)(ex + 127) << 23), isc = __builtin_bit_cast(float, (unsigned)(127 - ex) << 23);
    u32x4 o;
    int w0 = 0, w1 = 0, w2 = 0, w3 = 0;
    w0 = CVT_PK_FP8(v[0] * sc, v[1] * sc, w0, false); w0 = CVT_PK_FP8(v[2] * sc, v[3] * sc, w0, true);
    w1 = CVT_PK_FP8(v[4] * sc, v[5] * sc, w1, false); w1 = CVT_PK_FP8(v[6] * sc, v[7] * sc, w1, true);
    w2 = CVT_PK_FP8(v[8] * sc, v[9] * sc, w2, false); w2 = CVT_PK_FP8(v[10] * sc, v[11] * sc, w2, true);
    w3 = CVT_PK_FP8(v[12] * sc, v[13] * sc, w3, false); w3 = CVT_PK_FP8(v[14] * sc, v[15] * sc, w3, true);
    o.x = (unsigned)w0; o.y = (unsigned)w1; o.z = (unsigned)w2; o.w = (unsigned)w3;
    unsigned char* dst = (which ? p.V8 : p.U8) + (size_t)row * D_MODEL + lane * 16;
    if (act) *(u32x4*)dst = o;
    if (lane == 0) (which ? p.VSC : p.USC)[row] = isc;
}
#define GE 4
struct GBuf { u32x4 u[GE]; u32x4 v[GE]; float gu; float gv; };
__device__ __forceinline__ void gather_load(const P& p, GBuf& b, int g, int idx0, int idx1, float g0, float g1, float u0, float u1, int lane) {
    const bool act = lane * 16 < D_MODEL;
#pragma unroll
    for (int q = 0; q < GE; ++q) {
        const int k = g * GE + q;
        const int ei = __shfl((k < 64) ? idx0 : idx1, k & 63, 64);
        b.u[q] = act ? *(const u32x4*)(p.U8 + (size_t)ei * D_MODEL + lane * 16) : (u32x4){0u, 0u, 0u, 0u};
        b.v[q] = act ? *(const u32x4*)(p.V8 + (size_t)ei * D_MODEL + lane * 16) : (u32x4){0u, 0u, 0u, 0u};
    }
    const int km = g * GE + ((lane >> 4) & 3);
    b.gv = __shfl((km < 64) ? g0 : g1, km & 63, 64);
    b.gu = __shfl((km < 64) ? u0 : u1, km & 63, 64);
}
__device__ __forceinline__ void gather_compute(const GBuf& b, const float (&hv)[16], float (&acc)[16], int lane) {
    float dt[GE];
#pragma unroll
    for (int q = 0; q < GE; ++q) {
        float d = 0.f;
#pragma unroll
        for (int c = 0; c < 4; ++c) {
            const f32x2 lo = CVT_PK_F32_FP8((int)b.u[q][c], false), hi = CVT_PK_F32_FP8((int)b.u[q][c], true);
            d += hv[c * 4 + 0] * lo.x + hv[c * 4 + 1] * lo.y + hv[c * 4 + 2] * hi.x + hv[c * 4 + 3] * hi.y;
        }
        dt[q] = d;
    }
    float r2[2], r1;
    {
        const bool up = (lane & 32) != 0;
#pragma unroll
        for (int q = 0; q < 2; ++q) { const float keep = up ? dt[2 + q] : dt[q], send = up ? dt[q] : dt[2 + q]; r2[q] = keep + __shfl_xor(send, 32, 64); }
    }
    {
        const bool up = (lane & 16) != 0;
        const float keep = up ? r2[1] : r2[0], send = up ? r2[0] : r2[1];
        r1 = keep + __shfl_xor(send, 16, 64);
    }
    r1 += __shfl_xor(r1, 8, 64); r1 += __shfl_xor(r1, 4, 64); r1 += __shfl_xor(r1, 2, 64); r1 += __shfl_xor(r1, 1, 64);
    const float coef_mine = b.gv * geluf_(r1 * b.gu);
#pragma unroll
    for (int q = 0; q < GE; ++q) {
        const float coef = __shfl(coef_mine, q * 16, 64);
#pragma unroll
        for (int c = 0; c < 4; ++c) {
            const f32x2 lo = CVT_PK_F32_FP8((int)b.v[q][c], false), hi = CVT_PK_F32_FP8((int)b.v[q][c], true);
            acc[c * 4 + 0] += coef * lo.x; acc[c * 4 + 1] += coef * lo.y; acc[c * 4 + 2] += coef * hi.x; acc[c * 4 + 3] += coef * hi.y;
        }
    }
}
__device__ __forceinline__ void phase_peer_gather(const P& p, int l) {
    const int lane = otid() & 63;
    const int gw = (obid() * NTHREADS + otid()) >> 6, nw = (gridDim.x * NTHREADS) >> 6;
    constexpr int NG = PH * 16 / GE;
    const bool act = lane * 16 < D_MODEL;
    for (int t = gw; t < MTOT; t += nw) {
        float hv[16], acc[16];
        {
            const u32x4 z4 = {0u, 0u, 0u, 0u};
            const u32x4 ha = act ? *(const u32x4*)(p.H + (size_t)t * D_MODEL + lane * 16) : z4;
            const u32x4 hb = act ? *(const u32x4*)(p.H + (size_t)t * D_MODEL + lane * 16 + 8) : z4;
            hv[0] = LO16(ha.x); hv[1] = HI16(ha.x); hv[2] = LO16(ha.y); hv[3] = HI16(ha.y); hv[4] = LO16(ha.z); hv[5] = HI16(ha.z); hv[6] = LO16(ha.w); hv[7] = HI16(ha.w);
            hv[8] = LO16(hb.x); hv[9] = HI16(hb.x); hv[10] = LO16(hb.y); hv[11] = HI16(hb.y); hv[12] = LO16(hb.z); hv[13] = HI16(hb.z); hv[14] = LO16(hb.w); hv[15] = HI16(hb.w);
#pragma unroll
            for (int j = 0; j < 16; ++j) acc[j] = 0.f;
        }
        int idx0 = 0, idx1 = 0; float g0 = 0.f, g1 = 0.f, u0 = 0.f, u1 = 0.f;
        if (lane < PH * 16) { idx0 = p.IDX[(size_t)t * PH * 16 + lane]; g0 = p.G[(size_t)t * PH * 16 + lane]; u0 = p.GU[(size_t)t * PH * 16 + lane]; }
        if (64 + lane < PH * 16) { idx1 = p.IDX[(size_t)t * PH * 16 + 64 + lane]; g1 = p.G[(size_t)t * PH * 16 + 64 + lane]; u1 = p.GU[(size_t)t * PH * 16 + 64 + lane]; }
        GBuf b0, b1, b2;
        gather_load(p, b0, 0, idx0, idx1, g0, g1, u0, u1, lane);
        gather_load(p, b1, 1, idx0, idx1, g0, g1, u0, u1, lane);
        for (int g = 0; g < NG; g += 3) {
            if (g + 2 < NG) gather_load(p, b2, g + 2, idx0, idx1, g0, g1, u0, u1, lane);
            gather_compute(b0, hv, acc, lane);
            if (g + 1 < NG) {
                if (g + 3 < NG) gather_load(p, b0, g + 3, idx0, idx1, g0, g1, u0, u1, lane);
                gather_compute(b1, hv, acc, lane);
            }
            if (g + 2 < NG) {
                if (g + 4 < NG) gather_load(p, b1, g + 4, idx0, idx1, g0, g1, u0, u1, lane);
                gather_compute(b2, hv, acc, lane);
            }
        }
        float xn[16]; float ss = 0.f;
#pragma unroll
        for (int j = 0; j < 16; ++j) xn[j] = 0.f;
        if (act) {
            const float* g2 = p.MOD + (size_t)(l * 2 + (t >= CTX ? 1 : 0)) * 6 * D_MODEL + 5 * D_MODEL + lane * 16;
            float* xp = p.X + (size_t)t * D_MODEL + lane * 16;
#pragma unroll
            for (int c = 0; c < 4; ++c) {
                float4 x = *(float4*)(xp + c * 4);
                x.x += g2[c * 4 + 0] * acc[c * 4 + 0]; x.y += g2[c * 4 + 1] * acc[c * 4 + 1]; x.z += g2[c * 4 + 2] * acc[c * 4 + 2]; x.w += g2[c * 4 + 3] * acc[c * 4 + 3];
                if (l + 1 < DEPTH) *(float4*)(xp + c * 4) = x;
                xn[c * 4 + 0] = x.x; xn[c * 4 + 1] = x.y; xn[c * 4 + 2] = x.z; xn[c * 4 + 3] = x.w;
                ss += x.x * x.x + x.y * x.y + x.z * x.z + x.w * x.w;
            }
        }
        ss = wave_sum(ss);
        const float rstd = rsqrtf(ss / D_MODEL + 1e-6f);
        if (act) {
            if (l + 1 < DEPTH) {
                const float* gn = p.in[I_N1G] + (size_t)(l + 1) * D_MODEL + lane * 16;
                const float* mod = p.MOD + (size_t)((l + 1) * 2 + (t >= CTX ? 1 : 0)) * 6 * D_MODEL + lane * 16;
                float o[16];
#pragma unroll
                for (int j = 0; j < 16; ++j) o[j] = xn[j] * rstd * gn[j] * (1.0f + mod[D_MODEL + j]) + mod[j];
                u32x4 w0, w1;
                w0.x = pack2bf(o[0], o[1]); w0.y = pack2bf(o[2], o[3]); w0.z = pack2bf(o[4], o[5]); w0.w = pack2bf(o[6], o[7]);
                w1.x = pack2bf(o[8], o[9]); w1.y = pack2bf(o[10], o[11]); w1.z = pack2bf(o[12], o[13]); w1.w = pack2bf(o[14], o[15]);
                *(u32x4*)(p.H + (size_t)t * D_MODEL + lane * 16) = w0; *(u32x4*)(p.H + (size_t)t * D_MODEL + lane * 16 + 8) = w1;
            } else if (t >= CTX) {
                const float* fg = p.in[I_FG] + lane * 16;
                float* op = p.out + (size_t)(t - CTX) * D_MODEL + lane * 16;
#pragma unroll
                for (int c = 0; c < 4; ++c) {
                    float4 o; o.x = xn[c * 4 + 0] * rstd * fg[c * 4 + 0]; o.y = xn[c * 4 + 1] * rstd * fg[c * 4 + 1]; o.z = xn[c * 4 + 2] * rstd * fg[c * 4 + 2]; o.w = xn[c * 4 + 3] * rstd * fg[c * 4 + 3];
                    *(float4*)(op + c * 4) = o;
                }
            }
        }
    }
}
__device__ __forceinline__ void phase_final(const P& p) {
    const int lane = otid() & 63;
    const int gw = (obid() * NTHREADS + otid()) >> 6, nw = (gridDim.x * NTHREADS) >> 6;
    const float* g = p.in[I_FG];
    for (int t = gw; t < SEQ; t += nw) {
        const float* x = p.X + (size_t)(CTX + t) * D_MODEL;
        float v[D_MODEL / 64]; float ss = 0.f;
#pragma unroll
        for (int j = 0; j < D_MODEL / 64; ++j) { v[j] = x[lane + 64 * j]; ss += v[j] * v[j]; }
        ss = wave_sum(ss);
        float rstd = rsqrtf(ss / D_MODEL + 1e-6f);
#pragma unroll
        for (int j = 0; j < D_MODEL / 64; ++j) p.out[(size_t)t * D_MODEL + lane + 64 * j] = v[j] * rstd * g[lane + 64 * j];
    }
}

__global__ void __launch_bounds__(NTHREADS) fwd_megakernel(P p_arg) {
#ifdef EMU
    char* smem = emu_smem();
#else
    __shared__ __attribute__((aligned(16))) char smem_raw[SMEM_BYTES + 16];
    char* smem = smem_raw;
#endif
#ifndef EMU
    volatile LAS unsigned* xst = (volatile LAS unsigned*)(smem_raw + SMEM_BYTES);
    if (threadIdx.x == 0) { xst[0] = 0u; xst[1] = 0u; xst[2] = 0u; xst[3] = 0u; }
    __syncthreads();
    XcdBarrier xb = xcd_barrier_post(p_arg.bar, xst);
#endif
    { LOADP(); phase_init(p, smem); }
#ifndef EMU
    GRID_SYNC_CG();
#endif
#ifdef EMU
    GRID_SYNC();
#endif
#ifndef EMU
    if (threadIdx.x == 0) {
        unsigned base_ = 0;
        for (unsigned j = 0; j < xb.x; ++j) base_ += xb_ld(&p_arg.bar[XB_XCNT(j)]);
        xst[2] = base_ + xst[3];
    }
    __syncthreads();
#endif
    PROBE_INIT();
    for (int l = 0; l < DEPTH; ++l) {
        if (l == 0) {
            { LOADP(); phase_norm(p, 0, 0); }
            { LOADP(); phase_s5const(p, 0); }
            { LOADP(); phase_convert_weights(p, 0, smem, obid(), (int)gridDim.x); }
            GRID_SYNC(); PROBE_AFTER(0);
        }
        { LOADP(); phase_gemm_in(p, l, smem); }
        GRID_SYNC(); PROBE_AFTER(1);
        { LOADP(); phase_rwkv_prep1(p, l); }
        GRID_SYNC(); PROBE_AFTER(14);
        { LOADP(); phase_rwkv_prep2(p, l, smem); }
        GRID_SYNC(); PROBE_AFTER(2);
        { LOADP(); for (int job = obid(); job < 2 * NC * RH; job += gridDim.x) rwkv_chunk_job(p, job, smem); }
        __syncthreads(); PROBE_AFTER(20);
        { LOADP(); phase_gla_kv(p, l, smem); }
        PROBE_AFTER(21);
        { LOADP(); phase_s5_pass(p, l, smem, false); }
        GRID_SYNC(); PROBE_AFTER(3);
        {
            LOADP();
            const int n_rw = 2 * RH, n_gla = 2 * GH * 8192 / NTHREADS, n_s5 = (2 * SG * 64 + NTHREADS - 1) / NTHREADS;
            const int G_ = (int)gridDim.x;
            if (G_ > 2 * n_rw) {
                if (obid() < n_rw) { rwkv_seq_job(p, obid(), smem); PROBE_AFTER(24); }
                else {
                    const int nb = G_ - n_rw, bid = obid() - n_rw;
                    for (int job = bid; job < n_gla + n_s5 + PEER_CONV_JOBS; job += nb) {
                        if (job < n_gla) gla_scan_job(p, job);
                        else if (job < n_gla + n_s5) s5_carry_job(p, job - n_gla);
                        else peer_conv_job(p, l, job - n_gla - n_s5);
                    }
                    { P pg = p; late_select(pg, l & 1); for (int job = bid; job < G2_JOBS; job += nb) g2_gemm_job(pg, job, smem); }
                    if (l + 1 < DEPTH) { late_select(p, (l + 1) & 1); phase_convert_weights(p, l + 1, smem, bid, nb); }
                }
            } else {
                for (int job = obid(); job < n_rw + n_gla + n_s5 + PEER_CONV_JOBS; job += G_) {
                    if (job < n_rw) rwkv_seq_job(p, job, smem);
                    else if (job < n_rw + n_gla) gla_scan_job(p, job - n_rw);
                    else if (job < n_rw + n_gla + n_s5) s5_carry_job(p, job - n_rw - n_gla);
                    else peer_conv_job(p, l, job - n_rw - n_gla - n_s5);
                }
                __syncthreads();
                { P pg = p; late_select(pg, l & 1); for (int job = obid(); job < G2_JOBS; job += G_) g2_gemm_job(pg, job, smem); }
                if (l + 1 < DEPTH) { late_select(p, (l + 1) & 1); phase_convert_weights(p, l + 1, smem, obid(), G_); }
            }
        }
        GRID_SYNC(); PROBE_AFTER(4);
        { LOADP(); phase_rwkv_out(p); }
        PROBE_AFTER(22);
        { LOADP(); phase_gla_out(p, l, smem); }
        PROBE_AFTER(23);
        { LOADP(); phase_s5_pass(p, l, smem, true); }
        GRID_SYNC(); PROBE_AFTER(5);
        { LOADP(); phase_side_elem(p, l); }
        if (l + 1 < DEPTH) { LOADP(); phase_s5const(p, l + 1); }
        { LOADP(); late_select(p, l & 1); phase_glu_gemm(p, l, smem); }
        GRID_SYNC(); PROBE_AFTER(7);
        { LOADP(); late_select(p, l & 1); phase_merge(p, l, smem); }
        GRID_SYNC(); PROBE_AFTER(8);
        { LOADP(); late_select(p, l & 1); phase_outproj(p, l, smem); }
        GRID_SYNC(); PROBE_AFTER(9);
        { LOADP(); phase_norm(p, l, 1); }
        GRID_SYNC(); PROBE_AFTER(10);
        { LOADP(); late_select(p, l & 1); phase_peer_q(p, l, smem); }
        GRID_SYNC(); PROBE_AFTER(11);
        { LOADP(); late_select(p, l & 1); phase_peer_topk(p, l, smem); }
        GRID_SYNC(); PROBE_AFTER(12);
        { LOADP(); phase_peer_gather(p, l); }
        if (l + 1 < DEPTH) { GRID_SYNC(); PROBE_AFTER(13); }
    }
}

static inline size_t align_up(size_t x) { return (x + 255) & ~(size_t)255; }

extern "C" void kernel_launch(void* const* d_in, const int* in_sizes, int n_in, void* d_out, int out_size, void* d_ws, size_t ws_size, hipStream_t stream) {
    P p;
    memset(&p, 0, sizeof(p));
    for (int i = 0; i < 39; ++i) p.in[i] = (const float*)d_in[i];
    p.out = (float*)d_out;
    char* w = (char*)d_ws; size_t off = 0;
    auto take = [&](size_t bytes) { void* r = w + off; off = align_up(off + bytes); return r; };
    p.bar = (unsigned*)take(16384);
    p.X = (float*)take((size_t)MTOT * D_MODEL * 4);
    p.H = (bf16_t*)take((size_t)MTOT * D_MODEL * 2);
    p.MOD = (float*)take((size_t)DEPTH * 2 * 6 * D_MODEL * 4);
    p.Z = (bf16_t*)take((size_t)MTOT * ZLD * 2);
    p.ZGT = (bf16_t*)take((size_t)MTOT * 3 * D_MODEL * 2);
    p.V = (bf16_t*)take((size_t)MTOT * RW * 2);
    {
        char* ra = (char*)take((size_t)MTOT * RW * 2 * 2 > (size_t)MTOT * GLA_V * 4 ? (size_t)MTOT * RW * 2 * 2 : (size_t)MTOT * GLA_V * 4);
        p.R = (bf16_t*)ra; p.KK = (bf16_t*)(ra + (size_t)MTOT * RW * 2);
        p.OGLA = (float*)ra;
    }
    {
        char* rb = (char*)take((size_t)2 * MTOT * RW * 2 > (size_t)3 * MTOT * PH * 16 * 4 ? (size_t)2 * MTOT * RW * 2 : (size_t)3 * MTOT * PH * 16 * 4);
        p.KD = (bf16_t*)rb;
        p.IDX = (int*)rb; p.G = (float*)(rb + (size_t)MTOT * PH * 16 * 4); p.GU = (float*)(rb + (size_t)2 * MTOT * PH * 16 * 4);
    }
    p.BB = (bf16_t*)take((size_t)2 * MTOT * RW * 2);
    p.G2B = p.BB;
    p.LW = (float*)take((size_t)2 * MTOT * RW * 4);
    p.SP = (bf16_t*)p.LW;
    static_assert((size_t)2 * NC * GH * 8192 * 2 <= (size_t)2 * MTOT * RW * 4, "SP alias");
    p.BONUS = (float*)take((size_t)2 * MTOT * RH * 4);
    p.KS = (bf16_t*)take((size_t)MTOT * RW * 2);
    p.LR = (bf16_t*)take((size_t)MTOT * 256 * 2);
    p.WT_W2 = (bf16_t*)take((size_t)2 * NPAD(RW) * 64 * 2);
    p.WT_A2 = (bf16_t*)take((size_t)2 * NPAD(RW) * 64 * 2);
    p.GS = (bf16_t*)take((size_t)MTOT * 128 * 2);
    p.Y = (float*)take((size_t)2 * MTOT * RW * 4);
    p.Y0T = (float*)take((size_t)2 * NC * RH * 4096 * 4);
    p.KV = (float*)take((size_t)2 * NC * GH * 8192 * 4);
    p.DEC = (float*)take((size_t)2 * NC * GH * 64 * 4);
    p.S5A = (float*)take((size_t)2 * SG * 64 * 2 * 4);
    p.S5BB = (float*)take((size_t)2 * SG * 64 * 16 * 2 * 4);
    p.S5END = (float*)take((size_t)2 * NC * SG * 64 * 2 * 4);
    p.S5CAR = (float*)take((size_t)2 * NC * SG * 64 * 2 * 4);
    {
        const size_t szc1 = (size_t)2 * NC * RH * SEQ_REC;
        const size_t szc2 = (size_t)MTOT * SW * 2 + (size_t)MTOT * RW * 4 + (size_t)MTOT * 3 * BW * 2 + (size_t)MTOT * D_MODEL * 2 + 1024;
        char* rc = (char*)take(szc1 > szc2 ? szc1 : szc2);
        p.REC = rc;
        char* c2 = rc;
        p.GY = (bf16_t*)c2; c2 += align_up((size_t)MTOT * SW * 2);
        p.YN = (float*)c2; c2 += align_up((size_t)MTOT * RW * 4);
        p.BR = (bf16_t*)c2; c2 += align_up((size_t)MTOT * 3 * BW * 2);
        p.M = (bf16_t*)c2;
    }
    p.SN = (bf16_t*)take((size_t)2 * NC * RH * 4096 * 2);
    p.QH = (bf16_t*)take((size_t)2 * NC * RH * 4096 * 2);
    p.WT_IN = (bf16_t*)take((size_t)NPAD192(D_IN) * D_MODEL * 2);
    {
        char* lb = (char*)take(2 * LATE_BYTES); size_t lo = 0;
        auto ltake = [&](size_t bytes) { void* r = lb + lo; lo = AL256(lo + bytes); return r; };
        p.WT_G2 = (bf16_t*)ltake((size_t)NPAD(RW) * 128 * 2);
        p.WT_GLU = (bf16_t*)ltake((size_t)NPAD(2 * SW) * SW * 2);
        p.WT_BR = (bf16_t*)ltake((size_t)3 * D_MODEL * BW * 2);
        p.WT_OUT = (bf16_t*)ltake((size_t)D_MODEL * D_MODEL * 2);
        p.WT_Q = (bf16_t*)ltake((size_t)PQ * D_MODEL * 2);
        p.KHI = (bf16_t*)ltake((size_t)PH * 2 * 128 * 128 * 2); p.KLO = (bf16_t*)ltake((size_t)PH * 2 * 128 * 128 * 2);
        if (lo != LATE_BYTES) fprintf(stderr, "late weights layout mismatch\n");
    }
    p.U8 = (unsigned char*)take((size_t)NEXP * D_MODEL);
    p.V8 = (unsigned char*)take((size_t)NEXP * D_MODEL);
    p.USC = (float*)take((size_t)NEXP * 4); p.VSC = (float*)take((size_t)NEXP * 4);
    p.QHI = p.Z; p.QLO = p.Z + (size_t)MTOT * PQ;
    static_assert((size_t)PQ * 4 <= (size_t)D_IN * 2 && ((size_t)MTOT * ZLD * 2) % 256 == 0, "Q alias");
    if (off > ws_size) { fprintf(stderr, "ws too small: need %zu have %zu\n", off, ws_size); return; }
#ifdef EMU
    fprintf(stderr, "ws used %zu MB\n", off >> 20);
    emu_launch([=] { fwd_megakernel(p); }, EMU_GRID, NTHREADS);
#else
    hipMemsetAsync(p.bar, 0, 16384, stream);
    static int grid_blocks = 0;
    if (!grid_blocks) {
        int dev = 0, cus = 0, per_cu = 0;
        hipGetDevice(&dev);
        hipDeviceGetAttribute(&cus, hipDeviceAttributeMultiprocessorCount, dev);
        hipOccupancyMaxActiveBlocksPerMultiprocessor(&per_cu, fwd_megakernel, NTHREADS, 0);
        if (per_cu > 1) per_cu = 1;
        grid_blocks = cus * per_cu;
    }
    void* args[] = {&p};
    hipError_t e = hipLaunchCooperativeKernel((void*)fwd_megakernel, dim3(grid_blocks), dim3(NTHREADS), args, 0, stream);
    if (e != hipSuccess) fprintf(stderr, "cooperative launch failed: %s (grid %d)\n", hipGetErrorString(e), grid_blocks);
#endif
}
```

```cpp
#include <hip/hip_runtime.h>
#ifndef EMU
#include <hip/hip_cooperative_groups.h>
namespace cg = cooperative_groups;
#endif
#include <cstdio>
#include <cstdint>
#include <cstring>
#include <type_traits>

#ifdef CFG_SMALL
#define D_MODEL 128
#define SEQ 640
#define DEPTH 2
#define GRID_W 10
#define CTX 128
#define GH 1
#define RH 2
#define SG 8
#define PH 2
#else
#define D_MODEL 1024
#define SEQ 16384
#define DEPTH 4
#define GRID_W 64
#define CTX 256
#define GH 4
#define RH 8
#define SG 32
#define PH 8
#endif
#define MTOT (CTX + SEQ)
#define ROWS (SEQ / GRID_W)
#define GLA_K (GH * 64)
#define GLA_V (GH * 128)
#define RW (RH * 64)
#define RWKV_IN (3 * RW + 4 * 64 + 128)
#define SW (SG * 16)
#define BW GLA_V
#define ZQ 0
#define ZK (GLA_K)
#define ZV (2 * GLA_K)
#define ZOG (ZV + GLA_V)
#define ZAF (ZOG + GLA_V)
#define ZAB (ZAF + 16)
#define ZR (ZAB + 16)
#define ZS5 (ZR + RWKV_IN)
#define ZG (ZS5 + SW)
#define D_IN (ZG + 3 * D_MODEL)
#define ZLD ZG
#define NC (MTOT / 64)
#define NCC (CTX / 64)
#define RB (ROWS / 64)
#define PQ (PH * 256)
#define NEXP 16384
#define NTHREADS 256
#define SMEM_BYTES 133120

typedef unsigned short bf16_t;
typedef short bf16x8 __attribute__((ext_vector_type(8)));
typedef float f32x4 __attribute__((ext_vector_type(4)));
typedef unsigned u32x4 __attribute__((ext_vector_type(4)));
typedef unsigned u32x2 __attribute__((ext_vector_type(2)));
#ifdef EMU
#define MFMA16(a, b, c) emu_mfma_16x16x32_bf16(a, b, c)
#else
#define MFMA16(a, b, c) __builtin_amdgcn_mfma_f32_16x16x32_bf16(a, b, c, 0, 0, 0)
#endif
typedef float f32x2 __attribute__((ext_vector_type(2)));
#ifdef EMU
#define CVT_PK_FP8(a, b, old, hi) emu_cvt_pk_fp8_f32(a, b, old, hi)
#define CVT_PK_F32_FP8(w, hi) emu_cvt_pk_f32_fp8(w, hi)
#else
#define CVT_PK_FP8(a, b, old, hi) __builtin_amdgcn_cvt_pk_fp8_f32(a, b, old, hi)
#define CVT_PK_F32_FP8(w, hi) __builtin_amdgcn_cvt_pk_f32_fp8(w, hi)
#endif
#ifdef EMU
#define MFMA16_ACC(a, b, c) c = emu_mfma_16x16x32_bf16(a, b, c)
#else
#define MFMA16_ACC(a, b, c) asm volatile("v_mfma_f32_16x16x32_bf16 %0, %1, %2, %0" : "+a"(c) : "v"(a), "v"(b))
#endif
#define NPAD(n) (((n) + 127) / 128 * 128)
#define NPAD192(n) (((n) + 383) / 384 * 384)

__device__ __forceinline__ float bf2f(bf16_t h) { return __builtin_bit_cast(float, ((unsigned)h) << 16); }
#ifdef EMU
__device__ __forceinline__ bf16_t f2bf(float f) { unsigned u = __builtin_bit_cast(unsigned, f); u += 0x7FFFu + ((u >> 16) & 1u); return (bf16_t)(u >> 16); }
__device__ __forceinline__ unsigned pack2bf(float a, float b) { return (unsigned)f2bf(a) | ((unsigned)f2bf(b) << 16); }
#else
typedef float f2v_t __attribute__((ext_vector_type(2))); typedef __bf16 b2v_t __attribute__((ext_vector_type(2)));
__device__ __forceinline__ bf16_t f2bf(float f) { return __builtin_bit_cast(unsigned short, (__bf16)f); }
__device__ __forceinline__ unsigned pack2bf(float a, float b) { f2v_t v = {a, b}; b2v_t r = __builtin_convertvector(v, b2v_t); return __builtin_bit_cast(unsigned, r); }
#endif
#ifdef EMU
#define fexp_(x) expf(x)
#define flog_(x) logf(x)
#else
#define fexp_(x) __expf(x)
#define flog_(x) __logf(x)
#endif
#define LO16(x) __builtin_bit_cast(float, (x) << 16)
#define HI16(x) __builtin_bit_cast(float, (x) & 0xFFFF0000u)
__device__ __forceinline__ float sigmoidf_(float x) { return 1.0f / (1.0f + fexp_(-x)); }
__device__ __forceinline__ float siluf_(float x) { return x * sigmoidf_(x); }
__device__ __forceinline__ float geluf_(float x) { const float y = 1.5957691216057308f * (x + 0.044715f * x * x * x); return x / (1.0f + fexp_(-y)); }
__device__ __forceinline__ float softplusf_(float x) { return fmaxf(x, 0.f) + flog_(1.0f + fexp_(-fabsf(x))); }
__device__ __forceinline__ float tanhf_(float x) { const float e = fexp_(-2.0f * fabsf(x)); const float t = (1.0f - e) / (1.0f + e); return x < 0.f ? -t : t; }
__device__ __forceinline__ float wave_sum(float v) {
#pragma unroll
    for (int m = 32; m >= 1; m >>= 1) v += __shfl_xor(v, m, 64);
    return v;
}

struct P {
    const float* in[39];
    float* out;
    float* X;
    bf16_t* H;
    bf16_t* Z;
    bf16_t* ZGT;
    float* MOD;
    bf16_t* R; bf16_t* V; bf16_t* KK; bf16_t* KD; bf16_t* BB;
    float* LW;
    char* REC;
    bf16_t* SN;
    bf16_t* QH;
    float* BONUS;
    bf16_t* KS;
    bf16_t* LR;
    bf16_t* WT_W2;
    bf16_t* WT_A2;
    bf16_t* GS;
    float* Y;
    bf16_t* G2B;
    float* Y0T;
    float* KV;
    bf16_t* SP;
    float* DEC;
    float* OGLA;
    float* S5A;
    float* S5BB;
    float* S5END;
    float* S5CAR;
    bf16_t* GY;
    float* YN;
    bf16_t* BR;
    bf16_t* M;
    bf16_t* QHI; bf16_t* QLO;
    bf16_t* KHI; bf16_t* KLO;
    int* IDX;
    float* G;
    float* GU;
    unsigned* bar;
    bf16_t* WT_IN;
    bf16_t* WT_G2;
    bf16_t* WT_GLU;
    bf16_t* WT_BR;
    bf16_t* WT_OUT;
    bf16_t* WT_Q;
    unsigned char* U8; unsigned char* V8;
    float* USC; float* VSC;
};

enum { I_X = 0, I_C, I_CTX, I_CCTX, I_WMOD, I_BMOD, I_N1G, I_N2G, I_WIN, I_GLA_WA2, I_GLA_BA, I_GLA_NG, I_RCONV, I_RW0, I_RW2, I_RA0, I_RA2, I_RG2,
       I_RKK, I_RKA, I_RRK, I_RLNW, I_RLNB, I_S5LRE, I_S5LIM, I_S5LS, I_S5BRE, I_S5BIM, I_S5CRE, I_S5CIM, I_S5D, I_S5GLU, I_WBR, I_WOUT, I_PWQ, I_PKEYS, I_PU, I_PV, I_FG };

#define AL256(x) (((size_t)(x) + 255) & ~(size_t)255)
#define LATE_BYTES (AL256((size_t)NPAD(RW) * 128 * 2) + AL256((size_t)NPAD(2 * SW) * SW * 2) + AL256((size_t)3 * D_MODEL * BW * 2) + AL256((size_t)D_MODEL * D_MODEL * 2) + \
                    AL256((size_t)PQ * D_MODEL * 2) + 2 * AL256((size_t)PH * 2 * 128 * 128 * 2))
__device__ __forceinline__ void late_select(P& p, int par) {
    const size_t o = (size_t)par * (LATE_BYTES / 2);
    p.WT_G2 += o; p.WT_GLU += o; p.WT_BR += o; p.WT_OUT += o; p.WT_Q += o; p.KHI += o; p.KLO += o;
}
#ifdef EMU
__device__ __forceinline__ int otid() { return threadIdx.x; }
__device__ __forceinline__ int obid() { return blockIdx.x; }
#else
__device__ __forceinline__ int otid() { int t = threadIdx.x; asm volatile("" : "+v"(t)); return t; }
__device__ __forceinline__ int obid() { int b = blockIdx.x; asm volatile("" : "+s"(b)); return b; }
#endif
#ifdef EMU
#define WAVE_SYNC() emu_wave_barrier()
#ifndef EMU_GRID
#define EMU_GRID 4
#endif
#else
#define WAVE_SYNC() __builtin_amdgcn_wave_barrier()
#endif
#ifndef EMU
#define XB_TMO      128
#define XB_XCNT(j)  (256  + 64 * (j))
#define XB_XSUB(j)  (1280 + 64 * (j))
#define XB_XGEN(j)  (2304 + 64 * (j))
#define XB_TOP      3328
#define XB_TOPGEN   3392
#define XCD_BAR_WORDS 3456
#define XB_SPIN_CAP (1u << 22)
#define LAS __attribute__((address_space(3)))
__device__ __forceinline__ unsigned xb_ld(unsigned* p)              { return __hip_atomic_load(p, __ATOMIC_RELAXED, __HIP_MEMORY_SCOPE_SYSTEM); }
__device__ __forceinline__ unsigned xb_add(unsigned* p, unsigned v) { return __hip_atomic_fetch_add(p, v, __ATOMIC_RELAXED, __HIP_MEMORY_SCOPE_SYSTEM); }
__device__ __forceinline__ unsigned xb_xcc_id() { return (unsigned)__builtin_amdgcn_s_getreg((3 << 11) | 20) & 0xFu; }
#define XB_SPIN(cond, bar) do { unsigned _sp = 0; while (cond) { __builtin_amdgcn_s_sleep(1); \
    if ((++_sp & 255u) == 0u) { if (xb_ld(&(bar)[XB_TMO])) break; if (_sp > XB_SPIN_CAP) { atomicAdd(&(bar)[XB_TMO], 1u); break; } } } } while (0)
struct XcdBarrier { unsigned* bar; unsigned x; volatile LAS unsigned* st; };
__device__ __forceinline__ XcdBarrier xcd_barrier_post(unsigned* bar, volatile LAS unsigned* st) {
    XcdBarrier b; b.bar = bar; b.x = xb_xcc_id(); b.st = st;
    if (threadIdx.x == 0) st[3] = xb_add(&bar[XB_XCNT(b.x)], 1u);
    return b;
}
__device__ __forceinline__ void xcd_barrier_complete(unsigned* bar, unsigned x, unsigned& nloc, unsigned& nx) {
    const unsigned G = gridDim.x * gridDim.y * gridDim.z;
    unsigned sum, cnt, mine, sp = 0u;
    for (;;) {
        sum = 0u; cnt = 0u; mine = 0u;
#pragma unroll
        for (unsigned j = 0; j < 16; ++j) { const unsigned c = xb_ld(&bar[XB_XCNT(j)]); sum += c; cnt += (c > 0u) ? 1u : 0u; mine = (j == x) ? c : mine; }
        if (sum == G) break;
        __builtin_amdgcn_s_sleep(1);
        if ((++sp & 255u) == 0u) { if (xb_ld(&bar[XB_TMO])) break; if (sp > XB_SPIN_CAP) { atomicAdd(&bar[XB_TMO], 1u); break; } }
    }
    nloc = mine > 0u ? mine : 1u; nx = cnt > 0u ? cnt : 1u;
}
__device__ __forceinline__ void xcd_barrier(const XcdBarrier& b) {
    asm volatile("s_waitcnt vmcnt(0)" ::: "memory");
    __syncthreads();
    if (threadIdx.x == 0) {
        unsigned* bar = b.bar;
        __builtin_amdgcn_fence(__ATOMIC_RELEASE, "agent");
        asm volatile("s_waitcnt vmcnt(0)" ::: "memory");
        const unsigned G = gridDim.x;
        const unsigned old = xb_add(&bar[XB_TOP], 1u);
        const unsigned tg = old / G;
        if (old + 1u == (tg + 1u) * G) xb_add(&bar[XB_TOPGEN], 1u);
        else XB_SPIN(xb_ld(&bar[XB_TOPGEN]) == tg, bar);
        __builtin_amdgcn_fence(__ATOMIC_ACQUIRE, "agent");
        asm volatile("s_waitcnt vmcnt(0)" ::: "memory");
    }
    __syncthreads();
}
#define GRID_SYNC_CG() { (void)xb; asm volatile("s_waitcnt vmcnt(0)" ::: "memory"); cg::this_grid().sync(); }
#define GRID_SYNC() xcd_barrier(xb)
#else
#define GRID_SYNC() emu_grid_sync()
#endif

#ifdef EMU
#define LOADP() P p = p_arg
#else
typedef __attribute__((address_space(4))) const unsigned long long cu64_t;
__device__ __forceinline__ void load_params(P& p) {
    cu64_t* q = (cu64_t*)__builtin_amdgcn_kernarg_segment_ptr();
    asm volatile("" : "+s"(q));
    typedef __attribute__((address_space(1))) char gchar_t;
    char* w[sizeof(P) / 8];
#pragma unroll
    for (int i = 0; i < (int)(sizeof(P) / 8); ++i) w[i] = (char*)(gchar_t*)q[i];
    __builtin_memcpy(&p, w, sizeof(P));
}
#define LOADP() P p; load_params(p)
#endif
#define PROBE_MULT 3
#if defined(PROBE_ID) && !defined(EMU)
#define PROBE_INIT() unsigned long long probe_t0 = wall_clock64()
#define PROBE_AFTER(id) { if (blockIdx.x == 0) { unsigned long long now_ = wall_clock64(); if ((id) == PROBE_ID || (id) == PROBE_ID2) { const unsigned long long dt_ = now_ - probe_t0; \
    while (wall_clock64() - now_ < dt_ * PROBE_MULT) __builtin_amdgcn_s_sleep(8); now_ = wall_clock64(); } probe_t0 = now_; } }
#else
#define PROBE_INIT()
#define PROBE_AFTER(id)
#endif
__device__ __forceinline__ int gla_tok(int n, int i) {
    if (n < NCC) return n * 64 + i;
    int m = n - NCC; int col = m / RB, rb = m % RB;
    return CTX + (rb * 64 + i) * GRID_W + col;
}
__device__ __forceinline__ int chunk_order(int d, int s) {
    if (d == 0) return s;
    return (s < NCC) ? (NCC - 1 - s) : (NC - 1 - (s - NCC));
}
__device__ __forceinline__ int tok_order(int d, int s) {
    if (d == 0) return s;
    return (s < CTX) ? (CTX - 1 - s) : (MTOT - 1 - (s - CTX));
}


#define LDS_ROW 72
__device__ __forceinline__ void mfma_gemm_tile(const bf16_t* Wt, int ldw, const bf16_t* Act, int lda, int K, int n0, int m0, bf16_t* lds, f32x4 (&acc)[4][4]) {
    bf16_t* Ws = lds; bf16_t* As = lds + 128 * LDS_ROW;
    const int tid = otid(), lane = tid & 63, wave = tid >> 6, wn = wave >> 1, wm = wave & 1;
    const int lrow = tid >> 3, lkc = (tid & 7) * 8;
    u32x4 pw[4], pa[4];
#pragma unroll
    for (int i = 0; i < 4; ++i) {
        pw[i] = *(const u32x4*)(Wt + (size_t)(n0 + lrow + 32 * i) * ldw + lkc);
        pa[i] = *(const u32x4*)(Act + (size_t)(m0 + lrow + 32 * i) * lda + lkc);
    }
    for (int k0 = 0; k0 < K; k0 += 64) {
        __syncthreads();
#pragma unroll
        for (int i = 0; i < 4; ++i) {
            *(u32x4*)(Ws + (lrow + 32 * i) * LDS_ROW + lkc) = pw[i];
            *(u32x4*)(As + (lrow + 32 * i) * LDS_ROW + lkc) = pa[i];
        }
        __syncthreads();
        if (k0 + 64 < K) {
#pragma unroll
            for (int i = 0; i < 4; ++i) {
                pw[i] = *(const u32x4*)(Wt + (size_t)(n0 + lrow + 32 * i) * ldw + k0 + 64 + lkc);
                pa[i] = *(const u32x4*)(Act + (size_t)(m0 + lrow + 32 * i) * lda + k0 + 64 + lkc);
            }
        }
#pragma unroll
        for (int ks = 0; ks < 2; ++ks) {
            bf16x8 a[4], b[4];
#pragma unroll
            for (int i = 0; i < 4; ++i) {
                a[i] = *(const bf16x8*)(Ws + (wn * 64 + i * 16 + (lane & 15)) * LDS_ROW + ks * 32 + (lane >> 4) * 8);
                b[i] = *(const bf16x8*)(As + (wm * 64 + i * 16 + (lane & 15)) * LDS_ROW + ks * 32 + (lane >> 4) * 8);
            }
#pragma unroll
            for (int ni = 0; ni < 4; ++ni)
#pragma unroll
                for (int mi = 0; mi < 4; ++mi) acc[ni][mi] = MFMA16(a[ni], b[mi], acc[ni][mi]);
        }
    }
}
#define L64_ROW 72
#ifdef EMU
struct BufRsrc { const char* base; };
__device__ __forceinline__ BufRsrc make_rsrc(const void* p, size_t) { BufRsrc r; r.base = (const char*)p; return r; }
__device__ __forceinline__ u32x4 buf_load16(const BufRsrc& r, unsigned voff, unsigned soff) { return *(const u32x4*)(r.base + voff + soff); }
#else
typedef __amdgpu_buffer_rsrc_t BufRsrc;
__device__ __forceinline__ BufRsrc make_rsrc(const void* p, size_t bytes) { return __builtin_amdgcn_make_buffer_rsrc((void*)p, 0, (int)bytes, 0x00020000); }
__device__ __forceinline__ u32x4 buf_load16(const BufRsrc& r, unsigned voff, unsigned soff) { return __builtin_bit_cast(u32x4, __builtin_amdgcn_raw_buffer_load_b128(r, voff, soff, 0)); }
#endif
template <int NI, int MI>
__device__ __forceinline__ void mfma_gemm_tile_t(const bf16_t* Wt, int ldw, size_t wbytes, const bf16_t* Act, int lda, size_t abytes, int K, int n0, int m0, bf16_t* lds, f32x4 (&acc)[NI][MI], unsigned long long* gacc = nullptr) {
    constexpr int WR = 32 * NI, AR = 32 * MI, BUF = (WR + AR) * L64_ROW;
    const int tid = otid(), lane = tid & 63, wave = tid >> 6, wn = wave >> 1, wm = wave & 1;
    const int lrow = tid >> 3, lkc = (tid & 7) * 8;
    const BufRsrc rw = make_rsrc(Wt, wbytes), ra = make_rsrc(Act, abytes);
    unsigned vw[NI], va[MI];
#pragma unroll
    for (int i = 0; i < NI; ++i) vw[i] = (unsigned)(((size_t)(n0 + lrow + 32 * i) * ldw + lkc) * 2);
#pragma unroll
    for (int i = 0; i < MI; ++i) va[i] = (unsigned)(((size_t)(m0 + lrow + 32 * i) * lda + lkc) * 2);
    u32x4 qw0[NI], qa0[MI];
    const int nk = K / 64;
#define GT_LOAD(QW, QA, KT) { const unsigned so_ = (unsigned)(((KT) < nk) ? (KT) : (nk - 1)) * 128u; \
    _Pragma("unroll") for (int i = 0; i < NI; ++i) QW[i] = buf_load16(rw, vw[i], so_); \
    _Pragma("unroll") for (int i = 0; i < MI; ++i) QA[i] = buf_load16(ra, va[i], so_); }
#define GT_STORE(QW, QA, DST) { \
    _Pragma("unroll") for (int i = 0; i < NI; ++i) *(u32x4*)((DST) + (lrow + 32 * i) * L64_ROW + lkc) = QW[i]; \
    _Pragma("unroll") for (int i = 0; i < MI; ++i) *(u32x4*)((DST) + (WR + lrow + 32 * i) * L64_ROW + lkc) = QA[i]; }
#define GT_COMPUTE(CUR) { _Pragma("unroll") for (int ks = 0; ks < 2; ++ks) { bf16x8 b[MI], a[NI]; \
    _Pragma("unroll") for (int i = 0; i < MI; ++i) b[i] = *(const bf16x8*)((CUR) + (WR + wm * 16 * MI + i * 16 + (lane & 15)) * L64_ROW + ks * 32 + (lane >> 4) * 8); \
    _Pragma("unroll") for (int i = 0; i < NI; ++i) a[i] = *(const bf16x8*)((CUR) + (wn * 16 * NI + i * 16 + (lane & 15)) * L64_ROW + ks * 32 + (lane >> 4) * 8); \
    _Pragma("unroll") for (int ni = 0; ni < NI; ++ni) { \
        _Pragma("unroll") for (int mi = 0; mi < MI; ++mi) MFMA16_ACC(a[ni], b[mi], acc[ni][mi]); } } }
    GT_LOAD(qw0, qa0, 0)
    __syncthreads();
    GT_STORE(qw0, qa0, lds)
    __syncthreads();
    for (int kt = 0; kt < nk; kt += 2) {
        GT_LOAD(qw0, qa0, kt + 1)
        GT_COMPUTE(lds)
        GT_STORE(qw0, qa0, lds + BUF)
        __syncthreads();
        GT_LOAD(qw0, qa0, kt + 2)
        GT_COMPUTE(lds + BUF)
        GT_STORE(qw0, qa0, lds)
        __syncthreads();
    }
#undef GT_LOAD
#undef GT_STORE
#undef GT_COMPUTE
}
#define ZERO_ACC4(acc) { _Pragma("unroll") for (int i_ = 0; i_ < 4; ++i_) _Pragma("unroll") for (int j_ = 0; j_ < 4; ++j_) acc[i_][j_] = (f32x4){0.f, 0.f, 0.f, 0.f}; }
#define FOR_ACC(acc, n0, m0, BODY) { const int lane_ = otid() & 63, wave_ = otid() >> 6; \
    _Pragma("unroll") for (int ni_ = 0; ni_ < 4; ++ni_) _Pragma("unroll") for (int mi_ = 0; mi_ < 4; ++mi_) { \
        const int n = (n0) + (wave_ >> 1) * 64 + ni_ * 16 + (lane_ >> 4) * 4; const int m = (m0) + (wave_ & 1) * 64 + mi_ * 16 + (lane_ & 15); const f32x4 v = acc[ni_][mi_]; BODY } }
__device__ __forceinline__ u32x2 pack4(float a, float b, float c, float d) { u32x2 r; r.x = pack2bf(a, b); r.y = pack2bf(c, d); return r; }

__device__ __forceinline__ void convert_wt_job(const float* W, int K, int N, int Npad, bf16_t* out, int job, float* T, int ilv) {
    const int tid = otid();
    const int nkt = K / 64;
    const int n0 = (job / nkt) * 64, k0 = (job % nkt) * 64;
    __syncthreads();
    for (int idx = tid; idx < 4096; idx += NTHREADS) {
        int kk = idx >> 6, nn = idx & 63;
        int nr = n0 + nn; int src = ilv ? ((nr & 1) ? (N / 2 + (nr >> 1)) : (nr >> 1)) : nr;
        T[kk * 65 + nn] = (nr < N) ? W[(size_t)(k0 + kk) * N + src] : 0.f;
    }
    __syncthreads();
    {
        int nn = tid >> 2, part = tid & 3;
        unsigned w[8];
#pragma unroll
        for (int j = 0; j < 8; ++j) w[j] = pack2bf(T[(part * 16 + 2 * j) * 65 + nn], T[(part * 16 + 2 * j + 1) * 65 + nn]);
        u32x4* o = (u32x4*)(out + (size_t)(n0 + nn) * K + k0 + part * 16);
        o[0] = (u32x4){w[0], w[1], w[2], w[3]}; o[1] = (u32x4){w[4], w[5], w[6], w[7]};
    }
}
__device__ __forceinline__ void phase_convert_weights(const P& p, int l, char* smem, int bid, int nb) {
    float* T = (float*)smem;
    struct Item { const float* W; int K, N, Npad; bf16_t* out; };
    const Item items[12] = {
        {p.in[I_RW2] + ((size_t)l * 2 + 0) * 64 * RW, 64, RW, NPAD(RW), p.WT_W2},
        {p.in[I_RW2] + ((size_t)l * 2 + 1) * 64 * RW, 64, RW, NPAD(RW), p.WT_W2 + (size_t)NPAD(RW) * 64},
        {p.in[I_RA2] + ((size_t)l * 2 + 0) * 64 * RW, 64, RW, NPAD(RW), p.WT_A2},
        {p.in[I_RA2] + ((size_t)l * 2 + 1) * 64 * RW, 64, RW, NPAD(RW), p.WT_A2 + (size_t)NPAD(RW) * 64},
        {p.in[I_WIN] + (size_t)l * D_MODEL * D_IN, D_MODEL, D_IN, NPAD192(D_IN), p.WT_IN},
        {p.in[I_RG2] + (size_t)l * 128 * RW, 128, RW, RW, p.WT_G2},
        {p.in[I_S5GLU] + (size_t)l * SW * 2 * SW, SW, 2 * SW, 2 * SW, p.WT_GLU},
        {p.in[I_WBR] + ((size_t)l * 3 + 0) * BW * D_MODEL, BW, D_MODEL, D_MODEL, p.WT_BR},
        {p.in[I_WBR] + ((size_t)l * 3 + 1) * BW * D_MODEL, BW, D_MODEL, D_MODEL, p.WT_BR + (size_t)D_MODEL * BW},
        {p.in[I_WBR] + ((size_t)l * 3 + 2) * BW * D_MODEL, BW, D_MODEL, D_MODEL, p.WT_BR + (size_t)2 * D_MODEL * BW},
        {p.in[I_WOUT] + (size_t)l * D_MODEL * D_MODEL, D_MODEL, D_MODEL, D_MODEL, p.WT_OUT},
        {p.in[I_PWQ] + (size_t)l * D_MODEL * PQ, D_MODEL, PQ, PQ, p.WT_Q}};
    int base = 0;
#pragma unroll
    for (int it = 0; it < 12; ++it) {
        const int nj = (items[it].Npad / 64) * (items[it].K / 64);
        for (int j = (bid + nb - (base % nb)) % nb; j < nj; j += nb)
            convert_wt_job(items[it].W, items[it].K, items[it].N, items[it].Npad, items[it].out, j, T, it == 6);
        base += nj;
    }
    __syncthreads();
    {
        const float* ks = p.in[I_PKEYS] + (size_t)l * PH * 2 * 128 * 128;
        for (size_t i = (size_t)bid * NTHREADS + otid(); i < (size_t)PH * 2 * 128 * 128; i += (size_t)nb * NTHREADS) {
            const float v = ks[i]; const bf16_t hb = f2bf(v);
            p.KHI[i] = hb; p.KLO[i] = f2bf(v - bf2f(hb));
        }
    }
}

#ifdef EMU
__device__ __forceinline__ int xcd_rank() { return obid(); }
#else
__device__ __forceinline__ int xcd_rank() { return (int)((volatile LAS unsigned*)(unsigned)(SMEM_BYTES))[2]; }
#endif
__device__ __forceinline__ bool tile_map(int it, int ntm, int ntn, int PM, int& mt, int& nt) {
    const int G = gridDim.x;
    const long id = (long)it * G + xcd_rank();
    if (id >= (long)ntm * ntn) return false;
    const int full = ntm / PM; const long fullsz = (long)full * PM * ntn;
    if (id < fullsz) { const int p = (int)(id / (PM * ntn)), rem = (int)(id % (PM * ntn)); nt = rem / PM; mt = p * PM + rem % PM; }
    else { const int rem = (int)(id - fullsz), hh = ntm - full * PM; nt = rem / hh; mt = full * PM + rem % hh; }
    return true;
}

template <int NI, int MI, class Pre, class Post>
__device__ __forceinline__ void gemm_tile_run(const bf16_t* Wt, int ldw, size_t wbytes, const bf16_t* Act, int lda, size_t abytes, int K, int n0, int m0, bf16_t* lds, Pre pre, Post post) {
    f32x4 acc[NI][MI];
#pragma unroll
    for (int i = 0; i < NI; ++i)
#pragma unroll
        for (int j = 0; j < MI; ++j) acc[i][j] = (f32x4){0.f, 0.f, 0.f, 0.f};
    pre(m0, n0, acc, lds);
    mfma_gemm_tile_t<NI, MI>(Wt, ldw, wbytes, Act, lda, abytes, K, n0, m0, lds, acc);
    const int lane = otid() & 63, wave = otid() >> 6;
#pragma unroll
    for (int ni = 0; ni < NI; ++ni)
#pragma unroll
        for (int mi = 0; mi < MI; ++mi)
            post(ni, mi, m0 + (wave & 1) * 16 * MI + mi * 16 + (lane & 15), n0 + (wave >> 1) * 16 * NI + ni * 16 + (lane >> 4) * 4, acc[ni][mi]);
}
struct NoPre { template <class A> __device__ __forceinline__ void operator()(int, int, A&, bf16_t*) const {} };
template <int NI, class PreM, class PreT, class Post>
__device__ __forceinline__ void gemm_phase(const bf16_t* Wt, int ldw, size_t wbytes, const bf16_t* Act, int lda, size_t abytes, int K, int N, bf16_t* lds, PreM prem, PreT pret, Post post) {
    const int ntn = N / (32 * NI), ntm = MTOT / 256 - 1;
    const int PM = (ntn >= 16) ? 2 : ((ntn >= 8) ? 4 : 8);
    for (int it = 0;; ++it) {
        int mt_, nt_; if (!tile_map(it, ntm, ntn, PM, mt_, nt_)) break;
        gemm_tile_run<NI, 8>(Wt, ldw, wbytes, Act, lda, abytes, K, nt_ * 32 * NI, mt_ * 256, lds, prem, post);
    }
    for (int job = obid(); job < 4 * ntn; job += gridDim.x)
        gemm_tile_run<NI, 2>(Wt, ldw, wbytes, Act, lda, abytes, K, (job >> 2) * 32 * NI, MTOT - 256 + (job & 3) * 64, lds, pret, post);
}

__device__ __forceinline__ void phase_init(const P& p, char* smem) {
    const int tid = otid();
    float* sc = (float*)smem;
    for (int i = tid; i < D_MODEL; i += NTHREADS) { sc[i] = siluf_(p.in[I_CCTX][i]); sc[D_MODEL + i] = siluf_(p.in[I_C][i]); }
    __syncthreads();
    const int ncolblk = (6 * D_MODEL) / NTHREADS;
    for (int job = obid(); job < DEPTH * ncolblk; job += gridDim.x) {
        int l = job / ncolblk, n = (job % ncolblk) * NTHREADS + tid;
        const float* w = p.in[I_WMOD] + (size_t)l * D_MODEL * 6 * D_MODEL + n;
        float a0 = 0.f, a1 = 0.f;
        for (int k = 0; k < D_MODEL; ++k) { float wv = w[(size_t)k * 6 * D_MODEL]; a0 += sc[k] * wv; a1 += sc[D_MODEL + k] * wv; }
        float b = p.in[I_BMOD][l * 6 * D_MODEL + n];
        p.MOD[(size_t)(l * 2 + 0) * 6 * D_MODEL + n] = a0 + b;
        p.MOD[(size_t)(l * 2 + 1) * 6 * D_MODEL + n] = a1 + b;
    }
    const size_t gtid = (size_t)obid() * NTHREADS + tid, gn = (size_t)gridDim.x * NTHREADS;
    for (size_t i = gtid; i < (size_t)CTX * D_MODEL; i += gn) p.X[i] = p.in[I_CTX][i];
    for (size_t i = gtid; i < (size_t)SEQ * D_MODEL; i += gn) p.X[(size_t)CTX * D_MODEL + i] = p.in[I_X][i];
    __syncthreads();
}

__device__ __forceinline__ void phase_s5const(const P& p, int l) {
    const size_t gtid = (size_t)obid() * NTHREADS + otid(), gn = (size_t)gridDim.x * NTHREADS;
    for (size_t i = gtid; i < (size_t)2 * SG * 64; i += gn) {
        int d = (int)(i / (SG * 64)), g = (int)((i / 64) % SG), s = (int)(i % 64);
        size_t li = ((size_t)(l * 2 + d) * SG + g) * 64 + s;
        float lre = p.in[I_S5LRE][li], lim = p.in[I_S5LIM][li];
        float dt = expf(p.in[I_S5LS][(l * 2 + d) * SG + g]);
        float mag = expf(lre * dt);
        float are = mag * cosf(lim * dt), aim = mag * sinf(lim * dt);
        float den = lre * lre + lim * lim;
        float fre = ((are - 1.0f) * lre + aim * lim) / den;
        float fim = (aim * lre - (are - 1.0f) * lim) / den;
        p.S5A[i * 2 + 0] = are; p.S5A[i * 2 + 1] = aim;
        const float* bre = p.in[I_S5BRE] + (((size_t)l * SG + g) * 64 + s) * 16;
        const float* bim = p.in[I_S5BIM] + (((size_t)l * SG + g) * 64 + s) * 16;
        for (int c = 0; c < 16; ++c) {
            p.S5BB[(i * 16 + c) * 2 + 0] = fre * bre[c] - fim * bim[c];
            p.S5BB[(i * 16 + c) * 2 + 1] = fre * bim[c] + fim * bre[c];
        }
    }
}

__device__ __forceinline__ void phase_norm(const P& p, int l, int which) {
    const int lane = otid() & 63;
    const int gw = (obid() * NTHREADS + otid()) >> 6, nw = (gridDim.x * NTHREADS) >> 6;
    const float* g = p.in[which ? I_N2G : I_N1G] + l * D_MODEL;
    constexpr int NJ = (D_MODEL + 255) / 256;
    for (int t = gw; t < MTOT; t += nw) {
        const float* x = p.X + (size_t)t * D_MODEL;
        const float* mod = p.MOD + (size_t)(l * 2 + (t >= CTX ? 1 : 0)) * 6 * D_MODEL + (which ? 3 * D_MODEL : 0);
        float4 v[NJ]; float ss = 0.f;
#pragma unroll
        for (int j = 0; j < NJ; ++j) {
            const int e = j * 256 + lane * 4;
            if (e < D_MODEL) v[j] = *(const float4*)(x + e); else { v[j].x = 0.f; v[j].y = 0.f; v[j].z = 0.f; v[j].w = 0.f; }
            ss += v[j].x * v[j].x + v[j].y * v[j].y + v[j].z * v[j].z + v[j].w * v[j].w;
        }
        ss = wave_sum(ss);
        const float rstd = rsqrtf(ss / D_MODEL + 1e-6f);
#pragma unroll
        for (int j = 0; j < NJ; ++j) {
            const int e = j * 256 + lane * 4;
            if (e < D_MODEL) {
                const float4 gg = *(const float4*)(g + e), sc = *(const float4*)(mod + D_MODEL + e), sh = *(const float4*)(mod + e);
                *(u32x2*)(p.H + (size_t)t * D_MODEL + e) = pack4(v[j].x * rstd * gg.x * (1.0f + sc.x) + sh.x, v[j].y * rstd * gg.y * (1.0f + sc.y) + sh.y,
                                                                 v[j].z * rstd * gg.z * (1.0f + sc.z) + sh.z, v[j].w * rstd * gg.w * (1.0f + sc.w) + sh.w);
            }
        }
    }
}

__device__ __forceinline__ void phase_gemm_in(const P& p, int l, char* smem) {
    constexpr int NI = 6, MI = 8;
    const int ntn = NPAD192(D_IN) / 192, ntm = MTOT / 256;
    for (int it = 0;; ++it) {
        int mt_, nt_; if (!tile_map(it, ntm, ntn, 4, mt_, nt_)) break;
        const int m0 = mt_ * 256, n0 = nt_ * 192;
        f32x4 acc[NI][MI];
#pragma unroll
        for (int i = 0; i < NI; ++i)
#pragma unroll
            for (int j = 0; j < MI; ++j) acc[i][j] = (f32x4){0.f, 0.f, 0.f, 0.f};
        mfma_gemm_tile_t<NI, MI>(p.WT_IN, D_MODEL, (size_t)NPAD192(D_IN) * D_MODEL * 2, p.H, D_MODEL, (size_t)MTOT * D_MODEL * 2, D_MODEL, n0, m0, (bf16_t*)smem, acc);
        const int lane = otid() & 63, wave = otid() >> 6;
#pragma unroll
        for (int ni = 0; ni < NI; ++ni)
#pragma unroll
            for (int mi = 0; mi < MI; ++mi) {
                const int n = n0 + (wave >> 1) * 16 * NI + ni * 16 + (lane >> 4) * 4, m = m0 + (wave & 1) * 16 * MI + mi * 16 + (lane & 15);
                const u32x2 pk_ = pack4(acc[ni][mi][0], acc[ni][mi][1], acc[ni][mi][2], acc[ni][mi][3]);
                if (n < ZG) *(u32x2*)(p.Z + (size_t)m * ZLD + n) = pk_;
                else if (n < D_IN) *(u32x2*)(p.ZGT + ((((size_t)(m >> 4) * (3 * D_MODEL / 16) + ((n - ZG) >> 4)) * 64 + lane) * 4)) =
                    pack4(sigmoidf_(acc[ni][mi][0]), sigmoidf_(acc[ni][mi][1]), sigmoidf_(acc[ni][mi][2]), sigmoidf_(acc[ni][mi][3]));
            }
    }
}

__device__ __forceinline__ void unpack8(const u32x4 w, float (&f)[8]) {
    f[0] = LO16(w.x); f[1] = HI16(w.x); f[2] = LO16(w.y); f[3] = HI16(w.y); f[4] = LO16(w.z); f[5] = HI16(w.z); f[6] = LO16(w.w); f[7] = HI16(w.w);
}
__device__ __forceinline__ u32x4 pack8(const float (&f)[8]) {
    u32x4 o; o.x = pack2bf(f[0], f[1]); o.y = pack2bf(f[2], f[3]);
    o.z = pack2bf(f[4], f[5]); o.w = pack2bf(f[6], f[7]); return o;
}
__device__ __forceinline__ void load8f(const float* p, float (&f)[8]) {
    const float4 a = *(const float4*)p, b = *(const float4*)(p + 4);
    f[0] = a.x; f[1] = a.y; f[2] = a.z; f[3] = a.w; f[4] = b.x; f[5] = b.y; f[6] = b.z; f[7] = b.w;
}
__device__ __forceinline__ void store8f(float* p, const float (&f)[8]) {
    float4 a, b; a.x = f[0]; a.y = f[1]; a.z = f[2]; a.w = f[3]; b.x = f[4]; b.y = f[5]; b.z = f[6]; b.w = f[7];
    *(float4*)p = a; *(float4*)(p + 4) = b;
}
__device__ __forceinline__ void conv8(const bf16_t* zp, const float* conv, int c0, bool act, bool first, bool last, float (&out)[8]) {
    const u32x4 z4 = {0u, 0u, 0u, 0u};
    const u32x4 a0 = act ? *(const u32x4*)(zp + c0) : z4;
    const u32x4 am = (act && !first) ? *(const u32x4*)(zp + c0 - ZLD) : z4;
    const u32x4 an = (act && !last) ? *(const u32x4*)(zp + c0 + ZLD) : z4;
    float w0[8], w1[8], w2[8], f0[8], fm[8], fn[8];
    if (act) { load8f(conv + c0, w0); load8f(conv + RWKV_IN + c0, w1); load8f(conv + 2 * RWKV_IN + c0, w2); }
    else {
#pragma unroll
        for (int e = 0; e < 8; ++e) { w0[e] = 0.f; w1[e] = 0.f; w2[e] = 0.f; }
    }
    unpack8(a0, f0); unpack8(am, fm); unpack8(an, fn);
#pragma unroll
    for (int e = 0; e < 8; ++e) out[e] = w1[e] * f0[e] + w0[e] * fm[e] + w2[e] * fn[e];
}
__device__ __forceinline__ void phase_rwkv_prep1(const P& p, int l) {
    const int lane = otid() & 63;
    const int gw = (obid() * NTHREADS + otid()) >> 6, nw = (gridDim.x * NTHREADS) >> 6;
    const float* conv = p.in[I_RCONV] + (size_t)l * 3 * RWKV_IN;
    const float* k_k = p.in[I_RKK] + (size_t)l * RW;
    const bool act = lane * 8 < RW, act2 = lane * 8 < 384;
    float kkw[8];
    if (act) load8f(k_k + lane * 8, kkw);
    else {
#pragma unroll
        for (int e = 0; e < 8; ++e) kkw[e] = 0.f;
    }
    for (int t = gw; t < MTOT; t += nw) {
        const bool first = (t == 0) || (t == CTX), last = (t == CTX - 1) || (t == MTOT - 1);
        const bf16_t* zp = p.Z + (size_t)t * ZLD + ZR;
        float rv[8], kv[8], vv[8], lr[8];
        conv8(zp, conv, 0 * RW + lane * 8, act, first, last, rv);
        conv8(zp, conv, 1 * RW + lane * 8, act, first, last, kv);
        conv8(zp, conv, 2 * RW + lane * 8, act, first, last, vv);
        conv8(zp, conv, 3 * RW + lane * 8, act2, first, last, lr);
        float kk[8]; float ss = 0.f;
#pragma unroll
        for (int e = 0; e < 8; ++e) { kk[e] = kv[e] * kkw[e]; ss += kk[e] * kk[e]; }
        ss += __shfl_xor(ss, 1, 64); ss += __shfl_xor(ss, 2, 64); ss += __shfl_xor(ss, 4, 64);
        const float inv = 1.0f / fmaxf(sqrtf(ss), 1e-12f);
#pragma unroll
        for (int e = 0; e < 8; ++e) kk[e] *= inv;
        if (act) {
            const size_t o = (size_t)t * RW + lane * 8;
            *(u32x4*)(p.R + o) = pack8(rv); *(u32x4*)(p.KS + o) = pack8(kv); *(u32x4*)(p.V + o) = pack8(vv); *(u32x4*)(p.KK + o) = pack8(kk);
        }
        if (act2) {
            const int cc = lane * 8;
            if (cc < 128) {
#pragma unroll
                for (int e = 0; e < 8; ++e) lr[e] = tanhf_(lr[e]);
                *(u32x4*)(p.LR + (size_t)t * 256 + cc) = pack8(lr);
            } else if (cc < 256) {
                *(u32x4*)(p.LR + (size_t)t * 256 + cc) = pack8(lr);
            } else {
#pragma unroll
                for (int e = 0; e < 8; ++e) lr[e] = sigmoidf_(lr[e]);
                *(u32x4*)(p.GS + (size_t)t * 128 + cc - 256) = pack8(lr);
            }
        }
    }
}
__device__ __forceinline__ void phase_rwkv_prep2(const P& p, int l, char* smem) {
    const int ntm = MTOT / 128, ntn = NPAD(RW) / 128;
    const float* k_a = p.in[I_RKA] + (size_t)l * RW;
    const float* r_k = p.in[I_RRK] + (size_t)l * RW;
    for (int job = obid(); job < ntm * ntn * 2; job += gridDim.x) {
        const int d = job % 2, n0 = ((job / 2) % ntn) * 128, m0 = (job / (2 * ntn)) * 128;
        const float* w0 = p.in[I_RW0] + (size_t)(l * 2 + d) * RW;
        const float* a0 = p.in[I_RA0] + (size_t)(l * 2 + d) * RW;
        f32x4 accw[4][4], acca[4][4]; ZERO_ACC4(accw); ZERO_ACC4(acca);
        mfma_gemm_tile(p.WT_W2 + (size_t)d * NPAD(RW) * 64, 64, p.LR + d * 64, 256, 64, n0, m0, (bf16_t*)smem, accw);
        mfma_gemm_tile(p.WT_A2 + (size_t)d * NPAD(RW) * 64, 64, p.LR + 128 + d * 64, 256, 64, n0, m0, (bf16_t*)smem, acca);
        const int lane = otid() & 63, wave = otid() >> 6;
#pragma unroll
        for (int mi = 0; mi < 4; ++mi) {
            const int m = m0 + (wave & 1) * 64 + mi * 16 + (lane & 15);
            float bon = 0.f;
#pragma unroll
            for (int ni = 0; ni < 4; ++ni) {
                const int n = n0 + (wave >> 1) * 64 + ni * 16 + (lane >> 4) * 4;
                if (n < RW) {
                    const u32x2 kq = *(const u32x2*)(p.KS + (size_t)m * RW + n), kkq = *(const u32x2*)(p.KK + (size_t)m * RW + n), rq = *(const u32x2*)(p.R + (size_t)m * RW + n);
                    const float kv[4] = {LO16(kq.x), HI16(kq.x), LO16(kq.y), HI16(kq.y)};
                    const float kkv[4] = {LO16(kkq.x), HI16(kkq.x), LO16(kkq.y), HI16(kkq.y)};
                    const float rv[4] = {LO16(rq.x), HI16(rq.x), LO16(rq.y), HI16(rq.y)};
                    float lw[4], kd[4], bb[4];
#pragma unroll
                    for (int e = 0; e < 4; ++e) {
                        const float x = w0[n + e] + accw[ni][mi][e];
                        lw[e] = -fexp_(-softplusf_(-x) - 0.5f);
                        const float aa = sigmoidf_(a0[n + e] + acca[ni][mi][e]);
                        kd[e] = kv[e] * (1.0f + (aa - 1.0f) * k_a[n + e]);
                        bb[e] = kkv[e] * aa;
                        bon += rv[e] * kd[e] * r_k[n + e];
                    }
                    const size_t o = ((size_t)d * MTOT + m) * RW + n;
                    float4 lo4; lo4.x = lw[0]; lo4.y = lw[1]; lo4.z = lw[2]; lo4.w = lw[3];
                    *(float4*)(p.LW + o) = lo4;
                    *(u32x2*)(p.KD + o) = pack4(kd[0], kd[1], kd[2], kd[3]);
                    *(u32x2*)(p.BB + o) = pack4(bb[0], bb[1], bb[2], bb[3]);
                }
            }
            bon += __shfl_xor(bon, 16, 64); bon += __shfl_xor(bon, 32, 64);
            const int hh = (n0 + (wave >> 1) * 64) >> 6;
            if ((lane >> 4) == 0 && hh < RH) p.BONUS[((size_t)d * MTOT + m) * RH + hh] = bon;
        }
    }
}

#define CH_ROW 72
#define SEQ_REC 16640
#define CH_SLOT (64 * CH_ROW)
#define CH_XR_OFF (7 * CH_SLOT * 2)
#define CH_AAB_OFF (CH_XR_OFF + 64 * 132 * 4)
#define CH_GC_OFF (CH_AAB_OFF + 64 * 72 * 4)
template <int MT, int NT>
__device__ __forceinline__ void lds_mm(const bf16_t* A, int m0, const bf16_t* Bt, int n0, f32x4 (&acc)[MT][NT]) {
    const int lane = otid() & 63, q = lane >> 4, r = lane & 15;
#pragma unroll
    for (int s = 0; s < 2; ++s) {
        bf16x8 a[MT], b[NT];
#pragma unroll
        for (int i = 0; i < MT; ++i) a[i] = *(const bf16x8*)(A + (m0 + i * 16 + r) * CH_ROW + s * 32 + q * 8);
#pragma unroll
        for (int i = 0; i < NT; ++i) b[i] = *(const bf16x8*)(Bt + (n0 + i * 16 + r) * CH_ROW + s * 32 + q * 8);
#pragma unroll
        for (int i = 0; i < MT; ++i)
#pragma unroll
            for (int jj = 0; jj < NT; ++jj) acc[i][jj] = MFMA16(a[i], b[jj], acc[i][jj]);
    }
}
__device__ __forceinline__ void rwkv_chunk_job(const P& p, int l, int job, char* smem) {
    const int tid = otid(), lane = tid & 63, wv = tid >> 6, q = lane >> 4, r = lane & 15;
    const int d = job / (NC * RH), n = (job / RH) % NC, h = job % RH;
    const size_t base = (size_t)(d * NC + n) * RH + h;
    bf16_t* S0 = (bf16_t*)smem; bf16_t* S1 = S0 + CH_SLOT; bf16_t* S2 = S1 + CH_SLOT; bf16_t* S3 = S2 + CH_SLOT;
    bf16_t* S4 = S3 + CH_SLOT; bf16_t* S5 = S4 + CH_SLOT; bf16_t* S6 = S5 + CH_SLOT;
    float* X = (float*)(smem + CH_XR_OFF);
    float* AABt = (float*)(smem + CH_AAB_OFF);
    bf16_t* U0t = (bf16_t*)(smem + CH_AAB_OFF);
    bf16_t* Aht = U0t + CH_SLOT;
    float* GC = (float*)(smem + CH_GC_OFF);
    __syncthreads();
    u32x4 gkk[2], gr[2], gv[2], gks[2];
#pragma unroll
    for (int it = 0; it < 2; ++it) {
        const int c = tid + 256 * it, i = c >> 3, k0 = (c & 7) * 8; const int tok = 64 * n + (d ? 63 - i : i);
        const size_t o1 = (size_t)tok * RW + h * 64 + k0;
        gkk[it] = *(const u32x4*)(p.KK + o1); gr[it] = *(const u32x4*)(p.R + o1); gv[it] = *(const u32x4*)(p.V + o1); gks[it] = *(const u32x4*)(p.KS + o1);
    }
    {
        const int iw = 16 * wv + r; const int tokw = 64 * n + (d ? 63 - iw : iw);
        bf16x8 fw[2], fa[2];
#pragma unroll
        for (int s2 = 0; s2 < 2; ++s2) {
            fw[s2] = *(const bf16x8*)(p.LR + (size_t)tokw * 256 + d * 64 + s2 * 32 + q * 8);
            fa[s2] = *(const bf16x8*)(p.LR + (size_t)tokw * 256 + 128 + d * 64 + s2 * 32 + q * 8);
        }
        const bf16_t* w2 = p.WT_W2 + ((size_t)d * NPAD(RW) + h * 64) * 64; const bf16_t* a2 = p.WT_A2 + ((size_t)d * NPAD(RW) + h * 64) * 64;
        const float* w0 = p.in[I_RW0] + (size_t)(l * 2 + d) * RW + h * 64; const float* a0 = p.in[I_RA0] + (size_t)(l * 2 + d) * RW + h * 64;
#pragma unroll
        for (int nt = 0; nt < 4; ++nt) {
            f32x4 cw = {0.f, 0.f, 0.f, 0.f}, ca = {0.f, 0.f, 0.f, 0.f};
#pragma unroll
            for (int s2 = 0; s2 < 2; ++s2) {
                const bf16x8 bw = *(const bf16x8*)(w2 + (size_t)(nt * 16 + r) * 64 + s2 * 32 + q * 8), ba = *(const bf16x8*)(a2 + (size_t)(nt * 16 + r) * 64 + s2 * 32 + q * 8);
                cw = MFMA16(fw[s2], bw, cw); ca = MFMA16(fa[s2], ba, ca);
            }
            const float w0c = w0[nt * 16 + r], a0c = a0[nt * 16 + r];
#pragma unroll
            for (int e = 0; e < 4; ++e) {
                const int i = 16 * wv + 4 * q + e;
                X[i * 132 + nt * 16 + r] = -fexp_(-softplusf_(-(w0c + cw[e])) - 0.5f);
                X[i * 132 + 64 + nt * 16 + r] = sigmoidf_(a0c + ca[e]);
            }
        }
    }
    __syncthreads();
    {
        const int k = tid & 63, seg = tid >> 6;
        float v[16]; float run = 0.f;
#pragma unroll
        for (int e = 0; e < 16; ++e) { run += X[(seg * 16 + e) * 132 + k]; v[e] = run; }
        AABt[seg * 64 + k] = run;
        __syncthreads();
        float off = 0.f;
        for (int s2 = 0; s2 < seg; ++s2) off += AABt[s2 * 64 + k];
#pragma unroll
        for (int e = 0; e < 16; ++e) X[(seg * 16 + e) * 132 + k] = v[e] + off;
    }
    __syncthreads();
#pragma unroll
    for (int it = 0; it < 2; ++it) {
        const int c = tid + 256 * it, i = c >> 3, k0 = (c & 7) * 8;
        float L[8], Lp[8], LC[8], kkv[8], rv[8], vv[8], kdv[8], bbv[8], aav[8], ksv[8], kav[8], rkv[8];
        load8f(X + i * 132 + k0, L); load8f(X + 63 * 132 + k0, LC); load8f(X + i * 132 + 64 + k0, aav);
        load8f(p.in[I_RKA] + (size_t)l * RW + h * 64 + k0, kav); load8f(p.in[I_RRK] + (size_t)l * RW + h * 64 + k0, rkv);
        if (i > 0) load8f(X + (i - 1) * 132 + k0, Lp);
        else {
#pragma unroll
            for (int e = 0; e < 8; ++e) Lp[e] = 0.f;
        }
        unpack8(gkk[it], kkv); unpack8(gr[it], rv); unpack8(gv[it], vv); unpack8(gks[it], ksv);
        float bon = 0.f;
#pragma unroll
        for (int e = 0; e < 8; ++e) { kdv[e] = ksv[e] * (1.0f + (aav[e] - 1.0f) * kav[e]); bbv[e] = kkv[e] * aav[e]; bon += rv[e] * kdv[e] * rkv[e]; }
        bon += __shfl_xor(bon, 1, 64); bon += __shfl_xor(bon, 2, 64); bon += __shfl_xor(bon, 4, 64);
        if ((tid & 7) == 0) p.BONUS[((size_t)d * MTOT + 64 * n + (d ? 63 - i : i)) * RH + h] = bon;
        float at[8], rt[8], bt[8], kt[8], bh[8], kh[8];
#pragma unroll
        for (int e = 0; e < 8; ++e) {
            const float eL = fexp_(L[e]), eLp = fexp_(Lp[e]), eNL = fexp_(-L[e]), eCL = fexp_(LC[e] - L[e]);
            at[e] = -kkv[e] * eLp; rt[e] = rv[e] * eL; bt[e] = bbv[e] * eNL; kt[e] = kdv[e] * eNL; bh[e] = bbv[e] * eCL; kh[e] = kdv[e] * eCL;
            if (i == 63) GC[k0 + e] = eL;
        }
        *(u32x4*)(S0 + i * CH_ROW + k0) = pack8(at);
        store8f(X + i * 132 + 64 + k0, at);
        *(u32x4*)(S1 + i * CH_ROW + k0) = pack8(rt);
        *(u32x4*)(S2 + i * CH_ROW + k0) = pack8(bt);
        *(u32x4*)(S3 + i * CH_ROW + k0) = pack8(kt);
#pragma unroll
        for (int e = 0; e < 8; ++e) {
            S4[(k0 + e) * CH_ROW + i] = f2bf(vv[e]);
            S5[(k0 + e) * CH_ROW + i] = f2bf(bh[e]);
            S6[(k0 + e) * CH_ROW + i] = f2bf(kh[e]);
        }
    }
    __syncthreads();
    {
        f32x4 acc[4][4]; ZERO_ACC4(acc);
        lds_mm<4, 4>((wv < 2) ? S0 : S1, 0, (wv & 1) ? S3 : S2, 0, acc);
        __syncthreads();
#pragma unroll
        for (int mt = 0; mt < 4; ++mt)
#pragma unroll
            for (int nt = 0; nt < 4; ++nt) {
                const int jc = nt * 16 + r, i0 = mt * 16 + 4 * q;
                if (wv == 0) {
                    f32x4 o;
#pragma unroll
                    for (int e = 0; e < 4; ++e) o[e] = (jc < i0 + e) ? acc[mt][nt][e] : 0.f;
                    *(f32x4*)(AABt + jc * 72 + i0) = o;
                } else {
                    bf16_t* dst = (wv == 1) ? S0 : ((wv == 2) ? S2 : S3);
#pragma unroll
                    for (int e = 0; e < 4; ++e) {
                        const bool ok = (wv == 1) ? (jc < i0 + e) : (jc <= i0 + e);
                        dst[(i0 + e) * CH_ROW + jc] = f2bf(ok ? acc[mt][nt][e] : 0.f);
                    }
                }
            }
    }
    __syncthreads();
    {
        f32x4 acc[1][4];
#pragma unroll
        for (int nt = 0; nt < 4; ++nt) acc[0][nt] = (f32x4){0.f, 0.f, 0.f, 0.f};
        lds_mm<1, 4>(S0, 16 * wv, S4, 0, acc);
#pragma unroll
        for (int nt = 0; nt < 4; ++nt)
#pragma unroll
            for (int e = 0; e < 4; ++e) X[(16 * wv + 4 * q + e) * 132 + nt * 16 + r] = acc[0][nt][e];
    }
    __syncthreads();
    if (tid < 128) {
        const int c = tid;
        for (int bi = 0; bi < 4; ++bi) {
            float acc[16];
#pragma unroll
            for (int e = 0; e < 16; ++e) acc[e] = X[(16 * bi + e) * 132 + c];
            for (int jj = 0; jj < 16 * bi; ++jj) {
                const float uj = X[jj * 132 + c];
                const f32x4* ap = (const f32x4*)(AABt + jj * 72 + 16 * bi);
                const f32x4 a0 = ap[0], a1 = ap[1], a2 = ap[2], a3 = ap[3];
#pragma unroll
                for (int e = 0; e < 4; ++e) { acc[e] += a0[e] * uj; acc[4 + e] += a1[e] * uj; acc[8 + e] += a2[e] * uj; acc[12 + e] += a3[e] * uj; }
            }
#pragma unroll
            for (int e = 0; e < 16; ++e) {
                const float u = acc[e];
                X[(16 * bi + e) * 132 + c] = u;
                const f32x4* ap = (const f32x4*)(AABt + (16 * bi + e) * 72 + 16 * bi);
                const f32x4 a0 = ap[0], a1 = ap[1], a2 = ap[2], a3 = ap[3];
#pragma unroll
                for (int e2 = 0; e2 < 16; ++e2) if (e2 > e) acc[e2] += ((e2 < 4) ? a0[e2 & 3] : (e2 < 8) ? a1[e2 & 3] : (e2 < 12) ? a2[e2 & 3] : a3[e2 & 3]) * u;
            }
        }
    }
    __syncthreads();
    if (tid < 128) {
        const int c = tid;
        bf16_t* dst = (c < 64) ? (U0t + c * CH_ROW) : (Aht + (c - 64) * CH_ROW);
        u32x4 ov[8];
#pragma unroll
        for (int g = 0; g < 8; ++g) {
            float v[8];
#pragma unroll
            for (int e = 0; e < 8; ++e) v[e] = X[(g * 8 + e) * 132 + c];
            ov[g].x = pack2bf(v[0], v[1]); ov[g].y = pack2bf(v[2], v[3]);
            ov[g].z = pack2bf(v[4], v[5]); ov[g].w = pack2bf(v[6], v[7]);
        }
#pragma unroll
        for (int g = 0; g < 8; ++g) *(u32x4*)(dst + g * 8) = ov[g];
    }
    __syncthreads();
    {
        f32x4 acc[4][4]; ZERO_ACC4(acc);
        char* rec = p.REC + base * SEQ_REC;
        if (wv == 0) {
            lds_mm<4, 4>(Aht, 0, S5, 0, acc);
#pragma unroll
            for (int nt = 0; nt < 4; ++nt)
#pragma unroll
                for (int s2 = 0; s2 < 2; ++s2) {
                    u32x4 o;
                    o.x = pack2bf(acc[2 * s2][nt][0], acc[2 * s2][nt][1]); o.y = pack2bf(acc[2 * s2][nt][2], acc[2 * s2][nt][3]);
                    o.z = pack2bf(acc[2 * s2 + 1][nt][0], acc[2 * s2 + 1][nt][1]); o.w = pack2bf(acc[2 * s2 + 1][nt][2], acc[2 * s2 + 1][nt][3]);
                    *(u32x4*)(rec + (((nt * 2 + s2) * 64 + lane) * 8) * 2) = o;
                }
        } else if (wv == 1) {
            lds_mm<4, 4>(S5, 0, U0t, 0, acc);
            lds_mm<4, 4>(S6, 0, S4, 0, acc);
#pragma unroll
            for (int mt = 0; mt < 4; ++mt)
#pragma unroll
                for (int nt = 0; nt < 4; ++nt) *(u32x2*)(rec + 8192 + (((nt * 4 + mt) * 64 + lane) * 4) * 2) = pack4(acc[mt][nt][0], acc[mt][nt][1], acc[mt][nt][2], acc[mt][nt][3]);
        } else if (wv == 2) {
            lds_mm<4, 4>(S2, 0, Aht, 0, acc);
#pragma unroll
            for (int mt = 0; mt < 4; ++mt)
#pragma unroll
                for (int nt = 0; nt < 4; ++nt)
#pragma unroll
                    for (int e = 0; e < 4; ++e) {
                        const int t = mt * 16 + 4 * q + e, kc = nt * 16 + r;
                        p.QH[(base * 64 + t) * 64 + kc] = f2bf(acc[mt][nt][e] + bf2f(S1[t * CH_ROW + kc]));
                    }
        } else if (wv == 3) {
            lds_mm<4, 4>(S2, 0, U0t, 0, acc);
            lds_mm<4, 4>(S3, 0, S4, 0, acc);
#pragma unroll
            for (int mt = 0; mt < 4; ++mt)
#pragma unroll
                for (int nt = 0; nt < 4; ++nt) *(f32x4*)(p.Y0T + (((base * 4 + mt) * 4 + nt) * 64 + lane) * 4) = acc[mt][nt];
        }
        if (tid < 64) ((float*)(rec + 16384))[tid] = GC[tid];
    }
}

#define SEQ_SLOT 16896
__device__ __forceinline__ void rwkv_seq_gload(const P& p, size_t base, int tid, u32x4 (&g)[5]) {
    const u32x4* m = (const u32x4*)(p.REC + base * SEQ_REC);
#pragma unroll
    for (int i = 0; i < 4; ++i) g[i] = m[tid + 256 * i];
    if (tid < 16) g[4] = m[1024 + tid];
}
__device__ __forceinline__ void rwkv_seq_lstore(char* slot, int tid, const u32x4 (&g)[5]) {
    u32x4* d = (u32x4*)slot;
#pragma unroll
    for (int i = 0; i < 4; ++i) d[tid + 256 * i] = g[i];
    if (tid < 16) d[1024 + tid] = g[4];
}
__device__ __forceinline__ void rwkv_seq_step(const P& p, const char* slot, size_t base, int wv, int lane, f32x4 (&X)[4]) {
    const int q = lane >> 4, r = lane & 15;
    const bf16_t* mt = (const bf16_t*)slot; const bf16_t* ntb = (const bf16_t*)(slot + 8192); const float* gc = (const float*)(slot + 16384);
    unsigned xh[4][2];
#pragma unroll
    for (int kt = 0; kt < 4; ++kt) {
        xh[kt][0] = pack2bf(X[kt][0], X[kt][1]); xh[kt][1] = pack2bf(X[kt][2], X[kt][3]);
        *(u32x2*)(p.SN + (base * 64 + 16 * wv + r) * 64 + 16 * kt + 4 * q) = (u32x2){xh[kt][0], xh[kt][1]};
    }
    bf16x8 bh[2];
#pragma unroll
    for (int s2 = 0; s2 < 2; ++s2) bh[s2] = __builtin_bit_cast(bf16x8, ((u32x4){xh[2 * s2][0], xh[2 * s2][1], xh[2 * s2 + 1][0], xh[2 * s2 + 1][1]}));
#pragma unroll
    for (int tile = 0; tile < 4; ++tile) {
        const u32x2 nb = *(const u32x2*)(ntb + ((wv * 4 + tile) * 64 + lane) * 4);
        const f32x4 g4 = *(const f32x4*)(gc + tile * 16 + 4 * q);
        f32x4 acc;
        acc[0] = g4[0] * X[tile][0] + LO16(nb.x); acc[1] = g4[1] * X[tile][1] + HI16(nb.x);
        acc[2] = g4[2] * X[tile][2] + LO16(nb.y); acc[3] = g4[3] * X[tile][3] + HI16(nb.y);
#pragma unroll
        for (int s2 = 0; s2 < 2; ++s2) {
            const bf16x8 ah = *(const bf16x8*)(mt + ((tile * 2 + s2) * 64 + lane) * 8);
            acc = MFMA16(ah, bh[s2], acc);
        }
        X[tile] = acc;
    }
}
__device__ __forceinline__ void rwkv_seq_job(const P& p, int job, char* smem) {
    const int tid = otid(), lane = tid & 63, wv = tid >> 6;
    const int d = job / RH, h = job % RH;
    f32x4 X[4];
#pragma unroll
    for (int kt = 0; kt < 4; ++kt) X[kt] = (f32x4){0.f, 0.f, 0.f, 0.f};
    u32x4 g0[5], g1[5], g2[5];
#define SEQ_BASE(s_) ((size_t)(d * NC + chunk_order(d, ((s_) < NC) ? (s_) : NC - 1)) * RH + h)
    __syncthreads();
    rwkv_seq_gload(p, SEQ_BASE(0), tid, g0);
    rwkv_seq_gload(p, SEQ_BASE(1), tid, g1);
    rwkv_seq_gload(p, SEQ_BASE(2), tid, g2);
    rwkv_seq_lstore(smem, tid, g0);
    __syncthreads();
    for (int s = 0; s < NC; s += 6) {
#define SEQ_SUB(u, GFREE, GNEXT) \
        if (s + (u) < NC) { \
            rwkv_seq_gload(p, SEQ_BASE(s + (u) + 3), tid, GFREE); \
            rwkv_seq_step(p, smem + (((u) & 1) ? SEQ_SLOT : 0), SEQ_BASE(s + (u)), wv, lane, X); \
            rwkv_seq_lstore(smem + (((u) & 1) ? 0 : SEQ_SLOT), tid, GNEXT); \
        } \
        __syncthreads();
        SEQ_SUB(0, g0, g1)
        SEQ_SUB(1, g1, g2)
        SEQ_SUB(2, g2, g0)
        SEQ_SUB(3, g0, g1)
        SEQ_SUB(4, g1, g2)
        SEQ_SUB(5, g2, g0)
#undef SEQ_SUB
    }
#undef SEQ_BASE
}
struct RoBuf { bf16x8 a[2]; bf16x8 b[4][2]; f32x4 y0[4]; };
__device__ __forceinline__ void rwkv_out_load(const P& p, int job, int wv, int lane, RoBuf& o) {
    const int q = lane >> 4, r = lane & 15;
    const size_t base = (size_t)job;
#pragma unroll
    for (int s2 = 0; s2 < 2; ++s2) {
        o.a[s2] = *(const bf16x8*)(p.QH + (base * 64 + 16 * wv + r) * 64 + s2 * 32 + q * 8);
#pragma unroll
        for (int nt = 0; nt < 4; ++nt) o.b[nt][s2] = *(const bf16x8*)(p.SN + (base * 64 + nt * 16 + r) * 64 + s2 * 32 + q * 8);
    }
#pragma unroll
    for (int nt = 0; nt < 4; ++nt) o.y0[nt] = *(const f32x4*)(p.Y0T + (((base * 4 + wv) * 4 + nt) * 64 + lane) * 4);
}
__device__ __forceinline__ void rwkv_out_compute(const P& p, int job, int wv, int lane, const RoBuf& o) {
    const int q = lane >> 4, r = lane & 15;
    const int d = job / (NC * RH), n = (job / RH) % NC, h = job % RH;
#pragma unroll
    for (int nt = 0; nt < 4; ++nt) {
        f32x4 acc = o.y0[nt];
        acc = MFMA16(o.a[0], o.b[nt][0], acc);
        acc = MFMA16(o.a[1], o.b[nt][1], acc);
#pragma unroll
        for (int e = 0; e < 4; ++e) {
            const int t = 16 * wv + 4 * q + e; const int tok = 64 * n + (d ? 63 - t : t);
            p.Y[((size_t)d * MTOT + tok) * RW + h * 64 + nt * 16 + r] = acc[e];
        }
    }
}
__device__ __forceinline__ void phase_rwkv_out(const P& p) {
    const int tid = otid(), lane = tid & 63, wv = tid >> 6;
    if (wv >= 4) return;
    const int G = gridDim.x, total = 2 * NC * RH;
    int job = obid();
    if (job >= total) return;
    RoBuf b0, b1;
    rwkv_out_load(p, job, wv, lane, b0);
    for (; job < total; job += 2 * G) {
        if (job + G < total) rwkv_out_load(p, job + G, wv, lane, b1);
        rwkv_out_compute(p, job, wv, lane, b0);
        if (job + G < total) {
            if (job + 2 * G < total) rwkv_out_load(p, job + 2 * G, wv, lane, b0);
            rwkv_out_compute(p, job + G, wv, lane, b1);
        }
    }
}

#define GL_QR 0
#define GL_KR 9216
#define GL_VT 18432
#define GL_QI 36864
#define GL_KI 46080
#define GL_AT 55296
#define GL_CUM 64512
#define GL_ALR 81920
#define GL_WA 86016
__device__ __forceinline__ void gla_load_qkv(const P& p, int n, int h, char* smem) {
    const int tid = otid();
    bf16_t* Qr = (bf16_t*)(smem + GL_QR); bf16_t* Kr = (bf16_t*)(smem + GL_KR); bf16_t* Vt = (bf16_t*)(smem + GL_VT);
    for (int c = tid; c < 512; c += NTHREADS) {
        const int row = c >> 3, part = c & 7; const int t = gla_tok(n, row);
        const u32x4 qv = *(const u32x4*)(p.Z + (size_t)t * ZLD + ZQ + h * 64 + part * 8);
        const u32x4 kv = *(const u32x4*)(p.Z + (size_t)t * ZLD + ZK + h * 64 + part * 8);
        u32x4 qs;
        qs.x = pack2bf(LO16(qv.x) * 0.125f, HI16(qv.x) * 0.125f);
        qs.y = pack2bf(LO16(qv.y) * 0.125f, HI16(qv.y) * 0.125f);
        qs.z = pack2bf(LO16(qv.z) * 0.125f, HI16(qv.z) * 0.125f);
        qs.w = pack2bf(LO16(qv.w) * 0.125f, HI16(qv.w) * 0.125f);
        *(u32x4*)(Qr + row * CH_ROW + part * 8) = qs;
        *(u32x4*)(Kr + row * CH_ROW + part * 8) = kv;
    }
    for (int c = tid; c < 1024; c += NTHREADS) {
        const int row = c >> 4, part = c & 15; const int t = gla_tok(n, row);
        const u32x4 vv = *(const u32x4*)(p.Z + (size_t)t * ZLD + ZV + h * 128 + part * 8);
        bf16_t* dst = Vt + (part * 8) * CH_ROW + row;
        dst[0 * CH_ROW] = (bf16_t)(vv.x & 0xFFFF); dst[1 * CH_ROW] = (bf16_t)(vv.x >> 16);
        dst[2 * CH_ROW] = (bf16_t)(vv.y & 0xFFFF); dst[3 * CH_ROW] = (bf16_t)(vv.y >> 16);
        dst[4 * CH_ROW] = (bf16_t)(vv.z & 0xFFFF); dst[5 * CH_ROW] = (bf16_t)(vv.z >> 16);
        dst[6 * CH_ROW] = (bf16_t)(vv.w & 0xFFFF); dst[7 * CH_ROW] = (bf16_t)(vv.w >> 16);
    }
}
__device__ __forceinline__ void gla_cum(const P& p, int l, int n, int h, int d, char* smem) {
    const int tid = otid();
    float* CUM = (float*)(smem + GL_CUM); float* ALR = (float*)(smem + GL_ALR); float* WA = (float*)(smem + GL_WA);
    for (int c = tid; c < 256; c += NTHREADS) {
        const int row = c >> 2, part = c & 3; const int t = gla_tok(n, row);
        const u32x2 a = *(const u32x2*)(p.Z + (size_t)t * ZLD + (d ? ZAB : ZAF) + part * 4);
        float* dst = ALR + row * 16 + part * 4;
        dst[0] = LO16(a.x); dst[1] = HI16(a.x); dst[2] = LO16(a.y); dst[3] = HI16(a.y);
    }
    for (int c = tid; c < 16 * 64 + 64; c += NTHREADS) {
        if (c < 1024) WA[c] = p.in[I_GLA_WA2][((size_t)(l * 2 + d) * 16 + (c >> 6)) * GLA_K + h * 64 + (c & 63)];
        else WA[c] = p.in[I_GLA_BA][(size_t)(l * 2 + d) * GLA_K + h * 64 + (c - 1024)];
    }
    __syncthreads();
    for (int idx = tid; idx < 4096; idx += NTHREADS) {
        const int i = idx >> 6, k = idx & 63;
        float a = WA[1024 + k];
#pragma unroll
        for (int r = 0; r < 16; ++r) a += ALR[i * 16 + r] * WA[r * 64 + k];
        CUM[i * 68 + k] = (fminf(a, 0.f) - flog_(1.0f + fexp_(-fabsf(a)))) * (1.0f / 16.0f);
    }
    __syncthreads();
    {
        const int k = tid & 63, seg = (tid >> 6) & 3;
        float v[16]; float run = 0.f;
        if (tid < 256) {
#pragma unroll
            for (int e = 0; e < 16; ++e) { const int pos = seg * 16 + e; const int i = d ? 63 - pos : pos; run += CUM[i * 68 + k]; v[e] = run; }
            ALR[seg * 64 + k] = run;
        }
        __syncthreads();
        if (tid < 256) {
            float off = 0.f;
            for (int s2 = 0; s2 < seg; ++s2) off += ALR[s2 * 64 + k];
#pragma unroll
            for (int e = 0; e < 16; ++e) { const int pos = seg * 16 + e; const int i = d ? 63 - pos : pos; CUM[i * 68 + k] = v[e] + off; }
        }
    }
    __syncthreads();
}
__device__ __forceinline__ void phase_gla_kv(const P& p, int l, char* smem) {
    const int tid = otid(), lane = tid & 63, wv = tid >> 6, q = lane >> 4, r = lane & 15;
    bf16_t* Kr = (bf16_t*)(smem + GL_KR); bf16_t* Vt = (bf16_t*)(smem + GL_VT); bf16_t* KdT = (bf16_t*)(smem + GL_KI);
    float* CUM = (float*)(smem + GL_CUM);
    for (int job = obid(); job < NC * GH; job += gridDim.x) {
        const int n = job / GH, h = job % GH;
        __syncthreads();
        gla_load_qkv(p, n, h, smem);
        for (int d = 0; d < 2; ++d) {
            gla_cum(p, l, n, h, d, smem);
            const int li = d ? 0 : 63;
            for (int idx = tid; idx < 4096; idx += NTHREADS) {
                const int i = idx >> 6, k = idx & 63;
                KdT[k * CH_ROW + i] = f2bf(bf2f(Kr[i * CH_ROW + k]) * fexp_(CUM[li * 68 + k] - CUM[i * 68 + k]));
            }
            if (tid < 64) p.DEC[((size_t)(d * NC + n) * GH + h) * 64 + tid] = fexp_(CUM[li * 68 + tid]);
            __syncthreads();
            float* kvt = p.KV + ((size_t)(d * NC + n) * GH + h) * 8192;
            for (int mt = wv; mt < 4; mt += NTHREADS / 64) {
                f32x4 acc[1][8];
#pragma unroll
                for (int nt = 0; nt < 8; ++nt) acc[0][nt] = (f32x4){0.f, 0.f, 0.f, 0.f};
                lds_mm<1, 8>(KdT, 16 * mt, Vt, 0, acc);
#pragma unroll
                for (int nt = 0; nt < 8; ++nt) *(f32x4*)(kvt + (size_t)(nt * 16 + r) * 64 + 16 * mt + 4 * q) = acc[0][nt];
            }
            __syncthreads();
        }
    }
    __syncthreads();
}
__device__ __forceinline__ void gla_scan_job(const P& p, int job) {
    const int base = job * NTHREADS + otid();
    const int d = base / (GH * 8192), h = (base / 8192) % GH, e = base % 8192;
    const float* __restrict__ kvp = p.KV; const float* __restrict__ decp = p.DEC; bf16_t* __restrict__ sp = p.SP;
    float S = 0.f;
    for (int s = 0; s < NC; s += 4) {
        float kv[4], dc[4]; size_t oo[4];
#pragma unroll
        for (int u = 0; u < 4; ++u) {
            const int n = chunk_order(d, (s + u < NC) ? s + u : NC - 1);
            oo[u] = ((size_t)(d * NC + n) * GH + h);
            kv[u] = kvp[oo[u] * 8192 + e]; dc[u] = decp[oo[u] * 64 + (e & 63)];
        }
#pragma unroll
        for (int u = 0; u < 4; ++u) if (s + u < NC) { sp[oo[u] * 8192 + e] = f2bf(S); S = dc[u] * S + kv[u]; }
    }
}
__device__ __forceinline__ void phase_gla_out(const P& p, int l, char* smem) {
    const int tid = otid(), lane = tid & 63, wv = tid >> 6, q = lane >> 4, r = lane & 15;
    bf16_t* Qr = (bf16_t*)(smem + GL_QR); bf16_t* Kr = (bf16_t*)(smem + GL_KR); bf16_t* Vt = (bf16_t*)(smem + GL_VT);
    bf16_t* Qi = (bf16_t*)(smem + GL_QI); bf16_t* Ki = (bf16_t*)(smem + GL_KI); bf16_t* At = (bf16_t*)(smem + GL_AT);
    float* CUM = (float*)(smem + GL_CUM);
    for (int job = obid(); job < NC * GH; job += gridDim.x) {
        const int n = job / GH, h = job % GH;
        __syncthreads();
        gla_load_qkv(p, n, h, smem);
        f32x4 o[1][8];
#pragma unroll
        for (int nt = 0; nt < 8; ++nt) o[0][nt] = (f32x4){0.f, 0.f, 0.f, 0.f};
        for (int d = 0; d < 2; ++d) {
            gla_cum(p, l, n, h, d, smem);
            for (int idx = tid; idx < 4096; idx += NTHREADS) {
                const int i = idx >> 6, k = idx & 63; const float c = CUM[i * 68 + k];
                Qi[i * CH_ROW + k] = f2bf(bf2f(Qr[i * CH_ROW + k]) * fexp_(c));
                Ki[i * CH_ROW + k] = f2bf(bf2f(Kr[i * CH_ROW + k]) * fexp_(-c));
            }
            __syncthreads();
            if (wv < 4) {
                f32x4 a[1][4];
#pragma unroll
                for (int nt = 0; nt < 4; ++nt) a[0][nt] = (f32x4){0.f, 0.f, 0.f, 0.f};
                lds_mm<1, 4>(Qi, 16 * wv, Ki, 0, a);
#pragma unroll
                for (int nt = 0; nt < 4; ++nt)
#pragma unroll
                    for (int e = 0; e < 4; ++e) {
                        const int i = 16 * wv + 4 * q + e, j = nt * 16 + r;
                        const bool ok = d ? (j >= i) : (j <= i);
                        At[i * CH_ROW + j] = f2bf(ok ? a[0][nt][e] : 0.f);
                    }
                WAVE_SYNC();
                lds_mm<1, 8>(At, 16 * wv, Vt, 0, o);
                const bf16_t* sp = p.SP + ((size_t)(d * NC + n) * GH + h) * 8192;
#pragma unroll
                for (int s2 = 0; s2 < 2; ++s2) {
                    const bf16x8 af = *(const bf16x8*)(Qi + (16 * wv + r) * CH_ROW + s2 * 32 + q * 8);
#pragma unroll
                    for (int nt = 0; nt < 8; ++nt) {
                        const bf16x8 bfr = *(const bf16x8*)(sp + (size_t)(nt * 16 + r) * 64 + s2 * 32 + q * 8);
                        o[0][nt] = MFMA16(af, bfr, o[0][nt]);
                    }
                }
            }
            __syncthreads();
        }
        if (wv < 4) {
#pragma unroll
            for (int nt = 0; nt < 8; ++nt)
#pragma unroll
                for (int e = 0; e < 4; ++e) {
                    const int t = gla_tok(n, 16 * wv + 4 * q + e);
                    p.OGLA[(size_t)t * GLA_V + h * 128 + nt * 16 + r] = o[0][nt][e];
                }
        }
    }
    __syncthreads();
}

#define S5_XH_OFF (2 * 64 * 132 * 4)
#define S5_XL_OFF (S5_XH_OFF + 64 * 136 * 2)
#define S5_CT_OFF (S5_XL_OFF + 64 * 136 * 2)
__device__ __forceinline__ void phase_s5_pass(const P& p, int l, char* smem, bool with_out) {
    const int tid = otid(), lane = tid & 63, wv = tid >> 6, q = lane >> 4, r = lane & 15;
    float* BU = (float*)smem; bf16_t* XH = (bf16_t*)(smem + S5_XH_OFF); bf16_t* XL = (bf16_t*)(smem + S5_XL_OFF); bf16_t* CTp = (bf16_t*)(smem + S5_CT_OFF);
    const int dW = (wv >> 1) & 1, ntb = (wv & 1) * 4;
    const int dS = (tid >> 6) & 1, st = tid & 63;
    bf16x8 bhi[4], blo[4];
    float are = 0.f, aim = 0.f, dco = 0.f;
    int cur_g = -1;
    const bf16x8 zero8 = {0, 0, 0, 0, 0, 0, 0, 0};
    bf16x8 a_cur[4]; float2 car_cur = {0.f, 0.f};
#define S5_FETCH(JOB, A, CAR) { const int n_ = (JOB) / SG, g_ = (JOB) % SG; \
        if (wv < 4) { _Pragma("unroll") for (int mt = 0; mt < 4; ++mt) A[mt] = (q < 2) ? *(const bf16x8*)(p.Z + (size_t)(n_ * 64 + 16 * mt + r) * ZLD + ZS5 + g_ * 16 + 8 * q) : zero8; } \
        if (with_out && tid < 128) CAR = *(const float2*)(p.S5CAR + ((((size_t)dS * NC + n_) * SG + g_) * 64 + st) * 2); }
    if (obid() < NC * SG) S5_FETCH(obid(), a_cur, car_cur);
    for (int job = obid(); job < NC * SG; job += gridDim.x) {
        const int n = job / SG, g = job % SG;
        __syncthreads();
        if (g != cur_g) {
            cur_g = g;
            if (wv < 4) {
#pragma unroll
                for (int jn = 0; jn < 4; ++jn) {
                    const int kk = 16 * (ntb + jn) + r; const size_t ci = ((size_t)dW * SG + g) * 64 + (kk >> 1);
                    float f[8], lo[8];
#pragma unroll
                    for (int e = 0; e < 8; ++e) f[e] = (q < 2) ? p.S5BB[(ci * 16 + 8 * q + e) * 2 + (kk & 1)] : 0.f;
                    const u32x4 hv = pack8(f);
                    float hf[8]; unpack8(hv, hf);
#pragma unroll
                    for (int e = 0; e < 8; ++e) lo[e] = f[e] - hf[e];
                    bhi[jn] = __builtin_bit_cast(bf16x8, hv); blo[jn] = __builtin_bit_cast(bf16x8, pack8(lo));
                }
            }
            if (tid < 128) { const size_t ci = ((size_t)dS * SG + g) * 64 + st; are = p.S5A[ci * 2]; aim = p.S5A[ci * 2 + 1]; }
            if (with_out) {
                for (int idx = tid; idx < 16 * 128; idx += NTHREADS) {
                    const int c = idx >> 7, kk = idx & 127;
                    const float v = (kk & 1) ? -p.in[I_S5CIM][((size_t)l * SG + g) * 1024 + c * 64 + (kk >> 1)] : p.in[I_S5CRE][((size_t)l * SG + g) * 1024 + c * 64 + (kk >> 1)];
                    CTp[c * 136 + kk] = f2bf(v);
                }
                dco = p.in[I_S5D][(size_t)l * SW + g * 16 + r];
            }
        }
        float xr = car_cur.x, xi = car_cur.y;
        const size_t eo = (((size_t)dS * NC + n) * SG + g) * 64 + st;
        unsigned short uu[4] = {0, 0, 0, 0};
        if (with_out && wv < 4) {
#pragma unroll
            for (int e = 0; e < 4; ++e) uu[e] = p.Z[(size_t)(n * 64 + 16 * wv + 4 * q + e) * ZLD + ZS5 + g * 16 + r];
        }
        if (wv < 4) {
#pragma unroll
            for (int mt = 0; mt < 4; ++mt) {
                const bf16x8 a = a_cur[mt];
#pragma unroll
                for (int jn = 0; jn < 4; ++jn) {
                    f32x4 acc = {0.f, 0.f, 0.f, 0.f};
                    acc = MFMA16(a, bhi[jn], acc);
                    acc = MFMA16(a, blo[jn], acc);
#pragma unroll
                    for (int e = 0; e < 4; ++e) BU[(dW * 64 + 16 * mt + 4 * q + e) * 132 + 16 * (ntb + jn) + r] = acc[e];
                }
            }
        }
        if (job + (int)gridDim.x < NC * SG) S5_FETCH(job + (int)gridDim.x, a_cur, car_cur);
        __syncthreads();
        if (tid < 128) {
            float2* bp0 = (float2*)(BU + (dS * 64 + (dS ? 63 : 0)) * 132 + st * 2);
#define S5_SCAN(SGN) { _Pragma("unroll 1") for (int ib = 0; ib < 4; ++ib) { float2 bv[16]; \
                _Pragma("unroll") for (int u = 0; u < 16; ++u) bv[u] = bp0[(SGN) * (ib * 16 + u) * 66]; \
                _Pragma("unroll") for (int u = 0; u < 16; ++u) { \
                    const float nr = are * xr - aim * xi + bv[u].x, ni = are * xi + aim * xr + bv[u].y; xr = nr; xi = ni; \
                    if (with_out) { float2 o; o.x = xr; o.y = xi; bp0[(SGN) * (ib * 16 + u) * 66] = o; } } } }
            if (dS) S5_SCAN(-1) else S5_SCAN(1)
            if (!with_out) { float2 o; o.x = xr; o.y = xi; *(float2*)(p.S5END + eo * 2) = o; }
        }
        if (with_out) {
            __syncthreads();
            for (int cidx = tid; cidx < 64 * 16; cidx += NTHREADS) {
                const int i = cidx >> 4, k0 = (cidx & 15) * 8;
                float a[8], b[8], lo[8];
                load8f(BU + (0 * 64 + i) * 132 + k0, a); load8f(BU + (1 * 64 + i) * 132 + k0, b);
#pragma unroll
                for (int e = 0; e < 8; ++e) a[e] += b[e];
                const u32x4 hv = pack8(a);
                float hf[8]; unpack8(hv, hf);
#pragma unroll
                for (int e = 0; e < 8; ++e) lo[e] = a[e] - hf[e];
                *(u32x4*)(XH + i * 136 + k0) = hv; *(u32x4*)(XL + i * 136 + k0) = pack8(lo);
            }
            __syncthreads();
            if (wv < 4) {
                f32x4 acc = {0.f, 0.f, 0.f, 0.f};
#pragma unroll
                for (int ks = 0; ks < 4; ++ks) {
                    const bf16x8 ah = *(const bf16x8*)(XH + (16 * wv + r) * 136 + ks * 32 + q * 8), al = *(const bf16x8*)(XL + (16 * wv + r) * 136 + ks * 32 + q * 8);
                    const bf16x8 b = *(const bf16x8*)(CTp + r * 136 + ks * 32 + q * 8);
                    acc = MFMA16(ah, b, acc);
                    acc = MFMA16(al, b, acc);
                }
#pragma unroll
                for (int e = 0; e < 4; ++e) {
                    const int i = 16 * wv + 4 * q + e;
                    const float u = bf2f(uu[e]);
                    p.GY[(size_t)(n * 64 + i) * SW + g * 16 + r] = f2bf(geluf_(acc[e] + dco * u));
                }
            }
        }
    }
    __syncthreads();
}
__device__ __forceinline__ void s5_carry_job(const P& p, int job) {
    const int base = job * NTHREADS + otid();
    if (base >= 2 * SG * 64) return;
    const int d = base / (SG * 64), g = (base / 64) % SG, st = base % 64;
    const size_t ci = ((size_t)d * SG + g) * 64 + st;
    float ar = p.S5A[ci * 2], ai = p.S5A[ci * 2 + 1];
    for (int i = 0; i < 6; ++i) { const float nr = ar * ar - ai * ai, ni = 2.f * ar * ai; ar = nr; ai = ni; }
    const float2* __restrict__ endp = (const float2*)p.S5END; float2* __restrict__ carp = (float2*)p.S5CAR;
    float cr = 0.f, cim = 0.f;
    for (int s = 0; s < NC; s += 4) {
        float2 ev[4]; size_t eo[4];
#pragma unroll
        for (int u = 0; u < 4; ++u) {
            const int n = chunk_order(d, (s + u < NC) ? s + u : NC - 1);
            eo[u] = (((size_t)d * NC + n) * SG + g) * 64 + st;
            ev[u] = endp[eo[u]];
        }
#pragma unroll
        for (int u = 0; u < 4; ++u) if (s + u < NC) {
            float2 c; c.x = cr; c.y = cim; carp[eo[u]] = c;
            const float nr = ar * cr - ai * cim + ev[u].x, ni = ar * cim + ai * cr + ev[u].y;
            cr = nr; cim = ni;
        }
    }
}

__device__ __forceinline__ void phase_side_elem(const P& p, int l) {
    const int lane = otid() & 63;
    const int gw = (obid() * NTHREADS + otid()) >> 6, nw = (gridDim.x * NTHREADS) >> 6;
    const bool actg = lane * 8 < GLA_V, actr = lane * 8 < RW;
    float gng[8], lnw[8], lnb[8];
#pragma unroll
    for (int e = 0; e < 8; ++e) { gng[e] = 0.f; lnw[e] = 0.f; lnb[e] = 0.f; }
    if (actg) load8f(p.in[I_GLA_NG] + (size_t)l * 128 + ((lane * 8) & 127), gng);
    if (actr) { load8f(p.in[I_RLNW] + (size_t)l * RW + lane * 8, lnw); load8f(p.in[I_RLNB] + (size_t)l * RW + lane * 8, lnb); }
    for (int t = gw; t < MTOT; t += nw) {
        float og[8], zo[8], y0[8], y1[8], vv[8];
        const u32x4 z4 = {0u, 0u, 0u, 0u};
#pragma unroll
        for (int e = 0; e < 8; ++e) { og[e] = 0.f; y0[e] = 0.f; y1[e] = 0.f; }
        if (actg) load8f(p.OGLA + (size_t)t * GLA_V + lane * 8, og);
        unpack8(actg ? *(const u32x4*)(p.Z + (size_t)t * ZLD + ZOG + lane * 8) : z4, zo);
        if (actr) { load8f(p.Y + (size_t)t * RW + lane * 8, y0); load8f(p.Y + ((size_t)MTOT + t) * RW + lane * 8, y1); }
        unpack8(actr ? *(const u32x4*)(p.V + (size_t)t * RW + lane * 8) : z4, vv);
        float g2v[8]; unpack8(actr ? *(const u32x4*)(p.G2B + (size_t)t * RW + lane * 8) : z4, g2v);
        const int hh = (lane * 8) >> 6;
        const float bon = actr ? (p.BONUS[(size_t)t * RH + hh] + p.BONUS[((size_t)MTOT + t) * RH + hh]) : 0.f;
        float ss = 0.f;
#pragma unroll
        for (int e = 0; e < 8; ++e) ss += og[e] * og[e];
        ss += __shfl_xor(ss, 1, 64); ss += __shfl_xor(ss, 2, 64); ss += __shfl_xor(ss, 4, 64); ss += __shfl_xor(ss, 8, 64);
        const float rstd = rsqrtf(ss * (1.0f / 128.f) + 1e-6f);
        float br[8];
#pragma unroll
        for (int e = 0; e < 8; ++e) br[e] = og[e] * rstd * gng[e] * siluf_(zo[e]);
        if (actg) *(u32x4*)(p.BR + (size_t)t * 3 * BW + lane * 8) = pack8(br);
        float y[8]; float sm = 0.f;
#pragma unroll
        for (int e = 0; e < 8; ++e) { y[e] = y0[e] + y1[e]; sm += y[e]; }
        sm += __shfl_xor(sm, 1, 64); sm += __shfl_xor(sm, 2, 64); sm += __shfl_xor(sm, 4, 64);
        const float mu = sm * (1.0f / 64.f);
        float sv = 0.f;
#pragma unroll
        for (int e = 0; e < 8; ++e) { y[e] -= mu; sv += y[e] * y[e]; }
        sv += __shfl_xor(sv, 1, 64); sv += __shfl_xor(sv, 2, 64); sv += __shfl_xor(sv, 4, 64);
        const float rs = rsqrtf(sv * (1.0f / 64.f) + 64e-5f);
        float yn[8];
#pragma unroll
        for (int e = 0; e < 8; ++e) yn[e] = y[e] * rs * lnw[e] + lnb[e] + bon * vv[e];
#pragma unroll
        for (int e = 0; e < 8; ++e) yn[e] *= g2v[e];
        if (actr) *(u32x4*)(p.BR + (size_t)t * 3 * BW + BW + lane * 8) = pack8(yn);
    }
}

__device__ __forceinline__ void g2_gemm_job(const P& p, int job, char* smem) {
    const int ntn = NPAD(RW) / 128;
    gemm_tile_run<4, 8>(p.WT_G2, 128, (size_t)NPAD(RW) * 128 * 2, p.GS, 128, (size_t)MTOT * 128 * 2, 128, (job % ntn) * 128, (job / ntn) * 256, (bf16_t*)smem, NoPre(),
        [&](int, int, int m, int n, const f32x4 v) { if (n < RW) *(u32x2*)(p.G2B + (size_t)m * RW + n) = pack4(v[0], v[1], v[2], v[3]); });
}
#define G2_JOBS ((MTOT / 256) * (NPAD(RW) / 128))
__device__ __forceinline__ void phase_glu_gemm(const P& p, int l, char* smem) {
    gemm_phase<4>(p.WT_GLU, SW, (size_t)NPAD(2 * SW) * SW * 2, p.GY, SW, (size_t)MTOT * SW * 2, SW, 2 * SW, (bf16_t*)smem, NoPre(), NoPre(),
        [&](int, int, int m, int n, const f32x4 v) {
            *(unsigned*)(p.BR + (size_t)m * 3 * BW + 2 * BW + (n >> 1)) = pack2bf(v[0] * sigmoidf_(v[1]), v[2] * sigmoidf_(v[3]));
        });
}
__device__ __forceinline__ void phase_merge(const P& p, int l, char* smem) {
    const int ntn = D_MODEL / 128, ntm = (MTOT - 256) / 128;
    auto run = [&](auto mi_tag, int n0, int m0) {
        constexpr int MI = decltype(mi_tag)::value;
        f32x4 macc[4][MI];
#pragma unroll
        for (int i = 0; i < 4; ++i)
#pragma unroll
            for (int j = 0; j < MI; ++j) macc[i][j] = (f32x4){0.f, 0.f, 0.f, 0.f};
        const int lane = otid() & 63, wave = otid() >> 6;
        for (int b = 0; b < 3; ++b) {
            f32x4 acc[4][MI];
#pragma unroll
            for (int i = 0; i < 4; ++i)
#pragma unroll
                for (int j = 0; j < MI; ++j) acc[i][j] = (f32x4){0.f, 0.f, 0.f, 0.f};
            mfma_gemm_tile_t<4, MI>(p.WT_BR + (size_t)b * D_MODEL * BW, BW, (size_t)D_MODEL * BW * 2, p.BR + b * BW, 3 * BW, (size_t)MTOT * 3 * BW * 2 - b * BW * 2, BW, n0, m0, (bf16_t*)smem, acc);
#pragma unroll
            for (int ni = 0; ni < 4; ++ni)
#pragma unroll
                for (int mi = 0; mi < MI; ++mi) {
                    const int n = n0 + (wave >> 1) * 64 + ni * 16 + (lane >> 4) * 4, m = m0 + (wave & 1) * 16 * MI + mi * 16 + (lane & 15);
                    const u32x2 g = *(const u32x2*)(p.ZGT + ((((size_t)(m >> 4) * (3 * D_MODEL / 16) + ((b * D_MODEL + n) >> 4)) * 64 + lane) * 4));
                    macc[ni][mi][0] += LO16(g.x) * acc[ni][mi][0]; macc[ni][mi][1] += HI16(g.x) * acc[ni][mi][1];
                    macc[ni][mi][2] += LO16(g.y) * acc[ni][mi][2]; macc[ni][mi][3] += HI16(g.y) * acc[ni][mi][3];
                }
        }
#pragma unroll
        for (int ni = 0; ni < 4; ++ni)
#pragma unroll
            for (int mi = 0; mi < MI; ++mi) {
                const int n = n0 + (wave >> 1) * 64 + ni * 16 + (lane >> 4) * 4, m = m0 + (wave & 1) * 16 * MI + mi * 16 + (lane & 15);
                *(u32x2*)(p.M + (size_t)m * D_MODEL + n) = pack4(macc[ni][mi][0], macc[ni][mi][1], macc[ni][mi][2], macc[ni][mi][3]);
            }
    };
    for (int it = 0;; ++it) {
        int mt_, nt_; if (!tile_map(it, ntm, ntn, (ntn >= 8) ? 4 : 8, mt_, nt_)) break;
        run(std::integral_constant<int, 4>(), nt_ * 128, mt_ * 128);
    }
    for (int job = obid(); job < 4 * ntn; job += gridDim.x) run(std::integral_constant<int, 2>(), (job >> 2) * 128, MTOT - 256 + (job & 3) * 64);
}

__device__ __forceinline__ void phase_outproj(const P& p, int l, char* smem) {
    gemm_phase<4>(p.WT_OUT, D_MODEL, (size_t)D_MODEL * D_MODEL * 2, p.M, D_MODEL, (size_t)MTOT * D_MODEL * 2, D_MODEL, D_MODEL, (bf16_t*)smem, NoPre(), NoPre(),
        [&](int, int, int m, int n, const f32x4 v) {
            const float* g1 = p.MOD + (size_t)(l * 2 + (m >= CTX ? 1 : 0)) * 6 * D_MODEL + 2 * D_MODEL + n;
            float4* xp = (float4*)(p.X + (size_t)m * D_MODEL + n); float4 x = *xp;
            x.x += g1[0] * v[0]; x.y += g1[1] * v[1]; x.z += g1[2] * v[2]; x.w += g1[3] * v[3]; *xp = x;
        });
}

__device__ __forceinline__ void store_q_hilo(const P& p, int m, int n, const f32x4 v) {
    const bf16_t h0 = f2bf(v[0]), h1 = f2bf(v[1]), h2 = f2bf(v[2]), h3 = f2bf(v[3]);
    u32x2 hv; hv.x = (unsigned)h0 | ((unsigned)h1 << 16); hv.y = (unsigned)h2 | ((unsigned)h3 << 16);
    *(u32x2*)(p.QHI + (size_t)m * PQ + n) = hv;
    *(u32x2*)(p.QLO + (size_t)m * PQ + n) = pack4(v[0] - bf2f(h0), v[1] - bf2f(h1), v[2] - bf2f(h2), v[3] - bf2f(h3));
}
__device__ __forceinline__ void phase_peer_q(const P& p, int l, char* smem) {
    gemm_phase<4>(p.WT_Q, D_MODEL, (size_t)PQ * D_MODEL * 2, p.H, D_MODEL, (size_t)MTOT * D_MODEL * 2, D_MODEL, PQ, (bf16_t*)smem, NoPre(), NoPre(),
        [&](int, int, int m, int n, const f32x4 v) { store_q_hilo(p, m, n, v); });
}

#define TK_ROW 129
__device__ __forceinline__ unsigned tk_key(float f, unsigned lowmask, unsigned low) {
    unsigned u = __builtin_bit_cast(unsigned, f);
    u ^= (u & 0x80000000u) ? 0xFFFFFFFFu : 0x80000000u;
    return (u & ~lowmask) | low;
}
#define TK_INSERT(lv, xk) { unsigned x_ = (xk); _Pragma("unroll") for (int z_ = 0; z_ < 16; ++z_) { const unsigned hi_ = lv[z_] > x_ ? lv[z_] : x_; x_ = lv[z_] > x_ ? x_ : lv[z_]; lv[z_] = hi_; } }
__device__ __forceinline__ void phase_peer_topk(const P& p, int l, char* smem) {
    const int tid = otid(), lane = tid & 63, wv = tid >> 6, q = lane >> 4, r = lane & 15;
    float* sc = (float*)smem + wv * (64 * TK_ROW);
    const int gw = (obid() * NTHREADS + tid) >> 6, nw = (gridDim.x * NTHREADS) >> 6;
    const float NEG = -3.0e38f;
    for (int job = gw; job < (MTOT / 32) * PH; job += nw) {
        const int t0 = (job / PH) * 32, h = job % PH;
#pragma unroll
        for (int sd = 0; sd < 2; ++sd) {
            f32x4 acc[2][8];
#pragma unroll
            for (int mt = 0; mt < 2; ++mt)
#pragma unroll
                for (int nt = 0; nt < 8; ++nt) acc[mt][nt] = (f32x4){0.f, 0.f, 0.f, 0.f};
#pragma unroll
            for (int ks = 0; ks < 4; ++ks) {
                bf16x8 ah[2], al[2];
#pragma unroll
                for (int mt = 0; mt < 2; ++mt) {
                    const size_t qo = (size_t)(t0 + mt * 16 + r) * PQ + h * 256 + sd * 128 + ks * 32 + q * 8;
                    ah[mt] = *(const bf16x8*)(p.QHI + qo); al[mt] = *(const bf16x8*)(p.QLO + qo);
                }
#pragma unroll
                for (int nt = 0; nt < 8; ++nt) {
                    const size_t ko = ((size_t)(h * 2 + sd) * 128 + nt * 16 + r) * 128 + ks * 32 + q * 8;
                    const bf16x8 bh = *(const bf16x8*)(p.KHI + ko), bl = *(const bf16x8*)(p.KLO + ko);
#pragma unroll
                    for (int mt = 0; mt < 2; ++mt) {
                        acc[mt][nt] = MFMA16(ah[mt], bh, acc[mt][nt]);
                        acc[mt][nt] = MFMA16(al[mt], bh, acc[mt][nt]);
                        acc[mt][nt] = MFMA16(ah[mt], bl, acc[mt][nt]);
                    }
                }
            }
#pragma unroll
            for (int mt = 0; mt < 2; ++mt)
#pragma unroll
                for (int nt = 0; nt < 8; ++nt)
#pragma unroll
                    for (int e = 0; e < 4; ++e) sc[(sd * 32 + mt * 16 + 4 * q + e) * TK_ROW + nt * 16 + r] = acc[mt][nt][e];
        }
        WAVE_SYNC();
        unsigned lv[16];
#pragma unroll
        for (int z = 0; z < 16; ++z) lv[z] = 0u;
        {
            const float* row = sc + lane * TK_ROW;
#pragma unroll 4
            for (int k = 0; k < 128; ++k) TK_INSERT(lv, tk_key(row[k], 0x7Fu, (unsigned)(127 - k)));
        }
        float lvv[16]; int li[16];
        {
            const float* row = sc + lane * TK_ROW;
#pragma unroll
            for (int z = 0; z < 16; ++z) { li[z] = 127 - (int)(lv[z] & 0x7Fu); lvv[z] = row[li[z]]; }
        }
        WAVE_SYNC();
        {
            float* row = sc + lane * TK_ROW;
#pragma unroll
            for (int z = 0; z < 16; ++z) { row[z] = lvv[z]; ((int*)row)[16 + z] = li[z]; }
        }
        WAVE_SYNC();
        const float* r1 = sc + (lane & 31) * TK_ROW; const float* r2 = sc + (32 + (lane & 31)) * TK_ROW;
        unsigned tk[16];
#pragma unroll
        for (int z = 0; z < 16; ++z) tk[z] = 0u;
        for (int i = 0; i < 16; ++i) {
            const float a = r1[i];
            const int nj = 16 / (i + 1);
            for (int j = 0; j < nj; ++j) TK_INSERT(tk, tk_key(a + r2[j], 0xFFu, (unsigned)(255 - (i * 16 + j))));
        }
        int tc[16];
#pragma unroll
        for (int z = 0; z < 16; ++z) tc[z] = 255 - (int)(tk[z] & 0xFFu);
        if (lane < 32) {
            float vals[16]; float mx = 0.f; float ssum = 0.f;
#pragma unroll
            for (int z = 0; z < 16; ++z) { vals[z] = r1[tc[z] >> 4] + r2[tc[z] & 15]; if (z == 0) mx = vals[0]; vals[z] = fexp_(vals[z] - mx); ssum += vals[z]; }
            const float inv = 1.0f / ssum;
            const size_t o = (size_t)(t0 + lane) * PH * 16 + h * 16;
#pragma unroll
            for (int z = 0; z < 16; ++z) {
                const int ex_ = ((const int*)r1)[16 + (tc[z] >> 4)] * 128 + ((const int*)r2)[16 + (tc[z] & 15)];
                p.IDX[o + z] = ex_;
                p.G[o + z] = vals[z] * inv * p.VSC[ex_];
                p.GU[o + z] = p.USC[ex_];
            }
        }
        WAVE_SYNC();
    }
}

#define PEER_CONV_JOBS (2 * NEXP / 4)
__device__ __forceinline__ void peer_conv_job(const P& p, int l, int job) {
    const int tid = otid(), lane = tid & 63, wv = tid >> 6;
    if (wv >= 4) return;
    const int rowg = job * 4 + wv; const int which = rowg / NEXP, row = rowg % NEXP;
    const float* src = p.in[which ? I_PV : I_PU] + ((size_t)l * NEXP + row) * D_MODEL + lane * 16;
    const bool act = lane * 16 < D_MODEL;
    float v[16]; float amax = 0.f;
#pragma unroll
    for (int c = 0; c < 4; ++c) {
        float4 a; a.x = 0.f; a.y = 0.f; a.z = 0.f; a.w = 0.f;
        if (act) a = *(const float4*)(src + c * 4);
        v[c * 4 + 0] = a.x; v[c * 4 + 1] = a.y; v[c * 4 + 2] = a.z; v[c * 4 + 3] = a.w;
        amax = fmaxf(amax, fmaxf(fmaxf(fabsf(a.x), fabsf(a.y)), fmaxf(fabsf(a.z), fabsf(a.w))));
    }
#pragma unroll
    for (int m = 32; m >= 1; m >>= 1) amax = fmaxf(amax, __shfl_xor(amax, m, 64));
    int ex = 0;
    if (amax > 0.f) ex = 7 - (int)((__builtin_bit_cast(unsigned, amax) >> 23) & 0xFF) + 127;
    ex = ex < -100 ? -100 : (ex > 100 ? 100 : ex);
    const float sc = __builtin_bit_cast(float, (unsigned)(ex + 127) << 23), isc = __builtin_bit_cast(float, (unsigned)(127 - ex) << 23);
    u32x4 o;
    int w0 = 0, w1 = 0, w2 = 0, w3 = 0;
    w0 = CVT_PK_FP8(v[0] * sc, v[1] * sc, w0, false); w0 = CVT_PK_FP8(v[2] * sc, v[3] * sc, w0, true);
    w1 = CVT_PK_FP8(v[4] * sc, v[5] * sc, w1, false); w1 = CVT_PK_FP8(v[6] * sc, v[7] * sc, w1, true);
    w2 = CVT_PK_FP8(v[8] * sc, v[9] * sc, w2, false); w2 = CVT_PK_FP8(v[10] * sc, v[11] * sc, w2, true);
    w3 = CVT_PK_FP8(v[12] * sc, v[13] * sc, w3, false); w3 = CVT_PK_FP8(v[14] * sc, v[15] * sc, w3, true);
    o.x = (unsigned)w0; o.y = (unsigned)w1; o.z = (unsigned)w2; o.w = (unsigned)w3;
    unsigned char* dst = (which ? p.V8 : p.U8) + (size_t)row * D_MODEL + lane * 16;
    if (act) *(u32x4*)dst = o;
    if (lane == 0) (which ? p.VSC : p.USC)[row] = isc;
}
#define GE 4
struct GBuf { u32x4 u[GE]; u32x4 v[GE]; float gu; float gv; };
__device__ __forceinline__ void gather_load(const P& p, GBuf& b, int g, int idx0, int idx1, float g0, float g1, float u0, float u1, int lane) {
    const bool act = lane * 16 < D_MODEL;
#pragma unroll
    for (int q = 0; q < GE; ++q) {
        const int k = g * GE + q;
        const int ei = __shfl((k < 64) ? idx0 : idx1, k & 63, 64);
        b.u[q] = act ? *(const u32x4*)(p.U8 + (size_t)ei * D_MODEL + lane * 16) : (u32x4){0u, 0u, 0u, 0u};
        b.v[q] = act ? *(const u32x4*)(p.V8 + (size_t)ei * D_MODEL + lane * 16) : (u32x4){0u, 0u, 0u, 0u};
    }
    const int km = g * GE + ((lane >> 4) & 3);
    b.gv = __shfl((km < 64) ? g0 : g1, km & 63, 64);
    b.gu = __shfl((km < 64) ? u0 : u1, km & 63, 64);
}
__device__ __forceinline__ void gather_compute(const GBuf& b, const float (&hv)[16], float (&acc)[16], int lane) {
    float dt[GE];
#pragma unroll
    for (int q = 0; q < GE; ++q) {
        float d = 0.f;
#pragma unroll
        for (int c = 0; c < 4; ++c) {
            const f32x2 lo = CVT_PK_F32_FP8((int)b.u[q][c], false), hi = CVT_PK_F32_FP8((int)b.u[q][c], true);
            d += hv[c * 4 + 0] * lo.x + hv[c * 4 + 1] * lo.y + hv[c * 4 + 2] * hi.x + hv[c * 4 + 3] * hi.y;
        }
        dt[q] = d;
    }
    float r2[2], r1;
    {
        const bool up = (lane & 32) != 0;
#pragma unroll
        for (int q = 0; q < 2; ++q) { const float keep = up ? dt[2 + q] : dt[q], send = up ? dt[q] : dt[2 + q]; r2[q] = keep + __shfl_xor(send, 32, 64); }
    }
    {
        const bool up = (lane & 16) != 0;
        const float keep = up ? r2[1] : r2[0], send = up ? r2[0] : r2[1];
        r1 = keep + __shfl_xor(send, 16, 64);
    }
    r1 += __shfl_xor(r1, 8, 64); r1 += __shfl_xor(r1, 4, 64); r1 += __shfl_xor(r1, 2, 64); r1 += __shfl_xor(r1, 1, 64);
    const float coef_mine = b.gv * geluf_(r1 * b.gu);
#pragma unroll
    for (int q = 0; q < GE; ++q) {
        const float coef = __shfl(coef_mine, q * 16, 64);
#pragma unroll
        for (int c = 0; c < 4; ++c) {
            const f32x2 lo = CVT_PK_F32_FP8((int)b.v[q][c], false), hi = CVT_PK_F32_FP8((int)b.v[q][c], true);
            acc[c * 4 + 0] += coef * lo.x; acc[c * 4 + 1] += coef * lo.y; acc[c * 4 + 2] += coef * hi.x; acc[c * 4 + 3] += coef * hi.y;
        }
    }
}
__device__ __forceinline__ void phase_peer_gather(const P& p, int l) {
    const int lane = otid() & 63;
    const int gw = (obid() * NTHREADS + otid()) >> 6, nw = (gridDim.x * NTHREADS) >> 6;
    constexpr int NG = PH * 16 / GE;
    const bool act = lane * 16 < D_MODEL;
    for (int t = gw; t < MTOT; t += nw) {
        float hv[16], acc[16];
        {
            const u32x4 z4 = {0u, 0u, 0u, 0u};
            const u32x4 ha = act ? *(const u32x4*)(p.H + (size_t)t * D_MODEL + lane * 16) : z4;
            const u32x4 hb = act ? *(const u32x4*)(p.H + (size_t)t * D_MODEL + lane * 16 + 8) : z4;
            hv[0] = LO16(ha.x); hv[1] = HI16(ha.x); hv[2] = LO16(ha.y); hv[3] = HI16(ha.y); hv[4] = LO16(ha.z); hv[5] = HI16(ha.z); hv[6] = LO16(ha.w); hv[7] = HI16(ha.w);
            hv[8] = LO16(hb.x); hv[9] = HI16(hb.x); hv[10] = LO16(hb.y); hv[11] = HI16(hb.y); hv[12] = LO16(hb.z); hv[13] = HI16(hb.z); hv[14] = LO16(hb.w); hv[15] = HI16(hb.w);
#pragma unroll
            for (int j = 0; j < 16; ++j) acc[j] = 0.f;
        }
        int idx0 = 0, idx1 = 0; float g0 = 0.f, g1 = 0.f, u0 = 0.f, u1 = 0.f;
        if (lane < PH * 16) { idx0 = p.IDX[(size_t)t * PH * 16 + lane]; g0 = p.G[(size_t)t * PH * 16 + lane]; u0 = p.GU[(size_t)t * PH * 16 + lane]; }
        if (64 + lane < PH * 16) { idx1 = p.IDX[(size_t)t * PH * 16 + 64 + lane]; g1 = p.G[(size_t)t * PH * 16 + 64 + lane]; u1 = p.GU[(size_t)t * PH * 16 + 64 + lane]; }
        GBuf b0, b1, b2;
        gather_load(p, b0, 0, idx0, idx1, g0, g1, u0, u1, lane);
        gather_load(p, b1, 1, idx0, idx1, g0, g1, u0, u1, lane);
        for (int g = 0; g < NG; g += 3) {
            if (g + 2 < NG) gather_load(p, b2, g + 2, idx0, idx1, g0, g1, u0, u1, lane);
            gather_compute(b0, hv, acc, lane);
            if (g + 1 < NG) {
                if (g + 3 < NG) gather_load(p, b0, g + 3, idx0, idx1, g0, g1, u0, u1, lane);
                gather_compute(b1, hv, acc, lane);
            }
            if (g + 2 < NG) {
                if (g + 4 < NG) gather_load(p, b1, g + 4, idx0, idx1, g0, g1, u0, u1, lane);
                gather_compute(b2, hv, acc, lane);
            }
        }
        float xn[16]; float ss = 0.f;
#pragma unroll
        for (int j = 0; j < 16; ++j) xn[j] = 0.f;
        if (act) {
            const float* g2 = p.MOD + (size_t)(l * 2 + (t >= CTX ? 1 : 0)) * 6 * D_MODEL + 5 * D_MODEL + lane * 16;
            float* xp = p.X + (size_t)t * D_MODEL + lane * 16;
#pragma unroll
            for (int c = 0; c < 4; ++c) {
                float4 x = *(float4*)(xp + c * 4);
                x.x += g2[c * 4 + 0] * acc[c * 4 + 0]; x.y += g2[c * 4 + 1] * acc[c * 4 + 1]; x.z += g2[c * 4 + 2] * acc[c * 4 + 2]; x.w += g2[c * 4 + 3] * acc[c * 4 + 3];
                if (l + 1 < DEPTH) *(float4*)(xp + c * 4) = x;
                xn[c * 4 + 0] = x.x; xn[c * 4 + 1] = x.y; xn[c * 4 + 2] = x.z; xn[c * 4 + 3] = x.w;
                ss += x.x * x.x + x.y * x.y + x.z * x.z + x.w * x.w;
            }
        }
        ss = wave_sum(ss);
        const float rstd = rsqrtf(ss / D_MODEL + 1e-6f);
        if (act) {
            if (l + 1 < DEPTH) {
                const float* gn = p.in[I_N1G] + (size_t)(l + 1) * D_MODEL + lane * 16;
                const float* mod = p.MOD + (size_t)((l + 1) * 2 + (t >= CTX ? 1 : 0)) * 6 * D_MODEL + lane * 16;
                float o[16];
#pragma unroll
                for (int j = 0; j < 16; ++j) o[j] = xn[j] * rstd * gn[j] * (1.0f + mod[D_MODEL + j]) + mod[j];
                u32x4 w0, w1;
                w0.x = pack2bf(o[0], o[1]); w0.y = pack2bf(o[2], o[3]); w0.z = pack2bf(o[4], o[5]); w0.w = pack2bf(o[6], o[7]);
                w1.x = pack2bf(o[8], o[9]); w1.y = pack2bf(o[10], o[11]); w1.z = pack2bf(o[12], o[13]); w1.w = pack2bf(o[14], o[15]);
                *(u32x4*)(p.H + (size_t)t * D_MODEL + lane * 16) = w0; *(u32x4*)(p.H + (size_t)t * D_MODEL + lane * 16 + 8) = w1;
            } else if (t >= CTX) {
                const float* fg = p.in[I_FG] + lane * 16;
                float* op = p.out + (size_t)(t - CTX) * D_MODEL + lane * 16;
#pragma unroll
                for (int c = 0; c < 4; ++c) {
                    float4 o; o.x = xn[c * 4 + 0] * rstd * fg[c * 4 + 0]; o.y = xn[c * 4 + 1] * rstd * fg[c * 4 + 1]; o.z = xn[c * 4 + 2] * rstd * fg[c * 4 + 2]; o.w = xn[c * 4 + 3] * rstd * fg[c * 4 + 3];
                    *(float4*)(op + c * 4) = o;
                }
            }
        }
    }
}
__device__ __forceinline__ void phase_final(const P& p) {
    const int lane = otid() & 63;
    const int gw = (obid() * NTHREADS + otid()) >> 6, nw = (gridDim.x * NTHREADS) >> 6;
    const float* g = p.in[I_FG];
    for (int t = gw; t < SEQ; t += nw) {
        const float* x = p.X + (size_t)(CTX + t) * D_MODEL;
        float v[D_MODEL / 64]; float ss = 0.f;
#pragma unroll
        for (int j = 0; j < D_MODEL / 64; ++j) { v[j] = x[lane + 64 * j]; ss += v[j] * v[j]; }
        ss = wave_sum(ss);
        float rstd = rsqrtf(ss / D_MODEL + 1e-6f);
#pragma unroll
        for (int j = 0; j < D_MODEL / 64; ++j) p.out[(size_t)t * D_MODEL + lane + 64 * j] = v[j] * rstd * g[lane + 64 * j];
    }
}

__global__ void __launch_bounds__(NTHREADS) fwd_megakernel(P p_arg) {
#ifdef EMU
    char* smem = emu_smem();
#else
    __shared__ __attribute__((aligned(16))) char smem_raw[SMEM_BYTES + 16];
    char* smem = smem_raw;
#endif
#ifndef EMU
    volatile LAS unsigned* xst = (volatile LAS unsigned*)(smem_raw + SMEM_BYTES);
    if (threadIdx.x == 0) { xst[0] = 0u; xst[1] = 0u; xst[2] = 0u; xst[3] = 0u; }
    __syncthreads();
    XcdBarrier xb = xcd_barrier_post(p_arg.bar, xst);
#endif
    { LOADP(); phase_init(p, smem); }
#ifndef EMU
    GRID_SYNC_CG();
#endif
#ifdef EMU
    GRID_SYNC();
#endif
#ifndef EMU
    if (threadIdx.x == 0) {
        unsigned base_ = 0;
        for (unsigned j = 0; j < xb.x; ++j) base_ += xb_ld(&p_arg.bar[XB_XCNT(j)]);
        xst[2] = base_ + xst[3];
    }
    __syncthreads();
#endif
    PROBE_INIT();
    for (int l = 0; l < DEPTH; ++l) {
        if (l == 0) {
            { LOADP(); phase_norm(p, 0, 0); }
            { LOADP(); phase_s5const(p, 0); }
            { LOADP(); phase_convert_weights(p, 0, smem, obid(), (int)gridDim.x); }
            GRID_SYNC(); PROBE_AFTER(0);
        }
        { LOADP(); phase_gemm_in(p, l, smem); }
        GRID_SYNC(); PROBE_AFTER(1);
        { LOADP(); phase_rwkv_prep1(p, l); }
        GRID_SYNC(); PROBE_AFTER(14);
        { LOADP(); for (int job = obid(); job < 2 * NC * RH; job += gridDim.x) rwkv_chunk_job(p, l, job, smem); }
        __syncthreads(); PROBE_AFTER(20);
        { LOADP(); phase_gla_kv(p, l, smem); }
        PROBE_AFTER(21);
        { LOADP(); phase_s5_pass(p, l, smem, false); }
        GRID_SYNC(); PROBE_AFTER(3);
        {
            LOADP();
            const int n_rw = 2 * RH, n_gla = 2 * GH * 8192 / NTHREADS, n_s5 = (2 * SG * 64 + NTHREADS - 1) / NTHREADS;
            const int G_ = (int)gridDim.x;
            if (G_ > 2 * n_rw) {
                if (obid() < n_rw) { rwkv_seq_job(p, obid(), smem); PROBE_AFTER(24); }
                else {
                    const int nb = G_ - n_rw, bid = obid() - n_rw;
                    for (int job = bid; job < n_gla + n_s5 + PEER_CONV_JOBS; job += nb) {
                        if (job < n_gla) gla_scan_job(p, job);
                        else if (job < n_gla + n_s5) s5_carry_job(p, job - n_gla);
                        else peer_conv_job(p, l, job - n_gla - n_s5);
                    }
                    { P pg = p; late_select(pg, l & 1); for (int job = bid; job < G2_JOBS; job += nb) g2_gemm_job(pg, job, smem); }
                    if (l + 1 < DEPTH) { late_select(p, (l + 1) & 1); phase_convert_weights(p, l + 1, smem, bid, nb); }
                }
            } else {
                for (int job = obid(); job < n_rw + n_gla + n_s5 + PEER_CONV_JOBS; job += G_) {
                    if (job < n_rw) rwkv_seq_job(p, job, smem);
                    else if (job < n_rw + n_gla) gla_scan_job(p, job - n_rw);
                    else if (job < n_rw + n_gla + n_s5) s5_carry_job(p, job - n_rw - n_gla);
                    else peer_conv_job(p, l, job - n_rw - n_gla - n_s5);
                }
                __syncthreads();
                { P pg = p; late_select(pg, l & 1); for (int job = obid(); job < G2_JOBS; job += G_) g2_gemm_job(pg, job, smem); }
                if (l + 1 < DEPTH) { late_select(p, (l + 1) & 1); phase_convert_weights(p, l + 1, smem, obid(), G_); }
            }
        }
        GRID_SYNC(); PROBE_AFTER(4);
        { LOADP(); phase_rwkv_out(p); }
        PROBE_AFTER(22);
        { LOADP(); phase_gla_out(p, l, smem); }
        PROBE_AFTER(23);
        { LOADP(); phase_s5_pass(p, l, smem, true); }
        GRID_SYNC(); PROBE_AFTER(5);
        { LOADP(); phase_side_elem(p, l); }
        if (l + 1 < DEPTH) { LOADP(); phase_s5const(p, l + 1); }
        { LOADP(); late_select(p, l & 1); phase_glu_gemm(p, l, smem); }
        GRID_SYNC(); PROBE_AFTER(7);
        { LOADP(); late_select(p, l & 1); phase_merge(p, l, smem); }
        GRID_SYNC(); PROBE_AFTER(8);
        { LOADP(); late_select(p, l & 1); phase_outproj(p, l, smem); }
        GRID_SYNC(); PROBE_AFTER(9);
        { LOADP(); phase_norm(p, l, 1); }
        GRID_SYNC(); PROBE_AFTER(10);
        { LOADP(); late_select(p, l & 1); phase_peer_q(p, l, smem); }
        GRID_SYNC(); PROBE_AFTER(11);
        { LOADP(); late_select(p, l & 1); phase_peer_topk(p, l, smem); }
        GRID_SYNC(); PROBE_AFTER(12);
        { LOADP(); phase_peer_gather(p, l); }
        if (l + 1 < DEPTH) { GRID_SYNC(); PROBE_AFTER(13); }
    }
}

static inline size_t align_up(size_t x) { return (x + 255) & ~(size_t)255; }

extern "C" void kernel_launch(void* const* d_in, const int* in_sizes, int n_in, void* d_out, int out_size, void* d_ws, size_t ws_size, hipStream_t stream) {
    P p;
    memset(&p, 0, sizeof(p));
    for (int i = 0; i < 39; ++i) p.in[i] = (const float*)d_in[i];
    p.out = (float*)d_out;
    char* w = (char*)d_ws; size_t off = 0;
    auto take = [&](size_t bytes) { void* r = w + off; off = align_up(off + bytes); return r; };
    p.bar = (unsigned*)take(16384);
    p.X = (float*)take((size_t)MTOT * D_MODEL * 4);
    p.H = (bf16_t*)take((size_t)MTOT * D_MODEL * 2);
    p.MOD = (float*)take((size_t)DEPTH * 2 * 6 * D_MODEL * 4);
    p.Z = (bf16_t*)take((size_t)MTOT * ZLD * 2);
    p.ZGT = (bf16_t*)take((size_t)MTOT * 3 * D_MODEL * 2);
    p.V = (bf16_t*)take((size_t)MTOT * RW * 2);
    {
        char* ra = (char*)take((size_t)MTOT * RW * 2 * 2 > (size_t)MTOT * GLA_V * 4 ? (size_t)MTOT * RW * 2 * 2 : (size_t)MTOT * GLA_V * 4);
        p.R = (bf16_t*)ra; p.KK = (bf16_t*)(ra + (size_t)MTOT * RW * 2);
        p.OGLA = (float*)ra;
    }
    {
        char* rb = (char*)take((size_t)2 * MTOT * RW * 2 > (size_t)3 * MTOT * PH * 16 * 4 ? (size_t)2 * MTOT * RW * 2 : (size_t)3 * MTOT * PH * 16 * 4);
        p.KD = (bf16_t*)rb;
        p.IDX = (int*)rb; p.G = (float*)(rb + (size_t)MTOT * PH * 16 * 4); p.GU = (float*)(rb + (size_t)2 * MTOT * PH * 16 * 4);
    }
    p.BB = (bf16_t*)take((size_t)2 * MTOT * RW * 2);
    p.G2B = p.BB;
    p.LW = (float*)take((size_t)2 * MTOT * RW * 4);
    p.SP = (bf16_t*)p.LW;
    static_assert((size_t)2 * NC * GH * 8192 * 2 <= (size_t)2 * MTOT * RW * 4, "SP alias");
    p.BONUS = (float*)take((size_t)2 * MTOT * RH * 4);
    p.KS = (bf16_t*)take((size_t)MTOT * RW * 2);
    p.LR = (bf16_t*)take((size_t)MTOT * 256 * 2);
    p.WT_W2 = (bf16_t*)take((size_t)2 * NPAD(RW) * 64 * 2);
    p.WT_A2 = (bf16_t*)take((size_t)2 * NPAD(RW) * 64 * 2);
    p.GS = (bf16_t*)take((size_t)MTOT * 128 * 2);
    p.Y = (float*)take((size_t)2 * MTOT * RW * 4);
    p.Y0T = (float*)take((size_t)2 * NC * RH * 4096 * 4);
    p.KV = (float*)take((size_t)2 * NC * GH * 8192 * 4);
    p.DEC = (float*)take((size_t)2 * NC * GH * 64 * 4);
    p.S5A = (float*)take((size_t)2 * SG * 64 * 2 * 4);
    p.S5BB = (float*)take((size_t)2 * SG * 64 * 16 * 2 * 4);
    p.S5END = (float*)take((size_t)2 * NC * SG * 64 * 2 * 4);
    p.S5CAR = (float*)take((size_t)2 * NC * SG * 64 * 2 * 4);
    {
        const size_t szc1 = (size_t)2 * NC * RH * SEQ_REC;
        const size_t szc2 = (size_t)MTOT * SW * 2 + (size_t)MTOT * RW * 4 + (size_t)MTOT * 3 * BW * 2 + (size_t)MTOT * D_MODEL * 2 + 1024;
        char* rc = (char*)take(szc1 > szc2 ? szc1 : szc2);
        p.REC = rc;
        char* c2 = rc;
        p.GY = (bf16_t*)c2; c2 += align_up((size_t)MTOT * SW * 2);
        p.YN = (float*)c2; c2 += align_up((size_t)MTOT * RW * 4);
        p.BR = (bf16_t*)c2; c2 += align_up((size_t)MTOT * 3 * BW * 2);
        p.M = (bf16_t*)c2;
    }
    p.SN = (bf16_t*)take((size_t)2 * NC * RH * 4096 * 2);
    p.QH = (bf16_t*)take((size_t)2 * NC * RH * 4096 * 2);
    p.WT_IN = (bf16_t*)take((size_t)NPAD192(D_IN) * D_MODEL * 2);
    {
        char* lb = (char*)take(2 * LATE_BYTES); size_t lo = 0;
        auto ltake = [&](size_t bytes) { void* r = lb + lo; lo = AL256(lo + bytes); return r; };
        p.WT_G2 = (bf16_t*)ltake((size_t)NPAD(RW) * 128 * 2);
        p.WT_GLU = (bf16_t*)ltake((size_t)NPAD(2 * SW) * SW * 2);
        p.WT_BR = (bf16_t*)ltake((size_t)3 * D_MODEL * BW * 2);
        p.WT_OUT = (bf16_t*)ltake((size_t)D_MODEL * D_MODEL * 2);
        p.WT_Q = (bf16_t*)ltake((size_t)PQ * D_MODEL * 2);
        p.KHI = (bf16_t*)ltake((size_t)PH * 2 * 128 * 128 * 2); p.KLO = (bf16_t*)ltake((size_t)PH * 2 * 128 * 128 * 2);
        if (lo != LATE_BYTES) fprintf(stderr, "late weights layout mismatch\n");
    }
    p.U8 = (unsigned char*)take((size_t)NEXP * D_MODEL);
    p.V8 = (unsigned char*)take((size_t)NEXP * D_MODEL);
    p.USC = (float*)take((size_t)NEXP * 4); p.VSC = (float*)take((size_t)NEXP * 4);
    p.QHI = p.Z; p.QLO = p.Z + (size_t)MTOT * PQ;
    static_assert((size_t)PQ * 4 <= (size_t)D_IN * 2 && ((size_t)MTOT * ZLD * 2) % 256 == 0, "Q alias");
    if (off > ws_size) { fprintf(stderr, "ws too small: need %zu have %zu\n", off, ws_size); return; }
#ifdef EMU
    fprintf(stderr, "ws used %zu MB\n", off >> 20);
    emu_launch([=] { fwd_megakernel(p); }, EMU_GRID, NTHREADS);
#else
    hipMemsetAsync(p.bar, 0, 16384, stream);
    static int grid_blocks = 0;
    if (!grid_blocks) {
        int dev = 0, cus = 0, per_cu = 0;
        hipGetDevice(&dev);
        hipDeviceGetAttribute(&cus, hipDeviceAttributeMultiprocessorCount, dev);
        hipOccupancyMaxActiveBlocksPerMultiprocessor(&per_cu, fwd_megakernel, NTHREADS, 0);
        if (per_cu > 1) per_cu = 1;
        grid_blocks = cus * per_cu;
    }
    void* args[] = {&p};
    hipError_t e = hipLaunchCooperativeKernel((void*)fwd_megakernel, dim3(grid_blocks), dim3(NTHREADS), args, 0, stream);
    if (e != hipSuccess) fprintf(stderr, "cooperative launch failed: %s (grid %d)\n", hipGetErrorString(e), grid_blocks);
#endif
}
```

```cpp
#include <hip/hip_runtime.h>
#ifndef EMU
#include <hip/hip_cooperative_groups.h>
namespace cg = cooperative_groups;
#endif
#include <cstdio>
#include <cstdint>
#include <cstring>
#include <type_traits>

#ifdef CFG_SMALL
#define D_MODEL 128
#define SEQ 640
#define DEPTH 2
#define GRID_W 10
#define CTX 128
#define GH 1
#define RH 2
#define SG 8
#define PH 2
#else
#define D_MODEL 1024
#define SEQ 16384
#define DEPTH 4
#define GRID_W 64
#define CTX 256
#define GH 4
#define RH 8
#define SG 32
#define PH 8
#endif
#define MTOT (CTX + SEQ)
#define ROWS (SEQ / GRID_W)
#define GLA_K (GH * 64)
#define GLA_V (GH * 128)
#define RW (RH * 64)
#define RWKV_IN (3 * RW + 4 * 64 + 128)
#define SW (SG * 16)
#define BW GLA_V
#define ZQ 0
#define ZK (GLA_K)
#define ZV (2 * GLA_K)
#define ZOG (ZV + GLA_V)
#define ZAF (ZOG + GLA_V)
#define ZAB (ZAF + 16)
#define ZR (ZAB + 16)
#define ZS5 (ZR + RWKV_IN)
#define ZG (ZS5 + SW)
#define D_IN (ZG + 3 * D_MODEL)
#define ZLD ZG
#define NC (MTOT / 64)
#define NCC (CTX / 64)
#define RB (ROWS / 64)
#define PQ (PH * 256)
#define NEXP 16384
#define NTHREADS 256
#define SMEM_BYTES 133120

typedef unsigned short bf16_t;
typedef short bf16x8 __attribute__((ext_vector_type(8)));
typedef float f32x4 __attribute__((ext_vector_type(4)));
typedef unsigned u32x4 __attribute__((ext_vector_type(4)));
typedef unsigned u32x2 __attribute__((ext_vector_type(2)));
#ifdef EMU
#define MFMA16(a, b, c) emu_mfma_16x16x32_bf16(a, b, c)
#else
#define MFMA16(a, b, c) __builtin_amdgcn_mfma_f32_16x16x32_bf16(a, b, c, 0, 0, 0)
#endif
typedef float f32x2 __attribute__((ext_vector_type(2)));
#ifdef EMU
#define CVT_PK_FP8(a, b, old, hi) emu_cvt_pk_fp8_f32(a, b, old, hi)
#define CVT_PK_F32_FP8(w, hi) emu_cvt_pk_f32_fp8(w, hi)
#else
#define CVT_PK_FP8(a, b, old, hi) __builtin_amdgcn_cvt_pk_fp8_f32(a, b, old, hi)
#define CVT_PK_F32_FP8(w, hi) __builtin_amdgcn_cvt_pk_f32_fp8(w, hi)
#endif
#ifdef EMU
#define MFMA16_ACC(a, b, c) c = emu_mfma_16x16x32_bf16(a, b, c)
#else
#define MFMA16_ACC(a, b, c) asm volatile("v_mfma_f32_16x16x32_bf16 %0, %1, %2, %0" : "+a"(c) : "v"(a), "v"(b))
#endif
#define NPAD(n) (((n) + 127) / 128 * 128)
#define NPAD192(n) (((n) + 383) / 384 * 384)

__device__ __forceinline__ float bf2f(bf16_t h) { return __builtin_bit_cast(float, ((unsigned)h) << 16); }
#ifdef EMU
__device__ __forceinline__ bf16_t f2bf(float f) { unsigned u = __builtin_bit_cast(unsigned, f); u += 0x7FFFu + ((u >> 16) & 1u); return (bf16_t)(u >> 16); }
__device__ __forceinline__ unsigned pack2bf(float a, float b) { return (unsigned)f2bf(a) | ((unsigned)f2bf(b) << 16); }
#else
typedef float f2v_t __attribute__((ext_vector_type(2))); typedef __bf16 b2v_t __attribute__((ext_vector_type(2)));
__device__ __forceinline__ bf16_t f2bf(float f) { return __builtin_bit_cast(unsigned short, (__bf16)f); }
__device__ __forceinline__ unsigned pack2bf(float a, float b) { f2v_t v = {a, b}; b2v_t r = __builtin_convertvector(v, b2v_t); return __builtin_bit_cast(unsigned, r); }
#endif
#ifdef EMU
#define fexp_(x) expf(x)
#define flog_(x) logf(x)
#else
#define fexp_(x) __expf(x)
#define flog_(x) __logf(x)
#endif
#define LO16(x) __builtin_bit_cast(float, (x) << 16)
#define HI16(x) __builtin_bit_cast(float, (x) & 0xFFFF0000u)
__device__ __forceinline__ float sigmoidf_(float x) { return 1.0f / (1.0f + fexp_(-x)); }
__device__ __forceinline__ float siluf_(float x) { return x * sigmoidf_(x); }
__device__ __forceinline__ float geluf_(float x) { const float y = 1.5957691216057308f * (x + 0.044715f * x * x * x); return x / (1.0f + fexp_(-y)); }
__device__ __forceinline__ float softplusf_(float x) { return fmaxf(x, 0.f) + flog_(1.0f + fexp_(-fabsf(x))); }
__device__ __forceinline__ float tanhf_(float x) { const float e = fexp_(-2.0f * fabsf(x)); const float t = (1.0f - e) / (1.0f + e); return x < 0.f ? -t : t; }
__device__ __forceinline__ float wave_sum(float v) {
#pragma unroll
    for (int m = 32; m >= 1; m >>= 1) v += __shfl_xor(v, m, 64);
    return v;
}

struct P {
    const float* in[39];
    float* out;
    float* X;
    bf16_t* H;
    bf16_t* Z;
    bf16_t* ZGT;
    float* MOD;
    bf16_t* R; bf16_t* V; bf16_t* KK; bf16_t* KD; bf16_t* BB;
    float* LW;
    char* REC;
    bf16_t* SN;
    bf16_t* QH;
    float* BONUS;
    bf16_t* KS;
    bf16_t* LR;
    bf16_t* WT_W2;
    bf16_t* WT_A2;
    bf16_t* GS;
    float* Y;
    bf16_t* G2B;
    float* Y0T;
    float* KV;
    bf16_t* SP;
    float* DEC;
    float* OGLA;
    float* S5A;
    float* S5BB;
    float* S5END;
    float* S5CAR;
    bf16_t* GY;
    float* YN;
    bf16_t* BR;
    bf16_t* M;
    bf16_t* QHI; bf16_t* QLO;
    bf16_t* KHI; bf16_t* KLO;
    int* IDX;
    float* G;
    float* GU;
    unsigned* bar;
    bf16_t* WT_IN;
    bf16_t* WT_G2;
    bf16_t* WT_GLU;
    bf16_t* WT_BR;
    bf16_t* WT_OUT;
    bf16_t* WT_Q;
    unsigned char* U8; unsigned char* V8;
    float* USC; float* VSC;
};

enum { I_X = 0, I_C, I_CTX, I_CCTX, I_WMOD, I_BMOD, I_N1G, I_N2G, I_WIN, I_GLA_WA2, I_GLA_BA, I_GLA_NG, I_RCONV, I_RW0, I_RW2, I_RA0, I_RA2, I_RG2,
       I_RKK, I_RKA, I_RRK, I_RLNW, I_RLNB, I_S5LRE, I_S5LIM, I_S5LS, I_S5BRE, I_S5BIM, I_S5CRE, I_S5CIM, I_S5D, I_S5GLU, I_WBR, I_WOUT, I_PWQ, I_PKEYS, I_PU, I_PV, I_FG };

#define AL256(x) (((size_t)(x) + 255) & ~(size_t)255)
#define LATE_BYTES (AL256((size_t)NPAD(RW) * 128 * 2) + AL256((size_t)NPAD(2 * SW) * SW * 2) + AL256((size_t)3 * D_MODEL * BW * 2) + AL256((size_t)D_MODEL * D_MODEL * 2) + \
                    AL256((size_t)PQ * D_MODEL * 2) + 2 * AL256((size_t)PH * 2 * 128 * 128 * 2))
__device__ __forceinline__ void late_select(P& p, int par) {
    const size_t o = (size_t)par * (LATE_BYTES / 2);
    p.WT_G2 += o; p.WT_GLU += o; p.WT_BR += o; p.WT_OUT += o; p.WT_Q += o; p.KHI += o; p.KLO += o;
}
#ifdef EMU
__device__ __forceinline__ int otid() { return threadIdx.x; }
__device__ __forceinline__ int obid() { return blockIdx.x; }
#else
__device__ __forceinline__ int otid() { int t = threadIdx.x; asm volatile("" : "+v"(t)); return t; }
__device__ __forceinline__ int obid() { int b = blockIdx.x; asm volatile("" : "+s"(b)); return b; }
#endif
#ifdef EMU
#define WAVE_SYNC() emu_wave_barrier()
#ifndef EMU_GRID
#define EMU_GRID 4
#endif
#else
#define WAVE_SYNC() __builtin_amdgcn_wave_barrier()
#endif
#ifndef EMU
#define XB_TMO      128
#define XB_XCNT(j)  (256  + 64 * (j))
#define XB_XSUB(j)  (1280 + 64 * (j))
#define XB_XGEN(j)  (2304 + 64 * (j))
#define XB_TOP      3328
#define XB_TOPGEN   3392
#define XCD_BAR_WORDS 3456
#define XB_SPIN_CAP (1u << 22)
#define LAS __attribute__((address_space(3)))
__device__ __forceinline__ unsigned xb_ld(unsigned* p)              { return __hip_atomic_load(p, __ATOMIC_RELAXED, __HIP_MEMORY_SCOPE_SYSTEM); }
__device__ __forceinline__ unsigned xb_add(unsigned* p, unsigned v) { return __hip_atomic_fetch_add(p, v, __ATOMIC_RELAXED, __HIP_MEMORY_SCOPE_SYSTEM); }
__device__ __forceinline__ unsigned xb_xcc_id() { return (unsigned)__builtin_amdgcn_s_getreg((3 << 11) | 20) & 0xFu; }
#define XB_SPIN(cond, bar) do { unsigned _sp = 0; while (cond) { __builtin_amdgcn_s_sleep(1); \
    if ((++_sp & 255u) == 0u) { if (xb_ld(&(bar)[XB_TMO])) break; if (_sp > XB_SPIN_CAP) { atomicAdd(&(bar)[XB_TMO], 1u); break; } } } } while (0)
struct XcdBarrier { unsigned* bar; unsigned x; volatile LAS unsigned* st; };
__device__ __forceinline__ XcdBarrier xcd_barrier_post(unsigned* bar, volatile LAS unsigned* st) {
    XcdBarrier b; b.bar = bar; b.x = xb_xcc_id(); b.st = st;
    if (threadIdx.x == 0) st[3] = xb_add(&bar[XB_XCNT(b.x)], 1u);
    return b;
}
__device__ __forceinline__ void xcd_barrier_complete(unsigned* bar, unsigned x, unsigned& nloc, unsigned& nx) {
    const unsigned G = gridDim.x * gridDim.y * gridDim.z;
    unsigned sum, cnt, mine, sp = 0u;
    for (;;) {
        sum = 0u; cnt = 0u; mine = 0u;
#pragma unroll
        for (unsigned j = 0; j < 16; ++j) { const unsigned c = xb_ld(&bar[XB_XCNT(j)]); sum += c; cnt += (c > 0u) ? 1u : 0u; mine = (j == x) ? c : mine; }
        if (sum == G) break;
        __builtin_amdgcn_s_sleep(1);
        if ((++sp & 255u) == 0u) { if (xb_ld(&bar[XB_TMO])) break; if (sp > XB_SPIN_CAP) { atomicAdd(&bar[XB_TMO], 1u); break; } }
    }
    nloc = mine > 0u ? mine : 1u; nx = cnt > 0u ? cnt : 1u;
}
__device__ __forceinline__ void xcd_barrier(const XcdBarrier& b) {
    asm volatile("s_waitcnt vmcnt(0)" ::: "memory");
    __syncthreads();
    if (threadIdx.x == 0) {
        unsigned* bar = b.bar;
        __builtin_amdgcn_fence(__ATOMIC_RELEASE, "agent");
        asm volatile("s_waitcnt vmcnt(0)" ::: "memory");
        const unsigned G = gridDim.x;
        const unsigned old = xb_add(&bar[XB_TOP], 1u);
        const unsigned tg = old / G;
        if (old + 1u == (tg + 1u) * G) xb_add(&bar[XB_TOPGEN], 1u);
        else XB_SPIN(xb_ld(&bar[XB_TOPGEN]) == tg, bar);
        __builtin_amdgcn_fence(__ATOMIC_ACQUIRE, "agent");
        asm volatile("s_waitcnt vmcnt(0)" ::: "memory");
    }
    __syncthreads();
}
#define GRID_SYNC_CG() { (void)xb; asm volatile("s_waitcnt vmcnt(0)" ::: "memory"); cg::this_grid().sync(); }
#define GRID_SYNC() xcd_barrier(xb)
#else
#define GRID_SYNC() emu_grid_sync()
#endif

#ifdef EMU
#define LOADP() P p = p_arg
#else
typedef __attribute__((address_space(4))) const unsigned long long cu64_t;
__device__ __forceinline__ void load_params(P& p) {
    cu64_t* q = (cu64_t*)__builtin_amdgcn_kernarg_segment_ptr();
    asm volatile("" : "+s"(q));
    typedef __attribute__((address_space(1))) char gchar_t;
    char* w[sizeof(P) / 8];
#pragma unroll
    for (int i = 0; i < (int)(sizeof(P) / 8); ++i) w[i] = (char*)(gchar_t*)q[i];
    __builtin_memcpy(&p, w, sizeof(P));
}
#define LOADP() P p; load_params(p)
#endif
#define PROBE_MULT 3
#if defined(PROBE_ID) && !defined(EMU)
#define PROBE_INIT() unsigned long long probe_t0 = wall_clock64()
#define PROBE_AFTER(id) { if (blockIdx.x == 0) { unsigned long long now_ = wall_clock64(); if ((id) == PROBE_ID || (id) == PROBE_ID2) { const unsigned long long dt_ = now_ - probe_t0; \
    while (wall_clock64() - now_ < dt_ * PROBE_MULT) __builtin_amdgcn_s_sleep(8); now_ = wall_clock64(); } probe_t0 = now_; } }
#else
#define PROBE_INIT()
#define PROBE_AFTER(id)
#endif
__device__ __forceinline__ int gla_tok(int n, int i) {
    if (n < NCC) return n * 64 + i;
    int m = n - NCC; int col = m / RB, rb = m % RB;
    return CTX + (rb * 64 + i) * GRID_W + col;
}
__device__ __forceinline__ int chunk_order(int d, int s) {
    if (d == 0) return s;
    return (s < NCC) ? (NCC - 1 - s) : (NC - 1 - (s - NCC));
}
__device__ __forceinline__ int tok_order(int d, int s) {
    if (d == 0) return s;
    return (s < CTX) ? (CTX - 1 - s) : (MTOT - 1 - (s - CTX));
}


#define LDS_ROW 72
__device__ __forceinline__ void mfma_gemm_tile(const bf16_t* Wt, int ldw, const bf16_t* Act, int lda, int K, int n0, int m0, bf16_t* lds, f32x4 (&acc)[4][4]) {
    bf16_t* Ws = lds; bf16_t* As = lds + 128 * LDS_ROW;
    const int tid = otid(), lane = tid & 63, wave = tid >> 6, wn = wave >> 1, wm = wave & 1;
    const int lrow = tid >> 3, lkc = (tid & 7) * 8;
    u32x4 pw[4], pa[4];
#pragma unroll
    for (int i = 0; i < 4; ++i) {
        pw[i] = *(const u32x4*)(Wt + (size_t)(n0 + lrow + 32 * i) * ldw + lkc);
        pa[i] = *(const u32x4*)(Act + (size_t)(m0 + lrow + 32 * i) * lda + lkc);
    }
    for (int k0 = 0; k0 < K; k0 += 64) {
        __syncthreads();
#pragma unroll
        for (int i = 0; i < 4; ++i) {
            *(u32x4*)(Ws + (lrow + 32 * i) * LDS_ROW + lkc) = pw[i];
            *(u32x4*)(As + (lrow + 32 * i) * LDS_ROW + lkc) = pa[i];
        }
        __syncthreads();
        if (k0 + 64 < K) {
#pragma unroll
            for (int i = 0; i < 4; ++i) {
                pw[i] = *(const u32x4*)(Wt + (size_t)(n0 + lrow + 32 * i) * ldw + k0 + 64 + lkc);
                pa[i] = *(const u32x4*)(Act + (size_t)(m0 + lrow + 32 * i) * lda + k0 + 64 + lkc);
            }
        }
#pragma unroll
        for (int ks = 0; ks < 2; ++ks) {
            bf16x8 a[4], b[4];
#pragma unroll
            for (int i = 0; i < 4; ++i) {
                a[i] = *(const bf16x8*)(Ws + (wn * 64 + i * 16 + (lane & 15)) * LDS_ROW + ks * 32 + (lane >> 4) * 8);
                b[i] = *(const bf16x8*)(As + (wm * 64 + i * 16 + (lane & 15)) * LDS_ROW + ks * 32 + (lane >> 4) * 8);
            }
#pragma unroll
            for (int ni = 0; ni < 4; ++ni)
#pragma unroll
                for (int mi = 0; mi < 4; ++mi) acc[ni][mi] = MFMA16(a[ni], b[mi], acc[ni][mi]);
        }
    }
}
#define L64_ROW 72
#ifdef EMU
struct BufRsrc { const char* base; };
__device__ __forceinline__ BufRsrc make_rsrc(const void* p, size_t) { BufRsrc r; r.base = (const char*)p; return r; }
__device__ __forceinline__ u32x4 buf_load16(const BufRsrc& r, unsigned voff, unsigned soff) { return *(const u32x4*)(r.base + voff + soff); }
#else
typedef __amdgpu_buffer_rsrc_t BufRsrc;
__device__ __forceinline__ BufRsrc make_rsrc(const void* p, size_t bytes) { return __builtin_amdgcn_make_buffer_rsrc((void*)p, 0, (int)bytes, 0x00020000); }
__device__ __forceinline__ u32x4 buf_load16(const BufRsrc& r, unsigned voff, unsigned soff) { return __builtin_bit_cast(u32x4, __builtin_amdgcn_raw_buffer_load_b128(r, voff, soff, 0)); }
#endif
template <int NI, int MI>
__device__ __forceinline__ void mfma_gemm_tile_t(const bf16_t* Wt, int ldw, size_t wbytes, const bf16_t* Act, int lda, size_t abytes, int K, int n0, int m0, bf16_t* lds, f32x4 (&acc)[NI][MI], unsigned long long* gacc = nullptr) {
    constexpr int WR = 32 * NI, AR = 32 * MI, BUF = (WR + AR) * L64_ROW;
    const int tid = otid(), lane = tid & 63, wave = tid >> 6, wn = wave >> 1, wm = wave & 1;
    const int lrow = tid >> 3, lkc = (tid & 7) * 8;
    const BufRsrc rw = make_rsrc(Wt, wbytes), ra = make_rsrc(Act, abytes);
    unsigned vw[NI], va[MI];
#pragma unroll
    for (int i = 0; i < NI; ++i) vw[i] = (unsigned)(((size_t)(n0 + lrow + 32 * i) * ldw + lkc) * 2);
#pragma unroll
    for (int i = 0; i < MI; ++i) va[i] = (unsigned)(((size_t)(m0 + lrow + 32 * i) * lda + lkc) * 2);
    u32x4 qw0[NI], qa0[MI];
    const int nk = K / 64;
#define GT_LOAD(QW, QA, KT) { const unsigned so_ = (unsigned)(((KT) < nk) ? (KT) : (nk - 1)) * 128u; \
    _Pragma("unroll") for (int i = 0; i < NI; ++i) QW[i] = buf_load16(rw, vw[i], so_); \
    _Pragma("unroll") for (int i = 0; i < MI; ++i) QA[i] = buf_load16(ra, va[i], so_); }
#define GT_STORE(QW, QA, DST) { \
    _Pragma("unroll") for (int i = 0; i < NI; ++i) *(u32x4*)((DST) + (lrow + 32 * i) * L64_ROW + lkc) = QW[i]; \
    _Pragma("unroll") for (int i = 0; i < MI; ++i) *(u32x4*)((DST) + (WR + lrow + 32 * i) * L64_ROW + lkc) = QA[i]; }
#define GT_COMPUTE(CUR) { _Pragma("unroll") for (int ks = 0; ks < 2; ++ks) { bf16x8 b[MI], a[NI]; \
    _Pragma("unroll") for (int i = 0; i < MI; ++i) b[i] = *(const bf16x8*)((CUR) + (WR + wm * 16 * MI + i * 16 + (lane & 15)) * L64_ROW + ks * 32 + (lane >> 4) * 8); \
    _Pragma("unroll") for (int i = 0; i < NI; ++i) a[i] = *(const bf16x8*)((CUR) + (wn * 16 * NI + i * 16 + (lane & 15)) * L64_ROW + ks * 32 + (lane >> 4) * 8); \
    _Pragma("unroll") for (int ni = 0; ni < NI; ++ni) { \
        _Pragma("unroll") for (int mi = 0; mi < MI; ++mi) MFMA16_ACC(a[ni], b[mi], acc[ni][mi]); } } }
    GT_LOAD(qw0, qa0, 0)
    __syncthreads();
    GT_STORE(qw0, qa0, lds)
    __syncthreads();
    for (int kt = 0; kt < nk; kt += 2) {
        GT_LOAD(qw0, qa0, kt + 1)
        GT_COMPUTE(lds)
        GT_STORE(qw0, qa0, lds + BUF)
        __syncthreads();
        GT_LOAD(qw0, qa0, kt + 2)
        GT_COMPUTE(lds + BUF)
        GT_STORE(qw0, qa0, lds)
        __syncthreads();
    }
#undef GT_LOAD
#undef GT_STORE
#undef GT_COMPUTE
}
#define ZERO_ACC4(acc) { _Pragma("unroll") for (int i_ = 0; i_ < 4; ++i_) _Pragma("unroll") for (int j_ = 0; j_ < 4; ++j_) acc[i_][j_] = (f32x4){0.f, 0.f, 0.f, 0.f}; }
#define FOR_ACC(acc, n0, m0, BODY) { const int lane_ = otid() & 63, wave_ = otid() >> 6; \
    _Pragma("unroll") for (int ni_ = 0; ni_ < 4; ++ni_) _Pragma("unroll") for (int mi_ = 0; mi_ < 4; ++mi_) { \
        const int n = (n0) + (wave_ >> 1) * 64 + ni_ * 16 + (lane_ >> 4) * 4; const int m = (m0) + (wave_ & 1) * 64 + mi_ * 16 + (lane_ & 15); const f32x4 v = acc[ni_][mi_]; BODY } }
__device__ __forceinline__ u32x2 pack4(float a, float b, float c, float d) { u32x2 r; r.x = pack2bf(a, b); r.y = pack2bf(c, d); return r; }

__device__ __forceinline__ void convert_wt_job(const float* W, int K, int N, int Npad, bf16_t* out, int job, float* T, int ilv) {
    const int tid = otid();
    const int nkt = K / 64;
    const int n0 = (job / nkt) * 64, k0 = (job % nkt) * 64;
    __syncthreads();
    for (int idx = tid; idx < 4096; idx += NTHREADS) {
        int kk = idx >> 6, nn = idx & 63;
        int nr = n0 + nn; int src = ilv ? ((nr & 1) ? (N / 2 + (nr >> 1)) : (nr >> 1)) : nr;
        T[kk * 65 + nn] = (nr < N) ? W[(size_t)(k0 + kk) * N + src] : 0.f;
    }
    __syncthreads();
    {
        int nn = tid >> 2, part = tid & 3;
        unsigned w[8];
#pragma unroll
        for (int j = 0; j < 8; ++j) w[j] = pack2bf(T[(part * 16 + 2 * j) * 65 + nn], T[(part * 16 + 2 * j + 1) * 65 + nn]);
        u32x4* o = (u32x4*)(out + (size_t)(n0 + nn) * K + k0 + part * 16);
        o[0] = (u32x4){w[0], w[1], w[2], w[3]}; o[1] = (u32x4){w[4], w[5], w[6], w[7]};
    }
}
__device__ __forceinline__ void phase_convert_weights(const P& p, int l, char* smem, int bid, int nb) {
    float* T = (float*)smem;
    struct Item { const float* W; int K, N, Npad; bf16_t* out; };
    const Item items[12] = {
        {p.in[I_RW2] + ((size_t)l * 2 + 0) * 64 * RW, 64, RW, NPAD(RW), p.WT_W2},
        {p.in[I_RW2] + ((size_t)l * 2 + 1) * 64 * RW, 64, RW, NPAD(RW), p.WT_W2 + (size_t)NPAD(RW) * 64},
        {p.in[I_RA2] + ((size_t)l * 2 + 0) * 64 * RW, 64, RW, NPAD(RW), p.WT_A2},
        {p.in[I_RA2] + ((size_t)l * 2 + 1) * 64 * RW, 64, RW, NPAD(RW), p.WT_A2 + (size_t)NPAD(RW) * 64},
        {p.in[I_WIN] + (size_t)l * D_MODEL * D_IN, D_MODEL, D_IN, NPAD192(D_IN), p.WT_IN},
        {p.in[I_RG2] + (size_t)l * 128 * RW, 128, RW, RW, p.WT_G2},
        {p.in[I_S5GLU] + (size_t)l * SW * 2 * SW, SW, 2 * SW, 2 * SW, p.WT_GLU},
        {p.in[I_WBR] + ((size_t)l * 3 + 0) * BW * D_MODEL, BW, D_MODEL, D_MODEL, p.WT_BR},
        {p.in[I_WBR] + ((size_t)l * 3 + 1) * BW * D_MODEL, BW, D_MODEL, D_MODEL, p.WT_BR + (size_t)D_MODEL * BW},
        {p.in[I_WBR] + ((size_t)l * 3 + 2) * BW * D_MODEL, BW, D_MODEL, D_MODEL, p.WT_BR + (size_t)2 * D_MODEL * BW},
        {p.in[I_WOUT] + (size_t)l * D_MODEL * D_MODEL, D_MODEL, D_MODEL, D_MODEL, p.WT_OUT},
        {p.in[I_PWQ] + (size_t)l * D_MODEL * PQ, D_MODEL, PQ, PQ, p.WT_Q}};
    int base = 0;
#pragma unroll
    for (int it = 0; it < 12; ++it) {
        const int nj = (items[it].Npad / 64) * (items[it].K / 64);
        for (int j = (bid + nb - (base % nb)) % nb; j < nj; j += nb)
            convert_wt_job(items[it].W, items[it].K, items[it].N, items[it].Npad, items[it].out, j, T, it == 6);
        base += nj;
    }
    __syncthreads();
    {
        const float* ks = p.in[I_PKEYS] + (size_t)l * PH * 2 * 128 * 128;
        for (size_t i = (size_t)bid * NTHREADS + otid(); i < (size_t)PH * 2 * 128 * 128; i += (size_t)nb * NTHREADS) {
            const float v = ks[i]; const bf16_t hb = f2bf(v);
            p.KHI[i] = hb; p.KLO[i] = f2bf(v - bf2f(hb));
        }
    }
}

#ifdef EMU
__device__ __forceinline__ int xcd_rank() { return obid(); }
#else
__device__ __forceinline__ int xcd_rank() { return (int)((volatile LAS unsigned*)(unsigned)(SMEM_BYTES))[2]; }
#endif
__device__ __forceinline__ bool tile_map(int it, int ntm, int ntn, int PM, int& mt, int& nt) {
    const int G = gridDim.x;
    const long id = (long)it * G + xcd_rank();
    if (id >= (long)ntm * ntn) return false;
    const int full = ntm / PM; const long fullsz = (long)full * PM * ntn;
    if (id < fullsz) { const int p = (int)(id / (PM * ntn)), rem = (int)(id % (PM * ntn)); nt = rem / PM; mt = p * PM + rem % PM; }
    else { const int rem = (int)(id - fullsz), hh = ntm - full * PM; nt = rem / hh; mt = full * PM + rem % hh; }
    return true;
}

template <int NI, int MI, class Pre, class Post>
__device__ __forceinline__ void gemm_tile_run(const bf16_t* Wt, int ldw, size_t wbytes, const bf16_t* Act, int lda, size_t abytes, int K, int n0, int m0, bf16_t* lds, Pre pre, Post post) {
    f32x4 acc[NI][MI];
#pragma unroll
    for (int i = 0; i < NI; ++i)
#pragma unroll
        for (int j = 0; j < MI; ++j) acc[i][j] = (f32x4){0.f, 0.f, 0.f, 0.f};
    pre(m0, n0, acc, lds);
    mfma_gemm_tile_t<NI, MI>(Wt, ldw, wbytes, Act, lda, abytes, K, n0, m0, lds, acc);
    const int lane = otid() & 63, wave = otid() >> 6;
#pragma unroll
    for (int ni = 0; ni < NI; ++ni)
#pragma unroll
        for (int mi = 0; mi < MI; ++mi)
            post(ni, mi, m0 + (wave & 1) * 16 * MI + mi * 16 + (lane & 15), n0 + (wave >> 1) * 16 * NI + ni * 16 + (lane >> 4) * 4, acc[ni][mi]);
}
struct NoPre { template <class A> __device__ __forceinline__ void operator()(int, int, A&, bf16_t*) const {} };
template <int NI, class PreM, class PreT, class Post>
__device__ __forceinline__ void gemm_phase(const bf16_t* Wt, int ldw, size_t wbytes, const bf16_t* Act, int lda, size_t abytes, int K, int N, bf16_t* lds, PreM prem, PreT pret, Post post) {
    const int ntn = N / (32 * NI), ntm = MTOT / 256 - 1;
    const int PM = (ntn >= 16) ? 2 : ((ntn >= 8) ? 4 : 8);
    for (int it = 0;; ++it) {
        int mt_, nt_; if (!tile_map(it, ntm, ntn, PM, mt_, nt_)) break;
        gemm_tile_run<NI, 8>(Wt, ldw, wbytes, Act, lda, abytes, K, nt_ * 32 * NI, mt_ * 256, lds, prem, post);
    }
    for (int job = obid(); job < 4 * ntn; job += gridDim.x)
        gemm_tile_run<NI, 2>(Wt, ldw, wbytes, Act, lda, abytes, K, (job >> 2) * 32 * NI, MTOT - 256 + (job & 3) * 64, lds, pret, post);
}

__device__ __forceinline__ void phase_init(const P& p, char* smem) {
    const int tid = otid();
    float* sc = (float*)smem;
    for (int i = tid; i < D_MODEL; i += NTHREADS) { sc[i] = siluf_(p.in[I_CCTX][i]); sc[D_MODEL + i] = siluf_(p.in[I_C][i]); }
    __syncthreads();
    const int ncolblk = (6 * D_MODEL) / NTHREADS;
    for (int job = obid(); job < DEPTH * ncolblk; job += gridDim.x) {
        int l = job / ncolblk, n = (job % ncolblk) * NTHREADS + tid;
        const float* w = p.in[I_WMOD] + (size_t)l * D_MODEL * 6 * D_MODEL + n;
        float a0 = 0.f, a1 = 0.f;
        for (int k = 0; k < D_MODEL; ++k) { float wv = w[(size_t)k * 6 * D_MODEL]; a0 += sc[k] * wv; a1 += sc[D_MODEL + k] * wv; }
        float b = p.in[I_BMOD][l * 6 * D_MODEL + n];
        p.MOD[(size_t)(l * 2 + 0) * 6 * D_MODEL + n] = a0 + b;
        p.MOD[(size_t)(l * 2 + 1) * 6 * D_MODEL + n] = a1 + b;
    }
    const size_t gtid = (size_t)obid() * NTHREADS + tid, gn = (size_t)gridDim.x * NTHREADS;
    for (size_t i = gtid; i < (size_t)CTX * D_MODEL; i += gn) p.X[i] = p.in[I_CTX][i];
    for (size_t i = gtid; i < (size_t)SEQ * D_MODEL; i += gn) p.X[(size_t)CTX * D_MODEL + i] = p.in[I_X][i];
    __syncthreads();
}

__device__ __forceinline__ void phase_s5const(const P& p, int l) {
    const size_t gtid = (size_t)obid() * NTHREADS + otid(), gn = (size_t)gridDim.x * NTHREADS;
    for (size_t i = gtid; i < (size_t)2 * SG * 64; i += gn) {
        int d = (int)(i / (SG * 64)), g = (int)((i / 64) % SG), s = (int)(i % 64);
        size_t li = ((size_t)(l * 2 + d) * SG + g) * 64 + s;
        float lre = p.in[I_S5LRE][li], lim = p.in[I_S5LIM][li];
        float dt = expf(p.in[I_S5LS][(l * 2 + d) * SG + g]);
        float mag = expf(lre * dt);
        float are = mag * cosf(lim * dt), aim = mag * sinf(lim * dt);
        float den = lre * lre + lim * lim;
        float fre = ((are - 1.0f) * lre + aim * lim) / den;
        float fim = (aim * lre - (are - 1.0f) * lim) / den;
        p.S5A[i * 2 + 0] = are; p.S5A[i * 2 + 1] = aim;
        const float* bre = p.in[I_S5BRE] + (((size_t)l * SG + g) * 64 + s) * 16;
        const float* bim = p.in[I_S5BIM] + (((size_t)l * SG + g) * 64 + s) * 16;
        for (int c = 0; c < 16; ++c) {
            p.S5BB[(i * 16 + c) * 2 + 0] = fre * bre[c] - fim * bim[c];
            p.S5BB[(i * 16 + c) * 2 + 1] = fre * bim[c] + fim * bre[c];
        }
    }
}

__device__ __forceinline__ void phase_norm(const P& p, int l, int which) {
    const int lane = otid() & 63;
    const int gw = (obid() * NTHREADS + otid()) >> 6, nw = (gridDim.x * NTHREADS) >> 6;
    const float* g = p.in[which ? I_N2G : I_N1G] + l * D_MODEL;
    constexpr int NJ = (D_MODEL + 255) / 256;
    for (int t = gw; t < MTOT; t += nw) {
        const float* x = p.X + (size_t)t * D_MODEL;
        const float* mod = p.MOD + (size_t)(l * 2 + (t >= CTX ? 1 : 0)) * 6 * D_MODEL + (which ? 3 * D_MODEL : 0);
        float4 v[NJ]; float ss = 0.f;
#pragma unroll
        for (int j = 0; j < NJ; ++j) {
            const int e = j * 256 + lane * 4;
            if (e < D_MODEL) v[j] = *(const float4*)(x + e); else { v[j].x = 0.f; v[j].y = 0.f; v[j].z = 0.f; v[j].w = 0.f; }
            ss += v[j].x * v[j].x + v[j].y * v[j].y + v[j].z * v[j].z + v[j].w * v[j].w;
        }
        ss = wave_sum(ss);
        const float rstd = rsqrtf(ss / D_MODEL + 1e-6f);
#pragma unroll
        for (int j = 0; j < NJ; ++j) {
            const int e = j * 256 + lane * 4;
            if (e < D_MODEL) {
                const float4 gg = *(const float4*)(g + e), sc = *(const float4*)(mod + D_MODEL + e), sh = *(const float4*)(mod + e);
                *(u32x2*)(p.H + (size_t)t * D_MODEL + e) = pack4(v[j].x * rstd * gg.x * (1.0f + sc.x) + sh.x, v[j].y * rstd * gg.y * (1.0f + sc.y) + sh.y,
                                                                 v[j].z * rstd * gg.z * (1.0f + sc.z) + sh.z, v[j].w * rstd * gg.w * (1.0f + sc.w) + sh.w);
            }
        }
    }
}

__device__ __forceinline__ void phase_gemm_in(const P& p, int l, char* smem) {
    constexpr int NI = 6, MI = 8;
    const int ntn = NPAD192(D_IN) / 192, ntm = MTOT / 256;
    for (int it = 0;; ++it) {
        int mt_, nt_; if (!tile_map(it, ntm, ntn, 4, mt_, nt_)) break;
        const int m0 = mt_ * 256, n0 = nt_ * 192;
        f32x4 acc[NI][MI];
#pragma unroll
        for (int i = 0; i < NI; ++i)
#pragma unroll
            for (int j = 0; j < MI; ++j) acc[i][j] = (f32x4){0.f, 0.f, 0.f, 0.f};
        mfma_gemm_tile_t<NI, MI>(p.WT_IN, D_MODEL, (size_t)NPAD192(D_IN) * D_MODEL * 2, p.H, D_MODEL, (size_t)MTOT * D_MODEL * 2, D_MODEL, n0, m0, (bf16_t*)smem, acc);
        const int lane = otid() & 63, wave = otid() >> 6;
#pragma unroll
        for (int ni = 0; ni < NI; ++ni)
#pragma unroll
            for (int mi = 0; mi < MI; ++mi) {
                const int n = n0 + (wave >> 1) * 16 * NI + ni * 16 + (lane >> 4) * 4, m = m0 + (wave & 1) * 16 * MI + mi * 16 + (lane & 15);
                const u32x2 pk_ = pack4(acc[ni][mi][0], acc[ni][mi][1], acc[ni][mi][2], acc[ni][mi][3]);
                if (n < ZG) *(u32x2*)(p.Z + (size_t)m * ZLD + n) = pk_;
                else if (n < D_IN) *(u32x2*)(p.ZGT + ((((size_t)(m >> 4) * (3 * D_MODEL / 16) + ((n - ZG) >> 4)) * 64 + lane) * 4)) =
                    pack4(sigmoidf_(acc[ni][mi][0]), sigmoidf_(acc[ni][mi][1]), sigmoidf_(acc[ni][mi][2]), sigmoidf_(acc[ni][mi][3]));
            }
    }
}

__device__ __forceinline__ void unpack8(const u32x4 w, float (&f)[8]) {
    f[0] = LO16(w.x); f[1] = HI16(w.x); f[2] = LO16(w.y); f[3] = HI16(w.y); f[4] = LO16(w.z); f[5] = HI16(w.z); f[6] = LO16(w.w); f[7] = HI16(w.w);
}
__device__ __forceinline__ u32x4 pack8(const float (&f)[8]) {
    u32x4 o; o.x = pack2bf(f[0], f[1]); o.y = pack2bf(f[2], f[3]);
    o.z = pack2bf(f[4], f[5]); o.w = pack2bf(f[6], f[7]); return o;
}
__device__ __forceinline__ void load8f(const float* p, float (&f)[8]) {
    const float4 a = *(const float4*)p, b = *(const float4*)(p + 4);
    f[0] = a.x; f[1] = a.y; f[2] = a.z; f[3] = a.w; f[4] = b.x; f[5] = b.y; f[6] = b.z; f[7] = b.w;
}
__device__ __forceinline__ void store8f(float* p, const float (&f)[8]) {
    float4 a, b; a.x = f[0]; a.y = f[1]; a.z = f[2]; a.w = f[3]; b.x = f[4]; b.y = f[5]; b.z = f[6]; b.w = f[7];
    *(float4*)p = a; *(float4*)(p + 4) = b;
}
__device__ __forceinline__ void conv8(const bf16_t* zp, const float* conv, int c0, bool act, bool first, bool last, float (&out)[8]) {
    const u32x4 z4 = {0u, 0u, 0u, 0u};
    const u32x4 a0 = act ? *(const u32x4*)(zp + c0) : z4;
    const u32x4 am = (act && !first) ? *(const u32x4*)(zp + c0 - ZLD) : z4;
    const u32x4 an = (act && !last) ? *(const u32x4*)(zp + c0 + ZLD) : z4;
    float w0[8], w1[8], w2[8], f0[8], fm[8], fn[8];
    if (act) { load8f(conv + c0, w0); load8f(conv + RWKV_IN + c0, w1); load8f(conv + 2 * RWKV_IN + c0, w2); }
    else {
#pragma unroll
        for (int e = 0; e < 8; ++e) { w0[e] = 0.f; w1[e] = 0.f; w2[e] = 0.f; }
    }
    unpack8(a0, f0); unpack8(am, fm); unpack8(an, fn);
#pragma unroll
    for (int e = 0; e < 8; ++e) out[e] = w1[e] * f0[e] + w0[e] * fm[e] + w2[e] * fn[e];
}
__device__ __forceinline__ void phase_rwkv_prep1(const P& p, int l) {
    const int lane = otid() & 63;
    const int gw = (obid() * NTHREADS + otid()) >> 6, nw = (gridDim.x * NTHREADS) >> 6;
    const float* conv = p.in[I_RCONV] + (size_t)l * 3 * RWKV_IN;
    const float* k_k = p.in[I_RKK] + (size_t)l * RW;
    const bool act = lane * 8 < RW, act2 = lane * 8 < 384;
    float kkw[8];
    if (act) load8f(k_k + lane * 8, kkw);
    else {
#pragma unroll
        for (int e = 0; e < 8; ++e) kkw[e] = 0.f;
    }
    for (int t = gw; t < MTOT; t += nw) {
        const bool first = (t == 0) || (t == CTX), last = (t == CTX - 1) || (t == MTOT - 1);
        const bf16_t* zp = p.Z + (size_t)t * ZLD + ZR;
        float rv[8], kv[8], vv[8], lr[8];
        conv8(zp, conv, 0 * RW + lane * 8, act, first, last, rv);
        conv8(zp, conv, 1 * RW + lane * 8, act, first, last, kv);
        conv8(zp, conv, 2 * RW + lane * 8, act, first, last, vv);
        conv8(zp, conv, 3 * RW + lane * 8, act2, first, last, lr);
        float kk[8]; float ss = 0.f;
#pragma unroll
        for (int e = 0; e < 8; ++e) { kk[e] = kv[e] * kkw[e]; ss += kk[e] * kk[e]; }
        ss += __shfl_xor(ss, 1, 64); ss += __shfl_xor(ss, 2, 64); ss += __shfl_xor(ss, 4, 64);
        const float inv = 1.0f / fmaxf(sqrtf(ss), 1e-12f);
#pragma unroll
        for (int e = 0; e < 8; ++e) kk[e] *= inv;
        if (act) {
            const size_t o = (size_t)t * RW + lane * 8;
            *(u32x4*)(p.R + o) = pack8(rv); *(u32x4*)(p.KS + o) = pack8(kv); *(u32x4*)(p.V + o) = pack8(vv); *(u32x4*)(p.KK + o) = pack8(kk);
        }
        if (act2) {
            const int cc = lane * 8;
            if (cc < 128) {
#pragma unroll
                for (int e = 0; e < 8; ++e) lr[e] = tanhf_(lr[e]);
                *(u32x4*)(p.LR + (size_t)t * 256 + cc) = pack8(lr);
            } else if (cc < 256) {
                *(u32x4*)(p.LR + (size_t)t * 256 + cc) = pack8(lr);
            } else {
#pragma unroll
                for (int e = 0; e < 8; ++e) lr[e] = sigmoidf_(lr[e]);
                *(u32x4*)(p.GS + (size_t)t * 128 + cc - 256) = pack8(lr);
            }
        }
    }
}
__device__ __forceinline__ void phase_rwkv_prep2(const P& p, int l, char* smem) {
    const int ntm = MTOT / 128, ntn = NPAD(RW) / 128;
    const float* k_a = p.in[I_RKA] + (size_t)l * RW;
    const float* r_k = p.in[I_RRK] + (size_t)l * RW;
    for (int job = obid(); job < ntm * ntn * 2; job += gridDim.x) {
        const int d = job % 2, n0 = ((job / 2) % ntn) * 128, m0 = (job / (2 * ntn)) * 128;
        const float* w0 = p.in[I_RW0] + (size_t)(l * 2 + d) * RW;
        const float* a0 = p.in[I_RA0] + (size_t)(l * 2 + d) * RW;
        f32x4 accw[4][4], acca[4][4]; ZERO_ACC4(accw); ZERO_ACC4(acca);
        mfma_gemm_tile(p.WT_W2 + (size_t)d * NPAD(RW) * 64, 64, p.LR + d * 64, 256, 64, n0, m0, (bf16_t*)smem, accw);
        mfma_gemm_tile(p.WT_A2 + (size_t)d * NPAD(RW) * 64, 64, p.LR + 128 + d * 64, 256, 64, n0, m0, (bf16_t*)smem, acca);
        const int lane = otid() & 63, wave = otid() >> 6;
#pragma unroll
        for (int mi = 0; mi < 4; ++mi) {
            const int m = m0 + (wave & 1) * 64 + mi * 16 + (lane & 15);
            float bon = 0.f;
#pragma unroll
            for (int ni = 0; ni < 4; ++ni) {
                const int n = n0 + (wave >> 1) * 64 + ni * 16 + (lane >> 4) * 4;
                if (n < RW) {
                    const u32x2 kq = *(const u32x2*)(p.KS + (size_t)m * RW + n), kkq = *(const u32x2*)(p.KK + (size_t)m * RW + n), rq = *(const u32x2*)(p.R + (size_t)m * RW + n);
                    const float kv[4] = {LO16(kq.x), HI16(kq.x), LO16(kq.y), HI16(kq.y)};
                    const float kkv[4] = {LO16(kkq.x), HI16(kkq.x), LO16(kkq.y), HI16(kkq.y)};
                    const float rv[4] = {LO16(rq.x), HI16(rq.x), LO16(rq.y), HI16(rq.y)};
                    float lw[4], kd[4], bb[4];
#pragma unroll
                    for (int e = 0; e < 4; ++e) {
                        const float x = w0[n + e] + accw[ni][mi][e];
                        lw[e] = -fexp_(-softplusf_(-x) - 0.5f);
                        const float aa = sigmoidf_(a0[n + e] + acca[ni][mi][e]);
                        kd[e] = kv[e] * (1.0f + (aa - 1.0f) * k_a[n + e]);
                        bb[e] = kkv[e] * aa;
                        bon += rv[e] * kd[e] * r_k[n + e];
                    }
                    const size_t o = ((size_t)d * MTOT + m) * RW + n;
                    float4 lo4; lo4.x = lw[0]; lo4.y = lw[1]; lo4.z = lw[2]; lo4.w = lw[3];
                    *(float4*)(p.LW + o) = lo4;
                    *(u32x2*)(p.KD + o) = pack4(kd[0], kd[1], kd[2], kd[3]);
                    *(u32x2*)(p.BB + o) = pack4(bb[0], bb[1], bb[2], bb[3]);
                }
            }
            bon += __shfl_xor(bon, 16, 64); bon += __shfl_xor(bon, 32, 64);
            const int hh = (n0 + (wave >> 1) * 64) >> 6;
            if ((lane >> 4) == 0 && hh < RH) p.BONUS[((size_t)d * MTOT + m) * RH + hh] = bon;
        }
    }
}

#define CH_ROW 72
#define SEQ_REC 16640
#define CH_SLOT (64 * CH_ROW)
#define CH_XR_OFF (7 * CH_SLOT * 2)
#define CH_AAB_OFF (CH_XR_OFF + 64 * 132 * 4)
#define CH_GC_OFF (CH_AAB_OFF + 64 * 72 * 4)
template <int MT, int NT>
__device__ __forceinline__ void lds_mm(const bf16_t* A, int m0, const bf16_t* Bt, int n0, f32x4 (&acc)[MT][NT]) {
    const int lane = otid() & 63, q = lane >> 4, r = lane & 15;
#pragma unroll
    for (int s = 0; s < 2; ++s) {
        bf16x8 a[MT], b[NT];
#pragma unroll
        for (int i = 0; i < MT; ++i) a[i] = *(const bf16x8*)(A + (m0 + i * 16 + r) * CH_ROW + s * 32 + q * 8);
#pragma unroll
        for (int i = 0; i < NT; ++i) b[i] = *(const bf16x8*)(Bt + (n0 + i * 16 + r) * CH_ROW + s * 32 + q * 8);
#pragma unroll
        for (int i = 0; i < MT; ++i)
#pragma unroll
            for (int jj = 0; jj < NT; ++jj) acc[i][jj] = MFMA16(a[i], b[jj], acc[i][jj]);
    }
}
__device__ __forceinline__ void rwkv_chunk_job(const P& p, int l, int job, char* smem) {
    const int tid = otid(), lane = tid & 63, wv = tid >> 6, q = lane >> 4, r = lane & 15;
    const int d = job / (NC * RH), n = (job / RH) % NC, h = job % RH;
    const size_t base = (size_t)(d * NC + n) * RH + h;
    bf16_t* S0 = (bf16_t*)smem; bf16_t* S1 = S0 + CH_SLOT; bf16_t* S2 = S1 + CH_SLOT; bf16_t* S3 = S2 + CH_SLOT;
    bf16_t* S4 = S3 + CH_SLOT; bf16_t* S5 = S4 + CH_SLOT; bf16_t* S6 = S5 + CH_SLOT;
    float* X = (float*)(smem + CH_XR_OFF);
    float* AABt = (float*)(smem + CH_AAB_OFF);
    bf16_t* U0t = (bf16_t*)(smem + CH_AAB_OFF);
    bf16_t* Aht = U0t + CH_SLOT;
    float* GC = (float*)(smem + CH_GC_OFF);
    __syncthreads();
    u32x4 gkk[2], gr[2], gv[2], gks[2];
#pragma unroll
    for (int it = 0; it < 2; ++it) {
        const int c = tid + 256 * it, i = c >> 3, k0 = (c & 7) * 8; const int tok = 64 * n + (d ? 63 - i : i);
        const size_t o1 = (size_t)tok * RW + h * 64 + k0;
        gkk[it] = *(const u32x4*)(p.KK + o1); gr[it] = *(const u32x4*)(p.R + o1); gv[it] = *(const u32x4*)(p.V + o1); gks[it] = *(const u32x4*)(p.KS + o1);
    }
    {
        const int iw = 16 * wv + r; const int tokw = 64 * n + (d ? 63 - iw : iw);
        bf16x8 fw[2], fa[2];
#pragma unroll
        for (int s2 = 0; s2 < 2; ++s2) {
            fw[s2] = *(const bf16x8*)(p.LR + (size_t)tokw * 256 + d * 64 + s2 * 32 + q * 8);
            fa[s2] = *(const bf16x8*)(p.LR + (size_t)tokw * 256 + 128 + d * 64 + s2 * 32 + q * 8);
        }
        const bf16_t* w2 = p.WT_W2 + ((size_t)d * NPAD(RW) + h * 64) * 64; const bf16_t* a2 = p.WT_A2 + ((size_t)d * NPAD(RW) + h * 64) * 64;
        const float* w0 = p.in[I_RW0] + (size_t)(l * 2 + d) * RW + h * 64; const float* a0 = p.in[I_RA0] + (size_t)(l * 2 + d) * RW + h * 64;
#pragma unroll
        for (int nt = 0; nt < 4; ++nt) {
            f32x4 cw = {0.f, 0.f, 0.f, 0.f}, ca = {0.f, 0.f, 0.f, 0.f};
#pragma unroll
            for (int s2 = 0; s2 < 2; ++s2) {
                const bf16x8 bw = *(const bf16x8*)(w2 + (size_t)(nt * 16 + r) * 64 + s2 * 32 + q * 8), ba = *(const bf16x8*)(a2 + (size_t)(nt * 16 + r) * 64 + s2 * 32 + q * 8);
                cw = MFMA16(fw[s2], bw, cw); ca = MFMA16(fa[s2], ba, ca);
            }
            const float w0c = w0[nt * 16 + r], a0c = a0[nt * 16 + r];
#pragma unroll
            for (int e = 0; e < 4; ++e) {
                const int i = 16 * wv + 4 * q + e;
                X[i * 132 + nt * 16 + r] = -fexp_(-softplusf_(-(w0c + cw[e])) - 0.5f);
                X[i * 132 + 64 + nt * 16 + r] = sigmoidf_(a0c + ca[e]);
            }
        }
    }
    __syncthreads();
    {
        const int k = tid & 63, seg = tid >> 6;
        float v[16]; float run = 0.f;
#pragma unroll
        for (int e = 0; e < 16; ++e) { run += X[(seg * 16 + e) * 132 + k]; v[e] = run; }
        AABt[seg * 64 + k] = run;
        __syncthreads();
        float off = 0.f;
        for (int s2 = 0; s2 < seg; ++s2) off += AABt[s2 * 64 + k];
#pragma unroll
        for (int e = 0; e < 16; ++e) X[(seg * 16 + e) * 132 + k] = v[e] + off;
    }
    __syncthreads();
#pragma unroll
    for (int it = 0; it < 2; ++it) {
        const int c = tid + 256 * it, i = c >> 3, k0 = (c & 7) * 8;
        float L[8], Lp[8], LC[8], kkv[8], rv[8], vv[8], kdv[8], bbv[8], aav[8], ksv[8], kav[8], rkv[8];
        load8f(X + i * 132 + k0, L); load8f(X + 63 * 132 + k0, LC); load8f(X + i * 132 + 64 + k0, aav);
        load8f(p.in[I_RKA] + (size_t)l * RW + h * 64 + k0, kav); load8f(p.in[I_RRK] + (size_t)l * RW + h * 64 + k0, rkv);
        if (i > 0) load8f(X + (i - 1) * 132 + k0, Lp);
        else {
#pragma unroll
            for (int e = 0; e < 8; ++e) Lp[e] = 0.f;
        }
        unpack8(gkk[it], kkv); unpack8(gr[it], rv); unpack8(gv[it], vv); unpack8(gks[it], ksv);
        float bon = 0.f;
#pragma unroll
        for (int e = 0; e < 8; ++e) { kdv[e] = ksv[e] * (1.0f + (aav[e] - 1.0f) * kav[e]); bbv[e] = kkv[e] * aav[e]; bon += rv[e] * kdv[e] * rkv[e]; }
        bon += __shfl_xor(bon, 1, 64); bon += __shfl_xor(bon, 2, 64); bon += __shfl_xor(bon, 4, 64);
        if ((tid & 7) == 0) p.BONUS[((size_t)d * MTOT + 64 * n + (d ? 63 - i : i)) * RH + h] = bon;
        float at[8], rt[8], bt[8], kt[8], bh[8], kh[8];
#pragma unroll
        for (int e = 0; e < 8; ++e) {
            const float eL = fexp_(L[e]), eLp = fexp_(Lp[e]), eNL = fexp_(-L[e]), eCL = fexp_(LC[e] - L[e]);
            at[e] = -kkv[e] * eLp; rt[e] = rv[e] * eL; bt[e] = bbv[e] * eNL; kt[e] = kdv[e] * eNL; bh[e] = bbv[e] * eCL; kh[e] = kdv[e] * eCL;
            if (i == 63) GC[k0 + e] = eL;
        }
        *(u32x4*)(S0 + i * CH_ROW + k0) = pack8(at);
        store8f(X + i * 132 + 64 + k0, at);
        *(u32x4*)(S1 + i * CH_ROW + k0) = pack8(rt);
        *(u32x4*)(S2 + i * CH_ROW + k0) = pack8(bt);
        *(u32x4*)(S3 + i * CH_ROW + k0) = pack8(kt);
#pragma unroll
        for (int e = 0; e < 8; ++e) {
            S4[(k0 + e) * CH_ROW + i] = f2bf(vv[e]);
            S5[(k0 + e) * CH_ROW + i] = f2bf(bh[e]);
            S6[(k0 + e) * CH_ROW + i] = f2bf(kh[e]);
        }
    }
    __syncthreads();
    {
        f32x4 acc[4][4]; ZERO_ACC4(acc);
        lds_mm<4, 4>((wv < 2) ? S0 : S1, 0, (wv & 1) ? S3 : S2, 0, acc);
        __syncthreads();
#pragma unroll
        for (int mt = 0; mt < 4; ++mt)
#pragma unroll
            for (int nt = 0; nt < 4; ++nt) {
                const int jc = nt * 16 + r, i0 = mt * 16 + 4 * q;
                if (wv == 0) {
                    f32x4 o;
#pragma unroll
                    for (int e = 0; e < 4; ++e) o[e] = (jc < i0 + e) ? acc[mt][nt][e] : 0.f;
                    *(f32x4*)(AABt + jc * 72 + i0) = o;
                } else {
                    bf16_t* dst = (wv == 1) ? S0 : ((wv == 2) ? S2 : S3);
#pragma unroll
                    for (int e = 0; e < 4; ++e) {
                        const bool ok = (wv == 1) ? (jc < i0 + e) : (jc <= i0 + e);
                        dst[(i0 + e) * CH_ROW + jc] = f2bf(ok ? acc[mt][nt][e] : 0.f);
                    }
                }
            }
    }
    __syncthreads();
    {
        f32x4 acc[1][4];
#pragma unroll
        for (int nt = 0; nt < 4; ++nt) acc[0][nt] = (f32x4){0.f, 0.f, 0.f, 0.f};
        lds_mm<1, 4>(S0, 16 * wv, S4, 0, acc);
#pragma unroll
        for (int nt = 0; nt < 4; ++nt)
#pragma unroll
            for (int e = 0; e < 4; ++e) X[(16 * wv + 4 * q + e) * 132 + nt * 16 + r] = acc[0][nt][e];
    }
    __syncthreads();
    if (tid < 128) {
        const int c = tid;
        for (int bi = 0; bi < 4; ++bi) {
            float acc[16];
#pragma unroll
            for (int e = 0; e < 16; ++e) acc[e] = X[(16 * bi + e) * 132 + c];
            for (int jj = 0; jj < 16 * bi; ++jj) {
                const float uj = X[jj * 132 + c];
                const f32x4* ap = (const f32x4*)(AABt + jj * 72 + 16 * bi);
                const f32x4 a0 = ap[0], a1 = ap[1], a2 = ap[2], a3 = ap[3];
#pragma unroll
                for (int e = 0; e < 4; ++e) { acc[e] += a0[e] * uj; acc[4 + e] += a1[e] * uj; acc[8 + e] += a2[e] * uj; acc[12 + e] += a3[e] * uj; }
            }
#pragma unroll
            for (int e = 0; e < 16; ++e) {
                const float u = acc[e];
                X[(16 * bi + e) * 132 + c] = u;
                const f32x4* ap = (const f32x4*)(AABt + (16 * bi + e) * 72 + 16 * bi);
                const f32x4 a0 = ap[0], a1 = ap[1], a2 = ap[2], a3 = ap[3];
#pragma unroll
                for (int e2 = 0; e2 < 16; ++e2) if (e2 > e) acc[e2] += ((e2 < 4) ? a0[e2 & 3] : (e2 < 8) ? a1[e2 & 3] : (e2 < 12) ? a2[e2 & 3] : a3[e2 & 3]) * u;
            }
        }
    }
    __syncthreads();
    if (tid < 128) {
        const int c = tid;
        bf16_t* dst = (c < 64) ? (U0t + c * CH_ROW) : (Aht + (c - 64) * CH_ROW);
        u32x4 ov[8];
#pragma unroll
        for (int g = 0; g < 8; ++g) {
            float v[8];
#pragma unroll
            for (int e = 0; e < 8; ++e) v[e] = X[(g * 8 + e) * 132 + c];
            ov[g].x = pack2bf(v[0], v[1]); ov[g].y = pack2bf(v[2], v[3]);
            ov[g].z = pack2bf(v[4], v[5]); ov[g].w = pack2bf(v[6], v[7]);
        }
#pragma unroll
        for (int g = 0; g < 8; ++g) *(u32x4*)(dst + g * 8) = ov[g];
    }
    __syncthreads();
    {
        f32x4 acc[4][4]; ZERO_ACC4(acc);
        char* rec = p.REC + base * SEQ_REC;
        if (wv == 0) {
            lds_mm<4, 4>(Aht, 0, S5, 0, acc);
#pragma unroll
            for (int nt = 0; nt < 4; ++nt)
#pragma unroll
                for (int s2 = 0; s2 < 2; ++s2) {
                    u32x4 o;
                    o.x = pack2bf(acc[2 * s2][nt][0], acc[2 * s2][nt][1]); o.y = pack2bf(acc[2 * s2][nt][2], acc[2 * s2][nt][3]);
                    o.z = pack2bf(acc[2 * s2 + 1][nt][0], acc[2 * s2 + 1][nt][1]); o.w = pack2bf(acc[2 * s2 + 1][nt][2], acc[2 * s2 + 1][nt][3]);
                    *(u32x4*)(rec + (((nt * 2 + s2) * 64 + lane) * 8) * 2) = o;
                }
        } else if (wv == 1) {
            lds_mm<4, 4>(S5, 0, U0t, 0, acc);
            lds_mm<4, 4>(S6, 0, S4, 0, acc);
#pragma unroll
            for (int mt = 0; mt < 4; ++mt)
#pragma unroll
                for (int nt = 0; nt < 4; ++nt) *(u32x2*)(rec + 8192 + (((nt * 4 + mt) * 64 + lane) * 4) * 2) = pack4(acc[mt][nt][0], acc[mt][nt][1], acc[mt][nt][2], acc[mt][nt][3]);
        } else if (wv == 2) {
            lds_mm<4, 4>(S2, 0, Aht, 0, acc);
#pragma unroll
            for (int mt = 0; mt < 4; ++mt)
#pragma unroll
                for (int nt = 0; nt < 4; ++nt)
#pragma unroll
                    for (int e = 0; e < 4; ++e) {
                        const int t = mt * 16 + 4 * q + e, kc = nt * 16 + r;
                        p.QH[(base * 64 + t) * 64 + kc] = f2bf(acc[mt][nt][e] + bf2f(S1[t * CH_ROW + kc]));
                    }
        } else if (wv == 3) {
            lds_mm<4, 4>(S2, 0, U0t, 0, acc);
            lds_mm<4, 4>(S3, 0, S4, 0, acc);
#pragma unroll
            for (int mt = 0; mt < 4; ++mt)
#pragma unroll
                for (int nt = 0; nt < 4; ++nt) *(f32x4*)(p.Y0T + (((base * 4 + mt) * 4 + nt) * 64 + lane) * 4) = acc[mt][nt];
        }
        if (tid < 64) ((float*)(rec + 16384))[tid] = GC[tid];
    }
}

#define SEQ_SLOT 16896
__device__ __forceinline__ void rwkv_seq_gload(const P& p, size_t base, int tid, u32x4 (&g)[5]) {
    const u32x4* m = (const u32x4*)(p.REC + base * SEQ_REC);
#pragma unroll
    for (int i = 0; i < 4; ++i) g[i] = m[tid + 256 * i];
    if (tid < 16) g[4] = m[1024 + tid];
}
__device__ __forceinline__ void rwkv_seq_lstore(char* slot, int tid, const u32x4 (&g)[5]) {
    u32x4* d = (u32x4*)slot;
#pragma unroll
    for (int i = 0; i < 4; ++i) d[tid + 256 * i] = g[i];
    if (tid < 16) d[1024 + tid] = g[4];
}
__device__ __forceinline__ void rwkv_seq_step(const P& p, const char* slot, size_t base, int wv, int lane, f32x4 (&X)[4]) {
    const int q = lane >> 4, r = lane & 15;
    const bf16_t* mt = (const bf16_t*)slot; const bf16_t* ntb = (const bf16_t*)(slot + 8192); const float* gc = (const float*)(slot + 16384);
    unsigned xh[4][2];
#pragma unroll
    for (int kt = 0; kt < 4; ++kt) {
        xh[kt][0] = pack2bf(X[kt][0], X[kt][1]); xh[kt][1] = pack2bf(X[kt][2], X[kt][3]);
        *(u32x2*)(p.SN + (base * 64 + 16 * wv + r) * 64 + 16 * kt + 4 * q) = (u32x2){xh[kt][0], xh[kt][1]};
    }
    bf16x8 bh[2];
#pragma unroll
    for (int s2 = 0; s2 < 2; ++s2) bh[s2] = __builtin_bit_cast(bf16x8, ((u32x4){xh[2 * s2][0], xh[2 * s2][1], xh[2 * s2 + 1][0], xh[2 * s2 + 1][1]}));
#pragma unroll
    for (int tile = 0; tile < 4; ++tile) {
        const u32x2 nb = *(const u32x2*)(ntb + ((wv * 4 + tile) * 64 + lane) * 4);
        const f32x4 g4 = *(const f32x4*)(gc + tile * 16 + 4 * q);
        f32x4 acc;
        acc[0] = g4[0] * X[tile][0] + LO16(nb.x); acc[1] = g4[1] * X[tile][1] + HI16(nb.x);
        acc[2] = g4[2] * X[tile][2] + LO16(nb.y); acc[3] = g4[3] * X[tile][3] + HI16(nb.y);
#pragma unroll
        for (int s2 = 0; s2 < 2; ++s2) {
            const bf16x8 ah = *(const bf16x8*)(mt + ((tile * 2 + s2) * 64 + lane) * 8);
            acc = MFMA16(ah, bh[s2], acc);
        }
        X[tile] = acc;
    }
}
__device__ __forceinline__ void rwkv_seq_job(const P& p, int job, char* smem) {
    const int tid = otid(), lane = tid & 63, wv = tid >> 6;
    const int d = job / RH, h = job % RH;
    f32x4 X[4];
#pragma unroll
    for (int kt = 0; kt < 4; ++kt) X[kt] = (f32x4){0.f, 0.f, 0.f, 0.f};
    u32x4 g0[5], g1[5], g2[5];
#define SEQ_BASE(s_) ((size_t)(d * NC + chunk_order(d, ((s_) < NC) ? (s_) : NC - 1)) * RH + h)
    __syncthreads();
    rwkv_seq_gload(p, SEQ_BASE(0), tid, g0);
    rwkv_seq_gload(p, SEQ_BASE(1), tid, g1);
    rwkv_seq_gload(p, SEQ_BASE(2), tid, g2);
    rwkv_seq_lstore(smem, tid, g0);
    __syncthreads();
    for (int s = 0; s < NC; s += 6) {
#define SEQ_SUB(u, GFREE, GNEXT) \
        if (s + (u) < NC) { \
            rwkv_seq_gload(p, SEQ_BASE(s + (u) + 3), tid, GFREE); \
            rwkv_seq_step(p, smem + (((u) & 1) ? SEQ_SLOT : 0), SEQ_BASE(s + (u)), wv, lane, X); \
            rwkv_seq_lstore(smem + (((u) & 1) ? 0 : SEQ_SLOT), tid, GNEXT); \
        } \
        __syncthreads();
        SEQ_SUB(0, g0, g1)
        SEQ_SUB(1, g1, g2)
        SEQ_SUB(2, g2, g0)
        SEQ_SUB(3, g0, g1)
        SEQ_SUB(4, g1, g2)
        SEQ_SUB(5, g2, g0)
#undef SEQ_SUB
    }
#undef SEQ_BASE
}
struct RoBuf { bf16x8 a[2]; bf16x8 b[4][2]; f32x4 y0[4]; };
__device__ __forceinline__ void rwkv_out_load(const P& p, int job, int wv, int lane, RoBuf& o) {
    const int q = lane >> 4, r = lane & 15;
    const size_t base = (size_t)job;
#pragma unroll
    for (int s2 = 0; s2 < 2; ++s2) {
        o.a[s2] = *(const bf16x8*)(p.QH + (base * 64 + 16 * wv + r) * 64 + s2 * 32 + q * 8);
#pragma unroll
        for (int nt = 0; nt < 4; ++nt) o.b[nt][s2] = *(const bf16x8*)(p.SN + (base * 64 + nt * 16 + r) * 64 + s2 * 32 + q * 8);
    }
#pragma unroll
    for (int nt = 0; nt < 4; ++nt) o.y0[nt] = *(const f32x4*)(p.Y0T + (((base * 4 + wv) * 4 + nt) * 64 + lane) * 4);
}
__device__ __forceinline__ void rwkv_out_compute(const P& p, int job, int wv, int lane, const RoBuf& o) {
    const int q = lane >> 4, r = lane & 15;
    const int d = job / (NC * RH), n = (job / RH) % NC, h = job % RH;
#pragma unroll
    for (int nt = 0; nt < 4; ++nt) {
        f32x4 acc = o.y0[nt];
        acc = MFMA16(o.a[0], o.b[nt][0], acc);
        acc = MFMA16(o.a[1], o.b[nt][1], acc);
#pragma unroll
        for (int e = 0; e < 4; ++e) {
            const int t = 16 * wv + 4 * q + e; const int tok = 64 * n + (d ? 63 - t : t);
            p.Y[((size_t)d * MTOT + tok) * RW + h * 64 + nt * 16 + r] = acc[e];
        }
    }
}
__device__ __forceinline__ void phase_rwkv_out(const P& p) {
    const int tid = otid(), lane = tid & 63, wv = tid >> 6;
    if (wv >= 4) return;
    const int G = gridDim.x, total = 2 * NC * RH;
    int job = obid();
    if (job >= total) return;
    RoBuf b0, b1;
    rwkv_out_load(p, job, wv, lane, b0);
    for (; job < total; job += 2 * G) {
        if (job + G < total) rwkv_out_load(p, job + G, wv, lane, b1);
        rwkv_out_compute(p, job, wv, lane, b0);
        if (job + G < total) {
            if (job + 2 * G < total) rwkv_out_load(p, job + 2 * G, wv, lane, b0);
            rwkv_out_compute(p, job + G, wv, lane, b1);
        }
    }
}

#define GL_QR 0
#define GL_KR 9216
#define GL_VT 18432
#define GL_QI 36864
#define GL_KI 46080
#define GL_AT 55296
#define GL_CUM 64512
#define GL_ALR 81920
#define GL_WA 86016
__device__ __forceinline__ void gla_load_qkv(const P& p, int n, int h, char* smem) {
    const int tid = otid();
    bf16_t* Qr = (bf16_t*)(smem + GL_QR); bf16_t* Kr = (bf16_t*)(smem + GL_KR); bf16_t* Vt = (bf16_t*)(smem + GL_VT);
    for (int c = tid; c < 512; c += NTHREADS) {
        const int row = c >> 3, part = c & 7; const int t = gla_tok(n, row);
        const u32x4 qv = *(const u32x4*)(p.Z + (size_t)t * ZLD + ZQ + h * 64 + part * 8);
        const u32x4 kv = *(const u32x4*)(p.Z + (size_t)t * ZLD + ZK + h * 64 + part * 8);
        u32x4 qs;
        qs.x = pack2bf(LO16(qv.x) * 0.125f, HI16(qv.x) * 0.125f);
        qs.y = pack2bf(LO16(qv.y) * 0.125f, HI16(qv.y) * 0.125f);
        qs.z = pack2bf(LO16(qv.z) * 0.125f, HI16(qv.z) * 0.125f);
        qs.w = pack2bf(LO16(qv.w) * 0.125f, HI16(qv.w) * 0.125f);
        *(u32x4*)(Qr + row * CH_ROW + part * 8) = qs;
        *(u32x4*)(Kr + row * CH_ROW + part * 8) = kv;
    }
    for (int c = tid; c < 1024; c += NTHREADS) {
        const int row = c >> 4, part = c & 15; const int t = gla_tok(n, row);
        const u32x4 vv = *(const u32x4*)(p.Z + (size_t)t * ZLD + ZV + h * 128 + part * 8);
        bf16_t* dst = Vt + (part * 8) * CH_ROW + row;
        dst[0 * CH_ROW] = (bf16_t)(vv.x & 0xFFFF); dst[1 * CH_ROW] = (bf16_t)(vv.x >> 16);
        dst[2 * CH_ROW] = (bf16_t)(vv.y & 0xFFFF); dst[3 * CH_ROW] = (bf16_t)(vv.y >> 16);
        dst[4 * CH_ROW] = (bf16_t)(vv.z & 0xFFFF); dst[5 * CH_ROW] = (bf16_t)(vv.z >> 16);
        dst[6 * CH_ROW] = (bf16_t)(vv.w & 0xFFFF); dst[7 * CH_ROW] = (bf16_t)(vv.w >> 16);
    }
}
__device__ __forceinline__ void gla_cum(const P& p, int l, int n, int h, int d, char* smem) {
    const int tid = otid();
    float* CUM = (float*)(smem + GL_CUM); float* ALR = (float*)(smem + GL_ALR); float* WA = (float*)(smem + GL_WA);
    for (int c = tid; c < 256; c += NTHREADS) {
        const int row = c >> 2, part = c & 3; const int t = gla_tok(n, row);
        const u32x2 a = *(const u32x2*)(p.Z + (size_t)t * ZLD + (d ? ZAB : ZAF) + part * 4);
        float* dst = ALR + row * 16 + part * 4;
        dst[0] = LO16(a.x); dst[1] = HI16(a.x); dst[2] = LO16(a.y); dst[3] = HI16(a.y);
    }
    for (int c = tid; c < 16 * 64 + 64; c += NTHREADS) {
        if (c < 1024) WA[c] = p.in[I_GLA_WA2][((size_t)(l * 2 + d) * 16 + (c >> 6)) * GLA_K + h * 64 + (c & 63)];
        else WA[c] = p.in[I_GLA_BA][(size_t)(l * 2 + d) * GLA_K + h * 64 + (c - 1024)];
    }
    __syncthreads();
    for (int idx = tid; idx < 4096; idx += NTHREADS) {
        const int i = idx >> 6, k = idx & 63;
        float a = WA[1024 + k];
#pragma unroll
        for (int r = 0; r < 16; ++r) a += ALR[i * 16 + r] * WA[r * 64 + k];
        CUM[i * 68 + k] = (fminf(a, 0.f) - flog_(1.0f + fexp_(-fabsf(a)))) * (1.0f / 16.0f);
    }
    __syncthreads();
    {
        const int k = tid & 63, seg = (tid >> 6) & 3;
        float v[16]; float run = 0.f;
        if (tid < 256) {
#pragma unroll
            for (int e = 0; e < 16; ++e) { const int pos = seg * 16 + e; const int i = d ? 63 - pos : pos; run += CUM[i * 68 + k]; v[e] = run; }
            ALR[seg * 64 + k] = run;
        }
        __syncthreads();
        if (tid < 256) {
            float off = 0.f;
            for (int s2 = 0; s2 < seg; ++s2) off += ALR[s2 * 64 + k];
#pragma unroll
            for (int e = 0; e < 16; ++e) { const int pos = seg * 16 + e; const int i = d ? 63 - pos : pos; CUM[i * 68 + k] = v[e] + off; }
        }
    }
    __syncthreads();
}
__device__ __forceinline__ void phase_gla_kv(const P& p, int l, char* smem) {
    const int tid = otid(), lane = tid & 63, wv = tid >> 6, q = lane >> 4, r = lane & 15;
    bf16_t* Kr = (bf16_t*)(smem + GL_KR); bf16_t* Vt = (bf16_t*)(smem + GL_VT); bf16_t* KdT = (bf16_t*)(smem + GL_KI);
    float* CUM = (float*)(smem + GL_CUM);
    for (int job = obid(); job < NC * GH; job += gridDim.x) {
        const int n = job / GH, h = job % GH;
        __syncthreads();
        gla_load_qkv(p, n, h, smem);
        for (int d = 0; d < 2; ++d) {
            gla_cum(p, l, n, h, d, smem);
            const int li = d ? 0 : 63;
            for (int idx = tid; idx < 4096; idx += NTHREADS) {
                const int i = idx >> 6, k = idx & 63;
                KdT[k * CH_ROW + i] = f2bf(bf2f(Kr[i * CH_ROW + k]) * fexp_(CUM[li * 68 + k] - CUM[i * 68 + k]));
            }
            if (tid < 64) p.DEC[((size_t)(d * NC + n) * GH + h) * 64 + tid] = fexp_(CUM[li * 68 + tid]);
            __syncthreads();
            float* kvt = p.KV + ((size_t)(d * NC + n) * GH + h) * 8192;
            for (int mt = wv; mt < 4; mt += NTHREADS / 64) {
                f32x4 acc[1][8];
#pragma unroll
                for (int nt = 0; nt < 8; ++nt) acc[0][nt] = (f32x4){0.f, 0.f, 0.f, 0.f};
                lds_mm<1, 8>(KdT, 16 * mt, Vt, 0, acc);
#pragma unroll
                for (int nt = 0; nt < 8; ++nt) *(f32x4*)(kvt + (size_t)(nt * 16 + r) * 64 + 16 * mt + 4 * q) = acc[0][nt];
            }
            __syncthreads();
        }
    }
    __syncthreads();
}
__device__ __forceinline__ void gla_scan_job(const P& p, int job) {
    const int base = job * NTHREADS + otid();
    const int d = base / (GH * 8192), h = (base / 8192) % GH, e = base % 8192;
    const float* __restrict__ kvp = p.KV; const float* __restrict__ decp = p.DEC; bf16_t* __restrict__ sp = p.SP;
    float S = 0.f;
    for (int s = 0; s < NC; s += 4) {
        float kv[4], dc[4]; size_t oo[4];
#pragma unroll
        for (int u = 0; u < 4; ++u) {
            const int n = chunk_order(d, (s + u < NC) ? s + u : NC - 1);
            oo[u] = ((size_t)(d * NC + n) * GH + h);
            kv[u] = kvp[oo[u] * 8192 + e]; dc[u] = decp[oo[u] * 64 + (e & 63)];
        }
#pragma unroll
        for (int u = 0; u < 4; ++u) if (s + u < NC) { sp[oo[u] * 8192 + e] = f2bf(S); S = dc[u] * S + kv[u]; }
    }
}
__device__ __forceinline__ void phase_gla_out(const P& p, int l, char* smem) {
    const int tid = otid(), lane = tid & 63, wv = tid >> 6, q = lane >> 4, r = lane & 15;
    bf16_t* Qr = (bf16_t*)(smem + GL_QR); bf16_t* Kr = (bf16_t*)(smem + GL_KR); bf16_t* Vt = (bf16_t*)(smem + GL_VT);
    bf16_t* Qi = (bf16_t*)(smem + GL_QI); bf16_t* Ki = (bf16_t*)(smem + GL_KI); bf16_t* At = (bf16_t*)(smem + GL_AT);
    float* CUM = (float*)(smem + GL_CUM);
    for (int job = obid(); job < NC * GH; job += gridDim.x) {
        const int n = job / GH, h = job % GH;
        __syncthreads();
        gla_load_qkv(p, n, h, smem);
        f32x4 o[1][8];
#pragma unroll
        for (int nt = 0; nt < 8; ++nt) o[0][nt] = (f32x4){0.f, 0.f, 0.f, 0.f};
        for (int d = 0; d < 2; ++d) {
            gla_cum(p, l, n, h, d, smem);
            for (int idx = tid; idx < 4096; idx += NTHREADS) {
                const int i = idx >> 6, k = idx & 63; const float c = CUM[i * 68 + k];
                Qi[i * CH_ROW + k] = f2bf(bf2f(Qr[i * CH_ROW + k]) * fexp_(c));
                Ki[i * CH_ROW + k] = f2bf(bf2f(Kr[i * CH_ROW + k]) * fexp_(-c));
            }
            __syncthreads();
            if (wv < 4) {
                f32x4 a[1][4];
#pragma unroll
                for (int nt = 0; nt < 4; ++nt) a[0][nt] = (f32x4){0.f, 0.f, 0.f, 0.f};
                lds_mm<1, 4>(Qi, 16 * wv, Ki, 0, a);
#pragma unroll
                for (int nt = 0; nt < 4; ++nt)
#pragma unroll
                    for (int e = 0; e < 4; ++e) {
                        const int i = 16 * wv + 4 * q + e, j = nt * 16 + r;
                        const bool ok = d ? (j >= i) : (j <= i);
                        At[i * CH_ROW + j] = f2bf(ok ? a[0][nt][e] : 0.f);
                    }
                WAVE_SYNC();
                lds_mm<1, 8>(At, 16 * wv, Vt, 0, o);
                const bf16_t* sp = p.SP + ((size_t)(d * NC + n) * GH + h) * 8192;
#pragma unroll
                for (int s2 = 0; s2 < 2; ++s2) {
                    const bf16x8 af = *(const bf16x8*)(Qi + (16 * wv + r) * CH_ROW + s2 * 32 + q * 8);
#pragma unroll
                    for (int nt = 0; nt < 8; ++nt) {
                        const bf16x8 bfr = *(const bf16x8*)(sp + (size_t)(nt * 16 + r) * 64 + s2 * 32 + q * 8);
                        o[0][nt] = MFMA16(af, bfr, o[0][nt]);
                    }
                }
            }
            __syncthreads();
        }
        if (wv < 4) {
#pragma unroll
            for (int nt = 0; nt < 8; ++nt)
#pragma unroll
                for (int e = 0; e < 4; ++e) {
                    const int t = gla_tok(n, 16 * wv + 4 * q + e);
                    p.OGLA[(size_t)t * GLA_V + h * 128 + nt * 16 + r] = o[0][nt][e];
                }
        }
    }
    __syncthreads();
}

#define S5_XH_OFF (2 * 64 * 132 * 4)
#define S5_XL_OFF (S5_XH_OFF + 64 * 136 * 2)
#define S5_CT_OFF (S5_XL_OFF + 64 * 136 * 2)
__device__ __forceinline__ void phase_s5_pass(const P& p, int l, char* smem, bool with_out) {
    const int tid = otid(), lane = tid & 63, wv = tid >> 6, q = lane >> 4, r = lane & 15;
    float* BU = (float*)smem; bf16_t* XH = (bf16_t*)(smem + S5_XH_OFF); bf16_t* XL = (bf16_t*)(smem + S5_XL_OFF); bf16_t* CTp = (bf16_t*)(smem + S5_CT_OFF);
    const int dW = (wv >> 1) & 1, ntb = (wv & 1) * 4;
    const int dS = (tid >> 6) & 1, st = tid & 63;
    bf16x8 bhi[4], blo[4];
    float are = 0.f, aim = 0.f, dco = 0.f;
    int cur_g = -1;
    const bf16x8 zero8 = {0, 0, 0, 0, 0, 0, 0, 0};
    bf16x8 a_cur[4]; float2 car_cur = {0.f, 0.f};
#define S5_FETCH(JOB, A, CAR) { const int n_ = (JOB) / SG, g_ = (JOB) % SG; \
        if (wv < 4) { _Pragma("unroll") for (int mt = 0; mt < 4; ++mt) A[mt] = (q < 2) ? *(const bf16x8*)(p.Z + (size_t)(n_ * 64 + 16 * mt + r) * ZLD + ZS5 + g_ * 16 + 8 * q) : zero8; } \
        if (with_out && tid < 128) CAR = *(const float2*)(p.S5CAR + ((((size_t)dS * NC + n_) * SG + g_) * 64 + st) * 2); }
    if (obid() < NC * SG) S5_FETCH(obid(), a_cur, car_cur);
    for (int job = obid(); job < NC * SG; job += gridDim.x) {
        const int n = job / SG, g = job % SG;
        __syncthreads();
        if (g != cur_g) {
            cur_g = g;
            if (wv < 4) {
#pragma unroll
                for (int jn = 0; jn < 4; ++jn) {
                    const int kk = 16 * (ntb + jn) + r; const size_t ci = ((size_t)dW * SG + g) * 64 + (kk >> 1);
                    float f[8], lo[8];
#pragma unroll
                    for (int e = 0; e < 8; ++e) f[e] = (q < 2) ? p.S5BB[(ci * 16 + 8 * q + e) * 2 + (kk & 1)] : 0.f;
                    const u32x4 hv = pack8(f);
                    float hf[8]; unpack8(hv, hf);
#pragma unroll
                    for (int e = 0; e < 8; ++e) lo[e] = f[e] - hf[e];
                    bhi[jn] = __builtin_bit_cast(bf16x8, hv); blo[jn] = __builtin_bit_cast(bf16x8, pack8(lo));
                }
            }
            if (tid < 128) { const size_t ci = ((size_t)dS * SG + g) * 64 + st; are = p.S5A[ci * 2]; aim = p.S5A[ci * 2 + 1]; }
            if (with_out) {
                for (int idx = tid; idx < 16 * 128; idx += NTHREADS) {
                    const int c = idx >> 7, kk = idx & 127;
                    const float v = (kk & 1) ? -p.in[I_S5CIM][((size_t)l * SG + g) * 1024 + c * 64 + (kk >> 1)] : p.in[I_S5CRE][((size_t)l * SG + g) * 1024 + c * 64 + (kk >> 1)];
                    CTp[c * 136 + kk] = f2bf(v);
                }
                dco = p.in[I_S5D][(size_t)l * SW + g * 16 + r];
            }
        }
        float xr = car_cur.x, xi = car_cur.y;
        const size_t eo = (((size_t)dS * NC + n) * SG + g) * 64 + st;
        unsigned short uu[4] = {0, 0, 0, 0};
        if (with_out && wv < 4) {
#pragma unroll
            for (int e = 0; e < 4; ++e) uu[e] = p.Z[(size_t)(n * 64 + 16 * wv + 4 * q + e) * ZLD + ZS5 + g * 16 + r];
        }
        if (wv < 4) {
#pragma unroll
            for (int mt = 0; mt < 4; ++mt) {
                const bf16x8 a = a_cur[mt];
#pragma unroll
                for (int jn = 0; jn < 4; ++jn) {
                    f32x4 acc = {0.f, 0.f, 0.f, 0.f};
                    acc = MFMA16(a, bhi[jn], acc);
                    acc = MFMA16(a, blo[jn], acc);
#pragma unroll
                    for (int e = 0; e < 4; ++e) BU[(dW * 64 + 16 * mt + 4 * q + e) * 132 + 16 * (ntb + jn) + r] = acc[e];
                }
            }
        }
        if (job + (int)gridDim.x < NC * SG) S5_FETCH(job + (int)gridDim.x, a_cur, car_cur);
        __syncthreads();
        if (tid < 128) {
            float2* bp0 = (float2*)(BU + (dS * 64 + (dS ? 63 : 0)) * 132 + st * 2);
#define S5_SCAN(SGN) { _Pragma("unroll 1") for (int ib = 0; ib < 4; ++ib) { float2 bv[16]; \
                _Pragma("unroll") for (int u = 0; u < 16; ++u) bv[u] = bp0[(SGN) * (ib * 16 + u) * 66]; \
                _Pragma("unroll") for (int u = 0; u < 16; ++u) { \
                    const float nr = are * xr - aim * xi + bv[u].x, ni = are * xi + aim * xr + bv[u].y; xr = nr; xi = ni; \
                    if (with_out) { float2 o; o.x = xr; o.y = xi; bp0[(SGN) * (ib * 16 + u) * 66] = o; } } } }
            if (dS) S5_SCAN(-1) else S5_SCAN(1)
            if (!with_out) { float2 o; o.x = xr; o.y = xi; *(float2*)(p.S5END + eo * 2) = o; }
        }
        if (with_out) {
            __syncthreads();
            for (int cidx = tid; cidx < 64 * 16; cidx += NTHREADS) {
                const int i = cidx >> 4, k0 = (cidx & 15) * 8;
                float a[8], b[8], lo[8];
                load8f(BU + (0 * 64 + i) * 132 + k0, a); load8f(BU + (1 * 64 + i) * 132 + k0, b);
#pragma unroll
                for (int e = 0; e < 8; ++e) a[e] += b[e];
                const u32x4 hv = pack8(a);
                float hf[8]; unpack8(hv, hf);
#pragma unroll
                for (int e = 0; e < 8; ++e) lo[e] = a[e] - hf[e];
                *(u32x4*)(XH + i * 136 + k0) = hv; *(u32x4*)(XL + i * 136 + k0) = pack8(lo);
            }
            __syncthreads();
            if (wv < 4) {
                f32x4 acc = {0.f, 0.f, 0.f, 0.f};
#pragma unroll
                for (int ks = 0; ks < 4; ++ks) {
                    const bf16x8 ah = *(const bf16x8*)(XH + (16 * wv + r) * 136 + ks * 32 + q * 8), al = *(const bf16x8*)(XL + (16 * wv + r) * 136 + ks * 32 + q * 8);
                    const bf16x8 b = *(const bf16x8*)(CTp + r * 136 + ks * 32 + q * 8);
                    acc = MFMA16(ah, b, acc);
                    acc = MFMA16(al, b, acc);
                }
#pragma unroll
                for (int e = 0; e < 4; ++e) {
                    const int i = 16 * wv + 4 * q + e;
                    const float u = bf2f(uu[e]);
                    p.GY[(size_t)(n * 64 + i) * SW + g * 16 + r] = f2bf(geluf_(acc[e] + dco * u));
                }
            }
        }
    }
    __syncthreads();
}
__device__ __forceinline__ void s5_carry_job(const P& p, int job) {
    const int base = job * NTHREADS + otid();
    if (base >= 2 * SG * 64) return;
    const int d = base / (SG * 64), g = (base / 64) % SG, st = base % 64;
    const size_t ci = ((size_t)d * SG + g) * 64 + st;
    float ar = p.S5A[ci * 2], ai = p.S5A[ci * 2 + 1];
    for (int i = 0; i < 6; ++i) { const float nr = ar * ar - ai * ai, ni = 2.f * ar * ai; ar = nr; ai = ni; }
    const float2* __restrict__ endp = (const float2*)p.S5END; float2* __restrict__ carp = (float2*)p.S5CAR;
    float cr = 0.f, cim = 0.f;
    for (int s = 0; s < NC; s += 4) {
        float2 ev[4]; size_t eo[4];
#pragma unroll
        for (int u = 0; u < 4; ++u) {
            const int n = chunk_order(d, (s + u < NC) ? s + u : NC - 1);
            eo[u] = (((size_t)d * NC + n) * SG + g) * 64 + st;
            ev[u] = endp[eo[u]];
        }
#pragma unroll
        for (int u = 0; u < 4; ++u) if (s + u < NC) {
            float2 c; c.x = cr; c.y = cim; carp[eo[u]] = c;
            const float nr = ar * cr - ai * cim + ev[u].x, ni = ar * cim + ai * cr + ev[u].y;
            cr = nr; cim = ni;
        }
    }
}

__device__ __forceinline__ void phase_side_elem(const P& p, int l) {
    const int lane = otid() & 63;
    const int gw = (obid() * NTHREADS + otid()) >> 6, nw = (gridDim.x * NTHREADS) >> 6;
    const bool actg = lane * 8 < GLA_V, actr = lane * 8 < RW;
    float gng[8], lnw[8], lnb[8];
#pragma unroll
    for (int e = 0; e < 8; ++e) { gng[e] = 0.f; lnw[e] = 0.f; lnb[e] = 0.f; }
    if (actg) load8f(p.in[I_GLA_NG] + (size_t)l * 128 + ((lane * 8) & 127), gng);
    if (actr) { load8f(p.in[I_RLNW] + (size_t)l * RW + lane * 8, lnw); load8f(p.in[I_RLNB] + (size_t)l * RW + lane * 8, lnb); }
    for (int t = gw; t < MTOT; t += nw) {
        float og[8], zo[8], y0[8], y1[8], vv[8];
        const u32x4 z4 = {0u, 0u, 0u, 0u};
#pragma unroll
        for (int e = 0; e < 8; ++e) { og[e] = 0.f; y0[e] = 0.f; y1[e] = 0.f; }
        if (actg) load8f(p.OGLA + (size_t)t * GLA_V + lane * 8, og);
        unpack8(actg ? *(const u32x4*)(p.Z + (size_t)t * ZLD + ZOG + lane * 8) : z4, zo);
        if (actr) { load8f(p.Y + (size_t)t * RW + lane * 8, y0); load8f(p.Y + ((size_t)MTOT + t) * RW + lane * 8, y1); }
        unpack8(actr ? *(const u32x4*)(p.V + (size_t)t * RW + lane * 8) : z4, vv);
        float g2v[8]; unpack8(actr ? *(const u32x4*)(p.G2B + (size_t)t * RW + lane * 8) : z4, g2v);
        const int hh = (lane * 8) >> 6;
        const float bon = actr ? (p.BONUS[(size_t)t * RH + hh] + p.BONUS[((size_t)MTOT + t) * RH + hh]) : 0.f;
        float ss = 0.f;
#pragma unroll
        for (int e = 0; e < 8; ++e) ss += og[e] * og[e];
        ss += __shfl_xor(ss, 1, 64); ss += __shfl_xor(ss, 2, 64); ss += __shfl_xor(ss, 4, 64); ss += __shfl_xor(ss, 8, 64);
        const float rstd = rsqrtf(ss * (1.0f / 128.f) + 1e-6f);
        float br[8];
#pragma unroll
        for (int e = 0; e < 8; ++e) br[e] = og[e] * rstd * gng[e] * siluf_(zo[e]);
        if (actg) *(u32x4*)(p.BR + (size_t)t * 3 * BW + lane * 8) = pack8(br);
        float y[8]; float sm = 0.f;
#pragma unroll
        for (int e = 0; e < 8; ++e) { y[e] = y0[e] + y1[e]; sm += y[e]; }
        sm += __shfl_xor(sm, 1, 64); sm += __shfl_xor(sm, 2, 64); sm += __shfl_xor(sm, 4, 64);
        const float mu = sm * (1.0f / 64.f);
        float sv = 0.f;
#pragma unroll
        for (int e = 0; e < 8; ++e) { y[e] -= mu; sv += y[e] * y[e]; }
        sv += __shfl_xor(sv, 1, 64); sv += __shfl_xor(sv, 2, 64); sv += __shfl_xor(sv, 4, 64);
        const float rs = rsqrtf(sv * (1.0f / 64.f) + 64e-5f);
        float yn[8];
#pragma unroll
        for (int e = 0; e < 8; ++e) yn[e] = y[e] * rs * lnw[e] + lnb[e] + bon * vv[e];
#pragma unroll
        for (int e = 0; e < 8; ++e) yn[e] *= g2v[e];
        if (actr) *(u32x4*)(p.BR + (size_t)t * 3 * BW + BW + lane * 8) = pack8(yn);
    }
}

__device__ __forceinline__ void g2_gemm_job(const P& p, int job, char* smem) {
    const int ntn = NPAD(RW) / 128;
    gemm_tile_run<4, 8>(p.WT_G2, 128, (size_t)NPAD(RW) * 128 * 2, p.GS, 128, (size_t)MTOT * 128 * 2, 128, (job % ntn) * 128, (job / ntn) * 256, (bf16_t*)smem, NoPre(),
        [&](int, int, int m, int n, const f32x4 v) { if (n < RW) *(u32x2*)(p.G2B + (size_t)m * RW + n) = pack4(v[0], v[1], v[2], v[3]); });
}
#define G2_JOBS ((MTOT / 256) * (NPAD(RW) / 128))
__device__ __forceinline__ void phase_glu_gemm(const P& p, int l, char* smem) {
    gemm_phase<4>(p.WT_GLU, SW, (size_t)NPAD(2 * SW) * SW * 2, p.GY, SW, (size_t)MTOT * SW * 2, SW, 2 * SW, (bf16_t*)smem, NoPre(), NoPre(),
        [&](int, int, int m, int n, const f32x4 v) {
            *(unsigned*)(p.BR + (size_t)m * 3 * BW + 2 * BW + (n >> 1)) = pack2bf(v[0] * sigmoidf_(v[1]), v[2] * sigmoidf_(v[3]));
        });
}
__device__ __forceinline__ void phase_merge(const P& p, int l, char* smem) {
    const int ntn = D_MODEL / 128, ntm = (MTOT - 256) / 256;
    auto run = [&](auto mi_tag, int n0, int m0) {
        constexpr int MI = decltype(mi_tag)::value;
        f32x4 macc[4][MI];
#pragma unroll
        for (int i = 0; i < 4; ++i)
#pragma unroll
            for (int j = 0; j < MI; ++j) macc[i][j] = (f32x4){0.f, 0.f, 0.f, 0.f};
        const int lane = otid() & 63, wave = otid() >> 6;
        for (int b = 0; b < 3; ++b) {
            f32x4 acc[4][MI];
#pragma unroll
            for (int i = 0; i < 4; ++i)
#pragma unroll
                for (int j = 0; j < MI; ++j) acc[i][j] = (f32x4){0.f, 0.f, 0.f, 0.f};
            mfma_gemm_tile_t<4, MI>(p.WT_BR + (size_t)b * D_MODEL * BW, BW, (size_t)D_MODEL * BW * 2, p.BR + b * BW, 3 * BW, (size_t)MTOT * 3 * BW * 2 - b * BW * 2, BW, n0, m0, (bf16_t*)smem, acc);
#pragma unroll
            for (int ni = 0; ni < 4; ++ni)
#pragma unroll
                for (int mi = 0; mi < MI; ++mi) {
                    const int n = n0 + (wave >> 1) * 64 + ni * 16 + (lane >> 4) * 4, m = m0 + (wave & 1) * 16 * MI + mi * 16 + (lane & 15);
                    const u32x2 g = *(const u32x2*)(p.ZGT + ((((size_t)(m >> 4) * (3 * D_MODEL / 16) + ((b * D_MODEL + n) >> 4)) * 64 + lane) * 4));
                    macc[ni][mi][0] += LO16(g.x) * acc[ni][mi][0]; macc[ni][mi][1] += HI16(g.x) * acc[ni][mi][1];
                    macc[ni][mi][2] += LO16(g.y) * acc[ni][mi][2]; macc[ni][mi][3] += HI16(g.y) * acc[ni][mi][3];
                }
        }
#pragma unroll
        for (int ni = 0; ni < 4; ++ni)
#pragma unroll
            for (int mi = 0; mi < MI; ++mi) {
                const int n = n0 + (wave >> 1) * 64 + ni * 16 + (lane >> 4) * 4, m = m0 + (wave & 1) * 16 * MI + mi * 16 + (lane & 15);
                *(u32x2*)(p.M + (size_t)m * D_MODEL + n) = pack4(macc[ni][mi][0], macc[ni][mi][1], macc[ni][mi][2], macc[ni][mi][3]);
            }
    };
    for (int it = 0;; ++it) {
        int mt_, nt_; if (!tile_map(it, ntm, ntn, (ntn >= 8) ? 4 : 8, mt_, nt_)) break;
        run(std::integral_constant<int, 8>(), nt_ * 128, mt_ * 256);
    }
    for (int job = obid(); job < 4 * ntn; job += gridDim.x) run(std::integral_constant<int, 2>(), (job >> 2) * 128, MTOT - 256 + (job & 3) * 64);
}

__device__ __forceinline__ void phase_outproj(const P& p, int l, char* smem) {
    gemm_phase<4>(p.WT_OUT, D_MODEL, (size_t)D_MODEL * D_MODEL * 2, p.M, D_MODEL, (size_t)MTOT * D_MODEL * 2, D_MODEL, D_MODEL, (bf16_t*)smem, NoPre(), NoPre(),
        [&](int, int, int m, int n, const f32x4 v) {
            const float* g1 = p.MOD + (size_t)(l * 2 + (m >= CTX ? 1 : 0)) * 6 * D_MODEL + 2 * D_MODEL + n;
            float4* xp = (float4*)(p.X + (size_t)m * D_MODEL + n); float4 x = *xp;
            x.x += g1[0] * v[0]; x.y += g1[1] * v[1]; x.z += g1[2] * v[2]; x.w += g1[3] * v[3]; *xp = x;
        });
}

__device__ __forceinline__ void store_q_hilo(const P& p, int m, int n, const f32x4 v) {
    const bf16_t h0 = f2bf(v[0]), h1 = f2bf(v[1]), h2 = f2bf(v[2]), h3 = f2bf(v[3]);
    u32x2 hv; hv.x = (unsigned)h0 | ((unsigned)h1 << 16); hv.y = (unsigned)h2 | ((unsigned)h3 << 16);
    *(u32x2*)(p.QHI + (size_t)m * PQ + n) = hv;
    *(u32x2*)(p.QLO + (size_t)m * PQ + n) = pack4(v[0] - bf2f(h0), v[1] - bf2f(h1), v[2] - bf2f(h2), v[3] - bf2f(h3));
}
__device__ __forceinline__ void phase_peer_q(const P& p, int l, char* smem) {
    gemm_phase<4>(p.WT_Q, D_MODEL, (size_t)PQ * D_MODEL * 2, p.H, D_MODEL, (size_t)MTOT * D_MODEL * 2, D_MODEL, PQ, (bf16_t*)smem, NoPre(), NoPre(),
        [&](int, int, int m, int n, const f32x4 v) { store_q_hilo(p, m, n, v); });
}

#define TK_ROW 129
__device__ __forceinline__ unsigned tk_key(float f, unsigned lowmask, unsigned low) {
    unsigned u = __builtin_bit_cast(unsigned, f);
    u ^= (u & 0x80000000u) ? 0xFFFFFFFFu : 0x80000000u;
    return (u & ~lowmask) | low;
}
#define TK_INSERT(lv, xk) { unsigned x_ = (xk); _Pragma("unroll") for (int z_ = 0; z_ < 16; ++z_) { const unsigned hi_ = lv[z_] > x_ ? lv[z_] : x_; x_ = lv[z_] > x_ ? x_ : lv[z_]; lv[z_] = hi_; } }
__device__ __forceinline__ void phase_peer_topk(const P& p, int l, char* smem) {
    const int tid = otid(), lane = tid & 63, wv = tid >> 6, q = lane >> 4, r = lane & 15;
    float* sc = (float*)smem + wv * (64 * TK_ROW);
    const int gw = (obid() * NTHREADS + tid) >> 6, nw = (gridDim.x * NTHREADS) >> 6;
    const float NEG = -3.0e38f;
    for (int job = gw; job < (MTOT / 32) * PH; job += nw) {
        const int t0 = (job / PH) * 32, h = job % PH;
#pragma unroll
        for (int sd = 0; sd < 2; ++sd) {
            f32x4 acc[2][8];
#pragma unroll
            for (int mt = 0; mt < 2; ++mt)
#pragma unroll
                for (int nt = 0; nt < 8; ++nt) acc[mt][nt] = (f32x4){0.f, 0.f, 0.f, 0.f};
#pragma unroll
            for (int ks = 0; ks < 4; ++ks) {
                bf16x8 ah[2], al[2];
#pragma unroll
                for (int mt = 0; mt < 2; ++mt) {
                    const size_t qo = (size_t)(t0 + mt * 16 + r) * PQ + h * 256 + sd * 128 + ks * 32 + q * 8;
                    ah[mt] = *(const bf16x8*)(p.QHI + qo); al[mt] = *(const bf16x8*)(p.QLO + qo);
                }
#pragma unroll
                for (int nt = 0; nt < 8; ++nt) {
                    const size_t ko = ((size_t)(h * 2 + sd) * 128 + nt * 16 + r) * 128 + ks * 32 + q * 8;
                    const bf16x8 bh = *(const bf16x8*)(p.KHI + ko), bl = *(const bf16x8*)(p.KLO + ko);
#pragma unroll
                    for (int mt = 0; mt < 2; ++mt) {
                        acc[mt][nt] = MFMA16(ah[mt], bh, acc[mt][nt]);
                        acc[mt][nt] = MFMA16(al[mt], bh, acc[mt][nt]);
                        acc[mt][nt] = MFMA16(ah[mt], bl, acc[mt][nt]);
                    }
                }
            }
#pragma unroll
            for (int mt = 0; mt < 2; ++mt)
#pragma unroll
                for (int nt = 0; nt < 8; ++nt)
#pragma unroll
                    for (int e = 0; e < 4; ++e) sc[(sd * 32 + mt * 16 + 4 * q + e) * TK_ROW + nt * 16 + r] = acc[mt][nt][e];
        }
        WAVE_SYNC();
        unsigned lv[16];
#pragma unroll
        for (int z = 0; z < 16; ++z) lv[z] = 0u;
        {
            const float* row = sc + lane * TK_ROW;
#pragma unroll 4
            for (int k = 0; k < 128; ++k) TK_INSERT(lv, tk_key(row[k], 0x7Fu, (unsigned)(127 - k)));
        }
        float lvv[16]; int li[16];
        {
            const float* row = sc + lane * TK_ROW;
#pragma unroll
            for (int z = 0; z < 16; ++z) { li[z] = 127 - (int)(lv[z] & 0x7Fu); lvv[z] = row[li[z]]; }
        }
        WAVE_SYNC();
        {
            float* row = sc + lane * TK_ROW;
#pragma unroll
            for (int z = 0; z < 16; ++z) { row[z] = lvv[z]; ((int*)row)[16 + z] = li[z]; }
        }
        WAVE_SYNC();
        const float* r1 = sc + (lane & 31) * TK_ROW; const float* r2 = sc + (32 + (lane & 31)) * TK_ROW;
        unsigned tk[16];
#pragma unroll
        for (int z = 0; z < 16; ++z) tk[z] = 0u;
        for (int i = 0; i < 16; ++i) {
            const float a = r1[i];
            const int nj = 16 / (i + 1);
            for (int j = 0; j < nj; ++j) TK_INSERT(tk, tk_key(a + r2[j], 0xFFu, (unsigned)(255 - (i * 16 + j))));
        }
        int tc[16];
#pragma unroll
        for (int z = 0; z < 16; ++z) tc[z] = 255 - (int)(tk[z] & 0xFFu);
        if (lane < 32) {
            float vals[16]; float mx = 0.f; float ssum = 0.f;
#pragma unroll
            for (int z = 0; z < 16; ++z) { vals[z] = r1[tc[z] >> 4] + r2[tc[z] & 15]; if (z == 0) mx = vals[0]; vals[z] = fexp_(vals[z] - mx); ssum += vals[z]; }
            const float inv = 1.0f / ssum;
            const size_t o = (size_t)(t0 + lane) * PH * 16 + h * 16;
#pragma unroll
            for (int z = 0; z < 16; ++z) {
                const int ex_ = ((const int*)r1)[16 + (tc[z] >> 4)] * 128 + ((const int*)r2)[16 + (tc[z] & 15)];
                p.IDX[o + z] = ex_;
                p.G[o + z] = vals[z] * inv * p.VSC[ex_];
                p.GU[o + z] = p.USC[ex_];
            }
        }
        WAVE_SYNC();
    }
}

#define PEER_CONV_JOBS (2 * NEXP / 4)
__device__ __forceinline__ void peer_conv_job(const P& p, int l, int job) {
    const int tid = otid(), lane = tid & 63, wv = tid >> 6;
    if (wv >= 4) return;
    const int rowg = job * 4 + wv; const int which = rowg / NEXP, row = rowg % NEXP;
    const float* src = p.in[which ? I_PV : I_PU] + ((size_t)l * NEXP + row) * D_MODEL + lane * 16;
    const bool act = lane * 16 < D_MODEL;
    float v[16]; float amax = 0.f;
#pragma unroll
    for (int c = 0; c < 4; ++c) {
        float4 a; a.x = 0.f; a.y = 0.f; a.z = 0.f; a.w = 0.f;
        if (act) a = *(const float4*)(src + c * 4);
        v[c * 4 + 0] = a.x; v[c * 4 + 1] = a.y; v[c * 4 + 2] = a.z; v[c * 4 + 3] = a.w;
        amax = fmaxf(amax, fmaxf(fmaxf(fabsf(a.x), fabsf(a.y)), fmaxf(fabsf(a.z), fabsf(a.w))));
    }
#pragma unroll
    for (int m = 32; m >= 1; m >>= 1) amax = fmaxf(amax, __shfl_xor(amax, m, 64));
    int ex = 0;
    if (amax > 0.f) ex = 7 - (int)((__builtin_bit_cast(unsigned, amax) >> 23) & 0xFF) + 127;
    ex = ex < -100 ? -100 : (ex > 100 ? 100 : ex);
    const float sc = __builtin_bit_cast(float, (unsigned)(ex + 127) << 23), isc = __builtin_bit_cast(float, (unsigned)(127 - ex) << 23);
    u32x4 o;
    int w0 = 0, w1 = 0, w2 = 0, w3 = 0;
    w0 = CVT_PK_FP8(v[0] * sc, v[1] * sc, w0, false); w0 = CVT_PK_FP8(v[2] * sc, v[3] * sc, w0, true);
    w1 = CVT_PK_FP8(v[4] * sc, v[5] * sc, w1, false); w1 = CVT_PK_FP8(v[6] * sc, v[7] * sc, w1, true);
    w2 = CVT_PK_FP8(v[8] * sc, v[9] * sc, w2, false); w2 = CVT_PK_FP8(v[10] * sc, v[11] * sc, w2, true);
    w3 = CVT_PK_FP8(v[12] * sc, v[13] * sc, w3, false); w3 = CVT_PK_FP8(v[14] * sc, v[15] * sc, w3, true);
    o.x = (unsigned)w0; o.y = (unsigned)w1; o.z = (unsigned)w2; o.w = (unsigned)w3;
    unsigned char* dst = (which ? p.V8 : p.U8) + (size_t)row * D_MODEL + lane * 16;
    if (act) *(u32x4*)dst = o;
    if (lane == 0) (which ? p.VSC : p.USC)[row] = isc;
}
#define GE 4
struct GBuf { u32x4 u[GE]; u32x4 v[GE]; float gu; float gv; };
__device__ __forceinline__ void gather_load(const P& p, GBuf& b, int g, int idx0, int idx1, float g0, float g1, float u0, float u1, int lane) {
    const bool act = lane * 16 < D_MODEL;
#pragma unroll
    for (int q = 0; q < GE; ++q) {
        const int k = g * GE + q;
        const int ei = __shfl((k < 64) ? idx0 : idx1, k & 63, 64);
        b.u[q] = act ? *(const u32x4*)(p.U8 + (size_t)ei * D_MODEL + lane * 16) : (u32x4){0u, 0u, 0u, 0u};
        b.v[q] = act ? *(const u32x4*)(p.V8 + (size_t)ei * D_MODEL + lane * 16) : (u32x4){0u, 0u, 0u, 0u};
    }
    const int km = g * GE + ((lane >> 4) & 3);
    b.gv = __shfl((km < 64) ? g0 : g1, km & 63, 64);
    b.gu = __shfl((km < 64) ? u0 : u1, km & 63, 64);
}
__device__ __forceinline__ void gather_compute(const GBuf& b, const float (&hv)[16], float (&acc)[16], int lane) {
    float dt[GE];
#pragma unroll
    for (int q = 0; q < GE; ++q) {
        float d = 0.f;
#pragma unroll
        for (int c = 0; c < 4; ++c) {
            const f32x2 lo = CVT_PK_F32_FP8((int)b.u[q][c], false), hi = CVT_PK_F32_FP8((int)b.u[q][c], true);
            d += hv[c * 4 + 0] * lo.x + hv[c * 4 + 1] * lo.y + hv[c * 4 + 2] * hi.x + hv[c * 4 + 3] * hi.y;
        }
        dt[q] = d;
    }
    float r2[2], r1;
    {
        const bool up = (lane & 32) != 0;
#pragma unroll
        for (int q = 0; q < 2; ++q) { const float keep = up ? dt[2 + q] : dt[q], send = up ? dt[q] : dt[2 + q]; r2[q] = keep + __shfl_xor(send, 32, 64); }
    }
    {
        const bool up = (lane & 16) != 0;
        const float keep = up ? r2[1] : r2[0], send = up ? r2[0] : r2[1];
        r1 = keep + __shfl_xor(send, 16, 64);
    }
    r1 += __shfl_xor(r1, 8, 64); r1 += __shfl_xor(r1, 4, 64); r1 += __shfl_xor(r1, 2, 64); r1 += __shfl_xor(r1, 1, 64);
    const float coef_mine = b.gv * geluf_(r1 * b.gu);
#pragma unroll
    for (int q = 0; q < GE; ++q) {
        const float coef = __shfl(coef_mine, q * 16, 64);
#pragma unroll
        for (int c = 0; c < 4; ++c) {
            const f32x2 lo = CVT_PK_F32_FP8((int)b.v[q][c], false), hi = CVT_PK_F32_FP8((int)b.v[q][c], true);
            acc[c * 4 + 0] += coef * lo.x; acc[c * 4 + 1] += coef * lo.y; acc[c * 4 + 2] += coef * hi.x; acc[c * 4 + 3] += coef * hi.y;
        }
    }
}
__device__ __forceinline__ void phase_peer_gather(const P& p, int l) {
    const int lane = otid() & 63;
    const int gw = (obid() * NTHREADS + otid()) >> 6, nw = (gridDim.x * NTHREADS) >> 6;
    constexpr int NG = PH * 16 / GE;
    const bool act = lane * 16 < D_MODEL;
    for (int t = gw; t < MTOT; t += nw) {
        float hv[16], acc[16];
        {
            const u32x4 z4 = {0u, 0u, 0u, 0u};
            const u32x4 ha = act ? *(const u32x4*)(p.H + (size_t)t * D_MODEL + lane * 16) : z4;
            const u32x4 hb = act ? *(const u32x4*)(p.H + (size_t)t * D_MODEL + lane * 16 + 8) : z4;
            hv[0] = LO16(ha.x); hv[1] = HI16(ha.x); hv[2] = LO16(ha.y); hv[3] = HI16(ha.y); hv[4] = LO16(ha.z); hv[5] = HI16(ha.z); hv[6] = LO16(ha.w); hv[7] = HI16(ha.w);
            hv[8] = LO16(hb.x); hv[9] = HI16(hb.x); hv[10] = LO16(hb.y); hv[11] = HI16(hb.y); hv[12] = LO16(hb.z); hv[13] = HI16(hb.z); hv[14] = LO16(hb.w); hv[15] = HI16(hb.w);
#pragma unroll
            for (int j = 0; j < 16; ++j) acc[j] = 0.f;
        }
        int idx0 = 0, idx1 = 0; float g0 = 0.f, g1 = 0.f, u0 = 0.f, u1 = 0.f;
        if (lane < PH * 16) { idx0 = p.IDX[(size_t)t * PH * 16 + lane]; g0 = p.G[(size_t)t * PH * 16 + lane]; u0 = p.GU[(size_t)t * PH * 16 + lane]; }
        if (64 + lane < PH * 16) { idx1 = p.IDX[(size_t)t * PH * 16 + 64 + lane]; g1 = p.G[(size_t)t * PH * 16 + 64 + lane]; u1 = p.GU[(size_t)t * PH * 16 + 64 + lane]; }
        GBuf b0, b1, b2;
        gather_load(p, b0, 0, idx0, idx1, g0, g1, u0, u1, lane);
        gather_load(p, b1, 1, idx0, idx1, g0, g1, u0, u1, lane);
        for (int g = 0; g < NG; g += 3) {
            if (g + 2 < NG) gather_load(p, b2, g + 2, idx0, idx1, g0, g1, u0, u1, lane);
            gather_compute(b0, hv, acc, lane);
            if (g + 1 < NG) {
                if (g + 3 < NG) gather_load(p, b0, g + 3, idx0, idx1, g0, g1, u0, u1, lane);
                gather_compute(b1, hv, acc, lane);
            }
            if (g + 2 < NG) {
                if (g + 4 < NG) gather_load(p, b1, g + 4, idx0, idx1, g0, g1, u0, u1, lane);
                gather_compute(b2, hv, acc, lane);
            }
        }
        float xn[16]; float ss = 0.f;
#pragma unroll
        for (int j = 0; j < 16; ++j) xn[j] = 0.f;
        if (act) {
            const float* g2 = p.MOD + (size_t)(l * 2 + (t >= CTX ? 1 : 0)) * 6 * D_MODEL + 5 * D_MODEL + lane * 16;
            float* xp = p.X + (size_t)t * D_MODEL + lane * 16;
#pragma unroll
            for (int c = 0; c < 4; ++c) {
                float4 x = *(float4*)(xp + c * 4);
                x.x += g2[c * 4 + 0] * acc[c * 4 + 0]; x.y += g2[c * 4 + 1] * acc[c * 4 + 1]; x.z += g2[c * 4 + 2] * acc[c * 4 + 2]; x.w += g2[c * 4 + 3] * acc[c * 4 + 3];
                if (l + 1 < DEPTH) *(float4*)(xp + c * 4) = x;
                xn[c * 4 + 0] = x.x; xn[c * 4 + 1] = x.y; xn[c * 4 + 2] = x.z; xn[c * 4 + 3] = x.w;
                ss += x.x * x.x + x.y * x.y + x.z * x.z + x.w * x.w;
            }
        }
        ss = wave_sum(ss);
        const float rstd = rsqrtf(ss / D_MODEL + 1e-6f);
        if (act) {
            if (l + 1 < DEPTH) {
                const float* gn = p.in[I_N1G] + (size_t)(l + 1) * D_MODEL + lane * 16;
                const float* mod = p.MOD + (size_t)((l + 1) * 2 + (t >= CTX ? 1 : 0)) * 6 * D_MODEL + lane * 16;
                float o[16];
#pragma unroll
                for (int j = 0; j < 16; ++j) o[j] = xn[j] * rstd * gn[j] * (1.0f + mod[D_MODEL + j]) + mod[j];
                u32x4 w0, w1;
                w0.x = pack2bf(o[0], o[1]); w0.y = pack2bf(o[2], o[3]); w0.z = pack2bf(o[4], o[5]); w0.w = pack2bf(o[6], o[7]);
                w1.x = pack2bf(o[8], o[9]); w1.y = pack2bf(o[10], o[11]); w1.z = pack2bf(o[12], o[13]); w1.w = pack2bf(o[14], o[15]);
                *(u32x4*)(p.H + (size_t)t * D_MODEL + lane * 16) = w0; *(u32x4*)(p.H + (size_t)t * D_MODEL + lane * 16 + 8) = w1;
            } else if (t >= CTX) {
                const float* fg = p.in[I_FG] + lane * 16;
                float* op = p.out + (size_t)(t - CTX) * D_MODEL + lane * 16;
#pragma unroll
                for (int c = 0; c < 4; ++c) {
                    float4 o; o.x = xn[c * 4 + 0] * rstd * fg[c * 4 + 0]; o.y = xn[c * 4 + 1] * rstd * fg[c * 4 + 1]; o.z = xn[c * 4 + 2] * rstd * fg[c * 4 + 2]; o.w = xn[c * 4 + 3] * rstd * fg[c * 4 + 3];
                    *(float4*)(op + c * 4) = o;
                }
            }
        }
    }
}
__device__ __forceinline__ void phase_final(const P& p) {
    const int lane = otid() & 63;
    const int gw = (obid() * NTHREADS + otid()) >> 6, nw = (gridDim.x * NTHREADS) >> 6;
    const float* g = p.in[I_FG];
    for (int t = gw; t < SEQ; t += nw) {
        const float* x = p.X + (size_t)(CTX + t) * D_MODEL;
        float v[D_MODEL / 64]; float ss = 0.f;
#pragma unroll
        for (int j = 0; j < D_MODEL / 64; ++j) { v[j] = x[lane + 64 * j]; ss += v[j] * v[j]; }
        ss = wave_sum(ss);
        float rstd = rsqrtf(ss / D_MODEL + 1e-6f);
#pragma unroll
        for (int j = 0; j < D_MODEL / 64; ++j) p.out[(size_t)t * D_MODEL + lane + 64 * j] = v[j] * rstd * g[lane + 64 * j];
    }
}

__global__ void __launch_bounds__(NTHREADS) fwd_megakernel(P p_arg) {
#ifdef EMU
    char* smem = emu_smem();
#else
    __shared__ __attribute__((aligned(16))) char smem_raw[SMEM_BYTES + 16];
    char* smem = smem_raw;
#endif
#ifndef EMU
    volatile LAS unsigned* xst = (volatile LAS unsigned*)(smem_raw + SMEM_BYTES);
    if (threadIdx.x == 0) { xst[0] = 0u; xst[1] = 0u; xst[2] = 0u; xst[3] = 0u; }
    __syncthreads();
    XcdBarrier xb = xcd_barrier_post(p_arg.bar, xst);
#endif
    { LOADP(); phase_init(p, smem); }
#ifndef EMU
    GRID_SYNC_CG();
#endif
#ifdef EMU
    GRID_SYNC();
#endif
#ifndef EMU
    if (threadIdx.x == 0) {
        unsigned base_ = 0;
        for (unsigned j = 0; j < xb.x; ++j) base_ += xb_ld(&p_arg.bar[XB_XCNT(j)]);
        xst[2] = base_ + xst[3];
    }
    __syncthreads();
#endif
    PROBE_INIT();
    for (int l = 0; l < DEPTH; ++l) {
        if (l == 0) {
            { LOADP(); phase_norm(p, 0, 0); }
            { LOADP(); phase_s5const(p, 0); }
            { LOADP(); phase_convert_weights(p, 0, smem, obid(), (int)gridDim.x); }
            GRID_SYNC(); PROBE_AFTER(0);
        }
        { LOADP(); phase_gemm_in(p, l, smem); }
        GRID_SYNC(); PROBE_AFTER(1);
        { LOADP(); phase_rwkv_prep1(p, l); }
        GRID_SYNC(); PROBE_AFTER(14);
        { LOADP(); for (int job = obid(); job < 2 * NC * RH; job += gridDim.x) rwkv_chunk_job(p, l, job, smem); }
        __syncthreads(); PROBE_AFTER(20);
        { LOADP(); phase_gla_kv(p, l, smem); }
        PROBE_AFTER(21);
        { LOADP(); phase_s5_pass(p, l, smem, false); }
        GRID_SYNC(); PROBE_AFTER(3);
        {
            LOADP();
            const int n_rw = 2 * RH, n_gla = 2 * GH * 8192 / NTHREADS, n_s5 = (2 * SG * 64 + NTHREADS - 1) / NTHREADS;
            const int G_ = (int)gridDim.x;
            if (G_ > 2 * n_rw) {
                if (obid() < n_rw) { rwkv_seq_job(p, obid(), smem); PROBE_AFTER(24); }
                else {
                    const int nb = G_ - n_rw, bid = obid() - n_rw;
                    for (int job = bid; job < n_gla + n_s5 + PEER_CONV_JOBS; job += nb) {
                        if (job < n_gla) gla_scan_job(p, job);
                        else if (job < n_gla + n_s5) s5_carry_job(p, job - n_gla);
                        else peer_conv_job(p, l, job - n_gla - n_s5);
                    }
                    { P pg = p; late_select(pg, l & 1); for (int job = bid; job < G2_JOBS; job += nb) g2_gemm_job(pg, job, smem); }
                    if (l + 1 < DEPTH) { late_select(p, (l + 1) & 1); phase_convert_weights(p, l + 1, smem, bid, nb); }
                }
            } else {
                for (int job = obid(); job < n_rw + n_gla + n_s5 + PEER_CONV_JOBS; job += G_) {
                    if (job < n_rw) rwkv_seq_job(p, job, smem);
                    else if (job < n_rw + n_gla) gla_scan_job(p, job - n_rw);
                    else if (job < n_rw + n_gla + n_s5) s5_carry_job(p, job - n_rw - n_gla);
                    else peer_conv_job(p, l, job - n_rw - n_gla - n_s5);
                }
                __syncthreads();
                { P pg = p; late_select(pg, l & 1); for (int job = obid(); job < G2_JOBS; job += G_) g2_gemm_job(pg, job, smem); }
                if (l + 1 < DEPTH) { late_select(p, (l + 1) & 1); phase_convert_weights(p, l + 1, smem, obid(), G_); }
            }
        }
        GRID_SYNC(); PROBE_AFTER(4);
        { LOADP(); phase_rwkv_out(p); }
        PROBE_AFTER(22);
        { LOADP(); phase_gla_out(p, l, smem); }
        PROBE_AFTER(23);
        { LOADP(); phase_s5_pass(p, l, smem, true); }
        GRID_SYNC(); PROBE_AFTER(5);
        { LOADP(); phase_side_elem(p, l); }
        if (l + 1 < DEPTH) { LOADP(); phase_s5const(p, l + 1); }
        { LOADP(); late_select(p, l & 1); phase_glu_gemm(p, l, smem); }
        GRID_SYNC(); PROBE_AFTER(7);
        { LOADP(); late_select(p, l & 1); phase_merge(p, l, smem); }
        GRID_SYNC(); PROBE_AFTER(8);
        { LOADP(); late_select(p, l & 1); phase_outproj(p, l, smem); }
        GRID_SYNC(); PROBE_AFTER(9);
        { LOADP(); phase_norm(p, l, 1); }
        GRID_SYNC(); PROBE_AFTER(10);
        { LOADP(); late_select(p, l & 1); phase_peer_q(p, l, smem); }
        GRID_SYNC(); PROBE_AFTER(11);
        { LOADP(); late_select(p, l & 1); phase_peer_topk(p, l, smem); }
        GRID_SYNC(); PROBE_AFTER(12);
        { LOADP(); phase_peer_gather(p, l); }
        if (l + 1 < DEPTH) { GRID_SYNC(); PROBE_AFTER(13); }
    }
}

static inline size_t align_up(size_t x) { return (x + 255) & ~(size_t)255; }

extern "C" void kernel_launch(void* const* d_in, const int* in_sizes, int n_in, void* d_out, int out_size, void* d_ws, size_t ws_size, hipStream_t stream) {
    P p;
    memset(&p, 0, sizeof(p));
    for (int i = 0; i < 39; ++i) p.in[i] = (const float*)d_in[i];
    p.out = (float*)d_out;
    char* w = (char*)d_ws; size_t off = 0;
    auto take = [&](size_t bytes) { void* r = w + off; off = align_up(off + bytes); return r; };
    p.bar = (unsigned*)take(16384);
    p.X = (float*)take((size_t)MTOT * D_MODEL * 4);
    p.H = (bf16_t*)take((size_t)MTOT * D_MODEL * 2);
    p.MOD = (float*)take((size_t)DEPTH * 2 * 6 * D_MODEL * 4);
    p.Z = (bf16_t*)take((size_t)MTOT * ZLD * 2);
    p.ZGT = (bf16_t*)take((size_t)MTOT * 3 * D_MODEL * 2);
    p.V = (bf16_t*)take((size_t)MTOT * RW * 2);
    {
        char* ra = (char*)take((size_t)MTOT * RW * 2 * 2 > (size_t)MTOT * GLA_V * 4 ? (size_t)MTOT * RW * 2 * 2 : (size_t)MTOT * GLA_V * 4);
        p.R = (bf16_t*)ra; p.KK = (bf16_t*)(ra + (size_t)MTOT * RW * 2);
        p.OGLA = (float*)ra;
    }
    {
        char* rb = (char*)take((size_t)2 * MTOT * RW * 2 > (size_t)3 * MTOT * PH * 16 * 4 ? (size_t)2 * MTOT * RW * 2 : (size_t)3 * MTOT * PH * 16 * 4);
        p.KD = (bf16_t*)rb;
        p.IDX = (int*)rb; p.G = (float*)(rb + (size_t)MTOT * PH * 16 * 4); p.GU = (float*)(rb + (size_t)2 * MTOT * PH * 16 * 4);
    }
    p.BB = (bf16_t*)take((size_t)2 * MTOT * RW * 2);
    p.G2B = p.BB;
    p.LW = (float*)take((size_t)2 * MTOT * RW * 4);
    p.SP = (bf16_t*)p.LW;
    static_assert((size_t)2 * NC * GH * 8192 * 2 <= (size_t)2 * MTOT * RW * 4, "SP alias");
    p.BONUS = (float*)take((size_t)2 * MTOT * RH * 4);
    p.KS = (bf16_t*)take((size_t)MTOT * RW * 2);
    p.LR = (bf16_t*)take((size_t)MTOT * 256 * 2);
    p.WT_W2 = (bf16_t*)take((size_t)2 * NPAD(RW) * 64 * 2);
    p.WT_A2 = (bf16_t*)take((size_t)2 * NPAD(RW) * 64 * 2);
    p.GS = (bf16_t*)take((size_t)MTOT * 128 * 2);
    p.Y = (float*)take((size_t)2 * MTOT * RW * 4);
    p.Y0T = (float*)take((size_t)2 * NC * RH * 4096 * 4);
    p.KV = (float*)take((size_t)2 * NC * GH * 8192 * 4);
    p.DEC = (float*)take((size_t)2 * NC * GH * 64 * 4);
    p.S5A = (float*)take((size_t)2 * SG * 64 * 2 * 4);
    p.S5BB = (float*)take((size_t)2 * SG * 64 * 16 * 2 * 4);
    p.S5END = (float*)take((size_t)2 * NC * SG * 64 * 2 * 4);
    p.S5CAR = (float*)take((size_t)2 * NC * SG * 64 * 2 * 4);
    {
        const size_t szc1 = (size_t)2 * NC * RH * SEQ_REC;
        const size_t szc2 = (size_t)MTOT * SW * 2 + (size_t)MTOT * RW * 4 + (size_t)MTOT * 3 * BW * 2 + (size_t)MTOT * D_MODEL * 2 + 1024;
        char* rc = (char*)take(szc1 > szc2 ? szc1 : szc2);
        p.REC = rc;
        char* c2 = rc;
        p.GY = (bf16_t*)c2; c2 += align_up((size_t)MTOT * SW * 2);
        p.YN = (float*)c2; c2 += align_up((size_t)MTOT * RW * 4);
        p.BR = (bf16_t*)c2; c2 += align_up((size_t)MTOT * 3 * BW * 2);
        p.M = (bf16_t*)c2;
    }
    p.SN = (bf16_t*)take((size_t)2 * NC * RH * 4096 * 2);
    p.QH = (bf16_t*)take((size_t)2 * NC * RH * 4096 * 2);
    p.WT_IN = (bf16_t*)take((size_t)NPAD192(D_IN) * D_MODEL * 2);
    {
        char* lb = (char*)take(2 * LATE_BYTES); size_t lo = 0;
        auto ltake = [&](size_t bytes) { void* r = lb + lo; lo = AL256(lo + bytes); return r; };
        p.WT_G2 = (bf16_t*)ltake((size_t)NPAD(RW) * 128 * 2);
        p.WT_GLU = (bf16_t*)ltake((size_t)NPAD(2 * SW) * SW * 2);
        p.WT_BR = (bf16_t*)ltake((size_t)3 * D_MODEL * BW * 2);
        p.WT_OUT = (bf16_t*)ltake((size_t)D_MODEL * D_MODEL * 2);
        p.WT_Q = (bf16_t*)ltake((size_t)PQ * D_MODEL * 2);
        p.KHI = (bf16_t*)ltake((size_t)PH * 2 * 128 * 128 * 2); p.KLO = (bf16_t*)ltake((size_t)PH * 2 * 128 * 128 * 2);
        if (lo != LATE_BYTES) fprintf(stderr, "late weights layout mismatch\n");
    }
    p.U8 = (unsigned char*)take((size_t)NEXP * D_MODEL);
    p.V8 = (unsigned char*)take((size_t)NEXP * D_MODEL);
    p.USC = (float*)take((size_t)NEXP * 4); p.VSC = (float*)take((size_t)NEXP * 4);
    p.QHI = p.Z; p.QLO = p.Z + (size_t)MTOT * PQ;
    static_assert((size_t)PQ * 4 <= (size_t)D_IN * 2 && ((size_t)MTOT * ZLD * 2) % 256 == 0, "Q alias");
    if (off > ws_size) { fprintf(stderr, "ws too small: need %zu have %zu\n", off, ws_size); return; }
#ifdef EMU
    fprintf(stderr, "ws used %zu MB\n", off >> 20);
    emu_launch([=] { fwd_megakernel(p); }, EMU_GRID, NTHREADS);
#else
    hipMemsetAsync(p.bar, 0, 16384, stream);
    static int grid_blocks = 0;
    if (!grid_blocks) {
        int dev = 0, cus = 0, per_cu = 0;
        hipGetDevice(&dev);
        hipDeviceGetAttribute(&cus, hipDeviceAttributeMultiprocessorCount, dev);
        hipOccupancyMaxActiveBlocksPerMultiprocessor(&per_cu, fwd_megakernel, NTHREADS, 0);
        if (per_cu > 1) per_cu = 1;
        grid_blocks = cus * per_cu;
    }
    void* args[] = {&p};
    hipError_t e = hipLaunchCooperativeKernel((void*)fwd_megakernel, dim3(grid_blocks), dim3(NTHREADS), args, 0, stream);
    if (e != hipSuccess) fprintf(stderr, "cooperative launch failed: %s (grid %d)\n", hipGetErrorString(e), grid_blocks);
#endif
}
```

```cpp
#include <hip/hip_runtime.h>
#ifndef EMU
#include <hip/hip_cooperative_groups.h>
namespace cg = cooperative_groups;
#endif
#include <cstdio>
#include <cstdint>
#include <cstring>
#include <type_traits>

#ifdef CFG_SMALL
#define D_MODEL 128
#define SEQ 640
#define DEPTH 2
#define GRID_W 10
#define CTX 128
#define GH 1
#define RH 2
#define SG 8
#define PH 2
#else
#define D_MODEL 1024
#define SEQ 16384
#define DEPTH 4
#define GRID_W 64
#define CTX 256
#define GH 4
#define RH 8
#define SG 32
#define PH 8
#endif
#define MTOT (CTX + SEQ)
#define ROWS (SEQ / GRID_W)
#define GLA_K (GH * 64)
#define GLA_V (GH * 128)
#define RW (RH * 64)
#define RWKV_IN (3 * RW + 4 * 64 + 128)
#define SW (SG * 16)
#define BW GLA_V
#define ZQ 0
#define ZK (GLA_K)
#define ZV (2 * GLA_K)
#define ZOG (ZV + GLA_V)
#define ZAF (ZOG + GLA_V)
#define ZAB (ZAF + 16)
#define ZR (ZAB + 16)
#define ZS5 (ZR + RWKV_IN)
#define ZG (ZS5 + SW)
#define D_IN (ZG + 3 * D_MODEL)
#define ZLD ZG
#define NC (MTOT / 64)
#define NCC (CTX / 64)
#define RB (ROWS / 64)
#define PQ (PH * 256)
#define NEXP 16384
#define NTHREADS 256
#define SMEM_BYTES 133120

typedef unsigned short bf16_t;
typedef short bf16x8 __attribute__((ext_vector_type(8)));
typedef float f32x4 __attribute__((ext_vector_type(4)));
typedef unsigned u32x4 __attribute__((ext_vector_type(4)));
typedef unsigned u32x2 __attribute__((ext_vector_type(2)));
#ifdef EMU
#define MFMA16(a, b, c) emu_mfma_16x16x32_bf16(a, b, c)
#else
#define MFMA16(a, b, c) __builtin_amdgcn_mfma_f32_16x16x32_bf16(a, b, c, 0, 0, 0)
#endif
typedef float f32x2 __attribute__((ext_vector_type(2)));
#ifdef EMU
#define CVT_PK_FP8(a, b, old, hi) emu_cvt_pk_fp8_f32(a, b, old, hi)
#define CVT_PK_F32_FP8(w, hi) emu_cvt_pk_f32_fp8(w, hi)
#else
#define CVT_PK_FP8(a, b, old, hi) __builtin_amdgcn_cvt_pk_fp8_f32(a, b, old, hi)
#define CVT_PK_F32_FP8(w, hi) __builtin_amdgcn_cvt_pk_f32_fp8(w, hi)
#endif
#ifdef EMU
#define MFMA16_ACC(a, b, c) c = emu_mfma_16x16x32_bf16(a, b, c)
#else
#define MFMA16_ACC(a, b, c) asm volatile("v_mfma_f32_16x16x32_bf16 %0, %1, %2, %0" : "+a"(c) : "v"(a), "v"(b))
#endif
#define NPAD(n) (((n) + 127) / 128 * 128)
#define NPAD192(n) (((n) + 383) / 384 * 384)

__device__ __forceinline__ float bf2f(bf16_t h) { return __builtin_bit_cast(float, ((unsigned)h) << 16); }
#ifdef EMU
__device__ __forceinline__ bf16_t f2bf(float f) { unsigned u = __builtin_bit_cast(unsigned, f); u += 0x7FFFu + ((u >> 16) & 1u); return (bf16_t)(u >> 16); }
__device__ __forceinline__ unsigned pack2bf(float a, float b) { return (unsigned)f2bf(a) | ((unsigned)f2bf(b) << 16); }
#else
typedef float f2v_t __attribute__((ext_vector_type(2))); typedef __bf16 b2v_t __attribute__((ext_vector_type(2)));
__device__ __forceinline__ bf16_t f2bf(float f) { return __builtin_bit_cast(unsigned short, (__bf16)f); }
__device__ __forceinline__ unsigned pack2bf(float a, float b) { f2v_t v = {a, b}; b2v_t r = __builtin_convertvector(v, b2v_t); return __builtin_bit_cast(unsigned, r); }
#endif
#ifdef EMU
#define fexp_(x) expf(x)
#define flog_(x) logf(x)
#else
#define fexp_(x) __expf(x)
#define flog_(x) __logf(x)
#endif
#define LO16(x) __builtin_bit_cast(float, (x) << 16)
#define HI16(x) __builtin_bit_cast(float, (x) & 0xFFFF0000u)
__device__ __forceinline__ float sigmoidf_(float x) { return 1.0f / (1.0f + fexp_(-x)); }
__device__ __forceinline__ float siluf_(float x) { return x * sigmoidf_(x); }
__device__ __forceinline__ float geluf_(float x) { const float y = 1.5957691216057308f * (x + 0.044715f * x * x * x); return x / (1.0f + fexp_(-y)); }
__device__ __forceinline__ float softplusf_(float x) { return fmaxf(x, 0.f) + flog_(1.0f + fexp_(-fabsf(x))); }
__device__ __forceinline__ float tanhf_(float x) { const float e = fexp_(-2.0f * fabsf(x)); const float t = (1.0f - e) / (1.0f + e); return x < 0.f ? -t : t; }
__device__ __forceinline__ float wave_sum(float v) {
#pragma unroll
    for (int m = 32; m >= 1; m >>= 1) v += __shfl_xor(v, m, 64);
    return v;
}

struct P {
    const float* in[39];
    float* out;
    float* X;
    bf16_t* H;
    bf16_t* Z;
    bf16_t* ZGT;
    float* MOD;
    bf16_t* R; bf16_t* V; bf16_t* KK; bf16_t* KD; bf16_t* BB;
    float* LW;
    char* REC;
    bf16_t* SN;
    bf16_t* QH;
    float* BONUS;
    bf16_t* KS;
    bf16_t* LR;
    bf16_t* WT_W2;
    bf16_t* WT_A2;
    bf16_t* GS;
    float* Y;
    bf16_t* G2B;
    float* Y0T;
    float* KV;
    bf16_t* SP;
    float* DEC;
    float* OGLA;
    float* S5A;
    float* S5BB;
    float* S5END;
    float* S5CAR;
    bf16_t* GY;
    float* YN;
    bf16_t* BR;
    bf16_t* M;
    bf16_t* QHI; bf16_t* QLO;
    bf16_t* KHI; bf16_t* KLO;
    int* IDX;
    float* G;
    float* GU;
    unsigned* bar;
    bf16_t* WT_IN;
    bf16_t* WT_G2;
    bf16_t* WT_GLU;
    bf16_t* WT_BR;
    bf16_t* WT_OUT;
    bf16_t* WT_Q;
    unsigned char* U8; unsigned char* V8;
    float* USC; float* VSC;
};

enum { I_X = 0, I_C, I_CTX, I_CCTX, I_WMOD, I_BMOD, I_N1G, I_N2G, I_WIN, I_GLA_WA2, I_GLA_BA, I_GLA_NG, I_RCONV, I_RW0, I_RW2, I_RA0, I_RA2, I_RG2,
       I_RKK, I_RKA, I_RRK, I_RLNW, I_RLNB, I_S5LRE, I_S5LIM, I_S5LS, I_S5BRE, I_S5BIM, I_S5CRE, I_S5CIM, I_S5D, I_S5GLU, I_WBR, I_WOUT, I_PWQ, I_PKEYS, I_PU, I_PV, I_FG };

#define AL256(x) (((size_t)(x) + 255) & ~(size_t)255)
#define LATE_BYTES (AL256((size_t)NPAD(RW) * 128 * 2) + AL256((size_t)NPAD(2 * SW) * SW * 2) + AL256((size_t)3 * D_MODEL * BW * 2) + AL256((size_t)D_MODEL * D_MODEL * 2) + \
                    AL256((size_t)PQ * D_MODEL * 2) + 2 * AL256((size_t)PH * 2 * 128 * 128 * 2))
__device__ __forceinline__ void late_select(P& p, int par) {
    const size_t o = (size_t)par * (LATE_BYTES / 2);
    p.WT_G2 += o; p.WT_GLU += o; p.WT_BR += o; p.WT_OUT += o; p.WT_Q += o; p.KHI += o; p.KLO += o;
}
#ifdef EMU
__device__ __forceinline__ int otid() { return threadIdx.x; }
__device__ __forceinline__ int obid() { return blockIdx.x; }
#else
__device__ __forceinline__ int otid() { int t = threadIdx.x; asm volatile("" : "+v"(t)); return t; }
__device__ __forceinline__ int obid() { int b = blockIdx.x; asm volatile("" : "+s"(b)); return b; }
#endif
#ifdef EMU
#define WAVE_SYNC() emu_wave_barrier()
#ifndef EMU_GRID
#define EMU_GRID 4
#endif
#else
#define WAVE_SYNC() __builtin_amdgcn_wave_barrier()
#endif
#ifndef EMU
#define XB_TMO      128
#define XB_XCNT(j)  (256  + 64 * (j))
#define XB_XSUB(j)  (1280 + 64 * (j))
#define XB_XGEN(j)  (2304 + 64 * (j))
#define XB_TOP      3328
#define XB_TOPGEN   3392
#define XCD_BAR_WORDS 3456
#define XB_SPIN_CAP (1u << 22)
#define LAS __attribute__((address_space(3)))
__device__ __forceinline__ unsigned xb_ld(unsigned* p)              { return __hip_atomic_load(p, __ATOMIC_RELAXED, __HIP_MEMORY_SCOPE_SYSTEM); }
__device__ __forceinline__ unsigned xb_add(unsigned* p, unsigned v) { return __hip_atomic_fetch_add(p, v, __ATOMIC_RELAXED, __HIP_MEMORY_SCOPE_SYSTEM); }
__device__ __forceinline__ unsigned xb_xcc_id() { return (unsigned)__builtin_amdgcn_s_getreg((3 << 11) | 20) & 0xFu; }
#define XB_SPIN(cond, bar) do { unsigned _sp = 0; while (cond) { __builtin_amdgcn_s_sleep(1); \
    if ((++_sp & 255u) == 0u) { if (xb_ld(&(bar)[XB_TMO])) break; if (_sp > XB_SPIN_CAP) { atomicAdd(&(bar)[XB_TMO], 1u); break; } } } } while (0)
struct XcdBarrier { unsigned* bar; unsigned x; volatile LAS unsigned* st; };
__device__ __forceinline__ XcdBarrier xcd_barrier_post(unsigned* bar, volatile LAS unsigned* st) {
    XcdBarrier b; b.bar = bar; b.x = xb_xcc_id(); b.st = st;
    if (threadIdx.x == 0) st[3] = xb_add(&bar[XB_XCNT(b.x)], 1u);
    return b;
}
__device__ __forceinline__ void xcd_barrier_complete(unsigned* bar, unsigned x, unsigned& nloc, unsigned& nx) {
    const unsigned G = gridDim.x * gridDim.y * gridDim.z;
    unsigned sum, cnt, mine, sp = 0u;
    for (;;) {
        sum = 0u; cnt = 0u; mine = 0u;
#pragma unroll
        for (unsigned j = 0; j < 16; ++j) { const unsigned c = xb_ld(&bar[XB_XCNT(j)]); sum += c; cnt += (c > 0u) ? 1u : 0u; mine = (j == x) ? c : mine; }
        if (sum == G) break;
        __builtin_amdgcn_s_sleep(1);
        if ((++sp & 255u) == 0u) { if (xb_ld(&bar[XB_TMO])) break; if (sp > XB_SPIN_CAP) { atomicAdd(&bar[XB_TMO], 1u); break; } }
    }
    nloc = mine > 0u ? mine : 1u; nx = cnt > 0u ? cnt : 1u;
}
__device__ __forceinline__ void xcd_barrier(const XcdBarrier& b) {
    asm volatile("s_waitcnt vmcnt(0)" ::: "memory");
    __syncthreads();
    if (threadIdx.x == 0) {
        unsigned* bar = b.bar;
        __builtin_amdgcn_fence(__ATOMIC_RELEASE, "agent");
        asm volatile("s_waitcnt vmcnt(0)" ::: "memory");
        const unsigned G = gridDim.x;
        const unsigned old = xb_add(&bar[XB_TOP], 1u);
        const unsigned tg = old / G;
        if (old + 1u == (tg + 1u) * G) xb_add(&bar[XB_TOPGEN], 1u);
        else XB_SPIN(xb_ld(&bar[XB_TOPGEN]) == tg, bar);
        __builtin_amdgcn_fence(__ATOMIC_ACQUIRE, "agent");
        asm volatile("s_waitcnt vmcnt(0)" ::: "memory");
    }
    __syncthreads();
}
#define GRID_SYNC_CG() { (void)xb; asm volatile("s_waitcnt vmcnt(0)" ::: "memory"); cg::this_grid().sync(); }
#define GRID_SYNC() xcd_barrier(xb)
#else
#define GRID_SYNC() emu_grid_sync()
#endif

#ifdef EMU
#define LOADP() P p = p_arg
#else
typedef __attribute__((address_space(4))) const unsigned long long cu64_t;
__device__ __forceinline__ void load_params(P& p) {
    cu64_t* q = (cu64_t*)__builtin_amdgcn_kernarg_segment_ptr();
    asm volatile("" : "+s"(q));
    typedef __attribute__((address_space(1))) char gchar_t;
    char* w[sizeof(P) / 8];
#pragma unroll
    for (int i = 0; i < (int)(sizeof(P) / 8); ++i) w[i] = (char*)(gchar_t*)q[i];
    __builtin_memcpy(&p, w, sizeof(P));
}
#define LOADP() P p; load_params(p)
#endif
#define PROBE_MULT 3
#if defined(PROBE_ID) && !defined(EMU)
#define PROBE_INIT() unsigned long long probe_t0 = wall_clock64()
#define PROBE_AFTER(id) { if (blockIdx.x == 0) { unsigned long long now_ = wall_clock64(); if ((id) == PROBE_ID || (id) == PROBE_ID2) { const unsigned long long dt_ = now_ - probe_t0; \
    while (wall_clock64() - now_ < dt_ * PROBE_MULT) __builtin_amdgcn_s_sleep(8); now_ = wall_clock64(); } probe_t0 = now_; } }
#else
#define PROBE_INIT()
#define PROBE_AFTER(id)
#endif
__device__ __forceinline__ int gla_tok(int n, int i) {
    if (n < NCC) return n * 64 + i;
    int m = n - NCC; int col = m / RB, rb = m % RB;
    return CTX + (rb * 64 + i) * GRID_W + col;
}
__device__ __forceinline__ int chunk_order(int d, int s) {
    if (d == 0) return s;
    return (s < NCC) ? (NCC - 1 - s) : (NC - 1 - (s - NCC));
}
__device__ __forceinline__ int tok_order(int d, int s) {
    if (d == 0) return s;
    return (s < CTX) ? (CTX - 1 - s) : (MTOT - 1 - (s - CTX));
}


#define LDS_ROW 72
__device__ __forceinline__ void mfma_gemm_tile(const bf16_t* Wt, int ldw, const bf16_t* Act, int lda, int K, int n0, int m0, bf16_t* lds, f32x4 (&acc)[4][4]) {
    bf16_t* Ws = lds; bf16_t* As = lds + 128 * LDS_ROW;
    const int tid = otid(), lane = tid & 63, wave = tid >> 6, wn = wave >> 1, wm = wave & 1;
    const int lrow = tid >> 3, lkc = (tid & 7) * 8;
    u32x4 pw[4], pa[4];
#pragma unroll
    for (int i = 0; i < 4; ++i) {
        pw[i] = *(const u32x4*)(Wt + (size_t)(n0 + lrow + 32 * i) * ldw + lkc);
        pa[i] = *(const u32x4*)(Act + (size_t)(m0 + lrow + 32 * i) * lda + lkc);
    }
    for (int k0 = 0; k0 < K; k0 += 64) {
        __syncthreads();
#pragma unroll
        for (int i = 0; i < 4; ++i) {
            *(u32x4*)(Ws + (lrow + 32 * i) * LDS_ROW + lkc) = pw[i];
            *(u32x4*)(As + (lrow + 32 * i) * LDS_ROW + lkc) = pa[i];
        }
        __syncthreads();
        if (k0 + 64 < K) {
#pragma unroll
            for (int i = 0; i < 4; ++i) {
                pw[i] = *(const u32x4*)(Wt + (size_t)(n0 + lrow + 32 * i) * ldw + k0 + 64 + lkc);
                pa[i] = *(const u32x4*)(Act + (size_t)(m0 + lrow + 32 * i) * lda + k0 + 64 + lkc);
            }
        }
#pragma unroll
        for (int ks = 0; ks < 2; ++ks) {
            bf16x8 a[4], b[4];
#pragma unroll
            for (int i = 0; i < 4; ++i) {
                a[i] = *(const bf16x8*)(Ws + (wn * 64 + i * 16 + (lane & 15)) * LDS_ROW + ks * 32 + (lane >> 4) * 8);
                b[i] = *(const bf16x8*)(As + (wm * 64 + i * 16 + (lane & 15)) * LDS_ROW + ks * 32 + (lane >> 4) * 8);
            }
#pragma unroll
            for (int ni = 0; ni < 4; ++ni)
#pragma unroll
                for (int mi = 0; mi < 4; ++mi) acc[ni][mi] = MFMA16(a[ni], b[mi], acc[ni][mi]);
        }
    }
}
#define L64_ROW 72
#ifdef EMU
struct BufRsrc { const char* base; };
__device__ __forceinline__ BufRsrc make_rsrc(const void* p, size_t) { BufRsrc r; r.base = (const char*)p; return r; }
__device__ __forceinline__ u32x4 buf_load16(const BufRsrc& r, unsigned voff, unsigned soff) { return *(const u32x4*)(r.base + voff + soff); }
#else
typedef __amdgpu_buffer_rsrc_t BufRsrc;
__device__ __forceinline__ BufRsrc make_rsrc(const void* p, size_t bytes) { return __builtin_amdgcn_make_buffer_rsrc((void*)p, 0, (int)bytes, 0x00020000); }
__device__ __forceinline__ u32x4 buf_load16(const BufRsrc& r, unsigned voff, unsigned soff) { return __builtin_bit_cast(u32x4, __builtin_amdgcn_raw_buffer_load_b128(r, voff, soff, 0)); }
#endif
template <int NI, int MI>
__device__ __forceinline__ void mfma_gemm_tile_t(const bf16_t* Wt, int ldw, size_t wbytes, const bf16_t* Act, int lda, size_t abytes, int K, int n0, int m0, bf16_t* lds, f32x4 (&acc)[NI][MI], unsigned long long* gacc = nullptr) {
    constexpr int WR = 32 * NI, AR = 32 * MI, BUF = (WR + AR) * L64_ROW;
    const int tid = otid(), lane = tid & 63, wave = tid >> 6, wn = wave >> 1, wm = wave & 1;
    const int lrow = tid >> 3, lkc = (tid & 7) * 8;
    const BufRsrc rw = make_rsrc(Wt, wbytes), ra = make_rsrc(Act, abytes);
    unsigned vw[NI], va[MI];
#pragma unroll
    for (int i = 0; i < NI; ++i) vw[i] = (unsigned)(((size_t)(n0 + lrow + 32 * i) * ldw + lkc) * 2);
#pragma unroll
    for (int i = 0; i < MI; ++i) va[i] = (unsigned)(((size_t)(m0 + lrow + 32 * i) * lda + lkc) * 2);
    u32x4 qw0[NI], qa0[MI];
    const int nk = K / 64;
#define GT_LOAD(QW, QA, KT) { const unsigned so_ = (unsigned)(((KT) < nk) ? (KT) : (nk - 1)) * 128u; \
    _Pragma("unroll") for (int i = 0; i < NI; ++i) QW[i] = buf_load16(rw, vw[i], so_); \
    _Pragma("unroll") for (int i = 0; i < MI; ++i) QA[i] = buf_load16(ra, va[i], so_); }
#define GT_STORE(QW, QA, DST) { \
    _Pragma("unroll") for (int i = 0; i < NI; ++i) *(u32x4*)((DST) + (lrow + 32 * i) * L64_ROW + lkc) = QW[i]; \
    _Pragma("unroll") for (int i = 0; i < MI; ++i) *(u32x4*)((DST) + (WR + lrow + 32 * i) * L64_ROW + lkc) = QA[i]; }
#define GT_COMPUTE(CUR) { _Pragma("unroll") for (int ks = 0; ks < 2; ++ks) { bf16x8 b[MI], a[NI]; \
    _Pragma("unroll") for (int i = 0; i < MI; ++i) b[i] = *(const bf16x8*)((CUR) + (WR + wm * 16 * MI + i * 16 + (lane & 15)) * L64_ROW + ks * 32 + (lane >> 4) * 8); \
    _Pragma("unroll") for (int i = 0; i < NI; ++i) a[i] = *(const bf16x8*)((CUR) + (wn * 16 * NI + i * 16 + (lane & 15)) * L64_ROW + ks * 32 + (lane >> 4) * 8); \
    _Pragma("unroll") for (int ni = 0; ni < NI; ++ni) { \
        _Pragma("unroll") for (int mi = 0; mi < MI; ++mi) MFMA16_ACC(a[ni], b[mi], acc[ni][mi]); } } }
    GT_LOAD(qw0, qa0, 0)
    __syncthreads();
    GT_STORE(qw0, qa0, lds)
    __syncthreads();
    for (int kt = 0; kt < nk; kt += 2) {
        GT_LOAD(qw0, qa0, kt + 1)
        GT_COMPUTE(lds)
        GT_STORE(qw0, qa0, lds + BUF)
        __syncthreads();
        GT_LOAD(qw0, qa0, kt + 2)
        GT_COMPUTE(lds + BUF)
        GT_STORE(qw0, qa0, lds)
        __syncthreads();
    }
#undef GT_LOAD
#undef GT_STORE
#undef GT_COMPUTE
}
#define ZERO_ACC4(acc) { _Pragma("unroll") for (int i_ = 0; i_ < 4; ++i_) _Pragma("unroll") for (int j_ = 0; j_ < 4; ++j_) acc[i_][j_] = (f32x4){0.f, 0.f, 0.f, 0.f}; }
#define FOR_ACC(acc, n0, m0, BODY) { const int lane_ = otid() & 63, wave_ = otid() >> 6; \
    _Pragma("unroll") for (int ni_ = 0; ni_ < 4; ++ni_) _Pragma("unroll") for (int mi_ = 0; mi_ < 4; ++mi_) { \
        const int n = (n0) + (wave_ >> 1) * 64 + ni_ * 16 + (lane_ >> 4) * 4; const int m = (m0) + (wave_ & 1) * 64 + mi_ * 16 + (lane_ & 15); const f32x4 v = acc[ni_][mi_]; BODY } }
__device__ __forceinline__ u32x2 pack4(float a, float b, float c, float d) { u32x2 r; r.x = pack2bf(a, b); r.y = pack2bf(c, d); return r; }

__device__ __forceinline__ void convert_wt_job(const float* W, int K, int N, int Npad, bf16_t* out, int job, float* T, int ilv) {
    const int tid = otid();
    const int nkt = K / 64;
    const int n0 = (job / nkt) * 64, k0 = (job % nkt) * 64;
    __syncthreads();
    for (int idx = tid; idx < 4096; idx += NTHREADS) {
        int kk = idx >> 6, nn = idx & 63;
        int nr = n0 + nn; int src = ilv ? ((nr & 1) ? (N / 2 + (nr >> 1)) : (nr >> 1)) : nr;
        T[kk * 65 + nn] = (nr < N) ? W[(size_t)(k0 + kk) * N + src] : 0.f;
    }
    __syncthreads();
    {
        int nn = tid >> 2, part = tid & 3;
        unsigned w[8];
#pragma unroll
        for (int j = 0; j < 8; ++j) w[j] = pack2bf(T[(part * 16 + 2 * j) * 65 + nn], T[(part * 16 + 2 * j + 1) * 65 + nn]);
        u32x4* o = (u32x4*)(out + (size_t)(n0 + nn) * K + k0 + part * 16);
        o[0] = (u32x4){w[0], w[1], w[2], w[3]}; o[1] = (u32x4){w[4], w[5], w[6], w[7]};
    }
}
__device__ __forceinline__ void phase_convert_weights(const P& p, int l, char* smem, int bid, int nb) {
    float* T = (float*)smem;
    struct Item { const float* W; int K, N, Npad; bf16_t* out; };
    const Item items[12] = {
        {p.in[I_RW2] + ((size_t)l * 2 + 0) * 64 * RW, 64, RW, NPAD(RW), p.WT_W2},
        {p.in[I_RW2] + ((size_t)l * 2 + 1) * 64 * RW, 64, RW, NPAD(RW), p.WT_W2 + (size_t)NPAD(RW) * 64},
        {p.in[I_RA2] + ((size_t)l * 2 + 0) * 64 * RW, 64, RW, NPAD(RW), p.WT_A2},
        {p.in[I_RA2] + ((size_t)l * 2 + 1) * 64 * RW, 64, RW, NPAD(RW), p.WT_A2 + (size_t)NPAD(RW) * 64},
        {p.in[I_WIN] + (size_t)l * D_MODEL * D_IN, D_MODEL, D_IN, NPAD192(D_IN), p.WT_IN},
        {p.in[I_RG2] + (size_t)l * 128 * RW, 128, RW, RW, p.WT_G2},
        {p.in[I_S5GLU] + (size_t)l * SW * 2 * SW, SW, 2 * SW, 2 * SW, p.WT_GLU},
        {p.in[I_WBR] + ((size_t)l * 3 + 0) * BW * D_MODEL, BW, D_MODEL, D_MODEL, p.WT_BR},
        {p.in[I_WBR] + ((size_t)l * 3 + 1) * BW * D_MODEL, BW, D_MODEL, D_MODEL, p.WT_BR + (size_t)D_MODEL * BW},
        {p.in[I_WBR] + ((size_t)l * 3 + 2) * BW * D_MODEL, BW, D_MODEL, D_MODEL, p.WT_BR + (size_t)2 * D_MODEL * BW},
        {p.in[I_WOUT] + (size_t)l * D_MODEL * D_MODEL, D_MODEL, D_MODEL, D_MODEL, p.WT_OUT},
        {p.in[I_PWQ] + (size_t)l * D_MODEL * PQ, D_MODEL, PQ, PQ, p.WT_Q}};
    int base = 0;
#pragma unroll
    for (int it = 0; it < 12; ++it) {
        const int nj = (items[it].Npad / 64) * (items[it].K / 64);
        for (int j = (bid + nb - (base % nb)) % nb; j < nj; j += nb)
            convert_wt_job(items[it].W, items[it].K, items[it].N, items[it].Npad, items[it].out, j, T, it == 6);
        base += nj;
    }
    __syncthreads();
    {
        const float* ks = p.in[I_PKEYS] + (size_t)l * PH * 2 * 128 * 128;
        for (size_t i = (size_t)bid * NTHREADS + otid(); i < (size_t)PH * 2 * 128 * 128; i += (size_t)nb * NTHREADS) {
            const float v = ks[i]; const bf16_t hb = f2bf(v);
            p.KHI[i] = hb; p.KLO[i] = f2bf(v - bf2f(hb));
        }
    }
}

#ifdef EMU
__device__ __forceinline__ int xcd_rank() { return obid(); }
#else
__device__ __forceinline__ int xcd_rank() { return (int)((volatile LAS unsigned*)(unsigned)(SMEM_BYTES))[2]; }
#endif
__device__ __forceinline__ bool tile_map(int it, int ntm, int ntn, int PM, int& mt, int& nt) {
    const int G = gridDim.x;
    const long id = (long)it * G + xcd_rank();
    if (id >= (long)ntm * ntn) return false;
    const int full = ntm / PM; const long fullsz = (long)full * PM * ntn;
    if (id < fullsz) { const int p = (int)(id / (PM * ntn)), rem = (int)(id % (PM * ntn)); nt = rem / PM; mt = p * PM + rem % PM; }
    else { const int rem = (int)(id - fullsz), hh = ntm - full * PM; nt = rem / hh; mt = full * PM + rem % hh; }
    return true;
}

template <int NI, int MI, class Pre, class Post>
__device__ __forceinline__ void gemm_tile_run(const bf16_t* Wt, int ldw, size_t wbytes, const bf16_t* Act, int lda, size_t abytes, int K, int n0, int m0, bf16_t* lds, Pre pre, Post post) {
    f32x4 acc[NI][MI];
#pragma unroll
    for (int i = 0; i < NI; ++i)
#pragma unroll
        for (int j = 0; j < MI; ++j) acc[i][j] = (f32x4){0.f, 0.f, 0.f, 0.f};
    pre(m0, n0, acc, lds);
    mfma_gemm_tile_t<NI, MI>(Wt, ldw, wbytes, Act, lda, abytes, K, n0, m0, lds, acc);
    const int lane = otid() & 63, wave = otid() >> 6;
#pragma unroll
    for (int ni = 0; ni < NI; ++ni)
#pragma unroll
        for (int mi = 0; mi < MI; ++mi)
            post(ni, mi, m0 + (wave & 1) * 16 * MI + mi * 16 + (lane & 15), n0 + (wave >> 1) * 16 * NI + ni * 16 + (lane >> 4) * 4, acc[ni][mi]);
}
struct NoPre { template <class A> __device__ __forceinline__ void operator()(int, int, A&, bf16_t*) const {} };
template <int NI, class PreM, class PreT, class Post>
__device__ __forceinline__ void gemm_phase(const bf16_t* Wt, int ldw, size_t wbytes, const bf16_t* Act, int lda, size_t abytes, int K, int N, bf16_t* lds, PreM prem, PreT pret, Post post) {
    const int ntn = N / (32 * NI), ntm = MTOT / 256 - 1;
    const int PM = (ntn >= 16) ? 2 : ((ntn >= 8) ? 4 : 8);
    for (int it = 0;; ++it) {
        int mt_, nt_; if (!tile_map(it, ntm, ntn, PM, mt_, nt_)) break;
        gemm_tile_run<NI, 8>(Wt, ldw, wbytes, Act, lda, abytes, K, nt_ * 32 * NI, mt_ * 256, lds, prem, post);
    }
    for (int job = obid(); job < 4 * ntn; job += gridDim.x)
        gemm_tile_run<NI, 2>(Wt, ldw, wbytes, Act, lda, abytes, K, (job >> 2) * 32 * NI, MTOT - 256 + (job & 3) * 64, lds, pret, post);
}

__device__ __forceinline__ void phase_init(const P& p, char* smem) {
    const int tid = otid();
    float* sc = (float*)smem;
    for (int i = tid; i < D_MODEL; i += NTHREADS) { sc[i] = siluf_(p.in[I_CCTX][i]); sc[D_MODEL + i] = siluf_(p.in[I_C][i]); }
    __syncthreads();
    const int ncolblk = (6 * D_MODEL) / NTHREADS;
    for (int job = obid(); job < DEPTH * ncolblk; job += gridDim.x) {
        int l = job / ncolblk, n = (job % ncolblk) * NTHREADS + tid;
        const float* w = p.in[I_WMOD] + (size_t)l * D_MODEL * 6 * D_MODEL + n;
        float a0 = 0.f, a1 = 0.f;
        for (int k = 0; k < D_MODEL; ++k) { float wv = w[(size_t)k * 6 * D_MODEL]; a0 += sc[k] * wv; a1 += sc[D_MODEL + k] * wv; }
        float b = p.in[I_BMOD][l * 6 * D_MODEL + n];
        p.MOD[(size_t)(l * 2 + 0) * 6 * D_MODEL + n] = a0 + b;
        p.MOD[(size_t)(l * 2 + 1) * 6 * D_MODEL + n] = a1 + b;
    }
    const size_t gtid = (size_t)obid() * NTHREADS + tid, gn = (size_t)gridDim.x * NTHREADS;
    for (size_t i = gtid; i < (size_t)CTX * D_MODEL; i += gn) p.X[i] = p.in[I_CTX][i];
    for (size_t i = gtid; i < (size_t)SEQ * D_MODEL; i += gn) p.X[(size_t)CTX * D_MODEL + i] = p.in[I_X][i];
    __syncthreads();
}

__device__ __forceinline__ void phase_s5const(const P& p, int l) {
    const size_t gtid = (size_t)obid() * NTHREADS + otid(), gn = (size_t)gridDim.x * NTHREADS;
    for (size_t i = gtid; i < (size_t)2 * SG * 64; i += gn) {
        int d = (int)(i / (SG * 64)), g = (int)((i / 64) % SG), s = (int)(i % 64);
        size_t li = ((size_t)(l * 2 + d) * SG + g) * 64 + s;
        float lre = p.in[I_S5LRE][li], lim = p.in[I_S5LIM][li];
        float dt = expf(p.in[I_S5LS][(l * 2 + d) * SG + g]);
        float mag = expf(lre * dt);
        float are = mag * cosf(lim * dt), aim = mag * sinf(lim * dt);
        float den = lre * lre + lim * lim;
        float fre = ((are - 1.0f) * lre + aim * lim) / den;
        float fim = (aim * lre - (are - 1.0f) * lim) / den;
        p.S5A[i * 2 + 0] = are; p.S5A[i * 2 + 1] = aim;
        const float* bre = p.in[I_S5BRE] + (((size_t)l * SG + g) * 64 + s) * 16;
        const float* bim = p.in[I_S5BIM] + (((size_t)l * SG + g) * 64 + s) * 16;
        for (int c = 0; c < 16; ++c) {
            p.S5BB[(i * 16 + c) * 2 + 0] = fre * bre[c] - fim * bim[c];
            p.S5BB[(i * 16 + c) * 2 + 1] = fre * bim[c] + fim * bre[c];
        }
    }
}

__device__ __forceinline__ void phase_norm(const P& p, int l, int which) {
    const int lane = otid() & 63;
    const int gw = (obid() * NTHREADS + otid()) >> 6, nw = (gridDim.x * NTHREADS) >> 6;
    const float* g = p.in[which ? I_N2G : I_N1G] + l * D_MODEL;
    constexpr int NJ = (D_MODEL + 255) / 256;
    for (int t = gw; t < MTOT; t += nw) {
        const float* x = p.X + (size_t)t * D_MODEL;
        const float* mod = p.MOD + (size_t)(l * 2 + (t >= CTX ? 1 : 0)) * 6 * D_MODEL + (which ? 3 * D_MODEL : 0);
        float4 v[NJ]; float ss = 0.f;
#pragma unroll
        for (int j = 0; j < NJ; ++j) {
            const int e = j * 256 + lane * 4;
            if (e < D_MODEL) v[j] = *(const float4*)(x + e); else { v[j].x = 0.f; v[j].y = 0.f; v[j].z = 0.f; v[j].w = 0.f; }
            ss += v[j].x * v[j].x + v[j].y * v[j].y + v[j].z * v[j].z + v[j].w * v[j].w;
        }
        ss = wave_sum(ss);
        const float rstd = rsqrtf(ss / D_MODEL + 1e-6f);
#pragma unroll
        for (int j = 0; j < NJ; ++j) {
            const int e = j * 256 + lane * 4;
            if (e < D_MODEL) {
                const float4 gg = *(const float4*)(g + e), sc = *(const float4*)(mod + D_MODEL + e), sh = *(const float4*)(mod + e);
                *(u32x2*)(p.H + (size_t)t * D_MODEL + e) = pack4(v[j].x * rstd * gg.x * (1.0f + sc.x) + sh.x, v[j].y * rstd * gg.y * (1.0f + sc.y) + sh.y,
                                                                 v[j].z * rstd * gg.z * (1.0f + sc.z) + sh.z, v[j].w * rstd * gg.w * (1.0f + sc.w) + sh.w);
            }
        }
    }
}

__device__ __forceinline__ void phase_gemm_in(const P& p, int l, char* smem) {
    constexpr int NI = 6, MI = 8;
    const int ntn = NPAD192(D_IN) / 192, ntm = MTOT / 256;
    for (int it = 0;; ++it) {
        int mt_, nt_; if (!tile_map(it, ntm, ntn, 4, mt_, nt_)) break;
        const int m0 = mt_ * 256, n0 = nt_ * 192;
        f32x4 acc[NI][MI];
#pragma unroll
        for (int i = 0; i < NI; ++i)
#pragma unroll
            for (int j = 0; j < MI; ++j) acc[i][j] = (f32x4){0.f, 0.f, 0.f, 0.f};
        mfma_gemm_tile_t<NI, MI>(p.WT_IN, D_MODEL, (size_t)NPAD192(D_IN) * D_MODEL * 2, p.H, D_MODEL, (size_t)MTOT * D_MODEL * 2, D_MODEL, n0, m0, (bf16_t*)smem, acc);
        const int lane = otid() & 63, wave = otid() >> 6;
#pragma unroll
        for (int ni = 0; ni < NI; ++ni)
#pragma unroll
            for (int mi = 0; mi < MI; ++mi) {
                const int n = n0 + (wave >> 1) * 16 * NI + ni * 16 + (lane >> 4) * 4, m = m0 + (wave & 1) * 16 * MI + mi * 16 + (lane & 15);
                const u32x2 pk_ = pack4(acc[ni][mi][0], acc[ni][mi][1], acc[ni][mi][2], acc[ni][mi][3]);
                if (n < ZG) *(u32x2*)(p.Z + (size_t)m * ZLD + n) = pk_;
                else if (n < D_IN) *(u32x2*)(p.ZGT + ((((size_t)(m >> 4) * (3 * D_MODEL / 16) + ((n - ZG) >> 4)) * 64 + lane) * 4)) =
                    pack4(sigmoidf_(acc[ni][mi][0]), sigmoidf_(acc[ni][mi][1]), sigmoidf_(acc[ni][mi][2]), sigmoidf_(acc[ni][mi][3]));
            }
    }
}

__device__ __forceinline__ void unpack8(const u32x4 w, float (&f)[8]) {
    f[0] = LO16(w.x); f[1] = HI16(w.x); f[2] = LO16(w.y); f[3] = HI16(w.y); f[4] = LO16(w.z); f[5] = HI16(w.z); f[6] = LO16(w.w); f[7] = HI16(w.w);
}
__device__ __forceinline__ u32x4 pack8(const float (&f)[8]) {
    u32x4 o; o.x = pack2bf(f[0], f[1]); o.y = pack2bf(f[2], f[3]);
    o.z = pack2bf(f[4], f[5]); o.w = pack2bf(f[6], f[7]); return o;
}
__device__ __forceinline__ void load8f(const float* p, float (&f)[8]) {
    const float4 a = *(const float4*)p, b = *(const float4*)(p + 4);
    f[0] = a.x; f[1] = a.y; f[2] = a.z; f[3] = a.w; f[4] = b.x; f[5] = b.y; f[6] = b.z; f[7] = b.w;
}
__device__ __forceinline__ void store8f(float* p, const float (&f)[8]) {
    float4 a, b; a.x = f[0]; a.y = f[1]; a.z = f[2]; a.w = f[3]; b.x = f[4]; b.y = f[5]; b.z = f[6]; b.w = f[7];
    *(float4*)p = a; *(float4*)(p + 4) = b;
}
__device__ __forceinline__ void conv8(const bf16_t* zp, const float* conv, int c0, bool act, bool first, bool last, float (&out)[8]) {
    const u32x4 z4 = {0u, 0u, 0u, 0u};
    const u32x4 a0 = act ? *(const u32x4*)(zp + c0) : z4;
    const u32x4 am = (act && !first) ? *(const u32x4*)(zp + c0 - ZLD) : z4;
    const u32x4 an = (act && !last) ? *(const u32x4*)(zp + c0 + ZLD) : z4;
    float w0[8], w1[8], w2[8], f0[8], fm[8], fn[8];
    if (act) { load8f(conv + c0, w0); load8f(conv + RWKV_IN + c0, w1); load8f(conv + 2 * RWKV_IN + c0, w2); }
    else {
#pragma unroll
        for (int e = 0; e < 8; ++e) { w0[e] = 0.f; w1[e] = 0.f; w2[e] = 0.f; }
    }
    unpack8(a0, f0); unpack8(am, fm); unpack8(an, fn);
#pragma unroll
    for (int e = 0; e < 8; ++e) out[e] = w1[e] * f0[e] + w0[e] * fm[e] + w2[e] * fn[e];
}
__device__ __forceinline__ void phase_rwkv_prep1(const P& p, int l) {
    const int lane = otid() & 63;
    const int gw = (obid() * NTHREADS + otid()) >> 6, nw = (gridDim.x * NTHREADS) >> 6;
    const float* conv = p.in[I_RCONV] + (size_t)l * 3 * RWKV_IN;
    const float* k_k = p.in[I_RKK] + (size_t)l * RW;
    const bool act = lane * 8 < RW, act2 = lane * 8 < 384;
    float kkw[8];
    if (act) load8f(k_k + lane * 8, kkw);
    else {
#pragma unroll
        for (int e = 0; e < 8; ++e) kkw[e] = 0.f;
    }
    for (int t = gw; t < MTOT; t += nw) {
        const bool first = (t == 0) || (t == CTX), last = (t == CTX - 1) || (t == MTOT - 1);
        const bf16_t* zp = p.Z + (size_t)t * ZLD + ZR;
        float rv[8], kv[8], vv[8], lr[8];
        conv8(zp, conv, 0 * RW + lane * 8, act, first, last, rv);
        conv8(zp, conv, 1 * RW + lane * 8, act, first, last, kv);
        conv8(zp, conv, 2 * RW + lane * 8, act, first, last, vv);
        conv8(zp, conv, 3 * RW + lane * 8, act2, first, last, lr);
        float kk[8]; float ss = 0.f;
#pragma unroll
        for (int e = 0; e < 8; ++e) { kk[e] = kv[e] * kkw[e]; ss += kk[e] * kk[e]; }
        ss += __shfl_xor(ss, 1, 64); ss += __shfl_xor(ss, 2, 64); ss += __shfl_xor(ss, 4, 64);
        const float inv = 1.0f / fmaxf(sqrtf(ss), 1e-12f);
#pragma unroll
        for (int e = 0; e < 8; ++e) kk[e] *= inv;
        if (act) {
            const size_t o = (size_t)t * RW + lane * 8;
            *(u32x4*)(p.R + o) = pack8(rv); *(u32x4*)(p.KS + o) = pack8(kv); *(u32x4*)(p.V + o) = pack8(vv); *(u32x4*)(p.KK + o) = pack8(kk);
        }
        if (act2) {
            const int cc = lane * 8;
            if (cc < 128) {
#pragma unroll
                for (int e = 0; e < 8; ++e) lr[e] = tanhf_(lr[e]);
                *(u32x4*)(p.LR + (size_t)t * 256 + cc) = pack8(lr);
            } else if (cc < 256) {
                *(u32x4*)(p.LR + (size_t)t * 256 + cc) = pack8(lr);
            } else {
#pragma unroll
                for (int e = 0; e < 8; ++e) lr[e] = sigmoidf_(lr[e]);
                *(u32x4*)(p.GS + (size_t)t * 128 + cc - 256) = pack8(lr);
            }
        }
    }
}
__device__ __forceinline__ void phase_rwkv_prep2(const P& p, int l, char* smem) {
    const int ntm = MTOT / 128, ntn = NPAD(RW) / 128;
    const float* k_a = p.in[I_RKA] + (size_t)l * RW;
    const float* r_k = p.in[I_RRK] + (size_t)l * RW;
    for (int job = obid(); job < ntm * ntn * 2; job += gridDim.x) {
        const int d = job % 2, n0 = ((job / 2) % ntn) * 128, m0 = (job / (2 * ntn)) * 128;
        const float* w0 = p.in[I_RW0] + (size_t)(l * 2 + d) * RW;
        const float* a0 = p.in[I_RA0] + (size_t)(l * 2 + d) * RW;
        f32x4 accw[4][4], acca[4][4]; ZERO_ACC4(accw); ZERO_ACC4(acca);
        mfma_gemm_tile(p.WT_W2 + (size_t)d * NPAD(RW) * 64, 64, p.LR + d * 64, 256, 64, n0, m0, (bf16_t*)smem, accw);
        mfma_gemm_tile(p.WT_A2 + (size_t)d * NPAD(RW) * 64, 64, p.LR + 128 + d * 64, 256, 64, n0, m0, (bf16_t*)smem, acca);
        const int lane = otid() & 63, wave = otid() >> 6;
#pragma unroll
        for (int mi = 0; mi < 4; ++mi) {
            const int m = m0 + (wave & 1) * 64 + mi * 16 + (lane & 15);
            float bon = 0.f;
#pragma unroll
            for (int ni = 0; ni < 4; ++ni) {
                const int n = n0 + (wave >> 1) * 64 + ni * 16 + (lane >> 4) * 4;
                if (n < RW) {
                    const u32x2 kq = *(const u32x2*)(p.KS + (size_t)m * RW + n), kkq = *(const u32x2*)(p.KK + (size_t)m * RW + n), rq = *(const u32x2*)(p.R + (size_t)m * RW + n);
                    const float kv[4] = {LO16(kq.x), HI16(kq.x), LO16(kq.y), HI16(kq.y)};
                    const float kkv[4] = {LO16(kkq.x), HI16(kkq.x), LO16(kkq.y), HI16(kkq.y)};
                    const float rv[4] = {LO16(rq.x), HI16(rq.x), LO16(rq.y), HI16(rq.y)};
                    float lw[4], kd[4], bb[4];
#pragma unroll
                    for (int e = 0; e < 4; ++e) {
                        const float x = w0[n + e] + accw[ni][mi][e];
                        lw[e] = -fexp_(-softplusf_(-x) - 0.5f);
                        const float aa = sigmoidf_(a0[n + e] + acca[ni][mi][e]);
                        kd[e] = kv[e] * (1.0f + (aa - 1.0f) * k_a[n + e]);
                        bb[e] = kkv[e] * aa;
                        bon += rv[e] * kd[e] * r_k[n + e];
                    }
                    const size_t o = ((size_t)d * MTOT + m) * RW + n;
                    float4 lo4; lo4.x = lw[0]; lo4.y = lw[1]; lo4.z = lw[2]; lo4.w = lw[3];
                    *(float4*)(p.LW + o) = lo4;
                    *(u32x2*)(p.KD + o) = pack4(kd[0], kd[1], kd[2], kd[3]);
                    *(u32x2*)(p.BB + o) = pack4(bb[0], bb[1], bb[2], bb[3]);
                }
            }
            bon += __shfl_xor(bon, 16, 64); bon += __shfl_xor(bon, 32, 64);
            const int hh = (n0 + (wave >> 1) * 64) >> 6;
            if ((lane >> 4) == 0 && hh < RH) p.BONUS[((size_t)d * MTOT + m) * RH + hh] = bon;
        }
    }
}

#define CH_ROW 72
#define SEQ_REC 16640
#define CH_SLOT (64 * CH_ROW)
#define CH_XR_OFF (7 * CH_SLOT * 2)
#define CH_AAB_OFF (CH_XR_OFF + 64 * 132 * 4)
#define CH_GC_OFF (CH_AAB_OFF + 64 * 72 * 4)
template <int MT, int NT>
__device__ __forceinline__ void lds_mm(const bf16_t* A, int m0, const bf16_t* Bt, int n0, f32x4 (&acc)[MT][NT]) {
    const int lane = otid() & 63, q = lane >> 4, r = lane & 15;
#pragma unroll
    for (int s = 0; s < 2; ++s) {
        bf16x8 a[MT], b[NT];
#pragma unroll
        for (int i = 0; i < MT; ++i) a[i] = *(const bf16x8*)(A + (m0 + i * 16 + r) * CH_ROW + s * 32 + q * 8);
#pragma unroll
        for (int i = 0; i < NT; ++i) b[i] = *(const bf16x8*)(Bt + (n0 + i * 16 + r) * CH_ROW + s * 32 + q * 8);
#pragma unroll
        for (int i = 0; i < MT; ++i)
#pragma unroll
            for (int jj = 0; jj < NT; ++jj) acc[i][jj] = MFMA16(a[i], b[jj], acc[i][jj]);
    }
}
__device__ __forceinline__ void rwkv_chunk_job(const P& p, int l, int job, char* smem) {
    const int tid = otid(), lane = tid & 63, wv = tid >> 6, q = lane >> 4, r = lane & 15;
    const int d = job / (NC * RH), n = (job / RH) % NC, h = job % RH;
    const size_t base = (size_t)(d * NC + n) * RH + h;
    bf16_t* S0 = (bf16_t*)smem; bf16_t* S1 = S0 + CH_SLOT; bf16_t* S2 = S1 + CH_SLOT; bf16_t* S3 = S2 + CH_SLOT;
    bf16_t* S4 = S3 + CH_SLOT; bf16_t* S5 = S4 + CH_SLOT; bf16_t* S6 = S5 + CH_SLOT;
    float* X = (float*)(smem + CH_XR_OFF);
    float* AABt = (float*)(smem + CH_AAB_OFF);
    bf16_t* U0t = (bf16_t*)(smem + CH_AAB_OFF);
    bf16_t* Aht = U0t + CH_SLOT;
    float* GC = (float*)(smem + CH_GC_OFF);
    __syncthreads();
    u32x4 gkk[2], gr[2], gv[2], gks[2];
#pragma unroll
    for (int it = 0; it < 2; ++it) {
        const int c = tid + 256 * it, i = c >> 3, k0 = (c & 7) * 8; const int tok = 64 * n + (d ? 63 - i : i);
        const size_t o1 = (size_t)tok * RW + h * 64 + k0;
        gkk[it] = *(const u32x4*)(p.KK + o1); gr[it] = *(const u32x4*)(p.R + o1); gv[it] = *(const u32x4*)(p.V + o1); gks[it] = *(const u32x4*)(p.KS + o1);
    }
    {
        const int iw = 16 * wv + r; const int tokw = 64 * n + (d ? 63 - iw : iw);
        bf16x8 fw[2], fa[2];
#pragma unroll
        for (int s2 = 0; s2 < 2; ++s2) {
            fw[s2] = *(const bf16x8*)(p.LR + (size_t)tokw * 256 + d * 64 + s2 * 32 + q * 8);
            fa[s2] = *(const bf16x8*)(p.LR + (size_t)tokw * 256 + 128 + d * 64 + s2 * 32 + q * 8);
        }
        const bf16_t* w2 = p.WT_W2 + ((size_t)d * NPAD(RW) + h * 64) * 64; const bf16_t* a2 = p.WT_A2 + ((size_t)d * NPAD(RW) + h * 64) * 64;
        const float* w0 = p.in[I_RW0] + (size_t)(l * 2 + d) * RW + h * 64; const float* a0 = p.in[I_RA0] + (size_t)(l * 2 + d) * RW + h * 64;
#pragma unroll
        for (int nt = 0; nt < 4; ++nt) {
            f32x4 cw = {0.f, 0.f, 0.f, 0.f}, ca = {0.f, 0.f, 0.f, 0.f};
#pragma unroll
            for (int s2 = 0; s2 < 2; ++s2) {
                const bf16x8 bw = *(const bf16x8*)(w2 + (size_t)(nt * 16 + r) * 64 + s2 * 32 + q * 8), ba = *(const bf16x8*)(a2 + (size_t)(nt * 16 + r) * 64 + s2 * 32 + q * 8);
                cw = MFMA16(fw[s2], bw, cw); ca = MFMA16(fa[s2], ba, ca);
            }
            const float w0c = w0[nt * 16 + r], a0c = a0[nt * 16 + r];
#pragma unroll
            for (int e = 0; e < 4; ++e) {
                const int i = 16 * wv + 4 * q + e;
                X[i * 132 + nt * 16 + r] = -fexp_(-softplusf_(-(w0c + cw[e])) - 0.5f);
                X[i * 132 + 64 + nt * 16 + r] = sigmoidf_(a0c + ca[e]);
            }
        }
    }
    __syncthreads();
    {
        const int k = tid & 63, seg = tid >> 6;
        float v[16]; float run = 0.f;
#pragma unroll
        for (int e = 0; e < 16; ++e) { run += X[(seg * 16 + e) * 132 + k]; v[e] = run; }
        AABt[seg * 64 + k] = run;
        __syncthreads();
        float off = 0.f;
        for (int s2 = 0; s2 < seg; ++s2) off += AABt[s2 * 64 + k];
#pragma unroll
        for (int e = 0; e < 16; ++e) X[(seg * 16 + e) * 132 + k] = v[e] + off;
    }
    __syncthreads();
#pragma unroll
    for (int it = 0; it < 2; ++it) {
        const int c = tid + 256 * it, i = c >> 3, k0 = (c & 7) * 8;
        float L[8], Lp[8], LC[8], kkv[8], rv[8], vv[8], kdv[8], bbv[8], aav[8], ksv[8], kav[8], rkv[8];
        load8f(X + i * 132 + k0, L); load8f(X + 63 * 132 + k0, LC); load8f(X + i * 132 + 64 + k0, aav);
        load8f(p.in[I_RKA] + (size_t)l * RW + h * 64 + k0, kav); load8f(p.in[I_RRK] + (size_t)l * RW + h * 64 + k0, rkv);
        if (i > 0) load8f(X + (i - 1) * 132 + k0, Lp);
        else {
#pragma unroll
            for (int e = 0; e < 8; ++e) Lp[e] = 0.f;
        }
        unpack8(gkk[it], kkv); unpack8(gr[it], rv); unpack8(gv[it], vv); unpack8(gks[it], ksv);
        float bon = 0.f;
#pragma unroll
        for (int e = 0; e < 8; ++e) { kdv[e] = ksv[e] * (1.0f + (aav[e] - 1.0f) * kav[e]); bbv[e] = kkv[e] * aav[e]; bon += rv[e] * kdv[e] * rkv[e]; }
        bon += __shfl_xor(bon, 1, 64); bon += __shfl_xor(bon, 2, 64); bon += __shfl_xor(bon, 4, 64);
        if ((tid & 7) == 0) p.BONUS[((size_t)d * MTOT + 64 * n + (d ? 63 - i : i)) * RH + h] = bon;
        float at[8], rt[8], bt[8], kt[8], bh[8], kh[8];
#pragma unroll
        for (int e = 0; e < 8; ++e) {
            const float eL = fexp_(L[e]), eLp = fexp_(Lp[e]), eNL = fexp_(-L[e]), eCL = fexp_(LC[e] - L[e]);
            at[e] = -kkv[e] * eLp; rt[e] = rv[e] * eL; bt[e] = bbv[e] * eNL; kt[e] = kdv[e] * eNL; bh[e] = bbv[e] * eCL; kh[e] = kdv[e] * eCL;
            if (i == 63) GC[k0 + e] = eL;
        }
        *(u32x4*)(S0 + i * CH_ROW + k0) = pack8(at);
        store8f(X + i * 132 + 64 + k0, at);
        *(u32x4*)(S1 + i * CH_ROW + k0) = pack8(rt);
        *(u32x4*)(S2 + i * CH_ROW + k0) = pack8(bt);
        *(u32x4*)(S3 + i * CH_ROW + k0) = pack8(kt);
#pragma unroll
        for (int e = 0; e < 8; ++e) {
            S4[(k0 + e) * CH_ROW + i] = f2bf(vv[e]);
            S5[(k0 + e) * CH_ROW + i] = f2bf(bh[e]);
            S6[(k0 + e) * CH_ROW + i] = f2bf(kh[e]);
        }
    }
    __syncthreads();
    {
        f32x4 acc[4][4]; ZERO_ACC4(acc);
        lds_mm<4, 4>((wv < 2) ? S0 : S1, 0, (wv & 1) ? S3 : S2, 0, acc);
        __syncthreads();
#pragma unroll
        for (int mt = 0; mt < 4; ++mt)
#pragma unroll
            for (int nt = 0; nt < 4; ++nt) {
                const int jc = nt * 16 + r, i0 = mt * 16 + 4 * q;
                if (wv == 0) {
                    f32x4 o;
#pragma unroll
                    for (int e = 0; e < 4; ++e) o[e] = (jc < i0 + e) ? acc[mt][nt][e] : 0.f;
                    *(f32x4*)(AABt + jc * 72 + i0) = o;
                } else {
                    bf16_t* dst = (wv == 1) ? S0 : ((wv == 2) ? S2 : S3);
#pragma unroll
                    for (int e = 0; e < 4; ++e) {
                        const bool ok = (wv == 1) ? (jc < i0 + e) : (jc <= i0 + e);
                        dst[(i0 + e) * CH_ROW + jc] = f2bf(ok ? acc[mt][nt][e] : 0.f);
                    }
                }
            }
    }
    __syncthreads();
    {
        f32x4 acc[1][4];
#pragma unroll
        for (int nt = 0; nt < 4; ++nt) acc[0][nt] = (f32x4){0.f, 0.f, 0.f, 0.f};
        lds_mm<1, 4>(S0, 16 * wv, S4, 0, acc);
#pragma unroll
        for (int nt = 0; nt < 4; ++nt)
#pragma unroll
            for (int e = 0; e < 4; ++e) X[(16 * wv + 4 * q + e) * 132 + nt * 16 + r] = acc[0][nt][e];
    }
    __syncthreads();
    if (tid < 128) {
        const int c = tid;
        for (int bi = 0; bi < 4; ++bi) {
            float acc[16];
#pragma unroll
            for (int e = 0; e < 16; ++e) acc[e] = X[(16 * bi + e) * 132 + c];
            for (int jj = 0; jj < 16 * bi; ++jj) {
                const float uj = X[jj * 132 + c];
                const f32x4* ap = (const f32x4*)(AABt + jj * 72 + 16 * bi);
                const f32x4 a0 = ap[0], a1 = ap[1], a2 = ap[2], a3 = ap[3];
#pragma unroll
                for (int e = 0; e < 4; ++e) { acc[e] += a0[e] * uj; acc[4 + e] += a1[e] * uj; acc[8 + e] += a2[e] * uj; acc[12 + e] += a3[e] * uj; }
            }
#pragma unroll
            for (int e = 0; e < 16; ++e) {
                const float u = acc[e];
                X[(16 * bi + e) * 132 + c] = u;
                const f32x4* ap = (const f32x4*)(AABt + (16 * bi + e) * 72 + 16 * bi);
                const f32x4 a0 = ap[0], a1 = ap[1], a2 = ap[2], a3 = ap[3];
#pragma unroll
                for (int e2 = 0; e2 < 16; ++e2) if (e2 > e) acc[e2] += ((e2 < 4) ? a0[e2 & 3] : (e2 < 8) ? a1[e2 & 3] : (e2 < 12) ? a2[e2 & 3] : a3[e2 & 3]) * u;
            }
        }
    }
    __syncthreads();
    if (tid < 128) {
        const int c = tid;
        bf16_t* dst = (c < 64) ? (U0t + c * CH_ROW) : (Aht + (c - 64) * CH_ROW);
        u32x4 ov[8];
#pragma unroll
        for (int g = 0; g < 8; ++g) {
            float v[8];
#pragma unroll
            for (int e = 0; e < 8; ++e) v[e] = X[(g * 8 + e) * 132 + c];
            ov[g].x = pack2bf(v[0], v[1]); ov[g].y = pack2bf(v[2], v[3]);
            ov[g].z = pack2bf(v[4], v[5]); ov[g].w = pack2bf(v[6], v[7]);
        }
#pragma unroll
        for (int g = 0; g < 8; ++g) *(u32x4*)(dst + g * 8) = ov[g];
    }
    __syncthreads();
    {
        f32x4 acc[4][4]; ZERO_ACC4(acc);
        char* rec = p.REC + base * SEQ_REC;
        if (wv == 0) {
            lds_mm<4, 4>(Aht, 0, S5, 0, acc);
#pragma unroll
            for (int nt = 0; nt < 4; ++nt)
#pragma unroll
                for (int s2 = 0; s2 < 2; ++s2) {
                    u32x4 o;
                    o.x = pack2bf(acc[2 * s2][nt][0], acc[2 * s2][nt][1]); o.y = pack2bf(acc[2 * s2][nt][2], acc[2 * s2][nt][3]);
                    o.z = pack2bf(acc[2 * s2 + 1][nt][0], acc[2 * s2 + 1][nt][1]); o.w = pack2bf(acc[2 * s2 + 1][nt][2], acc[2 * s2 + 1][nt][3]);
                    *(u32x4*)(rec + (((nt * 2 + s2) * 64 + lane) * 8) * 2) = o;
                }
        } else if (wv == 1) {
            lds_mm<4, 4>(S5, 0, U0t, 0, acc);
            lds_mm<4, 4>(S6, 0, S4, 0, acc);
#pragma unroll
            for (int mt = 0; mt < 4; ++mt)
#pragma unroll
                for (int nt = 0; nt < 4; ++nt) *(u32x2*)(rec + 8192 + (((nt * 4 + mt) * 64 + lane) * 4) * 2) = pack4(acc[mt][nt][0], acc[mt][nt][1], acc[mt][nt][2], acc[mt][nt][3]);
        } else if (wv == 2) {
            lds_mm<4, 4>(S2, 0, Aht, 0, acc);
#pragma unroll
            for (int mt = 0; mt < 4; ++mt)
#pragma unroll
                for (int nt = 0; nt < 4; ++nt)
#pragma unroll
                    for (int e = 0; e < 4; ++e) {
                        const int t = mt * 16 + 4 * q + e, kc = nt * 16 + r;
                        p.QH[(base * 64 + t) * 64 + kc] = f2bf(acc[mt][nt][e] + bf2f(S1[t * CH_ROW + kc]));
                    }
        } else if (wv == 3) {
            lds_mm<4, 4>(S2, 0, U0t, 0, acc);
            lds_mm<4, 4>(S3, 0, S4, 0, acc);
#pragma unroll
            for (int mt = 0; mt < 4; ++mt)
#pragma unroll
                for (int nt = 0; nt < 4; ++nt) *(f32x4*)(p.Y0T + (((base * 4 + mt) * 4 + nt) * 64 + lane) * 4) = acc[mt][nt];
        }
        if (tid < 64) ((float*)(rec + 16384))[tid] = GC[tid];
    }
}

#define SEQ_SLOT 16896
__device__ __forceinline__ void rwkv_seq_gload(const P& p, size_t base, int tid, u32x4 (&g)[5]) {
    const u32x4* m = (const u32x4*)(p.REC + base * SEQ_REC);
#pragma unroll
    for (int i = 0; i < 4; ++i) g[i] = m[tid + 256 * i];
    if (tid < 16) g[4] = m[1024 + tid];
}
__device__ __forceinline__ void rwkv_seq_lstore(char* slot, int tid, const u32x4 (&g)[5]) {
    u32x4* d = (u32x4*)slot;
#pragma unroll
    for (int i = 0; i < 4; ++i) d[tid + 256 * i] = g[i];
    if (tid < 16) d[1024 + tid] = g[4];
}
__device__ __forceinline__ void rwkv_seq_step(const P& p, const char* slot, size_t base, int wv, int lane, f32x4 (&X)[4]) {
    const int q = lane >> 4, r = lane & 15;
    const bf16_t* mt = (const bf16_t*)slot; const bf16_t* ntb = (const bf16_t*)(slot + 8192); const float* gc = (const float*)(slot + 16384);
    unsigned xh[4][2];
#pragma unroll
    for (int kt = 0; kt < 4; ++kt) {
        xh[kt][0] = pack2bf(X[kt][0], X[kt][1]); xh[kt][1] = pack2bf(X[kt][2], X[kt][3]);
        *(u32x2*)(p.SN + (base * 64 + 16 * wv + r) * 64 + 16 * kt + 4 * q) = (u32x2){xh[kt][0], xh[kt][1]};
    }
    bf16x8 bh[2];
#pragma unroll
    for (int s2 = 0; s2 < 2; ++s2) bh[s2] = __builtin_bit_cast(bf16x8, ((u32x4){xh[2 * s2][0], xh[2 * s2][1], xh[2 * s2 + 1][0], xh[2 * s2 + 1][1]}));
#pragma unroll
    for (int tile = 0; tile < 4; ++tile) {
        const u32x2 nb = *(const u32x2*)(ntb + ((wv * 4 + tile) * 64 + lane) * 4);
        const f32x4 g4 = *(const f32x4*)(gc + tile * 16 + 4 * q);
        f32x4 acc;
        acc[0] = g4[0] * X[tile][0] + LO16(nb.x); acc[1] = g4[1] * X[tile][1] + HI16(nb.x);
        acc[2] = g4[2] * X[tile][2] + LO16(nb.y); acc[3] = g4[3] * X[tile][3] + HI16(nb.y);
#pragma unroll
        for (int s2 = 0; s2 < 2; ++s2) {
            const bf16x8 ah = *(const bf16x8*)(mt + ((tile * 2 + s2) * 64 + lane) * 8);
            acc = MFMA16(ah, bh[s2], acc);
        }
        X[tile] = acc;
    }
}
__device__ __forceinline__ void rwkv_seq_job(const P& p, int job, char* smem) {
    const int tid = otid(), lane = tid & 63, wv = tid >> 6;
    const int d = job / RH, h = job % RH;
    f32x4 X[4];
#pragma unroll
    for (int kt = 0; kt < 4; ++kt) X[kt] = (f32x4){0.f, 0.f, 0.f, 0.f};
    u32x4 g0[5], g1[5], g2[5];
#define SEQ_BASE(s_) ((size_t)(d * NC + chunk_order(d, ((s_) < NC) ? (s_) : NC - 1)) * RH + h)
    __syncthreads();
    rwkv_seq_gload(p, SEQ_BASE(0), tid, g0);
    rwkv_seq_gload(p, SEQ_BASE(1), tid, g1);
    rwkv_seq_gload(p, SEQ_BASE(2), tid, g2);
    rwkv_seq_lstore(smem, tid, g0);
    __syncthreads();
    for (int s = 0; s < NC; s += 6) {
#define SEQ_SUB(u, GFREE, GNEXT) \
        if (s + (u) < NC) { \
            rwkv_seq_gload(p, SEQ_BASE(s + (u) + 3), tid, GFREE); \
            rwkv_seq_step(p, smem + (((u) & 1) ? SEQ_SLOT : 0), SEQ_BASE(s + (u)), wv, lane, X); \
            rwkv_seq_lstore(smem + (((u) & 1) ? 0 : SEQ_SLOT), tid, GNEXT); \
        } \
        __syncthreads();
        SEQ_SUB(0, g0, g1)
        SEQ_SUB(1, g1, g2)
        SEQ_SUB(2, g2, g0)
        SEQ_SUB(3, g0, g1)
        SEQ_SUB(4, g1, g2)
        SEQ_SUB(5, g2, g0)
#undef SEQ_SUB
    }
#undef SEQ_BASE
}
struct RoBuf { bf16x8 a[2]; bf16x8 b[4][2]; f32x4 y0[4]; };
__device__ __forceinline__ void rwkv_out_load(const P& p, int job, int wv, int lane, RoBuf& o) {
    const int q = lane >> 4, r = lane & 15;
    const size_t base = (size_t)job;
#pragma unroll
    for (int s2 = 0; s2 < 2; ++s2) {
        o.a[s2] = *(const bf16x8*)(p.QH + (base * 64 + 16 * wv + r) * 64 + s2 * 32 + q * 8);
#pragma unroll
        for (int nt = 0; nt < 4; ++nt) o.b[nt][s2] = *(const bf16x8*)(p.SN + (base * 64 + nt * 16 + r) * 64 + s2 * 32 + q * 8);
    }
#pragma unroll
    for (int nt = 0; nt < 4; ++nt) o.y0[nt] = *(const f32x4*)(p.Y0T + (((base * 4 + wv) * 4 + nt) * 64 + lane) * 4);
}
__device__ __forceinline__ void rwkv_out_compute(const P& p, int job, int wv, int lane, const RoBuf& o) {
    const int q = lane >> 4, r = lane & 15;
    const int d = job / (NC * RH), n = (job / RH) % NC, h = job % RH;
#pragma unroll
    for (int nt = 0; nt < 4; ++nt) {
        f32x4 acc = o.y0[nt];
        acc = MFMA16(o.a[0], o.b[nt][0], acc);
        acc = MFMA16(o.a[1], o.b[nt][1], acc);
#pragma unroll
        for (int e = 0; e < 4; ++e) {
            const int t = 16 * wv + 4 * q + e; const int tok = 64 * n + (d ? 63 - t : t);
            p.Y[((size_t)d * MTOT + tok) * RW + h * 64 + nt * 16 + r] = acc[e];
        }
    }
}
__device__ __forceinline__ void phase_rwkv_out(const P& p) {
    const int tid = otid(), lane = tid & 63, wv = tid >> 6;
    if (wv >= 4) return;
    const int G = gridDim.x, total = 2 * NC * RH;
    int job = obid();
    if (job >= total) return;
    RoBuf b0, b1;
    rwkv_out_load(p, job, wv, lane, b0);
    for (; job < total; job += 2 * G) {
        if (job + G < total) rwkv_out_load(p, job + G, wv, lane, b1);
        rwkv_out_compute(p, job, wv, lane, b0);
        if (job + G < total) {
            if (job + 2 * G < total) rwkv_out_load(p, job + 2 * G, wv, lane, b0);
            rwkv_out_compute(p, job + G, wv, lane, b1);
        }
    }
}

#define GL_QR 0
#define GL_KR 9216
#define GL_VT 18432
#define GL_QI 36864
#define GL_KI 46080
#define GL_AT 55296
#define GL_CUM 64512
#define GL_ALR 81920
#define GL_WA 86016
__device__ __forceinline__ void gla_load_qkv(const P& p, int n, int h, char* smem) {
    const int tid = otid();
    bf16_t* Qr = (bf16_t*)(smem + GL_QR); bf16_t* Kr = (bf16_t*)(smem + GL_KR); bf16_t* Vt = (bf16_t*)(smem + GL_VT);
    for (int c = tid; c < 512; c += NTHREADS) {
        const int row = c >> 3, part = c & 7; const int t = gla_tok(n, row);
        const u32x4 qv = *(const u32x4*)(p.Z + (size_t)t * ZLD + ZQ + h * 64 + part * 8);
        const u32x4 kv = *(const u32x4*)(p.Z + (size_t)t * ZLD + ZK + h * 64 + part * 8);
        u32x4 qs;
        qs.x = pack2bf(LO16(qv.x) * 0.125f, HI16(qv.x) * 0.125f);
        qs.y = pack2bf(LO16(qv.y) * 0.125f, HI16(qv.y) * 0.125f);
        qs.z = pack2bf(LO16(qv.z) * 0.125f, HI16(qv.z) * 0.125f);
        qs.w = pack2bf(LO16(qv.w) * 0.125f, HI16(qv.w) * 0.125f);
        *(u32x4*)(Qr + row * CH_ROW + part * 8) = qs;
        *(u32x4*)(Kr + row * CH_ROW + part * 8) = kv;
    }
    for (int c = tid; c < 1024; c += NTHREADS) {
        const int row = c >> 4, part = c & 15; const int t = gla_tok(n, row);
        const u32x4 vv = *(const u32x4*)(p.Z + (size_t)t * ZLD + ZV + h * 128 + part * 8);
        bf16_t* dst = Vt + (part * 8) * CH_ROW + row;
        dst[0 * CH_ROW] = (bf16_t)(vv.x & 0xFFFF); dst[1 * CH_ROW] = (bf16_t)(vv.x >> 16);
        dst[2 * CH_ROW] = (bf16_t)(vv.y & 0xFFFF); dst[3 * CH_ROW] = (bf16_t)(vv.y >> 16);
        dst[4 * CH_ROW] = (bf16_t)(vv.z & 0xFFFF); dst[5 * CH_ROW] = (bf16_t)(vv.z >> 16);
        dst[6 * CH_ROW] = (bf16_t)(vv.w & 0xFFFF); dst[7 * CH_ROW] = (bf16_t)(vv.w >> 16);
    }
}
__device__ __forceinline__ void gla_cum(const P& p, int l, int n, int h, int d, char* smem) {
    const int tid = otid();
    float* CUM = (float*)(smem + GL_CUM); float* ALR = (float*)(smem + GL_ALR); float* WA = (float*)(smem + GL_WA);
    for (int c = tid; c < 256; c += NTHREADS) {
        const int row = c >> 2, part = c & 3; const int t = gla_tok(n, row);
        const u32x2 a = *(const u32x2*)(p.Z + (size_t)t * ZLD + (d ? ZAB : ZAF) + part * 4);
        float* dst = ALR + row * 16 + part * 4;
        dst[0] = LO16(a.x); dst[1] = HI16(a.x); dst[2] = LO16(a.y); dst[3] = HI16(a.y);
    }
    for (int c = tid; c < 16 * 64 + 64; c += NTHREADS) {
        if (c < 1024) WA[c] = p.in[I_GLA_WA2][((size_t)(l * 2 + d) * 16 + (c >> 6)) * GLA_K + h * 64 + (c & 63)];
        else WA[c] = p.in[I_GLA_BA][(size_t)(l * 2 + d) * GLA_K + h * 64 + (c - 1024)];
    }
    __syncthreads();
    for (int idx = tid; idx < 4096; idx += NTHREADS) {
        const int i = idx >> 6, k = idx & 63;
        float a = WA[1024 + k];
#pragma unroll
        for (int r = 0; r < 16; ++r) a += ALR[i * 16 + r] * WA[r * 64 + k];
        CUM[i * 68 + k] = (fminf(a, 0.f) - flog_(1.0f + fexp_(-fabsf(a)))) * (1.0f / 16.0f);
    }
    __syncthreads();
    {
        const int k = tid & 63, seg = (tid >> 6) & 3;
        float v[16]; float run = 0.f;
        if (tid < 256) {
#pragma unroll
            for (int e = 0; e < 16; ++e) { const int pos = seg * 16 + e; const int i = d ? 63 - pos : pos; run += CUM[i * 68 + k]; v[e] = run; }
            ALR[seg * 64 + k] = run;
        }
        __syncthreads();
        if (tid < 256) {
            float off = 0.f;
            for (int s2 = 0; s2 < seg; ++s2) off += ALR[s2 * 64 + k];
#pragma unroll
            for (int e = 0; e < 16; ++e) { const int pos = seg * 16 + e; const int i = d ? 63 - pos : pos; CUM[i * 68 + k] = v[e] + off; }
        }
    }
    __syncthreads();
}
__device__ __forceinline__ void phase_gla_kv(const P& p, int l, char* smem) {
    const int tid = otid(), lane = tid & 63, wv = tid >> 6, q = lane >> 4, r = lane & 15;
    bf16_t* Kr = (bf16_t*)(smem + GL_KR); bf16_t* Vt = (bf16_t*)(smem + GL_VT); bf16_t* KdT = (bf16_t*)(smem + GL_KI);
    float* CUM = (float*)(smem + GL_CUM);
    for (int job = (obid() + (int)gridDim.x - 64 % (int)gridDim.x) % (int)gridDim.x; job < NC * GH; job += gridDim.x) {
        const int n = job / GH, h = job % GH;
        __syncthreads();
        gla_load_qkv(p, n, h, smem);
        for (int d = 0; d < 2; ++d) {
            gla_cum(p, l, n, h, d, smem);
            const int li = d ? 0 : 63;
            for (int idx = tid; idx < 4096; idx += NTHREADS) {
                const int i = idx >> 6, k = idx & 63;
                KdT[k * CH_ROW + i] = f2bf(bf2f(Kr[i * CH_ROW + k]) * fexp_(CUM[li * 68 + k] - CUM[i * 68 + k]));
            }
            if (tid < 64) p.DEC[((size_t)(d * NC + n) * GH + h) * 64 + tid] = fexp_(CUM[li * 68 + tid]);
            __syncthreads();
            float* kvt = p.KV + ((size_t)(d * NC + n) * GH + h) * 8192;
            for (int mt = wv; mt < 4; mt += NTHREADS / 64) {
                f32x4 acc[1][8];
#pragma unroll
                for (int nt = 0; nt < 8; ++nt) acc[0][nt] = (f32x4){0.f, 0.f, 0.f, 0.f};
                lds_mm<1, 8>(KdT, 16 * mt, Vt, 0, acc);
#pragma unroll
                for (int nt = 0; nt < 8; ++nt) *(f32x4*)(kvt + (size_t)(nt * 16 + r) * 64 + 16 * mt + 4 * q) = acc[0][nt];
            }
            __syncthreads();
        }
    }
    __syncthreads();
}
__device__ __forceinline__ void gla_scan_job(const P& p, int job) {
    const int base = job * NTHREADS + otid();
    const int d = base / (GH * 8192), h = (base / 8192) % GH, e = base % 8192;
    const float* __restrict__ kvp = p.KV; const float* __restrict__ decp = p.DEC; bf16_t* __restrict__ sp = p.SP;
    float S = 0.f;
    for (int s = 0; s < NC; s += 4) {
        float kv[4], dc[4]; size_t oo[4];
#pragma unroll
        for (int u = 0; u < 4; ++u) {
            const int n = chunk_order(d, (s + u < NC) ? s + u : NC - 1);
            oo[u] = ((size_t)(d * NC + n) * GH + h);
            kv[u] = kvp[oo[u] * 8192 + e]; dc[u] = decp[oo[u] * 64 + (e & 63)];
        }
#pragma unroll
        for (int u = 0; u < 4; ++u) if (s + u < NC) { sp[oo[u] * 8192 + e] = f2bf(S); S = dc[u] * S + kv[u]; }
    }
}
__device__ __forceinline__ void phase_gla_out(const P& p, int l, char* smem) {
    const int tid = otid(), lane = tid & 63, wv = tid >> 6, q = lane >> 4, r = lane & 15;
    bf16_t* Qr = (bf16_t*)(smem + GL_QR); bf16_t* Kr = (bf16_t*)(smem + GL_KR); bf16_t* Vt = (bf16_t*)(smem + GL_VT);
    bf16_t* Qi = (bf16_t*)(smem + GL_QI); bf16_t* Ki = (bf16_t*)(smem + GL_KI); bf16_t* At = (bf16_t*)(smem + GL_AT);
    float* CUM = (float*)(smem + GL_CUM);
    for (int job = (obid() + (int)gridDim.x - 64 % (int)gridDim.x) % (int)gridDim.x; job < NC * GH; job += gridDim.x) {
        const int n = job / GH, h = job % GH;
        __syncthreads();
        gla_load_qkv(p, n, h, smem);
        f32x4 o[1][8];
#pragma unroll
        for (int nt = 0; nt < 8; ++nt) o[0][nt] = (f32x4){0.f, 0.f, 0.f, 0.f};
        for (int d = 0; d < 2; ++d) {
            gla_cum(p, l, n, h, d, smem);
            for (int idx = tid; idx < 4096; idx += NTHREADS) {
                const int i = idx >> 6, k = idx & 63; const float c = CUM[i * 68 + k];
                Qi[i * CH_ROW + k] = f2bf(bf2f(Qr[i * CH_ROW + k]) * fexp_(c));
                Ki[i * CH_ROW + k] = f2bf(bf2f(Kr[i * CH_ROW + k]) * fexp_(-c));
            }
            __syncthreads();
            if (wv < 4) {
                f32x4 a[1][4];
#pragma unroll
                for (int nt = 0; nt < 4; ++nt) a[0][nt] = (f32x4){0.f, 0.f, 0.f, 0.f};
                lds_mm<1, 4>(Qi, 16 * wv, Ki, 0, a);
#pragma unroll
                for (int nt = 0; nt < 4; ++nt)
#pragma unroll
                    for (int e = 0; e < 4; ++e) {
                        const int i = 16 * wv + 4 * q + e, j = nt * 16 + r;
                        const bool ok = d ? (j >= i) : (j <= i);
                        At[i * CH_ROW + j] = f2bf(ok ? a[0][nt][e] : 0.f);
                    }
                WAVE_SYNC();
                lds_mm<1, 8>(At, 16 * wv, Vt, 0, o);
                const bf16_t* sp = p.SP + ((size_t)(d * NC + n) * GH + h) * 8192;
#pragma unroll
                for (int s2 = 0; s2 < 2; ++s2) {
                    const bf16x8 af = *(const bf16x8*)(Qi + (16 * wv + r) * CH_ROW + s2 * 32 + q * 8);
#pragma unroll
                    for (int nt = 0; nt < 8; ++nt) {
                        const bf16x8 bfr = *(const bf16x8*)(sp + (size_t)(nt * 16 + r) * 64 + s2 * 32 + q * 8);
                        o[0][nt] = MFMA16(af, bfr, o[0][nt]);
                    }
                }
            }
            __syncthreads();
        }
        if (wv < 4) {
#pragma unroll
            for (int nt = 0; nt < 8; ++nt)
#pragma unroll
                for (int e = 0; e < 4; ++e) {
                    const int t = gla_tok(n, 16 * wv + 4 * q + e);
                    p.OGLA[(size_t)t * GLA_V + h * 128 + nt * 16 + r] = o[0][nt][e];
                }
        }
    }
    __syncthreads();
}

#define S5_XH_OFF (2 * 64 * 132 * 4)
#define S5_XL_OFF (S5_XH_OFF + 64 * 136 * 2)
#define S5_CT_OFF (S5_XL_OFF + 64 * 136 * 2)
__device__ __forceinline__ void phase_s5_pass(const P& p, int l, char* smem, bool with_out) {
    const int tid = otid(), lane = tid & 63, wv = tid >> 6, q = lane >> 4, r = lane & 15;
    float* BU = (float*)smem; bf16_t* XH = (bf16_t*)(smem + S5_XH_OFF); bf16_t* XL = (bf16_t*)(smem + S5_XL_OFF); bf16_t* CTp = (bf16_t*)(smem + S5_CT_OFF);
    const int dW = (wv >> 1) & 1, ntb = (wv & 1) * 4;
    const int dS = (tid >> 6) & 1, st = tid & 63;
    bf16x8 bhi[4], blo[4];
    float are = 0.f, aim = 0.f, dco = 0.f;
    int cur_g = -1;
    const bf16x8 zero8 = {0, 0, 0, 0, 0, 0, 0, 0};
    bf16x8 a_cur[4]; float2 car_cur = {0.f, 0.f};
#define S5_FETCH(JOB, A, CAR) { const int n_ = (JOB) / SG, g_ = (JOB) % SG; \
        if (wv < 4) { _Pragma("unroll") for (int mt = 0; mt < 4; ++mt) A[mt] = (q < 2) ? *(const bf16x8*)(p.Z + (size_t)(n_ * 64 + 16 * mt + r) * ZLD + ZS5 + g_ * 16 + 8 * q) : zero8; } \
        if (with_out && tid < 128) CAR = *(const float2*)(p.S5CAR + ((((size_t)dS * NC + n_) * SG + g_) * 64 + st) * 2); }
    const int job0 = (obid() + (int)gridDim.x - 128 % (int)gridDim.x) % (int)gridDim.x;
    if (job0 < NC * SG) S5_FETCH(job0, a_cur, car_cur);
    for (int job = job0; job < NC * SG; job += gridDim.x) {
        const int n = job / SG, g = job % SG;
        __syncthreads();
        if (g != cur_g) {
            cur_g = g;
            if (wv < 4) {
#pragma unroll
                for (int jn = 0; jn < 4; ++jn) {
                    const int kk = 16 * (ntb + jn) + r; const size_t ci = ((size_t)dW * SG + g) * 64 + (kk >> 1);
                    float f[8], lo[8];
#pragma unroll
                    for (int e = 0; e < 8; ++e) f[e] = (q < 2) ? p.S5BB[(ci * 16 + 8 * q + e) * 2 + (kk & 1)] : 0.f;
                    const u32x4 hv = pack8(f);
                    float hf[8]; unpack8(hv, hf);
#pragma unroll
                    for (int e = 0; e < 8; ++e) lo[e] = f[e] - hf[e];
                    bhi[jn] = __builtin_bit_cast(bf16x8, hv); blo[jn] = __builtin_bit_cast(bf16x8, pack8(lo));
                }
            }
            if (tid < 128) { const size_t ci = ((size_t)dS * SG + g) * 64 + st; are = p.S5A[ci * 2]; aim = p.S5A[ci * 2 + 1]; }
            if (with_out) {
                for (int idx = tid; idx < 16 * 128; idx += NTHREADS) {
                    const int c = idx >> 7, kk = idx & 127;
                    const float v = (kk & 1) ? -p.in[I_S5CIM][((size_t)l * SG + g) * 1024 + c * 64 + (kk >> 1)] : p.in[I_S5CRE][((size_t)l * SG + g) * 1024 + c * 64 + (kk >> 1)];
                    CTp[c * 136 + kk] = f2bf(v);
                }
                dco = p.in[I_S5D][(size_t)l * SW + g * 16 + r];
            }
        }
        float xr = car_cur.x, xi = car_cur.y;
        const size_t eo = (((size_t)dS * NC + n) * SG + g) * 64 + st;
        unsigned short uu[4] = {0, 0, 0, 0};
        if (with_out && wv < 4) {
#pragma unroll
            for (int e = 0; e < 4; ++e) uu[e] = p.Z[(size_t)(n * 64 + 16 * wv + 4 * q + e) * ZLD + ZS5 + g * 16 + r];
        }
        if (wv < 4) {
#pragma unroll
            for (int mt = 0; mt < 4; ++mt) {
                const bf16x8 a = a_cur[mt];
#pragma unroll
                for (int jn = 0; jn < 4; ++jn) {
                    f32x4 acc = {0.f, 0.f, 0.f, 0.f};
                    acc = MFMA16(a, bhi[jn], acc);
                    acc = MFMA16(a, blo[jn], acc);
#pragma unroll
                    for (int e = 0; e < 4; ++e) BU[(dW * 64 + 16 * mt + 4 * q + e) * 132 + 16 * (ntb + jn) + r] = acc[e];
                }
            }
        }
        if (job + (int)gridDim.x < NC * SG) S5_FETCH(job + (int)gridDim.x, a_cur, car_cur);
        __syncthreads();
        if (tid < 128) {
            float2* bp0 = (float2*)(BU + (dS * 64 + (dS ? 63 : 0)) * 132 + st * 2);
#define S5_SCAN(SGN) { _Pragma("unroll 1") for (int ib = 0; ib < 4; ++ib) { float2 bv[16]; \
                _Pragma("unroll") for (int u = 0; u < 16; ++u) bv[u] = bp0[(SGN) * (ib * 16 + u) * 66]; \
                _Pragma("unroll") for (int u = 0; u < 16; ++u) { \
                    const float nr = are * xr - aim * xi + bv[u].x, ni = are * xi + aim * xr + bv[u].y; xr = nr; xi = ni; \
                    if (with_out) { float2 o; o.x = xr; o.y = xi; bp0[(SGN) * (ib * 16 + u) * 66] = o; } } } }
            if (dS) S5_SCAN(-1) else S5_SCAN(1)
            if (!with_out) { float2 o; o.x = xr; o.y = xi; *(float2*)(p.S5END + eo * 2) = o; }
        }
        if (with_out) {
            __syncthreads();
            for (int cidx = tid; cidx < 64 * 16; cidx += NTHREADS) {
                const int i = cidx >> 4, k0 = (cidx & 15) * 8;
                float a[8], b[8], lo[8];
                load8f(BU + (0 * 64 + i) * 132 + k0, a); load8f(BU + (1 * 64 + i) * 132 + k0, b);
#pragma unroll
                for (int e = 0; e < 8; ++e) a[e] += b[e];
                const u32x4 hv = pack8(a);
                float hf[8]; unpack8(hv, hf);
#pragma unroll
                for (int e = 0; e < 8; ++e) lo[e] = a[e] - hf[e];
                *(u32x4*)(XH + i * 136 + k0) = hv; *(u32x4*)(XL + i * 136 + k0) = pack8(lo);
            }
            __syncthreads();
            if (wv < 4) {
                f32x4 acc = {0.f, 0.f, 0.f, 0.f};
#pragma unroll
                for (int ks = 0; ks < 4; ++ks) {
                    const bf16x8 ah = *(const bf16x8*)(XH + (16 * wv + r) * 136 + ks * 32 + q * 8), al = *(const bf16x8*)(XL + (16 * wv + r) * 136 + ks * 32 + q * 8);
                    const bf16x8 b = *(const bf16x8*)(CTp + r * 136 + ks * 32 + q * 8);
                    acc = MFMA16(ah, b, acc);
                    acc = MFMA16(al, b, acc);
                }
#pragma unroll
                for (int e = 0; e < 4; ++e) {
                    const int i = 16 * wv + 4 * q + e;
                    const float u = bf2f(uu[e]);
                    p.GY[(size_t)(n * 64 + i) * SW + g * 16 + r] = f2bf(geluf_(acc[e] + dco * u));
                }
            }
        }
    }
    __syncthreads();
}
__device__ __forceinline__ void s5_carry_job(const P& p, int job) {
    const int base = job * NTHREADS + otid();
    if (base >= 2 * SG * 64) return;
    const int d = base / (SG * 64), g = (base / 64) % SG, st = base % 64;
    const size_t ci = ((size_t)d * SG + g) * 64 + st;
    float ar = p.S5A[ci * 2], ai = p.S5A[ci * 2 + 1];
    for (int i = 0; i < 6; ++i) { const float nr = ar * ar - ai * ai, ni = 2.f * ar * ai; ar = nr; ai = ni; }
    const float2* __restrict__ endp = (const float2*)p.S5END; float2* __restrict__ carp = (float2*)p.S5CAR;
    float cr = 0.f, cim = 0.f;
    for (int s = 0; s < NC; s += 4) {
        float2 ev[4]; size_t eo[4];
#pragma unroll
        for (int u = 0; u < 4; ++u) {
            const int n = chunk_order(d, (s + u < NC) ? s + u : NC - 1);
            eo[u] = (((size_t)d * NC + n) * SG + g) * 64 + st;
            ev[u] = endp[eo[u]];
        }
#pragma unroll
        for (int u = 0; u < 4; ++u) if (s + u < NC) {
            float2 c; c.x = cr; c.y = cim; carp[eo[u]] = c;
            const float nr = ar * cr - ai * cim + ev[u].x, ni = ar * cim + ai * cr + ev[u].y;
            cr = nr; cim = ni;
        }
    }
}

__device__ __forceinline__ void phase_side_elem(const P& p, int l) {
    const int lane = otid() & 63;
    const int gw = (obid() * NTHREADS + otid()) >> 6, nw = (gridDim.x * NTHREADS) >> 6;
    const bool actg = lane * 8 < GLA_V, actr = lane * 8 < RW;
    float gng[8], lnw[8], lnb[8];
#pragma unroll
    for (int e = 0; e < 8; ++e) { gng[e] = 0.f; lnw[e] = 0.f; lnb[e] = 0.f; }
    if (actg) load8f(p.in[I_GLA_NG] + (size_t)l * 128 + ((lane * 8) & 127), gng);
    if (actr) { load8f(p.in[I_RLNW] + (size_t)l * RW + lane * 8, lnw); load8f(p.in[I_RLNB] + (size_t)l * RW + lane * 8, lnb); }
    for (int t = gw; t < MTOT; t += nw) {
        float og[8], zo[8], y0[8], y1[8], vv[8];
        const u32x4 z4 = {0u, 0u, 0u, 0u};
#pragma unroll
        for (int e = 0; e < 8; ++e) { og[e] = 0.f; y0[e] = 0.f; y1[e] = 0.f; }
        if (actg) load8f(p.OGLA + (size_t)t * GLA_V + lane * 8, og);
        unpack8(actg ? *(const u32x4*)(p.Z + (size_t)t * ZLD + ZOG + lane * 8) : z4, zo);
        if (actr) { load8f(p.Y + (size_t)t * RW + lane * 8, y0); load8f(p.Y + ((size_t)MTOT + t) * RW + lane * 8, y1); }
        unpack8(actr ? *(const u32x4*)(p.V + (size_t)t * RW + lane * 8) : z4, vv);
        float g2v[8]; unpack8(actr ? *(const u32x4*)(p.G2B + (size_t)t * RW + lane * 8) : z4, g2v);
        const int hh = (lane * 8) >> 6;
        const float bon = actr ? (p.BONUS[(size_t)t * RH + hh] + p.BONUS[((size_t)MTOT + t) * RH + hh]) : 0.f;
        float ss = 0.f;
#pragma unroll
        for (int e = 0; e < 8; ++e) ss += og[e] * og[e];
        ss += __shfl_xor(ss, 1, 64); ss += __shfl_xor(ss, 2, 64); ss += __shfl_xor(ss, 4, 64); ss += __shfl_xor(ss, 8, 64);
        const float rstd = rsqrtf(ss * (1.0f / 128.f) + 1e-6f);
        float br[8];
#pragma unroll
        for (int e = 0; e < 8; ++e) br[e] = og[e] * rstd * gng[e] * siluf_(zo[e]);
        if (actg) *(u32x4*)(p.BR + (size_t)t * 3 * BW + lane * 8) = pack8(br);
        float y[8]; float sm = 0.f;
#pragma unroll
        for (int e = 0; e < 8; ++e) { y[e] = y0[e] + y1[e]; sm += y[e]; }
        sm += __shfl_xor(sm, 1, 64); sm += __shfl_xor(sm, 2, 64); sm += __shfl_xor(sm, 4, 64);
        const float mu = sm * (1.0f / 64.f);
        float sv = 0.f;
#pragma unroll
        for (int e = 0; e < 8; ++e) { y[e] -= mu; sv += y[e] * y[e]; }
        sv += __shfl_xor(sv, 1, 64); sv += __shfl_xor(sv, 2, 64); sv += __shfl_xor(sv, 4, 64);
        const float rs = rsqrtf(sv * (1.0f / 64.f) + 64e-5f);
        float yn[8];
#pragma unroll
        for (int e = 0; e < 8; ++e) yn[e] = y[e] * rs * lnw[e] + lnb[e] + bon * vv[e];
#pragma unroll
        for (int e = 0; e < 8; ++e) yn[e] *= g2v[e];
        if (actr) *(u32x4*)(p.BR + (size_t)t * 3 * BW + BW + lane * 8) = pack8(yn);
    }
}

__device__ __forceinline__ void g2_gemm_job(const P& p, int job, char* smem) {
    const int ntn = NPAD(RW) / 128;
    gemm_tile_run<4, 8>(p.WT_G2, 128, (size_t)NPAD(RW) * 128 * 2, p.GS, 128, (size_t)MTOT * 128 * 2, 128, (job % ntn) * 128, (job / ntn) * 256, (bf16_t*)smem, NoPre(),
        [&](int, int, int m, int n, const f32x4 v) { if (n < RW) *(u32x2*)(p.G2B + (size_t)m * RW + n) = pack4(v[0], v[1], v[2], v[3]); });
}
#define G2_JOBS ((MTOT / 256) * (NPAD(RW) / 128))
__device__ __forceinline__ void phase_glu_gemm(const P& p, int l, char* smem) {
    gemm_phase<4>(p.WT_GLU, SW, (size_t)NPAD(2 * SW) * SW * 2, p.GY, SW, (size_t)MTOT * SW * 2, SW, 2 * SW, (bf16_t*)smem, NoPre(), NoPre(),
        [&](int, int, int m, int n, const f32x4 v) {
            *(unsigned*)(p.BR + (size_t)m * 3 * BW + 2 * BW + (n >> 1)) = pack2bf(v[0] * sigmoidf_(v[1]), v[2] * sigmoidf_(v[3]));
        });
}
__device__ __forceinline__ void phase_merge(const P& p, int l, char* smem) {
    const int ntn = D_MODEL / 128, ntm = (MTOT - 256) / 256;
    auto run = [&](auto mi_tag, int n0, int m0) {
        constexpr int MI = decltype(mi_tag)::value;
        f32x4 macc[4][MI];
#pragma unroll
        for (int i = 0; i < 4; ++i)
#pragma unroll
            for (int j = 0; j < MI; ++j) macc[i][j] = (f32x4){0.f, 0.f, 0.f, 0.f};
        const int lane = otid() & 63, wave = otid() >> 6;
        for (int b = 0; b < 3; ++b) {
            f32x4 acc[4][MI];
#pragma unroll
            for (int i = 0; i < 4; ++i)
#pragma unroll
                for (int j = 0; j < MI; ++j) acc[i][j] = (f32x4){0.f, 0.f, 0.f, 0.f};
            mfma_gemm_tile_t<4, MI>(p.WT_BR + (size_t)b * D_MODEL * BW, BW, (size_t)D_MODEL * BW * 2, p.BR + b * BW, 3 * BW, (size_t)MTOT * 3 * BW * 2 - b * BW * 2, BW, n0, m0, (bf16_t*)smem, acc);
#pragma unroll
            for (int ni = 0; ni < 4; ++ni)
#pragma unroll
                for (int mi = 0; mi < MI; ++mi) {
                    const int n = n0 + (wave >> 1) * 64 + ni * 16 + (lane >> 4) * 4, m = m0 + (wave & 1) * 16 * MI + mi * 16 + (lane & 15);
                    const u32x2 g = *(const u32x2*)(p.ZGT + ((((size_t)(m >> 4) * (3 * D_MODEL / 16) + ((b * D_MODEL + n) >> 4)) * 64 + lane) * 4));
                    macc[ni][mi][0] += LO16(g.x) * acc[ni][mi][0]; macc[ni][mi][1] += HI16(g.x) * acc[ni][mi][1];
                    macc[ni][mi][2] += LO16(g.y) * acc[ni][mi][2]; macc[ni][mi][3] += HI16(g.y) * acc[ni][mi][3];
                }
        }
#pragma unroll
        for (int ni = 0; ni < 4; ++ni)
#pragma unroll
            for (int mi = 0; mi < MI; ++mi) {
                const int n = n0 + (wave >> 1) * 64 + ni * 16 + (lane >> 4) * 4, m = m0 + (wave & 1) * 16 * MI + mi * 16 + (lane & 15);
                *(u32x2*)(p.M + (size_t)m * D_MODEL + n) = pack4(macc[ni][mi][0], macc[ni][mi][1], macc[ni][mi][2], macc[ni][mi][3]);
            }
    };
    for (int it = 0;; ++it) {
        int mt_, nt_; if (!tile_map(it, ntm, ntn, (ntn >= 8) ? 4 : 8, mt_, nt_)) break;
        run(std::integral_constant<int, 8>(), nt_ * 128, mt_ * 256);
    }
    for (int job = obid(); job < 4 * ntn; job += gridDim.x) run(std::integral_constant<int, 2>(), (job >> 2) * 128, MTOT - 256 + (job & 3) * 64);
}

__device__ __forceinline__ void phase_outproj(const P& p, int l, char* smem) {
    gemm_phase<4>(p.WT_OUT, D_MODEL, (size_t)D_MODEL * D_MODEL * 2, p.M, D_MODEL, (size_t)MTOT * D_MODEL * 2, D_MODEL, D_MODEL, (bf16_t*)smem, NoPre(), NoPre(),
        [&](int, int, int m, int n, const f32x4 v) {
            const float* g1 = p.MOD + (size_t)(l * 2 + (m >= CTX ? 1 : 0)) * 6 * D_MODEL + 2 * D_MODEL + n;
            float4* xp = (float4*)(p.X + (size_t)m * D_MODEL + n); float4 x = *xp;
            x.x += g1[0] * v[0]; x.y += g1[1] * v[1]; x.z += g1[2] * v[2]; x.w += g1[3] * v[3]; *xp = x;
        });
}

__device__ __forceinline__ void store_q_hilo(const P& p, int m, int n, const f32x4 v) {
    const bf16_t h0 = f2bf(v[0]), h1 = f2bf(v[1]), h2 = f2bf(v[2]), h3 = f2bf(v[3]);
    u32x2 hv; hv.x = (unsigned)h0 | ((unsigned)h1 << 16); hv.y = (unsigned)h2 | ((unsigned)h3 << 16);
    *(u32x2*)(p.QHI + (size_t)m * PQ + n) = hv;
    *(u32x2*)(p.QLO + (size_t)m * PQ + n) = pack4(v[0] - bf2f(h0), v[1] - bf2f(h1), v[2] - bf2f(h2), v[3] - bf2f(h3));
}
__device__ __forceinline__ void phase_peer_q(const P& p, int l, char* smem) {
    gemm_phase<4>(p.WT_Q, D_MODEL, (size_t)PQ * D_MODEL * 2, p.H, D_MODEL, (size_t)MTOT * D_MODEL * 2, D_MODEL, PQ, (bf16_t*)smem, NoPre(), NoPre(),
        [&](int, int, int m, int n, const f32x4 v) { store_q_hilo(p, m, n, v); });
}

#define TK_ROW 129
__device__ __forceinline__ unsigned tk_key(float f, unsigned lowmask, unsigned low) {
    unsigned u = __builtin_bit_cast(unsigned, f);
    u ^= (u & 0x80000000u) ? 0xFFFFFFFFu : 0x80000000u;
    return (u & ~lowmask) | low;
}
#define TK_INSERT(lv, xk) { unsigned x_ = (xk); _Pragma("unroll") for (int z_ = 0; z_ < 16; ++z_) { const unsigned hi_ = lv[z_] > x_ ? lv[z_] : x_; x_ = lv[z_] > x_ ? x_ : lv[z_]; lv[z_] = hi_; } }
__device__ __forceinline__ void phase_peer_topk(const P& p, int l, char* smem) {
    const int tid = otid(), lane = tid & 63, wv = tid >> 6, q = lane >> 4, r = lane & 15;
    float* sc = (float*)smem + wv * (64 * TK_ROW);
    const int gw = (obid() * NTHREADS + tid) >> 6, nw = (gridDim.x * NTHREADS) >> 6;
    const float NEG = -3.0e38f;
    for (int job = gw; job < (MTOT / 32) * PH; job += nw) {
        const int t0 = (job / PH) * 32, h = job % PH;
#pragma unroll
        for (int sd = 0; sd < 2; ++sd) {
            f32x4 acc[2][8];
#pragma unroll
            for (int mt = 0; mt < 2; ++mt)
#pragma unroll
                for (int nt = 0; nt < 8; ++nt) acc[mt][nt] = (f32x4){0.f, 0.f, 0.f, 0.f};
#pragma unroll
            for (int ks = 0; ks < 4; ++ks) {
                bf16x8 ah[2], al[2];
#pragma unroll
                for (int mt = 0; mt < 2; ++mt) {
                    const size_t qo = (size_t)(t0 + mt * 16 + r) * PQ + h * 256 + sd * 128 + ks * 32 + q * 8;
                    ah[mt] = *(const bf16x8*)(p.QHI + qo); al[mt] = *(const bf16x8*)(p.QLO + qo);
                }
#pragma unroll
                for (int nt = 0; nt < 8; ++nt) {
                    const size_t ko = ((size_t)(h * 2 + sd) * 128 + nt * 16 + r) * 128 + ks * 32 + q * 8;
                    const bf16x8 bh = *(const bf16x8*)(p.KHI + ko), bl = *(const bf16x8*)(p.KLO + ko);
#pragma unroll
                    for (int mt = 0; mt < 2; ++mt) {
                        acc[mt][nt] = MFMA16(ah[mt], bh, acc[mt][nt]);
                        acc[mt][nt] = MFMA16(al[mt], bh, acc[mt][nt]);
                        acc[mt][nt] = MFMA16(ah[mt], bl, acc[mt][nt]);
                    }
                }
            }
#pragma unroll
            for (int mt = 0; mt < 2; ++mt)
#pragma unroll
                for (int nt = 0; nt < 8; ++nt)
#pragma unroll
                    for (int e = 0; e < 4; ++e) sc[(sd * 32 + mt * 16 + 4 * q + e) * TK_ROW + nt * 16 + r] = acc[mt][nt][e];
        }
        WAVE_SYNC();
        unsigned lv[16];
#pragma unroll
        for (int z = 0; z < 16; ++z) lv[z] = 0u;
        {
            const float* row = sc + lane * TK_ROW;
#pragma unroll 4
            for (int k = 0; k < 128; ++k) TK_INSERT(lv, tk_key(row[k], 0x7Fu, (unsigned)(127 - k)));
        }
        float lvv[16]; int li[16];
        {
            const float* row = sc + lane * TK_ROW;
#pragma unroll
            for (int z = 0; z < 16; ++z) { li[z] = 127 - (int)(lv[z] & 0x7Fu); lvv[z] = row[li[z]]; }
        }
        WAVE_SYNC();
        {
            float* row = sc + lane * TK_ROW;
#pragma unroll
            for (int z = 0; z < 16; ++z) { row[z] = lvv[z]; ((int*)row)[16 + z] = li[z]; }
        }
        WAVE_SYNC();
        const float* r1 = sc + (lane & 31) * TK_ROW; const float* r2 = sc + (32 + (lane & 31)) * TK_ROW;
        unsigned tk[16];
#pragma unroll
        for (int z = 0; z < 16; ++z) tk[z] = 0u;
        for (int i = 0; i < 16; ++i) {
            const float a = r1[i];
            const int nj = 16 / (i + 1);
            for (int j = 0; j < nj; ++j) TK_INSERT(tk, tk_key(a + r2[j], 0xFFu, (unsigned)(255 - (i * 16 + j))));
        }
        int tc[16];
#pragma unroll
        for (int z = 0; z < 16; ++z) tc[z] = 255 - (int)(tk[z] & 0xFFu);
        if (lane < 32) {
            float vals[16]; float mx = 0.f; float ssum = 0.f;
#pragma unroll
            for (int z = 0; z < 16; ++z) { vals[z] = r1[tc[z] >> 4] + r2[tc[z] & 15]; if (z == 0) mx = vals[0]; vals[z] = fexp_(vals[z] - mx); ssum += vals[z]; }
            const float inv = 1.0f / ssum;
            const size_t o = (size_t)(t0 + lane) * PH * 16 + h * 16;
#pragma unroll
            for (int z = 0; z < 16; ++z) {
                const int ex_ = ((const int*)r1)[16 + (tc[z] >> 4)] * 128 + ((const int*)r2)[16 + (tc[z] & 15)];
                p.IDX[o + z] = ex_;
                p.G[o + z] = vals[z] * inv * p.VSC[ex_];
                p.GU[o + z] = p.USC[ex_];
            }
        }
        WAVE_SYNC();
    }
}

#define PEER_CONV_JOBS (2 * NEXP / 4)
__device__ __forceinline__ void peer_conv_job(const P& p, int l, int job) {
    const int tid = otid(), lane = tid & 63, wv = tid >> 6;
    if (wv >= 4) return;
    const int rowg = job * 4 + wv; const int which = rowg / NEXP, row = rowg % NEXP;
    const float* src = p.in[which ? I_PV : I_PU] + ((size_t)l * NEXP + row) * D_MODEL + lane * 16;
    const bool act = lane * 16 < D_MODEL;
    float v[16]; float amax = 0.f;
#pragma unroll
    for (int c = 0; c < 4; ++c) {
        float4 a; a.x = 0.f; a.y = 0.f; a.z = 0.f; a.w = 0.f;
        if (act) a = *(const float4*)(src + c * 4);
        v[c * 4 + 0] = a.x; v[c * 4 + 1] = a.y; v[c * 4 + 2] = a.z; v[c * 4 + 3] = a.w;
        amax = fmaxf(amax, fmaxf(fmaxf(fabsf(a.x), fabsf(a.y)), fmaxf(fabsf(a.z), fabsf(a.w))));
    }
#pragma unroll
    for (int m = 32; m >= 1; m >>= 1) amax = fmaxf(amax, __shfl_xor(amax, m, 64));
    int ex = 0;
    if (amax > 0.f) ex = 7 - (int)((__builtin_bit_cast(unsigned, amax) >> 23) & 0xFF) + 127;
    ex = ex < -100 ? -100 : (ex > 100 ? 100 : ex);
    const float sc = __builtin_bit_cast(float, (unsigned)(ex + 127) << 23), isc = __builtin_bit_cast(float, (unsigned)(127 - ex) << 23);
    u32x4 o;
    int w0 = 0, w1 = 0, w2 = 0, w3 = 0;
    w0 = CVT_PK_FP8(v[0] * sc, v[1] * sc, w0, false); w0 = CVT_PK_FP8(v[2] * sc, v[3] * sc, w0, true);
    w1 = CVT_PK_FP8(v[4] * sc, v[5] * sc, w1, false); w1 = CVT_PK_FP8(v[6] * sc, v[7] * sc, w1, true);
    w2 = CVT_PK_FP8(v[8] * sc, v[9] * sc, w2, false); w2 = CVT_PK_FP8(v[10] * sc, v[11] * sc, w2, true);
    w3 = CVT_PK_FP8(v[12] * sc, v[13] * sc, w3, false); w3 = CVT_PK_FP8(v[14] * sc, v[15] * sc, w3, true);
    o.x = (unsigned)w0; o.y = (unsigned)w1; o.z = (unsigned)w2; o.w = (unsigned)w3;
    unsigned char* dst = (which ? p.V8 : p.U8) + (size_t)row * D_MODEL + lane * 16;
    if (act) *(u32x4*)dst = o;
    if (lane == 0) (which ? p.VSC : p.USC)[row] = isc;
}
#define GE 4
struct GBuf { u32x4 u[GE]; u32x4 v[GE]; float gu; float gv; };
__device__ __forceinline__ void gather_load(const P& p, GBuf& b, int g, int idx0, int idx1, float g0, float g1, float u0, float u1, int lane) {
    const bool act = lane * 16 < D_MODEL;
#pragma unroll
    for (int q = 0; q < GE; ++q) {
        const int k = g * GE + q;
        const int ei = __shfl((k < 64) ? idx0 : idx1, k & 63, 64);
        b.u[q] = act ? *(const u32x4*)(p.U8 + (size_t)ei * D_MODEL + lane * 16) : (u32x4){0u, 0u, 0u, 0u};
        b.v[q] = act ? *(const u32x4*)(p.V8 + (size_t)ei * D_MODEL + lane * 16) : (u32x4){0u, 0u, 0u, 0u};
    }
    const int km = g * GE + ((lane >> 4) & 3);
    b.gv = __shfl((km < 64) ? g0 : g1, km & 63, 64);
    b.gu = __shfl((km < 64) ? u0 : u1, km & 63, 64);
}
__device__ __forceinline__ void gather_compute(const GBuf& b, const float (&hv)[16], float (&acc)[16], int lane) {
    float dt[GE];
#pragma unroll
    for (int q = 0; q < GE; ++q) {
        float d = 0.f;
#pragma unroll
        for (int c = 0; c < 4; ++c) {
            const f32x2 lo = CVT_PK_F32_FP8((int)b.u[q][c], false), hi = CVT_PK_F32_FP8((int)b.u[q][c], true);
            d += hv[c * 4 + 0] * lo.x + hv[c * 4 + 1] * lo.y + hv[c * 4 + 2] * hi.x + hv[c * 4 + 3] * hi.y;
        }
        dt[q] = d;
    }
    float r2[2], r1;
    {
        const bool up = (lane & 32) != 0;
#pragma unroll
        for (int q = 0; q < 2; ++q) { const float keep = up ? dt[2 + q] : dt[q], send = up ? dt[q] : dt[2 + q]; r2[q] = keep + __shfl_xor(send, 32, 64); }
    }
    {
        const bool up = (lane & 16) != 0;
        const float keep = up ? r2[1] : r2[0], send = up ? r2[0] : r2[1];
        r1 = keep + __shfl_xor(send, 16, 64);
    }
    r1 += __shfl_xor(r1, 8, 64); r1 += __shfl_xor(r1, 4, 64); r1 += __shfl_xor(r1, 2, 64); r1 += __shfl_xor(r1, 1, 64);
    const float coef_mine = b.gv * geluf_(r1 * b.gu);
#pragma unroll
    for (int q = 0; q < GE; ++q) {
        const float coef = __shfl(coef_mine, q * 16, 64);
#pragma unroll
        for (int c = 0; c < 4; ++c) {
            const f32x2 lo = CVT_PK_F32_FP8((int)b.v[q][c], false), hi = CVT_PK_F32_FP8((int)b.v[q][c], true);
            acc[c * 4 + 0] += coef * lo.x; acc[c * 4 + 1] += coef * lo.y; acc[c * 4 + 2] += coef * hi.x; acc[c * 4 + 3] += coef * hi.y;
        }
    }
}
__device__ __forceinline__ void phase_peer_gather(const P& p, int l) {
    const int lane = otid() & 63;
    const int gw = (obid() * NTHREADS + otid()) >> 6, nw = (gridDim.x * NTHREADS) >> 6;
    constexpr int NG = PH * 16 / GE;
    const bool act = lane * 16 < D_MODEL;
    for (int t = gw; t < MTOT; t += nw) {
        float hv[16], acc[16];
        {
            const u32x4 z4 = {0u, 0u, 0u, 0u};
            const u32x4 ha = act ? *(const u32x4*)(p.H + (size_t)t * D_MODEL + lane * 16) : z4;
            const u32x4 hb = act ? *(const u32x4*)(p.H + (size_t)t * D_MODEL + lane * 16 + 8) : z4;
            hv[0] = LO16(ha.x); hv[1] = HI16(ha.x); hv[2] = LO16(ha.y); hv[3] = HI16(ha.y); hv[4] = LO16(ha.z); hv[5] = HI16(ha.z); hv[6] = LO16(ha.w); hv[7] = HI16(ha.w);
            hv[8] = LO16(hb.x); hv[9] = HI16(hb.x); hv[10] = LO16(hb.y); hv[11] = HI16(hb.y); hv[12] = LO16(hb.z); hv[13] = HI16(hb.z); hv[14] = LO16(hb.w); hv[15] = HI16(hb.w);
#pragma unroll
            for (int j = 0; j < 16; ++j) acc[j] = 0.f;
        }
        int idx0 = 0, idx1 = 0; float g0 = 0.f, g1 = 0.f, u0 = 0.f, u1 = 0.f;
        if (lane < PH * 16) { idx0 = p.IDX[(size_t)t * PH * 16 + lane]; g0 = p.G[(size_t)t * PH * 16 + lane]; u0 = p.GU[(size_t)t * PH * 16 + lane]; }
        if (64 + lane < PH * 16) { idx1 = p.IDX[(size_t)t * PH * 16 + 64 + lane]; g1 = p.G[(size_t)t * PH * 16 + 64 + lane]; u1 = p.GU[(size_t)t * PH * 16 + 64 + lane]; }
        GBuf b0, b1, b2;
        gather_load(p, b0, 0, idx0, idx1, g0, g1, u0, u1, lane);
        gather_load(p, b1, 1, idx0, idx1, g0, g1, u0, u1, lane);
        for (int g = 0; g < NG; g += 3) {
            if (g + 2 < NG) gather_load(p, b2, g + 2, idx0, idx1, g0, g1, u0, u1, lane);
            gather_compute(b0, hv, acc, lane);
            if (g + 1 < NG) {
                if (g + 3 < NG) gather_load(p, b0, g + 3, idx0, idx1, g0, g1, u0, u1, lane);
                gather_compute(b1, hv, acc, lane);
            }
            if (g + 2 < NG) {
                if (g + 4 < NG) gather_load(p, b1, g + 4, idx0, idx1, g0, g1, u0, u1, lane);
                gather_compute(b2, hv, acc, lane);
            }
        }
        float xn[16]; float ss = 0.f;
#pragma unroll
        for (int j = 0; j < 16; ++j) xn[j] = 0.f;
        if (act) {
            const float* g2 = p.MOD + (size_t)(l * 2 + (t >= CTX ? 1 : 0)) * 6 * D_MODEL + 5 * D_MODEL + lane * 16;
            float* xp = p.X + (size_t)t * D_MODEL + lane * 16;
#pragma unroll
            for (int c = 0; c < 4; ++c) {
                float4 x = *(float4*)(xp + c * 4);
                x.x += g2[c * 4 + 0] * acc[c * 4 + 0]; x.y += g2[c * 4 + 1] * acc[c * 4 + 1]; x.z += g2[c * 4 + 2] * acc[c * 4 + 2]; x.w += g2[c * 4 + 3] * acc[c * 4 + 3];
                if (l + 1 < DEPTH) *(float4*)(xp + c * 4) = x;
                xn[c * 4 + 0] = x.x; xn[c * 4 + 1] = x.y; xn[c * 4 + 2] = x.z; xn[c * 4 + 3] = x.w;
                ss += x.x * x.x + x.y * x.y + x.z * x.z + x.w * x.w;
            }
        }
        ss = wave_sum(ss);
        const float rstd = rsqrtf(ss / D_MODEL + 1e-6f);
        if (act) {
            if (l + 1 < DEPTH) {
                const float* gn = p.in[I_N1G] + (size_t)(l + 1) * D_MODEL + lane * 16;
                const float* mod = p.MOD + (size_t)((l + 1) * 2 + (t >= CTX ? 1 : 0)) * 6 * D_MODEL + lane * 16;
                float o[16];
#pragma unroll
                for (int j = 0; j < 16; ++j) o[j] = xn[j] * rstd * gn[j] * (1.0f + mod[D_MODEL + j]) + mod[j];
                u32x4 w0, w1;
                w0.x = pack2bf(o[0], o[1]); w0.y = pack2bf(o[2], o[3]); w0.z = pack2bf(o[4], o[5]); w0.w = pack2bf(o[6], o[7]);
                w1.x = pack2bf(o[8], o[9]); w1.y = pack2bf(o[10], o[11]); w1.z = pack2bf(o[12], o[13]); w1.w = pack2bf(o[14], o[15]);
                *(u32x4*)(p.H + (size_t)t * D_MODEL + lane * 16) = w0; *(u32x4*)(p.H + (size_t)t * D_MODEL + lane * 16 + 8) = w1;
            } else if (t >= CTX) {
                const float* fg = p.in[I_FG] + lane * 16;
                float* op = p.out + (size_t)(t - CTX) * D_MODEL + lane * 16;
#pragma unroll
                for (int c = 0; c < 4; ++c) {
                    float4 o; o.x = xn[c * 4 + 0] * rstd * fg[c * 4 + 0]; o.y = xn[c * 4 + 1] * rstd * fg[c * 4 + 1]; o.z = xn[c * 4 + 2] * rstd * fg[c * 4 + 2]; o.w = xn[c * 4 + 3] * rstd * fg[c * 4 + 3];
                    *(float4*)(op + c * 4) = o;
                }
            }
        }
    }
}
__device__ __forceinline__ void phase_final(const P& p) {
    const int lane = otid() & 63;
    const int gw = (obid() * NTHREADS + otid()) >> 6, nw = (gridDim.x * NTHREADS) >> 6;
    const float* g = p.in[I_FG];
    for (int t = gw; t < SEQ; t += nw) {
        const float* x = p.X + (size_t)(CTX + t) * D_MODEL;
        float v[D_MODEL / 64]; float ss = 0.f;
#pragma unroll
        for (int j = 0; j < D_MODEL / 64; ++j) { v[j] = x[lane + 64 * j]; ss += v[j] * v[j]; }
        ss = wave_sum(ss);
        float rstd = rsqrtf(ss / D_MODEL + 1e-6f);
#pragma unroll
        for (int j = 0; j < D_MODEL / 64; ++j) p.out[(size_t)t * D_MODEL + lane + 64 * j] = v[j] * rstd * g[lane + 64 * j];
    }
}

__global__ void __launch_bounds__(NTHREADS) fwd_megakernel(P p_arg) {
#ifdef EMU
    char* smem = emu_smem();
#else
    __shared__ __attribute__((aligned(16))) char smem_raw[SMEM_BYTES + 16];
    char* smem = smem_raw;
#endif
#ifndef EMU
    volatile LAS unsigned* xst = (volatile LAS unsigned*)(smem_raw + SMEM_BYTES);
    if (threadIdx.x == 0) { xst[0] = 0u; xst[1] = 0u; xst[2] = 0u; xst[3] = 0u; }
    __syncthreads();
    XcdBarrier xb = xcd_barrier_post(p_arg.bar, xst);
#endif
    { LOADP(); phase_init(p, smem); }
#ifndef EMU
    GRID_SYNC_CG();
#endif
#ifdef EMU
    GRID_SYNC();
#endif
#ifndef EMU
    if (threadIdx.x == 0) {
        unsigned base_ = 0;
        for (unsigned j = 0; j < xb.x; ++j) base_ += xb_ld(&p_arg.bar[XB_XCNT(j)]);
        xst[2] = base_ + xst[3];
    }
    __syncthreads();
#endif
    PROBE_INIT();
    for (int l = 0; l < DEPTH; ++l) {
        if (l == 0) {
            { LOADP(); phase_norm(p, 0, 0); }
            { LOADP(); phase_s5const(p, 0); }
            { LOADP(); phase_convert_weights(p, 0, smem, obid(), (int)gridDim.x); }
            GRID_SYNC(); PROBE_AFTER(0);
        }
        { LOADP(); phase_gemm_in(p, l, smem); }
        GRID_SYNC(); PROBE_AFTER(1);
        { LOADP(); phase_rwkv_prep1(p, l); }
        GRID_SYNC(); PROBE_AFTER(14);
        { LOADP(); for (int job = obid(); job < 2 * NC * RH; job += gridDim.x) rwkv_chunk_job(p, l, job, smem); }
        __syncthreads(); PROBE_AFTER(20);
        { LOADP(); phase_gla_kv(p, l, smem); }
        PROBE_AFTER(21);
        { LOADP(); phase_s5_pass(p, l, smem, false); }
        GRID_SYNC(); PROBE_AFTER(3);
        {
            LOADP();
            const int n_rw = 2 * RH, n_gla = 2 * GH * 8192 / NTHREADS, n_s5 = (2 * SG * 64 + NTHREADS - 1) / NTHREADS;
            const int G_ = (int)gridDim.x;
            if (G_ > 2 * n_rw) {
                if (obid() < n_rw) { rwkv_seq_job(p, obid(), smem); PROBE_AFTER(24); }
                else {
                    const int nb = G_ - n_rw, bid = obid() - n_rw;
                    for (int job = bid; job < n_gla + n_s5 + PEER_CONV_JOBS; job += nb) {
                        if (job < n_gla) gla_scan_job(p, job);
                        else if (job < n_gla + n_s5) s5_carry_job(p, job - n_gla);
                        else peer_conv_job(p, l, job - n_gla - n_s5);
                    }
                    { P pg = p; late_select(pg, l & 1); for (int job = bid; job < G2_JOBS; job += nb) g2_gemm_job(pg, job, smem); }
                    if (l + 1 < DEPTH) { late_select(p, (l + 1) & 1); phase_convert_weights(p, l + 1, smem, bid, nb); }
                }
            } else {
                for (int job = obid(); job < n_rw + n_gla + n_s5 + PEER_CONV_JOBS; job += G_) {
                    if (job < n_rw) rwkv_seq_job(p, job, smem);
                    else if (job < n_rw + n_gla) gla_scan_job(p, job - n_rw);
                    else if (job < n_rw + n_gla + n_s5) s5_carry_job(p, job - n_rw - n_gla);
                    else peer_conv_job(p, l, job - n_rw - n_gla - n_s5);
                }
                __syncthreads();
                { P pg = p; late_select(pg, l & 1); for (int job = obid(); job < G2_JOBS; job += G_) g2_gemm_job(pg, job, smem); }
                if (l + 1 < DEPTH) { late_select(p, (l + 1) & 1); phase_convert_weights(p, l + 1, smem, obid(), G_); }
            }
        }
        GRID_SYNC(); PROBE_AFTER(4);
        { LOADP(); phase_rwkv_out(p); }
        PROBE_AFTER(22);
        { LOADP(); phase_gla_out(p, l, smem); }
        PROBE_AFTER(23);
        { LOADP(); phase_s5_pass(p, l, smem, true); }
        GRID_SYNC(); PROBE_AFTER(5);
        { LOADP(); phase_side_elem(p, l); }
        if (l + 1 < DEPTH) { LOADP(); phase_s5const(p, l + 1); }
        { LOADP(); late_select(p, l & 1); phase_glu_gemm(p, l, smem); }
        GRID_SYNC(); PROBE_AFTER(7);
        { LOADP(); late_select(p, l & 1); phase_merge(p, l, smem); }
        GRID_SYNC(); PROBE_AFTER(8);
        { LOADP(); late_select(p, l & 1); phase_outproj(p, l, smem); }
        GRID_SYNC(); PROBE_AFTER(9);
        { LOADP(); phase_norm(p, l, 1); }
        GRID_SYNC(); PROBE_AFTER(10);
        { LOADP(); late_select(p, l & 1); phase_peer_q(p, l, smem); }
        GRID_SYNC(); PROBE_AFTER(11);
        { LOADP(); late_select(p, l & 1); phase_peer_topk(p, l, smem); }
        GRID_SYNC(); PROBE_AFTER(12);
        { LOADP(); phase_peer_gather(p, l); }
        if (l + 1 < DEPTH) { GRID_SYNC(); PROBE_AFTER(13); }
    }
}

static inline size_t align_up(size_t x) { return (x + 255) & ~(size_t)255; }

extern "C" void kernel_launch(void* const* d_in, const int* in_sizes, int n_in, void* d_out, int out_size, void* d_ws, size_t ws_size, hipStream_t stream) {
    P p;
    memset(&p, 0, sizeof(p));
    for (int i = 0; i < 39; ++i) p.in[i] = (const float*)d_in[i];
    p.out = (float*)d_out;
    char* w = (char*)d_ws; size_t off = 0;
    auto take = [&](size_t bytes) { void* r = w + off; off = align_up(off + bytes); return r; };
    p.bar = (unsigned*)take(16384);
    p.X = (float*)take((size_t)MTOT * D_MODEL * 4);
    p.H = (bf16_t*)take((size_t)MTOT * D_MODEL * 2);
    p.MOD = (float*)take((size_t)DEPTH * 2 * 6 * D_MODEL * 4);
    p.Z = (bf16_t*)take((size_t)MTOT * ZLD * 2);
    p.ZGT = (bf16_t*)take((size_t)MTOT * 3 * D_MODEL * 2);
    p.V = (bf16_t*)take((size_t)MTOT * RW * 2);
    {
        char* ra = (char*)take((size_t)MTOT * RW * 2 * 2 > (size_t)MTOT * GLA_V * 4 ? (size_t)MTOT * RW * 2 * 2 : (size_t)MTOT * GLA_V * 4);
        p.R = (bf16_t*)ra; p.KK = (bf16_t*)(ra + (size_t)MTOT * RW * 2);
        p.OGLA = (float*)ra;
    }
    {
        char* rb = (char*)take((size_t)2 * MTOT * RW * 2 > (size_t)3 * MTOT * PH * 16 * 4 ? (size_t)2 * MTOT * RW * 2 : (size_t)3 * MTOT * PH * 16 * 4);
        p.KD = (bf16_t*)rb;
        p.IDX = (int*)rb; p.G = (float*)(rb + (size_t)MTOT * PH * 16 * 4); p.GU = (float*)(rb + (size_t)2 * MTOT * PH * 16 * 4);
    }
    p.BB = (bf16_t*)take((size_t)2 * MTOT * RW * 2);
    p.G2B = p.BB;
    p.LW = (float*)take((size_t)2 * MTOT * RW * 4);
    p.SP = (bf16_t*)p.LW;
    static_assert((size_t)2 * NC * GH * 8192 * 2 <= (size_t)2 * MTOT * RW * 4, "SP alias");
    p.BONUS = (float*)take((size_t)2 * MTOT * RH * 4);
    p.KS = (bf16_t*)take((size_t)MTOT * RW * 2);
    p.LR = (bf16_t*)take((size_t)MTOT * 256 * 2);
    p.WT_W2 = (bf16_t*)take((size_t)2 * NPAD(RW) * 64 * 2);
    p.WT_A2 = (bf16_t*)take((size_t)2 * NPAD(RW) * 64 * 2);
    p.GS = (bf16_t*)take((size_t)MTOT * 128 * 2);
    p.Y = (float*)take((size_t)2 * MTOT * RW * 4);
    p.Y0T = (float*)take((size_t)2 * NC * RH * 4096 * 4);
    p.KV = (float*)take((size_t)2 * NC * GH * 8192 * 4);
    p.DEC = (float*)take((size_t)2 * NC * GH * 64 * 4);
    p.S5A = (float*)take((size_t)2 * SG * 64 * 2 * 4);
    p.S5BB = (float*)take((size_t)2 * SG * 64 * 16 * 2 * 4);
    p.S5END = (float*)take((size_t)2 * NC * SG * 64 * 2 * 4);
    p.S5CAR = (float*)take((size_t)2 * NC * SG * 64 * 2 * 4);
    {
        const size_t szc1 = (size_t)2 * NC * RH * SEQ_REC;
        const size_t szc2 = (size_t)MTOT * SW * 2 + (size_t)MTOT * RW * 4 + (size_t)MTOT * 3 * BW * 2 + (size_t)MTOT * D_MODEL * 2 + 1024;
        char* rc = (char*)take(szc1 > szc2 ? szc1 : szc2);
        p.REC = rc;
        char* c2 = rc;
        p.GY = (bf16_t*)c2; c2 += align_up((size_t)MTOT * SW * 2);
        p.YN = (float*)c2; c2 += align_up((size_t)MTOT * RW * 4);
        p.BR = (bf16_t*)c2; c2 += align_up((size_t)MTOT * 3 * BW * 2);
        p.M = (bf16_t*)c2;
    }
    p.SN = (bf16_t*)take((size_t)2 * NC * RH * 4096 * 2);
    p.QH = (bf16_t*)take((size_t)2 * NC * RH * 4096 * 2);
    p.WT_IN = (bf16_t*)take((size_t)NPAD192(D_IN) * D_MODEL * 2);
    {
        char* lb = (char*)take(2 * LATE_BYTES); size_t lo = 0;
        auto ltake = [&](size_t bytes) { void* r = lb + lo; lo = AL256(lo + bytes); return r; };
        p.WT_G2 = (bf16_t*)ltake((size_t)NPAD(RW) * 128 * 2);
        p.WT_GLU = (bf16_t*)ltake((size_t)NPAD(2 * SW) * SW * 2);
        p.WT_BR = (bf16_t*)ltake((size_t)3 * D_MODEL * BW * 2);
        p.WT_OUT = (bf16_t*)ltake((size_t)D_MODEL * D_MODEL * 2);
        p.WT_Q = (bf16_t*)ltake((size_t)PQ * D_MODEL * 2);
        p.KHI = (bf16_t*)ltake((size_t)PH * 2 * 128 * 128 * 2); p.KLO = (bf16_t*)ltake((size_t)PH * 2 * 128 * 128 * 2);
        if (lo != LATE_BYTES) fprintf(stderr, "late weights layout mismatch\n");
    }
    p.U8 = (unsigned char*)take((size_t)NEXP * D_MODEL);
    p.V8 = (unsigned char*)take((size_t)NEXP * D_MODEL);
    p.USC = (float*)take((size_t)NEXP * 4); p.VSC = (float*)take((size_t)NEXP * 4);
    p.QHI = p.Z; p.QLO = p.Z + (size_t)MTOT * PQ;
    static_assert((size_t)PQ * 4 <= (size_t)D_IN * 2 && ((size_t)MTOT * ZLD * 2) % 256 == 0, "Q alias");
    if (off > ws_size) { fprintf(stderr, "ws too small: need %zu have %zu\n", off, ws_size); return; }
#ifdef EMU
    fprintf(stderr, "ws used %zu MB\n", off >> 20);
    emu_launch([=] { fwd_megakernel(p); }, EMU_GRID, NTHREADS);
#else
    hipMemsetAsync(p.bar, 0, 16384, stream);
    static int grid_blocks = 0;
    if (!grid_blocks) {
        int dev = 0, cus = 0, per_cu = 0;
        hipGetDevice(&dev);
        hipDeviceGetAttribute(&cus, hipDeviceAttributeMultiprocessorCount, dev);
        hipOccupancyMaxActiveBlocksPerMultiprocessor(&per_cu, fwd_megakernel, NTHREADS, 0);
        if (per_cu > 1) per_cu = 1;
        grid_blocks = cus * per_cu;
    }
    void* args[] = {&p};
    hipError_t e = hipLaunchCooperativeKernel((void*)fwd_megakernel, dim3(grid_blocks), dim3(NTHREADS), args, 0, stream);
    if (e != hipSuccess) fprintf(stderr, "cooperative launch failed: %s (grid %d)\n", hipGetErrorString(e), grid_blocks);
#endif
}
```

```cpp
#include <hip/hip_runtime.h>
#ifndef EMU
#include <hip/hip_cooperative_groups.h>
namespace cg = cooperative_groups;
#endif
#include <cstdio>
#include <cstdint>
#include <cstring>
#include <type_traits>

#ifdef CFG_SMALL
#define D_MODEL 128
#define SEQ 640
#define DEPTH 2
#define GRID_W 10
#define CTX 128
#define GH 1
#define RH 2
#define SG 8
#define PH 2
#else
#define D_MODEL 1024
#define SEQ 16384
#define DEPTH 4
#define GRID_W 64
#define CTX 256
#define GH 4
#define RH 8
#define SG 32
#define PH 8
#endif
#define MTOT (CTX + SEQ)
#define ROWS (SEQ / GRID_W)
#define GLA_K (GH * 64)
#define GLA_V (GH * 128)
#define RW (RH * 64)
#define RWKV_IN (3 * RW + 4 * 64 + 128)
#define SW (SG * 16)
#define BW GLA_V
#define ZQ 0
#define ZK (GLA_K)
#define ZV (2 * GLA_K)
#define ZOG (ZV + GLA_V)
#define ZAF (ZOG + GLA_V)
#define ZAB (ZAF + 16)
#define ZR (ZAB + 16)
#define ZS5 (ZR + RWKV_IN)
#define ZG (ZS5 + SW)
#define D_IN (ZG + 3 * D_MODEL)
#define ZLD ZG
#define NC (MTOT / 64)
#define NCC (CTX / 64)
#define RB (ROWS / 64)
#define PQ (PH * 256)
#define NEXP 16384
#define NTHREADS 256
#define SMEM_BYTES 133120

typedef unsigned short bf16_t;
typedef short bf16x8 __attribute__((ext_vector_type(8)));
typedef float f32x4 __attribute__((ext_vector_type(4)));
typedef unsigned u32x4 __attribute__((ext_vector_type(4)));
typedef unsigned u32x2 __attribute__((ext_vector_type(2)));
#ifdef EMU
#define MFMA16(a, b, c) emu_mfma_16x16x32_bf16(a, b, c)
#else
#define MFMA16(a, b, c) __builtin_amdgcn_mfma_f32_16x16x32_bf16(a, b, c, 0, 0, 0)
#endif
typedef float f32x2 __attribute__((ext_vector_type(2)));
#ifdef EMU
#define CVT_PK_FP8(a, b, old, hi) emu_cvt_pk_fp8_f32(a, b, old, hi)
#define CVT_PK_F32_FP8(w, hi) emu_cvt_pk_f32_fp8(w, hi)
#else
#define CVT_PK_FP8(a, b, old, hi) __builtin_amdgcn_cvt_pk_fp8_f32(a, b, old, hi)
#define CVT_PK_F32_FP8(w, hi) __builtin_amdgcn_cvt_pk_f32_fp8(w, hi)
#endif
#ifdef EMU
#define MFMA16_ACC(a, b, c) c = emu_mfma_16x16x32_bf16(a, b, c)
#else
#define MFMA16_ACC(a, b, c) asm volatile("v_mfma_f32_16x16x32_bf16 %0, %1, %2, %0" : "+a"(c) : "v"(a), "v"(b))
#endif
#define NPAD(n) (((n) + 127) / 128 * 128)
#define NPAD192(n) (((n) + 383) / 384 * 384)

__device__ __forceinline__ float bf2f(bf16_t h) { return __builtin_bit_cast(float, ((unsigned)h) << 16); }
#ifdef EMU
__device__ __forceinline__ bf16_t f2bf(float f) { unsigned u = __builtin_bit_cast(unsigned, f); u += 0x7FFFu + ((u >> 16) & 1u); return (bf16_t)(u >> 16); }
__device__ __forceinline__ unsigned pack2bf(float a, float b) { return (unsigned)f2bf(a) | ((unsigned)f2bf(b) << 16); }
#else
typedef float f2v_t __attribute__((ext_vector_type(2))); typedef __bf16 b2v_t __attribute__((ext_vector_type(2)));
__device__ __forceinline__ bf16_t f2bf(float f) { return __builtin_bit_cast(unsigned short, (__bf16)f); }
__device__ __forceinline__ unsigned pack2bf(float a, float b) { f2v_t v = {a, b}; b2v_t r = __builtin_convertvector(v, b2v_t); return __builtin_bit_cast(unsigned, r); }
#endif
#ifdef EMU
#define fexp_(x) expf(x)
#define flog_(x) logf(x)
#else
#define fexp_(x) __expf(x)
#define flog_(x) __logf(x)
#endif
#define LO16(x) __builtin_bit_cast(float, (x) << 16)
#define HI16(x) __builtin_bit_cast(float, (x) & 0xFFFF0000u)
__device__ __forceinline__ float sigmoidf_(float x) { return 1.0f / (1.0f + fexp_(-x)); }
__device__ __forceinline__ float siluf_(float x) { return x * sigmoidf_(x); }
__device__ __forceinline__ float geluf_(float x) { const float y = 1.5957691216057308f * (x + 0.044715f * x * x * x); return x / (1.0f + fexp_(-y)); }
__device__ __forceinline__ float softplusf_(float x) { return fmaxf(x, 0.f) + flog_(1.0f + fexp_(-fabsf(x))); }
__device__ __forceinline__ float tanhf_(float x) { const float e = fexp_(-2.0f * fabsf(x)); const float t = (1.0f - e) / (1.0f + e); return x < 0.f ? -t : t; }
__device__ __forceinline__ float wave_sum(float v) {
#pragma unroll
    for (int m = 32; m >= 1; m >>= 1) v += __shfl_xor(v, m, 64);
    return v;
}

struct P {
    const float* in[39];
    float* out;
    float* X;
    bf16_t* H;
    bf16_t* Z;
    bf16_t* ZGT;
    float* MOD;
    bf16_t* R; bf16_t* V; bf16_t* KK; bf16_t* KD; bf16_t* BB;
    float* LW;
    char* REC;
    bf16_t* SN;
    bf16_t* QH;
    float* BONUS;
    bf16_t* KS;
    bf16_t* LR;
    bf16_t* WT_W2;
    bf16_t* WT_A2;
    bf16_t* GS;
    float* Y;
    bf16_t* G2B;
    float* Y0T;
    float* KV;
    bf16_t* SP;
    float* DEC;
    float* OGLA;
    float* S5A;
    float* S5BB;
    float* S5END;
    float* S5CAR;
    bf16_t* GY;
    float* YN;
    bf16_t* BR;
    bf16_t* M;
    bf16_t* QHI; bf16_t* QLO;
    bf16_t* KHI; bf16_t* KLO;
    int* IDX;
    float* G;
    float* GU;
    unsigned* bar;
    bf16_t* WT_IN;
    bf16_t* WT_G2;
    bf16_t* WT_GLU;
    bf16_t* WT_BR;
    bf16_t* WT_OUT;
    bf16_t* WT_Q;
    unsigned char* U8; unsigned char* V8;
    float* USC; float* VSC;
};

enum { I_X = 0, I_C, I_CTX, I_CCTX, I_WMOD, I_BMOD, I_N1G, I_N2G, I_WIN, I_GLA_WA2, I_GLA_BA, I_GLA_NG, I_RCONV, I_RW0, I_RW2, I_RA0, I_RA2, I_RG2,
       I_RKK, I_RKA, I_RRK, I_RLNW, I_RLNB, I_S5LRE, I_S5LIM, I_S5LS, I_S5BRE, I_S5BIM, I_S5CRE, I_S5CIM, I_S5D, I_S5GLU, I_WBR, I_WOUT, I_PWQ, I_PKEYS, I_PU, I_PV, I_FG };

#define AL256(x) (((size_t)(x) + 255) & ~(size_t)255)
#define LATE_BYTES (AL256((size_t)NPAD(RW) * 128 * 2) + AL256((size_t)NPAD(2 * SW) * SW * 2) + AL256((size_t)3 * D_MODEL * BW * 2) + AL256((size_t)D_MODEL * D_MODEL * 2) + \
                    AL256((size_t)PQ * D_MODEL * 2) + 2 * AL256((size_t)PH * 2 * 128 * 128 * 2))
__device__ __forceinline__ void late_select(P& p, int par) {
    const size_t o = (size_t)par * (LATE_BYTES / 2);
    p.WT_G2 += o; p.WT_GLU += o; p.WT_BR += o; p.WT_OUT += o; p.WT_Q += o; p.KHI += o; p.KLO += o;
}
#ifdef EMU
__device__ __forceinline__ int otid() { return threadIdx.x; }
__device__ __forceinline__ int obid() { return blockIdx.x; }
#else
__device__ __forceinline__ int otid() { int t = threadIdx.x; asm volatile("" : "+v"(t)); return t; }
__device__ __forceinline__ int obid() { int b = blockIdx.x; asm volatile("" : "+s"(b)); return b; }
#endif
#ifdef EMU
#define WAVE_SYNC() emu_wave_barrier()
#ifndef EMU_GRID
#define EMU_GRID 4
#endif
#else
#define WAVE_SYNC() __builtin_amdgcn_wave_barrier()
#endif
#ifndef EMU
#define XB_TMO      128
#define XB_XCNT(j)  (256  + 64 * (j))
#define XB_XSUB(j)  (1280 + 64 * (j))
#define XB_XGEN(j)  (2304 + 64 * (j))
#define XB_TOP      3328
#define XB_TOPGEN   3392
#define XCD_BAR_WORDS 3456
#define XB_SPIN_CAP (1u << 22)
#define LAS __attribute__((address_space(3)))
__device__ __forceinline__ unsigned xb_ld(unsigned* p)              { return __hip_atomic_load(p, __ATOMIC_RELAXED, __HIP_MEMORY_SCOPE_SYSTEM); }
__device__ __forceinline__ unsigned xb_add(unsigned* p, unsigned v) { return __hip_atomic_fetch_add(p, v, __ATOMIC_RELAXED, __HIP_MEMORY_SCOPE_SYSTEM); }
__device__ __forceinline__ unsigned xb_xcc_id() { return (unsigned)__builtin_amdgcn_s_getreg((3 << 11) | 20) & 0xFu; }
#define XB_SPIN(cond, bar) do { unsigned _sp = 0; while (cond) { __builtin_amdgcn_s_sleep(1); \
    if ((++_sp & 255u) == 0u) { if (xb_ld(&(bar)[XB_TMO])) break; if (_sp > XB_SPIN_CAP) { atomicAdd(&(bar)[XB_TMO], 1u); break; } } } } while (0)
struct XcdBarrier { unsigned* bar; unsigned x; volatile LAS unsigned* st; };
__device__ __forceinline__ XcdBarrier xcd_barrier_post(unsigned* bar, volatile LAS unsigned* st) {
    XcdBarrier b; b.bar = bar; b.x = xb_xcc_id(); b.st = st;
    if (threadIdx.x == 0) st[3] = xb_add(&bar[XB_XCNT(b.x)], 1u);
    return b;
}
__device__ __forceinline__ void xcd_barrier_complete(unsigned* bar, unsigned x, unsigned& nloc, unsigned& nx) {
    const unsigned G = gridDim.x * gridDim.y * gridDim.z;
    unsigned sum, cnt, mine, sp = 0u;
    for (;;) {
        sum = 0u; cnt = 0u; mine = 0u;
#pragma unroll
        for (unsigned j = 0; j < 16; ++j) { const unsigned c = xb_ld(&bar[XB_XCNT(j)]); sum += c; cnt += (c > 0u) ? 1u : 0u; mine = (j == x) ? c : mine; }
        if (sum == G) break;
        __builtin_amdgcn_s_sleep(1);
        if ((++sp & 255u) == 0u) { if (xb_ld(&bar[XB_TMO])) break; if (sp > XB_SPIN_CAP) { atomicAdd(&bar[XB_TMO], 1u); break; } }
    }
    nloc = mine > 0u ? mine : 1u; nx = cnt > 0u ? cnt : 1u;
}
__device__ __forceinline__ void xcd_barrier(const XcdBarrier& b) {
    asm volatile("s_waitcnt vmcnt(0)" ::: "memory");
    __syncthreads();
    if (threadIdx.x == 0) {
        unsigned* bar = b.bar;
        __builtin_amdgcn_fence(__ATOMIC_RELEASE, "agent");
        asm volatile("s_waitcnt vmcnt(0)" ::: "memory");
        const unsigned G = gridDim.x;
        const unsigned old = xb_add(&bar[XB_TOP], 1u);
        const unsigned tg = old / G;
        if (old + 1u == (tg + 1u) * G) xb_add(&bar[XB_TOPGEN], 1u);
        else XB_SPIN(xb_ld(&bar[XB_TOPGEN]) == tg, bar);
        __builtin_amdgcn_fence(__ATOMIC_ACQUIRE, "agent");
        asm volatile("s_waitcnt vmcnt(0)" ::: "memory");
    }
    __syncthreads();
}
#define GRID_SYNC_CG() { (void)xb; asm volatile("s_waitcnt vmcnt(0)" ::: "memory"); cg::this_grid().sync(); }
#define GRID_SYNC() xcd_barrier(xb)
#else
#define GRID_SYNC() emu_grid_sync()
#endif

#ifdef EMU
#define LOADP() P p = p_arg
#else
typedef __attribute__((address_space(4))) const unsigned long long cu64_t;
__device__ __forceinline__ void load_params(P& p) {
    cu64_t* q = (cu64_t*)__builtin_amdgcn_kernarg_segment_ptr();
    asm volatile("" : "+s"(q));
    typedef __attribute__((address_space(1))) char gchar_t;
    char* w[sizeof(P) / 8];
#pragma unroll
    for (int i = 0; i < (int)(sizeof(P) / 8); ++i) w[i] = (char*)(gchar_t*)q[i];
    __builtin_memcpy(&p, w, sizeof(P));
}
#define LOADP() P p; load_params(p)
#endif
#define PROBE_MULT 3
#if defined(PROBE_ID) && !defined(EMU)
#define PROBE_INIT() unsigned long long probe_t0 = wall_clock64()
#define PROBE_AFTER(id) { if (blockIdx.x == 0) { unsigned long long now_ = wall_clock64(); if ((id) == PROBE_ID || (id) == PROBE_ID2) { const unsigned long long dt_ = now_ - probe_t0; \
    while (wall_clock64() - now_ < dt_ * PROBE_MULT) __builtin_amdgcn_s_sleep(8); now_ = wall_clock64(); } probe_t0 = now_; } }
#else
#define PROBE_INIT()
#define PROBE_AFTER(id)
#endif
__device__ __forceinline__ int gla_tok(int n, int i) {
    if (n < NCC) return n * 64 + i;
    int m = n - NCC; int col = m / RB, rb = m % RB;
    return CTX + (rb * 64 + i) * GRID_W + col;
}
__device__ __forceinline__ int chunk_order(int d, int s) {
    if (d == 0) return s;
    return (s < NCC) ? (NCC - 1 - s) : (NC - 1 - (s - NCC));
}
__device__ __forceinline__ int tok_order(int d, int s) {
    if (d == 0) return s;
    return (s < CTX) ? (CTX - 1 - s) : (MTOT - 1 - (s - CTX));
}


#define LDS_ROW 72
__device__ __forceinline__ void mfma_gemm_tile(const bf16_t* Wt, int ldw, const bf16_t* Act, int lda, int K, int n0, int m0, bf16_t* lds, f32x4 (&acc)[4][4]) {
    bf16_t* Ws = lds; bf16_t* As = lds + 128 * LDS_ROW;
    const int tid = otid(), lane = tid & 63, wave = tid >> 6, wn = wave >> 1, wm = wave & 1;
    const int lrow = tid >> 3, lkc = (tid & 7) * 8;
    u32x4 pw[4], pa[4];
#pragma unroll
    for (int i = 0; i < 4; ++i) {
        pw[i] = *(const u32x4*)(Wt + (size_t)(n0 + lrow + 32 * i) * ldw + lkc);
        pa[i] = *(const u32x4*)(Act + (size_t)(m0 + lrow + 32 * i) * lda + lkc);
    }
    for (int k0 = 0; k0 < K; k0 += 64) {
        __syncthreads();
#pragma unroll
        for (int i = 0; i < 4; ++i) {
            *(u32x4*)(Ws + (lrow + 32 * i) * LDS_ROW + lkc) = pw[i];
            *(u32x4*)(As + (lrow + 32 * i) * LDS_ROW + lkc) = pa[i];
        }
        __syncthreads();
        if (k0 + 64 < K) {
#pragma unroll
            for (int i = 0; i < 4; ++i) {
                pw[i] = *(const u32x4*)(Wt + (size_t)(n0 + lrow + 32 * i) * ldw + k0 + 64 + lkc);
                pa[i] = *(const u32x4*)(Act + (size_t)(m0 + lrow + 32 * i) * lda + k0 + 64 + lkc);
            }
        }
#pragma unroll
        for (int ks = 0; ks < 2; ++ks) {
            bf16x8 a[4], b[4];
#pragma unroll
            for (int i = 0; i < 4; ++i) {
                a[i] = *(const bf16x8*)(Ws + (wn * 64 + i * 16 + (lane & 15)) * LDS_ROW + ks * 32 + (lane >> 4) * 8);
                b[i] = *(const bf16x8*)(As + (wm * 64 + i * 16 + (lane & 15)) * LDS_ROW + ks * 32 + (lane >> 4) * 8);
            }
#pragma unroll
            for (int ni = 0; ni < 4; ++ni)
#pragma unroll
                for (int mi = 0; mi < 4; ++mi) acc[ni][mi] = MFMA16(a[ni], b[mi], acc[ni][mi]);
        }
    }
}
#define L64_ROW 72
#ifdef EMU
struct BufRsrc { const char* base; };
__device__ __forceinline__ BufRsrc make_rsrc(const void* p, size_t) { BufRsrc r; r.base = (const char*)p; return r; }
__device__ __forceinline__ u32x4 buf_load16(const BufRsrc& r, unsigned voff, unsigned soff) { return *(const u32x4*)(r.base + voff + soff); }
#else
typedef __amdgpu_buffer_rsrc_t BufRsrc;
__device__ __forceinline__ BufRsrc make_rsrc(const void* p, size_t bytes) { return __builtin_amdgcn_make_buffer_rsrc((void*)p, 0, (int)bytes, 0x00020000); }
__device__ __forceinline__ u32x4 buf_load16(const BufRsrc& r, unsigned voff, unsigned soff) { return __builtin_bit_cast(u32x4, __builtin_amdgcn_raw_buffer_load_b128(r, voff, soff, 0)); }
#endif
template <int NI, int MI>
__device__ __forceinline__ void mfma_gemm_tile_t(const bf16_t* Wt, int ldw, size_t wbytes, const bf16_t* Act, int lda, size_t abytes, int K, int n0, int m0, bf16_t* lds, f32x4 (&acc)[NI][MI], unsigned long long* gacc = nullptr) {
    constexpr int WR = 32 * NI, AR = 32 * MI, BUF = (WR + AR) * L64_ROW;
    const int tid = otid(), lane = tid & 63, wave = tid >> 6, wn = wave >> 1, wm = wave & 1;
    const int lrow = tid >> 3, lkc = (tid & 7) * 8;
    const BufRsrc rw = make_rsrc(Wt, wbytes), ra = make_rsrc(Act, abytes);
    unsigned vw[NI], va[MI];
#pragma unroll
    for (int i = 0; i < NI; ++i) vw[i] = (unsigned)(((size_t)(n0 + lrow + 32 * i) * ldw + lkc) * 2);
#pragma unroll
    for (int i = 0; i < MI; ++i) va[i] = (unsigned)(((size_t)(m0 + lrow + 32 * i) * lda + lkc) * 2);
    u32x4 qw0[NI], qa0[MI];
    const int nk = K / 64;
#define GT_LOAD(QW, QA, KT) { const unsigned so_ = (unsigned)(((KT) < nk) ? (KT) : (nk - 1)) * 128u; \
    _Pragma("unroll") for (int i = 0; i < NI; ++i) QW[i] = buf_load16(rw, vw[i], so_); \
    _Pragma("unroll") for (int i = 0; i < MI; ++i) QA[i] = buf_load16(ra, va[i], so_); }
#define GT_STORE(QW, QA, DST) { \
    _Pragma("unroll") for (int i = 0; i < NI; ++i) *(u32x4*)((DST) + (lrow + 32 * i) * L64_ROW + lkc) = QW[i]; \
    _Pragma("unroll") for (int i = 0; i < MI; ++i) *(u32x4*)((DST) + (WR + lrow + 32 * i) * L64_ROW + lkc) = QA[i]; }
#define GT_COMPUTE(CUR) { _Pragma("unroll") for (int ks = 0; ks < 2; ++ks) { bf16x8 b[MI], a[NI]; \
    _Pragma("unroll") for (int i = 0; i < MI; ++i) b[i] = *(const bf16x8*)((CUR) + (WR + wm * 16 * MI + i * 16 + (lane & 15)) * L64_ROW + ks * 32 + (lane >> 4) * 8); \
    _Pragma("unroll") for (int i = 0; i < NI; ++i) a[i] = *(const bf16x8*)((CUR) + (wn * 16 * NI + i * 16 + (lane & 15)) * L64_ROW + ks * 32 + (lane >> 4) * 8); \
    _Pragma("unroll") for (int ni = 0; ni < NI; ++ni) { \
        _Pragma("unroll") for (int mi = 0; mi < MI; ++mi) MFMA16_ACC(a[ni], b[mi], acc[ni][mi]); } } }
    GT_LOAD(qw0, qa0, 0)
    __syncthreads();
    GT_STORE(qw0, qa0, lds)
    __syncthreads();
    for (int kt = 0; kt < nk; kt += 2) {
        GT_LOAD(qw0, qa0, kt + 1)
        GT_COMPUTE(lds)
        GT_STORE(qw0, qa0, lds + BUF)
        __syncthreads();
        GT_LOAD(qw0, qa0, kt + 2)
        GT_COMPUTE(lds + BUF)
        GT_STORE(qw0, qa0, lds)
        __syncthreads();
    }
#undef GT_LOAD
#undef GT_STORE
#undef GT_COMPUTE
}
#define ZERO_ACC4(acc) { _Pragma("unroll") for (int i_ = 0; i_ < 4; ++i_) _Pragma("unroll") for (int j_ = 0; j_ < 4; ++j_) acc[i_][j_] = (f32x4){0.f, 0.f, 0.f, 0.f}; }
#define FOR_ACC(acc, n0, m0, BODY) { const int lane_ = otid() & 63, wave_ = otid() >> 6; \
    _Pragma("unroll") for (int ni_ = 0; ni_ < 4; ++ni_) _Pragma("unroll") for (int mi_ = 0; mi_ < 4; ++mi_) { \
        const int n = (n0) + (wave_ >> 1) * 64 + ni_ * 16 + (lane_ >> 4) * 4; const int m = (m0) + (wave_ & 1) * 64 + mi_ * 16 + (lane_ & 15); const f32x4 v = acc[ni_][mi_]; BODY } }
__device__ __forceinline__ u32x2 pack4(float a, float b, float c, float d) { u32x2 r; r.x = pack2bf(a, b); r.y = pack2bf(c, d); return r; }

__device__ __forceinline__ void convert_wt_job(const float* W, int K, int N, int Npad, bf16_t* out, int job, float* T, int ilv) {
    const int tid = otid();
    const int nkt = K / 64;
    const int n0 = (job / nkt) * 64, k0 = (job % nkt) * 64;
    __syncthreads();
    float wv_[4096 / NTHREADS];
#pragma unroll
    for (int it_ = 0; it_ < 4096 / NTHREADS; ++it_) {
        const int idx = tid + it_ * NTHREADS;
        const int kk = idx >> 6, nn = idx & 63;
        const int nr = n0 + nn; int src = ilv ? ((nr & 1) ? (N / 2 + (nr >> 1)) : (nr >> 1)) : nr;
        src = src < N ? src : N - 1;
        wv_[it_] = W[(size_t)(k0 + kk) * N + src];
    }
#pragma unroll
    for (int it_ = 0; it_ < 4096 / NTHREADS; ++it_) {
        const int idx = tid + it_ * NTHREADS;
        const int kk = idx >> 6, nn = idx & 63;
        T[kk * 65 + nn] = (n0 + nn < N) ? wv_[it_] : 0.f;
    }
    __syncthreads();
    {
        int nn = tid >> 2, part = tid & 3;
        unsigned w[8];
#pragma unroll
        for (int j = 0; j < 8; ++j) w[j] = pack2bf(T[(part * 16 + 2 * j) * 65 + nn], T[(part * 16 + 2 * j + 1) * 65 + nn]);
        u32x4* o = (u32x4*)(out + (size_t)(n0 + nn) * K + k0 + part * 16);
        o[0] = (u32x4){w[0], w[1], w[2], w[3]}; o[1] = (u32x4){w[4], w[5], w[6], w[7]};
    }
}
__device__ __forceinline__ void phase_convert_weights(const P& p, int l, char* smem, int bid, int nb) {
    float* T = (float*)smem;
    struct Item { const float* W; int K, N, Npad; bf16_t* out; };
    const Item items[12] = {
        {p.in[I_RW2] + ((size_t)l * 2 + 0) * 64 * RW, 64, RW, NPAD(RW), p.WT_W2},
        {p.in[I_RW2] + ((size_t)l * 2 + 1) * 64 * RW, 64, RW, NPAD(RW), p.WT_W2 + (size_t)NPAD(RW) * 64},
        {p.in[I_RA2] + ((size_t)l * 2 + 0) * 64 * RW, 64, RW, NPAD(RW), p.WT_A2},
        {p.in[I_RA2] + ((size_t)l * 2 + 1) * 64 * RW, 64, RW, NPAD(RW), p.WT_A2 + (size_t)NPAD(RW) * 64},
        {p.in[I_WIN] + (size_t)l * D_MODEL * D_IN, D_MODEL, D_IN, NPAD192(D_IN), p.WT_IN},
        {p.in[I_RG2] + (size_t)l * 128 * RW, 128, RW, RW, p.WT_G2},
        {p.in[I_S5GLU] + (size_t)l * SW * 2 * SW, SW, 2 * SW, 2 * SW, p.WT_GLU},
        {p.in[I_WBR] + ((size_t)l * 3 + 0) * BW * D_MODEL, BW, D_MODEL, D_MODEL, p.WT_BR},
        {p.in[I_WBR] + ((size_t)l * 3 + 1) * BW * D_MODEL, BW, D_MODEL, D_MODEL, p.WT_BR + (size_t)D_MODEL * BW},
        {p.in[I_WBR] + ((size_t)l * 3 + 2) * BW * D_MODEL, BW, D_MODEL, D_MODEL, p.WT_BR + (size_t)2 * D_MODEL * BW},
        {p.in[I_WOUT] + (size_t)l * D_MODEL * D_MODEL, D_MODEL, D_MODEL, D_MODEL, p.WT_OUT},
        {p.in[I_PWQ] + (size_t)l * D_MODEL * PQ, D_MODEL, PQ, PQ, p.WT_Q}};
    int base = 0;
#pragma unroll
    for (int it = 0; it < 12; ++it) {
        const int nj = (items[it].Npad / 64) * (items[it].K / 64);
        for (int j = (bid + nb - (base % nb)) % nb; j < nj; j += nb)
            convert_wt_job(items[it].W, items[it].K, items[it].N, items[it].Npad, items[it].out, j, T, it == 6);
        base += nj;
    }
    __syncthreads();
    {
        const float* ks = p.in[I_PKEYS] + (size_t)l * PH * 2 * 128 * 128;
        for (size_t i = (size_t)bid * NTHREADS + otid(); i < (size_t)PH * 2 * 128 * 128; i += (size_t)nb * NTHREADS) {
            const float v = ks[i]; const bf16_t hb = f2bf(v);
            p.KHI[i] = hb; p.KLO[i] = f2bf(v - bf2f(hb));
        }
    }
}

#ifdef EMU
__device__ __forceinline__ int xcd_rank() { return obid(); }
#else
__device__ __forceinline__ int xcd_rank() { return (int)((volatile LAS unsigned*)(unsigned)(SMEM_BYTES))[2]; }
#endif
__device__ __forceinline__ bool tile_map(int it, int ntm, int ntn, int PM, int& mt, int& nt) {
    const int G = gridDim.x;
    const long id = (long)it * G + xcd_rank();
    if (id >= (long)ntm * ntn) return false;
    const int full = ntm / PM; const long fullsz = (long)full * PM * ntn;
    if (id < fullsz) { const int p = (int)(id / (PM * ntn)), rem = (int)(id % (PM * ntn)); nt = rem / PM; mt = p * PM + rem % PM; }
    else { const int rem = (int)(id - fullsz), hh = ntm - full * PM; nt = rem / hh; mt = full * PM + rem % hh; }
    return true;
}

template <int NI, int MI, class Pre, class Post>
__device__ __forceinline__ void gemm_tile_run(const bf16_t* Wt, int ldw, size_t wbytes, const bf16_t* Act, int lda, size_t abytes, int K, int n0, int m0, bf16_t* lds, Pre pre, Post post) {
    f32x4 acc[NI][MI];
#pragma unroll
    for (int i = 0; i < NI; ++i)
#pragma unroll
        for (int j = 0; j < MI; ++j) acc[i][j] = (f32x4){0.f, 0.f, 0.f, 0.f};
    pre(m0, n0, acc, lds);
    mfma_gemm_tile_t<NI, MI>(Wt, ldw, wbytes, Act, lda, abytes, K, n0, m0, lds, acc);
    const int lane = otid() & 63, wave = otid() >> 6;
#pragma unroll
    for (int ni = 0; ni < NI; ++ni)
#pragma unroll
        for (int mi = 0; mi < MI; ++mi)
            post(ni, mi, m0 + (wave & 1) * 16 * MI + mi * 16 + (lane & 15), n0 + (wave >> 1) * 16 * NI + ni * 16 + (lane >> 4) * 4, acc[ni][mi]);
}
struct NoPre { template <class A> __device__ __forceinline__ void operator()(int, int, A&, bf16_t*) const {} };
template <int NI, class PreM, class PreT, class Post>
__device__ __forceinline__ void gemm_phase(const bf16_t* Wt, int ldw, size_t wbytes, const bf16_t* Act, int lda, size_t abytes, int K, int N, bf16_t* lds, PreM prem, PreT pret, Post post) {
    const int ntn = N / (32 * NI), ntm = MTOT / 256 - 1;
    const int PM = (ntn >= 16) ? 2 : ((ntn >= 8) ? 4 : 8);
    for (int it = 0;; ++it) {
        int mt_, nt_; if (!tile_map(it, ntm, ntn, PM, mt_, nt_)) break;
        gemm_tile_run<NI, 8>(Wt, ldw, wbytes, Act, lda, abytes, K, nt_ * 32 * NI, mt_ * 256, lds, prem, post);
    }
    for (int job = obid(); job < 4 * ntn; job += gridDim.x)
        gemm_tile_run<NI, 2>(Wt, ldw, wbytes, Act, lda, abytes, K, (job >> 2) * 32 * NI, MTOT - 256 + (job & 3) * 64, lds, pret, post);
}

__device__ __forceinline__ void phase_init(const P& p, char* smem) {
    const int tid = otid();
    float* sc = (float*)smem;
    for (int i = tid; i < D_MODEL; i += NTHREADS) { sc[i] = siluf_(p.in[I_CCTX][i]); sc[D_MODEL + i] = siluf_(p.in[I_C][i]); }
    __syncthreads();
    float* red = sc + 2 * D_MODEL;
    const int ncb = (6 * D_MODEL) / 128;
    for (int job = obid(); job < DEPTH * ncb; job += gridDim.x) {
        const int l = job / ncb, col = tid & 127, kh = tid >> 7, n = (job % ncb) * 128 + col;
        const float* w = p.in[I_WMOD] + (size_t)l * D_MODEL * 6 * D_MODEL + n + (size_t)kh * (D_MODEL / 2) * 6 * D_MODEL;
        const float* s0 = sc + kh * (D_MODEL / 2); const float* s1 = sc + D_MODEL + kh * (D_MODEL / 2);
        float a0 = 0.f, a1 = 0.f;
#pragma unroll 16
        for (int k = 0; k < D_MODEL / 2; ++k) { const float wv = w[(size_t)k * 6 * D_MODEL]; a0 += s0[k] * wv; a1 += s1[k] * wv; }
        red[(kh * 128 + col) * 2 + 0] = a0; red[(kh * 128 + col) * 2 + 1] = a1;
        __syncthreads();
        if (kh == 0) {
            a0 += red[(128 + col) * 2 + 0]; a1 += red[(128 + col) * 2 + 1];
            const float b = p.in[I_BMOD][l * 6 * D_MODEL + n];
            p.MOD[(size_t)(l * 2 + 0) * 6 * D_MODEL + n] = a0 + b;
            p.MOD[(size_t)(l * 2 + 1) * 6 * D_MODEL + n] = a1 + b;
        }
        __syncthreads();
    }
    {
        const size_t gtid = (size_t)obid() * NTHREADS + tid, gn = (size_t)gridDim.x * NTHREADS;
        const float4* sa = (const float4*)p.in[I_CTX]; const float4* sb = (const float4*)p.in[I_X]; float4* d4 = (float4*)p.X;
        const size_t na = (size_t)CTX * D_MODEL / 4, nb_ = (size_t)SEQ * D_MODEL / 4;
        size_t i = gtid;
        for (; i + 7 * gn < na + nb_; i += 8 * gn) {
            float4 v0, v1, v2, v3, v4, v5, v6, v7;
#define CP_LD(V, U) { const size_t j_ = i + (U) * gn; V = (j_ < na) ? sa[j_] : sb[j_ - na]; }
            CP_LD(v0, 0) CP_LD(v1, 1) CP_LD(v2, 2) CP_LD(v3, 3) CP_LD(v4, 4) CP_LD(v5, 5) CP_LD(v6, 6) CP_LD(v7, 7)
#undef CP_LD
            d4[i] = v0; d4[i + gn] = v1; d4[i + 2 * gn] = v2; d4[i + 3 * gn] = v3; d4[i + 4 * gn] = v4; d4[i + 5 * gn] = v5; d4[i + 6 * gn] = v6; d4[i + 7 * gn] = v7;
        }
        for (; i < na + nb_; i += gn) d4[i] = (i < na) ? sa[i] : sb[i - na];
    }
    __syncthreads();
}

__device__ __forceinline__ void phase_s5const(const P& p, int l) {
    const size_t gtid = (size_t)obid() * NTHREADS + otid(), gn = (size_t)gridDim.x * NTHREADS;
    for (size_t i = gtid; i < (size_t)2 * SG * 64; i += gn) {
        int d = (int)(i / (SG * 64)), g = (int)((i / 64) % SG), s = (int)(i % 64);
        size_t li = ((size_t)(l * 2 + d) * SG + g) * 64 + s;
        float lre = p.in[I_S5LRE][li], lim = p.in[I_S5LIM][li];
        float dt = expf(p.in[I_S5LS][(l * 2 + d) * SG + g]);
        float mag = expf(lre * dt);
        float are = mag * cosf(lim * dt), aim = mag * sinf(lim * dt);
        float den = lre * lre + lim * lim;
        float fre = ((are - 1.0f) * lre + aim * lim) / den;
        float fim = (aim * lre - (are - 1.0f) * lim) / den;
        p.S5A[i * 2 + 0] = are; p.S5A[i * 2 + 1] = aim;
        const float* bre = p.in[I_S5BRE] + (((size_t)l * SG + g) * 64 + s) * 16;
        const float* bim = p.in[I_S5BIM] + (((size_t)l * SG + g) * 64 + s) * 16;
        float br_[16], bi_[16];
#pragma unroll
        for (int c = 0; c < 16; ++c) { br_[c] = bre[c]; bi_[c] = bim[c]; }
#pragma unroll
        for (int c = 0; c < 16; ++c) {
            p.S5BB[(i * 16 + c) * 2 + 0] = fre * br_[c] - fim * bi_[c];
            p.S5BB[(i * 16 + c) * 2 + 1] = fre * bi_[c] + fim * br_[c];
        }
    }
}

__device__ __forceinline__ void phase_norm(const P& p, int l, int which) {
    const int lane = otid() & 63;
    const int gw = (obid() * NTHREADS + otid()) >> 6, nw = (gridDim.x * NTHREADS) >> 6;
    const float* g = p.in[which ? I_N2G : I_N1G] + l * D_MODEL;
    constexpr int NJ = (D_MODEL + 255) / 256;
    float4 vn[NJ];
#pragma unroll
    for (int j = 0; j < NJ; ++j) { const int e = j * 256 + lane * 4; vn[j] = (e < D_MODEL && gw < MTOT) ? *(const float4*)(p.X + (size_t)gw * D_MODEL + e) : (float4){0.f, 0.f, 0.f, 0.f}; }
    for (int t = gw; t < MTOT; t += nw) {
        const float* mod = p.MOD + (size_t)(l * 2 + (t >= CTX ? 1 : 0)) * 6 * D_MODEL + (which ? 3 * D_MODEL : 0);
        float4 v[NJ]; float ss = 0.f;
#pragma unroll
        for (int j = 0; j < NJ; ++j) v[j] = vn[j];
        if (t + nw < MTOT) {
#pragma unroll
            for (int j = 0; j < NJ; ++j) { const int e = j * 256 + lane * 4; if (e < D_MODEL) vn[j] = *(const float4*)(p.X + (size_t)(t + nw) * D_MODEL + e); }
        }
#pragma unroll
        for (int j = 0; j < NJ; ++j) ss += v[j].x * v[j].x + v[j].y * v[j].y + v[j].z * v[j].z + v[j].w * v[j].w;
        ss = wave_sum(ss);
        const float rstd = rsqrtf(ss / D_MODEL + 1e-6f);
#pragma unroll
        for (int j = 0; j < NJ; ++j) {
            const int e = j * 256 + lane * 4;
            if (e < D_MODEL) {
                const float4 gg = *(const float4*)(g + e), sc = *(const float4*)(mod + D_MODEL + e), sh = *(const float4*)(mod + e);
                *(u32x2*)(p.H + (size_t)t * D_MODEL + e) = pack4(v[j].x * rstd * gg.x * (1.0f + sc.x) + sh.x, v[j].y * rstd * gg.y * (1.0f + sc.y) + sh.y,
                                                                 v[j].z * rstd * gg.z * (1.0f + sc.z) + sh.z, v[j].w * rstd * gg.w * (1.0f + sc.w) + sh.w);
            }
        }
    }
}

__device__ __forceinline__ void phase_gemm_in(const P& p, int l, char* smem) {
    constexpr int NI = 6, MI = 8;
    const int ntn = NPAD192(D_IN) / 192, ntm = MTOT / 256;
    for (int it = 0;; ++it) {
        int mt_, nt_; if (!tile_map(it, ntm, ntn, 4, mt_, nt_)) break;
        const int m0 = mt_ * 256, n0 = nt_ * 192;
        f32x4 acc[NI][MI];
#pragma unroll
        for (int i = 0; i < NI; ++i)
#pragma unroll
            for (int j = 0; j < MI; ++j) acc[i][j] = (f32x4){0.f, 0.f, 0.f, 0.f};
        mfma_gemm_tile_t<NI, MI>(p.WT_IN, D_MODEL, (size_t)NPAD192(D_IN) * D_MODEL * 2, p.H, D_MODEL, (size_t)MTOT * D_MODEL * 2, D_MODEL, n0, m0, (bf16_t*)smem, acc);
        const int lane = otid() & 63, wave = otid() >> 6;
#pragma unroll
        for (int ni = 0; ni < NI; ++ni)
#pragma unroll
            for (int mi = 0; mi < MI; ++mi) {
                const int n = n0 + (wave >> 1) * 16 * NI + ni * 16 + (lane >> 4) * 4, m = m0 + (wave & 1) * 16 * MI + mi * 16 + (lane & 15);
                const u32x2 pk_ = pack4(acc[ni][mi][0], acc[ni][mi][1], acc[ni][mi][2], acc[ni][mi][3]);
                if (n < ZG) *(u32x2*)(p.Z + (size_t)m * ZLD + n) = pk_;
                else if (n < D_IN) *(u32x2*)(p.ZGT + ((((size_t)(m >> 4) * (3 * D_MODEL / 16) + ((n - ZG) >> 4)) * 64 + lane) * 4)) =
                    pack4(sigmoidf_(acc[ni][mi][0]), sigmoidf_(acc[ni][mi][1]), sigmoidf_(acc[ni][mi][2]), sigmoidf_(acc[ni][mi][3]));
            }
    }
}

__device__ __forceinline__ void unpack8(const u32x4 w, float (&f)[8]) {
    f[0] = LO16(w.x); f[1] = HI16(w.x); f[2] = LO16(w.y); f[3] = HI16(w.y); f[4] = LO16(w.z); f[5] = HI16(w.z); f[6] = LO16(w.w); f[7] = HI16(w.w);
}
__device__ __forceinline__ u32x4 pack8(const float (&f)[8]) {
    u32x4 o; o.x = pack2bf(f[0], f[1]); o.y = pack2bf(f[2], f[3]);
    o.z = pack2bf(f[4], f[5]); o.w = pack2bf(f[6], f[7]); return o;
}
__device__ __forceinline__ void load8f(const float* p, float (&f)[8]) {
    const float4 a = *(const float4*)p, b = *(const float4*)(p + 4);
    f[0] = a.x; f[1] = a.y; f[2] = a.z; f[3] = a.w; f[4] = b.x; f[5] = b.y; f[6] = b.z; f[7] = b.w;
}
__device__ __forceinline__ void store8f(float* p, const float (&f)[8]) {
    float4 a, b; a.x = f[0]; a.y = f[1]; a.z = f[2]; a.w = f[3]; b.x = f[4]; b.y = f[5]; b.z = f[6]; b.w = f[7];
    *(float4*)p = a; *(float4*)(p + 4) = b;
}
__device__ __forceinline__ void conv8(const bf16_t* zp, const float* conv, int c0, bool act, bool first, bool last, float (&out)[8]) {
    const u32x4 z4 = {0u, 0u, 0u, 0u};
    const u32x4 a0 = act ? *(const u32x4*)(zp + c0) : z4;
    const u32x4 am = (act && !first) ? *(const u32x4*)(zp + c0 - ZLD) : z4;
    const u32x4 an = (act && !last) ? *(const u32x4*)(zp + c0 + ZLD) : z4;
    float w0[8], w1[8], w2[8], f0[8], fm[8], fn[8];
    if (act) { load8f(conv + c0, w0); load8f(conv + RWKV_IN + c0, w1); load8f(conv + 2 * RWKV_IN + c0, w2); }
    else {
#pragma unroll
        for (int e = 0; e < 8; ++e) { w0[e] = 0.f; w1[e] = 0.f; w2[e] = 0.f; }
    }
    unpack8(a0, f0); unpack8(am, fm); unpack8(an, fn);
#pragma unroll
    for (int e = 0; e < 8; ++e) out[e] = w1[e] * f0[e] + w0[e] * fm[e] + w2[e] * fn[e];
}
__device__ __forceinline__ void phase_rwkv_prep1(const P& p, int l) {
    const int lane = otid() & 63;
    const int gw = (obid() * NTHREADS + otid()) >> 6, nw = (gridDim.x * NTHREADS) >> 6;
    const float* conv = p.in[I_RCONV] + (size_t)l * 3 * RWKV_IN;
    const float* k_k = p.in[I_RKK] + (size_t)l * RW;
    const bool act = lane * 8 < RW, act2 = lane * 8 < 384;
    float kkw[8];
    if (act) load8f(k_k + lane * 8, kkw);
    else {
#pragma unroll
        for (int e = 0; e < 8; ++e) kkw[e] = 0.f;
    }
    for (int t = gw; t < MTOT; t += nw) {
        const bool first = (t == 0) || (t == CTX), last = (t == CTX - 1) || (t == MTOT - 1);
        const bf16_t* zp = p.Z + (size_t)t * ZLD + ZR;
        float rv[8], kv[8], vv[8], lr[8];
        conv8(zp, conv, 0 * RW + lane * 8, act, first, last, rv);
        conv8(zp, conv, 1 * RW + lane * 8, act, first, last, kv);
        conv8(zp, conv, 2 * RW + lane * 8, act, first, last, vv);
        conv8(zp, conv, 3 * RW + lane * 8, act2, first, last, lr);
        float kk[8]; float ss = 0.f;
#pragma unroll
        for (int e = 0; e < 8; ++e) { kk[e] = kv[e] * kkw[e]; ss += kk[e] * kk[e]; }
        ss += __shfl_xor(ss, 1, 64); ss += __shfl_xor(ss, 2, 64); ss += __shfl_xor(ss, 4, 64);
        const float inv = 1.0f / fmaxf(sqrtf(ss), 1e-12f);
#pragma unroll
        for (int e = 0; e < 8; ++e) kk[e] *= inv;
        if (act) {
            const size_t o = (size_t)t * RW + lane * 8;
            *(u32x4*)(p.R + o) = pack8(rv); *(u32x4*)(p.KS + o) = pack8(kv); *(u32x4*)(p.V + o) = pack8(vv); *(u32x4*)(p.KK + o) = pack8(kk);
        }
        if (act2) {
            const int cc = lane * 8;
            if (cc < 128) {
#pragma unroll
                for (int e = 0; e < 8; ++e) lr[e] = tanhf_(lr[e]);
                *(u32x4*)(p.LR + (size_t)t * 256 + cc) = pack8(lr);
            } else if (cc < 256) {
                *(u32x4*)(p.LR + (size_t)t * 256 + cc) = pack8(lr);
            } else {
#pragma unroll
                for (int e = 0; e < 8; ++e) lr[e] = sigmoidf_(lr[e]);
                *(u32x4*)(p.GS + (size_t)t * 128 + cc - 256) = pack8(lr);
            }
        }
    }
}
__device__ __forceinline__ void phase_rwkv_prep2(const P& p, int l, char* smem) {
    const int ntm = MTOT / 128, ntn = NPAD(RW) / 128;
    const float* k_a = p.in[I_RKA] + (size_t)l * RW;
    const float* r_k = p.in[I_RRK] + (size_t)l * RW;
    for (int job = obid(); job < ntm * ntn * 2; job += gridDim.x) {
        const int d = job % 2, n0 = ((job / 2) % ntn) * 128, m0 = (job / (2 * ntn)) * 128;
        const float* w0 = p.in[I_RW0] + (size_t)(l * 2 + d) * RW;
        const float* a0 = p.in[I_RA0] + (size_t)(l * 2 + d) * RW;
        f32x4 accw[4][4], acca[4][4]; ZERO_ACC4(accw); ZERO_ACC4(acca);
        mfma_gemm_tile(p.WT_W2 + (size_t)d * NPAD(RW) * 64, 64, p.LR + d * 64, 256, 64, n0, m0, (bf16_t*)smem, accw);
        mfma_gemm_tile(p.WT_A2 + (size_t)d * NPAD(RW) * 64, 64, p.LR + 128 + d * 64, 256, 64, n0, m0, (bf16_t*)smem, acca);
        const int lane = otid() & 63, wave = otid() >> 6;
#pragma unroll
        for (int mi = 0; mi < 4; ++mi) {
            const int m = m0 + (wave & 1) * 64 + mi * 16 + (lane & 15);
            float bon = 0.f;
#pragma unroll
            for (int ni = 0; ni < 4; ++ni) {
                const int n = n0 + (wave >> 1) * 64 + ni * 16 + (lane >> 4) * 4;
                if (n < RW) {
                    const u32x2 kq = *(const u32x2*)(p.KS + (size_t)m * RW + n), kkq = *(const u32x2*)(p.KK + (size_t)m * RW + n), rq = *(const u32x2*)(p.R + (size_t)m * RW + n);
                    const float kv[4] = {LO16(kq.x), HI16(kq.x), LO16(kq.y), HI16(kq.y)};
                    const float kkv[4] = {LO16(kkq.x), HI16(kkq.x), LO16(kkq.y), HI16(kkq.y)};
                    const float rv[4] = {LO16(rq.x), HI16(rq.x), LO16(rq.y), HI16(rq.y)};
                    float lw[4], kd[4], bb[4];
#pragma unroll
                    for (int e = 0; e < 4; ++e) {
                        const float x = w0[n + e] + accw[ni][mi][e];
                        lw[e] = -fexp_(-softplusf_(-x) - 0.5f);
                        const float aa = sigmoidf_(a0[n + e] + acca[ni][mi][e]);
                        kd[e] = kv[e] * (1.0f + (aa - 1.0f) * k_a[n + e]);
                        bb[e] = kkv[e] * aa;
                        bon += rv[e] * kd[e] * r_k[n + e];
                    }
                    const size_t o = ((size_t)d * MTOT + m) * RW + n;
                    float4 lo4; lo4.x = lw[0]; lo4.y = lw[1]; lo4.z = lw[2]; lo4.w = lw[3];
                    *(float4*)(p.LW + o) = lo4;
                    *(u32x2*)(p.KD + o) = pack4(kd[0], kd[1], kd[2], kd[3]);
                    *(u32x2*)(p.BB + o) = pack4(bb[0], bb[1], bb[2], bb[3]);
                }
            }
            bon += __shfl_xor(bon, 16, 64); bon += __shfl_xor(bon, 32, 64);
            const int hh = (n0 + (wave >> 1) * 64) >> 6;
            if ((lane >> 4) == 0 && hh < RH) p.BONUS[((size_t)d * MTOT + m) * RH + hh] = bon;
        }
    }
}

#define CH_ROW 72
#define SEQ_REC 16640
#define CH_SLOT (64 * CH_ROW)
#define CH_XR_OFF (7 * CH_SLOT * 2)
#define CH_AAB_OFF (CH_XR_OFF + 64 * 132 * 4)
#define CH_GC_OFF (CH_AAB_OFF + 64 * 72 * 4)
template <int MT, int NT>
__device__ __forceinline__ void lds_mm(const bf16_t* A, int m0, const bf16_t* Bt, int n0, f32x4 (&acc)[MT][NT]) {
    const int lane = otid() & 63, q = lane >> 4, r = lane & 15;
#pragma unroll
    for (int s = 0; s < 2; ++s) {
        bf16x8 a[MT], b[NT];
#pragma unroll
        for (int i = 0; i < MT; ++i) a[i] = *(const bf16x8*)(A + (m0 + i * 16 + r) * CH_ROW + s * 32 + q * 8);
#pragma unroll
        for (int i = 0; i < NT; ++i) b[i] = *(const bf16x8*)(Bt + (n0 + i * 16 + r) * CH_ROW + s * 32 + q * 8);
#pragma unroll
        for (int i = 0; i < MT; ++i)
#pragma unroll
            for (int jj = 0; jj < NT; ++jj) acc[i][jj] = MFMA16(a[i], b[jj], acc[i][jj]);
    }
}
struct ChunkPre { bf16x8 fw[2], fa[2]; };
__device__ __forceinline__ void rwkv_chunk_fetch(const P& p, int job, ChunkPre& c) {
    const int tid = otid(), lane = tid & 63, wv = tid >> 6, q = lane >> 4, r = lane & 15;
    const int d = job / (NC * RH), n = (job / RH) % NC;
    const int iw = 16 * wv + r; const int tokw = 64 * n + (d ? 63 - iw : iw);
#pragma unroll
    for (int s2 = 0; s2 < 2; ++s2) {
        c.fw[s2] = *(const bf16x8*)(p.LR + (size_t)tokw * 256 + d * 64 + s2 * 32 + q * 8);
        c.fa[s2] = *(const bf16x8*)(p.LR + (size_t)tokw * 256 + 128 + d * 64 + s2 * 32 + q * 8);
    }
}
__device__ __forceinline__ void rwkv_chunk_job(const P& p, int l, int job, int next_job, ChunkPre& pre, char* smem) {
    const int tid = otid(), lane = tid & 63, wv = tid >> 6, q = lane >> 4, r = lane & 15;
    const int d = job / (NC * RH), n = (job / RH) % NC, h = job % RH;
    const size_t base = (size_t)(d * NC + n) * RH + h;
    bf16_t* S0 = (bf16_t*)smem; bf16_t* S1 = S0 + CH_SLOT; bf16_t* S2 = S1 + CH_SLOT; bf16_t* S3 = S2 + CH_SLOT;
    bf16_t* S4 = S3 + CH_SLOT; bf16_t* S5 = S4 + CH_SLOT; bf16_t* S6 = S5 + CH_SLOT;
    float* X = (float*)(smem + CH_XR_OFF);
    float* AABt = (float*)(smem + CH_AAB_OFF);
    bf16_t* U0t = (bf16_t*)(smem + CH_AAB_OFF);
    bf16_t* Aht = U0t + CH_SLOT;
    float* GC = (float*)(smem + CH_GC_OFF);
    __syncthreads();
    u32x4 gkk[2], gr[2], gv[2], gks[2];
#pragma unroll
    for (int it = 0; it < 2; ++it) {
        const int c = tid + 256 * it, i = c >> 3, k0 = (c & 7) * 8; const int tok = 64 * n + (d ? 63 - i : i);
        const size_t o1 = (size_t)tok * RW + h * 64 + k0;
        gkk[it] = *(const u32x4*)(p.KK + o1); gr[it] = *(const u32x4*)(p.R + o1); gv[it] = *(const u32x4*)(p.V + o1); gks[it] = *(const u32x4*)(p.KS + o1);
    }
    {
        const bf16_t* w2 = p.WT_W2 + ((size_t)d * NPAD(RW) + h * 64) * 64; const bf16_t* a2 = p.WT_A2 + ((size_t)d * NPAD(RW) + h * 64) * 64;
        const float* w0 = p.in[I_RW0] + (size_t)(l * 2 + d) * RW + h * 64; const float* a0 = p.in[I_RA0] + (size_t)(l * 2 + d) * RW + h * 64;
        bf16x8 bwf[4][2], baf[4][2];
#pragma unroll
        for (int nt = 0; nt < 4; ++nt)
#pragma unroll
            for (int s2 = 0; s2 < 2; ++s2) {
                bwf[nt][s2] = *(const bf16x8*)(w2 + (size_t)(nt * 16 + r) * 64 + s2 * 32 + q * 8);
                baf[nt][s2] = *(const bf16x8*)(a2 + (size_t)(nt * 16 + r) * 64 + s2 * 32 + q * 8);
            }
#ifndef EMU
        __builtin_amdgcn_sched_barrier(0);
#endif
#pragma unroll
        for (int nt = 0; nt < 4; ++nt) {
            f32x4 cw = {0.f, 0.f, 0.f, 0.f}, ca = {0.f, 0.f, 0.f, 0.f};
#pragma unroll
            for (int s2 = 0; s2 < 2; ++s2) { cw = MFMA16(pre.fw[s2], bwf[nt][s2], cw); ca = MFMA16(pre.fa[s2], baf[nt][s2], ca); }
            const float w0c = w0[nt * 16 + r], a0c = a0[nt * 16 + r];
#pragma unroll
            for (int e = 0; e < 4; ++e) {
                const int i = 16 * wv + 4 * q + e;
                X[i * 132 + nt * 16 + r] = -fexp_(-softplusf_(-(w0c + cw[e])) - 0.5f);
                X[i * 132 + 64 + nt * 16 + r] = sigmoidf_(a0c + ca[e]);
            }
        }
    }
    __syncthreads();
    {
        const int k = tid & 63, seg = tid >> 6;
        float v[16]; float run = 0.f;
#pragma unroll
        for (int e = 0; e < 16; ++e) { run += X[(seg * 16 + e) * 132 + k]; v[e] = run; }
        AABt[seg * 64 + k] = run;
        __syncthreads();
        float off = 0.f;
        for (int s2 = 0; s2 < seg; ++s2) off += AABt[s2 * 64 + k];
#pragma unroll
        for (int e = 0; e < 16; ++e) X[(seg * 16 + e) * 132 + k] = v[e] + off;
    }
    __syncthreads();
#pragma unroll
    for (int it = 0; it < 2; ++it) {
        const int c = tid + 256 * it, i = c >> 3, k0 = (c & 7) * 8;
        float L[8], Lp[8], LC[8], kkv[8], rv[8], vv[8], kdv[8], bbv[8], aav[8], ksv[8], kav[8], rkv[8];
        load8f(X + i * 132 + k0, L); load8f(X + 63 * 132 + k0, LC); load8f(X + i * 132 + 64 + k0, aav);
        load8f(p.in[I_RKA] + (size_t)l * RW + h * 64 + k0, kav); load8f(p.in[I_RRK] + (size_t)l * RW + h * 64 + k0, rkv);
        if (i > 0) load8f(X + (i - 1) * 132 + k0, Lp);
        else {
#pragma unroll
            for (int e = 0; e < 8; ++e) Lp[e] = 0.f;
        }
        unpack8(gkk[it], kkv); unpack8(gr[it], rv); unpack8(gv[it], vv); unpack8(gks[it], ksv);
        float bon = 0.f;
#pragma unroll
        for (int e = 0; e < 8; ++e) { kdv[e] = ksv[e] * (1.0f + (aav[e] - 1.0f) * kav[e]); bbv[e] = kkv[e] * aav[e]; bon += rv[e] * kdv[e] * rkv[e]; }
        bon += __shfl_xor(bon, 1, 64); bon += __shfl_xor(bon, 2, 64); bon += __shfl_xor(bon, 4, 64);
        if ((tid & 7) == 0) p.BONUS[((size_t)d * MTOT + 64 * n + (d ? 63 - i : i)) * RH + h] = bon;
        float at[8], rt[8], bt[8], kt[8], bh[8], kh[8];
#pragma unroll
        for (int e = 0; e < 8; ++e) {
            const float eL = fexp_(L[e]), eLp = fexp_(Lp[e]), eNL = fexp_(-L[e]), eCL = fexp_(LC[e] - L[e]);
            at[e] = -kkv[e] * eLp; rt[e] = rv[e] * eL; bt[e] = bbv[e] * eNL; kt[e] = kdv[e] * eNL; bh[e] = bbv[e] * eCL; kh[e] = kdv[e] * eCL;
            if (i == 63) GC[k0 + e] = eL;
        }
        *(u32x4*)(S0 + i * CH_ROW + k0) = pack8(at);
        store8f(X + i * 132 + 64 + k0, at);
        *(u32x4*)(S1 + i * CH_ROW + k0) = pack8(rt);
        *(u32x4*)(S2 + i * CH_ROW + k0) = pack8(bt);
        *(u32x4*)(S3 + i * CH_ROW + k0) = pack8(kt);
#pragma unroll
        for (int e = 0; e < 8; ++e) {
            S4[(k0 + e) * CH_ROW + i] = f2bf(vv[e]);
            S5[(k0 + e) * CH_ROW + i] = f2bf(bh[e]);
            S6[(k0 + e) * CH_ROW + i] = f2bf(kh[e]);
        }
    }
    __syncthreads();
    {
        f32x4 acc[4][4]; ZERO_ACC4(acc);
        lds_mm<4, 4>((wv < 2) ? S0 : S1, 0, (wv & 1) ? S3 : S2, 0, acc);
        __syncthreads();
#pragma unroll
        for (int mt = 0; mt < 4; ++mt)
#pragma unroll
            for (int nt = 0; nt < 4; ++nt) {
                const int jc = nt * 16 + r, i0 = mt * 16 + 4 * q;
                if (wv == 0) {
                    f32x4 o;
#pragma unroll
                    for (int e = 0; e < 4; ++e) o[e] = (jc < i0 + e) ? acc[mt][nt][e] : 0.f;
                    *(f32x4*)(AABt + jc * 72 + i0) = o;
                } else {
                    bf16_t* dst = (wv == 1) ? S0 : ((wv == 2) ? S2 : S3);
#pragma unroll
                    for (int e = 0; e < 4; ++e) {
                        const bool ok = (wv == 1) ? (jc < i0 + e) : (jc <= i0 + e);
                        dst[(i0 + e) * CH_ROW + jc] = f2bf(ok ? acc[mt][nt][e] : 0.f);
                    }
                }
            }
    }
    __syncthreads();
    {
        f32x4 acc[1][4];
#pragma unroll
        for (int nt = 0; nt < 4; ++nt) acc[0][nt] = (f32x4){0.f, 0.f, 0.f, 0.f};
        lds_mm<1, 4>(S0, 16 * wv, S4, 0, acc);
#pragma unroll
        for (int nt = 0; nt < 4; ++nt)
#pragma unroll
            for (int e = 0; e < 4; ++e) X[(16 * wv + 4 * q + e) * 132 + nt * 16 + r] = acc[0][nt][e];
    }
    __syncthreads();
    if (next_job >= 0) rwkv_chunk_fetch(p, next_job, pre);
    if (tid < 128) {
        const int c = tid;
        for (int bi = 0; bi < 4; ++bi) {
            float acc[16];
#pragma unroll
            for (int e = 0; e < 16; ++e) acc[e] = X[(16 * bi + e) * 132 + c];
#pragma unroll 16
            for (int jj = 0; jj < 16 * bi; ++jj) {
                const float uj = X[jj * 132 + c];
                const f32x4* ap = (const f32x4*)(AABt + jj * 72 + 16 * bi);
                const f32x4 a0 = ap[0], a1 = ap[1], a2 = ap[2], a3 = ap[3];
#pragma unroll
                for (int e = 0; e < 4; ++e) { acc[e] += a0[e] * uj; acc[4 + e] += a1[e] * uj; acc[8 + e] += a2[e] * uj; acc[12 + e] += a3[e] * uj; }
            }
#pragma unroll
            for (int e = 0; e < 16; ++e) {
                const float u = acc[e];
                X[(16 * bi + e) * 132 + c] = u;
                const f32x4* ap = (const f32x4*)(AABt + (16 * bi + e) * 72 + 16 * bi);
                const f32x4 a0 = ap[0], a1 = ap[1], a2 = ap[2], a3 = ap[3];
#pragma unroll
                for (int e2 = 0; e2 < 16; ++e2) if (e2 > e) acc[e2] += ((e2 < 4) ? a0[e2 & 3] : (e2 < 8) ? a1[e2 & 3] : (e2 < 12) ? a2[e2 & 3] : a3[e2 & 3]) * u;
            }
        }
    }
    __syncthreads();
    if (tid < 128) {
        const int c = tid;
        bf16_t* dst = (c < 64) ? (U0t + c * CH_ROW) : (Aht + (c - 64) * CH_ROW);
        u32x4 ov[8];
#pragma unroll
        for (int g = 0; g < 8; ++g) {
            float v[8];
#pragma unroll
            for (int e = 0; e < 8; ++e) v[e] = X[(g * 8 + e) * 132 + c];
            ov[g].x = pack2bf(v[0], v[1]); ov[g].y = pack2bf(v[2], v[3]);
            ov[g].z = pack2bf(v[4], v[5]); ov[g].w = pack2bf(v[6], v[7]);
        }
#pragma unroll
        for (int g = 0; g < 8; ++g) *(u32x4*)(dst + g * 8) = ov[g];
    }
    __syncthreads();
    {
        f32x4 acc[4][4]; ZERO_ACC4(acc);
        char* rec = p.REC + base * SEQ_REC;
        if (wv == 0) {
            lds_mm<4, 4>(Aht, 0, S5, 0, acc);
#pragma unroll
            for (int nt = 0; nt < 4; ++nt)
#pragma unroll
                for (int s2 = 0; s2 < 2; ++s2) {
                    u32x4 o;
                    o.x = pack2bf(acc[2 * s2][nt][0], acc[2 * s2][nt][1]); o.y = pack2bf(acc[2 * s2][nt][2], acc[2 * s2][nt][3]);
                    o.z = pack2bf(acc[2 * s2 + 1][nt][0], acc[2 * s2 + 1][nt][1]); o.w = pack2bf(acc[2 * s2 + 1][nt][2], acc[2 * s2 + 1][nt][3]);
                    *(u32x4*)(rec + (((nt * 2 + s2) * 64 + lane) * 8) * 2) = o;
                }
        } else if (wv == 1) {
            lds_mm<4, 4>(S5, 0, U0t, 0, acc);
            lds_mm<4, 4>(S6, 0, S4, 0, acc);
#pragma unroll
            for (int mt = 0; mt < 4; ++mt)
#pragma unroll
                for (int nt = 0; nt < 4; ++nt) *(u32x2*)(rec + 8192 + (((nt * 4 + mt) * 64 + lane) * 4) * 2) = pack4(acc[mt][nt][0], acc[mt][nt][1], acc[mt][nt][2], acc[mt][nt][3]);
        } else if (wv == 2) {
            lds_mm<4, 4>(S2, 0, Aht, 0, acc);
#pragma unroll
            for (int mt = 0; mt < 4; ++mt)
#pragma unroll
                for (int nt = 0; nt < 4; ++nt)
#pragma unroll
                    for (int e = 0; e < 4; ++e) {
                        const int t = mt * 16 + 4 * q + e, kc = nt * 16 + r;
                        p.QH[(base * 64 + t) * 64 + kc] = f2bf(acc[mt][nt][e] + bf2f(S1[t * CH_ROW + kc]));
                    }
        } else if (wv == 3) {
            lds_mm<4, 4>(S2, 0, U0t, 0, acc);
            lds_mm<4, 4>(S3, 0, S4, 0, acc);
#pragma unroll
            for (int mt = 0; mt < 4; ++mt)
#pragma unroll
                for (int nt = 0; nt < 4; ++nt) *(f32x4*)(p.Y0T + (((base * 4 + mt) * 4 + nt) * 64 + lane) * 4) = acc[mt][nt];
        }
        if (tid < 64) ((float*)(rec + 16384))[tid] = GC[tid];
    }
}

#define SEQ_SLOT 16896
__device__ __forceinline__ void rwkv_seq_gload(const P& p, size_t base, int tid, u32x4 (&g)[5]) {
    const u32x4* m = (const u32x4*)(p.REC + base * SEQ_REC);
#pragma unroll
    for (int i = 0; i < 4; ++i) g[i] = m[tid + 256 * i];
    if (tid < 16) g[4] = m[1024 + tid];
}
__device__ __forceinline__ void rwkv_seq_lstore(char* slot, int tid, const u32x4 (&g)[5]) {
    u32x4* d = (u32x4*)slot;
#pragma unroll
    for (int i = 0; i < 4; ++i) d[tid + 256 * i] = g[i];
    if (tid < 16) d[1024 + tid] = g[4];
}
__device__ __forceinline__ void rwkv_seq_step(const P& p, const char* slot, size_t base, int wv, int lane, f32x4 (&X)[4]) {
    const int q = lane >> 4, r = lane & 15;
    const bf16_t* mt = (const bf16_t*)slot; const bf16_t* ntb = (const bf16_t*)(slot + 8192); const float* gc = (const float*)(slot + 16384);
    unsigned xh[4][2];
#pragma unroll
    for (int kt = 0; kt < 4; ++kt) {
        xh[kt][0] = pack2bf(X[kt][0], X[kt][1]); xh[kt][1] = pack2bf(X[kt][2], X[kt][3]);
        *(u32x2*)(p.SN + (base * 64 + 16 * wv + r) * 64 + 16 * kt + 4 * q) = (u32x2){xh[kt][0], xh[kt][1]};
    }
    bf16x8 bh[2];
#pragma unroll
    for (int s2 = 0; s2 < 2; ++s2) bh[s2] = __builtin_bit_cast(bf16x8, ((u32x4){xh[2 * s2][0], xh[2 * s2][1], xh[2 * s2 + 1][0], xh[2 * s2 + 1][1]}));
#pragma unroll
    for (int tile = 0; tile < 4; ++tile) {
        const u32x2 nb = *(const u32x2*)(ntb + ((wv * 4 + tile) * 64 + lane) * 4);
        const f32x4 g4 = *(const f32x4*)(gc + tile * 16 + 4 * q);
        f32x4 acc;
        acc[0] = g4[0] * X[tile][0] + LO16(nb.x); acc[1] = g4[1] * X[tile][1] + HI16(nb.x);
        acc[2] = g4[2] * X[tile][2] + LO16(nb.y); acc[3] = g4[3] * X[tile][3] + HI16(nb.y);
#pragma unroll
        for (int s2 = 0; s2 < 2; ++s2) {
            const bf16x8 ah = *(const bf16x8*)(mt + ((tile * 2 + s2) * 64 + lane) * 8);
            acc = MFMA16(ah, bh[s2], acc);
        }
        X[tile] = acc;
    }
}
__device__ __forceinline__ void rwkv_seq_job(const P& p, int job, char* smem) {
    const int tid = otid(), lane = tid & 63, wv = tid >> 6;
    const int d = job / RH, h = job % RH;
    f32x4 X[4];
#pragma unroll
    for (int kt = 0; kt < 4; ++kt) X[kt] = (f32x4){0.f, 0.f, 0.f, 0.f};
    u32x4 g0[5], g1[5], g2[5];
#define SEQ_BASE(s_) ((size_t)(d * NC + chunk_order(d, ((s_) < NC) ? (s_) : NC - 1)) * RH + h)
    __syncthreads();
    rwkv_seq_gload(p, SEQ_BASE(0), tid, g0);
    rwkv_seq_gload(p, SEQ_BASE(1), tid, g1);
    rwkv_seq_gload(p, SEQ_BASE(2), tid, g2);
    rwkv_seq_lstore(smem, tid, g0);
    __syncthreads();
    for (int s = 0; s < NC; s += 6) {
#define SEQ_SUB(u, GFREE, GNEXT) \
        if (s + (u) < NC) { \
            rwkv_seq_gload(p, SEQ_BASE(s + (u) + 3), tid, GFREE); \
            rwkv_seq_step(p, smem + (((u) & 1) ? SEQ_SLOT : 0), SEQ_BASE(s + (u)), wv, lane, X); \
            rwkv_seq_lstore(smem + (((u) & 1) ? 0 : SEQ_SLOT), tid, GNEXT); \
        } \
        __syncthreads();
        SEQ_SUB(0, g0, g1)
        SEQ_SUB(1, g1, g2)
        SEQ_SUB(2, g2, g0)
        SEQ_SUB(3, g0, g1)
        SEQ_SUB(4, g1, g2)
        SEQ_SUB(5, g2, g0)
#undef SEQ_SUB
    }
#undef SEQ_BASE
}
struct RoBuf { bf16x8 a[2]; bf16x8 b[4][2]; f32x4 y0[4]; };
__device__ __forceinline__ void rwkv_out_load(const P& p, int job, int wv, int lane, RoBuf& o) {
    const int q = lane >> 4, r = lane & 15;
    const size_t base = (size_t)job;
#pragma unroll
    for (int s2 = 0; s2 < 2; ++s2) {
        o.a[s2] = *(const bf16x8*)(p.QH + (base * 64 + 16 * wv + r) * 64 + s2 * 32 + q * 8);
#pragma unroll
        for (int nt = 0; nt < 4; ++nt) o.b[nt][s2] = *(const bf16x8*)(p.SN + (base * 64 + nt * 16 + r) * 64 + s2 * 32 + q * 8);
    }
#pragma unroll
    for (int nt = 0; nt < 4; ++nt) o.y0[nt] = *(const f32x4*)(p.Y0T + (((base * 4 + wv) * 4 + nt) * 64 + lane) * 4);
}
__device__ __forceinline__ void rwkv_out_compute(const P& p, int job, int wv, int lane, const RoBuf& o) {
    const int q = lane >> 4, r = lane & 15;
    const int d = job / (NC * RH), n = (job / RH) % NC, h = job % RH;
#pragma unroll
    for (int nt = 0; nt < 4; ++nt) {
        f32x4 acc = o.y0[nt];
        acc = MFMA16(o.a[0], o.b[nt][0], acc);
        acc = MFMA16(o.a[1], o.b[nt][1], acc);
#pragma unroll
        for (int e = 0; e < 4; ++e) {
            const int t = 16 * wv + 4 * q + e; const int tok = 64 * n + (d ? 63 - t : t);
            p.Y[((size_t)d * MTOT + tok) * RW + h * 64 + nt * 16 + r] = acc[e];
        }
    }
}
__device__ __forceinline__ void phase_rwkv_out(const P& p) {
    const int tid = otid(), lane = tid & 63, wv = tid >> 6;
    if (wv >= 4) return;
    const int G = gridDim.x, total = 2 * NC * RH;
    int job = obid();
    if (job >= total) return;
    RoBuf b0, b1;
    rwkv_out_load(p, job, wv, lane, b0);
    for (; job < total; job += 2 * G) {
        if (job + G < total) rwkv_out_load(p, job + G, wv, lane, b1);
        rwkv_out_compute(p, job, wv, lane, b0);
        if (job + G < total) {
            if (job + 2 * G < total) rwkv_out_load(p, job + 2 * G, wv, lane, b0);
            rwkv_out_compute(p, job + G, wv, lane, b1);
        }
    }
}

#define GL_QR 0
#define GL_KR 9216
#define GL_VT 18432
#define GL_QI 36864
#define GL_KI 46080
#define GL_AT 55296
#define GL_CUM 64512
#define GL_ALR 81920
#define GL_WA 86016
__device__ __forceinline__ void gla_load_qkv(const P& p, int n, int h, char* smem) {
    const int tid = otid();
    bf16_t* Qr = (bf16_t*)(smem + GL_QR); bf16_t* Kr = (bf16_t*)(smem + GL_KR); bf16_t* Vt = (bf16_t*)(smem + GL_VT);
#pragma unroll
    for (int it_ = 0; it_ < 512 / NTHREADS; ++it_) {
        const int c = tid + it_ * NTHREADS;
        const int row = c >> 3, part = c & 7; const int t = gla_tok(n, row);
        const u32x4 qv = *(const u32x4*)(p.Z + (size_t)t * ZLD + ZQ + h * 64 + part * 8);
        const u32x4 kv = *(const u32x4*)(p.Z + (size_t)t * ZLD + ZK + h * 64 + part * 8);
        u32x4 qs;
        qs.x = pack2bf(LO16(qv.x) * 0.125f, HI16(qv.x) * 0.125f);
        qs.y = pack2bf(LO16(qv.y) * 0.125f, HI16(qv.y) * 0.125f);
        qs.z = pack2bf(LO16(qv.z) * 0.125f, HI16(qv.z) * 0.125f);
        qs.w = pack2bf(LO16(qv.w) * 0.125f, HI16(qv.w) * 0.125f);
        *(u32x4*)(Qr + row * CH_ROW + part * 8) = qs;
        *(u32x4*)(Kr + row * CH_ROW + part * 8) = kv;
    }
#pragma unroll
    for (int it_ = 0; it_ < 1024 / NTHREADS; ++it_) {
        const int c = tid + it_ * NTHREADS;
        const int row = c >> 4, part = c & 15; const int t = gla_tok(n, row);
        const u32x4 vv = *(const u32x4*)(p.Z + (size_t)t * ZLD + ZV + h * 128 + part * 8);
        bf16_t* dst = Vt + (part * 8) * CH_ROW + row;
        dst[0 * CH_ROW] = (bf16_t)(vv.x & 0xFFFF); dst[1 * CH_ROW] = (bf16_t)(vv.x >> 16);
        dst[2 * CH_ROW] = (bf16_t)(vv.y & 0xFFFF); dst[3 * CH_ROW] = (bf16_t)(vv.y >> 16);
        dst[4 * CH_ROW] = (bf16_t)(vv.z & 0xFFFF); dst[5 * CH_ROW] = (bf16_t)(vv.z >> 16);
        dst[6 * CH_ROW] = (bf16_t)(vv.w & 0xFFFF); dst[7 * CH_ROW] = (bf16_t)(vv.w >> 16);
    }
}
__device__ __forceinline__ void gla_load_wa(const P& p, int l, int h, char* smem) {
    float* WA = (float*)(smem + GL_WA);
    for (int c = otid(); c < 2 * (16 * 64 + 64); c += NTHREADS) {
        const int d = c / 1088, cc = c % 1088;
        WA[c] = (cc < 1024) ? p.in[I_GLA_WA2][((size_t)(l * 2 + d) * 16 + (cc >> 6)) * GLA_K + h * 64 + (cc & 63)] : p.in[I_GLA_BA][(size_t)(l * 2 + d) * GLA_K + h * 64 + (cc - 1024)];
    }
}
__device__ __forceinline__ void gla_cum(const P& p, int l, int n, int h, int d, char* smem) {
    const int tid = otid(), lane = tid & 63, wv = tid >> 6, q = lane >> 4, r = lane & 15;
    float* CUM = (float*)(smem + GL_CUM); float* ALR = (float*)(smem + GL_ALR); const float* WA = (const float*)(smem + GL_WA) + d * 1088;
    if (wv < 4) {
        const bf16x8 zero8 = {0, 0, 0, 0, 0, 0, 0, 0};
        const int t = gla_tok(n, 16 * wv + r);
        const bf16x8 ub = (q < 2) ? *(const bf16x8*)(p.Z + (size_t)t * ZLD + (d ? ZAB : ZAF) + 8 * q) : zero8;
#pragma unroll
        for (int nt = 0; nt < 4; ++nt) {
            float f[8], lo[8];
#pragma unroll
            for (int e = 0; e < 8; ++e) f[e] = (q < 2) ? WA[(8 * q + e) * 64 + nt * 16 + r] : 0.f;
            const u32x4 hv = pack8(f);
            float hf[8]; unpack8(hv, hf);
#pragma unroll
            for (int e = 0; e < 8; ++e) lo[e] = f[e] - hf[e];
            f32x4 acc = {0.f, 0.f, 0.f, 0.f};
            acc = MFMA16(__builtin_bit_cast(bf16x8, hv), ub, acc);
            acc = MFMA16(__builtin_bit_cast(bf16x8, pack8(lo)), ub, acc);
            f32x4 o;
#pragma unroll
            for (int e = 0; e < 4; ++e) { const float a = acc[e] + WA[1024 + nt * 16 + 4 * q + e]; o[e] = (fminf(a, 0.f) - flog_(1.0f + fexp_(-fabsf(a)))) * (1.0f / 16.0f); }
            *(f32x4*)(CUM + (16 * wv + r) * 68 + nt * 16 + 4 * q) = o;
        }
    }
    __syncthreads();
    {
        const int k = tid & 63, seg = (tid >> 6) & 3;
        float v[16]; float run = 0.f;
        if (tid < 256) {
#pragma unroll
            for (int e = 0; e < 16; ++e) { const int pos = seg * 16 + e; const int i = d ? 63 - pos : pos; run += CUM[i * 68 + k]; v[e] = run; }
            ALR[seg * 64 + k] = run;
        }
        __syncthreads();
        if (tid < 256) {
            float off = 0.f;
            for (int s2 = 0; s2 < seg; ++s2) off += ALR[s2 * 64 + k];
#pragma unroll
            for (int e = 0; e < 16; ++e) { const int pos = seg * 16 + e; const int i = d ? 63 - pos : pos; CUM[i * 68 + k] = v[e] + off; }
        }
    }
    __syncthreads();
}
__device__ __forceinline__ void phase_gla_kv(const P& p, int l, char* smem) {
    const int tid = otid(), lane = tid & 63, wv = tid >> 6, q = lane >> 4, r = lane & 15;
    bf16_t* Kr = (bf16_t*)(smem + GL_KR); bf16_t* Vt = (bf16_t*)(smem + GL_VT); bf16_t* KdT = (bf16_t*)(smem + GL_KI);
    float* CUM = (float*)(smem + GL_CUM);
    int cur_h = -1;
    for (int job = (obid() + (int)gridDim.x - 64 % (int)gridDim.x) % (int)gridDim.x; job < NC * GH; job += gridDim.x) {
        const int n = job / GH, h = job % GH;
        __syncthreads();
        if (h != cur_h) { cur_h = h; gla_load_wa(p, l, h, smem); }
        gla_load_qkv(p, n, h, smem);
        __syncthreads();
        for (int d = 0; d < 2; ++d) {
            gla_cum(p, l, n, h, d, smem);
            const int li = d ? 0 : 63;
#pragma unroll
            for (int it_ = 0; it_ < 4096 / NTHREADS; ++it_) {
                const int idx = tid + it_ * NTHREADS;
                const int i = idx >> 6, k = idx & 63;
                KdT[k * CH_ROW + i] = f2bf(bf2f(Kr[i * CH_ROW + k]) * fexp_(CUM[li * 68 + k] - CUM[i * 68 + k]));
            }
            if (tid < 64) p.DEC[((size_t)(d * NC + n) * GH + h) * 64 + tid] = fexp_(CUM[li * 68 + tid]);
            __syncthreads();
            float* kvt = p.KV + ((size_t)(d * NC + n) * GH + h) * 8192;
            for (int mt = wv; mt < 4; mt += NTHREADS / 64) {
                f32x4 acc[1][8];
#pragma unroll
                for (int nt = 0; nt < 8; ++nt) acc[0][nt] = (f32x4){0.f, 0.f, 0.f, 0.f};
                lds_mm<1, 8>(KdT, 16 * mt, Vt, 0, acc);
#pragma unroll
                for (int nt = 0; nt < 8; ++nt) *(f32x4*)(kvt + (size_t)(nt * 16 + r) * 64 + 16 * mt + 4 * q) = acc[0][nt];
            }
            __syncthreads();
        }
    }
    __syncthreads();
}
__device__ __forceinline__ void gla_scan_job(const P& p, int job) {
    const int base = job * NTHREADS + otid();
    const int d = base / (GH * 8192), h = (base / 8192) % GH, e = base % 8192;
    const float* __restrict__ kvp = p.KV; const float* __restrict__ decp = p.DEC; bf16_t* __restrict__ sp = p.SP;
    float S = 0.f;
    for (int s = 0; s < NC; s += 4) {
        float kv[4], dc[4]; size_t oo[4];
#pragma unroll
        for (int u = 0; u < 4; ++u) {
            const int n = chunk_order(d, (s + u < NC) ? s + u : NC - 1);
            oo[u] = ((size_t)(d * NC + n) * GH + h);
            kv[u] = kvp[oo[u] * 8192 + e]; dc[u] = decp[oo[u] * 64 + (e & 63)];
        }
#pragma unroll
        for (int u = 0; u < 4; ++u) if (s + u < NC) { sp[oo[u] * 8192 + e] = f2bf(S); S = dc[u] * S + kv[u]; }
    }
}
__device__ __forceinline__ void phase_gla_out(const P& p, int l, char* smem) {
    const int tid = otid(), lane = tid & 63, wv = tid >> 6, q = lane >> 4, r = lane & 15;
    bf16_t* Qr = (bf16_t*)(smem + GL_QR); bf16_t* Kr = (bf16_t*)(smem + GL_KR); bf16_t* Vt = (bf16_t*)(smem + GL_VT);
    bf16_t* Qi = (bf16_t*)(smem + GL_QI); bf16_t* Ki = (bf16_t*)(smem + GL_KI); bf16_t* At = (bf16_t*)(smem + GL_AT);
    float* CUM = (float*)(smem + GL_CUM);
    int cur_h = -1;
    for (int job = (obid() + (int)gridDim.x - 64 % (int)gridDim.x) % (int)gridDim.x; job < NC * GH; job += gridDim.x) {
        const int n = job / GH, h = job % GH;
        __syncthreads();
        if (h != cur_h) { cur_h = h; gla_load_wa(p, l, h, smem); }
        gla_load_qkv(p, n, h, smem);
        __syncthreads();
        f32x4 o[1][8];
#pragma unroll
        for (int nt = 0; nt < 8; ++nt) o[0][nt] = (f32x4){0.f, 0.f, 0.f, 0.f};
        for (int d = 0; d < 2; ++d) {
            gla_cum(p, l, n, h, d, smem);
            bf16x8 spf[2][8];
            {
                const bf16_t* sp = p.SP + ((size_t)(d * NC + n) * GH + h) * 8192;
#pragma unroll
                for (int s2 = 0; s2 < 2; ++s2)
#pragma unroll
                    for (int nt = 0; nt < 8; ++nt) spf[s2][nt] = *(const bf16x8*)(sp + (size_t)(nt * 16 + r) * 64 + s2 * 32 + q * 8);
            }
#pragma unroll
            for (int it_ = 0; it_ < 4096 / NTHREADS; ++it_) {
                const int idx = tid + it_ * NTHREADS;
                const int i = idx >> 6, k = idx & 63; const float c = CUM[i * 68 + k];
                Qi[i * CH_ROW + k] = f2bf(bf2f(Qr[i * CH_ROW + k]) * fexp_(c));
                Ki[i * CH_ROW + k] = f2bf(bf2f(Kr[i * CH_ROW + k]) * fexp_(-c));
            }
            __syncthreads();
            if (wv < 4) {
                f32x4 a[1][4];
#pragma unroll
                for (int nt = 0; nt < 4; ++nt) a[0][nt] = (f32x4){0.f, 0.f, 0.f, 0.f};
                lds_mm<1, 4>(Qi, 16 * wv, Ki, 0, a);
#pragma unroll
                for (int nt = 0; nt < 4; ++nt)
#pragma unroll
                    for (int e = 0; e < 4; ++e) {
                        const int i = 16 * wv + 4 * q + e, j = nt * 16 + r;
                        const bool ok = d ? (j >= i) : (j <= i);
                        At[i * CH_ROW + j] = f2bf(ok ? a[0][nt][e] : 0.f);
                    }
                WAVE_SYNC();
                lds_mm<1, 8>(At, 16 * wv, Vt, 0, o);
#pragma unroll
                for (int s2 = 0; s2 < 2; ++s2) {
                    const bf16x8 af = *(const bf16x8*)(Qi + (16 * wv + r) * CH_ROW + s2 * 32 + q * 8);
#pragma unroll
                    for (int nt = 0; nt < 8; ++nt) o[0][nt] = MFMA16(af, spf[s2][nt], o[0][nt]);
                }
            }
            __syncthreads();
        }
        if (wv < 4) {
#pragma unroll
            for (int nt = 0; nt < 8; ++nt)
#pragma unroll
                for (int e = 0; e < 4; ++e) {
                    const int t = gla_tok(n, 16 * wv + 4 * q + e);
                    p.OGLA[(size_t)t * GLA_V + h * 128 + nt * 16 + r] = o[0][nt][e];
                }
        }
    }
    __syncthreads();
}

#define S5_XH_OFF (2 * 64 * 132 * 4)
#define S5_XL_OFF (S5_XH_OFF + 64 * 136 * 2)
#define S5_CT_OFF (S5_XL_OFF + 64 * 136 * 2)
__device__ __forceinline__ void phase_s5_pass(const P& p, int l, char* smem, bool with_out) {
    const int tid = otid(), lane = tid & 63, wv = tid >> 6, q = lane >> 4, r = lane & 15;
    float* BU = (float*)smem; bf16_t* XH = (bf16_t*)(smem + S5_XH_OFF); bf16_t* XL = (bf16_t*)(smem + S5_XL_OFF); bf16_t* CTp = (bf16_t*)(smem + S5_CT_OFF);
    const int dW = (wv >> 1) & 1, ntb = (wv & 1) * 4;
    const int dS = (tid >> 6) & 1, st = tid & 63;
    bf16x8 bhi[4], blo[4];
    float are = 0.f, aim = 0.f, dco = 0.f;
    int cur_g = -1;
    const bf16x8 zero8 = {0, 0, 0, 0, 0, 0, 0, 0};
    bf16x8 a_cur[4]; float2 car_cur = {0.f, 0.f};
#define S5_FETCH(JOB, A, CAR) { const int n_ = (JOB) / SG, g_ = (JOB) % SG; \
        if (wv < 4) { _Pragma("unroll") for (int mt = 0; mt < 4; ++mt) A[mt] = (q < 2) ? *(const bf16x8*)(p.Z + (size_t)(n_ * 64 + 16 * mt + r) * ZLD + ZS5 + g_ * 16 + 8 * q) : zero8; } \
        if (with_out && tid < 128) CAR = *(const float2*)(p.S5CAR + ((((size_t)dS * NC + n_) * SG + g_) * 64 + st) * 2); }
    const int job0 = (obid() + (int)gridDim.x - 128 % (int)gridDim.x) % (int)gridDim.x;
    if (job0 < NC * SG) S5_FETCH(job0, a_cur, car_cur);
    for (int job = job0; job < NC * SG; job += gridDim.x) {
        const int n = job / SG, g = job % SG;
        __syncthreads();
        if (g != cur_g) {
            cur_g = g;
            if (wv < 4) {
#pragma unroll
                for (int jn = 0; jn < 4; ++jn) {
                    const int kk = 16 * (ntb + jn) + r; const size_t ci = ((size_t)dW * SG + g) * 64 + (kk >> 1);
                    float f[8], lo[8];
#pragma unroll
                    for (int e = 0; e < 8; ++e) f[e] = (q < 2) ? p.S5BB[(ci * 16 + 8 * q + e) * 2 + (kk & 1)] : 0.f;
                    const u32x4 hv = pack8(f);
                    float hf[8]; unpack8(hv, hf);
#pragma unroll
                    for (int e = 0; e < 8; ++e) lo[e] = f[e] - hf[e];
                    bhi[jn] = __builtin_bit_cast(bf16x8, hv); blo[jn] = __builtin_bit_cast(bf16x8, pack8(lo));
                }
            }
            if (tid < 128) { const size_t ci = ((size_t)dS * SG + g) * 64 + st; are = p.S5A[ci * 2]; aim = p.S5A[ci * 2 + 1]; }
            if (with_out) {
#pragma unroll
                for (int it_ = 0; it_ < 16 * 128 / NTHREADS; ++it_) {
                    const int idx = tid + it_ * NTHREADS;
                    const int c = idx >> 7, kk = idx & 127;
                    const float v = (kk & 1) ? -p.in[I_S5CIM][((size_t)l * SG + g) * 1024 + c * 64 + (kk >> 1)] : p.in[I_S5CRE][((size_t)l * SG + g) * 1024 + c * 64 + (kk >> 1)];
                    CTp[c * 136 + kk] = f2bf(v);
                }
                dco = p.in[I_S5D][(size_t)l * SW + g * 16 + r];
            }
        }
        float xr = car_cur.x, xi = car_cur.y;
        const size_t eo = (((size_t)dS * NC + n) * SG + g) * 64 + st;
        unsigned short uu[4] = {0, 0, 0, 0};
        if (with_out && wv < 4) {
#pragma unroll
            for (int e = 0; e < 4; ++e) uu[e] = p.Z[(size_t)(n * 64 + 16 * wv + 4 * q + e) * ZLD + ZS5 + g * 16 + r];
        }
        if (wv < 4) {
#pragma unroll
            for (int mt = 0; mt < 4; ++mt) {
                const bf16x8 a = a_cur[mt];
#pragma unroll
                for (int jn = 0; jn < 4; ++jn) {
                    f32x4 acc = {0.f, 0.f, 0.f, 0.f};
                    acc = MFMA16(a, bhi[jn], acc);
                    acc = MFMA16(a, blo[jn], acc);
#pragma unroll
                    for (int e = 0; e < 4; ++e) BU[(dW * 64 + 16 * mt + 4 * q + e) * 132 + 16 * (ntb + jn) + r] = acc[e];
                }
            }
        }
        if (job + (int)gridDim.x < NC * SG) S5_FETCH(job + (int)gridDim.x, a_cur, car_cur);
        __syncthreads();
        if (tid < 128) {
            float2* bp0 = (float2*)(BU + (dS * 64 + (dS ? 63 : 0)) * 132 + st * 2);
#define S5_SCAN(SGN) { _Pragma("unroll 1") for (int ib = 0; ib < 4; ++ib) { float2 bv[16]; \
                _Pragma("unroll") for (int u = 0; u < 16; ++u) bv[u] = bp0[(SGN) * (ib * 16 + u) * 66]; \
                _Pragma("unroll") for (int u = 0; u < 16; ++u) { \
                    const float nr = are * xr - aim * xi + bv[u].x, ni = are * xi + aim * xr + bv[u].y; xr = nr; xi = ni; \
                    if (with_out) { float2 o; o.x = xr; o.y = xi; bp0[(SGN) * (ib * 16 + u) * 66] = o; } } } }
            if (dS) S5_SCAN(-1) else S5_SCAN(1)
            if (!with_out) { float2 o; o.x = xr; o.y = xi; *(float2*)(p.S5END + eo * 2) = o; }
        }
        if (with_out) {
            __syncthreads();
#pragma unroll
            for (int it_ = 0; it_ < 64 * 16 / NTHREADS; ++it_) {
                const int cidx = tid + it_ * NTHREADS;
                const int i = cidx >> 4, k0 = (cidx & 15) * 8;
                float a[8], b[8], lo[8];
                load8f(BU + (0 * 64 + i) * 132 + k0, a); load8f(BU + (1 * 64 + i) * 132 + k0, b);
#pragma unroll
                for (int e = 0; e < 8; ++e) a[e] += b[e];
                const u32x4 hv = pack8(a);
                float hf[8]; unpack8(hv, hf);
#pragma unroll
                for (int e = 0; e < 8; ++e) lo[e] = a[e] - hf[e];
                *(u32x4*)(XH + i * 136 + k0) = hv; *(u32x4*)(XL + i * 136 + k0) = pack8(lo);
            }
            __syncthreads();
            if (wv < 4) {
                f32x4 acc = {0.f, 0.f, 0.f, 0.f};
#pragma unroll
                for (int ks = 0; ks < 4; ++ks) {
                    const bf16x8 ah = *(const bf16x8*)(XH + (16 * wv + r) * 136 + ks * 32 + q * 8), al = *(const bf16x8*)(XL + (16 * wv + r) * 136 + ks * 32 + q * 8);
                    const bf16x8 b = *(const bf16x8*)(CTp + r * 136 + ks * 32 + q * 8);
                    acc = MFMA16(ah, b, acc);
                    acc = MFMA16(al, b, acc);
                }
#pragma unroll
                for (int e = 0; e < 4; ++e) {
                    const int i = 16 * wv + 4 * q + e;
                    const float u = bf2f(uu[e]);
                    p.GY[(size_t)(n * 64 + i) * SW + g * 16 + r] = f2bf(geluf_(acc[e] + dco * u));
                }
            }
        }
    }
    __syncthreads();
}
__device__ __forceinline__ void s5_carry_job(const P& p, int job) {
    const int base = job * NTHREADS + otid();
    if (base >= 2 * SG * 64) return;
    const int d = base / (SG * 64), g = (base / 64) % SG, st = base % 64;
    const size_t ci = ((size_t)d * SG + g) * 64 + st;
    float ar = p.S5A[ci * 2], ai = p.S5A[ci * 2 + 1];
    for (int i = 0; i < 6; ++i) { const float nr = ar * ar - ai * ai, ni = 2.f * ar * ai; ar = nr; ai = ni; }
    const float2* __restrict__ endp = (const float2*)p.S5END; float2* __restrict__ carp = (float2*)p.S5CAR;
    float cr = 0.f, cim = 0.f;
    for (int s = 0; s < NC; s += 4) {
        float2 ev[4]; size_t eo[4];
#pragma unroll
        for (int u = 0; u < 4; ++u) {
            const int n = chunk_order(d, (s + u < NC) ? s + u : NC - 1);
            eo[u] = (((size_t)d * NC + n) * SG + g) * 64 + st;
            ev[u] = endp[eo[u]];
        }
#pragma unroll
        for (int u = 0; u < 4; ++u) if (s + u < NC) {
            float2 c; c.x = cr; c.y = cim; carp[eo[u]] = c;
            const float nr = ar * cr - ai * cim + ev[u].x, ni = ar * cim + ai * cr + ev[u].y;
            cr = nr; cim = ni;
        }
    }
}

__device__ __forceinline__ void phase_side_elem(const P& p, int l) {
    const int lane = otid() & 63;
    const int gw = (obid() * NTHREADS + otid()) >> 6, nw = (gridDim.x * NTHREADS) >> 6;
    const bool actg = lane * 8 < GLA_V, actr = lane * 8 < RW;
    float gng[8], lnw[8], lnb[8];
#pragma unroll
    for (int e = 0; e < 8; ++e) { gng[e] = 0.f; lnw[e] = 0.f; lnb[e] = 0.f; }
    if (actg) load8f(p.in[I_GLA_NG] + (size_t)l * 128 + ((lane * 8) & 127), gng);
    if (actr) { load8f(p.in[I_RLNW] + (size_t)l * RW + lane * 8, lnw); load8f(p.in[I_RLNB] + (size_t)l * RW + lane * 8, lnb); }
    struct SePre { float og[8], y0[8], y1[8]; u32x4 zo, vv, g2; float bon; };
    auto se_fetch = [&](int t, SePre& c) {
        const u32x4 z4 = {0u, 0u, 0u, 0u};
#pragma unroll
        for (int e = 0; e < 8; ++e) { c.og[e] = 0.f; c.y0[e] = 0.f; c.y1[e] = 0.f; }
        if (actg) load8f(p.OGLA + (size_t)t * GLA_V + lane * 8, c.og);
        c.zo = actg ? *(const u32x4*)(p.Z + (size_t)t * ZLD + ZOG + lane * 8) : z4;
        if (actr) { load8f(p.Y + (size_t)t * RW + lane * 8, c.y0); load8f(p.Y + ((size_t)MTOT + t) * RW + lane * 8, c.y1); }
        c.vv = actr ? *(const u32x4*)(p.V + (size_t)t * RW + lane * 8) : z4;
        c.g2 = actr ? *(const u32x4*)(p.G2B + (size_t)t * RW + lane * 8) : z4;
        const int hh_ = (lane * 8) >> 6;
        c.bon = actr ? (p.BONUS[(size_t)t * RH + hh_] + p.BONUS[((size_t)MTOT + t) * RH + hh_]) : 0.f;
    };
    SePre nx;
    if (gw < MTOT) se_fetch(gw, nx);
    for (int t = gw; t < MTOT; t += nw) {
        float og[8], zo[8], y0[8], y1[8], vv[8], g2v[8];
#pragma unroll
        for (int e = 0; e < 8; ++e) { og[e] = nx.og[e]; y0[e] = nx.y0[e]; y1[e] = nx.y1[e]; }
        unpack8(nx.zo, zo); unpack8(nx.vv, vv); unpack8(nx.g2, g2v);
        const float bon = nx.bon;
        if (t + nw < MTOT) se_fetch(t + nw, nx);
        float ss = 0.f;
#pragma unroll
        for (int e = 0; e < 8; ++e) ss += og[e] * og[e];
        ss += __shfl_xor(ss, 1, 64); ss += __shfl_xor(ss, 2, 64); ss += __shfl_xor(ss, 4, 64); ss += __shfl_xor(ss, 8, 64);
        const float rstd = rsqrtf(ss * (1.0f / 128.f) + 1e-6f);
        float br[8];
#pragma unroll
        for (int e = 0; e < 8; ++e) br[e] = og[e] * rstd * gng[e] * siluf_(zo[e]);
        if (actg) *(u32x4*)(p.BR + (size_t)t * 3 * BW + lane * 8) = pack8(br);
        float y[8]; float sm = 0.f;
#pragma unroll
        for (int e = 0; e < 8; ++e) { y[e] = y0[e] + y1[e]; sm += y[e]; }
        sm += __shfl_xor(sm, 1, 64); sm += __shfl_xor(sm, 2, 64); sm += __shfl_xor(sm, 4, 64);
        const float mu = sm * (1.0f / 64.f);
        float sv = 0.f;
#pragma unroll
        for (int e = 0; e < 8; ++e) { y[e] -= mu; sv += y[e] * y[e]; }
        sv += __shfl_xor(sv, 1, 64); sv += __shfl_xor(sv, 2, 64); sv += __shfl_xor(sv, 4, 64);
        const float rs = rsqrtf(sv * (1.0f / 64.f) + 64e-5f);
        float yn[8];
#pragma unroll
        for (int e = 0; e < 8; ++e) yn[e] = y[e] * rs * lnw[e] + lnb[e] + bon * vv[e];
#pragma unroll
        for (int e = 0; e < 8; ++e) yn[e] *= g2v[e];
        if (actr) *(u32x4*)(p.BR + (size_t)t * 3 * BW + BW + lane * 8) = pack8(yn);
    }
}

__device__ __forceinline__ void g2_gemm_job(const P& p, int job, char* smem) {
    const int ntn = NPAD(RW) / 128;
    gemm_tile_run<4, 8>(p.WT_G2, 128, (size_t)NPAD(RW) * 128 * 2, p.GS, 128, (size_t)MTOT * 128 * 2, 128, (job % ntn) * 128, (job / ntn) * 256, (bf16_t*)smem, NoPre(),
        [&](int, int, int m, int n, const f32x4 v) { if (n < RW) *(u32x2*)(p.G2B + (size_t)m * RW + n) = pack4(v[0], v[1], v[2], v[3]); });
}
#define G2_JOBS ((MTOT / 256) * (NPAD(RW) / 128))
__device__ __forceinline__ void phase_glu_gemm(const P& p, int l, char* smem) {
    gemm_phase<4>(p.WT_GLU, SW, (size_t)NPAD(2 * SW) * SW * 2, p.GY, SW, (size_t)MTOT * SW * 2, SW, 2 * SW, (bf16_t*)smem, NoPre(), NoPre(),
        [&](int, int, int m, int n, const f32x4 v) {
            *(unsigned*)(p.BR + (size_t)m * 3 * BW + 2 * BW + (n >> 1)) = pack2bf(v[0] * sigmoidf_(v[1]), v[2] * sigmoidf_(v[3]));
        });
}
__device__ __forceinline__ void phase_merge(const P& p, int l, char* smem) {
    const int ntn = D_MODEL / 128, ntm = (MTOT - 256) / 256;
    auto run = [&](auto mi_tag, int n0, int m0) {
        constexpr int MI = decltype(mi_tag)::value;
        f32x4 macc[4][MI];
#pragma unroll
        for (int i = 0; i < 4; ++i)
#pragma unroll
            for (int j = 0; j < MI; ++j) macc[i][j] = (f32x4){0.f, 0.f, 0.f, 0.f};
        const int lane = otid() & 63, wave = otid() >> 6;
        for (int b = 0; b < 3; ++b) {
            f32x4 acc[4][MI];
#pragma unroll
            for (int i = 0; i < 4; ++i)
#pragma unroll
                for (int j = 0; j < MI; ++j) acc[i][j] = (f32x4){0.f, 0.f, 0.f, 0.f};
            mfma_gemm_tile_t<4, MI>(p.WT_BR + (size_t)b * D_MODEL * BW, BW, (size_t)D_MODEL * BW * 2, p.BR + b * BW, 3 * BW, (size_t)MTOT * 3 * BW * 2 - b * BW * 2, BW, n0, m0, (bf16_t*)smem, acc);
#pragma unroll
            for (int ni = 0; ni < 4; ++ni)
#pragma unroll
                for (int mi = 0; mi < MI; ++mi) {
                    const int n = n0 + (wave >> 1) * 64 + ni * 16 + (lane >> 4) * 4, m = m0 + (wave & 1) * 16 * MI + mi * 16 + (lane & 15);
                    const u32x2 g = *(const u32x2*)(p.ZGT + ((((size_t)(m >> 4) * (3 * D_MODEL / 16) + ((b * D_MODEL + n) >> 4)) * 64 + lane) * 4));
                    macc[ni][mi][0] += LO16(g.x) * acc[ni][mi][0]; macc[ni][mi][1] += HI16(g.x) * acc[ni][mi][1];
                    macc[ni][mi][2] += LO16(g.y) * acc[ni][mi][2]; macc[ni][mi][3] += HI16(g.y) * acc[ni][mi][3];
                }
        }
#pragma unroll
        for (int ni = 0; ni < 4; ++ni)
#pragma unroll
            for (int mi = 0; mi < MI; ++mi) {
                const int n = n0 + (wave >> 1) * 64 + ni * 16 + (lane >> 4) * 4, m = m0 + (wave & 1) * 16 * MI + mi * 16 + (lane & 15);
                *(u32x2*)(p.M + (size_t)m * D_MODEL + n) = pack4(macc[ni][mi][0], macc[ni][mi][1], macc[ni][mi][2], macc[ni][mi][3]);
            }
    };
    for (int it = 0;; ++it) {
        int mt_, nt_; if (!tile_map(it, ntm, ntn, (ntn >= 8) ? 4 : 8, mt_, nt_)) break;
        run(std::integral_constant<int, 8>(), nt_ * 128, mt_ * 256);
    }
    for (int job = obid(); job < 4 * ntn; job += gridDim.x) run(std::integral_constant<int, 2>(), (job >> 2) * 128, MTOT - 256 + (job & 3) * 64);
}

template <int MI>
__device__ __forceinline__ void outproj_tile(const P& p, int l, int n0, int m0, char* smem) {
    f32x4 acc[4][MI];
#pragma unroll
    for (int i = 0; i < 4; ++i)
#pragma unroll
        for (int j = 0; j < MI; ++j) acc[i][j] = (f32x4){0.f, 0.f, 0.f, 0.f};
    mfma_gemm_tile_t<4, MI>(p.WT_OUT, D_MODEL, (size_t)D_MODEL * D_MODEL * 2, p.M, D_MODEL, (size_t)MTOT * D_MODEL * 2, D_MODEL, n0, m0, (bf16_t*)smem, acc);
    const int lane = otid() & 63, wave = otid() >> 6;
    const float* g1b = p.MOD + (size_t)(l * 2) * 6 * D_MODEL + 2 * D_MODEL;
#pragma unroll
    for (int ni = 0; ni < 4; ++ni) {
        const int n = n0 + (wave >> 1) * 64 + ni * 16 + (lane >> 4) * 4;
        const float4 ga = *(const float4*)(g1b + n), gb = *(const float4*)(g1b + 6 * D_MODEL + n);
        float4 xv[MI];
#pragma unroll
        for (int mi = 0; mi < MI; ++mi) xv[mi] = *(const float4*)(p.X + (size_t)(m0 + (wave & 1) * 16 * MI + mi * 16 + (lane & 15)) * D_MODEL + n);
#pragma unroll
        for (int mi = 0; mi < MI; ++mi) {
            const int m = m0 + (wave & 1) * 16 * MI + mi * 16 + (lane & 15);
            const float4 g = (m >= CTX) ? gb : ga; float4 x = xv[mi];
            x.x += g.x * acc[ni][mi][0]; x.y += g.y * acc[ni][mi][1]; x.z += g.z * acc[ni][mi][2]; x.w += g.w * acc[ni][mi][3];
            *(float4*)(p.X + (size_t)m * D_MODEL + n) = x;
        }
    }
}
__device__ __forceinline__ void phase_outproj(const P& p, int l, char* smem) {
    const int ntn = D_MODEL / 128, ntm = MTOT / 256 - 1;
    const int PM = (ntn >= 16) ? 2 : ((ntn >= 8) ? 4 : 8);
    for (int it = 0;; ++it) {
        int mt_, nt_; if (!tile_map(it, ntm, ntn, PM, mt_, nt_)) break;
        outproj_tile<8>(p, l, nt_ * 128, mt_ * 256, smem);
    }
    for (int job = obid(); job < 4 * ntn; job += gridDim.x) outproj_tile<2>(p, l, (job >> 2) * 128, MTOT - 256 + (job & 3) * 64, smem);
}

__device__ __forceinline__ void store_q_hilo(const P& p, int m, int n, const f32x4 v) {
    const bf16_t h0 = f2bf(v[0]), h1 = f2bf(v[1]), h2 = f2bf(v[2]), h3 = f2bf(v[3]);
    u32x2 hv; hv.x = (unsigned)h0 | ((unsigned)h1 << 16); hv.y = (unsigned)h2 | ((unsigned)h3 << 16);
    *(u32x2*)(p.QHI + (size_t)m * PQ + n) = hv;
    *(u32x2*)(p.QLO + (size_t)m * PQ + n) = pack4(v[0] - bf2f(h0), v[1] - bf2f(h1), v[2] - bf2f(h2), v[3] - bf2f(h3));
}
__device__ __forceinline__ void phase_peer_q(const P& p, int l, char* smem) {
    gemm_phase<4>(p.WT_Q, D_MODEL, (size_t)PQ * D_MODEL * 2, p.H, D_MODEL, (size_t)MTOT * D_MODEL * 2, D_MODEL, PQ, (bf16_t*)smem, NoPre(), NoPre(),
        [&](int, int, int m, int n, const f32x4 v) { store_q_hilo(p, m, n, v); });
}

#define TK_ROW 129
__device__ __forceinline__ unsigned tk_key(float f, unsigned lowmask, unsigned low) {
    unsigned u = __builtin_bit_cast(unsigned, f);
    u ^= (u & 0x80000000u) ? 0xFFFFFFFFu : 0x80000000u;
    return (u & ~lowmask) | low;
}
#define TK_INSERT(lv, xk) { unsigned x_ = (xk); _Pragma("unroll") for (int z_ = 0; z_ < 16; ++z_) { const unsigned hi_ = lv[z_] > x_ ? lv[z_] : x_; x_ = lv[z_] > x_ ? x_ : lv[z_]; lv[z_] = hi_; } }
__device__ __forceinline__ void phase_peer_topk(const P& p, int l, char* smem) {
    const int tid = otid(), lane = tid & 63, wv = tid >> 6, q = lane >> 4, r = lane & 15;
    float* sc = (float*)smem + wv * (64 * TK_ROW);
    const int gw = (obid() * NTHREADS + tid) >> 6, nw = (gridDim.x * NTHREADS) >> 6;
    const float NEG = -3.0e38f;
    for (int job = gw; job < (MTOT / 32) * PH; job += nw) {
        const int t0 = (job / PH) * 32, h = job % PH;
#pragma unroll
        for (int sd = 0; sd < 2; ++sd) {
            f32x4 acc[2][8];
#pragma unroll
            for (int mt = 0; mt < 2; ++mt)
#pragma unroll
                for (int nt = 0; nt < 8; ++nt) acc[mt][nt] = (f32x4){0.f, 0.f, 0.f, 0.f};
#define TK_LOADF(KS, AH, AL, BH, BL) { \
                _Pragma("unroll") for (int mt = 0; mt < 2; ++mt) { \
                    const size_t qo = (size_t)(t0 + mt * 16 + r) * PQ + h * 256 + sd * 128 + (KS) * 32 + q * 8; \
                    AH[mt] = *(const bf16x8*)(p.QHI + qo); AL[mt] = *(const bf16x8*)(p.QLO + qo); } \
                _Pragma("unroll") for (int nt = 0; nt < 8; ++nt) { \
                    const size_t ko = ((size_t)(h * 2 + sd) * 128 + nt * 16 + r) * 128 + (KS) * 32 + q * 8; \
                    BH[nt] = *(const bf16x8*)(p.KHI + ko); BL[nt] = *(const bf16x8*)(p.KLO + ko); } }
#define TK_MFMA(AH, AL, BH, BL) { \
                _Pragma("unroll") for (int nt = 0; nt < 8; ++nt) \
                    _Pragma("unroll") for (int mt = 0; mt < 2; ++mt) { \
                        acc[mt][nt] = MFMA16(AH[mt], BH[nt], acc[mt][nt]); \
                        acc[mt][nt] = MFMA16(AL[mt], BH[nt], acc[mt][nt]); \
                        acc[mt][nt] = MFMA16(AH[mt], BL[nt], acc[mt][nt]); } }
#ifdef EMU
#define TK_SB()
#else
#define TK_SB() __builtin_amdgcn_sched_barrier(0)
#endif
            {
                bf16x8 ah0[2], al0[2], bh0[8], bl0[8], ah1[2], al1[2], bh1[8], bl1[8];
                TK_LOADF(0, ah0, al0, bh0, bl0)
                TK_LOADF(1, ah1, al1, bh1, bl1) TK_SB(); TK_MFMA(ah0, al0, bh0, bl0) TK_SB();
                TK_LOADF(2, ah0, al0, bh0, bl0) TK_SB(); TK_MFMA(ah1, al1, bh1, bl1) TK_SB();
                TK_LOADF(3, ah1, al1, bh1, bl1) TK_SB(); TK_MFMA(ah0, al0, bh0, bl0) TK_SB();
                TK_MFMA(ah1, al1, bh1, bl1)
            }
#undef TK_LOADF
#undef TK_MFMA
#undef TK_SB
#pragma unroll
            for (int mt = 0; mt < 2; ++mt)
#pragma unroll
                for (int nt = 0; nt < 8; ++nt)
#pragma unroll
                    for (int e = 0; e < 4; ++e) sc[(sd * 32 + mt * 16 + 4 * q + e) * TK_ROW + nt * 16 + r] = acc[mt][nt][e];
        }
        WAVE_SYNC();
        unsigned lv[16];
        {
            const float* row = sc + lane * TK_ROW;
#pragma unroll 1
            for (int g = 0; g < 8; ++g) {
                unsigned gv[16];
#pragma unroll
                for (int z = 0; z < 16; ++z) gv[z] = tk_key(row[g * 16 + z], 0x7Fu, (unsigned)(127 - (g * 16 + z)));
#pragma unroll
                for (int k = 2; k <= 16; k <<= 1)
#pragma unroll
                    for (int j = k >> 1; j > 0; j >>= 1)
#pragma unroll
                        for (int i = 0; i < 16; ++i) {
                            const int i2 = i ^ j;
                            if (i2 > i) {
                                const unsigned hi_ = gv[i] > gv[i2] ? gv[i] : gv[i2], lo_ = gv[i] > gv[i2] ? gv[i2] : gv[i];
                                if ((i & k) == 0) { gv[i] = hi_; gv[i2] = lo_; } else { gv[i] = lo_; gv[i2] = hi_; }
                            }
                        }
                if (g == 0) {
#pragma unroll
                    for (int z = 0; z < 16; ++z) lv[z] = gv[z];
                } else {
#pragma unroll
                    for (int z = 0; z < 16; ++z) lv[z] = lv[z] > gv[15 - z] ? lv[z] : gv[15 - z];
#pragma unroll
                    for (int j = 8; j > 0; j >>= 1)
#pragma unroll
                        for (int i = 0; i < 16; ++i) {
                            const int i2 = i ^ j;
                            if (i2 > i) { const unsigned hi_ = lv[i] > lv[i2] ? lv[i] : lv[i2], lo_ = lv[i] > lv[i2] ? lv[i2] : lv[i]; lv[i] = hi_; lv[i2] = lo_; }
                        }
                }
            }
        }
        float lvv[16]; int li[16];
        {
            const float* row = sc + lane * TK_ROW;
#pragma unroll
            for (int z = 0; z < 16; ++z) { li[z] = 127 - (int)(lv[z] & 0x7Fu); lvv[z] = row[li[z]]; }
        }
        WAVE_SYNC();
        {
            float* row = sc + lane * TK_ROW;
#pragma unroll
            for (int z = 0; z < 16; ++z) { row[z] = lvv[z]; ((int*)row)[16 + z] = li[z]; }
        }
        WAVE_SYNC();
        const float* r1 = sc + (lane & 31) * TK_ROW; const float* r2 = sc + (32 + (lane & 31)) * TK_ROW;
        unsigned tk[16];
        {
            constexpr int CI[64] = {0,0,0,0,0,0,0,0,0,0,0,0,0,0,0,0,1,1,1,1,1,1,1,1,2,2,2,2,2,3,3,3,3,4,4,4,5,5,6,6,7,7,8,9,10,11,12,13,14,15,0,0,0,0,0,0,0,0,0,0,0,0,0,0};
            constexpr int CJ[64] = {0,1,2,3,4,5,6,7,8,9,10,11,12,13,14,15,0,1,2,3,4,5,6,7,0,1,2,3,4,0,1,2,3,0,1,2,0,1,0,1,0,1,0,0,0,0,0,0,0,0,0,0,0,0,0,0,0,0,0,0,0,0,0,0};
            float av[16], bv[16];
#pragma unroll
            for (int z = 0; z < 16; ++z) { av[z] = r1[z]; bv[z] = r2[z]; }
#pragma unroll
            for (int g = 0; g < 4; ++g) {
                unsigned gv[16];
#pragma unroll
                for (int z = 0; z < 16; ++z) {
                    constexpr int dummy_ = 0; (void)dummy_;
                    const int c = g * 16 + z;
                    gv[z] = (c < 50) ? tk_key(av[CI[c]] + bv[CJ[c]], 0xFFu, (unsigned)(255 - (CI[c] * 16 + CJ[c]))) : 0u;
                }
#pragma unroll
                for (int k = 2; k <= 16; k <<= 1)
#pragma unroll
                    for (int j = k >> 1; j > 0; j >>= 1)
#pragma unroll
                        for (int i = 0; i < 16; ++i) {
                            const int i2 = i ^ j;
                            if (i2 > i) {
                                const unsigned hi_ = gv[i] > gv[i2] ? gv[i] : gv[i2], lo_ = gv[i] > gv[i2] ? gv[i2] : gv[i];
                                if ((i & k) == 0) { gv[i] = hi_; gv[i2] = lo_; } else { gv[i] = lo_; gv[i2] = hi_; }
                            }
                        }
                if (g == 0) {
#pragma unroll
                    for (int z = 0; z < 16; ++z) tk[z] = gv[z];
                } else {
#pragma unroll
                    for (int z = 0; z < 16; ++z) tk[z] = tk[z] > gv[15 - z] ? tk[z] : gv[15 - z];
#pragma unroll
                    for (int j = 8; j > 0; j >>= 1)
#pragma unroll
                        for (int i = 0; i < 16; ++i) {
                            const int i2 = i ^ j;
                            if (i2 > i) { const unsigned hi_ = tk[i] > tk[i2] ? tk[i] : tk[i2], lo_ = tk[i] > tk[i2] ? tk[i2] : tk[i]; tk[i] = hi_; tk[i2] = lo_; }
                        }
                }
            }
        }
        int tc[16];
#pragma unroll
        for (int z = 0; z < 16; ++z) tc[z] = 255 - (int)(tk[z] & 0xFFu);
        if (lane < 32) {
            float vals[16]; float mx = 0.f; float ssum = 0.f;
#pragma unroll
            for (int z = 0; z < 16; ++z) { vals[z] = r1[tc[z] >> 4] + r2[tc[z] & 15]; if (z == 0) mx = vals[0]; vals[z] = fexp_(vals[z] - mx); ssum += vals[z]; }
            const float inv = 1.0f / ssum;
            const size_t o = (size_t)(t0 + lane) * PH * 16 + h * 16;
            int exs[16]; float vs[16], us[16];
#pragma unroll
            for (int z = 0; z < 16; ++z) {
                exs[z] = ((const int*)r1)[16 + (tc[z] >> 4)] * 128 + ((const int*)r2)[16 + (tc[z] & 15)];
                vs[z] = p.VSC[exs[z]]; us[z] = p.USC[exs[z]];
            }
#pragma unroll
            for (int z = 0; z < 16; z += 4) {
                typedef int i32x4_t __attribute__((ext_vector_type(4)));
                *(i32x4_t*)(p.IDX + o + z) = (i32x4_t){exs[z], exs[z + 1], exs[z + 2], exs[z + 3]};
                *(f32x4*)(p.G + o + z) = (f32x4){vals[z] * inv * vs[z], vals[z + 1] * inv * vs[z + 1], vals[z + 2] * inv * vs[z + 2], vals[z + 3] * inv * vs[z + 3]};
                *(f32x4*)(p.GU + o + z) = (f32x4){us[z], us[z + 1], us[z + 2], us[z + 3]};
            }
        }
        WAVE_SYNC();
    }
}

#define PEER_CONV_JOBS (2 * NEXP / 4)
__device__ __forceinline__ void peer_conv_job(const P& p, int l, int job) {
    const int tid = otid(), lane = tid & 63, wv = tid >> 6;
    if (wv >= 4) return;
    const int rowg = job * 4 + wv; const int which = rowg / NEXP, row = rowg % NEXP;
    const float* src = p.in[which ? I_PV : I_PU] + ((size_t)l * NEXP + row) * D_MODEL + lane * 16;
    const bool act = lane * 16 < D_MODEL;
    float v[16]; float amax = 0.f;
#pragma unroll
    for (int c = 0; c < 4; ++c) {
        float4 a; a.x = 0.f; a.y = 0.f; a.z = 0.f; a.w = 0.f;
        if (act) a = *(const float4*)(src + c * 4);
        v[c * 4 + 0] = a.x; v[c * 4 + 1] = a.y; v[c * 4 + 2] = a.z; v[c * 4 + 3] = a.w;
        amax = fmaxf(amax, fmaxf(fmaxf(fabsf(a.x), fabsf(a.y)), fmaxf(fabsf(a.z), fabsf(a.w))));
    }
#pragma unroll
    for (int m = 32; m >= 1; m >>= 1) amax = fmaxf(amax, __shfl_xor(amax, m, 64));
    int ex = 0;
    if (amax > 0.f) ex = 7 - (int)((__builtin_bit_cast(unsigned, amax) >> 23) & 0xFF) + 127;
    ex = ex < -100 ? -100 : (ex > 100 ? 100 : ex);
    const float sc = __builtin_bit_cast(float, (unsigned)(ex + 127) << 23), isc = __builtin_bit_cast(float, (unsigned)(127 - ex) << 23);
    u32x4 o;
    int w0 = 0, w1 = 0, w2 = 0, w3 = 0;
    w0 = CVT_PK_FP8(v[0] * sc, v[1] * sc, w0, false); w0 = CVT_PK_FP8(v[2] * sc, v[3] * sc, w0, true);
    w1 = CVT_PK_FP8(v[4] * sc, v[5] * sc, w1, false); w1 = CVT_PK_FP8(v[6] * sc, v[7] * sc, w1, true);
    w2 = CVT_PK_FP8(v[8] * sc, v[9] * sc, w2, false); w2 = CVT_PK_FP8(v[10] * sc, v[11] * sc, w2, true);
    w3 = CVT_PK_FP8(v[12] * sc, v[13] * sc, w3, false); w3 = CVT_PK_FP8(v[14] * sc, v[15] * sc, w3, true);
    o.x = (unsigned)w0; o.y = (unsigned)w1; o.z = (unsigned)w2; o.w = (unsigned)w3;
    unsigned char* dst = (which ? p.V8 : p.U8) + (size_t)row * D_MODEL + lane * 16;
    if (act) *(u32x4*)dst = o;
    if (lane == 0) (which ? p.VSC : p.USC)[row] = isc;
}
#define GE 4
struct GBuf { u32x4 u[GE]; u32x4 v[GE]; float gu; float gv; };
__device__ __forceinline__ void gather_load(const P& p, GBuf& b, int g, int idx0, int idx1, float g0, float g1, float u0, float u1, int lane) {
    const bool act = lane * 16 < D_MODEL;
#pragma unroll
    for (int q = 0; q < GE; ++q) {
        const int k = g * GE + q;
        const int ei = __shfl((k < 64) ? idx0 : idx1, k & 63, 64);
        b.u[q] = act ? *(const u32x4*)(p.U8 + (size_t)ei * D_MODEL + lane * 16) : (u32x4){0u, 0u, 0u, 0u};
        b.v[q] = act ? *(const u32x4*)(p.V8 + (size_t)ei * D_MODEL + lane * 16) : (u32x4){0u, 0u, 0u, 0u};
    }
    const int km = g * GE + ((lane >> 4) & 3);
    b.gv = __shfl((km < 64) ? g0 : g1, km & 63, 64);
    b.gu = __shfl((km < 64) ? u0 : u1, km & 63, 64);
}
__device__ __forceinline__ void gather_compute(const GBuf& b, const f32x2 (&hv)[8], f32x2 (&acc)[8], int lane) {
    float dt[GE];
#pragma unroll
    for (int q = 0; q < GE; ++q) {
        f32x2 d2 = {0.f, 0.f};
#pragma unroll
        for (int c = 0; c < 4; ++c) {
            const f32x2 lo = CVT_PK_F32_FP8((int)b.u[q][c], false), hi = CVT_PK_F32_FP8((int)b.u[q][c], true);
            d2 = __builtin_elementwise_fma(hv[2 * c], lo, d2);
            d2 = __builtin_elementwise_fma(hv[2 * c + 1], hi, d2);
        }
        dt[q] = d2.x + d2.y;
    }
    float r2[2], r1;
    {
        const bool up = (lane & 32) != 0;
#pragma unroll
        for (int q = 0; q < 2; ++q) { const float keep = up ? dt[2 + q] : dt[q], send = up ? dt[q] : dt[2 + q]; r2[q] = keep + __shfl_xor(send, 32, 64); }
    }
    {
        const bool up = (lane & 16) != 0;
        const float keep = up ? r2[1] : r2[0], send = up ? r2[0] : r2[1];
        r1 = keep + __shfl_xor(send, 16, 64);
    }
    r1 += __shfl_xor(r1, 8, 64); r1 += __shfl_xor(r1, 4, 64); r1 += __shfl_xor(r1, 2, 64); r1 += __shfl_xor(r1, 1, 64);
    const float coef_mine = b.gv * geluf_(r1 * b.gu);
#pragma unroll
    for (int q = 0; q < GE; ++q) {
        const float coef = __shfl(coef_mine, q * 16, 64);
        const f32x2 coef2 = {coef, coef};
#pragma unroll
        for (int c = 0; c < 4; ++c) {
            const f32x2 lo = CVT_PK_F32_FP8((int)b.v[q][c], false), hi = CVT_PK_F32_FP8((int)b.v[q][c], true);
            acc[2 * c] = __builtin_elementwise_fma(coef2, lo, acc[2 * c]);
            acc[2 * c + 1] = __builtin_elementwise_fma(coef2, hi, acc[2 * c + 1]);
        }
    }
}
__device__ __forceinline__ void phase_peer_gather(const P& p, int l) {
    const int lane = otid() & 63;
    const int gw = (obid() * NTHREADS + otid()) >> 6, nw = (gridDim.x * NTHREADS) >> 6;
    constexpr int NG = PH * 16 / GE;
    const bool act = lane * 16 < D_MODEL;
    for (int t = gw; t < MTOT; t += nw) {
        f32x2 hv[8], acc[8];
        {
            const u32x4 z4 = {0u, 0u, 0u, 0u};
            const u32x4 ha = act ? *(const u32x4*)(p.H + (size_t)t * D_MODEL + lane * 16) : z4;
            const u32x4 hb = act ? *(const u32x4*)(p.H + (size_t)t * D_MODEL + lane * 16 + 8) : z4;
            hv[0] = (f32x2){LO16(ha.x), HI16(ha.x)}; hv[1] = (f32x2){LO16(ha.y), HI16(ha.y)}; hv[2] = (f32x2){LO16(ha.z), HI16(ha.z)}; hv[3] = (f32x2){LO16(ha.w), HI16(ha.w)};
            hv[4] = (f32x2){LO16(hb.x), HI16(hb.x)}; hv[5] = (f32x2){LO16(hb.y), HI16(hb.y)}; hv[6] = (f32x2){LO16(hb.z), HI16(hb.z)}; hv[7] = (f32x2){LO16(hb.w), HI16(hb.w)};
#pragma unroll
            for (int j = 0; j < 8; ++j) acc[j] = (f32x2){0.f, 0.f};
        }
        int idx0 = 0, idx1 = 0; float g0 = 0.f, g1 = 0.f, u0 = 0.f, u1 = 0.f;
        if (lane < PH * 16) { idx0 = p.IDX[(size_t)t * PH * 16 + lane]; g0 = p.G[(size_t)t * PH * 16 + lane]; u0 = p.GU[(size_t)t * PH * 16 + lane]; }
        if (64 + lane < PH * 16) { idx1 = p.IDX[(size_t)t * PH * 16 + 64 + lane]; g1 = p.G[(size_t)t * PH * 16 + 64 + lane]; u1 = p.GU[(size_t)t * PH * 16 + 64 + lane]; }
        GBuf b0, b1, b2;
        gather_load(p, b0, 0, idx0, idx1, g0, g1, u0, u1, lane);
        gather_load(p, b1, 1, idx0, idx1, g0, g1, u0, u1, lane);
        for (int g = 0; g < NG; g += 3) {
            if (g + 2 < NG) gather_load(p, b2, g + 2, idx0, idx1, g0, g1, u0, u1, lane);
            gather_compute(b0, hv, acc, lane);
            if (g + 1 < NG) {
                if (g + 3 < NG) gather_load(p, b0, g + 3, idx0, idx1, g0, g1, u0, u1, lane);
                gather_compute(b1, hv, acc, lane);
            }
            if (g + 2 < NG) {
                if (g + 4 < NG) gather_load(p, b1, g + 4, idx0, idx1, g0, g1, u0, u1, lane);
                gather_compute(b2, hv, acc, lane);
            }
        }
        float xn[16]; float ss = 0.f;
#pragma unroll
        for (int j = 0; j < 16; ++j) xn[j] = 0.f;
        if (act) {
            const float* g2p = p.MOD + (size_t)(l * 2 + (t >= CTX ? 1 : 0)) * 6 * D_MODEL + 5 * D_MODEL + lane * 16;
            float* xp = p.X + (size_t)t * D_MODEL + lane * 16;
            float4 g2q[4], xq[4];
#pragma unroll
            for (int c = 0; c < 4; ++c) { g2q[c] = *(const float4*)(g2p + c * 4); xq[c] = *(const float4*)(xp + c * 4); }
#pragma unroll
            for (int c = 0; c < 4; ++c) {
                float4 x = xq[c];
                x.x += g2q[c].x * acc[2 * c].x; x.y += g2q[c].y * acc[2 * c].y; x.z += g2q[c].z * acc[2 * c + 1].x; x.w += g2q[c].w * acc[2 * c + 1].y;
                if (l + 1 < DEPTH) *(float4*)(xp + c * 4) = x;
                xn[c * 4 + 0] = x.x; xn[c * 4 + 1] = x.y; xn[c * 4 + 2] = x.z; xn[c * 4 + 3] = x.w;
                ss += x.x * x.x + x.y * x.y + x.z * x.z + x.w * x.w;
            }
        }
        ss = wave_sum(ss);
        const float rstd = rsqrtf(ss / D_MODEL + 1e-6f);
        if (act) {
            if (l + 1 < DEPTH) {
                const float* gn = p.in[I_N1G] + (size_t)(l + 1) * D_MODEL + lane * 16;
                const float* mod = p.MOD + (size_t)((l + 1) * 2 + (t >= CTX ? 1 : 0)) * 6 * D_MODEL + lane * 16;
                float o[16];
#pragma unroll
                for (int j = 0; j < 16; ++j) o[j] = xn[j] * rstd * gn[j] * (1.0f + mod[D_MODEL + j]) + mod[j];
                u32x4 w0, w1;
                w0.x = pack2bf(o[0], o[1]); w0.y = pack2bf(o[2], o[3]); w0.z = pack2bf(o[4], o[5]); w0.w = pack2bf(o[6], o[7]);
                w1.x = pack2bf(o[8], o[9]); w1.y = pack2bf(o[10], o[11]); w1.z = pack2bf(o[12], o[13]); w1.w = pack2bf(o[14], o[15]);
                *(u32x4*)(p.H + (size_t)t * D_MODEL + lane * 16) = w0; *(u32x4*)(p.H + (size_t)t * D_MODEL + lane * 16 + 8) = w1;
            } else if (t >= CTX) {
                const float* fg = p.in[I_FG] + lane * 16;
                float* op = p.out + (size_t)(t - CTX) * D_MODEL + lane * 16;
#pragma unroll
                for (int c = 0; c < 4; ++c) {
                    float4 o; o.x = xn[c * 4 + 0] * rstd * fg[c * 4 + 0]; o.y = xn[c * 4 + 1] * rstd * fg[c * 4 + 1]; o.z = xn[c * 4 + 2] * rstd * fg[c * 4 + 2]; o.w = xn[c * 4 + 3] * rstd * fg[c * 4 + 3];
                    *(float4*)(op + c * 4) = o;
                }
            }
        }
    }
}
__device__ __forceinline__ void phase_final(const P& p) {
    const int lane = otid() & 63;
    const int gw = (obid() * NTHREADS + otid()) >> 6, nw = (gridDim.x * NTHREADS) >> 6;
    const float* g = p.in[I_FG];
    for (int t = gw; t < SEQ; t += nw) {
        const float* x = p.X + (size_t)(CTX + t) * D_MODEL;
        float v[D_MODEL / 64]; float ss = 0.f;
#pragma unroll
        for (int j = 0; j < D_MODEL / 64; ++j) { v[j] = x[lane + 64 * j]; ss += v[j] * v[j]; }
        ss = wave_sum(ss);
        float rstd = rsqrtf(ss / D_MODEL + 1e-6f);
#pragma unroll
        for (int j = 0; j < D_MODEL / 64; ++j) p.out[(size_t)t * D_MODEL + lane + 64 * j] = v[j] * rstd * g[lane + 64 * j];
    }
}

__global__ void __launch_bounds__(NTHREADS) fwd_megakernel(P p_arg) {
#ifdef EMU
    char* smem = emu_smem();
#else
    __shared__ __attribute__((aligned(16))) char smem_raw[SMEM_BYTES + 16];
    char* smem = smem_raw;
#endif
#ifndef EMU
    volatile LAS unsigned* xst = (volatile LAS unsigned*)(smem_raw + SMEM_BYTES);
    if (threadIdx.x == 0) { xst[0] = 0u; xst[1] = 0u; xst[2] = 0u; xst[3] = 0u; }
    __syncthreads();
    XcdBarrier xb = xcd_barrier_post(p_arg.bar, xst);
#endif
    { LOADP(); phase_init(p, smem); }
#ifndef EMU
    GRID_SYNC_CG();
#endif
#ifdef EMU
    GRID_SYNC();
#endif
#ifndef EMU
    if (threadIdx.x == 0) {
        unsigned base_ = 0;
        for (unsigned j = 0; j < xb.x; ++j) base_ += xb_ld(&p_arg.bar[XB_XCNT(j)]);
        xst[2] = base_ + xst[3];
    }
    __syncthreads();
#endif
    PROBE_INIT();
    for (int l = 0; l < DEPTH; ++l) {
        if (l == 0) {
            { LOADP(); phase_norm(p, 0, 0); }
            { LOADP(); phase_s5const(p, 0); }
            { LOADP(); phase_convert_weights(p, 0, smem, obid(), (int)gridDim.x); }
            GRID_SYNC(); PROBE_AFTER(0);
        }
        { LOADP(); phase_gemm_in(p, l, smem); }
        GRID_SYNC(); PROBE_AFTER(1);
        { LOADP(); phase_rwkv_prep1(p, l); }
        GRID_SYNC(); PROBE_AFTER(14);
        { LOADP(); ChunkPre cpre; const int tot_ = 2 * NC * RH, G2_ = (int)gridDim.x;
          if (obid() < tot_) rwkv_chunk_fetch(p, obid(), cpre);
          for (int job = obid(); job < tot_; job += G2_) rwkv_chunk_job(p, l, job, (job + G2_ < tot_) ? job + G2_ : -1, cpre, smem); }
        __syncthreads(); PROBE_AFTER(20);
        { LOADP(); phase_gla_kv(p, l, smem); }
        PROBE_AFTER(21);
        { LOADP(); phase_s5_pass(p, l, smem, false); }
        GRID_SYNC(); PROBE_AFTER(3);
        {
            LOADP();
            const int n_rw = 2 * RH, n_gla = 2 * GH * 8192 / NTHREADS, n_s5 = (2 * SG * 64 + NTHREADS - 1) / NTHREADS;
            const int G_ = (int)gridDim.x;
            if (G_ > 2 * n_rw) {
                if (obid() < n_rw) { rwkv_seq_job(p, obid(), smem); PROBE_AFTER(24); }
                else {
                    const int nb = G_ - n_rw, bid = obid() - n_rw;
                    for (int job = bid; job < n_gla + n_s5 + PEER_CONV_JOBS; job += nb) {
                        if (job < n_gla) gla_scan_job(p, job);
                        else if (job < n_gla + n_s5) s5_carry_job(p, job - n_gla);
                        else peer_conv_job(p, l, job - n_gla - n_s5);
                    }
                    { P pg = p; late_select(pg, l & 1); for (int job = bid; job < G2_JOBS; job += nb) g2_gemm_job(pg, job, smem); }
                    if (l + 1 < DEPTH) { late_select(p, (l + 1) & 1); phase_convert_weights(p, l + 1, smem, bid, nb); }
                }
            } else {
                for (int job = obid(); job < n_rw + n_gla + n_s5 + PEER_CONV_JOBS; job += G_) {
                    if (job < n_rw) rwkv_seq_job(p, job, smem);
                    else if (job < n_rw + n_gla) gla_scan_job(p, job - n_rw);
                    else if (job < n_rw + n_gla + n_s5) s5_carry_job(p, job - n_rw - n_gla);
                    else peer_conv_job(p, l, job - n_rw - n_gla - n_s5);
                }
                __syncthreads();
                { P pg = p; late_select(pg, l & 1); for (int job = obid(); job < G2_JOBS; job += G_) g2_gemm_job(pg, job, smem); }
                if (l + 1 < DEPTH) { late_select(p, (l + 1) & 1); phase_convert_weights(p, l + 1, smem, obid(), G_); }
            }
        }
        GRID_SYNC(); PROBE_AFTER(4);
        { LOADP(); phase_rwkv_out(p); }
        PROBE_AFTER(22);
        { LOADP(); phase_gla_out(p, l, smem); }
        PROBE_AFTER(23);
        { LOADP(); phase_s5_pass(p, l, smem, true); }
        GRID_SYNC(); PROBE_AFTER(5);
        { LOADP(); phase_side_elem(p, l); }
        if (l + 1 < DEPTH) { LOADP(); phase_s5const(p, l + 1); }
        { LOADP(); late_select(p, l & 1); phase_glu_gemm(p, l, smem); }
        GRID_SYNC(); PROBE_AFTER(7);
        { LOADP(); late_select(p, l & 1); phase_merge(p, l, smem); }
        GRID_SYNC(); PROBE_AFTER(8);
        { LOADP(); late_select(p, l & 1); phase_outproj(p, l, smem); }
        GRID_SYNC(); PROBE_AFTER(9);
        { LOADP(); phase_norm(p, l, 1); }
        GRID_SYNC(); PROBE_AFTER(10);
        { LOADP(); late_select(p, l & 1); phase_peer_q(p, l, smem); }
        GRID_SYNC(); PROBE_AFTER(11);
        { LOADP(); late_select(p, l & 1); phase_peer_topk(p, l, smem); }
        GRID_SYNC(); PROBE_AFTER(12);
        { LOADP(); phase_peer_gather(p, l); }
        if (l + 1 < DEPTH) { GRID_SYNC(); PROBE_AFTER(13); }
    }
}

static inline size_t align_up(size_t x) { return (x + 255) & ~(size_t)255; }

extern "C" void kernel_launch(void* const* d_in, const int* in_sizes, int n_in, void* d_out, int out_size, void* d_ws, size_t ws_size, hipStream_t stream) {
    P p;
    memset(&p, 0, sizeof(p));
    for (int i = 0; i < 39; ++i) p.in[i] = (const float*)d_in[i];
    p.out = (float*)d_out;
    char* w = (char*)d_ws; size_t off = 0;
    auto take = [&](size_t bytes) { void* r = w + off; off = align_up(off + bytes); return r; };
    p.bar = (unsigned*)take(16384);
    p.X = (float*)take((size_t)MTOT * D_MODEL * 4);
    p.H = (bf16_t*)take((size_t)MTOT * D_MODEL * 2);
    p.MOD = (float*)take((size_t)DEPTH * 2 * 6 * D_MODEL * 4);
    p.Z = (bf16_t*)take((size_t)MTOT * ZLD * 2);
    p.ZGT = (bf16_t*)take((size_t)MTOT * 3 * D_MODEL * 2);
    p.V = (bf16_t*)take((size_t)MTOT * RW * 2);
    {
        char* ra = (char*)take((size_t)MTOT * RW * 2 * 2 > (size_t)MTOT * GLA_V * 4 ? (size_t)MTOT * RW * 2 * 2 : (size_t)MTOT * GLA_V * 4);
        p.R = (bf16_t*)ra; p.KK = (bf16_t*)(ra + (size_t)MTOT * RW * 2);
        p.OGLA = (float*)ra;
    }
    {
        char* rb = (char*)take((size_t)2 * MTOT * RW * 2 > (size_t)3 * MTOT * PH * 16 * 4 ? (size_t)2 * MTOT * RW * 2 : (size_t)3 * MTOT * PH * 16 * 4);
        p.KD = (bf16_t*)rb;
        p.IDX = (int*)rb; p.G = (float*)(rb + (size_t)MTOT * PH * 16 * 4); p.GU = (float*)(rb + (size_t)2 * MTOT * PH * 16 * 4);
    }
    p.BB = (bf16_t*)take((size_t)2 * MTOT * RW * 2);
    p.G2B = p.BB;
    p.LW = (float*)take((size_t)2 * MTOT * RW * 4);
    p.SP = (bf16_t*)p.LW;
    static_assert((size_t)2 * NC * GH * 8192 * 2 <= (size_t)2 * MTOT * RW * 4, "SP alias");
    p.BONUS = (float*)take((size_t)2 * MTOT * RH * 4);
    p.KS = (bf16_t*)take((size_t)MTOT * RW * 2);
    p.LR = (bf16_t*)take((size_t)MTOT * 256 * 2);
    p.WT_W2 = (bf16_t*)take((size_t)2 * NPAD(RW) * 64 * 2);
    p.WT_A2 = (bf16_t*)take((size_t)2 * NPAD(RW) * 64 * 2);
    p.GS = (bf16_t*)take((size_t)MTOT * 128 * 2);
    p.Y = (float*)take((size_t)2 * MTOT * RW * 4);
    p.Y0T = (float*)take((size_t)2 * NC * RH * 4096 * 4);
    p.KV = (float*)take((size_t)2 * NC * GH * 8192 * 4);
    p.DEC = (float*)take((size_t)2 * NC * GH * 64 * 4);
    p.S5A = (float*)take((size_t)2 * SG * 64 * 2 * 4);
    p.S5BB = (float*)take((size_t)2 * SG * 64 * 16 * 2 * 4);
    p.S5END = (float*)take((size_t)2 * NC * SG * 64 * 2 * 4);
    p.S5CAR = (float*)take((size_t)2 * NC * SG * 64 * 2 * 4);
    {
        const size_t szc1 = (size_t)2 * NC * RH * SEQ_REC;
        const size_t szc2 = (size_t)MTOT * SW * 2 + (size_t)MTOT * RW * 4 + (size_t)MTOT * 3 * BW * 2 + (size_t)MTOT * D_MODEL * 2 + 1024;
        char* rc = (char*)take(szc1 > szc2 ? szc1 : szc2);
        p.REC = rc;
        char* c2 = rc;
        p.GY = (bf16_t*)c2; c2 += align_up((size_t)MTOT * SW * 2);
        p.YN = (float*)c2; c2 += align_up((size_t)MTOT * RW * 4);
        p.BR = (bf16_t*)c2; c2 += align_up((size_t)MTOT * 3 * BW * 2);
        p.M = (bf16_t*)c2;
    }
    p.SN = (bf16_t*)take((size_t)2 * NC * RH * 4096 * 2);
    p.QH = (bf16_t*)take((size_t)2 * NC * RH * 4096 * 2);
    p.WT_IN = (bf16_t*)take((size_t)NPAD192(D_IN) * D_MODEL * 2);
    {
        char* lb = (char*)take(2 * LATE_BYTES); size_t lo = 0;
        auto ltake = [&](size_t bytes) { void* r = lb + lo; lo = AL256(lo + bytes); return r; };
        p.WT_G2 = (bf16_t*)ltake((size_t)NPAD(RW) * 128 * 2);
        p.WT_GLU = (bf16_t*)ltake((size_t)NPAD(2 * SW) * SW * 2);
        p.WT_BR = (bf16_t*)ltake((size_t)3 * D_MODEL * BW * 2);
        p.WT_OUT = (bf16_t*)ltake((size_t)D_MODEL * D_MODEL * 2);
        p.WT_Q = (bf16_t*)ltake((size_t)PQ * D_MODEL * 2);
        p.KHI = (bf16_t*)ltake((size_t)PH * 2 * 128 * 128 * 2); p.KLO = (bf16_t*)ltake((size_t)PH * 2 * 128 * 128 * 2);
        if (lo != LATE_BYTES) fprintf(stderr, "late weights layout mismatch\n");
    }
    p.U8 = (unsigned char*)take((size_t)NEXP * D_MODEL);
    p.V8 = (unsigned char*)take((size_t)NEXP * D_MODEL);
    p.USC = (float*)take((size_t)NEXP * 4); p.VSC = (float*)take((size_t)NEXP * 4);
    p.QHI = p.Z; p.QLO = p.Z + (size_t)MTOT * PQ;
    static_assert((size_t)PQ * 4 <= (size_t)D_IN * 2 && ((size_t)MTOT * ZLD * 2) % 256 == 0, "Q alias");
    if (off > ws_size) { fprintf(stderr, "ws too small: need %zu have %zu\n", off, ws_size); return; }
#ifdef EMU
    fprintf(stderr, "ws used %zu MB\n", off >> 20);
    emu_launch([=] { fwd_megakernel(p); }, EMU_GRID, NTHREADS);
#else
    hipMemsetAsync(p.bar, 0, 16384, stream);
    static int grid_blocks = 0;
    if (!grid_blocks) {
        int dev = 0, cus = 0, per_cu = 0;
        hipGetDevice(&dev);
        hipDeviceGetAttribute(&cus, hipDeviceAttributeMultiprocessorCount, dev);
        hipOccupancyMaxActiveBlocksPerMultiprocessor(&per_cu, fwd_megakernel, NTHREADS, 0);
        if (per_cu > 1) per_cu = 1;
        grid_blocks = cus * per_cu;
    }
    void* args[] = {&p};
    hipError_t e = hipLaunchCooperativeKernel((void*)fwd_megakernel, dim3(grid_blocks), dim3(NTHREADS), args, 0, stream);
    if (e != hipSuccess) fprintf(stderr, "cooperative launch failed: %s (grid %d)\n", hipGetErrorString(e), grid_blocks);
#endif
}
```
